# Optimizing an MI355X kernel written in HIP

```python
import jax, jax.numpy as jnp
from jax import lax
import numpy as np

D_MODEL = 1024
BATCH = 4
SEQ = 4096
DEPTH = 2

CHUNK = 64
EPS = 1e-6
NEG_BIG = -1e30
D_MIX = D_MODEL
A_HEADS = 8
A_KV_HEADS = 2
HEAD_DIM = 64
IDX_HEADS = 4
IDX_DIM = 64
IDX_TOPK_MAX = 256
Q_BLOCK = 128
ROPE_THETA = 10000.0
A_WIDTH = A_HEADS * HEAD_DIM
POOL_WINDOWS = (2, 4, 8, 16)
POOL_GROUP = 64
B_WIDTH = len(POOL_WINDOWS) * POOL_GROUP
C_HEADS = 4
C_KDIM = 64
C_VDIM = 64
C_WIDTH = C_HEADS * C_VDIM
N_EXPERTS = 32
TOP_K = 4
D_FF = D_MODEL
SWIGLU_LIMIT = 7.0
SWIGLU_ALPHA = 1.702
MOE_BLOCK = 128
IN_SPLITS = (A_WIDTH, A_KV_HEADS * HEAD_DIM, A_KV_HEADS * HEAD_DIM,
             IDX_HEADS * IDX_DIM, IDX_DIM, IDX_HEADS,
             B_WIDTH,
             C_HEADS * C_KDIM, C_HEADS * C_KDIM, C_WIDTH, C_WIDTH)
D_IN = sum(IN_SPLITS)

kernel_name = "chunk_causal_hybrid_dsa_pool_hgrn2_moe"


def rms_norm(x, g):
    xf = x.astype(jnp.float32)
    y = xf * lax.rsqrt(jnp.mean(xf * xf, axis=-1, keepdims=True) + EPS)
    return (y * g.astype(jnp.float32)).astype(x.dtype)


def rope(x, pos):
    d = x.shape[-1]
    inv = jnp.power(jnp.float32(ROPE_THETA), -jnp.arange(0, d, 2, dtype=jnp.float32) / d)
    ang = pos.astype(jnp.float32)[..., None] * inv
    cos = jnp.cos(ang)[:, :, None, :]
    sin = jnp.sin(ang)[:, :, None, :]
    xf = x.astype(jnp.float32)
    x1, x2 = xf[..., : d // 2], xf[..., d // 2:]
    return jnp.concatenate([x1 * cos - x2 * sin, x2 * cos + x1 * sin], axis=-1).astype(x.dtype)


def split_cols(z):
    out, off = [], 0
    for n in IN_SPLITS:
        out.append(z[..., off:off + n])
        off += n
    return out


def dsa_mixer(q, k, v, qi, ki, wi, pos):
    B_, S_, _ = q.shape
    q = rope(q.reshape(B_, S_, A_HEADS, HEAD_DIM), pos)
    k = rope(k.reshape(B_, S_, A_KV_HEADS, HEAD_DIM), pos)
    v = v.reshape(B_, S_, A_KV_HEADS, HEAD_DIM)
    qi = rope(qi.reshape(B_, S_, IDX_HEADS, IDX_DIM), pos).astype(jnp.float32)
    ki = rope(ki.reshape(B_, S_, 1, IDX_DIM), pos)[:, :, 0].astype(jnp.float32)
    wi = wi.astype(jnp.float32) * (IDX_HEADS * IDX_DIM) ** -0.5
    topk = min(IDX_TOPK_MAX, S_ // 4)
    group = A_HEADS // A_KV_HEADS
    key_pos = jnp.arange(S_)
    n_blocks = S_ // Q_BLOCK

    def block(i):
        t0 = i * Q_BLOCK
        qb = lax.dynamic_slice_in_dim(q, t0, Q_BLOCK, axis=1)
        qib = lax.dynamic_slice_in_dim(qi, t0, Q_BLOCK, axis=1)
        wib = lax.dynamic_slice_in_dim(wi, t0, Q_BLOCK, axis=1)
        t_idx = t0 + jnp.arange(Q_BLOCK)
        limit = (t_idx // CHUNK + 1) * CHUNK
        admissible = key_pos[None, :] < limit[:, None]
        s = jnp.einsum('bthd,bsd->bths', qib, ki)
        score = jnp.einsum('bths,bth->bts', jax.nn.relu(s), wib)
        score = jnp.where(admissible[None], score, NEG_BIG)
        _, sel = lax.top_k(score, topk)
        valid = sel < limit[None, :, None]
        k_sel = jax.vmap(lambda kb, ib: kb[ib])(k, sel)
        v_sel = jax.vmap(lambda vb, ib: vb[ib])(v, sel)
        qg = qb.reshape(B_, Q_BLOCK, A_KV_HEADS, group, HEAD_DIM).astype(jnp.float32)
        logits = jnp.einsum('btngd,btknd->btngk', qg, k_sel.astype(jnp.float32)) * HEAD_DIM ** -0.5
        logits = jnp.where(valid[:, :, None, None, :], logits, NEG_BIG)
        p = jax.nn.softmax(logits, axis=-1)
        o = jnp.einsum('btngk,btknd->btngd', p, v_sel.astype(jnp.float32))
        return o.reshape(B_, Q_BLOCK, A_WIDTH).astype(q.dtype)

    out = lax.map(block, jnp.arange(n_blocks))
    return out.transpose(1, 0, 2, 3).reshape(B_, S_, A_WIDTH)


def pool_mixer(u, w_pool, pool_scale):
    B_, S_, _ = u.shape
    uf = u.astype(jnp.float32).reshape(B_, S_, len(POOL_WINDOWS), POOL_GROUP)
    cs = jnp.cumsum(uf, axis=1)
    outs = []
    for g, w in enumerate(POOL_WINDOWS):
        cg = cs[:, :, g]
        prev = jnp.pad(cg, ((0, 0), (w, 0), (0, 0)))[:, :S_]
        cnt = jnp.minimum(jnp.arange(1, S_ + 1), w).astype(jnp.float32)[None, :, None]
        outs.append((cg - prev) / cnt - uf[:, :, g])
    pooled = jnp.stack(outs, axis=2)
    y = jnp.einsum('bsgc,gce->bsge', pooled, w_pool.astype(jnp.float32))
    return (y.reshape(B_, S_, B_WIDTH) * pool_scale.astype(jnp.float32)).astype(u.dtype)


def hgrn2_mixer(q, fz, i, g, lb, norm_g):
    B_, S_, _ = q.shape
    nC = S_ // CHUNK
    zf = fz.astype(jnp.float32)
    lbf = lb.astype(jnp.float32)
    f = lbf + (1.0 - lbf) * jax.nn.sigmoid(zf)
    log_f = jnp.log(f)
    k_in = (1.0 - lbf) * jax.nn.sigmoid(-zf)

    def heads(a, d):
        return a.astype(jnp.float32).reshape(B_, nC, CHUNK, C_HEADS, d).transpose(1, 0, 3, 2, 4)

    qh = heads(jax.nn.silu(q.astype(jnp.float32)), C_KDIM)
    lfh = heads(log_f, C_KDIM)
    kh = heads(k_in, C_KDIM)
    vh = heads(i, C_VDIM)
    causal = jnp.tril(jnp.ones((CHUNK, CHUNK), dtype=bool))

    def step(state, xs):
        qc, lfc, kc, vc = xs
        b = jnp.cumsum(lfc, axis=2)
        o_inter = jnp.einsum('bhtk,bhkv->bhtv', qc * jnp.exp(b), state)
        diff = jnp.where(causal[None, None, :, :, None],
                         b[:, :, :, None, :] - b[:, :, None, :, :], NEG_BIG)
        attn = jnp.einsum('bhtk,bhtsk,bhsk->bhts', qc, jnp.exp(diff), kc)
        o = o_inter + jnp.einsum('bhts,bhsv->bhtv', attn, vc)
        b_last = b[:, :, -1, :]
        state = jnp.exp(b_last)[..., None] * state + jnp.einsum(
            'bhsk,bhsv->bhkv', kc * jnp.exp(b_last[:, :, None, :] - b), vc)
        return state, o

    s0 = jnp.zeros((B_, C_HEADS, C_KDIM, C_VDIM), jnp.float32)
    _, o = lax.scan(step, s0, (qh, lfh, kh, vh))
    o = o.transpose(1, 0, 3, 2, 4).reshape(B_, S_, C_HEADS, C_VDIM)
    o = rms_norm(o, norm_g).reshape(B_, S_, C_WIDTH) * jax.nn.silu(g.astype(jnp.float32))
    return o.astype(q.dtype)


def token_mix(u, pos, w_in, w_out, pool_w, pool_scale, hgrn_g, lb):
    z = u @ w_in
    qa, ka, va, qi, ki, wi, ub, qc, fc, ic, gc = split_cols(z)
    ya = dsa_mixer(qa, ka, va, qi, ki, wi, pos)
    yb = pool_mixer(ub, pool_w, pool_scale)
    yc = hgrn2_mixer(qc, fc, ic, gc, lb, hgrn_g)
    return jnp.concatenate([ya, yb, yc], axis=-1) @ w_out


def moe(h, w_router, b_router, w1, b1, w2, b2):
    B_, S_, D_ = h.shape
    N = B_ * S_
    xf = h.reshape(N, D_)
    logits = xf.astype(jnp.float32) @ w_router.astype(jnp.float32) + b_router.astype(jnp.float32)
    top_val, top_idx = lax.top_k(logits, TOP_K)
    gates = jax.nn.softmax(top_val, axis=-1)
    A = N * TOP_K
    e_flat = top_idx.reshape(A)
    order = jnp.argsort(e_flat)
    e_sorted = e_flat[order]
    tok_sorted = order // TOP_K
    gate_sorted = gates.reshape(A)[order]
    counts = jnp.bincount(e_flat, length=N_EXPERTS)
    starts = jnp.cumsum(counts) - counts
    padded = (counts + MOE_BLOCK - 1) // MOE_BLOCK * MOE_BLOCK
    pad_ends = jnp.cumsum(padded)
    pad_starts = pad_ends - padded
    dest = pad_starts[e_sorted] + jnp.arange(A) - starts[e_sorted]
    nb = -(-A // MOE_BLOCK) + N_EXPERTS
    x_pad = jnp.zeros((nb * MOE_BLOCK, D_), h.dtype).at[dest].set(xf[tok_sorted])
    blk_e = jnp.minimum(jnp.searchsorted(pad_ends, jnp.arange(nb) * MOE_BLOCK, side='right'),
                        N_EXPERTS - 1)

    def expert_block(args):
        xb, e = args
        hid = xb @ w1[e] + b1[e]
        x_glu = jnp.minimum(hid[:, 0::2], SWIGLU_LIMIT)
        x_lin = jnp.clip(hid[:, 1::2], -SWIGLU_LIMIT, SWIGLU_LIMIT)
        act = x_glu * jax.nn.sigmoid(SWIGLU_ALPHA * x_glu) * (x_lin + 1.0)
        return act @ w2[e] + b2[e]

    y_pad = lax.map(expert_block, (x_pad.reshape(nb, MOE_BLOCK, D_), blk_e))
    y_sorted = y_pad.reshape(nb * MOE_BLOCK, D_)[dest] * gate_sorted[:, None].astype(h.dtype)
    y = jnp.zeros((N, D_), h.dtype).at[tok_sorted].add(y_sorted)
    return y.reshape(B_, S_, D_)


def setup_inputs(seed: int = 0) -> dict:
    key = jax.random.key(seed)
    ks = jax.random.split(key, 24)
    f32 = jnp.float32
    nrm = lambda k, shape, s: jax.random.normal(k, shape, f32) * s
    x = jax.random.normal(ks[0], (BATCH, SEQ, D_MODEL), f32)
    c = jax.random.normal(ks[1], (BATCH, D_MODEL), f32)
    offset = jax.random.randint(ks[2], (BATCH, 1), 0, 4096, dtype=jnp.int32)
    positions = offset + jnp.arange(SEQ, dtype=jnp.int32)[None, :]
    return {
        "x": x,
        "c": c,
        "positions": positions,
        "w_ada": nrm(ks[3], (DEPTH, D_MODEL, 6 * D_MODEL), 0.5 * D_MODEL ** -0.5),
        "b_ada": nrm(ks[4], (DEPTH, 6 * D_MODEL), 0.02),
        "norm1_g": 1.0 + nrm(ks[5], (DEPTH, D_MODEL), 0.1),
        "norm2_g": 1.0 + nrm(ks[6], (DEPTH, D_MODEL), 0.1),
        "w_in": nrm(ks[7], (DEPTH, D_MODEL, D_IN), D_MODEL ** -0.5),
        "w_out": nrm(ks[8], (DEPTH, D_MIX, D_MODEL), D_MIX ** -0.5),
        "pool_w": nrm(ks[9], (DEPTH, len(POOL_WINDOWS), POOL_GROUP, POOL_GROUP), POOL_GROUP ** -0.5),
        "pool_scale": 1.0 + nrm(ks[10], (DEPTH, B_WIDTH), 0.1),
        "hgrn_norm_g": 1.0 + nrm(ks[11], (DEPTH, C_VDIM), 0.1),
        "lb_logits": nrm(ks[12], (DEPTH, C_HEADS * C_KDIM), 1.0),
        "w_router": nrm(ks[13], (DEPTH, D_MODEL, N_EXPERTS), D_MODEL ** -0.5),
        "b_router": nrm(ks[14], (DEPTH, N_EXPERTS), 0.01),
        "w1": nrm(ks[15], (DEPTH, N_EXPERTS, D_MODEL, 2 * D_FF), D_MODEL ** -0.5),
        "b1": nrm(ks[16], (DEPTH, N_EXPERTS, 2 * D_FF), 0.01),
        "w2": nrm(ks[17], (DEPTH, N_EXPERTS, D_FF, D_MODEL), D_FF ** -0.5),
        "b2": nrm(ks[18], (DEPTH, N_EXPERTS, D_MODEL), 0.01),
        "final_g": 1.0 + nrm(ks[19], (D_MODEL,), 0.1),
    }


def reference(x, c, positions, w_ada, b_ada, norm1_g, norm2_g, w_in, w_out, pool_w,
              pool_scale, hgrn_norm_g, lb_logits, w_router, b_router, w1, b1, w2, b2, final_g):
    p = jax.nn.softmax(lb_logits.astype(jnp.float32), axis=0)
    lower_bounds = jnp.clip(jnp.cumsum(p, axis=0) - p[0], 0.0, 1.0)
    c_act = jax.nn.silu(c)
    h = x
    for l in range(DEPTH):
        mod = c_act @ w_ada[l] + b_ada[l]
        sh1, sc1, g1, sh2, sc2, g2 = [m[:, None, :] for m in jnp.split(mod, 6, axis=-1)]
        u = rms_norm(h, norm1_g[l]) * (1.0 + sc1) + sh1
        h = h + g1 * token_mix(u, positions, w_in[l], w_out[l], pool_w[l], pool_scale[l],
                               hgrn_norm_g[l], lower_bounds[l])
        u = rms_norm(h, norm2_g[l]) * (1.0 + sc2) + sh2
        h = h + g2 * moe(u, w_router[l], b_router[l], w1[l], b1[l], w2[l], b2[l])
    return rms_norm(h, final_g)
```

```cpp
#include <hip/hip_runtime.h>
#include <hip/hip_cooperative_groups.h>
#include <cstdio>
#include <cstdint>
namespace cg = cooperative_groups;

#ifndef MK_ONE_LAUNCH
#define MK_ONE_LAUNCH 0
#endif

#define LAS __attribute__((address_space(3)))
typedef unsigned short bf16_t;
typedef short bf16x8 __attribute__((ext_vector_type(8)));
typedef float f32x4 __attribute__((ext_vector_type(4)));
typedef float f32x2 __attribute__((ext_vector_type(2)));
typedef unsigned u32x4 __attribute__((ext_vector_type(4)));
typedef unsigned u32x2 __attribute__((ext_vector_type(2)));

constexpr int D = 1024, NBATCH = 4, SEQ = 4096, NTOK = NBATCH * SEQ, DEPTH = 2;
constexpr int D_IN = 2372, NPAD = 2560;
constexpr int NE = 32, TOPK = 4, FF = 1024;
constexpr int NWAVES = 8, NTHREADS = 512;
constexpr float EPS = 1e-6f;
constexpr int ROWCAP = 73728;

constexpr size_t MiB = 1u << 20;
constexpr size_t WS_CTL = 0, CTL_BYTES = 1 * MiB;
constexpr size_t WS_MOD = 1 * MiB;
constexpr size_t WS_ROPEC = 2 * MiB;
constexpr size_t WS_ROPES = 4 * MiB;
constexpr size_t WS_WIN = 6 * MiB;
constexpr size_t WS_WOUT = 16 * MiB;
constexpr size_t WS_ROWTOK = 20 * MiB;
constexpr size_t WS_EIDX = 22 * MiB;
constexpr size_t WS_SLOT = 22 * MiB + 256 * 1024;
constexpr size_t WS_GATE = 22 * MiB + 512 * 1024;
constexpr size_t WS_WI = 23 * MiB;
constexpr size_t WS_KI = 24 * MiB;
constexpr size_t WS_K = 26 * MiB;
constexpr size_t WS_V = 30 * MiB;
constexpr size_t WS_QI = 34 * MiB;
constexpr size_t WS_Q = 42 * MiB;
constexpr size_t WS_UB = 58 * MiB;
constexpr size_t WS_HG = 74 * MiB;
constexpr size_t WS_SEL = 138 * MiB;
constexpr size_t WS_HL = 154 * MiB;
constexpr size_t WS_HD = 170 * MiB;
constexpr size_t WS_MIX = 171 * MiB;
constexpr size_t WS_U = 203 * MiB;
constexpr size_t WS_H = 235 * MiB;
constexpr size_t WS_W1 = 299 * MiB;
constexpr size_t WS_W2 = 555 * MiB;
constexpr size_t WS_ACT = 683 * MiB;
constexpr size_t WS_Y = 827 * MiB;
constexpr size_t WS_END = 971 * MiB;
constexpr int CW_CNT = 1024;
constexpr int CW_BAR = 8192;

constexpr int LDS_BYTES = 147456;
constexpr int LDS_TAB = 131072;
constexpr int LDS_PARK = 131072 + 1024;

__device__ __forceinline__ unsigned f2bf(float f) { unsigned u = __builtin_bit_cast(unsigned, f); return (u + 0x7fffu + ((u >> 16) & 1u)) >> 16; }
__device__ __forceinline__ unsigned pk2(float lo, float hi) { return f2bf(lo) | (f2bf(hi) << 16); }
__device__ __forceinline__ float bf2f(unsigned short b) { return __builtin_bit_cast(float, ((unsigned)b) << 16); }
__device__ __forceinline__ float bflo(unsigned w) { return __builtin_bit_cast(float, w << 16); }
__device__ __forceinline__ float bfhi(unsigned w) { return __builtin_bit_cast(float, w & 0xffff0000u); }
__device__ __forceinline__ float wave_sum(float v) {
#pragma unroll
    for (int o = 1; o < 64; o <<= 1) v += __shfl_xor(v, o);
    return v;
}
__device__ __forceinline__ float wave_max(float v) {
#pragma unroll
    for (int o = 1; o < 64; o <<= 1) v = fmaxf(v, __shfl_xor(v, o));
    return v;
}
__device__ __forceinline__ float sigmoidf_(float z) { return 1.0f / (1.0f + __expf(-z)); }
__device__ __forceinline__ float siluf_(float z) { return z / (1.0f + __expf(-z)); }

namespace pg8 {
constexpr int BM = 256, BK = 64, HALF = 128, HTB = HALF * BK * 2, STAGE_BYTES = 8 * HTB;
constexpr int KD = 1024, NKT = KD / BK;
__host__ __device__ __forceinline__ int lds_byte(int r, int c) { const int st = (r >> 4) * 2 + (c >> 5), rr = r & 15, cc = c & 31, ob = rr * 64 + cc * 2; return st * 1024 + (ob ^ (((ob >> 9) & 1) << 5)); }
__host__ __device__ __forceinline__ void stage_rc(int b, int& R, int& C) { const int st = b / 1024, sb = b % 1024, swz = sb ^ (((sb >> 9) & 1) << 5); R = (st >> 1) * 16 + swz / 64; C = (st & 1) * 32 + (swz % 64) / 2; }

struct Unit { const char* A; const char* B; const int* ridx; int nvalid; int row0, pn, e, b; };

template <class Epi, class Sched, bool GATHER, bool ALIGN_EPI>
__device__ __forceinline__ void gemm_phase(LAS unsigned char* lds, LAS unsigned* park, int tid_in, const Sched& S, const Epi& E) {
    const int tid = tid_in, wid = __builtin_amdgcn_readfirstlane(tid >> 6), lane = tid & 63, wr = wid >> 2, wc = wid & 3, fr = lane & 15, fq = lane >> 4;
    constexpr int K = KD, nt = NKT;
    unsigned voffB[2], vA[2][2];
#pragma unroll
    for (int i = 0; i < 2; ++i) { int R, C; stage_rc(tid * 16 + i * 8192, R, C); voffB[i] = (unsigned)(R * K + C) * 2u; }
    constexpr size_t kstep = (size_t)(BK * 2);
    constexpr size_t hstep = (size_t)HALF * K * 2;
    const unsigned ldsw = (unsigned)wid * 1024u;
    const int aoff = lds_byte(wr * 64 + fr, fq * 8), boff = lds_byte(wc * 32 + fr, fq * 8);
#define PG8_SA(b, h) (((b) * 2 + (h)) * HTB)
#define PG8_SB(b, h) ((4 + (b) * 2 + (h)) * HTB)
#define PG8_STAGE(bufoff, gbase, voff) do { _Pragma("unroll") for (int _i = 0; _i < 2; ++_i) \
        __builtin_amdgcn_global_load_lds((const unsigned*)((const char*)(gbase) + (voff)[_i]), (LAS unsigned*)(lds + (bufoff) + ldsw + _i * 8192), 16, 0, 0); } while (0)
#define PG8_LDA(dst, b, h) do { _Pragma("unroll") for (int m = 0; m < 4; ++m) _Pragma("unroll") for (int k = 0; k < 2; ++k) dst[m][k] = *(const LAS bf16x8*)(lds + PG8_SA(b, h) + aoff + m * 2048 + k * 1024); } while (0)
#define PG8_LDB(dst, b, h) do { _Pragma("unroll") for (int n = 0; n < 2; ++n) _Pragma("unroll") for (int k = 0; k < 2; ++k) dst[n][k] = *(const LAS bf16x8*)(lds + PG8_SB(b, h) + boff + n * 2048 + k * 1024); } while (0)
#define PG8_MMA(ai, bj, At, Bt) do { __builtin_amdgcn_s_setprio(1); _Pragma("unroll") for (int m = 0; m < 4; ++m) _Pragma("unroll") for (int n = 0; n < 2; ++n) _Pragma("unroll") for (int k = 0; k < 2; ++k) \
        acc[ai][bj][m][n] = __builtin_amdgcn_mfma_f32_16x16x32_bf16(Bt[n][k], At[m][k], acc[ai][bj][m][n], 0, 0, 0); __builtin_amdgcn_s_setprio(0); } while (0)
#define PG8_WAIT_V(n) asm volatile("s_waitcnt vmcnt(" #n ")" ::: "memory")
#define PG8_WAIT_L(n) asm volatile("s_waitcnt lgkmcnt(" #n ")" ::: "memory")
#define PG8_BAR __builtin_amdgcn_s_barrier()
#define PG8_SCHED __builtin_amdgcn_sched_barrier(0)
#define PG8_OFFS(dst, u) do { _Pragma("unroll") for (int _h = 0; _h < 2; ++_h) _Pragma("unroll") for (int _i = 0; _i < 2; ++_i) { \
        int _R, _C; stage_rc(tid * 16 + _i * 8192, _R, _C); const int _rr = _h * HALF + _R; \
        if constexpr (GATHER) { const int _ix = (u).ridx[_rr < (u).nvalid ? _rr : 0]; dst[_h][_i] = (unsigned)(_ix * K + _C) * 2u; } \
        else dst[_h][_i] = (unsigned)(_rr * K + _C) * 2u; } } while (0)
    Unit cur, nxt; int ui = 0;
    if (!S.next(0, cur)) return;
    f32x4 acc[2][2][4][2];
#pragma unroll
    for (int a = 0; a < 2; ++a)
#pragma unroll
        for (int b = 0; b < 2; ++b)
#pragma unroll
            for (int m = 0; m < 4; ++m)
#pragma unroll
                for (int n = 0; n < 2; ++n) acc[a][b][m][n] = (f32x4){0.f, 0.f, 0.f, 0.f};
    bf16x8 At[4][2], B0[2][2], B1[2][2];
    PG8_OFFS(vA, cur);
    const char* cA = cur.A; const char* cB = cur.B;
    PG8_STAGE(PG8_SB(0, 0), cB, voffB); PG8_STAGE(PG8_SB(0, 1), cB + hstep, voffB); PG8_STAGE(PG8_SA(0, 0), cA, vA[0]); PG8_STAGE(PG8_SA(0, 1), cA, vA[1]);
    if (wr == 1) PG8_BAR;
    PG8_WAIT_V(2); PG8_BAR;
    PG8_STAGE(PG8_SB(1, 0), cB + kstep, voffB); PG8_STAGE(PG8_SA(1, 0), cA + kstep, vA[0]); PG8_STAGE(PG8_SB(1, 1), cB + hstep + kstep, voffB);
    PG8_WAIT_V(6); PG8_BAR;
    for (;;) {
        const bool has_next = S.next(ui + 1, nxt);
        const char* nA = has_next ? nxt.A : cA; const char* nB = has_next ? nxt.B : cB;
        if constexpr (GATHER) {
            unsigned nv[2][2];
            if (has_next) { PG8_OFFS(nv, nxt); } else {
#pragma unroll
                for (int h = 0; h < 2; ++h) { nv[h][0] = vA[h][0]; nv[h][1] = vA[h][1]; } }
            *(LAS u32x4*)(park + tid * 4) = (u32x4){nv[0][0], nv[0][1], nv[1][0], nv[1][1]};
        }
        for (int t = 0; t < nt; t += 2) {
            const bool last = (t == nt - 2);
            const char* a1 = cA + (size_t)(t + 1) * kstep;
            const char* a2 = last ? nA : cA + (size_t)(t + 2) * kstep; const char* b2 = last ? nB : cB + (size_t)(t + 2) * kstep;
            const char* a3 = a2 + kstep; const char* b3 = b2 + kstep;
            PG8_LDB(B0, 0, 0); PG8_LDB(B1, 0, 1); PG8_SCHED; PG8_LDA(At, 0, 0); PG8_STAGE(PG8_SA(1, 1), a1, vA[1]);
            if constexpr (GATHER) { if (last) { const u32x4 pv = *(const LAS u32x4*)(park + tid * 4); vA[0][0] = pv.x; vA[0][1] = pv.y; vA[1][0] = pv.z; vA[1][1] = pv.w; } }
            PG8_WAIT_V(8); PG8_WAIT_L(0); PG8_BAR; PG8_MMA(0, 0, At, B0); PG8_MMA(0, 1, At, B1); PG8_BAR; PG8_SCHED;
            PG8_LDA(At, 0, 1); PG8_STAGE(PG8_SB(0, 0), b2, voffB); PG8_STAGE(PG8_SB(0, 1), b2 + hstep, voffB); PG8_STAGE(PG8_SA(0, 0), a2, vA[0]);
            PG8_WAIT_V(8); PG8_WAIT_L(0); PG8_BAR; PG8_MMA(1, 0, At, B0); PG8_MMA(1, 1, At, B1); PG8_BAR; PG8_SCHED;
            PG8_LDB(B0, 1, 0); PG8_LDB(B1, 1, 1); PG8_SCHED; PG8_LDA(At, 1, 0); PG8_STAGE(PG8_SA(0, 1), a2, vA[1]);
            PG8_WAIT_V(8); PG8_WAIT_L(0); PG8_BAR; PG8_MMA(0, 0, At, B0); PG8_MMA(0, 1, At, B1); PG8_BAR; PG8_SCHED;
            PG8_LDA(At, 1, 1); PG8_STAGE(PG8_SB(1, 0), b3, voffB); PG8_STAGE(PG8_SB(1, 1), b3 + hstep, voffB); PG8_STAGE(PG8_SA(1, 0), a3, vA[0]);
            PG8_WAIT_V(8); PG8_WAIT_L(0); PG8_BAR; PG8_MMA(1, 0, At, B0); PG8_MMA(1, 1, At, B1); PG8_BAR; PG8_SCHED;
        }
        if constexpr (ALIGN_EPI) { if (wr == 0) PG8_BAR; }
        { int fr2 = fr, fq2 = fq; asm volatile("" : "+v"(fr2), "+v"(fq2)); E(acc, cur, wr, wc, fr2, fq2); }
        if (!has_next) break;
#pragma unroll
        for (int a = 0; a < 2; ++a)
#pragma unroll
            for (int b = 0; b < 2; ++b)
#pragma unroll
                for (int m = 0; m < 4; ++m)
#pragma unroll
                    for (int n = 0; n < 2; ++n) acc[a][b][m][n] = (f32x4){0.f, 0.f, 0.f, 0.f};
        cur = nxt; cA = nA; cB = nB; ++ui;
        if constexpr (ALIGN_EPI) { if (wr == 1) PG8_BAR; }
    }
    PG8_WAIT_V(0);
    if constexpr (!ALIGN_EPI) { if (wr == 0) PG8_BAR; }
    PG8_BAR;
#undef PG8_SA
#undef PG8_SB
#undef PG8_STAGE
#undef PG8_LDA
#undef PG8_LDB
#undef PG8_MMA
#undef PG8_WAIT_V
#undef PG8_WAIT_L
#undef PG8_BAR
#undef PG8_SCHED
#undef PG8_OFFS
}
}

struct Args {
    const float* x; const float* c; const int* pos; const float* w_ada; const float* b_ada; const float* norm1_g; const float* norm2_g;
    const float* w_in; const float* w_out; const float* pool_w; const float* pool_scale; const float* hgrn_g; const float* lb_logits;
    const float* w_router; const float* b_router; const float* w1; const float* b1; const float* w2; const float* b2; const float* final_g;
    float* out; unsigned char* ws; int ph_lo, ph_hi;
};

struct Ctx {
    LAS unsigned char* lds;
    int tid, lane, wave, G, vcu;
    unsigned char* ws;
};

struct DenseOrder {
    const char* A; const char* B; int nM, nN, nwg, G, c;
    __device__ __forceinline__ bool next(int i, pg8::Unit& u) const {
        const long L = (long)i * G + c; if (L >= nwg) return false;
        int wgid = (int)L; { const int q = nwg / 8, r = nwg % 8, xcd = wgid % 8, off = wgid / 8; wgid = (xcd < r ? xcd * (q + 1) : r * (q + 1) + (xcd - r) * q) + off; }
        const int nig = 8 * nN, gid = wgid / nig, fm = gid * 8, gsz = (nM - fm) < 8 ? (nM - fm) : 8;
        const int pm = fm + ((wgid % nig) % gsz), pn = (wgid % nig) / gsz;
        u.A = A + (size_t)pm * 256 * pg8::KD * 2; u.B = B + (size_t)pn * 256 * pg8::KD * 2; u.ridx = nullptr; u.nvalid = 256; u.row0 = pm * 256; u.pn = pn; u.e = 0; u.b = pm >> 4;
        return true;
    }
};

template <bool FIRST> struct MoeOrder {
    LAS const int* tab; const char* A; const char* B; const int* rowtok; int G, c;
    static constexpr int NTN = FIRST ? 8 : 4;
    __device__ __forceinline__ bool next(int i, pg8::Unit& u) const {
        const int P = tab[32]; const long L = (long)i * G + c; if (L >= (long)P * NTN) return false;
        const int p = (int)(L / NTN), nt = (int)(L % NTN);
        int e = 0;
#pragma unroll 1
        for (int k = 1; k < 32; ++k) e = (tab[k] <= p) ? k : e;
        const int mt = p - tab[e], cnt = tab[33 + e];
        if (FIRST) { u.A = A; u.ridx = rowtok + e * NTOK + mt * 256; u.nvalid = (cnt - mt * 256) < 256 ? (cnt - mt * 256) : 256; u.B = B + ((size_t)e * 2048 + nt * 256) * pg8::KD * 2; }
        else { u.A = A + (size_t)p * 256 * pg8::KD * 2; u.ridx = nullptr; u.nvalid = 256; u.B = B + ((size_t)e * 1024 + nt * 256) * pg8::KD * 2; }
        u.row0 = p * 256; u.pn = nt; u.e = e; u.b = 0;
        return true;
    }
};

struct EpiIn {
    unsigned char* ws;
    __device__ __forceinline__ void operator()(const f32x4 (&acc)[2][2][4][2], const pg8::Unit& u, int wr, int wc, int fr, int fq) const {
        const int pn = u.pn;
        const float* rc = (const float*)(ws + WS_ROPEC); const float* rs = (const float*)(ws + WS_ROPES);
#pragma unroll
        for (int ai = 0; ai < 2; ++ai)
#pragma unroll
            for (int m = 0; m < 4; ++m) {
                const int r = u.row0 + ai * 128 + wr * 64 + m * 16 + fr;
#pragma unroll
                for (int bj = 0; bj < 2; ++bj) {
                    const f32x4 a0 = acc[ai][bj][m][0], a1 = acc[ai][bj][m][1];
                    const int g32 = bj * 4 + wc;
                    bool rope = false; bf16_t* dst = nullptr; float scl = 1.f;
                    if (pn <= 1) { rope = true; dst = (bf16_t*)(ws + WS_Q) + (size_t)r * 512 + (pn * 4 + (g32 >> 1)) * 64; scl = 0.125f; }
                    else if (pn == 2 && bj == 0) { rope = true; dst = (bf16_t*)(ws + WS_K) + (size_t)r * 128 + (g32 >> 1) * 64; }
                    else if (pn == 3) { rope = true; dst = (bf16_t*)(ws + WS_QI) + (size_t)r * 256 + (g32 >> 1) * 64; }
                    else if (pn == 4 && bj == 0 && wc < 2) { rope = true; dst = (bf16_t*)(ws + WS_KI) + (size_t)r * 64; }
                    if (rope) {
                        const int d = 16 * (g32 & 1) + 4 * fq;
                        const f32x4 cv = *(const f32x4*)(rc + (size_t)r * 32 + d), sv = *(const f32x4*)(rs + (size_t)r * 32 + d);
                        const f32x4 o1 = (a0 * cv - a1 * sv) * scl, o2 = (a1 * cv + a0 * sv) * scl;
                        u32x2 w1v, w2v; w1v.x = pk2(o1[0], o1[1]); w1v.y = pk2(o1[2], o1[3]); w2v.x = pk2(o2[0], o2[1]); w2v.y = pk2(o2[2], o2[3]);
                        *(u32x2*)(dst + d) = w1v; *(u32x2*)(dst + 32 + d) = w2v;
                    } else if (pn == 2) {
                        bf16_t* vp = (bf16_t*)(ws + WS_V) + (size_t)r * 128 + wc * 32 + 4 * fq;
                        u32x2 w0v, w1v; w0v.x = pk2(a0[0], a0[1]); w0v.y = pk2(a0[2], a0[3]); w1v.x = pk2(a1[0], a1[1]); w1v.y = pk2(a1[2], a1[3]);
                        *(u32x2*)(vp) = w0v; *(u32x2*)(vp + 16) = w1v;
                    } else if (pn == 4) {
                        if (bj == 0 && wc == 2 && fq == 0) *(f32x4*)((float*)(ws + WS_WI) + (size_t)r * 4) = a0 * 0.0625f;
                    } else if (pn == 5) {
                        float* p = (float*)(ws + WS_UB) + (size_t)r * 256 + bj * 128 + wc * 32 + 4 * fq;
                        *(f32x4*)p = a0; *(f32x4*)(p + 16) = a1;
                    } else if (pn >= 6) {
                        float* p = (float*)(ws + WS_HG) + (size_t)r * 1024 + (pn - 6) * 256 + bj * 128 + wc * 32 + 4 * fq;
                        *(f32x4*)p = a0; *(f32x4*)(p + 16) = a1;
                    }
                }
            }
    }
};
struct EpiOut {
    const float* hin; float* hout; const float* gate;
    __device__ __forceinline__ void operator()(const f32x4 (&acc)[2][2][4][2], const pg8::Unit& u, int wr, int wc, int fr, int fq) const {
        const int col0 = u.pn * 256 + wc * 32 + 4 * fq; const float* gp = gate + (size_t)u.b * 6144 + col0;
        f32x4 gv[2][2];
#pragma unroll
        for (int bj = 0; bj < 2; ++bj)
#pragma unroll
            for (int n = 0; n < 2; ++n) gv[bj][n] = *(const f32x4*)(gp + bj * 128 + n * 16);
#pragma unroll
        for (int ai = 0; ai < 2; ++ai)
#pragma unroll
            for (int m = 0; m < 4; ++m) { const size_t off = (size_t)(u.row0 + ai * 128 + wr * 64 + m * 16 + fr) * D + col0;
#pragma unroll
                for (int bj = 0; bj < 2; ++bj)
#pragma unroll
                    for (int n = 0; n < 2; ++n) { const f32x4 hv = *(const f32x4*)(hin + off + bj * 128 + n * 16); *(f32x4*)(hout + off + bj * 128 + n * 16) = hv + gv[bj][n] * acc[ai][bj][m][n]; }
                asm volatile("" ::: "memory"); }
    }
};
struct EpiG1 {
    bf16_t* act; const float* b1l;
    __device__ __forceinline__ void operator()(const f32x4 (&acc)[2][2][4][2], const pg8::Unit& u, int wr, int wc, int fr, int fq) const {
        f32x4 bg[2], bl[2];
#pragma unroll
        for (int bj = 0; bj < 2; ++bj) { const int ja = u.pn * 128 + (bj * 4 + wc) * 16 + 4 * fq; const float* bp = b1l + (size_t)u.e * 2048 + 2 * ja;
            const f32x4 t0 = *(const f32x4*)bp, t1 = *(const f32x4*)(bp + 4); bg[bj] = (f32x4){t0[0], t0[2], t1[0], t1[2]}; bl[bj] = (f32x4){t0[1], t0[3], t1[1], t1[3]}; }
#pragma unroll
        for (int ai = 0; ai < 2; ++ai)
#pragma unroll
            for (int m = 0; m < 4; ++m) { bf16_t* rowp = act + (size_t)(u.row0 + ai * 128 + wr * 64 + m * 16 + fr) * FF + u.pn * 128 + wc * 16 + 4 * fq;
#pragma unroll
                for (int bj = 0; bj < 2; ++bj) { const f32x4 hg = acc[ai][bj][m][0] + bg[bj], hl = acc[ai][bj][m][1] + bl[bj]; float o[4];
#pragma unroll
                    for (int j = 0; j < 4; ++j) { const float xg = fminf(hg[j], 7.0f), xl = fminf(fmaxf(hl[j], -7.0f), 7.0f); o[j] = xg * sigmoidf_(1.702f * xg) * (xl + 1.0f); }
                    u32x2 w; w.x = pk2(o[0], o[1]); w.y = pk2(o[2], o[3]); *(u32x2*)(rowp + bj * 64) = w; } }
    }
};
struct EpiG2 {
    bf16_t* y; const float* b2l;
    __device__ __forceinline__ void operator()(const f32x4 (&acc)[2][2][4][2], const pg8::Unit& u, int wr, int wc, int fr, int fq) const {
        const int col0 = u.pn * 256 + wc * 32 + 4 * fq; const float* bp = b2l + (size_t)u.e * 1024 + col0;
        f32x4 bv[2][2];
#pragma unroll
        for (int bj = 0; bj < 2; ++bj)
#pragma unroll
            for (int n = 0; n < 2; ++n) bv[bj][n] = *(const f32x4*)(bp + bj * 128 + n * 16);
#pragma unroll
        for (int ai = 0; ai < 2; ++ai)
#pragma unroll
            for (int m = 0; m < 4; ++m) { bf16_t* rowp = y + (size_t)(u.row0 + ai * 128 + wr * 64 + m * 16 + fr) * D + col0;
#pragma unroll
                for (int bj = 0; bj < 2; ++bj)
#pragma unroll
                    for (int n = 0; n < 2; ++n) { const f32x4 v = acc[ai][bj][m][n] + bv[bj][n]; u32x2 w; w.x = pk2(v[0], v[1]); w.y = pk2(v[2], v[3]); *(u32x2*)(rowp + bj * 128 + n * 16) = w; } }
    }
};

__device__ __forceinline__ int win_dest(int s) {
    int base, loc, heads_rope;
    if (s < 512) { base = 0; loc = s; heads_rope = 1; }
    else if (s < 640) { base = 512; loc = s - 512; heads_rope = 1; }
    else if (s < 768) { return 640 + (s - 640); }
    else if (s < 1024) { base = 768; loc = s - 768; heads_rope = 1; }
    else if (s < 1088) { base = 1024; loc = s - 1024; heads_rope = 1; }
    else if (s < 1092) { return 1088 + (s - 1088); }
    else if (s < 1348) { return 1280 + (s - 1092); }
    else { return 1536 + (s - 1348); }
    (void)heads_rope;
    const int hd = loc >> 6, d = loc & 63, x2 = d >> 5, dd = d & 31, half = dd >> 4, q15 = dd & 15;
    return base + hd * 64 + 32 * half + 16 * x2 + q15;
}
__device__ __forceinline__ int w1_dest(int s) { const int ja = s >> 1, n = s & 1, nt = ja >> 7, jj = ja & 127, g32 = jj >> 4, r = jj & 15; return 256 * nt + 32 * g32 + 16 * n + r; }

template <int MAP>
__device__ __forceinline__ void transpose_item(const float* W, int N, bf16_t* WT, LAS float* scr, int kb, int nb, int lane) {
    const int k0 = 64 * kb, n0 = 32 * nb, col = n0 + (lane & 31); const bool ok = col < N;
    float v[32];
    const float* src = W + (size_t)(k0 + (lane >> 5)) * N + (ok ? col : 0);
#pragma unroll
    for (int i = 0; i < 32; ++i) v[i] = src[(size_t)(2 * i) * N];
#pragma unroll
    for (int i = 0; i < 32; ++i) scr[(2 * i + (lane >> 5)) * 33 + (lane & 31)] = ok ? v[i] : 0.f;
    asm volatile("s_waitcnt lgkmcnt(0)" ::: "memory");
    const int c = lane & 7;
#pragma unroll
    for (int j = 0; j < 4; ++j) { const int n = (lane >> 3) + 8 * j; const LAS float* s = scr + (8 * c) * 33 + n;
        u32x4 o; o.x = pk2(s[0 * 33], s[1 * 33]); o.y = pk2(s[2 * 33], s[3 * 33]); o.z = pk2(s[4 * 33], s[5 * 33]); o.w = pk2(s[6 * 33], s[7 * 33]);
        const int sc = n0 + n;
        if (sc < N) { const int dest = MAP == 1 ? win_dest(sc) : (MAP == 2 ? w1_dest(sc) : sc); *(u32x4*)(WT + (size_t)dest * 1024 + k0 + 8 * c) = o; } }
    asm volatile("s_waitcnt lgkmcnt(0)" ::: "memory");
}

__device__ __forceinline__ void phase_prep(const Args& a, Ctx& C) {
    unsigned char* ws = C.ws;
    {
        LAS float* ca = (LAS float*)C.lds;
        LAS float* red = ca + 4096;
        for (int i = C.tid; i < 4096; i += NTHREADS) { const float v = a.c[i]; ca[i] = siluf_(v); }
        __syncthreads();
        for (int it = blockIdx.x; it < 192; it += C.G) {
            const int l = it / 96, cb = it % 96, col = cb * 64 + (C.tid & 63), kg = C.tid >> 6;
            const float* w = a.w_ada + (size_t)l * 1024 * 6144 + col;
            float s0 = 0.f, s1 = 0.f, s2 = 0.f, s3 = 0.f;
#pragma unroll 8
            for (int k = kg * 128; k < kg * 128 + 128; ++k) { const float wv = w[(size_t)k * 6144]; s0 += ca[k] * wv; s1 += ca[1024 + k] * wv; s2 += ca[2048 + k] * wv; s3 += ca[3072 + k] * wv; }
            red[(kg * 4 + 0) * 64 + (C.tid & 63)] = s0; red[(kg * 4 + 1) * 64 + (C.tid & 63)] = s1; red[(kg * 4 + 2) * 64 + (C.tid & 63)] = s2; red[(kg * 4 + 3) * 64 + (C.tid & 63)] = s3;
            __syncthreads();
            if (C.tid < 256) { const int b = C.tid >> 6, cc = C.tid & 63; float s = 0.f;
#pragma unroll
                for (int g = 0; g < 8; ++g) s += red[(g * 4 + b) * 64 + cc];
                ((float*)(ws + WS_MOD))[(size_t)(l * 4 + b) * 6144 + cb * 64 + cc] = s + a.b_ada[l * 6144 + cb * 64 + cc]; }
            __syncthreads();
        }
    }
    const int gw = C.vcu * NWAVES + C.wave, NGW = C.G * NWAVES;
    for (int tk = gw; tk < NTOK; tk += NGW) {
        if (C.lane < 32) {
            const float posf = (float)a.pos[tk];
            const float inv = exp2f(-(float)C.lane * (13.287712379549449f / 32.0f));
            const double ang = (double)(posf * inv);
            const double kq = rint(ang * 0.63661977236758134308);
            const double y = fma(-kq, 1.57079632679489661923, ang);
            const double y2 = y * y;
            const double sy = y * (1.0 + y2 * (-1.0 / 6 + y2 * (1.0 / 120 + y2 * (-1.0 / 5040 + y2 * (1.0 / 362880 - y2 * (1.0 / 39916800))))));
            const double cy = 1.0 + y2 * (-0.5 + y2 * (1.0 / 24 + y2 * (-1.0 / 720 + y2 * (1.0 / 40320 + y2 * (-1.0 / 3628800 + y2 * (1.0 / 479001600))))));
            const int q = ((int)((long long)kq)) & 3;
            const double sn = (q == 0) ? sy : (q == 1) ? cy : (q == 2) ? -sy : -cy;
            const double cs = (q == 0) ? cy : (q == 1) ? -sy : (q == 2) ? -cy : sy;
            ((float*)(ws + WS_ROPEC))[(size_t)tk * 32 + C.lane] = (float)cs;
            ((float*)(ws + WS_ROPES))[(size_t)tk * 32 + C.lane] = (float)sn;
        }
    }
    LAS float* scr = (LAS float*)(C.lds + C.wave * 16384);
    constexpr int I_IN = 2 * 16 * 75, I_OUT = 2 * 16 * 32, I_W1 = 64 * 16 * 64, I_W2 = 64 * 16 * 32;
    for (int it = gw; it < I_IN + I_OUT + I_W1 + I_W2; it += NGW) {
        int r = it;
        if (r < I_IN) { const int l = r / (16 * 75), q = r % (16 * 75); transpose_item<1>(a.w_in + (size_t)l * 1024 * D_IN, D_IN, (bf16_t*)(ws + WS_WIN) + (size_t)l * NPAD * 1024, scr, q / 75, q % 75, C.lane); continue; }
        r -= I_IN;
        if (r < I_OUT) { const int l = r / (16 * 32), q = r % (16 * 32); transpose_item<0>(a.w_out + (size_t)l * 1024 * 1024, 1024, (bf16_t*)(ws + WS_WOUT) + (size_t)l * 1024 * 1024, scr, q / 32, q % 32, C.lane); continue; }
        r -= I_OUT;
        if (r < I_W1) { const int le = r / (16 * 64), q = r % (16 * 64); transpose_item<2>(a.w1 + (size_t)le * 1024 * 2048, 2048, (bf16_t*)(ws + WS_W1) + (size_t)le * 2048 * 1024, scr, q / 64, q % 64, C.lane); continue; }
        r -= I_W1;
        { const int le = r / (16 * 32), q = r % (16 * 32); transpose_item<0>(a.w2 + (size_t)le * 1024 * 1024, 1024, (bf16_t*)(ws + WS_W2) + (size_t)le * 1024 * 1024, scr, q / 32, q % 32, C.lane); }
    }
}

__device__ __forceinline__ void norm_mod_store(const f32x4 (&v)[4], const float* g, const float* sh, const float* sc, bf16_t* urow, int lane) {
    float ss = 0.f;
#pragma unroll
    for (int j = 0; j < 4; ++j) ss += (v[j].x * v[j].x + v[j].y * v[j].y) + (v[j].z * v[j].z + v[j].w * v[j].w);
    const float rstd = 1.0f / sqrtf(wave_sum(ss) * (1.0f / D) + EPS);
#pragma unroll
    for (int j = 0; j < 4; ++j) { const int idx = 4 * lane + 256 * j; const f32x4 gv = *(const f32x4*)(g + idx), shv = *(const f32x4*)(sh + idx), scv = *(const f32x4*)(sc + idx);
        const f32x4 o = v[j] * rstd * gv * (scv + 1.0f) + shv; u32x2 w; w.x = pk2(o[0], o[1]); w.y = pk2(o[2], o[3]); *(u32x2*)(urow + idx) = w; }
}

__device__ __forceinline__ void phase_u0(const Args& a, Ctx& C) {
    const int gw = C.vcu * NWAVES + C.wave, NGW = C.G * NWAVES; const float* mod = (const float*)(C.ws + WS_MOD);
    for (int tk = gw; tk < NTOK; tk += NGW) {
        const int b = tk >> 12; const f32x4* xr = (const f32x4*)(a.x + (size_t)tk * D) + C.lane; f32x4 v[4];
#pragma unroll
        for (int j = 0; j < 4; ++j) v[j] = xr[64 * j];
        const float* mb = mod + (size_t)(0 * 4 + b) * 6144;
        norm_mod_store(v, a.norm1_g, mb + 0, mb + 1024, (bf16_t*)(C.ws + WS_U) + (size_t)tk * D, C.lane);
    }
}

__device__ __forceinline__ unsigned sortable(float f) { const unsigned u = __builtin_bit_cast(unsigned, f); return (u & 0x80000000u) ? ~u : (u | 0x80000000u); }
__device__ __forceinline__ int mbcnt64(unsigned long long m) { return __builtin_amdgcn_mbcnt_hi((unsigned)(m >> 32), __builtin_amdgcn_mbcnt_lo((unsigned)m, 0)); }

__device__ __forceinline__ void select_query(Ctx& C, int tk, LAS float* sc, LAS float* qs) {
    unsigned char* ws = C.ws; const int lane = C.lane;
    const int tpos = tk & (SEQ - 1), b = tk >> 12, cch = tpos >> 6, L = 64 * (cch + 1), nj = cch + 1;
    int* sel = (int*)(ws + WS_SEL) + (size_t)tk * 256;
    if (L <= 256) { for (int i = lane; i < L; i += 64) sel[i] = i; return; }
    {
        const u32x2 w = *(const u32x2*)((const bf16_t*)(ws + WS_QI) + (size_t)tk * 256 + 4 * lane);
        *(LAS f32x4*)(qs + 4 * lane) = (f32x4){bflo(w.x), bfhi(w.x), bflo(w.y), bfhi(w.y)};
    }
    const f32x4 wi = *(const f32x4*)((const float*)(ws + WS_WI) + (size_t)tk * 4);
    asm volatile("s_waitcnt lgkmcnt(0)" ::: "memory"); __builtin_amdgcn_wave_barrier();
    const bf16_t* kib = (const bf16_t*)(ws + WS_KI) + (size_t)b * SEQ * 64;
#pragma unroll 1
    for (int j0 = 0; j0 < 64; ++j0) {
        asm volatile("" ::: "memory");
        const int sA = 64 * j0 + lane;
        if (j0 >= nj) { sc[sA] = -3.0e38f; continue; }
        u32x4 ka[8];
#pragma unroll
        for (int i = 0; i < 8; ++i) ka[i] = *(const u32x4*)(kib + (size_t)sA * 64 + 8 * i);
        float aA[4] = {0.f, 0.f, 0.f, 0.f};
#pragma unroll
        for (int i = 0; i < 8; ++i) {
            const float a0 = bflo(ka[i].x), a1 = bfhi(ka[i].x), a2 = bflo(ka[i].y), a3 = bfhi(ka[i].y), a4 = bflo(ka[i].z), a5 = bfhi(ka[i].z), a6 = bflo(ka[i].w), a7 = bfhi(ka[i].w);
#pragma unroll
            for (int h = 0; h < 4; ++h) {
                const f32x4 q0 = *(const LAS f32x4*)(qs + h * 64 + 8 * i), q1 = *(const LAS f32x4*)(qs + h * 64 + 8 * i + 4);
                aA[h] += q0.x * a0 + q0.y * a1 + q0.z * a2 + q0.w * a3 + q1.x * a4 + q1.y * a5 + q1.z * a6 + q1.w * a7;
            }
        }
        float scA = fmaxf(aA[0], 0.f) * wi[0] + fmaxf(aA[1], 0.f) * wi[1] + fmaxf(aA[2], 0.f) * wi[2] + fmaxf(aA[3], 0.f) * wi[3];
        scA = (scA == 0.f) ? 0.f : scA;
        sc[sA] = scA;
    }
    asm volatile("s_waitcnt lgkmcnt(0)" ::: "memory"); __builtin_amdgcn_wave_barrier();
    unsigned key[64];
#pragma unroll
    for (int j = 0; j < 64; ++j) key[j] = sortable(sc[64 * j + lane]);
    unsigned T = 0u;
#pragma unroll 1
    for (int bit = 31; bit >= 0; --bit) {
        const unsigned cand = T | (1u << bit); int c = 0;
#pragma unroll
        for (int j = 0; j < 64; ++j) c += (key[j] >= cand) ? 1 : 0;
#pragma unroll
        for (int o = 1; o < 64; o <<= 1) c += __shfl_xor(c, o);
        if (c >= 256) T = cand;
    }
    int cgt = 0;
#pragma unroll
    for (int j = 0; j < 64; ++j) cgt += (key[j] > T) ? 1 : 0;
#pragma unroll
    for (int o = 1; o < 64; o <<= 1) cgt += __shfl_xor(cgt, o);
    const int need = 256 - cgt; int base = 0, eqseen = 0;
#pragma unroll 1
    for (int j = 0; j < nj; ++j) {
        const unsigned kj = sortable(sc[64 * j + lane]);
        const bool gt = kj > T, eq = kj == T; const unsigned long long em = __ballot(eq);
        const bool take = gt || (eq && (eqseen + mbcnt64(em)) < need); const unsigned long long tm = __ballot(take);
        if (take) sel[base + mbcnt64(tm)] = 64 * j + lane;
        base += __popcll(tm); eqseen += __popcll(em);
    }
}

__device__ __forceinline__ void attend_query(Ctx& C, int tk, LAS float* qf, LAS float* P, LAS int* sl) {
    unsigned char* ws = C.ws; const int lane = C.lane;
    const int tpos = tk & (SEQ - 1), b = tk >> 12, L = 64 * ((tpos >> 6) + 1), nsel = L < 256 ? L : 256;
    {
        const u32x4 w = *(const u32x4*)((const bf16_t*)(ws + WS_Q) + (size_t)tk * 512 + 8 * lane);
        *(LAS f32x4*)(qf + 8 * lane) = (f32x4){bflo(w.x), bfhi(w.x), bflo(w.y), bfhi(w.y)}; *(LAS f32x4*)(qf + 8 * lane + 4) = (f32x4){bflo(w.z), bfhi(w.z), bflo(w.w), bfhi(w.w)};
        const int* sg = (const int*)(ws + WS_SEL) + (size_t)tk * 256;
#pragma unroll
        for (int i = 0; i < 4; ++i) sl[64 * i + lane] = (64 * i + lane) < nsel ? sg[64 * i + lane] : 0;
    }
    asm volatile("s_waitcnt lgkmcnt(0)" ::: "memory"); __builtin_amdgcn_wave_barrier();
    const bf16_t* kb = (const bf16_t*)(ws + WS_K) + (size_t)b * SEQ * 128; const bf16_t* vb = (const bf16_t*)(ws + WS_V) + (size_t)b * SEQ * 128;
#pragma unroll 1
    for (int i = 0; i < 4; ++i) {
        const int slot = 64 * i + lane; const bool valid = slot < nsel; const int key = sl[slot];
#pragma unroll 1
        for (int n = 0; n < 2; ++n) {
            asm volatile("" ::: "memory");
            float ac[4] = {0.f, 0.f, 0.f, 0.f};
#pragma unroll 1
            for (int c2 = 0; c2 < 4; ++c2) {
                asm volatile("" ::: "memory");
                u32x4 kr[2];
#pragma unroll
                for (int c = 0; c < 2; ++c) kr[c] = *(const u32x4*)(kb + (size_t)key * 128 + n * 64 + 8 * (2 * c2 + c));
#pragma unroll
                for (int c = 0; c < 2; ++c) {
                    const float a0 = bflo(kr[c].x), a1 = bfhi(kr[c].x), a2 = bflo(kr[c].y), a3 = bfhi(kr[c].y), a4 = bflo(kr[c].z), a5 = bfhi(kr[c].z), a6 = bflo(kr[c].w), a7 = bfhi(kr[c].w);
#pragma unroll
                    for (int h = 0; h < 4; ++h) {
                        const f32x4 q0 = *(const LAS f32x4*)(qf + (4 * n + h) * 64 + 8 * (2 * c2 + c)), q1 = *(const LAS f32x4*)(qf + (4 * n + h) * 64 + 8 * (2 * c2 + c) + 4);
                        ac[h] += q0.x * a0 + q0.y * a1 + q0.z * a2 + q0.w * a3 + q1.x * a4 + q1.y * a5 + q1.z * a6 + q1.w * a7;
                    }
                }
            }
            *(LAS f32x4*)(P + slot * 8 + 4 * n) = valid ? (f32x4){ac[0], ac[1], ac[2], ac[3]} : (f32x4){-1e30f, -1e30f, -1e30f, -1e30f};
        }
    }
    asm volatile("s_waitcnt lgkmcnt(0)" ::: "memory"); __builtin_amdgcn_wave_barrier();
    float lg[4][8];
#pragma unroll
    for (int i = 0; i < 4; ++i) { const f32x4 t0 = *(const LAS f32x4*)(P + (64 * i + lane) * 8), t1 = *(const LAS f32x4*)(P + (64 * i + lane) * 8 + 4);
        lg[i][0] = t0.x; lg[i][1] = t0.y; lg[i][2] = t0.z; lg[i][3] = t0.w; lg[i][4] = t1.x; lg[i][5] = t1.y; lg[i][6] = t1.z; lg[i][7] = t1.w; }
    float inv[8];
#pragma unroll
    for (int h = 0; h < 8; ++h) {
        const float m = wave_max(fmaxf(fmaxf(lg[0][h], lg[1][h]), fmaxf(lg[2][h], lg[3][h]))); float s = 0.f;
#pragma unroll
        for (int i = 0; i < 4; ++i) { const float p = (64 * i + lane) < nsel ? __expf(lg[i][h] - m) : 0.f; lg[i][h] = p; s += p; }
        inv[h] = 1.0f / wave_sum(s);
    }
#pragma unroll
    for (int i = 0; i < 4; ++i) { LAS float* pp = P + (64 * i + lane) * 8;
        *(LAS f32x4*)pp = (f32x4){lg[i][0], lg[i][1], lg[i][2], lg[i][3]}; *(LAS f32x4*)(pp + 4) = (f32x4){lg[i][4], lg[i][5], lg[i][6], lg[i][7]}; }
    asm volatile("s_waitcnt lgkmcnt(0)" ::: "memory"); __builtin_amdgcn_wave_barrier();
    float o[8] = {0.f, 0.f, 0.f, 0.f, 0.f, 0.f, 0.f, 0.f};
#pragma unroll 4
    for (int slot = 0; slot < nsel; ++slot) {
        const int key = sl[slot];
        const float v0 = bf2f(vb[(size_t)key * 128 + lane]), v1 = bf2f(vb[(size_t)key * 128 + 64 + lane]);
        const f32x4 p0 = *(const LAS f32x4*)(P + slot * 8), p1 = *(const LAS f32x4*)(P + slot * 8 + 4);
        o[0] += p0.x * v0; o[1] += p0.y * v0; o[2] += p0.z * v0; o[3] += p0.w * v0; o[4] += p1.x * v1; o[5] += p1.y * v1; o[6] += p1.z * v1; o[7] += p1.w * v1;
    }
    bf16_t* mo = (bf16_t*)(ws + WS_MIX) + (size_t)tk * D;
#pragma unroll
    for (int h = 0; h < 8; ++h) mo[h * 64 + lane] = (bf16_t)f2bf(o[h] * inv[h]);
    asm volatile("s_waitcnt lgkmcnt(0)" ::: "memory"); __builtin_amdgcn_wave_barrier();
}

__device__ __forceinline__ void pool_item(const Args& a, Ctx& C, int l, int item) {
    unsigned char* ws = C.ws; const int tid = C.tid;
    const int g = item & 3, tt = item >> 2, b = tt >> 6, tp0 = (tt & 63) * 64, w = 2 << g;
    LAS float* ub = (LAS float*)C.lds;
    LAS float* pw = ub + 79 * 64;
    LAS float* pl = pw + 64 * 64;
    const float* ubg = (const float*)(ws + WS_UB);
    for (int idx = tid; idx < 79 * 16; idx += NTHREADS) { const int row = idx >> 4, c4 = idx & 15, tp = tp0 - 15 + row;
        f32x4 v = (f32x4){0.f, 0.f, 0.f, 0.f}; if (tp >= 0) v = *(const f32x4*)(ubg + (size_t)(b * SEQ + tp) * 256 + g * 64 + 4 * c4);
        *(LAS f32x4*)(ub + row * 64 + 4 * c4) = v; }
    for (int idx = tid; idx < 1024; idx += NTHREADS) *(LAS f32x4*)(pw + 4 * idx) = *(const f32x4*)(a.pool_w + (size_t)(l * 4 + g) * 4096 + 4 * idx);
    __syncthreads();
    const int t = tid >> 3, c8 = (tid & 7) * 8, tpos = tp0 + t, wl = (tpos + 1) < w ? (tpos + 1) : w;
    {
        float s[8] = {0.f, 0.f, 0.f, 0.f, 0.f, 0.f, 0.f, 0.f};
        for (int i = 0; i < wl; ++i) {
#pragma unroll
            for (int j = 0; j < 8; ++j) s[j] += ub[(t + 15 - i) * 64 + c8 + j]; }
        const float rw = 1.0f / (float)wl;
#pragma unroll
        for (int j = 0; j < 8; ++j) pl[t * 65 + c8 + j] = s[j] * rw - ub[(t + 15) * 64 + c8 + j];
    }
    __syncthreads();
    float y[8] = {0.f, 0.f, 0.f, 0.f, 0.f, 0.f, 0.f, 0.f};
#pragma unroll 8
    for (int cc = 0; cc < 64; ++cc) { const float p = pl[t * 65 + cc]; const f32x4 w0 = *(const LAS f32x4*)(pw + cc * 64 + c8), w1 = *(const LAS f32x4*)(pw + cc * 64 + c8 + 4);
        y[0] += p * w0.x; y[1] += p * w0.y; y[2] += p * w0.z; y[3] += p * w0.w; y[4] += p * w1.x; y[5] += p * w1.y; y[6] += p * w1.z; y[7] += p * w1.w; }
    const float* ps = a.pool_scale + l * 256 + g * 64 + c8;
    u32x4 o; o.x = pk2(y[0] * ps[0], y[1] * ps[1]); o.y = pk2(y[2] * ps[2], y[3] * ps[3]); o.z = pk2(y[4] * ps[4], y[5] * ps[5]); o.w = pk2(y[6] * ps[6], y[7] * ps[7]);
    *(u32x4*)((bf16_t*)(ws + WS_MIX) + (size_t)(b * SEQ + tpos) * D + 512 + g * 64 + c8) = o;
    __syncthreads();
}

constexpr int HP = 65;
__device__ __forceinline__ void hgrn_gates(const Args& a, Ctx& C, int l, int b, int hh, int c, LAS float* bq, LAS float* kin) {
    const int tid = C.tid, s = tid >> 3, k8 = (tid & 7) * 8;
    const float* z = (const float*)(C.ws + WS_HG) + (size_t)(b * SEQ + c * 64 + s) * 1024 + 256 + hh * 64 + k8;
    const f32x4 z0 = *(const f32x4*)z, z1 = *(const f32x4*)(z + 4); const float zz[8] = {z0.x, z0.y, z0.z, z0.w, z1.x, z1.y, z1.z, z1.w};
#pragma unroll
    for (int j = 0; j < 8; ++j) {
        const int kk = hh * 64 + k8 + j; float lb = 0.f;
        if (l == 1) lb = 1.0f / (1.0f + expf(a.lb_logits[kk] - a.lb_logits[256 + kk]));
        const float sg = 1.0f / (1.0f + expf(-zz[j])), sn = 1.0f / (1.0f + expf(zz[j]));
        bq[s * HP + k8 + j] = logf(lb + (1.0f - lb) * sg); kin[s * HP + k8 + j] = (1.0f - lb) * sn;
    }
    __syncthreads();
    if (tid < 64) { float r = 0.f; for (int ss = 0; ss < 64; ++ss) { r += bq[ss * HP + tid]; bq[ss * HP + tid] = r; } }
    __syncthreads();
}
__device__ __forceinline__ void hgrn_local_item(const Args& a, Ctx& C, int l, int item) {
    const int tid = C.tid, c = item & 63, hh = (item >> 6) & 3, b = item >> 8;
    LAS float* bq = (LAS float*)C.lds; LAS float* kin = bq + 64 * HP; LAS float* vv = kin + 64 * HP;
    hgrn_gates(a, C, l, b, hh, c, bq, kin);
    { const int s = tid >> 3, k8 = (tid & 7) * 8;
        const float* vp = (const float*)(C.ws + WS_HG) + (size_t)(b * SEQ + c * 64 + s) * 1024 + 512 + hh * 64 + k8;
        *(LAS f32x4*)(vv + s * 64 + k8) = *(const f32x4*)vp; *(LAS f32x4*)(vv + s * 64 + k8 + 4) = *(const f32x4*)(vp + 4);
#pragma unroll
        for (int j = 0; j < 8; ++j) kin[s * HP + k8 + j] *= __expf(bq[63 * HP + k8 + j] - bq[s * HP + k8 + j]); }
    __syncthreads();
    const int k = tid >> 3, v8 = (tid & 7) * 8; float Lr[8] = {0.f, 0.f, 0.f, 0.f, 0.f, 0.f, 0.f, 0.f};
#pragma unroll 8
    for (int s = 0; s < 64; ++s) { const float w = kin[s * HP + k]; const f32x4 x0 = *(const LAS f32x4*)(vv + s * 64 + v8), x1 = *(const LAS f32x4*)(vv + s * 64 + v8 + 4);
        Lr[0] += w * x0.x; Lr[1] += w * x0.y; Lr[2] += w * x0.z; Lr[3] += w * x0.w; Lr[4] += w * x1.x; Lr[5] += w * x1.y; Lr[6] += w * x1.z; Lr[7] += w * x1.w; }
    float* hl = (float*)(C.ws + WS_HL) + (size_t)item * 4096 + k * 64 + v8;
    *(f32x4*)hl = (f32x4){Lr[0], Lr[1], Lr[2], Lr[3]}; *(f32x4*)(hl + 4) = (f32x4){Lr[4], Lr[5], Lr[6], Lr[7]};
    if ((tid & 7) == 0) ((float*)(C.ws + WS_HD))[(size_t)item * 64 + k] = __expf(bq[63 * HP + k]);
    __syncthreads();
}
__device__ __forceinline__ void hgrn_out_item(const Args& a, Ctx& C, int l, int item) {
    const int tid = C.tid, c = item & 63, hh = (item >> 6) & 3, b = item >> 8;
    LAS float* bq = (LAS float*)C.lds; LAS float* kin = bq + 64 * HP; LAS float* qq = kin + 64 * HP; LAS float* At = qq + 64 * HP; LAS float* vv = At + 64 * HP; LAS float* Ss = vv + 4096;
    hgrn_gates(a, C, l, b, hh, c, bq, kin);
    { const int s = tid >> 3, k8 = (tid & 7) * 8; const float* row = (const float*)(C.ws + WS_HG) + (size_t)(b * SEQ + c * 64 + s) * 1024 + hh * 64 + k8;
        const f32x4 q0 = *(const f32x4*)row, q1 = *(const f32x4*)(row + 4);
        qq[s * HP + k8 + 0] = siluf_(q0.x); qq[s * HP + k8 + 1] = siluf_(q0.y); qq[s * HP + k8 + 2] = siluf_(q0.z); qq[s * HP + k8 + 3] = siluf_(q0.w);
        qq[s * HP + k8 + 4] = siluf_(q1.x); qq[s * HP + k8 + 5] = siluf_(q1.y); qq[s * HP + k8 + 6] = siluf_(q1.z); qq[s * HP + k8 + 7] = siluf_(q1.w);
        *(LAS f32x4*)(vv + s * 64 + k8) = *(const f32x4*)(row + 512); *(LAS f32x4*)(vv + s * 64 + k8 + 4) = *(const f32x4*)(row + 516); }
    {
        const int k = tid >> 3, v8 = (tid & 7) * 8; f32x4 s0 = (f32x4){0.f, 0.f, 0.f, 0.f}, s1 = s0;
        const float* hl = (const float*)(C.ws + WS_HL) + (size_t)(item - c) * 4096 + k * 64 + v8; const float* hd = (const float*)(C.ws + WS_HD) + (size_t)(item - c) * 64 + k;
#pragma unroll 4
        for (int j = 0; j < c; ++j) { const float dj = hd[(size_t)j * 64]; const f32x4 l0 = *(const f32x4*)(hl + (size_t)j * 4096), l1 = *(const f32x4*)(hl + (size_t)j * 4096 + 4); s0 = s0 * dj + l0; s1 = s1 * dj + l1; }
        *(LAS f32x4*)(Ss + k * 64 + v8) = s0; *(LAS f32x4*)(Ss + k * 64 + v8 + 4) = s1; }
    __syncthreads();
    { const int t = tid >> 3, sg = tid & 7; float ac[8] = {0.f, 0.f, 0.f, 0.f, 0.f, 0.f, 0.f, 0.f};
        for (int k = 0; k < 64; ++k) { const float qt = qq[t * HP + k], bt = bq[t * HP + k];
#pragma unroll
            for (int i = 0; i < 8; ++i) { const int s = sg + 8 * i; if (s <= t) ac[i] += qt * kin[s * HP + k] * __expf(bt - bq[s * HP + k]); } }
#pragma unroll
        for (int i = 0; i < 8; ++i) At[t * HP + sg + 8 * i] = ac[i]; }
    __syncthreads();
    { const int t = tid >> 3, v8 = (tid & 7) * 8; float o[8] = {0.f, 0.f, 0.f, 0.f, 0.f, 0.f, 0.f, 0.f};
#pragma unroll 4
        for (int k = 0; k < 64; ++k) { const float qe = qq[t * HP + k] * __expf(bq[t * HP + k]); const f32x4 x0 = *(const LAS f32x4*)(Ss + k * 64 + v8), x1 = *(const LAS f32x4*)(Ss + k * 64 + v8 + 4);
            o[0] += qe * x0.x; o[1] += qe * x0.y; o[2] += qe * x0.z; o[3] += qe * x0.w; o[4] += qe * x1.x; o[5] += qe * x1.y; o[6] += qe * x1.z; o[7] += qe * x1.w; }
        for (int s = 0; s <= t; ++s) { const float w = At[t * HP + s]; const f32x4 x0 = *(const LAS f32x4*)(vv + s * 64 + v8), x1 = *(const LAS f32x4*)(vv + s * 64 + v8 + 4);
            o[0] += w * x0.x; o[1] += w * x0.y; o[2] += w * x0.z; o[3] += w * x0.w; o[4] += w * x1.x; o[5] += w * x1.y; o[6] += w * x1.z; o[7] += w * x1.w; }
        float ss = 0.f;
#pragma unroll
        for (int j = 0; j < 8; ++j) ss += o[j] * o[j];
        ss += __shfl_xor(ss, 1); ss += __shfl_xor(ss, 2); ss += __shfl_xor(ss, 4);
        const float rstd = 1.0f / sqrtf(ss * (1.0f / 64.0f) + EPS);
        const float* gp = (const float*)(C.ws + WS_HG) + (size_t)(b * SEQ + c * 64 + t) * 1024 + 768 + hh * 64 + v8; const float* ng = a.hgrn_g + l * 64 + v8;
        const f32x4 g0 = *(const f32x4*)gp, g1 = *(const f32x4*)(gp + 4); const float gg[8] = {g0.x, g0.y, g0.z, g0.w, g1.x, g1.y, g1.z, g1.w}; float y[8];
#pragma unroll
        for (int j = 0; j < 8; ++j) y[j] = o[j] * rstd * ng[j] * siluf_(gg[j]);
        u32x4 w; w.x = pk2(y[0], y[1]); w.y = pk2(y[2], y[3]); w.z = pk2(y[4], y[5]); w.w = pk2(y[6], y[7]);
        *(u32x4*)((bf16_t*)(C.ws + WS_MIX) + (size_t)(b * SEQ + c * 64 + t) * D + 768 + hh * 64 + v8) = w; }
    __syncthreads();
}

__device__ __forceinline__ void phase_mix1(const Args& a, Ctx& C, int l) {
#ifndef MIX1MASK
#define MIX1MASK 7
#endif
    if (MIX1MASK & 1) for (int it = blockIdx.x; it < 1024; it += C.G) hgrn_local_item(a, C, l, it);
    if (MIX1MASK & 2) for (int it = blockIdx.x; it < 1024; it += C.G) pool_item(a, C, l, it);
    LAS float* sc = (LAS float*)(C.lds + C.wave * 17408); LAS float* qs = sc + 4096;
    const int gw = blockIdx.x * NWAVES + C.wave, NGW = C.G * NWAVES;
    if (MIX1MASK & 4) for (int p = gw; p < 2048; p += NGW)
        for (int b = 0; b < 4; ++b) { select_query(C, b * SEQ + p, sc, qs); select_query(C, b * SEQ + (SEQ - 1 - p), sc, qs); }
}
__device__ __forceinline__ void phase_mix2(const Args& a, Ctx& C, int l) {
#ifndef MIX2MASK
#define MIX2MASK 3
#endif
    if (MIX2MASK & 1) for (int it = blockIdx.x; it < 1024; it += C.G) hgrn_out_item(a, C, l, it);
    LAS float* qf = (LAS float*)(C.lds + C.wave * 11264); LAS float* P = qf + 512; LAS int* sl = (LAS int*)(P + 2048);
    const int gw = blockIdx.x * NWAVES + C.wave, NGW = C.G * NWAVES;
    if (MIX2MASK & 2) for (int tk = gw; tk < NTOK; tk += NGW) attend_query(C, tk, qf, P, sl);
}

__device__ __forceinline__ void phase_router(const Args& a, Ctx& C, int l) {
    unsigned char* ws = C.ws; const int lane = C.lane;
    LAS float* us = (LAS float*)(C.lds + C.wave * 8192);
    const float* mod = (const float*)(ws + WS_MOD); const float* H = (const float*)(ws + WS_H);
    const float* wr = a.w_router + (size_t)l * 1024 * 32; unsigned* cnt = (unsigned*)(ws + WS_CTL) + CW_CNT + l * 32 * 64;
    const int gw = blockIdx.x * NWAVES + C.wave, NGW = C.G * NWAVES;
    for (int base = gw * 2; base < NTOK; base += NGW * 2) {
#pragma unroll
        for (int hf = 0; hf < 2; ++hf) {
            const int tk = base + hf, b = tk >> 12; const f32x4* hr = (const f32x4*)(H + (size_t)tk * D) + lane; f32x4 v[4];
#pragma unroll
            for (int j = 0; j < 4; ++j) v[j] = hr[64 * j];
            float ss = 0.f;
#pragma unroll
            for (int j = 0; j < 4; ++j) ss += (v[j].x * v[j].x + v[j].y * v[j].y) + (v[j].z * v[j].z + v[j].w * v[j].w);
            const float rstd = 1.0f / sqrtf(wave_sum(ss) * (1.0f / D) + EPS);
            const float* mb = mod + (size_t)(l * 4 + b) * 6144; bf16_t* urow = (bf16_t*)(ws + WS_U) + (size_t)tk * D;
#pragma unroll
            for (int j = 0; j < 4; ++j) { const int idx = 4 * lane + 256 * j; const f32x4 gv = *(const f32x4*)(a.norm2_g + l * 1024 + idx), shv = *(const f32x4*)(mb + 3072 + idx), scv = *(const f32x4*)(mb + 4096 + idx);
                const f32x4 o = v[j] * rstd * gv * (scv + 1.0f) + shv; u32x2 w; w.x = pk2(o[0], o[1]); w.y = pk2(o[2], o[3]); *(u32x2*)(urow + idx) = w;
                *(LAS f32x4*)(us + hf * 1024 + idx) = o; }
        }
        asm volatile("s_waitcnt lgkmcnt(0)" ::: "memory"); __builtin_amdgcn_wave_barrier();
        const int e = lane & 31, hf = lane >> 5; float acc0 = 0.f, acc1 = 0.f;
        const LAS float* up = us + hf * 1024;
#pragma unroll 8
        for (int d = 0; d < 1024; d += 2) { acc0 += up[d] * wr[d * 32 + e]; acc1 += up[d + 1] * wr[(d + 1) * 32 + e]; }
        float val = acc0 + acc1 + a.b_router[l * 32 + e];
        float tv[4]; int te[4];
#pragma unroll
        for (int k = 0; k < 4; ++k) {
            float bv = val; int bi = e;
#pragma unroll
            for (int o = 1; o < 32; o <<= 1) { const float ov = __shfl_xor(bv, o); const int oi = __shfl_xor(bi, o); if (ov > bv || (ov == bv && oi < bi)) { bv = ov; bi = oi; } }
            tv[k] = bv; te[k] = bi; if (e == bi) val = -3.0e38f;
        }
        const float e1 = __expf(tv[1] - tv[0]), e2 = __expf(tv[2] - tv[0]), e3 = __expf(tv[3] - tv[0]); const float rs = 1.0f / (1.0f + e1 + e2 + e3);
        if (e < 4) {
            const int tk = base + hf; const int ex = e == 0 ? te[0] : e == 1 ? te[1] : e == 2 ? te[2] : te[3]; const float gt = (e == 0 ? 1.0f : e == 1 ? e1 : e == 2 ? e2 : e3) * rs;
            const unsigned slot = atomicAdd(cnt + ex * 64, 1u);
            ((int*)(ws + WS_ROWTOK))[(size_t)ex * NTOK + slot] = tk;
            ((int*)(ws + WS_EIDX))[tk * 4 + e] = ex; ((int*)(ws + WS_SLOT))[tk * 4 + e] = (int)slot; ((float*)(ws + WS_GATE))[tk * 4 + e] = gt;
        }
        asm volatile("s_waitcnt lgkmcnt(0)" ::: "memory"); __builtin_amdgcn_wave_barrier();
    }
}

__device__ __forceinline__ void moe_table(Ctx& C, int l, LAS int* tab) {
    if (C.tid < 32) { const unsigned* cnt = (const unsigned*)(C.ws + WS_CTL) + CW_CNT + l * 32 * 64; tab[33 + C.tid] = (int)__hip_atomic_load(cnt + C.tid * 64, __ATOMIC_RELAXED, __HIP_MEMORY_SCOPE_AGENT); }
    __syncthreads();
    if (C.tid == 0) { int p = 0; for (int e = 0; e < 32; ++e) { tab[e] = p; p += (tab[33 + e] + 255) >> 8; } tab[32] = p; }
    __syncthreads();
}

__device__ __forceinline__ void phase_combine(const Args& a, Ctx& C, int l) {
    unsigned char* ws = C.ws; const int lane = C.lane;
    const float* mod = (const float*)(ws + WS_MOD); float* H = (float*)(ws + WS_H); const bf16_t* Y = (const bf16_t*)(ws + WS_Y);
    const unsigned* cnt = (const unsigned*)(ws + WS_CTL) + CW_CNT + l * 32 * 64;
    int mt = 0; if (lane < 32) mt = ((int)__hip_atomic_load(cnt + lane * 64, __ATOMIC_RELAXED, __HIP_MEMORY_SCOPE_AGENT) + 255) >> 8;
    int incl = mt;
#pragma unroll
    for (int o = 1; o < 32; o <<= 1) { const int t = __shfl_up(incl, o); if ((lane & 31) >= o) incl += t; }
    const int excl = incl - mt;
    const int gw = blockIdx.x * NWAVES + C.wave, NGW = C.G * NWAVES;
    for (int tk = gw; tk < NTOK; tk += NGW) {
        const int b = tk >> 12; f32x4 v[4]; f32x4* hr = (f32x4*)(H + (size_t)tk * D) + lane;
#pragma unroll
        for (int j = 0; j < 4; ++j) v[j] = hr[64 * j];
        f32x4 m[4];
#pragma unroll
        for (int j = 0; j < 4; ++j) m[j] = (f32x4){0.f, 0.f, 0.f, 0.f};
#pragma unroll
        for (int k = 0; k < 4; ++k) {
            const int ex = ((const int*)(ws + WS_EIDX))[tk * 4 + k], slot = ((const int*)(ws + WS_SLOT))[tk * 4 + k]; const float gt = ((const float*)(ws + WS_GATE))[tk * 4 + k];
            const int row = 256 * __shfl(excl, ex) + slot; const u32x2* yr = (const u32x2*)(Y + (size_t)row * D) + lane;
#pragma unroll
            for (int j = 0; j < 4; ++j) { const u32x2 w = yr[64 * j]; m[j] += (f32x4){bflo(w.x), bfhi(w.x), bflo(w.y), bfhi(w.y)} * gt; }
        }
        const float* mb = mod + (size_t)(l * 4 + b) * 6144;
#pragma unroll
        for (int j = 0; j < 4; ++j) { const f32x4 g2 = *(const f32x4*)(mb + 5120 + 4 * lane + 256 * j); v[j] += g2 * m[j]; hr[64 * j] = v[j]; }
        if (l + 1 < DEPTH) { const float* mn = mod + (size_t)((l + 1) * 4 + b) * 6144; norm_mod_store(v, a.norm1_g + (l + 1) * 1024, mn + 0, mn + 1024, (bf16_t*)(ws + WS_U) + (size_t)tk * D, lane); }
        else {
            float ss = 0.f;
#pragma unroll
            for (int j = 0; j < 4; ++j) ss += (v[j].x * v[j].x + v[j].y * v[j].y) + (v[j].z * v[j].z + v[j].w * v[j].w);
            const float rstd = 1.0f / sqrtf(wave_sum(ss) * (1.0f / D) + EPS);
            f32x4* orow = (f32x4*)(a.out + (size_t)tk * D) + lane;
#pragma unroll
            for (int j = 0; j < 4; ++j) orow[64 * j] = v[j] * rstd * *(const f32x4*)(a.final_g + 4 * lane + 256 * j);
        }
    }
}

typedef const __attribute__((address_space(4))) Args* KArgsPtr;
__device__ __forceinline__ Args load_args() {
#if defined(__HIP_DEVICE_COMPILE__)
    KArgsPtr p = (KArgsPtr)__builtin_amdgcn_kernarg_segment_ptr(); asm volatile("" : "+s"(p)); Args a;
    a.x = p->x; a.c = p->c; a.pos = p->pos; a.w_ada = p->w_ada; a.b_ada = p->b_ada; a.norm1_g = p->norm1_g; a.norm2_g = p->norm2_g; a.w_in = p->w_in; a.w_out = p->w_out; a.pool_w = p->pool_w;
    a.pool_scale = p->pool_scale; a.hgrn_g = p->hgrn_g; a.lb_logits = p->lb_logits; a.w_router = p->w_router; a.b_router = p->b_router; a.w1 = p->w1; a.b1 = p->b1; a.w2 = p->w2; a.b2 = p->b2; a.final_g = p->final_g;
    a.out = p->out; a.ws = p->ws; a.ph_lo = p->ph_lo; a.ph_hi = p->ph_hi; return a;
#else
    return Args{};
#endif
}
__device__ __forceinline__ int lane_id() { return __builtin_amdgcn_mbcnt_hi(~0u, __builtin_amdgcn_mbcnt_lo(~0u, 0)); }
__device__ __forceinline__ Ctx make_ctx(unsigned char* ws, int wv) {
    extern __shared__ __attribute__((aligned(16))) unsigned char lds_raw[];
    Ctx C; C.lds = (LAS unsigned char*)lds_raw; { int l_ = lane_id(); asm volatile("" : "+v"(l_)); C.lane = l_; } C.wave = wv; C.tid = wv * 64 + C.lane;
    C.G = gridDim.x; { const int bx = blockIdx.x; C.vcu = (C.G % 8 == 0) ? (bx % 8) * (C.G / 8) + bx / 8 : bx; }
    C.ws = ws; return C;
}
#ifndef PHASE_FN
#define PHASE_FN __device__ __forceinline__ void
#endif
#define GEMM_FN __device__ __forceinline__ void
PHASE_FN ph_prep(int wv) { const Args a = load_args(); Ctx C = make_ctx(a.ws, wv); phase_prep(a, C); }
PHASE_FN ph_u0(int wv) { const Args a = load_args(); Ctx C = make_ctx(a.ws, wv); phase_u0(a, C); }
GEMM_FN ph_gin(int l, int wv) { const Args a = load_args(); Ctx C = make_ctx(a.ws, wv); unsigned char* ws = a.ws;
    DenseOrder S{(const char*)(ws + WS_U), (const char*)(ws + WS_WIN) + (size_t)l * NPAD * 1024 * 2, NTOK / 256, NPAD / 256, (NTOK / 256) * (NPAD / 256), C.G, (int)blockIdx.x};
    EpiIn E{ws}; pg8::gemm_phase<EpiIn, DenseOrder, false, true>(C.lds, (LAS unsigned*)(C.lds + LDS_PARK), C.tid, S, E); }
PHASE_FN ph_mix1(int l, int wv) { const Args a = load_args(); Ctx C = make_ctx(a.ws, wv); phase_mix1(a, C, l); }
PHASE_FN ph_mix2(int l, int wv) { const Args a = load_args(); Ctx C = make_ctx(a.ws, wv); phase_mix2(a, C, l); }
GEMM_FN ph_gout(int l, int wv) { const Args a = load_args(); Ctx C = make_ctx(a.ws, wv); unsigned char* ws = a.ws;
    DenseOrder S{(const char*)(ws + WS_MIX), (const char*)(ws + WS_WOUT) + (size_t)l * 1024 * 1024 * 2, NTOK / 256, 4, (NTOK / 256) * 4, C.G, (int)blockIdx.x};
    EpiOut E{l == 0 ? a.x : (const float*)(ws + WS_H), (float*)(ws + WS_H), (const float*)(ws + WS_MOD) + (size_t)l * 4 * 6144 + 2048};
    pg8::gemm_phase<EpiOut, DenseOrder, false, true>(C.lds, (LAS unsigned*)(C.lds + LDS_PARK), C.tid, S, E); }
PHASE_FN ph_router(int l, int wv) { const Args a = load_args(); Ctx C = make_ctx(a.ws, wv); phase_router(a, C, l); }
GEMM_FN ph_g1(int l, int wv) { const Args a = load_args(); Ctx C = make_ctx(a.ws, wv); unsigned char* ws = a.ws;
    LAS int* tab = (LAS int*)(C.lds + LDS_TAB); moe_table(C, l, tab);
    MoeOrder<true> S{tab, (const char*)(ws + WS_U), (const char*)(ws + WS_W1) + (size_t)l * 32 * 2048 * 1024 * 2, (const int*)(ws + WS_ROWTOK), C.G, C.vcu};
    EpiG1 E{(bf16_t*)(ws + WS_ACT), a.b1 + (size_t)l * 32 * 2048}; pg8::gemm_phase<EpiG1, MoeOrder<true>, true, true>(C.lds, (LAS unsigned*)(C.lds + LDS_PARK), C.tid, S, E); }
GEMM_FN ph_g2(int l, int wv) { const Args a = load_args(); Ctx C = make_ctx(a.ws, wv); unsigned char* ws = a.ws;
    LAS int* tab = (LAS int*)(C.lds + LDS_TAB); moe_table(C, l, tab);
    MoeOrder<false> S{tab, (const char*)(ws + WS_ACT), (const char*)(ws + WS_W2) + (size_t)l * 32 * 1024 * 1024 * 2, nullptr, C.G, C.vcu};
    EpiG2 E{(bf16_t*)(ws + WS_Y), a.b2 + (size_t)l * 32 * 1024}; pg8::gemm_phase<EpiG2, MoeOrder<false>, false, true>(C.lds, (LAS unsigned*)(C.lds + LDS_PARK), C.tid, S, E); }
PHASE_FN ph_combine(int l, int wv) { const Args a = load_args(); Ctx C = make_ctx(a.ws, wv); phase_combine(a, C, l); }

constexpr int NPHASES = 2 + 8 * DEPTH;
__global__ void __launch_bounds__(NTHREADS, 2) mega_fwd(Args a) {
#if MK_ONE_LAUNCH
    cg::grid_group grid = cg::this_grid();
#define SEAM() do { __syncthreads(); grid.sync(); } while (0)
#else
#define SEAM() do { } while (0)
#endif
    const int lo = a.ph_lo, hi = a.ph_hi;
    const int wv = __builtin_amdgcn_readfirstlane((int)threadIdx.x >> 6);
#ifndef KINDMASK
#define KINDMASK 0xffffu
#endif
#define KON(k) (((KINDMASK) >> (k)) & 1u)
#define RUN(kind, id, call) do { if (KON(kind) && lo <= (id) && (id) < hi) { call; if ((id) + 1 < hi) SEAM(); } } while (0)
    RUN(0, 0, ph_prep(wv));
    RUN(1, 1, ph_u0(wv));
    RUN(2, 2, ph_gin(0, wv)); RUN(3, 3, ph_mix1(0, wv)); RUN(4, 4, ph_mix2(0, wv)); RUN(5, 5, ph_gout(0, wv)); RUN(6, 6, ph_router(0, wv)); RUN(7, 7, ph_g1(0, wv)); RUN(8, 8, ph_g2(0, wv)); RUN(9, 9, ph_combine(0, wv));
    RUN(2, 10, ph_gin(1, wv)); RUN(3, 11, ph_mix1(1, wv)); RUN(4, 12, ph_mix2(1, wv)); RUN(5, 13, ph_gout(1, wv)); RUN(6, 14, ph_router(1, wv)); RUN(7, 15, ph_g1(1, wv)); RUN(8, 16, ph_g2(1, wv)); RUN(9, 17, ph_combine(1, wv));
}

extern "C" void kernel_launch(void* const* d_in, const int* in_sizes, int n_in, void* d_out, int out_size, void* d_ws, size_t ws_size, hipStream_t stream) {
    static int grid = 0;
    if (grid == 0) {
        if (n_in != 20 || out_size != NTOK * D || ws_size < WS_END) { fprintf(stderr, "kernel_launch: unexpected shapes: n_in %d out %d ws %zu (need %zu)\n", n_in, out_size, ws_size, (size_t)WS_END); grid = -1; return; }
        int dev = 0, cus = 0, per_cu = 0;
        hipGetDevice(&dev); hipDeviceGetAttribute(&cus, hipDeviceAttributeMultiprocessorCount, dev);
        if (hipFuncSetAttribute((const void*)mega_fwd, hipFuncAttributeMaxDynamicSharedMemorySize, LDS_BYTES) != hipSuccess) { fprintf(stderr, "kernel_launch: hipFuncSetAttribute failed\n"); grid = -1; return; }
        hipOccupancyMaxActiveBlocksPerMultiprocessor(&per_cu, (const void*)mega_fwd, NTHREADS, LDS_BYTES);
        (void)hipGetLastError();
        if (per_cu < 1) fprintf(stderr, "kernel_launch: occupancy query says %d blocks per CU\n", per_cu);
        grid = cus;
    }
    if (grid < 0) return;
    hipMemsetAsync((char*)d_ws + WS_CTL, 0, CTL_BYTES, stream);
    Args a{};
    a.x = (const float*)d_in[0]; a.c = (const float*)d_in[1]; a.pos = (const int*)d_in[2]; a.w_ada = (const float*)d_in[3]; a.b_ada = (const float*)d_in[4];
    a.norm1_g = (const float*)d_in[5]; a.norm2_g = (const float*)d_in[6]; a.w_in = (const float*)d_in[7]; a.w_out = (const float*)d_in[8]; a.pool_w = (const float*)d_in[9];
    a.pool_scale = (const float*)d_in[10]; a.hgrn_g = (const float*)d_in[11]; a.lb_logits = (const float*)d_in[12]; a.w_router = (const float*)d_in[13]; a.b_router = (const float*)d_in[14];
    a.w1 = (const float*)d_in[15]; a.b1 = (const float*)d_in[16]; a.w2 = (const float*)d_in[17]; a.b2 = (const float*)d_in[18]; a.final_g = (const float*)d_in[19];
    a.out = (float*)d_out; a.ws = (unsigned char*)d_ws;
#if MK_ONE_LAUNCH
    a.ph_lo = 0; a.ph_hi = NPHASES;
    void* args[] = {&a};
    hipError_t e = hipLaunchCooperativeKernel((const void*)mega_fwd, dim3(grid), dim3(NTHREADS), args, LDS_BYTES, stream);
    if (e != hipSuccess) fprintf(stderr, "cooperative launch failed: %s (grid %d)\n", hipGetErrorString(e), grid);
#else
    for (int p = 0; p < NPHASES; ++p) { a.ph_lo = p; a.ph_hi = p + 1; hipLaunchKernelGGL(mega_fwd, dim3(grid), dim3(NTHREADS), LDS_BYTES, stream, a); }
#endif
}
```

```cpp
#include <hip/hip_runtime.h>
#include <hip/hip_cooperative_groups.h>
#include <cstdio>
#include <cstdint>
namespace cg = cooperative_groups;

#ifndef MK_ONE_LAUNCH
#define MK_ONE_LAUNCH 1
#endif

#define LAS __attribute__((address_space(3)))
typedef unsigned short bf16_t;
typedef short bf16x8 __attribute__((ext_vector_type(8)));
typedef float f32x4 __attribute__((ext_vector_type(4)));
typedef float f32x2 __attribute__((ext_vector_type(2)));
typedef unsigned u32x4 __attribute__((ext_vector_type(4)));
typedef unsigned u32x2 __attribute__((ext_vector_type(2)));

constexpr int D = 1024, NBATCH = 4, SEQ = 4096, NTOK = NBATCH * SEQ, DEPTH = 2;
constexpr int D_IN = 2372, NPAD = 2560;
constexpr int NE = 32, TOPK = 4, FF = 1024;
constexpr int NWAVES = 8, NTHREADS = 512;
constexpr float EPS = 1e-6f;
constexpr int ROWCAP = 73728;

constexpr size_t MiB = 1u << 20;
constexpr size_t WS_CTL = 0, CTL_BYTES = 1 * MiB;
constexpr size_t WS_MOD = 1 * MiB;
constexpr size_t WS_ROPEC = 2 * MiB;
constexpr size_t WS_ROPES = 4 * MiB;
constexpr size_t WS_WIN = 6 * MiB;
constexpr size_t WS_WOUT = 16 * MiB;
constexpr size_t WS_ROWTOK = 20 * MiB;
constexpr size_t WS_EIDX = 22 * MiB;
constexpr size_t WS_SLOT = 22 * MiB + 256 * 1024;
constexpr size_t WS_GATE = 22 * MiB + 512 * 1024;
constexpr size_t WS_WI = 23 * MiB;
constexpr size_t WS_KI = 24 * MiB;
constexpr size_t WS_K = 26 * MiB;
constexpr size_t WS_V = 30 * MiB;
constexpr size_t WS_QI = 34 * MiB;
constexpr size_t WS_Q = 42 * MiB;
constexpr size_t WS_UB = 58 * MiB;
constexpr size_t WS_HG = 74 * MiB;
constexpr size_t WS_SEL = 138 * MiB;
constexpr size_t WS_HL = 154 * MiB;
constexpr size_t WS_HD = 170 * MiB;
constexpr size_t WS_MIX = 171 * MiB;
constexpr size_t WS_U = 203 * MiB;
constexpr size_t WS_H = 235 * MiB;
constexpr size_t WS_W1 = 299 * MiB;
constexpr size_t WS_W2 = 555 * MiB;
constexpr size_t WS_ACT = 683 * MiB;
constexpr size_t WS_Y = 827 * MiB;
constexpr size_t WS_END = 971 * MiB;
constexpr int CW_CNT = 1024;
constexpr int CW_BAR = 8192;

constexpr int LDS_BYTES = 147456;
constexpr int LDS_TAB = 131072;
constexpr int LDS_PARK = 131072 + 1024;

__device__ __forceinline__ unsigned f2bf(float f) { unsigned u = __builtin_bit_cast(unsigned, f); return (u + 0x7fffu + ((u >> 16) & 1u)) >> 16; }
__device__ __forceinline__ unsigned pk2(float lo, float hi) { return f2bf(lo) | (f2bf(hi) << 16); }
__device__ __forceinline__ float bf2f(unsigned short b) { return __builtin_bit_cast(float, ((unsigned)b) << 16); }
__device__ __forceinline__ float bflo(unsigned w) { return __builtin_bit_cast(float, w << 16); }
__device__ __forceinline__ float bfhi(unsigned w) { return __builtin_bit_cast(float, w & 0xffff0000u); }
__device__ __forceinline__ float wave_sum(float v) {
#pragma unroll
    for (int o = 1; o < 64; o <<= 1) v += __shfl_xor(v, o);
    return v;
}
__device__ __forceinline__ float wave_max(float v) {
#pragma unroll
    for (int o = 1; o < 64; o <<= 1) v = fmaxf(v, __shfl_xor(v, o));
    return v;
}
__device__ __forceinline__ float sigmoidf_(float z) { return 1.0f / (1.0f + __expf(-z)); }
__device__ __forceinline__ float siluf_(float z) { return z / (1.0f + __expf(-z)); }

namespace pg8 {
constexpr int BM = 256, BK = 64, HALF = 128, HTB = HALF * BK * 2, STAGE_BYTES = 8 * HTB;
constexpr int KD = 1024, NKT = KD / BK;
__host__ __device__ __forceinline__ int lds_byte(int r, int c) { const int st = (r >> 4) * 2 + (c >> 5), rr = r & 15, cc = c & 31, ob = rr * 64 + cc * 2; return st * 1024 + (ob ^ (((ob >> 9) & 1) << 5)); }
__host__ __device__ __forceinline__ void stage_rc(int b, int& R, int& C) { const int st = b / 1024, sb = b % 1024, swz = sb ^ (((sb >> 9) & 1) << 5); R = (st >> 1) * 16 + swz / 64; C = (st & 1) * 32 + (swz % 64) / 2; }

struct Unit { const char* A; const char* B; const int* ridx; int nvalid; int row0, pn, e, b; };

template <class Epi, class Sched, bool GATHER, bool ALIGN_EPI>
__device__ __forceinline__ void gemm_phase(LAS unsigned char* lds, LAS unsigned* park, int tid_in, const Sched& S, const Epi& E) {
    const int tid = tid_in, wid = __builtin_amdgcn_readfirstlane(tid >> 6), lane = tid & 63, wr = wid >> 2, wc = wid & 3, fr = lane & 15, fq = lane >> 4;
    constexpr int K = KD, nt = NKT;
    unsigned voffB[2], vA[2][2];
#pragma unroll
    for (int i = 0; i < 2; ++i) { int R, C; stage_rc(tid * 16 + i * 8192, R, C); voffB[i] = (unsigned)(R * K + C) * 2u; }
    constexpr size_t kstep = (size_t)(BK * 2);
    constexpr size_t hstep = (size_t)HALF * K * 2;
    const unsigned ldsw = (unsigned)wid * 1024u;
    const int aoff = lds_byte(wr * 64 + fr, fq * 8), boff = lds_byte(wc * 32 + fr, fq * 8);
#define PG8_SA(b, h) (((b) * 2 + (h)) * HTB)
#define PG8_SB(b, h) ((4 + (b) * 2 + (h)) * HTB)
#define PG8_STAGE(bufoff, gbase, voff) do { _Pragma("unroll") for (int _i = 0; _i < 2; ++_i) \
        __builtin_amdgcn_global_load_lds((const unsigned*)((const char*)(gbase) + (voff)[_i]), (LAS unsigned*)(lds + (bufoff) + ldsw + _i * 8192), 16, 0, 0); } while (0)
#define PG8_LDA(dst, b, h) do { _Pragma("unroll") for (int m = 0; m < 4; ++m) _Pragma("unroll") for (int k = 0; k < 2; ++k) dst[m][k] = *(const LAS bf16x8*)(lds + PG8_SA(b, h) + aoff + m * 2048 + k * 1024); } while (0)
#define PG8_LDB(dst, b, h) do { _Pragma("unroll") for (int n = 0; n < 2; ++n) _Pragma("unroll") for (int k = 0; k < 2; ++k) dst[n][k] = *(const LAS bf16x8*)(lds + PG8_SB(b, h) + boff + n * 2048 + k * 1024); } while (0)
#define PG8_MMA(ai, bj, At, Bt) do { __builtin_amdgcn_s_setprio(1); _Pragma("unroll") for (int m = 0; m < 4; ++m) _Pragma("unroll") for (int n = 0; n < 2; ++n) _Pragma("unroll") for (int k = 0; k < 2; ++k) \
        acc[ai][bj][m][n] = __builtin_amdgcn_mfma_f32_16x16x32_bf16(Bt[n][k], At[m][k], acc[ai][bj][m][n], 0, 0, 0); __builtin_amdgcn_s_setprio(0); } while (0)
#define PG8_WAIT_V(n) asm volatile("s_waitcnt vmcnt(" #n ")" ::: "memory")
#define PG8_WAIT_L(n) asm volatile("s_waitcnt lgkmcnt(" #n ")" ::: "memory")
#define PG8_BAR __builtin_amdgcn_s_barrier()
#define PG8_SCHED __builtin_amdgcn_sched_barrier(0)
#define PG8_OFFS(dst, u) do { _Pragma("unroll") for (int _h = 0; _h < 2; ++_h) _Pragma("unroll") for (int _i = 0; _i < 2; ++_i) { \
        int _R, _C; stage_rc(tid * 16 + _i * 8192, _R, _C); const int _rr = _h * HALF + _R; \
        if constexpr (GATHER) { const int _ix = (u).ridx[_rr < (u).nvalid ? _rr : 0]; dst[_h][_i] = (unsigned)(_ix * K + _C) * 2u; } \
        else dst[_h][_i] = (unsigned)(_rr * K + _C) * 2u; } } while (0)
    Unit cur, nxt; int ui = 0;
    if (!S.next(0, cur)) return;
    f32x4 acc[2][2][4][2];
#pragma unroll
    for (int a = 0; a < 2; ++a)
#pragma unroll
        for (int b = 0; b < 2; ++b)
#pragma unroll
            for (int m = 0; m < 4; ++m)
#pragma unroll
                for (int n = 0; n < 2; ++n) acc[a][b][m][n] = (f32x4){0.f, 0.f, 0.f, 0.f};
    bf16x8 At[4][2], B0[2][2], B1[2][2];
    PG8_OFFS(vA, cur);
    const char* cA = cur.A; const char* cB = cur.B;
    PG8_STAGE(PG8_SB(0, 0), cB, voffB); PG8_STAGE(PG8_SB(0, 1), cB + hstep, voffB); PG8_STAGE(PG8_SA(0, 0), cA, vA[0]); PG8_STAGE(PG8_SA(0, 1), cA, vA[1]);
    if (wr == 1) PG8_BAR;
    PG8_WAIT_V(2); PG8_BAR;
    PG8_STAGE(PG8_SB(1, 0), cB + kstep, voffB); PG8_STAGE(PG8_SA(1, 0), cA + kstep, vA[0]); PG8_STAGE(PG8_SB(1, 1), cB + hstep + kstep, voffB);
    PG8_WAIT_V(6); PG8_BAR;
    for (;;) {
        const bool has_next = S.next(ui + 1, nxt);
        const char* nA = has_next ? nxt.A : cA; const char* nB = has_next ? nxt.B : cB;
        if constexpr (GATHER) {
            unsigned nv[2][2];
            if (has_next) { PG8_OFFS(nv, nxt); } else {
#pragma unroll
                for (int h = 0; h < 2; ++h) { nv[h][0] = vA[h][0]; nv[h][1] = vA[h][1]; } }
            *(LAS u32x4*)(park + tid * 4) = (u32x4){nv[0][0], nv[0][1], nv[1][0], nv[1][1]};
        }
        for (int t = 0; t < nt; t += 2) {
            const bool last = (t == nt - 2);
            const char* a1 = cA + (size_t)(t + 1) * kstep;
            const char* a2 = last ? nA : cA + (size_t)(t + 2) * kstep; const char* b2 = last ? nB : cB + (size_t)(t + 2) * kstep;
            const char* a3 = a2 + kstep; const char* b3 = b2 + kstep;
            PG8_LDB(B0, 0, 0); PG8_LDB(B1, 0, 1); PG8_SCHED; PG8_LDA(At, 0, 0); PG8_STAGE(PG8_SA(1, 1), a1, vA[1]);
            if constexpr (GATHER) { if (last) { const u32x4 pv = *(const LAS u32x4*)(park + tid * 4); vA[0][0] = pv.x; vA[0][1] = pv.y; vA[1][0] = pv.z; vA[1][1] = pv.w; } }
            PG8_WAIT_V(8); PG8_WAIT_L(0); PG8_BAR; PG8_MMA(0, 0, At, B0); PG8_MMA(0, 1, At, B1); PG8_BAR; PG8_SCHED;
            PG8_LDA(At, 0, 1); PG8_STAGE(PG8_SB(0, 0), b2, voffB); PG8_STAGE(PG8_SB(0, 1), b2 + hstep, voffB); PG8_STAGE(PG8_SA(0, 0), a2, vA[0]);
            PG8_WAIT_V(8); PG8_WAIT_L(0); PG8_BAR; PG8_MMA(1, 0, At, B0); PG8_MMA(1, 1, At, B1); PG8_BAR; PG8_SCHED;
            PG8_LDB(B0, 1, 0); PG8_LDB(B1, 1, 1); PG8_SCHED; PG8_LDA(At, 1, 0); PG8_STAGE(PG8_SA(0, 1), a2, vA[1]);
            PG8_WAIT_V(8); PG8_WAIT_L(0); PG8_BAR; PG8_MMA(0, 0, At, B0); PG8_MMA(0, 1, At, B1); PG8_BAR; PG8_SCHED;
            PG8_LDA(At, 1, 1); PG8_STAGE(PG8_SB(1, 0), b3, voffB); PG8_STAGE(PG8_SB(1, 1), b3 + hstep, voffB); PG8_STAGE(PG8_SA(1, 0), a3, vA[0]);
            PG8_WAIT_V(8); PG8_WAIT_L(0); PG8_BAR; PG8_MMA(1, 0, At, B0); PG8_MMA(1, 1, At, B1); PG8_BAR; PG8_SCHED;
        }
        if constexpr (ALIGN_EPI) { if (wr == 0) PG8_BAR; }
        { int fr2 = fr, fq2 = fq; asm volatile("" : "+v"(fr2), "+v"(fq2)); E(acc, cur, wr, wc, fr2, fq2); }
        if (!has_next) break;
#pragma unroll
        for (int a = 0; a < 2; ++a)
#pragma unroll
            for (int b = 0; b < 2; ++b)
#pragma unroll
                for (int m = 0; m < 4; ++m)
#pragma unroll
                    for (int n = 0; n < 2; ++n) acc[a][b][m][n] = (f32x4){0.f, 0.f, 0.f, 0.f};
        cur = nxt; cA = nA; cB = nB; ++ui;
        if constexpr (ALIGN_EPI) { if (wr == 1) PG8_BAR; }
    }
    PG8_WAIT_V(0);
    if constexpr (!ALIGN_EPI) { if (wr == 0) PG8_BAR; }
    PG8_BAR;
#undef PG8_SA
#undef PG8_SB
#undef PG8_STAGE
#undef PG8_LDA
#undef PG8_LDB
#undef PG8_MMA
#undef PG8_WAIT_V
#undef PG8_WAIT_L
#undef PG8_BAR
#undef PG8_SCHED
#undef PG8_OFFS
}
}

struct Args {
    const float* x; const float* c; const int* pos; const float* w_ada; const float* b_ada; const float* norm1_g; const float* norm2_g;
    const float* w_in; const float* w_out; const float* pool_w; const float* pool_scale; const float* hgrn_g; const float* lb_logits;
    const float* w_router; const float* b_router; const float* w1; const float* b1; const float* w2; const float* b2; const float* final_g;
    float* out; unsigned char* ws; int ph_lo, ph_hi;
};

struct Ctx {
    LAS unsigned char* lds;
    int tid, lane, wave, G, vcu;
    unsigned char* ws;
};

struct DenseOrder {
    const char* A; const char* B; int nM, nN, nwg, G, c;
    __device__ __forceinline__ bool next(int i, pg8::Unit& u) const {
        const long L = (long)i * G + c; if (L >= nwg) return false;
        int wgid = (int)L; { const int q = nwg / 8, r = nwg % 8, xcd = wgid % 8, off = wgid / 8; wgid = (xcd < r ? xcd * (q + 1) : r * (q + 1) + (xcd - r) * q) + off; }
        const int nig = 8 * nN, gid = wgid / nig, fm = gid * 8, gsz = (nM - fm) < 8 ? (nM - fm) : 8;
        const int pm = fm + ((wgid % nig) % gsz), pn = (wgid % nig) / gsz;
        u.A = A + (size_t)pm * 256 * pg8::KD * 2; u.B = B + (size_t)pn * 256 * pg8::KD * 2; u.ridx = nullptr; u.nvalid = 256; u.row0 = pm * 256; u.pn = pn; u.e = 0; u.b = pm >> 4;
        return true;
    }
};

template <bool FIRST> struct MoeOrder {
    LAS const int* tab; const char* A; const char* B; const int* rowtok; int G, c;
    static constexpr int NTN = FIRST ? 8 : 4;
    __device__ __forceinline__ bool next(int i, pg8::Unit& u) const {
        const int P = tab[32]; const long L = (long)i * G + c; if (L >= (long)P * NTN) return false;
        const int p = (int)(L / NTN), nt = (int)(L % NTN);
        int e = 0;
#pragma unroll 1
        for (int k = 1; k < 32; ++k) e = (tab[k] <= p) ? k : e;
        const int mt = p - tab[e], cnt = tab[33 + e];
        if (FIRST) { u.A = A; u.ridx = rowtok + e * NTOK + mt * 256; u.nvalid = (cnt - mt * 256) < 256 ? (cnt - mt * 256) : 256; u.B = B + ((size_t)e * 2048 + nt * 256) * pg8::KD * 2; }
        else { u.A = A + (size_t)p * 256 * pg8::KD * 2; u.ridx = nullptr; u.nvalid = 256; u.B = B + ((size_t)e * 1024 + nt * 256) * pg8::KD * 2; }
        u.row0 = p * 256; u.pn = nt; u.e = e; u.b = 0;
        return true;
    }
};

struct EpiIn {
    unsigned char* ws;
    __device__ __forceinline__ void operator()(const f32x4 (&acc)[2][2][4][2], const pg8::Unit& u, int wr, int wc, int fr, int fq) const {
        const int pn = u.pn;
        const float* rc = (const float*)(ws + WS_ROPEC); const float* rs = (const float*)(ws + WS_ROPES);
#pragma unroll
        for (int ai = 0; ai < 2; ++ai)
#pragma unroll
            for (int m = 0; m < 4; ++m) {
                const int r = u.row0 + ai * 128 + wr * 64 + m * 16 + fr;
#pragma unroll
                for (int bj = 0; bj < 2; ++bj) {
                    const f32x4 a0 = acc[ai][bj][m][0], a1 = acc[ai][bj][m][1];
                    const int g32 = bj * 4 + wc;
                    bool rope = false; bf16_t* dst = nullptr; float scl = 1.f;
                    if (pn <= 1) { rope = true; dst = (bf16_t*)(ws + WS_Q) + (size_t)r * 512 + (pn * 4 + (g32 >> 1)) * 64; scl = 0.125f; }
                    else if (pn == 2 && bj == 0) { rope = true; dst = (bf16_t*)(ws + WS_K) + (size_t)r * 128 + (g32 >> 1) * 64; }
                    else if (pn == 3) { rope = true; dst = (bf16_t*)(ws + WS_QI) + (size_t)r * 256 + (g32 >> 1) * 64; }
                    else if (pn == 4 && bj == 0 && wc < 2) { rope = true; dst = (bf16_t*)(ws + WS_KI) + (size_t)r * 64; }
                    if (rope) {
                        const int d = 16 * (g32 & 1) + 4 * fq;
                        const f32x4 cv = *(const f32x4*)(rc + (size_t)r * 32 + d), sv = *(const f32x4*)(rs + (size_t)r * 32 + d);
                        const f32x4 o1 = (a0 * cv - a1 * sv) * scl, o2 = (a1 * cv + a0 * sv) * scl;
                        u32x2 w1v, w2v; w1v.x = pk2(o1[0], o1[1]); w1v.y = pk2(o1[2], o1[3]); w2v.x = pk2(o2[0], o2[1]); w2v.y = pk2(o2[2], o2[3]);
                        *(u32x2*)(dst + d) = w1v; *(u32x2*)(dst + 32 + d) = w2v;
                    } else if (pn == 2) {
                        bf16_t* vp = (bf16_t*)(ws + WS_V) + (size_t)r * 128 + wc * 32 + 4 * fq;
                        u32x2 w0v, w1v; w0v.x = pk2(a0[0], a0[1]); w0v.y = pk2(a0[2], a0[3]); w1v.x = pk2(a1[0], a1[1]); w1v.y = pk2(a1[2], a1[3]);
                        *(u32x2*)(vp) = w0v; *(u32x2*)(vp + 16) = w1v;
                    } else if (pn == 4) {
                        if (bj == 0 && wc == 2 && fq == 0) *(f32x4*)((float*)(ws + WS_WI) + (size_t)r * 4) = a0 * 0.0625f;
                    } else if (pn == 5) {
                        float* p = (float*)(ws + WS_UB) + (size_t)r * 256 + bj * 128 + wc * 32 + 4 * fq;
                        *(f32x4*)p = a0; *(f32x4*)(p + 16) = a1;
                    } else if (pn >= 6) {
                        float* p = (float*)(ws + WS_HG) + (size_t)r * 1024 + (pn - 6) * 256 + bj * 128 + wc * 32 + 4 * fq;
                        *(f32x4*)p = a0; *(f32x4*)(p + 16) = a1;
                    }
                }
            }
    }
};
struct EpiOut {
    const float* hin; float* hout; const float* gate;
    __device__ __forceinline__ void operator()(const f32x4 (&acc)[2][2][4][2], const pg8::Unit& u, int wr, int wc, int fr, int fq) const {
        const int col0 = u.pn * 256 + wc * 32 + 4 * fq; const float* gp = gate + (size_t)u.b * 6144 + col0;
        f32x4 gv[2][2];
#pragma unroll
        for (int bj = 0; bj < 2; ++bj)
#pragma unroll
            for (int n = 0; n < 2; ++n) gv[bj][n] = *(const f32x4*)(gp + bj * 128 + n * 16);
#pragma unroll
        for (int ai = 0; ai < 2; ++ai)
#pragma unroll
            for (int m = 0; m < 4; ++m) { const size_t off = (size_t)(u.row0 + ai * 128 + wr * 64 + m * 16 + fr) * D + col0;
#pragma unroll
                for (int bj = 0; bj < 2; ++bj)
#pragma unroll
                    for (int n = 0; n < 2; ++n) { const f32x4 hv = *(const f32x4*)(hin + off + bj * 128 + n * 16); *(f32x4*)(hout + off + bj * 128 + n * 16) = hv + gv[bj][n] * acc[ai][bj][m][n]; }
                asm volatile("" ::: "memory"); }
    }
};
struct EpiG1 {
    bf16_t* act; const float* b1l;
    __device__ __forceinline__ void operator()(const f32x4 (&acc)[2][2][4][2], const pg8::Unit& u, int wr, int wc, int fr, int fq) const {
        f32x4 bg[2], bl[2];
#pragma unroll
        for (int bj = 0; bj < 2; ++bj) { const int ja = u.pn * 128 + (bj * 4 + wc) * 16 + 4 * fq; const float* bp = b1l + (size_t)u.e * 2048 + 2 * ja;
            const f32x4 t0 = *(const f32x4*)bp, t1 = *(const f32x4*)(bp + 4); bg[bj] = (f32x4){t0[0], t0[2], t1[0], t1[2]}; bl[bj] = (f32x4){t0[1], t0[3], t1[1], t1[3]}; }
#pragma unroll
        for (int ai = 0; ai < 2; ++ai)
#pragma unroll
            for (int m = 0; m < 4; ++m) { bf16_t* rowp = act + (size_t)(u.row0 + ai * 128 + wr * 64 + m * 16 + fr) * FF + u.pn * 128 + wc * 16 + 4 * fq;
#pragma unroll
                for (int bj = 0; bj < 2; ++bj) { const f32x4 hg = acc[ai][bj][m][0] + bg[bj], hl = acc[ai][bj][m][1] + bl[bj]; float o[4];
#pragma unroll
                    for (int j = 0; j < 4; ++j) { const float xg = fminf(hg[j], 7.0f), xl = fminf(fmaxf(hl[j], -7.0f), 7.0f); o[j] = xg * sigmoidf_(1.702f * xg) * (xl + 1.0f); }
                    u32x2 w; w.x = pk2(o[0], o[1]); w.y = pk2(o[2], o[3]); *(u32x2*)(rowp + bj * 64) = w; } }
    }
};
struct EpiG2 {
    bf16_t* y; const float* b2l;
    __device__ __forceinline__ void operator()(const f32x4 (&acc)[2][2][4][2], const pg8::Unit& u, int wr, int wc, int fr, int fq) const {
        const int col0 = u.pn * 256 + wc * 32 + 4 * fq; const float* bp = b2l + (size_t)u.e * 1024 + col0;
        f32x4 bv[2][2];
#pragma unroll
        for (int bj = 0; bj < 2; ++bj)
#pragma unroll
            for (int n = 0; n < 2; ++n) bv[bj][n] = *(const f32x4*)(bp + bj * 128 + n * 16);
#pragma unroll
        for (int ai = 0; ai < 2; ++ai)
#pragma unroll
            for (int m = 0; m < 4; ++m) { bf16_t* rowp = y + (size_t)(u.row0 + ai * 128 + wr * 64 + m * 16 + fr) * D + col0;
#pragma unroll
                for (int bj = 0; bj < 2; ++bj)
#pragma unroll
                    for (int n = 0; n < 2; ++n) { const f32x4 v = acc[ai][bj][m][n] + bv[bj][n]; u32x2 w; w.x = pk2(v[0], v[1]); w.y = pk2(v[2], v[3]); *(u32x2*)(rowp + bj * 128 + n * 16) = w; } }
    }
};

__device__ __forceinline__ int win_dest(int s) {
    int base, loc, heads_rope;
    if (s < 512) { base = 0; loc = s; heads_rope = 1; }
    else if (s < 640) { base = 512; loc = s - 512; heads_rope = 1; }
    else if (s < 768) { return 640 + (s - 640); }
    else if (s < 1024) { base = 768; loc = s - 768; heads_rope = 1; }
    else if (s < 1088) { base = 1024; loc = s - 1024; heads_rope = 1; }
    else if (s < 1092) { return 1088 + (s - 1088); }
    else if (s < 1348) { return 1280 + (s - 1092); }
    else { return 1536 + (s - 1348); }
    (void)heads_rope;
    const int hd = loc >> 6, d = loc & 63, x2 = d >> 5, dd = d & 31, half = dd >> 4, q15 = dd & 15;
    return base + hd * 64 + 32 * half + 16 * x2 + q15;
}
__device__ __forceinline__ int w1_dest(int s) { const int ja = s >> 1, n = s & 1, nt = ja >> 7, jj = ja & 127, g32 = jj >> 4, r = jj & 15; return 256 * nt + 32 * g32 + 16 * n + r; }

template <int MAP>
__device__ __forceinline__ void transpose_item(const float* W, int N, bf16_t* WT, LAS float* scr, int kb, int nb, int lane) {
    const int k0 = 64 * kb, n0 = 32 * nb, col = n0 + (lane & 31); const bool ok = col < N;
    float v[32];
    const float* src = W + (size_t)(k0 + (lane >> 5)) * N + (ok ? col : 0);
#pragma unroll
    for (int i = 0; i < 32; ++i) v[i] = src[(size_t)(2 * i) * N];
#pragma unroll
    for (int i = 0; i < 32; ++i) scr[(2 * i + (lane >> 5)) * 33 + (lane & 31)] = ok ? v[i] : 0.f;
    asm volatile("s_waitcnt lgkmcnt(0)" ::: "memory");
    const int c = lane & 7;
#pragma unroll
    for (int j = 0; j < 4; ++j) { const int n = (lane >> 3) + 8 * j; const LAS float* s = scr + (8 * c) * 33 + n;
        u32x4 o; o.x = pk2(s[0 * 33], s[1 * 33]); o.y = pk2(s[2 * 33], s[3 * 33]); o.z = pk2(s[4 * 33], s[5 * 33]); o.w = pk2(s[6 * 33], s[7 * 33]);
        const int sc = n0 + n;
        if (sc < N) { const int dest = MAP == 1 ? win_dest(sc) : (MAP == 2 ? w1_dest(sc) : sc); *(u32x4*)(WT + (size_t)dest * 1024 + k0 + 8 * c) = o; } }
    asm volatile("s_waitcnt lgkmcnt(0)" ::: "memory");
}

__device__ __forceinline__ void phase_prep(const Args& a, Ctx& C) {
    unsigned char* ws = C.ws;
    {
        LAS float* ca = (LAS float*)C.lds;
        LAS float* red = ca + 4096;
        for (int i = C.tid; i < 4096; i += NTHREADS) { const float v = a.c[i]; ca[i] = siluf_(v); }
        __syncthreads();
        for (int it = blockIdx.x; it < 192; it += C.G) {
            const int l = it / 96, cb = it % 96, col = cb * 64 + (C.tid & 63), kg = C.tid >> 6;
            const float* w = a.w_ada + (size_t)l * 1024 * 6144 + col;
            float s0 = 0.f, s1 = 0.f, s2 = 0.f, s3 = 0.f;
#pragma unroll 8
            for (int k = kg * 128; k < kg * 128 + 128; ++k) { const float wv = w[(size_t)k * 6144]; s0 += ca[k] * wv; s1 += ca[1024 + k] * wv; s2 += ca[2048 + k] * wv; s3 += ca[3072 + k] * wv; }
            red[(kg * 4 + 0) * 64 + (C.tid & 63)] = s0; red[(kg * 4 + 1) * 64 + (C.tid & 63)] = s1; red[(kg * 4 + 2) * 64 + (C.tid & 63)] = s2; red[(kg * 4 + 3) * 64 + (C.tid & 63)] = s3;
            __syncthreads();
            if (C.tid < 256) { const int b = C.tid >> 6, cc = C.tid & 63; float s = 0.f;
#pragma unroll
                for (int g = 0; g < 8; ++g) s += red[(g * 4 + b) * 64 + cc];
                ((float*)(ws + WS_MOD))[(size_t)(l * 4 + b) * 6144 + cb * 64 + cc] = s + a.b_ada[l * 6144 + cb * 64 + cc]; }
            __syncthreads();
        }
    }
    const int gw = C.vcu * NWAVES + C.wave, NGW = C.G * NWAVES;
    for (int tk = gw; tk < NTOK; tk += NGW) {
        if (C.lane < 32) {
            const float posf = (float)a.pos[tk];
            const float inv = exp2f(-(float)C.lane * (13.287712379549449f / 32.0f));
            const double ang = (double)(posf * inv);
            const double kq = rint(ang * 0.63661977236758134308);
            const double y = fma(-kq, 1.57079632679489661923, ang);
            const double y2 = y * y;
            const double sy = y * (1.0 + y2 * (-1.0 / 6 + y2 * (1.0 / 120 + y2 * (-1.0 / 5040 + y2 * (1.0 / 362880 - y2 * (1.0 / 39916800))))));
            const double cy = 1.0 + y2 * (-0.5 + y2 * (1.0 / 24 + y2 * (-1.0 / 720 + y2 * (1.0 / 40320 + y2 * (-1.0 / 3628800 + y2 * (1.0 / 479001600))))));
            const int q = ((int)((long long)kq)) & 3;
            const double sn = (q == 0) ? sy : (q == 1) ? cy : (q == 2) ? -sy : -cy;
            const double cs = (q == 0) ? cy : (q == 1) ? -sy : (q == 2) ? -cy : sy;
            ((float*)(ws + WS_ROPEC))[(size_t)tk * 32 + C.lane] = (float)cs;
            ((float*)(ws + WS_ROPES))[(size_t)tk * 32 + C.lane] = (float)sn;
        }
    }
    LAS float* scr = (LAS float*)(C.lds + C.wave * 16384);
    constexpr int I_IN = 2 * 16 * 75, I_OUT = 2 * 16 * 32, I_W1 = 64 * 16 * 64, I_W2 = 64 * 16 * 32;
    for (int it = gw; it < I_IN + I_OUT + I_W1 + I_W2; it += NGW) {
        int r = it;
        if (r < I_IN) { const int l = r / (16 * 75), q = r % (16 * 75); transpose_item<1>(a.w_in + (size_t)l * 1024 * D_IN, D_IN, (bf16_t*)(ws + WS_WIN) + (size_t)l * NPAD * 1024, scr, q / 75, q % 75, C.lane); continue; }
        r -= I_IN;
        if (r < I_OUT) { const int l = r / (16 * 32), q = r % (16 * 32); transpose_item<0>(a.w_out + (size_t)l * 1024 * 1024, 1024, (bf16_t*)(ws + WS_WOUT) + (size_t)l * 1024 * 1024, scr, q / 32, q % 32, C.lane); continue; }
        r -= I_OUT;
        if (r < I_W1) { const int le = r / (16 * 64), q = r % (16 * 64); transpose_item<2>(a.w1 + (size_t)le * 1024 * 2048, 2048, (bf16_t*)(ws + WS_W1) + (size_t)le * 2048 * 1024, scr, q / 64, q % 64, C.lane); continue; }
        r -= I_W1;
        { const int le = r / (16 * 32), q = r % (16 * 32); transpose_item<0>(a.w2 + (size_t)le * 1024 * 1024, 1024, (bf16_t*)(ws + WS_W2) + (size_t)le * 1024 * 1024, scr, q / 32, q % 32, C.lane); }
    }
}

__device__ __forceinline__ void norm_mod_store(const f32x4 (&v)[4], const float* g, const float* sh, const float* sc, bf16_t* urow, int lane) {
    float ss = 0.f;
#pragma unroll
    for (int j = 0; j < 4; ++j) ss += (v[j].x * v[j].x + v[j].y * v[j].y) + (v[j].z * v[j].z + v[j].w * v[j].w);
    const float rstd = 1.0f / sqrtf(wave_sum(ss) * (1.0f / D) + EPS);
#pragma unroll
    for (int j = 0; j < 4; ++j) { const int idx = 4 * lane + 256 * j; const f32x4 gv = *(const f32x4*)(g + idx), shv = *(const f32x4*)(sh + idx), scv = *(const f32x4*)(sc + idx);
        const f32x4 o = v[j] * rstd * gv * (scv + 1.0f) + shv; u32x2 w; w.x = pk2(o[0], o[1]); w.y = pk2(o[2], o[3]); *(u32x2*)(urow + idx) = w; }
}

__device__ __forceinline__ void phase_u0(const Args& a, Ctx& C) {
    const int gw = C.vcu * NWAVES + C.wave, NGW = C.G * NWAVES; const float* mod = (const float*)(C.ws + WS_MOD);
    for (int tk = gw; tk < NTOK; tk += NGW) {
        const int b = tk >> 12; const f32x4* xr = (const f32x4*)(a.x + (size_t)tk * D) + C.lane; f32x4 v[4];
#pragma unroll
        for (int j = 0; j < 4; ++j) v[j] = xr[64 * j];
        const float* mb = mod + (size_t)(0 * 4 + b) * 6144;
        norm_mod_store(v, a.norm1_g, mb + 0, mb + 1024, (bf16_t*)(C.ws + WS_U) + (size_t)tk * D, C.lane);
    }
}

__device__ __forceinline__ unsigned sortable(float f) { const unsigned u = __builtin_bit_cast(unsigned, f); return (u & 0x80000000u) ? ~u : (u | 0x80000000u); }
__device__ __forceinline__ int mbcnt64(unsigned long long m) { return __builtin_amdgcn_mbcnt_hi((unsigned)(m >> 32), __builtin_amdgcn_mbcnt_lo((unsigned)m, 0)); }

__device__ __forceinline__ void select_query(Ctx& C, int tk, LAS float* sc, LAS float* qs) {
    unsigned char* ws = C.ws; const int lane = C.lane;
    const int tpos = tk & (SEQ - 1), b = tk >> 12, cch = tpos >> 6, L = 64 * (cch + 1), nj = cch + 1;
    int* sel = (int*)(ws + WS_SEL) + (size_t)tk * 256;
    if (L <= 256) { for (int i = lane; i < L; i += 64) sel[i] = i; return; }
    {
        const u32x2 w = *(const u32x2*)((const bf16_t*)(ws + WS_QI) + (size_t)tk * 256 + 4 * lane);
        *(LAS f32x4*)(qs + 4 * lane) = (f32x4){bflo(w.x), bfhi(w.x), bflo(w.y), bfhi(w.y)};
    }
    const f32x4 wi = *(const f32x4*)((const float*)(ws + WS_WI) + (size_t)tk * 4);
    asm volatile("s_waitcnt lgkmcnt(0)" ::: "memory"); __builtin_amdgcn_wave_barrier();
    const bf16_t* kib = (const bf16_t*)(ws + WS_KI) + (size_t)b * SEQ * 64;
#pragma unroll 1
    for (int j0 = 0; j0 < 64; ++j0) {
        asm volatile("" ::: "memory");
        const int sA = 64 * j0 + lane;
        if (j0 >= nj) { sc[sA] = -3.0e38f; continue; }
        u32x4 ka[8];
#pragma unroll
        for (int i = 0; i < 8; ++i) ka[i] = *(const u32x4*)(kib + (size_t)sA * 64 + 8 * i);
        float aA[4] = {0.f, 0.f, 0.f, 0.f};
#pragma unroll
        for (int i = 0; i < 8; ++i) {
            const float a0 = bflo(ka[i].x), a1 = bfhi(ka[i].x), a2 = bflo(ka[i].y), a3 = bfhi(ka[i].y), a4 = bflo(ka[i].z), a5 = bfhi(ka[i].z), a6 = bflo(ka[i].w), a7 = bfhi(ka[i].w);
#pragma unroll
            for (int h = 0; h < 4; ++h) {
                const f32x4 q0 = *(const LAS f32x4*)(qs + h * 64 + 8 * i), q1 = *(const LAS f32x4*)(qs + h * 64 + 8 * i + 4);
                aA[h] += q0.x * a0 + q0.y * a1 + q0.z * a2 + q0.w * a3 + q1.x * a4 + q1.y * a5 + q1.z * a6 + q1.w * a7;
            }
        }
        float scA = fmaxf(aA[0], 0.f) * wi[0] + fmaxf(aA[1], 0.f) * wi[1] + fmaxf(aA[2], 0.f) * wi[2] + fmaxf(aA[3], 0.f) * wi[3];
        scA = (scA == 0.f) ? 0.f : scA;
        sc[sA] = scA;
    }
    asm volatile("s_waitcnt lgkmcnt(0)" ::: "memory"); __builtin_amdgcn_wave_barrier();
    unsigned key[64];
#pragma unroll
    for (int j = 0; j < 64; ++j) key[j] = sortable(sc[64 * j + lane]);
    unsigned T = 0u;
#pragma unroll 1
    for (int bit = 31; bit >= 0; --bit) {
        const unsigned cand = T | (1u << bit); int c = 0;
#pragma unroll
        for (int j = 0; j < 64; ++j) c += (key[j] >= cand) ? 1 : 0;
#pragma unroll
        for (int o = 1; o < 64; o <<= 1) c += __shfl_xor(c, o);
        if (c >= 256) T = cand;
    }
    int cgt = 0;
#pragma unroll
    for (int j = 0; j < 64; ++j) cgt += (key[j] > T) ? 1 : 0;
#pragma unroll
    for (int o = 1; o < 64; o <<= 1) cgt += __shfl_xor(cgt, o);
    const int need = 256 - cgt; int base = 0, eqseen = 0;
#pragma unroll 1
    for (int j = 0; j < nj; ++j) {
        const unsigned kj = sortable(sc[64 * j + lane]);
        const bool gt = kj > T, eq = kj == T; const unsigned long long em = __ballot(eq);
        const bool take = gt || (eq && (eqseen + mbcnt64(em)) < need); const unsigned long long tm = __ballot(take);
        if (take) sel[base + mbcnt64(tm)] = 64 * j + lane;
        base += __popcll(tm); eqseen += __popcll(em);
    }
}

__device__ __forceinline__ void attend_query(Ctx& C, int tk, LAS float* qf, LAS float* P, LAS int* sl) {
    unsigned char* ws = C.ws; const int lane = C.lane;
    const int tpos = tk & (SEQ - 1), b = tk >> 12, L = 64 * ((tpos >> 6) + 1), nsel = L < 256 ? L : 256;
    {
        const u32x4 w = *(const u32x4*)((const bf16_t*)(ws + WS_Q) + (size_t)tk * 512 + 8 * lane);
        *(LAS f32x4*)(qf + 8 * lane) = (f32x4){bflo(w.x), bfhi(w.x), bflo(w.y), bfhi(w.y)}; *(LAS f32x4*)(qf + 8 * lane + 4) = (f32x4){bflo(w.z), bfhi(w.z), bflo(w.w), bfhi(w.w)};
        const int* sg = (const int*)(ws + WS_SEL) + (size_t)tk * 256;
#pragma unroll
        for (int i = 0; i < 4; ++i) sl[64 * i + lane] = (64 * i + lane) < nsel ? sg[64 * i + lane] : 0;
    }
    asm volatile("s_waitcnt lgkmcnt(0)" ::: "memory"); __builtin_amdgcn_wave_barrier();
    const bf16_t* kb = (const bf16_t*)(ws + WS_K) + (size_t)b * SEQ * 128; const bf16_t* vb = (const bf16_t*)(ws + WS_V) + (size_t)b * SEQ * 128;
#pragma unroll 1
    for (int i = 0; i < 4; ++i) {
        const int slot = 64 * i + lane; const bool valid = slot < nsel; const int key = sl[slot];
#pragma unroll 1
        for (int n = 0; n < 2; ++n) {
            asm volatile("" ::: "memory");
            float ac[4] = {0.f, 0.f, 0.f, 0.f};
#pragma unroll 1
            for (int c2 = 0; c2 < 4; ++c2) {
                asm volatile("" ::: "memory");
                u32x4 kr[2];
#pragma unroll
                for (int c = 0; c < 2; ++c) kr[c] = *(const u32x4*)(kb + (size_t)key * 128 + n * 64 + 8 * (2 * c2 + c));
#pragma unroll
                for (int c = 0; c < 2; ++c) {
                    const float a0 = bflo(kr[c].x), a1 = bfhi(kr[c].x), a2 = bflo(kr[c].y), a3 = bfhi(kr[c].y), a4 = bflo(kr[c].z), a5 = bfhi(kr[c].z), a6 = bflo(kr[c].w), a7 = bfhi(kr[c].w);
#pragma unroll
                    for (int h = 0; h < 4; ++h) {
                        const f32x4 q0 = *(const LAS f32x4*)(qf + (4 * n + h) * 64 + 8 * (2 * c2 + c)), q1 = *(const LAS f32x4*)(qf + (4 * n + h) * 64 + 8 * (2 * c2 + c) + 4);
                        ac[h] += q0.x * a0 + q0.y * a1 + q0.z * a2 + q0.w * a3 + q1.x * a4 + q1.y * a5 + q1.z * a6 + q1.w * a7;
                    }
                }
            }
            *(LAS f32x4*)(P + slot * 8 + 4 * n) = valid ? (f32x4){ac[0], ac[1], ac[2], ac[3]} : (f32x4){-1e30f, -1e30f, -1e30f, -1e30f};
        }
    }
    asm volatile("s_waitcnt lgkmcnt(0)" ::: "memory"); __builtin_amdgcn_wave_barrier();
    float lg[4][8];
#pragma unroll
    for (int i = 0; i < 4; ++i) { const f32x4 t0 = *(const LAS f32x4*)(P + (64 * i + lane) * 8), t1 = *(const LAS f32x4*)(P + (64 * i + lane) * 8 + 4);
        lg[i][0] = t0.x; lg[i][1] = t0.y; lg[i][2] = t0.z; lg[i][3] = t0.w; lg[i][4] = t1.x; lg[i][5] = t1.y; lg[i][6] = t1.z; lg[i][7] = t1.w; }
    float inv[8];
#pragma unroll
    for (int h = 0; h < 8; ++h) {
        const float m = wave_max(fmaxf(fmaxf(lg[0][h], lg[1][h]), fmaxf(lg[2][h], lg[3][h]))); float s = 0.f;
#pragma unroll
        for (int i = 0; i < 4; ++i) { const float p = (64 * i + lane) < nsel ? __expf(lg[i][h] - m) : 0.f; lg[i][h] = p; s += p; }
        inv[h] = 1.0f / wave_sum(s);
    }
#pragma unroll
    for (int i = 0; i < 4; ++i) { LAS float* pp = P + (64 * i + lane) * 8;
        *(LAS f32x4*)pp = (f32x4){lg[i][0], lg[i][1], lg[i][2], lg[i][3]}; *(LAS f32x4*)(pp + 4) = (f32x4){lg[i][4], lg[i][5], lg[i][6], lg[i][7]}; }
    asm volatile("s_waitcnt lgkmcnt(0)" ::: "memory"); __builtin_amdgcn_wave_barrier();
    float o[8] = {0.f, 0.f, 0.f, 0.f, 0.f, 0.f, 0.f, 0.f};
#pragma unroll 4
    for (int slot = 0; slot < nsel; ++slot) {
        const int key = sl[slot];
        const float v0 = bf2f(vb[(size_t)key * 128 + lane]), v1 = bf2f(vb[(size_t)key * 128 + 64 + lane]);
        const f32x4 p0 = *(const LAS f32x4*)(P + slot * 8), p1 = *(const LAS f32x4*)(P + slot * 8 + 4);
        o[0] += p0.x * v0; o[1] += p0.y * v0; o[2] += p0.z * v0; o[3] += p0.w * v0; o[4] += p1.x * v1; o[5] += p1.y * v1; o[6] += p1.z * v1; o[7] += p1.w * v1;
    }
    bf16_t* mo = (bf16_t*)(ws + WS_MIX) + (size_t)tk * D;
#pragma unroll
    for (int h = 0; h < 8; ++h) mo[h * 64 + lane] = (bf16_t)f2bf(o[h] * inv[h]);
    asm volatile("s_waitcnt lgkmcnt(0)" ::: "memory"); __builtin_amdgcn_wave_barrier();
}

__device__ __forceinline__ void pool_item(const Args& a, Ctx& C, int l, int item) {
    unsigned char* ws = C.ws; const int tid = C.tid;
    const int g = item & 3, tt = item >> 2, b = tt >> 6, tp0 = (tt & 63) * 64, w = 2 << g;
    LAS float* ub = (LAS float*)C.lds;
    LAS float* pw = ub + 79 * 64;
    LAS float* pl = pw + 64 * 64;
    const float* ubg = (const float*)(ws + WS_UB);
    for (int idx = tid; idx < 79 * 16; idx += NTHREADS) { const int row = idx >> 4, c4 = idx & 15, tp = tp0 - 15 + row;
        f32x4 v = (f32x4){0.f, 0.f, 0.f, 0.f}; if (tp >= 0) v = *(const f32x4*)(ubg + (size_t)(b * SEQ + tp) * 256 + g * 64 + 4 * c4);
        *(LAS f32x4*)(ub + row * 64 + 4 * c4) = v; }
    for (int idx = tid; idx < 1024; idx += NTHREADS) *(LAS f32x4*)(pw + 4 * idx) = *(const f32x4*)(a.pool_w + (size_t)(l * 4 + g) * 4096 + 4 * idx);
    __syncthreads();
    const int t = tid >> 3, c8 = (tid & 7) * 8, tpos = tp0 + t, wl = (tpos + 1) < w ? (tpos + 1) : w;
    {
        float s[8] = {0.f, 0.f, 0.f, 0.f, 0.f, 0.f, 0.f, 0.f};
        for (int i = 0; i < wl; ++i) {
#pragma unroll
            for (int j = 0; j < 8; ++j) s[j] += ub[(t + 15 - i) * 64 + c8 + j]; }
        const float rw = 1.0f / (float)wl;
#pragma unroll
        for (int j = 0; j < 8; ++j) pl[t * 65 + c8 + j] = s[j] * rw - ub[(t + 15) * 64 + c8 + j];
    }
    __syncthreads();
    float y[8] = {0.f, 0.f, 0.f, 0.f, 0.f, 0.f, 0.f, 0.f};
#pragma unroll 8
    for (int cc = 0; cc < 64; ++cc) { const float p = pl[t * 65 + cc]; const f32x4 w0 = *(const LAS f32x4*)(pw + cc * 64 + c8), w1 = *(const LAS f32x4*)(pw + cc * 64 + c8 + 4);
        y[0] += p * w0.x; y[1] += p * w0.y; y[2] += p * w0.z; y[3] += p * w0.w; y[4] += p * w1.x; y[5] += p * w1.y; y[6] += p * w1.z; y[7] += p * w1.w; }
    const float* ps = a.pool_scale + l * 256 + g * 64 + c8;
    u32x4 o; o.x = pk2(y[0] * ps[0], y[1] * ps[1]); o.y = pk2(y[2] * ps[2], y[3] * ps[3]); o.z = pk2(y[4] * ps[4], y[5] * ps[5]); o.w = pk2(y[6] * ps[6], y[7] * ps[7]);
    *(u32x4*)((bf16_t*)(ws + WS_MIX) + (size_t)(b * SEQ + tpos) * D + 512 + g * 64 + c8) = o;
    __syncthreads();
}

constexpr int HP = 65;
__device__ __forceinline__ void hgrn_gates(const Args& a, Ctx& C, int l, int b, int hh, int c, LAS float* bq, LAS float* kin) {
    const int tid = C.tid, s = tid >> 3, k8 = (tid & 7) * 8;
    const float* z = (const float*)(C.ws + WS_HG) + (size_t)(b * SEQ + c * 64 + s) * 1024 + 256 + hh * 64 + k8;
    const f32x4 z0 = *(const f32x4*)z, z1 = *(const f32x4*)(z + 4); const float zz[8] = {z0.x, z0.y, z0.z, z0.w, z1.x, z1.y, z1.z, z1.w};
#pragma unroll
    for (int j = 0; j < 8; ++j) {
        const int kk = hh * 64 + k8 + j; float lb = 0.f;
        if (l == 1) lb = 1.0f / (1.0f + expf(a.lb_logits[kk] - a.lb_logits[256 + kk]));
        const float sg = 1.0f / (1.0f + expf(-zz[j])), sn = 1.0f / (1.0f + expf(zz[j]));
        bq[s * HP + k8 + j] = logf(lb + (1.0f - lb) * sg); kin[s * HP + k8 + j] = (1.0f - lb) * sn;
    }
    __syncthreads();
    if (tid < 64) { float r = 0.f; for (int ss = 0; ss < 64; ++ss) { r += bq[ss * HP + tid]; bq[ss * HP + tid] = r; } }
    __syncthreads();
}
__device__ __forceinline__ void hgrn_local_item(const Args& a, Ctx& C, int l, int item) {
    const int tid = C.tid, c = item & 63, hh = (item >> 6) & 3, b = item >> 8;
    LAS float* bq = (LAS float*)C.lds; LAS float* kin = bq + 64 * HP; LAS float* vv = kin + 64 * HP;
    hgrn_gates(a, C, l, b, hh, c, bq, kin);
    { const int s = tid >> 3, k8 = (tid & 7) * 8;
        const float* vp = (const float*)(C.ws + WS_HG) + (size_t)(b * SEQ + c * 64 + s) * 1024 + 512 + hh * 64 + k8;
        *(LAS f32x4*)(vv + s * 64 + k8) = *(const f32x4*)vp; *(LAS f32x4*)(vv + s * 64 + k8 + 4) = *(const f32x4*)(vp + 4);
#pragma unroll
        for (int j = 0; j < 8; ++j) kin[s * HP + k8 + j] *= __expf(bq[63 * HP + k8 + j] - bq[s * HP + k8 + j]); }
    __syncthreads();
    const int k = tid >> 3, v8 = (tid & 7) * 8; float Lr[8] = {0.f, 0.f, 0.f, 0.f, 0.f, 0.f, 0.f, 0.f};
#pragma unroll 8
    for (int s = 0; s < 64; ++s) { const float w = kin[s * HP + k]; const f32x4 x0 = *(const LAS f32x4*)(vv + s * 64 + v8), x1 = *(const LAS f32x4*)(vv + s * 64 + v8 + 4);
        Lr[0] += w * x0.x; Lr[1] += w * x0.y; Lr[2] += w * x0.z; Lr[3] += w * x0.w; Lr[4] += w * x1.x; Lr[5] += w * x1.y; Lr[6] += w * x1.z; Lr[7] += w * x1.w; }
    float* hl = (float*)(C.ws + WS_HL) + (size_t)item * 4096 + k * 64 + v8;
    *(f32x4*)hl = (f32x4){Lr[0], Lr[1], Lr[2], Lr[3]}; *(f32x4*)(hl + 4) = (f32x4){Lr[4], Lr[5], Lr[6], Lr[7]};
    if ((tid & 7) == 0) ((float*)(C.ws + WS_HD))[(size_t)item * 64 + k] = __expf(bq[63 * HP + k]);
    __syncthreads();
}
__device__ __forceinline__ void hgrn_out_item(const Args& a, Ctx& C, int l, int item) {
    const int tid = C.tid, c = item & 63, hh = (item >> 6) & 3, b = item >> 8;
    LAS float* bq = (LAS float*)C.lds; LAS float* kin = bq + 64 * HP; LAS float* qq = kin + 64 * HP; LAS float* At = qq + 64 * HP; LAS float* vv = At + 64 * HP; LAS float* Ss = vv + 4096;
    hgrn_gates(a, C, l, b, hh, c, bq, kin);
    { const int s = tid >> 3, k8 = (tid & 7) * 8; const float* row = (const float*)(C.ws + WS_HG) + (size_t)(b * SEQ + c * 64 + s) * 1024 + hh * 64 + k8;
        const f32x4 q0 = *(const f32x4*)row, q1 = *(const f32x4*)(row + 4);
        qq[s * HP + k8 + 0] = siluf_(q0.x); qq[s * HP + k8 + 1] = siluf_(q0.y); qq[s * HP + k8 + 2] = siluf_(q0.z); qq[s * HP + k8 + 3] = siluf_(q0.w);
        qq[s * HP + k8 + 4] = siluf_(q1.x); qq[s * HP + k8 + 5] = siluf_(q1.y); qq[s * HP + k8 + 6] = siluf_(q1.z); qq[s * HP + k8 + 7] = siluf_(q1.w);
        *(LAS f32x4*)(vv + s * 64 + k8) = *(const f32x4*)(row + 512); *(LAS f32x4*)(vv + s * 64 + k8 + 4) = *(const f32x4*)(row + 516); }
    {
        const int k = tid >> 3, v8 = (tid & 7) * 8; f32x4 s0 = (f32x4){0.f, 0.f, 0.f, 0.f}, s1 = s0;
        const float* hl = (const float*)(C.ws + WS_HL) + (size_t)(item - c) * 4096 + k * 64 + v8; const float* hd = (const float*)(C.ws + WS_HD) + (size_t)(item - c) * 64 + k;
#pragma unroll 4
        for (int j = 0; j < c; ++j) { const float dj = hd[(size_t)j * 64]; const f32x4 l0 = *(const f32x4*)(hl + (size_t)j * 4096), l1 = *(const f32x4*)(hl + (size_t)j * 4096 + 4); s0 = s0 * dj + l0; s1 = s1 * dj + l1; }
        *(LAS f32x4*)(Ss + k * 64 + v8) = s0; *(LAS f32x4*)(Ss + k * 64 + v8 + 4) = s1; }
    __syncthreads();
    { const int t = tid >> 3, sg = tid & 7; float ac[8] = {0.f, 0.f, 0.f, 0.f, 0.f, 0.f, 0.f, 0.f};
        for (int k = 0; k < 64; ++k) { const float qt = qq[t * HP + k], bt = bq[t * HP + k];
#pragma unroll
            for (int i = 0; i < 8; ++i) { const int s = sg + 8 * i; if (s <= t) ac[i] += qt * kin[s * HP + k] * __expf(bt - bq[s * HP + k]); } }
#pragma unroll
        for (int i = 0; i < 8; ++i) At[t * HP + sg + 8 * i] = ac[i]; }
    __syncthreads();
    { const int t = tid >> 3, v8 = (tid & 7) * 8; float o[8] = {0.f, 0.f, 0.f, 0.f, 0.f, 0.f, 0.f, 0.f};
#pragma unroll 4
        for (int k = 0; k < 64; ++k) { const float qe = qq[t * HP + k] * __expf(bq[t * HP + k]); const f32x4 x0 = *(const LAS f32x4*)(Ss + k * 64 + v8), x1 = *(const LAS f32x4*)(Ss + k * 64 + v8 + 4);
            o[0] += qe * x0.x; o[1] += qe * x0.y; o[2] += qe * x0.z; o[3] += qe * x0.w; o[4] += qe * x1.x; o[5] += qe * x1.y; o[6] += qe * x1.z; o[7] += qe * x1.w; }
        for (int s = 0; s <= t; ++s) { const float w = At[t * HP + s]; const f32x4 x0 = *(const LAS f32x4*)(vv + s * 64 + v8), x1 = *(const LAS f32x4*)(vv + s * 64 + v8 + 4);
            o[0] += w * x0.x; o[1] += w * x0.y; o[2] += w * x0.z; o[3] += w * x0.w; o[4] += w * x1.x; o[5] += w * x1.y; o[6] += w * x1.z; o[7] += w * x1.w; }
        float ss = 0.f;
#pragma unroll
        for (int j = 0; j < 8; ++j) ss += o[j] * o[j];
        ss += __shfl_xor(ss, 1); ss += __shfl_xor(ss, 2); ss += __shfl_xor(ss, 4);
        const float rstd = 1.0f / sqrtf(ss * (1.0f / 64.0f) + EPS);
        const float* gp = (const float*)(C.ws + WS_HG) + (size_t)(b * SEQ + c * 64 + t) * 1024 + 768 + hh * 64 + v8; const float* ng = a.hgrn_g + l * 64 + v8;
        const f32x4 g0 = *(const f32x4*)gp, g1 = *(const f32x4*)(gp + 4); const float gg[8] = {g0.x, g0.y, g0.z, g0.w, g1.x, g1.y, g1.z, g1.w}; float y[8];
#pragma unroll
        for (int j = 0; j < 8; ++j) y[j] = o[j] * rstd * ng[j] * siluf_(gg[j]);
        u32x4 w; w.x = pk2(y[0], y[1]); w.y = pk2(y[2], y[3]); w.z = pk2(y[4], y[5]); w.w = pk2(y[6], y[7]);
        *(u32x4*)((bf16_t*)(C.ws + WS_MIX) + (size_t)(b * SEQ + c * 64 + t) * D + 768 + hh * 64 + v8) = w; }
    __syncthreads();
}

__device__ __forceinline__ void phase_mix1(const Args& a, Ctx& C, int l) {
#ifndef MIX1MASK
#define MIX1MASK 7
#endif
    if (MIX1MASK & 1) for (int it = blockIdx.x; it < 1024; it += C.G) hgrn_local_item(a, C, l, it);
    if (MIX1MASK & 2) for (int it = blockIdx.x; it < 1024; it += C.G) pool_item(a, C, l, it);
    LAS float* sc = (LAS float*)(C.lds + C.wave * 17408); LAS float* qs = sc + 4096;
    const int gw = blockIdx.x * NWAVES + C.wave, NGW = C.G * NWAVES;
    if (MIX1MASK & 4) for (int p = gw; p < 2048; p += NGW)
        for (int b = 0; b < 4; ++b) { select_query(C, b * SEQ + p, sc, qs); select_query(C, b * SEQ + (SEQ - 1 - p), sc, qs); }
}
__device__ __forceinline__ void phase_mix2(const Args& a, Ctx& C, int l) {
#ifndef MIX2MASK
#define MIX2MASK 3
#endif
    if (MIX2MASK & 1) for (int it = blockIdx.x; it < 1024; it += C.G) hgrn_out_item(a, C, l, it);
    LAS float* qf = (LAS float*)(C.lds + C.wave * 11264); LAS float* P = qf + 512; LAS int* sl = (LAS int*)(P + 2048);
    const int gw = blockIdx.x * NWAVES + C.wave, NGW = C.G * NWAVES;
    if (MIX2MASK & 2) for (int tk = gw; tk < NTOK; tk += NGW) attend_query(C, tk, qf, P, sl);
}

__device__ __forceinline__ void phase_router(const Args& a, Ctx& C, int l) {
    unsigned char* ws = C.ws; const int lane = C.lane;
    LAS float* us = (LAS float*)(C.lds + C.wave * 8192);
    const float* mod = (const float*)(ws + WS_MOD); const float* H = (const float*)(ws + WS_H);
    const float* wr = a.w_router + (size_t)l * 1024 * 32; unsigned* cnt = (unsigned*)(ws + WS_CTL) + CW_CNT + l * 32 * 64;
    const int gw = blockIdx.x * NWAVES + C.wave, NGW = C.G * NWAVES;
    for (int base = gw * 2; base < NTOK; base += NGW * 2) {
#pragma unroll
        for (int hf = 0; hf < 2; ++hf) {
            const int tk = base + hf, b = tk >> 12; const f32x4* hr = (const f32x4*)(H + (size_t)tk * D) + lane; f32x4 v[4];
#pragma unroll
            for (int j = 0; j < 4; ++j) v[j] = hr[64 * j];
            float ss = 0.f;
#pragma unroll
            for (int j = 0; j < 4; ++j) ss += (v[j].x * v[j].x + v[j].y * v[j].y) + (v[j].z * v[j].z + v[j].w * v[j].w);
            const float rstd = 1.0f / sqrtf(wave_sum(ss) * (1.0f / D) + EPS);
            const float* mb = mod + (size_t)(l * 4 + b) * 6144; bf16_t* urow = (bf16_t*)(ws + WS_U) + (size_t)tk * D;
#pragma unroll
            for (int j = 0; j < 4; ++j) { const int idx = 4 * lane + 256 * j; const f32x4 gv = *(const f32x4*)(a.norm2_g + l * 1024 + idx), shv = *(const f32x4*)(mb + 3072 + idx), scv = *(const f32x4*)(mb + 4096 + idx);
                const f32x4 o = v[j] * rstd * gv * (scv + 1.0f) + shv; u32x2 w; w.x = pk2(o[0], o[1]); w.y = pk2(o[2], o[3]); *(u32x2*)(urow + idx) = w;
                *(LAS f32x4*)(us + hf * 1024 + idx) = o; }
        }
        asm volatile("s_waitcnt lgkmcnt(0)" ::: "memory"); __builtin_amdgcn_wave_barrier();
        const int e = lane & 31, hf = lane >> 5; float acc0 = 0.f, acc1 = 0.f;
        const LAS float* up = us + hf * 1024;
#pragma unroll 8
        for (int d = 0; d < 1024; d += 2) { acc0 += up[d] * wr[d * 32 + e]; acc1 += up[d + 1] * wr[(d + 1) * 32 + e]; }
        float val = acc0 + acc1 + a.b_router[l * 32 + e];
        float tv[4]; int te[4];
#pragma unroll
        for (int k = 0; k < 4; ++k) {
            float bv = val; int bi = e;
#pragma unroll
            for (int o = 1; o < 32; o <<= 1) { const float ov = __shfl_xor(bv, o); const int oi = __shfl_xor(bi, o); if (ov > bv || (ov == bv && oi < bi)) { bv = ov; bi = oi; } }
            tv[k] = bv; te[k] = bi; if (e == bi) val = -3.0e38f;
        }
        const float e1 = __expf(tv[1] - tv[0]), e2 = __expf(tv[2] - tv[0]), e3 = __expf(tv[3] - tv[0]); const float rs = 1.0f / (1.0f + e1 + e2 + e3);
        if (e < 4) {
            const int tk = base + hf; const int ex = e == 0 ? te[0] : e == 1 ? te[1] : e == 2 ? te[2] : te[3]; const float gt = (e == 0 ? 1.0f : e == 1 ? e1 : e == 2 ? e2 : e3) * rs;
            const unsigned slot = atomicAdd(cnt + ex * 64, 1u);
            ((int*)(ws + WS_ROWTOK))[(size_t)ex * NTOK + slot] = tk;
            ((int*)(ws + WS_EIDX))[tk * 4 + e] = ex; ((int*)(ws + WS_SLOT))[tk * 4 + e] = (int)slot; ((float*)(ws + WS_GATE))[tk * 4 + e] = gt;
        }
        asm volatile("s_waitcnt lgkmcnt(0)" ::: "memory"); __builtin_amdgcn_wave_barrier();
    }
}

__device__ __forceinline__ void moe_table(Ctx& C, int l, LAS int* tab) {
    if (C.tid < 32) { const unsigned* cnt = (const unsigned*)(C.ws + WS_CTL) + CW_CNT + l * 32 * 64; tab[33 + C.tid] = (int)__hip_atomic_load(cnt + C.tid * 64, __ATOMIC_RELAXED, __HIP_MEMORY_SCOPE_AGENT); }
    __syncthreads();
    if (C.tid == 0) { int p = 0; for (int e = 0; e < 32; ++e) { tab[e] = p; p += (tab[33 + e] + 255) >> 8; } tab[32] = p; }
    __syncthreads();
}

__device__ __forceinline__ void phase_combine(const Args& a, Ctx& C, int l) {
    unsigned char* ws = C.ws; const int lane = C.lane;
    const float* mod = (const float*)(ws + WS_MOD); float* H = (float*)(ws + WS_H); const bf16_t* Y = (const bf16_t*)(ws + WS_Y);
    const unsigned* cnt = (const unsigned*)(ws + WS_CTL) + CW_CNT + l * 32 * 64;
    int mt = 0; if (lane < 32) mt = ((int)__hip_atomic_load(cnt + lane * 64, __ATOMIC_RELAXED, __HIP_MEMORY_SCOPE_AGENT) + 255) >> 8;
    int incl = mt;
#pragma unroll
    for (int o = 1; o < 32; o <<= 1) { const int t = __shfl_up(incl, o); if ((lane & 31) >= o) incl += t; }
    const int excl = incl - mt;
    const int gw = blockIdx.x * NWAVES + C.wave, NGW = C.G * NWAVES;
    for (int tk = gw; tk < NTOK; tk += NGW) {
        const int b = tk >> 12; f32x4 v[4]; f32x4* hr = (f32x4*)(H + (size_t)tk * D) + lane;
#pragma unroll
        for (int j = 0; j < 4; ++j) v[j] = hr[64 * j];
        f32x4 m[4];
#pragma unroll
        for (int j = 0; j < 4; ++j) m[j] = (f32x4){0.f, 0.f, 0.f, 0.f};
#pragma unroll
        for (int k = 0; k < 4; ++k) {
            const int ex = ((const int*)(ws + WS_EIDX))[tk * 4 + k], slot = ((const int*)(ws + WS_SLOT))[tk * 4 + k]; const float gt = ((const float*)(ws + WS_GATE))[tk * 4 + k];
            const int row = 256 * __shfl(excl, ex) + slot; const u32x2* yr = (const u32x2*)(Y + (size_t)row * D) + lane;
#pragma unroll
            for (int j = 0; j < 4; ++j) { const u32x2 w = yr[64 * j]; m[j] += (f32x4){bflo(w.x), bfhi(w.x), bflo(w.y), bfhi(w.y)} * gt; }
        }
        const float* mb = mod + (size_t)(l * 4 + b) * 6144;
#pragma unroll
        for (int j = 0; j < 4; ++j) { const f32x4 g2 = *(const f32x4*)(mb + 5120 + 4 * lane + 256 * j); v[j] += g2 * m[j]; hr[64 * j] = v[j]; }
        if (l + 1 < DEPTH) { const float* mn = mod + (size_t)((l + 1) * 4 + b) * 6144; norm_mod_store(v, a.norm1_g + (l + 1) * 1024, mn + 0, mn + 1024, (bf16_t*)(ws + WS_U) + (size_t)tk * D, lane); }
        else {
            float ss = 0.f;
#pragma unroll
            for (int j = 0; j < 4; ++j) ss += (v[j].x * v[j].x + v[j].y * v[j].y) + (v[j].z * v[j].z + v[j].w * v[j].w);
            const float rstd = 1.0f / sqrtf(wave_sum(ss) * (1.0f / D) + EPS);
            f32x4* orow = (f32x4*)(a.out + (size_t)tk * D) + lane;
#pragma unroll
            for (int j = 0; j < 4; ++j) orow[64 * j] = v[j] * rstd * *(const f32x4*)(a.final_g + 4 * lane + 256 * j);
        }
    }
}

typedef const __attribute__((address_space(4))) Args* KArgsPtr;
__device__ __forceinline__ Args load_args() {
#if defined(__HIP_DEVICE_COMPILE__)
    KArgsPtr p = (KArgsPtr)__builtin_amdgcn_kernarg_segment_ptr(); asm volatile("" : "+s"(p)); Args a;
    a.x = p->x; a.c = p->c; a.pos = p->pos; a.w_ada = p->w_ada; a.b_ada = p->b_ada; a.norm1_g = p->norm1_g; a.norm2_g = p->norm2_g; a.w_in = p->w_in; a.w_out = p->w_out; a.pool_w = p->pool_w;
    a.pool_scale = p->pool_scale; a.hgrn_g = p->hgrn_g; a.lb_logits = p->lb_logits; a.w_router = p->w_router; a.b_router = p->b_router; a.w1 = p->w1; a.b1 = p->b1; a.w2 = p->w2; a.b2 = p->b2; a.final_g = p->final_g;
    a.out = p->out; a.ws = p->ws; a.ph_lo = p->ph_lo; a.ph_hi = p->ph_hi; return a;
#else
    return Args{};
#endif
}
__device__ __forceinline__ int lane_id() { return __builtin_amdgcn_mbcnt_hi(~0u, __builtin_amdgcn_mbcnt_lo(~0u, 0)); }
__device__ __forceinline__ Ctx make_ctx(unsigned char* ws, int wv) {
    extern __shared__ __attribute__((aligned(16))) unsigned char lds_raw[];
    Ctx C; C.lds = (LAS unsigned char*)lds_raw; { int l_ = lane_id(); asm volatile("" : "+v"(l_)); C.lane = l_; } C.wave = wv; C.tid = wv * 64 + C.lane;
    C.G = gridDim.x; { const int bx = blockIdx.x; C.vcu = (C.G % 8 == 0) ? (bx % 8) * (C.G / 8) + bx / 8 : bx; }
    C.ws = ws; return C;
}
#ifndef PHASE_FN
#define PHASE_FN __device__ __forceinline__ void
#endif
#define GEMM_FN __device__ __forceinline__ void
PHASE_FN ph_prep(int wv) { const Args a = load_args(); Ctx C = make_ctx(a.ws, wv); phase_prep(a, C); }
PHASE_FN ph_u0(int wv) { const Args a = load_args(); Ctx C = make_ctx(a.ws, wv); phase_u0(a, C); }
GEMM_FN ph_gin(int l, int wv) { const Args a = load_args(); Ctx C = make_ctx(a.ws, wv); unsigned char* ws = a.ws;
    DenseOrder S{(const char*)(ws + WS_U), (const char*)(ws + WS_WIN) + (size_t)l * NPAD * 1024 * 2, NTOK / 256, NPAD / 256, (NTOK / 256) * (NPAD / 256), C.G, (int)blockIdx.x};
    EpiIn E{ws}; pg8::gemm_phase<EpiIn, DenseOrder, false, true>(C.lds, (LAS unsigned*)(C.lds + LDS_PARK), C.tid, S, E); }
PHASE_FN ph_mix1(int l, int wv) { const Args a = load_args(); Ctx C = make_ctx(a.ws, wv); phase_mix1(a, C, l); }
PHASE_FN ph_mix2(int l, int wv) { const Args a = load_args(); Ctx C = make_ctx(a.ws, wv); phase_mix2(a, C, l); }
GEMM_FN ph_gout(int l, int wv) { const Args a = load_args(); Ctx C = make_ctx(a.ws, wv); unsigned char* ws = a.ws;
    DenseOrder S{(const char*)(ws + WS_MIX), (const char*)(ws + WS_WOUT) + (size_t)l * 1024 * 1024 * 2, NTOK / 256, 4, (NTOK / 256) * 4, C.G, (int)blockIdx.x};
    EpiOut E{l == 0 ? a.x : (const float*)(ws + WS_H), (float*)(ws + WS_H), (const float*)(ws + WS_MOD) + (size_t)l * 4 * 6144 + 2048};
    pg8::gemm_phase<EpiOut, DenseOrder, false, true>(C.lds, (LAS unsigned*)(C.lds + LDS_PARK), C.tid, S, E); }
PHASE_FN ph_router(int l, int wv) { const Args a = load_args(); Ctx C = make_ctx(a.ws, wv); phase_router(a, C, l); }
GEMM_FN ph_g1(int l, int wv) { const Args a = load_args(); Ctx C = make_ctx(a.ws, wv); unsigned char* ws = a.ws;
    LAS int* tab = (LAS int*)(C.lds + LDS_TAB); moe_table(C, l, tab);
    MoeOrder<true> S{tab, (const char*)(ws + WS_U), (const char*)(ws + WS_W1) + (size_t)l * 32 * 2048 * 1024 * 2, (const int*)(ws + WS_ROWTOK), C.G, C.vcu};
    EpiG1 E{(bf16_t*)(ws + WS_ACT), a.b1 + (size_t)l * 32 * 2048}; pg8::gemm_phase<EpiG1, MoeOrder<true>, true, true>(C.lds, (LAS unsigned*)(C.lds + LDS_PARK), C.tid, S, E); }
GEMM_FN ph_g2(int l, int wv) { const Args a = load_args(); Ctx C = make_ctx(a.ws, wv); unsigned char* ws = a.ws;
    LAS int* tab = (LAS int*)(C.lds + LDS_TAB); moe_table(C, l, tab);
    MoeOrder<false> S{tab, (const char*)(ws + WS_ACT), (const char*)(ws + WS_W2) + (size_t)l * 32 * 1024 * 1024 * 2, nullptr, C.G, C.vcu};
    EpiG2 E{(bf16_t*)(ws + WS_Y), a.b2 + (size_t)l * 32 * 1024}; pg8::gemm_phase<EpiG2, MoeOrder<false>, false, true>(C.lds, (LAS unsigned*)(C.lds + LDS_PARK), C.tid, S, E); }
PHASE_FN ph_combine(int l, int wv) { const Args a = load_args(); Ctx C = make_ctx(a.ws, wv); phase_combine(a, C, l); }

constexpr int NPHASES = 2 + 8 * DEPTH;
__global__ void __launch_bounds__(NTHREADS, 2) mega_fwd(Args a) {
#if MK_ONE_LAUNCH
    cg::grid_group grid = cg::this_grid();
#define SEAM() do { __syncthreads(); grid.sync(); } while (0)
#else
#define SEAM() do { } while (0)
#endif
    const int lo = a.ph_lo, hi = a.ph_hi;
    const int wv = __builtin_amdgcn_readfirstlane((int)threadIdx.x >> 6);
#ifndef KINDMASK
#define KINDMASK 0xffffu
#endif
#define KON(k) (((KINDMASK) >> (k)) & 1u)
#define RUN(kind, id, call) do { if (KON(kind) && lo <= (id) && (id) < hi) { call; if ((id) + 1 < hi) SEAM(); } } while (0)
    RUN(0, 0, ph_prep(wv));
    RUN(1, 1, ph_u0(wv));
    RUN(2, 2, ph_gin(0, wv)); RUN(3, 3, ph_mix1(0, wv)); RUN(4, 4, ph_mix2(0, wv)); RUN(5, 5, ph_gout(0, wv)); RUN(6, 6, ph_router(0, wv)); RUN(7, 7, ph_g1(0, wv)); RUN(8, 8, ph_g2(0, wv)); RUN(9, 9, ph_combine(0, wv));
    RUN(2, 10, ph_gin(1, wv)); RUN(3, 11, ph_mix1(1, wv)); RUN(4, 12, ph_mix2(1, wv)); RUN(5, 13, ph_gout(1, wv)); RUN(6, 14, ph_router(1, wv)); RUN(7, 15, ph_g1(1, wv)); RUN(8, 16, ph_g2(1, wv)); RUN(9, 17, ph_combine(1, wv));
}

extern "C" void kernel_launch(void* const* d_in, const int* in_sizes, int n_in, void* d_out, int out_size, void* d_ws, size_t ws_size, hipStream_t stream) {
    static int grid = 0;
    if (grid == 0) {
        if (n_in != 20 || out_size != NTOK * D || ws_size < WS_END) { fprintf(stderr, "kernel_launch: unexpected shapes: n_in %d out %d ws %zu (need %zu)\n", n_in, out_size, ws_size, (size_t)WS_END); grid = -1; return; }
        int dev = 0, cus = 0, per_cu = 0;
        hipGetDevice(&dev); hipDeviceGetAttribute(&cus, hipDeviceAttributeMultiprocessorCount, dev);
        if (hipFuncSetAttribute((const void*)mega_fwd, hipFuncAttributeMaxDynamicSharedMemorySize, LDS_BYTES) != hipSuccess) { fprintf(stderr, "kernel_launch: hipFuncSetAttribute failed\n"); grid = -1; return; }
        hipOccupancyMaxActiveBlocksPerMultiprocessor(&per_cu, (const void*)mega_fwd, NTHREADS, LDS_BYTES);
        (void)hipGetLastError();
        if (per_cu < 1) fprintf(stderr, "kernel_launch: occupancy query says %d blocks per CU\n", per_cu);
        grid = cus;
    }
    if (grid < 0) return;
    hipMemsetAsync((char*)d_ws + WS_CTL, 0, CTL_BYTES, stream);
    Args a{};
    a.x = (const float*)d_in[0]; a.c = (const float*)d_in[1]; a.pos = (const int*)d_in[2]; a.w_ada = (const float*)d_in[3]; a.b_ada = (const float*)d_in[4];
    a.norm1_g = (const float*)d_in[5]; a.norm2_g = (const float*)d_in[6]; a.w_in = (const float*)d_in[7]; a.w_out = (const float*)d_in[8]; a.pool_w = (const float*)d_in[9];
    a.pool_scale = (const float*)d_in[10]; a.hgrn_g = (const float*)d_in[11]; a.lb_logits = (const float*)d_in[12]; a.w_router = (const float*)d_in[13]; a.b_router = (const float*)d_in[14];
    a.w1 = (const float*)d_in[15]; a.b1 = (const float*)d_in[16]; a.w2 = (const float*)d_in[17]; a.b2 = (const float*)d_in[18]; a.final_g = (const float*)d_in[19];
    a.out = (float*)d_out; a.ws = (unsigned char*)d_ws;
#if MK_ONE_LAUNCH
    a.ph_lo = 0; a.ph_hi = NPHASES;
    void* args[] = {&a};
    hipError_t e = hipLaunchCooperativeKernel((const void*)mega_fwd, dim3(grid), dim3(NTHREADS), args, LDS_BYTES, stream);
    if (e != hipSuccess) fprintf(stderr, "cooperative launch failed: %s (grid %d)\n", hipGetErrorString(e), grid);
#else
    for (int p = 0; p < NPHASES; ++p) { a.ph_lo = p; a.ph_hi = p + 1; hipLaunchKernelGGL(mega_fwd, dim3(grid), dim3(NTHREADS), LDS_BYTES, stream, a); }
#endif
}
```

```cpp
#include <hip/hip_runtime.h>
#include <hip/hip_cooperative_groups.h>
#include <cstdio>
#include <cstdint>
namespace cg = cooperative_groups;

#ifndef MK_ONE_LAUNCH
#define MK_ONE_LAUNCH 2
#endif

#define LAS __attribute__((address_space(3)))
typedef unsigned short bf16_t;
typedef short bf16x8 __attribute__((ext_vector_type(8)));
typedef float f32x4 __attribute__((ext_vector_type(4)));
typedef float f32x2 __attribute__((ext_vector_type(2)));
typedef unsigned u32x4 __attribute__((ext_vector_type(4)));
typedef unsigned u32x2 __attribute__((ext_vector_type(2)));

constexpr int D = 1024, NBATCH = 4, SEQ = 4096, NTOK = NBATCH * SEQ, DEPTH = 2;
constexpr int D_IN = 2372, NPAD = 2560;
constexpr int NE = 32, TOPK = 4, FF = 1024;
constexpr int NWAVES = 8, NTHREADS = 512;
constexpr float EPS = 1e-6f;
constexpr int ROWCAP = 73728;

constexpr size_t MiB = 1u << 20;
constexpr size_t WS_CTL = 0, CTL_BYTES = 1 * MiB;
constexpr size_t WS_MOD = 1 * MiB;
constexpr size_t WS_ROPEC = 2 * MiB;
constexpr size_t WS_ROPES = 4 * MiB;
constexpr size_t WS_WIN = 6 * MiB;
constexpr size_t WS_WOUT = 16 * MiB;
constexpr size_t WS_ROWTOK = 20 * MiB;
constexpr size_t WS_EIDX = 22 * MiB;
constexpr size_t WS_SLOT = 22 * MiB + 256 * 1024;
constexpr size_t WS_GATE = 22 * MiB + 512 * 1024;
constexpr size_t WS_WI = 23 * MiB;
constexpr size_t WS_KI = 24 * MiB;
constexpr size_t WS_K = 26 * MiB;
constexpr size_t WS_V = 30 * MiB;
constexpr size_t WS_QI = 34 * MiB;
constexpr size_t WS_Q = 42 * MiB;
constexpr size_t WS_UB = 58 * MiB;
constexpr size_t WS_HG = 74 * MiB;
constexpr size_t WS_SEL = 138 * MiB;
constexpr size_t WS_HL = 154 * MiB;
constexpr size_t WS_HD = 170 * MiB;
constexpr size_t WS_MIX = 171 * MiB;
constexpr size_t WS_U = 203 * MiB;
constexpr size_t WS_H = 235 * MiB;
constexpr size_t WS_W1 = 299 * MiB;
constexpr size_t WS_W2 = 555 * MiB;
constexpr size_t WS_ACT = 683 * MiB;
constexpr size_t WS_Y = 827 * MiB;
constexpr size_t WS_END = 971 * MiB;
constexpr int CW_CNT = 1024;
constexpr int CW_BAR = 8192;

constexpr int LDS_BYTES = 147456;
constexpr int LDS_TAB = 131072;
constexpr int LDS_PARK = 131072 + 1024;

__device__ __forceinline__ unsigned f2bf(float f) { unsigned u = __builtin_bit_cast(unsigned, f); return (u + 0x7fffu + ((u >> 16) & 1u)) >> 16; }
__device__ __forceinline__ unsigned pk2(float lo, float hi) { return f2bf(lo) | (f2bf(hi) << 16); }
__device__ __forceinline__ float bf2f(unsigned short b) { return __builtin_bit_cast(float, ((unsigned)b) << 16); }
__device__ __forceinline__ float bflo(unsigned w) { return __builtin_bit_cast(float, w << 16); }
__device__ __forceinline__ float bfhi(unsigned w) { return __builtin_bit_cast(float, w & 0xffff0000u); }
__device__ __forceinline__ float wave_sum(float v) {
#pragma unroll
    for (int o = 1; o < 64; o <<= 1) v += __shfl_xor(v, o);
    return v;
}
__device__ __forceinline__ float wave_max(float v) {
#pragma unroll
    for (int o = 1; o < 64; o <<= 1) v = fmaxf(v, __shfl_xor(v, o));
    return v;
}
__device__ __forceinline__ float sigmoidf_(float z) { return 1.0f / (1.0f + __expf(-z)); }
__device__ __forceinline__ float siluf_(float z) { return z / (1.0f + __expf(-z)); }

namespace pg8 {
constexpr int BM = 256, BK = 64, HALF = 128, HTB = HALF * BK * 2, STAGE_BYTES = 8 * HTB;
constexpr int KD = 1024, NKT = KD / BK;
__host__ __device__ __forceinline__ int lds_byte(int r, int c) { const int st = (r >> 4) * 2 + (c >> 5), rr = r & 15, cc = c & 31, ob = rr * 64 + cc * 2; return st * 1024 + (ob ^ (((ob >> 9) & 1) << 5)); }
__host__ __device__ __forceinline__ void stage_rc(int b, int& R, int& C) { const int st = b / 1024, sb = b % 1024, swz = sb ^ (((sb >> 9) & 1) << 5); R = (st >> 1) * 16 + swz / 64; C = (st & 1) * 32 + (swz % 64) / 2; }

struct Unit { const char* A; const char* B; const int* ridx; int nvalid; int row0, pn, e, b; };

template <class Epi, class Sched, bool GATHER, bool ALIGN_EPI>
__device__ __forceinline__ void gemm_phase(LAS unsigned char* lds, LAS unsigned* park, int tid_in, const Sched& S, const Epi& E) {
    const int tid = tid_in, wid = __builtin_amdgcn_readfirstlane(tid >> 6), lane = tid & 63, wr = wid >> 2, wc = wid & 3, fr = lane & 15, fq = lane >> 4;
    constexpr int K = KD, nt = NKT;
    unsigned voffB[2], vA[2][2];
#pragma unroll
    for (int i = 0; i < 2; ++i) { int R, C; stage_rc(tid * 16 + i * 8192, R, C); voffB[i] = (unsigned)(R * K + C) * 2u; }
    constexpr size_t kstep = (size_t)(BK * 2);
    constexpr size_t hstep = (size_t)HALF * K * 2;
    const unsigned ldsw = (unsigned)wid * 1024u;
    const int aoff = lds_byte(wr * 64 + fr, fq * 8), boff = lds_byte(wc * 32 + fr, fq * 8);
#define PG8_SA(b, h) (((b) * 2 + (h)) * HTB)
#define PG8_SB(b, h) ((4 + (b) * 2 + (h)) * HTB)
#define PG8_STAGE(bufoff, gbase, voff) do { _Pragma("unroll") for (int _i = 0; _i < 2; ++_i) \
        __builtin_amdgcn_global_load_lds((const unsigned*)((const char*)(gbase) + (voff)[_i]), (LAS unsigned*)(lds + (bufoff) + ldsw + _i * 8192), 16, 0, 0); } while (0)
#define PG8_LDA(dst, b, h) do { _Pragma("unroll") for (int m = 0; m < 4; ++m) _Pragma("unroll") for (int k = 0; k < 2; ++k) dst[m][k] = *(const LAS bf16x8*)(lds + PG8_SA(b, h) + aoff + m * 2048 + k * 1024); } while (0)
#define PG8_LDB(dst, b, h) do { _Pragma("unroll") for (int n = 0; n < 2; ++n) _Pragma("unroll") for (int k = 0; k < 2; ++k) dst[n][k] = *(const LAS bf16x8*)(lds + PG8_SB(b, h) + boff + n * 2048 + k * 1024); } while (0)
#define PG8_MMA(ai, bj, At, Bt) do { __builtin_amdgcn_s_setprio(1); _Pragma("unroll") for (int m = 0; m < 4; ++m) _Pragma("unroll") for (int n = 0; n < 2; ++n) _Pragma("unroll") for (int k = 0; k < 2; ++k) \
        acc[ai][bj][m][n] = __builtin_amdgcn_mfma_f32_16x16x32_bf16(Bt[n][k], At[m][k], acc[ai][bj][m][n], 0, 0, 0); __builtin_amdgcn_s_setprio(0); } while (0)
#define PG8_WAIT_V(n) asm volatile("s_waitcnt vmcnt(" #n ")" ::: "memory")
#define PG8_WAIT_L(n) asm volatile("s_waitcnt lgkmcnt(" #n ")" ::: "memory")
#define PG8_BAR __builtin_amdgcn_s_barrier()
#define PG8_SCHED __builtin_amdgcn_sched_barrier(0)
#define PG8_OFFS(dst, u) do { _Pragma("unroll") for (int _h = 0; _h < 2; ++_h) _Pragma("unroll") for (int _i = 0; _i < 2; ++_i) { \
        int _R, _C; stage_rc(tid * 16 + _i * 8192, _R, _C); const int _rr = _h * HALF + _R; \
        if constexpr (GATHER) { const int _ix = (u).ridx[_rr < (u).nvalid ? _rr : 0]; dst[_h][_i] = (unsigned)(_ix * K + _C) * 2u; } \
        else dst[_h][_i] = (unsigned)(_rr * K + _C) * 2u; } } while (0)
    Unit cur, nxt; int ui = 0;
    if (!S.next(0, cur)) return;
    f32x4 acc[2][2][4][2];
#pragma unroll
    for (int a = 0; a < 2; ++a)
#pragma unroll
        for (int b = 0; b < 2; ++b)
#pragma unroll
            for (int m = 0; m < 4; ++m)
#pragma unroll
                for (int n = 0; n < 2; ++n) acc[a][b][m][n] = (f32x4){0.f, 0.f, 0.f, 0.f};
    bf16x8 At[4][2], B0[2][2], B1[2][2];
    PG8_OFFS(vA, cur);
    const char* cA = cur.A; const char* cB = cur.B;
    PG8_STAGE(PG8_SB(0, 0), cB, voffB); PG8_STAGE(PG8_SB(0, 1), cB + hstep, voffB); PG8_STAGE(PG8_SA(0, 0), cA, vA[0]); PG8_STAGE(PG8_SA(0, 1), cA, vA[1]);
    if (wr == 1) PG8_BAR;
    PG8_WAIT_V(2); PG8_BAR;
    PG8_STAGE(PG8_SB(1, 0), cB + kstep, voffB); PG8_STAGE(PG8_SA(1, 0), cA + kstep, vA[0]); PG8_STAGE(PG8_SB(1, 1), cB + hstep + kstep, voffB);
    PG8_WAIT_V(6); PG8_BAR;
    for (;;) {
        const bool has_next = S.next(ui + 1, nxt);
        const char* nA = has_next ? nxt.A : cA; const char* nB = has_next ? nxt.B : cB;
        if constexpr (GATHER) {
            unsigned nv[2][2];
            if (has_next) { PG8_OFFS(nv, nxt); } else {
#pragma unroll
                for (int h = 0; h < 2; ++h) { nv[h][0] = vA[h][0]; nv[h][1] = vA[h][1]; } }
            *(LAS u32x4*)(park + tid * 4) = (u32x4){nv[0][0], nv[0][1], nv[1][0], nv[1][1]};
        }
        for (int t = 0; t < nt; t += 2) {
            const bool last = (t == nt - 2);
            const char* a1 = cA + (size_t)(t + 1) * kstep;
            const char* a2 = last ? nA : cA + (size_t)(t + 2) * kstep; const char* b2 = last ? nB : cB + (size_t)(t + 2) * kstep;
            const char* a3 = a2 + kstep; const char* b3 = b2 + kstep;
            PG8_LDB(B0, 0, 0); PG8_LDB(B1, 0, 1); PG8_SCHED; PG8_LDA(At, 0, 0); PG8_STAGE(PG8_SA(1, 1), a1, vA[1]);
            if constexpr (GATHER) { if (last) { const u32x4 pv = *(const LAS u32x4*)(park + tid * 4); vA[0][0] = pv.x; vA[0][1] = pv.y; vA[1][0] = pv.z; vA[1][1] = pv.w; } }
            PG8_WAIT_V(8); PG8_WAIT_L(0); PG8_BAR; PG8_MMA(0, 0, At, B0); PG8_MMA(0, 1, At, B1); PG8_BAR; PG8_SCHED;
            PG8_LDA(At, 0, 1); PG8_STAGE(PG8_SB(0, 0), b2, voffB); PG8_STAGE(PG8_SB(0, 1), b2 + hstep, voffB); PG8_STAGE(PG8_SA(0, 0), a2, vA[0]);
            PG8_WAIT_V(8); PG8_WAIT_L(0); PG8_BAR; PG8_MMA(1, 0, At, B0); PG8_MMA(1, 1, At, B1); PG8_BAR; PG8_SCHED;
            PG8_LDB(B0, 1, 0); PG8_LDB(B1, 1, 1); PG8_SCHED; PG8_LDA(At, 1, 0); PG8_STAGE(PG8_SA(0, 1), a2, vA[1]);
            PG8_WAIT_V(8); PG8_WAIT_L(0); PG8_BAR; PG8_MMA(0, 0, At, B0); PG8_MMA(0, 1, At, B1); PG8_BAR; PG8_SCHED;
            PG8_LDA(At, 1, 1); PG8_STAGE(PG8_SB(1, 0), b3, voffB); PG8_STAGE(PG8_SB(1, 1), b3 + hstep, voffB); PG8_STAGE(PG8_SA(1, 0), a3, vA[0]);
            PG8_WAIT_V(8); PG8_WAIT_L(0); PG8_BAR; PG8_MMA(1, 0, At, B0); PG8_MMA(1, 1, At, B1); PG8_BAR; PG8_SCHED;
        }
        if constexpr (ALIGN_EPI) { if (wr == 0) PG8_BAR; }
        { int fr2 = fr, fq2 = fq; asm volatile("" : "+v"(fr2), "+v"(fq2)); E(acc, cur, wr, wc, fr2, fq2); }
        if (!has_next) break;
#pragma unroll
        for (int a = 0; a < 2; ++a)
#pragma unroll
            for (int b = 0; b < 2; ++b)
#pragma unroll
                for (int m = 0; m < 4; ++m)
#pragma unroll
                    for (int n = 0; n < 2; ++n) acc[a][b][m][n] = (f32x4){0.f, 0.f, 0.f, 0.f};
        cur = nxt; cA = nA; cB = nB; ++ui;
        if constexpr (ALIGN_EPI) { if (wr == 1) PG8_BAR; }
    }
    PG8_WAIT_V(0);
    if constexpr (!ALIGN_EPI) { if (wr == 0) PG8_BAR; }
    PG8_BAR;
#undef PG8_SA
#undef PG8_SB
#undef PG8_STAGE
#undef PG8_LDA
#undef PG8_LDB
#undef PG8_MMA
#undef PG8_WAIT_V
#undef PG8_WAIT_L
#undef PG8_BAR
#undef PG8_SCHED
#undef PG8_OFFS
}
}

struct Args {
    const float* x; const float* c; const int* pos; const float* w_ada; const float* b_ada; const float* norm1_g; const float* norm2_g;
    const float* w_in; const float* w_out; const float* pool_w; const float* pool_scale; const float* hgrn_g; const float* lb_logits;
    const float* w_router; const float* b_router; const float* w1; const float* b1; const float* w2; const float* b2; const float* final_g;
    float* out; unsigned char* ws; int ph_lo, ph_hi;
};

struct Ctx {
    LAS unsigned char* lds;
    int tid, lane, wave, G, vcu;
    unsigned char* ws;
};

struct DenseOrder {
    const char* A; const char* B; int nM, nN, nwg, G, c;
    __device__ __forceinline__ bool next(int i, pg8::Unit& u) const {
        const long L = (long)i * G + c; if (L >= nwg) return false;
        int wgid = (int)L; { const int q = nwg / 8, r = nwg % 8, xcd = wgid % 8, off = wgid / 8; wgid = (xcd < r ? xcd * (q + 1) : r * (q + 1) + (xcd - r) * q) + off; }
        const int nig = 8 * nN, gid = wgid / nig, fm = gid * 8, gsz = (nM - fm) < 8 ? (nM - fm) : 8;
        const int pm = fm + ((wgid % nig) % gsz), pn = (wgid % nig) / gsz;
        u.A = A + (size_t)pm * 256 * pg8::KD * 2; u.B = B + (size_t)pn * 256 * pg8::KD * 2; u.ridx = nullptr; u.nvalid = 256; u.row0 = pm * 256; u.pn = pn; u.e = 0; u.b = pm >> 4;
        return true;
    }
};

template <bool FIRST> struct MoeOrder {
    LAS const int* tab; const char* A; const char* B; const int* rowtok; int G, c;
    static constexpr int NTN = FIRST ? 8 : 4;
    __device__ __forceinline__ bool next(int i, pg8::Unit& u) const {
        const int P = tab[32]; const long L = (long)i * G + c; if (L >= (long)P * NTN) return false;
        const int p = (int)(L / NTN), nt = (int)(L % NTN);
        int e = 0;
#pragma unroll 1
        for (int k = 1; k < 32; ++k) e = (tab[k] <= p) ? k : e;
        const int mt = p - tab[e], cnt = tab[33 + e];
        if (FIRST) { u.A = A; u.ridx = rowtok + e * NTOK + mt * 256; u.nvalid = (cnt - mt * 256) < 256 ? (cnt - mt * 256) : 256; u.B = B + ((size_t)e * 2048 + nt * 256) * pg8::KD * 2; }
        else { u.A = A + (size_t)p * 256 * pg8::KD * 2; u.ridx = nullptr; u.nvalid = 256; u.B = B + ((size_t)e * 1024 + nt * 256) * pg8::KD * 2; }
        u.row0 = p * 256; u.pn = nt; u.e = e; u.b = 0;
        return true;
    }
};

struct EpiIn {
    unsigned char* ws;
    __device__ __forceinline__ void operator()(const f32x4 (&acc)[2][2][4][2], const pg8::Unit& u, int wr, int wc, int fr, int fq) const {
        const int pn = u.pn;
        const float* rc = (const float*)(ws + WS_ROPEC); const float* rs = (const float*)(ws + WS_ROPES);
#pragma unroll
        for (int ai = 0; ai < 2; ++ai)
#pragma unroll
            for (int m = 0; m < 4; ++m) {
                const int r = u.row0 + ai * 128 + wr * 64 + m * 16 + fr;
#pragma unroll
                for (int bj = 0; bj < 2; ++bj) {
                    const f32x4 a0 = acc[ai][bj][m][0], a1 = acc[ai][bj][m][1];
                    const int g32 = bj * 4 + wc;
                    bool rope = false; bf16_t* dst = nullptr; float scl = 1.f;
                    if (pn <= 1) { rope = true; dst = (bf16_t*)(ws + WS_Q) + (size_t)r * 512 + (pn * 4 + (g32 >> 1)) * 64; scl = 0.125f; }
                    else if (pn == 2 && bj == 0) { rope = true; dst = (bf16_t*)(ws + WS_K) + (size_t)r * 128 + (g32 >> 1) * 64; }
                    else if (pn == 3) { rope = true; dst = (bf16_t*)(ws + WS_QI) + (size_t)r * 256 + (g32 >> 1) * 64; }
                    else if (pn == 4 && bj == 0 && wc < 2) { rope = true; dst = (bf16_t*)(ws + WS_KI) + (size_t)r * 64; }
                    if (rope) {
                        const int d = 16 * (g32 & 1) + 4 * fq;
                        const f32x4 cv = *(const f32x4*)(rc + (size_t)r * 32 + d), sv = *(const f32x4*)(rs + (size_t)r * 32 + d);
                        const f32x4 o1 = (a0 * cv - a1 * sv) * scl, o2 = (a1 * cv + a0 * sv) * scl;
                        u32x2 w1v, w2v; w1v.x = pk2(o1[0], o1[1]); w1v.y = pk2(o1[2], o1[3]); w2v.x = pk2(o2[0], o2[1]); w2v.y = pk2(o2[2], o2[3]);
                        *(u32x2*)(dst + d) = w1v; *(u32x2*)(dst + 32 + d) = w2v;
                    } else if (pn == 2) {
                        bf16_t* vp = (bf16_t*)(ws + WS_V) + (size_t)r * 128 + wc * 32 + 4 * fq;
                        u32x2 w0v, w1v; w0v.x = pk2(a0[0], a0[1]); w0v.y = pk2(a0[2], a0[3]); w1v.x = pk2(a1[0], a1[1]); w1v.y = pk2(a1[2], a1[3]);
                        *(u32x2*)(vp) = w0v; *(u32x2*)(vp + 16) = w1v;
                    } else if (pn == 4) {
                        if (bj == 0 && wc == 2 && fq == 0) *(f32x4*)((float*)(ws + WS_WI) + (size_t)r * 4) = a0 * 0.0625f;
                    } else if (pn == 5) {
                        float* p = (float*)(ws + WS_UB) + (size_t)r * 256 + bj * 128 + wc * 32 + 4 * fq;
                        *(f32x4*)p = a0; *(f32x4*)(p + 16) = a1;
                    } else if (pn >= 6) {
                        float* p = (float*)(ws + WS_HG) + (size_t)r * 1024 + (pn - 6) * 256 + bj * 128 + wc * 32 + 4 * fq;
                        *(f32x4*)p = a0; *(f32x4*)(p + 16) = a1;
                    }
                }
            }
    }
};
struct EpiOut {
    const float* hin; float* hout; const float* gate;
    __device__ __forceinline__ void operator()(const f32x4 (&acc)[2][2][4][2], const pg8::Unit& u, int wr, int wc, int fr, int fq) const {
        const int col0 = u.pn * 256 + wc * 32 + 4 * fq; const float* gp = gate + (size_t)u.b * 6144 + col0;
        f32x4 gv[2][2];
#pragma unroll
        for (int bj = 0; bj < 2; ++bj)
#pragma unroll
            for (int n = 0; n < 2; ++n) gv[bj][n] = *(const f32x4*)(gp + bj * 128 + n * 16);
#pragma unroll
        for (int ai = 0; ai < 2; ++ai)
#pragma unroll
            for (int m = 0; m < 4; ++m) { const size_t off = (size_t)(u.row0 + ai * 128 + wr * 64 + m * 16 + fr) * D + col0;
#pragma unroll
                for (int bj = 0; bj < 2; ++bj)
#pragma unroll
                    for (int n = 0; n < 2; ++n) { const f32x4 hv = *(const f32x4*)(hin + off + bj * 128 + n * 16); *(f32x4*)(hout + off + bj * 128 + n * 16) = hv + gv[bj][n] * acc[ai][bj][m][n]; }
                asm volatile("" ::: "memory"); }
    }
};
struct EpiG1 {
    bf16_t* act; const float* b1l;
    __device__ __forceinline__ void operator()(const f32x4 (&acc)[2][2][4][2], const pg8::Unit& u, int wr, int wc, int fr, int fq) const {
        f32x4 bg[2], bl[2];
#pragma unroll
        for (int bj = 0; bj < 2; ++bj) { const int ja = u.pn * 128 + (bj * 4 + wc) * 16 + 4 * fq; const float* bp = b1l + (size_t)u.e * 2048 + 2 * ja;
            const f32x4 t0 = *(const f32x4*)bp, t1 = *(const f32x4*)(bp + 4); bg[bj] = (f32x4){t0[0], t0[2], t1[0], t1[2]}; bl[bj] = (f32x4){t0[1], t0[3], t1[1], t1[3]}; }
#pragma unroll
        for (int ai = 0; ai < 2; ++ai)
#pragma unroll
            for (int m = 0; m < 4; ++m) { bf16_t* rowp = act + (size_t)(u.row0 + ai * 128 + wr * 64 + m * 16 + fr) * FF + u.pn * 128 + wc * 16 + 4 * fq;
#pragma unroll
                for (int bj = 0; bj < 2; ++bj) { const f32x4 hg = acc[ai][bj][m][0] + bg[bj], hl = acc[ai][bj][m][1] + bl[bj]; float o[4];
#pragma unroll
                    for (int j = 0; j < 4; ++j) { const float xg = fminf(hg[j], 7.0f), xl = fminf(fmaxf(hl[j], -7.0f), 7.0f); o[j] = xg * sigmoidf_(1.702f * xg) * (xl + 1.0f); }
                    u32x2 w; w.x = pk2(o[0], o[1]); w.y = pk2(o[2], o[3]); *(u32x2*)(rowp + bj * 64) = w; } }
    }
};
struct EpiG2 {
    bf16_t* y; const float* b2l;
    __device__ __forceinline__ void operator()(const f32x4 (&acc)[2][2][4][2], const pg8::Unit& u, int wr, int wc, int fr, int fq) const {
        const int col0 = u.pn * 256 + wc * 32 + 4 * fq; const float* bp = b2l + (size_t)u.e * 1024 + col0;
        f32x4 bv[2][2];
#pragma unroll
        for (int bj = 0; bj < 2; ++bj)
#pragma unroll
            for (int n = 0; n < 2; ++n) bv[bj][n] = *(const f32x4*)(bp + bj * 128 + n * 16);
#pragma unroll
        for (int ai = 0; ai < 2; ++ai)
#pragma unroll
            for (int m = 0; m < 4; ++m) { bf16_t* rowp = y + (size_t)(u.row0 + ai * 128 + wr * 64 + m * 16 + fr) * D + col0;
#pragma unroll
                for (int bj = 0; bj < 2; ++bj)
#pragma unroll
                    for (int n = 0; n < 2; ++n) { const f32x4 v = acc[ai][bj][m][n] + bv[bj][n]; u32x2 w; w.x = pk2(v[0], v[1]); w.y = pk2(v[2], v[3]); *(u32x2*)(rowp + bj * 128 + n * 16) = w; } }
    }
};

__device__ __forceinline__ int win_dest(int s) {
    int base, loc, heads_rope;
    if (s < 512) { base = 0; loc = s; heads_rope = 1; }
    else if (s < 640) { base = 512; loc = s - 512; heads_rope = 1; }
    else if (s < 768) { return 640 + (s - 640); }
    else if (s < 1024) { base = 768; loc = s - 768; heads_rope = 1; }
    else if (s < 1088) { base = 1024; loc = s - 1024; heads_rope = 1; }
    else if (s < 1092) { return 1088 + (s - 1088); }
    else if (s < 1348) { return 1280 + (s - 1092); }
    else { return 1536 + (s - 1348); }
    (void)heads_rope;
    const int hd = loc >> 6, d = loc & 63, x2 = d >> 5, dd = d & 31, half = dd >> 4, q15 = dd & 15;
    return base + hd * 64 + 32 * half + 16 * x2 + q15;
}
__device__ __forceinline__ int w1_dest(int s) { const int ja = s >> 1, n = s & 1, nt = ja >> 7, jj = ja & 127, g32 = jj >> 4, r = jj & 15; return 256 * nt + 32 * g32 + 16 * n + r; }

template <int MAP>
__device__ __forceinline__ void transpose_item(const float* W, int N, bf16_t* WT, LAS float* scr, int kb, int nb, int lane) {
    const int k0 = 64 * kb, n0 = 32 * nb, col = n0 + (lane & 31); const bool ok = col < N;
    float v[32];
    const float* src = W + (size_t)(k0 + (lane >> 5)) * N + (ok ? col : 0);
#pragma unroll
    for (int i = 0; i < 32; ++i) v[i] = src[(size_t)(2 * i) * N];
#pragma unroll
    for (int i = 0; i < 32; ++i) scr[(2 * i + (lane >> 5)) * 33 + (lane & 31)] = ok ? v[i] : 0.f;
    asm volatile("s_waitcnt lgkmcnt(0)" ::: "memory");
    const int c = lane & 7;
#pragma unroll
    for (int j = 0; j < 4; ++j) { const int n = (lane >> 3) + 8 * j; const LAS float* s = scr + (8 * c) * 33 + n;
        u32x4 o; o.x = pk2(s[0 * 33], s[1 * 33]); o.y = pk2(s[2 * 33], s[3 * 33]); o.z = pk2(s[4 * 33], s[5 * 33]); o.w = pk2(s[6 * 33], s[7 * 33]);
        const int sc = n0 + n;
        if (sc < N) { const int dest = MAP == 1 ? win_dest(sc) : (MAP == 2 ? w1_dest(sc) : sc); *(u32x4*)(WT + (size_t)dest * 1024 + k0 + 8 * c) = o; } }
    asm volatile("s_waitcnt lgkmcnt(0)" ::: "memory");
}

__device__ __forceinline__ void phase_prep(const Args& a, Ctx& C) {
    unsigned char* ws = C.ws;
    {
        LAS float* ca = (LAS float*)C.lds;
        LAS float* red = ca + 4096;
        for (int i = C.tid; i < 4096; i += NTHREADS) { const float v = a.c[i]; ca[i] = siluf_(v); }
        __syncthreads();
        for (int it = blockIdx.x; it < 192; it += C.G) {
            const int l = it / 96, cb = it % 96, col = cb * 64 + (C.tid & 63), kg = C.tid >> 6;
            const float* w = a.w_ada + (size_t)l * 1024 * 6144 + col;
            float s0 = 0.f, s1 = 0.f, s2 = 0.f, s3 = 0.f;
#pragma unroll 8
            for (int k = kg * 128; k < kg * 128 + 128; ++k) { const float wv = w[(size_t)k * 6144]; s0 += ca[k] * wv; s1 += ca[1024 + k] * wv; s2 += ca[2048 + k] * wv; s3 += ca[3072 + k] * wv; }
            red[(kg * 4 + 0) * 64 + (C.tid & 63)] = s0; red[(kg * 4 + 1) * 64 + (C.tid & 63)] = s1; red[(kg * 4 + 2) * 64 + (C.tid & 63)] = s2; red[(kg * 4 + 3) * 64 + (C.tid & 63)] = s3;
            __syncthreads();
            if (C.tid < 256) { const int b = C.tid >> 6, cc = C.tid & 63; float s = 0.f;
#pragma unroll
                for (int g = 0; g < 8; ++g) s += red[(g * 4 + b) * 64 + cc];
                ((float*)(ws + WS_MOD))[(size_t)(l * 4 + b) * 6144 + cb * 64 + cc] = s + a.b_ada[l * 6144 + cb * 64 + cc]; }
            __syncthreads();
        }
    }
    const int gw = C.vcu * NWAVES + C.wave, NGW = C.G * NWAVES;
    for (int tk = gw; tk < NTOK; tk += NGW) {
        if (C.lane < 32) {
            const float posf = (float)a.pos[tk];
            const float inv = exp2f(-(float)C.lane * (13.287712379549449f / 32.0f));
            const double ang = (double)(posf * inv);
            const double kq = rint(ang * 0.63661977236758134308);
            const double y = fma(-kq, 1.57079632679489661923, ang);
            const double y2 = y * y;
            const double sy = y * (1.0 + y2 * (-1.0 / 6 + y2 * (1.0 / 120 + y2 * (-1.0 / 5040 + y2 * (1.0 / 362880 - y2 * (1.0 / 39916800))))));
            const double cy = 1.0 + y2 * (-0.5 + y2 * (1.0 / 24 + y2 * (-1.0 / 720 + y2 * (1.0 / 40320 + y2 * (-1.0 / 3628800 + y2 * (1.0 / 479001600))))));
            const int q = ((int)((long long)kq)) & 3;
            const double sn = (q == 0) ? sy : (q == 1) ? cy : (q == 2) ? -sy : -cy;
            const double cs = (q == 0) ? cy : (q == 1) ? -sy : (q == 2) ? -cy : sy;
            ((float*)(ws + WS_ROPEC))[(size_t)tk * 32 + C.lane] = (float)cs;
            ((float*)(ws + WS_ROPES))[(size_t)tk * 32 + C.lane] = (float)sn;
        }
    }
    LAS float* scr = (LAS float*)(C.lds + C.wave * 16384);
    constexpr int I_IN = 2 * 16 * 75, I_OUT = 2 * 16 * 32, I_W1 = 64 * 16 * 64, I_W2 = 64 * 16 * 32;
    for (int it = gw; it < I_IN + I_OUT + I_W1 + I_W2; it += NGW) {
        int r = it;
        if (r < I_IN) { const int l = r / (16 * 75), q = r % (16 * 75); transpose_item<1>(a.w_in + (size_t)l * 1024 * D_IN, D_IN, (bf16_t*)(ws + WS_WIN) + (size_t)l * NPAD * 1024, scr, q / 75, q % 75, C.lane); continue; }
        r -= I_IN;
        if (r < I_OUT) { const int l = r / (16 * 32), q = r % (16 * 32); transpose_item<0>(a.w_out + (size_t)l * 1024 * 1024, 1024, (bf16_t*)(ws + WS_WOUT) + (size_t)l * 1024 * 1024, scr, q / 32, q % 32, C.lane); continue; }
        r -= I_OUT;
        if (r < I_W1) { const int le = r / (16 * 64), q = r % (16 * 64); transpose_item<2>(a.w1 + (size_t)le * 1024 * 2048, 2048, (bf16_t*)(ws + WS_W1) + (size_t)le * 2048 * 1024, scr, q / 64, q % 64, C.lane); continue; }
        r -= I_W1;
        { const int le = r / (16 * 32), q = r % (16 * 32); transpose_item<0>(a.w2 + (size_t)le * 1024 * 1024, 1024, (bf16_t*)(ws + WS_W2) + (size_t)le * 1024 * 1024, scr, q / 32, q % 32, C.lane); }
    }
}

__device__ __forceinline__ void norm_mod_store(const f32x4 (&v)[4], const float* g, const float* sh, const float* sc, bf16_t* urow, int lane) {
    float ss = 0.f;
#pragma unroll
    for (int j = 0; j < 4; ++j) ss += (v[j].x * v[j].x + v[j].y * v[j].y) + (v[j].z * v[j].z + v[j].w * v[j].w);
    const float rstd = 1.0f / sqrtf(wave_sum(ss) * (1.0f / D) + EPS);
#pragma unroll
    for (int j = 0; j < 4; ++j) { const int idx = 4 * lane + 256 * j; const f32x4 gv = *(const f32x4*)(g + idx), shv = *(const f32x4*)(sh + idx), scv = *(const f32x4*)(sc + idx);
        const f32x4 o = v[j] * rstd * gv * (scv + 1.0f) + shv; u32x2 w; w.x = pk2(o[0], o[1]); w.y = pk2(o[2], o[3]); *(u32x2*)(urow + idx) = w; }
}

__device__ __forceinline__ void phase_u0(const Args& a, Ctx& C) {
    const int gw = C.vcu * NWAVES + C.wave, NGW = C.G * NWAVES; const float* mod = (const float*)(C.ws + WS_MOD);
    for (int tk = gw; tk < NTOK; tk += NGW) {
        const int b = tk >> 12; const f32x4* xr = (const f32x4*)(a.x + (size_t)tk * D) + C.lane; f32x4 v[4];
#pragma unroll
        for (int j = 0; j < 4; ++j) v[j] = xr[64 * j];
        const float* mb = mod + (size_t)(0 * 4 + b) * 6144;
        norm_mod_store(v, a.norm1_g, mb + 0, mb + 1024, (bf16_t*)(C.ws + WS_U) + (size_t)tk * D, C.lane);
    }
}

__device__ __forceinline__ unsigned sortable(float f) { const unsigned u = __builtin_bit_cast(unsigned, f); return (u & 0x80000000u) ? ~u : (u | 0x80000000u); }
__device__ __forceinline__ int mbcnt64(unsigned long long m) { return __builtin_amdgcn_mbcnt_hi((unsigned)(m >> 32), __builtin_amdgcn_mbcnt_lo((unsigned)m, 0)); }

__device__ __forceinline__ void select_query(Ctx& C, int tk, LAS float* sc, LAS float* qs) {
    unsigned char* ws = C.ws; const int lane = C.lane;
    const int tpos = tk & (SEQ - 1), b = tk >> 12, cch = tpos >> 6, L = 64 * (cch + 1), nj = cch + 1;
    int* sel = (int*)(ws + WS_SEL) + (size_t)tk * 256;
    if (L <= 256) { for (int i = lane; i < L; i += 64) sel[i] = i; return; }
    {
        const u32x2 w = *(const u32x2*)((const bf16_t*)(ws + WS_QI) + (size_t)tk * 256 + 4 * lane);
        *(LAS f32x4*)(qs + 4 * lane) = (f32x4){bflo(w.x), bfhi(w.x), bflo(w.y), bfhi(w.y)};
    }
    const f32x4 wi = *(const f32x4*)((const float*)(ws + WS_WI) + (size_t)tk * 4);
    asm volatile("s_waitcnt lgkmcnt(0)" ::: "memory"); __builtin_amdgcn_wave_barrier();
    const bf16_t* kib = (const bf16_t*)(ws + WS_KI) + (size_t)b * SEQ * 64;
#pragma unroll 1
    for (int j0 = 0; j0 < 64; ++j0) {
        asm volatile("" ::: "memory");
        const int sA = 64 * j0 + lane;
        if (j0 >= nj) { sc[sA] = -3.0e38f; continue; }
        u32x4 ka[8];
#pragma unroll
        for (int i = 0; i < 8; ++i) ka[i] = *(const u32x4*)(kib + (size_t)sA * 64 + 8 * i);
        float aA[4] = {0.f, 0.f, 0.f, 0.f};
#pragma unroll
        for (int i = 0; i < 8; ++i) {
            const float a0 = bflo(ka[i].x), a1 = bfhi(ka[i].x), a2 = bflo(ka[i].y), a3 = bfhi(ka[i].y), a4 = bflo(ka[i].z), a5 = bfhi(ka[i].z), a6 = bflo(ka[i].w), a7 = bfhi(ka[i].w);
#pragma unroll
            for (int h = 0; h < 4; ++h) {
                const f32x4 q0 = *(const LAS f32x4*)(qs + h * 64 + 8 * i), q1 = *(const LAS f32x4*)(qs + h * 64 + 8 * i + 4);
                aA[h] += q0.x * a0 + q0.y * a1 + q0.z * a2 + q0.w * a3 + q1.x * a4 + q1.y * a5 + q1.z * a6 + q1.w * a7;
            }
        }
        float scA = fmaxf(aA[0], 0.f) * wi[0] + fmaxf(aA[1], 0.f) * wi[1] + fmaxf(aA[2], 0.f) * wi[2] + fmaxf(aA[3], 0.f) * wi[3];
        scA = (scA == 0.f) ? 0.f : scA;
        sc[sA] = scA;
    }
    asm volatile("s_waitcnt lgkmcnt(0)" ::: "memory"); __builtin_amdgcn_wave_barrier();
    unsigned key[64];
#pragma unroll
    for (int j = 0; j < 64; ++j) key[j] = sortable(sc[64 * j + lane]);
    unsigned T = 0u;
#pragma unroll 1
    for (int bit = 31; bit >= 0; --bit) {
        const unsigned cand = T | (1u << bit); int c = 0;
#pragma unroll
        for (int j = 0; j < 64; ++j) c += (key[j] >= cand) ? 1 : 0;
#pragma unroll
        for (int o = 1; o < 64; o <<= 1) c += __shfl_xor(c, o);
        if (c >= 256) T = cand;
    }
    int cgt = 0;
#pragma unroll
    for (int j = 0; j < 64; ++j) cgt += (key[j] > T) ? 1 : 0;
#pragma unroll
    for (int o = 1; o < 64; o <<= 1) cgt += __shfl_xor(cgt, o);
    const int need = 256 - cgt; int base = 0, eqseen = 0;
#pragma unroll 1
    for (int j = 0; j < nj; ++j) {
        const unsigned kj = sortable(sc[64 * j + lane]);
        const bool gt = kj > T, eq = kj == T; const unsigned long long em = __ballot(eq);
        const bool take = gt || (eq && (eqseen + mbcnt64(em)) < need); const unsigned long long tm = __ballot(take);
        if (take) sel[base + mbcnt64(tm)] = 64 * j + lane;
        base += __popcll(tm); eqseen += __popcll(em);
    }
}

__device__ __forceinline__ void attend_query(Ctx& C, int tk, LAS float* qf, LAS float* P, LAS int* sl) {
    unsigned char* ws = C.ws; const int lane = C.lane;
    const int tpos = tk & (SEQ - 1), b = tk >> 12, L = 64 * ((tpos >> 6) + 1), nsel = L < 256 ? L : 256;
    {
        const u32x4 w = *(const u32x4*)((const bf16_t*)(ws + WS_Q) + (size_t)tk * 512 + 8 * lane);
        *(LAS f32x4*)(qf + 8 * lane) = (f32x4){bflo(w.x), bfhi(w.x), bflo(w.y), bfhi(w.y)}; *(LAS f32x4*)(qf + 8 * lane + 4) = (f32x4){bflo(w.z), bfhi(w.z), bflo(w.w), bfhi(w.w)};
        const int* sg = (const int*)(ws + WS_SEL) + (size_t)tk * 256;
#pragma unroll
        for (int i = 0; i < 4; ++i) sl[64 * i + lane] = (64 * i + lane) < nsel ? sg[64 * i + lane] : 0;
    }
    asm volatile("s_waitcnt lgkmcnt(0)" ::: "memory"); __builtin_amdgcn_wave_barrier();
    const bf16_t* kb = (const bf16_t*)(ws + WS_K) + (size_t)b * SEQ * 128; const bf16_t* vb = (const bf16_t*)(ws + WS_V) + (size_t)b * SEQ * 128;
#pragma unroll 1
    for (int i = 0; i < 4; ++i) {
        const int slot = 64 * i + lane; const bool valid = slot < nsel; const int key = sl[slot];
#pragma unroll 1
        for (int n = 0; n < 2; ++n) {
            asm volatile("" ::: "memory");
            float ac[4] = {0.f, 0.f, 0.f, 0.f};
#pragma unroll 1
            for (int c2 = 0; c2 < 4; ++c2) {
                asm volatile("" ::: "memory");
                u32x4 kr[2];
#pragma unroll
                for (int c = 0; c < 2; ++c) kr[c] = *(const u32x4*)(kb + (size_t)key * 128 + n * 64 + 8 * (2 * c2 + c));
#pragma unroll
                for (int c = 0; c < 2; ++c) {
                    const float a0 = bflo(kr[c].x), a1 = bfhi(kr[c].x), a2 = bflo(kr[c].y), a3 = bfhi(kr[c].y), a4 = bflo(kr[c].z), a5 = bfhi(kr[c].z), a6 = bflo(kr[c].w), a7 = bfhi(kr[c].w);
#pragma unroll
                    for (int h = 0; h < 4; ++h) {
                        const f32x4 q0 = *(const LAS f32x4*)(qf + (4 * n + h) * 64 + 8 * (2 * c2 + c)), q1 = *(const LAS f32x4*)(qf + (4 * n + h) * 64 + 8 * (2 * c2 + c) + 4);
                        ac[h] += q0.x * a0 + q0.y * a1 + q0.z * a2 + q0.w * a3 + q1.x * a4 + q1.y * a5 + q1.z * a6 + q1.w * a7;
                    }
                }
            }
            *(LAS f32x4*)(P + slot * 8 + 4 * n) = valid ? (f32x4){ac[0], ac[1], ac[2], ac[3]} : (f32x4){-1e30f, -1e30f, -1e30f, -1e30f};
        }
    }
    asm volatile("s_waitcnt lgkmcnt(0)" ::: "memory"); __builtin_amdgcn_wave_barrier();
    float lg[4][8];
#pragma unroll
    for (int i = 0; i < 4; ++i) { const f32x4 t0 = *(const LAS f32x4*)(P + (64 * i + lane) * 8), t1 = *(const LAS f32x4*)(P + (64 * i + lane) * 8 + 4);
        lg[i][0] = t0.x; lg[i][1] = t0.y; lg[i][2] = t0.z; lg[i][3] = t0.w; lg[i][4] = t1.x; lg[i][5] = t1.y; lg[i][6] = t1.z; lg[i][7] = t1.w; }
    float inv[8];
#pragma unroll
    for (int h = 0; h < 8; ++h) {
        const float m = wave_max(fmaxf(fmaxf(lg[0][h], lg[1][h]), fmaxf(lg[2][h], lg[3][h]))); float s = 0.f;
#pragma unroll
        for (int i = 0; i < 4; ++i) { const float p = (64 * i + lane) < nsel ? __expf(lg[i][h] - m) : 0.f; lg[i][h] = p; s += p; }
        inv[h] = 1.0f / wave_sum(s);
    }
#pragma unroll
    for (int i = 0; i < 4; ++i) { LAS float* pp = P + (64 * i + lane) * 8;
        *(LAS f32x4*)pp = (f32x4){lg[i][0], lg[i][1], lg[i][2], lg[i][3]}; *(LAS f32x4*)(pp + 4) = (f32x4){lg[i][4], lg[i][5], lg[i][6], lg[i][7]}; }
    asm volatile("s_waitcnt lgkmcnt(0)" ::: "memory"); __builtin_amdgcn_wave_barrier();
    float o[8] = {0.f, 0.f, 0.f, 0.f, 0.f, 0.f, 0.f, 0.f};
#pragma unroll 4
    for (int slot = 0; slot < nsel; ++slot) {
        const int key = sl[slot];
        const float v0 = bf2f(vb[(size_t)key * 128 + lane]), v1 = bf2f(vb[(size_t)key * 128 + 64 + lane]);
        const f32x4 p0 = *(const LAS f32x4*)(P + slot * 8), p1 = *(const LAS f32x4*)(P + slot * 8 + 4);
        o[0] += p0.x * v0; o[1] += p0.y * v0; o[2] += p0.z * v0; o[3] += p0.w * v0; o[4] += p1.x * v1; o[5] += p1.y * v1; o[6] += p1.z * v1; o[7] += p1.w * v1;
    }
    bf16_t* mo = (bf16_t*)(ws + WS_MIX) + (size_t)tk * D;
#pragma unroll
    for (int h = 0; h < 8; ++h) mo[h * 64 + lane] = (bf16_t)f2bf(o[h] * inv[h]);
    asm volatile("s_waitcnt lgkmcnt(0)" ::: "memory"); __builtin_amdgcn_wave_barrier();
}

__device__ __forceinline__ void pool_item(const Args& a, Ctx& C, int l, int item) {
    unsigned char* ws = C.ws; const int tid = C.tid;
    const int g = item & 3, tt = item >> 2, b = tt >> 6, tp0 = (tt & 63) * 64, w = 2 << g;
    LAS float* ub = (LAS float*)C.lds;
    LAS float* pw = ub + 79 * 64;
    LAS float* pl = pw + 64 * 64;
    const float* ubg = (const float*)(ws + WS_UB);
    for (int idx = tid; idx < 79 * 16; idx += NTHREADS) { const int row = idx >> 4, c4 = idx & 15, tp = tp0 - 15 + row;
        f32x4 v = (f32x4){0.f, 0.f, 0.f, 0.f}; if (tp >= 0) v = *(const f32x4*)(ubg + (size_t)(b * SEQ + tp) * 256 + g * 64 + 4 * c4);
        *(LAS f32x4*)(ub + row * 64 + 4 * c4) = v; }
    for (int idx = tid; idx < 1024; idx += NTHREADS) *(LAS f32x4*)(pw + 4 * idx) = *(const f32x4*)(a.pool_w + (size_t)(l * 4 + g) * 4096 + 4 * idx);
    __syncthreads();
    const int t = tid >> 3, c8 = (tid & 7) * 8, tpos = tp0 + t, wl = (tpos + 1) < w ? (tpos + 1) : w;
    {
        float s[8] = {0.f, 0.f, 0.f, 0.f, 0.f, 0.f, 0.f, 0.f};
        for (int i = 0; i < wl; ++i) {
#pragma unroll
            for (int j = 0; j < 8; ++j) s[j] += ub[(t + 15 - i) * 64 + c8 + j]; }
        const float rw = 1.0f / (float)wl;
#pragma unroll
        for (int j = 0; j < 8; ++j) pl[t * 65 + c8 + j] = s[j] * rw - ub[(t + 15) * 64 + c8 + j];
    }
    __syncthreads();
    float y[8] = {0.f, 0.f, 0.f, 0.f, 0.f, 0.f, 0.f, 0.f};
#pragma unroll 8
    for (int cc = 0; cc < 64; ++cc) { const float p = pl[t * 65 + cc]; const f32x4 w0 = *(const LAS f32x4*)(pw + cc * 64 + c8), w1 = *(const LAS f32x4*)(pw + cc * 64 + c8 + 4);
        y[0] += p * w0.x; y[1] += p * w0.y; y[2] += p * w0.z; y[3] += p * w0.w; y[4] += p * w1.x; y[5] += p * w1.y; y[6] += p * w1.z; y[7] += p * w1.w; }
    const float* ps = a.pool_scale + l * 256 + g * 64 + c8;
    u32x4 o; o.x = pk2(y[0] * ps[0], y[1] * ps[1]); o.y = pk2(y[2] * ps[2], y[3] * ps[3]); o.z = pk2(y[4] * ps[4], y[5] * ps[5]); o.w = pk2(y[6] * ps[6], y[7] * ps[7]);
    *(u32x4*)((bf16_t*)(ws + WS_MIX) + (size_t)(b * SEQ + tpos) * D + 512 + g * 64 + c8) = o;
    __syncthreads();
}

constexpr int HP = 65;
__device__ __forceinline__ void hgrn_gates(const Args& a, Ctx& C, int l, int b, int hh, int c, LAS float* bq, LAS float* kin) {
    const int tid = C.tid, s = tid >> 3, k8 = (tid & 7) * 8;
    const float* z = (const float*)(C.ws + WS_HG) + (size_t)(b * SEQ + c * 64 + s) * 1024 + 256 + hh * 64 + k8;
    const f32x4 z0 = *(const f32x4*)z, z1 = *(const f32x4*)(z + 4); const float zz[8] = {z0.x, z0.y, z0.z, z0.w, z1.x, z1.y, z1.z, z1.w};
#pragma unroll
    for (int j = 0; j < 8; ++j) {
        const int kk = hh * 64 + k8 + j; float lb = 0.f;
        if (l == 1) lb = 1.0f / (1.0f + expf(a.lb_logits[kk] - a.lb_logits[256 + kk]));
        const float sg = 1.0f / (1.0f + expf(-zz[j])), sn = 1.0f / (1.0f + expf(zz[j]));
        bq[s * HP + k8 + j] = logf(lb + (1.0f - lb) * sg); kin[s * HP + k8 + j] = (1.0f - lb) * sn;
    }
    __syncthreads();
    if (tid < 64) { float r = 0.f; for (int ss = 0; ss < 64; ++ss) { r += bq[ss * HP + tid]; bq[ss * HP + tid] = r; } }
    __syncthreads();
}
__device__ __forceinline__ void hgrn_local_item(const Args& a, Ctx& C, int l, int item) {
    const int tid = C.tid, c = item & 63, hh = (item >> 6) & 3, b = item >> 8;
    LAS float* bq = (LAS float*)C.lds; LAS float* kin = bq + 64 * HP; LAS float* vv = kin + 64 * HP;
    hgrn_gates(a, C, l, b, hh, c, bq, kin);
    { const int s = tid >> 3, k8 = (tid & 7) * 8;
        const float* vp = (const float*)(C.ws + WS_HG) + (size_t)(b * SEQ + c * 64 + s) * 1024 + 512 + hh * 64 + k8;
        *(LAS f32x4*)(vv + s * 64 + k8) = *(const f32x4*)vp; *(LAS f32x4*)(vv + s * 64 + k8 + 4) = *(const f32x4*)(vp + 4);
#pragma unroll
        for (int j = 0; j < 8; ++j) kin[s * HP + k8 + j] *= __expf(bq[63 * HP + k8 + j] - bq[s * HP + k8 + j]); }
    __syncthreads();
    const int k = tid >> 3, v8 = (tid & 7) * 8; float Lr[8] = {0.f, 0.f, 0.f, 0.f, 0.f, 0.f, 0.f, 0.f};
#pragma unroll 8
    for (int s = 0; s < 64; ++s) { const float w = kin[s * HP + k]; const f32x4 x0 = *(const LAS f32x4*)(vv + s * 64 + v8), x1 = *(const LAS f32x4*)(vv + s * 64 + v8 + 4);
        Lr[0] += w * x0.x; Lr[1] += w * x0.y; Lr[2] += w * x0.z; Lr[3] += w * x0.w; Lr[4] += w * x1.x; Lr[5] += w * x1.y; Lr[6] += w * x1.z; Lr[7] += w * x1.w; }
    float* hl = (float*)(C.ws + WS_HL) + (size_t)item * 4096 + k * 64 + v8;
    *(f32x4*)hl = (f32x4){Lr[0], Lr[1], Lr[2], Lr[3]}; *(f32x4*)(hl + 4) = (f32x4){Lr[4], Lr[5], Lr[6], Lr[7]};
    if ((tid & 7) == 0) ((float*)(C.ws + WS_HD))[(size_t)item * 64 + k] = __expf(bq[63 * HP + k]);
    __syncthreads();
}
__device__ __forceinline__ void hgrn_out_item(const Args& a, Ctx& C, int l, int item) {
    const int tid = C.tid, c = item & 63, hh = (item >> 6) & 3, b = item >> 8;
    LAS float* bq = (LAS float*)C.lds; LAS float* kin = bq + 64 * HP; LAS float* qq = kin + 64 * HP; LAS float* At = qq + 64 * HP; LAS float* vv = At + 64 * HP; LAS float* Ss = vv + 4096;
    hgrn_gates(a, C, l, b, hh, c, bq, kin);
    { const int s = tid >> 3, k8 = (tid & 7) * 8; const float* row = (const float*)(C.ws + WS_HG) + (size_t)(b * SEQ + c * 64 + s) * 1024 + hh * 64 + k8;
        const f32x4 q0 = *(const f32x4*)row, q1 = *(const f32x4*)(row + 4);
        qq[s * HP + k8 + 0] = siluf_(q0.x); qq[s * HP + k8 + 1] = siluf_(q0.y); qq[s * HP + k8 + 2] = siluf_(q0.z); qq[s * HP + k8 + 3] = siluf_(q0.w);
        qq[s * HP + k8 + 4] = siluf_(q1.x); qq[s * HP + k8 + 5] = siluf_(q1.y); qq[s * HP + k8 + 6] = siluf_(q1.z); qq[s * HP + k8 + 7] = siluf_(q1.w);
        *(LAS f32x4*)(vv + s * 64 + k8) = *(const f32x4*)(row + 512); *(LAS f32x4*)(vv + s * 64 + k8 + 4) = *(const f32x4*)(row + 516); }
    {
        const int k = tid >> 3, v8 = (tid & 7) * 8; f32x4 s0 = (f32x4){0.f, 0.f, 0.f, 0.f}, s1 = s0;
        const float* hl = (const float*)(C.ws + WS_HL) + (size_t)(item - c) * 4096 + k * 64 + v8; const float* hd = (const float*)(C.ws + WS_HD) + (size_t)(item - c) * 64 + k;
#pragma unroll 4
        for (int j = 0; j < c; ++j) { const float dj = hd[(size_t)j * 64]; const f32x4 l0 = *(const f32x4*)(hl + (size_t)j * 4096), l1 = *(const f32x4*)(hl + (size_t)j * 4096 + 4); s0 = s0 * dj + l0; s1 = s1 * dj + l1; }
        *(LAS f32x4*)(Ss + k * 64 + v8) = s0; *(LAS f32x4*)(Ss + k * 64 + v8 + 4) = s1; }
    __syncthreads();
    { const int t = tid >> 3, sg = tid & 7; float ac[8] = {0.f, 0.f, 0.f, 0.f, 0.f, 0.f, 0.f, 0.f};
        for (int k = 0; k < 64; ++k) { const float qt = qq[t * HP + k], bt = bq[t * HP + k];
#pragma unroll
            for (int i = 0; i < 8; ++i) { const int s = sg + 8 * i; if (s <= t) ac[i] += qt * kin[s * HP + k] * __expf(bt - bq[s * HP + k]); } }
#pragma unroll
        for (int i = 0; i < 8; ++i) At[t * HP + sg + 8 * i] = ac[i]; }
    __syncthreads();
    { const int t = tid >> 3, v8 = (tid & 7) * 8; float o[8] = {0.f, 0.f, 0.f, 0.f, 0.f, 0.f, 0.f, 0.f};
#pragma unroll 4
        for (int k = 0; k < 64; ++k) { const float qe = qq[t * HP + k] * __expf(bq[t * HP + k]); const f32x4 x0 = *(const LAS f32x4*)(Ss + k * 64 + v8), x1 = *(const LAS f32x4*)(Ss + k * 64 + v8 + 4);
            o[0] += qe * x0.x; o[1] += qe * x0.y; o[2] += qe * x0.z; o[3] += qe * x0.w; o[4] += qe * x1.x; o[5] += qe * x1.y; o[6] += qe * x1.z; o[7] += qe * x1.w; }
        for (int s = 0; s <= t; ++s) { const float w = At[t * HP + s]; const f32x4 x0 = *(const LAS f32x4*)(vv + s * 64 + v8), x1 = *(const LAS f32x4*)(vv + s * 64 + v8 + 4);
            o[0] += w * x0.x; o[1] += w * x0.y; o[2] += w * x0.z; o[3] += w * x0.w; o[4] += w * x1.x; o[5] += w * x1.y; o[6] += w * x1.z; o[7] += w * x1.w; }
        float ss = 0.f;
#pragma unroll
        for (int j = 0; j < 8; ++j) ss += o[j] * o[j];
        ss += __shfl_xor(ss, 1); ss += __shfl_xor(ss, 2); ss += __shfl_xor(ss, 4);
        const float rstd = 1.0f / sqrtf(ss * (1.0f / 64.0f) + EPS);
        const float* gp = (const float*)(C.ws + WS_HG) + (size_t)(b * SEQ + c * 64 + t) * 1024 + 768 + hh * 64 + v8; const float* ng = a.hgrn_g + l * 64 + v8;
        const f32x4 g0 = *(const f32x4*)gp, g1 = *(const f32x4*)(gp + 4); const float gg[8] = {g0.x, g0.y, g0.z, g0.w, g1.x, g1.y, g1.z, g1.w}; float y[8];
#pragma unroll
        for (int j = 0; j < 8; ++j) y[j] = o[j] * rstd * ng[j] * siluf_(gg[j]);
        u32x4 w; w.x = pk2(y[0], y[1]); w.y = pk2(y[2], y[3]); w.z = pk2(y[4], y[5]); w.w = pk2(y[6], y[7]);
        *(u32x4*)((bf16_t*)(C.ws + WS_MIX) + (size_t)(b * SEQ + c * 64 + t) * D + 768 + hh * 64 + v8) = w; }
    __syncthreads();
}

__device__ __forceinline__ int wave_isum(int v) {
    v += __builtin_amdgcn_update_dpp(0, v, 0xB1, 0xF, 0xF, true);
    v += __builtin_amdgcn_update_dpp(0, v, 0x4E, 0xF, 0xF, true);
    v += __builtin_amdgcn_update_dpp(0, v, 0x141, 0xF, 0xF, true);
    v += __builtin_amdgcn_update_dpp(0, v, 0x140, 0xF, 0xF, true);
    return __builtin_amdgcn_readlane(v, 0) + __builtin_amdgcn_readlane(v, 16) + __builtin_amdgcn_readlane(v, 32) + __builtin_amdgcn_readlane(v, 48);
}
typedef float f32x16 __attribute__((ext_vector_type(16)));
template <int NJ>
__device__ __forceinline__ void select_from_lds(const LAS float* sq, int nj, int* sel, int lane) {
    unsigned key[NJ];
#pragma unroll
    for (int j = 0; j < NJ; ++j) key[j] = sortable(sq[64 * j + lane]);
    unsigned T = 0u;
#pragma unroll 1
    for (int bit = 31; bit >= 0; --bit) {
        const unsigned cand = T | (1u << bit); int c = 0;
#pragma unroll
        for (int j = 0; j < NJ; ++j) c += (key[j] >= cand) ? 1 : 0;
        if (wave_isum(c) >= 256) T = cand;
    }
    int cgt = 0;
#pragma unroll
    for (int j = 0; j < NJ; ++j) cgt += (key[j] > T) ? 1 : 0;
    cgt = wave_isum(cgt);
    const int need = 256 - cgt; int base = 0, eqseen = 0;
#pragma unroll 1
    for (int j = 0; j < nj; ++j) {
        const unsigned kj = sortable(sq[64 * j + lane]);
        const bool gt = kj > T, eq = kj == T; const unsigned long long em = __ballot(eq);
        const bool take = gt || (eq && (eqseen + mbcnt64(em)) < need); const unsigned long long tm = __ballot(take);
        if (take) sel[base + mbcnt64(tm)] = 64 * j + lane;
        base += __popcll(tm); eqseen += __popcll(em);
    }
}
__device__ __forceinline__ void transpose32(unsigned (&a)[32]) {
#pragma unroll
    for (int st = 0; st < 5; ++st) {
        const int j = 16 >> st; const unsigned m = (st == 0) ? 0x0000FFFFu : (st == 1) ? 0x00FF00FFu : (st == 2) ? 0x0F0F0F0Fu : (st == 3) ? 0x33333333u : 0x55555555u;
#pragma unroll
        for (int idx = 0; idx < 16; ++idx) { const int k = (idx / j) * 2 * j + (idx % j); const unsigned t = (a[k] ^ (a[k + j] >> j)) & m; a[k] ^= t; a[k + j] ^= (t << j); }
    }
}
template <int NB>
__device__ __forceinline__ void select_bits(const LAS float* sq, int nj, int* sel, int lane) {
    unsigned pl[NB][32];
#pragma unroll
    for (int blk = 0; blk < NB; ++blk) {
#pragma unroll
        for (int j = 0; j < 32; ++j) pl[blk][j] = sortable(sq[64 * (32 * blk + j) + lane]);
        transpose32(pl[blk]);
    }
    unsigned M[NB], GT[NB];
#pragma unroll
    for (int blk = 0; blk < NB; ++blk) { M[blk] = 0xFFFFFFFFu; GT[blk] = 0u; }
    unsigned T = 0u; int G = 0;
#pragma unroll
    for (int w = 0; w < 32; ++w) {
        unsigned n[NB]; int c = 0;
#pragma unroll
        for (int blk = 0; blk < NB; ++blk) { n[blk] = M[blk] & pl[blk][w]; c += __popc(n[blk]); }
        const int tot = wave_isum(c);
        const bool take = (G + tot) >= 256;
        const unsigned flip = take ? 0u : 0xFFFFFFFFu;
        T |= take ? (1u << (31 - w)) : 0u; G += take ? 0 : tot;
#pragma unroll
        for (int blk = 0; blk < NB; ++blk) { GT[blk] |= n[blk] & flip; M[blk] &= (pl[blk][w] ^ flip); }
    }
    const int need = 256 - G;
    int ceq = 0;
#pragma unroll
    for (int blk = 0; blk < NB; ++blk) ceq += __popc(M[blk]);
    const int toteq = wave_isum(ceq);
    if (toteq == need) {
        int cnt = 0;
#pragma unroll
        for (int blk = 0; blk < NB; ++blk) { GT[blk] |= M[blk]; cnt += __popc(GT[blk]); }
        int incl = cnt;
#pragma unroll
        for (int o = 1; o < 64; o <<= 1) { const int t = __shfl_up(incl, o); if (lane >= o) incl += t; }
        int pos = incl - cnt;
#pragma unroll
        for (int blk = 0; blk < NB; ++blk) { unsigned mk = GT[blk];
            while (mk) { const int x = 31 - __clz((int)mk); mk &= ~(1u << x); sel[pos++] = 64 * (32 * blk + 31 - x) + lane; } }
    } else {
        int base = 0, eqseen = 0;
#pragma unroll 1
        for (int j = 0; j < nj; ++j) {
            const unsigned kj = sortable(sq[64 * j + lane]);
            const bool gt = kj > T, eq = kj == T; const unsigned long long em = __ballot(eq);
            const bool take = gt || (eq && (eqseen + mbcnt64(em)) < need); const unsigned long long tm = __ballot(take);
            if (take) sel[base + mbcnt64(tm)] = 64 * j + lane;
            base += __popcll(tm); eqseen += __popcll(em);
        }
    }
}
__device__ __forceinline__ void index_unit(Ctx& C, int b, int cch, int sub) {
    unsigned char* ws = C.ws; const int lane = C.lane, w = C.wave;
    const int tk0 = b * SEQ + 64 * cch + 8 * sub, L = 64 * (cch + 1), nj = cch + 1;
    if (L <= 256) { int* sel = (int*)(ws + WS_SEL) + (size_t)(tk0 + w) * 256; for (int i = lane; i < L; i += 64) sel[i] = i; return; }
    LAS float* scl = (LAS float*)C.lds;
#ifndef IDXREP
#define IDXREP 0
#endif
    for (int repA = 0; repA < ((IDXREP & 1) ? 2 : 1); ++repA) {
        const int r = lane & 31, hf = lane >> 5, qq = r >> 2, h = r & 3;
        bf16x8 aq[4];
#pragma unroll
        for (int ks = 0; ks < 4; ++ks) aq[ks] = *(const bf16x8*)((const bf16_t*)(ws + WS_QI) + (size_t)(tk0 + qq) * 256 + h * 64 + 16 * ks + 8 * hf);
        f32x4 wq[4];
#pragma unroll
        for (int g = 0; g < 4; ++g) wq[g] = *(const f32x4*)((const float*)(ws + WS_WI) + (size_t)(tk0 + 2 * g + hf) * 4);
        const bf16_t* kib = (const bf16_t*)(ws + WS_KI) + (size_t)b * SEQ * 64;
#pragma unroll 1
        for (int kt = w; kt < 2 * nj; kt += NWAVES) {
            bf16x8 bk[4];
#pragma unroll
            for (int ks = 0; ks < 4; ++ks) bk[ks] = *(const bf16x8*)(kib + (size_t)(32 * kt + r) * 64 + 16 * ks + 8 * hf);
            f32x16 acc;
#pragma unroll
            for (int i = 0; i < 16; ++i) acc[i] = 0.f;
#pragma unroll
            for (int ks = 0; ks < 4; ++ks) acc = __builtin_amdgcn_mfma_f32_32x32x16_bf16(aq[ks], bk[ks], acc, 0, 0, 0);
#pragma unroll
            for (int g = 0; g < 4; ++g) {
                float sc = fmaxf(acc[4 * g + 0], 0.f) * wq[g][0] + fmaxf(acc[4 * g + 1], 0.f) * wq[g][1] + fmaxf(acc[4 * g + 2], 0.f) * wq[g][2] + fmaxf(acc[4 * g + 3], 0.f) * wq[g][3];
                sc = (sc == 0.f) ? 0.f : sc;
                scl[(2 * g + hf) * 4096 + 32 * kt + r] = sc;
            }
        }
        const int njp = nj <= 32 ? 32 : 64;
        for (int j = nj; j < njp; ++j) scl[w * 4096 + 64 * j + lane] = -3.0e38f;
    }
    __syncthreads();
    for (int repB = 0; repB < ((IDXREP & 2) ? 2 : 1); ++repB) {
        const LAS float* sq = scl + w * 4096; int* sel = (int*)(ws + WS_SEL) + (size_t)(tk0 + w) * 256;
        if (nj <= 32) select_bits<1>(sq, nj, sel, lane); else select_bits<2>(sq, nj, sel, lane);
    }
    __syncthreads();
}

typedef short s16x4 __attribute__((ext_vector_type(4)));
__device__ __forceinline__ unsigned cvt_pk_bf16(float lo, float hi) { unsigned r; asm volatile("v_cvt_pk_bf16_f32 %0, %1, %2" : "=v"(r) : "v"(lo), "v"(hi)); return r; }
constexpr int VROW = 272;
__device__ __forceinline__ void attend_query_mfma(Ctx& C, int tk, LAS unsigned char* vs) {
    unsigned char* ws = C.ws; const int lane = C.lane, c = lane & 15, g = lane >> 4;
    const int tpos = tk & (SEQ - 1), b = tk >> 12, L = 64 * ((tpos >> 6) + 1), nsel = L < 256 ? L : 256;
    const bf16_t* kb = (const bf16_t*)(ws + WS_K) + (size_t)b * SEQ * 128; const bf16_t* vb = (const bf16_t*)(ws + WS_V) + (size_t)b * SEQ * 128;
    int selr[4];
    { const int* sg = (const int*)(ws + WS_SEL) + (size_t)tk * 256;
#pragma unroll
      for (int i = 0; i < 4; ++i) selr[i] = (64 * i + lane) < nsel ? sg[64 * i + lane] : 0; }
    bf16x8 bq0[2], bq1[2];
    { const bf16_t* qp = (const bf16_t*)(ws + WS_Q) + (size_t)tk * 512 + (c & 7) * 64 + 8 * g; const bf16x8 z = (bf16x8){0, 0, 0, 0, 0, 0, 0, 0};
#pragma unroll
      for (int ks = 0; ks < 2; ++ks) { const bf16x8 q = *(const bf16x8*)(qp + 32 * ks); bq0[ks] = (c < 4) ? q : z; bq1[ks] = (c >= 4 && c < 8) ? q : z; } }
    f32x4 acc[16];
#pragma unroll
    for (int kt = 0; kt < 16; ++kt) {
        if ((kt & 1) == 0) asm volatile("" ::: "memory");
        const int key = __shfl(selr[kt >> 2], 16 * (kt & 3) + c);
        const bf16_t* kr = kb + (size_t)key * 128 + 8 * g;
        const bf16x8 a00 = *(const bf16x8*)(kr), a01 = *(const bf16x8*)(kr + 32), a10 = *(const bf16x8*)(kr + 64), a11 = *(const bf16x8*)(kr + 96);
        f32x4 t = (f32x4){0.f, 0.f, 0.f, 0.f};
        t = __builtin_amdgcn_mfma_f32_16x16x32_bf16(a00, bq0[0], t, 0, 0, 0); t = __builtin_amdgcn_mfma_f32_16x16x32_bf16(a01, bq0[1], t, 0, 0, 0);
        t = __builtin_amdgcn_mfma_f32_16x16x32_bf16(a10, bq1[0], t, 0, 0, 0); t = __builtin_amdgcn_mfma_f32_16x16x32_bf16(a11, bq1[1], t, 0, 0, 0);
        acc[kt] = t;
    }
    { const int lim = nsel - 4 * g;
#pragma unroll
      for (int kt = 0; kt < 16; ++kt)
#pragma unroll
        for (int r = 0; r < 4; ++r) acc[kt][r] = (16 * kt + r < lim) ? acc[kt][r] : -1e30f; }
    float m = -1e30f;
#pragma unroll
    for (int kt = 0; kt < 16; ++kt) m = fmaxf(m, fmaxf(fmaxf(acc[kt][0], acc[kt][1]), fmaxf(acc[kt][2], acc[kt][3])));
    m = fmaxf(m, __shfl_xor(m, 16)); m = fmaxf(m, __shfl_xor(m, 32));
    float sum = 0.f;
#pragma unroll
    for (int kt = 0; kt < 16; ++kt)
#pragma unroll
        for (int r = 0; r < 4; ++r) { const float pv = __expf(acc[kt][r] - m); acc[kt][r] = pv; sum += pv; }
    sum += __shfl_xor(sum, 16); sum += __shfl_xor(sum, 32);
    const float inv = 1.0f / sum;
    bf16x8 bp[8];
#pragma unroll
    for (int T = 0; T < 8; ++T) { u32x4 w; w.x = cvt_pk_bf16(acc[2 * T][0], acc[2 * T][1]); w.y = cvt_pk_bf16(acc[2 * T][2], acc[2 * T][3]); w.z = cvt_pk_bf16(acc[2 * T + 1][0], acc[2 * T + 1][1]); w.w = cvt_pk_bf16(acc[2 * T + 1][2], acc[2 * T + 1][3]);
        bp[T] = __builtin_bit_cast(bf16x8, w); }
    f32x4 ao0[4], ao1[4];
#pragma unroll
    for (int dt = 0; dt < 4; ++dt) { ao0[dt] = (f32x4){0.f, 0.f, 0.f, 0.f}; ao1[dt] = (f32x4){0.f, 0.f, 0.f, 0.f}; }
    const int q4 = c >> 2, p4 = c & 3;
    u32x4 vst[8];
#define ATT_VLOAD(T) do { _Pragma("unroll") for (int i = 0; i < 8; ++i) { const int row = g + 4 * i; \
        const int key = __shfl(selr[(T) >> 1], 32 * ((T) & 1) + row); vst[i] = *(const u32x4*)(vb + (size_t)key * 128 + 8 * c); } } while (0)
    ATT_VLOAD(0);
#pragma unroll
    for (int T = 0; T < 8; ++T) {
        LAS unsigned char* buf = vs + (T & 1) * (32 * VROW);
        asm volatile("" ::: "memory");
#pragma unroll
        for (int i = 0; i < 8; ++i) *(LAS u32x4*)(buf + (g + 4 * i) * VROW + 16 * c) = vst[i];
        if (T < 7) ATT_VLOAD(T + 1);
#pragma unroll
        for (int n = 0; n < 2; ++n)
#pragma unroll
            for (int dt = 0; dt < 4; ++dt) {
                LAS s16x4* p0 = (LAS s16x4*)(buf + (4 * g + q4) * VROW + (n * 64 + 16 * dt + 4 * p4) * 2);
                const s16x4 lo = __builtin_amdgcn_ds_read_tr16_b64_v4i16(p0), hi = __builtin_amdgcn_ds_read_tr16_b64_v4i16((LAS s16x4*)((LAS unsigned char*)p0 + 16 * VROW));
                const bf16x8 av = (bf16x8){lo[0], lo[1], lo[2], lo[3], hi[0], hi[1], hi[2], hi[3]};
                if (n == 0) ao0[dt] = __builtin_amdgcn_mfma_f32_16x16x32_bf16(av, bp[T], ao0[dt], 0, 0, 0);
                else ao1[dt] = __builtin_amdgcn_mfma_f32_16x16x32_bf16(av, bp[T], ao1[dt], 0, 0, 0);
            }
    }
#undef ATT_VLOAD
    if (c < 8) {
        bf16_t* mo = (bf16_t*)(ws + WS_MIX) + (size_t)tk * D + c * 64 + 4 * g;
#pragma unroll
        for (int dt = 0; dt < 4; ++dt) { f32x4 o; o[0] = (c < 4 ? ao0[dt][0] : ao1[dt][0]) * inv; o[1] = (c < 4 ? ao0[dt][1] : ao1[dt][1]) * inv; o[2] = (c < 4 ? ao0[dt][2] : ao1[dt][2]) * inv; o[3] = (c < 4 ? ao0[dt][3] : ao1[dt][3]) * inv; u32x2 w; w.x = cvt_pk_bf16(o[0], o[1]); w.y = cvt_pk_bf16(o[2], o[3]); *(u32x2*)(mo + 16 * dt) = w; }
    }
}

__device__ __forceinline__ void hgrn_out_group(const Args& a, Ctx& C, int l, int item) {
    const int tid = C.tid, lane = C.lane, w = C.wave, cg = item & 15, hh = (item >> 4) & 3, b = item >> 6, c0 = 4 * cg, bh = b * 4 + hh;
    LAS float* bq = (LAS float*)C.lds; LAS float* kin = bq + 64 * HP; LAS float* qq = kin + 64 * HP; LAS float* At = qq + 64 * HP; LAS float* vv = At + 64 * HP; LAS float* Ss = vv + 4096;
    const float* HG = (const float*)(C.ws + WS_HG); const float* HLb = (const float*)(C.ws + WS_HL) + (size_t)bh * 64 * 4096; const float* HDb = (const float*)(C.ws + WS_HD) + (size_t)bh * 64 * 64;
    float lbv[8];
#pragma unroll
    for (int j = 0; j < 8; ++j) { const int kk = hh * 64 + 8 * w + j; lbv[j] = (l == 1) ? 1.0f / (1.0f + expf(a.lb_logits[kk] - a.lb_logits[256 + kk])) : 0.f; }
    const int kS = tid >> 3, v8 = (tid & 7) * 8; f32x4 s0 = (f32x4){0.f, 0.f, 0.f, 0.f}, s1 = s0;
    { const float* hl = HLb + kS * 64 + v8; const float* hd = HDb + kS;
#pragma unroll 8
      for (int j = 0; j < c0; ++j) { const float dj = hd[(size_t)j * 64]; const f32x4 l0 = *(const f32x4*)(hl + (size_t)j * 4096), l1 = *(const f32x4*)(hl + (size_t)j * 4096 + 4); s0 = s0 * dj + l0; s1 = s1 * dj + l1; } }
#pragma unroll 1
    for (int c = c0; c < c0 + 4; ++c) {
        const size_t tok0 = (size_t)b * SEQ + c * 64;
        const f32x4 lc0 = *(const f32x4*)(HLb + (size_t)c * 4096 + kS * 64 + v8), lc1 = *(const f32x4*)(HLb + (size_t)c * 4096 + kS * 64 + v8 + 4);
        *(LAS f32x4*)(Ss + kS * 64 + v8) = s0; *(LAS f32x4*)(Ss + kS * 64 + v8 + 4) = s1;
        {
            const float* z = HG + (tok0 + lane) * 1024 + 256 + hh * 64 + 8 * w; const f32x4 z0 = *(const f32x4*)z, z1 = *(const f32x4*)(z + 4); const float zz[8] = {z0.x, z0.y, z0.z, z0.w, z1.x, z1.y, z1.z, z1.w};
#pragma unroll
            for (int j = 0; j < 8; ++j) { const float lb = lbv[j]; const float sg = 1.0f / (1.0f + __expf(-zz[j])), sn = 1.0f / (1.0f + __expf(zz[j])); float lf = __logf(lb + (1.0f - lb) * sg);
#pragma unroll
                for (int o = 1; o < 64; o <<= 1) { const float t = __shfl_up(lf, o); if (lane >= o) lf += t; }
                bq[lane * HP + 8 * w + j] = lf; kin[lane * HP + 8 * w + j] = (1.0f - lb) * sn; }
        }
        { const int sr = tid >> 3, k8 = (tid & 7) * 8; const float* row = HG + (tok0 + sr) * 1024 + hh * 64 + k8;
            const f32x4 q0 = *(const f32x4*)row, q1 = *(const f32x4*)(row + 4);
            qq[sr * HP + k8 + 0] = siluf_(q0.x); qq[sr * HP + k8 + 1] = siluf_(q0.y); qq[sr * HP + k8 + 2] = siluf_(q0.z); qq[sr * HP + k8 + 3] = siluf_(q0.w);
            qq[sr * HP + k8 + 4] = siluf_(q1.x); qq[sr * HP + k8 + 5] = siluf_(q1.y); qq[sr * HP + k8 + 6] = siluf_(q1.z); qq[sr * HP + k8 + 7] = siluf_(q1.w);
            *(LAS f32x4*)(vv + sr * 64 + k8) = *(const f32x4*)(row + 512); *(LAS f32x4*)(vv + sr * 64 + k8 + 4) = *(const f32x4*)(row + 516); }
        __syncthreads();
        { const int t = tid >> 3, sg = tid & 7; float ac[8] = {0.f, 0.f, 0.f, 0.f, 0.f, 0.f, 0.f, 0.f};
            for (int k = 0; k < 64; ++k) { const float qt = qq[t * HP + k], bt = bq[t * HP + k];
#pragma unroll
                for (int i = 0; i < 8; ++i) { const int sx = sg + 8 * i; if (sx <= t) ac[i] += qt * kin[sx * HP + k] * __expf(bt - bq[sx * HP + k]); } }
#pragma unroll
            for (int i = 0; i < 8; ++i) At[t * HP + sg + 8 * i] = ac[i]; }
        __syncthreads();
        { const int t = tid >> 3; float o[8] = {0.f, 0.f, 0.f, 0.f, 0.f, 0.f, 0.f, 0.f};
#pragma unroll 4
            for (int k = 0; k < 64; ++k) { const float qe = qq[t * HP + k] * __expf(bq[t * HP + k]); const f32x4 x0 = *(const LAS f32x4*)(Ss + k * 64 + v8), x1 = *(const LAS f32x4*)(Ss + k * 64 + v8 + 4);
                o[0] += qe * x0.x; o[1] += qe * x0.y; o[2] += qe * x0.z; o[3] += qe * x0.w; o[4] += qe * x1.x; o[5] += qe * x1.y; o[6] += qe * x1.z; o[7] += qe * x1.w; }
            for (int sx = 0; sx <= t; ++sx) { const float wv = At[t * HP + sx]; const f32x4 x0 = *(const LAS f32x4*)(vv + sx * 64 + v8), x1 = *(const LAS f32x4*)(vv + sx * 64 + v8 + 4);
                o[0] += wv * x0.x; o[1] += wv * x0.y; o[2] += wv * x0.z; o[3] += wv * x0.w; o[4] += wv * x1.x; o[5] += wv * x1.y; o[6] += wv * x1.z; o[7] += wv * x1.w; }
            float ss = 0.f;
#pragma unroll
            for (int j = 0; j < 8; ++j) ss += o[j] * o[j];
            ss += __shfl_xor(ss, 1); ss += __shfl_xor(ss, 2); ss += __shfl_xor(ss, 4);
            const float rstd = 1.0f / sqrtf(ss * (1.0f / 64.0f) + EPS);
            const float* gp = HG + (tok0 + t) * 1024 + 768 + hh * 64 + v8; const float* ng = a.hgrn_g + l * 64 + v8;
            const f32x4 g0 = *(const f32x4*)gp, g1 = *(const f32x4*)(gp + 4); const float gg[8] = {g0.x, g0.y, g0.z, g0.w, g1.x, g1.y, g1.z, g1.w}; float y[8];
#pragma unroll
            for (int j = 0; j < 8; ++j) y[j] = o[j] * rstd * ng[j] * siluf_(gg[j]);
            u32x4 wv; wv.x = pk2(y[0], y[1]); wv.y = pk2(y[2], y[3]); wv.z = pk2(y[4], y[5]); wv.w = pk2(y[6], y[7]);
            *(u32x4*)((bf16_t*)(C.ws + WS_MIX) + (tok0 + t) * D + 768 + hh * 64 + v8) = wv; }
        { const float dc = __expf(bq[63 * HP + kS]); s0 = s0 * dc + lc0; s1 = s1 * dc + lc1; }
        __syncthreads();
    }
}

template <bool WITH_Q>
__device__ __forceinline__ void hgrn_fill(const Args& a, Ctx& C, int l, int hh, size_t tok0, LAS float* fz, LAS float* kn, LAS float* qq, LAS float* vv) {
    const int tid = C.tid, sr = tid >> 3, k8 = (tid & 7) * 8; const float* row = (const float*)(C.ws + WS_HG) + (tok0 + sr) * 1024 + hh * 64 + k8;
    const f32x4 z0 = *(const f32x4*)(row + 256), z1 = *(const f32x4*)(row + 260); const float zz[8] = {z0.x, z0.y, z0.z, z0.w, z1.x, z1.y, z1.z, z1.w}; float fo[8], ko[8];
#pragma unroll
    for (int j = 0; j < 8; ++j) { const int kk = hh * 64 + k8 + j; const float lb = (l == 1) ? 1.0f / (1.0f + expf(a.lb_logits[kk] - a.lb_logits[256 + kk])) : 0.f;
        const float sg = 1.0f / (1.0f + expf(-zz[j])), sn = 1.0f / (1.0f + expf(zz[j])); fo[j] = lb + (1.0f - lb) * sg; ko[j] = (1.0f - lb) * sn; }
    *(LAS f32x4*)(fz + sr * 64 + k8) = (f32x4){fo[0], fo[1], fo[2], fo[3]}; *(LAS f32x4*)(fz + sr * 64 + k8 + 4) = (f32x4){fo[4], fo[5], fo[6], fo[7]};
    *(LAS f32x4*)(kn + sr * 64 + k8) = (f32x4){ko[0], ko[1], ko[2], ko[3]}; *(LAS f32x4*)(kn + sr * 64 + k8 + 4) = (f32x4){ko[4], ko[5], ko[6], ko[7]};
    if (WITH_Q) { const f32x4 q0 = *(const f32x4*)row, q1 = *(const f32x4*)(row + 4);
        *(LAS f32x4*)(qq + sr * 64 + k8) = (f32x4){siluf_(q0.x), siluf_(q0.y), siluf_(q0.z), siluf_(q0.w)}; *(LAS f32x4*)(qq + sr * 64 + k8 + 4) = (f32x4){siluf_(q1.x), siluf_(q1.y), siluf_(q1.z), siluf_(q1.w)}; }
    *(LAS f32x4*)(vv + sr * 64 + k8) = *(const f32x4*)(row + 512); *(LAS f32x4*)(vv + sr * 64 + k8 + 4) = *(const f32x4*)(row + 516);
}
__device__ __forceinline__ void hgrn_local2(const Args& a, Ctx& C, int l, int item) {
    const int tid = C.tid, c = item & 63, hh = (item >> 6) & 3, b = item >> 8, v = tid & 63, kq = tid >> 6;
    LAS float* fz = (LAS float*)C.lds; LAS float* kn = fz + 4096; LAS float* vv = kn + 4096;
    hgrn_fill<false>(a, C, l, hh, (size_t)b * SEQ + c * 64, fz, kn, nullptr, vv);
    __syncthreads();
    float S[8] = {0.f, 0.f, 0.f, 0.f, 0.f, 0.f, 0.f, 0.f}, dp[8] = {1.f, 1.f, 1.f, 1.f, 1.f, 1.f, 1.f, 1.f};
#pragma unroll 4
    for (int sx = 0; sx < 64; ++sx) { const f32x4 f0 = *(const LAS f32x4*)(fz + sx * 64 + 8 * kq), f1 = *(const LAS f32x4*)(fz + sx * 64 + 8 * kq + 4), k0 = *(const LAS f32x4*)(kn + sx * 64 + 8 * kq), k1 = *(const LAS f32x4*)(kn + sx * 64 + 8 * kq + 4);
        const float vs = vv[sx * 64 + v]; const float ff[8] = {f0.x, f0.y, f0.z, f0.w, f1.x, f1.y, f1.z, f1.w}, kk[8] = {k0.x, k0.y, k0.z, k0.w, k1.x, k1.y, k1.z, k1.w};
#pragma unroll
        for (int j = 0; j < 8; ++j) { S[j] = ff[j] * S[j] + kk[j] * vs; dp[j] *= ff[j]; } }
    float* hl = (float*)(C.ws + WS_HL) + (size_t)item * 4096 + (8 * kq) * 64 + v;
#pragma unroll
    for (int j = 0; j < 8; ++j) hl[j * 64] = S[j];
    if (v == 0) { float* hd = (float*)(C.ws + WS_HD) + (size_t)item * 64 + 8 * kq;
#pragma unroll
        for (int j = 0; j < 8; ++j) hd[j] = dp[j]; }
    __syncthreads();
}
__device__ __forceinline__ void hgrn_out2(const Args& a, Ctx& C, int l, int item) {
    const int tid = C.tid, cg = item & 15, hh = (item >> 4) & 3, b = item >> 6, c0 = 4 * cg, bh = b * 4 + hh, v = tid & 63, kq = tid >> 6;
    LAS float* fz = (LAS float*)C.lds; LAS float* kn = fz + 4096; LAS float* qq = kn + 4096; LAS float* vv = qq + 4096; LAS float* part = vv + 4096;
    const float* HLb = (const float*)(C.ws + WS_HL) + (size_t)bh * 64 * 4096 + (8 * kq) * 64 + v; const float* HDb = (const float*)(C.ws + WS_HD) + (size_t)bh * 64 * 64 + 8 * kq;
    float S[8] = {0.f, 0.f, 0.f, 0.f, 0.f, 0.f, 0.f, 0.f};
#pragma unroll 2
    for (int j = 0; j < c0; ++j) { const f32x4 d0 = *(const f32x4*)(HDb + (size_t)j * 64), d1 = *(const f32x4*)(HDb + (size_t)j * 64 + 4); const float dd[8] = {d0.x, d0.y, d0.z, d0.w, d1.x, d1.y, d1.z, d1.w};
#pragma unroll
        for (int i = 0; i < 8; ++i) S[i] = dd[i] * S[i] + HLb[(size_t)j * 4096 + i * 64]; }
#pragma unroll 1
    for (int c = c0; c < c0 + 4; ++c) {
        const size_t tok0 = (size_t)b * SEQ + c * 64;
        hgrn_fill<true>(a, C, l, hh, tok0, fz, kn, qq, vv);
        __syncthreads();
#pragma unroll 1
        for (int half = 0; half < 2; ++half) {
#pragma unroll 4
            for (int sl = 0; sl < 32; ++sl) { const int sx = 32 * half + sl;
                const f32x4 f0 = *(const LAS f32x4*)(fz + sx * 64 + 8 * kq), f1 = *(const LAS f32x4*)(fz + sx * 64 + 8 * kq + 4), k0 = *(const LAS f32x4*)(kn + sx * 64 + 8 * kq), k1 = *(const LAS f32x4*)(kn + sx * 64 + 8 * kq + 4);
                const f32x4 q0 = *(const LAS f32x4*)(qq + sx * 64 + 8 * kq), q1 = *(const LAS f32x4*)(qq + sx * 64 + 8 * kq + 4);
                const float vs = vv[sx * 64 + v]; const float ff[8] = {f0.x, f0.y, f0.z, f0.w, f1.x, f1.y, f1.z, f1.w}, kk[8] = {k0.x, k0.y, k0.z, k0.w, k1.x, k1.y, k1.z, k1.w}, qv[8] = {q0.x, q0.y, q0.z, q0.w, q1.x, q1.y, q1.z, q1.w};
                float op = 0.f;
#pragma unroll
                for (int j = 0; j < 8; ++j) { S[j] = ff[j] * S[j] + kk[j] * vs; op += qv[j] * S[j]; }
                part[(kq * 32 + sl) * 64 + v] = op; }
            __syncthreads();
            { const int t = tid >> 4, v4 = (tid & 15) * 4; f32x4 o = (f32x4){0.f, 0.f, 0.f, 0.f};
#pragma unroll
                for (int kk2 = 0; kk2 < 8; ++kk2) o += *(const LAS f32x4*)(part + (kk2 * 32 + t) * 64 + v4);
                float ss = o.x * o.x + o.y * o.y + o.z * o.z + o.w * o.w;
                ss += __shfl_xor(ss, 1); ss += __shfl_xor(ss, 2); ss += __shfl_xor(ss, 4); ss += __shfl_xor(ss, 8);
                const float rstd = 1.0f / sqrtf(ss * (1.0f / 64.0f) + EPS);
                const size_t tok = tok0 + 32 * half + t;
                const f32x4 gg = *(const f32x4*)((const float*)(C.ws + WS_HG) + tok * 1024 + 768 + hh * 64 + v4), ng = *(const f32x4*)(a.hgrn_g + l * 64 + v4);
                const float y0 = o.x * rstd * ng.x * siluf_(gg.x), y1 = o.y * rstd * ng.y * siluf_(gg.y), y2 = o.z * rstd * ng.z * siluf_(gg.z), y3 = o.w * rstd * ng.w * siluf_(gg.w);
                u32x2 wv; wv.x = pk2(y0, y1); wv.y = pk2(y2, y3);
                *(u32x2*)((bf16_t*)(C.ws + WS_MIX) + tok * D + 768 + hh * 64 + v4) = wv; }
            __syncthreads();
        }
    }
}

__device__ __forceinline__ void phase_mix1(const Args& a, Ctx& C, int l) {
#ifndef MIX1MASK
#define MIX1MASK 7
#endif
#ifndef MIX1REP
#define MIX1REP 0
#endif
    for (int rep = 0; rep < ((MIX1REP & 1) && l == 0 ? 2 : 1); ++rep) for (int it = blockIdx.x; it < 1024; it += C.G) hgrn_local2(a, C, l, it);
    for (int rep = 0; rep < ((MIX1REP & 2) && l == 0 ? 2 : 1); ++rep) for (int it = blockIdx.x; it < 1024; it += C.G) pool_item(a, C, l, it);
    for (int rep = 0; rep < ((MIX1REP & 4) && l == 0 ? 2 : 1); ++rep) for (int base = 0; base < 2048; base += 2 * C.G) {
        const int u1 = base + (int)blockIdx.x, u2 = base + 2 * C.G - 1 - (int)blockIdx.x;
        if (u1 < 2048) index_unit(C, (u1 >> 3) & 3, u1 >> 5, u1 & 7);
        if (u2 < 2048) index_unit(C, (u2 >> 3) & 3, u2 >> 5, u2 & 7);
    }
}
__device__ __forceinline__ void phase_mix2(const Args& a, Ctx& C, int l) {
#ifndef MIX2MASK
#define MIX2MASK 3
#endif
#ifndef MIX2REP
#define MIX2REP 0
#endif
    for (int rep = 0; rep < ((MIX2REP & 1) ? 2 : 1); ++rep) for (int it = blockIdx.x; it < 256; it += C.G) hgrn_out2(a, C, l, it);
    LAS unsigned char* vs = C.lds + C.wave * (2 * 32 * VROW);
    const int gw = blockIdx.x * NWAVES + C.wave, NGW = C.G * NWAVES;
    for (int rep = 0; rep < ((MIX2REP & 2) ? 2 : 1); ++rep) for (int tk = gw; tk < NTOK; tk += NGW) attend_query_mfma(C, tk, vs);
}

__device__ __forceinline__ void phase_router(const Args& a, Ctx& C, int l) {
    unsigned char* ws = C.ws; const int lane = C.lane;
    LAS float* us = (LAS float*)(C.lds + C.wave * 8192);
    const float* mod = (const float*)(ws + WS_MOD); const float* H = (const float*)(ws + WS_H);
    const float* wr = a.w_router + (size_t)l * 1024 * 32; unsigned* cnt = (unsigned*)(ws + WS_CTL) + CW_CNT + l * 32 * 64;
    const int gw = blockIdx.x * NWAVES + C.wave, NGW = C.G * NWAVES;
    for (int base = gw * 2; base < NTOK; base += NGW * 2) {
#pragma unroll
        for (int hf = 0; hf < 2; ++hf) {
            const int tk = base + hf, b = tk >> 12; const f32x4* hr = (const f32x4*)(H + (size_t)tk * D) + lane; f32x4 v[4];
#pragma unroll
            for (int j = 0; j < 4; ++j) v[j] = hr[64 * j];
            float ss = 0.f;
#pragma unroll
            for (int j = 0; j < 4; ++j) ss += (v[j].x * v[j].x + v[j].y * v[j].y) + (v[j].z * v[j].z + v[j].w * v[j].w);
            const float rstd = 1.0f / sqrtf(wave_sum(ss) * (1.0f / D) + EPS);
            const float* mb = mod + (size_t)(l * 4 + b) * 6144; bf16_t* urow = (bf16_t*)(ws + WS_U) + (size_t)tk * D;
#pragma unroll
            for (int j = 0; j < 4; ++j) { const int idx = 4 * lane + 256 * j; const f32x4 gv = *(const f32x4*)(a.norm2_g + l * 1024 + idx), shv = *(const f32x4*)(mb + 3072 + idx), scv = *(const f32x4*)(mb + 4096 + idx);
                const f32x4 o = v[j] * rstd * gv * (scv + 1.0f) + shv; u32x2 w; w.x = pk2(o[0], o[1]); w.y = pk2(o[2], o[3]); *(u32x2*)(urow + idx) = w;
                *(LAS f32x4*)(us + hf * 1024 + idx) = o; }
        }
        asm volatile("s_waitcnt lgkmcnt(0)" ::: "memory"); __builtin_amdgcn_wave_barrier();
        const int e = lane & 31, hf = lane >> 5; float acc0 = 0.f, acc1 = 0.f;
        const LAS float* up = us + hf * 1024;
#pragma unroll 8
        for (int d = 0; d < 1024; d += 2) { acc0 += up[d] * wr[d * 32 + e]; acc1 += up[d + 1] * wr[(d + 1) * 32 + e]; }
        float val = acc0 + acc1 + a.b_router[l * 32 + e];
        float tv[4]; int te[4];
#pragma unroll
        for (int k = 0; k < 4; ++k) {
            float bv = val; int bi = e;
#pragma unroll
            for (int o = 1; o < 32; o <<= 1) { const float ov = __shfl_xor(bv, o); const int oi = __shfl_xor(bi, o); if (ov > bv || (ov == bv && oi < bi)) { bv = ov; bi = oi; } }
            tv[k] = bv; te[k] = bi; if (e == bi) val = -3.0e38f;
        }
        const float e1 = __expf(tv[1] - tv[0]), e2 = __expf(tv[2] - tv[0]), e3 = __expf(tv[3] - tv[0]); const float rs = 1.0f / (1.0f + e1 + e2 + e3);
        if (e < 4) {
            const int tk = base + hf; const int ex = e == 0 ? te[0] : e == 1 ? te[1] : e == 2 ? te[2] : te[3]; const float gt = (e == 0 ? 1.0f : e == 1 ? e1 : e == 2 ? e2 : e3) * rs;
            const unsigned slot = atomicAdd(cnt + ex * 64, 1u);
            ((int*)(ws + WS_ROWTOK))[(size_t)ex * NTOK + slot] = tk;
            ((int*)(ws + WS_EIDX))[tk * 4 + e] = ex; ((int*)(ws + WS_SLOT))[tk * 4 + e] = (int)slot; ((float*)(ws + WS_GATE))[tk * 4 + e] = gt;
        }
        asm volatile("s_waitcnt lgkmcnt(0)" ::: "memory"); __builtin_amdgcn_wave_barrier();
    }
}

__device__ __forceinline__ void moe_table(Ctx& C, int l, LAS int* tab) {
    if (C.tid < 32) { const unsigned* cnt = (const unsigned*)(C.ws + WS_CTL) + CW_CNT + l * 32 * 64; tab[33 + C.tid] = (int)__hip_atomic_load(cnt + C.tid * 64, __ATOMIC_RELAXED, __HIP_MEMORY_SCOPE_AGENT); }
    __syncthreads();
    if (C.tid == 0) { int p = 0; for (int e = 0; e < 32; ++e) { tab[e] = p; p += (tab[33 + e] + 255) >> 8; } tab[32] = p; }
    __syncthreads();
}

__device__ __forceinline__ void phase_combine(const Args& a, Ctx& C, int l) {
    unsigned char* ws = C.ws; const int lane = C.lane;
    const float* mod = (const float*)(ws + WS_MOD); float* H = (float*)(ws + WS_H); const bf16_t* Y = (const bf16_t*)(ws + WS_Y);
    const unsigned* cnt = (const unsigned*)(ws + WS_CTL) + CW_CNT + l * 32 * 64;
    int mt = 0; if (lane < 32) mt = ((int)__hip_atomic_load(cnt + lane * 64, __ATOMIC_RELAXED, __HIP_MEMORY_SCOPE_AGENT) + 255) >> 8;
    int incl = mt;
#pragma unroll
    for (int o = 1; o < 32; o <<= 1) { const int t = __shfl_up(incl, o); if ((lane & 31) >= o) incl += t; }
    const int excl = incl - mt;
    const int gw = blockIdx.x * NWAVES + C.wave, NGW = C.G * NWAVES;
    for (int tk = gw; tk < NTOK; tk += NGW) {
        const int b = tk >> 12; f32x4 v[4]; f32x4* hr = (f32x4*)(H + (size_t)tk * D) + lane;
#pragma unroll
        for (int j = 0; j < 4; ++j) v[j] = hr[64 * j];
        f32x4 m[4];
#pragma unroll
        for (int j = 0; j < 4; ++j) m[j] = (f32x4){0.f, 0.f, 0.f, 0.f};
#pragma unroll
        for (int k = 0; k < 4; ++k) {
            const int ex = ((const int*)(ws + WS_EIDX))[tk * 4 + k], slot = ((const int*)(ws + WS_SLOT))[tk * 4 + k]; const float gt = ((const float*)(ws + WS_GATE))[tk * 4 + k];
            const int row = 256 * __shfl(excl, ex) + slot; const u32x2* yr = (const u32x2*)(Y + (size_t)row * D) + lane;
#pragma unroll
            for (int j = 0; j < 4; ++j) { const u32x2 w = yr[64 * j]; m[j] += (f32x4){bflo(w.x), bfhi(w.x), bflo(w.y), bfhi(w.y)} * gt; }
        }
        const float* mb = mod + (size_t)(l * 4 + b) * 6144;
#pragma unroll
        for (int j = 0; j < 4; ++j) { const f32x4 g2 = *(const f32x4*)(mb + 5120 + 4 * lane + 256 * j); v[j] += g2 * m[j]; hr[64 * j] = v[j]; }
        if (l + 1 < DEPTH) { const float* mn = mod + (size_t)((l + 1) * 4 + b) * 6144; norm_mod_store(v, a.norm1_g + (l + 1) * 1024, mn + 0, mn + 1024, (bf16_t*)(ws + WS_U) + (size_t)tk * D, lane); }
        else {
            float ss = 0.f;
#pragma unroll
            for (int j = 0; j < 4; ++j) ss += (v[j].x * v[j].x + v[j].y * v[j].y) + (v[j].z * v[j].z + v[j].w * v[j].w);
            const float rstd = 1.0f / sqrtf(wave_sum(ss) * (1.0f / D) + EPS);
            f32x4* orow = (f32x4*)(a.out + (size_t)tk * D) + lane;
#pragma unroll
            for (int j = 0; j < 4; ++j) orow[64 * j] = v[j] * rstd * *(const f32x4*)(a.final_g + 4 * lane + 256 * j);
        }
    }
}


#define XB_TMO      128
#define XB_XCNT(j)  (256  + 64 * (j))
#define XB_XSUB(j)  (1280 + 64 * (j))
#define XB_XGEN(j)  (2304 + 64 * (j))
#define XB_TOP      3328
#define XB_TOPGEN   3392
#define XCD_BAR_WORDS 3456
#define XB_SPIN_CAP (1u << 22)
__device__ __forceinline__ unsigned xb_ld(unsigned* p)              { return __hip_atomic_load(p, __ATOMIC_RELAXED, __HIP_MEMORY_SCOPE_AGENT); }
__device__ __forceinline__ unsigned xb_add(unsigned* p, unsigned v) { return __hip_atomic_fetch_add(p, v, __ATOMIC_RELAXED, __HIP_MEMORY_SCOPE_AGENT); }
__device__ __forceinline__ unsigned xb_xcc_id() { return (unsigned)__builtin_amdgcn_s_getreg((3 << 11) | 20) & 0xFu; }
#define XB_SPIN(cond, bar) do { unsigned _sp = 0; while (cond) { __builtin_amdgcn_s_sleep(1); \
    if ((++_sp & 255u) == 0u) { if (xb_ld(&(bar)[XB_TMO])) break; if (_sp > XB_SPIN_CAP) { atomicAdd(&(bar)[XB_TMO], 1u); break; } } } } while (0)
struct XcdBarrier { unsigned* bar; unsigned x; volatile LAS unsigned* st; };
__device__ __forceinline__ XcdBarrier xcd_barrier_post(unsigned* bar, volatile LAS unsigned* st, bool leader) {
    XcdBarrier b; b.bar = bar; b.x = xb_xcc_id(); b.st = st;
    if (leader) (void)xb_add(&bar[XB_XCNT(b.x)], 1u);
    return b;
}
__device__ __forceinline__ void xcd_barrier_complete(unsigned* bar, unsigned x, unsigned& nloc, unsigned& nx) {
    const unsigned G = gridDim.x * gridDim.y * gridDim.z;
    unsigned sum, cnt, mine, sp = 0u;
    for (;;) {
        sum = 0u; cnt = 0u; mine = 0u;
#pragma unroll
        for (unsigned j = 0; j < 16; ++j) { const unsigned c = xb_ld(&bar[XB_XCNT(j)]); sum += c; cnt += (c > 0u) ? 1u : 0u; mine = (j == x) ? c : mine; }
        if (sum == G) break;
        __builtin_amdgcn_s_sleep(1);
        if ((++sp & 255u) == 0u) { if (xb_ld(&bar[XB_TMO])) break; if (sp > XB_SPIN_CAP) { atomicAdd(&bar[XB_TMO], 1u); break; } }
    }
    nloc = mine > 0u ? mine : 1u; nx = cnt > 0u ? cnt : 1u;
}
__device__ __forceinline__ void xcd_barrier(const XcdBarrier& b, bool leader) {
    asm volatile("s_waitcnt vmcnt(0)" ::: "memory");
    __syncthreads();
    if (leader) {
        unsigned* bar = b.bar;
        __builtin_amdgcn_s_waitcnt(0);
        unsigned nloc = b.st[0], nx = b.st[1];
        if (nloc == 0u) { xcd_barrier_complete(bar, b.x, nloc, nx); b.st[0] = nloc; b.st[1] = nx; }
        const unsigned old = xb_add(&bar[XB_XSUB(b.x)], 1u);
        const unsigned gen = old / nloc;
        if (old + 1u == (gen + 1u) * nloc) {
            __builtin_amdgcn_fence(__ATOMIC_RELEASE, "agent");
            asm volatile("s_waitcnt vmcnt(0)" ::: "memory");
            const unsigned og = xb_add(&bar[XB_TOP], 1u);
            const unsigned tg = og / nx;
            if (og + 1u == (tg + 1u) * nx) xb_add(&bar[XB_TOPGEN], 1u);
            else XB_SPIN(xb_ld(&bar[XB_TOPGEN]) == tg, bar);
            __builtin_amdgcn_fence(__ATOMIC_ACQUIRE, "agent");
            xb_add(&bar[XB_XGEN(b.x)], 1u);
            asm volatile("s_waitcnt vmcnt(0)" ::: "memory");
        } else {
            XB_SPIN(xb_ld(&bar[XB_XGEN(b.x)]) == gen, bar);
            __builtin_amdgcn_fence(__ATOMIC_ACQUIRE, "agent");
            asm volatile("s_waitcnt vmcnt(0)" ::: "memory");
        }
    }
    __syncthreads();
}

typedef const __attribute__((address_space(4))) Args* KArgsPtr;
__device__ __forceinline__ Args load_args() {
#if defined(__HIP_DEVICE_COMPILE__)
    KArgsPtr p = (KArgsPtr)__builtin_amdgcn_kernarg_segment_ptr(); asm volatile("" : "+s"(p)); Args a;
    a.x = p->x; a.c = p->c; a.pos = p->pos; a.w_ada = p->w_ada; a.b_ada = p->b_ada; a.norm1_g = p->norm1_g; a.norm2_g = p->norm2_g; a.w_in = p->w_in; a.w_out = p->w_out; a.pool_w = p->pool_w;
    a.pool_scale = p->pool_scale; a.hgrn_g = p->hgrn_g; a.lb_logits = p->lb_logits; a.w_router = p->w_router; a.b_router = p->b_router; a.w1 = p->w1; a.b1 = p->b1; a.w2 = p->w2; a.b2 = p->b2; a.final_g = p->final_g;
    a.out = p->out; a.ws = p->ws; a.ph_lo = p->ph_lo; a.ph_hi = p->ph_hi; return a;
#else
    return Args{};
#endif
}
__device__ __forceinline__ int lane_id() { return __builtin_amdgcn_mbcnt_hi(~0u, __builtin_amdgcn_mbcnt_lo(~0u, 0)); }
__device__ __forceinline__ Ctx make_ctx(unsigned char* ws, int wv) {
    extern __shared__ __attribute__((aligned(16))) unsigned char lds_raw[];
    Ctx C; C.lds = (LAS unsigned char*)lds_raw; { int l_ = lane_id(); asm volatile("" : "+v"(l_)); C.lane = l_; } C.wave = wv; C.tid = wv * 64 + C.lane;
    C.G = gridDim.x; { const int bx = blockIdx.x; C.vcu = (C.G % 8 == 0) ? (bx % 8) * (C.G / 8) + bx / 8 : bx; }
    C.ws = ws; return C;
}
#ifndef PHASE_FN
#define PHASE_FN __device__ __forceinline__ void
#endif
#define GEMM_FN __device__ __forceinline__ void
PHASE_FN ph_prep(int wv) { const Args a = load_args(); Ctx C = make_ctx(a.ws, wv); phase_prep(a, C); }
PHASE_FN ph_u0(int wv) { const Args a = load_args(); Ctx C = make_ctx(a.ws, wv); phase_u0(a, C); }
GEMM_FN ph_gin(int l, int wv) { const Args a = load_args(); Ctx C = make_ctx(a.ws, wv); unsigned char* ws = a.ws;
    DenseOrder S{(const char*)(ws + WS_U), (const char*)(ws + WS_WIN) + (size_t)l * NPAD * 1024 * 2, NTOK / 256, NPAD / 256, (NTOK / 256) * (NPAD / 256), C.G, (int)blockIdx.x};
    EpiIn E{ws}; pg8::gemm_phase<EpiIn, DenseOrder, false, true>(C.lds, (LAS unsigned*)(C.lds + LDS_PARK), C.tid, S, E); }
PHASE_FN ph_mix1(int l, int wv) { const Args a = load_args(); Ctx C = make_ctx(a.ws, wv); phase_mix1(a, C, l); }
PHASE_FN ph_mix2(int l, int wv) { const Args a = load_args(); Ctx C = make_ctx(a.ws, wv); phase_mix2(a, C, l); }
GEMM_FN ph_gout(int l, int wv) { const Args a = load_args(); Ctx C = make_ctx(a.ws, wv); unsigned char* ws = a.ws;
    DenseOrder S{(const char*)(ws + WS_MIX), (const char*)(ws + WS_WOUT) + (size_t)l * 1024 * 1024 * 2, NTOK / 256, 4, (NTOK / 256) * 4, C.G, (int)blockIdx.x};
    EpiOut E{l == 0 ? a.x : (const float*)(ws + WS_H), (float*)(ws + WS_H), (const float*)(ws + WS_MOD) + (size_t)l * 4 * 6144 + 2048};
    pg8::gemm_phase<EpiOut, DenseOrder, false, true>(C.lds, (LAS unsigned*)(C.lds + LDS_PARK), C.tid, S, E); }
PHASE_FN ph_router(int l, int wv) { const Args a = load_args(); Ctx C = make_ctx(a.ws, wv); phase_router(a, C, l); }
GEMM_FN ph_g1(int l, int wv) { const Args a = load_args(); Ctx C = make_ctx(a.ws, wv); unsigned char* ws = a.ws;
    LAS int* tab = (LAS int*)(C.lds + LDS_TAB); moe_table(C, l, tab);
    MoeOrder<true> S{tab, (const char*)(ws + WS_U), (const char*)(ws + WS_W1) + (size_t)l * 32 * 2048 * 1024 * 2, (const int*)(ws + WS_ROWTOK), C.G, C.vcu};
    EpiG1 E{(bf16_t*)(ws + WS_ACT), a.b1 + (size_t)l * 32 * 2048}; pg8::gemm_phase<EpiG1, MoeOrder<true>, true, true>(C.lds, (LAS unsigned*)(C.lds + LDS_PARK), C.tid, S, E); }
GEMM_FN ph_g2(int l, int wv) { const Args a = load_args(); Ctx C = make_ctx(a.ws, wv); unsigned char* ws = a.ws;
    LAS int* tab = (LAS int*)(C.lds + LDS_TAB); moe_table(C, l, tab);
    MoeOrder<false> S{tab, (const char*)(ws + WS_ACT), (const char*)(ws + WS_W2) + (size_t)l * 32 * 1024 * 1024 * 2, nullptr, C.G, C.vcu};
    EpiG2 E{(bf16_t*)(ws + WS_Y), a.b2 + (size_t)l * 32 * 1024}; pg8::gemm_phase<EpiG2, MoeOrder<false>, false, true>(C.lds, (LAS unsigned*)(C.lds + LDS_PARK), C.tid, S, E); }
PHASE_FN ph_combine(int l, int wv) { const Args a = load_args(); Ctx C = make_ctx(a.ws, wv); phase_combine(a, C, l); }

constexpr int NPHASES = 2 + 8 * DEPTH;
__global__ void __launch_bounds__(NTHREADS, 2) mega_fwd(Args a) {
#if MK_ONE_LAUNCH == 1
    cg::grid_group grid = cg::this_grid();
#define SEAM() do { __syncthreads(); grid.sync(); } while (0)
#elif MK_ONE_LAUNCH == 2
    extern __shared__ __attribute__((aligned(16))) unsigned char lds_k[];
    volatile LAS unsigned* bst = (volatile LAS unsigned*)((LAS unsigned char*)lds_k + LDS_BYTES - 64);
    const bool leader = (threadIdx.x == 0);
    if (leader) { bst[0] = 0u; bst[1] = 0u; }
    __syncthreads();
    const XcdBarrier xbar = xcd_barrier_post((unsigned*)(a.ws + WS_CTL) + CW_BAR, bst, leader);
#define SEAM() xcd_barrier(xbar, leader)
#else
#define SEAM() do { } while (0)
#endif
    const int lo = a.ph_lo, hi = a.ph_hi;
    const int wv = __builtin_amdgcn_readfirstlane((int)threadIdx.x >> 6);
#ifndef KINDMASK
#define KINDMASK 0xffffu
#endif
#define KON(k) (((KINDMASK) >> (k)) & 1u)
#ifndef REP_ID
#define REP_ID -1
#endif
#define RUN(kind, id, call) do { if (KON(kind) && lo <= (id) && (id) < hi) { call; if ((id) == REP_ID) { __syncthreads(); call; } if ((id) + 1 < hi) SEAM(); } } while (0)
    RUN(0, 0, ph_prep(wv));
    RUN(1, 1, ph_u0(wv));
    RUN(2, 2, ph_gin(0, wv)); RUN(3, 3, ph_mix1(0, wv)); RUN(4, 4, ph_mix2(0, wv)); RUN(5, 5, ph_gout(0, wv)); RUN(6, 6, ph_router(0, wv)); RUN(7, 7, ph_g1(0, wv)); RUN(8, 8, ph_g2(0, wv)); RUN(9, 9, ph_combine(0, wv));
    RUN(2, 10, ph_gin(1, wv)); RUN(3, 11, ph_mix1(1, wv)); RUN(4, 12, ph_mix2(1, wv)); RUN(5, 13, ph_gout(1, wv)); RUN(6, 14, ph_router(1, wv)); RUN(7, 15, ph_g1(1, wv)); RUN(8, 16, ph_g2(1, wv)); RUN(9, 17, ph_combine(1, wv));
}

extern "C" void kernel_launch(void* const* d_in, const int* in_sizes, int n_in, void* d_out, int out_size, void* d_ws, size_t ws_size, hipStream_t stream) {
    static int grid = 0;
    if (grid == 0) {
        if (n_in != 20 || out_size != NTOK * D || ws_size < WS_END) { fprintf(stderr, "kernel_launch: unexpected shapes: n_in %d out %d ws %zu (need %zu)\n", n_in, out_size, ws_size, (size_t)WS_END); grid = -1; return; }
        int dev = 0, cus = 0, per_cu = 0;
        hipGetDevice(&dev); hipDeviceGetAttribute(&cus, hipDeviceAttributeMultiprocessorCount, dev);
        if (hipFuncSetAttribute((const void*)mega_fwd, hipFuncAttributeMaxDynamicSharedMemorySize, LDS_BYTES) != hipSuccess) { fprintf(stderr, "kernel_launch: hipFuncSetAttribute failed\n"); grid = -1; return; }
        hipOccupancyMaxActiveBlocksPerMultiprocessor(&per_cu, (const void*)mega_fwd, NTHREADS, LDS_BYTES);
        (void)hipGetLastError();
        if (per_cu < 1) fprintf(stderr, "kernel_launch: occupancy query says %d blocks per CU\n", per_cu);
        grid = cus;
    }
    if (grid < 0) return;
    hipMemsetAsync((char*)d_ws + WS_CTL, 0, CTL_BYTES, stream);
    Args a{};
    a.x = (const float*)d_in[0]; a.c = (const float*)d_in[1]; a.pos = (const int*)d_in[2]; a.w_ada = (const float*)d_in[3]; a.b_ada = (const float*)d_in[4];
    a.norm1_g = (const float*)d_in[5]; a.norm2_g = (const float*)d_in[6]; a.w_in = (const float*)d_in[7]; a.w_out = (const float*)d_in[8]; a.pool_w = (const float*)d_in[9];
    a.pool_scale = (const float*)d_in[10]; a.hgrn_g = (const float*)d_in[11]; a.lb_logits = (const float*)d_in[12]; a.w_router = (const float*)d_in[13]; a.b_router = (const float*)d_in[14];
    a.w1 = (const float*)d_in[15]; a.b1 = (const float*)d_in[16]; a.w2 = (const float*)d_in[17]; a.b2 = (const float*)d_in[18]; a.final_g = (const float*)d_in[19];
    a.out = (float*)d_out; a.ws = (unsigned char*)d_ws;
#if MK_ONE_LAUNCH == 1
    a.ph_lo = 0; a.ph_hi = NPHASES;
    void* args[] = {&a};
    hipError_t e = hipLaunchCooperativeKernel((const void*)mega_fwd, dim3(grid), dim3(NTHREADS), args, LDS_BYTES, stream);
    if (e != hipSuccess) fprintf(stderr, "cooperative launch failed: %s (grid %d)\n", hipGetErrorString(e), grid);
#elif MK_ONE_LAUNCH == 2
    a.ph_lo = 0; a.ph_hi = NPHASES;
    hipLaunchKernelGGL(mega_fwd, dim3(grid), dim3(NTHREADS), LDS_BYTES, stream, a);
#else
    for (int p = 0; p < NPHASES; ++p) { a.ph_lo = p; a.ph_hi = p + 1; hipLaunchKernelGGL(mega_fwd, dim3(grid), dim3(NTHREADS), LDS_BYTES, stream, a); }
#endif
}
```

```cpp
#include <hip/hip_runtime.h>
#include <hip/hip_cooperative_groups.h>
#include <cstdio>
#include <cstdint>
namespace cg = cooperative_groups;

#ifndef MK_ONE_LAUNCH
#define MK_ONE_LAUNCH 2
#endif

#define LAS __attribute__((address_space(3)))
typedef unsigned short bf16_t;
typedef short bf16x8 __attribute__((ext_vector_type(8)));
typedef float f32x4 __attribute__((ext_vector_type(4)));
typedef float f32x2 __attribute__((ext_vector_type(2)));
typedef unsigned u32x4 __attribute__((ext_vector_type(4)));
typedef unsigned u32x2 __attribute__((ext_vector_type(2)));

constexpr int D = 1024, NBATCH = 4, SEQ = 4096, NTOK = NBATCH * SEQ, DEPTH = 2;
constexpr int D_IN = 2372, NPAD = 2560;
constexpr int NE = 32, TOPK = 4, FF = 1024;
constexpr int NWAVES = 8, NTHREADS = 512;
constexpr float EPS = 1e-6f;
constexpr int ROWCAP = 73728;

constexpr size_t MiB = 1u << 20;
constexpr size_t WS_CTL = 0, CTL_BYTES = 1 * MiB;
constexpr size_t WS_MOD = 1 * MiB;
constexpr size_t WS_ROPEC = 2 * MiB;
constexpr size_t WS_ROPES = 4 * MiB;
constexpr size_t WS_WIN = 6 * MiB;
constexpr size_t WS_WOUT = 16 * MiB;
constexpr size_t WS_ROWTOK = 20 * MiB;
constexpr size_t WS_EIDX = 22 * MiB;
constexpr size_t WS_SLOT = 22 * MiB + 256 * 1024;
constexpr size_t WS_GATE = 22 * MiB + 512 * 1024;
constexpr size_t WS_WI = 23 * MiB;
constexpr size_t WS_WRH = 23 * MiB + 256 * 1024;
constexpr size_t WS_WRL = 23 * MiB + 512 * 1024;
constexpr size_t WS_KI = 24 * MiB;
constexpr size_t WS_K = 26 * MiB;
constexpr size_t WS_V = 30 * MiB;
constexpr size_t WS_QI = 34 * MiB;
constexpr size_t WS_Q = 42 * MiB;
constexpr size_t WS_UB = 58 * MiB;
constexpr size_t WS_HG = 74 * MiB;
constexpr size_t WS_SEL = 138 * MiB;
constexpr size_t WS_HL = 154 * MiB;
constexpr size_t WS_HD = 170 * MiB;
constexpr size_t WS_MIX = 171 * MiB;
constexpr size_t WS_U = 203 * MiB;
constexpr size_t WS_H = 235 * MiB;
constexpr size_t WS_W1 = 299 * MiB;
constexpr size_t WS_W2 = 555 * MiB;
constexpr size_t WS_ACT = 683 * MiB;
constexpr size_t WS_Y = 827 * MiB;
constexpr size_t WS_END = 971 * MiB;
constexpr int CW_CNT = 1024;
constexpr int CW_BAR = 8192;

constexpr int LDS_BYTES = 147456;
constexpr int LDS_TAB = 131072;
constexpr int LDS_PARK = 131072 + 1024;

__device__ __forceinline__ unsigned f2bf(float f) { unsigned u = __builtin_bit_cast(unsigned, f); return (u + 0x7fffu + ((u >> 16) & 1u)) >> 16; }
typedef __bf16 bf16x2_t __attribute__((ext_vector_type(2)));
__device__ __forceinline__ unsigned cvt_pk_bf16(float lo, float hi) { const f32x2 v = {lo, hi}; const bf16x2_t b = __builtin_convertvector(v, bf16x2_t); return __builtin_bit_cast(unsigned, b); }
__device__ __forceinline__ unsigned pk2(float lo, float hi) { return cvt_pk_bf16(lo, hi); }
__device__ __forceinline__ float bf2f(unsigned short b) { return __builtin_bit_cast(float, ((unsigned)b) << 16); }
__device__ __forceinline__ float bflo(unsigned w) { return __builtin_bit_cast(float, w << 16); }
__device__ __forceinline__ float bfhi(unsigned w) { return __builtin_bit_cast(float, w & 0xffff0000u); }
__device__ __forceinline__ float wave_sum(float v) {
#pragma unroll
    for (int o = 1; o < 64; o <<= 1) v += __shfl_xor(v, o);
    return v;
}
__device__ __forceinline__ float wave_max(float v) {
#pragma unroll
    for (int o = 1; o < 64; o <<= 1) v = fmaxf(v, __shfl_xor(v, o));
    return v;
}
__device__ __forceinline__ float sigmoidf_(float z) { return __builtin_amdgcn_rcpf(1.0f + __expf(-z)); }
__device__ __forceinline__ float siluf_(float z) { return z * __builtin_amdgcn_rcpf(1.0f + __expf(-z)); }

namespace pg8 {
constexpr int BM = 256, BK = 64, HALF = 128, HTB = HALF * BK * 2, STAGE_BYTES = 8 * HTB;
constexpr int KD = 1024, NKT = KD / BK;
__host__ __device__ __forceinline__ int lds_byte(int r, int c) { const int st = (r >> 4) * 2 + (c >> 5), rr = r & 15, cc = c & 31, ob = rr * 64 + cc * 2; return st * 1024 + (ob ^ (((ob >> 9) & 1) << 5)); }
__host__ __device__ __forceinline__ void stage_rc(int b, int& R, int& C) { const int st = b / 1024, sb = b % 1024, swz = sb ^ (((sb >> 9) & 1) << 5); R = (st >> 1) * 16 + swz / 64; C = (st & 1) * 32 + (swz % 64) / 2; }

struct Unit { const char* A; const char* B; const int* ridx; int nvalid; int row0, pn, e, b; };

template <class Epi, class Sched, bool GATHER, bool ALIGN_EPI>
__device__ __forceinline__ void gemm_phase(LAS unsigned char* lds, LAS unsigned* park, int tid_in, const Sched& S, const Epi& E) {
    const int tid = tid_in, wid = __builtin_amdgcn_readfirstlane(tid >> 6), lane = tid & 63, wr = wid >> 2, wc = wid & 3, fr = lane & 15, fq = lane >> 4;
    constexpr int K = KD, nt = NKT;
    unsigned voffB[2], vA[2][2];
#pragma unroll
    for (int i = 0; i < 2; ++i) { int R, C; stage_rc(tid * 16 + i * 8192, R, C); voffB[i] = (unsigned)(R * K + C) * 2u; }
    constexpr size_t kstep = (size_t)(BK * 2);
    constexpr size_t hstep = (size_t)HALF * K * 2;
    const unsigned ldsw = (unsigned)wid * 1024u;
    const int aoff = lds_byte(wr * 64 + fr, fq * 8), boff = lds_byte(wc * 32 + fr, fq * 8);
#define PG8_SA(b, h) (((b) * 2 + (h)) * HTB)
#define PG8_SB(b, h) ((4 + (b) * 2 + (h)) * HTB)
#define PG8_STAGE(bufoff, gbase, voff) do { _Pragma("unroll") for (int _i = 0; _i < 2; ++_i) \
        __builtin_amdgcn_global_load_lds((const unsigned*)((const char*)(gbase) + (voff)[_i]), (LAS unsigned*)(lds + (bufoff) + ldsw + _i * 8192), 16, 0, 0); } while (0)
#define PG8_LDA(dst, b, h) do { _Pragma("unroll") for (int m = 0; m < 4; ++m) _Pragma("unroll") for (int k = 0; k < 2; ++k) dst[m][k] = *(const LAS bf16x8*)(lds + PG8_SA(b, h) + aoff + m * 2048 + k * 1024); } while (0)
#define PG8_LDB(dst, b, h) do { _Pragma("unroll") for (int n = 0; n < 2; ++n) _Pragma("unroll") for (int k = 0; k < 2; ++k) dst[n][k] = *(const LAS bf16x8*)(lds + PG8_SB(b, h) + boff + n * 2048 + k * 1024); } while (0)
#define PG8_MMA(ai, bj, At, Bt) do { __builtin_amdgcn_s_setprio(1); _Pragma("unroll") for (int m = 0; m < 4; ++m) _Pragma("unroll") for (int n = 0; n < 2; ++n) _Pragma("unroll") for (int k = 0; k < 2; ++k) \
        acc[ai][bj][m][n] = __builtin_amdgcn_mfma_f32_16x16x32_bf16(Bt[n][k], At[m][k], acc[ai][bj][m][n], 0, 0, 0); __builtin_amdgcn_s_setprio(0); } while (0)
#define PG8_WAIT_V(n) asm volatile("s_waitcnt vmcnt(" #n ")" ::: "memory")
#define PG8_WAIT_L(n) asm volatile("s_waitcnt lgkmcnt(" #n ")" ::: "memory")
#define PG8_BAR __builtin_amdgcn_s_barrier()
#define PG8_SCHED __builtin_amdgcn_sched_barrier(0)
#define PG8_OFFS(dst, u) do { _Pragma("unroll") for (int _h = 0; _h < 2; ++_h) _Pragma("unroll") for (int _i = 0; _i < 2; ++_i) { \
        int _R, _C; stage_rc(tid * 16 + _i * 8192, _R, _C); const int _rr = _h * HALF + _R; \
        if constexpr (GATHER) { const int _ix = (u).ridx[_rr < (u).nvalid ? _rr : 0]; dst[_h][_i] = (unsigned)(_ix * K + _C) * 2u; } \
        else dst[_h][_i] = (unsigned)(_rr * K + _C) * 2u; } } while (0)
    Unit cur, nxt; int ui = 0;
    if (!S.next(0, cur)) return;
    f32x4 acc[2][2][4][2];
#pragma unroll
    for (int a = 0; a < 2; ++a)
#pragma unroll
        for (int b = 0; b < 2; ++b)
#pragma unroll
            for (int m = 0; m < 4; ++m)
#pragma unroll
                for (int n = 0; n < 2; ++n) acc[a][b][m][n] = (f32x4){0.f, 0.f, 0.f, 0.f};
    bf16x8 At[4][2], B0[2][2], B1[2][2];
    PG8_OFFS(vA, cur);
    const char* cA = cur.A; const char* cB = cur.B;
    PG8_STAGE(PG8_SB(0, 0), cB, voffB); PG8_STAGE(PG8_SB(0, 1), cB + hstep, voffB); PG8_STAGE(PG8_SA(0, 0), cA, vA[0]); PG8_STAGE(PG8_SA(0, 1), cA, vA[1]);
    if (wr == 1) PG8_BAR;
    PG8_WAIT_V(2); PG8_BAR;
    PG8_STAGE(PG8_SB(1, 0), cB + kstep, voffB); PG8_STAGE(PG8_SA(1, 0), cA + kstep, vA[0]); PG8_STAGE(PG8_SB(1, 1), cB + hstep + kstep, voffB);
    PG8_WAIT_V(6); PG8_BAR;
    for (;;) {
        const bool has_next = S.next(ui + 1, nxt);
        const char* nA = has_next ? nxt.A : cA; const char* nB = has_next ? nxt.B : cB;
        if constexpr (GATHER) {
            unsigned nv[2][2];
            if (has_next) { PG8_OFFS(nv, nxt); } else {
#pragma unroll
                for (int h = 0; h < 2; ++h) { nv[h][0] = vA[h][0]; nv[h][1] = vA[h][1]; } }
            *(LAS u32x4*)(park + tid * 4) = (u32x4){nv[0][0], nv[0][1], nv[1][0], nv[1][1]};
        }
        for (int t = 0; t < nt; t += 2) {
            const bool last = (t == nt - 2);
            const char* a1 = cA + (size_t)(t + 1) * kstep;
            const char* a2 = last ? nA : cA + (size_t)(t + 2) * kstep; const char* b2 = last ? nB : cB + (size_t)(t + 2) * kstep;
            const char* a3 = a2 + kstep; const char* b3 = b2 + kstep;
            PG8_LDB(B0, 0, 0); PG8_LDB(B1, 0, 1); PG8_SCHED; PG8_LDA(At, 0, 0); PG8_STAGE(PG8_SA(1, 1), a1, vA[1]);
            if constexpr (GATHER) { if (last) { const u32x4 pv = *(const LAS u32x4*)(park + tid * 4); vA[0][0] = pv.x; vA[0][1] = pv.y; vA[1][0] = pv.z; vA[1][1] = pv.w; } }
            PG8_WAIT_V(8); PG8_WAIT_L(0); PG8_BAR; PG8_MMA(0, 0, At, B0); PG8_MMA(0, 1, At, B1); PG8_BAR; PG8_SCHED;
            PG8_LDA(At, 0, 1); PG8_STAGE(PG8_SB(0, 0), b2, voffB); PG8_STAGE(PG8_SB(0, 1), b2 + hstep, voffB); PG8_STAGE(PG8_SA(0, 0), a2, vA[0]);
            PG8_WAIT_V(8); PG8_WAIT_L(0); PG8_BAR; PG8_MMA(1, 0, At, B0); PG8_MMA(1, 1, At, B1); PG8_BAR; PG8_SCHED;
            PG8_LDB(B0, 1, 0); PG8_LDB(B1, 1, 1); PG8_SCHED; PG8_LDA(At, 1, 0); PG8_STAGE(PG8_SA(0, 1), a2, vA[1]);
            PG8_WAIT_V(8); PG8_WAIT_L(0); PG8_BAR; PG8_MMA(0, 0, At, B0); PG8_MMA(0, 1, At, B1); PG8_BAR; PG8_SCHED;
            PG8_LDA(At, 1, 1); PG8_STAGE(PG8_SB(1, 0), b3, voffB); PG8_STAGE(PG8_SB(1, 1), b3 + hstep, voffB); PG8_STAGE(PG8_SA(1, 0), a3, vA[0]);
            PG8_WAIT_V(8); PG8_WAIT_L(0); PG8_BAR; PG8_MMA(1, 0, At, B0); PG8_MMA(1, 1, At, B1); PG8_BAR; PG8_SCHED;
        }
        if constexpr (ALIGN_EPI) { if (wr == 0) PG8_BAR; }
#ifndef EPIREP
#define EPIREP 1
#endif
        for (int er = 0; er < Epi::REP; ++er) { int fr2 = fr, fq2 = fq; asm volatile("" : "+v"(fr2), "+v"(fq2)); E(acc, cur, wr, wc, fr2, fq2); }
        if (!has_next) break;
#pragma unroll
        for (int a = 0; a < 2; ++a)
#pragma unroll
            for (int b = 0; b < 2; ++b)
#pragma unroll
                for (int m = 0; m < 4; ++m)
#pragma unroll
                    for (int n = 0; n < 2; ++n) acc[a][b][m][n] = (f32x4){0.f, 0.f, 0.f, 0.f};
        cur = nxt; cA = nA; cB = nB; ++ui;
        if constexpr (ALIGN_EPI) { if (wr == 1) PG8_BAR; }
    }
    PG8_WAIT_V(0);
    if constexpr (!ALIGN_EPI) { if (wr == 0) PG8_BAR; }
    PG8_BAR;
#undef PG8_SA
#undef PG8_SB
#undef PG8_STAGE
#undef PG8_LDA
#undef PG8_LDB
#undef PG8_MMA
#undef PG8_WAIT_V
#undef PG8_WAIT_L
#undef PG8_BAR
#undef PG8_SCHED
#undef PG8_OFFS
}
}

struct Args {
    const float* x; const float* c; const int* pos; const float* w_ada; const float* b_ada; const float* norm1_g; const float* norm2_g;
    const float* w_in; const float* w_out; const float* pool_w; const float* pool_scale; const float* hgrn_g; const float* lb_logits;
    const float* w_router; const float* b_router; const float* w1; const float* b1; const float* w2; const float* b2; const float* final_g;
    float* out; unsigned char* ws; int ph_lo, ph_hi;
};

struct Ctx {
    LAS unsigned char* lds;
    int tid, lane, wave, G, vcu;
    unsigned char* ws;
};

struct DenseOrder {
    const char* A; const char* B; int nM, nN, nwg, G, c;
    __device__ __forceinline__ bool next(int i, pg8::Unit& u) const {
        const long L = (long)i * G + c; if (L >= nwg) return false;
        int wgid = (int)L; { const int q = nwg / 8, r = nwg % 8, xcd = wgid % 8, off = wgid / 8; wgid = (xcd < r ? xcd * (q + 1) : r * (q + 1) + (xcd - r) * q) + off; }
        const int nig = 8 * nN, gid = wgid / nig, fm = gid * 8, gsz = (nM - fm) < 8 ? (nM - fm) : 8;
        const int pm = fm + ((wgid % nig) % gsz), pn = (wgid % nig) / gsz;
        u.A = A + (size_t)pm * 256 * pg8::KD * 2; u.B = B + (size_t)pn * 256 * pg8::KD * 2; u.ridx = nullptr; u.nvalid = 256; u.row0 = pm * 256; u.pn = pn; u.e = 0; u.b = pm >> 4;
        return true;
    }
};

template <bool FIRST> struct MoeOrder {
    LAS const int* tab; const char* A; const char* B; const int* rowtok; int G, c;
    static constexpr int NTN = FIRST ? 8 : 4;
    __device__ __forceinline__ bool next(int i, pg8::Unit& u) const {
#ifndef KREP
#define KREP 1
#endif
        const int P = tab[32]; const long L = (long)(i / (FIRST ? 1 : KREP)) * G + c; if (L >= (long)P * NTN) return false;
        const int p = (int)(L / NTN), nt = (int)(L % NTN);
        int e = 0;
#pragma unroll 1
        for (int k = 1; k < 32; ++k) e = (tab[k] <= p) ? k : e;
        const int mt = p - tab[e], cnt = tab[33 + e];
        if (FIRST) { u.A = A; u.ridx = rowtok + e * NTOK + mt * 256; u.nvalid = (cnt - mt * 256) < 256 ? (cnt - mt * 256) : 256; u.B = B + ((size_t)e * 2048 + nt * 256) * pg8::KD * 2; }
        else { u.A = A + (size_t)p * 256 * pg8::KD * 2; u.ridx = nullptr; u.nvalid = 256; u.B = B + ((size_t)e * 1024 + nt * 256) * pg8::KD * 2; }
        u.row0 = p * 256; u.pn = nt; u.e = e; u.b = (FIRST ? 1 : ((i % KREP) == KREP - 1));
        return true;
    }
};

#ifndef EPIREP_IN
#define EPIREP_IN 1
#endif
#ifndef EPIREP_G1
#define EPIREP_G1 1
#endif
#ifndef EPIREP_G2
#define EPIREP_G2 1
#endif
struct EpiIn {
    static constexpr int REP = EPIREP_IN;
    unsigned char* ws;
    __device__ __forceinline__ void operator()(const f32x4 (&acc)[2][2][4][2], const pg8::Unit& u, int wr, int wc, int fr, int fq) const {
        const int pn = u.pn;
        const float* rc = (const float*)(ws + WS_ROPEC); const float* rs = (const float*)(ws + WS_ROPES);
        const bool rope = (pn <= 1) || (pn == 3) || (pn == 2 && wc < 2) || (pn == 4 && wc == 0);
#pragma unroll
        for (int ai = 0; ai < 2; ++ai)
#pragma unroll
            for (int m = 0; m < 4; ++m) {
                const int r = u.row0 + ai * 128 + wr * 64 + m * 16 + fr;
                if (rope) {
                    bf16_t* dst; float scl = 1.f;
                    if (pn <= 1) { dst = (bf16_t*)(ws + WS_Q) + (size_t)r * 512 + (pn * 4 + wc) * 64; scl = 0.125f; }
                    else if (pn == 2) dst = (bf16_t*)(ws + WS_K) + (size_t)r * 128 + wc * 64;
                    else if (pn == 3) dst = (bf16_t*)(ws + WS_QI) + (size_t)r * 256 + wc * 64;
                    else dst = (bf16_t*)(ws + WS_KI) + (size_t)r * 64;
                    const f32x4 c0 = *(const f32x4*)(rc + (size_t)r * 32 + 8 * fq), c1 = *(const f32x4*)(rc + (size_t)r * 32 + 8 * fq + 4), s0 = *(const f32x4*)(rs + (size_t)r * 32 + 8 * fq), s1 = *(const f32x4*)(rs + (size_t)r * 32 + 8 * fq + 4);
                    const f32x4 x10 = acc[ai][0][m][0], x11 = acc[ai][0][m][1], x20 = acc[ai][1][m][0], x21 = acc[ai][1][m][1];
                    const f32x4 o10 = (x10 * c0 - x20 * s0) * scl, o11 = (x11 * c1 - x21 * s1) * scl, o20 = (x20 * c0 + x10 * s0) * scl, o21 = (x21 * c1 + x11 * s1) * scl;
                    u32x4 w1v, w2v; w1v.x = pk2(o10[0], o10[1]); w1v.y = pk2(o10[2], o10[3]); w1v.z = pk2(o11[0], o11[1]); w1v.w = pk2(o11[2], o11[3]);
                    w2v.x = pk2(o20[0], o20[1]); w2v.y = pk2(o20[2], o20[3]); w2v.z = pk2(o21[0], o21[1]); w2v.w = pk2(o21[2], o21[3]);
                    *(u32x4*)(dst + 8 * fq) = w1v; *(u32x4*)(dst + 32 + 8 * fq) = w2v;
                } else if (pn == 2) {
#pragma unroll
                    for (int bj = 0; bj < 2; ++bj) { const f32x4 a0 = acc[ai][bj][m][0], a1 = acc[ai][bj][m][1]; u32x4 w; w.x = pk2(a0[0], a0[1]); w.y = pk2(a0[2], a0[3]); w.z = pk2(a1[0], a1[1]); w.w = pk2(a1[2], a1[3]);
                        *(u32x4*)((bf16_t*)(ws + WS_V) + (size_t)r * 128 + bj * 64 + (wc - 2) * 32 + 8 * fq) = w; }
                } else if (pn == 4) {
                    if (wc == 1 && fq == 0) *(f32x4*)((float*)(ws + WS_WI) + (size_t)r * 4) = acc[ai][0][m][0] * 0.0625f;
                } else {
                    float* p = (pn == 5) ? (float*)(ws + WS_UB) + (size_t)r * 256 + wc * 32 + 8 * fq : (float*)(ws + WS_HG) + (size_t)r * 1024 + (pn - 6) * 256 + wc * 32 + 8 * fq;
#pragma unroll
                    for (int bj = 0; bj < 2; ++bj) { *(f32x4*)(p + bj * 128) = acc[ai][bj][m][0]; *(f32x4*)(p + bj * 128 + 4) = acc[ai][bj][m][1]; }
                }
            }
    }
};
struct EpiOut {
    static constexpr int REP = 1;
    const float* hin; float* hout; const float* gate;
    __device__ __forceinline__ void operator()(const f32x4 (&acc)[2][2][4][2], const pg8::Unit& u, int wr, int wc, int fr, int fq) const {
        const int col0 = u.pn * 256 + wc * 32 + 8 * fq; const float* gp = gate + (size_t)u.b * 6144 + col0;
        f32x4 gv[2][2];
#pragma unroll
        for (int bj = 0; bj < 2; ++bj)
#pragma unroll
            for (int n = 0; n < 2; ++n) gv[bj][n] = *(const f32x4*)(gp + bj * 128 + n * 4);
#pragma unroll
        for (int ai = 0; ai < 2; ++ai)
#pragma unroll
            for (int m = 0; m < 4; ++m) { const size_t off = (size_t)(u.row0 + ai * 128 + wr * 64 + m * 16 + fr) * D + col0;
#pragma unroll
                for (int bj = 0; bj < 2; ++bj)
#pragma unroll
                    for (int n = 0; n < 2; ++n) { const f32x4 hv = *(const f32x4*)(hin + off + bj * 128 + n * 4); *(f32x4*)(hout + off + bj * 128 + n * 4) = hv + gv[bj][n] * acc[ai][bj][m][n]; }
                asm volatile("" ::: "memory"); }
    }
};
struct EpiG1 {
    static constexpr int REP = EPIREP_G1;
    bf16_t* act; const float* b1l;
    __device__ __forceinline__ void operator()(const f32x4 (&acc)[2][2][4][2], const pg8::Unit& u, int wr, int wc, int fr, int fq) const {
        const int ja0 = u.pn * 128 + wc * 32 + 8 * fq; const float* bp = b1l + (size_t)u.e * 2048 + 2 * ja0;
        f32x4 bg[2], bl[2];
#pragma unroll
        for (int n = 0; n < 2; ++n) { const f32x4 t0 = *(const f32x4*)(bp + 8 * n), t1 = *(const f32x4*)(bp + 8 * n + 4); bg[n] = (f32x4){t0[0], t0[2], t1[0], t1[2]}; bl[n] = (f32x4){t0[1], t0[3], t1[1], t1[3]}; }
#pragma unroll
        for (int ai = 0; ai < 2; ++ai)
#pragma unroll
            for (int m = 0; m < 4; ++m) { float o[8];
#pragma unroll
                for (int n = 0; n < 2; ++n) { const f32x4 hg = acc[ai][0][m][n] + bg[n], hl = acc[ai][1][m][n] + bl[n];
#pragma unroll
                    for (int j = 0; j < 4; ++j) { const float xg = fminf(hg[j], 7.0f), xl = fminf(fmaxf(hl[j], -7.0f), 7.0f); o[4 * n + j] = xg * sigmoidf_(1.702f * xg) * (xl + 1.0f); } }
                u32x4 w; w.x = pk2(o[0], o[1]); w.y = pk2(o[2], o[3]); w.z = pk2(o[4], o[5]); w.w = pk2(o[6], o[7]);
                *(u32x4*)(act + (size_t)(u.row0 + ai * 128 + wr * 64 + m * 16 + fr) * FF + ja0) = w; }
    }
};
struct EpiG2 {
    static constexpr int REP = EPIREP_G2;
    bf16_t* y; const float* b2l;
    __device__ __forceinline__ void operator()(const f32x4 (&acc)[2][2][4][2], const pg8::Unit& u, int wr, int wc, int fr, int fq) const {
        if (!u.b) return;
        const int col0 = u.pn * 256 + wc * 32 + 8 * fq; const float* bp = b2l + (size_t)u.e * 1024 + col0;
        f32x4 bv[2][2];
#pragma unroll
        for (int bj = 0; bj < 2; ++bj)
#pragma unroll
            for (int n = 0; n < 2; ++n) bv[bj][n] = *(const f32x4*)(bp + bj * 128 + n * 4);
#pragma unroll
        for (int ai = 0; ai < 2; ++ai)
#pragma unroll
            for (int m = 0; m < 4; ++m) { bf16_t* rowp = y + (size_t)(u.row0 + ai * 128 + wr * 64 + m * 16 + fr) * D + col0;
#pragma unroll
                for (int bj = 0; bj < 2; ++bj) { const f32x4 v0 = acc[ai][bj][m][0] + bv[bj][0], v1 = acc[ai][bj][m][1] + bv[bj][1];
                    u32x4 w; w.x = pk2(v0[0], v0[1]); w.y = pk2(v0[2], v0[3]); w.z = pk2(v1[0], v1[1]); w.w = pk2(v1[2], v1[3]); *(u32x4*)(rowp + bj * 128) = w; } }
    }
};
__device__ __forceinline__ int slot32(int d) { return 16 * ((d >> 2) & 1) + 4 * ((d >> 3) & 3) + (d & 3); }
__device__ __forceinline__ int win_dest(int s) {
    if (s < 512) { const int hd = s >> 6, d64 = s & 63; return 256 * (hd >> 2) + 128 * (d64 >> 5) + 32 * (hd & 3) + slot32(d64 & 31); }
    if (s < 640) { const int hd = (s - 512) >> 6, d64 = s & 63; return 512 + 128 * (d64 >> 5) + 32 * hd + slot32(d64 & 31); }
    if (s < 768) { const int v = s - 640; return 512 + 128 * (v >> 6) + 32 * (2 + ((v & 63) >> 5)) + slot32(v & 31); }
    if (s < 1024) { const int hd = (s - 768) >> 6, d64 = s & 63; return 768 + 128 * (d64 >> 5) + 32 * hd + slot32(d64 & 31); }
    if (s < 1088) { const int d64 = s - 1024; return 1024 + 128 * (d64 >> 5) + slot32(d64 & 31); }
    if (s < 1092) return 1024 + 32 + (s - 1088);
    if (s < 1348) { const int v = s - 1092; return 1280 + (v & ~31) + slot32(v & 31); }
    { const int v = s - 1348; return 1536 + (v & ~31) + slot32(v & 31); }
}
__device__ __forceinline__ int perm_dest(int s) { return (s & ~31) + 16 * ((s >> 2) & 1) + 4 * ((s >> 3) & 3) + (s & 3); }
__device__ __forceinline__ int w1_dest(int s) { const int jg = s >> 1, isl = s & 1, nt = jg >> 7, ja = jg & 127; return 256 * nt + 128 * isl + (ja & ~31) + slot32(ja & 31); }

template <int MAP>
__device__ __forceinline__ void transpose_item(const float* W, int N, bf16_t* WT, LAS float* scr, int kb, int nb, int lane) {
    const int k0 = 64 * kb, n0 = 32 * nb, col = n0 + (lane & 31); const bool ok = col < N;
    float v[32];
    const float* src = W + (size_t)(k0 + (lane >> 5)) * N + (ok ? col : 0);
#pragma unroll
    for (int i = 0; i < 32; ++i) v[i] = src[(size_t)(2 * i) * N];
#pragma unroll
    for (int i = 0; i < 32; ++i) scr[(2 * i + (lane >> 5)) * 33 + (lane & 31)] = ok ? v[i] : 0.f;
    asm volatile("s_waitcnt lgkmcnt(0)" ::: "memory");
    const int c = lane & 7;
#pragma unroll
    for (int j = 0; j < 4; ++j) { const int n = (lane >> 3) + 8 * j; const LAS float* s = scr + (8 * c) * 33 + n;
        u32x4 o; o.x = pk2(s[0 * 33], s[1 * 33]); o.y = pk2(s[2 * 33], s[3 * 33]); o.z = pk2(s[4 * 33], s[5 * 33]); o.w = pk2(s[6 * 33], s[7 * 33]);
        const int sc = n0 + n;
        if (sc < N) { const int dest = MAP == 1 ? win_dest(sc) : (MAP == 2 ? w1_dest(sc) : (MAP == 3 ? perm_dest(sc) : sc)); *(u32x4*)(WT + (size_t)dest * 1024 + k0 + 8 * c) = o; } }
    asm volatile("s_waitcnt lgkmcnt(0)" ::: "memory");
}

__device__ __forceinline__ void phase_prep(const Args& a, Ctx& C) {
    unsigned char* ws = C.ws;
    {
        LAS float* ca = (LAS float*)C.lds;
        LAS float* red = ca + 4096;
        for (int i = C.tid; i < 4096; i += NTHREADS) { const float v = a.c[i]; ca[i] = siluf_(v); }
        __syncthreads();
        for (int it = blockIdx.x; it < 192; it += C.G) {
            const int l = it / 96, cb = it % 96, col = cb * 64 + (C.tid & 63), kg = C.tid >> 6;
            const float* w = a.w_ada + (size_t)l * 1024 * 6144 + col;
            float s0 = 0.f, s1 = 0.f, s2 = 0.f, s3 = 0.f;
#pragma unroll 8
            for (int k = kg * 128; k < kg * 128 + 128; ++k) { const float wv = w[(size_t)k * 6144]; s0 += ca[k] * wv; s1 += ca[1024 + k] * wv; s2 += ca[2048 + k] * wv; s3 += ca[3072 + k] * wv; }
            red[(kg * 4 + 0) * 64 + (C.tid & 63)] = s0; red[(kg * 4 + 1) * 64 + (C.tid & 63)] = s1; red[(kg * 4 + 2) * 64 + (C.tid & 63)] = s2; red[(kg * 4 + 3) * 64 + (C.tid & 63)] = s3;
            __syncthreads();
            if (C.tid < 256) { const int b = C.tid >> 6, cc = C.tid & 63; float s = 0.f;
#pragma unroll
                for (int g = 0; g < 8; ++g) s += red[(g * 4 + b) * 64 + cc];
                ((float*)(ws + WS_MOD))[(size_t)(l * 4 + b) * 6144 + cb * 64 + cc] = s + a.b_ada[l * 6144 + cb * 64 + cc]; }
            __syncthreads();
        }
    }
    const int gw = C.vcu * NWAVES + C.wave, NGW = C.G * NWAVES;
    for (int tk = gw; tk < NTOK; tk += NGW) {
        if (C.lane < 32) {
            const float posf = (float)a.pos[tk];
            const float inv = exp2f(-(float)C.lane * (13.287712379549449f / 32.0f));
            const double ang = (double)(posf * inv);
            const double kq = rint(ang * 0.63661977236758134308);
            const double y = fma(-kq, 1.57079632679489661923, ang);
            const double y2 = y * y;
            const double sy = y * (1.0 + y2 * (-1.0 / 6 + y2 * (1.0 / 120 + y2 * (-1.0 / 5040 + y2 * (1.0 / 362880 - y2 * (1.0 / 39916800))))));
            const double cy = 1.0 + y2 * (-0.5 + y2 * (1.0 / 24 + y2 * (-1.0 / 720 + y2 * (1.0 / 40320 + y2 * (-1.0 / 3628800 + y2 * (1.0 / 479001600))))));
            const int q = ((int)((long long)kq)) & 3;
            const double sn = (q == 0) ? sy : (q == 1) ? cy : (q == 2) ? -sy : -cy;
            const double cs = (q == 0) ? cy : (q == 1) ? -sy : (q == 2) ? -cy : sy;
            ((float*)(ws + WS_ROPEC))[(size_t)tk * 32 + C.lane] = (float)cs;
            ((float*)(ws + WS_ROPES))[(size_t)tk * 32 + C.lane] = (float)sn;
        }
    }
    for (int i = gw * 64 + C.lane; i < 2 * 32 * 1024; i += NGW * 64) { const int l = i >> 15, e = (i >> 10) & 31, k = i & 1023; const float wv = a.w_router[(size_t)l * 32768 + k * 32 + e];
        const unsigned hi = f2bf(wv); const float lo = wv - bf2f((unsigned short)hi); ((bf16_t*)(ws + WS_WRH))[i] = (bf16_t)hi; ((bf16_t*)(ws + WS_WRL))[i] = (bf16_t)f2bf(lo); }
    LAS float* scr = (LAS float*)(C.lds + C.wave * 16384);
    constexpr int I_IN = 2 * 16 * 75, I_OUT = 2 * 16 * 32, I_W1 = 64 * 16 * 64, I_W2 = 64 * 16 * 32;
    for (int it = gw; it < I_IN + I_OUT + I_W1 + I_W2; it += NGW) {
        int r = it;
        if (r < I_IN) { const int l = r / (16 * 75), q = r % (16 * 75); transpose_item<1>(a.w_in + (size_t)l * 1024 * D_IN, D_IN, (bf16_t*)(ws + WS_WIN) + (size_t)l * NPAD * 1024, scr, q / 75, q % 75, C.lane); continue; }
        r -= I_IN;
        if (r < I_OUT) { const int l = r / (16 * 32), q = r % (16 * 32); transpose_item<3>(a.w_out + (size_t)l * 1024 * 1024, 1024, (bf16_t*)(ws + WS_WOUT) + (size_t)l * 1024 * 1024, scr, q / 32, q % 32, C.lane); continue; }
        r -= I_OUT;
        if (r < I_W1) { const int le = r / (16 * 64), q = r % (16 * 64); transpose_item<2>(a.w1 + (size_t)le * 1024 * 2048, 2048, (bf16_t*)(ws + WS_W1) + (size_t)le * 2048 * 1024, scr, q / 64, q % 64, C.lane); continue; }
        r -= I_W1;
        { const int le = r / (16 * 32), q = r % (16 * 32); transpose_item<3>(a.w2 + (size_t)le * 1024 * 1024, 1024, (bf16_t*)(ws + WS_W2) + (size_t)le * 1024 * 1024, scr, q / 32, q % 32, C.lane); }
    }
}

__device__ __forceinline__ void norm_mod_store(const f32x4 (&v)[4], const float* g, const float* sh, const float* sc, bf16_t* urow, int lane) {
    float ss = 0.f;
#pragma unroll
    for (int j = 0; j < 4; ++j) ss += (v[j].x * v[j].x + v[j].y * v[j].y) + (v[j].z * v[j].z + v[j].w * v[j].w);
    const float rstd = 1.0f / sqrtf(wave_sum(ss) * (1.0f / D) + EPS);
#pragma unroll
    for (int j = 0; j < 4; ++j) { const int idx = 4 * lane + 256 * j; const f32x4 gv = *(const f32x4*)(g + idx), shv = *(const f32x4*)(sh + idx), scv = *(const f32x4*)(sc + idx);
        const f32x4 o = v[j] * rstd * gv * (scv + 1.0f) + shv; u32x2 w; w.x = pk2(o[0], o[1]); w.y = pk2(o[2], o[3]); *(u32x2*)(urow + idx) = w; }
}

__device__ __forceinline__ void phase_u0(const Args& a, Ctx& C) {
    const int gw = C.vcu * NWAVES + C.wave, NGW = C.G * NWAVES; const float* mod = (const float*)(C.ws + WS_MOD);
    for (int tk = gw; tk < NTOK; tk += NGW) {
        const int b = tk >> 12; const f32x4* xr = (const f32x4*)(a.x + (size_t)tk * D) + C.lane; f32x4 v[4];
#pragma unroll
        for (int j = 0; j < 4; ++j) v[j] = xr[64 * j];
        const float* mb = mod + (size_t)(0 * 4 + b) * 6144;
        norm_mod_store(v, a.norm1_g, mb + 0, mb + 1024, (bf16_t*)(C.ws + WS_U) + (size_t)tk * D, C.lane);
    }
}

__device__ __forceinline__ unsigned sortable(float f) { const unsigned u = __builtin_bit_cast(unsigned, f); return (u & 0x80000000u) ? ~u : (u | 0x80000000u); }
__device__ __forceinline__ int mbcnt64(unsigned long long m) { return __builtin_amdgcn_mbcnt_hi((unsigned)(m >> 32), __builtin_amdgcn_mbcnt_lo((unsigned)m, 0)); }

__device__ __forceinline__ void select_query(Ctx& C, int tk, LAS float* sc, LAS float* qs) {
    unsigned char* ws = C.ws; const int lane = C.lane;
    const int tpos = tk & (SEQ - 1), b = tk >> 12, cch = tpos >> 6, L = 64 * (cch + 1), nj = cch + 1;
    int* sel = (int*)(ws + WS_SEL) + (size_t)tk * 256;
    if (L <= 256) { for (int i = lane; i < L; i += 64) sel[i] = i; return; }
    {
        const u32x2 w = *(const u32x2*)((const bf16_t*)(ws + WS_QI) + (size_t)tk * 256 + 4 * lane);
        *(LAS f32x4*)(qs + 4 * lane) = (f32x4){bflo(w.x), bfhi(w.x), bflo(w.y), bfhi(w.y)};
    }
    const f32x4 wi = *(const f32x4*)((const float*)(ws + WS_WI) + (size_t)tk * 4);
    asm volatile("s_waitcnt lgkmcnt(0)" ::: "memory"); __builtin_amdgcn_wave_barrier();
    const bf16_t* kib = (const bf16_t*)(ws + WS_KI) + (size_t)b * SEQ * 64;
#pragma unroll 1
    for (int j0 = 0; j0 < 64; ++j0) {
        asm volatile("" ::: "memory");
        const int sA = 64 * j0 + lane;
        if (j0 >= nj) { sc[sA] = -3.0e38f; continue; }
        u32x4 ka[8];
#pragma unroll
        for (int i = 0; i < 8; ++i) ka[i] = *(const u32x4*)(kib + (size_t)sA * 64 + 8 * i);
        float aA[4] = {0.f, 0.f, 0.f, 0.f};
#pragma unroll
        for (int i = 0; i < 8; ++i) {
            const float a0 = bflo(ka[i].x), a1 = bfhi(ka[i].x), a2 = bflo(ka[i].y), a3 = bfhi(ka[i].y), a4 = bflo(ka[i].z), a5 = bfhi(ka[i].z), a6 = bflo(ka[i].w), a7 = bfhi(ka[i].w);
#pragma unroll
            for (int h = 0; h < 4; ++h) {
                const f32x4 q0 = *(const LAS f32x4*)(qs + h * 64 + 8 * i), q1 = *(const LAS f32x4*)(qs + h * 64 + 8 * i + 4);
                aA[h] += q0.x * a0 + q0.y * a1 + q0.z * a2 + q0.w * a3 + q1.x * a4 + q1.y * a5 + q1.z * a6 + q1.w * a7;
            }
        }
        float scA = fmaxf(aA[0], 0.f) * wi[0] + fmaxf(aA[1], 0.f) * wi[1] + fmaxf(aA[2], 0.f) * wi[2] + fmaxf(aA[3], 0.f) * wi[3];
        scA = (scA == 0.f) ? 0.f : scA;
        sc[sA] = scA;
    }
    asm volatile("s_waitcnt lgkmcnt(0)" ::: "memory"); __builtin_amdgcn_wave_barrier();
    unsigned key[64];
#pragma unroll
    for (int j = 0; j < 64; ++j) key[j] = sortable(sc[64 * j + lane]);
    unsigned T = 0u;
#pragma unroll 1
    for (int bit = 31; bit >= 0; --bit) {
        const unsigned cand = T | (1u << bit); int c = 0;
#pragma unroll
        for (int j = 0; j < 64; ++j) c += (key[j] >= cand) ? 1 : 0;
#pragma unroll
        for (int o = 1; o < 64; o <<= 1) c += __shfl_xor(c, o);
        if (c >= 256) T = cand;
    }
    int cgt = 0;
#pragma unroll
    for (int j = 0; j < 64; ++j) cgt += (key[j] > T) ? 1 : 0;
#pragma unroll
    for (int o = 1; o < 64; o <<= 1) cgt += __shfl_xor(cgt, o);
    const int need = 256 - cgt; int base = 0, eqseen = 0;
#pragma unroll 1
    for (int j = 0; j < nj; ++j) {
        const unsigned kj = sortable(sc[64 * j + lane]);
        const bool gt = kj > T, eq = kj == T; const unsigned long long em = __ballot(eq);
        const bool take = gt || (eq && (eqseen + mbcnt64(em)) < need); const unsigned long long tm = __ballot(take);
        if (take) sel[base + mbcnt64(tm)] = 64 * j + lane;
        base += __popcll(tm); eqseen += __popcll(em);
    }
}

__device__ __forceinline__ void attend_query(Ctx& C, int tk, LAS float* qf, LAS float* P, LAS int* sl) {
    unsigned char* ws = C.ws; const int lane = C.lane;
    const int tpos = tk & (SEQ - 1), b = tk >> 12, L = 64 * ((tpos >> 6) + 1), nsel = L < 256 ? L : 256;
    {
        const u32x4 w = *(const u32x4*)((const bf16_t*)(ws + WS_Q) + (size_t)tk * 512 + 8 * lane);
        *(LAS f32x4*)(qf + 8 * lane) = (f32x4){bflo(w.x), bfhi(w.x), bflo(w.y), bfhi(w.y)}; *(LAS f32x4*)(qf + 8 * lane + 4) = (f32x4){bflo(w.z), bfhi(w.z), bflo(w.w), bfhi(w.w)};
        const int* sg = (const int*)(ws + WS_SEL) + (size_t)tk * 256;
#pragma unroll
        for (int i = 0; i < 4; ++i) sl[64 * i + lane] = (64 * i + lane) < nsel ? sg[64 * i + lane] : 0;
    }
    asm volatile("s_waitcnt lgkmcnt(0)" ::: "memory"); __builtin_amdgcn_wave_barrier();
    const bf16_t* kb = (const bf16_t*)(ws + WS_K) + (size_t)b * SEQ * 128; const bf16_t* vb = (const bf16_t*)(ws + WS_V) + (size_t)b * SEQ * 128;
#pragma unroll 1
    for (int i = 0; i < 4; ++i) {
        const int slot = 64 * i + lane; const bool valid = slot < nsel; const int key = sl[slot];
#pragma unroll 1
        for (int n = 0; n < 2; ++n) {
            asm volatile("" ::: "memory");
            float ac[4] = {0.f, 0.f, 0.f, 0.f};
#pragma unroll 1
            for (int c2 = 0; c2 < 4; ++c2) {
                asm volatile("" ::: "memory");
                u32x4 kr[2];
#pragma unroll
                for (int c = 0; c < 2; ++c) kr[c] = *(const u32x4*)(kb + (size_t)key * 128 + n * 64 + 8 * (2 * c2 + c));
#pragma unroll
                for (int c = 0; c < 2; ++c) {
                    const float a0 = bflo(kr[c].x), a1 = bfhi(kr[c].x), a2 = bflo(kr[c].y), a3 = bfhi(kr[c].y), a4 = bflo(kr[c].z), a5 = bfhi(kr[c].z), a6 = bflo(kr[c].w), a7 = bfhi(kr[c].w);
#pragma unroll
                    for (int h = 0; h < 4; ++h) {
                        const f32x4 q0 = *(const LAS f32x4*)(qf + (4 * n + h) * 64 + 8 * (2 * c2 + c)), q1 = *(const LAS f32x4*)(qf + (4 * n + h) * 64 + 8 * (2 * c2 + c) + 4);
                        ac[h] += q0.x * a0 + q0.y * a1 + q0.z * a2 + q0.w * a3 + q1.x * a4 + q1.y * a5 + q1.z * a6 + q1.w * a7;
                    }
                }
            }
            *(LAS f32x4*)(P + slot * 8 + 4 * n) = valid ? (f32x4){ac[0], ac[1], ac[2], ac[3]} : (f32x4){-1e30f, -1e30f, -1e30f, -1e30f};
        }
    }
    asm volatile("s_waitcnt lgkmcnt(0)" ::: "memory"); __builtin_amdgcn_wave_barrier();
    float lg[4][8];
#pragma unroll
    for (int i = 0; i < 4; ++i) { const f32x4 t0 = *(const LAS f32x4*)(P + (64 * i + lane) * 8), t1 = *(const LAS f32x4*)(P + (64 * i + lane) * 8 + 4);
        lg[i][0] = t0.x; lg[i][1] = t0.y; lg[i][2] = t0.z; lg[i][3] = t0.w; lg[i][4] = t1.x; lg[i][5] = t1.y; lg[i][6] = t1.z; lg[i][7] = t1.w; }
    float inv[8];
#pragma unroll
    for (int h = 0; h < 8; ++h) {
        const float m = wave_max(fmaxf(fmaxf(lg[0][h], lg[1][h]), fmaxf(lg[2][h], lg[3][h]))); float s = 0.f;
#pragma unroll
        for (int i = 0; i < 4; ++i) { const float p = (64 * i + lane) < nsel ? __expf(lg[i][h] - m) : 0.f; lg[i][h] = p; s += p; }
        inv[h] = 1.0f / wave_sum(s);
    }
#pragma unroll
    for (int i = 0; i < 4; ++i) { LAS float* pp = P + (64 * i + lane) * 8;
        *(LAS f32x4*)pp = (f32x4){lg[i][0], lg[i][1], lg[i][2], lg[i][3]}; *(LAS f32x4*)(pp + 4) = (f32x4){lg[i][4], lg[i][5], lg[i][6], lg[i][7]}; }
    asm volatile("s_waitcnt lgkmcnt(0)" ::: "memory"); __builtin_amdgcn_wave_barrier();
    float o[8] = {0.f, 0.f, 0.f, 0.f, 0.f, 0.f, 0.f, 0.f};
#pragma unroll 4
    for (int slot = 0; slot < nsel; ++slot) {
        const int key = sl[slot];
        const float v0 = bf2f(vb[(size_t)key * 128 + lane]), v1 = bf2f(vb[(size_t)key * 128 + 64 + lane]);
        const f32x4 p0 = *(const LAS f32x4*)(P + slot * 8), p1 = *(const LAS f32x4*)(P + slot * 8 + 4);
        o[0] += p0.x * v0; o[1] += p0.y * v0; o[2] += p0.z * v0; o[3] += p0.w * v0; o[4] += p1.x * v1; o[5] += p1.y * v1; o[6] += p1.z * v1; o[7] += p1.w * v1;
    }
    bf16_t* mo = (bf16_t*)(ws + WS_MIX) + (size_t)tk * D;
#pragma unroll
    for (int h = 0; h < 8; ++h) mo[h * 64 + lane] = (bf16_t)f2bf(o[h] * inv[h]);
    asm volatile("s_waitcnt lgkmcnt(0)" ::: "memory"); __builtin_amdgcn_wave_barrier();
}

__device__ __forceinline__ void pool_item(const Args& a, Ctx& C, int l, int item) {
    unsigned char* ws = C.ws; const int tid = C.tid;
    const int g = item & 3, tt = item >> 2, b = tt >> 6, tp0 = (tt & 63) * 64, w = 2 << g;
    LAS float* ub = (LAS float*)C.lds;
    LAS float* pw = ub + 79 * 64;
    LAS float* pl = pw + 64 * 64;
    const float* ubg = (const float*)(ws + WS_UB);
    for (int idx = tid; idx < 79 * 16; idx += NTHREADS) { const int row = idx >> 4, c4 = idx & 15, tp = tp0 - 15 + row;
        f32x4 v = (f32x4){0.f, 0.f, 0.f, 0.f}; if (tp >= 0) v = *(const f32x4*)(ubg + (size_t)(b * SEQ + tp) * 256 + g * 64 + 4 * c4);
        *(LAS f32x4*)(ub + row * 64 + 4 * c4) = v; }
    for (int idx = tid; idx < 1024; idx += NTHREADS) *(LAS f32x4*)(pw + 4 * idx) = *(const f32x4*)(a.pool_w + (size_t)(l * 4 + g) * 4096 + 4 * idx);
    __syncthreads();
    const int t = tid >> 3, c8 = (tid & 7) * 8, tpos = tp0 + t, wl = (tpos + 1) < w ? (tpos + 1) : w;
    {
        float s[8] = {0.f, 0.f, 0.f, 0.f, 0.f, 0.f, 0.f, 0.f};
        for (int i = 0; i < wl; ++i) {
#pragma unroll
            for (int j = 0; j < 8; ++j) s[j] += ub[(t + 15 - i) * 64 + c8 + j]; }
        const float rw = 1.0f / (float)wl;
#pragma unroll
        for (int j = 0; j < 8; ++j) pl[t * 65 + c8 + j] = s[j] * rw - ub[(t + 15) * 64 + c8 + j];
    }
    __syncthreads();
    float y[8] = {0.f, 0.f, 0.f, 0.f, 0.f, 0.f, 0.f, 0.f};
#pragma unroll 8
    for (int cc = 0; cc < 64; ++cc) { const float p = pl[t * 65 + cc]; const f32x4 w0 = *(const LAS f32x4*)(pw + cc * 64 + c8), w1 = *(const LAS f32x4*)(pw + cc * 64 + c8 + 4);
        y[0] += p * w0.x; y[1] += p * w0.y; y[2] += p * w0.z; y[3] += p * w0.w; y[4] += p * w1.x; y[5] += p * w1.y; y[6] += p * w1.z; y[7] += p * w1.w; }
    const float* ps = a.pool_scale + l * 256 + g * 64 + c8;
    u32x4 o; o.x = pk2(y[0] * ps[0], y[1] * ps[1]); o.y = pk2(y[2] * ps[2], y[3] * ps[3]); o.z = pk2(y[4] * ps[4], y[5] * ps[5]); o.w = pk2(y[6] * ps[6], y[7] * ps[7]);
    *(u32x4*)((bf16_t*)(ws + WS_MIX) + (size_t)(b * SEQ + tpos) * D + 512 + g * 64 + c8) = o;
    __syncthreads();
}

constexpr int HP = 65;
__device__ __forceinline__ void hgrn_gates(const Args& a, Ctx& C, int l, int b, int hh, int c, LAS float* bq, LAS float* kin) {
    const int tid = C.tid, s = tid >> 3, k8 = (tid & 7) * 8;
    const float* z = (const float*)(C.ws + WS_HG) + (size_t)(b * SEQ + c * 64 + s) * 1024 + 256 + hh * 64 + k8;
    const f32x4 z0 = *(const f32x4*)z, z1 = *(const f32x4*)(z + 4); const float zz[8] = {z0.x, z0.y, z0.z, z0.w, z1.x, z1.y, z1.z, z1.w};
#pragma unroll
    for (int j = 0; j < 8; ++j) {
        const int kk = hh * 64 + k8 + j; float lb = 0.f;
        if (l == 1) lb = 1.0f / (1.0f + expf(a.lb_logits[kk] - a.lb_logits[256 + kk]));
        const float sg = 1.0f / (1.0f + expf(-zz[j])), sn = 1.0f / (1.0f + expf(zz[j]));
        bq[s * HP + k8 + j] = logf(lb + (1.0f - lb) * sg); kin[s * HP + k8 + j] = (1.0f - lb) * sn;
    }
    __syncthreads();
    if (tid < 64) { float r = 0.f; for (int ss = 0; ss < 64; ++ss) { r += bq[ss * HP + tid]; bq[ss * HP + tid] = r; } }
    __syncthreads();
}
__device__ __forceinline__ void hgrn_local_item(const Args& a, Ctx& C, int l, int item) {
    const int tid = C.tid, c = item & 63, hh = (item >> 6) & 3, b = item >> 8;
    LAS float* bq = (LAS float*)C.lds; LAS float* kin = bq + 64 * HP; LAS float* vv = kin + 64 * HP;
    hgrn_gates(a, C, l, b, hh, c, bq, kin);
    { const int s = tid >> 3, k8 = (tid & 7) * 8;
        const float* vp = (const float*)(C.ws + WS_HG) + (size_t)(b * SEQ + c * 64 + s) * 1024 + 512 + hh * 64 + k8;
        *(LAS f32x4*)(vv + s * 64 + k8) = *(const f32x4*)vp; *(LAS f32x4*)(vv + s * 64 + k8 + 4) = *(const f32x4*)(vp + 4);
#pragma unroll
        for (int j = 0; j < 8; ++j) kin[s * HP + k8 + j] *= __expf(bq[63 * HP + k8 + j] - bq[s * HP + k8 + j]); }
    __syncthreads();
    const int k = tid >> 3, v8 = (tid & 7) * 8; float Lr[8] = {0.f, 0.f, 0.f, 0.f, 0.f, 0.f, 0.f, 0.f};
#pragma unroll 8
    for (int s = 0; s < 64; ++s) { const float w = kin[s * HP + k]; const f32x4 x0 = *(const LAS f32x4*)(vv + s * 64 + v8), x1 = *(const LAS f32x4*)(vv + s * 64 + v8 + 4);
        Lr[0] += w * x0.x; Lr[1] += w * x0.y; Lr[2] += w * x0.z; Lr[3] += w * x0.w; Lr[4] += w * x1.x; Lr[5] += w * x1.y; Lr[6] += w * x1.z; Lr[7] += w * x1.w; }
    float* hl = (float*)(C.ws + WS_HL) + (size_t)item * 4096 + k * 64 + v8;
    *(f32x4*)hl = (f32x4){Lr[0], Lr[1], Lr[2], Lr[3]}; *(f32x4*)(hl + 4) = (f32x4){Lr[4], Lr[5], Lr[6], Lr[7]};
    if ((tid & 7) == 0) ((float*)(C.ws + WS_HD))[(size_t)item * 64 + k] = __expf(bq[63 * HP + k]);
    __syncthreads();
}
__device__ __forceinline__ void hgrn_out_item(const Args& a, Ctx& C, int l, int item) {
    const int tid = C.tid, c = item & 63, hh = (item >> 6) & 3, b = item >> 8;
    LAS float* bq = (LAS float*)C.lds; LAS float* kin = bq + 64 * HP; LAS float* qq = kin + 64 * HP; LAS float* At = qq + 64 * HP; LAS float* vv = At + 64 * HP; LAS float* Ss = vv + 4096;
    hgrn_gates(a, C, l, b, hh, c, bq, kin);
    { const int s = tid >> 3, k8 = (tid & 7) * 8; const float* row = (const float*)(C.ws + WS_HG) + (size_t)(b * SEQ + c * 64 + s) * 1024 + hh * 64 + k8;
        const f32x4 q0 = *(const f32x4*)row, q1 = *(const f32x4*)(row + 4);
        qq[s * HP + k8 + 0] = siluf_(q0.x); qq[s * HP + k8 + 1] = siluf_(q0.y); qq[s * HP + k8 + 2] = siluf_(q0.z); qq[s * HP + k8 + 3] = siluf_(q0.w);
        qq[s * HP + k8 + 4] = siluf_(q1.x); qq[s * HP + k8 + 5] = siluf_(q1.y); qq[s * HP + k8 + 6] = siluf_(q1.z); qq[s * HP + k8 + 7] = siluf_(q1.w);
        *(LAS f32x4*)(vv + s * 64 + k8) = *(const f32x4*)(row + 512); *(LAS f32x4*)(vv + s * 64 + k8 + 4) = *(const f32x4*)(row + 516); }
    {
        const int k = tid >> 3, v8 = (tid & 7) * 8; f32x4 s0 = (f32x4){0.f, 0.f, 0.f, 0.f}, s1 = s0;
        const float* hl = (const float*)(C.ws + WS_HL) + (size_t)(item - c) * 4096 + k * 64 + v8; const float* hd = (const float*)(C.ws + WS_HD) + (size_t)(item - c) * 64 + k;
#pragma unroll 4
        for (int j = 0; j < c; ++j) { const float dj = hd[(size_t)j * 64]; const f32x4 l0 = *(const f32x4*)(hl + (size_t)j * 4096), l1 = *(const f32x4*)(hl + (size_t)j * 4096 + 4); s0 = s0 * dj + l0; s1 = s1 * dj + l1; }
        *(LAS f32x4*)(Ss + k * 64 + v8) = s0; *(LAS f32x4*)(Ss + k * 64 + v8 + 4) = s1; }
    __syncthreads();
    { const int t = tid >> 3, sg = tid & 7; float ac[8] = {0.f, 0.f, 0.f, 0.f, 0.f, 0.f, 0.f, 0.f};
        for (int k = 0; k < 64; ++k) { const float qt = qq[t * HP + k], bt = bq[t * HP + k];
#pragma unroll
            for (int i = 0; i < 8; ++i) { const int s = sg + 8 * i; if (s <= t) ac[i] += qt * kin[s * HP + k] * __expf(bt - bq[s * HP + k]); } }
#pragma unroll
        for (int i = 0; i < 8; ++i) At[t * HP + sg + 8 * i] = ac[i]; }
    __syncthreads();
    { const int t = tid >> 3, v8 = (tid & 7) * 8; float o[8] = {0.f, 0.f, 0.f, 0.f, 0.f, 0.f, 0.f, 0.f};
#pragma unroll 4
        for (int k = 0; k < 64; ++k) { const float qe = qq[t * HP + k] * __expf(bq[t * HP + k]); const f32x4 x0 = *(const LAS f32x4*)(Ss + k * 64 + v8), x1 = *(const LAS f32x4*)(Ss + k * 64 + v8 + 4);
            o[0] += qe * x0.x; o[1] += qe * x0.y; o[2] += qe * x0.z; o[3] += qe * x0.w; o[4] += qe * x1.x; o[5] += qe * x1.y; o[6] += qe * x1.z; o[7] += qe * x1.w; }
        for (int s = 0; s <= t; ++s) { const float w = At[t * HP + s]; const f32x4 x0 = *(const LAS f32x4*)(vv + s * 64 + v8), x1 = *(const LAS f32x4*)(vv + s * 64 + v8 + 4);
            o[0] += w * x0.x; o[1] += w * x0.y; o[2] += w * x0.z; o[3] += w * x0.w; o[4] += w * x1.x; o[5] += w * x1.y; o[6] += w * x1.z; o[7] += w * x1.w; }
        float ss = 0.f;
#pragma unroll
        for (int j = 0; j < 8; ++j) ss += o[j] * o[j];
        ss += __shfl_xor(ss, 1); ss += __shfl_xor(ss, 2); ss += __shfl_xor(ss, 4);
        const float rstd = 1.0f / sqrtf(ss * (1.0f / 64.0f) + EPS);
        const float* gp = (const float*)(C.ws + WS_HG) + (size_t)(b * SEQ + c * 64 + t) * 1024 + 768 + hh * 64 + v8; const float* ng = a.hgrn_g + l * 64 + v8;
        const f32x4 g0 = *(const f32x4*)gp, g1 = *(const f32x4*)(gp + 4); const float gg[8] = {g0.x, g0.y, g0.z, g0.w, g1.x, g1.y, g1.z, g1.w}; float y[8];
#pragma unroll
        for (int j = 0; j < 8; ++j) y[j] = o[j] * rstd * ng[j] * siluf_(gg[j]);
        u32x4 w; w.x = pk2(y[0], y[1]); w.y = pk2(y[2], y[3]); w.z = pk2(y[4], y[5]); w.w = pk2(y[6], y[7]);
        *(u32x4*)((bf16_t*)(C.ws + WS_MIX) + (size_t)(b * SEQ + c * 64 + t) * D + 768 + hh * 64 + v8) = w; }
    __syncthreads();
}

__device__ __forceinline__ int wave_isum(int v) {
    v += __builtin_amdgcn_update_dpp(0, v, 0xB1, 0xF, 0xF, true);
    v += __builtin_amdgcn_update_dpp(0, v, 0x4E, 0xF, 0xF, true);
    v += __builtin_amdgcn_update_dpp(0, v, 0x141, 0xF, 0xF, true);
    v += __builtin_amdgcn_update_dpp(0, v, 0x140, 0xF, 0xF, true);
    return __builtin_amdgcn_readlane(v, 0) + __builtin_amdgcn_readlane(v, 16) + __builtin_amdgcn_readlane(v, 32) + __builtin_amdgcn_readlane(v, 48);
}
typedef float f32x16 __attribute__((ext_vector_type(16)));
template <int NJ>
__device__ __forceinline__ void select_from_lds(const LAS float* sq, int nj, int* sel, int lane) {
    unsigned key[NJ];
#pragma unroll
    for (int j = 0; j < NJ; ++j) key[j] = sortable(sq[64 * j + lane]);
    unsigned T = 0u;
#pragma unroll 1
    for (int bit = 31; bit >= 0; --bit) {
        const unsigned cand = T | (1u << bit); int c = 0;
#pragma unroll
        for (int j = 0; j < NJ; ++j) c += (key[j] >= cand) ? 1 : 0;
        if (wave_isum(c) >= 256) T = cand;
    }
    int cgt = 0;
#pragma unroll
    for (int j = 0; j < NJ; ++j) cgt += (key[j] > T) ? 1 : 0;
    cgt = wave_isum(cgt);
    const int need = 256 - cgt; int base = 0, eqseen = 0;
#pragma unroll 1
    for (int j = 0; j < nj; ++j) {
        const unsigned kj = sortable(sq[64 * j + lane]);
        const bool gt = kj > T, eq = kj == T; const unsigned long long em = __ballot(eq);
        const bool take = gt || (eq && (eqseen + mbcnt64(em)) < need); const unsigned long long tm = __ballot(take);
        if (take) sel[base + mbcnt64(tm)] = 64 * j + lane;
        base += __popcll(tm); eqseen += __popcll(em);
    }
}
__device__ __forceinline__ void transpose32(unsigned (&a)[32]) {
#pragma unroll
    for (int st = 0; st < 5; ++st) {
        const int j = 16 >> st; const unsigned m = (st == 0) ? 0x0000FFFFu : (st == 1) ? 0x00FF00FFu : (st == 2) ? 0x0F0F0F0Fu : (st == 3) ? 0x33333333u : 0x55555555u;
#pragma unroll
        for (int idx = 0; idx < 16; ++idx) { const int k = (idx / j) * 2 * j + (idx % j); const unsigned t = (a[k] ^ (a[k + j] >> j)) & m; a[k] ^= t; a[k + j] ^= (t << j); }
    }
}
template <int NB>
__device__ __forceinline__ void select_bits(const LAS float* sq, int nj, int* sel, int lane) {
    unsigned pl[NB][32];
#pragma unroll
    for (int blk = 0; blk < NB; ++blk) {
#pragma unroll
        for (int j = 0; j < 32; ++j) pl[blk][j] = sortable(sq[64 * (32 * blk + j) + lane]);
        transpose32(pl[blk]);
    }
    unsigned M[NB], GT[NB];
#pragma unroll
    for (int blk = 0; blk < NB; ++blk) { M[blk] = 0xFFFFFFFFu; GT[blk] = 0u; }
    unsigned T = 0u; int G = 0;
#pragma unroll
    for (int w = 0; w < 32; ++w) {
        unsigned n[NB]; int c = 0;
#pragma unroll
        for (int blk = 0; blk < NB; ++blk) { n[blk] = M[blk] & pl[blk][w]; c += __popc(n[blk]); }
        const int tot = wave_isum(c);
        const bool take = (G + tot) >= 256;
        const unsigned flip = take ? 0u : 0xFFFFFFFFu;
        T |= take ? (1u << (31 - w)) : 0u; G += take ? 0 : tot;
#pragma unroll
        for (int blk = 0; blk < NB; ++blk) { GT[blk] |= n[blk] & flip; M[blk] &= (pl[blk][w] ^ flip); }
    }
    const int need = 256 - G;
    int ceq = 0;
#pragma unroll
    for (int blk = 0; blk < NB; ++blk) ceq += __popc(M[blk]);
    const int toteq = wave_isum(ceq);
    if (toteq == need) {
        int cnt = 0;
#pragma unroll
        for (int blk = 0; blk < NB; ++blk) { GT[blk] |= M[blk]; cnt += __popc(GT[blk]); }
        int incl = cnt;
#pragma unroll
        for (int o = 1; o < 64; o <<= 1) { const int t = __shfl_up(incl, o); if (lane >= o) incl += t; }
        int pos = incl - cnt;
#pragma unroll
        for (int blk = 0; blk < NB; ++blk) { unsigned mk = GT[blk];
            while (mk) { const int x = 31 - __clz((int)mk); mk &= ~(1u << x); sel[pos++] = 64 * (32 * blk + 31 - x) + lane; } }
    } else {
        int base = 0, eqseen = 0;
#pragma unroll 1
        for (int j = 0; j < nj; ++j) {
            const unsigned kj = sortable(sq[64 * j + lane]);
            const bool gt = kj > T, eq = kj == T; const unsigned long long em = __ballot(eq);
            const bool take = gt || (eq && (eqseen + mbcnt64(em)) < need); const unsigned long long tm = __ballot(take);
            if (take) sel[base + mbcnt64(tm)] = 64 * j + lane;
            base += __popcll(tm); eqseen += __popcll(em);
        }
    }
}
__device__ __forceinline__ void index_unit(Ctx& C, int b, int cch, int sub) {
    unsigned char* ws = C.ws; const int lane = C.lane, w = C.wave;
    const int tk0 = b * SEQ + 64 * cch + 8 * sub, L = 64 * (cch + 1), nj = cch + 1;
    if (L <= 256) { int* sel = (int*)(ws + WS_SEL) + (size_t)(tk0 + w) * 256; for (int i = lane; i < L; i += 64) sel[i] = i; return; }
    LAS float* scl = (LAS float*)C.lds;
#ifndef IDXREP
#define IDXREP 0
#endif
    for (int repA = 0; repA < ((IDXREP & 1) ? 2 : 1); ++repA) {
        const int r = lane & 31, hf = lane >> 5, qq = r >> 2, h = r & 3;
        bf16x8 aq[4];
#pragma unroll
        for (int ks = 0; ks < 4; ++ks) aq[ks] = *(const bf16x8*)((const bf16_t*)(ws + WS_QI) + (size_t)(tk0 + qq) * 256 + h * 64 + 16 * ks + 8 * hf);
        f32x4 wq[4];
#pragma unroll
        for (int g = 0; g < 4; ++g) wq[g] = *(const f32x4*)((const float*)(ws + WS_WI) + (size_t)(tk0 + 2 * g + hf) * 4);
        const bf16_t* kib = (const bf16_t*)(ws + WS_KI) + (size_t)b * SEQ * 64;
        const int ntile = 2 * nj;
        bf16x8 bk[4], bk2[4];
#define IDX_LOAD(d1, d2, kta) do { const int _k1 = (kta), _k2 = ((kta) + NWAVES) < ntile ? (kta) + NWAVES : (kta); _Pragma("unroll") for (int ks = 0; ks < 4; ++ks) { \
            d1[ks] = *(const bf16x8*)(kib + (size_t)(32 * _k1 + r) * 64 + 16 * ks + 8 * hf); d2[ks] = *(const bf16x8*)(kib + (size_t)(32 * _k2 + r) * 64 + 16 * ks + 8 * hf); } } while (0)
        if (w < ntile) IDX_LOAD(bk, bk2, w);
#pragma unroll 1
        for (int kt = w; kt < ntile; kt += 2 * NWAVES) {
            const bool two = (kt + NWAVES) < ntile; const int kt2 = two ? kt + NWAVES : kt;
            bf16x8 nk[4], nk2[4];
            const bool more = (kt + 2 * NWAVES) < ntile;
            if (more) IDX_LOAD(nk, nk2, kt + 2 * NWAVES);
            f32x16 acc, acc2;
#pragma unroll
            for (int i = 0; i < 16; ++i) { acc[i] = 0.f; acc2[i] = 0.f; }
#pragma unroll
            for (int ks = 0; ks < 4; ++ks) { acc = __builtin_amdgcn_mfma_f32_32x32x16_bf16(aq[ks], bk[ks], acc, 0, 0, 0); acc2 = __builtin_amdgcn_mfma_f32_32x32x16_bf16(aq[ks], bk2[ks], acc2, 0, 0, 0); }
#pragma unroll
            for (int g = 0; g < 4; ++g) {
                float sc = fmaxf(acc[4 * g + 0], 0.f) * wq[g][0] + fmaxf(acc[4 * g + 1], 0.f) * wq[g][1] + fmaxf(acc[4 * g + 2], 0.f) * wq[g][2] + fmaxf(acc[4 * g + 3], 0.f) * wq[g][3];
                sc = (sc == 0.f) ? 0.f : sc;
                scl[(2 * g + hf) * 4096 + 32 * kt + r] = sc;
                float sc2 = fmaxf(acc2[4 * g + 0], 0.f) * wq[g][0] + fmaxf(acc2[4 * g + 1], 0.f) * wq[g][1] + fmaxf(acc2[4 * g + 2], 0.f) * wq[g][2] + fmaxf(acc2[4 * g + 3], 0.f) * wq[g][3];
                sc2 = (sc2 == 0.f) ? 0.f : sc2;
                if (two) scl[(2 * g + hf) * 4096 + 32 * kt2 + r] = sc2;
            }
            if (more) {
#pragma unroll
                for (int ks = 0; ks < 4; ++ks) { bk[ks] = nk[ks]; bk2[ks] = nk2[ks]; } }
        }
#undef IDX_LOAD
        const int njp = nj <= 32 ? 32 : 64;
        for (int j = nj; j < njp; ++j) scl[w * 4096 + 64 * j + lane] = -3.0e38f;
    }
    __syncthreads();
    for (int repB = 0; repB < ((IDXREP & 2) ? 2 : 1); ++repB) {
        const LAS float* sq = scl + w * 4096; int* sel = (int*)(ws + WS_SEL) + (size_t)(tk0 + w) * 256;
        if (nj <= 32) select_bits<1>(sq, nj, sel, lane); else select_bits<2>(sq, nj, sel, lane);
    }
    __syncthreads();
}

typedef short s16x4 __attribute__((ext_vector_type(4)));
constexpr int VROW = 272;
__device__ __forceinline__ void attend_query_mfma(Ctx& C, int tk, LAS unsigned char* vs) {
    unsigned char* ws = C.ws; const int lane = C.lane, c = lane & 15, g = lane >> 4;
    const int tpos = tk & (SEQ - 1), b = tk >> 12, L = 64 * ((tpos >> 6) + 1), nsel = L < 256 ? L : 256;
    const bf16_t* kb = (const bf16_t*)(ws + WS_K) + (size_t)b * SEQ * 128; const bf16_t* vb = (const bf16_t*)(ws + WS_V) + (size_t)b * SEQ * 128;
    int selr[4];
    { const int* sg = (const int*)(ws + WS_SEL) + (size_t)tk * 256;
#pragma unroll
      for (int i = 0; i < 4; ++i) selr[i] = (64 * i + lane) < nsel ? sg[64 * i + lane] : 0; }
    bf16x8 bq0[2], bq1[2];
    { const bf16_t* qp = (const bf16_t*)(ws + WS_Q) + (size_t)tk * 512 + (c & 7) * 64 + 8 * g; const bf16x8 z = (bf16x8){0, 0, 0, 0, 0, 0, 0, 0};
#pragma unroll
      for (int ks = 0; ks < 2; ++ks) { const bf16x8 q = *(const bf16x8*)(qp + 32 * ks); bq0[ks] = (c < 4) ? q : z; bq1[ks] = (c >= 4 && c < 8) ? q : z; } }
    f32x4 acc[16];
#pragma unroll
    for (int kt = 0; kt < 16; ++kt) {
        if ((kt & 3) == 0) asm volatile("" ::: "memory");
        const int key = __shfl(selr[kt >> 2], 16 * (kt & 3) + c);
        const bf16_t* kr = kb + (size_t)key * 128 + 8 * g;
        const bf16x8 a00 = *(const bf16x8*)(kr), a01 = *(const bf16x8*)(kr + 32), a10 = *(const bf16x8*)(kr + 64), a11 = *(const bf16x8*)(kr + 96);
        f32x4 t = (f32x4){0.f, 0.f, 0.f, 0.f};
        t = __builtin_amdgcn_mfma_f32_16x16x32_bf16(a00, bq0[0], t, 0, 0, 0); t = __builtin_amdgcn_mfma_f32_16x16x32_bf16(a01, bq0[1], t, 0, 0, 0);
        t = __builtin_amdgcn_mfma_f32_16x16x32_bf16(a10, bq1[0], t, 0, 0, 0); t = __builtin_amdgcn_mfma_f32_16x16x32_bf16(a11, bq1[1], t, 0, 0, 0);
        acc[kt] = t;
    }
    { const int lim = nsel - 4 * g;
#pragma unroll
      for (int kt = 0; kt < 16; ++kt)
#pragma unroll
        for (int r = 0; r < 4; ++r) acc[kt][r] = (16 * kt + r < lim) ? acc[kt][r] : -1e30f; }
    float m = -1e30f;
#pragma unroll
    for (int kt = 0; kt < 16; ++kt) m = fmaxf(m, fmaxf(fmaxf(acc[kt][0], acc[kt][1]), fmaxf(acc[kt][2], acc[kt][3])));
    m = fmaxf(m, __shfl_xor(m, 16)); m = fmaxf(m, __shfl_xor(m, 32));
    float sum = 0.f;
#pragma unroll
    for (int kt = 0; kt < 16; ++kt)
#pragma unroll
        for (int r = 0; r < 4; ++r) { const float pv = __expf(acc[kt][r] - m); acc[kt][r] = pv; sum += pv; }
    sum += __shfl_xor(sum, 16); sum += __shfl_xor(sum, 32);
    const float inv = 1.0f / sum;
    bf16x8 bp[8];
#pragma unroll
    for (int T = 0; T < 8; ++T) { u32x4 w; w.x = cvt_pk_bf16(acc[2 * T][0], acc[2 * T][1]); w.y = cvt_pk_bf16(acc[2 * T][2], acc[2 * T][3]); w.z = cvt_pk_bf16(acc[2 * T + 1][0], acc[2 * T + 1][1]); w.w = cvt_pk_bf16(acc[2 * T + 1][2], acc[2 * T + 1][3]);
        bp[T] = __builtin_bit_cast(bf16x8, w); }
    f32x4 ao0[4], ao1[4];
#pragma unroll
    for (int dt = 0; dt < 4; ++dt) { ao0[dt] = (f32x4){0.f, 0.f, 0.f, 0.f}; ao1[dt] = (f32x4){0.f, 0.f, 0.f, 0.f}; }
    const int q4 = c >> 2, p4 = c & 3;
    u32x4 vst[8];
#define ATT_VLOAD(T) do { _Pragma("unroll") for (int i = 0; i < 8; ++i) { const int row = g + 4 * i; \
        const int key = __shfl(selr[(T) >> 1], 32 * ((T) & 1) + row); vst[i] = *(const u32x4*)(vb + (size_t)key * 128 + 8 * c); } } while (0)
    ATT_VLOAD(0);
#pragma unroll
    for (int T = 0; T < 8; ++T) {
        LAS unsigned char* buf = vs + (T & 1) * (32 * VROW);
        asm volatile("" ::: "memory");
#pragma unroll
        for (int i = 0; i < 8; ++i) *(LAS u32x4*)(buf + (g + 4 * i) * VROW + 16 * c) = vst[i];
        if (T < 7) ATT_VLOAD(T + 1);
#pragma unroll
        for (int n = 0; n < 2; ++n)
#pragma unroll
            for (int dt = 0; dt < 4; ++dt) {
                LAS s16x4* p0 = (LAS s16x4*)(buf + (4 * g + q4) * VROW + (n * 64 + 16 * dt + 4 * p4) * 2);
                const s16x4 lo = __builtin_amdgcn_ds_read_tr16_b64_v4i16(p0), hi = __builtin_amdgcn_ds_read_tr16_b64_v4i16((LAS s16x4*)((LAS unsigned char*)p0 + 16 * VROW));
                const bf16x8 av = (bf16x8){lo[0], lo[1], lo[2], lo[3], hi[0], hi[1], hi[2], hi[3]};
                if (n == 0) ao0[dt] = __builtin_amdgcn_mfma_f32_16x16x32_bf16(av, bp[T], ao0[dt], 0, 0, 0);
                else ao1[dt] = __builtin_amdgcn_mfma_f32_16x16x32_bf16(av, bp[T], ao1[dt], 0, 0, 0);
            }
    }
#undef ATT_VLOAD
    if (c < 8) {
        bf16_t* mo = (bf16_t*)(ws + WS_MIX) + (size_t)tk * D + c * 64 + 4 * g;
#pragma unroll
        for (int dt = 0; dt < 4; ++dt) { f32x4 o; o[0] = (c < 4 ? ao0[dt][0] : ao1[dt][0]) * inv; o[1] = (c < 4 ? ao0[dt][1] : ao1[dt][1]) * inv; o[2] = (c < 4 ? ao0[dt][2] : ao1[dt][2]) * inv; o[3] = (c < 4 ? ao0[dt][3] : ao1[dt][3]) * inv; u32x2 w; w.x = cvt_pk_bf16(o[0], o[1]); w.y = cvt_pk_bf16(o[2], o[3]); *(u32x2*)(mo + 16 * dt) = w; }
    }
}

__device__ __forceinline__ void hgrn_out_group(const Args& a, Ctx& C, int l, int item) {
    const int tid = C.tid, lane = C.lane, w = C.wave, cg = item & 15, hh = (item >> 4) & 3, b = item >> 6, c0 = 4 * cg, bh = b * 4 + hh;
    LAS float* bq = (LAS float*)C.lds; LAS float* kin = bq + 64 * HP; LAS float* qq = kin + 64 * HP; LAS float* At = qq + 64 * HP; LAS float* vv = At + 64 * HP; LAS float* Ss = vv + 4096;
    const float* HG = (const float*)(C.ws + WS_HG); const float* HLb = (const float*)(C.ws + WS_HL) + (size_t)bh * 64 * 4096; const float* HDb = (const float*)(C.ws + WS_HD) + (size_t)bh * 64 * 64;
    float lbv[8];
#pragma unroll
    for (int j = 0; j < 8; ++j) { const int kk = hh * 64 + 8 * w + j; lbv[j] = (l == 1) ? 1.0f / (1.0f + expf(a.lb_logits[kk] - a.lb_logits[256 + kk])) : 0.f; }
    const int kS = tid >> 3, v8 = (tid & 7) * 8; f32x4 s0 = (f32x4){0.f, 0.f, 0.f, 0.f}, s1 = s0;
    { const float* hl = HLb + kS * 64 + v8; const float* hd = HDb + kS;
#pragma unroll 8
      for (int j = 0; j < c0; ++j) { const float dj = hd[(size_t)j * 64]; const f32x4 l0 = *(const f32x4*)(hl + (size_t)j * 4096), l1 = *(const f32x4*)(hl + (size_t)j * 4096 + 4); s0 = s0 * dj + l0; s1 = s1 * dj + l1; } }
#pragma unroll 1
    for (int c = c0; c < c0 + 4; ++c) {
        const size_t tok0 = (size_t)b * SEQ + c * 64;
        const f32x4 lc0 = *(const f32x4*)(HLb + (size_t)c * 4096 + kS * 64 + v8), lc1 = *(const f32x4*)(HLb + (size_t)c * 4096 + kS * 64 + v8 + 4);
        *(LAS f32x4*)(Ss + kS * 64 + v8) = s0; *(LAS f32x4*)(Ss + kS * 64 + v8 + 4) = s1;
        {
            const float* z = HG + (tok0 + lane) * 1024 + 256 + hh * 64 + 8 * w; const f32x4 z0 = *(const f32x4*)z, z1 = *(const f32x4*)(z + 4); const float zz[8] = {z0.x, z0.y, z0.z, z0.w, z1.x, z1.y, z1.z, z1.w};
#pragma unroll
            for (int j = 0; j < 8; ++j) { const float lb = lbv[j]; const float sg = 1.0f / (1.0f + __expf(-zz[j])), sn = 1.0f / (1.0f + __expf(zz[j])); float lf = __logf(lb + (1.0f - lb) * sg);
#pragma unroll
                for (int o = 1; o < 64; o <<= 1) { const float t = __shfl_up(lf, o); if (lane >= o) lf += t; }
                bq[lane * HP + 8 * w + j] = lf; kin[lane * HP + 8 * w + j] = (1.0f - lb) * sn; }
        }
        { const int sr = tid >> 3, k8 = (tid & 7) * 8; const float* row = HG + (tok0 + sr) * 1024 + hh * 64 + k8;
            const f32x4 q0 = *(const f32x4*)row, q1 = *(const f32x4*)(row + 4);
            qq[sr * HP + k8 + 0] = siluf_(q0.x); qq[sr * HP + k8 + 1] = siluf_(q0.y); qq[sr * HP + k8 + 2] = siluf_(q0.z); qq[sr * HP + k8 + 3] = siluf_(q0.w);
            qq[sr * HP + k8 + 4] = siluf_(q1.x); qq[sr * HP + k8 + 5] = siluf_(q1.y); qq[sr * HP + k8 + 6] = siluf_(q1.z); qq[sr * HP + k8 + 7] = siluf_(q1.w);
            *(LAS f32x4*)(vv + sr * 64 + k8) = *(const f32x4*)(row + 512); *(LAS f32x4*)(vv + sr * 64 + k8 + 4) = *(const f32x4*)(row + 516); }
        __syncthreads();
        { const int t = tid >> 3, sg = tid & 7; float ac[8] = {0.f, 0.f, 0.f, 0.f, 0.f, 0.f, 0.f, 0.f};
            for (int k = 0; k < 64; ++k) { const float qt = qq[t * HP + k], bt = bq[t * HP + k];
#pragma unroll
                for (int i = 0; i < 8; ++i) { const int sx = sg + 8 * i; if (sx <= t) ac[i] += qt * kin[sx * HP + k] * __expf(bt - bq[sx * HP + k]); } }
#pragma unroll
            for (int i = 0; i < 8; ++i) At[t * HP + sg + 8 * i] = ac[i]; }
        __syncthreads();
        { const int t = tid >> 3; float o[8] = {0.f, 0.f, 0.f, 0.f, 0.f, 0.f, 0.f, 0.f};
#pragma unroll 4
            for (int k = 0; k < 64; ++k) { const float qe = qq[t * HP + k] * __expf(bq[t * HP + k]); const f32x4 x0 = *(const LAS f32x4*)(Ss + k * 64 + v8), x1 = *(const LAS f32x4*)(Ss + k * 64 + v8 + 4);
                o[0] += qe * x0.x; o[1] += qe * x0.y; o[2] += qe * x0.z; o[3] += qe * x0.w; o[4] += qe * x1.x; o[5] += qe * x1.y; o[6] += qe * x1.z; o[7] += qe * x1.w; }
            for (int sx = 0; sx <= t; ++sx) { const float wv = At[t * HP + sx]; const f32x4 x0 = *(const LAS f32x4*)(vv + sx * 64 + v8), x1 = *(const LAS f32x4*)(vv + sx * 64 + v8 + 4);
                o[0] += wv * x0.x; o[1] += wv * x0.y; o[2] += wv * x0.z; o[3] += wv * x0.w; o[4] += wv * x1.x; o[5] += wv * x1.y; o[6] += wv * x1.z; o[7] += wv * x1.w; }
            float ss = 0.f;
#pragma unroll
            for (int j = 0; j < 8; ++j) ss += o[j] * o[j];
            ss += __shfl_xor(ss, 1); ss += __shfl_xor(ss, 2); ss += __shfl_xor(ss, 4);
            const float rstd = 1.0f / sqrtf(ss * (1.0f / 64.0f) + EPS);
            const float* gp = HG + (tok0 + t) * 1024 + 768 + hh * 64 + v8; const float* ng = a.hgrn_g + l * 64 + v8;
            const f32x4 g0 = *(const f32x4*)gp, g1 = *(const f32x4*)(gp + 4); const float gg[8] = {g0.x, g0.y, g0.z, g0.w, g1.x, g1.y, g1.z, g1.w}; float y[8];
#pragma unroll
            for (int j = 0; j < 8; ++j) y[j] = o[j] * rstd * ng[j] * siluf_(gg[j]);
            u32x4 wv; wv.x = pk2(y[0], y[1]); wv.y = pk2(y[2], y[3]); wv.z = pk2(y[4], y[5]); wv.w = pk2(y[6], y[7]);
            *(u32x4*)((bf16_t*)(C.ws + WS_MIX) + (tok0 + t) * D + 768 + hh * 64 + v8) = wv; }
        { const float dc = __expf(bq[63 * HP + kS]); s0 = s0 * dc + lc0; s1 = s1 * dc + lc1; }
        __syncthreads();
    }
}

template <bool WITH_Q>
__device__ __forceinline__ void hgrn_fill(const Args& a, Ctx& C, int l, int hh, size_t tok0, LAS float* fz, LAS float* kn, LAS float* qq, LAS float* vv) {
    const int tid = C.tid, sr = tid >> 3, k8 = (tid & 7) * 8; const float* row = (const float*)(C.ws + WS_HG) + (tok0 + sr) * 1024 + hh * 64 + k8;
    const f32x4 z0 = *(const f32x4*)(row + 256), z1 = *(const f32x4*)(row + 260); const float zz[8] = {z0.x, z0.y, z0.z, z0.w, z1.x, z1.y, z1.z, z1.w}; float fo[8], ko[8];
#pragma unroll
    for (int j = 0; j < 8; ++j) { const int kk = hh * 64 + k8 + j; const float lb = (l == 1) ? 1.0f / (1.0f + expf(a.lb_logits[kk] - a.lb_logits[256 + kk])) : 0.f;
        const float sg = 1.0f / (1.0f + expf(-zz[j])), sn = 1.0f / (1.0f + expf(zz[j])); fo[j] = lb + (1.0f - lb) * sg; ko[j] = (1.0f - lb) * sn; }
    *(LAS f32x4*)(fz + sr * 64 + k8) = (f32x4){fo[0], fo[1], fo[2], fo[3]}; *(LAS f32x4*)(fz + sr * 64 + k8 + 4) = (f32x4){fo[4], fo[5], fo[6], fo[7]};
    *(LAS f32x4*)(kn + sr * 64 + k8) = (f32x4){ko[0], ko[1], ko[2], ko[3]}; *(LAS f32x4*)(kn + sr * 64 + k8 + 4) = (f32x4){ko[4], ko[5], ko[6], ko[7]};
    if (WITH_Q) { const f32x4 q0 = *(const f32x4*)row, q1 = *(const f32x4*)(row + 4);
        *(LAS f32x4*)(qq + sr * 64 + k8) = (f32x4){siluf_(q0.x), siluf_(q0.y), siluf_(q0.z), siluf_(q0.w)}; *(LAS f32x4*)(qq + sr * 64 + k8 + 4) = (f32x4){siluf_(q1.x), siluf_(q1.y), siluf_(q1.z), siluf_(q1.w)}; }
    *(LAS f32x4*)(vv + sr * 64 + k8) = *(const f32x4*)(row + 512); *(LAS f32x4*)(vv + sr * 64 + k8 + 4) = *(const f32x4*)(row + 516);
}
__device__ __forceinline__ void hgrn_local2(const Args& a, Ctx& C, int l, int item) {
    const int tid = C.tid, c = item & 63, hh = (item >> 6) & 3, b = item >> 8, v = tid & 63, kq = tid >> 6;
    LAS float* fz = (LAS float*)C.lds; LAS float* kn = fz + 4096; LAS float* vv = kn + 4096;
    hgrn_fill<false>(a, C, l, hh, (size_t)b * SEQ + c * 64, fz, kn, nullptr, vv);
    __syncthreads();
    float S[8] = {0.f, 0.f, 0.f, 0.f, 0.f, 0.f, 0.f, 0.f}, dp[8] = {1.f, 1.f, 1.f, 1.f, 1.f, 1.f, 1.f, 1.f};
#pragma unroll 4
    for (int sx = 0; sx < 64; ++sx) { const f32x4 f0 = *(const LAS f32x4*)(fz + sx * 64 + 8 * kq), f1 = *(const LAS f32x4*)(fz + sx * 64 + 8 * kq + 4), k0 = *(const LAS f32x4*)(kn + sx * 64 + 8 * kq), k1 = *(const LAS f32x4*)(kn + sx * 64 + 8 * kq + 4);
        const float vs = vv[sx * 64 + v]; const float ff[8] = {f0.x, f0.y, f0.z, f0.w, f1.x, f1.y, f1.z, f1.w}, kk[8] = {k0.x, k0.y, k0.z, k0.w, k1.x, k1.y, k1.z, k1.w};
#pragma unroll
        for (int j = 0; j < 8; ++j) { S[j] = ff[j] * S[j] + kk[j] * vs; dp[j] *= ff[j]; } }
    float* hl = (float*)(C.ws + WS_HL) + (size_t)item * 4096 + (8 * kq) * 64 + v;
#pragma unroll
    for (int j = 0; j < 8; ++j) hl[j * 64] = S[j];
    if (v == 0) { float* hd = (float*)(C.ws + WS_HD) + (size_t)item * 64 + 8 * kq;
#pragma unroll
        for (int j = 0; j < 8; ++j) hd[j] = dp[j]; }
    __syncthreads();
}
__device__ __forceinline__ void hgrn_out2(const Args& a, Ctx& C, int l, int item) {
    const int tid = C.tid, cg = item & 15, hh = (item >> 4) & 3, b = item >> 6, c0 = 4 * cg, bh = b * 4 + hh, v = tid & 63, kq = tid >> 6;
    LAS float* fz = (LAS float*)C.lds; LAS float* kn = fz + 4096; LAS float* qq = kn + 4096; LAS float* vv = qq + 4096; LAS float* part = vv + 4096;
    const float* HLb = (const float*)(C.ws + WS_HL) + (size_t)bh * 64 * 4096 + (8 * kq) * 64 + v; const float* HDb = (const float*)(C.ws + WS_HD) + (size_t)bh * 64 * 64 + 8 * kq;
    float S[8] = {0.f, 0.f, 0.f, 0.f, 0.f, 0.f, 0.f, 0.f};
#pragma unroll 2
    for (int j = 0; j < c0; ++j) { const f32x4 d0 = *(const f32x4*)(HDb + (size_t)j * 64), d1 = *(const f32x4*)(HDb + (size_t)j * 64 + 4); const float dd[8] = {d0.x, d0.y, d0.z, d0.w, d1.x, d1.y, d1.z, d1.w};
#pragma unroll
        for (int i = 0; i < 8; ++i) S[i] = dd[i] * S[i] + HLb[(size_t)j * 4096 + i * 64]; }
#pragma unroll 1
    for (int c = c0; c < c0 + 4; ++c) {
        const size_t tok0 = (size_t)b * SEQ + c * 64;
        hgrn_fill<true>(a, C, l, hh, tok0, fz, kn, qq, vv);
        __syncthreads();
#pragma unroll 1
        for (int half = 0; half < 2; ++half) {
#pragma unroll 4
            for (int sl = 0; sl < 32; ++sl) { const int sx = 32 * half + sl;
                const f32x4 f0 = *(const LAS f32x4*)(fz + sx * 64 + 8 * kq), f1 = *(const LAS f32x4*)(fz + sx * 64 + 8 * kq + 4), k0 = *(const LAS f32x4*)(kn + sx * 64 + 8 * kq), k1 = *(const LAS f32x4*)(kn + sx * 64 + 8 * kq + 4);
                const f32x4 q0 = *(const LAS f32x4*)(qq + sx * 64 + 8 * kq), q1 = *(const LAS f32x4*)(qq + sx * 64 + 8 * kq + 4);
                const float vs = vv[sx * 64 + v]; const float ff[8] = {f0.x, f0.y, f0.z, f0.w, f1.x, f1.y, f1.z, f1.w}, kk[8] = {k0.x, k0.y, k0.z, k0.w, k1.x, k1.y, k1.z, k1.w}, qv[8] = {q0.x, q0.y, q0.z, q0.w, q1.x, q1.y, q1.z, q1.w};
                float op = 0.f;
#pragma unroll
                for (int j = 0; j < 8; ++j) { S[j] = ff[j] * S[j] + kk[j] * vs; op += qv[j] * S[j]; }
                part[(kq * 32 + sl) * 64 + v] = op; }
            __syncthreads();
            { const int t = tid >> 4, v4 = (tid & 15) * 4; f32x4 o = (f32x4){0.f, 0.f, 0.f, 0.f};
#pragma unroll
                for (int kk2 = 0; kk2 < 8; ++kk2) o += *(const LAS f32x4*)(part + (kk2 * 32 + t) * 64 + v4);
                float ss = o.x * o.x + o.y * o.y + o.z * o.z + o.w * o.w;
                ss += __shfl_xor(ss, 1); ss += __shfl_xor(ss, 2); ss += __shfl_xor(ss, 4); ss += __shfl_xor(ss, 8);
                const float rstd = 1.0f / sqrtf(ss * (1.0f / 64.0f) + EPS);
                const size_t tok = tok0 + 32 * half + t;
                const f32x4 gg = *(const f32x4*)((const float*)(C.ws + WS_HG) + tok * 1024 + 768 + hh * 64 + v4), ng = *(const f32x4*)(a.hgrn_g + l * 64 + v4);
                const float y0 = o.x * rstd * ng.x * siluf_(gg.x), y1 = o.y * rstd * ng.y * siluf_(gg.y), y2 = o.z * rstd * ng.z * siluf_(gg.z), y3 = o.w * rstd * ng.w * siluf_(gg.w);
                u32x2 wv; wv.x = pk2(y0, y1); wv.y = pk2(y2, y3);
                *(u32x2*)((bf16_t*)(C.ws + WS_MIX) + tok * D + 768 + hh * 64 + v4) = wv; }
            __syncthreads();
        }
    }
}

__device__ __forceinline__ void pool_wave(const Args& a, Ctx& C, int l) {
    unsigned char* ws = C.ws; const int lane = C.lane;
    const int gwv = blockIdx.x * NWAVES + C.wave, g = gwv & 3, widx = gwv >> 2, nw = (C.G * NWAVES) >> 2, w = 2 << g;
    float pwr[64];
#pragma unroll
    for (int c = 0; c < 64; ++c) pwr[c] = a.pool_w[(size_t)(l * 4 + g) * 4096 + c * 64 + lane];
    const float psc = a.pool_scale[l * 256 + g * 64 + lane];
    const float* ubg = (const float*)(ws + WS_UB) + g * 64 + lane;
    for (int tile = widx; tile < NTOK / 8; tile += nw) {
        const int tok0 = tile * 8, tp0 = tok0 & (SEQ - 1);
        float row[23];
#pragma unroll
        for (int r = 0; r < 23; ++r) { const int tp = tp0 - 15 + r; row[r] = (tp >= 0) ? ubg[(size_t)(tok0 - 15 + r) * 256] : 0.f; }
        float pooled[8];
#pragma unroll
        for (int t = 0; t < 8; ++t) {
            float sm = 0.f;
#pragma unroll
            for (int i = 0; i < 16; ++i) if (i < w) sm += row[15 + t - i];
            const int tpos = tp0 + t; const int wl = (tpos + 1) < w ? (tpos + 1) : w;
            pooled[t] = sm * (1.0f / (float)wl) - row[15 + t];
        }
        float y[8] = {0.f, 0.f, 0.f, 0.f, 0.f, 0.f, 0.f, 0.f};
#pragma unroll
        for (int c = 0; c < 64; ++c) {
#pragma unroll
            for (int t = 0; t < 8; ++t) y[t] += __builtin_bit_cast(float, __builtin_amdgcn_readlane(__builtin_bit_cast(int, pooled[t]), c)) * pwr[c];
        }
        bf16_t* mo = (bf16_t*)(ws + WS_MIX) + (size_t)tok0 * D + 512 + g * 64 + lane;
#pragma unroll
        for (int t = 0; t < 8; ++t) mo[(size_t)t * D] = (bf16_t)f2bf(y[t] * psc);
    }
}

__device__ __forceinline__ void phase_mix1(const Args& a, Ctx& C, int l) {
#ifndef MIX1MASK
#define MIX1MASK 7
#endif
#ifndef MIX1REP
#define MIX1REP 0
#endif
    for (int rep = 0; rep < ((MIX1REP & 1) && l == 0 ? 2 : 1); ++rep) for (int it = blockIdx.x; it < 1024; it += C.G) hgrn_local2(a, C, l, it);
    for (int rep = 0; rep < ((MIX1REP & 2) && l == 0 ? 2 : 1); ++rep) pool_wave(a, C, l);
    __syncthreads();
    for (int rep = 0; rep < ((MIX1REP & 4) && l == 0 ? 2 : 1); ++rep) for (int base = 0; base < 2048; base += 2 * C.G) {
        const int u1 = base + (int)blockIdx.x, u2 = base + 2 * C.G - 1 - (int)blockIdx.x;
        if (u1 < 2048) index_unit(C, (u1 >> 3) & 3, u1 >> 5, u1 & 7);
        if (u2 < 2048) index_unit(C, (u2 >> 3) & 3, u2 >> 5, u2 & 7);
    }
}
__device__ __forceinline__ void phase_mix2(const Args& a, Ctx& C, int l) {
#ifndef MIX2MASK
#define MIX2MASK 3
#endif
#ifndef MIX2REP
#define MIX2REP 0
#endif
    for (int rep = 0; rep < ((MIX2REP & 1) ? 2 : 1); ++rep) for (int it = blockIdx.x; it < 256; it += C.G) hgrn_out2(a, C, l, it);
    LAS unsigned char* vs = C.lds + C.wave * (2 * 32 * VROW);
    const int gw = blockIdx.x * NWAVES + C.wave, NGW = C.G * NWAVES;
    for (int rep = 0; rep < ((MIX2REP & 2) ? 2 : 1); ++rep) for (int tk = gw; tk < NTOK; tk += NGW) attend_query_mfma(C, tk, vs);
}

__device__ __forceinline__ void phase_router(const Args& a, Ctx& C, int l) {
    unsigned char* ws = C.ws; const int lane = C.lane;
    LAS float* us = (LAS float*)(C.lds + C.wave * 8192);
    const float* mod = (const float*)(ws + WS_MOD); const float* H = (const float*)(ws + WS_H);
    const float* wr = a.w_router + (size_t)l * 1024 * 32; unsigned* cnt = (unsigned*)(ws + WS_CTL) + CW_CNT + l * 32 * 64;
    const int gw = blockIdx.x * NWAVES + C.wave, NGW = C.G * NWAVES;
    for (int base = gw * 2; base < NTOK; base += NGW * 2) {
#pragma unroll
        for (int hf = 0; hf < 2; ++hf) {
            const int tk = base + hf, b = tk >> 12; const f32x4* hr = (const f32x4*)(H + (size_t)tk * D) + lane; f32x4 v[4];
#pragma unroll
            for (int j = 0; j < 4; ++j) v[j] = hr[64 * j];
            float ss = 0.f;
#pragma unroll
            for (int j = 0; j < 4; ++j) ss += (v[j].x * v[j].x + v[j].y * v[j].y) + (v[j].z * v[j].z + v[j].w * v[j].w);
            const float rstd = 1.0f / sqrtf(wave_sum(ss) * (1.0f / D) + EPS);
            const float* mb = mod + (size_t)(l * 4 + b) * 6144; bf16_t* urow = (bf16_t*)(ws + WS_U) + (size_t)tk * D;
#pragma unroll
            for (int j = 0; j < 4; ++j) { const int idx = 4 * lane + 256 * j; const f32x4 gv = *(const f32x4*)(a.norm2_g + l * 1024 + idx), shv = *(const f32x4*)(mb + 3072 + idx), scv = *(const f32x4*)(mb + 4096 + idx);
                const f32x4 o = v[j] * rstd * gv * (scv + 1.0f) + shv; u32x2 w; w.x = pk2(o[0], o[1]); w.y = pk2(o[2], o[3]); *(u32x2*)(urow + idx) = w;
                *(LAS f32x4*)(us + hf * 1024 + idx) = o; }
        }
        asm volatile("s_waitcnt lgkmcnt(0)" ::: "memory"); __builtin_amdgcn_wave_barrier();
        const int e = lane & 31, hf = lane >> 5; float acc0 = 0.f, acc1 = 0.f;
        const LAS float* up = us + hf * 1024;
#pragma unroll 8
        for (int d = 0; d < 1024; d += 2) { acc0 += up[d] * wr[d * 32 + e]; acc1 += up[d + 1] * wr[(d + 1) * 32 + e]; }
        float val = acc0 + acc1 + a.b_router[l * 32 + e];
        float tv[4]; int te[4];
#pragma unroll
        for (int k = 0; k < 4; ++k) {
            float bv = val; int bi = e;
#pragma unroll
            for (int o = 1; o < 32; o <<= 1) { const float ov = __shfl_xor(bv, o); const int oi = __shfl_xor(bi, o); if (ov > bv || (ov == bv && oi < bi)) { bv = ov; bi = oi; } }
            tv[k] = bv; te[k] = bi; if (e == bi) val = -3.0e38f;
        }
        const float e1 = __expf(tv[1] - tv[0]), e2 = __expf(tv[2] - tv[0]), e3 = __expf(tv[3] - tv[0]); const float rs = 1.0f / (1.0f + e1 + e2 + e3);
        if (e < 4) {
            const int tk = base + hf; const int ex = e == 0 ? te[0] : e == 1 ? te[1] : e == 2 ? te[2] : te[3]; const float gt = (e == 0 ? 1.0f : e == 1 ? e1 : e == 2 ? e2 : e3) * rs;
            const unsigned slot = atomicAdd(cnt + ex * 64, 1u);
            ((int*)(ws + WS_ROWTOK))[(size_t)ex * NTOK + slot] = tk;
            ((int*)(ws + WS_EIDX))[tk * 4 + e] = ex; ((int*)(ws + WS_SLOT))[tk * 4 + e] = (int)slot; ((float*)(ws + WS_GATE))[tk * 4 + e] = gt;
        }
        asm volatile("s_waitcnt lgkmcnt(0)" ::: "memory"); __builtin_amdgcn_wave_barrier();
    }
}

constexpr int URS = 2064;
__device__ __forceinline__ void phase_router2(const Args& a, Ctx& C, int l) {
    unsigned char* ws = C.ws; const int lane = C.lane, w = C.wave;
    LAS unsigned char* uh = C.lds; LAS unsigned char* ul = uh + 16 * URS; LAS float* part = (LAS float*)(ul + 16 * URS);
    const float* mod = (const float*)(ws + WS_MOD); const float* H = (const float*)(ws + WS_H);
    const bf16_t* wrh = (const bf16_t*)(ws + WS_WRH) + (size_t)l * 32768; const bf16_t* wrl = (const bf16_t*)(ws + WS_WRL) + (size_t)l * 32768;
    unsigned* cnt = (unsigned*)(ws + WS_CTL) + CW_CNT + l * 32 * 64;
    for (int tile = blockIdx.x; tile < NTOK / 16; tile += C.G) {
        const int tok0 = tile * 16;
#pragma unroll
        for (int hf = 0; hf < 2; ++hf) {
            const int tr = 2 * w + hf, tk = tok0 + tr, b = tk >> 12; const f32x4* hr = (const f32x4*)(H + (size_t)tk * D) + lane; f32x4 v[4];
#pragma unroll
            for (int j = 0; j < 4; ++j) v[j] = hr[64 * j];
            float ss = 0.f;
#pragma unroll
            for (int j = 0; j < 4; ++j) ss += (v[j].x * v[j].x + v[j].y * v[j].y) + (v[j].z * v[j].z + v[j].w * v[j].w);
            const float rstd = 1.0f / sqrtf(wave_sum(ss) * (1.0f / D) + EPS);
            const float* mb = mod + (size_t)(l * 4 + b) * 6144; bf16_t* urow = (bf16_t*)(ws + WS_U) + (size_t)tk * D;
#pragma unroll
            for (int j = 0; j < 4; ++j) { const int idx = 4 * lane + 256 * j; const f32x4 gv = *(const f32x4*)(a.norm2_g + l * 1024 + idx), shv = *(const f32x4*)(mb + 3072 + idx), scv = *(const f32x4*)(mb + 4096 + idx);
                const f32x4 o = v[j] * rstd * gv * (scv + 1.0f) + shv; u32x2 hi; hi.x = pk2(o[0], o[1]); hi.y = pk2(o[2], o[3]); *(u32x2*)(urow + idx) = hi;
                u32x2 lo; lo.x = pk2(o[0] - bflo(hi.x), o[1] - bfhi(hi.x)); lo.y = pk2(o[2] - bflo(hi.y), o[3] - bfhi(hi.y));
                *(LAS u32x2*)(uh + tr * URS + idx * 2) = hi; *(LAS u32x2*)(ul + tr * URS + idx * 2) = lo; }
        }
        __syncthreads();
        {
            const int c = lane & 15, g = lane >> 4; f32x4 acc0 = (f32x4){0.f, 0.f, 0.f, 0.f}, acc1 = acc0;
#pragma unroll
            for (int kk = 0; kk < 4; ++kk) { const int ks = 4 * w + kk;
                const bf16x8 ah = *(const LAS bf16x8*)(uh + c * URS + (32 * ks + 8 * g) * 2), al = *(const LAS bf16x8*)(ul + c * URS + (32 * ks + 8 * g) * 2);
                const bf16x8 bh0 = *(const bf16x8*)(wrh + (size_t)c * 1024 + 32 * ks + 8 * g), bl0 = *(const bf16x8*)(wrl + (size_t)c * 1024 + 32 * ks + 8 * g);
                const bf16x8 bh1 = *(const bf16x8*)(wrh + (size_t)(c + 16) * 1024 + 32 * ks + 8 * g), bl1 = *(const bf16x8*)(wrl + (size_t)(c + 16) * 1024 + 32 * ks + 8 * g);
                acc0 = __builtin_amdgcn_mfma_f32_16x16x32_bf16(al, bh0, acc0, 0, 0, 0); acc0 = __builtin_amdgcn_mfma_f32_16x16x32_bf16(ah, bl0, acc0, 0, 0, 0); acc0 = __builtin_amdgcn_mfma_f32_16x16x32_bf16(ah, bh0, acc0, 0, 0, 0);
                acc1 = __builtin_amdgcn_mfma_f32_16x16x32_bf16(al, bh1, acc1, 0, 0, 0); acc1 = __builtin_amdgcn_mfma_f32_16x16x32_bf16(ah, bl1, acc1, 0, 0, 0); acc1 = __builtin_amdgcn_mfma_f32_16x16x32_bf16(ah, bh1, acc1, 0, 0, 0); }
#pragma unroll
            for (int r = 0; r < 4; ++r) { part[(w * 16 + 4 * g + r) * 32 + c] = acc0[r]; part[(w * 16 + 4 * g + r) * 32 + 16 + c] = acc1[r]; }
        }
        __syncthreads();
        {
            const int e = lane & 31, hf = lane >> 5, tr = 2 * w + hf, tk = tok0 + tr; float val = a.b_router[l * 32 + e];
#pragma unroll
            for (int ww = 0; ww < 8; ++ww) val += part[(ww * 16 + tr) * 32 + e];
            float tv[4]; int te[4];
#pragma unroll
            for (int k = 0; k < 4; ++k) {
                float bv = val; int bi = e;
#pragma unroll
                for (int o = 1; o < 32; o <<= 1) { const float ov = __shfl_xor(bv, o); const int oi = __shfl_xor(bi, o); if (ov > bv || (ov == bv && oi < bi)) { bv = ov; bi = oi; } }
                tv[k] = bv; te[k] = bi; if (e == bi) val = -3.0e38f;
            }
            const float e1 = __expf(tv[1] - tv[0]), e2 = __expf(tv[2] - tv[0]), e3 = __expf(tv[3] - tv[0]); const float rs = 1.0f / (1.0f + e1 + e2 + e3);
            if (e < 4) {
                const int ex = e == 0 ? te[0] : e == 1 ? te[1] : e == 2 ? te[2] : te[3]; const float gt = (e == 0 ? 1.0f : e == 1 ? e1 : e == 2 ? e2 : e3) * rs;
                const unsigned slot = atomicAdd(cnt + ex * 64, 1u);
                ((int*)(ws + WS_ROWTOK))[(size_t)ex * NTOK + slot] = tk;
                ((int*)(ws + WS_EIDX))[tk * 4 + e] = ex; ((int*)(ws + WS_SLOT))[tk * 4 + e] = (int)slot; ((float*)(ws + WS_GATE))[tk * 4 + e] = gt;
            }
        }
        __syncthreads();
    }
}

__device__ __forceinline__ void moe_table(Ctx& C, int l, LAS int* tab) {
    if (C.tid < 32) { const unsigned* cnt = (const unsigned*)(C.ws + WS_CTL) + CW_CNT + l * 32 * 64; tab[33 + C.tid] = (int)__hip_atomic_load(cnt + C.tid * 64, __ATOMIC_RELAXED, __HIP_MEMORY_SCOPE_AGENT); }
    __syncthreads();
    if (C.tid == 0) { int p = 0; for (int e = 0; e < 32; ++e) { tab[e] = p; p += (tab[33 + e] + 255) >> 8; } tab[32] = p; }
    __syncthreads();
}

__device__ __forceinline__ void phase_combine(const Args& a, Ctx& C, int l) {
    unsigned char* ws = C.ws; const int lane = C.lane;
    const float* mod = (const float*)(ws + WS_MOD); float* H = (float*)(ws + WS_H); const bf16_t* Y = (const bf16_t*)(ws + WS_Y);
    const unsigned* cnt = (const unsigned*)(ws + WS_CTL) + CW_CNT + l * 32 * 64;
    int mt = 0; if (lane < 32) mt = ((int)__hip_atomic_load(cnt + lane * 64, __ATOMIC_RELAXED, __HIP_MEMORY_SCOPE_AGENT) + 255) >> 8;
    int incl = mt;
#pragma unroll
    for (int o = 1; o < 32; o <<= 1) { const int t = __shfl_up(incl, o); if ((lane & 31) >= o) incl += t; }
    const int excl = incl - mt;
    const int gw = blockIdx.x * NWAVES + C.wave, NGW = C.G * NWAVES;
    for (int tk = gw; tk < NTOK; tk += NGW) {
        const int b = tk >> 12; f32x4 v[4]; f32x4* hr = (f32x4*)(H + (size_t)tk * D) + lane;
#pragma unroll
        for (int j = 0; j < 4; ++j) v[j] = hr[64 * j];
        f32x4 m[4];
#pragma unroll
        for (int j = 0; j < 4; ++j) m[j] = (f32x4){0.f, 0.f, 0.f, 0.f};
#pragma unroll
        for (int k = 0; k < 4; ++k) {
            const int ex = ((const int*)(ws + WS_EIDX))[tk * 4 + k], slot = ((const int*)(ws + WS_SLOT))[tk * 4 + k]; const float gt = ((const float*)(ws + WS_GATE))[tk * 4 + k];
            const int row = 256 * __shfl(excl, ex) + slot; const u32x2* yr = (const u32x2*)(Y + (size_t)row * D) + lane;
#pragma unroll
            for (int j = 0; j < 4; ++j) { const u32x2 w = yr[64 * j]; m[j] += (f32x4){bflo(w.x), bfhi(w.x), bflo(w.y), bfhi(w.y)} * gt; }
        }
        const float* mb = mod + (size_t)(l * 4 + b) * 6144;
#pragma unroll
        for (int j = 0; j < 4; ++j) { const f32x4 g2 = *(const f32x4*)(mb + 5120 + 4 * lane + 256 * j); v[j] += g2 * m[j]; if (l + 1 < DEPTH) hr[64 * j] = v[j]; }
        if (l + 1 < DEPTH) { const float* mn = mod + (size_t)((l + 1) * 4 + b) * 6144; norm_mod_store(v, a.norm1_g + (l + 1) * 1024, mn + 0, mn + 1024, (bf16_t*)(ws + WS_U) + (size_t)tk * D, lane); }
        else {
            float ss = 0.f;
#pragma unroll
            for (int j = 0; j < 4; ++j) ss += (v[j].x * v[j].x + v[j].y * v[j].y) + (v[j].z * v[j].z + v[j].w * v[j].w);
            const float rstd = 1.0f / sqrtf(wave_sum(ss) * (1.0f / D) + EPS);
            f32x4* orow = (f32x4*)(a.out + (size_t)tk * D) + lane;
#pragma unroll
            for (int j = 0; j < 4; ++j) orow[64 * j] = v[j] * rstd * *(const f32x4*)(a.final_g + 4 * lane + 256 * j);
        }
    }
}


#define XB_TMO      128
#define XB_XCNT(j)  (256  + 64 * (j))
#define XB_XSUB(j)  (1280 + 64 * (j))
#define XB_XGEN(j)  (2304 + 64 * (j))
#define XB_TOP      3328
#define XB_TOPGEN   3392
#define XCD_BAR_WORDS 3456
#define XB_SPIN_CAP (1u << 22)
__device__ __forceinline__ unsigned xb_ld(unsigned* p)              { return __hip_atomic_load(p, __ATOMIC_RELAXED, __HIP_MEMORY_SCOPE_AGENT); }
__device__ __forceinline__ unsigned xb_add(unsigned* p, unsigned v) { return __hip_atomic_fetch_add(p, v, __ATOMIC_RELAXED, __HIP_MEMORY_SCOPE_AGENT); }
__device__ __forceinline__ unsigned xb_xcc_id() { return (unsigned)__builtin_amdgcn_s_getreg((3 << 11) | 20) & 0xFu; }
#define XB_SPIN(cond, bar) do { unsigned _sp = 0; while (cond) { __builtin_amdgcn_s_sleep(1); \
    if ((++_sp & 255u) == 0u) { if (xb_ld(&(bar)[XB_TMO])) break; if (_sp > XB_SPIN_CAP) { atomicAdd(&(bar)[XB_TMO], 1u); break; } } } } while (0)
struct XcdBarrier { unsigned* bar; unsigned x; volatile LAS unsigned* st; };
__device__ __forceinline__ XcdBarrier xcd_barrier_post(unsigned* bar, volatile LAS unsigned* st, bool leader) {
    XcdBarrier b; b.bar = bar; b.x = xb_xcc_id(); b.st = st;
    if (leader) (void)xb_add(&bar[XB_XCNT(b.x)], 1u);
    return b;
}
__device__ __forceinline__ void xcd_barrier_complete(unsigned* bar, unsigned x, unsigned& nloc, unsigned& nx) {
    const unsigned G = gridDim.x * gridDim.y * gridDim.z;
    unsigned sum, cnt, mine, sp = 0u;
    for (;;) {
        sum = 0u; cnt = 0u; mine = 0u;
#pragma unroll
        for (unsigned j = 0; j < 16; ++j) { const unsigned c = xb_ld(&bar[XB_XCNT(j)]); sum += c; cnt += (c > 0u) ? 1u : 0u; mine = (j == x) ? c : mine; }
        if (sum == G) break;
        __builtin_amdgcn_s_sleep(1);
        if ((++sp & 255u) == 0u) { if (xb_ld(&bar[XB_TMO])) break; if (sp > XB_SPIN_CAP) { atomicAdd(&bar[XB_TMO], 1u); break; } }
    }
    nloc = mine > 0u ? mine : 1u; nx = cnt > 0u ? cnt : 1u;
}
__device__ __forceinline__ void xcd_barrier(const XcdBarrier& b, bool leader) {
    asm volatile("s_waitcnt vmcnt(0)" ::: "memory");
    __syncthreads();
    if (leader) {
        unsigned* bar = b.bar;
        __builtin_amdgcn_s_waitcnt(0);
        unsigned nloc = b.st[0], nx = b.st[1];
        if (nloc == 0u) { xcd_barrier_complete(bar, b.x, nloc, nx); b.st[0] = nloc; b.st[1] = nx; }
        const unsigned old = xb_add(&bar[XB_XSUB(b.x)], 1u);
        const unsigned gen = old / nloc;
        if (old + 1u == (gen + 1u) * nloc) {
            __builtin_amdgcn_fence(__ATOMIC_RELEASE, "agent");
            asm volatile("s_waitcnt vmcnt(0)" ::: "memory");
            const unsigned og = xb_add(&bar[XB_TOP], 1u);
            const unsigned tg = og / nx;
            if (og + 1u == (tg + 1u) * nx) xb_add(&bar[XB_TOPGEN], 1u);
            else XB_SPIN(xb_ld(&bar[XB_TOPGEN]) == tg, bar);
            __builtin_amdgcn_fence(__ATOMIC_ACQUIRE, "agent");
            xb_add(&bar[XB_XGEN(b.x)], 1u);
            asm volatile("s_waitcnt vmcnt(0)" ::: "memory");
        } else {
            XB_SPIN(xb_ld(&bar[XB_XGEN(b.x)]) == gen, bar);
            __builtin_amdgcn_fence(__ATOMIC_ACQUIRE, "agent");
            asm volatile("s_waitcnt vmcnt(0)" ::: "memory");
        }
    }
    __syncthreads();
}

typedef const __attribute__((address_space(4))) Args* KArgsPtr;
__device__ __forceinline__ Args load_args() {
#if defined(__HIP_DEVICE_COMPILE__)
    KArgsPtr p = (KArgsPtr)__builtin_amdgcn_kernarg_segment_ptr(); asm volatile("" : "+s"(p)); Args a;
    a.x = p->x; a.c = p->c; a.pos = p->pos; a.w_ada = p->w_ada; a.b_ada = p->b_ada; a.norm1_g = p->norm1_g; a.norm2_g = p->norm2_g; a.w_in = p->w_in; a.w_out = p->w_out; a.pool_w = p->pool_w;
    a.pool_scale = p->pool_scale; a.hgrn_g = p->hgrn_g; a.lb_logits = p->lb_logits; a.w_router = p->w_router; a.b_router = p->b_router; a.w1 = p->w1; a.b1 = p->b1; a.w2 = p->w2; a.b2 = p->b2; a.final_g = p->final_g;
    a.out = p->out; a.ws = p->ws; a.ph_lo = p->ph_lo; a.ph_hi = p->ph_hi; return a;
#else
    return Args{};
#endif
}
__device__ __forceinline__ int lane_id() { return __builtin_amdgcn_mbcnt_hi(~0u, __builtin_amdgcn_mbcnt_lo(~0u, 0)); }
__device__ __forceinline__ Ctx make_ctx(unsigned char* ws, int wv) {
    extern __shared__ __attribute__((aligned(16))) unsigned char lds_raw[];
    Ctx C; C.lds = (LAS unsigned char*)lds_raw; { int l_ = lane_id(); asm volatile("" : "+v"(l_)); C.lane = l_; } C.wave = wv; C.tid = wv * 64 + C.lane;
    C.G = gridDim.x; { const int bx = blockIdx.x; C.vcu = (C.G % 8 == 0) ? (bx % 8) * (C.G / 8) + bx / 8 : bx; }
    C.ws = ws; return C;
}
#ifndef PHASE_FN
#define PHASE_FN __device__ __forceinline__ void
#endif
#define GEMM_FN __device__ __forceinline__ void
PHASE_FN ph_prep(int wv) { const Args a = load_args(); Ctx C = make_ctx(a.ws, wv); phase_prep(a, C); }
PHASE_FN ph_u0(int wv) { const Args a = load_args(); Ctx C = make_ctx(a.ws, wv); phase_u0(a, C); }
GEMM_FN ph_gin(int l, int wv) { const Args a = load_args(); Ctx C = make_ctx(a.ws, wv); unsigned char* ws = a.ws;
    DenseOrder S{(const char*)(ws + WS_U), (const char*)(ws + WS_WIN) + (size_t)l * NPAD * 1024 * 2, NTOK / 256, NPAD / 256, (NTOK / 256) * (NPAD / 256), C.G, (int)blockIdx.x};
    EpiIn E{ws}; pg8::gemm_phase<EpiIn, DenseOrder, false, true>(C.lds, (LAS unsigned*)(C.lds + LDS_PARK), C.tid, S, E); }
PHASE_FN ph_mix1(int l, int wv) { const Args a = load_args(); Ctx C = make_ctx(a.ws, wv); phase_mix1(a, C, l); }
PHASE_FN ph_mix2(int l, int wv) { const Args a = load_args(); Ctx C = make_ctx(a.ws, wv); phase_mix2(a, C, l); }
GEMM_FN ph_gout(int l, int wv) { const Args a = load_args(); Ctx C = make_ctx(a.ws, wv); unsigned char* ws = a.ws;
    DenseOrder S{(const char*)(ws + WS_MIX), (const char*)(ws + WS_WOUT) + (size_t)l * 1024 * 1024 * 2, NTOK / 256, 4, (NTOK / 256) * 4, C.G, (int)blockIdx.x};
    EpiOut E{l == 0 ? a.x : (const float*)(ws + WS_H), (float*)(ws + WS_H), (const float*)(ws + WS_MOD) + (size_t)l * 4 * 6144 + 2048};
    pg8::gemm_phase<EpiOut, DenseOrder, false, true>(C.lds, (LAS unsigned*)(C.lds + LDS_PARK), C.tid, S, E); }
PHASE_FN ph_router(int l, int wv) { const Args a = load_args(); Ctx C = make_ctx(a.ws, wv); phase_router2(a, C, l); }
GEMM_FN ph_g1(int l, int wv) { const Args a = load_args(); Ctx C = make_ctx(a.ws, wv); unsigned char* ws = a.ws;
    LAS int* tab = (LAS int*)(C.lds + LDS_TAB); moe_table(C, l, tab);
    MoeOrder<true> S{tab, (const char*)(ws + WS_U), (const char*)(ws + WS_W1) + (size_t)l * 32 * 2048 * 1024 * 2, (const int*)(ws + WS_ROWTOK), C.G, C.vcu};
    EpiG1 E{(bf16_t*)(ws + WS_ACT), a.b1 + (size_t)l * 32 * 2048}; pg8::gemm_phase<EpiG1, MoeOrder<true>, true, true>(C.lds, (LAS unsigned*)(C.lds + LDS_PARK), C.tid, S, E); }
GEMM_FN ph_g2(int l, int wv) { const Args a = load_args(); Ctx C = make_ctx(a.ws, wv); unsigned char* ws = a.ws;
    LAS int* tab = (LAS int*)(C.lds + LDS_TAB); moe_table(C, l, tab);
    MoeOrder<false> S{tab, (const char*)(ws + WS_ACT), (const char*)(ws + WS_W2) + (size_t)l * 32 * 1024 * 1024 * 2, nullptr, C.G, C.vcu};
    EpiG2 E{(bf16_t*)(ws + WS_Y), a.b2 + (size_t)l * 32 * 1024}; pg8::gemm_phase<EpiG2, MoeOrder<false>, false, true>(C.lds, (LAS unsigned*)(C.lds + LDS_PARK), C.tid, S, E); }
PHASE_FN ph_combine(int l, int wv) { const Args a = load_args(); Ctx C = make_ctx(a.ws, wv); phase_combine(a, C, l); }

constexpr int NPHASES = 2 + 8 * DEPTH;
__global__ void __launch_bounds__(NTHREADS, 2) mega_fwd(Args a) {
#if MK_ONE_LAUNCH == 1
    cg::grid_group grid = cg::this_grid();
#define SEAM() do { __syncthreads(); grid.sync(); } while (0)
#elif MK_ONE_LAUNCH == 2
    extern __shared__ __attribute__((aligned(16))) unsigned char lds_k[];
    volatile LAS unsigned* bst = (volatile LAS unsigned*)((LAS unsigned char*)lds_k + LDS_BYTES - 64);
    const bool leader = (threadIdx.x == 0);
    if (leader) { bst[0] = 0u; bst[1] = 0u; }
    __syncthreads();
    const XcdBarrier xbar = xcd_barrier_post((unsigned*)(a.ws + WS_CTL) + CW_BAR, bst, leader);
#define SEAM() xcd_barrier(xbar, leader)
#else
#define SEAM() do { } while (0)
#endif
    const int lo = a.ph_lo, hi = a.ph_hi;
    const int wv = __builtin_amdgcn_readfirstlane((int)threadIdx.x >> 6);
#ifndef KINDMASK
#define KINDMASK 0xffffu
#endif
#define KON(k) (((KINDMASK) >> (k)) & 1u)
#ifndef REP_ID
#define REP_ID -1
#endif
#define RUN(kind, id, call) do { if (KON(kind) && lo <= (id) && (id) < hi) { call; if ((id) == REP_ID) { __syncthreads(); call; } if ((id) + 1 < hi) SEAM(); } } while (0)
    RUN(0, 0, ph_prep(wv));
    RUN(1, 1, ph_u0(wv));
    RUN(2, 2, ph_gin(0, wv)); RUN(3, 3, ph_mix1(0, wv)); RUN(4, 4, ph_mix2(0, wv)); RUN(5, 5, ph_gout(0, wv)); RUN(6, 6, ph_router(0, wv)); RUN(7, 7, ph_g1(0, wv)); RUN(8, 8, ph_g2(0, wv)); RUN(9, 9, ph_combine(0, wv));
    RUN(2, 10, ph_gin(1, wv)); RUN(3, 11, ph_mix1(1, wv)); RUN(4, 12, ph_mix2(1, wv)); RUN(5, 13, ph_gout(1, wv)); RUN(6, 14, ph_router(1, wv)); RUN(7, 15, ph_g1(1, wv)); RUN(8, 16, ph_g2(1, wv)); RUN(9, 17, ph_combine(1, wv));
}

extern "C" void kernel_launch(void* const* d_in, const int* in_sizes, int n_in, void* d_out, int out_size, void* d_ws, size_t ws_size, hipStream_t stream) {
    static int grid = 0;
    if (grid == 0) {
        if (n_in != 20 || out_size != NTOK * D || ws_size < WS_END) { fprintf(stderr, "kernel_launch: unexpected shapes: n_in %d out %d ws %zu (need %zu)\n", n_in, out_size, ws_size, (size_t)WS_END); grid = -1; return; }
        int dev = 0, cus = 0, per_cu = 0;
        hipGetDevice(&dev); hipDeviceGetAttribute(&cus, hipDeviceAttributeMultiprocessorCount, dev);
        if (hipFuncSetAttribute((const void*)mega_fwd, hipFuncAttributeMaxDynamicSharedMemorySize, LDS_BYTES) != hipSuccess) { fprintf(stderr, "kernel_launch: hipFuncSetAttribute failed\n"); grid = -1; return; }
        hipOccupancyMaxActiveBlocksPerMultiprocessor(&per_cu, (const void*)mega_fwd, NTHREADS, LDS_BYTES);
        (void)hipGetLastError();
        if (per_cu < 1) fprintf(stderr, "kernel_launch: occupancy query says %d blocks per CU\n", per_cu);
        grid = cus;
    }
    if (grid < 0) return;
    hipMemsetAsync((char*)d_ws + WS_CTL, 0, CTL_BYTES, stream);
    Args a{};
    a.x = (const float*)d_in[0]; a.c = (const float*)d_in[1]; a.pos = (const int*)d_in[2]; a.w_ada = (const float*)d_in[3]; a.b_ada = (const float*)d_in[4];
    a.norm1_g = (const float*)d_in[5]; a.norm2_g = (const float*)d_in[6]; a.w_in = (const float*)d_in[7]; a.w_out = (const float*)d_in[8]; a.pool_w = (const float*)d_in[9];
    a.pool_scale = (const float*)d_in[10]; a.hgrn_g = (const float*)d_in[11]; a.lb_logits = (const float*)d_in[12]; a.w_router = (const float*)d_in[13]; a.b_router = (const float*)d_in[14];
    a.w1 = (const float*)d_in[15]; a.b1 = (const float*)d_in[16]; a.w2 = (const float*)d_in[17]; a.b2 = (const float*)d_in[18]; a.final_g = (const float*)d_in[19];
    a.out = (float*)d_out; a.ws = (unsigned char*)d_ws;
#if MK_ONE_LAUNCH == 1
    a.ph_lo = 0; a.ph_hi = NPHASES;
    void* args[] = {&a};
    hipError_t e = hipLaunchCooperativeKernel((const void*)mega_fwd, dim3(grid), dim3(NTHREADS), args, LDS_BYTES, stream);
    if (e != hipSuccess) fprintf(stderr, "cooperative launch failed: %s (grid %d)\n", hipGetErrorString(e), grid);
#elif MK_ONE_LAUNCH == 2
    a.ph_lo = 0; a.ph_hi = NPHASES;
    hipLaunchKernelGGL(mega_fwd, dim3(grid), dim3(NTHREADS), LDS_BYTES, stream, a);
#else
    for (int p = 0; p < NPHASES; ++p) { a.ph_lo = p; a.ph_hi = p + 1; hipLaunchKernelGGL(mega_fwd, dim3(grid), dim3(NTHREADS), LDS_BYTES, stream, a); }
#endif
}
```

```cpp
#include <hip/hip_runtime.h>
#include <hip/hip_cooperative_groups.h>
#include <cstdio>
#include <cstdint>
namespace cg = cooperative_groups;

#ifndef MK_ONE_LAUNCH
#define MK_ONE_LAUNCH 2
#endif

#define LAS __attribute__((address_space(3)))
typedef unsigned short bf16_t;
typedef short bf16x8 __attribute__((ext_vector_type(8)));
typedef float f32x4 __attribute__((ext_vector_type(4)));
typedef float f32x2 __attribute__((ext_vector_type(2)));
typedef unsigned u32x4 __attribute__((ext_vector_type(4)));
typedef unsigned u32x2 __attribute__((ext_vector_type(2)));

constexpr int D = 1024, NBATCH = 4, SEQ = 4096, NTOK = NBATCH * SEQ, DEPTH = 2;
constexpr int D_IN = 2372, NPAD = 2560;
constexpr int NE = 32, TOPK = 4, FF = 1024;
constexpr int NWAVES = 8, NTHREADS = 512;
constexpr float EPS = 1e-6f;
constexpr int ROWCAP = 73728;

constexpr size_t MiB = 1u << 20;
constexpr size_t WS_CTL = 0, CTL_BYTES = 1 * MiB;
constexpr size_t WS_MOD = 1 * MiB;
constexpr size_t WS_ROPEC = 2 * MiB;
constexpr size_t WS_ROPES = 4 * MiB;
constexpr size_t WS_WIN = 6 * MiB;
constexpr size_t WS_WOUT = 16 * MiB;
constexpr size_t WS_ROWTOK = 20 * MiB;
constexpr size_t WS_EIDX = 22 * MiB;
constexpr size_t WS_SLOT = 22 * MiB + 256 * 1024;
constexpr size_t WS_GATE = 22 * MiB + 512 * 1024;
constexpr size_t WS_WI = 23 * MiB;
constexpr size_t WS_WRH = 23 * MiB + 256 * 1024;
constexpr size_t WS_WRL = 23 * MiB + 512 * 1024;
constexpr size_t WS_KI = 24 * MiB;
constexpr size_t WS_K = 26 * MiB;
constexpr size_t WS_V = 30 * MiB;
constexpr size_t WS_QI = 34 * MiB;
constexpr size_t WS_Q = 42 * MiB;
constexpr size_t WS_UB = 58 * MiB;
constexpr size_t WS_HG = 74 * MiB;
constexpr size_t WS_SEL = 138 * MiB;
constexpr size_t WS_HL = 154 * MiB;
constexpr size_t WS_HD = 170 * MiB;
constexpr size_t WS_MIX = 171 * MiB;
constexpr size_t WS_U = 203 * MiB;
constexpr size_t WS_H = 235 * MiB;
constexpr size_t WS_W1 = 299 * MiB;
constexpr size_t WS_W2 = 555 * MiB;
constexpr size_t WS_ACT = 683 * MiB;
constexpr size_t WS_Y = 827 * MiB;
constexpr size_t WS_END = 971 * MiB;
constexpr int CW_CNT = 1024;
constexpr int CW_BAR = 8192;

constexpr int LDS_BYTES = 147456;
constexpr int LDS_TAB = 131072;
constexpr int LDS_PARK = 131072 + 1024;

__device__ __forceinline__ unsigned f2bf(float f) { unsigned u = __builtin_bit_cast(unsigned, f); return (u + 0x7fffu + ((u >> 16) & 1u)) >> 16; }
typedef __bf16 bf16x2_t __attribute__((ext_vector_type(2)));
__device__ __forceinline__ unsigned cvt_pk_bf16(float lo, float hi) { const f32x2 v = {lo, hi}; const bf16x2_t b = __builtin_convertvector(v, bf16x2_t); return __builtin_bit_cast(unsigned, b); }
__device__ __forceinline__ unsigned pk2(float lo, float hi) { return cvt_pk_bf16(lo, hi); }
__device__ __forceinline__ float bf2f(unsigned short b) { return __builtin_bit_cast(float, ((unsigned)b) << 16); }
__device__ __forceinline__ float bflo(unsigned w) { return __builtin_bit_cast(float, w << 16); }
__device__ __forceinline__ float bfhi(unsigned w) { return __builtin_bit_cast(float, w & 0xffff0000u); }
__device__ __forceinline__ float wave_sum(float v) {
#pragma unroll
    for (int o = 1; o < 64; o <<= 1) v += __shfl_xor(v, o);
    return v;
}
__device__ __forceinline__ float wave_max(float v) {
#pragma unroll
    for (int o = 1; o < 64; o <<= 1) v = fmaxf(v, __shfl_xor(v, o));
    return v;
}
__device__ __forceinline__ float sigmoidf_(float z) { return __builtin_amdgcn_rcpf(1.0f + __expf(-z)); }
__device__ __forceinline__ float siluf_(float z) { return z * __builtin_amdgcn_rcpf(1.0f + __expf(-z)); }

namespace pg8 {
constexpr int BM = 256, BK = 64, HALF = 128, HTB = HALF * BK * 2, STAGE_BYTES = 8 * HTB;
constexpr int KD = 1024, NKT = KD / BK;
__host__ __device__ __forceinline__ int lds_byte(int r, int c) { const int st = (r >> 4) * 2 + (c >> 5), rr = r & 15, cc = c & 31, ob = rr * 64 + cc * 2; return st * 1024 + (ob ^ (((ob >> 9) & 1) << 5)); }
__host__ __device__ __forceinline__ void stage_rc(int b, int& R, int& C) { const int st = b / 1024, sb = b % 1024, swz = sb ^ (((sb >> 9) & 1) << 5); R = (st >> 1) * 16 + swz / 64; C = (st & 1) * 32 + (swz % 64) / 2; }

struct Unit { const char* A; const char* B; const int* ridx; int nvalid; int row0, pn, e, b; };

template <class Epi, class Sched, bool GATHER, bool ALIGN_EPI>
__device__ __forceinline__ void gemm_phase(LAS unsigned char* lds, LAS unsigned* park, int tid_in, const Sched& S, const Epi& E) {
    const int tid = tid_in, wid = __builtin_amdgcn_readfirstlane(tid >> 6), lane = tid & 63, wr = wid >> 2, wc = wid & 3, fr = lane & 15, fq = lane >> 4;
    constexpr int K = KD, nt = NKT;
    unsigned voffB[2], vA[2][2];
#pragma unroll
    for (int i = 0; i < 2; ++i) { int R, C; stage_rc(tid * 16 + i * 8192, R, C); voffB[i] = (unsigned)(R * K + C) * 2u; }
    constexpr size_t kstep = (size_t)(BK * 2);
    constexpr size_t hstep = (size_t)HALF * K * 2;
    const unsigned ldsw = (unsigned)wid * 1024u;
    const int aoff = lds_byte(wr * 64 + fr, fq * 8), boff = lds_byte(wc * 32 + fr, fq * 8);
#define PG8_SA(b, h) (((b) * 2 + (h)) * HTB)
#define PG8_SB(b, h) ((4 + (b) * 2 + (h)) * HTB)
#define PG8_STAGE(bufoff, gbase, voff) do { _Pragma("unroll") for (int _i = 0; _i < 2; ++_i) \
        __builtin_amdgcn_global_load_lds((const unsigned*)((const char*)(gbase) + (voff)[_i]), (LAS unsigned*)(lds + (bufoff) + ldsw + _i * 8192), 16, 0, 0); } while (0)
#define PG8_LDA(dst, b, h) do { _Pragma("unroll") for (int m = 0; m < 4; ++m) _Pragma("unroll") for (int k = 0; k < 2; ++k) dst[m][k] = *(const LAS bf16x8*)(lds + PG8_SA(b, h) + aoff + m * 2048 + k * 1024); } while (0)
#define PG8_LDB(dst, b, h) do { _Pragma("unroll") for (int n = 0; n < 2; ++n) _Pragma("unroll") for (int k = 0; k < 2; ++k) dst[n][k] = *(const LAS bf16x8*)(lds + PG8_SB(b, h) + boff + n * 2048 + k * 1024); } while (0)
#define PG8_MMA(ai, bj, At, Bt) do { __builtin_amdgcn_s_setprio(1); _Pragma("unroll") for (int m = 0; m < 4; ++m) _Pragma("unroll") for (int n = 0; n < 2; ++n) _Pragma("unroll") for (int k = 0; k < 2; ++k) \
        acc[ai][bj][m][n] = __builtin_amdgcn_mfma_f32_16x16x32_bf16(Bt[n][k], At[m][k], acc[ai][bj][m][n], 0, 0, 0); __builtin_amdgcn_s_setprio(0); } while (0)
#define PG8_WAIT_V(n) asm volatile("s_waitcnt vmcnt(" #n ")" ::: "memory")
#define PG8_WAIT_L(n) asm volatile("s_waitcnt lgkmcnt(" #n ")" ::: "memory")
#define PG8_BAR __builtin_amdgcn_s_barrier()
#define PG8_SCHED __builtin_amdgcn_sched_barrier(0)
#define PG8_OFFS(dst, u) do { _Pragma("unroll") for (int _h = 0; _h < 2; ++_h) _Pragma("unroll") for (int _i = 0; _i < 2; ++_i) { \
        int _R, _C; stage_rc(tid * 16 + _i * 8192, _R, _C); const int _rr = _h * HALF + _R; \
        if constexpr (GATHER) { const int _ix = (u).ridx[_rr < (u).nvalid ? _rr : 0]; dst[_h][_i] = (unsigned)(_ix * K + _C) * 2u; } \
        else dst[_h][_i] = (unsigned)(_rr * K + _C) * 2u; } } while (0)
    Unit cur, nxt; int ui = 0;
    if (!S.next(0, cur)) return;
    f32x4 acc[2][2][4][2];
#pragma unroll
    for (int a = 0; a < 2; ++a)
#pragma unroll
        for (int b = 0; b < 2; ++b)
#pragma unroll
            for (int m = 0; m < 4; ++m)
#pragma unroll
                for (int n = 0; n < 2; ++n) acc[a][b][m][n] = (f32x4){0.f, 0.f, 0.f, 0.f};
    bf16x8 At[4][2], B0[2][2], B1[2][2];
    PG8_OFFS(vA, cur);
    const char* cA = cur.A; const char* cB = cur.B;
    PG8_STAGE(PG8_SB(0, 0), cB, voffB); PG8_STAGE(PG8_SB(0, 1), cB + hstep, voffB); PG8_STAGE(PG8_SA(0, 0), cA, vA[0]); PG8_STAGE(PG8_SA(0, 1), cA, vA[1]);
    if (wr == 1) PG8_BAR;
    PG8_WAIT_V(2); PG8_BAR;
    PG8_STAGE(PG8_SB(1, 0), cB + kstep, voffB); PG8_STAGE(PG8_SA(1, 0), cA + kstep, vA[0]); PG8_STAGE(PG8_SB(1, 1), cB + hstep + kstep, voffB);
    PG8_WAIT_V(6); PG8_BAR;
    for (;;) {
        const bool has_next = S.next(ui + 1, nxt);
        const char* nA = has_next ? nxt.A : cA; const char* nB = has_next ? nxt.B : cB;
        if constexpr (GATHER) {
            unsigned nv[2][2];
            if (has_next) { PG8_OFFS(nv, nxt); } else {
#pragma unroll
                for (int h = 0; h < 2; ++h) { nv[h][0] = vA[h][0]; nv[h][1] = vA[h][1]; } }
            *(LAS u32x4*)(park + tid * 4) = (u32x4){nv[0][0], nv[0][1], nv[1][0], nv[1][1]};
        }
        for (int t = 0; t < nt; t += 2) {
            const bool last = (t == nt - 2);
            const char* a1 = cA + (size_t)(t + 1) * kstep;
            const char* a2 = last ? nA : cA + (size_t)(t + 2) * kstep; const char* b2 = last ? nB : cB + (size_t)(t + 2) * kstep;
            const char* a3 = a2 + kstep; const char* b3 = b2 + kstep;
            PG8_LDB(B0, 0, 0); PG8_LDB(B1, 0, 1); PG8_SCHED; PG8_LDA(At, 0, 0); PG8_STAGE(PG8_SA(1, 1), a1, vA[1]);
            if constexpr (GATHER) { if (last) { const u32x4 pv = *(const LAS u32x4*)(park + tid * 4); vA[0][0] = pv.x; vA[0][1] = pv.y; vA[1][0] = pv.z; vA[1][1] = pv.w; } }
            PG8_WAIT_V(8); PG8_WAIT_L(0); PG8_BAR; PG8_MMA(0, 0, At, B0); PG8_MMA(0, 1, At, B1); PG8_BAR; PG8_SCHED;
            PG8_LDA(At, 0, 1); PG8_STAGE(PG8_SB(0, 0), b2, voffB); PG8_STAGE(PG8_SB(0, 1), b2 + hstep, voffB); PG8_STAGE(PG8_SA(0, 0), a2, vA[0]);
            PG8_WAIT_V(8); PG8_WAIT_L(0); PG8_BAR; PG8_MMA(1, 0, At, B0); PG8_MMA(1, 1, At, B1); PG8_BAR; PG8_SCHED;
            PG8_LDB(B0, 1, 0); PG8_LDB(B1, 1, 1); PG8_SCHED; PG8_LDA(At, 1, 0); PG8_STAGE(PG8_SA(0, 1), a2, vA[1]);
            PG8_WAIT_V(8); PG8_WAIT_L(0); PG8_BAR; PG8_MMA(0, 0, At, B0); PG8_MMA(0, 1, At, B1); PG8_BAR; PG8_SCHED;
            PG8_LDA(At, 1, 1); PG8_STAGE(PG8_SB(1, 0), b3, voffB); PG8_STAGE(PG8_SB(1, 1), b3 + hstep, voffB); PG8_STAGE(PG8_SA(1, 0), a3, vA[0]);
            PG8_WAIT_V(8); PG8_WAIT_L(0); PG8_BAR; PG8_MMA(1, 0, At, B0); PG8_MMA(1, 1, At, B1); PG8_BAR; PG8_SCHED;
        }
        if constexpr (ALIGN_EPI) { if (wr == 0) PG8_BAR; }
#ifndef EPIREP
#define EPIREP 1
#endif
        for (int er = 0; er < Epi::REP; ++er) { int fr2 = fr, fq2 = fq; asm volatile("" : "+v"(fr2), "+v"(fq2)); E(acc, cur, wr, wc, fr2, fq2); }
        if (!has_next) break;
#pragma unroll
        for (int a = 0; a < 2; ++a)
#pragma unroll
            for (int b = 0; b < 2; ++b)
#pragma unroll
                for (int m = 0; m < 4; ++m)
#pragma unroll
                    for (int n = 0; n < 2; ++n) acc[a][b][m][n] = (f32x4){0.f, 0.f, 0.f, 0.f};
        cur = nxt; cA = nA; cB = nB; ++ui;
        if constexpr (ALIGN_EPI) { if (wr == 1) PG8_BAR; }
    }
    PG8_WAIT_V(0);
    if constexpr (!ALIGN_EPI) { if (wr == 0) PG8_BAR; }
    PG8_BAR;
#undef PG8_SA
#undef PG8_SB
#undef PG8_STAGE
#undef PG8_LDA
#undef PG8_LDB
#undef PG8_MMA
#undef PG8_WAIT_V
#undef PG8_WAIT_L
#undef PG8_BAR
#undef PG8_SCHED
#undef PG8_OFFS
}
}

struct Args {
    const float* x; const float* c; const int* pos; const float* w_ada; const float* b_ada; const float* norm1_g; const float* norm2_g;
    const float* w_in; const float* w_out; const float* pool_w; const float* pool_scale; const float* hgrn_g; const float* lb_logits;
    const float* w_router; const float* b_router; const float* w1; const float* b1; const float* w2; const float* b2; const float* final_g;
    float* out; unsigned char* ws; int ph_lo, ph_hi;
};

struct Ctx {
    LAS unsigned char* lds;
    int tid, lane, wave, G, vcu;
    unsigned char* ws;
};

struct DenseOrder {
    const char* A; const char* B; int nM, nN, nwg, G, c;
    __device__ __forceinline__ bool next(int i, pg8::Unit& u) const {
        const long L = (long)i * G + c; if (L >= nwg) return false;
        int wgid = (int)L; { const int q = nwg / 8, r = nwg % 8, xcd = wgid % 8, off = wgid / 8; wgid = (xcd < r ? xcd * (q + 1) : r * (q + 1) + (xcd - r) * q) + off; }
        const int nig = 8 * nN, gid = wgid / nig, fm = gid * 8, gsz = (nM - fm) < 8 ? (nM - fm) : 8;
        const int pm = fm + ((wgid % nig) % gsz), pn = (wgid % nig) / gsz;
        u.A = A + (size_t)pm * 256 * pg8::KD * 2; u.B = B + (size_t)pn * 256 * pg8::KD * 2; u.ridx = nullptr; u.nvalid = 256; u.row0 = pm * 256; u.pn = pn; u.e = 0; u.b = pm >> 4;
        return true;
    }
};

template <bool FIRST> struct MoeOrder {
    LAS const int* tab; const char* A; const char* B; const int* rowtok; int G, c;
    static constexpr int NTN = FIRST ? 8 : 4;
    __device__ __forceinline__ bool next(int i, pg8::Unit& u) const {
#ifndef KREP
#define KREP 1
#endif
        const int P = tab[32]; const long L = (long)(i / (FIRST ? 1 : KREP)) * G + c; if (L >= (long)P * NTN) return false;
        const int p = (int)(L / NTN), nt = (int)(L % NTN);
        int e = 0;
#pragma unroll 1
        for (int k = 1; k < 32; ++k) e = (tab[k] <= p) ? k : e;
        const int mt = p - tab[e], cnt = tab[33 + e];
        if (FIRST) { u.A = A; u.ridx = rowtok + e * NTOK + mt * 256; u.nvalid = (cnt - mt * 256) < 256 ? (cnt - mt * 256) : 256; u.B = B + ((size_t)e * 2048 + nt * 256) * pg8::KD * 2; }
        else { u.A = A + (size_t)p * 256 * pg8::KD * 2; u.ridx = nullptr; u.nvalid = 256; u.B = B + ((size_t)e * 1024 + nt * 256) * pg8::KD * 2; }
        u.row0 = p * 256; u.pn = nt; u.e = e; u.b = (FIRST ? 1 : ((i % KREP) == KREP - 1));
        return true;
    }
};

#ifndef EPIREP_IN
#define EPIREP_IN 1
#endif
#ifndef EPIREP_G1
#define EPIREP_G1 1
#endif
#ifndef EPIREP_G2
#define EPIREP_G2 1
#endif
struct EpiIn {
    static constexpr int REP = EPIREP_IN;
    unsigned char* ws;
    __device__ __forceinline__ void operator()(const f32x4 (&acc)[2][2][4][2], const pg8::Unit& u, int wr, int wc, int fr, int fq) const {
        const int pn = u.pn;
        const float* rc = (const float*)(ws + WS_ROPEC); const float* rs = (const float*)(ws + WS_ROPES);
        const bool rope = (pn <= 1) || (pn == 3) || (pn == 2 && wc < 2) || (pn == 4 && wc == 0);
#pragma unroll
        for (int ai = 0; ai < 2; ++ai)
#pragma unroll
            for (int m = 0; m < 4; ++m) {
                const int r = u.row0 + ai * 128 + wr * 64 + m * 16 + fr;
                if (rope) {
                    bf16_t* dst; float scl = 1.f;
                    if (pn <= 1) { dst = (bf16_t*)(ws + WS_Q) + (size_t)r * 512 + (pn * 4 + wc) * 64; scl = 0.125f; }
                    else if (pn == 2) dst = (bf16_t*)(ws + WS_K) + (size_t)r * 128 + wc * 64;
                    else if (pn == 3) dst = (bf16_t*)(ws + WS_QI) + (size_t)r * 256 + wc * 64;
                    else dst = (bf16_t*)(ws + WS_KI) + (size_t)r * 64;
                    const f32x4 c0 = *(const f32x4*)(rc + (size_t)r * 32 + 8 * fq), c1 = *(const f32x4*)(rc + (size_t)r * 32 + 8 * fq + 4), s0 = *(const f32x4*)(rs + (size_t)r * 32 + 8 * fq), s1 = *(const f32x4*)(rs + (size_t)r * 32 + 8 * fq + 4);
                    const f32x4 x10 = acc[ai][0][m][0], x11 = acc[ai][0][m][1], x20 = acc[ai][1][m][0], x21 = acc[ai][1][m][1];
                    const f32x4 o10 = (x10 * c0 - x20 * s0) * scl, o11 = (x11 * c1 - x21 * s1) * scl, o20 = (x20 * c0 + x10 * s0) * scl, o21 = (x21 * c1 + x11 * s1) * scl;
                    u32x4 w1v, w2v; w1v.x = pk2(o10[0], o10[1]); w1v.y = pk2(o10[2], o10[3]); w1v.z = pk2(o11[0], o11[1]); w1v.w = pk2(o11[2], o11[3]);
                    w2v.x = pk2(o20[0], o20[1]); w2v.y = pk2(o20[2], o20[3]); w2v.z = pk2(o21[0], o21[1]); w2v.w = pk2(o21[2], o21[3]);
                    *(u32x4*)(dst + 8 * fq) = w1v; *(u32x4*)(dst + 32 + 8 * fq) = w2v;
                } else if (pn == 2) {
#pragma unroll
                    for (int bj = 0; bj < 2; ++bj) { const f32x4 a0 = acc[ai][bj][m][0], a1 = acc[ai][bj][m][1]; u32x4 w; w.x = pk2(a0[0], a0[1]); w.y = pk2(a0[2], a0[3]); w.z = pk2(a1[0], a1[1]); w.w = pk2(a1[2], a1[3]);
                        *(u32x4*)((bf16_t*)(ws + WS_V) + (size_t)r * 128 + bj * 64 + (wc - 2) * 32 + 8 * fq) = w; }
                } else if (pn == 4) {
                    if (wc == 1 && fq == 0) *(f32x4*)((float*)(ws + WS_WI) + (size_t)r * 4) = acc[ai][0][m][0] * 0.0625f;
                } else {
                    float* p = (pn == 5) ? (float*)(ws + WS_UB) + (size_t)r * 256 + wc * 32 + 8 * fq : (float*)(ws + WS_HG) + (size_t)r * 1024 + (pn - 6) * 256 + wc * 32 + 8 * fq;
#pragma unroll
                    for (int bj = 0; bj < 2; ++bj) { *(f32x4*)(p + bj * 128) = acc[ai][bj][m][0]; *(f32x4*)(p + bj * 128 + 4) = acc[ai][bj][m][1]; }
                }
            }
    }
};
struct EpiOut {
    static constexpr int REP = 1;
    const float* hin; float* hout; const float* gate;
    __device__ __forceinline__ void operator()(const f32x4 (&acc)[2][2][4][2], const pg8::Unit& u, int wr, int wc, int fr, int fq) const {
        const int col0 = u.pn * 256 + wc * 32 + 8 * fq; const float* gp = gate + (size_t)u.b * 6144 + col0;
        f32x4 gv[2][2];
#pragma unroll
        for (int bj = 0; bj < 2; ++bj)
#pragma unroll
            for (int n = 0; n < 2; ++n) gv[bj][n] = *(const f32x4*)(gp + bj * 128 + n * 4);
#pragma unroll
        for (int ai = 0; ai < 2; ++ai)
#pragma unroll
            for (int m = 0; m < 4; ++m) { const size_t off = (size_t)(u.row0 + ai * 128 + wr * 64 + m * 16 + fr) * D + col0;
#pragma unroll
                for (int bj = 0; bj < 2; ++bj)
#pragma unroll
                    for (int n = 0; n < 2; ++n) { const f32x4 hv = *(const f32x4*)(hin + off + bj * 128 + n * 4); *(f32x4*)(hout + off + bj * 128 + n * 4) = hv + gv[bj][n] * acc[ai][bj][m][n]; }
                asm volatile("" ::: "memory"); }
    }
};
struct EpiG1 {
    static constexpr int REP = EPIREP_G1;
    bf16_t* act; const float* b1l;
    __device__ __forceinline__ void operator()(const f32x4 (&acc)[2][2][4][2], const pg8::Unit& u, int wr, int wc, int fr, int fq) const {
        const int ja0 = u.pn * 128 + wc * 32 + 8 * fq; const float* bp = b1l + (size_t)u.e * 2048 + 2 * ja0;
        f32x4 bg[2], bl[2];
#pragma unroll
        for (int n = 0; n < 2; ++n) { const f32x4 t0 = *(const f32x4*)(bp + 8 * n), t1 = *(const f32x4*)(bp + 8 * n + 4); bg[n] = (f32x4){t0[0], t0[2], t1[0], t1[2]}; bl[n] = (f32x4){t0[1], t0[3], t1[1], t1[3]}; }
#pragma unroll
        for (int ai = 0; ai < 2; ++ai)
#pragma unroll
            for (int m = 0; m < 4; ++m) { float o[8];
#pragma unroll
                for (int n = 0; n < 2; ++n) { const f32x4 hg = acc[ai][0][m][n] + bg[n], hl = acc[ai][1][m][n] + bl[n];
#pragma unroll
                    for (int j = 0; j < 4; ++j) { const float xg = fminf(hg[j], 7.0f), xl = fminf(fmaxf(hl[j], -7.0f), 7.0f); o[4 * n + j] = xg * sigmoidf_(1.702f * xg) * (xl + 1.0f); } }
                u32x4 w; w.x = pk2(o[0], o[1]); w.y = pk2(o[2], o[3]); w.z = pk2(o[4], o[5]); w.w = pk2(o[6], o[7]);
                *(u32x4*)(act + (size_t)(u.row0 + ai * 128 + wr * 64 + m * 16 + fr) * FF + ja0) = w; }
    }
};
struct EpiG2 {
    static constexpr int REP = EPIREP_G2;
    bf16_t* y; const float* b2l;
    __device__ __forceinline__ void operator()(const f32x4 (&acc)[2][2][4][2], const pg8::Unit& u, int wr, int wc, int fr, int fq) const {
        if (!u.b) return;
        const int col0 = u.pn * 256 + wc * 32 + 8 * fq; const float* bp = b2l + (size_t)u.e * 1024 + col0;
        f32x4 bv[2][2];
#pragma unroll
        for (int bj = 0; bj < 2; ++bj)
#pragma unroll
            for (int n = 0; n < 2; ++n) bv[bj][n] = *(const f32x4*)(bp + bj * 128 + n * 4);
#pragma unroll
        for (int ai = 0; ai < 2; ++ai)
#pragma unroll
            for (int m = 0; m < 4; ++m) { bf16_t* rowp = y + (size_t)(u.row0 + ai * 128 + wr * 64 + m * 16 + fr) * D + col0;
#pragma unroll
                for (int bj = 0; bj < 2; ++bj) { const f32x4 v0 = acc[ai][bj][m][0] + bv[bj][0], v1 = acc[ai][bj][m][1] + bv[bj][1];
                    u32x4 w; w.x = pk2(v0[0], v0[1]); w.y = pk2(v0[2], v0[3]); w.z = pk2(v1[0], v1[1]); w.w = pk2(v1[2], v1[3]); *(u32x4*)(rowp + bj * 128) = w; } }
    }
};
__device__ __forceinline__ int slot32(int d) { return 16 * ((d >> 2) & 1) + 4 * ((d >> 3) & 3) + (d & 3); }
__device__ __forceinline__ int win_dest(int s) {
    if (s < 512) { const int hd = s >> 6, d64 = s & 63; return 256 * (hd >> 2) + 128 * (d64 >> 5) + 32 * (hd & 3) + slot32(d64 & 31); }
    if (s < 640) { const int hd = (s - 512) >> 6, d64 = s & 63; return 512 + 128 * (d64 >> 5) + 32 * hd + slot32(d64 & 31); }
    if (s < 768) { const int v = s - 640; return 512 + 128 * (v >> 6) + 32 * (2 + ((v & 63) >> 5)) + slot32(v & 31); }
    if (s < 1024) { const int hd = (s - 768) >> 6, d64 = s & 63; return 768 + 128 * (d64 >> 5) + 32 * hd + slot32(d64 & 31); }
    if (s < 1088) { const int d64 = s - 1024; return 1024 + 128 * (d64 >> 5) + slot32(d64 & 31); }
    if (s < 1092) return 1024 + 32 + (s - 1088);
    if (s < 1348) { const int v = s - 1092; return 1280 + (v & ~31) + slot32(v & 31); }
    { const int v = s - 1348; return 1536 + (v & ~31) + slot32(v & 31); }
}
__device__ __forceinline__ int perm_dest(int s) { return (s & ~31) + 16 * ((s >> 2) & 1) + 4 * ((s >> 3) & 3) + (s & 3); }
__device__ __forceinline__ int w1_dest(int s) { const int jg = s >> 1, isl = s & 1, nt = jg >> 7, ja = jg & 127; return 256 * nt + 128 * isl + (ja & ~31) + slot32(ja & 31); }

template <int MAP>
__device__ __forceinline__ void transpose_item(const float* W, int N, bf16_t* WT, LAS float* scr, int kb, int nb, int lane) {
    const int k0 = 64 * kb, n0 = 32 * nb, col = n0 + (lane & 31); const bool ok = col < N;
    float v[32];
    const float* src = W + (size_t)(k0 + (lane >> 5)) * N + (ok ? col : 0);
#pragma unroll
    for (int i = 0; i < 32; ++i) v[i] = src[(size_t)(2 * i) * N];
#pragma unroll
    for (int i = 0; i < 32; ++i) scr[(2 * i + (lane >> 5)) * 33 + (lane & 31)] = ok ? v[i] : 0.f;
    asm volatile("s_waitcnt lgkmcnt(0)" ::: "memory");
    const int c = lane & 7;
#pragma unroll
    for (int j = 0; j < 4; ++j) { const int n = (lane >> 3) + 8 * j; const LAS float* s = scr + (8 * c) * 33 + n;
        u32x4 o; o.x = pk2(s[0 * 33], s[1 * 33]); o.y = pk2(s[2 * 33], s[3 * 33]); o.z = pk2(s[4 * 33], s[5 * 33]); o.w = pk2(s[6 * 33], s[7 * 33]);
        const int sc = n0 + n;
        if (sc < N) { const int dest = MAP == 1 ? win_dest(sc) : (MAP == 2 ? w1_dest(sc) : (MAP == 3 ? perm_dest(sc) : sc)); *(u32x4*)(WT + (size_t)dest * 1024 + k0 + 8 * c) = o; } }
    asm volatile("s_waitcnt lgkmcnt(0)" ::: "memory");
}

__device__ __forceinline__ void phase_prep(const Args& a, Ctx& C) {
    unsigned char* ws = C.ws;
    {
        LAS float* ca = (LAS float*)C.lds;
        LAS float* red = ca + 4096;
        for (int i = C.tid; i < 4096; i += NTHREADS) { const float v = a.c[i]; ca[i] = siluf_(v); }
        __syncthreads();
        for (int it = blockIdx.x; it < 192; it += C.G) {
            const int l = it / 96, cb = it % 96, col = cb * 64 + (C.tid & 63), kg = C.tid >> 6;
            const float* w = a.w_ada + (size_t)l * 1024 * 6144 + col;
            float s0 = 0.f, s1 = 0.f, s2 = 0.f, s3 = 0.f;
#pragma unroll 8
            for (int k = kg * 128; k < kg * 128 + 128; ++k) { const float wv = w[(size_t)k * 6144]; s0 += ca[k] * wv; s1 += ca[1024 + k] * wv; s2 += ca[2048 + k] * wv; s3 += ca[3072 + k] * wv; }
            red[(kg * 4 + 0) * 64 + (C.tid & 63)] = s0; red[(kg * 4 + 1) * 64 + (C.tid & 63)] = s1; red[(kg * 4 + 2) * 64 + (C.tid & 63)] = s2; red[(kg * 4 + 3) * 64 + (C.tid & 63)] = s3;
            __syncthreads();
            if (C.tid < 256) { const int b = C.tid >> 6, cc = C.tid & 63; float s = 0.f;
#pragma unroll
                for (int g = 0; g < 8; ++g) s += red[(g * 4 + b) * 64 + cc];
                ((float*)(ws + WS_MOD))[(size_t)(l * 4 + b) * 6144 + cb * 64 + cc] = s + a.b_ada[l * 6144 + cb * 64 + cc]; }
            __syncthreads();
        }
    }
    const int gw = C.vcu * NWAVES + C.wave, NGW = C.G * NWAVES;
    for (int tk = gw; tk < NTOK; tk += NGW) {
        if (C.lane < 32) {
            const float posf = (float)a.pos[tk];
            const float inv = exp2f(-(float)C.lane * (13.287712379549449f / 32.0f));
            const double ang = (double)(posf * inv);
            const double kq = rint(ang * 0.63661977236758134308);
            const double y = fma(-kq, 1.57079632679489661923, ang);
            const double y2 = y * y;
            const double sy = y * (1.0 + y2 * (-1.0 / 6 + y2 * (1.0 / 120 + y2 * (-1.0 / 5040 + y2 * (1.0 / 362880 - y2 * (1.0 / 39916800))))));
            const double cy = 1.0 + y2 * (-0.5 + y2 * (1.0 / 24 + y2 * (-1.0 / 720 + y2 * (1.0 / 40320 + y2 * (-1.0 / 3628800 + y2 * (1.0 / 479001600))))));
            const int q = ((int)((long long)kq)) & 3;
            const double sn = (q == 0) ? sy : (q == 1) ? cy : (q == 2) ? -sy : -cy;
            const double cs = (q == 0) ? cy : (q == 1) ? -sy : (q == 2) ? -cy : sy;
            ((float*)(ws + WS_ROPEC))[(size_t)tk * 32 + C.lane] = (float)cs;
            ((float*)(ws + WS_ROPES))[(size_t)tk * 32 + C.lane] = (float)sn;
        }
    }
    for (int i = gw * 64 + C.lane; i < 2 * 32 * 1024; i += NGW * 64) { const int l = i >> 15, e = (i >> 10) & 31, k = i & 1023; const float wv = a.w_router[(size_t)l * 32768 + k * 32 + e];
        const unsigned hi = f2bf(wv); const float lo = wv - bf2f((unsigned short)hi); ((bf16_t*)(ws + WS_WRH))[i] = (bf16_t)hi; ((bf16_t*)(ws + WS_WRL))[i] = (bf16_t)f2bf(lo); }
    LAS float* scr = (LAS float*)(C.lds + C.wave * 16384);
    constexpr int I_IN = 2 * 16 * 75, I_OUT = 2 * 16 * 32;
    for (int it = gw; it < I_IN + I_OUT; it += NGW) {
        int r = it;
        if (r < I_IN) { const int l = r / (16 * 75), q = r % (16 * 75); transpose_item<1>(a.w_in + (size_t)l * 1024 * D_IN, D_IN, (bf16_t*)(ws + WS_WIN) + (size_t)l * NPAD * 1024, scr, q / 75, q % 75, C.lane); continue; }
        r -= I_IN;
        { const int l = r / (16 * 32), q = r % (16 * 32); transpose_item<3>(a.w_out + (size_t)l * 1024 * 1024, 1024, (bf16_t*)(ws + WS_WOUT) + (size_t)l * 1024 * 1024, scr, q / 32, q % 32, C.lane); }
    }
}

struct Conv {
    const float* w1l; const float* w2l; bf16_t* w1t; bf16_t* w2t;
    int it, step, lane; bool pend;
    const float* W; bf16_t* WT; int N, map, k0, n0;
    float v[32];
    static constexpr int NITEMS = 32 * 16 * 64 + 32 * 16 * 32;
    __device__ __forceinline__ void issue() {
        if (it >= NITEMS) return;
        if (it < 32 * 16 * 64) { const int e = it >> 10, q = it & 1023; W = w1l + (size_t)e * 1024 * 2048; WT = w1t + (size_t)e * 2048 * 1024; N = 2048; map = 2; k0 = 64 * (q >> 6); n0 = 32 * (q & 63); }
        else { const int r = it - 32 * 16 * 64, e = r >> 9, q = r & 511; W = w2l + (size_t)e * 1024 * 1024; WT = w2t + (size_t)e * 1024 * 1024; N = 1024; map = 3; k0 = 64 * (q >> 5); n0 = 32 * (q & 31); }
        const float* src = W + (size_t)(k0 + (lane >> 5)) * N + n0 + (lane & 31);
#pragma unroll
        for (int i = 0; i < 32; ++i) v[i] = src[(size_t)(2 * i) * N];
        pend = true; it += step;
    }
    __device__ __forceinline__ void finish(LAS float* scr) {
        if (!pend) return;
#pragma unroll
        for (int i = 0; i < 32; ++i) scr[(2 * i + (lane >> 5)) * 33 + (lane & 31)] = v[i];
        asm volatile("s_waitcnt lgkmcnt(0)" ::: "memory");
        const int c = lane & 7;
#pragma unroll
        for (int j = 0; j < 4; ++j) { const int n = (lane >> 3) + 8 * j; const LAS float* sp = scr + (8 * c) * 33 + n;
            u32x4 o; o.x = pk2(sp[0 * 33], sp[1 * 33]); o.y = pk2(sp[2 * 33], sp[3 * 33]); o.z = pk2(sp[4 * 33], sp[5 * 33]); o.w = pk2(sp[6 * 33], sp[7 * 33]);
            const int sc = n0 + n; const int dest = map == 2 ? w1_dest(sc) : perm_dest(sc); *(u32x4*)(WT + (size_t)dest * 1024 + k0 + 8 * c) = o; }
        asm volatile("s_waitcnt lgkmcnt(0)" ::: "memory");
        pend = false;
    }
};

__device__ __forceinline__ void norm_mod_store(const f32x4 (&v)[4], const float* g, const float* sh, const float* sc, bf16_t* urow, int lane) {
    float ss = 0.f;
#pragma unroll
    for (int j = 0; j < 4; ++j) ss += (v[j].x * v[j].x + v[j].y * v[j].y) + (v[j].z * v[j].z + v[j].w * v[j].w);
    const float rstd = 1.0f / sqrtf(wave_sum(ss) * (1.0f / D) + EPS);
#pragma unroll
    for (int j = 0; j < 4; ++j) { const int idx = 4 * lane + 256 * j; const f32x4 gv = *(const f32x4*)(g + idx), shv = *(const f32x4*)(sh + idx), scv = *(const f32x4*)(sc + idx);
        const f32x4 o = v[j] * rstd * gv * (scv + 1.0f) + shv; u32x2 w; w.x = pk2(o[0], o[1]); w.y = pk2(o[2], o[3]); *(u32x2*)(urow + idx) = w; }
}

__device__ __forceinline__ void phase_u0(const Args& a, Ctx& C) {
    const int gw = C.vcu * NWAVES + C.wave, NGW = C.G * NWAVES; const float* mod = (const float*)(C.ws + WS_MOD);
    for (int tk = gw; tk < NTOK; tk += NGW) {
        const int b = tk >> 12; const f32x4* xr = (const f32x4*)(a.x + (size_t)tk * D) + C.lane; f32x4 v[4];
#pragma unroll
        for (int j = 0; j < 4; ++j) v[j] = xr[64 * j];
        const float* mb = mod + (size_t)(0 * 4 + b) * 6144;
        norm_mod_store(v, a.norm1_g, mb + 0, mb + 1024, (bf16_t*)(C.ws + WS_U) + (size_t)tk * D, C.lane);
    }
}

__device__ __forceinline__ unsigned sortable(float f) { const unsigned u = __builtin_bit_cast(unsigned, f); return (u & 0x80000000u) ? ~u : (u | 0x80000000u); }
__device__ __forceinline__ int mbcnt64(unsigned long long m) { return __builtin_amdgcn_mbcnt_hi((unsigned)(m >> 32), __builtin_amdgcn_mbcnt_lo((unsigned)m, 0)); }

__device__ __forceinline__ void select_query(Ctx& C, int tk, LAS float* sc, LAS float* qs) {
    unsigned char* ws = C.ws; const int lane = C.lane;
    const int tpos = tk & (SEQ - 1), b = tk >> 12, cch = tpos >> 6, L = 64 * (cch + 1), nj = cch + 1;
    int* sel = (int*)(ws + WS_SEL) + (size_t)tk * 256;
    if (L <= 256) { for (int i = lane; i < L; i += 64) sel[i] = i; return; }
    {
        const u32x2 w = *(const u32x2*)((const bf16_t*)(ws + WS_QI) + (size_t)tk * 256 + 4 * lane);
        *(LAS f32x4*)(qs + 4 * lane) = (f32x4){bflo(w.x), bfhi(w.x), bflo(w.y), bfhi(w.y)};
    }
    const f32x4 wi = *(const f32x4*)((const float*)(ws + WS_WI) + (size_t)tk * 4);
    asm volatile("s_waitcnt lgkmcnt(0)" ::: "memory"); __builtin_amdgcn_wave_barrier();
    const bf16_t* kib = (const bf16_t*)(ws + WS_KI) + (size_t)b * SEQ * 64;
#pragma unroll 1
    for (int j0 = 0; j0 < 64; ++j0) {
        asm volatile("" ::: "memory");
        const int sA = 64 * j0 + lane;
        if (j0 >= nj) { sc[sA] = -3.0e38f; continue; }
        u32x4 ka[8];
#pragma unroll
        for (int i = 0; i < 8; ++i) ka[i] = *(const u32x4*)(kib + (size_t)sA * 64 + 8 * i);
        float aA[4] = {0.f, 0.f, 0.f, 0.f};
#pragma unroll
        for (int i = 0; i < 8; ++i) {
            const float a0 = bflo(ka[i].x), a1 = bfhi(ka[i].x), a2 = bflo(ka[i].y), a3 = bfhi(ka[i].y), a4 = bflo(ka[i].z), a5 = bfhi(ka[i].z), a6 = bflo(ka[i].w), a7 = bfhi(ka[i].w);
#pragma unroll
            for (int h = 0; h < 4; ++h) {
                const f32x4 q0 = *(const LAS f32x4*)(qs + h * 64 + 8 * i), q1 = *(const LAS f32x4*)(qs + h * 64 + 8 * i + 4);
                aA[h] += q0.x * a0 + q0.y * a1 + q0.z * a2 + q0.w * a3 + q1.x * a4 + q1.y * a5 + q1.z * a6 + q1.w * a7;
            }
        }
        float scA = fmaxf(aA[0], 0.f) * wi[0] + fmaxf(aA[1], 0.f) * wi[1] + fmaxf(aA[2], 0.f) * wi[2] + fmaxf(aA[3], 0.f) * wi[3];
        scA = (scA == 0.f) ? 0.f : scA;
        sc[sA] = scA;
    }
    asm volatile("s_waitcnt lgkmcnt(0)" ::: "memory"); __builtin_amdgcn_wave_barrier();
    unsigned key[64];
#pragma unroll
    for (int j = 0; j < 64; ++j) key[j] = sortable(sc[64 * j + lane]);
    unsigned T = 0u;
#pragma unroll 1
    for (int bit = 31; bit >= 0; --bit) {
        const unsigned cand = T | (1u << bit); int c = 0;
#pragma unroll
        for (int j = 0; j < 64; ++j) c += (key[j] >= cand) ? 1 : 0;
#pragma unroll
        for (int o = 1; o < 64; o <<= 1) c += __shfl_xor(c, o);
        if (c >= 256) T = cand;
    }
    int cgt = 0;
#pragma unroll
    for (int j = 0; j < 64; ++j) cgt += (key[j] > T) ? 1 : 0;
#pragma unroll
    for (int o = 1; o < 64; o <<= 1) cgt += __shfl_xor(cgt, o);
    const int need = 256 - cgt; int base = 0, eqseen = 0;
#pragma unroll 1
    for (int j = 0; j < nj; ++j) {
        const unsigned kj = sortable(sc[64 * j + lane]);
        const bool gt = kj > T, eq = kj == T; const unsigned long long em = __ballot(eq);
        const bool take = gt || (eq && (eqseen + mbcnt64(em)) < need); const unsigned long long tm = __ballot(take);
        if (take) sel[base + mbcnt64(tm)] = 64 * j + lane;
        base += __popcll(tm); eqseen += __popcll(em);
    }
}

__device__ __forceinline__ void attend_query(Ctx& C, int tk, LAS float* qf, LAS float* P, LAS int* sl) {
    unsigned char* ws = C.ws; const int lane = C.lane;
    const int tpos = tk & (SEQ - 1), b = tk >> 12, L = 64 * ((tpos >> 6) + 1), nsel = L < 256 ? L : 256;
    {
        const u32x4 w = *(const u32x4*)((const bf16_t*)(ws + WS_Q) + (size_t)tk * 512 + 8 * lane);
        *(LAS f32x4*)(qf + 8 * lane) = (f32x4){bflo(w.x), bfhi(w.x), bflo(w.y), bfhi(w.y)}; *(LAS f32x4*)(qf + 8 * lane + 4) = (f32x4){bflo(w.z), bfhi(w.z), bflo(w.w), bfhi(w.w)};
        const int* sg = (const int*)(ws + WS_SEL) + (size_t)tk * 256;
#pragma unroll
        for (int i = 0; i < 4; ++i) sl[64 * i + lane] = (64 * i + lane) < nsel ? sg[64 * i + lane] : 0;
    }
    asm volatile("s_waitcnt lgkmcnt(0)" ::: "memory"); __builtin_amdgcn_wave_barrier();
    const bf16_t* kb = (const bf16_t*)(ws + WS_K) + (size_t)b * SEQ * 128; const bf16_t* vb = (const bf16_t*)(ws + WS_V) + (size_t)b * SEQ * 128;
#pragma unroll 1
    for (int i = 0; i < 4; ++i) {
        const int slot = 64 * i + lane; const bool valid = slot < nsel; const int key = sl[slot];
#pragma unroll 1
        for (int n = 0; n < 2; ++n) {
            asm volatile("" ::: "memory");
            float ac[4] = {0.f, 0.f, 0.f, 0.f};
#pragma unroll 1
            for (int c2 = 0; c2 < 4; ++c2) {
                asm volatile("" ::: "memory");
                u32x4 kr[2];
#pragma unroll
                for (int c = 0; c < 2; ++c) kr[c] = *(const u32x4*)(kb + (size_t)key * 128 + n * 64 + 8 * (2 * c2 + c));
#pragma unroll
                for (int c = 0; c < 2; ++c) {
                    const float a0 = bflo(kr[c].x), a1 = bfhi(kr[c].x), a2 = bflo(kr[c].y), a3 = bfhi(kr[c].y), a4 = bflo(kr[c].z), a5 = bfhi(kr[c].z), a6 = bflo(kr[c].w), a7 = bfhi(kr[c].w);
#pragma unroll
                    for (int h = 0; h < 4; ++h) {
                        const f32x4 q0 = *(const LAS f32x4*)(qf + (4 * n + h) * 64 + 8 * (2 * c2 + c)), q1 = *(const LAS f32x4*)(qf + (4 * n + h) * 64 + 8 * (2 * c2 + c) + 4);
                        ac[h] += q0.x * a0 + q0.y * a1 + q0.z * a2 + q0.w * a3 + q1.x * a4 + q1.y * a5 + q1.z * a6 + q1.w * a7;
                    }
                }
            }
            *(LAS f32x4*)(P + slot * 8 + 4 * n) = valid ? (f32x4){ac[0], ac[1], ac[2], ac[3]} : (f32x4){-1e30f, -1e30f, -1e30f, -1e30f};
        }
    }
    asm volatile("s_waitcnt lgkmcnt(0)" ::: "memory"); __builtin_amdgcn_wave_barrier();
    float lg[4][8];
#pragma unroll
    for (int i = 0; i < 4; ++i) { const f32x4 t0 = *(const LAS f32x4*)(P + (64 * i + lane) * 8), t1 = *(const LAS f32x4*)(P + (64 * i + lane) * 8 + 4);
        lg[i][0] = t0.x; lg[i][1] = t0.y; lg[i][2] = t0.z; lg[i][3] = t0.w; lg[i][4] = t1.x; lg[i][5] = t1.y; lg[i][6] = t1.z; lg[i][7] = t1.w; }
    float inv[8];
#pragma unroll
    for (int h = 0; h < 8; ++h) {
        const float m = wave_max(fmaxf(fmaxf(lg[0][h], lg[1][h]), fmaxf(lg[2][h], lg[3][h]))); float s = 0.f;
#pragma unroll
        for (int i = 0; i < 4; ++i) { const float p = (64 * i + lane) < nsel ? __expf(lg[i][h] - m) : 0.f; lg[i][h] = p; s += p; }
        inv[h] = 1.0f / wave_sum(s);
    }
#pragma unroll
    for (int i = 0; i < 4; ++i) { LAS float* pp = P + (64 * i + lane) * 8;
        *(LAS f32x4*)pp = (f32x4){lg[i][0], lg[i][1], lg[i][2], lg[i][3]}; *(LAS f32x4*)(pp + 4) = (f32x4){lg[i][4], lg[i][5], lg[i][6], lg[i][7]}; }
    asm volatile("s_waitcnt lgkmcnt(0)" ::: "memory"); __builtin_amdgcn_wave_barrier();
    float o[8] = {0.f, 0.f, 0.f, 0.f, 0.f, 0.f, 0.f, 0.f};
#pragma unroll 4
    for (int slot = 0; slot < nsel; ++slot) {
        const int key = sl[slot];
        const float v0 = bf2f(vb[(size_t)key * 128 + lane]), v1 = bf2f(vb[(size_t)key * 128 + 64 + lane]);
        const f32x4 p0 = *(const LAS f32x4*)(P + slot * 8), p1 = *(const LAS f32x4*)(P + slot * 8 + 4);
        o[0] += p0.x * v0; o[1] += p0.y * v0; o[2] += p0.z * v0; o[3] += p0.w * v0; o[4] += p1.x * v1; o[5] += p1.y * v1; o[6] += p1.z * v1; o[7] += p1.w * v1;
    }
    bf16_t* mo = (bf16_t*)(ws + WS_MIX) + (size_t)tk * D;
#pragma unroll
    for (int h = 0; h < 8; ++h) mo[h * 64 + lane] = (bf16_t)f2bf(o[h] * inv[h]);
    asm volatile("s_waitcnt lgkmcnt(0)" ::: "memory"); __builtin_amdgcn_wave_barrier();
}

__device__ __forceinline__ void pool_item(const Args& a, Ctx& C, int l, int item) {
    unsigned char* ws = C.ws; const int tid = C.tid;
    const int g = item & 3, tt = item >> 2, b = tt >> 6, tp0 = (tt & 63) * 64, w = 2 << g;
    LAS float* ub = (LAS float*)C.lds;
    LAS float* pw = ub + 79 * 64;
    LAS float* pl = pw + 64 * 64;
    const float* ubg = (const float*)(ws + WS_UB);
    for (int idx = tid; idx < 79 * 16; idx += NTHREADS) { const int row = idx >> 4, c4 = idx & 15, tp = tp0 - 15 + row;
        f32x4 v = (f32x4){0.f, 0.f, 0.f, 0.f}; if (tp >= 0) v = *(const f32x4*)(ubg + (size_t)(b * SEQ + tp) * 256 + g * 64 + 4 * c4);
        *(LAS f32x4*)(ub + row * 64 + 4 * c4) = v; }
    for (int idx = tid; idx < 1024; idx += NTHREADS) *(LAS f32x4*)(pw + 4 * idx) = *(const f32x4*)(a.pool_w + (size_t)(l * 4 + g) * 4096 + 4 * idx);
    __syncthreads();
    const int t = tid >> 3, c8 = (tid & 7) * 8, tpos = tp0 + t, wl = (tpos + 1) < w ? (tpos + 1) : w;
    {
        float s[8] = {0.f, 0.f, 0.f, 0.f, 0.f, 0.f, 0.f, 0.f};
        for (int i = 0; i < wl; ++i) {
#pragma unroll
            for (int j = 0; j < 8; ++j) s[j] += ub[(t + 15 - i) * 64 + c8 + j]; }
        const float rw = 1.0f / (float)wl;
#pragma unroll
        for (int j = 0; j < 8; ++j) pl[t * 65 + c8 + j] = s[j] * rw - ub[(t + 15) * 64 + c8 + j];
    }
    __syncthreads();
    float y[8] = {0.f, 0.f, 0.f, 0.f, 0.f, 0.f, 0.f, 0.f};
#pragma unroll 8
    for (int cc = 0; cc < 64; ++cc) { const float p = pl[t * 65 + cc]; const f32x4 w0 = *(const LAS f32x4*)(pw + cc * 64 + c8), w1 = *(const LAS f32x4*)(pw + cc * 64 + c8 + 4);
        y[0] += p * w0.x; y[1] += p * w0.y; y[2] += p * w0.z; y[3] += p * w0.w; y[4] += p * w1.x; y[5] += p * w1.y; y[6] += p * w1.z; y[7] += p * w1.w; }
    const float* ps = a.pool_scale + l * 256 + g * 64 + c8;
    u32x4 o; o.x = pk2(y[0] * ps[0], y[1] * ps[1]); o.y = pk2(y[2] * ps[2], y[3] * ps[3]); o.z = pk2(y[4] * ps[4], y[5] * ps[5]); o.w = pk2(y[6] * ps[6], y[7] * ps[7]);
    *(u32x4*)((bf16_t*)(ws + WS_MIX) + (size_t)(b * SEQ + tpos) * D + 512 + g * 64 + c8) = o;
    __syncthreads();
}

constexpr int HP = 65;
__device__ __forceinline__ void hgrn_gates(const Args& a, Ctx& C, int l, int b, int hh, int c, LAS float* bq, LAS float* kin) {
    const int tid = C.tid, s = tid >> 3, k8 = (tid & 7) * 8;
    const float* z = (const float*)(C.ws + WS_HG) + (size_t)(b * SEQ + c * 64 + s) * 1024 + 256 + hh * 64 + k8;
    const f32x4 z0 = *(const f32x4*)z, z1 = *(const f32x4*)(z + 4); const float zz[8] = {z0.x, z0.y, z0.z, z0.w, z1.x, z1.y, z1.z, z1.w};
#pragma unroll
    for (int j = 0; j < 8; ++j) {
        const int kk = hh * 64 + k8 + j; float lb = 0.f;
        if (l == 1) lb = 1.0f / (1.0f + expf(a.lb_logits[kk] - a.lb_logits[256 + kk]));
        const float sg = 1.0f / (1.0f + expf(-zz[j])), sn = 1.0f / (1.0f + expf(zz[j]));
        bq[s * HP + k8 + j] = logf(lb + (1.0f - lb) * sg); kin[s * HP + k8 + j] = (1.0f - lb) * sn;
    }
    __syncthreads();
    if (tid < 64) { float r = 0.f; for (int ss = 0; ss < 64; ++ss) { r += bq[ss * HP + tid]; bq[ss * HP + tid] = r; } }
    __syncthreads();
}
__device__ __forceinline__ void hgrn_local_item(const Args& a, Ctx& C, int l, int item) {
    const int tid = C.tid, c = item & 63, hh = (item >> 6) & 3, b = item >> 8;
    LAS float* bq = (LAS float*)C.lds; LAS float* kin = bq + 64 * HP; LAS float* vv = kin + 64 * HP;
    hgrn_gates(a, C, l, b, hh, c, bq, kin);
    { const int s = tid >> 3, k8 = (tid & 7) * 8;
        const float* vp = (const float*)(C.ws + WS_HG) + (size_t)(b * SEQ + c * 64 + s) * 1024 + 512 + hh * 64 + k8;
        *(LAS f32x4*)(vv + s * 64 + k8) = *(const f32x4*)vp; *(LAS f32x4*)(vv + s * 64 + k8 + 4) = *(const f32x4*)(vp + 4);
#pragma unroll
        for (int j = 0; j < 8; ++j) kin[s * HP + k8 + j] *= __expf(bq[63 * HP + k8 + j] - bq[s * HP + k8 + j]); }
    __syncthreads();
    const int k = tid >> 3, v8 = (tid & 7) * 8; float Lr[8] = {0.f, 0.f, 0.f, 0.f, 0.f, 0.f, 0.f, 0.f};
#pragma unroll 8
    for (int s = 0; s < 64; ++s) { const float w = kin[s * HP + k]; const f32x4 x0 = *(const LAS f32x4*)(vv + s * 64 + v8), x1 = *(const LAS f32x4*)(vv + s * 64 + v8 + 4);
        Lr[0] += w * x0.x; Lr[1] += w * x0.y; Lr[2] += w * x0.z; Lr[3] += w * x0.w; Lr[4] += w * x1.x; Lr[5] += w * x1.y; Lr[6] += w * x1.z; Lr[7] += w * x1.w; }
    float* hl = (float*)(C.ws + WS_HL) + (size_t)item * 4096 + k * 64 + v8;
    *(f32x4*)hl = (f32x4){Lr[0], Lr[1], Lr[2], Lr[3]}; *(f32x4*)(hl + 4) = (f32x4){Lr[4], Lr[5], Lr[6], Lr[7]};
    if ((tid & 7) == 0) ((float*)(C.ws + WS_HD))[(size_t)item * 64 + k] = __expf(bq[63 * HP + k]);
    __syncthreads();
}
__device__ __forceinline__ void hgrn_out_item(const Args& a, Ctx& C, int l, int item) {
    const int tid = C.tid, c = item & 63, hh = (item >> 6) & 3, b = item >> 8;
    LAS float* bq = (LAS float*)C.lds; LAS float* kin = bq + 64 * HP; LAS float* qq = kin + 64 * HP; LAS float* At = qq + 64 * HP; LAS float* vv = At + 64 * HP; LAS float* Ss = vv + 4096;
    hgrn_gates(a, C, l, b, hh, c, bq, kin);
    { const int s = tid >> 3, k8 = (tid & 7) * 8; const float* row = (const float*)(C.ws + WS_HG) + (size_t)(b * SEQ + c * 64 + s) * 1024 + hh * 64 + k8;
        const f32x4 q0 = *(const f32x4*)row, q1 = *(const f32x4*)(row + 4);
        qq[s * HP + k8 + 0] = siluf_(q0.x); qq[s * HP + k8 + 1] = siluf_(q0.y); qq[s * HP + k8 + 2] = siluf_(q0.z); qq[s * HP + k8 + 3] = siluf_(q0.w);
        qq[s * HP + k8 + 4] = siluf_(q1.x); qq[s * HP + k8 + 5] = siluf_(q1.y); qq[s * HP + k8 + 6] = siluf_(q1.z); qq[s * HP + k8 + 7] = siluf_(q1.w);
        *(LAS f32x4*)(vv + s * 64 + k8) = *(const f32x4*)(row + 512); *(LAS f32x4*)(vv + s * 64 + k8 + 4) = *(const f32x4*)(row + 516); }
    {
        const int k = tid >> 3, v8 = (tid & 7) * 8; f32x4 s0 = (f32x4){0.f, 0.f, 0.f, 0.f}, s1 = s0;
        const float* hl = (const float*)(C.ws + WS_HL) + (size_t)(item - c) * 4096 + k * 64 + v8; const float* hd = (const float*)(C.ws + WS_HD) + (size_t)(item - c) * 64 + k;
#pragma unroll 4
        for (int j = 0; j < c; ++j) { const float dj = hd[(size_t)j * 64]; const f32x4 l0 = *(const f32x4*)(hl + (size_t)j * 4096), l1 = *(const f32x4*)(hl + (size_t)j * 4096 + 4); s0 = s0 * dj + l0; s1 = s1 * dj + l1; }
        *(LAS f32x4*)(Ss + k * 64 + v8) = s0; *(LAS f32x4*)(Ss + k * 64 + v8 + 4) = s1; }
    __syncthreads();
    { const int t = tid >> 3, sg = tid & 7; float ac[8] = {0.f, 0.f, 0.f, 0.f, 0.f, 0.f, 0.f, 0.f};
        for (int k = 0; k < 64; ++k) { const float qt = qq[t * HP + k], bt = bq[t * HP + k];
#pragma unroll
            for (int i = 0; i < 8; ++i) { const int s = sg + 8 * i; if (s <= t) ac[i] += qt * kin[s * HP + k] * __expf(bt - bq[s * HP + k]); } }
#pragma unroll
        for (int i = 0; i < 8; ++i) At[t * HP + sg + 8 * i] = ac[i]; }
    __syncthreads();
    { const int t = tid >> 3, v8 = (tid & 7) * 8; float o[8] = {0.f, 0.f, 0.f, 0.f, 0.f, 0.f, 0.f, 0.f};
#pragma unroll 4
        for (int k = 0; k < 64; ++k) { const float qe = qq[t * HP + k] * __expf(bq[t * HP + k]); const f32x4 x0 = *(const LAS f32x4*)(Ss + k * 64 + v8), x1 = *(const LAS f32x4*)(Ss + k * 64 + v8 + 4);
            o[0] += qe * x0.x; o[1] += qe * x0.y; o[2] += qe * x0.z; o[3] += qe * x0.w; o[4] += qe * x1.x; o[5] += qe * x1.y; o[6] += qe * x1.z; o[7] += qe * x1.w; }
        for (int s = 0; s <= t; ++s) { const float w = At[t * HP + s]; const f32x4 x0 = *(const LAS f32x4*)(vv + s * 64 + v8), x1 = *(const LAS f32x4*)(vv + s * 64 + v8 + 4);
            o[0] += w * x0.x; o[1] += w * x0.y; o[2] += w * x0.z; o[3] += w * x0.w; o[4] += w * x1.x; o[5] += w * x1.y; o[6] += w * x1.z; o[7] += w * x1.w; }
        float ss = 0.f;
#pragma unroll
        for (int j = 0; j < 8; ++j) ss += o[j] * o[j];
        ss += __shfl_xor(ss, 1); ss += __shfl_xor(ss, 2); ss += __shfl_xor(ss, 4);
        const float rstd = 1.0f / sqrtf(ss * (1.0f / 64.0f) + EPS);
        const float* gp = (const float*)(C.ws + WS_HG) + (size_t)(b * SEQ + c * 64 + t) * 1024 + 768 + hh * 64 + v8; const float* ng = a.hgrn_g + l * 64 + v8;
        const f32x4 g0 = *(const f32x4*)gp, g1 = *(const f32x4*)(gp + 4); const float gg[8] = {g0.x, g0.y, g0.z, g0.w, g1.x, g1.y, g1.z, g1.w}; float y[8];
#pragma unroll
        for (int j = 0; j < 8; ++j) y[j] = o[j] * rstd * ng[j] * siluf_(gg[j]);
        u32x4 w; w.x = pk2(y[0], y[1]); w.y = pk2(y[2], y[3]); w.z = pk2(y[4], y[5]); w.w = pk2(y[6], y[7]);
        *(u32x4*)((bf16_t*)(C.ws + WS_MIX) + (size_t)(b * SEQ + c * 64 + t) * D + 768 + hh * 64 + v8) = w; }
    __syncthreads();
}

__device__ __forceinline__ int wave_isum(int v) {
    v += __builtin_amdgcn_update_dpp(0, v, 0xB1, 0xF, 0xF, true);
    v += __builtin_amdgcn_update_dpp(0, v, 0x4E, 0xF, 0xF, true);
    v += __builtin_amdgcn_update_dpp(0, v, 0x141, 0xF, 0xF, true);
    v += __builtin_amdgcn_update_dpp(0, v, 0x140, 0xF, 0xF, true);
    return __builtin_amdgcn_readlane(v, 0) + __builtin_amdgcn_readlane(v, 16) + __builtin_amdgcn_readlane(v, 32) + __builtin_amdgcn_readlane(v, 48);
}
typedef float f32x16 __attribute__((ext_vector_type(16)));
template <int NJ>
__device__ __forceinline__ void select_from_lds(const LAS float* sq, int nj, int* sel, int lane) {
    unsigned key[NJ];
#pragma unroll
    for (int j = 0; j < NJ; ++j) key[j] = sortable(sq[64 * j + lane]);
    unsigned T = 0u;
#pragma unroll 1
    for (int bit = 31; bit >= 0; --bit) {
        const unsigned cand = T | (1u << bit); int c = 0;
#pragma unroll
        for (int j = 0; j < NJ; ++j) c += (key[j] >= cand) ? 1 : 0;
        if (wave_isum(c) >= 256) T = cand;
    }
    int cgt = 0;
#pragma unroll
    for (int j = 0; j < NJ; ++j) cgt += (key[j] > T) ? 1 : 0;
    cgt = wave_isum(cgt);
    const int need = 256 - cgt; int base = 0, eqseen = 0;
#pragma unroll 1
    for (int j = 0; j < nj; ++j) {
        const unsigned kj = sortable(sq[64 * j + lane]);
        const bool gt = kj > T, eq = kj == T; const unsigned long long em = __ballot(eq);
        const bool take = gt || (eq && (eqseen + mbcnt64(em)) < need); const unsigned long long tm = __ballot(take);
        if (take) sel[base + mbcnt64(tm)] = 64 * j + lane;
        base += __popcll(tm); eqseen += __popcll(em);
    }
}
__device__ __forceinline__ void transpose32(unsigned (&a)[32]) {
#pragma unroll
    for (int st = 0; st < 5; ++st) {
        const int j = 16 >> st; const unsigned m = (st == 0) ? 0x0000FFFFu : (st == 1) ? 0x00FF00FFu : (st == 2) ? 0x0F0F0F0Fu : (st == 3) ? 0x33333333u : 0x55555555u;
#pragma unroll
        for (int idx = 0; idx < 16; ++idx) { const int k = (idx / j) * 2 * j + (idx % j); const unsigned t = (a[k] ^ (a[k + j] >> j)) & m; a[k] ^= t; a[k + j] ^= (t << j); }
    }
}
template <int NB>
__device__ __forceinline__ void select_bits(const LAS float* sq, int nj, int* sel, int lane) {
    unsigned pl[NB][32];
#pragma unroll
    for (int blk = 0; blk < NB; ++blk) {
#pragma unroll
        for (int j = 0; j < 32; ++j) pl[blk][j] = sortable(sq[64 * (32 * blk + j) + lane]);
        transpose32(pl[blk]);
    }
    unsigned M[NB], GT[NB];
#pragma unroll
    for (int blk = 0; blk < NB; ++blk) { M[blk] = 0xFFFFFFFFu; GT[blk] = 0u; }
    unsigned T = 0u; int G = 0;
#pragma unroll
    for (int w = 0; w < 32; ++w) {
        unsigned n[NB]; int c = 0;
#pragma unroll
        for (int blk = 0; blk < NB; ++blk) { n[blk] = M[blk] & pl[blk][w]; c += __popc(n[blk]); }
        const int tot = wave_isum(c);
        const bool take = (G + tot) >= 256;
        const unsigned flip = take ? 0u : 0xFFFFFFFFu;
        T |= take ? (1u << (31 - w)) : 0u; G += take ? 0 : tot;
#pragma unroll
        for (int blk = 0; blk < NB; ++blk) { GT[blk] |= n[blk] & flip; M[blk] &= (pl[blk][w] ^ flip); }
    }
    const int need = 256 - G;
    int ceq = 0;
#pragma unroll
    for (int blk = 0; blk < NB; ++blk) ceq += __popc(M[blk]);
    const int toteq = wave_isum(ceq);
    if (toteq == need) {
        int cnt = 0;
#pragma unroll
        for (int blk = 0; blk < NB; ++blk) { GT[blk] |= M[blk]; cnt += __popc(GT[blk]); }
        int incl = cnt;
#pragma unroll
        for (int o = 1; o < 64; o <<= 1) { const int t = __shfl_up(incl, o); if (lane >= o) incl += t; }
        int pos = incl - cnt;
#pragma unroll
        for (int blk = 0; blk < NB; ++blk) { unsigned mk = GT[blk];
            while (mk) { const int x = 31 - __clz((int)mk); mk &= ~(1u << x); sel[pos++] = 64 * (32 * blk + 31 - x) + lane; } }
    } else {
        int base = 0, eqseen = 0;
#pragma unroll 1
        for (int j = 0; j < nj; ++j) {
            const unsigned kj = sortable(sq[64 * j + lane]);
            const bool gt = kj > T, eq = kj == T; const unsigned long long em = __ballot(eq);
            const bool take = gt || (eq && (eqseen + mbcnt64(em)) < need); const unsigned long long tm = __ballot(take);
            if (take) sel[base + mbcnt64(tm)] = 64 * j + lane;
            base += __popcll(tm); eqseen += __popcll(em);
        }
    }
}
__device__ __forceinline__ void index_unit(Ctx& C, int b, int cch, int sub) {
    unsigned char* ws = C.ws; const int lane = C.lane, w = C.wave;
    const int tk0 = b * SEQ + 64 * cch + 8 * sub, L = 64 * (cch + 1), nj = cch + 1;
    if (L <= 256) { int* sel = (int*)(ws + WS_SEL) + (size_t)(tk0 + w) * 256; for (int i = lane; i < L; i += 64) sel[i] = i; return; }
    LAS float* scl = (LAS float*)C.lds;
#ifndef IDXREP
#define IDXREP 0
#endif
    for (int repA = 0; repA < ((IDXREP & 1) ? 2 : 1); ++repA) {
        const int r = lane & 31, hf = lane >> 5, qq = r >> 2, h = r & 3;
        bf16x8 aq[4];
#pragma unroll
        for (int ks = 0; ks < 4; ++ks) aq[ks] = *(const bf16x8*)((const bf16_t*)(ws + WS_QI) + (size_t)(tk0 + qq) * 256 + h * 64 + 16 * ks + 8 * hf);
        f32x4 wq[4];
#pragma unroll
        for (int g = 0; g < 4; ++g) wq[g] = *(const f32x4*)((const float*)(ws + WS_WI) + (size_t)(tk0 + 2 * g + hf) * 4);
        const bf16_t* kib = (const bf16_t*)(ws + WS_KI) + (size_t)b * SEQ * 64;
        const int ntile = 2 * nj;
        bf16x8 bk[4], bk2[4];
#define IDX_LOAD(d1, d2, kta) do { const int _k1 = (kta), _k2 = ((kta) + NWAVES) < ntile ? (kta) + NWAVES : (kta); _Pragma("unroll") for (int ks = 0; ks < 4; ++ks) { \
            d1[ks] = *(const bf16x8*)(kib + (size_t)(32 * _k1 + r) * 64 + 16 * ks + 8 * hf); d2[ks] = *(const bf16x8*)(kib + (size_t)(32 * _k2 + r) * 64 + 16 * ks + 8 * hf); } } while (0)
        if (w < ntile) IDX_LOAD(bk, bk2, w);
#pragma unroll 1
        for (int kt = w; kt < ntile; kt += 2 * NWAVES) {
            const bool two = (kt + NWAVES) < ntile; const int kt2 = two ? kt + NWAVES : kt;
            bf16x8 nk[4], nk2[4];
            const bool more = (kt + 2 * NWAVES) < ntile;
            if (more) IDX_LOAD(nk, nk2, kt + 2 * NWAVES);
            f32x16 acc, acc2;
#pragma unroll
            for (int i = 0; i < 16; ++i) { acc[i] = 0.f; acc2[i] = 0.f; }
#pragma unroll
            for (int ks = 0; ks < 4; ++ks) { acc = __builtin_amdgcn_mfma_f32_32x32x16_bf16(aq[ks], bk[ks], acc, 0, 0, 0); acc2 = __builtin_amdgcn_mfma_f32_32x32x16_bf16(aq[ks], bk2[ks], acc2, 0, 0, 0); }
#pragma unroll
            for (int g = 0; g < 4; ++g) {
                float sc = fmaxf(acc[4 * g + 0], 0.f) * wq[g][0] + fmaxf(acc[4 * g + 1], 0.f) * wq[g][1] + fmaxf(acc[4 * g + 2], 0.f) * wq[g][2] + fmaxf(acc[4 * g + 3], 0.f) * wq[g][3];
                sc = (sc == 0.f) ? 0.f : sc;
                scl[(2 * g + hf) * 4096 + 32 * kt + r] = sc;
                float sc2 = fmaxf(acc2[4 * g + 0], 0.f) * wq[g][0] + fmaxf(acc2[4 * g + 1], 0.f) * wq[g][1] + fmaxf(acc2[4 * g + 2], 0.f) * wq[g][2] + fmaxf(acc2[4 * g + 3], 0.f) * wq[g][3];
                sc2 = (sc2 == 0.f) ? 0.f : sc2;
                if (two) scl[(2 * g + hf) * 4096 + 32 * kt2 + r] = sc2;
            }
            if (more) {
#pragma unroll
                for (int ks = 0; ks < 4; ++ks) { bk[ks] = nk[ks]; bk2[ks] = nk2[ks]; } }
        }
#undef IDX_LOAD
        const int njp = nj <= 32 ? 32 : 64;
        for (int j = nj; j < njp; ++j) scl[w * 4096 + 64 * j + lane] = -3.0e38f;
    }
    __syncthreads();
    for (int repB = 0; repB < ((IDXREP & 2) ? 2 : 1); ++repB) {
        const LAS float* sq = scl + w * 4096; int* sel = (int*)(ws + WS_SEL) + (size_t)(tk0 + w) * 256;
        if (nj <= 32) select_bits<1>(sq, nj, sel, lane); else select_bits<2>(sq, nj, sel, lane);
    }
    __syncthreads();
}

__device__ __forceinline__ unsigned sortable16(unsigned h) { return (h & 0x8000u) ? (~h & 0xFFFFu) : (h | 0x8000u); }
__device__ __forceinline__ unsigned short f2h_bits(float f) { const _Float16 h = (_Float16)f; unsigned short b = __builtin_bit_cast(unsigned short, h); return b == 0x8000u ? (unsigned short)0 : b; }
template <int NB>
__device__ __forceinline__ void select_bits16(const LAS unsigned short* sq, int nj, int* sel, int lane) {
    unsigned a[32];
#pragma unroll
    for (int j = 0; j < 32; ++j) { const unsigned lo = sortable16(sq[64 * j + lane]); const unsigned hi = (NB == 2) ? sortable16(sq[64 * (32 + j) + lane]) : 0u; a[j] = lo | (hi << 16); }
    transpose32(a);
    unsigned Ml = 0xFFFFFFFFu, Mh = (NB == 2) ? 0xFFFFFFFFu : 0u, Gl = 0u, Gh = 0u; unsigned T = 0u; int G = 0;
#pragma unroll
    for (int bit = 15; bit >= 0; --bit) {
        const unsigned nl = Ml & a[31 - bit], nh = Mh & a[15 - bit];
        const int tot = wave_isum(__popc(nl) + __popc(nh));
        const bool take = (G + tot) >= 256; const unsigned flip = take ? 0u : 0xFFFFFFFFu;
        T |= take ? (1u << bit) : 0u; G += take ? 0 : tot;
        Gl |= nl & flip; Gh |= nh & flip; Ml &= (a[31 - bit] ^ flip); Mh &= (a[15 - bit] ^ flip);
    }
    const int need = 256 - G;
    if (T != 0x8000u) {
        const int ceq = __popc(Ml) + __popc(Mh); int incl = ceq;
#pragma unroll
        for (int o = 1; o < 64; o <<= 1) { const int t = __shfl_up(incl, o); if (lane >= o) incl += t; }
        int quota = need - (incl - ceq); quota = quota < 0 ? 0 : (quota > ceq ? ceq : quota);
        const int cnt = __popc(Gl) + __popc(Gh) + quota; int inc2 = cnt;
#pragma unroll
        for (int o = 1; o < 64; o <<= 1) { const int t = __shfl_up(inc2, o); if (lane >= o) inc2 += t; }
        int pos = inc2 - cnt;
        { unsigned mk = Gl; while (mk) { const int x = 31 - __clz((int)mk); mk &= ~(1u << x); sel[pos++] = 64 * (31 - x) + lane; } }
        if (NB == 2) { unsigned mk = Gh; while (mk) { const int x = 31 - __clz((int)mk); mk &= ~(1u << x); sel[pos++] = 64 * (63 - x) + lane; } }
        { unsigned mk = Ml; while (mk && quota > 0) { const int x = 31 - __clz((int)mk); mk &= ~(1u << x); sel[pos++] = 64 * (31 - x) + lane; --quota; } }
        if (NB == 2) { unsigned mk = Mh; while (mk && quota > 0) { const int x = 31 - __clz((int)mk); mk &= ~(1u << x); sel[pos++] = 64 * (63 - x) + lane; --quota; } }
    } else {
        int base = 0, eqseen = 0;
#pragma unroll 1
        for (int j = 0; j < nj; ++j) {
            const unsigned kj = sortable16(sq[64 * j + lane]);
            const bool gt = kj > T, eq = kj == T; const unsigned long long em = __ballot(eq);
            const bool take = gt || (eq && (eqseen + mbcnt64(em)) < need); const unsigned long long tm = __ballot(take);
            if (take) sel[base + mbcnt64(tm)] = 64 * j + lane;
            base += __popcll(tm); eqseen += __popcll(em);
        }
    }
}
constexpr int KST_ROW = 144, KST_BYTES = 64 * KST_ROW;
__device__ __forceinline__ void index_unit2(Ctx& C, int b, int cch, int sub) {
    unsigned char* ws = C.ws; const int lane = C.lane, w = C.wave;
    const int tk0 = b * SEQ + 64 * cch + 8 * sub, L = 64 * (cch + 1), nj = cch + 1;
    if (L <= 256) { int* sel = (int*)(ws + WS_SEL) + (size_t)(tk0 + w) * 256; for (int i = lane; i < L; i += 64) sel[i] = i; return; }
    LAS unsigned short* sclh = (LAS unsigned short*)C.lds;
    LAS unsigned char* kst = C.lds + 65536 + w * KST_BYTES;
    {
        const int r = lane & 31, hf = lane >> 5, qq = r >> 2, h = r & 3;
        bf16x8 aq[4];
#pragma unroll
        for (int ks = 0; ks < 4; ++ks) aq[ks] = *(const bf16x8*)((const bf16_t*)(ws + WS_QI) + (size_t)(tk0 + qq) * 256 + h * 64 + 16 * ks + 8 * hf);
        f32x4 wq[4];
#pragma unroll
        for (int g = 0; g < 4; ++g) wq[g] = *(const f32x4*)((const float*)(ws + WS_WI) + (size_t)(tk0 + 2 * g + hf) * 4);
        const unsigned char* kib = ws + WS_KI + (size_t)b * SEQ * 128;
        const int ntile = 2 * nj;
        u32x4 st[8];
#define IDX2_LOAD(kta) do { const int _t1 = (kta), _t2 = ((kta) + NWAVES) < ntile ? (kta) + NWAVES : (kta); _Pragma("unroll") for (int j = 0; j < 4; ++j) { \
            st[j] = *(const u32x4*)(kib + (size_t)_t1 * 4096 + 1024 * j + 16 * lane); st[4 + j] = *(const u32x4*)(kib + (size_t)_t2 * 4096 + 1024 * j + 16 * lane); } } while (0)
        if (w < ntile) IDX2_LOAD(w);
#pragma unroll 1
        for (int kt = w; kt < ntile; kt += 2 * NWAVES) {
            const bool two = (kt + NWAVES) < ntile; const int kt2 = two ? kt + NWAVES : kt;
#pragma unroll
            for (int j = 0; j < 4; ++j) { *(LAS u32x4*)(kst + (8 * j + (lane >> 3)) * KST_ROW + 16 * (lane & 7)) = st[j]; *(LAS u32x4*)(kst + (32 + 8 * j + (lane >> 3)) * KST_ROW + 16 * (lane & 7)) = st[4 + j]; }
            if ((kt + 2 * NWAVES) < ntile) IDX2_LOAD(kt + 2 * NWAVES);
            f32x16 acc, acc2;
#pragma unroll
            for (int i = 0; i < 16; ++i) { acc[i] = 0.f; acc2[i] = 0.f; }
#pragma unroll
            for (int ks = 0; ks < 4; ++ks) { const bf16x8 b1 = *(const LAS bf16x8*)(kst + r * KST_ROW + 32 * ks + 16 * hf), b2 = *(const LAS bf16x8*)(kst + (32 + r) * KST_ROW + 32 * ks + 16 * hf);
                acc = __builtin_amdgcn_mfma_f32_32x32x16_bf16(aq[ks], b1, acc, 0, 0, 0); acc2 = __builtin_amdgcn_mfma_f32_32x32x16_bf16(aq[ks], b2, acc2, 0, 0, 0); }
#pragma unroll
            for (int g = 0; g < 4; ++g) {
                const float sc = fmaxf(acc[4 * g + 0], 0.f) * wq[g][0] + fmaxf(acc[4 * g + 1], 0.f) * wq[g][1] + fmaxf(acc[4 * g + 2], 0.f) * wq[g][2] + fmaxf(acc[4 * g + 3], 0.f) * wq[g][3];
                sclh[(2 * g + hf) * 4096 + 32 * kt + r] = f2h_bits(sc);
                const float sc2 = fmaxf(acc2[4 * g + 0], 0.f) * wq[g][0] + fmaxf(acc2[4 * g + 1], 0.f) * wq[g][1] + fmaxf(acc2[4 * g + 2], 0.f) * wq[g][2] + fmaxf(acc2[4 * g + 3], 0.f) * wq[g][3];
                if (two) sclh[(2 * g + hf) * 4096 + 32 * kt2 + r] = f2h_bits(sc2);
            }
        }
#undef IDX2_LOAD
        const int njp = nj <= 32 ? 32 : 64;
        for (int j = nj; j < njp; ++j) sclh[w * 4096 + 64 * j + lane] = (unsigned short)0xFBFFu;
    }
    __syncthreads();
    {
        const LAS unsigned short* sq = sclh + w * 4096; int* sel = (int*)(ws + WS_SEL) + (size_t)(tk0 + w) * 256;
        if (nj <= 32) select_bits16<1>(sq, nj, sel, lane); else select_bits16<2>(sq, nj, sel, lane);
    }
    __syncthreads();
}

typedef short s16x4 __attribute__((ext_vector_type(4)));
constexpr int VROW = 272;
__device__ __forceinline__ void attend_query_mfma(Ctx& C, int tk, LAS unsigned char* vs, Conv& cv) {
    unsigned char* ws = C.ws; const int lane = C.lane, c = lane & 15, g = lane >> 4;
    const int tpos = tk & (SEQ - 1), b = tk >> 12, L = 64 * ((tpos >> 6) + 1), nsel = L < 256 ? L : 256;
    const bf16_t* kb = (const bf16_t*)(ws + WS_K) + (size_t)b * SEQ * 128; const bf16_t* vb = (const bf16_t*)(ws + WS_V) + (size_t)b * SEQ * 128;
    int selr[4];
    { const int* sg = (const int*)(ws + WS_SEL) + (size_t)tk * 256;
#pragma unroll
      for (int i = 0; i < 4; ++i) selr[i] = (64 * i + lane) < nsel ? sg[64 * i + lane] : 0; }
    bf16x8 bq0[2], bq1[2];
    { const bf16_t* qp = (const bf16_t*)(ws + WS_Q) + (size_t)tk * 512 + (c & 7) * 64 + 8 * g; const bf16x8 z = (bf16x8){0, 0, 0, 0, 0, 0, 0, 0};
#pragma unroll
      for (int ks = 0; ks < 2; ++ks) { const bf16x8 q = *(const bf16x8*)(qp + 32 * ks); bq0[ks] = (c < 4) ? q : z; bq1[ks] = (c >= 4 && c < 8) ? q : z; } }
    cv.issue();
    f32x4 acc[16];
#pragma unroll
    for (int kt = 0; kt < 16; ++kt) {
        if ((kt & 3) == 0) asm volatile("" ::: "memory");
        const int key = __shfl(selr[kt >> 2], 16 * (kt & 3) + c);
        const bf16_t* kr = kb + (size_t)key * 128 + 8 * g;
        const bf16x8 a00 = *(const bf16x8*)(kr), a01 = *(const bf16x8*)(kr + 32), a10 = *(const bf16x8*)(kr + 64), a11 = *(const bf16x8*)(kr + 96);
        f32x4 t = (f32x4){0.f, 0.f, 0.f, 0.f};
        t = __builtin_amdgcn_mfma_f32_16x16x32_bf16(a00, bq0[0], t, 0, 0, 0); t = __builtin_amdgcn_mfma_f32_16x16x32_bf16(a01, bq0[1], t, 0, 0, 0);
        t = __builtin_amdgcn_mfma_f32_16x16x32_bf16(a10, bq1[0], t, 0, 0, 0); t = __builtin_amdgcn_mfma_f32_16x16x32_bf16(a11, bq1[1], t, 0, 0, 0);
        acc[kt] = t;
    }
    asm volatile("" ::: "memory"); cv.finish((LAS float*)vs); cv.issue();
    { const int lim = nsel - 4 * g;
#pragma unroll
      for (int kt = 0; kt < 16; ++kt)
#pragma unroll
        for (int r = 0; r < 4; ++r) acc[kt][r] = (16 * kt + r < lim) ? acc[kt][r] : -1e30f; }
    float m = -1e30f;
#pragma unroll
    for (int kt = 0; kt < 16; ++kt) m = fmaxf(m, fmaxf(fmaxf(acc[kt][0], acc[kt][1]), fmaxf(acc[kt][2], acc[kt][3])));
    m = fmaxf(m, __shfl_xor(m, 16)); m = fmaxf(m, __shfl_xor(m, 32));
    float sum = 0.f;
#pragma unroll
    for (int kt = 0; kt < 16; ++kt)
#pragma unroll
        for (int r = 0; r < 4; ++r) { const float pv = __expf(acc[kt][r] - m); acc[kt][r] = pv; sum += pv; }
    sum += __shfl_xor(sum, 16); sum += __shfl_xor(sum, 32);
    const float inv = 1.0f / sum;
    bf16x8 bp[8];
#pragma unroll
    for (int T = 0; T < 8; ++T) { u32x4 w; w.x = cvt_pk_bf16(acc[2 * T][0], acc[2 * T][1]); w.y = cvt_pk_bf16(acc[2 * T][2], acc[2 * T][3]); w.z = cvt_pk_bf16(acc[2 * T + 1][0], acc[2 * T + 1][1]); w.w = cvt_pk_bf16(acc[2 * T + 1][2], acc[2 * T + 1][3]);
        bp[T] = __builtin_bit_cast(bf16x8, w); }
    f32x4 ao0[4], ao1[4];
#pragma unroll
    for (int dt = 0; dt < 4; ++dt) { ao0[dt] = (f32x4){0.f, 0.f, 0.f, 0.f}; ao1[dt] = (f32x4){0.f, 0.f, 0.f, 0.f}; }
    const int q4 = c >> 2, p4 = c & 3;
    u32x4 vst[8];
#define ATT_VLOAD(T) do { _Pragma("unroll") for (int i = 0; i < 8; ++i) { const int row = g + 4 * i; \
        const int key = __shfl(selr[(T) >> 1], 32 * ((T) & 1) + row); vst[i] = *(const u32x4*)(vb + (size_t)key * 128 + 8 * c); } } while (0)
    ATT_VLOAD(0);
#pragma unroll
    for (int T = 0; T < 8; ++T) {
        LAS unsigned char* buf = vs + (T & 1) * (32 * VROW);
        asm volatile("" ::: "memory");
#pragma unroll
        for (int i = 0; i < 8; ++i) *(LAS u32x4*)(buf + (g + 4 * i) * VROW + 16 * c) = vst[i];
        if (T < 7) ATT_VLOAD(T + 1);
#pragma unroll
        for (int n = 0; n < 2; ++n)
#pragma unroll
            for (int dt = 0; dt < 4; ++dt) {
                LAS s16x4* p0 = (LAS s16x4*)(buf + (4 * g + q4) * VROW + (n * 64 + 16 * dt + 4 * p4) * 2);
                const s16x4 lo = __builtin_amdgcn_ds_read_tr16_b64_v4i16(p0), hi = __builtin_amdgcn_ds_read_tr16_b64_v4i16((LAS s16x4*)((LAS unsigned char*)p0 + 16 * VROW));
                const bf16x8 av = (bf16x8){lo[0], lo[1], lo[2], lo[3], hi[0], hi[1], hi[2], hi[3]};
                if (n == 0) ao0[dt] = __builtin_amdgcn_mfma_f32_16x16x32_bf16(av, bp[T], ao0[dt], 0, 0, 0);
                else ao1[dt] = __builtin_amdgcn_mfma_f32_16x16x32_bf16(av, bp[T], ao1[dt], 0, 0, 0);
            }
        if (T == 3) { asm volatile("" ::: "memory"); cv.finish((LAS float*)vs); cv.issue(); }
    }
#undef ATT_VLOAD
    asm volatile("" ::: "memory"); cv.finish((LAS float*)vs);
    if (c < 8) {
        bf16_t* mo = (bf16_t*)(ws + WS_MIX) + (size_t)tk * D + c * 64 + 4 * g;
#pragma unroll
        for (int dt = 0; dt < 4; ++dt) { f32x4 o; o[0] = (c < 4 ? ao0[dt][0] : ao1[dt][0]) * inv; o[1] = (c < 4 ? ao0[dt][1] : ao1[dt][1]) * inv; o[2] = (c < 4 ? ao0[dt][2] : ao1[dt][2]) * inv; o[3] = (c < 4 ? ao0[dt][3] : ao1[dt][3]) * inv; u32x2 w; w.x = cvt_pk_bf16(o[0], o[1]); w.y = cvt_pk_bf16(o[2], o[3]); *(u32x2*)(mo + 16 * dt) = w; }
    }
}

__device__ __forceinline__ void hgrn_out_group(const Args& a, Ctx& C, int l, int item) {
    const int tid = C.tid, lane = C.lane, w = C.wave, cg = item & 15, hh = (item >> 4) & 3, b = item >> 6, c0 = 4 * cg, bh = b * 4 + hh;
    LAS float* bq = (LAS float*)C.lds; LAS float* kin = bq + 64 * HP; LAS float* qq = kin + 64 * HP; LAS float* At = qq + 64 * HP; LAS float* vv = At + 64 * HP; LAS float* Ss = vv + 4096;
    const float* HG = (const float*)(C.ws + WS_HG); const float* HLb = (const float*)(C.ws + WS_HL) + (size_t)bh * 64 * 4096; const float* HDb = (const float*)(C.ws + WS_HD) + (size_t)bh * 64 * 64;
    float lbv[8];
#pragma unroll
    for (int j = 0; j < 8; ++j) { const int kk = hh * 64 + 8 * w + j; lbv[j] = (l == 1) ? 1.0f / (1.0f + expf(a.lb_logits[kk] - a.lb_logits[256 + kk])) : 0.f; }
    const int kS = tid >> 3, v8 = (tid & 7) * 8; f32x4 s0 = (f32x4){0.f, 0.f, 0.f, 0.f}, s1 = s0;
    { const float* hl = HLb + kS * 64 + v8; const float* hd = HDb + kS;
#pragma unroll 8
      for (int j = 0; j < c0; ++j) { const float dj = hd[(size_t)j * 64]; const f32x4 l0 = *(const f32x4*)(hl + (size_t)j * 4096), l1 = *(const f32x4*)(hl + (size_t)j * 4096 + 4); s0 = s0 * dj + l0; s1 = s1 * dj + l1; } }
#pragma unroll 1
    for (int c = c0; c < c0 + 4; ++c) {
        const size_t tok0 = (size_t)b * SEQ + c * 64;
        const f32x4 lc0 = *(const f32x4*)(HLb + (size_t)c * 4096 + kS * 64 + v8), lc1 = *(const f32x4*)(HLb + (size_t)c * 4096 + kS * 64 + v8 + 4);
        *(LAS f32x4*)(Ss + kS * 64 + v8) = s0; *(LAS f32x4*)(Ss + kS * 64 + v8 + 4) = s1;
        {
            const float* z = HG + (tok0 + lane) * 1024 + 256 + hh * 64 + 8 * w; const f32x4 z0 = *(const f32x4*)z, z1 = *(const f32x4*)(z + 4); const float zz[8] = {z0.x, z0.y, z0.z, z0.w, z1.x, z1.y, z1.z, z1.w};
#pragma unroll
            for (int j = 0; j < 8; ++j) { const float lb = lbv[j]; const float sg = 1.0f / (1.0f + __expf(-zz[j])), sn = 1.0f / (1.0f + __expf(zz[j])); float lf = __logf(lb + (1.0f - lb) * sg);
#pragma unroll
                for (int o = 1; o < 64; o <<= 1) { const float t = __shfl_up(lf, o); if (lane >= o) lf += t; }
                bq[lane * HP + 8 * w + j] = lf; kin[lane * HP + 8 * w + j] = (1.0f - lb) * sn; }
        }
        { const int sr = tid >> 3, k8 = (tid & 7) * 8; const float* row = HG + (tok0 + sr) * 1024 + hh * 64 + k8;
            const f32x4 q0 = *(const f32x4*)row, q1 = *(const f32x4*)(row + 4);
            qq[sr * HP + k8 + 0] = siluf_(q0.x); qq[sr * HP + k8 + 1] = siluf_(q0.y); qq[sr * HP + k8 + 2] = siluf_(q0.z); qq[sr * HP + k8 + 3] = siluf_(q0.w);
            qq[sr * HP + k8 + 4] = siluf_(q1.x); qq[sr * HP + k8 + 5] = siluf_(q1.y); qq[sr * HP + k8 + 6] = siluf_(q1.z); qq[sr * HP + k8 + 7] = siluf_(q1.w);
            *(LAS f32x4*)(vv + sr * 64 + k8) = *(const f32x4*)(row + 512); *(LAS f32x4*)(vv + sr * 64 + k8 + 4) = *(const f32x4*)(row + 516); }
        __syncthreads();
        { const int t = tid >> 3, sg = tid & 7; float ac[8] = {0.f, 0.f, 0.f, 0.f, 0.f, 0.f, 0.f, 0.f};
            for (int k = 0; k < 64; ++k) { const float qt = qq[t * HP + k], bt = bq[t * HP + k];
#pragma unroll
                for (int i = 0; i < 8; ++i) { const int sx = sg + 8 * i; if (sx <= t) ac[i] += qt * kin[sx * HP + k] * __expf(bt - bq[sx * HP + k]); } }
#pragma unroll
            for (int i = 0; i < 8; ++i) At[t * HP + sg + 8 * i] = ac[i]; }
        __syncthreads();
        { const int t = tid >> 3; float o[8] = {0.f, 0.f, 0.f, 0.f, 0.f, 0.f, 0.f, 0.f};
#pragma unroll 4
            for (int k = 0; k < 64; ++k) { const float qe = qq[t * HP + k] * __expf(bq[t * HP + k]); const f32x4 x0 = *(const LAS f32x4*)(Ss + k * 64 + v8), x1 = *(const LAS f32x4*)(Ss + k * 64 + v8 + 4);
                o[0] += qe * x0.x; o[1] += qe * x0.y; o[2] += qe * x0.z; o[3] += qe * x0.w; o[4] += qe * x1.x; o[5] += qe * x1.y; o[6] += qe * x1.z; o[7] += qe * x1.w; }
            for (int sx = 0; sx <= t; ++sx) { const float wv = At[t * HP + sx]; const f32x4 x0 = *(const LAS f32x4*)(vv + sx * 64 + v8), x1 = *(const LAS f32x4*)(vv + sx * 64 + v8 + 4);
                o[0] += wv * x0.x; o[1] += wv * x0.y; o[2] += wv * x0.z; o[3] += wv * x0.w; o[4] += wv * x1.x; o[5] += wv * x1.y; o[6] += wv * x1.z; o[7] += wv * x1.w; }
            float ss = 0.f;
#pragma unroll
            for (int j = 0; j < 8; ++j) ss += o[j] * o[j];
            ss += __shfl_xor(ss, 1); ss += __shfl_xor(ss, 2); ss += __shfl_xor(ss, 4);
            const float rstd = 1.0f / sqrtf(ss * (1.0f / 64.0f) + EPS);
            const float* gp = HG + (tok0 + t) * 1024 + 768 + hh * 64 + v8; const float* ng = a.hgrn_g + l * 64 + v8;
            const f32x4 g0 = *(const f32x4*)gp, g1 = *(const f32x4*)(gp + 4); const float gg[8] = {g0.x, g0.y, g0.z, g0.w, g1.x, g1.y, g1.z, g1.w}; float y[8];
#pragma unroll
            for (int j = 0; j < 8; ++j) y[j] = o[j] * rstd * ng[j] * siluf_(gg[j]);
            u32x4 wv; wv.x = pk2(y[0], y[1]); wv.y = pk2(y[2], y[3]); wv.z = pk2(y[4], y[5]); wv.w = pk2(y[6], y[7]);
            *(u32x4*)((bf16_t*)(C.ws + WS_MIX) + (tok0 + t) * D + 768 + hh * 64 + v8) = wv; }
        { const float dc = __expf(bq[63 * HP + kS]); s0 = s0 * dc + lc0; s1 = s1 * dc + lc1; }
        __syncthreads();
    }
}

template <bool WITH_Q>
__device__ __forceinline__ void hgrn_fill(const Args& a, Ctx& C, int l, int hh, size_t tok0, LAS float* fz, LAS float* kn, LAS float* qq, LAS float* vv) {
    const int tid = C.tid, sr = tid >> 3, k8 = (tid & 7) * 8; const float* row = (const float*)(C.ws + WS_HG) + (tok0 + sr) * 1024 + hh * 64 + k8;
    const f32x4 z0 = *(const f32x4*)(row + 256), z1 = *(const f32x4*)(row + 260); const float zz[8] = {z0.x, z0.y, z0.z, z0.w, z1.x, z1.y, z1.z, z1.w}; float fo[8], ko[8];
#pragma unroll
    for (int j = 0; j < 8; ++j) { const int kk = hh * 64 + k8 + j; const float lb = (l == 1) ? 1.0f / (1.0f + expf(a.lb_logits[kk] - a.lb_logits[256 + kk])) : 0.f;
        const float sg = 1.0f / (1.0f + expf(-zz[j])), sn = 1.0f / (1.0f + expf(zz[j])); fo[j] = lb + (1.0f - lb) * sg; ko[j] = (1.0f - lb) * sn; }
    *(LAS f32x4*)(fz + sr * 64 + k8) = (f32x4){fo[0], fo[1], fo[2], fo[3]}; *(LAS f32x4*)(fz + sr * 64 + k8 + 4) = (f32x4){fo[4], fo[5], fo[6], fo[7]};
    *(LAS f32x4*)(kn + sr * 64 + k8) = (f32x4){ko[0], ko[1], ko[2], ko[3]}; *(LAS f32x4*)(kn + sr * 64 + k8 + 4) = (f32x4){ko[4], ko[5], ko[6], ko[7]};
    if (WITH_Q) { const f32x4 q0 = *(const f32x4*)row, q1 = *(const f32x4*)(row + 4);
        *(LAS f32x4*)(qq + sr * 64 + k8) = (f32x4){siluf_(q0.x), siluf_(q0.y), siluf_(q0.z), siluf_(q0.w)}; *(LAS f32x4*)(qq + sr * 64 + k8 + 4) = (f32x4){siluf_(q1.x), siluf_(q1.y), siluf_(q1.z), siluf_(q1.w)}; }
    *(LAS f32x4*)(vv + sr * 64 + k8) = *(const f32x4*)(row + 512); *(LAS f32x4*)(vv + sr * 64 + k8 + 4) = *(const f32x4*)(row + 516);
}
__device__ __forceinline__ void hgrn_local2(const Args& a, Ctx& C, int l, int item) {
    const int tid = C.tid, c = item & 63, hh = (item >> 6) & 3, b = item >> 8, v = tid & 63, kq = tid >> 6;
    LAS float* fz = (LAS float*)C.lds; LAS float* kn = fz + 4096; LAS float* vv = kn + 4096;
    hgrn_fill<false>(a, C, l, hh, (size_t)b * SEQ + c * 64, fz, kn, nullptr, vv);
    __syncthreads();
    float S[8] = {0.f, 0.f, 0.f, 0.f, 0.f, 0.f, 0.f, 0.f}, dp[8] = {1.f, 1.f, 1.f, 1.f, 1.f, 1.f, 1.f, 1.f};
#pragma unroll 4
    for (int sx = 0; sx < 64; ++sx) { const f32x4 f0 = *(const LAS f32x4*)(fz + sx * 64 + 8 * kq), f1 = *(const LAS f32x4*)(fz + sx * 64 + 8 * kq + 4), k0 = *(const LAS f32x4*)(kn + sx * 64 + 8 * kq), k1 = *(const LAS f32x4*)(kn + sx * 64 + 8 * kq + 4);
        const float vs = vv[sx * 64 + v]; const float ff[8] = {f0.x, f0.y, f0.z, f0.w, f1.x, f1.y, f1.z, f1.w}, kk[8] = {k0.x, k0.y, k0.z, k0.w, k1.x, k1.y, k1.z, k1.w};
#pragma unroll
        for (int j = 0; j < 8; ++j) { S[j] = ff[j] * S[j] + kk[j] * vs; dp[j] *= ff[j]; } }
    float* hl = (float*)(C.ws + WS_HL) + (size_t)item * 4096 + (8 * kq) * 64 + v;
#pragma unroll
    for (int j = 0; j < 8; ++j) hl[j * 64] = S[j];
    if (v == 0) { float* hd = (float*)(C.ws + WS_HD) + (size_t)item * 64 + 8 * kq;
#pragma unroll
        for (int j = 0; j < 8; ++j) hd[j] = dp[j]; }
    __syncthreads();
}
__device__ __forceinline__ void hgrn_out2(const Args& a, Ctx& C, int l, int item) {
    const int tid = C.tid, cg = item & 15, hh = (item >> 4) & 3, b = item >> 6, c0 = 4 * cg, bh = b * 4 + hh, v = tid & 63, kq = tid >> 6;
    LAS float* fz = (LAS float*)C.lds; LAS float* kn = fz + 4096; LAS float* qq = kn + 4096; LAS float* vv = qq + 4096; LAS float* part = vv + 4096;
    const float* HLb = (const float*)(C.ws + WS_HL) + (size_t)bh * 64 * 4096 + (8 * kq) * 64 + v; const float* HDb = (const float*)(C.ws + WS_HD) + (size_t)bh * 64 * 64 + 8 * kq;
    float S[8] = {0.f, 0.f, 0.f, 0.f, 0.f, 0.f, 0.f, 0.f};
#pragma unroll 2
    for (int j = 0; j < c0; ++j) { const f32x4 d0 = *(const f32x4*)(HDb + (size_t)j * 64), d1 = *(const f32x4*)(HDb + (size_t)j * 64 + 4); const float dd[8] = {d0.x, d0.y, d0.z, d0.w, d1.x, d1.y, d1.z, d1.w};
#pragma unroll
        for (int i = 0; i < 8; ++i) S[i] = dd[i] * S[i] + HLb[(size_t)j * 4096 + i * 64]; }
#pragma unroll 1
    for (int c = c0; c < c0 + 4; ++c) {
        const size_t tok0 = (size_t)b * SEQ + c * 64;
        hgrn_fill<true>(a, C, l, hh, tok0, fz, kn, qq, vv);
        __syncthreads();
#pragma unroll 1
        for (int half = 0; half < 2; ++half) {
#pragma unroll 4
            for (int sl = 0; sl < 32; ++sl) { const int sx = 32 * half + sl;
                const f32x4 f0 = *(const LAS f32x4*)(fz + sx * 64 + 8 * kq), f1 = *(const LAS f32x4*)(fz + sx * 64 + 8 * kq + 4), k0 = *(const LAS f32x4*)(kn + sx * 64 + 8 * kq), k1 = *(const LAS f32x4*)(kn + sx * 64 + 8 * kq + 4);
                const f32x4 q0 = *(const LAS f32x4*)(qq + sx * 64 + 8 * kq), q1 = *(const LAS f32x4*)(qq + sx * 64 + 8 * kq + 4);
                const float vs = vv[sx * 64 + v]; const float ff[8] = {f0.x, f0.y, f0.z, f0.w, f1.x, f1.y, f1.z, f1.w}, kk[8] = {k0.x, k0.y, k0.z, k0.w, k1.x, k1.y, k1.z, k1.w}, qv[8] = {q0.x, q0.y, q0.z, q0.w, q1.x, q1.y, q1.z, q1.w};
                float op = 0.f;
#pragma unroll
                for (int j = 0; j < 8; ++j) { S[j] = ff[j] * S[j] + kk[j] * vs; op += qv[j] * S[j]; }
                part[(kq * 32 + sl) * 64 + v] = op; }
            __syncthreads();
            { const int t = tid >> 4, v4 = (tid & 15) * 4; f32x4 o = (f32x4){0.f, 0.f, 0.f, 0.f};
#pragma unroll
                for (int kk2 = 0; kk2 < 8; ++kk2) o += *(const LAS f32x4*)(part + (kk2 * 32 + t) * 64 + v4);
                float ss = o.x * o.x + o.y * o.y + o.z * o.z + o.w * o.w;
                ss += __shfl_xor(ss, 1); ss += __shfl_xor(ss, 2); ss += __shfl_xor(ss, 4); ss += __shfl_xor(ss, 8);
                const float rstd = 1.0f / sqrtf(ss * (1.0f / 64.0f) + EPS);
                const size_t tok = tok0 + 32 * half + t;
                const f32x4 gg = *(const f32x4*)((const float*)(C.ws + WS_HG) + tok * 1024 + 768 + hh * 64 + v4), ng = *(const f32x4*)(a.hgrn_g + l * 64 + v4);
                const float y0 = o.x * rstd * ng.x * siluf_(gg.x), y1 = o.y * rstd * ng.y * siluf_(gg.y), y2 = o.z * rstd * ng.z * siluf_(gg.z), y3 = o.w * rstd * ng.w * siluf_(gg.w);
                u32x2 wv; wv.x = pk2(y0, y1); wv.y = pk2(y2, y3);
                *(u32x2*)((bf16_t*)(C.ws + WS_MIX) + tok * D + 768 + hh * 64 + v4) = wv; }
            __syncthreads();
        }
    }
}

__device__ __forceinline__ void pool_wave(const Args& a, Ctx& C, int l) {
    unsigned char* ws = C.ws; const int lane = C.lane;
    const int gwv = blockIdx.x * NWAVES + C.wave, g = gwv & 3, widx = gwv >> 2, nw = (C.G * NWAVES) >> 2, w = 2 << g;
    float pwr[64];
#pragma unroll
    for (int c = 0; c < 64; ++c) pwr[c] = a.pool_w[(size_t)(l * 4 + g) * 4096 + c * 64 + lane];
    const float psc = a.pool_scale[l * 256 + g * 64 + lane];
    const float* ubg = (const float*)(ws + WS_UB) + g * 64 + lane;
    for (int tile = widx; tile < NTOK / 8; tile += nw) {
        const int tok0 = tile * 8, tp0 = tok0 & (SEQ - 1);
        float row[23];
#pragma unroll
        for (int r = 0; r < 23; ++r) { const int tp = tp0 - 15 + r; row[r] = (tp >= 0) ? ubg[(size_t)(tok0 - 15 + r) * 256] : 0.f; }
        float pooled[8];
#pragma unroll
        for (int t = 0; t < 8; ++t) {
            float sm = 0.f;
#pragma unroll
            for (int i = 0; i < 16; ++i) if (i < w) sm += row[15 + t - i];
            const int tpos = tp0 + t; const int wl = (tpos + 1) < w ? (tpos + 1) : w;
            pooled[t] = sm * (1.0f / (float)wl) - row[15 + t];
        }
        float y[8] = {0.f, 0.f, 0.f, 0.f, 0.f, 0.f, 0.f, 0.f};
#pragma unroll
        for (int c = 0; c < 64; ++c) {
#pragma unroll
            for (int t = 0; t < 8; ++t) y[t] += __builtin_bit_cast(float, __builtin_amdgcn_readlane(__builtin_bit_cast(int, pooled[t]), c)) * pwr[c];
        }
        bf16_t* mo = (bf16_t*)(ws + WS_MIX) + (size_t)tok0 * D + 512 + g * 64 + lane;
#pragma unroll
        for (int t = 0; t < 8; ++t) mo[(size_t)t * D] = (bf16_t)f2bf(y[t] * psc);
    }
}

__device__ __forceinline__ void phase_mix1(const Args& a, Ctx& C, int l) {
#ifndef MIX1MASK
#define MIX1MASK 7
#endif
#ifndef MIX1REP
#define MIX1REP 0
#endif
    for (int rep = 0; rep < ((MIX1REP & 1) && l == 0 ? 2 : 1); ++rep) for (int it = blockIdx.x; it < 1024; it += C.G) hgrn_local2(a, C, l, it);
    for (int rep = 0; rep < ((MIX1REP & 2) && l == 0 ? 2 : 1); ++rep) pool_wave(a, C, l);
    __syncthreads();
    for (int rep = 0; rep < ((MIX1REP & 4) && l == 0 ? 2 : 1); ++rep) for (int base = 0; base < 2048; base += 2 * C.G) {
        const int u1 = base + (int)blockIdx.x, u2 = base + 2 * C.G - 1 - (int)blockIdx.x;
        if (u1 < 2048) index_unit2(C, (u1 >> 3) & 3, u1 >> 5, u1 & 7);
        if (u2 < 2048) index_unit2(C, (u2 >> 3) & 3, u2 >> 5, u2 & 7);
    }
}
__device__ __forceinline__ void phase_mix2(const Args& a, Ctx& C, int l) {
#ifndef MIX2MASK
#define MIX2MASK 3
#endif
#ifndef MIX2REP
#define MIX2REP 0
#endif
    for (int rep = 0; rep < ((MIX2REP & 1) ? 2 : 1); ++rep) for (int it = blockIdx.x; it < 256; it += C.G) hgrn_out2(a, C, l, it);
    LAS unsigned char* vs = C.lds + C.wave * (2 * 32 * VROW);
    const int gw = blockIdx.x * NWAVES + C.wave, NGW = C.G * NWAVES;
    Conv cv; cv.w1l = a.w1 + (size_t)l * 32 * 1024 * 2048; cv.w2l = a.w2 + (size_t)l * 32 * 1024 * 1024; cv.w1t = (bf16_t*)(C.ws + WS_W1) + (size_t)l * 32 * 2048 * 1024; cv.w2t = (bf16_t*)(C.ws + WS_W2) + (size_t)l * 32 * 1024 * 1024;
    cv.it = gw; cv.step = NGW; cv.lane = C.lane; cv.pend = false;
    for (int tk = gw; tk < NTOK; tk += NGW) attend_query_mfma(C, tk, vs, cv);
    while (cv.pend || cv.it < Conv::NITEMS) { cv.finish((LAS float*)vs); cv.issue(); }
}

__device__ __forceinline__ void phase_router(const Args& a, Ctx& C, int l) {
    unsigned char* ws = C.ws; const int lane = C.lane;
    LAS float* us = (LAS float*)(C.lds + C.wave * 8192);
    const float* mod = (const float*)(ws + WS_MOD); const float* H = (const float*)(ws + WS_H);
    const float* wr = a.w_router + (size_t)l * 1024 * 32; unsigned* cnt = (unsigned*)(ws + WS_CTL) + CW_CNT + l * 32 * 64;
    const int gw = blockIdx.x * NWAVES + C.wave, NGW = C.G * NWAVES;
    for (int base = gw * 2; base < NTOK; base += NGW * 2) {
#pragma unroll
        for (int hf = 0; hf < 2; ++hf) {
            const int tk = base + hf, b = tk >> 12; const f32x4* hr = (const f32x4*)(H + (size_t)tk * D) + lane; f32x4 v[4];
#pragma unroll
            for (int j = 0; j < 4; ++j) v[j] = hr[64 * j];
            float ss = 0.f;
#pragma unroll
            for (int j = 0; j < 4; ++j) ss += (v[j].x * v[j].x + v[j].y * v[j].y) + (v[j].z * v[j].z + v[j].w * v[j].w);
            const float rstd = 1.0f / sqrtf(wave_sum(ss) * (1.0f / D) + EPS);
            const float* mb = mod + (size_t)(l * 4 + b) * 6144; bf16_t* urow = (bf16_t*)(ws + WS_U) + (size_t)tk * D;
#pragma unroll
            for (int j = 0; j < 4; ++j) { const int idx = 4 * lane + 256 * j; const f32x4 gv = *(const f32x4*)(a.norm2_g + l * 1024 + idx), shv = *(const f32x4*)(mb + 3072 + idx), scv = *(const f32x4*)(mb + 4096 + idx);
                const f32x4 o = v[j] * rstd * gv * (scv + 1.0f) + shv; u32x2 w; w.x = pk2(o[0], o[1]); w.y = pk2(o[2], o[3]); *(u32x2*)(urow + idx) = w;
                *(LAS f32x4*)(us + hf * 1024 + idx) = o; }
        }
        asm volatile("s_waitcnt lgkmcnt(0)" ::: "memory"); __builtin_amdgcn_wave_barrier();
        const int e = lane & 31, hf = lane >> 5; float acc0 = 0.f, acc1 = 0.f;
        const LAS float* up = us + hf * 1024;
#pragma unroll 8
        for (int d = 0; d < 1024; d += 2) { acc0 += up[d] * wr[d * 32 + e]; acc1 += up[d + 1] * wr[(d + 1) * 32 + e]; }
        float val = acc0 + acc1 + a.b_router[l * 32 + e];
        float tv[4]; int te[4];
#pragma unroll
        for (int k = 0; k < 4; ++k) {
            float bv = val; int bi = e;
#pragma unroll
            for (int o = 1; o < 32; o <<= 1) { const float ov = __shfl_xor(bv, o); const int oi = __shfl_xor(bi, o); if (ov > bv || (ov == bv && oi < bi)) { bv = ov; bi = oi; } }
            tv[k] = bv; te[k] = bi; if (e == bi) val = -3.0e38f;
        }
        const float e1 = __expf(tv[1] - tv[0]), e2 = __expf(tv[2] - tv[0]), e3 = __expf(tv[3] - tv[0]); const float rs = 1.0f / (1.0f + e1 + e2 + e3);
        if (e < 4) {
            const int tk = base + hf; const int ex = e == 0 ? te[0] : e == 1 ? te[1] : e == 2 ? te[2] : te[3]; const float gt = (e == 0 ? 1.0f : e == 1 ? e1 : e == 2 ? e2 : e3) * rs;
            const unsigned slot = atomicAdd(cnt + ex * 64, 1u);
            ((int*)(ws + WS_ROWTOK))[(size_t)ex * NTOK + slot] = tk;
            ((int*)(ws + WS_EIDX))[tk * 4 + e] = ex; ((int*)(ws + WS_SLOT))[tk * 4 + e] = (int)slot; ((float*)(ws + WS_GATE))[tk * 4 + e] = gt;
        }
        asm volatile("s_waitcnt lgkmcnt(0)" ::: "memory"); __builtin_amdgcn_wave_barrier();
    }
}

constexpr int URS = 2064;
__device__ __forceinline__ void phase_router2(const Args& a, Ctx& C, int l) {
    unsigned char* ws = C.ws; const int lane = C.lane, w = C.wave;
    LAS unsigned char* uh = C.lds; LAS unsigned char* ul = uh + 16 * URS; LAS float* part = (LAS float*)(ul + 16 * URS);
    const float* mod = (const float*)(ws + WS_MOD); const float* H = (const float*)(ws + WS_H);
    const bf16_t* wrh = (const bf16_t*)(ws + WS_WRH) + (size_t)l * 32768; const bf16_t* wrl = (const bf16_t*)(ws + WS_WRL) + (size_t)l * 32768;
    unsigned* cnt = (unsigned*)(ws + WS_CTL) + CW_CNT + l * 32 * 64;
    for (int tile = blockIdx.x; tile < NTOK / 16; tile += C.G) {
        const int tok0 = tile * 16;
#pragma unroll
        for (int hf = 0; hf < 2; ++hf) {
            const int tr = 2 * w + hf, tk = tok0 + tr, b = tk >> 12; const f32x4* hr = (const f32x4*)(H + (size_t)tk * D) + lane; f32x4 v[4];
#pragma unroll
            for (int j = 0; j < 4; ++j) v[j] = hr[64 * j];
            float ss = 0.f;
#pragma unroll
            for (int j = 0; j < 4; ++j) ss += (v[j].x * v[j].x + v[j].y * v[j].y) + (v[j].z * v[j].z + v[j].w * v[j].w);
            const float rstd = 1.0f / sqrtf(wave_sum(ss) * (1.0f / D) + EPS);
            const float* mb = mod + (size_t)(l * 4 + b) * 6144; bf16_t* urow = (bf16_t*)(ws + WS_U) + (size_t)tk * D;
#pragma unroll
            for (int j = 0; j < 4; ++j) { const int idx = 4 * lane + 256 * j; const f32x4 gv = *(const f32x4*)(a.norm2_g + l * 1024 + idx), shv = *(const f32x4*)(mb + 3072 + idx), scv = *(const f32x4*)(mb + 4096 + idx);
                const f32x4 o = v[j] * rstd * gv * (scv + 1.0f) + shv; u32x2 hi; hi.x = pk2(o[0], o[1]); hi.y = pk2(o[2], o[3]); *(u32x2*)(urow + idx) = hi;
                u32x2 lo; lo.x = pk2(o[0] - bflo(hi.x), o[1] - bfhi(hi.x)); lo.y = pk2(o[2] - bflo(hi.y), o[3] - bfhi(hi.y));
                *(LAS u32x2*)(uh + tr * URS + idx * 2) = hi; *(LAS u32x2*)(ul + tr * URS + idx * 2) = lo; }
        }
        __syncthreads();
        {
            const int c = lane & 15, g = lane >> 4; f32x4 acc0 = (f32x4){0.f, 0.f, 0.f, 0.f}, acc1 = acc0;
#pragma unroll
            for (int kk = 0; kk < 4; ++kk) { const int ks = 4 * w + kk;
                const bf16x8 ah = *(const LAS bf16x8*)(uh + c * URS + (32 * ks + 8 * g) * 2), al = *(const LAS bf16x8*)(ul + c * URS + (32 * ks + 8 * g) * 2);
                const bf16x8 bh0 = *(const bf16x8*)(wrh + (size_t)c * 1024 + 32 * ks + 8 * g), bl0 = *(const bf16x8*)(wrl + (size_t)c * 1024 + 32 * ks + 8 * g);
                const bf16x8 bh1 = *(const bf16x8*)(wrh + (size_t)(c + 16) * 1024 + 32 * ks + 8 * g), bl1 = *(const bf16x8*)(wrl + (size_t)(c + 16) * 1024 + 32 * ks + 8 * g);
                acc0 = __builtin_amdgcn_mfma_f32_16x16x32_bf16(al, bh0, acc0, 0, 0, 0); acc0 = __builtin_amdgcn_mfma_f32_16x16x32_bf16(ah, bl0, acc0, 0, 0, 0); acc0 = __builtin_amdgcn_mfma_f32_16x16x32_bf16(ah, bh0, acc0, 0, 0, 0);
                acc1 = __builtin_amdgcn_mfma_f32_16x16x32_bf16(al, bh1, acc1, 0, 0, 0); acc1 = __builtin_amdgcn_mfma_f32_16x16x32_bf16(ah, bl1, acc1, 0, 0, 0); acc1 = __builtin_amdgcn_mfma_f32_16x16x32_bf16(ah, bh1, acc1, 0, 0, 0); }
#pragma unroll
            for (int r = 0; r < 4; ++r) { part[(w * 16 + 4 * g + r) * 32 + c] = acc0[r]; part[(w * 16 + 4 * g + r) * 32 + 16 + c] = acc1[r]; }
        }
        __syncthreads();
        {
            const int e = lane & 31, hf = lane >> 5, tr = 2 * w + hf, tk = tok0 + tr; float val = a.b_router[l * 32 + e];
#pragma unroll
            for (int ww = 0; ww < 8; ++ww) val += part[(ww * 16 + tr) * 32 + e];
            float tv[4]; int te[4];
#pragma unroll
            for (int k = 0; k < 4; ++k) {
                float bv = val; int bi = e;
#pragma unroll
                for (int o = 1; o < 32; o <<= 1) { const float ov = __shfl_xor(bv, o); const int oi = __shfl_xor(bi, o); if (ov > bv || (ov == bv && oi < bi)) { bv = ov; bi = oi; } }
                tv[k] = bv; te[k] = bi; if (e == bi) val = -3.0e38f;
            }
            const float e1 = __expf(tv[1] - tv[0]), e2 = __expf(tv[2] - tv[0]), e3 = __expf(tv[3] - tv[0]); const float rs = 1.0f / (1.0f + e1 + e2 + e3);
            if (e < 4) {
                const int ex = e == 0 ? te[0] : e == 1 ? te[1] : e == 2 ? te[2] : te[3]; const float gt = (e == 0 ? 1.0f : e == 1 ? e1 : e == 2 ? e2 : e3) * rs;
                const unsigned slot = atomicAdd(cnt + ex * 64, 1u);
                ((int*)(ws + WS_ROWTOK))[(size_t)ex * NTOK + slot] = tk;
                ((int*)(ws + WS_EIDX))[tk * 4 + e] = ex; ((int*)(ws + WS_SLOT))[tk * 4 + e] = (int)slot; ((float*)(ws + WS_GATE))[tk * 4 + e] = gt;
            }
        }
        __syncthreads();
    }
}

__device__ __forceinline__ void moe_table(Ctx& C, int l, LAS int* tab) {
    if (C.tid < 32) { const unsigned* cnt = (const unsigned*)(C.ws + WS_CTL) + CW_CNT + l * 32 * 64; tab[33 + C.tid] = (int)__hip_atomic_load(cnt + C.tid * 64, __ATOMIC_RELAXED, __HIP_MEMORY_SCOPE_AGENT); }
    __syncthreads();
    if (C.tid == 0) { int p = 0; for (int e = 0; e < 32; ++e) { tab[e] = p; p += (tab[33 + e] + 255) >> 8; } tab[32] = p; }
    __syncthreads();
}

__device__ __forceinline__ void phase_combine(const Args& a, Ctx& C, int l) {
    unsigned char* ws = C.ws; const int lane = C.lane;
    const float* mod = (const float*)(ws + WS_MOD); float* H = (float*)(ws + WS_H); const bf16_t* Y = (const bf16_t*)(ws + WS_Y);
    const unsigned* cnt = (const unsigned*)(ws + WS_CTL) + CW_CNT + l * 32 * 64;
    int mt = 0; if (lane < 32) mt = ((int)__hip_atomic_load(cnt + lane * 64, __ATOMIC_RELAXED, __HIP_MEMORY_SCOPE_AGENT) + 255) >> 8;
    int incl = mt;
#pragma unroll
    for (int o = 1; o < 32; o <<= 1) { const int t = __shfl_up(incl, o); if ((lane & 31) >= o) incl += t; }
    const int excl = incl - mt;
    const int gw = blockIdx.x * NWAVES + C.wave, NGW = C.G * NWAVES;
    for (int tk = gw; tk < NTOK; tk += NGW) {
        const int b = tk >> 12; f32x4 v[4]; f32x4* hr = (f32x4*)(H + (size_t)tk * D) + lane;
#pragma unroll
        for (int j = 0; j < 4; ++j) v[j] = hr[64 * j];
        f32x4 m[4];
#pragma unroll
        for (int j = 0; j < 4; ++j) m[j] = (f32x4){0.f, 0.f, 0.f, 0.f};
#pragma unroll
        for (int k = 0; k < 4; ++k) {
            const int ex = ((const int*)(ws + WS_EIDX))[tk * 4 + k], slot = ((const int*)(ws + WS_SLOT))[tk * 4 + k]; const float gt = ((const float*)(ws + WS_GATE))[tk * 4 + k];
            const int row = 256 * __shfl(excl, ex) + slot; const u32x2* yr = (const u32x2*)(Y + (size_t)row * D) + lane;
#pragma unroll
            for (int j = 0; j < 4; ++j) { const u32x2 w = yr[64 * j]; m[j] += (f32x4){bflo(w.x), bfhi(w.x), bflo(w.y), bfhi(w.y)} * gt; }
        }
        const float* mb = mod + (size_t)(l * 4 + b) * 6144;
#pragma unroll
        for (int j = 0; j < 4; ++j) { const f32x4 g2 = *(const f32x4*)(mb + 5120 + 4 * lane + 256 * j); v[j] += g2 * m[j]; if (l + 1 < DEPTH) hr[64 * j] = v[j]; }
        if (l + 1 < DEPTH) { const float* mn = mod + (size_t)((l + 1) * 4 + b) * 6144; norm_mod_store(v, a.norm1_g + (l + 1) * 1024, mn + 0, mn + 1024, (bf16_t*)(ws + WS_U) + (size_t)tk * D, lane); }
        else {
            float ss = 0.f;
#pragma unroll
            for (int j = 0; j < 4; ++j) ss += (v[j].x * v[j].x + v[j].y * v[j].y) + (v[j].z * v[j].z + v[j].w * v[j].w);
            const float rstd = 1.0f / sqrtf(wave_sum(ss) * (1.0f / D) + EPS);
            f32x4* orow = (f32x4*)(a.out + (size_t)tk * D) + lane;
#pragma unroll
            for (int j = 0; j < 4; ++j) orow[64 * j] = v[j] * rstd * *(const f32x4*)(a.final_g + 4 * lane + 256 * j);
        }
    }
}


#define XB_TMO      128
#define XB_XCNT(j)  (256  + 64 * (j))
#define XB_XSUB(j)  (1280 + 64 * (j))
#define XB_XGEN(j)  (2304 + 64 * (j))
#define XB_TOP      3328
#define XB_TOPGEN   3392
#define XCD_BAR_WORDS 3456
#define XB_SPIN_CAP (1u << 22)
__device__ __forceinline__ unsigned xb_ld(unsigned* p)              { return __hip_atomic_load(p, __ATOMIC_RELAXED, __HIP_MEMORY_SCOPE_AGENT); }
__device__ __forceinline__ unsigned xb_add(unsigned* p, unsigned v) { return __hip_atomic_fetch_add(p, v, __ATOMIC_RELAXED, __HIP_MEMORY_SCOPE_AGENT); }
__device__ __forceinline__ unsigned xb_xcc_id() { return (unsigned)__builtin_amdgcn_s_getreg((3 << 11) | 20) & 0xFu; }
#define XB_SPIN(cond, bar) do { unsigned _sp = 0; while (cond) { __builtin_amdgcn_s_sleep(1); \
    if ((++_sp & 255u) == 0u) { if (xb_ld(&(bar)[XB_TMO])) break; if (_sp > XB_SPIN_CAP) { atomicAdd(&(bar)[XB_TMO], 1u); break; } } } } while (0)
struct XcdBarrier { unsigned* bar; unsigned x; volatile LAS unsigned* st; };
__device__ __forceinline__ XcdBarrier xcd_barrier_post(unsigned* bar, volatile LAS unsigned* st, bool leader) {
    XcdBarrier b; b.bar = bar; b.x = xb_xcc_id(); b.st = st;
    if (leader) (void)xb_add(&bar[XB_XCNT(b.x)], 1u);
    return b;
}
__device__ __forceinline__ void xcd_barrier_complete(unsigned* bar, unsigned x, unsigned& nloc, unsigned& nx) {
    const unsigned G = gridDim.x * gridDim.y * gridDim.z;
    unsigned sum, cnt, mine, sp = 0u;
    for (;;) {
        sum = 0u; cnt = 0u; mine = 0u;
#pragma unroll
        for (unsigned j = 0; j < 16; ++j) { const unsigned c = xb_ld(&bar[XB_XCNT(j)]); sum += c; cnt += (c > 0u) ? 1u : 0u; mine = (j == x) ? c : mine; }
        if (sum == G) break;
        __builtin_amdgcn_s_sleep(1);
        if ((++sp & 255u) == 0u) { if (xb_ld(&bar[XB_TMO])) break; if (sp > XB_SPIN_CAP) { atomicAdd(&bar[XB_TMO], 1u); break; } }
    }
    nloc = mine > 0u ? mine : 1u; nx = cnt > 0u ? cnt : 1u;
}
__device__ __forceinline__ void xcd_barrier(const XcdBarrier& b, bool leader) {
    asm volatile("s_waitcnt vmcnt(0)" ::: "memory");
    __syncthreads();
    if (leader) {
        unsigned* bar = b.bar;
        __builtin_amdgcn_s_waitcnt(0);
        unsigned nloc = b.st[0], nx = b.st[1];
        if (nloc == 0u) { xcd_barrier_complete(bar, b.x, nloc, nx); b.st[0] = nloc; b.st[1] = nx; }
        const unsigned old = xb_add(&bar[XB_XSUB(b.x)], 1u);
        const unsigned gen = old / nloc;
        if (old + 1u == (gen + 1u) * nloc) {
            __builtin_amdgcn_fence(__ATOMIC_RELEASE, "agent");
            asm volatile("s_waitcnt vmcnt(0)" ::: "memory");
            const unsigned og = xb_add(&bar[XB_TOP], 1u);
            const unsigned tg = og / nx;
            if (og + 1u == (tg + 1u) * nx) xb_add(&bar[XB_TOPGEN], 1u);
            else XB_SPIN(xb_ld(&bar[XB_TOPGEN]) == tg, bar);
            __builtin_amdgcn_fence(__ATOMIC_ACQUIRE, "agent");
            xb_add(&bar[XB_XGEN(b.x)], 1u);
            asm volatile("s_waitcnt vmcnt(0)" ::: "memory");
        } else {
            XB_SPIN(xb_ld(&bar[XB_XGEN(b.x)]) == gen, bar);
            __builtin_amdgcn_fence(__ATOMIC_ACQUIRE, "agent");
            asm volatile("s_waitcnt vmcnt(0)" ::: "memory");
        }
    }
    __syncthreads();
}

typedef const __attribute__((address_space(4))) Args* KArgsPtr;
__device__ __forceinline__ Args load_args() {
#if defined(__HIP_DEVICE_COMPILE__)
    KArgsPtr p = (KArgsPtr)__builtin_amdgcn_kernarg_segment_ptr(); asm volatile("" : "+s"(p)); Args a;
    a.x = p->x; a.c = p->c; a.pos = p->pos; a.w_ada = p->w_ada; a.b_ada = p->b_ada; a.norm1_g = p->norm1_g; a.norm2_g = p->norm2_g; a.w_in = p->w_in; a.w_out = p->w_out; a.pool_w = p->pool_w;
    a.pool_scale = p->pool_scale; a.hgrn_g = p->hgrn_g; a.lb_logits = p->lb_logits; a.w_router = p->w_router; a.b_router = p->b_router; a.w1 = p->w1; a.b1 = p->b1; a.w2 = p->w2; a.b2 = p->b2; a.final_g = p->final_g;
    a.out = p->out; a.ws = p->ws; a.ph_lo = p->ph_lo; a.ph_hi = p->ph_hi; return a;
#else
    return Args{};
#endif
}
__device__ __forceinline__ int lane_id() { return __builtin_amdgcn_mbcnt_hi(~0u, __builtin_amdgcn_mbcnt_lo(~0u, 0)); }
__device__ __forceinline__ Ctx make_ctx(unsigned char* ws, int wv) {
    extern __shared__ __attribute__((aligned(16))) unsigned char lds_raw[];
    Ctx C; C.lds = (LAS unsigned char*)lds_raw; { int l_ = lane_id(); asm volatile("" : "+v"(l_)); C.lane = l_; } C.wave = wv; C.tid = wv * 64 + C.lane;
    C.G = gridDim.x; { const int bx = blockIdx.x; C.vcu = (C.G % 8 == 0) ? (bx % 8) * (C.G / 8) + bx / 8 : bx; }
    C.ws = ws; return C;
}
#ifndef PHASE_FN
#define PHASE_FN __device__ __forceinline__ void
#endif
#define GEMM_FN __device__ __forceinline__ void
PHASE_FN ph_prep(int wv) { const Args a = load_args(); Ctx C = make_ctx(a.ws, wv); phase_prep(a, C); }
PHASE_FN ph_u0(int wv) { const Args a = load_args(); Ctx C = make_ctx(a.ws, wv); phase_u0(a, C); }
GEMM_FN ph_gin(int l, int wv) { const Args a = load_args(); Ctx C = make_ctx(a.ws, wv); unsigned char* ws = a.ws;
    DenseOrder S{(const char*)(ws + WS_U), (const char*)(ws + WS_WIN) + (size_t)l * NPAD * 1024 * 2, NTOK / 256, NPAD / 256, (NTOK / 256) * (NPAD / 256), C.G, (int)blockIdx.x};
    EpiIn E{ws}; pg8::gemm_phase<EpiIn, DenseOrder, false, true>(C.lds, (LAS unsigned*)(C.lds + LDS_PARK), C.tid, S, E); }
PHASE_FN ph_mix1(int l, int wv) { const Args a = load_args(); Ctx C = make_ctx(a.ws, wv); phase_mix1(a, C, l); }
PHASE_FN ph_mix2(int l, int wv) { const Args a = load_args(); Ctx C = make_ctx(a.ws, wv); phase_mix2(a, C, l); }
GEMM_FN ph_gout(int l, int wv) { const Args a = load_args(); Ctx C = make_ctx(a.ws, wv); unsigned char* ws = a.ws;
    DenseOrder S{(const char*)(ws + WS_MIX), (const char*)(ws + WS_WOUT) + (size_t)l * 1024 * 1024 * 2, NTOK / 256, 4, (NTOK / 256) * 4, C.G, (int)blockIdx.x};
    EpiOut E{l == 0 ? a.x : (const float*)(ws + WS_H), (float*)(ws + WS_H), (const float*)(ws + WS_MOD) + (size_t)l * 4 * 6144 + 2048};
    pg8::gemm_phase<EpiOut, DenseOrder, false, true>(C.lds, (LAS unsigned*)(C.lds + LDS_PARK), C.tid, S, E); }
PHASE_FN ph_router(int l, int wv) { const Args a = load_args(); Ctx C = make_ctx(a.ws, wv); phase_router2(a, C, l); }
GEMM_FN ph_g1(int l, int wv) { const Args a = load_args(); Ctx C = make_ctx(a.ws, wv); unsigned char* ws = a.ws;
    LAS int* tab = (LAS int*)(C.lds + LDS_TAB); moe_table(C, l, tab);
    MoeOrder<true> S{tab, (const char*)(ws + WS_U), (const char*)(ws + WS_W1) + (size_t)l * 32 * 2048 * 1024 * 2, (const int*)(ws + WS_ROWTOK), C.G, C.vcu};
    EpiG1 E{(bf16_t*)(ws + WS_ACT), a.b1 + (size_t)l * 32 * 2048}; pg8::gemm_phase<EpiG1, MoeOrder<true>, true, true>(C.lds, (LAS unsigned*)(C.lds + LDS_PARK), C.tid, S, E); }
GEMM_FN ph_g2(int l, int wv) { const Args a = load_args(); Ctx C = make_ctx(a.ws, wv); unsigned char* ws = a.ws;
    LAS int* tab = (LAS int*)(C.lds + LDS_TAB); moe_table(C, l, tab);
    MoeOrder<false> S{tab, (const char*)(ws + WS_ACT), (const char*)(ws + WS_W2) + (size_t)l * 32 * 1024 * 1024 * 2, nullptr, C.G, C.vcu};
    EpiG2 E{(bf16_t*)(ws + WS_Y), a.b2 + (size_t)l * 32 * 1024}; pg8::gemm_phase<EpiG2, MoeOrder<false>, false, true>(C.lds, (LAS unsigned*)(C.lds + LDS_PARK), C.tid, S, E); }
PHASE_FN ph_combine(int l, int wv) { const Args a = load_args(); Ctx C = make_ctx(a.ws, wv); phase_combine(a, C, l); }

constexpr int NPHASES = 2 + 8 * DEPTH;
__global__ void __launch_bounds__(NTHREADS, 2) mega_fwd(Args a) {
#if MK_ONE_LAUNCH == 1
    cg::grid_group grid = cg::this_grid();
#define SEAM() do { __syncthreads(); grid.sync(); } while (0)
#elif MK_ONE_LAUNCH == 2
    extern __shared__ __attribute__((aligned(16))) unsigned char lds_k[];
    volatile LAS unsigned* bst = (volatile LAS unsigned*)((LAS unsigned char*)lds_k + LDS_BYTES - 64);
    const bool leader = (threadIdx.x == 0);
    if (leader) { bst[0] = 0u; bst[1] = 0u; }
    __syncthreads();
    const XcdBarrier xbar = xcd_barrier_post((unsigned*)(a.ws + WS_CTL) + CW_BAR, bst, leader);
#define SEAM() xcd_barrier(xbar, leader)
#else
#define SEAM() do { } while (0)
#endif
    const int lo = a.ph_lo, hi = a.ph_hi;
    const int wv = __builtin_amdgcn_readfirstlane((int)threadIdx.x >> 6);
#ifndef KINDMASK
#define KINDMASK 0xffffu
#endif
#define KON(k) (((KINDMASK) >> (k)) & 1u)
#ifndef REP_ID
#define REP_ID -1
#endif
#define RUN(kind, id, call) do { if (KON(kind) && lo <= (id) && (id) < hi) { call; if ((id) == REP_ID) { __syncthreads(); call; } if ((id) + 1 < hi) SEAM(); } } while (0)
    RUN(0, 0, ph_prep(wv));
    RUN(1, 1, ph_u0(wv));
    RUN(2, 2, ph_gin(0, wv)); RUN(3, 3, ph_mix1(0, wv)); RUN(4, 4, ph_mix2(0, wv)); RUN(5, 5, ph_gout(0, wv)); RUN(6, 6, ph_router(0, wv)); RUN(7, 7, ph_g1(0, wv)); RUN(8, 8, ph_g2(0, wv)); RUN(9, 9, ph_combine(0, wv));
    RUN(2, 10, ph_gin(1, wv)); RUN(3, 11, ph_mix1(1, wv)); RUN(4, 12, ph_mix2(1, wv)); RUN(5, 13, ph_gout(1, wv)); RUN(6, 14, ph_router(1, wv)); RUN(7, 15, ph_g1(1, wv)); RUN(8, 16, ph_g2(1, wv)); RUN(9, 17, ph_combine(1, wv));
}

extern "C" void kernel_launch(void* const* d_in, const int* in_sizes, int n_in, void* d_out, int out_size, void* d_ws, size_t ws_size, hipStream_t stream) {
    static int grid = 0;
    if (grid == 0) {
        if (n_in != 20 || out_size != NTOK * D || ws_size < WS_END) { fprintf(stderr, "kernel_launch: unexpected shapes: n_in %d out %d ws %zu (need %zu)\n", n_in, out_size, ws_size, (size_t)WS_END); grid = -1; return; }
        int dev = 0, cus = 0, per_cu = 0;
        hipGetDevice(&dev); hipDeviceGetAttribute(&cus, hipDeviceAttributeMultiprocessorCount, dev);
        if (hipFuncSetAttribute((const void*)mega_fwd, hipFuncAttributeMaxDynamicSharedMemorySize, LDS_BYTES) != hipSuccess) { fprintf(stderr, "kernel_launch: hipFuncSetAttribute failed\n"); grid = -1; return; }
        hipOccupancyMaxActiveBlocksPerMultiprocessor(&per_cu, (const void*)mega_fwd, NTHREADS, LDS_BYTES);
        (void)hipGetLastError();
        if (per_cu < 1) fprintf(stderr, "kernel_launch: occupancy query says %d blocks per CU\n", per_cu);
        grid = cus;
    }
    if (grid < 0) return;
    hipMemsetAsync((char*)d_ws + WS_CTL, 0, CTL_BYTES, stream);
    Args a{};
    a.x = (const float*)d_in[0]; a.c = (const float*)d_in[1]; a.pos = (const int*)d_in[2]; a.w_ada = (const float*)d_in[3]; a.b_ada = (const float*)d_in[4];
    a.norm1_g = (const float*)d_in[5]; a.norm2_g = (const float*)d_in[6]; a.w_in = (const float*)d_in[7]; a.w_out = (const float*)d_in[8]; a.pool_w = (const float*)d_in[9];
    a.pool_scale = (const float*)d_in[10]; a.hgrn_g = (const float*)d_in[11]; a.lb_logits = (const float*)d_in[12]; a.w_router = (const float*)d_in[13]; a.b_router = (const float*)d_in[14];
    a.w1 = (const float*)d_in[15]; a.b1 = (const float*)d_in[16]; a.w2 = (const float*)d_in[17]; a.b2 = (const float*)d_in[18]; a.final_g = (const float*)d_in[19];
    a.out = (float*)d_out; a.ws = (unsigned char*)d_ws;
#if MK_ONE_LAUNCH == 1
    a.ph_lo = 0; a.ph_hi = NPHASES;
    void* args[] = {&a};
    hipError_t e = hipLaunchCooperativeKernel((const void*)mega_fwd, dim3(grid), dim3(NTHREADS), args, LDS_BYTES, stream);
    if (e != hipSuccess) fprintf(stderr, "cooperative launch failed: %s (grid %d)\n", hipGetErrorString(e), grid);
#elif MK_ONE_LAUNCH == 2
    a.ph_lo = 0; a.ph_hi = NPHASES;
    hipLaunchKernelGGL(mega_fwd, dim3(grid), dim3(NTHREADS), LDS_BYTES, stream, a);
#else
    for (int p = 0; p < NPHASES; ++p) { a.ph_lo = p; a.ph_hi = p + 1; hipLaunchKernelGGL(mega_fwd, dim3(grid), dim3(NTHREADS), LDS_BYTES, stream, a); }
#endif
}
```

```cpp
#include <hip/hip_runtime.h>
#include <hip/hip_cooperative_groups.h>
#include <cstdio>
#include <cstdint>
namespace cg = cooperative_groups;

#ifndef MK_ONE_LAUNCH
#define PG8_USE_SP2 1
#define MK_ONE_LAUNCH 2
#endif

#define LAS __attribute__((address_space(3)))
typedef unsigned short bf16_t;
typedef short bf16x8 __attribute__((ext_vector_type(8)));
typedef float f32x4 __attribute__((ext_vector_type(4)));
typedef float f32x2 __attribute__((ext_vector_type(2)));
typedef unsigned u32x4 __attribute__((ext_vector_type(4)));
typedef unsigned u32x2 __attribute__((ext_vector_type(2)));

constexpr int D = 1024, NBATCH = 4, SEQ = 4096, NTOK = NBATCH * SEQ, DEPTH = 2;
constexpr int D_IN = 2372, NPAD = 2560;
constexpr int NE = 32, TOPK = 4, FF = 1024;
constexpr int NWAVES = 8, NTHREADS = 512;
constexpr float EPS = 1e-6f;
constexpr int ROWCAP = 73728;

constexpr size_t MiB = 1u << 20;
constexpr size_t WS_CTL = 0, CTL_BYTES = 1 * MiB;
constexpr size_t WS_MOD = 1 * MiB;
constexpr size_t WS_ROPEC = 2 * MiB;
constexpr size_t WS_ROPES = 4 * MiB;
constexpr size_t WS_WIN = 6 * MiB;
constexpr size_t WS_WOUT = 16 * MiB;
constexpr size_t WS_ROWTOK = 20 * MiB;
constexpr size_t WS_EIDX = 22 * MiB;
constexpr size_t WS_SLOT = 22 * MiB + 256 * 1024;
constexpr size_t WS_GATE = 22 * MiB + 512 * 1024;
constexpr size_t WS_WI = 23 * MiB;
constexpr size_t WS_WRH = 23 * MiB + 256 * 1024;
constexpr size_t WS_WRL = 23 * MiB + 512 * 1024;
constexpr size_t WS_KI = 24 * MiB;
constexpr size_t WS_K = 26 * MiB;
constexpr size_t WS_V = 30 * MiB;
constexpr size_t WS_QI = 34 * MiB;
constexpr size_t WS_Q = 42 * MiB;
constexpr size_t WS_UB = 58 * MiB;
constexpr size_t WS_HG = 74 * MiB;
constexpr size_t WS_SEL = 138 * MiB;
constexpr size_t WS_HL = 154 * MiB;
constexpr size_t WS_HD = 170 * MiB;
constexpr size_t WS_MIX = 171 * MiB;
constexpr size_t WS_U = 203 * MiB;
constexpr size_t WS_H = 235 * MiB;
constexpr size_t WS_W1 = 299 * MiB;
constexpr size_t WS_W2 = 555 * MiB;
constexpr size_t WS_ACT = 683 * MiB;
constexpr size_t WS_Y = 827 * MiB;
constexpr size_t WS_END = 971 * MiB;
constexpr int CW_CNT = 1024;
constexpr int CW_BAR = 8192;

constexpr int LDS_BYTES = 147456;
constexpr int LDS_TAB = 131072;
constexpr int LDS_PARK = 131072 + 1024;

__device__ __forceinline__ unsigned f2bf(float f) { unsigned u = __builtin_bit_cast(unsigned, f); return (u + 0x7fffu + ((u >> 16) & 1u)) >> 16; }
typedef __bf16 bf16x2_t __attribute__((ext_vector_type(2)));
__device__ __forceinline__ unsigned cvt_pk_bf16(float lo, float hi) { const f32x2 v = {lo, hi}; const bf16x2_t b = __builtin_convertvector(v, bf16x2_t); return __builtin_bit_cast(unsigned, b); }
__device__ __forceinline__ unsigned pk2(float lo, float hi) { return cvt_pk_bf16(lo, hi); }
__device__ __forceinline__ float bf2f(unsigned short b) { return __builtin_bit_cast(float, ((unsigned)b) << 16); }
__device__ __forceinline__ float bflo(unsigned w) { return __builtin_bit_cast(float, w << 16); }
__device__ __forceinline__ float bfhi(unsigned w) { return __builtin_bit_cast(float, w & 0xffff0000u); }
__device__ __forceinline__ float wave_sum(float v) {
#pragma unroll
    for (int o = 1; o < 64; o <<= 1) v += __shfl_xor(v, o);
    return v;
}
__device__ __forceinline__ float wave_max(float v) {
#pragma unroll
    for (int o = 1; o < 64; o <<= 1) v = fmaxf(v, __shfl_xor(v, o));
    return v;
}
__device__ __forceinline__ float sigmoidf_(float z) { return __builtin_amdgcn_rcpf(1.0f + __expf(-z)); }
__device__ __forceinline__ float siluf_(float z) { return z * __builtin_amdgcn_rcpf(1.0f + __expf(-z)); }

namespace pg8 {
constexpr int BM = 256, BK = 64, HALF = 128, HTB = HALF * BK * 2, STAGE_BYTES = 8 * HTB;
constexpr int KD = 1024, NKT = KD / BK;
__host__ __device__ __forceinline__ int lds_byte(int r, int c) { const int st = (r >> 4) * 2 + (c >> 5), rr = r & 15, cc = c & 31, ob = rr * 64 + cc * 2; return st * 1024 + (ob ^ (((ob >> 9) & 1) << 5)); }
__host__ __device__ __forceinline__ void stage_rc(int b, int& R, int& C) { const int st = b / 1024, sb = b % 1024, swz = sb ^ (((sb >> 9) & 1) << 5); R = (st >> 1) * 16 + swz / 64; C = (st & 1) * 32 + (swz % 64) / 2; }

struct Unit { const char* A; const char* B; const int* ridx; int nvalid; int row0, pn, e, b; };

template <class Epi, class Sched, bool GATHER, bool ALIGN_EPI>
__device__ __forceinline__ void gemm_phase(LAS unsigned char* lds, LAS unsigned* park, int tid_in, const Sched& S, const Epi& E) {
    const int tid = tid_in, wid = __builtin_amdgcn_readfirstlane(tid >> 6), lane = tid & 63, wr = wid >> 2, wc = wid & 3, fr = lane & 15, fq = lane >> 4;
    constexpr int K = KD, nt = NKT;
    unsigned voffB[2], vA[2][2];
#pragma unroll
    for (int i = 0; i < 2; ++i) { int R, C; stage_rc(tid * 16 + i * 8192, R, C); voffB[i] = (unsigned)(R * K + C) * 2u; }
    constexpr size_t kstep = (size_t)(BK * 2);
    constexpr size_t hstep = (size_t)HALF * K * 2;
    const unsigned ldsw = (unsigned)wid * 1024u;
    const int aoff = lds_byte(wr * 64 + fr, fq * 8), boff = lds_byte(wc * 32 + fr, fq * 8);
#define PG8_SA(b, h) (((b) * 2 + (h)) * HTB)
#define PG8_SB(b, h) ((4 + (b) * 2 + (h)) * HTB)
#define PG8_STAGE(bufoff, gbase, voff) do { _Pragma("unroll") for (int _i = 0; _i < 2; ++_i) \
        __builtin_amdgcn_global_load_lds((const unsigned*)((const char*)(gbase) + (voff)[_i]), (LAS unsigned*)(lds + (bufoff) + ldsw + _i * 8192), 16, 0, 0); } while (0)
#define PG8_LDA(dst, b, h) do { _Pragma("unroll") for (int m = 0; m < 4; ++m) _Pragma("unroll") for (int k = 0; k < 2; ++k) dst[m][k] = *(const LAS bf16x8*)(lds + PG8_SA(b, h) + aoff + m * 2048 + k * 1024); } while (0)
#define PG8_LDB(dst, b, h) do { _Pragma("unroll") for (int n = 0; n < 2; ++n) _Pragma("unroll") for (int k = 0; k < 2; ++k) dst[n][k] = *(const LAS bf16x8*)(lds + PG8_SB(b, h) + boff + n * 2048 + k * 1024); } while (0)
#define PG8_MMA(ai, bj, At, Bt) do { __builtin_amdgcn_s_setprio(1); _Pragma("unroll") for (int m = 0; m < 4; ++m) _Pragma("unroll") for (int n = 0; n < 2; ++n) _Pragma("unroll") for (int k = 0; k < 2; ++k) \
        acc[ai][bj][m][n] = __builtin_amdgcn_mfma_f32_16x16x32_bf16(Bt[n][k], At[m][k], acc[ai][bj][m][n], 0, 0, 0); __builtin_amdgcn_s_setprio(0); } while (0)
#define PG8_WAIT_V(n) asm volatile("s_waitcnt vmcnt(" #n ")" ::: "memory")
#define PG8_WAIT_L(n) asm volatile("s_waitcnt lgkmcnt(" #n ")" ::: "memory")
#define PG8_BAR __builtin_amdgcn_s_barrier()
#define PG8_SCHED __builtin_amdgcn_sched_barrier(0)
#define PG8_OFFS(dst, u) do { _Pragma("unroll") for (int _h = 0; _h < 2; ++_h) _Pragma("unroll") for (int _i = 0; _i < 2; ++_i) { \
        int _R, _C; stage_rc(tid * 16 + _i * 8192, _R, _C); const int _rr = _h * HALF + _R; \
        if constexpr (GATHER) { const int _ix = (u).ridx[_rr < (u).nvalid ? _rr : 0]; dst[_h][_i] = (unsigned)(_ix * K + _C) * 2u; } \
        else dst[_h][_i] = (unsigned)(_rr * K + _C) * 2u; } } while (0)
    Unit cur, nxt; int ui = 0;
    if (!S.next(0, cur)) return;
    f32x4 acc[2][2][4][2];
#pragma unroll
    for (int a = 0; a < 2; ++a)
#pragma unroll
        for (int b = 0; b < 2; ++b)
#pragma unroll
            for (int m = 0; m < 4; ++m)
#pragma unroll
                for (int n = 0; n < 2; ++n) acc[a][b][m][n] = (f32x4){0.f, 0.f, 0.f, 0.f};
    bf16x8 At[4][2], B0[2][2], B1[2][2];
    PG8_OFFS(vA, cur);
    const char* cA = cur.A; const char* cB = cur.B;
#if !defined(PG8_USE_SP2) || PG8_USE_SP2
    PG8_STAGE(PG8_SB(0, 0), cB, voffB); PG8_STAGE(PG8_SB(0, 1), cB + hstep, voffB); PG8_STAGE(PG8_SA(0, 0), cA, vA[0]); PG8_STAGE(PG8_SA(0, 1), cA, vA[1]);
    if (wr == 1) PG8_BAR;
    PG8_WAIT_V(2); PG8_BAR;
    PG8_STAGE(PG8_SB(1, 0), cB + kstep, voffB); PG8_STAGE(PG8_SA(1, 0), cA + kstep, vA[0]); PG8_STAGE(PG8_SB(1, 1), cB + hstep + kstep, voffB);
    PG8_WAIT_V(6); PG8_BAR;
#else
    PG8_STAGE(PG8_SB(0, 0), cB, voffB); PG8_STAGE(PG8_SA(0, 0), cA, vA[0]); PG8_STAGE(PG8_SB(0, 1), cB + hstep, voffB); PG8_STAGE(PG8_SA(0, 1), cA, vA[1]);
    if (wr == 1) PG8_BAR;
    PG8_WAIT_V(4); PG8_BAR;
    PG8_STAGE(PG8_SB(1, 0), cB + kstep, voffB); PG8_STAGE(PG8_SA(1, 0), cA + kstep, vA[0]); PG8_STAGE(PG8_SB(1, 1), cB + hstep + kstep, voffB);
    PG8_WAIT_V(6); PG8_BAR;
#endif
    for (;;) {
        const bool has_next = S.next(ui + 1, nxt);
        const char* nA = has_next ? nxt.A : cA; const char* nB = has_next ? nxt.B : cB;
        if constexpr (GATHER) {
            unsigned nv[2][2];
            if (has_next) { PG8_OFFS(nv, nxt); } else {
#pragma unroll
                for (int h = 0; h < 2; ++h) { nv[h][0] = vA[h][0]; nv[h][1] = vA[h][1]; } }
            *(LAS u32x4*)(park + tid * 4) = (u32x4){nv[0][0], nv[0][1], nv[1][0], nv[1][1]};
        }
        for (int t = 0; t < nt; t += 2) {
            const bool last = (t == nt - 2);
            const char* a1 = cA + (size_t)(t + 1) * kstep;
            const char* a2 = last ? nA : cA + (size_t)(t + 2) * kstep; const char* b2 = last ? nB : cB + (size_t)(t + 2) * kstep;
            const char* a3 = a2 + kstep; const char* b3 = b2 + kstep;
#ifndef PG8_USE_SP2
#define PG8_USE_SP2 1
#endif
            if constexpr (PG8_USE_SP2) {
            PG8_LDB(B0, 0, 0); PG8_LDB(B1, 0, 1); PG8_SCHED; PG8_LDA(At, 0, 0); PG8_STAGE(PG8_SA(1, 1), a1, vA[1]);
            if constexpr (GATHER) { if (last) { const u32x4 pv = *(const LAS u32x4*)(park + tid * 4); vA[0][0] = pv.x; vA[0][1] = pv.y; vA[1][0] = pv.z; vA[1][1] = pv.w; } }
            PG8_WAIT_V(8); PG8_WAIT_L(0); PG8_BAR; PG8_MMA(0, 0, At, B0); PG8_MMA(0, 1, At, B1); PG8_BAR; PG8_SCHED;
            PG8_LDA(At, 0, 1); PG8_STAGE(PG8_SB(0, 0), b2, voffB); PG8_STAGE(PG8_SB(0, 1), b2 + hstep, voffB); PG8_STAGE(PG8_SA(0, 0), a2, vA[0]);
            PG8_WAIT_V(8); PG8_WAIT_L(0); PG8_BAR; PG8_MMA(1, 0, At, B0); PG8_MMA(1, 1, At, B1); PG8_BAR; PG8_SCHED;
            PG8_LDB(B0, 1, 0); PG8_LDB(B1, 1, 1); PG8_SCHED; PG8_LDA(At, 1, 0); PG8_STAGE(PG8_SA(0, 1), a2, vA[1]);
            PG8_WAIT_V(8); PG8_WAIT_L(0); PG8_BAR; PG8_MMA(0, 0, At, B0); PG8_MMA(0, 1, At, B1); PG8_BAR; PG8_SCHED;
            PG8_LDA(At, 1, 1); PG8_STAGE(PG8_SB(1, 0), b3, voffB); PG8_STAGE(PG8_SB(1, 1), b3 + hstep, voffB); PG8_STAGE(PG8_SA(1, 0), a3, vA[0]);
            PG8_WAIT_V(8); PG8_WAIT_L(0); PG8_BAR; PG8_MMA(1, 0, At, B0); PG8_MMA(1, 1, At, B1); PG8_BAR; PG8_SCHED;
                    } else {
            PG8_LDB(B0, 0, 0); PG8_SCHED; PG8_LDA(At, 0, 0); PG8_STAGE(PG8_SA(1, 1), a1, vA[1]);
            if constexpr (GATHER) { if (last) { const u32x4 pv = *(const LAS u32x4*)(park + tid * 4); vA[0][0] = pv.x; vA[0][1] = pv.y; vA[1][0] = pv.z; vA[1][1] = pv.w; } }
            PG8_WAIT_L(8); PG8_BAR; PG8_WAIT_L(0); PG8_MMA(0, 0, At, B0); PG8_BAR; PG8_SCHED;
            PG8_LDB(B1, 0, 1); PG8_STAGE(PG8_SB(0, 0), b2, voffB);
            PG8_BAR; PG8_WAIT_L(0); PG8_MMA(0, 1, At, B1); PG8_BAR;
            PG8_LDA(At, 0, 1); PG8_STAGE(PG8_SA(0, 0), a2, vA[0]);
            PG8_BAR; PG8_WAIT_L(0); PG8_MMA(1, 0, At, B0); PG8_BAR; PG8_SCHED;
            PG8_STAGE(PG8_SB(0, 1), b2 + hstep, voffB);
            PG8_WAIT_V(6); PG8_BAR; PG8_MMA(1, 1, At, B1); PG8_BAR;
            PG8_LDB(B0, 1, 0); PG8_SCHED; PG8_LDA(At, 1, 0); PG8_STAGE(PG8_SA(0, 1), a2, vA[1]);
            PG8_WAIT_L(8); PG8_BAR; PG8_WAIT_L(0); PG8_MMA(0, 0, At, B0); PG8_BAR; PG8_SCHED;
            PG8_LDB(B1, 1, 1); PG8_STAGE(PG8_SB(1, 0), b3, voffB);
            PG8_BAR; PG8_WAIT_L(0); PG8_MMA(0, 1, At, B1); PG8_BAR;
            PG8_LDA(At, 1, 1); PG8_STAGE(PG8_SA(1, 0), a3, vA[0]);
            PG8_BAR; PG8_WAIT_L(0); PG8_MMA(1, 0, At, B0); PG8_BAR; PG8_SCHED;
            PG8_STAGE(PG8_SB(1, 1), b3 + hstep, voffB);
            PG8_WAIT_V(6); PG8_BAR; PG8_MMA(1, 1, At, B1); PG8_BAR;
            }
        }
        if constexpr (ALIGN_EPI) { if (wr == 0) PG8_BAR; }
#ifndef EPIREP
#define EPIREP 1
#endif
        for (int er = 0; er < Epi::REP; ++er) { int fr2 = fr, fq2 = fq; asm volatile("" : "+v"(fr2), "+v"(fq2)); E(acc, cur, wr, wc, fr2, fq2); }
        if (!has_next) break;
#pragma unroll
        for (int a = 0; a < 2; ++a)
#pragma unroll
            for (int b = 0; b < 2; ++b)
#pragma unroll
                for (int m = 0; m < 4; ++m)
#pragma unroll
                    for (int n = 0; n < 2; ++n) acc[a][b][m][n] = (f32x4){0.f, 0.f, 0.f, 0.f};
        cur = nxt; cA = nA; cB = nB; ++ui;
        if constexpr (ALIGN_EPI) { if (wr == 1) PG8_BAR; }
    }
    PG8_WAIT_V(0);
    if constexpr (!ALIGN_EPI) { if (wr == 0) PG8_BAR; }
    PG8_BAR;
#undef PG8_SA
#undef PG8_SB
#undef PG8_STAGE
#undef PG8_LDA
#undef PG8_LDB
#undef PG8_MMA
#undef PG8_WAIT_V
#undef PG8_WAIT_L
#undef PG8_BAR
#undef PG8_SCHED
#undef PG8_OFFS
}
}

struct Args {
    const float* x; const float* c; const int* pos; const float* w_ada; const float* b_ada; const float* norm1_g; const float* norm2_g;
    const float* w_in; const float* w_out; const float* pool_w; const float* pool_scale; const float* hgrn_g; const float* lb_logits;
    const float* w_router; const float* b_router; const float* w1; const float* b1; const float* w2; const float* b2; const float* final_g;
    float* out; unsigned char* ws; int ph_lo, ph_hi;
};

struct Ctx {
    LAS unsigned char* lds;
    int tid, lane, wave, G, vcu;
    unsigned char* ws;
};

struct DenseOrder {
    const char* A; const char* B; int nM, nN, nwg, G, c;
    __device__ __forceinline__ bool next(int i, pg8::Unit& u) const {
        const long L = (long)i * G + c; if (L >= nwg) return false;
        int wgid = (int)L; { const int q = nwg / 8, r = nwg % 8, xcd = wgid % 8, off = wgid / 8; wgid = (xcd < r ? xcd * (q + 1) : r * (q + 1) + (xcd - r) * q) + off; }
        const int nig = 8 * nN, gid = wgid / nig, fm = gid * 8, gsz = (nM - fm) < 8 ? (nM - fm) : 8;
        const int pm = fm + ((wgid % nig) % gsz), pn = (wgid % nig) / gsz;
        u.A = A + (size_t)pm * 256 * pg8::KD * 2; u.B = B + (size_t)pn * 256 * pg8::KD * 2; u.ridx = nullptr; u.nvalid = 256; u.row0 = pm * 256; u.pn = pn; u.e = 0; u.b = pm >> 4;
        return true;
    }
};

template <bool FIRST> struct MoeOrder {
    LAS const int* tab; const char* A; const char* B; const int* rowtok; int G, c;
    static constexpr int NTN = FIRST ? 8 : 4;
    __device__ __forceinline__ bool next(int i, pg8::Unit& u) const {
#ifndef KREP
#define KREP 1
#endif
        const int P = tab[32]; const long L = (long)(i / (FIRST ? 1 : KREP)) * G + c; if (L >= (long)P * NTN) return false;
        const int p = (int)(L / NTN), nt = (int)(L % NTN);
        int e = 0;
#pragma unroll 1
        for (int k = 1; k < 32; ++k) e = (tab[k] <= p) ? k : e;
        const int mt = p - tab[e], cnt = tab[33 + e];
        if (FIRST) { u.A = A; u.ridx = rowtok + e * NTOK + mt * 256; u.nvalid = (cnt - mt * 256) < 256 ? (cnt - mt * 256) : 256; u.B = B + ((size_t)e * 2048 + nt * 256) * pg8::KD * 2; }
        else { u.A = A + (size_t)p * 256 * pg8::KD * 2; u.ridx = nullptr; u.nvalid = 256; u.B = B + ((size_t)e * 1024 + nt * 256) * pg8::KD * 2; }
        u.row0 = p * 256; u.pn = nt; u.e = e; u.b = (FIRST ? 1 : ((i % KREP) == KREP - 1));
        return true;
    }
};

#ifndef EPIREP_IN
#define EPIREP_IN 1
#endif
#ifndef EPIREP_G1
#define EPIREP_G1 1
#endif
#ifndef EPIREP_G2
#define EPIREP_G2 1
#endif
struct EpiIn {
    static constexpr int REP = EPIREP_IN;
    unsigned char* ws;
    __device__ __forceinline__ void operator()(const f32x4 (&acc)[2][2][4][2], const pg8::Unit& u, int wr, int wc, int fr, int fq) const {
        const int pn = u.pn;
        const float* rc = (const float*)(ws + WS_ROPEC); const float* rs = (const float*)(ws + WS_ROPES);
        const bool rope = (pn <= 1) || (pn == 3) || (pn == 2 && wc < 2) || (pn == 4 && wc == 0);
#pragma unroll
        for (int ai = 0; ai < 2; ++ai)
#pragma unroll
            for (int m = 0; m < 4; ++m) {
                const int r = u.row0 + ai * 128 + wr * 64 + m * 16 + fr;
                if (rope) {
                    bf16_t* dst; float scl = 1.f;
                    if (pn <= 1) { dst = (bf16_t*)(ws + WS_Q) + (size_t)r * 512 + (pn * 4 + wc) * 64; scl = 0.125f; }
                    else if (pn == 2) dst = (bf16_t*)(ws + WS_K) + (size_t)r * 128 + wc * 64;
                    else if (pn == 3) dst = (bf16_t*)(ws + WS_QI) + (size_t)r * 256 + wc * 64;
                    else dst = (bf16_t*)(ws + WS_KI) + (size_t)r * 64;
                    const f32x4 c0 = *(const f32x4*)(rc + (size_t)r * 32 + 8 * fq), c1 = *(const f32x4*)(rc + (size_t)r * 32 + 8 * fq + 4), s0 = *(const f32x4*)(rs + (size_t)r * 32 + 8 * fq), s1 = *(const f32x4*)(rs + (size_t)r * 32 + 8 * fq + 4);
                    const f32x4 x10 = acc[ai][0][m][0], x11 = acc[ai][0][m][1], x20 = acc[ai][1][m][0], x21 = acc[ai][1][m][1];
                    const f32x4 o10 = (x10 * c0 - x20 * s0) * scl, o11 = (x11 * c1 - x21 * s1) * scl, o20 = (x20 * c0 + x10 * s0) * scl, o21 = (x21 * c1 + x11 * s1) * scl;
                    u32x4 w1v, w2v; w1v.x = pk2(o10[0], o10[1]); w1v.y = pk2(o10[2], o10[3]); w1v.z = pk2(o11[0], o11[1]); w1v.w = pk2(o11[2], o11[3]);
                    w2v.x = pk2(o20[0], o20[1]); w2v.y = pk2(o20[2], o20[3]); w2v.z = pk2(o21[0], o21[1]); w2v.w = pk2(o21[2], o21[3]);
                    *(u32x4*)(dst + 8 * fq) = w1v; *(u32x4*)(dst + 32 + 8 * fq) = w2v;
                } else if (pn == 2) {
#pragma unroll
                    for (int bj = 0; bj < 2; ++bj) { const f32x4 a0 = acc[ai][bj][m][0], a1 = acc[ai][bj][m][1]; u32x4 w; w.x = pk2(a0[0], a0[1]); w.y = pk2(a0[2], a0[3]); w.z = pk2(a1[0], a1[1]); w.w = pk2(a1[2], a1[3]);
                        *(u32x4*)((bf16_t*)(ws + WS_V) + (size_t)r * 128 + bj * 64 + (wc - 2) * 32 + 8 * fq) = w; }
                } else if (pn == 4) {
                    if (wc == 1 && fq == 0) *(f32x4*)((float*)(ws + WS_WI) + (size_t)r * 4) = acc[ai][0][m][0] * 0.0625f;
                } else {
                    float* p = (pn == 5) ? (float*)(ws + WS_UB) + (size_t)r * 256 + wc * 32 + 8 * fq : (float*)(ws + WS_HG) + (size_t)r * 1024 + (pn - 6) * 256 + wc * 32 + 8 * fq;
#pragma unroll
                    for (int bj = 0; bj < 2; ++bj) { *(f32x4*)(p + bj * 128) = acc[ai][bj][m][0]; *(f32x4*)(p + bj * 128 + 4) = acc[ai][bj][m][1]; }
                }
            }
    }
};
struct EpiOut {
    static constexpr int REP = 1;
    const float* hin; float* hout; const float* gate;
    __device__ __forceinline__ void operator()(const f32x4 (&acc)[2][2][4][2], const pg8::Unit& u, int wr, int wc, int fr, int fq) const {
        const int col0 = u.pn * 256 + wc * 32 + 8 * fq; const float* gp = gate + (size_t)u.b * 6144 + col0;
        f32x4 gv[2][2];
#pragma unroll
        for (int bj = 0; bj < 2; ++bj)
#pragma unroll
            for (int n = 0; n < 2; ++n) gv[bj][n] = *(const f32x4*)(gp + bj * 128 + n * 4);
#pragma unroll
        for (int ai = 0; ai < 2; ++ai)
#pragma unroll
            for (int m = 0; m < 4; ++m) { const size_t off = (size_t)(u.row0 + ai * 128 + wr * 64 + m * 16 + fr) * D + col0;
#pragma unroll
                for (int bj = 0; bj < 2; ++bj)
#pragma unroll
                    for (int n = 0; n < 2; ++n) { const f32x4 hv = *(const f32x4*)(hin + off + bj * 128 + n * 4); *(f32x4*)(hout + off + bj * 128 + n * 4) = hv + gv[bj][n] * acc[ai][bj][m][n]; }
                asm volatile("" ::: "memory"); }
    }
};
struct EpiG1 {
    static constexpr int REP = EPIREP_G1;
    bf16_t* act; const float* b1l;
    __device__ __forceinline__ void operator()(const f32x4 (&acc)[2][2][4][2], const pg8::Unit& u, int wr, int wc, int fr, int fq) const {
        const int ja0 = u.pn * 128 + wc * 32 + 8 * fq; const float* bp = b1l + (size_t)u.e * 2048 + 2 * ja0;
        f32x4 bg[2], bl[2];
#pragma unroll
        for (int n = 0; n < 2; ++n) { const f32x4 t0 = *(const f32x4*)(bp + 8 * n), t1 = *(const f32x4*)(bp + 8 * n + 4); bg[n] = (f32x4){t0[0], t0[2], t1[0], t1[2]}; bl[n] = (f32x4){t0[1], t0[3], t1[1], t1[3]}; }
#pragma unroll
        for (int ai = 0; ai < 2; ++ai)
#pragma unroll
            for (int m = 0; m < 4; ++m) { float o[8];
#pragma unroll
                for (int n = 0; n < 2; ++n) { const f32x4 hg = acc[ai][0][m][n] + bg[n], hl = acc[ai][1][m][n] + bl[n];
#pragma unroll
                    for (int j = 0; j < 4; ++j) { const float xg = fminf(hg[j], 7.0f), xl = fminf(fmaxf(hl[j], -7.0f), 7.0f); o[4 * n + j] = xg * sigmoidf_(1.702f * xg) * (xl + 1.0f); } }
                u32x4 w; w.x = pk2(o[0], o[1]); w.y = pk2(o[2], o[3]); w.z = pk2(o[4], o[5]); w.w = pk2(o[6], o[7]);
                *(u32x4*)(act + (size_t)(u.row0 + ai * 128 + wr * 64 + m * 16 + fr) * FF + ja0) = w; }
    }
};
struct EpiG2 {
    static constexpr int REP = EPIREP_G2;
    bf16_t* y; const float* b2l;
    __device__ __forceinline__ void operator()(const f32x4 (&acc)[2][2][4][2], const pg8::Unit& u, int wr, int wc, int fr, int fq) const {
        if (!u.b) return;
        const int col0 = u.pn * 256 + wc * 32 + 8 * fq; const float* bp = b2l + (size_t)u.e * 1024 + col0;
        f32x4 bv[2][2];
#pragma unroll
        for (int bj = 0; bj < 2; ++bj)
#pragma unroll
            for (int n = 0; n < 2; ++n) bv[bj][n] = *(const f32x4*)(bp + bj * 128 + n * 4);
#pragma unroll
        for (int ai = 0; ai < 2; ++ai)
#pragma unroll
            for (int m = 0; m < 4; ++m) { bf16_t* rowp = y + (size_t)(u.row0 + ai * 128 + wr * 64 + m * 16 + fr) * D + col0;
#pragma unroll
                for (int bj = 0; bj < 2; ++bj) { const f32x4 v0 = acc[ai][bj][m][0] + bv[bj][0], v1 = acc[ai][bj][m][1] + bv[bj][1];
                    u32x4 w; w.x = pk2(v0[0], v0[1]); w.y = pk2(v0[2], v0[3]); w.z = pk2(v1[0], v1[1]); w.w = pk2(v1[2], v1[3]); *(u32x4*)(rowp + bj * 128) = w; } }
    }
};
__device__ __forceinline__ int slot32(int d) { return 16 * ((d >> 2) & 1) + 4 * ((d >> 3) & 3) + (d & 3); }
__device__ __forceinline__ int win_dest(int s) {
    if (s < 512) { const int hd = s >> 6, d64 = s & 63; return 256 * (hd >> 2) + 128 * (d64 >> 5) + 32 * (hd & 3) + slot32(d64 & 31); }
    if (s < 640) { const int hd = (s - 512) >> 6, d64 = s & 63; return 512 + 128 * (d64 >> 5) + 32 * hd + slot32(d64 & 31); }
    if (s < 768) { const int v = s - 640; return 512 + 128 * (v >> 6) + 32 * (2 + ((v & 63) >> 5)) + slot32(v & 31); }
    if (s < 1024) { const int hd = (s - 768) >> 6, d64 = s & 63; return 768 + 128 * (d64 >> 5) + 32 * hd + slot32(d64 & 31); }
    if (s < 1088) { const int d64 = s - 1024; return 1024 + 128 * (d64 >> 5) + slot32(d64 & 31); }
    if (s < 1092) return 1024 + 32 + (s - 1088);
    if (s < 1348) { const int v = s - 1092; return 1280 + (v & ~31) + slot32(v & 31); }
    { const int v = s - 1348; return 1536 + (v & ~31) + slot32(v & 31); }
}
__device__ __forceinline__ int perm_dest(int s) { return (s & ~31) + 16 * ((s >> 2) & 1) + 4 * ((s >> 3) & 3) + (s & 3); }
__device__ __forceinline__ int w1_dest(int s) { const int jg = s >> 1, isl = s & 1, nt = jg >> 7, ja = jg & 127; return 256 * nt + 128 * isl + (ja & ~31) + slot32(ja & 31); }

template <int MAP>
__device__ __forceinline__ void transpose_item(const float* W, int N, bf16_t* WT, LAS float* scr, int kb, int nb, int lane) {
    const int k0 = 64 * kb, n0 = 32 * nb, col = n0 + (lane & 31); const bool ok = col < N;
    float v[32];
    const float* src = W + (size_t)(k0 + (lane >> 5)) * N + (ok ? col : 0);
#pragma unroll
    for (int i = 0; i < 32; ++i) v[i] = src[(size_t)(2 * i) * N];
#pragma unroll
    for (int i = 0; i < 32; ++i) scr[(2 * i + (lane >> 5)) * 33 + (lane & 31)] = ok ? v[i] : 0.f;
    asm volatile("s_waitcnt lgkmcnt(0)" ::: "memory");
    const int c = lane & 7;
#pragma unroll
    for (int j = 0; j < 4; ++j) { const int n = (lane >> 3) + 8 * j; const LAS float* s = scr + (8 * c) * 33 + n;
        u32x4 o; o.x = pk2(s[0 * 33], s[1 * 33]); o.y = pk2(s[2 * 33], s[3 * 33]); o.z = pk2(s[4 * 33], s[5 * 33]); o.w = pk2(s[6 * 33], s[7 * 33]);
        const int sc = n0 + n;
        if (sc < N) { const int dest = MAP == 1 ? win_dest(sc) : (MAP == 2 ? w1_dest(sc) : (MAP == 3 ? perm_dest(sc) : sc)); *(u32x4*)(WT + (size_t)dest * 1024 + k0 + 8 * c) = o; } }
    asm volatile("s_waitcnt lgkmcnt(0)" ::: "memory");
}

__device__ __forceinline__ void phase_prep(const Args& a, Ctx& C) {
    unsigned char* ws = C.ws;
    {
        LAS float* ca = (LAS float*)C.lds;
        LAS float* red = ca + 4096;
        for (int i = C.tid; i < 4096; i += NTHREADS) { const float v = a.c[i]; ca[i] = siluf_(v); }
        __syncthreads();
        for (int it = blockIdx.x; it < 192; it += C.G) {
            const int l = it / 96, cb = it % 96, col = cb * 64 + (C.tid & 63), kg = C.tid >> 6;
            const float* w = a.w_ada + (size_t)l * 1024 * 6144 + col;
            float s0 = 0.f, s1 = 0.f, s2 = 0.f, s3 = 0.f;
#pragma unroll 8
            for (int k = kg * 128; k < kg * 128 + 128; ++k) { const float wv = w[(size_t)k * 6144]; s0 += ca[k] * wv; s1 += ca[1024 + k] * wv; s2 += ca[2048 + k] * wv; s3 += ca[3072 + k] * wv; }
            red[(kg * 4 + 0) * 64 + (C.tid & 63)] = s0; red[(kg * 4 + 1) * 64 + (C.tid & 63)] = s1; red[(kg * 4 + 2) * 64 + (C.tid & 63)] = s2; red[(kg * 4 + 3) * 64 + (C.tid & 63)] = s3;
            __syncthreads();
            if (C.tid < 256) { const int b = C.tid >> 6, cc = C.tid & 63; float s = 0.f;
#pragma unroll
                for (int g = 0; g < 8; ++g) s += red[(g * 4 + b) * 64 + cc];
                ((float*)(ws + WS_MOD))[(size_t)(l * 4 + b) * 6144 + cb * 64 + cc] = s + a.b_ada[l * 6144 + cb * 64 + cc]; }
            __syncthreads();
        }
    }
    const int gw = C.vcu * NWAVES + C.wave, NGW = C.G * NWAVES;
    for (int tk = gw; tk < NTOK; tk += NGW) {
        if (C.lane < 32) {
            const float posf = (float)a.pos[tk];
            const float inv = exp2f(-(float)C.lane * (13.287712379549449f / 32.0f));
            const double ang = (double)(posf * inv);
            const double kq = rint(ang * 0.63661977236758134308);
            const double y = fma(-kq, 1.57079632679489661923, ang);
            const double y2 = y * y;
            const double sy = y * (1.0 + y2 * (-1.0 / 6 + y2 * (1.0 / 120 + y2 * (-1.0 / 5040 + y2 * (1.0 / 362880 - y2 * (1.0 / 39916800))))));
            const double cy = 1.0 + y2 * (-0.5 + y2 * (1.0 / 24 + y2 * (-1.0 / 720 + y2 * (1.0 / 40320 + y2 * (-1.0 / 3628800 + y2 * (1.0 / 479001600))))));
            const int q = ((int)((long long)kq)) & 3;
            const double sn = (q == 0) ? sy : (q == 1) ? cy : (q == 2) ? -sy : -cy;
            const double cs = (q == 0) ? cy : (q == 1) ? -sy : (q == 2) ? -cy : sy;
            ((float*)(ws + WS_ROPEC))[(size_t)tk * 32 + C.lane] = (float)cs;
            ((float*)(ws + WS_ROPES))[(size_t)tk * 32 + C.lane] = (float)sn;
        }
    }
    for (int i = gw * 64 + C.lane; i < 2 * 32 * 1024; i += NGW * 64) { const int l = i >> 15, e = (i >> 10) & 31, k = i & 1023; const float wv = a.w_router[(size_t)l * 32768 + k * 32 + e];
        const unsigned hi = f2bf(wv); const float lo = wv - bf2f((unsigned short)hi); ((bf16_t*)(ws + WS_WRH))[i] = (bf16_t)hi; ((bf16_t*)(ws + WS_WRL))[i] = (bf16_t)f2bf(lo); }
    LAS float* scr = (LAS float*)(C.lds + C.wave * 16384);
    constexpr int I_IN = 2 * 16 * 75, I_OUT = 2 * 16 * 32;
    for (int it = gw; it < I_IN + I_OUT; it += NGW) {
        int r = it;
        if (r < I_IN) { const int l = r / (16 * 75), q = r % (16 * 75); transpose_item<1>(a.w_in + (size_t)l * 1024 * D_IN, D_IN, (bf16_t*)(ws + WS_WIN) + (size_t)l * NPAD * 1024, scr, q / 75, q % 75, C.lane); continue; }
        r -= I_IN;
        { const int l = r / (16 * 32), q = r % (16 * 32); transpose_item<3>(a.w_out + (size_t)l * 1024 * 1024, 1024, (bf16_t*)(ws + WS_WOUT) + (size_t)l * 1024 * 1024, scr, q / 32, q % 32, C.lane); }
    }
}

struct Conv {
    const float* w1l; const float* w2l; bf16_t* w1t; bf16_t* w2t;
    int it, step, lane; bool pend;
    const float* W; bf16_t* WT; int N, map, k0, n0;
    f32x4 v4[8];
    static constexpr int NITEMS = 32 * 16 * 64 + 32 * 16 * 32;
    __device__ __forceinline__ void issue() {
        if (it >= NITEMS) return;
        if (it < 32 * 16 * 64) { const int e = it >> 10, q = it & 1023; W = w1l + (size_t)e * 1024 * 2048; WT = w1t + (size_t)e * 2048 * 1024; N = 2048; map = 2; k0 = 64 * (q >> 6); n0 = 32 * (q & 63); }
        else { const int r = it - 32 * 16 * 64, e = r >> 9, q = r & 511; W = w2l + (size_t)e * 1024 * 1024; WT = w2t + (size_t)e * 1024 * 1024; N = 1024; map = 3; k0 = 64 * (q >> 5); n0 = 32 * (q & 31); }
        const float* src = W + (size_t)(k0 + (lane >> 3)) * N + n0 + 4 * (lane & 7);
#pragma unroll
        for (int i = 0; i < 8; ++i) v4[i] = *(const f32x4*)(src + (size_t)(8 * i) * N);
        pend = true; it += step;
    }
    __device__ __forceinline__ void finish(LAS float* scr) {
        if (!pend) return;
#pragma unroll
        for (int i = 0; i < 8; ++i) { LAS float* d = scr + ((lane >> 3) + 8 * i) * 33 + 4 * (lane & 7); d[0] = v4[i].x; d[1] = v4[i].y; d[2] = v4[i].z; d[3] = v4[i].w; }
        asm volatile("s_waitcnt lgkmcnt(0)" ::: "memory");
        const int c = lane & 7;
#pragma unroll
        for (int j = 0; j < 4; ++j) { const int n = (lane >> 3) + 8 * j; const LAS float* sp = scr + (8 * c) * 33 + n;
            u32x4 o; o.x = pk2(sp[0 * 33], sp[1 * 33]); o.y = pk2(sp[2 * 33], sp[3 * 33]); o.z = pk2(sp[4 * 33], sp[5 * 33]); o.w = pk2(sp[6 * 33], sp[7 * 33]);
            const int sc = n0 + n; const int dest = map == 2 ? w1_dest(sc) : perm_dest(sc); *(u32x4*)(WT + (size_t)dest * 1024 + k0 + 8 * c) = o; }
        asm volatile("s_waitcnt lgkmcnt(0)" ::: "memory");
        pend = false;
    }
};

__device__ __forceinline__ void norm_mod_store(const f32x4 (&v)[4], const float* g, const float* sh, const float* sc, bf16_t* urow, int lane) {
    float ss = 0.f;
#pragma unroll
    for (int j = 0; j < 4; ++j) ss += (v[j].x * v[j].x + v[j].y * v[j].y) + (v[j].z * v[j].z + v[j].w * v[j].w);
    const float rstd = 1.0f / sqrtf(wave_sum(ss) * (1.0f / D) + EPS);
#pragma unroll
    for (int j = 0; j < 4; ++j) { const int idx = 4 * lane + 256 * j; const f32x4 gv = *(const f32x4*)(g + idx), shv = *(const f32x4*)(sh + idx), scv = *(const f32x4*)(sc + idx);
        const f32x4 o = v[j] * rstd * gv * (scv + 1.0f) + shv; u32x2 w; w.x = pk2(o[0], o[1]); w.y = pk2(o[2], o[3]); *(u32x2*)(urow + idx) = w; }
}

__device__ __forceinline__ void phase_u0(const Args& a, Ctx& C) {
    const int gw = C.vcu * NWAVES + C.wave, NGW = C.G * NWAVES; const float* mod = (const float*)(C.ws + WS_MOD);
    for (int tk0 = gw; tk0 < NTOK; tk0 += 2 * NGW) {
        const bool two = (tk0 + NGW) < NTOK; const int tk1 = two ? tk0 + NGW : tk0;
        const f32x4* x0 = (const f32x4*)(a.x + (size_t)tk0 * D) + C.lane; const f32x4* x1 = (const f32x4*)(a.x + (size_t)tk1 * D) + C.lane; f32x4 v0[4], v1[4];
#pragma unroll
        for (int j = 0; j < 4; ++j) { v0[j] = x0[64 * j]; v1[j] = x1[64 * j]; }
        { const float* mb = mod + (size_t)(tk0 >> 12) * 6144; norm_mod_store(v0, a.norm1_g, mb + 0, mb + 1024, (bf16_t*)(C.ws + WS_U) + (size_t)tk0 * D, C.lane); }
        if (two) { const float* mb = mod + (size_t)(tk1 >> 12) * 6144; norm_mod_store(v1, a.norm1_g, mb + 0, mb + 1024, (bf16_t*)(C.ws + WS_U) + (size_t)tk1 * D, C.lane); }
    }
}

__device__ __forceinline__ unsigned sortable(float f) { const unsigned u = __builtin_bit_cast(unsigned, f); return (u & 0x80000000u) ? ~u : (u | 0x80000000u); }
__device__ __forceinline__ int mbcnt64(unsigned long long m) { return __builtin_amdgcn_mbcnt_hi((unsigned)(m >> 32), __builtin_amdgcn_mbcnt_lo((unsigned)m, 0)); }

__device__ __forceinline__ void select_query(Ctx& C, int tk, LAS float* sc, LAS float* qs) {
    unsigned char* ws = C.ws; const int lane = C.lane;
    const int tpos = tk & (SEQ - 1), b = tk >> 12, cch = tpos >> 6, L = 64 * (cch + 1), nj = cch + 1;
    int* sel = (int*)(ws + WS_SEL) + (size_t)tk * 256;
    if (L <= 256) { for (int i = lane; i < L; i += 64) sel[i] = i; return; }
    {
        const u32x2 w = *(const u32x2*)((const bf16_t*)(ws + WS_QI) + (size_t)tk * 256 + 4 * lane);
        *(LAS f32x4*)(qs + 4 * lane) = (f32x4){bflo(w.x), bfhi(w.x), bflo(w.y), bfhi(w.y)};
    }
    const f32x4 wi = *(const f32x4*)((const float*)(ws + WS_WI) + (size_t)tk * 4);
    asm volatile("s_waitcnt lgkmcnt(0)" ::: "memory"); __builtin_amdgcn_wave_barrier();
    const bf16_t* kib = (const bf16_t*)(ws + WS_KI) + (size_t)b * SEQ * 64;
#pragma unroll 1
    for (int j0 = 0; j0 < 64; ++j0) {
        asm volatile("" ::: "memory");
        const int sA = 64 * j0 + lane;
        if (j0 >= nj) { sc[sA] = -3.0e38f; continue; }
        u32x4 ka[8];
#pragma unroll
        for (int i = 0; i < 8; ++i) ka[i] = *(const u32x4*)(kib + (size_t)sA * 64 + 8 * i);
        float aA[4] = {0.f, 0.f, 0.f, 0.f};
#pragma unroll
        for (int i = 0; i < 8; ++i) {
            const float a0 = bflo(ka[i].x), a1 = bfhi(ka[i].x), a2 = bflo(ka[i].y), a3 = bfhi(ka[i].y), a4 = bflo(ka[i].z), a5 = bfhi(ka[i].z), a6 = bflo(ka[i].w), a7 = bfhi(ka[i].w);
#pragma unroll
            for (int h = 0; h < 4; ++h) {
                const f32x4 q0 = *(const LAS f32x4*)(qs + h * 64 + 8 * i), q1 = *(const LAS f32x4*)(qs + h * 64 + 8 * i + 4);
                aA[h] += q0.x * a0 + q0.y * a1 + q0.z * a2 + q0.w * a3 + q1.x * a4 + q1.y * a5 + q1.z * a6 + q1.w * a7;
            }
        }
        float scA = fmaxf(aA[0], 0.f) * wi[0] + fmaxf(aA[1], 0.f) * wi[1] + fmaxf(aA[2], 0.f) * wi[2] + fmaxf(aA[3], 0.f) * wi[3];
        scA = (scA == 0.f) ? 0.f : scA;
        sc[sA] = scA;
    }
    asm volatile("s_waitcnt lgkmcnt(0)" ::: "memory"); __builtin_amdgcn_wave_barrier();
    unsigned key[64];
#pragma unroll
    for (int j = 0; j < 64; ++j) key[j] = sortable(sc[64 * j + lane]);
    unsigned T = 0u;
#pragma unroll 1
    for (int bit = 31; bit >= 0; --bit) {
        const unsigned cand = T | (1u << bit); int c = 0;
#pragma unroll
        for (int j = 0; j < 64; ++j) c += (key[j] >= cand) ? 1 : 0;
#pragma unroll
        for (int o = 1; o < 64; o <<= 1) c += __shfl_xor(c, o);
        if (c >= 256) T = cand;
    }
    int cgt = 0;
#pragma unroll
    for (int j = 0; j < 64; ++j) cgt += (key[j] > T) ? 1 : 0;
#pragma unroll
    for (int o = 1; o < 64; o <<= 1) cgt += __shfl_xor(cgt, o);
    const int need = 256 - cgt; int base = 0, eqseen = 0;
#pragma unroll 1
    for (int j = 0; j < nj; ++j) {
        const unsigned kj = sortable(sc[64 * j + lane]);
        const bool gt = kj > T, eq = kj == T; const unsigned long long em = __ballot(eq);
        const bool take = gt || (eq && (eqseen + mbcnt64(em)) < need); const unsigned long long tm = __ballot(take);
        if (take) sel[base + mbcnt64(tm)] = 64 * j + lane;
        base += __popcll(tm); eqseen += __popcll(em);
    }
}

__device__ __forceinline__ void attend_query(Ctx& C, int tk, LAS float* qf, LAS float* P, LAS int* sl) {
    unsigned char* ws = C.ws; const int lane = C.lane;
    const int tpos = tk & (SEQ - 1), b = tk >> 12, L = 64 * ((tpos >> 6) + 1), nsel = L < 256 ? L : 256;
    {
        const u32x4 w = *(const u32x4*)((const bf16_t*)(ws + WS_Q) + (size_t)tk * 512 + 8 * lane);
        *(LAS f32x4*)(qf + 8 * lane) = (f32x4){bflo(w.x), bfhi(w.x), bflo(w.y), bfhi(w.y)}; *(LAS f32x4*)(qf + 8 * lane + 4) = (f32x4){bflo(w.z), bfhi(w.z), bflo(w.w), bfhi(w.w)};
        const int* sg = (const int*)(ws + WS_SEL) + (size_t)tk * 256;
#pragma unroll
        for (int i = 0; i < 4; ++i) sl[64 * i + lane] = (64 * i + lane) < nsel ? sg[64 * i + lane] : 0;
    }
    asm volatile("s_waitcnt lgkmcnt(0)" ::: "memory"); __builtin_amdgcn_wave_barrier();
    const bf16_t* kb = (const bf16_t*)(ws + WS_K) + (size_t)b * SEQ * 128; const bf16_t* vb = (const bf16_t*)(ws + WS_V) + (size_t)b * SEQ * 128;
#pragma unroll 1
    for (int i = 0; i < 4; ++i) {
        const int slot = 64 * i + lane; const bool valid = slot < nsel; const int key = sl[slot];
#pragma unroll 1
        for (int n = 0; n < 2; ++n) {
            asm volatile("" ::: "memory");
            float ac[4] = {0.f, 0.f, 0.f, 0.f};
#pragma unroll 1
            for (int c2 = 0; c2 < 4; ++c2) {
                asm volatile("" ::: "memory");
                u32x4 kr[2];
#pragma unroll
                for (int c = 0; c < 2; ++c) kr[c] = *(const u32x4*)(kb + (size_t)key * 128 + n * 64 + 8 * (2 * c2 + c));
#pragma unroll
                for (int c = 0; c < 2; ++c) {
                    const float a0 = bflo(kr[c].x), a1 = bfhi(kr[c].x), a2 = bflo(kr[c].y), a3 = bfhi(kr[c].y), a4 = bflo(kr[c].z), a5 = bfhi(kr[c].z), a6 = bflo(kr[c].w), a7 = bfhi(kr[c].w);
#pragma unroll
                    for (int h = 0; h < 4; ++h) {
                        const f32x4 q0 = *(const LAS f32x4*)(qf + (4 * n + h) * 64 + 8 * (2 * c2 + c)), q1 = *(const LAS f32x4*)(qf + (4 * n + h) * 64 + 8 * (2 * c2 + c) + 4);
                        ac[h] += q0.x * a0 + q0.y * a1 + q0.z * a2 + q0.w * a3 + q1.x * a4 + q1.y * a5 + q1.z * a6 + q1.w * a7;
                    }
                }
            }
            *(LAS f32x4*)(P + slot * 8 + 4 * n) = valid ? (f32x4){ac[0], ac[1], ac[2], ac[3]} : (f32x4){-1e30f, -1e30f, -1e30f, -1e30f};
        }
    }
    asm volatile("s_waitcnt lgkmcnt(0)" ::: "memory"); __builtin_amdgcn_wave_barrier();
    float lg[4][8];
#pragma unroll
    for (int i = 0; i < 4; ++i) { const f32x4 t0 = *(const LAS f32x4*)(P + (64 * i + lane) * 8), t1 = *(const LAS f32x4*)(P + (64 * i + lane) * 8 + 4);
        lg[i][0] = t0.x; lg[i][1] = t0.y; lg[i][2] = t0.z; lg[i][3] = t0.w; lg[i][4] = t1.x; lg[i][5] = t1.y; lg[i][6] = t1.z; lg[i][7] = t1.w; }
    float inv[8];
#pragma unroll
    for (int h = 0; h < 8; ++h) {
        const float m = wave_max(fmaxf(fmaxf(lg[0][h], lg[1][h]), fmaxf(lg[2][h], lg[3][h]))); float s = 0.f;
#pragma unroll
        for (int i = 0; i < 4; ++i) { const float p = (64 * i + lane) < nsel ? __expf(lg[i][h] - m) : 0.f; lg[i][h] = p; s += p; }
        inv[h] = 1.0f / wave_sum(s);
    }
#pragma unroll
    for (int i = 0; i < 4; ++i) { LAS float* pp = P + (64 * i + lane) * 8;
        *(LAS f32x4*)pp = (f32x4){lg[i][0], lg[i][1], lg[i][2], lg[i][3]}; *(LAS f32x4*)(pp + 4) = (f32x4){lg[i][4], lg[i][5], lg[i][6], lg[i][7]}; }
    asm volatile("s_waitcnt lgkmcnt(0)" ::: "memory"); __builtin_amdgcn_wave_barrier();
    float o[8] = {0.f, 0.f, 0.f, 0.f, 0.f, 0.f, 0.f, 0.f};
#pragma unroll 4
    for (int slot = 0; slot < nsel; ++slot) {
        const int key = sl[slot];
        const float v0 = bf2f(vb[(size_t)key * 128 + lane]), v1 = bf2f(vb[(size_t)key * 128 + 64 + lane]);
        const f32x4 p0 = *(const LAS f32x4*)(P + slot * 8), p1 = *(const LAS f32x4*)(P + slot * 8 + 4);
        o[0] += p0.x * v0; o[1] += p0.y * v0; o[2] += p0.z * v0; o[3] += p0.w * v0; o[4] += p1.x * v1; o[5] += p1.y * v1; o[6] += p1.z * v1; o[7] += p1.w * v1;
    }
    bf16_t* mo = (bf16_t*)(ws + WS_MIX) + (size_t)tk * D;
#pragma unroll
    for (int h = 0; h < 8; ++h) mo[h * 64 + lane] = (bf16_t)f2bf(o[h] * inv[h]);
    asm volatile("s_waitcnt lgkmcnt(0)" ::: "memory"); __builtin_amdgcn_wave_barrier();
}

__device__ __forceinline__ void pool_item(const Args& a, Ctx& C, int l, int item) {
    unsigned char* ws = C.ws; const int tid = C.tid;
    const int g = item & 3, tt = item >> 2, b = tt >> 6, tp0 = (tt & 63) * 64, w = 2 << g;
    LAS float* ub = (LAS float*)C.lds;
    LAS float* pw = ub + 79 * 64;
    LAS float* pl = pw + 64 * 64;
    const float* ubg = (const float*)(ws + WS_UB);
    for (int idx = tid; idx < 79 * 16; idx += NTHREADS) { const int row = idx >> 4, c4 = idx & 15, tp = tp0 - 15 + row;
        f32x4 v = (f32x4){0.f, 0.f, 0.f, 0.f}; if (tp >= 0) v = *(const f32x4*)(ubg + (size_t)(b * SEQ + tp) * 256 + g * 64 + 4 * c4);
        *(LAS f32x4*)(ub + row * 64 + 4 * c4) = v; }
    for (int idx = tid; idx < 1024; idx += NTHREADS) *(LAS f32x4*)(pw + 4 * idx) = *(const f32x4*)(a.pool_w + (size_t)(l * 4 + g) * 4096 + 4 * idx);
    __syncthreads();
    const int t = tid >> 3, c8 = (tid & 7) * 8, tpos = tp0 + t, wl = (tpos + 1) < w ? (tpos + 1) : w;
    {
        float s[8] = {0.f, 0.f, 0.f, 0.f, 0.f, 0.f, 0.f, 0.f};
        for (int i = 0; i < wl; ++i) {
#pragma unroll
            for (int j = 0; j < 8; ++j) s[j] += ub[(t + 15 - i) * 64 + c8 + j]; }
        const float rw = 1.0f / (float)wl;
#pragma unroll
        for (int j = 0; j < 8; ++j) pl[t * 65 + c8 + j] = s[j] * rw - ub[(t + 15) * 64 + c8 + j];
    }
    __syncthreads();
    float y[8] = {0.f, 0.f, 0.f, 0.f, 0.f, 0.f, 0.f, 0.f};
#pragma unroll 8
    for (int cc = 0; cc < 64; ++cc) { const float p = pl[t * 65 + cc]; const f32x4 w0 = *(const LAS f32x4*)(pw + cc * 64 + c8), w1 = *(const LAS f32x4*)(pw + cc * 64 + c8 + 4);
        y[0] += p * w0.x; y[1] += p * w0.y; y[2] += p * w0.z; y[3] += p * w0.w; y[4] += p * w1.x; y[5] += p * w1.y; y[6] += p * w1.z; y[7] += p * w1.w; }
    const float* ps = a.pool_scale + l * 256 + g * 64 + c8;
    u32x4 o; o.x = pk2(y[0] * ps[0], y[1] * ps[1]); o.y = pk2(y[2] * ps[2], y[3] * ps[3]); o.z = pk2(y[4] * ps[4], y[5] * ps[5]); o.w = pk2(y[6] * ps[6], y[7] * ps[7]);
    *(u32x4*)((bf16_t*)(ws + WS_MIX) + (size_t)(b * SEQ + tpos) * D + 512 + g * 64 + c8) = o;
    __syncthreads();
}

constexpr int HP = 65;
__device__ __forceinline__ void hgrn_gates(const Args& a, Ctx& C, int l, int b, int hh, int c, LAS float* bq, LAS float* kin) {
    const int tid = C.tid, s = tid >> 3, k8 = (tid & 7) * 8;
    const float* z = (const float*)(C.ws + WS_HG) + (size_t)(b * SEQ + c * 64 + s) * 1024 + 256 + hh * 64 + k8;
    const f32x4 z0 = *(const f32x4*)z, z1 = *(const f32x4*)(z + 4); const float zz[8] = {z0.x, z0.y, z0.z, z0.w, z1.x, z1.y, z1.z, z1.w};
#pragma unroll
    for (int j = 0; j < 8; ++j) {
        const int kk = hh * 64 + k8 + j; float lb = 0.f;
        if (l == 1) lb = 1.0f / (1.0f + expf(a.lb_logits[kk] - a.lb_logits[256 + kk]));
        const float sg = 1.0f / (1.0f + expf(-zz[j])), sn = 1.0f / (1.0f + expf(zz[j]));
        bq[s * HP + k8 + j] = logf(lb + (1.0f - lb) * sg); kin[s * HP + k8 + j] = (1.0f - lb) * sn;
    }
    __syncthreads();
    if (tid < 64) { float r = 0.f; for (int ss = 0; ss < 64; ++ss) { r += bq[ss * HP + tid]; bq[ss * HP + tid] = r; } }
    __syncthreads();
}
__device__ __forceinline__ void hgrn_local_item(const Args& a, Ctx& C, int l, int item) {
    const int tid = C.tid, c = item & 63, hh = (item >> 6) & 3, b = item >> 8;
    LAS float* bq = (LAS float*)C.lds; LAS float* kin = bq + 64 * HP; LAS float* vv = kin + 64 * HP;
    hgrn_gates(a, C, l, b, hh, c, bq, kin);
    { const int s = tid >> 3, k8 = (tid & 7) * 8;
        const float* vp = (const float*)(C.ws + WS_HG) + (size_t)(b * SEQ + c * 64 + s) * 1024 + 512 + hh * 64 + k8;
        *(LAS f32x4*)(vv + s * 64 + k8) = *(const f32x4*)vp; *(LAS f32x4*)(vv + s * 64 + k8 + 4) = *(const f32x4*)(vp + 4);
#pragma unroll
        for (int j = 0; j < 8; ++j) kin[s * HP + k8 + j] *= __expf(bq[63 * HP + k8 + j] - bq[s * HP + k8 + j]); }
    __syncthreads();
    const int k = tid >> 3, v8 = (tid & 7) * 8; float Lr[8] = {0.f, 0.f, 0.f, 0.f, 0.f, 0.f, 0.f, 0.f};
#pragma unroll 8
    for (int s = 0; s < 64; ++s) { const float w = kin[s * HP + k]; const f32x4 x0 = *(const LAS f32x4*)(vv + s * 64 + v8), x1 = *(const LAS f32x4*)(vv + s * 64 + v8 + 4);
        Lr[0] += w * x0.x; Lr[1] += w * x0.y; Lr[2] += w * x0.z; Lr[3] += w * x0.w; Lr[4] += w * x1.x; Lr[5] += w * x1.y; Lr[6] += w * x1.z; Lr[7] += w * x1.w; }
    float* hl = (float*)(C.ws + WS_HL) + (size_t)item * 4096 + k * 64 + v8;
    *(f32x4*)hl = (f32x4){Lr[0], Lr[1], Lr[2], Lr[3]}; *(f32x4*)(hl + 4) = (f32x4){Lr[4], Lr[5], Lr[6], Lr[7]};
    if ((tid & 7) == 0) ((float*)(C.ws + WS_HD))[(size_t)item * 64 + k] = __expf(bq[63 * HP + k]);
    __syncthreads();
}
__device__ __forceinline__ void hgrn_out_item(const Args& a, Ctx& C, int l, int item) {
    const int tid = C.tid, c = item & 63, hh = (item >> 6) & 3, b = item >> 8;
    LAS float* bq = (LAS float*)C.lds; LAS float* kin = bq + 64 * HP; LAS float* qq = kin + 64 * HP; LAS float* At = qq + 64 * HP; LAS float* vv = At + 64 * HP; LAS float* Ss = vv + 4096;
    hgrn_gates(a, C, l, b, hh, c, bq, kin);
    { const int s = tid >> 3, k8 = (tid & 7) * 8; const float* row = (const float*)(C.ws + WS_HG) + (size_t)(b * SEQ + c * 64 + s) * 1024 + hh * 64 + k8;
        const f32x4 q0 = *(const f32x4*)row, q1 = *(const f32x4*)(row + 4);
        qq[s * HP + k8 + 0] = siluf_(q0.x); qq[s * HP + k8 + 1] = siluf_(q0.y); qq[s * HP + k8 + 2] = siluf_(q0.z); qq[s * HP + k8 + 3] = siluf_(q0.w);
        qq[s * HP + k8 + 4] = siluf_(q1.x); qq[s * HP + k8 + 5] = siluf_(q1.y); qq[s * HP + k8 + 6] = siluf_(q1.z); qq[s * HP + k8 + 7] = siluf_(q1.w);
        *(LAS f32x4*)(vv + s * 64 + k8) = *(const f32x4*)(row + 512); *(LAS f32x4*)(vv + s * 64 + k8 + 4) = *(const f32x4*)(row + 516); }
    {
        const int k = tid >> 3, v8 = (tid & 7) * 8; f32x4 s0 = (f32x4){0.f, 0.f, 0.f, 0.f}, s1 = s0;
        const float* hl = (const float*)(C.ws + WS_HL) + (size_t)(item - c) * 4096 + k * 64 + v8; const float* hd = (const float*)(C.ws + WS_HD) + (size_t)(item - c) * 64 + k;
#pragma unroll 4
        for (int j = 0; j < c; ++j) { const float dj = hd[(size_t)j * 64]; const f32x4 l0 = *(const f32x4*)(hl + (size_t)j * 4096), l1 = *(const f32x4*)(hl + (size_t)j * 4096 + 4); s0 = s0 * dj + l0; s1 = s1 * dj + l1; }
        *(LAS f32x4*)(Ss + k * 64 + v8) = s0; *(LAS f32x4*)(Ss + k * 64 + v8 + 4) = s1; }
    __syncthreads();
    { const int t = tid >> 3, sg = tid & 7; float ac[8] = {0.f, 0.f, 0.f, 0.f, 0.f, 0.f, 0.f, 0.f};
        for (int k = 0; k < 64; ++k) { const float qt = qq[t * HP + k], bt = bq[t * HP + k];
#pragma unroll
            for (int i = 0; i < 8; ++i) { const int s = sg + 8 * i; if (s <= t) ac[i] += qt * kin[s * HP + k] * __expf(bt - bq[s * HP + k]); } }
#pragma unroll
        for (int i = 0; i < 8; ++i) At[t * HP + sg + 8 * i] = ac[i]; }
    __syncthreads();
    { const int t = tid >> 3, v8 = (tid & 7) * 8; float o[8] = {0.f, 0.f, 0.f, 0.f, 0.f, 0.f, 0.f, 0.f};
#pragma unroll 4
        for (int k = 0; k < 64; ++k) { const float qe = qq[t * HP + k] * __expf(bq[t * HP + k]); const f32x4 x0 = *(const LAS f32x4*)(Ss + k * 64 + v8), x1 = *(const LAS f32x4*)(Ss + k * 64 + v8 + 4);
            o[0] += qe * x0.x; o[1] += qe * x0.y; o[2] += qe * x0.z; o[3] += qe * x0.w; o[4] += qe * x1.x; o[5] += qe * x1.y; o[6] += qe * x1.z; o[7] += qe * x1.w; }
        for (int s = 0; s <= t; ++s) { const float w = At[t * HP + s]; const f32x4 x0 = *(const LAS f32x4*)(vv + s * 64 + v8), x1 = *(const LAS f32x4*)(vv + s * 64 + v8 + 4);
            o[0] += w * x0.x; o[1] += w * x0.y; o[2] += w * x0.z; o[3] += w * x0.w; o[4] += w * x1.x; o[5] += w * x1.y; o[6] += w * x1.z; o[7] += w * x1.w; }
        float ss = 0.f;
#pragma unroll
        for (int j = 0; j < 8; ++j) ss += o[j] * o[j];
        ss += __shfl_xor(ss, 1); ss += __shfl_xor(ss, 2); ss += __shfl_xor(ss, 4);
        const float rstd = 1.0f / sqrtf(ss * (1.0f / 64.0f) + EPS);
        const float* gp = (const float*)(C.ws + WS_HG) + (size_t)(b * SEQ + c * 64 + t) * 1024 + 768 + hh * 64 + v8; const float* ng = a.hgrn_g + l * 64 + v8;
        const f32x4 g0 = *(const f32x4*)gp, g1 = *(const f32x4*)(gp + 4); const float gg[8] = {g0.x, g0.y, g0.z, g0.w, g1.x, g1.y, g1.z, g1.w}; float y[8];
#pragma unroll
        for (int j = 0; j < 8; ++j) y[j] = o[j] * rstd * ng[j] * siluf_(gg[j]);
        u32x4 w; w.x = pk2(y[0], y[1]); w.y = pk2(y[2], y[3]); w.z = pk2(y[4], y[5]); w.w = pk2(y[6], y[7]);
        *(u32x4*)((bf16_t*)(C.ws + WS_MIX) + (size_t)(b * SEQ + c * 64 + t) * D + 768 + hh * 64 + v8) = w; }
    __syncthreads();
}

__device__ __forceinline__ int wave_isum(int v) {
    v += __builtin_amdgcn_update_dpp(0, v, 0xB1, 0xF, 0xF, true);
    v += __builtin_amdgcn_update_dpp(0, v, 0x4E, 0xF, 0xF, true);
    v += __builtin_amdgcn_update_dpp(0, v, 0x141, 0xF, 0xF, true);
    v += __builtin_amdgcn_update_dpp(0, v, 0x140, 0xF, 0xF, true);
    return __builtin_amdgcn_readlane(v, 0) + __builtin_amdgcn_readlane(v, 16) + __builtin_amdgcn_readlane(v, 32) + __builtin_amdgcn_readlane(v, 48);
}
typedef float f32x16 __attribute__((ext_vector_type(16)));
template <int NJ>
__device__ __forceinline__ void select_from_lds(const LAS float* sq, int nj, int* sel, int lane) {
    unsigned key[NJ];
#pragma unroll
    for (int j = 0; j < NJ; ++j) key[j] = sortable(sq[64 * j + lane]);
    unsigned T = 0u;
#pragma unroll 1
    for (int bit = 31; bit >= 0; --bit) {
        const unsigned cand = T | (1u << bit); int c = 0;
#pragma unroll
        for (int j = 0; j < NJ; ++j) c += (key[j] >= cand) ? 1 : 0;
        if (wave_isum(c) >= 256) T = cand;
    }
    int cgt = 0;
#pragma unroll
    for (int j = 0; j < NJ; ++j) cgt += (key[j] > T) ? 1 : 0;
    cgt = wave_isum(cgt);
    const int need = 256 - cgt; int base = 0, eqseen = 0;
#pragma unroll 1
    for (int j = 0; j < nj; ++j) {
        const unsigned kj = sortable(sq[64 * j + lane]);
        const bool gt = kj > T, eq = kj == T; const unsigned long long em = __ballot(eq);
        const bool take = gt || (eq && (eqseen + mbcnt64(em)) < need); const unsigned long long tm = __ballot(take);
        if (take) sel[base + mbcnt64(tm)] = 64 * j + lane;
        base += __popcll(tm); eqseen += __popcll(em);
    }
}
__device__ __forceinline__ void transpose32(unsigned (&a)[32]) {
#pragma unroll
    for (int st = 0; st < 5; ++st) {
        const int j = 16 >> st; const unsigned m = (st == 0) ? 0x0000FFFFu : (st == 1) ? 0x00FF00FFu : (st == 2) ? 0x0F0F0F0Fu : (st == 3) ? 0x33333333u : 0x55555555u;
#pragma unroll
        for (int idx = 0; idx < 16; ++idx) { const int k = (idx / j) * 2 * j + (idx % j); const unsigned t = (a[k] ^ (a[k + j] >> j)) & m; a[k] ^= t; a[k + j] ^= (t << j); }
    }
}
template <int NB>
__device__ __forceinline__ void select_bits(const LAS float* sq, int nj, int* sel, int lane) {
    unsigned pl[NB][32];
#pragma unroll
    for (int blk = 0; blk < NB; ++blk) {
#pragma unroll
        for (int j = 0; j < 32; ++j) pl[blk][j] = sortable(sq[64 * (32 * blk + j) + lane]);
        transpose32(pl[blk]);
    }
    unsigned M[NB], GT[NB];
#pragma unroll
    for (int blk = 0; blk < NB; ++blk) { M[blk] = 0xFFFFFFFFu; GT[blk] = 0u; }
    unsigned T = 0u; int G = 0;
#pragma unroll
    for (int w = 0; w < 32; ++w) {
        unsigned n[NB]; int c = 0;
#pragma unroll
        for (int blk = 0; blk < NB; ++blk) { n[blk] = M[blk] & pl[blk][w]; c += __popc(n[blk]); }
        const int tot = wave_isum(c);
        const bool take = (G + tot) >= 256;
        const unsigned flip = take ? 0u : 0xFFFFFFFFu;
        T |= take ? (1u << (31 - w)) : 0u; G += take ? 0 : tot;
#pragma unroll
        for (int blk = 0; blk < NB; ++blk) { GT[blk] |= n[blk] & flip; M[blk] &= (pl[blk][w] ^ flip); }
    }
    const int need = 256 - G;
    int ceq = 0;
#pragma unroll
    for (int blk = 0; blk < NB; ++blk) ceq += __popc(M[blk]);
    const int toteq = wave_isum(ceq);
    if (toteq == need) {
        int cnt = 0;
#pragma unroll
        for (int blk = 0; blk < NB; ++blk) { GT[blk] |= M[blk]; cnt += __popc(GT[blk]); }
        int incl = cnt;
#pragma unroll
        for (int o = 1; o < 64; o <<= 1) { const int t = __shfl_up(incl, o); if (lane >= o) incl += t; }
        int pos = incl - cnt;
#pragma unroll
        for (int blk = 0; blk < NB; ++blk) { unsigned mk = GT[blk];
            while (mk) { const int x = 31 - __clz((int)mk); mk &= ~(1u << x); sel[pos++] = 64 * (32 * blk + 31 - x) + lane; } }
    } else {
        int base = 0, eqseen = 0;
#pragma unroll 1
        for (int j = 0; j < nj; ++j) {
            const unsigned kj = sortable(sq[64 * j + lane]);
            const bool gt = kj > T, eq = kj == T; const unsigned long long em = __ballot(eq);
            const bool take = gt || (eq && (eqseen + mbcnt64(em)) < need); const unsigned long long tm = __ballot(take);
            if (take) sel[base + mbcnt64(tm)] = 64 * j + lane;
            base += __popcll(tm); eqseen += __popcll(em);
        }
    }
}
__device__ __forceinline__ void index_unit(Ctx& C, int b, int cch, int sub) {
    unsigned char* ws = C.ws; const int lane = C.lane, w = C.wave;
    const int tk0 = b * SEQ + 64 * cch + 8 * sub, L = 64 * (cch + 1), nj = cch + 1;
    if (L <= 256) { int* sel = (int*)(ws + WS_SEL) + (size_t)(tk0 + w) * 256; for (int i = lane; i < L; i += 64) sel[i] = i; return; }
    LAS float* scl = (LAS float*)C.lds;
#ifndef IDXREP
#define IDXREP 0
#endif
    for (int repA = 0; repA < ((IDXREP & 1) ? 2 : 1); ++repA) {
        const int r = lane & 31, hf = lane >> 5, qq = r >> 2, h = r & 3;
        bf16x8 aq[4];
#pragma unroll
        for (int ks = 0; ks < 4; ++ks) aq[ks] = *(const bf16x8*)((const bf16_t*)(ws + WS_QI) + (size_t)(tk0 + qq) * 256 + h * 64 + 16 * ks + 8 * hf);
        f32x4 wq[4];
#pragma unroll
        for (int g = 0; g < 4; ++g) wq[g] = *(const f32x4*)((const float*)(ws + WS_WI) + (size_t)(tk0 + 2 * g + hf) * 4);
        const bf16_t* kib = (const bf16_t*)(ws + WS_KI) + (size_t)b * SEQ * 64;
        const int ntile = 2 * nj;
        bf16x8 bk[4], bk2[4];
#define IDX_LOAD(d1, d2, kta) do { const int _k1 = (kta), _k2 = ((kta) + NWAVES) < ntile ? (kta) + NWAVES : (kta); _Pragma("unroll") for (int ks = 0; ks < 4; ++ks) { \
            d1[ks] = *(const bf16x8*)(kib + (size_t)(32 * _k1 + r) * 64 + 16 * ks + 8 * hf); d2[ks] = *(const bf16x8*)(kib + (size_t)(32 * _k2 + r) * 64 + 16 * ks + 8 * hf); } } while (0)
        if (w < ntile) IDX_LOAD(bk, bk2, w);
#pragma unroll 1
        for (int kt = w; kt < ntile; kt += 2 * NWAVES) {
            const bool two = (kt + NWAVES) < ntile; const int kt2 = two ? kt + NWAVES : kt;
            bf16x8 nk[4], nk2[4];
            const bool more = (kt + 2 * NWAVES) < ntile;
            if (more) IDX_LOAD(nk, nk2, kt + 2 * NWAVES);
            f32x16 acc, acc2;
#pragma unroll
            for (int i = 0; i < 16; ++i) { acc[i] = 0.f; acc2[i] = 0.f; }
#pragma unroll
            for (int ks = 0; ks < 4; ++ks) { acc = __builtin_amdgcn_mfma_f32_32x32x16_bf16(aq[ks], bk[ks], acc, 0, 0, 0); acc2 = __builtin_amdgcn_mfma_f32_32x32x16_bf16(aq[ks], bk2[ks], acc2, 0, 0, 0); }
#pragma unroll
            for (int g = 0; g < 4; ++g) {
                float sc = fmaxf(acc[4 * g + 0], 0.f) * wq[g][0] + fmaxf(acc[4 * g + 1], 0.f) * wq[g][1] + fmaxf(acc[4 * g + 2], 0.f) * wq[g][2] + fmaxf(acc[4 * g + 3], 0.f) * wq[g][3];
                sc = (sc == 0.f) ? 0.f : sc;
                scl[(2 * g + hf) * 4096 + 32 * kt + r] = sc;
                float sc2 = fmaxf(acc2[4 * g + 0], 0.f) * wq[g][0] + fmaxf(acc2[4 * g + 1], 0.f) * wq[g][1] + fmaxf(acc2[4 * g + 2], 0.f) * wq[g][2] + fmaxf(acc2[4 * g + 3], 0.f) * wq[g][3];
                sc2 = (sc2 == 0.f) ? 0.f : sc2;
                if (two) scl[(2 * g + hf) * 4096 + 32 * kt2 + r] = sc2;
            }
            if (more) {
#pragma unroll
                for (int ks = 0; ks < 4; ++ks) { bk[ks] = nk[ks]; bk2[ks] = nk2[ks]; } }
        }
#undef IDX_LOAD
        const int njp = nj <= 32 ? 32 : 64;
        for (int j = nj; j < njp; ++j) scl[w * 4096 + 64 * j + lane] = -3.0e38f;
    }
    __syncthreads();
    for (int repB = 0; repB < ((IDXREP & 2) ? 2 : 1); ++repB) {
        const LAS float* sq = scl + w * 4096; int* sel = (int*)(ws + WS_SEL) + (size_t)(tk0 + w) * 256;
        if (nj <= 32) select_bits<1>(sq, nj, sel, lane); else select_bits<2>(sq, nj, sel, lane);
    }
    __syncthreads();
}

__device__ __forceinline__ unsigned sortable16(unsigned h) { return (h & 0x8000u) ? (~h & 0xFFFFu) : (h | 0x8000u); }
__device__ __forceinline__ unsigned short f2h_bits(float f) { const _Float16 h = (_Float16)f; unsigned short b = __builtin_bit_cast(unsigned short, h); return b == 0x8000u ? (unsigned short)0 : b; }
template <int NB>
__device__ __forceinline__ void select_bits16(const LAS unsigned short* sq, int nj, int* sel, int lane) {
    unsigned a[32];
#pragma unroll
    for (int j = 0; j < 32; ++j) { const unsigned lo = sortable16(sq[64 * j + lane]); const unsigned hi = (NB == 2) ? sortable16(sq[64 * (32 + j) + lane]) : 0u; a[j] = lo | (hi << 16); }
    transpose32(a);
    unsigned Ml = 0xFFFFFFFFu, Mh = (NB == 2) ? 0xFFFFFFFFu : 0u, Gl = 0u, Gh = 0u; unsigned T = 0u; int G = 0;
#pragma unroll
    for (int bit = 15; bit >= 0; --bit) {
        const unsigned nl = Ml & a[31 - bit], nh = Mh & a[15 - bit];
        const int tot = wave_isum(__popc(nl) + __popc(nh));
        const bool take = (G + tot) >= 256; const unsigned flip = take ? 0u : 0xFFFFFFFFu;
        T |= take ? (1u << bit) : 0u; G += take ? 0 : tot;
        Gl |= nl & flip; Gh |= nh & flip; Ml &= (a[31 - bit] ^ flip); Mh &= (a[15 - bit] ^ flip);
    }
    const int need = 256 - G;
    if (T != 0x8000u) {
        const int ceq = __popc(Ml) + __popc(Mh); int incl = ceq;
#pragma unroll
        for (int o = 1; o < 64; o <<= 1) { const int t = __shfl_up(incl, o); if (lane >= o) incl += t; }
        int quota = need - (incl - ceq); quota = quota < 0 ? 0 : (quota > ceq ? ceq : quota);
        const int cnt = __popc(Gl) + __popc(Gh) + quota; int inc2 = cnt;
#pragma unroll
        for (int o = 1; o < 64; o <<= 1) { const int t = __shfl_up(inc2, o); if (lane >= o) inc2 += t; }
        int pos = inc2 - cnt;
        { unsigned mk = Gl; while (mk) { const int x = 31 - __clz((int)mk); mk &= ~(1u << x); sel[pos++] = 64 * (31 - x) + lane; } }
        if (NB == 2) { unsigned mk = Gh; while (mk) { const int x = 31 - __clz((int)mk); mk &= ~(1u << x); sel[pos++] = 64 * (63 - x) + lane; } }
        { unsigned mk = Ml; while (mk && quota > 0) { const int x = 31 - __clz((int)mk); mk &= ~(1u << x); sel[pos++] = 64 * (31 - x) + lane; --quota; } }
        if (NB == 2) { unsigned mk = Mh; while (mk && quota > 0) { const int x = 31 - __clz((int)mk); mk &= ~(1u << x); sel[pos++] = 64 * (63 - x) + lane; --quota; } }
    } else {
        int base = 0, eqseen = 0;
#pragma unroll 1
        for (int j = 0; j < nj; ++j) {
            const unsigned kj = sortable16(sq[64 * j + lane]);
            const bool gt = kj > T, eq = kj == T; const unsigned long long em = __ballot(eq);
            const bool take = gt || (eq && (eqseen + mbcnt64(em)) < need); const unsigned long long tm = __ballot(take);
            if (take) sel[base + mbcnt64(tm)] = 64 * j + lane;
            base += __popcll(tm); eqseen += __popcll(em);
        }
    }
}
constexpr int KST_ROW = 144, KST_BYTES = 64 * KST_ROW;
__device__ __forceinline__ void index_unit2(Ctx& C, int b, int cch, int sub) {
    unsigned char* ws = C.ws; const int lane = C.lane, w = C.wave;
    const int tk0 = b * SEQ + 64 * cch + 8 * sub, L = 64 * (cch + 1), nj = cch + 1;
    if (L <= 256) { int* sel = (int*)(ws + WS_SEL) + (size_t)(tk0 + w) * 256; for (int i = lane; i < L; i += 64) sel[i] = i; return; }
    LAS unsigned short* sclh = (LAS unsigned short*)C.lds;
    LAS unsigned char* kst = C.lds + 65536 + w * KST_BYTES;
    {
        const int r = lane & 31, hf = lane >> 5, qq = r >> 2, h = r & 3;
        bf16x8 aq[4];
#pragma unroll
        for (int ks = 0; ks < 4; ++ks) aq[ks] = *(const bf16x8*)((const bf16_t*)(ws + WS_QI) + (size_t)(tk0 + qq) * 256 + h * 64 + 16 * ks + 8 * hf);
        f32x4 wq[4];
#pragma unroll
        for (int g = 0; g < 4; ++g) wq[g] = *(const f32x4*)((const float*)(ws + WS_WI) + (size_t)(tk0 + 2 * g + hf) * 4);
        const unsigned char* kib = ws + WS_KI + (size_t)b * SEQ * 128;
        const int ntile = 2 * nj;
        u32x4 st[8];
#define IDX2_LOAD(kta) do { const int _t1 = (kta), _t2 = ((kta) + NWAVES) < ntile ? (kta) + NWAVES : (kta); _Pragma("unroll") for (int j = 0; j < 4; ++j) { \
            st[j] = *(const u32x4*)(kib + (size_t)_t1 * 4096 + 1024 * j + 16 * lane); st[4 + j] = *(const u32x4*)(kib + (size_t)_t2 * 4096 + 1024 * j + 16 * lane); } } while (0)
        if (w < ntile) IDX2_LOAD(w);
#pragma unroll 1
        for (int kt = w; kt < ntile; kt += 2 * NWAVES) {
            const bool two = (kt + NWAVES) < ntile; const int kt2 = two ? kt + NWAVES : kt;
#pragma unroll
            for (int j = 0; j < 4; ++j) { *(LAS u32x4*)(kst + (8 * j + (lane >> 3)) * KST_ROW + 16 * (lane & 7)) = st[j]; *(LAS u32x4*)(kst + (32 + 8 * j + (lane >> 3)) * KST_ROW + 16 * (lane & 7)) = st[4 + j]; }
            if ((kt + 2 * NWAVES) < ntile) IDX2_LOAD(kt + 2 * NWAVES);
            f32x16 acc, acc2;
#pragma unroll
            for (int i = 0; i < 16; ++i) { acc[i] = 0.f; acc2[i] = 0.f; }
#pragma unroll
            for (int ks = 0; ks < 4; ++ks) { const bf16x8 b1 = *(const LAS bf16x8*)(kst + r * KST_ROW + 32 * ks + 16 * hf), b2 = *(const LAS bf16x8*)(kst + (32 + r) * KST_ROW + 32 * ks + 16 * hf);
                acc = __builtin_amdgcn_mfma_f32_32x32x16_bf16(aq[ks], b1, acc, 0, 0, 0); acc2 = __builtin_amdgcn_mfma_f32_32x32x16_bf16(aq[ks], b2, acc2, 0, 0, 0); }
#pragma unroll
            for (int g = 0; g < 4; ++g) {
                const float sc = fmaxf(acc[4 * g + 0], 0.f) * wq[g][0] + fmaxf(acc[4 * g + 1], 0.f) * wq[g][1] + fmaxf(acc[4 * g + 2], 0.f) * wq[g][2] + fmaxf(acc[4 * g + 3], 0.f) * wq[g][3];
                sclh[(2 * g + hf) * 4096 + 32 * kt + r] = f2h_bits(sc);
                const float sc2 = fmaxf(acc2[4 * g + 0], 0.f) * wq[g][0] + fmaxf(acc2[4 * g + 1], 0.f) * wq[g][1] + fmaxf(acc2[4 * g + 2], 0.f) * wq[g][2] + fmaxf(acc2[4 * g + 3], 0.f) * wq[g][3];
                if (two) sclh[(2 * g + hf) * 4096 + 32 * kt2 + r] = f2h_bits(sc2);
            }
        }
#undef IDX2_LOAD
        const int njp = nj <= 32 ? 32 : 64;
        for (int j = nj; j < njp; ++j) sclh[w * 4096 + 64 * j + lane] = (unsigned short)0xFBFFu;
    }
    __syncthreads();
    {
        const LAS unsigned short* sq = sclh + w * 4096; int* sel = (int*)(ws + WS_SEL) + (size_t)(tk0 + w) * 256;
        if (nj <= 32) select_bits16<1>(sq, nj, sel, lane); else select_bits16<2>(sq, nj, sel, lane);
    }
    __syncthreads();
}

typedef short s16x4 __attribute__((ext_vector_type(4)));
constexpr int VROW = 272;
__device__ __forceinline__ void attend_query_mfma(Ctx& C, int tk, LAS unsigned char* vs, Conv& cv) {
    unsigned char* ws = C.ws; const int lane = C.lane, c = lane & 15, g = lane >> 4;
    const int tpos = tk & (SEQ - 1), b = tk >> 12, L = 64 * ((tpos >> 6) + 1), nsel = L < 256 ? L : 256;
    const bf16_t* kb = (const bf16_t*)(ws + WS_K) + (size_t)b * SEQ * 128; const bf16_t* vb = (const bf16_t*)(ws + WS_V) + (size_t)b * SEQ * 128;
    int selr[4];
    { const int* sg = (const int*)(ws + WS_SEL) + (size_t)tk * 256;
#pragma unroll
      for (int i = 0; i < 4; ++i) selr[i] = (64 * i + lane) < nsel ? sg[64 * i + lane] : 0; }
    bf16x8 bq0[2], bq1[2];
    { const bf16_t* qp = (const bf16_t*)(ws + WS_Q) + (size_t)tk * 512 + (c & 7) * 64 + 8 * g; const bf16x8 z = (bf16x8){0, 0, 0, 0, 0, 0, 0, 0};
#pragma unroll
      for (int ks = 0; ks < 2; ++ks) { const bf16x8 q = *(const bf16x8*)(qp + 32 * ks); bq0[ks] = (c < 4) ? q : z; bq1[ks] = (c >= 4 && c < 8) ? q : z; } }
    cv.issue();
    f32x4 acc[16];
#pragma unroll
    for (int kt = 0; kt < 16; ++kt) {
        if ((kt & 3) == 0) asm volatile("" ::: "memory");
        const int key = __shfl(selr[kt >> 2], 16 * (kt & 3) + c);
        const bf16_t* kr = kb + (size_t)key * 128 + 8 * g;
        const bf16x8 a00 = *(const bf16x8*)(kr), a01 = *(const bf16x8*)(kr + 32), a10 = *(const bf16x8*)(kr + 64), a11 = *(const bf16x8*)(kr + 96);
        f32x4 t = (f32x4){0.f, 0.f, 0.f, 0.f};
        t = __builtin_amdgcn_mfma_f32_16x16x32_bf16(a00, bq0[0], t, 0, 0, 0); t = __builtin_amdgcn_mfma_f32_16x16x32_bf16(a01, bq0[1], t, 0, 0, 0);
        t = __builtin_amdgcn_mfma_f32_16x16x32_bf16(a10, bq1[0], t, 0, 0, 0); t = __builtin_amdgcn_mfma_f32_16x16x32_bf16(a11, bq1[1], t, 0, 0, 0);
        acc[kt] = t;
    }
    asm volatile("" ::: "memory"); cv.finish((LAS float*)vs); cv.issue();
    { const int lim = nsel - 4 * g;
#pragma unroll
      for (int kt = 0; kt < 16; ++kt)
#pragma unroll
        for (int r = 0; r < 4; ++r) acc[kt][r] = (16 * kt + r < lim) ? acc[kt][r] : -1e30f; }
    float m = -1e30f;
#pragma unroll
    for (int kt = 0; kt < 16; ++kt) m = fmaxf(m, fmaxf(fmaxf(acc[kt][0], acc[kt][1]), fmaxf(acc[kt][2], acc[kt][3])));
    m = fmaxf(m, __shfl_xor(m, 16)); m = fmaxf(m, __shfl_xor(m, 32));
    float sum = 0.f;
#pragma unroll
    for (int kt = 0; kt < 16; ++kt)
#pragma unroll
        for (int r = 0; r < 4; ++r) { const float pv = __expf(acc[kt][r] - m); acc[kt][r] = pv; sum += pv; }
    sum += __shfl_xor(sum, 16); sum += __shfl_xor(sum, 32);
    const float inv = 1.0f / sum;
    bf16x8 bp[8];
#pragma unroll
    for (int T = 0; T < 8; ++T) { u32x4 w; w.x = cvt_pk_bf16(acc[2 * T][0], acc[2 * T][1]); w.y = cvt_pk_bf16(acc[2 * T][2], acc[2 * T][3]); w.z = cvt_pk_bf16(acc[2 * T + 1][0], acc[2 * T + 1][1]); w.w = cvt_pk_bf16(acc[2 * T + 1][2], acc[2 * T + 1][3]);
        bp[T] = __builtin_bit_cast(bf16x8, w); }
    f32x4 ao0[4], ao1[4];
#pragma unroll
    for (int dt = 0; dt < 4; ++dt) { ao0[dt] = (f32x4){0.f, 0.f, 0.f, 0.f}; ao1[dt] = (f32x4){0.f, 0.f, 0.f, 0.f}; }
    const int q4 = c >> 2, p4 = c & 3;
    u32x4 vst[8];
#define ATT_VLOAD(T) do { _Pragma("unroll") for (int i = 0; i < 8; ++i) { const int row = g + 4 * i; \
        const int key = __shfl(selr[(T) >> 1], 32 * ((T) & 1) + row); vst[i] = *(const u32x4*)(vb + (size_t)key * 128 + 8 * c); } } while (0)
    ATT_VLOAD(0);
#pragma unroll
    for (int T = 0; T < 8; ++T) {
        LAS unsigned char* buf = vs + (T & 1) * (32 * VROW);
        asm volatile("" ::: "memory");
#pragma unroll
        for (int i = 0; i < 8; ++i) *(LAS u32x4*)(buf + (g + 4 * i) * VROW + 16 * c) = vst[i];
        if (T < 7) ATT_VLOAD(T + 1);
#pragma unroll
        for (int n = 0; n < 2; ++n)
#pragma unroll
            for (int dt = 0; dt < 4; ++dt) {
                LAS s16x4* p0 = (LAS s16x4*)(buf + (4 * g + q4) * VROW + (n * 64 + 16 * dt + 4 * p4) * 2);
                const s16x4 lo = __builtin_amdgcn_ds_read_tr16_b64_v4i16(p0), hi = __builtin_amdgcn_ds_read_tr16_b64_v4i16((LAS s16x4*)((LAS unsigned char*)p0 + 16 * VROW));
                const bf16x8 av = (bf16x8){lo[0], lo[1], lo[2], lo[3], hi[0], hi[1], hi[2], hi[3]};
                if (n == 0) ao0[dt] = __builtin_amdgcn_mfma_f32_16x16x32_bf16(av, bp[T], ao0[dt], 0, 0, 0);
                else ao1[dt] = __builtin_amdgcn_mfma_f32_16x16x32_bf16(av, bp[T], ao1[dt], 0, 0, 0);
            }
        if (T == 3) { asm volatile("" ::: "memory"); cv.finish((LAS float*)vs); cv.issue(); }
    }
#undef ATT_VLOAD
    asm volatile("" ::: "memory"); cv.finish((LAS float*)vs);
    if (c < 8) {
        bf16_t* mo = (bf16_t*)(ws + WS_MIX) + (size_t)tk * D + c * 64 + 4 * g;
#pragma unroll
        for (int dt = 0; dt < 4; ++dt) { f32x4 o; o[0] = (c < 4 ? ao0[dt][0] : ao1[dt][0]) * inv; o[1] = (c < 4 ? ao0[dt][1] : ao1[dt][1]) * inv; o[2] = (c < 4 ? ao0[dt][2] : ao1[dt][2]) * inv; o[3] = (c < 4 ? ao0[dt][3] : ao1[dt][3]) * inv; u32x2 w; w.x = cvt_pk_bf16(o[0], o[1]); w.y = cvt_pk_bf16(o[2], o[3]); *(u32x2*)(mo + 16 * dt) = w; }
    }
}

__device__ __forceinline__ void hgrn_out_group(const Args& a, Ctx& C, int l, int item) {
    const int tid = C.tid, lane = C.lane, w = C.wave, cg = item & 15, hh = (item >> 4) & 3, b = item >> 6, c0 = 4 * cg, bh = b * 4 + hh;
    LAS float* bq = (LAS float*)C.lds; LAS float* kin = bq + 64 * HP; LAS float* qq = kin + 64 * HP; LAS float* At = qq + 64 * HP; LAS float* vv = At + 64 * HP; LAS float* Ss = vv + 4096;
    const float* HG = (const float*)(C.ws + WS_HG); const float* HLb = (const float*)(C.ws + WS_HL) + (size_t)bh * 64 * 4096; const float* HDb = (const float*)(C.ws + WS_HD) + (size_t)bh * 64 * 64;
    float lbv[8];
#pragma unroll
    for (int j = 0; j < 8; ++j) { const int kk = hh * 64 + 8 * w + j; lbv[j] = (l == 1) ? 1.0f / (1.0f + expf(a.lb_logits[kk] - a.lb_logits[256 + kk])) : 0.f; }
    const int kS = tid >> 3, v8 = (tid & 7) * 8; f32x4 s0 = (f32x4){0.f, 0.f, 0.f, 0.f}, s1 = s0;
    { const float* hl = HLb + kS * 64 + v8; const float* hd = HDb + kS;
#pragma unroll 8
      for (int j = 0; j < c0; ++j) { const float dj = hd[(size_t)j * 64]; const f32x4 l0 = *(const f32x4*)(hl + (size_t)j * 4096), l1 = *(const f32x4*)(hl + (size_t)j * 4096 + 4); s0 = s0 * dj + l0; s1 = s1 * dj + l1; } }
#pragma unroll 1
    for (int c = c0; c < c0 + 4; ++c) {
        const size_t tok0 = (size_t)b * SEQ + c * 64;
        const f32x4 lc0 = *(const f32x4*)(HLb + (size_t)c * 4096 + kS * 64 + v8), lc1 = *(const f32x4*)(HLb + (size_t)c * 4096 + kS * 64 + v8 + 4);
        *(LAS f32x4*)(Ss + kS * 64 + v8) = s0; *(LAS f32x4*)(Ss + kS * 64 + v8 + 4) = s1;
        {
            const float* z = HG + (tok0 + lane) * 1024 + 256 + hh * 64 + 8 * w; const f32x4 z0 = *(const f32x4*)z, z1 = *(const f32x4*)(z + 4); const float zz[8] = {z0.x, z0.y, z0.z, z0.w, z1.x, z1.y, z1.z, z1.w};
#pragma unroll
            for (int j = 0; j < 8; ++j) { const float lb = lbv[j]; const float sg = 1.0f / (1.0f + __expf(-zz[j])), sn = 1.0f / (1.0f + __expf(zz[j])); float lf = __logf(lb + (1.0f - lb) * sg);
#pragma unroll
                for (int o = 1; o < 64; o <<= 1) { const float t = __shfl_up(lf, o); if (lane >= o) lf += t; }
                bq[lane * HP + 8 * w + j] = lf; kin[lane * HP + 8 * w + j] = (1.0f - lb) * sn; }
        }
        { const int sr = tid >> 3, k8 = (tid & 7) * 8; const float* row = HG + (tok0 + sr) * 1024 + hh * 64 + k8;
            const f32x4 q0 = *(const f32x4*)row, q1 = *(const f32x4*)(row + 4);
            qq[sr * HP + k8 + 0] = siluf_(q0.x); qq[sr * HP + k8 + 1] = siluf_(q0.y); qq[sr * HP + k8 + 2] = siluf_(q0.z); qq[sr * HP + k8 + 3] = siluf_(q0.w);
            qq[sr * HP + k8 + 4] = siluf_(q1.x); qq[sr * HP + k8 + 5] = siluf_(q1.y); qq[sr * HP + k8 + 6] = siluf_(q1.z); qq[sr * HP + k8 + 7] = siluf_(q1.w);
            *(LAS f32x4*)(vv + sr * 64 + k8) = *(const f32x4*)(row + 512); *(LAS f32x4*)(vv + sr * 64 + k8 + 4) = *(const f32x4*)(row + 516); }
        __syncthreads();
        { const int t = tid >> 3, sg = tid & 7; float ac[8] = {0.f, 0.f, 0.f, 0.f, 0.f, 0.f, 0.f, 0.f};
            for (int k = 0; k < 64; ++k) { const float qt = qq[t * HP + k], bt = bq[t * HP + k];
#pragma unroll
                for (int i = 0; i < 8; ++i) { const int sx = sg + 8 * i; if (sx <= t) ac[i] += qt * kin[sx * HP + k] * __expf(bt - bq[sx * HP + k]); } }
#pragma unroll
            for (int i = 0; i < 8; ++i) At[t * HP + sg + 8 * i] = ac[i]; }
        __syncthreads();
        { const int t = tid >> 3; float o[8] = {0.f, 0.f, 0.f, 0.f, 0.f, 0.f, 0.f, 0.f};
#pragma unroll 4
            for (int k = 0; k < 64; ++k) { const float qe = qq[t * HP + k] * __expf(bq[t * HP + k]); const f32x4 x0 = *(const LAS f32x4*)(Ss + k * 64 + v8), x1 = *(const LAS f32x4*)(Ss + k * 64 + v8 + 4);
                o[0] += qe * x0.x; o[1] += qe * x0.y; o[2] += qe * x0.z; o[3] += qe * x0.w; o[4] += qe * x1.x; o[5] += qe * x1.y; o[6] += qe * x1.z; o[7] += qe * x1.w; }
            for (int sx = 0; sx <= t; ++sx) { const float wv = At[t * HP + sx]; const f32x4 x0 = *(const LAS f32x4*)(vv + sx * 64 + v8), x1 = *(const LAS f32x4*)(vv + sx * 64 + v8 + 4);
                o[0] += wv * x0.x; o[1] += wv * x0.y; o[2] += wv * x0.z; o[3] += wv * x0.w; o[4] += wv * x1.x; o[5] += wv * x1.y; o[6] += wv * x1.z; o[7] += wv * x1.w; }
            float ss = 0.f;
#pragma unroll
            for (int j = 0; j < 8; ++j) ss += o[j] * o[j];
            ss += __shfl_xor(ss, 1); ss += __shfl_xor(ss, 2); ss += __shfl_xor(ss, 4);
            const float rstd = 1.0f / sqrtf(ss * (1.0f / 64.0f) + EPS);
            const float* gp = HG + (tok0 + t) * 1024 + 768 + hh * 64 + v8; const float* ng = a.hgrn_g + l * 64 + v8;
            const f32x4 g0 = *(const f32x4*)gp, g1 = *(const f32x4*)(gp + 4); const float gg[8] = {g0.x, g0.y, g0.z, g0.w, g1.x, g1.y, g1.z, g1.w}; float y[8];
#pragma unroll
            for (int j = 0; j < 8; ++j) y[j] = o[j] * rstd * ng[j] * siluf_(gg[j]);
            u32x4 wv; wv.x = pk2(y[0], y[1]); wv.y = pk2(y[2], y[3]); wv.z = pk2(y[4], y[5]); wv.w = pk2(y[6], y[7]);
            *(u32x4*)((bf16_t*)(C.ws + WS_MIX) + (tok0 + t) * D + 768 + hh * 64 + v8) = wv; }
        { const float dc = __expf(bq[63 * HP + kS]); s0 = s0 * dc + lc0; s1 = s1 * dc + lc1; }
        __syncthreads();
    }
}

template <bool WITH_Q>
__device__ __forceinline__ void hgrn_fill(const Args& a, Ctx& C, int l, int hh, size_t tok0, LAS float* fz, LAS float* kn, LAS float* qq, LAS float* vv) {
    const int tid = C.tid, sr = tid >> 3, k8 = (tid & 7) * 8; const float* row = (const float*)(C.ws + WS_HG) + (tok0 + sr) * 1024 + hh * 64 + k8;
    const f32x4 z0 = *(const f32x4*)(row + 256), z1 = *(const f32x4*)(row + 260); const float zz[8] = {z0.x, z0.y, z0.z, z0.w, z1.x, z1.y, z1.z, z1.w}; float fo[8], ko[8];
#pragma unroll
    for (int j = 0; j < 8; ++j) { const int kk = hh * 64 + k8 + j; const float lb = (l == 1) ? 1.0f / (1.0f + expf(a.lb_logits[kk] - a.lb_logits[256 + kk])) : 0.f;
        const float sg = 1.0f / (1.0f + expf(-zz[j])), sn = 1.0f / (1.0f + expf(zz[j])); fo[j] = lb + (1.0f - lb) * sg; ko[j] = (1.0f - lb) * sn; }
    *(LAS f32x4*)(fz + sr * 64 + k8) = (f32x4){fo[0], fo[1], fo[2], fo[3]}; *(LAS f32x4*)(fz + sr * 64 + k8 + 4) = (f32x4){fo[4], fo[5], fo[6], fo[7]};
    *(LAS f32x4*)(kn + sr * 64 + k8) = (f32x4){ko[0], ko[1], ko[2], ko[3]}; *(LAS f32x4*)(kn + sr * 64 + k8 + 4) = (f32x4){ko[4], ko[5], ko[6], ko[7]};
    if (WITH_Q) { const f32x4 q0 = *(const f32x4*)row, q1 = *(const f32x4*)(row + 4);
        *(LAS f32x4*)(qq + sr * 64 + k8) = (f32x4){siluf_(q0.x), siluf_(q0.y), siluf_(q0.z), siluf_(q0.w)}; *(LAS f32x4*)(qq + sr * 64 + k8 + 4) = (f32x4){siluf_(q1.x), siluf_(q1.y), siluf_(q1.z), siluf_(q1.w)}; }
    *(LAS f32x4*)(vv + sr * 64 + k8) = *(const f32x4*)(row + 512); *(LAS f32x4*)(vv + sr * 64 + k8 + 4) = *(const f32x4*)(row + 516);
}
__device__ __forceinline__ void hgrn_local2(const Args& a, Ctx& C, int l, int item) {
    const int tid = C.tid, c = item & 63, hh = (item >> 6) & 3, b = item >> 8, v = tid & 63, kq = tid >> 6;
    LAS float* fz = (LAS float*)C.lds; LAS float* kn = fz + 4096; LAS float* vv = kn + 4096;
    hgrn_fill<false>(a, C, l, hh, (size_t)b * SEQ + c * 64, fz, kn, nullptr, vv);
    __syncthreads();
    float S[8] = {0.f, 0.f, 0.f, 0.f, 0.f, 0.f, 0.f, 0.f}, dp[8] = {1.f, 1.f, 1.f, 1.f, 1.f, 1.f, 1.f, 1.f};
#pragma unroll 4
    for (int sx = 0; sx < 64; ++sx) { const f32x4 f0 = *(const LAS f32x4*)(fz + sx * 64 + 8 * kq), f1 = *(const LAS f32x4*)(fz + sx * 64 + 8 * kq + 4), k0 = *(const LAS f32x4*)(kn + sx * 64 + 8 * kq), k1 = *(const LAS f32x4*)(kn + sx * 64 + 8 * kq + 4);
        const float vs = vv[sx * 64 + v]; const float ff[8] = {f0.x, f0.y, f0.z, f0.w, f1.x, f1.y, f1.z, f1.w}, kk[8] = {k0.x, k0.y, k0.z, k0.w, k1.x, k1.y, k1.z, k1.w};
#pragma unroll
        for (int j = 0; j < 8; ++j) { S[j] = ff[j] * S[j] + kk[j] * vs; dp[j] *= ff[j]; } }
    float* hl = (float*)(C.ws + WS_HL) + (size_t)item * 4096 + (8 * kq) * 64 + v;
#pragma unroll
    for (int j = 0; j < 8; ++j) hl[j * 64] = S[j];
    if (v == 0) { float* hd = (float*)(C.ws + WS_HD) + (size_t)item * 64 + 8 * kq;
#pragma unroll
        for (int j = 0; j < 8; ++j) hd[j] = dp[j]; }
    __syncthreads();
}
__device__ __forceinline__ void hgrn_out2(const Args& a, Ctx& C, int l, int item) {
    const int tid = C.tid, cg = item & 15, hh = (item >> 4) & 3, b = item >> 6, c0 = 4 * cg, bh = b * 4 + hh, v = tid & 63, kq = tid >> 6;
    LAS float* fz = (LAS float*)C.lds; LAS float* kn = fz + 4096; LAS float* qq = kn + 4096; LAS float* vv = qq + 4096; LAS float* part = vv + 4096;
    const float* HLb = (const float*)(C.ws + WS_HL) + (size_t)bh * 64 * 4096 + (8 * kq) * 64 + v; const float* HDb = (const float*)(C.ws + WS_HD) + (size_t)bh * 64 * 64 + 8 * kq;
    float S[8] = {0.f, 0.f, 0.f, 0.f, 0.f, 0.f, 0.f, 0.f};
#pragma unroll 2
    for (int j = 0; j < c0; ++j) { const f32x4 d0 = *(const f32x4*)(HDb + (size_t)j * 64), d1 = *(const f32x4*)(HDb + (size_t)j * 64 + 4); const float dd[8] = {d0.x, d0.y, d0.z, d0.w, d1.x, d1.y, d1.z, d1.w};
#pragma unroll
        for (int i = 0; i < 8; ++i) S[i] = dd[i] * S[i] + HLb[(size_t)j * 4096 + i * 64]; }
#pragma unroll 1
    for (int c = c0; c < c0 + 4; ++c) {
        const size_t tok0 = (size_t)b * SEQ + c * 64;
        hgrn_fill<true>(a, C, l, hh, tok0, fz, kn, qq, vv);
        __syncthreads();
#pragma unroll 1
        for (int half = 0; half < 2; ++half) {
#pragma unroll 4
            for (int sl = 0; sl < 32; ++sl) { const int sx = 32 * half + sl;
                const f32x4 f0 = *(const LAS f32x4*)(fz + sx * 64 + 8 * kq), f1 = *(const LAS f32x4*)(fz + sx * 64 + 8 * kq + 4), k0 = *(const LAS f32x4*)(kn + sx * 64 + 8 * kq), k1 = *(const LAS f32x4*)(kn + sx * 64 + 8 * kq + 4);
                const f32x4 q0 = *(const LAS f32x4*)(qq + sx * 64 + 8 * kq), q1 = *(const LAS f32x4*)(qq + sx * 64 + 8 * kq + 4);
                const float vs = vv[sx * 64 + v]; const float ff[8] = {f0.x, f0.y, f0.z, f0.w, f1.x, f1.y, f1.z, f1.w}, kk[8] = {k0.x, k0.y, k0.z, k0.w, k1.x, k1.y, k1.z, k1.w}, qv[8] = {q0.x, q0.y, q0.z, q0.w, q1.x, q1.y, q1.z, q1.w};
                float op = 0.f;
#pragma unroll
                for (int j = 0; j < 8; ++j) { S[j] = ff[j] * S[j] + kk[j] * vs; op += qv[j] * S[j]; }
                part[(kq * 32 + sl) * 64 + v] = op; }
            __syncthreads();
            { const int t = tid >> 4, v4 = (tid & 15) * 4; f32x4 o = (f32x4){0.f, 0.f, 0.f, 0.f};
#pragma unroll
                for (int kk2 = 0; kk2 < 8; ++kk2) o += *(const LAS f32x4*)(part + (kk2 * 32 + t) * 64 + v4);
                float ss = o.x * o.x + o.y * o.y + o.z * o.z + o.w * o.w;
                ss += __shfl_xor(ss, 1); ss += __shfl_xor(ss, 2); ss += __shfl_xor(ss, 4); ss += __shfl_xor(ss, 8);
                const float rstd = 1.0f / sqrtf(ss * (1.0f / 64.0f) + EPS);
                const size_t tok = tok0 + 32 * half + t;
                const f32x4 gg = *(const f32x4*)((const float*)(C.ws + WS_HG) + tok * 1024 + 768 + hh * 64 + v4), ng = *(const f32x4*)(a.hgrn_g + l * 64 + v4);
                const float y0 = o.x * rstd * ng.x * siluf_(gg.x), y1 = o.y * rstd * ng.y * siluf_(gg.y), y2 = o.z * rstd * ng.z * siluf_(gg.z), y3 = o.w * rstd * ng.w * siluf_(gg.w);
                u32x2 wv; wv.x = pk2(y0, y1); wv.y = pk2(y2, y3);
                *(u32x2*)((bf16_t*)(C.ws + WS_MIX) + tok * D + 768 + hh * 64 + v4) = wv; }
            __syncthreads();
        }
    }
}

__device__ __forceinline__ void pool_wave(const Args& a, Ctx& C, int l) {
    unsigned char* ws = C.ws; const int lane = C.lane;
    const int gwv = blockIdx.x * NWAVES + C.wave, g = gwv & 3, widx = gwv >> 2, nw = (C.G * NWAVES) >> 2, w = 2 << g;
    float pwr[64];
#pragma unroll
    for (int c = 0; c < 64; ++c) pwr[c] = a.pool_w[(size_t)(l * 4 + g) * 4096 + c * 64 + lane];
    const float psc = a.pool_scale[l * 256 + g * 64 + lane];
    const float* ubg = (const float*)(ws + WS_UB) + g * 64 + lane;
    for (int tile = widx; tile < NTOK / 8; tile += nw) {
        const int tok0 = tile * 8, tp0 = tok0 & (SEQ - 1);
        float row[23];
#pragma unroll
        for (int r = 0; r < 23; ++r) { const int tp = tp0 - 15 + r; row[r] = (tp >= 0) ? ubg[(size_t)(tok0 - 15 + r) * 256] : 0.f; }
        float pooled[8];
#pragma unroll
        for (int t = 0; t < 8; ++t) {
            float sm = 0.f;
#pragma unroll
            for (int i = 0; i < 16; ++i) if (i < w) sm += row[15 + t - i];
            const int tpos = tp0 + t; const int wl = (tpos + 1) < w ? (tpos + 1) : w;
            pooled[t] = sm * (1.0f / (float)wl) - row[15 + t];
        }
        float y[8] = {0.f, 0.f, 0.f, 0.f, 0.f, 0.f, 0.f, 0.f};
#pragma unroll
        for (int c = 0; c < 64; ++c) {
#pragma unroll
            for (int t = 0; t < 8; ++t) y[t] += __builtin_bit_cast(float, __builtin_amdgcn_readlane(__builtin_bit_cast(int, pooled[t]), c)) * pwr[c];
        }
        bf16_t* mo = (bf16_t*)(ws + WS_MIX) + (size_t)tok0 * D + 512 + g * 64 + lane;
#pragma unroll
        for (int t = 0; t < 8; ++t) mo[(size_t)t * D] = (bf16_t)f2bf(y[t] * psc);
    }
}

__device__ __forceinline__ void phase_mix1(const Args& a, Ctx& C, int l) {
#ifndef MIX1MASK
#define MIX1MASK 7
#endif
#ifndef MIX1REP
#define MIX1REP 0
#endif
    for (int rep = 0; rep < ((MIX1REP & 1) && l == 0 ? 2 : 1); ++rep) for (int it = blockIdx.x; it < 1024; it += C.G) hgrn_local2(a, C, l, it);
    for (int rep = 0; rep < ((MIX1REP & 2) && l == 0 ? 2 : 1); ++rep) pool_wave(a, C, l);
    __syncthreads();
    for (int rep = 0; rep < ((MIX1REP & 4) && l == 0 ? 2 : 1); ++rep) for (int base = 0; base < 2048; base += 2 * C.G) {
        const int u1 = base + (int)blockIdx.x, u2 = base + 2 * C.G - 1 - (int)blockIdx.x;
        if (u1 < 2048) index_unit2(C, (u1 >> 3) & 3, u1 >> 5, u1 & 7);
        if (u2 < 2048) index_unit2(C, (u2 >> 3) & 3, u2 >> 5, u2 & 7);
    }
}
__device__ __forceinline__ void phase_mix2(const Args& a, Ctx& C, int l) {
#ifndef MIX2MASK
#define MIX2MASK 3
#endif
#ifndef MIX2REP
#define MIX2REP 0
#endif
    for (int rep = 0; rep < ((MIX2REP & 1) ? 2 : 1); ++rep) for (int it = blockIdx.x; it < 256; it += C.G) hgrn_out2(a, C, l, it);
    LAS unsigned char* vs = C.lds + C.wave * (2 * 32 * VROW);
    const int gw = blockIdx.x * NWAVES + C.wave, NGW = C.G * NWAVES;
    Conv cv; cv.w1l = a.w1 + (size_t)l * 32 * 1024 * 2048; cv.w2l = a.w2 + (size_t)l * 32 * 1024 * 1024; cv.w1t = (bf16_t*)(C.ws + WS_W1) + (size_t)l * 32 * 2048 * 1024; cv.w2t = (bf16_t*)(C.ws + WS_W2) + (size_t)l * 32 * 1024 * 1024;
    cv.it = gw; cv.step = NGW; cv.lane = C.lane; cv.pend = false;
    for (int tk = gw; tk < NTOK; tk += NGW) attend_query_mfma(C, tk, vs, cv);
    while (cv.pend || cv.it < Conv::NITEMS) { cv.finish((LAS float*)vs); cv.issue(); }
}

__device__ __forceinline__ void phase_router(const Args& a, Ctx& C, int l) {
    unsigned char* ws = C.ws; const int lane = C.lane;
    LAS float* us = (LAS float*)(C.lds + C.wave * 8192);
    const float* mod = (const float*)(ws + WS_MOD); const float* H = (const float*)(ws + WS_H);
    const float* wr = a.w_router + (size_t)l * 1024 * 32; unsigned* cnt = (unsigned*)(ws + WS_CTL) + CW_CNT + l * 32 * 64;
    const int gw = blockIdx.x * NWAVES + C.wave, NGW = C.G * NWAVES;
    for (int base = gw * 2; base < NTOK; base += NGW * 2) {
#pragma unroll
        for (int hf = 0; hf < 2; ++hf) {
            const int tk = base + hf, b = tk >> 12; const f32x4* hr = (const f32x4*)(H + (size_t)tk * D) + lane; f32x4 v[4];
#pragma unroll
            for (int j = 0; j < 4; ++j) v[j] = hr[64 * j];
            float ss = 0.f;
#pragma unroll
            for (int j = 0; j < 4; ++j) ss += (v[j].x * v[j].x + v[j].y * v[j].y) + (v[j].z * v[j].z + v[j].w * v[j].w);
            const float rstd = 1.0f / sqrtf(wave_sum(ss) * (1.0f / D) + EPS);
            const float* mb = mod + (size_t)(l * 4 + b) * 6144; bf16_t* urow = (bf16_t*)(ws + WS_U) + (size_t)tk * D;
#pragma unroll
            for (int j = 0; j < 4; ++j) { const int idx = 4 * lane + 256 * j; const f32x4 gv = *(const f32x4*)(a.norm2_g + l * 1024 + idx), shv = *(const f32x4*)(mb + 3072 + idx), scv = *(const f32x4*)(mb + 4096 + idx);
                const f32x4 o = v[j] * rstd * gv * (scv + 1.0f) + shv; u32x2 w; w.x = pk2(o[0], o[1]); w.y = pk2(o[2], o[3]); *(u32x2*)(urow + idx) = w;
                *(LAS f32x4*)(us + hf * 1024 + idx) = o; }
        }
        asm volatile("s_waitcnt lgkmcnt(0)" ::: "memory"); __builtin_amdgcn_wave_barrier();
        const int e = lane & 31, hf = lane >> 5; float acc0 = 0.f, acc1 = 0.f;
        const LAS float* up = us + hf * 1024;
#pragma unroll 8
        for (int d = 0; d < 1024; d += 2) { acc0 += up[d] * wr[d * 32 + e]; acc1 += up[d + 1] * wr[(d + 1) * 32 + e]; }
        float val = acc0 + acc1 + a.b_router[l * 32 + e];
        float tv[4]; int te[4];
#pragma unroll
        for (int k = 0; k < 4; ++k) {
            float bv = val; int bi = e;
#pragma unroll
            for (int o = 1; o < 32; o <<= 1) { const float ov = __shfl_xor(bv, o); const int oi = __shfl_xor(bi, o); if (ov > bv || (ov == bv && oi < bi)) { bv = ov; bi = oi; } }
            tv[k] = bv; te[k] = bi; if (e == bi) val = -3.0e38f;
        }
        const float e1 = __expf(tv[1] - tv[0]), e2 = __expf(tv[2] - tv[0]), e3 = __expf(tv[3] - tv[0]); const float rs = 1.0f / (1.0f + e1 + e2 + e3);
        if (e < 4) {
            const int tk = base + hf; const int ex = e == 0 ? te[0] : e == 1 ? te[1] : e == 2 ? te[2] : te[3]; const float gt = (e == 0 ? 1.0f : e == 1 ? e1 : e == 2 ? e2 : e3) * rs;
            const unsigned slot = atomicAdd(cnt + ex * 64, 1u);
            ((int*)(ws + WS_ROWTOK))[(size_t)ex * NTOK + slot] = tk;
            ((int*)(ws + WS_EIDX))[tk * 4 + e] = ex; ((int*)(ws + WS_SLOT))[tk * 4 + e] = (int)slot; ((float*)(ws + WS_GATE))[tk * 4 + e] = gt;
        }
        asm volatile("s_waitcnt lgkmcnt(0)" ::: "memory"); __builtin_amdgcn_wave_barrier();
    }
}

constexpr int URS = 2064;
__device__ __forceinline__ void phase_router2(const Args& a, Ctx& C, int l) {
    unsigned char* ws = C.ws; const int lane = C.lane, w = C.wave, tid = C.tid;
    LAS unsigned char* uh = C.lds; LAS unsigned char* ul = uh + 16 * URS; LAS float* part = (LAS float*)(ul + 16 * URS);
    LAS int* hist = (LAS int*)(part + 8 * 16 * 32);
    LAS int* asg = hist + 64;
    LAS float* asgg = (LAS float*)(asg + 2 * 1024);
    const float* mod = (const float*)(ws + WS_MOD); const float* H = (const float*)(ws + WS_H);
    const bf16_t* wrh = (const bf16_t*)(ws + WS_WRH) + (size_t)l * 32768; const bf16_t* wrl = (const bf16_t*)(ws + WS_WRL) + (size_t)l * 32768;
    unsigned* cnt = (unsigned*)(ws + WS_CTL) + CW_CNT + l * 32 * 64;
    const int ntile_all = NTOK / 16;
    for (int tile0 = blockIdx.x; tile0 < ntile_all; tile0 += 16 * C.G) {
        if (tid < 64) hist[tid] = 0;
        __syncthreads();
        int nt_here = 0;
        for (int tile = tile0; tile < ntile_all && nt_here < 16; tile += C.G, ++nt_here) {
            const int tok0 = tile * 16;
#pragma unroll
            for (int hf = 0; hf < 2; ++hf) {
                const int tr = 2 * w + hf, tk = tok0 + tr, b = tk >> 12; const f32x4* hr = (const f32x4*)(H + (size_t)tk * D) + lane; f32x4 v[4];
#pragma unroll
                for (int j = 0; j < 4; ++j) v[j] = hr[64 * j];
                float ss = 0.f;
#pragma unroll
                for (int j = 0; j < 4; ++j) ss += (v[j].x * v[j].x + v[j].y * v[j].y) + (v[j].z * v[j].z + v[j].w * v[j].w);
                const float rstd = 1.0f / sqrtf(wave_sum(ss) * (1.0f / D) + EPS);
                const float* mb = mod + (size_t)(l * 4 + b) * 6144; bf16_t* urow = (bf16_t*)(ws + WS_U) + (size_t)tk * D;
#pragma unroll
                for (int j = 0; j < 4; ++j) { const int idx = 4 * lane + 256 * j; const f32x4 gv = *(const f32x4*)(a.norm2_g + l * 1024 + idx), shv = *(const f32x4*)(mb + 3072 + idx), scv = *(const f32x4*)(mb + 4096 + idx);
                    const f32x4 o = v[j] * rstd * gv * (scv + 1.0f) + shv; u32x2 hi; hi.x = pk2(o[0], o[1]); hi.y = pk2(o[2], o[3]); *(u32x2*)(urow + idx) = hi;
                    u32x2 lo; lo.x = pk2(o[0] - bflo(hi.x), o[1] - bfhi(hi.x)); lo.y = pk2(o[2] - bflo(hi.y), o[3] - bfhi(hi.y));
                    *(LAS u32x2*)(uh + tr * URS + idx * 2) = hi; *(LAS u32x2*)(ul + tr * URS + idx * 2) = lo; }
            }
            __syncthreads();
            {
                const int c = lane & 15, g = lane >> 4; f32x4 acc0 = (f32x4){0.f, 0.f, 0.f, 0.f}, acc1 = acc0;
#pragma unroll
                for (int kk = 0; kk < 4; ++kk) { const int ks = 4 * w + kk;
                    const bf16x8 ah = *(const LAS bf16x8*)(uh + c * URS + (32 * ks + 8 * g) * 2), al = *(const LAS bf16x8*)(ul + c * URS + (32 * ks + 8 * g) * 2);
                    const bf16x8 bh0 = *(const bf16x8*)(wrh + (size_t)c * 1024 + 32 * ks + 8 * g), bl0 = *(const bf16x8*)(wrl + (size_t)c * 1024 + 32 * ks + 8 * g);
                    const bf16x8 bh1 = *(const bf16x8*)(wrh + (size_t)(c + 16) * 1024 + 32 * ks + 8 * g), bl1 = *(const bf16x8*)(wrl + (size_t)(c + 16) * 1024 + 32 * ks + 8 * g);
                    acc0 = __builtin_amdgcn_mfma_f32_16x16x32_bf16(al, bh0, acc0, 0, 0, 0); acc0 = __builtin_amdgcn_mfma_f32_16x16x32_bf16(ah, bl0, acc0, 0, 0, 0); acc0 = __builtin_amdgcn_mfma_f32_16x16x32_bf16(ah, bh0, acc0, 0, 0, 0);
                    acc1 = __builtin_amdgcn_mfma_f32_16x16x32_bf16(al, bh1, acc1, 0, 0, 0); acc1 = __builtin_amdgcn_mfma_f32_16x16x32_bf16(ah, bl1, acc1, 0, 0, 0); acc1 = __builtin_amdgcn_mfma_f32_16x16x32_bf16(ah, bh1, acc1, 0, 0, 0); }
#pragma unroll
                for (int r = 0; r < 4; ++r) { part[(w * 16 + 4 * g + r) * 32 + c] = acc0[r]; part[(w * 16 + 4 * g + r) * 32 + 16 + c] = acc1[r]; }
            }
            __syncthreads();
            {
                const int e = lane & 31, hf = lane >> 5, tr = 2 * w + hf; float val = a.b_router[l * 32 + e];
#pragma unroll
                for (int ww = 0; ww < 8; ++ww) val += part[(ww * 16 + tr) * 32 + e];
                float tv[4]; int te[4];
#pragma unroll
                for (int k = 0; k < 4; ++k) {
                    float bv = val; int bi = e;
#pragma unroll
                    for (int o = 1; o < 32; o <<= 1) { const float ov = __shfl_xor(bv, o); const int oi = __shfl_xor(bi, o); if (ov > bv || (ov == bv && oi < bi)) { bv = ov; bi = oi; } }
                    tv[k] = bv; te[k] = bi; if (e == bi) val = -3.0e38f;
                }
                const float e1 = __expf(tv[1] - tv[0]), e2 = __expf(tv[2] - tv[0]), e3 = __expf(tv[3] - tv[0]); const float rs = 1.0f / (1.0f + e1 + e2 + e3);
                if (e < 4) {
                    const int ex = e == 0 ? te[0] : e == 1 ? te[1] : e == 2 ? te[2] : te[3]; const float gt = (e == 0 ? 1.0f : e == 1 ? e1 : e == 2 ? e2 : e3) * rs;
                    const int ai = (nt_here * 16 + tr) * 4 + e;
                    asg[2 * ai] = ex; asg[2 * ai + 1] = __hip_atomic_fetch_add(&hist[ex], 1, __ATOMIC_RELAXED, __HIP_MEMORY_SCOPE_WORKGROUP); asgg[ai] = gt;
                }
            }
            __syncthreads();
        }
        if (tid < 32) { const int hc = hist[tid]; hist[32 + tid] = hc ? (int)atomicAdd(cnt + tid * 64, (unsigned)hc) : 0; }
        __syncthreads();
        for (int ai = tid; ai < nt_here * 64; ai += NTHREADS) {
            const int ti = ai >> 6, tr = (ai >> 2) & 15, k = ai & 3, tk = (tile0 + ti * C.G) * 16 + tr;
            const int ex = asg[2 * ai], slot = hist[32 + ex] + asg[2 * ai + 1];
            ((int*)(ws + WS_ROWTOK))[(size_t)ex * NTOK + slot] = tk;
            ((int*)(ws + WS_EIDX))[tk * 4 + k] = ex; ((int*)(ws + WS_SLOT))[tk * 4 + k] = slot; ((float*)(ws + WS_GATE))[tk * 4 + k] = asgg[ai];
        }
        __syncthreads();
    }
}

__device__ __forceinline__ void moe_table(Ctx& C, int l, LAS int* tab) {
    if (C.tid < 32) { const unsigned* cnt = (const unsigned*)(C.ws + WS_CTL) + CW_CNT + l * 32 * 64; tab[33 + C.tid] = (int)__hip_atomic_load(cnt + C.tid * 64, __ATOMIC_RELAXED, __HIP_MEMORY_SCOPE_AGENT); }
    __syncthreads();
    if (C.tid == 0) { int p = 0; for (int e = 0; e < 32; ++e) { tab[e] = p; p += (tab[33 + e] + 255) >> 8; } tab[32] = p; }
    __syncthreads();
}

__device__ __forceinline__ void phase_combine(const Args& a, Ctx& C, int l) {
    unsigned char* ws = C.ws; const int lane = C.lane;
    const float* mod = (const float*)(ws + WS_MOD); float* H = (float*)(ws + WS_H); const bf16_t* Y = (const bf16_t*)(ws + WS_Y);
    const unsigned* cnt = (const unsigned*)(ws + WS_CTL) + CW_CNT + l * 32 * 64;
    int mt = 0; if (lane < 32) mt = ((int)__hip_atomic_load(cnt + lane * 64, __ATOMIC_RELAXED, __HIP_MEMORY_SCOPE_AGENT) + 255) >> 8;
    int incl = mt;
#pragma unroll
    for (int o = 1; o < 32; o <<= 1) { const int t = __shfl_up(incl, o); if ((lane & 31) >= o) incl += t; }
    const int excl = incl - mt;
    const int gw = blockIdx.x * NWAVES + C.wave, NGW = C.G * NWAVES;
    for (int tk0 = gw; tk0 < NTOK; tk0 += 2 * NGW) {
        int tks[2]; tks[0] = tk0; tks[1] = (tk0 + NGW) < NTOK ? tk0 + NGW : tk0; const bool two = (tk0 + NGW) < NTOK;
        f32x4 v[2][4]; u32x2 yv[2][4][4]; float gts[2][4];
#pragma unroll
        for (int q = 0; q < 2; ++q) { const int tk = tks[q]; const f32x4* hr = (const f32x4*)(H + (size_t)tk * D) + lane;
#pragma unroll
            for (int j = 0; j < 4; ++j) v[q][j] = hr[64 * j];
            const int4 ex4 = *(const int4*)((const int*)(ws + WS_EIDX) + tk * 4), sl4 = *(const int4*)((const int*)(ws + WS_SLOT) + tk * 4); const f32x4 g4 = *(const f32x4*)((const float*)(ws + WS_GATE) + tk * 4);
            const int exs[4] = {ex4.x, ex4.y, ex4.z, ex4.w}, sls[4] = {sl4.x, sl4.y, sl4.z, sl4.w};
#pragma unroll
            for (int k = 0; k < 4; ++k) { gts[q][k] = g4[k]; const int row = 256 * __shfl(excl, exs[k]) + sls[k]; const u32x2* yr = (const u32x2*)(Y + (size_t)row * D) + lane;
#pragma unroll
                for (int j = 0; j < 4; ++j) yv[q][k][j] = yr[64 * j]; }
        }
#pragma unroll
        for (int q = 0; q < 2; ++q) {
            if (q == 1 && !two) break;
            const int tk = tks[q], b = tk >> 12; f32x4* hr = (f32x4*)(H + (size_t)tk * D) + lane;
            f32x4 m[4];
#pragma unroll
            for (int j = 0; j < 4; ++j) m[j] = (f32x4){0.f, 0.f, 0.f, 0.f};
#pragma unroll
            for (int k = 0; k < 4; ++k)
#pragma unroll
                for (int j = 0; j < 4; ++j) { const u32x2 w = yv[q][k][j]; m[j] += (f32x4){bflo(w.x), bfhi(w.x), bflo(w.y), bfhi(w.y)} * gts[q][k]; }
            const float* mb = mod + (size_t)(l * 4 + b) * 6144;
            f32x4 vv[4];
#pragma unroll
            for (int j = 0; j < 4; ++j) { const f32x4 g2 = *(const f32x4*)(mb + 5120 + 4 * lane + 256 * j); vv[j] = v[q][j] + g2 * m[j]; if (l + 1 < DEPTH) hr[64 * j] = vv[j]; }
            if (l + 1 < DEPTH) { const float* mn = mod + (size_t)((l + 1) * 4 + b) * 6144; norm_mod_store(vv, a.norm1_g + (l + 1) * 1024, mn + 0, mn + 1024, (bf16_t*)(ws + WS_U) + (size_t)tk * D, lane); }
            else {
                float ss = 0.f;
#pragma unroll
                for (int j = 0; j < 4; ++j) ss += (vv[j].x * vv[j].x + vv[j].y * vv[j].y) + (vv[j].z * vv[j].z + vv[j].w * vv[j].w);
                const float rstd = 1.0f / sqrtf(wave_sum(ss) * (1.0f / D) + EPS);
                f32x4* orow = (f32x4*)(a.out + (size_t)tk * D) + lane;
#pragma unroll
                for (int j = 0; j < 4; ++j) orow[64 * j] = vv[j] * rstd * *(const f32x4*)(a.final_g + 4 * lane + 256 * j);
            }
        }
    }
}

#define XB_TMO      128
#define XB_XCNT(j)  (256  + 64 * (j))
#define XB_XSUB(j)  (1280 + 64 * (j))
#define XB_XGEN(j)  (2304 + 64 * (j))
#define XB_TOP      3328
#define XB_TOPGEN   3392
#define XCD_BAR_WORDS 3456
#define XB_SPIN_CAP (1u << 22)
__device__ __forceinline__ unsigned xb_ld(unsigned* p)              { return __hip_atomic_load(p, __ATOMIC_RELAXED, __HIP_MEMORY_SCOPE_AGENT); }
__device__ __forceinline__ unsigned xb_add(unsigned* p, unsigned v) { return __hip_atomic_fetch_add(p, v, __ATOMIC_RELAXED, __HIP_MEMORY_SCOPE_AGENT); }
__device__ __forceinline__ unsigned xb_xcc_id() { return (unsigned)__builtin_amdgcn_s_getreg((3 << 11) | 20) & 0xFu; }
#define XB_SPIN(cond, bar) do { unsigned _sp = 0; while (cond) { __builtin_amdgcn_s_sleep(1); \
    if ((++_sp & 255u) == 0u) { if (xb_ld(&(bar)[XB_TMO])) break; if (_sp > XB_SPIN_CAP) { atomicAdd(&(bar)[XB_TMO], 1u); break; } } } } while (0)
struct XcdBarrier { unsigned* bar; unsigned x; volatile LAS unsigned* st; };
__device__ __forceinline__ XcdBarrier xcd_barrier_post(unsigned* bar, volatile LAS unsigned* st, bool leader) {
    XcdBarrier b; b.bar = bar; b.x = xb_xcc_id(); b.st = st;
    if (leader) (void)xb_add(&bar[XB_XCNT(b.x)], 1u);
    return b;
}
__device__ __forceinline__ void xcd_barrier_complete(unsigned* bar, unsigned x, unsigned& nloc, unsigned& nx) {
    const unsigned G = gridDim.x * gridDim.y * gridDim.z;
    unsigned sum, cnt, mine, sp = 0u;
    for (;;) {
        sum = 0u; cnt = 0u; mine = 0u;
#pragma unroll
        for (unsigned j = 0; j < 16; ++j) { const unsigned c = xb_ld(&bar[XB_XCNT(j)]); sum += c; cnt += (c > 0u) ? 1u : 0u; mine = (j == x) ? c : mine; }
        if (sum == G) break;
        __builtin_amdgcn_s_sleep(1);
        if ((++sp & 255u) == 0u) { if (xb_ld(&bar[XB_TMO])) break; if (sp > XB_SPIN_CAP) { atomicAdd(&bar[XB_TMO], 1u); break; } }
    }
    nloc = mine > 0u ? mine : 1u; nx = cnt > 0u ? cnt : 1u;
}
__device__ __forceinline__ void xcd_barrier(const XcdBarrier& b, bool leader) {
    asm volatile("s_waitcnt vmcnt(0)" ::: "memory");
    __syncthreads();
    if (leader) {
        unsigned* bar = b.bar;
        __builtin_amdgcn_s_waitcnt(0);
        unsigned nloc = b.st[0], nx = b.st[1];
        if (nloc == 0u) { xcd_barrier_complete(bar, b.x, nloc, nx); b.st[0] = nloc; b.st[1] = nx; }
        const unsigned old = xb_add(&bar[XB_XSUB(b.x)], 1u);
        const unsigned gen = old / nloc;
        if (old + 1u == (gen + 1u) * nloc) {
            __builtin_amdgcn_fence(__ATOMIC_RELEASE, "agent");
            asm volatile("s_waitcnt vmcnt(0)" ::: "memory");
            const unsigned og = xb_add(&bar[XB_TOP], 1u);
            const unsigned tg = og / nx;
            if (og + 1u == (tg + 1u) * nx) xb_add(&bar[XB_TOPGEN], 1u);
            else XB_SPIN(xb_ld(&bar[XB_TOPGEN]) == tg, bar);
            __builtin_amdgcn_fence(__ATOMIC_ACQUIRE, "agent");
            xb_add(&bar[XB_XGEN(b.x)], 1u);
            asm volatile("s_waitcnt vmcnt(0)" ::: "memory");
        } else {
            XB_SPIN(xb_ld(&bar[XB_XGEN(b.x)]) == gen, bar);
            __builtin_amdgcn_fence(__ATOMIC_ACQUIRE, "agent");
            asm volatile("s_waitcnt vmcnt(0)" ::: "memory");
        }
    }
    __syncthreads();
}

typedef const __attribute__((address_space(4))) Args* KArgsPtr;
__device__ __forceinline__ Args load_args() {
#if defined(__HIP_DEVICE_COMPILE__)
    KArgsPtr p = (KArgsPtr)__builtin_amdgcn_kernarg_segment_ptr(); asm volatile("" : "+s"(p)); Args a;
    a.x = p->x; a.c = p->c; a.pos = p->pos; a.w_ada = p->w_ada; a.b_ada = p->b_ada; a.norm1_g = p->norm1_g; a.norm2_g = p->norm2_g; a.w_in = p->w_in; a.w_out = p->w_out; a.pool_w = p->pool_w;
    a.pool_scale = p->pool_scale; a.hgrn_g = p->hgrn_g; a.lb_logits = p->lb_logits; a.w_router = p->w_router; a.b_router = p->b_router; a.w1 = p->w1; a.b1 = p->b1; a.w2 = p->w2; a.b2 = p->b2; a.final_g = p->final_g;
    a.out = p->out; a.ws = p->ws; a.ph_lo = p->ph_lo; a.ph_hi = p->ph_hi; return a;
#else
    return Args{};
#endif
}
__device__ __forceinline__ int lane_id() { return __builtin_amdgcn_mbcnt_hi(~0u, __builtin_amdgcn_mbcnt_lo(~0u, 0)); }
__device__ __forceinline__ Ctx make_ctx(unsigned char* ws, int wv) {
    extern __shared__ __attribute__((aligned(16))) unsigned char lds_raw[];
    Ctx C; C.lds = (LAS unsigned char*)lds_raw; { int l_ = lane_id(); asm volatile("" : "+v"(l_)); C.lane = l_; } C.wave = wv; C.tid = wv * 64 + C.lane;
    C.G = gridDim.x; { const int bx = blockIdx.x; C.vcu = (C.G % 8 == 0) ? (bx % 8) * (C.G / 8) + bx / 8 : bx; }
    C.ws = ws; return C;
}
#ifndef PHASE_FN
#define PHASE_FN __device__ __forceinline__ void
#endif
#define GEMM_FN __device__ __forceinline__ void
PHASE_FN ph_prep(int wv) { const Args a = load_args(); Ctx C = make_ctx(a.ws, wv); phase_prep(a, C); }
PHASE_FN ph_u0(int wv) { const Args a = load_args(); Ctx C = make_ctx(a.ws, wv); phase_u0(a, C); }
GEMM_FN ph_gin(int l, int wv) { const Args a = load_args(); Ctx C = make_ctx(a.ws, wv); unsigned char* ws = a.ws;
    DenseOrder S{(const char*)(ws + WS_U), (const char*)(ws + WS_WIN) + (size_t)l * NPAD * 1024 * 2, NTOK / 256, NPAD / 256, (NTOK / 256) * (NPAD / 256), C.G, (int)blockIdx.x};
    EpiIn E{ws}; pg8::gemm_phase<EpiIn, DenseOrder, false, true>(C.lds, (LAS unsigned*)(C.lds + LDS_PARK), C.tid, S, E); }
PHASE_FN ph_mix1(int l, int wv) { const Args a = load_args(); Ctx C = make_ctx(a.ws, wv); phase_mix1(a, C, l); }
PHASE_FN ph_mix2(int l, int wv) { const Args a = load_args(); Ctx C = make_ctx(a.ws, wv); phase_mix2(a, C, l); }
GEMM_FN ph_gout(int l, int wv) { const Args a = load_args(); Ctx C = make_ctx(a.ws, wv); unsigned char* ws = a.ws;
    DenseOrder S{(const char*)(ws + WS_MIX), (const char*)(ws + WS_WOUT) + (size_t)l * 1024 * 1024 * 2, NTOK / 256, 4, (NTOK / 256) * 4, C.G, (int)blockIdx.x};
    EpiOut E{l == 0 ? a.x : (const float*)(ws + WS_H), (float*)(ws + WS_H), (const float*)(ws + WS_MOD) + (size_t)l * 4 * 6144 + 2048};
    pg8::gemm_phase<EpiOut, DenseOrder, false, true>(C.lds, (LAS unsigned*)(C.lds + LDS_PARK), C.tid, S, E); }
PHASE_FN ph_router(int l, int wv) { const Args a = load_args(); Ctx C = make_ctx(a.ws, wv); phase_router2(a, C, l); }
GEMM_FN ph_g1(int l, int wv) { const Args a = load_args(); Ctx C = make_ctx(a.ws, wv); unsigned char* ws = a.ws;
    LAS int* tab = (LAS int*)(C.lds + LDS_TAB); moe_table(C, l, tab);
    MoeOrder<true> S{tab, (const char*)(ws + WS_U), (const char*)(ws + WS_W1) + (size_t)l * 32 * 2048 * 1024 * 2, (const int*)(ws + WS_ROWTOK), C.G, C.vcu};
    EpiG1 E{(bf16_t*)(ws + WS_ACT), a.b1 + (size_t)l * 32 * 2048}; pg8::gemm_phase<EpiG1, MoeOrder<true>, true, true>(C.lds, (LAS unsigned*)(C.lds + LDS_PARK), C.tid, S, E); }
GEMM_FN ph_g2(int l, int wv) { const Args a = load_args(); Ctx C = make_ctx(a.ws, wv); unsigned char* ws = a.ws;
    LAS int* tab = (LAS int*)(C.lds + LDS_TAB); moe_table(C, l, tab);
    MoeOrder<false> S{tab, (const char*)(ws + WS_ACT), (const char*)(ws + WS_W2) + (size_t)l * 32 * 1024 * 1024 * 2, nullptr, C.G, C.vcu};
    EpiG2 E{(bf16_t*)(ws + WS_Y), a.b2 + (size_t)l * 32 * 1024}; pg8::gemm_phase<EpiG2, MoeOrder<false>, false, true>(C.lds, (LAS unsigned*)(C.lds + LDS_PARK), C.tid, S, E); }
PHASE_FN ph_combine(int l, int wv) { const Args a = load_args(); Ctx C = make_ctx(a.ws, wv); phase_combine(a, C, l); }

constexpr int NPHASES = 2 + 8 * DEPTH;
__global__ void __launch_bounds__(NTHREADS, 2) mega_fwd(Args a) {
#if MK_ONE_LAUNCH == 1
    cg::grid_group grid = cg::this_grid();
#define SEAM() do { __syncthreads(); grid.sync(); } while (0)
#elif MK_ONE_LAUNCH == 2
    extern __shared__ __attribute__((aligned(16))) unsigned char lds_k[];
    volatile LAS unsigned* bst = (volatile LAS unsigned*)((LAS unsigned char*)lds_k + LDS_BYTES - 64);
    const bool leader = (threadIdx.x == 0);
    if (leader) { bst[0] = 0u; bst[1] = 0u; }
    __syncthreads();
    const XcdBarrier xbar = xcd_barrier_post((unsigned*)(a.ws + WS_CTL) + CW_BAR, bst, leader);
#define SEAM() xcd_barrier(xbar, leader)
#else
#define SEAM() do { } while (0)
#endif
    const int lo = a.ph_lo, hi = a.ph_hi;
    const int wv = __builtin_amdgcn_readfirstlane((int)threadIdx.x >> 6);
#ifndef KINDMASK
#define KINDMASK 0xffffu
#endif
#define KON(k) (((KINDMASK) >> (k)) & 1u)
#ifndef REP_ID
#define REP_ID -1
#endif
#ifndef STAMP_K
#define STAMP_K -1
#endif
#define CW_STAMP 512
#ifndef STAMP_OFF
#define STAMP_OFF 0.0f
#define STAMP_SCALE 5e-3f
#endif
#define RUN(kind, id, call) do { if (KON(kind) && lo <= (id) && (id) < hi) { call; if ((id) == REP_ID) { __syncthreads(); call; } if ((id) + 1 < hi || STAMP_K >= 0) SEAM(); \
        if (STAMP_K >= 0 && blockIdx.x == 0 && threadIdx.x == 0) { const unsigned long long _t = __builtin_amdgcn_s_memrealtime(); __hip_atomic_store((unsigned long long*)(a.ws + WS_CTL) + CW_STAMP / 2 + 1 + (id), _t, __ATOMIC_RELAXED, __HIP_MEMORY_SCOPE_AGENT); } } } while (0)
    if (STAMP_K >= 0) { if (blockIdx.x == 0 && threadIdx.x == 0) { const unsigned long long _t = __builtin_amdgcn_s_memrealtime(); __hip_atomic_store((unsigned long long*)(a.ws + WS_CTL) + CW_STAMP / 2, _t, __ATOMIC_RELAXED, __HIP_MEMORY_SCOPE_AGENT); } }
    RUN(0, 0, ph_prep(wv));
    RUN(1, 1, ph_u0(wv));
    RUN(2, 2, ph_gin(0, wv)); RUN(3, 3, ph_mix1(0, wv)); RUN(4, 4, ph_mix2(0, wv)); RUN(5, 5, ph_gout(0, wv)); RUN(6, 6, ph_router(0, wv)); RUN(7, 7, ph_g1(0, wv)); RUN(8, 8, ph_g2(0, wv)); RUN(9, 9, ph_combine(0, wv));
    RUN(2, 10, ph_gin(1, wv)); RUN(3, 11, ph_mix1(1, wv)); RUN(4, 12, ph_mix2(1, wv)); RUN(5, 13, ph_gout(1, wv)); RUN(6, 14, ph_router(1, wv)); RUN(7, 15, ph_g1(1, wv)); RUN(8, 16, ph_g2(1, wv)); RUN(9, 17, ph_combine(1, wv));
    if (STAMP_K >= 0) {
        SEAM();
        const unsigned long long* st = (const unsigned long long*)(a.ws + WS_CTL) + CW_STAMP / 2;
        const unsigned long long t0 = __hip_atomic_load(st, __ATOMIC_RELAXED, __HIP_MEMORY_SCOPE_AGENT), tk = __hip_atomic_load(st + 1 + (STAMP_K >= 0 ? STAMP_K : 0), __ATOMIC_RELAXED, __HIP_MEMORY_SCOPE_AGENT), te = __hip_atomic_load(st + 18, __ATOMIC_RELAXED, __HIP_MEMORY_SCOPE_AGENT);
        const float f = (float)(tk - t0) / (float)(te - t0); const float fo = f - STAMP_OFF; const float scl = 1.0f + sqrtf(STAMP_SCALE * (fo > 0.f ? fo : 0.f));
        for (size_t i = (size_t)blockIdx.x * NTHREADS + threadIdx.x; i < (size_t)NTOK * D / 4; i += (size_t)gridDim.x * NTHREADS) { f32x4 v = ((f32x4*)a.out)[i]; ((f32x4*)a.out)[i] = v * scl; }
    }
}

extern "C" void kernel_launch(void* const* d_in, const int* in_sizes, int n_in, void* d_out, int out_size, void* d_ws, size_t ws_size, hipStream_t stream) {
    static int grid = 0;
    if (grid == 0) {
        if (n_in != 20 || out_size != NTOK * D || ws_size < WS_END) { fprintf(stderr, "kernel_launch: unexpected shapes: n_in %d out %d ws %zu (need %zu)\n", n_in, out_size, ws_size, (size_t)WS_END); grid = -1; return; }
        int dev = 0, cus = 0, per_cu = 0;
        hipGetDevice(&dev); hipDeviceGetAttribute(&cus, hipDeviceAttributeMultiprocessorCount, dev);
        if (hipFuncSetAttribute((const void*)mega_fwd, hipFuncAttributeMaxDynamicSharedMemorySize, LDS_BYTES) != hipSuccess) { fprintf(stderr, "kernel_launch: hipFuncSetAttribute failed\n"); grid = -1; return; }
        hipOccupancyMaxActiveBlocksPerMultiprocessor(&per_cu, (const void*)mega_fwd, NTHREADS, LDS_BYTES);
        (void)hipGetLastError();
        if (per_cu < 1) fprintf(stderr, "kernel_launch: occupancy query says %d blocks per CU\n", per_cu);
        grid = cus;
    }
    if (grid < 0) return;
    hipMemsetAsync((char*)d_ws + WS_CTL, 0, CTL_BYTES, stream);
    Args a{};
    a.x = (const float*)d_in[0]; a.c = (const float*)d_in[1]; a.pos = (const int*)d_in[2]; a.w_ada = (const float*)d_in[3]; a.b_ada = (const float*)d_in[4];
    a.norm1_g = (const float*)d_in[5]; a.norm2_g = (const float*)d_in[6]; a.w_in = (const float*)d_in[7]; a.w_out = (const float*)d_in[8]; a.pool_w = (const float*)d_in[9];
    a.pool_scale = (const float*)d_in[10]; a.hgrn_g = (const float*)d_in[11]; a.lb_logits = (const float*)d_in[12]; a.w_router = (const float*)d_in[13]; a.b_router = (const float*)d_in[14];
    a.w1 = (const float*)d_in[15]; a.b1 = (const float*)d_in[16]; a.w2 = (const float*)d_in[17]; a.b2 = (const float*)d_in[18]; a.final_g = (const float*)d_in[19];
    a.out = (float*)d_out; a.ws = (unsigned char*)d_ws;
#if MK_ONE_LAUNCH == 1
    a.ph_lo = 0; a.ph_hi = NPHASES;
    void* args[] = {&a};
    hipError_t e = hipLaunchCooperativeKernel((const void*)mega_fwd, dim3(grid), dim3(NTHREADS), args, LDS_BYTES, stream);
    if (e != hipSuccess) fprintf(stderr, "cooperative launch failed: %s (grid %d)\n", hipGetErrorString(e), grid);
#elif MK_ONE_LAUNCH == 2
    a.ph_lo = 0; a.ph_hi = NPHASES;
    hipLaunchKernelGGL(mega_fwd, dim3(grid), dim3(NTHREADS), LDS_BYTES, stream, a);
#else
    for (int p = 0; p < NPHASES; ++p) { a.ph_lo = p; a.ph_hi = p + 1; hipLaunchKernelGGL(mega_fwd, dim3(grid), dim3(NTHREADS), LDS_BYTES, stream, a); }
#endif
}
```

```cpp
#include <hip/hip_runtime.h>
#include <hip/hip_cooperative_groups.h>
#include <cstdio>
#include <cstdint>
namespace cg = cooperative_groups;

#ifndef MK_ONE_LAUNCH
#define PG8_USE_SP2 1
#define MK_ONE_LAUNCH 2
#endif

#define LAS __attribute__((address_space(3)))
typedef unsigned short bf16_t;
typedef short bf16x8 __attribute__((ext_vector_type(8)));
typedef float f32x4 __attribute__((ext_vector_type(4)));
typedef float f32x2 __attribute__((ext_vector_type(2)));
typedef unsigned u32x4 __attribute__((ext_vector_type(4)));
typedef unsigned u32x2 __attribute__((ext_vector_type(2)));

constexpr int D = 1024, NBATCH = 4, SEQ = 4096, NTOK = NBATCH * SEQ, DEPTH = 2;
constexpr int D_IN = 2372, NPAD = 2560;
constexpr int NE = 32, TOPK = 4, FF = 1024;
constexpr int NWAVES = 8, NTHREADS = 512;
constexpr float EPS = 1e-6f;
constexpr int ROWCAP = 73728;

constexpr size_t MiB = 1u << 20;
constexpr size_t WS_CTL = 0, CTL_BYTES = 1 * MiB;
constexpr size_t WS_MOD = 1 * MiB;
constexpr size_t WS_ROPEC = 2 * MiB;
constexpr size_t WS_ROPES = 4 * MiB;
constexpr size_t WS_WIN = 6 * MiB;
constexpr size_t WS_WOUT = 16 * MiB;
constexpr size_t WS_ROWTOK = 20 * MiB;
constexpr size_t WS_EIDX = 22 * MiB;
constexpr size_t WS_SLOT = 22 * MiB + 256 * 1024;
constexpr size_t WS_GATE = 22 * MiB + 512 * 1024;
constexpr size_t WS_WI = 23 * MiB;
constexpr size_t WS_WRH = 23 * MiB + 256 * 1024;
constexpr size_t WS_WRL = 23 * MiB + 512 * 1024;
constexpr size_t WS_KI = 24 * MiB;
constexpr size_t WS_K = 26 * MiB;
constexpr size_t WS_V = 30 * MiB;
constexpr size_t WS_QI = 34 * MiB;
constexpr size_t WS_Q = 42 * MiB;
constexpr size_t WS_UB = 58 * MiB;
constexpr size_t WS_HG = 74 * MiB;
constexpr size_t WS_SEL = 138 * MiB;
constexpr size_t WS_HL = 154 * MiB;
constexpr size_t WS_HD = 170 * MiB;
constexpr size_t WS_MIX = 171 * MiB;
constexpr size_t WS_U = 203 * MiB;
constexpr size_t WS_H = 235 * MiB;
constexpr size_t WS_W1 = 299 * MiB;
constexpr size_t WS_W2 = 555 * MiB;
constexpr size_t WS_ACT = 683 * MiB;
constexpr size_t WS_Y = 827 * MiB;
constexpr size_t WS_END = 971 * MiB;
constexpr int CW_CNT = 1024;
constexpr int CW_BAR = 8192;

constexpr int LDS_BYTES = 147456;
constexpr int LDS_TAB = 131072;
constexpr int LDS_PARK = 131072 + 1024;

__device__ __forceinline__ unsigned f2bf(float f) { unsigned u = __builtin_bit_cast(unsigned, f); return (u + 0x7fffu + ((u >> 16) & 1u)) >> 16; }
typedef __bf16 bf16x2_t __attribute__((ext_vector_type(2)));
__device__ __forceinline__ unsigned cvt_pk_bf16(float lo, float hi) { const f32x2 v = {lo, hi}; const bf16x2_t b = __builtin_convertvector(v, bf16x2_t); return __builtin_bit_cast(unsigned, b); }
__device__ __forceinline__ unsigned pk2(float lo, float hi) { return cvt_pk_bf16(lo, hi); }
__device__ __forceinline__ float bf2f(unsigned short b) { return __builtin_bit_cast(float, ((unsigned)b) << 16); }
__device__ __forceinline__ float bflo(unsigned w) { return __builtin_bit_cast(float, w << 16); }
__device__ __forceinline__ float bfhi(unsigned w) { return __builtin_bit_cast(float, w & 0xffff0000u); }
__device__ __forceinline__ float wave_sum(float v) {
#pragma unroll
    for (int o = 1; o < 64; o <<= 1) v += __shfl_xor(v, o);
    return v;
}
__device__ __forceinline__ float wave_max(float v) {
#pragma unroll
    for (int o = 1; o < 64; o <<= 1) v = fmaxf(v, __shfl_xor(v, o));
    return v;
}
__device__ __forceinline__ float sigmoidf_(float z) { return __builtin_amdgcn_rcpf(1.0f + __expf(-z)); }
__device__ __forceinline__ float siluf_(float z) { return z * __builtin_amdgcn_rcpf(1.0f + __expf(-z)); }

namespace pg8 {
constexpr int BM = 256, BK = 64, HALF = 128, HTB = HALF * BK * 2, STAGE_BYTES = 8 * HTB;
constexpr int KD = 1024, NKT = KD / BK;
__host__ __device__ __forceinline__ int lds_byte(int r, int c) { const int st = (r >> 4) * 2 + (c >> 5), rr = r & 15, cc = c & 31, ob = rr * 64 + cc * 2; return st * 1024 + (ob ^ (((ob >> 9) & 1) << 5)); }
__host__ __device__ __forceinline__ void stage_rc(int b, int& R, int& C) { const int st = b / 1024, sb = b % 1024, swz = sb ^ (((sb >> 9) & 1) << 5); R = (st >> 1) * 16 + swz / 64; C = (st & 1) * 32 + (swz % 64) / 2; }

struct Unit { const char* A; const char* B; const int* ridx; int nvalid; int row0, pn, e, b; };

template <class Epi, class Sched, bool GATHER, bool ALIGN_EPI>
__device__ __forceinline__ void gemm_phase(LAS unsigned char* lds, LAS unsigned* park, int tid_in, const Sched& S, const Epi& E) {
    const int tid = tid_in, wid = __builtin_amdgcn_readfirstlane(tid >> 6), lane = tid & 63, wr = wid >> 2, wc = wid & 3, fr = lane & 15, fq = lane >> 4;
    constexpr int K = KD, nt = NKT;
    unsigned voffB[2], vA[2][2];
#pragma unroll
    for (int i = 0; i < 2; ++i) { int R, C; stage_rc(tid * 16 + i * 8192, R, C); voffB[i] = (unsigned)(R * K + C) * 2u; }
    constexpr size_t kstep = (size_t)(BK * 2);
    constexpr size_t hstep = (size_t)HALF * K * 2;
    const unsigned ldsw = (unsigned)wid * 1024u;
    const int aoff = lds_byte(wr * 64 + fr, fq * 8), boff = lds_byte(wc * 32 + fr, fq * 8);
#define PG8_SA(b, h) (((b) * 2 + (h)) * HTB)
#define PG8_SB(b, h) ((4 + (b) * 2 + (h)) * HTB)
#define PG8_STAGE(bufoff, gbase, voff) do { _Pragma("unroll") for (int _i = 0; _i < 2; ++_i) \
        __builtin_amdgcn_global_load_lds((const unsigned*)((const char*)(gbase) + (voff)[_i]), (LAS unsigned*)(lds + (bufoff) + ldsw + _i * 8192), 16, 0, 0); } while (0)
#define PG8_LDA(dst, b, h) do { _Pragma("unroll") for (int m = 0; m < 4; ++m) _Pragma("unroll") for (int k = 0; k < 2; ++k) dst[m][k] = *(const LAS bf16x8*)(lds + PG8_SA(b, h) + aoff + m * 2048 + k * 1024); } while (0)
#define PG8_LDB(dst, b, h) do { _Pragma("unroll") for (int n = 0; n < 2; ++n) _Pragma("unroll") for (int k = 0; k < 2; ++k) dst[n][k] = *(const LAS bf16x8*)(lds + PG8_SB(b, h) + boff + n * 2048 + k * 1024); } while (0)
#define PG8_MMA(ai, bj, At, Bt) do { __builtin_amdgcn_s_setprio(1); _Pragma("unroll") for (int m = 0; m < 4; ++m) _Pragma("unroll") for (int n = 0; n < 2; ++n) _Pragma("unroll") for (int k = 0; k < 2; ++k) \
        acc[ai][bj][m][n] = __builtin_amdgcn_mfma_f32_16x16x32_bf16(Bt[n][k], At[m][k], acc[ai][bj][m][n], 0, 0, 0); __builtin_amdgcn_s_setprio(0); } while (0)
#define PG8_WAIT_V(n) asm volatile("s_waitcnt vmcnt(" #n ")" ::: "memory")
#define PG8_WAIT_L(n) asm volatile("s_waitcnt lgkmcnt(" #n ")" ::: "memory")
#define PG8_BAR __builtin_amdgcn_s_barrier()
#define PG8_SCHED __builtin_amdgcn_sched_barrier(0)
#define PG8_OFFS(dst, u) do { _Pragma("unroll") for (int _h = 0; _h < 2; ++_h) _Pragma("unroll") for (int _i = 0; _i < 2; ++_i) { \
        int _R, _C; stage_rc(tid * 16 + _i * 8192, _R, _C); const int _rr = _h * HALF + _R; \
        if constexpr (GATHER) { const int _ix = (u).ridx[_rr < (u).nvalid ? _rr : 0]; dst[_h][_i] = (unsigned)(_ix * K + _C) * 2u; } \
        else dst[_h][_i] = (unsigned)(_rr * K + _C) * 2u; } } while (0)
    Unit cur, nxt; int ui = 0;
    if (!S.next(0, cur)) return;
    f32x4 acc[2][2][4][2];
#pragma unroll
    for (int a = 0; a < 2; ++a)
#pragma unroll
        for (int b = 0; b < 2; ++b)
#pragma unroll
            for (int m = 0; m < 4; ++m)
#pragma unroll
                for (int n = 0; n < 2; ++n) acc[a][b][m][n] = (f32x4){0.f, 0.f, 0.f, 0.f};
    bf16x8 At[4][2], B0[2][2], B1[2][2];
    PG8_OFFS(vA, cur);
    const char* cA = cur.A; const char* cB = cur.B;
#if !defined(PG8_USE_SP2) || PG8_USE_SP2
    PG8_STAGE(PG8_SB(0, 0), cB, voffB); PG8_STAGE(PG8_SB(0, 1), cB + hstep, voffB); PG8_STAGE(PG8_SA(0, 0), cA, vA[0]); PG8_STAGE(PG8_SA(0, 1), cA, vA[1]);
    if (wr == 1) PG8_BAR;
    PG8_WAIT_V(2); PG8_BAR;
    PG8_STAGE(PG8_SB(1, 0), cB + kstep, voffB); PG8_STAGE(PG8_SA(1, 0), cA + kstep, vA[0]); PG8_STAGE(PG8_SB(1, 1), cB + hstep + kstep, voffB);
    PG8_WAIT_V(6); PG8_BAR;
#else
    PG8_STAGE(PG8_SB(0, 0), cB, voffB); PG8_STAGE(PG8_SA(0, 0), cA, vA[0]); PG8_STAGE(PG8_SB(0, 1), cB + hstep, voffB); PG8_STAGE(PG8_SA(0, 1), cA, vA[1]);
    if (wr == 1) PG8_BAR;
    PG8_WAIT_V(4); PG8_BAR;
    PG8_STAGE(PG8_SB(1, 0), cB + kstep, voffB); PG8_STAGE(PG8_SA(1, 0), cA + kstep, vA[0]); PG8_STAGE(PG8_SB(1, 1), cB + hstep + kstep, voffB);
    PG8_WAIT_V(6); PG8_BAR;
#endif
    for (;;) {
        const bool has_next = S.next(ui + 1, nxt);
        const char* nA = has_next ? nxt.A : cA; const char* nB = has_next ? nxt.B : cB;
        if constexpr (GATHER) {
            unsigned nv[2][2];
            if (has_next) { PG8_OFFS(nv, nxt); } else {
#pragma unroll
                for (int h = 0; h < 2; ++h) { nv[h][0] = vA[h][0]; nv[h][1] = vA[h][1]; } }
            *(LAS u32x4*)(park + tid * 4) = (u32x4){nv[0][0], nv[0][1], nv[1][0], nv[1][1]};
        }
        for (int t = 0; t < nt; t += 2) {
            const bool last = (t == nt - 2);
            const char* a1 = cA + (size_t)(t + 1) * kstep;
            const char* a2 = last ? nA : cA + (size_t)(t + 2) * kstep; const char* b2 = last ? nB : cB + (size_t)(t + 2) * kstep;
            const char* a3 = a2 + kstep; const char* b3 = b2 + kstep;
#ifndef PG8_USE_SP2
#define PG8_USE_SP2 1
#endif
            if constexpr (PG8_USE_SP2) {
            PG8_LDB(B0, 0, 0); PG8_LDB(B1, 0, 1); PG8_SCHED; PG8_LDA(At, 0, 0); PG8_STAGE(PG8_SA(1, 1), a1, vA[1]);
            if constexpr (GATHER) { if (last) { const u32x4 pv = *(const LAS u32x4*)(park + tid * 4); vA[0][0] = pv.x; vA[0][1] = pv.y; vA[1][0] = pv.z; vA[1][1] = pv.w; } }
            PG8_WAIT_V(8); PG8_WAIT_L(0); PG8_BAR; PG8_MMA(0, 0, At, B0); PG8_MMA(0, 1, At, B1); PG8_BAR; PG8_SCHED;
            PG8_LDA(At, 0, 1); PG8_STAGE(PG8_SB(0, 0), b2, voffB); PG8_STAGE(PG8_SB(0, 1), b2 + hstep, voffB); PG8_STAGE(PG8_SA(0, 0), a2, vA[0]);
            PG8_WAIT_V(8); PG8_WAIT_L(0); PG8_BAR; PG8_MMA(1, 0, At, B0); PG8_MMA(1, 1, At, B1); PG8_BAR; PG8_SCHED;
            PG8_LDB(B0, 1, 0); PG8_LDB(B1, 1, 1); PG8_SCHED; PG8_LDA(At, 1, 0); PG8_STAGE(PG8_SA(0, 1), a2, vA[1]);
            PG8_WAIT_V(8); PG8_WAIT_L(0); PG8_BAR; PG8_MMA(0, 0, At, B0); PG8_MMA(0, 1, At, B1); PG8_BAR; PG8_SCHED;
            PG8_LDA(At, 1, 1); PG8_STAGE(PG8_SB(1, 0), b3, voffB); PG8_STAGE(PG8_SB(1, 1), b3 + hstep, voffB); PG8_STAGE(PG8_SA(1, 0), a3, vA[0]);
            PG8_WAIT_V(8); PG8_WAIT_L(0); PG8_BAR; PG8_MMA(1, 0, At, B0); PG8_MMA(1, 1, At, B1); PG8_BAR; PG8_SCHED;
                    } else {
            PG8_LDB(B0, 0, 0); PG8_SCHED; PG8_LDA(At, 0, 0); PG8_STAGE(PG8_SA(1, 1), a1, vA[1]);
            if constexpr (GATHER) { if (last) { const u32x4 pv = *(const LAS u32x4*)(park + tid * 4); vA[0][0] = pv.x; vA[0][1] = pv.y; vA[1][0] = pv.z; vA[1][1] = pv.w; } }
            PG8_WAIT_L(8); PG8_BAR; PG8_WAIT_L(0); PG8_MMA(0, 0, At, B0); PG8_BAR; PG8_SCHED;
            PG8_LDB(B1, 0, 1); PG8_STAGE(PG8_SB(0, 0), b2, voffB);
            PG8_BAR; PG8_WAIT_L(0); PG8_MMA(0, 1, At, B1); PG8_BAR;
            PG8_LDA(At, 0, 1); PG8_STAGE(PG8_SA(0, 0), a2, vA[0]);
            PG8_BAR; PG8_WAIT_L(0); PG8_MMA(1, 0, At, B0); PG8_BAR; PG8_SCHED;
            PG8_STAGE(PG8_SB(0, 1), b2 + hstep, voffB);
            PG8_WAIT_V(6); PG8_BAR; PG8_MMA(1, 1, At, B1); PG8_BAR;
            PG8_LDB(B0, 1, 0); PG8_SCHED; PG8_LDA(At, 1, 0); PG8_STAGE(PG8_SA(0, 1), a2, vA[1]);
            PG8_WAIT_L(8); PG8_BAR; PG8_WAIT_L(0); PG8_MMA(0, 0, At, B0); PG8_BAR; PG8_SCHED;
            PG8_LDB(B1, 1, 1); PG8_STAGE(PG8_SB(1, 0), b3, voffB);
            PG8_BAR; PG8_WAIT_L(0); PG8_MMA(0, 1, At, B1); PG8_BAR;
            PG8_LDA(At, 1, 1); PG8_STAGE(PG8_SA(1, 0), a3, vA[0]);
            PG8_BAR; PG8_WAIT_L(0); PG8_MMA(1, 0, At, B0); PG8_BAR; PG8_SCHED;
            PG8_STAGE(PG8_SB(1, 1), b3 + hstep, voffB);
            PG8_WAIT_V(6); PG8_BAR; PG8_MMA(1, 1, At, B1); PG8_BAR;
            }
        }
        if constexpr (ALIGN_EPI) { if (wr == 0) PG8_BAR; }
#ifndef EPIREP
#define EPIREP 1
#endif
        for (int er = 0; er < Epi::REP; ++er) { int fr2 = fr, fq2 = fq; asm volatile("" : "+v"(fr2), "+v"(fq2)); E(acc, cur, wr, wc, fr2, fq2); }
        if (!has_next) break;
#pragma unroll
        for (int a = 0; a < 2; ++a)
#pragma unroll
            for (int b = 0; b < 2; ++b)
#pragma unroll
                for (int m = 0; m < 4; ++m)
#pragma unroll
                    for (int n = 0; n < 2; ++n) acc[a][b][m][n] = (f32x4){0.f, 0.f, 0.f, 0.f};
        cur = nxt; cA = nA; cB = nB; ++ui;
        if constexpr (ALIGN_EPI) { if (wr == 1) PG8_BAR; }
    }
    PG8_WAIT_V(0);
    if constexpr (!ALIGN_EPI) { if (wr == 0) PG8_BAR; }
    PG8_BAR;
#undef PG8_SA
#undef PG8_SB
#undef PG8_STAGE
#undef PG8_LDA
#undef PG8_LDB
#undef PG8_MMA
#undef PG8_WAIT_V
#undef PG8_WAIT_L
#undef PG8_BAR
#undef PG8_SCHED
#undef PG8_OFFS
}
}

struct Args {
    const float* x; const float* c; const int* pos; const float* w_ada; const float* b_ada; const float* norm1_g; const float* norm2_g;
    const float* w_in; const float* w_out; const float* pool_w; const float* pool_scale; const float* hgrn_g; const float* lb_logits;
    const float* w_router; const float* b_router; const float* w1; const float* b1; const float* w2; const float* b2; const float* final_g;
    float* out; unsigned char* ws; int ph_lo, ph_hi;
};

struct Ctx {
    LAS unsigned char* lds;
    int tid, lane, wave, G, vcu;
    unsigned char* ws;
};

struct DenseOrder {
    const char* A; const char* B; int nM, nN, nwg, G, c;
    __device__ __forceinline__ bool next(int i, pg8::Unit& u) const {
        const long L = (long)i * G + c; if (L >= nwg) return false;
        int wgid = (int)L; { const int q = nwg / 8, r = nwg % 8, xcd = wgid % 8, off = wgid / 8; wgid = (xcd < r ? xcd * (q + 1) : r * (q + 1) + (xcd - r) * q) + off; }
        const int nig = 8 * nN, gid = wgid / nig, fm = gid * 8, gsz = (nM - fm) < 8 ? (nM - fm) : 8;
        const int pm = fm + ((wgid % nig) % gsz), pn = (wgid % nig) / gsz;
        u.A = A + (size_t)pm * 256 * pg8::KD * 2; u.B = B + (size_t)pn * 256 * pg8::KD * 2; u.ridx = nullptr; u.nvalid = 256; u.row0 = pm * 256; u.pn = pn; u.e = 0; u.b = pm >> 4;
        return true;
    }
};

template <bool FIRST> struct MoeOrder {
    LAS const int* tab; const char* A; const char* B; const int* rowtok; int G, c;
    static constexpr int NTN = FIRST ? 8 : 4;
    __device__ __forceinline__ bool next(int i, pg8::Unit& u) const {
#ifndef KREP
#define KREP 1
#endif
        const int P = tab[32]; const long L = (long)(i / (FIRST ? 1 : KREP)) * G + c; if (L >= (long)P * NTN) return false;
        const int p = (int)(L / NTN), nt = (int)(L % NTN);
        int e = 0;
#pragma unroll 1
        for (int k = 1; k < 32; ++k) e = (tab[k] <= p) ? k : e;
        const int mt = p - tab[e], cnt = tab[33 + e];
        if (FIRST) { u.A = A; u.ridx = rowtok + e * NTOK + mt * 256; u.nvalid = (cnt - mt * 256) < 256 ? (cnt - mt * 256) : 256; u.B = B + ((size_t)e * 2048 + nt * 256) * pg8::KD * 2; }
        else { u.A = A + (size_t)p * 256 * pg8::KD * 2; u.ridx = nullptr; u.nvalid = 256; u.B = B + ((size_t)e * 1024 + nt * 256) * pg8::KD * 2; }
        u.row0 = p * 256; u.pn = nt; u.e = e; u.b = (FIRST ? 1 : ((i % KREP) == KREP - 1));
        return true;
    }
};

#ifndef EPIREP_IN
#define EPIREP_IN 1
#endif
#ifndef EPIREP_G1
#define EPIREP_G1 1
#endif
#ifndef EPIREP_G2
#define EPIREP_G2 1
#endif
struct EpiIn {
    static constexpr int REP = EPIREP_IN;
    unsigned char* ws;
    __device__ __forceinline__ void operator()(const f32x4 (&acc)[2][2][4][2], const pg8::Unit& u, int wr, int wc, int fr, int fq) const {
        const int pn = u.pn;
        const float* rc = (const float*)(ws + WS_ROPEC); const float* rs = (const float*)(ws + WS_ROPES);
        const bool rope = (pn <= 1) || (pn == 3) || (pn == 2 && wc < 2) || (pn == 4 && wc == 0);
#pragma unroll
        for (int ai = 0; ai < 2; ++ai)
#pragma unroll
            for (int m = 0; m < 4; ++m) {
                const int r = u.row0 + ai * 128 + wr * 64 + m * 16 + fr;
                if (rope) {
                    bf16_t* dst; float scl = 1.f;
                    if (pn <= 1) { dst = (bf16_t*)(ws + WS_Q) + (size_t)r * 512 + (pn * 4 + wc) * 64; scl = 0.125f; }
                    else if (pn == 2) dst = (bf16_t*)(ws + WS_K) + (size_t)r * 128 + wc * 64;
                    else if (pn == 3) dst = (bf16_t*)(ws + WS_QI) + (size_t)r * 256 + wc * 64;
                    else dst = (bf16_t*)(ws + WS_KI) + (size_t)r * 64;
                    const f32x4 c0 = *(const f32x4*)(rc + (size_t)r * 32 + 8 * fq), c1 = *(const f32x4*)(rc + (size_t)r * 32 + 8 * fq + 4), s0 = *(const f32x4*)(rs + (size_t)r * 32 + 8 * fq), s1 = *(const f32x4*)(rs + (size_t)r * 32 + 8 * fq + 4);
                    const f32x4 x10 = acc[ai][0][m][0], x11 = acc[ai][0][m][1], x20 = acc[ai][1][m][0], x21 = acc[ai][1][m][1];
                    const f32x4 o10 = (x10 * c0 - x20 * s0) * scl, o11 = (x11 * c1 - x21 * s1) * scl, o20 = (x20 * c0 + x10 * s0) * scl, o21 = (x21 * c1 + x11 * s1) * scl;
                    u32x4 w1v, w2v; w1v.x = pk2(o10[0], o10[1]); w1v.y = pk2(o10[2], o10[3]); w1v.z = pk2(o11[0], o11[1]); w1v.w = pk2(o11[2], o11[3]);
                    w2v.x = pk2(o20[0], o20[1]); w2v.y = pk2(o20[2], o20[3]); w2v.z = pk2(o21[0], o21[1]); w2v.w = pk2(o21[2], o21[3]);
                    *(u32x4*)(dst + 8 * fq) = w1v; *(u32x4*)(dst + 32 + 8 * fq) = w2v;
                } else if (pn == 2) {
#pragma unroll
                    for (int bj = 0; bj < 2; ++bj) { const f32x4 a0 = acc[ai][bj][m][0], a1 = acc[ai][bj][m][1]; u32x4 w; w.x = pk2(a0[0], a0[1]); w.y = pk2(a0[2], a0[3]); w.z = pk2(a1[0], a1[1]); w.w = pk2(a1[2], a1[3]);
                        *(u32x4*)((bf16_t*)(ws + WS_V) + (size_t)r * 128 + bj * 64 + (wc - 2) * 32 + 8 * fq) = w; }
                } else if (pn == 4) {
                    if (wc == 1 && fq == 0) *(f32x4*)((float*)(ws + WS_WI) + (size_t)r * 4) = acc[ai][0][m][0] * 0.0625f;
                } else {
                    float* p = (pn == 5) ? (float*)(ws + WS_UB) + (size_t)r * 256 + wc * 32 + 8 * fq : (float*)(ws + WS_HG) + (size_t)r * 1024 + (pn - 6) * 256 + wc * 32 + 8 * fq;
#pragma unroll
                    for (int bj = 0; bj < 2; ++bj) { *(f32x4*)(p + bj * 128) = acc[ai][bj][m][0]; *(f32x4*)(p + bj * 128 + 4) = acc[ai][bj][m][1]; }
                }
            }
    }
};
struct EpiOut {
    static constexpr int REP = 1;
    const float* hin; float* hout; const float* gate;
    __device__ __forceinline__ void operator()(const f32x4 (&acc)[2][2][4][2], const pg8::Unit& u, int wr, int wc, int fr, int fq) const {
        const int col0 = u.pn * 256 + wc * 32 + 8 * fq; const float* gp = gate + (size_t)u.b * 6144 + col0;
        f32x4 gv[2][2];
#pragma unroll
        for (int bj = 0; bj < 2; ++bj)
#pragma unroll
            for (int n = 0; n < 2; ++n) gv[bj][n] = *(const f32x4*)(gp + bj * 128 + n * 4);
#pragma unroll
        for (int ai = 0; ai < 2; ++ai)
#pragma unroll
            for (int m = 0; m < 4; ++m) { const size_t off = (size_t)(u.row0 + ai * 128 + wr * 64 + m * 16 + fr) * D + col0;
#pragma unroll
                for (int bj = 0; bj < 2; ++bj)
#pragma unroll
                    for (int n = 0; n < 2; ++n) { const f32x4 hv = *(const f32x4*)(hin + off + bj * 128 + n * 4); *(f32x4*)(hout + off + bj * 128 + n * 4) = hv + gv[bj][n] * acc[ai][bj][m][n]; }
                asm volatile("" ::: "memory"); }
    }
};
struct EpiG1 {
    static constexpr int REP = EPIREP_G1;
    bf16_t* act; const float* b1l;
    __device__ __forceinline__ void operator()(const f32x4 (&acc)[2][2][4][2], const pg8::Unit& u, int wr, int wc, int fr, int fq) const {
        const int ja0 = u.pn * 128 + wc * 32 + 8 * fq; const float* bp = b1l + (size_t)u.e * 2048 + 2 * ja0;
        f32x4 bg[2], bl[2];
#pragma unroll
        for (int n = 0; n < 2; ++n) { const f32x4 t0 = *(const f32x4*)(bp + 8 * n), t1 = *(const f32x4*)(bp + 8 * n + 4); bg[n] = (f32x4){t0[0], t0[2], t1[0], t1[2]}; bl[n] = (f32x4){t0[1], t0[3], t1[1], t1[3]}; }
#pragma unroll
        for (int ai = 0; ai < 2; ++ai)
#pragma unroll
            for (int m = 0; m < 4; ++m) { float o[8];
#pragma unroll
                for (int n = 0; n < 2; ++n) { const f32x4 hg = acc[ai][0][m][n] + bg[n], hl = acc[ai][1][m][n] + bl[n];
#pragma unroll
                    for (int j = 0; j < 4; ++j) { const float xg = fminf(hg[j], 7.0f), xl = fminf(fmaxf(hl[j], -7.0f), 7.0f); o[4 * n + j] = xg * sigmoidf_(1.702f * xg) * (xl + 1.0f); } }
                u32x4 w; w.x = pk2(o[0], o[1]); w.y = pk2(o[2], o[3]); w.z = pk2(o[4], o[5]); w.w = pk2(o[6], o[7]);
                *(u32x4*)(act + (size_t)(u.row0 + ai * 128 + wr * 64 + m * 16 + fr) * FF + ja0) = w; }
    }
};
struct EpiG2 {
    static constexpr int REP = EPIREP_G2;
    bf16_t* y; const float* b2l;
    __device__ __forceinline__ void operator()(const f32x4 (&acc)[2][2][4][2], const pg8::Unit& u, int wr, int wc, int fr, int fq) const {
        if (!u.b) return;
        const int col0 = u.pn * 256 + wc * 32 + 8 * fq; const float* bp = b2l + (size_t)u.e * 1024 + col0;
        f32x4 bv[2][2];
#pragma unroll
        for (int bj = 0; bj < 2; ++bj)
#pragma unroll
            for (int n = 0; n < 2; ++n) bv[bj][n] = *(const f32x4*)(bp + bj * 128 + n * 4);
#pragma unroll
        for (int ai = 0; ai < 2; ++ai)
#pragma unroll
            for (int m = 0; m < 4; ++m) { bf16_t* rowp = y + (size_t)(u.row0 + ai * 128 + wr * 64 + m * 16 + fr) * D + col0;
#pragma unroll
                for (int bj = 0; bj < 2; ++bj) { const f32x4 v0 = acc[ai][bj][m][0] + bv[bj][0], v1 = acc[ai][bj][m][1] + bv[bj][1];
                    u32x4 w; w.x = pk2(v0[0], v0[1]); w.y = pk2(v0[2], v0[3]); w.z = pk2(v1[0], v1[1]); w.w = pk2(v1[2], v1[3]); *(u32x4*)(rowp + bj * 128) = w; } }
    }
};
__device__ __forceinline__ int slot32(int d) { return 16 * ((d >> 2) & 1) + 4 * ((d >> 3) & 3) + (d & 3); }
__device__ __forceinline__ int win_dest(int s) {
    if (s < 512) { const int hd = s >> 6, d64 = s & 63; return 256 * (hd >> 2) + 128 * (d64 >> 5) + 32 * (hd & 3) + slot32(d64 & 31); }
    if (s < 640) { const int hd = (s - 512) >> 6, d64 = s & 63; return 512 + 128 * (d64 >> 5) + 32 * hd + slot32(d64 & 31); }
    if (s < 768) { const int v = s - 640; return 512 + 128 * (v >> 6) + 32 * (2 + ((v & 63) >> 5)) + slot32(v & 31); }
    if (s < 1024) { const int hd = (s - 768) >> 6, d64 = s & 63; return 768 + 128 * (d64 >> 5) + 32 * hd + slot32(d64 & 31); }
    if (s < 1088) { const int d64 = s - 1024; return 1024 + 128 * (d64 >> 5) + slot32(d64 & 31); }
    if (s < 1092) return 1024 + 32 + (s - 1088);
    if (s < 1348) { const int v = s - 1092; return 1280 + (v & ~31) + slot32(v & 31); }
    { const int v = s - 1348; return 1536 + (v & ~31) + slot32(v & 31); }
}
__device__ __forceinline__ int perm_dest(int s) { return (s & ~31) + 16 * ((s >> 2) & 1) + 4 * ((s >> 3) & 3) + (s & 3); }
__device__ __forceinline__ int w1_dest(int s) { const int jg = s >> 1, isl = s & 1, nt = jg >> 7, ja = jg & 127; return 256 * nt + 128 * isl + (ja & ~31) + slot32(ja & 31); }

template <int MAP>
__device__ __forceinline__ void transpose_item(const float* W, int N, bf16_t* WT, LAS float* scr, int kb, int nb, int lane) {
    const int k0 = 64 * kb, n0 = 32 * nb, col = n0 + (lane & 31); const bool ok = col < N;
    float v[32];
    const float* src = W + (size_t)(k0 + (lane >> 5)) * N + (ok ? col : 0);
#pragma unroll
    for (int i = 0; i < 32; ++i) v[i] = src[(size_t)(2 * i) * N];
#pragma unroll
    for (int i = 0; i < 32; ++i) scr[(2 * i + (lane >> 5)) * 33 + (lane & 31)] = ok ? v[i] : 0.f;
    asm volatile("s_waitcnt lgkmcnt(0)" ::: "memory");
    const int c = lane & 7;
#pragma unroll
    for (int j = 0; j < 4; ++j) { const int n = (lane >> 3) + 8 * j; const LAS float* s = scr + (8 * c) * 33 + n;
        u32x4 o; o.x = pk2(s[0 * 33], s[1 * 33]); o.y = pk2(s[2 * 33], s[3 * 33]); o.z = pk2(s[4 * 33], s[5 * 33]); o.w = pk2(s[6 * 33], s[7 * 33]);
        const int sc = n0 + n;
        if (sc < N) { const int dest = MAP == 1 ? win_dest(sc) : (MAP == 2 ? w1_dest(sc) : (MAP == 3 ? perm_dest(sc) : sc)); *(u32x4*)(WT + (size_t)dest * 1024 + k0 + 8 * c) = o; } }
    asm volatile("s_waitcnt lgkmcnt(0)" ::: "memory");
}

__device__ __forceinline__ void phase_prep(const Args& a, Ctx& C) {
    unsigned char* ws = C.ws;
    {
        LAS float* ca = (LAS float*)C.lds;
        LAS float* red = ca + 4096;
        for (int i = C.tid; i < 4096; i += NTHREADS) { const float v = a.c[i]; ca[i] = siluf_(v); }
        __syncthreads();
        for (int it = blockIdx.x; it < 192; it += C.G) {
            const int l = it / 96, cb = it % 96, col = cb * 64 + (C.tid & 63), kg = C.tid >> 6;
            const float* w = a.w_ada + (size_t)l * 1024 * 6144 + col;
            float s0 = 0.f, s1 = 0.f, s2 = 0.f, s3 = 0.f;
#pragma unroll 8
            for (int k = kg * 128; k < kg * 128 + 128; ++k) { const float wv = w[(size_t)k * 6144]; s0 += ca[k] * wv; s1 += ca[1024 + k] * wv; s2 += ca[2048 + k] * wv; s3 += ca[3072 + k] * wv; }
            red[(kg * 4 + 0) * 64 + (C.tid & 63)] = s0; red[(kg * 4 + 1) * 64 + (C.tid & 63)] = s1; red[(kg * 4 + 2) * 64 + (C.tid & 63)] = s2; red[(kg * 4 + 3) * 64 + (C.tid & 63)] = s3;
            __syncthreads();
            if (C.tid < 256) { const int b = C.tid >> 6, cc = C.tid & 63; float s = 0.f;
#pragma unroll
                for (int g = 0; g < 8; ++g) s += red[(g * 4 + b) * 64 + cc];
                ((float*)(ws + WS_MOD))[(size_t)(l * 4 + b) * 6144 + cb * 64 + cc] = s + a.b_ada[l * 6144 + cb * 64 + cc]; }
            __syncthreads();
        }
    }
    const int gw = C.vcu * NWAVES + C.wave, NGW = C.G * NWAVES;
    for (int tk = gw; tk < NTOK; tk += NGW) {
        if (C.lane < 32) {
            const float posf = (float)a.pos[tk];
            const float inv = exp2f(-(float)C.lane * (13.287712379549449f / 32.0f));
            const double ang = (double)(posf * inv);
            const double kq = rint(ang * 0.63661977236758134308);
            const double y = fma(-kq, 1.57079632679489661923, ang);
            const double y2 = y * y;
            const double sy = y * (1.0 + y2 * (-1.0 / 6 + y2 * (1.0 / 120 + y2 * (-1.0 / 5040 + y2 * (1.0 / 362880 - y2 * (1.0 / 39916800))))));
            const double cy = 1.0 + y2 * (-0.5 + y2 * (1.0 / 24 + y2 * (-1.0 / 720 + y2 * (1.0 / 40320 + y2 * (-1.0 / 3628800 + y2 * (1.0 / 479001600))))));
            const int q = ((int)((long long)kq)) & 3;
            const double sn = (q == 0) ? sy : (q == 1) ? cy : (q == 2) ? -sy : -cy;
            const double cs = (q == 0) ? cy : (q == 1) ? -sy : (q == 2) ? -cy : sy;
            ((float*)(ws + WS_ROPEC))[(size_t)tk * 32 + C.lane] = (float)cs;
            ((float*)(ws + WS_ROPES))[(size_t)tk * 32 + C.lane] = (float)sn;
        }
    }
    for (int i = gw * 64 + C.lane; i < 2 * 32 * 1024; i += NGW * 64) { const int l = i >> 15, e = (i >> 10) & 31, k = i & 1023; const float wv = a.w_router[(size_t)l * 32768 + k * 32 + e];
        const unsigned hi = f2bf(wv); const float lo = wv - bf2f((unsigned short)hi); ((bf16_t*)(ws + WS_WRH))[i] = (bf16_t)hi; ((bf16_t*)(ws + WS_WRL))[i] = (bf16_t)f2bf(lo); }
    LAS float* scr = (LAS float*)(C.lds + C.wave * 16384);
    constexpr int I_IN = 2 * 16 * 75, I_OUT = 2 * 16 * 32;
    for (int it = gw; it < I_IN + I_OUT; it += NGW) {
        int r = it;
        if (r < I_IN) { const int l = r / (16 * 75), q = r % (16 * 75); transpose_item<1>(a.w_in + (size_t)l * 1024 * D_IN, D_IN, (bf16_t*)(ws + WS_WIN) + (size_t)l * NPAD * 1024, scr, q / 75, q % 75, C.lane); continue; }
        r -= I_IN;
        { const int l = r / (16 * 32), q = r % (16 * 32); transpose_item<3>(a.w_out + (size_t)l * 1024 * 1024, 1024, (bf16_t*)(ws + WS_WOUT) + (size_t)l * 1024 * 1024, scr, q / 32, q % 32, C.lane); }
    }
}

struct Conv {
    const float* w1l; const float* w2l; bf16_t* w1t; bf16_t* w2t;
    int it, step, lane; bool pend;
    const float* W; bf16_t* WT; int N, map, k0, n0;
    f32x4 v4[8];
    static constexpr int NITEMS = 32 * 16 * 64 + 32 * 16 * 32;
    __device__ __forceinline__ void issue() {
        if (it >= NITEMS) return;
        if (it < 32 * 16 * 64) { const int e = it >> 10, q = it & 1023; W = w1l + (size_t)e * 1024 * 2048; WT = w1t + (size_t)e * 2048 * 1024; N = 2048; map = 2; k0 = 64 * (q >> 6); n0 = 32 * (q & 63); }
        else { const int r = it - 32 * 16 * 64, e = r >> 9, q = r & 511; W = w2l + (size_t)e * 1024 * 1024; WT = w2t + (size_t)e * 1024 * 1024; N = 1024; map = 3; k0 = 64 * (q >> 5); n0 = 32 * (q & 31); }
        const float* src = W + (size_t)(k0 + (lane >> 3)) * N + n0 + 4 * (lane & 7);
#pragma unroll
        for (int i = 0; i < 8; ++i) v4[i] = *(const f32x4*)(src + (size_t)(8 * i) * N);
        pend = true; it += step;
    }
    __device__ __forceinline__ void finish(LAS float* scr) {
        if (!pend) return;
#pragma unroll
        for (int i = 0; i < 8; ++i) { LAS float* d = scr + ((lane >> 3) + 8 * i) * 33 + 4 * (lane & 7); d[0] = v4[i].x; d[1] = v4[i].y; d[2] = v4[i].z; d[3] = v4[i].w; }
        asm volatile("s_waitcnt lgkmcnt(0)" ::: "memory");
        const int c = lane & 7;
#pragma unroll
        for (int j = 0; j < 4; ++j) { const int n = (lane >> 3) + 8 * j; const LAS float* sp = scr + (8 * c) * 33 + n;
            u32x4 o; o.x = pk2(sp[0 * 33], sp[1 * 33]); o.y = pk2(sp[2 * 33], sp[3 * 33]); o.z = pk2(sp[4 * 33], sp[5 * 33]); o.w = pk2(sp[6 * 33], sp[7 * 33]);
            const int sc = n0 + n; const int dest = map == 2 ? w1_dest(sc) : perm_dest(sc); *(u32x4*)(WT + (size_t)dest * 1024 + k0 + 8 * c) = o; }
        asm volatile("s_waitcnt lgkmcnt(0)" ::: "memory");
        pend = false;
    }
};

__device__ __forceinline__ void norm_mod_store(const f32x4 (&v)[4], const float* g, const float* sh, const float* sc, bf16_t* urow, int lane) {
    float ss = 0.f;
#pragma unroll
    for (int j = 0; j < 4; ++j) ss += (v[j].x * v[j].x + v[j].y * v[j].y) + (v[j].z * v[j].z + v[j].w * v[j].w);
    const float rstd = 1.0f / sqrtf(wave_sum(ss) * (1.0f / D) + EPS);
#pragma unroll
    for (int j = 0; j < 4; ++j) { const int idx = 4 * lane + 256 * j; const f32x4 gv = *(const f32x4*)(g + idx), shv = *(const f32x4*)(sh + idx), scv = *(const f32x4*)(sc + idx);
        const f32x4 o = v[j] * rstd * gv * (scv + 1.0f) + shv; u32x2 w; w.x = pk2(o[0], o[1]); w.y = pk2(o[2], o[3]); *(u32x2*)(urow + idx) = w; }
}

__device__ __forceinline__ void phase_u0(const Args& a, Ctx& C) {
    const int gw = C.vcu * NWAVES + C.wave, NGW = C.G * NWAVES; const float* mod = (const float*)(C.ws + WS_MOD);
    for (int tk0 = gw; tk0 < NTOK; tk0 += 2 * NGW) {
        const bool two = (tk0 + NGW) < NTOK; const int tk1 = two ? tk0 + NGW : tk0;
        const f32x4* x0 = (const f32x4*)(a.x + (size_t)tk0 * D) + C.lane; const f32x4* x1 = (const f32x4*)(a.x + (size_t)tk1 * D) + C.lane; f32x4 v0[4], v1[4];
#pragma unroll
        for (int j = 0; j < 4; ++j) { v0[j] = x0[64 * j]; v1[j] = x1[64 * j]; }
        { const float* mb = mod + (size_t)(tk0 >> 12) * 6144; norm_mod_store(v0, a.norm1_g, mb + 0, mb + 1024, (bf16_t*)(C.ws + WS_U) + (size_t)tk0 * D, C.lane); }
        if (two) { const float* mb = mod + (size_t)(tk1 >> 12) * 6144; norm_mod_store(v1, a.norm1_g, mb + 0, mb + 1024, (bf16_t*)(C.ws + WS_U) + (size_t)tk1 * D, C.lane); }
    }
}

__device__ __forceinline__ unsigned sortable(float f) { const unsigned u = __builtin_bit_cast(unsigned, f); return (u & 0x80000000u) ? ~u : (u | 0x80000000u); }
__device__ __forceinline__ int mbcnt64(unsigned long long m) { return __builtin_amdgcn_mbcnt_hi((unsigned)(m >> 32), __builtin_amdgcn_mbcnt_lo((unsigned)m, 0)); }

__device__ __forceinline__ void select_query(Ctx& C, int tk, LAS float* sc, LAS float* qs) {
    unsigned char* ws = C.ws; const int lane = C.lane;
    const int tpos = tk & (SEQ - 1), b = tk >> 12, cch = tpos >> 6, L = 64 * (cch + 1), nj = cch + 1;
    int* sel = (int*)(ws + WS_SEL) + (size_t)tk * 256;
    if (L <= 256) { for (int i = lane; i < L; i += 64) sel[i] = i; return; }
    {
        const u32x2 w = *(const u32x2*)((const bf16_t*)(ws + WS_QI) + (size_t)tk * 256 + 4 * lane);
        *(LAS f32x4*)(qs + 4 * lane) = (f32x4){bflo(w.x), bfhi(w.x), bflo(w.y), bfhi(w.y)};
    }
    const f32x4 wi = *(const f32x4*)((const float*)(ws + WS_WI) + (size_t)tk * 4);
    asm volatile("s_waitcnt lgkmcnt(0)" ::: "memory"); __builtin_amdgcn_wave_barrier();
    const bf16_t* kib = (const bf16_t*)(ws + WS_KI) + (size_t)b * SEQ * 64;
#pragma unroll 1
    for (int j0 = 0; j0 < 64; ++j0) {
        asm volatile("" ::: "memory");
        const int sA = 64 * j0 + lane;
        if (j0 >= nj) { sc[sA] = -3.0e38f; continue; }
        u32x4 ka[8];
#pragma unroll
        for (int i = 0; i < 8; ++i) ka[i] = *(const u32x4*)(kib + (size_t)sA * 64 + 8 * i);
        float aA[4] = {0.f, 0.f, 0.f, 0.f};
#pragma unroll
        for (int i = 0; i < 8; ++i) {
            const float a0 = bflo(ka[i].x), a1 = bfhi(ka[i].x), a2 = bflo(ka[i].y), a3 = bfhi(ka[i].y), a4 = bflo(ka[i].z), a5 = bfhi(ka[i].z), a6 = bflo(ka[i].w), a7 = bfhi(ka[i].w);
#pragma unroll
            for (int h = 0; h < 4; ++h) {
                const f32x4 q0 = *(const LAS f32x4*)(qs + h * 64 + 8 * i), q1 = *(const LAS f32x4*)(qs + h * 64 + 8 * i + 4);
                aA[h] += q0.x * a0 + q0.y * a1 + q0.z * a2 + q0.w * a3 + q1.x * a4 + q1.y * a5 + q1.z * a6 + q1.w * a7;
            }
        }
        float scA = fmaxf(aA[0], 0.f) * wi[0] + fmaxf(aA[1], 0.f) * wi[1] + fmaxf(aA[2], 0.f) * wi[2] + fmaxf(aA[3], 0.f) * wi[3];
        scA = (scA == 0.f) ? 0.f : scA;
        sc[sA] = scA;
    }
    asm volatile("s_waitcnt lgkmcnt(0)" ::: "memory"); __builtin_amdgcn_wave_barrier();
    unsigned key[64];
#pragma unroll
    for (int j = 0; j < 64; ++j) key[j] = sortable(sc[64 * j + lane]);
    unsigned T = 0u;
#pragma unroll 1
    for (int bit = 31; bit >= 0; --bit) {
        const unsigned cand = T | (1u << bit); int c = 0;
#pragma unroll
        for (int j = 0; j < 64; ++j) c += (key[j] >= cand) ? 1 : 0;
#pragma unroll
        for (int o = 1; o < 64; o <<= 1) c += __shfl_xor(c, o);
        if (c >= 256) T = cand;
    }
    int cgt = 0;
#pragma unroll
    for (int j = 0; j < 64; ++j) cgt += (key[j] > T) ? 1 : 0;
#pragma unroll
    for (int o = 1; o < 64; o <<= 1) cgt += __shfl_xor(cgt, o);
    const int need = 256 - cgt; int base = 0, eqseen = 0;
#pragma unroll 1
    for (int j = 0; j < nj; ++j) {
        const unsigned kj = sortable(sc[64 * j + lane]);
        const bool gt = kj > T, eq = kj == T; const unsigned long long em = __ballot(eq);
        const bool take = gt || (eq && (eqseen + mbcnt64(em)) < need); const unsigned long long tm = __ballot(take);
        if (take) sel[base + mbcnt64(tm)] = 64 * j + lane;
        base += __popcll(tm); eqseen += __popcll(em);
    }
}

__device__ __forceinline__ void attend_query(Ctx& C, int tk, LAS float* qf, LAS float* P, LAS int* sl) {
    unsigned char* ws = C.ws; const int lane = C.lane;
    const int tpos = tk & (SEQ - 1), b = tk >> 12, L = 64 * ((tpos >> 6) + 1), nsel = L < 256 ? L : 256;
    {
        const u32x4 w = *(const u32x4*)((const bf16_t*)(ws + WS_Q) + (size_t)tk * 512 + 8 * lane);
        *(LAS f32x4*)(qf + 8 * lane) = (f32x4){bflo(w.x), bfhi(w.x), bflo(w.y), bfhi(w.y)}; *(LAS f32x4*)(qf + 8 * lane + 4) = (f32x4){bflo(w.z), bfhi(w.z), bflo(w.w), bfhi(w.w)};
        const int* sg = (const int*)(ws + WS_SEL) + (size_t)tk * 256;
#pragma unroll
        for (int i = 0; i < 4; ++i) sl[64 * i + lane] = (64 * i + lane) < nsel ? sg[64 * i + lane] : 0;
    }
    asm volatile("s_waitcnt lgkmcnt(0)" ::: "memory"); __builtin_amdgcn_wave_barrier();
    const bf16_t* kb = (const bf16_t*)(ws + WS_K) + (size_t)b * SEQ * 128; const bf16_t* vb = (const bf16_t*)(ws + WS_V) + (size_t)b * SEQ * 128;
#pragma unroll 1
    for (int i = 0; i < 4; ++i) {
        const int slot = 64 * i + lane; const bool valid = slot < nsel; const int key = sl[slot];
#pragma unroll 1
        for (int n = 0; n < 2; ++n) {
            asm volatile("" ::: "memory");
            float ac[4] = {0.f, 0.f, 0.f, 0.f};
#pragma unroll 1
            for (int c2 = 0; c2 < 4; ++c2) {
                asm volatile("" ::: "memory");
                u32x4 kr[2];
#pragma unroll
                for (int c = 0; c < 2; ++c) kr[c] = *(const u32x4*)(kb + (size_t)key * 128 + n * 64 + 8 * (2 * c2 + c));
#pragma unroll
                for (int c = 0; c < 2; ++c) {
                    const float a0 = bflo(kr[c].x), a1 = bfhi(kr[c].x), a2 = bflo(kr[c].y), a3 = bfhi(kr[c].y), a4 = bflo(kr[c].z), a5 = bfhi(kr[c].z), a6 = bflo(kr[c].w), a7 = bfhi(kr[c].w);
#pragma unroll
                    for (int h = 0; h < 4; ++h) {
                        const f32x4 q0 = *(const LAS f32x4*)(qf + (4 * n + h) * 64 + 8 * (2 * c2 + c)), q1 = *(const LAS f32x4*)(qf + (4 * n + h) * 64 + 8 * (2 * c2 + c) + 4);
                        ac[h] += q0.x * a0 + q0.y * a1 + q0.z * a2 + q0.w * a3 + q1.x * a4 + q1.y * a5 + q1.z * a6 + q1.w * a7;
                    }
                }
            }
            *(LAS f32x4*)(P + slot * 8 + 4 * n) = valid ? (f32x4){ac[0], ac[1], ac[2], ac[3]} : (f32x4){-1e30f, -1e30f, -1e30f, -1e30f};
        }
    }
    asm volatile("s_waitcnt lgkmcnt(0)" ::: "memory"); __builtin_amdgcn_wave_barrier();
    float lg[4][8];
#pragma unroll
    for (int i = 0; i < 4; ++i) { const f32x4 t0 = *(const LAS f32x4*)(P + (64 * i + lane) * 8), t1 = *(const LAS f32x4*)(P + (64 * i + lane) * 8 + 4);
        lg[i][0] = t0.x; lg[i][1] = t0.y; lg[i][2] = t0.z; lg[i][3] = t0.w; lg[i][4] = t1.x; lg[i][5] = t1.y; lg[i][6] = t1.z; lg[i][7] = t1.w; }
    float inv[8];
#pragma unroll
    for (int h = 0; h < 8; ++h) {
        const float m = wave_max(fmaxf(fmaxf(lg[0][h], lg[1][h]), fmaxf(lg[2][h], lg[3][h]))); float s = 0.f;
#pragma unroll
        for (int i = 0; i < 4; ++i) { const float p = (64 * i + lane) < nsel ? __expf(lg[i][h] - m) : 0.f; lg[i][h] = p; s += p; }
        inv[h] = 1.0f / wave_sum(s);
    }
#pragma unroll
    for (int i = 0; i < 4; ++i) { LAS float* pp = P + (64 * i + lane) * 8;
        *(LAS f32x4*)pp = (f32x4){lg[i][0], lg[i][1], lg[i][2], lg[i][3]}; *(LAS f32x4*)(pp + 4) = (f32x4){lg[i][4], lg[i][5], lg[i][6], lg[i][7]}; }
    asm volatile("s_waitcnt lgkmcnt(0)" ::: "memory"); __builtin_amdgcn_wave_barrier();
    float o[8] = {0.f, 0.f, 0.f, 0.f, 0.f, 0.f, 0.f, 0.f};
#pragma unroll 4
    for (int slot = 0; slot < nsel; ++slot) {
        const int key = sl[slot];
        const float v0 = bf2f(vb[(size_t)key * 128 + lane]), v1 = bf2f(vb[(size_t)key * 128 + 64 + lane]);
        const f32x4 p0 = *(const LAS f32x4*)(P + slot * 8), p1 = *(const LAS f32x4*)(P + slot * 8 + 4);
        o[0] += p0.x * v0; o[1] += p0.y * v0; o[2] += p0.z * v0; o[3] += p0.w * v0; o[4] += p1.x * v1; o[5] += p1.y * v1; o[6] += p1.z * v1; o[7] += p1.w * v1;
    }
    bf16_t* mo = (bf16_t*)(ws + WS_MIX) + (size_t)tk * D;
#pragma unroll
    for (int h = 0; h < 8; ++h) mo[h * 64 + lane] = (bf16_t)f2bf(o[h] * inv[h]);
    asm volatile("s_waitcnt lgkmcnt(0)" ::: "memory"); __builtin_amdgcn_wave_barrier();
}

__device__ __forceinline__ void pool_item(const Args& a, Ctx& C, int l, int item) {
    unsigned char* ws = C.ws; const int tid = C.tid;
    const int g = item & 3, tt = item >> 2, b = tt >> 6, tp0 = (tt & 63) * 64, w = 2 << g;
    LAS float* ub = (LAS float*)C.lds;
    LAS float* pw = ub + 79 * 64;
    LAS float* pl = pw + 64 * 64;
    const float* ubg = (const float*)(ws + WS_UB);
    for (int idx = tid; idx < 79 * 16; idx += NTHREADS) { const int row = idx >> 4, c4 = idx & 15, tp = tp0 - 15 + row;
        f32x4 v = (f32x4){0.f, 0.f, 0.f, 0.f}; if (tp >= 0) v = *(const f32x4*)(ubg + (size_t)(b * SEQ + tp) * 256 + g * 64 + 4 * c4);
        *(LAS f32x4*)(ub + row * 64 + 4 * c4) = v; }
    for (int idx = tid; idx < 1024; idx += NTHREADS) *(LAS f32x4*)(pw + 4 * idx) = *(const f32x4*)(a.pool_w + (size_t)(l * 4 + g) * 4096 + 4 * idx);
    __syncthreads();
    const int t = tid >> 3, c8 = (tid & 7) * 8, tpos = tp0 + t, wl = (tpos + 1) < w ? (tpos + 1) : w;
    {
        float s[8] = {0.f, 0.f, 0.f, 0.f, 0.f, 0.f, 0.f, 0.f};
        for (int i = 0; i < wl; ++i) {
#pragma unroll
            for (int j = 0; j < 8; ++j) s[j] += ub[(t + 15 - i) * 64 + c8 + j]; }
        const float rw = 1.0f / (float)wl;
#pragma unroll
        for (int j = 0; j < 8; ++j) pl[t * 65 + c8 + j] = s[j] * rw - ub[(t + 15) * 64 + c8 + j];
    }
    __syncthreads();
    float y[8] = {0.f, 0.f, 0.f, 0.f, 0.f, 0.f, 0.f, 0.f};
#pragma unroll 8
    for (int cc = 0; cc < 64; ++cc) { const float p = pl[t * 65 + cc]; const f32x4 w0 = *(const LAS f32x4*)(pw + cc * 64 + c8), w1 = *(const LAS f32x4*)(pw + cc * 64 + c8 + 4);
        y[0] += p * w0.x; y[1] += p * w0.y; y[2] += p * w0.z; y[3] += p * w0.w; y[4] += p * w1.x; y[5] += p * w1.y; y[6] += p * w1.z; y[7] += p * w1.w; }
    const float* ps = a.pool_scale + l * 256 + g * 64 + c8;
    u32x4 o; o.x = pk2(y[0] * ps[0], y[1] * ps[1]); o.y = pk2(y[2] * ps[2], y[3] * ps[3]); o.z = pk2(y[4] * ps[4], y[5] * ps[5]); o.w = pk2(y[6] * ps[6], y[7] * ps[7]);
    *(u32x4*)((bf16_t*)(ws + WS_MIX) + (size_t)(b * SEQ + tpos) * D + 512 + g * 64 + c8) = o;
    __syncthreads();
}

constexpr int HP = 65;
__device__ __forceinline__ void hgrn_gates(const Args& a, Ctx& C, int l, int b, int hh, int c, LAS float* bq, LAS float* kin) {
    const int tid = C.tid, s = tid >> 3, k8 = (tid & 7) * 8;
    const float* z = (const float*)(C.ws + WS_HG) + (size_t)(b * SEQ + c * 64 + s) * 1024 + 256 + hh * 64 + k8;
    const f32x4 z0 = *(const f32x4*)z, z1 = *(const f32x4*)(z + 4); const float zz[8] = {z0.x, z0.y, z0.z, z0.w, z1.x, z1.y, z1.z, z1.w};
#pragma unroll
    for (int j = 0; j < 8; ++j) {
        const int kk = hh * 64 + k8 + j; float lb = 0.f;
        if (l == 1) lb = 1.0f / (1.0f + expf(a.lb_logits[kk] - a.lb_logits[256 + kk]));
        const float sg = 1.0f / (1.0f + expf(-zz[j])), sn = 1.0f / (1.0f + expf(zz[j]));
        bq[s * HP + k8 + j] = logf(lb + (1.0f - lb) * sg); kin[s * HP + k8 + j] = (1.0f - lb) * sn;
    }
    __syncthreads();
    if (tid < 64) { float r = 0.f; for (int ss = 0; ss < 64; ++ss) { r += bq[ss * HP + tid]; bq[ss * HP + tid] = r; } }
    __syncthreads();
}
__device__ __forceinline__ void hgrn_local_item(const Args& a, Ctx& C, int l, int item) {
    const int tid = C.tid, c = item & 63, hh = (item >> 6) & 3, b = item >> 8;
    LAS float* bq = (LAS float*)C.lds; LAS float* kin = bq + 64 * HP; LAS float* vv = kin + 64 * HP;
    hgrn_gates(a, C, l, b, hh, c, bq, kin);
    { const int s = tid >> 3, k8 = (tid & 7) * 8;
        const float* vp = (const float*)(C.ws + WS_HG) + (size_t)(b * SEQ + c * 64 + s) * 1024 + 512 + hh * 64 + k8;
        *(LAS f32x4*)(vv + s * 64 + k8) = *(const f32x4*)vp; *(LAS f32x4*)(vv + s * 64 + k8 + 4) = *(const f32x4*)(vp + 4);
#pragma unroll
        for (int j = 0; j < 8; ++j) kin[s * HP + k8 + j] *= __expf(bq[63 * HP + k8 + j] - bq[s * HP + k8 + j]); }
    __syncthreads();
    const int k = tid >> 3, v8 = (tid & 7) * 8; float Lr[8] = {0.f, 0.f, 0.f, 0.f, 0.f, 0.f, 0.f, 0.f};
#pragma unroll 8
    for (int s = 0; s < 64; ++s) { const float w = kin[s * HP + k]; const f32x4 x0 = *(const LAS f32x4*)(vv + s * 64 + v8), x1 = *(const LAS f32x4*)(vv + s * 64 + v8 + 4);
        Lr[0] += w * x0.x; Lr[1] += w * x0.y; Lr[2] += w * x0.z; Lr[3] += w * x0.w; Lr[4] += w * x1.x; Lr[5] += w * x1.y; Lr[6] += w * x1.z; Lr[7] += w * x1.w; }
    float* hl = (float*)(C.ws + WS_HL) + (size_t)item * 4096 + k * 64 + v8;
    *(f32x4*)hl = (f32x4){Lr[0], Lr[1], Lr[2], Lr[3]}; *(f32x4*)(hl + 4) = (f32x4){Lr[4], Lr[5], Lr[6], Lr[7]};
    if ((tid & 7) == 0) ((float*)(C.ws + WS_HD))[(size_t)item * 64 + k] = __expf(bq[63 * HP + k]);
    __syncthreads();
}
__device__ __forceinline__ void hgrn_out_item(const Args& a, Ctx& C, int l, int item) {
    const int tid = C.tid, c = item & 63, hh = (item >> 6) & 3, b = item >> 8;
    LAS float* bq = (LAS float*)C.lds; LAS float* kin = bq + 64 * HP; LAS float* qq = kin + 64 * HP; LAS float* At = qq + 64 * HP; LAS float* vv = At + 64 * HP; LAS float* Ss = vv + 4096;
    hgrn_gates(a, C, l, b, hh, c, bq, kin);
    { const int s = tid >> 3, k8 = (tid & 7) * 8; const float* row = (const float*)(C.ws + WS_HG) + (size_t)(b * SEQ + c * 64 + s) * 1024 + hh * 64 + k8;
        const f32x4 q0 = *(const f32x4*)row, q1 = *(const f32x4*)(row + 4);
        qq[s * HP + k8 + 0] = siluf_(q0.x); qq[s * HP + k8 + 1] = siluf_(q0.y); qq[s * HP + k8 + 2] = siluf_(q0.z); qq[s * HP + k8 + 3] = siluf_(q0.w);
        qq[s * HP + k8 + 4] = siluf_(q1.x); qq[s * HP + k8 + 5] = siluf_(q1.y); qq[s * HP + k8 + 6] = siluf_(q1.z); qq[s * HP + k8 + 7] = siluf_(q1.w);
        *(LAS f32x4*)(vv + s * 64 + k8) = *(const f32x4*)(row + 512); *(LAS f32x4*)(vv + s * 64 + k8 + 4) = *(const f32x4*)(row + 516); }
    {
        const int k = tid >> 3, v8 = (tid & 7) * 8; f32x4 s0 = (f32x4){0.f, 0.f, 0.f, 0.f}, s1 = s0;
        const float* hl = (const float*)(C.ws + WS_HL) + (size_t)(item - c) * 4096 + k * 64 + v8; const float* hd = (const float*)(C.ws + WS_HD) + (size_t)(item - c) * 64 + k;
#pragma unroll 4
        for (int j = 0; j < c; ++j) { const float dj = hd[(size_t)j * 64]; const f32x4 l0 = *(const f32x4*)(hl + (size_t)j * 4096), l1 = *(const f32x4*)(hl + (size_t)j * 4096 + 4); s0 = s0 * dj + l0; s1 = s1 * dj + l1; }
        *(LAS f32x4*)(Ss + k * 64 + v8) = s0; *(LAS f32x4*)(Ss + k * 64 + v8 + 4) = s1; }
    __syncthreads();
    { const int t = tid >> 3, sg = tid & 7; float ac[8] = {0.f, 0.f, 0.f, 0.f, 0.f, 0.f, 0.f, 0.f};
        for (int k = 0; k < 64; ++k) { const float qt = qq[t * HP + k], bt = bq[t * HP + k];
#pragma unroll
            for (int i = 0; i < 8; ++i) { const int s = sg + 8 * i; if (s <= t) ac[i] += qt * kin[s * HP + k] * __expf(bt - bq[s * HP + k]); } }
#pragma unroll
        for (int i = 0; i < 8; ++i) At[t * HP + sg + 8 * i] = ac[i]; }
    __syncthreads();
    { const int t = tid >> 3, v8 = (tid & 7) * 8; float o[8] = {0.f, 0.f, 0.f, 0.f, 0.f, 0.f, 0.f, 0.f};
#pragma unroll 4
        for (int k = 0; k < 64; ++k) { const float qe = qq[t * HP + k] * __expf(bq[t * HP + k]); const f32x4 x0 = *(const LAS f32x4*)(Ss + k * 64 + v8), x1 = *(const LAS f32x4*)(Ss + k * 64 + v8 + 4);
            o[0] += qe * x0.x; o[1] += qe * x0.y; o[2] += qe * x0.z; o[3] += qe * x0.w; o[4] += qe * x1.x; o[5] += qe * x1.y; o[6] += qe * x1.z; o[7] += qe * x1.w; }
        for (int s = 0; s <= t; ++s) { const float w = At[t * HP + s]; const f32x4 x0 = *(const LAS f32x4*)(vv + s * 64 + v8), x1 = *(const LAS f32x4*)(vv + s * 64 + v8 + 4);
            o[0] += w * x0.x; o[1] += w * x0.y; o[2] += w * x0.z; o[3] += w * x0.w; o[4] += w * x1.x; o[5] += w * x1.y; o[6] += w * x1.z; o[7] += w * x1.w; }
        float ss = 0.f;
#pragma unroll
        for (int j = 0; j < 8; ++j) ss += o[j] * o[j];
        ss += __shfl_xor(ss, 1); ss += __shfl_xor(ss, 2); ss += __shfl_xor(ss, 4);
        const float rstd = 1.0f / sqrtf(ss * (1.0f / 64.0f) + EPS);
        const float* gp = (const float*)(C.ws + WS_HG) + (size_t)(b * SEQ + c * 64 + t) * 1024 + 768 + hh * 64 + v8; const float* ng = a.hgrn_g + l * 64 + v8;
        const f32x4 g0 = *(const f32x4*)gp, g1 = *(const f32x4*)(gp + 4); const float gg[8] = {g0.x, g0.y, g0.z, g0.w, g1.x, g1.y, g1.z, g1.w}; float y[8];
#pragma unroll
        for (int j = 0; j < 8; ++j) y[j] = o[j] * rstd * ng[j] * siluf_(gg[j]);
        u32x4 w; w.x = pk2(y[0], y[1]); w.y = pk2(y[2], y[3]); w.z = pk2(y[4], y[5]); w.w = pk2(y[6], y[7]);
        *(u32x4*)((bf16_t*)(C.ws + WS_MIX) + (size_t)(b * SEQ + c * 64 + t) * D + 768 + hh * 64 + v8) = w; }
    __syncthreads();
}

__device__ __forceinline__ int wave_isum(int v) {
    v += __builtin_amdgcn_update_dpp(0, v, 0xB1, 0xF, 0xF, true);
    v += __builtin_amdgcn_update_dpp(0, v, 0x4E, 0xF, 0xF, true);
    v += __builtin_amdgcn_update_dpp(0, v, 0x141, 0xF, 0xF, true);
    v += __builtin_amdgcn_update_dpp(0, v, 0x140, 0xF, 0xF, true);
    return __builtin_amdgcn_readlane(v, 0) + __builtin_amdgcn_readlane(v, 16) + __builtin_amdgcn_readlane(v, 32) + __builtin_amdgcn_readlane(v, 48);
}
typedef float f32x16 __attribute__((ext_vector_type(16)));
template <int NJ>
__device__ __forceinline__ void select_from_lds(const LAS float* sq, int nj, int* sel, int lane) {
    unsigned key[NJ];
#pragma unroll
    for (int j = 0; j < NJ; ++j) key[j] = sortable(sq[64 * j + lane]);
    unsigned T = 0u;
#pragma unroll 1
    for (int bit = 31; bit >= 0; --bit) {
        const unsigned cand = T | (1u << bit); int c = 0;
#pragma unroll
        for (int j = 0; j < NJ; ++j) c += (key[j] >= cand) ? 1 : 0;
        if (wave_isum(c) >= 256) T = cand;
    }
    int cgt = 0;
#pragma unroll
    for (int j = 0; j < NJ; ++j) cgt += (key[j] > T) ? 1 : 0;
    cgt = wave_isum(cgt);
    const int need = 256 - cgt; int base = 0, eqseen = 0;
#pragma unroll 1
    for (int j = 0; j < nj; ++j) {
        const unsigned kj = sortable(sq[64 * j + lane]);
        const bool gt = kj > T, eq = kj == T; const unsigned long long em = __ballot(eq);
        const bool take = gt || (eq && (eqseen + mbcnt64(em)) < need); const unsigned long long tm = __ballot(take);
        if (take) sel[base + mbcnt64(tm)] = 64 * j + lane;
        base += __popcll(tm); eqseen += __popcll(em);
    }
}
__device__ __forceinline__ void transpose32(unsigned (&a)[32]) {
#pragma unroll
    for (int st = 0; st < 5; ++st) {
        const int j = 16 >> st; const unsigned m = (st == 0) ? 0x0000FFFFu : (st == 1) ? 0x00FF00FFu : (st == 2) ? 0x0F0F0F0Fu : (st == 3) ? 0x33333333u : 0x55555555u;
#pragma unroll
        for (int idx = 0; idx < 16; ++idx) { const int k = (idx / j) * 2 * j + (idx % j); const unsigned t = (a[k] ^ (a[k + j] >> j)) & m; a[k] ^= t; a[k + j] ^= (t << j); }
    }
}
template <int NB>
__device__ __forceinline__ void select_bits(const LAS float* sq, int nj, int* sel, int lane) {
    unsigned pl[NB][32];
#pragma unroll
    for (int blk = 0; blk < NB; ++blk) {
#pragma unroll
        for (int j = 0; j < 32; ++j) pl[blk][j] = sortable(sq[64 * (32 * blk + j) + lane]);
        transpose32(pl[blk]);
    }
    unsigned M[NB], GT[NB];
#pragma unroll
    for (int blk = 0; blk < NB; ++blk) { M[blk] = 0xFFFFFFFFu; GT[blk] = 0u; }
    unsigned T = 0u; int G = 0;
#pragma unroll
    for (int w = 0; w < 32; ++w) {
        unsigned n[NB]; int c = 0;
#pragma unroll
        for (int blk = 0; blk < NB; ++blk) { n[blk] = M[blk] & pl[blk][w]; c += __popc(n[blk]); }
        const int tot = wave_isum(c);
        const bool take = (G + tot) >= 256;
        const unsigned flip = take ? 0u : 0xFFFFFFFFu;
        T |= take ? (1u << (31 - w)) : 0u; G += take ? 0 : tot;
#pragma unroll
        for (int blk = 0; blk < NB; ++blk) { GT[blk] |= n[blk] & flip; M[blk] &= (pl[blk][w] ^ flip); }
    }
    const int need = 256 - G;
    int ceq = 0;
#pragma unroll
    for (int blk = 0; blk < NB; ++blk) ceq += __popc(M[blk]);
    const int toteq = wave_isum(ceq);
    if (toteq == need) {
        int cnt = 0;
#pragma unroll
        for (int blk = 0; blk < NB; ++blk) { GT[blk] |= M[blk]; cnt += __popc(GT[blk]); }
        int incl = cnt;
#pragma unroll
        for (int o = 1; o < 64; o <<= 1) { const int t = __shfl_up(incl, o); if (lane >= o) incl += t; }
        int pos = incl - cnt;
#pragma unroll
        for (int blk = 0; blk < NB; ++blk) { unsigned mk = GT[blk];
            while (mk) { const int x = 31 - __clz((int)mk); mk &= ~(1u << x); sel[pos++] = 64 * (32 * blk + 31 - x) + lane; } }
    } else {
        int base = 0, eqseen = 0;
#pragma unroll 1
        for (int j = 0; j < nj; ++j) {
            const unsigned kj = sortable(sq[64 * j + lane]);
            const bool gt = kj > T, eq = kj == T; const unsigned long long em = __ballot(eq);
            const bool take = gt || (eq && (eqseen + mbcnt64(em)) < need); const unsigned long long tm = __ballot(take);
            if (take) sel[base + mbcnt64(tm)] = 64 * j + lane;
            base += __popcll(tm); eqseen += __popcll(em);
        }
    }
}
__device__ __forceinline__ void index_unit(Ctx& C, int b, int cch, int sub) {
    unsigned char* ws = C.ws; const int lane = C.lane, w = C.wave;
    const int tk0 = b * SEQ + 64 * cch + 8 * sub, L = 64 * (cch + 1), nj = cch + 1;
    if (L <= 256) { int* sel = (int*)(ws + WS_SEL) + (size_t)(tk0 + w) * 256; for (int i = lane; i < L; i += 64) sel[i] = i; return; }
    LAS float* scl = (LAS float*)C.lds;
#ifndef IDXREP
#define IDXREP 0
#endif
    for (int repA = 0; repA < ((IDXREP & 1) ? 2 : 1); ++repA) {
        const int r = lane & 31, hf = lane >> 5, qq = r >> 2, h = r & 3;
        bf16x8 aq[4];
#pragma unroll
        for (int ks = 0; ks < 4; ++ks) aq[ks] = *(const bf16x8*)((const bf16_t*)(ws + WS_QI) + (size_t)(tk0 + qq) * 256 + h * 64 + 16 * ks + 8 * hf);
        f32x4 wq[4];
#pragma unroll
        for (int g = 0; g < 4; ++g) wq[g] = *(const f32x4*)((const float*)(ws + WS_WI) + (size_t)(tk0 + 2 * g + hf) * 4);
        const bf16_t* kib = (const bf16_t*)(ws + WS_KI) + (size_t)b * SEQ * 64;
        const int ntile = 2 * nj;
        bf16x8 bk[4], bk2[4];
#define IDX_LOAD(d1, d2, kta) do { const int _k1 = (kta), _k2 = ((kta) + NWAVES) < ntile ? (kta) + NWAVES : (kta); _Pragma("unroll") for (int ks = 0; ks < 4; ++ks) { \
            d1[ks] = *(const bf16x8*)(kib + (size_t)(32 * _k1 + r) * 64 + 16 * ks + 8 * hf); d2[ks] = *(const bf16x8*)(kib + (size_t)(32 * _k2 + r) * 64 + 16 * ks + 8 * hf); } } while (0)
        if (w < ntile) IDX_LOAD(bk, bk2, w);
#pragma unroll 1
        for (int kt = w; kt < ntile; kt += 2 * NWAVES) {
            const bool two = (kt + NWAVES) < ntile; const int kt2 = two ? kt + NWAVES : kt;
            bf16x8 nk[4], nk2[4];
            const bool more = (kt + 2 * NWAVES) < ntile;
            if (more) IDX_LOAD(nk, nk2, kt + 2 * NWAVES);
            f32x16 acc, acc2;
#pragma unroll
            for (int i = 0; i < 16; ++i) { acc[i] = 0.f; acc2[i] = 0.f; }
#pragma unroll
            for (int ks = 0; ks < 4; ++ks) { acc = __builtin_amdgcn_mfma_f32_32x32x16_bf16(aq[ks], bk[ks], acc, 0, 0, 0); acc2 = __builtin_amdgcn_mfma_f32_32x32x16_bf16(aq[ks], bk2[ks], acc2, 0, 0, 0); }
#pragma unroll
            for (int g = 0; g < 4; ++g) {
                float sc = fmaxf(acc[4 * g + 0], 0.f) * wq[g][0] + fmaxf(acc[4 * g + 1], 0.f) * wq[g][1] + fmaxf(acc[4 * g + 2], 0.f) * wq[g][2] + fmaxf(acc[4 * g + 3], 0.f) * wq[g][3];
                sc = (sc == 0.f) ? 0.f : sc;
                scl[(2 * g + hf) * 4096 + 32 * kt + r] = sc;
                float sc2 = fmaxf(acc2[4 * g + 0], 0.f) * wq[g][0] + fmaxf(acc2[4 * g + 1], 0.f) * wq[g][1] + fmaxf(acc2[4 * g + 2], 0.f) * wq[g][2] + fmaxf(acc2[4 * g + 3], 0.f) * wq[g][3];
                sc2 = (sc2 == 0.f) ? 0.f : sc2;
                if (two) scl[(2 * g + hf) * 4096 + 32 * kt2 + r] = sc2;
            }
            if (more) {
#pragma unroll
                for (int ks = 0; ks < 4; ++ks) { bk[ks] = nk[ks]; bk2[ks] = nk2[ks]; } }
        }
#undef IDX_LOAD
        const int njp = nj <= 32 ? 32 : 64;
        for (int j = nj; j < njp; ++j) scl[w * 4096 + 64 * j + lane] = -3.0e38f;
    }
    __syncthreads();
    for (int repB = 0; repB < ((IDXREP & 2) ? 2 : 1); ++repB) {
        const LAS float* sq = scl + w * 4096; int* sel = (int*)(ws + WS_SEL) + (size_t)(tk0 + w) * 256;
        if (nj <= 32) select_bits<1>(sq, nj, sel, lane); else select_bits<2>(sq, nj, sel, lane);
    }
    __syncthreads();
}

__device__ __forceinline__ unsigned sortable16(unsigned h) { return (h & 0x8000u) ? (~h & 0xFFFFu) : (h | 0x8000u); }
__device__ __forceinline__ unsigned short f2h_bits(float f) { const _Float16 h = (_Float16)f; unsigned short b = __builtin_bit_cast(unsigned short, h); return b == 0x8000u ? (unsigned short)0 : b; }
template <int NB>
__device__ __forceinline__ void select_bits16(const LAS unsigned short* sq, int nj, int* sel, int lane) {
    unsigned a[32];
#pragma unroll
    for (int j = 0; j < 32; ++j) { const unsigned lo = sortable16(sq[64 * j + lane]); const unsigned hi = (NB == 2) ? sortable16(sq[64 * (32 + j) + lane]) : 0u; a[j] = lo | (hi << 16); }
    transpose32(a);
    unsigned Ml = 0xFFFFFFFFu, Mh = (NB == 2) ? 0xFFFFFFFFu : 0u, Gl = 0u, Gh = 0u; unsigned T = 0u; int G = 0;
#pragma unroll
    for (int bit = 15; bit >= 0; --bit) {
        const unsigned nl = Ml & a[31 - bit], nh = Mh & a[15 - bit];
        const int tot = wave_isum(__popc(nl) + __popc(nh));
        const bool take = (G + tot) >= 256; const unsigned flip = take ? 0u : 0xFFFFFFFFu;
        T |= take ? (1u << bit) : 0u; G += take ? 0 : tot;
        Gl |= nl & flip; Gh |= nh & flip; Ml &= (a[31 - bit] ^ flip); Mh &= (a[15 - bit] ^ flip);
    }
    const int need = 256 - G;
    if (T != 0x8000u) {
        const int ceq = __popc(Ml) + __popc(Mh); int incl = ceq;
#pragma unroll
        for (int o = 1; o < 64; o <<= 1) { const int t = __shfl_up(incl, o); if (lane >= o) incl += t; }
        int quota = need - (incl - ceq); quota = quota < 0 ? 0 : (quota > ceq ? ceq : quota);
        const int cnt = __popc(Gl) + __popc(Gh) + quota; int inc2 = cnt;
#pragma unroll
        for (int o = 1; o < 64; o <<= 1) { const int t = __shfl_up(inc2, o); if (lane >= o) inc2 += t; }
        int pos = inc2 - cnt;
        { unsigned mk = Gl; while (mk) { const int x = 31 - __clz((int)mk); mk &= ~(1u << x); sel[pos++] = 64 * (31 - x) + lane; } }
        if (NB == 2) { unsigned mk = Gh; while (mk) { const int x = 31 - __clz((int)mk); mk &= ~(1u << x); sel[pos++] = 64 * (63 - x) + lane; } }
        { unsigned mk = Ml; while (mk && quota > 0) { const int x = 31 - __clz((int)mk); mk &= ~(1u << x); sel[pos++] = 64 * (31 - x) + lane; --quota; } }
        if (NB == 2) { unsigned mk = Mh; while (mk && quota > 0) { const int x = 31 - __clz((int)mk); mk &= ~(1u << x); sel[pos++] = 64 * (63 - x) + lane; --quota; } }
    } else {
        int base = 0, eqseen = 0;
#pragma unroll 1
        for (int j = 0; j < nj; ++j) {
            const unsigned kj = sortable16(sq[64 * j + lane]);
            const bool gt = kj > T, eq = kj == T; const unsigned long long em = __ballot(eq);
            const bool take = gt || (eq && (eqseen + mbcnt64(em)) < need); const unsigned long long tm = __ballot(take);
            if (take) sel[base + mbcnt64(tm)] = 64 * j + lane;
            base += __popcll(tm); eqseen += __popcll(em);
        }
    }
}
constexpr int KST_ROW = 144, KST_BYTES = 64 * KST_ROW;
__device__ __forceinline__ void index_unit2(Ctx& C, int b, int cch, int sub) {
    unsigned char* ws = C.ws; const int lane = C.lane, w = C.wave;
    const int tk0 = b * SEQ + 64 * cch + 8 * sub, L = 64 * (cch + 1), nj = cch + 1;
    if (L <= 256) { int* sel = (int*)(ws + WS_SEL) + (size_t)(tk0 + w) * 256; for (int i = lane; i < L; i += 64) sel[i] = i; return; }
    LAS unsigned short* sclh = (LAS unsigned short*)C.lds;
    LAS unsigned char* kst = C.lds + 65536 + w * KST_BYTES;
    {
        const int r = lane & 31, hf = lane >> 5, qq = r >> 2, h = r & 3;
        bf16x8 aq[4];
#pragma unroll
        for (int ks = 0; ks < 4; ++ks) aq[ks] = *(const bf16x8*)((const bf16_t*)(ws + WS_QI) + (size_t)(tk0 + qq) * 256 + h * 64 + 16 * ks + 8 * hf);
        f32x4 wq[4];
#pragma unroll
        for (int g = 0; g < 4; ++g) wq[g] = *(const f32x4*)((const float*)(ws + WS_WI) + (size_t)(tk0 + 2 * g + hf) * 4);
        const unsigned char* kib = ws + WS_KI + (size_t)b * SEQ * 128;
        const int ntile = 2 * nj;
        u32x4 st[8];
#define IDX2_LOAD(kta) do { const int _t1 = (kta), _t2 = ((kta) + NWAVES) < ntile ? (kta) + NWAVES : (kta); _Pragma("unroll") for (int j = 0; j < 4; ++j) { \
            st[j] = *(const u32x4*)(kib + (size_t)_t1 * 4096 + 1024 * j + 16 * lane); st[4 + j] = *(const u32x4*)(kib + (size_t)_t2 * 4096 + 1024 * j + 16 * lane); } } while (0)
        if (w < ntile) IDX2_LOAD(w);
#pragma unroll 1
        for (int kt = w; kt < ntile; kt += 2 * NWAVES) {
            const bool two = (kt + NWAVES) < ntile; const int kt2 = two ? kt + NWAVES : kt;
#pragma unroll
            for (int j = 0; j < 4; ++j) { *(LAS u32x4*)(kst + (8 * j + (lane >> 3)) * KST_ROW + 16 * (lane & 7)) = st[j]; *(LAS u32x4*)(kst + (32 + 8 * j + (lane >> 3)) * KST_ROW + 16 * (lane & 7)) = st[4 + j]; }
            if ((kt + 2 * NWAVES) < ntile) IDX2_LOAD(kt + 2 * NWAVES);
            f32x16 acc, acc2;
#pragma unroll
            for (int i = 0; i < 16; ++i) { acc[i] = 0.f; acc2[i] = 0.f; }
#pragma unroll
            for (int ks = 0; ks < 4; ++ks) { const bf16x8 b1 = *(const LAS bf16x8*)(kst + r * KST_ROW + 32 * ks + 16 * hf), b2 = *(const LAS bf16x8*)(kst + (32 + r) * KST_ROW + 32 * ks + 16 * hf);
                acc = __builtin_amdgcn_mfma_f32_32x32x16_bf16(aq[ks], b1, acc, 0, 0, 0); acc2 = __builtin_amdgcn_mfma_f32_32x32x16_bf16(aq[ks], b2, acc2, 0, 0, 0); }
#pragma unroll
            for (int g = 0; g < 4; ++g) {
                const float sc = fmaxf(acc[4 * g + 0], 0.f) * wq[g][0] + fmaxf(acc[4 * g + 1], 0.f) * wq[g][1] + fmaxf(acc[4 * g + 2], 0.f) * wq[g][2] + fmaxf(acc[4 * g + 3], 0.f) * wq[g][3];
                sclh[(2 * g + hf) * 4096 + 32 * kt + r] = f2h_bits(sc);
                const float sc2 = fmaxf(acc2[4 * g + 0], 0.f) * wq[g][0] + fmaxf(acc2[4 * g + 1], 0.f) * wq[g][1] + fmaxf(acc2[4 * g + 2], 0.f) * wq[g][2] + fmaxf(acc2[4 * g + 3], 0.f) * wq[g][3];
                if (two) sclh[(2 * g + hf) * 4096 + 32 * kt2 + r] = f2h_bits(sc2);
            }
        }
#undef IDX2_LOAD
        const int njp = nj <= 32 ? 32 : 64;
        for (int j = nj; j < njp; ++j) sclh[w * 4096 + 64 * j + lane] = (unsigned short)0xFBFFu;
    }
    __syncthreads();
    {
        const LAS unsigned short* sq = sclh + w * 4096; int* sel = (int*)(ws + WS_SEL) + (size_t)(tk0 + w) * 256;
        if (nj <= 32) select_bits16<1>(sq, nj, sel, lane); else select_bits16<2>(sq, nj, sel, lane);
    }
    __syncthreads();
}

typedef short s16x4 __attribute__((ext_vector_type(4)));
constexpr int VROW = 272;
__device__ __forceinline__ void attend_query_mfma(Ctx& C, int tk, LAS unsigned char* vs, Conv& cv) {
    unsigned char* ws = C.ws; const int lane = C.lane, c = lane & 15, g = lane >> 4;
    const int tpos = tk & (SEQ - 1), b = tk >> 12, L = 64 * ((tpos >> 6) + 1), nsel = L < 256 ? L : 256;
    const bf16_t* kb = (const bf16_t*)(ws + WS_K) + (size_t)b * SEQ * 128; const bf16_t* vb = (const bf16_t*)(ws + WS_V) + (size_t)b * SEQ * 128;
    int selr[4];
    { const int* sg = (const int*)(ws + WS_SEL) + (size_t)tk * 256;
#pragma unroll
      for (int i = 0; i < 4; ++i) selr[i] = (64 * i + lane) < nsel ? sg[64 * i + lane] : 0; }
    bf16x8 bq0[2], bq1[2];
    { const bf16_t* qp = (const bf16_t*)(ws + WS_Q) + (size_t)tk * 512 + (c & 7) * 64 + 8 * g; const bf16x8 z = (bf16x8){0, 0, 0, 0, 0, 0, 0, 0};
#pragma unroll
      for (int ks = 0; ks < 2; ++ks) { const bf16x8 q = *(const bf16x8*)(qp + 32 * ks); bq0[ks] = (c < 4) ? q : z; bq1[ks] = (c >= 4 && c < 8) ? q : z; } }
    cv.issue();
    f32x4 acc[16];
#pragma unroll
    for (int kt = 0; kt < 16; ++kt) {
        if ((kt & 3) == 0) asm volatile("" ::: "memory");
        const int key = __shfl(selr[kt >> 2], 16 * (kt & 3) + c);
        const bf16_t* kr = kb + (size_t)key * 128 + 8 * g;
        const bf16x8 a00 = *(const bf16x8*)(kr), a01 = *(const bf16x8*)(kr + 32), a10 = *(const bf16x8*)(kr + 64), a11 = *(const bf16x8*)(kr + 96);
        f32x4 t = (f32x4){0.f, 0.f, 0.f, 0.f};
        t = __builtin_amdgcn_mfma_f32_16x16x32_bf16(a00, bq0[0], t, 0, 0, 0); t = __builtin_amdgcn_mfma_f32_16x16x32_bf16(a01, bq0[1], t, 0, 0, 0);
        t = __builtin_amdgcn_mfma_f32_16x16x32_bf16(a10, bq1[0], t, 0, 0, 0); t = __builtin_amdgcn_mfma_f32_16x16x32_bf16(a11, bq1[1], t, 0, 0, 0);
        acc[kt] = t;
    }
    asm volatile("" ::: "memory"); cv.finish((LAS float*)vs); cv.issue();
    { const int lim = nsel - 4 * g;
#pragma unroll
      for (int kt = 0; kt < 16; ++kt)
#pragma unroll
        for (int r = 0; r < 4; ++r) acc[kt][r] = (16 * kt + r < lim) ? acc[kt][r] : -1e30f; }
    float m = -1e30f;
#pragma unroll
    for (int kt = 0; kt < 16; ++kt) m = fmaxf(m, fmaxf(fmaxf(acc[kt][0], acc[kt][1]), fmaxf(acc[kt][2], acc[kt][3])));
    m = fmaxf(m, __shfl_xor(m, 16)); m = fmaxf(m, __shfl_xor(m, 32));
    float sum = 0.f;
#pragma unroll
    for (int kt = 0; kt < 16; ++kt)
#pragma unroll
        for (int r = 0; r < 4; ++r) { const float pv = __expf(acc[kt][r] - m); acc[kt][r] = pv; sum += pv; }
    sum += __shfl_xor(sum, 16); sum += __shfl_xor(sum, 32);
    const float inv = 1.0f / sum;
    bf16x8 bp[8];
#pragma unroll
    for (int T = 0; T < 8; ++T) { u32x4 w; w.x = cvt_pk_bf16(acc[2 * T][0], acc[2 * T][1]); w.y = cvt_pk_bf16(acc[2 * T][2], acc[2 * T][3]); w.z = cvt_pk_bf16(acc[2 * T + 1][0], acc[2 * T + 1][1]); w.w = cvt_pk_bf16(acc[2 * T + 1][2], acc[2 * T + 1][3]);
        bp[T] = __builtin_bit_cast(bf16x8, w); }
    f32x4 ao0[4], ao1[4];
#pragma unroll
    for (int dt = 0; dt < 4; ++dt) { ao0[dt] = (f32x4){0.f, 0.f, 0.f, 0.f}; ao1[dt] = (f32x4){0.f, 0.f, 0.f, 0.f}; }
    const int q4 = c >> 2, p4 = c & 3;
    u32x4 vst[8];
#define ATT_VLOAD(T) do { _Pragma("unroll") for (int i = 0; i < 8; ++i) { const int row = g + 4 * i; \
        const int key = __shfl(selr[(T) >> 1], 32 * ((T) & 1) + row); vst[i] = *(const u32x4*)(vb + (size_t)key * 128 + 8 * c); } } while (0)
    ATT_VLOAD(0);
#pragma unroll
    for (int T = 0; T < 8; ++T) {
        LAS unsigned char* buf = vs + (T & 1) * (32 * VROW);
        asm volatile("" ::: "memory");
#pragma unroll
        for (int i = 0; i < 8; ++i) *(LAS u32x4*)(buf + (g + 4 * i) * VROW + 16 * c) = vst[i];
        if (T < 7) ATT_VLOAD(T + 1);
#pragma unroll
        for (int n = 0; n < 2; ++n)
#pragma unroll
            for (int dt = 0; dt < 4; ++dt) {
                LAS s16x4* p0 = (LAS s16x4*)(buf + (4 * g + q4) * VROW + (n * 64 + 16 * dt + 4 * p4) * 2);
                const s16x4 lo = __builtin_amdgcn_ds_read_tr16_b64_v4i16(p0), hi = __builtin_amdgcn_ds_read_tr16_b64_v4i16((LAS s16x4*)((LAS unsigned char*)p0 + 16 * VROW));
                const bf16x8 av = (bf16x8){lo[0], lo[1], lo[2], lo[3], hi[0], hi[1], hi[2], hi[3]};
                if (n == 0) ao0[dt] = __builtin_amdgcn_mfma_f32_16x16x32_bf16(av, bp[T], ao0[dt], 0, 0, 0);
                else ao1[dt] = __builtin_amdgcn_mfma_f32_16x16x32_bf16(av, bp[T], ao1[dt], 0, 0, 0);
            }
        if (T == 3) { asm volatile("" ::: "memory"); cv.finish((LAS float*)vs); cv.issue(); }
    }
#undef ATT_VLOAD
    asm volatile("" ::: "memory"); cv.finish((LAS float*)vs);
    if (c < 8) {
        bf16_t* mo = (bf16_t*)(ws + WS_MIX) + (size_t)tk * D + c * 64 + 4 * g;
#pragma unroll
        for (int dt = 0; dt < 4; ++dt) { f32x4 o; o[0] = (c < 4 ? ao0[dt][0] : ao1[dt][0]) * inv; o[1] = (c < 4 ? ao0[dt][1] : ao1[dt][1]) * inv; o[2] = (c < 4 ? ao0[dt][2] : ao1[dt][2]) * inv; o[3] = (c < 4 ? ao0[dt][3] : ao1[dt][3]) * inv; u32x2 w; w.x = cvt_pk_bf16(o[0], o[1]); w.y = cvt_pk_bf16(o[2], o[3]); *(u32x2*)(mo + 16 * dt) = w; }
    }
}

__device__ __forceinline__ void hgrn_out_group(const Args& a, Ctx& C, int l, int item) {
    const int tid = C.tid, lane = C.lane, w = C.wave, cg = item & 15, hh = (item >> 4) & 3, b = item >> 6, c0 = 4 * cg, bh = b * 4 + hh;
    LAS float* bq = (LAS float*)C.lds; LAS float* kin = bq + 64 * HP; LAS float* qq = kin + 64 * HP; LAS float* At = qq + 64 * HP; LAS float* vv = At + 64 * HP; LAS float* Ss = vv + 4096;
    const float* HG = (const float*)(C.ws + WS_HG); const float* HLb = (const float*)(C.ws + WS_HL) + (size_t)bh * 64 * 4096; const float* HDb = (const float*)(C.ws + WS_HD) + (size_t)bh * 64 * 64;
    float lbv[8];
#pragma unroll
    for (int j = 0; j < 8; ++j) { const int kk = hh * 64 + 8 * w + j; lbv[j] = (l == 1) ? 1.0f / (1.0f + expf(a.lb_logits[kk] - a.lb_logits[256 + kk])) : 0.f; }
    const int kS = tid >> 3, v8 = (tid & 7) * 8; f32x4 s0 = (f32x4){0.f, 0.f, 0.f, 0.f}, s1 = s0;
    { const float* hl = HLb + kS * 64 + v8; const float* hd = HDb + kS;
#pragma unroll 8
      for (int j = 0; j < c0; ++j) { const float dj = hd[(size_t)j * 64]; const f32x4 l0 = *(const f32x4*)(hl + (size_t)j * 4096), l1 = *(const f32x4*)(hl + (size_t)j * 4096 + 4); s0 = s0 * dj + l0; s1 = s1 * dj + l1; } }
#pragma unroll 1
    for (int c = c0; c < c0 + 4; ++c) {
        const size_t tok0 = (size_t)b * SEQ + c * 64;
        const f32x4 lc0 = *(const f32x4*)(HLb + (size_t)c * 4096 + kS * 64 + v8), lc1 = *(const f32x4*)(HLb + (size_t)c * 4096 + kS * 64 + v8 + 4);
        *(LAS f32x4*)(Ss + kS * 64 + v8) = s0; *(LAS f32x4*)(Ss + kS * 64 + v8 + 4) = s1;
        {
            const float* z = HG + (tok0 + lane) * 1024 + 256 + hh * 64 + 8 * w; const f32x4 z0 = *(const f32x4*)z, z1 = *(const f32x4*)(z + 4); const float zz[8] = {z0.x, z0.y, z0.z, z0.w, z1.x, z1.y, z1.z, z1.w};
#pragma unroll
            for (int j = 0; j < 8; ++j) { const float lb = lbv[j]; const float sg = 1.0f / (1.0f + __expf(-zz[j])), sn = 1.0f / (1.0f + __expf(zz[j])); float lf = __logf(lb + (1.0f - lb) * sg);
#pragma unroll
                for (int o = 1; o < 64; o <<= 1) { const float t = __shfl_up(lf, o); if (lane >= o) lf += t; }
                bq[lane * HP + 8 * w + j] = lf; kin[lane * HP + 8 * w + j] = (1.0f - lb) * sn; }
        }
        { const int sr = tid >> 3, k8 = (tid & 7) * 8; const float* row = HG + (tok0 + sr) * 1024 + hh * 64 + k8;
            const f32x4 q0 = *(const f32x4*)row, q1 = *(const f32x4*)(row + 4);
            qq[sr * HP + k8 + 0] = siluf_(q0.x); qq[sr * HP + k8 + 1] = siluf_(q0.y); qq[sr * HP + k8 + 2] = siluf_(q0.z); qq[sr * HP + k8 + 3] = siluf_(q0.w);
            qq[sr * HP + k8 + 4] = siluf_(q1.x); qq[sr * HP + k8 + 5] = siluf_(q1.y); qq[sr * HP + k8 + 6] = siluf_(q1.z); qq[sr * HP + k8 + 7] = siluf_(q1.w);
            *(LAS f32x4*)(vv + sr * 64 + k8) = *(const f32x4*)(row + 512); *(LAS f32x4*)(vv + sr * 64 + k8 + 4) = *(const f32x4*)(row + 516); }
        __syncthreads();
        { const int t = tid >> 3, sg = tid & 7; float ac[8] = {0.f, 0.f, 0.f, 0.f, 0.f, 0.f, 0.f, 0.f};
            for (int k = 0; k < 64; ++k) { const float qt = qq[t * HP + k], bt = bq[t * HP + k];
#pragma unroll
                for (int i = 0; i < 8; ++i) { const int sx = sg + 8 * i; if (sx <= t) ac[i] += qt * kin[sx * HP + k] * __expf(bt - bq[sx * HP + k]); } }
#pragma unroll
            for (int i = 0; i < 8; ++i) At[t * HP + sg + 8 * i] = ac[i]; }
        __syncthreads();
        { const int t = tid >> 3; float o[8] = {0.f, 0.f, 0.f, 0.f, 0.f, 0.f, 0.f, 0.f};
#pragma unroll 4
            for (int k = 0; k < 64; ++k) { const float qe = qq[t * HP + k] * __expf(bq[t * HP + k]); const f32x4 x0 = *(const LAS f32x4*)(Ss + k * 64 + v8), x1 = *(const LAS f32x4*)(Ss + k * 64 + v8 + 4);
                o[0] += qe * x0.x; o[1] += qe * x0.y; o[2] += qe * x0.z; o[3] += qe * x0.w; o[4] += qe * x1.x; o[5] += qe * x1.y; o[6] += qe * x1.z; o[7] += qe * x1.w; }
            for (int sx = 0; sx <= t; ++sx) { const float wv = At[t * HP + sx]; const f32x4 x0 = *(const LAS f32x4*)(vv + sx * 64 + v8), x1 = *(const LAS f32x4*)(vv + sx * 64 + v8 + 4);
                o[0] += wv * x0.x; o[1] += wv * x0.y; o[2] += wv * x0.z; o[3] += wv * x0.w; o[4] += wv * x1.x; o[5] += wv * x1.y; o[6] += wv * x1.z; o[7] += wv * x1.w; }
            float ss = 0.f;
#pragma unroll
            for (int j = 0; j < 8; ++j) ss += o[j] * o[j];
            ss += __shfl_xor(ss, 1); ss += __shfl_xor(ss, 2); ss += __shfl_xor(ss, 4);
            const float rstd = 1.0f / sqrtf(ss * (1.0f / 64.0f) + EPS);
            const float* gp = HG + (tok0 + t) * 1024 + 768 + hh * 64 + v8; const float* ng = a.hgrn_g + l * 64 + v8;
            const f32x4 g0 = *(const f32x4*)gp, g1 = *(const f32x4*)(gp + 4); const float gg[8] = {g0.x, g0.y, g0.z, g0.w, g1.x, g1.y, g1.z, g1.w}; float y[8];
#pragma unroll
            for (int j = 0; j < 8; ++j) y[j] = o[j] * rstd * ng[j] * siluf_(gg[j]);
            u32x4 wv; wv.x = pk2(y[0], y[1]); wv.y = pk2(y[2], y[3]); wv.z = pk2(y[4], y[5]); wv.w = pk2(y[6], y[7]);
            *(u32x4*)((bf16_t*)(C.ws + WS_MIX) + (tok0 + t) * D + 768 + hh * 64 + v8) = wv; }
        { const float dc = __expf(bq[63 * HP + kS]); s0 = s0 * dc + lc0; s1 = s1 * dc + lc1; }
        __syncthreads();
    }
}

template <bool WITH_Q>
__device__ __forceinline__ void hgrn_fill(const Args& a, Ctx& C, int l, int hh, size_t tok0, LAS float* fz, LAS float* kn, LAS float* qq, LAS float* vv) {
    const int tid = C.tid, sr = tid >> 3, k8 = (tid & 7) * 8; const float* row = (const float*)(C.ws + WS_HG) + (tok0 + sr) * 1024 + hh * 64 + k8;
    const f32x4 z0 = *(const f32x4*)(row + 256), z1 = *(const f32x4*)(row + 260); const float zz[8] = {z0.x, z0.y, z0.z, z0.w, z1.x, z1.y, z1.z, z1.w}; float fo[8], ko[8];
#pragma unroll
    for (int j = 0; j < 8; ++j) { const int kk = hh * 64 + k8 + j; const float lb = (l == 1) ? 1.0f / (1.0f + expf(a.lb_logits[kk] - a.lb_logits[256 + kk])) : 0.f;
        const float sg = 1.0f / (1.0f + expf(-zz[j])), sn = 1.0f / (1.0f + expf(zz[j])); fo[j] = lb + (1.0f - lb) * sg; ko[j] = (1.0f - lb) * sn; }
    *(LAS f32x4*)(fz + sr * 64 + k8) = (f32x4){fo[0], fo[1], fo[2], fo[3]}; *(LAS f32x4*)(fz + sr * 64 + k8 + 4) = (f32x4){fo[4], fo[5], fo[6], fo[7]};
    *(LAS f32x4*)(kn + sr * 64 + k8) = (f32x4){ko[0], ko[1], ko[2], ko[3]}; *(LAS f32x4*)(kn + sr * 64 + k8 + 4) = (f32x4){ko[4], ko[5], ko[6], ko[7]};
    if (WITH_Q) { const f32x4 q0 = *(const f32x4*)row, q1 = *(const f32x4*)(row + 4);
        *(LAS f32x4*)(qq + sr * 64 + k8) = (f32x4){siluf_(q0.x), siluf_(q0.y), siluf_(q0.z), siluf_(q0.w)}; *(LAS f32x4*)(qq + sr * 64 + k8 + 4) = (f32x4){siluf_(q1.x), siluf_(q1.y), siluf_(q1.z), siluf_(q1.w)}; }
    *(LAS f32x4*)(vv + sr * 64 + k8) = *(const f32x4*)(row + 512); *(LAS f32x4*)(vv + sr * 64 + k8 + 4) = *(const f32x4*)(row + 516);
}
__device__ __forceinline__ void hgrn_local2(const Args& a, Ctx& C, int l, int item) {
    const int tid = C.tid, c = item & 63, hh = (item >> 6) & 3, b = item >> 8, v = tid & 63, kq = tid >> 6;
    LAS float* fz = (LAS float*)C.lds; LAS float* kn = fz + 4096; LAS float* vv = kn + 4096;
    hgrn_fill<false>(a, C, l, hh, (size_t)b * SEQ + c * 64, fz, kn, nullptr, vv);
    __syncthreads();
    float S[8] = {0.f, 0.f, 0.f, 0.f, 0.f, 0.f, 0.f, 0.f}, dp[8] = {1.f, 1.f, 1.f, 1.f, 1.f, 1.f, 1.f, 1.f};
#pragma unroll 4
    for (int sx = 0; sx < 64; ++sx) { const f32x4 f0 = *(const LAS f32x4*)(fz + sx * 64 + 8 * kq), f1 = *(const LAS f32x4*)(fz + sx * 64 + 8 * kq + 4), k0 = *(const LAS f32x4*)(kn + sx * 64 + 8 * kq), k1 = *(const LAS f32x4*)(kn + sx * 64 + 8 * kq + 4);
        const float vs = vv[sx * 64 + v]; const float ff[8] = {f0.x, f0.y, f0.z, f0.w, f1.x, f1.y, f1.z, f1.w}, kk[8] = {k0.x, k0.y, k0.z, k0.w, k1.x, k1.y, k1.z, k1.w};
#pragma unroll
        for (int j = 0; j < 8; ++j) { S[j] = ff[j] * S[j] + kk[j] * vs; dp[j] *= ff[j]; } }
    float* hl = (float*)(C.ws + WS_HL) + (size_t)item * 4096 + (8 * kq) * 64 + v;
#pragma unroll
    for (int j = 0; j < 8; ++j) hl[j * 64] = S[j];
    if (v == 0) { float* hd = (float*)(C.ws + WS_HD) + (size_t)item * 64 + 8 * kq;
#pragma unroll
        for (int j = 0; j < 8; ++j) hd[j] = dp[j]; }
    __syncthreads();
}
__device__ __forceinline__ void hgrn_out2(const Args& a, Ctx& C, int l, int item) {
    const int tid = C.tid, cg = item & 15, hh = (item >> 4) & 3, b = item >> 6, c0 = 4 * cg, bh = b * 4 + hh, v = tid & 63, kq = tid >> 6;
    LAS float* fz = (LAS float*)C.lds; LAS float* kn = fz + 4096; LAS float* qq = kn + 4096; LAS float* vv = qq + 4096; LAS float* part = vv + 4096;
    const float* HLb = (const float*)(C.ws + WS_HL) + (size_t)bh * 64 * 4096 + (8 * kq) * 64 + v; const float* HDb = (const float*)(C.ws + WS_HD) + (size_t)bh * 64 * 64 + 8 * kq;
    float S[8] = {0.f, 0.f, 0.f, 0.f, 0.f, 0.f, 0.f, 0.f};
#pragma unroll 2
    for (int j = 0; j < c0; ++j) { const f32x4 d0 = *(const f32x4*)(HDb + (size_t)j * 64), d1 = *(const f32x4*)(HDb + (size_t)j * 64 + 4); const float dd[8] = {d0.x, d0.y, d0.z, d0.w, d1.x, d1.y, d1.z, d1.w};
#pragma unroll
        for (int i = 0; i < 8; ++i) S[i] = dd[i] * S[i] + HLb[(size_t)j * 4096 + i * 64]; }
#pragma unroll 1
    for (int c = c0; c < c0 + 4; ++c) {
        const size_t tok0 = (size_t)b * SEQ + c * 64;
        hgrn_fill<true>(a, C, l, hh, tok0, fz, kn, qq, vv);
        __syncthreads();
#pragma unroll 1
        for (int half = 0; half < 2; ++half) {
#pragma unroll 4
            for (int sl = 0; sl < 32; ++sl) { const int sx = 32 * half + sl;
                const f32x4 f0 = *(const LAS f32x4*)(fz + sx * 64 + 8 * kq), f1 = *(const LAS f32x4*)(fz + sx * 64 + 8 * kq + 4), k0 = *(const LAS f32x4*)(kn + sx * 64 + 8 * kq), k1 = *(const LAS f32x4*)(kn + sx * 64 + 8 * kq + 4);
                const f32x4 q0 = *(const LAS f32x4*)(qq + sx * 64 + 8 * kq), q1 = *(const LAS f32x4*)(qq + sx * 64 + 8 * kq + 4);
                const float vs = vv[sx * 64 + v]; const float ff[8] = {f0.x, f0.y, f0.z, f0.w, f1.x, f1.y, f1.z, f1.w}, kk[8] = {k0.x, k0.y, k0.z, k0.w, k1.x, k1.y, k1.z, k1.w}, qv[8] = {q0.x, q0.y, q0.z, q0.w, q1.x, q1.y, q1.z, q1.w};
                float op = 0.f;
#pragma unroll
                for (int j = 0; j < 8; ++j) { S[j] = ff[j] * S[j] + kk[j] * vs; op += qv[j] * S[j]; }
                part[(kq * 32 + sl) * 64 + v] = op; }
            __syncthreads();
            { const int t = tid >> 4, v4 = (tid & 15) * 4; f32x4 o = (f32x4){0.f, 0.f, 0.f, 0.f};
#pragma unroll
                for (int kk2 = 0; kk2 < 8; ++kk2) o += *(const LAS f32x4*)(part + (kk2 * 32 + t) * 64 + v4);
                float ss = o.x * o.x + o.y * o.y + o.z * o.z + o.w * o.w;
                ss += __shfl_xor(ss, 1); ss += __shfl_xor(ss, 2); ss += __shfl_xor(ss, 4); ss += __shfl_xor(ss, 8);
                const float rstd = 1.0f / sqrtf(ss * (1.0f / 64.0f) + EPS);
                const size_t tok = tok0 + 32 * half + t;
                const f32x4 gg = *(const f32x4*)((const float*)(C.ws + WS_HG) + tok * 1024 + 768 + hh * 64 + v4), ng = *(const f32x4*)(a.hgrn_g + l * 64 + v4);
                const float y0 = o.x * rstd * ng.x * siluf_(gg.x), y1 = o.y * rstd * ng.y * siluf_(gg.y), y2 = o.z * rstd * ng.z * siluf_(gg.z), y3 = o.w * rstd * ng.w * siluf_(gg.w);
                u32x2 wv; wv.x = pk2(y0, y1); wv.y = pk2(y2, y3);
                *(u32x2*)((bf16_t*)(C.ws + WS_MIX) + tok * D + 768 + hh * 64 + v4) = wv; }
            __syncthreads();
        }
    }
}

__device__ __forceinline__ void pool_wave(const Args& a, Ctx& C, int l) {
    unsigned char* ws = C.ws; const int lane = C.lane;
    const int gwv = blockIdx.x * NWAVES + C.wave, g = gwv & 3, widx = gwv >> 2, nw = (C.G * NWAVES) >> 2, w = 2 << g;
    float pwr[64];
#pragma unroll
    for (int c = 0; c < 64; ++c) pwr[c] = a.pool_w[(size_t)(l * 4 + g) * 4096 + c * 64 + lane];
    const float psc = a.pool_scale[l * 256 + g * 64 + lane];
    const float* ubg = (const float*)(ws + WS_UB) + g * 64 + lane;
    for (int tile = widx; tile < NTOK / 8; tile += nw) {
        const int tok0 = tile * 8, tp0 = tok0 & (SEQ - 1);
        float row[23];
#pragma unroll
        for (int r = 0; r < 23; ++r) { const int tp = tp0 - 15 + r; row[r] = (tp >= 0) ? ubg[(size_t)(tok0 - 15 + r) * 256] : 0.f; }
        float pooled[8];
#pragma unroll
        for (int t = 0; t < 8; ++t) {
            float sm = 0.f;
#pragma unroll
            for (int i = 0; i < 16; ++i) if (i < w) sm += row[15 + t - i];
            const int tpos = tp0 + t; const int wl = (tpos + 1) < w ? (tpos + 1) : w;
            pooled[t] = sm * (1.0f / (float)wl) - row[15 + t];
        }
        float y[8] = {0.f, 0.f, 0.f, 0.f, 0.f, 0.f, 0.f, 0.f};
#pragma unroll
        for (int c = 0; c < 64; ++c) {
#pragma unroll
            for (int t = 0; t < 8; ++t) y[t] += __builtin_bit_cast(float, __builtin_amdgcn_readlane(__builtin_bit_cast(int, pooled[t]), c)) * pwr[c];
        }
        bf16_t* mo = (bf16_t*)(ws + WS_MIX) + (size_t)tok0 * D + 512 + g * 64 + lane;
#pragma unroll
        for (int t = 0; t < 8; ++t) mo[(size_t)t * D] = (bf16_t)f2bf(y[t] * psc);
    }
}

__device__ __forceinline__ void hgrn_local3(const Args& a, Ctx& C, int l, int item) {
    const int tid = C.tid, cg = item & 15, hh = (item >> 4) & 3, b = item >> 6, v = tid & 63, kq = tid >> 6;
    LAS float* fz = (LAS float*)C.lds; LAS float* kn = fz + 4096; LAS float* vv = kn + 4096;
    float S[8] = {0.f, 0.f, 0.f, 0.f, 0.f, 0.f, 0.f, 0.f}, dp[8] = {1.f, 1.f, 1.f, 1.f, 1.f, 1.f, 1.f, 1.f};
#pragma unroll 1
    for (int ci = 0; ci < 4; ++ci) {
        const int c = 4 * cg + ci;
        hgrn_fill<false>(a, C, l, hh, (size_t)b * SEQ + c * 64, fz, kn, nullptr, vv);
        __syncthreads();
#pragma unroll 4
        for (int sx = 0; sx < 64; ++sx) { const f32x4 f0 = *(const LAS f32x4*)(fz + sx * 64 + 8 * kq), f1 = *(const LAS f32x4*)(fz + sx * 64 + 8 * kq + 4), k0 = *(const LAS f32x4*)(kn + sx * 64 + 8 * kq), k1 = *(const LAS f32x4*)(kn + sx * 64 + 8 * kq + 4);
            const float vs = vv[sx * 64 + v]; const float ff[8] = {f0.x, f0.y, f0.z, f0.w, f1.x, f1.y, f1.z, f1.w}, kk[8] = {k0.x, k0.y, k0.z, k0.w, k1.x, k1.y, k1.z, k1.w};
#pragma unroll
            for (int j = 0; j < 8; ++j) { S[j] = ff[j] * S[j] + kk[j] * vs; dp[j] *= ff[j]; } }
        const size_t ch = (size_t)((b * 4 + hh) * 64 + c);
        float* hr = (float*)(C.ws + WS_HL) + ch * 4096;
#pragma unroll
        for (int j = 0; j < 8; ++j) { const int k = 8 * kq + j, kt = k >> 4, g = (k >> 2) & 3, r = k & 3, vq = v >> 4, cv = v & 15; hr[(((vq * 4 + kt) * 4 + g) * 16 + cv) * 4 + r] = S[j]; }
        if (v == 0) { float* he = (float*)(C.ws + WS_HD) + ch * 64 + 8 * kq;
#pragma unroll
            for (int j = 0; j < 8; ++j) he[j] = dp[j]; }
        __syncthreads();
    }
}
__device__ __forceinline__ float row_shr_add(float x, int) { return x; }
template <int N> __device__ __forceinline__ float dpp_row_shr(float x) { return __builtin_bit_cast(float, __builtin_amdgcn_update_dpp(0, __builtin_bit_cast(int, x), 0x110 + N, 0xF, 0xF, true)); }
__device__ __forceinline__ float row_scan16(float x) { x += dpp_row_shr<1>(x); x += dpp_row_shr<2>(x); x += dpp_row_shr<4>(x); x += dpp_row_shr<8>(x); return x; }
__device__ __forceinline__ float row_last16(float x) { return __builtin_bit_cast(float, __builtin_amdgcn_update_dpp(0, __builtin_bit_cast(int, x), 0x15F, 0xF, 0xF, true)); }
__device__ __forceinline__ float row_sum16(float v) {
    v += __builtin_bit_cast(float, __builtin_amdgcn_update_dpp(0, __builtin_bit_cast(int, v), 0xB1, 0xF, 0xF, true));
    v += __builtin_bit_cast(float, __builtin_amdgcn_update_dpp(0, __builtin_bit_cast(int, v), 0x4E, 0xF, 0xF, true));
    v += __builtin_bit_cast(float, __builtin_amdgcn_update_dpp(0, __builtin_bit_cast(int, v), 0x141, 0xF, 0xF, true));
    v += __builtin_bit_cast(float, __builtin_amdgcn_update_dpp(0, __builtin_bit_cast(int, v), 0x140, 0xF, 0xF, true));
    return v;
}
__device__ __forceinline__ void hgrn_out3(const Args& a, Ctx& C, int l, int item, LAS unsigned char* kls) {
    const int lane = C.lane, tt = lane & 15, g = lane >> 4, c = item & 63, hh = (item >> 6) & 3, b = item >> 8, bh = b * 4 + hh, cg = c >> 2, ci = c & 3;
    const float* HG = (const float*)(C.ws + WS_HG); const float* HR = (const float*)(C.ws + WS_HL); const float* HE = (const float*)(C.ws + WS_HD);
    float lb[16];
#pragma unroll
    for (int e = 0; e < 16; ++e) { const int kk = hh * 64 + 16 * (e >> 2) + 4 * g + (e & 3); lb[e] = (l == 1) ? 1.0f / (1.0f + expf(a.lb_logits[kk] - a.lb_logits[256 + kk])) : 0.f; }
    f32x4 S[4][4];
#pragma unroll
    for (int vq = 0; vq < 4; ++vq)
#pragma unroll
        for (int kt = 0; kt < 4; ++kt) S[vq][kt] = (f32x4){0.f, 0.f, 0.f, 0.f};
    const int nstep = cg + (ci > 0 ? 1 : 0);
#pragma unroll 1
    for (int st = 0; st < nstep; ++st) {
        const int chn = (st < cg) ? (4 * st + 3) : (4 * cg + ci - 1); const size_t ch = (size_t)(bh * 64 + chn);
        const float* hr = HR + ch * 4096 + (g * 16 + tt) * 4; const float* he = HE + ch * 64 + 4 * g;
        f32x4 ev[4];
#pragma unroll
        for (int kt = 0; kt < 4; ++kt) ev[kt] = *(const f32x4*)(he + 16 * kt);
#pragma unroll
        for (int vq = 0; vq < 4; ++vq)
#pragma unroll
            for (int kt = 0; kt < 4; ++kt) S[vq][kt] = S[vq][kt] * ev[kt] + *(const f32x4*)(hr + (vq * 4 + kt) * 256);
    }
    const size_t tok0 = (size_t)b * SEQ + c * 64;
#pragma unroll 1
    for (int sb = 0; sb < 4; ++sb) {
        const size_t tok = tok0 + 16 * sb + tt; const float* row = HG + tok * 1024 + hh * 64 + 4 * g;
        float qh[16], kt_[16], kp[16], dd[16];
#pragma unroll
        for (int e4 = 0; e4 < 4; ++e4) {
            const f32x4 q4 = *(const f32x4*)(row + 16 * e4), z4 = *(const f32x4*)(row + 256 + 16 * e4);
#pragma unroll
            for (int j = 0; j < 4; ++j) { const int e = 4 * e4 + j; const float lbe = lb[e];
                const float sg = __builtin_amdgcn_rcpf(1.0f + __expf(-z4[j])), sn = __builtin_amdgcn_rcpf(1.0f + __expf(z4[j]));
                const float lf = __logf(lbe + (1.0f - lbe) * sg), kin = (1.0f - lbe) * sn;
                const float cc = row_scan16(lf), c15 = row_last16(cc);
                qh[e] = siluf_(q4[j]) * __expf(cc); kt_[e] = kin * __expf(-cc); kp[e] = kin * __expf(c15 - cc); dd[e] = __expf(c15); }
        }
        bf16x8 Qf[2], Kf[2];
#pragma unroll
        for (int ks = 0; ks < 2; ++ks) { u32x4 wq, wk;
            wq.x = pk2(qh[8 * ks + 0], qh[8 * ks + 1]); wq.y = pk2(qh[8 * ks + 2], qh[8 * ks + 3]); wq.z = pk2(qh[8 * ks + 4], qh[8 * ks + 5]); wq.w = pk2(qh[8 * ks + 6], qh[8 * ks + 7]);
            wk.x = pk2(kt_[8 * ks + 0], kt_[8 * ks + 1]); wk.y = pk2(kt_[8 * ks + 2], kt_[8 * ks + 3]); wk.z = pk2(kt_[8 * ks + 4], kt_[8 * ks + 5]); wk.w = pk2(kt_[8 * ks + 6], kt_[8 * ks + 7]);
            Qf[ks] = __builtin_bit_cast(bf16x8, wq); Kf[ks] = __builtin_bit_cast(bf16x8, wk); }
#pragma unroll
        for (int e4 = 0; e4 < 4; ++e4) { u32x2 w; w.x = pk2(kp[4 * e4 + 0], kp[4 * e4 + 1]); w.y = pk2(kp[4 * e4 + 2], kp[4 * e4 + 3]); *(LAS u32x2*)(kls + tt * 144 + (16 * e4 + 4 * g) * 2) = w; }
        f32x4 at = (f32x4){0.f, 0.f, 0.f, 0.f};
        at = __builtin_amdgcn_mfma_f32_16x16x32_bf16(Kf[0], Qf[0], at, 0, 0, 0); at = __builtin_amdgcn_mfma_f32_16x16x32_bf16(Kf[1], Qf[1], at, 0, 0, 0);
#pragma unroll
        for (int r = 0; r < 4; ++r) at[r] = (4 * g + r <= tt) ? at[r] : 0.f;
        u32x4 wa; wa.x = pk2(at[0], at[1]); wa.y = pk2(at[2], at[3]); wa.z = 0u; wa.w = 0u; const bf16x8 Af = __builtin_bit_cast(bf16x8, wa);
        bf16x8 Vf[4];
        { const float* vp = HG + (tok0 + 16 * sb + 4 * g) * 1024 + 512 + hh * 64 + tt;
#pragma unroll
          for (int vq = 0; vq < 4; ++vq) { u32x4 w; w.x = pk2(vp[16 * vq], vp[1024 + 16 * vq]); w.y = pk2(vp[2048 + 16 * vq], vp[3072 + 16 * vq]); w.z = 0u; w.w = 0u; Vf[vq] = __builtin_bit_cast(bf16x8, w); } }
        f32x4 O[4];
#pragma unroll
        for (int vq = 0; vq < 4; ++vq) {
            u32x4 s0, s1; s0.x = pk2(S[vq][0][0], S[vq][0][1]); s0.y = pk2(S[vq][0][2], S[vq][0][3]); s0.z = pk2(S[vq][1][0], S[vq][1][1]); s0.w = pk2(S[vq][1][2], S[vq][1][3]);
            s1.x = pk2(S[vq][2][0], S[vq][2][1]); s1.y = pk2(S[vq][2][2], S[vq][2][3]); s1.z = pk2(S[vq][3][0], S[vq][3][1]); s1.w = pk2(S[vq][3][2], S[vq][3][3]);
            f32x4 o = (f32x4){0.f, 0.f, 0.f, 0.f};
            o = __builtin_amdgcn_mfma_f32_16x16x32_bf16(Qf[0], __builtin_bit_cast(bf16x8, s0), o, 0, 0, 0); o = __builtin_amdgcn_mfma_f32_16x16x32_bf16(Qf[1], __builtin_bit_cast(bf16x8, s1), o, 0, 0, 0);
            o = __builtin_amdgcn_mfma_f32_16x16x32_bf16(Af, Vf[vq], o, 0, 0, 0); O[vq] = o; }
        { float rs[4];
#pragma unroll
          for (int r = 0; r < 4; ++r) { float ss = O[0][r] * O[0][r] + O[1][r] * O[1][r] + O[2][r] * O[2][r] + O[3][r] * O[3][r]; ss = row_sum16(ss); rs[r] = 1.0f / sqrtf(ss * (1.0f / 64.0f) + EPS); }
          const float* gp = HG + (tok0 + 16 * sb + 4 * g) * 1024 + 768 + hh * 64 + tt; bf16_t* mo = (bf16_t*)(C.ws + WS_MIX) + (tok0 + 16 * sb + 4 * g) * D + 768 + hh * 64 + tt;
#pragma unroll
          for (int vq = 0; vq < 4; ++vq) { const float ngv = a.hgrn_g[l * 64 + 16 * vq + tt];
#pragma unroll
            for (int r = 0; r < 4; ++r) mo[(size_t)r * D + 16 * vq] = (bf16_t)f2bf(O[vq][r] * rs[r] * ngv * siluf_(gp[(size_t)r * 1024 + 16 * vq])); } }
        asm volatile("s_waitcnt lgkmcnt(0)" ::: "memory");
#pragma unroll
        for (int kt = 0; kt < 4; ++kt) {
            const s16x4 t4 = __builtin_amdgcn_ds_read_tr16_b64_v4i16((LAS s16x4*)(kls + (4 * g + (tt >> 2)) * 144 + (16 * kt + 4 * (tt & 3)) * 2));
            const bf16x8 Ktf = (bf16x8){t4[0], t4[1], t4[2], t4[3], 0, 0, 0, 0};
            const f32x4 dv = (f32x4){dd[4 * kt + 0], dd[4 * kt + 1], dd[4 * kt + 2], dd[4 * kt + 3]};
#pragma unroll
            for (int vq = 0; vq < 4; ++vq) S[vq][kt] = __builtin_amdgcn_mfma_f32_16x16x32_bf16(Ktf, Vf[vq], S[vq][kt] * dv, 0, 0, 0);
        }
        asm volatile("s_waitcnt lgkmcnt(0)" ::: "memory");
    }
}

__device__ __forceinline__ void phase_mix1(const Args& a, Ctx& C, int l) {
#ifndef MIX1MASK
#define MIX1MASK 7
#endif
#ifndef MIX1REP
#define MIX1REP 0
#endif
#ifndef HGRN3
#define HGRN3 1
#endif
    if (HGRN3) { for (int rep = 0; rep < ((MIX1REP & 1) && l == 0 ? 2 : 1); ++rep) for (int it = blockIdx.x; it < 256; it += C.G) hgrn_local3(a, C, l, it); }
    else for (int rep = 0; rep < ((MIX1REP & 1) && l == 0 ? 2 : 1); ++rep) for (int it = blockIdx.x; it < 1024; it += C.G) hgrn_local2(a, C, l, it);
    for (int rep = 0; rep < ((MIX1REP & 2) && l == 0 ? 2 : 1); ++rep) pool_wave(a, C, l);
    __syncthreads();
    for (int rep = 0; rep < ((MIX1REP & 4) && l == 0 ? 2 : 1); ++rep) for (int base = 0; base < 2048; base += 2 * C.G) {
        const int u1 = base + (int)blockIdx.x, u2 = base + 2 * C.G - 1 - (int)blockIdx.x;
        if (u1 < 2048) index_unit2(C, (u1 >> 3) & 3, u1 >> 5, u1 & 7);
        if (u2 < 2048) index_unit2(C, (u2 >> 3) & 3, u2 >> 5, u2 & 7);
    }
}
__device__ __forceinline__ void phase_mix2(const Args& a, Ctx& C, int l) {
#ifndef MIX2MASK
#define MIX2MASK 3
#endif
#ifndef MIX2REP
#define MIX2REP 0
#endif
    LAS int* qctr = (LAS int*)(C.lds + LDS_BYTES - 64 + 16);
    if (C.tid == 0) *qctr = 0;
    __syncthreads();
    if (HGRN3) { for (int rep = 0; rep < ((MIX2REP & 1) ? 2 : 1); ++rep) if (C.wave < 4) for (int it = blockIdx.x * 4 + C.wave; it < 1024; it += C.G * 4) hgrn_out3(a, C, l, it, C.lds + C.wave * (2 * 32 * VROW)); }
    else for (int rep = 0; rep < ((MIX2REP & 1) ? 2 : 1); ++rep) for (int it = blockIdx.x; it < 256; it += C.G) hgrn_out2(a, C, l, it);
    LAS unsigned char* vs = C.lds + C.wave * (2 * 32 * VROW);
    const int gw = blockIdx.x * NWAVES + C.wave, NGW = C.G * NWAVES;
    Conv cv; cv.w1l = a.w1 + (size_t)l * 32 * 1024 * 2048; cv.w2l = a.w2 + (size_t)l * 32 * 1024 * 1024; cv.w1t = (bf16_t*)(C.ws + WS_W1) + (size_t)l * 32 * 2048 * 1024; cv.w2t = (bf16_t*)(C.ws + WS_W2) + (size_t)l * 32 * 1024 * 1024;
    cv.it = gw; cv.step = NGW; cv.lane = C.lane; cv.pend = false;
    for (;;) {
        int n = 0; if (C.lane == 0) n = __hip_atomic_fetch_add(qctr, 1, __ATOMIC_RELAXED, __HIP_MEMORY_SCOPE_WORKGROUP);
        n = __builtin_amdgcn_readfirstlane(n);
        const int tk = (int)blockIdx.x * NWAVES + (n & 7) + NGW * (n >> 3);
        if (tk >= NTOK) break;
        attend_query_mfma(C, tk, vs, cv);
    }
    while (cv.pend || cv.it < Conv::NITEMS) { cv.finish((LAS float*)vs); cv.issue(); }
}

__device__ __forceinline__ void phase_router(const Args& a, Ctx& C, int l) {
    unsigned char* ws = C.ws; const int lane = C.lane;
    LAS float* us = (LAS float*)(C.lds + C.wave * 8192);
    const float* mod = (const float*)(ws + WS_MOD); const float* H = (const float*)(ws + WS_H);
    const float* wr = a.w_router + (size_t)l * 1024 * 32; unsigned* cnt = (unsigned*)(ws + WS_CTL) + CW_CNT + l * 32 * 64;
    const int gw = blockIdx.x * NWAVES + C.wave, NGW = C.G * NWAVES;
    for (int base = gw * 2; base < NTOK; base += NGW * 2) {
#pragma unroll
        for (int hf = 0; hf < 2; ++hf) {
            const int tk = base + hf, b = tk >> 12; const f32x4* hr = (const f32x4*)(H + (size_t)tk * D) + lane; f32x4 v[4];
#pragma unroll
            for (int j = 0; j < 4; ++j) v[j] = hr[64 * j];
            float ss = 0.f;
#pragma unroll
            for (int j = 0; j < 4; ++j) ss += (v[j].x * v[j].x + v[j].y * v[j].y) + (v[j].z * v[j].z + v[j].w * v[j].w);
            const float rstd = 1.0f / sqrtf(wave_sum(ss) * (1.0f / D) + EPS);
            const float* mb = mod + (size_t)(l * 4 + b) * 6144; bf16_t* urow = (bf16_t*)(ws + WS_U) + (size_t)tk * D;
#pragma unroll
            for (int j = 0; j < 4; ++j) { const int idx = 4 * lane + 256 * j; const f32x4 gv = *(const f32x4*)(a.norm2_g + l * 1024 + idx), shv = *(const f32x4*)(mb + 3072 + idx), scv = *(const f32x4*)(mb + 4096 + idx);
                const f32x4 o = v[j] * rstd * gv * (scv + 1.0f) + shv; u32x2 w; w.x = pk2(o[0], o[1]); w.y = pk2(o[2], o[3]); *(u32x2*)(urow + idx) = w;
                *(LAS f32x4*)(us + hf * 1024 + idx) = o; }
        }
        asm volatile("s_waitcnt lgkmcnt(0)" ::: "memory"); __builtin_amdgcn_wave_barrier();
        const int e = lane & 31, hf = lane >> 5; float acc0 = 0.f, acc1 = 0.f;
        const LAS float* up = us + hf * 1024;
#pragma unroll 8
        for (int d = 0; d < 1024; d += 2) { acc0 += up[d] * wr[d * 32 + e]; acc1 += up[d + 1] * wr[(d + 1) * 32 + e]; }
        float val = acc0 + acc1 + a.b_router[l * 32 + e];
        float tv[4]; int te[4];
#pragma unroll
        for (int k = 0; k < 4; ++k) {
            float bv = val; int bi = e;
#pragma unroll
            for (int o = 1; o < 32; o <<= 1) { const float ov = __shfl_xor(bv, o); const int oi = __shfl_xor(bi, o); if (ov > bv || (ov == bv && oi < bi)) { bv = ov; bi = oi; } }
            tv[k] = bv; te[k] = bi; if (e == bi) val = -3.0e38f;
        }
        const float e1 = __expf(tv[1] - tv[0]), e2 = __expf(tv[2] - tv[0]), e3 = __expf(tv[3] - tv[0]); const float rs = 1.0f / (1.0f + e1 + e2 + e3);
        if (e < 4) {
            const int tk = base + hf; const int ex = e == 0 ? te[0] : e == 1 ? te[1] : e == 2 ? te[2] : te[3]; const float gt = (e == 0 ? 1.0f : e == 1 ? e1 : e == 2 ? e2 : e3) * rs;
            const unsigned slot = atomicAdd(cnt + ex * 64, 1u);
            ((int*)(ws + WS_ROWTOK))[(size_t)ex * NTOK + slot] = tk;
            ((int*)(ws + WS_EIDX))[tk * 4 + e] = ex; ((int*)(ws + WS_SLOT))[tk * 4 + e] = (int)slot; ((float*)(ws + WS_GATE))[tk * 4 + e] = gt;
        }
        asm volatile("s_waitcnt lgkmcnt(0)" ::: "memory"); __builtin_amdgcn_wave_barrier();
    }
}

constexpr int URS = 2064;
__device__ __forceinline__ void phase_router2(const Args& a, Ctx& C, int l) {
    unsigned char* ws = C.ws; const int lane = C.lane, w = C.wave, tid = C.tid;
    LAS unsigned char* uh = C.lds; LAS unsigned char* ul = uh + 16 * URS; LAS float* part = (LAS float*)(ul + 16 * URS);
    LAS int* hist = (LAS int*)(part + 8 * 16 * 32);
    LAS int* asg = hist + 64;
    LAS float* asgg = (LAS float*)(asg + 2 * 1024);
    const float* mod = (const float*)(ws + WS_MOD); const float* H = (const float*)(ws + WS_H);
    const bf16_t* wrh = (const bf16_t*)(ws + WS_WRH) + (size_t)l * 32768; const bf16_t* wrl = (const bf16_t*)(ws + WS_WRL) + (size_t)l * 32768;
    unsigned* cnt = (unsigned*)(ws + WS_CTL) + CW_CNT + l * 32 * 64;
    const int ntile_all = NTOK / 16;
    for (int tile0 = blockIdx.x; tile0 < ntile_all; tile0 += 16 * C.G) {
        if (tid < 64) hist[tid] = 0;
        __syncthreads();
        int nt_here = 0;
        f32x4 hv[2][4];
#pragma unroll
        for (int hf = 0; hf < 2; ++hf) { const f32x4* hr = (const f32x4*)(H + (size_t)(tile0 * 16 + 2 * w + hf) * D) + lane;
#pragma unroll
            for (int j = 0; j < 4; ++j) hv[hf][j] = hr[64 * j]; }
        for (int tile = tile0; tile < ntile_all && nt_here < 16; tile += C.G, ++nt_here) {
            const int tok0 = tile * 16;
#pragma unroll
            for (int hf = 0; hf < 2; ++hf) {
                const int tr = 2 * w + hf, tk = tok0 + tr, b = tk >> 12; f32x4 v[4];
#pragma unroll
                for (int j = 0; j < 4; ++j) v[j] = hv[hf][j];
                float ss = 0.f;
#pragma unroll
                for (int j = 0; j < 4; ++j) ss += (v[j].x * v[j].x + v[j].y * v[j].y) + (v[j].z * v[j].z + v[j].w * v[j].w);
                const float rstd = 1.0f / sqrtf(wave_sum(ss) * (1.0f / D) + EPS);
                const float* mb = mod + (size_t)(l * 4 + b) * 6144; bf16_t* urow = (bf16_t*)(ws + WS_U) + (size_t)tk * D;
#pragma unroll
                for (int j = 0; j < 4; ++j) { const int idx = 4 * lane + 256 * j; const f32x4 gv = *(const f32x4*)(a.norm2_g + l * 1024 + idx), shv = *(const f32x4*)(mb + 3072 + idx), scv = *(const f32x4*)(mb + 4096 + idx);
                    const f32x4 o = v[j] * rstd * gv * (scv + 1.0f) + shv; u32x2 hi; hi.x = pk2(o[0], o[1]); hi.y = pk2(o[2], o[3]); *(u32x2*)(urow + idx) = hi;
                    u32x2 lo; lo.x = pk2(o[0] - bflo(hi.x), o[1] - bfhi(hi.x)); lo.y = pk2(o[2] - bflo(hi.y), o[3] - bfhi(hi.y));
                    *(LAS u32x2*)(uh + tr * URS + idx * 2) = hi; *(LAS u32x2*)(ul + tr * URS + idx * 2) = lo; }
            }
            { const int ntile2 = tile + C.G; if (ntile2 < ntile_all && nt_here + 1 < 16) {
#pragma unroll
                for (int hf = 0; hf < 2; ++hf) { const f32x4* hr = (const f32x4*)(H + (size_t)(ntile2 * 16 + 2 * w + hf) * D) + lane;
#pragma unroll
                    for (int j = 0; j < 4; ++j) hv[hf][j] = hr[64 * j]; } } }
            __syncthreads();
            {
                const int c = lane & 15, g = lane >> 4; f32x4 acc0 = (f32x4){0.f, 0.f, 0.f, 0.f}, acc1 = acc0;
#pragma unroll
                for (int kk = 0; kk < 4; ++kk) { const int ks = 4 * w + kk;
                    const bf16x8 ah = *(const LAS bf16x8*)(uh + c * URS + (32 * ks + 8 * g) * 2), al = *(const LAS bf16x8*)(ul + c * URS + (32 * ks + 8 * g) * 2);
                    const bf16x8 bh0 = *(const bf16x8*)(wrh + (size_t)c * 1024 + 32 * ks + 8 * g), bl0 = *(const bf16x8*)(wrl + (size_t)c * 1024 + 32 * ks + 8 * g);
                    const bf16x8 bh1 = *(const bf16x8*)(wrh + (size_t)(c + 16) * 1024 + 32 * ks + 8 * g), bl1 = *(const bf16x8*)(wrl + (size_t)(c + 16) * 1024 + 32 * ks + 8 * g);
                    acc0 = __builtin_amdgcn_mfma_f32_16x16x32_bf16(al, bh0, acc0, 0, 0, 0); acc0 = __builtin_amdgcn_mfma_f32_16x16x32_bf16(ah, bl0, acc0, 0, 0, 0); acc0 = __builtin_amdgcn_mfma_f32_16x16x32_bf16(ah, bh0, acc0, 0, 0, 0);
                    acc1 = __builtin_amdgcn_mfma_f32_16x16x32_bf16(al, bh1, acc1, 0, 0, 0); acc1 = __builtin_amdgcn_mfma_f32_16x16x32_bf16(ah, bl1, acc1, 0, 0, 0); acc1 = __builtin_amdgcn_mfma_f32_16x16x32_bf16(ah, bh1, acc1, 0, 0, 0); }
#pragma unroll
                for (int r = 0; r < 4; ++r) { part[(w * 16 + 4 * g + r) * 32 + c] = acc0[r]; part[(w * 16 + 4 * g + r) * 32 + 16 + c] = acc1[r]; }
            }
            __syncthreads();
            {
                const int e = lane & 31, hf = lane >> 5, tr = 2 * w + hf; float val = a.b_router[l * 32 + e];
#pragma unroll
                for (int ww = 0; ww < 8; ++ww) val += part[(ww * 16 + tr) * 32 + e];
                float tv[4]; int te[4];
#pragma unroll
                for (int k = 0; k < 4; ++k) {
                    float bv = val; int bi = e;
#pragma unroll
                    for (int o = 1; o < 32; o <<= 1) { const float ov = __shfl_xor(bv, o); const int oi = __shfl_xor(bi, o); if (ov > bv || (ov == bv && oi < bi)) { bv = ov; bi = oi; } }
                    tv[k] = bv; te[k] = bi; if (e == bi) val = -3.0e38f;
                }
                const float e1 = __expf(tv[1] - tv[0]), e2 = __expf(tv[2] - tv[0]), e3 = __expf(tv[3] - tv[0]); const float rs = 1.0f / (1.0f + e1 + e2 + e3);
                if (e < 4) {
                    const int ex = e == 0 ? te[0] : e == 1 ? te[1] : e == 2 ? te[2] : te[3]; const float gt = (e == 0 ? 1.0f : e == 1 ? e1 : e == 2 ? e2 : e3) * rs;
                    const int ai = (nt_here * 16 + tr) * 4 + e;
                    asg[2 * ai] = ex; asg[2 * ai + 1] = __hip_atomic_fetch_add(&hist[ex], 1, __ATOMIC_RELAXED, __HIP_MEMORY_SCOPE_WORKGROUP); asgg[ai] = gt;
                }
            }
            __syncthreads();
        }
        if (tid < 32) { const int hc = hist[tid]; hist[32 + tid] = hc ? (int)atomicAdd(cnt + tid * 64, (unsigned)hc) : 0; }
        __syncthreads();
        for (int ai = tid; ai < nt_here * 64; ai += NTHREADS) {
            const int ti = ai >> 6, tr = (ai >> 2) & 15, k = ai & 3, tk = (tile0 + ti * C.G) * 16 + tr;
            const int ex = asg[2 * ai], slot = hist[32 + ex] + asg[2 * ai + 1];
            ((int*)(ws + WS_ROWTOK))[(size_t)ex * NTOK + slot] = tk;
            ((int*)(ws + WS_EIDX))[tk * 4 + k] = ex; ((int*)(ws + WS_SLOT))[tk * 4 + k] = slot; ((float*)(ws + WS_GATE))[tk * 4 + k] = asgg[ai];
        }
        __syncthreads();
    }
}

__device__ __forceinline__ void moe_table(Ctx& C, int l, LAS int* tab) {
    if (C.tid < 32) { const unsigned* cnt = (const unsigned*)(C.ws + WS_CTL) + CW_CNT + l * 32 * 64; tab[33 + C.tid] = (int)__hip_atomic_load(cnt + C.tid * 64, __ATOMIC_RELAXED, __HIP_MEMORY_SCOPE_AGENT); }
    __syncthreads();
    if (C.tid == 0) { int p = 0; for (int e = 0; e < 32; ++e) { tab[e] = p; p += (tab[33 + e] + 255) >> 8; } tab[32] = p; }
    __syncthreads();
}

__device__ __forceinline__ void phase_combine(const Args& a, Ctx& C, int l) {
    unsigned char* ws = C.ws; const int lane = C.lane;
    const float* mod = (const float*)(ws + WS_MOD); float* H = (float*)(ws + WS_H); const bf16_t* Y = (const bf16_t*)(ws + WS_Y);
    const unsigned* cnt = (const unsigned*)(ws + WS_CTL) + CW_CNT + l * 32 * 64;
    int mt = 0; if (lane < 32) mt = ((int)__hip_atomic_load(cnt + lane * 64, __ATOMIC_RELAXED, __HIP_MEMORY_SCOPE_AGENT) + 255) >> 8;
    int incl = mt;
#pragma unroll
    for (int o = 1; o < 32; o <<= 1) { const int t = __shfl_up(incl, o); if ((lane & 31) >= o) incl += t; }
    const int excl = incl - mt;
    const int gw = blockIdx.x * NWAVES + C.wave, NGW = C.G * NWAVES;
    for (int tk0 = gw; tk0 < NTOK; tk0 += 2 * NGW) {
        int tks[2]; tks[0] = tk0; tks[1] = (tk0 + NGW) < NTOK ? tk0 + NGW : tk0; const bool two = (tk0 + NGW) < NTOK;
        f32x4 v[2][4]; u32x2 yv[2][4][4]; float gts[2][4];
#pragma unroll
        for (int q = 0; q < 2; ++q) { const int tk = tks[q]; const f32x4* hr = (const f32x4*)(H + (size_t)tk * D) + lane;
#pragma unroll
            for (int j = 0; j < 4; ++j) v[q][j] = hr[64 * j];
            const int4 ex4 = *(const int4*)((const int*)(ws + WS_EIDX) + tk * 4), sl4 = *(const int4*)((const int*)(ws + WS_SLOT) + tk * 4); const f32x4 g4 = *(const f32x4*)((const float*)(ws + WS_GATE) + tk * 4);
            const int exs[4] = {ex4.x, ex4.y, ex4.z, ex4.w}, sls[4] = {sl4.x, sl4.y, sl4.z, sl4.w};
#pragma unroll
            for (int k = 0; k < 4; ++k) { gts[q][k] = g4[k]; const int row = 256 * __shfl(excl, exs[k]) + sls[k]; const u32x2* yr = (const u32x2*)(Y + (size_t)row * D) + lane;
#pragma unroll
                for (int j = 0; j < 4; ++j) yv[q][k][j] = yr[64 * j]; }
        }
#pragma unroll
        for (int q = 0; q < 2; ++q) {
            if (q == 1 && !two) break;
            const int tk = tks[q], b = tk >> 12; f32x4* hr = (f32x4*)(H + (size_t)tk * D) + lane;
            f32x4 m[4];
#pragma unroll
            for (int j = 0; j < 4; ++j) m[j] = (f32x4){0.f, 0.f, 0.f, 0.f};
#pragma unroll
            for (int k = 0; k < 4; ++k)
#pragma unroll
                for (int j = 0; j < 4; ++j) { const u32x2 w = yv[q][k][j]; m[j] += (f32x4){bflo(w.x), bfhi(w.x), bflo(w.y), bfhi(w.y)} * gts[q][k]; }
            const float* mb = mod + (size_t)(l * 4 + b) * 6144;
            f32x4 vv[4];
#pragma unroll
            for (int j = 0; j < 4; ++j) { const f32x4 g2 = *(const f32x4*)(mb + 5120 + 4 * lane + 256 * j); vv[j] = v[q][j] + g2 * m[j]; if (l + 1 < DEPTH) hr[64 * j] = vv[j]; }
            if (l + 1 < DEPTH) { const float* mn = mod + (size_t)((l + 1) * 4 + b) * 6144; norm_mod_store(vv, a.norm1_g + (l + 1) * 1024, mn + 0, mn + 1024, (bf16_t*)(ws + WS_U) + (size_t)tk * D, lane); }
            else {
                float ss = 0.f;
#pragma unroll
                for (int j = 0; j < 4; ++j) ss += (vv[j].x * vv[j].x + vv[j].y * vv[j].y) + (vv[j].z * vv[j].z + vv[j].w * vv[j].w);
                const float rstd = 1.0f / sqrtf(wave_sum(ss) * (1.0f / D) + EPS);
                f32x4* orow = (f32x4*)(a.out + (size_t)tk * D) + lane;
#pragma unroll
                for (int j = 0; j < 4; ++j) orow[64 * j] = vv[j] * rstd * *(const f32x4*)(a.final_g + 4 * lane + 256 * j);
            }
        }
    }
}

#define XB_TMO      128
#define XB_XCNT(j)  (256  + 64 * (j))
#define XB_XSUB(j)  (1280 + 64 * (j))
#define XB_XGEN(j)  (2304 + 64 * (j))
#define XB_TOP      3328
#define XB_TOPGEN   3392
#define XCD_BAR_WORDS 3456
#define XB_SPIN_CAP (1u << 22)
__device__ __forceinline__ unsigned xb_ld(unsigned* p)              { return __hip_atomic_load(p, __ATOMIC_RELAXED, __HIP_MEMORY_SCOPE_AGENT); }
__device__ __forceinline__ unsigned xb_add(unsigned* p, unsigned v) { return __hip_atomic_fetch_add(p, v, __ATOMIC_RELAXED, __HIP_MEMORY_SCOPE_AGENT); }
__device__ __forceinline__ unsigned xb_xcc_id() { return (unsigned)__builtin_amdgcn_s_getreg((3 << 11) | 20) & 0xFu; }
#define XB_SPIN(cond, bar) do { unsigned _sp = 0; while (cond) { __builtin_amdgcn_s_sleep(1); \
    if ((++_sp & 255u) == 0u) { if (xb_ld(&(bar)[XB_TMO])) break; if (_sp > XB_SPIN_CAP) { atomicAdd(&(bar)[XB_TMO], 1u); break; } } } } while (0)
struct XcdBarrier { unsigned* bar; unsigned x; volatile LAS unsigned* st; };
__device__ __forceinline__ XcdBarrier xcd_barrier_post(unsigned* bar, volatile LAS unsigned* st, bool leader) {
    XcdBarrier b; b.bar = bar; b.x = xb_xcc_id(); b.st = st;
    if (leader) (void)xb_add(&bar[XB_XCNT(b.x)], 1u);
    return b;
}
__device__ __forceinline__ void xcd_barrier_complete(unsigned* bar, unsigned x, unsigned& nloc, unsigned& nx) {
    const unsigned G = gridDim.x * gridDim.y * gridDim.z;
    unsigned sum, cnt, mine, sp = 0u;
    for (;;) {
        sum = 0u; cnt = 0u; mine = 0u;
#pragma unroll
        for (unsigned j = 0; j < 16; ++j) { const unsigned c = xb_ld(&bar[XB_XCNT(j)]); sum += c; cnt += (c > 0u) ? 1u : 0u; mine = (j == x) ? c : mine; }
        if (sum == G) break;
        __builtin_amdgcn_s_sleep(1);
        if ((++sp & 255u) == 0u) { if (xb_ld(&bar[XB_TMO])) break; if (sp > XB_SPIN_CAP) { atomicAdd(&bar[XB_TMO], 1u); break; } }
    }
    nloc = mine > 0u ? mine : 1u; nx = cnt > 0u ? cnt : 1u;
}
__device__ __forceinline__ void xcd_barrier(const XcdBarrier& b, bool leader) {
    asm volatile("s_waitcnt vmcnt(0)" ::: "memory");
    __syncthreads();
    if (leader) {
        unsigned* bar = b.bar;
        __builtin_amdgcn_s_waitcnt(0);
        unsigned nloc = b.st[0], nx = b.st[1];
        if (nloc == 0u) { xcd_barrier_complete(bar, b.x, nloc, nx); b.st[0] = nloc; b.st[1] = nx; }
        const unsigned old = xb_add(&bar[XB_XSUB(b.x)], 1u);
        const unsigned gen = old / nloc;
        if (old + 1u == (gen + 1u) * nloc) {
            __builtin_amdgcn_fence(__ATOMIC_RELEASE, "agent");
            asm volatile("s_waitcnt vmcnt(0)" ::: "memory");
            const unsigned og = xb_add(&bar[XB_TOP], 1u);
            const unsigned tg = og / nx;
            if (og + 1u == (tg + 1u) * nx) xb_add(&bar[XB_TOPGEN], 1u);
            else XB_SPIN(xb_ld(&bar[XB_TOPGEN]) == tg, bar);
            __builtin_amdgcn_fence(__ATOMIC_ACQUIRE, "agent");
            xb_add(&bar[XB_XGEN(b.x)], 1u);
            asm volatile("s_waitcnt vmcnt(0)" ::: "memory");
        } else {
            XB_SPIN(xb_ld(&bar[XB_XGEN(b.x)]) == gen, bar);
            __builtin_amdgcn_fence(__ATOMIC_ACQUIRE, "agent");
            asm volatile("s_waitcnt vmcnt(0)" ::: "memory");
        }
    }
    __syncthreads();
}

typedef const __attribute__((address_space(4))) Args* KArgsPtr;
__device__ __forceinline__ Args load_args() {
#if defined(__HIP_DEVICE_COMPILE__)
    KArgsPtr p = (KArgsPtr)__builtin_amdgcn_kernarg_segment_ptr(); asm volatile("" : "+s"(p)); Args a;
    a.x = p->x; a.c = p->c; a.pos = p->pos; a.w_ada = p->w_ada; a.b_ada = p->b_ada; a.norm1_g = p->norm1_g; a.norm2_g = p->norm2_g; a.w_in = p->w_in; a.w_out = p->w_out; a.pool_w = p->pool_w;
    a.pool_scale = p->pool_scale; a.hgrn_g = p->hgrn_g; a.lb_logits = p->lb_logits; a.w_router = p->w_router; a.b_router = p->b_router; a.w1 = p->w1; a.b1 = p->b1; a.w2 = p->w2; a.b2 = p->b2; a.final_g = p->final_g;
    a.out = p->out; a.ws = p->ws; a.ph_lo = p->ph_lo; a.ph_hi = p->ph_hi; return a;
#else
    return Args{};
#endif
}
__device__ __forceinline__ int lane_id() { return __builtin_amdgcn_mbcnt_hi(~0u, __builtin_amdgcn_mbcnt_lo(~0u, 0)); }
__device__ __forceinline__ Ctx make_ctx(unsigned char* ws, int wv) {
    extern __shared__ __attribute__((aligned(16))) unsigned char lds_raw[];
    Ctx C; C.lds = (LAS unsigned char*)lds_raw; { int l_ = lane_id(); asm volatile("" : "+v"(l_)); C.lane = l_; } C.wave = wv; C.tid = wv * 64 + C.lane;
    C.G = gridDim.x; { const int bx = blockIdx.x; C.vcu = (C.G % 8 == 0) ? (bx % 8) * (C.G / 8) + bx / 8 : bx; }
    C.ws = ws; return C;
}
#ifndef PHASE_FN
#define PHASE_FN __device__ __forceinline__ void
#endif
#define GEMM_FN __device__ __forceinline__ void
PHASE_FN ph_prep(int wv) { const Args a = load_args(); Ctx C = make_ctx(a.ws, wv); phase_prep(a, C); }
PHASE_FN ph_u0(int wv) { const Args a = load_args(); Ctx C = make_ctx(a.ws, wv); phase_u0(a, C); }
GEMM_FN ph_gin(int l, int wv) { const Args a = load_args(); Ctx C = make_ctx(a.ws, wv); unsigned char* ws = a.ws;
    DenseOrder S{(const char*)(ws + WS_U), (const char*)(ws + WS_WIN) + (size_t)l * NPAD * 1024 * 2, NTOK / 256, NPAD / 256, (NTOK / 256) * (NPAD / 256), C.G, (int)blockIdx.x};
    EpiIn E{ws}; pg8::gemm_phase<EpiIn, DenseOrder, false, true>(C.lds, (LAS unsigned*)(C.lds + LDS_PARK), C.tid, S, E); }
PHASE_FN ph_mix1(int l, int wv) { const Args a = load_args(); Ctx C = make_ctx(a.ws, wv); phase_mix1(a, C, l); }
PHASE_FN ph_mix2(int l, int wv) { const Args a = load_args(); Ctx C = make_ctx(a.ws, wv); phase_mix2(a, C, l); }
GEMM_FN ph_gout(int l, int wv) { const Args a = load_args(); Ctx C = make_ctx(a.ws, wv); unsigned char* ws = a.ws;
    DenseOrder S{(const char*)(ws + WS_MIX), (const char*)(ws + WS_WOUT) + (size_t)l * 1024 * 1024 * 2, NTOK / 256, 4, (NTOK / 256) * 4, C.G, (int)blockIdx.x};
    EpiOut E{l == 0 ? a.x : (const float*)(ws + WS_H), (float*)(ws + WS_H), (const float*)(ws + WS_MOD) + (size_t)l * 4 * 6144 + 2048};
    pg8::gemm_phase<EpiOut, DenseOrder, false, true>(C.lds, (LAS unsigned*)(C.lds + LDS_PARK), C.tid, S, E); }
PHASE_FN ph_router(int l, int wv) { const Args a = load_args(); Ctx C = make_ctx(a.ws, wv); phase_router2(a, C, l); }
GEMM_FN ph_g1(int l, int wv) { const Args a = load_args(); Ctx C = make_ctx(a.ws, wv); unsigned char* ws = a.ws;
    LAS int* tab = (LAS int*)(C.lds + LDS_TAB); moe_table(C, l, tab);
    MoeOrder<true> S{tab, (const char*)(ws + WS_U), (const char*)(ws + WS_W1) + (size_t)l * 32 * 2048 * 1024 * 2, (const int*)(ws + WS_ROWTOK), C.G, C.vcu};
    EpiG1 E{(bf16_t*)(ws + WS_ACT), a.b1 + (size_t)l * 32 * 2048}; pg8::gemm_phase<EpiG1, MoeOrder<true>, true, true>(C.lds, (LAS unsigned*)(C.lds + LDS_PARK), C.tid, S, E); }
GEMM_FN ph_g2(int l, int wv) { const Args a = load_args(); Ctx C = make_ctx(a.ws, wv); unsigned char* ws = a.ws;
    LAS int* tab = (LAS int*)(C.lds + LDS_TAB); moe_table(C, l, tab);
    MoeOrder<false> S{tab, (const char*)(ws + WS_ACT), (const char*)(ws + WS_W2) + (size_t)l * 32 * 1024 * 1024 * 2, nullptr, C.G, C.vcu};
    EpiG2 E{(bf16_t*)(ws + WS_Y), a.b2 + (size_t)l * 32 * 1024}; pg8::gemm_phase<EpiG2, MoeOrder<false>, false, true>(C.lds, (LAS unsigned*)(C.lds + LDS_PARK), C.tid, S, E); }
PHASE_FN ph_combine(int l, int wv) { const Args a = load_args(); Ctx C = make_ctx(a.ws, wv); phase_combine(a, C, l); }

constexpr int NPHASES = 2 + 8 * DEPTH;
__global__ void __launch_bounds__(NTHREADS, 2) mega_fwd(Args a) {
#if MK_ONE_LAUNCH == 1
    cg::grid_group grid = cg::this_grid();
#define SEAM() do { __syncthreads(); grid.sync(); } while (0)
#elif MK_ONE_LAUNCH == 2
    extern __shared__ __attribute__((aligned(16))) unsigned char lds_k[];
    volatile LAS unsigned* bst = (volatile LAS unsigned*)((LAS unsigned char*)lds_k + LDS_BYTES - 64);
    const bool leader = (threadIdx.x == 0);
    if (leader) { bst[0] = 0u; bst[1] = 0u; }
    __syncthreads();
    const XcdBarrier xbar = xcd_barrier_post((unsigned*)(a.ws + WS_CTL) + CW_BAR, bst, leader);
#define SEAM() xcd_barrier(xbar, leader)
#else
#define SEAM() do { } while (0)
#endif
    const int lo = a.ph_lo, hi = a.ph_hi;
    const int wv = __builtin_amdgcn_readfirstlane((int)threadIdx.x >> 6);
#ifndef KINDMASK
#define KINDMASK 0xffffu
#endif
#define KON(k) (((KINDMASK) >> (k)) & 1u)
#ifndef REP_ID
#define REP_ID -1
#endif
#ifndef STAMP_K
#define STAMP_K -1
#endif
#define CW_STAMP 512
#ifndef STAMP_OFF
#define STAMP_OFF 0.0f
#define STAMP_SCALE 5e-3f
#endif
#define RUN(kind, id, call) do { if (KON(kind) && lo <= (id) && (id) < hi) { call; if ((id) == REP_ID) { __syncthreads(); call; } if ((id) + 1 < hi || STAMP_K >= 0) SEAM(); \
        if (STAMP_K >= 0 && blockIdx.x == 0 && threadIdx.x == 0) { const unsigned long long _t = __builtin_amdgcn_s_memrealtime(); __hip_atomic_store((unsigned long long*)(a.ws + WS_CTL) + CW_STAMP / 2 + 1 + (id), _t, __ATOMIC_RELAXED, __HIP_MEMORY_SCOPE_AGENT); } } } while (0)
    if (STAMP_K >= 0) { if (blockIdx.x == 0 && threadIdx.x == 0) { const unsigned long long _t = __builtin_amdgcn_s_memrealtime(); __hip_atomic_store((unsigned long long*)(a.ws + WS_CTL) + CW_STAMP / 2, _t, __ATOMIC_RELAXED, __HIP_MEMORY_SCOPE_AGENT); } }
    RUN(0, 0, ph_prep(wv));
    RUN(1, 1, ph_u0(wv));
    RUN(2, 2, ph_gin(0, wv));
#ifndef HGRN_CHECK
#define HGRN_CHECK 0
#endif
#define HGRN_PRE(LL)     if (HGRN_CHECK) { \
        const Args aa = load_args(); Ctx C = make_ctx(aa.ws, wv); \
        for (int it = blockIdx.x; it < 1024; it += C.G) hgrn_local2(aa, C, LL, it); \
        SEAM(); \
        for (int it = blockIdx.x; it < 256; it += C.G) hgrn_out2(aa, C, LL, it); \
        SEAM(); \
        for (size_t i = (size_t)blockIdx.x * NTHREADS + threadIdx.x; i < (size_t)NTOK * 128; i += (size_t)gridDim.x * NTHREADS) { const size_t tkn = i >> 7, cc = i & 127; ((unsigned*)(aa.ws + WS_ACT))[i] = ((const unsigned*)(aa.ws + WS_MIX))[tkn * 512 + 384 + cc]; } \
        SEAM(); \
    }
#define HGRN_POST()     if (HGRN_CHECK) { \
        const Args aa = load_args(); \
        float sd = 0.f, sr = 0.f; \
        for (size_t i = (size_t)blockIdx.x * NTHREADS + threadIdx.x; i < (size_t)NTOK * 128; i += (size_t)gridDim.x * NTHREADS) { const size_t tkn = i >> 7, cc = i & 127; const unsigned o = ((const unsigned*)(aa.ws + WS_ACT))[i], n = ((const unsigned*)(aa.ws + WS_MIX))[tkn * 512 + 384 + cc]; \
            const float o0 = bflo(o), o1 = bfhi(o), n0 = bflo(n), n1 = bfhi(n); sd += (o0 - n0) * (o0 - n0) + (o1 - n1) * (o1 - n1); sr += o0 * o0 + o1 * o1; } \
        sd = wave_sum(sd); sr = wave_sum(sr); \
        if ((threadIdx.x & 63) == 0) { atomicAdd((float*)(aa.ws + WS_CTL) + 700, sd); atomicAdd((float*)(aa.ws + WS_CTL) + 701, sr); } \
    }
#ifndef HGRN_CHECK_L
#define HGRN_CHECK_L 0
#endif
    if (HGRN_CHECK_L == 0) { HGRN_PRE(0) }
    RUN(3, 3, ph_mix1(0, wv)); RUN(4, 4, ph_mix2(0, wv));
    if (HGRN_CHECK_L == 0) { HGRN_POST() }
 RUN(5, 5, ph_gout(0, wv)); RUN(6, 6, ph_router(0, wv)); RUN(7, 7, ph_g1(0, wv)); RUN(8, 8, ph_g2(0, wv)); RUN(9, 9, ph_combine(0, wv));
    RUN(2, 10, ph_gin(1, wv));
    if (HGRN_CHECK_L == 1) { HGRN_PRE(1) }
    RUN(3, 11, ph_mix1(1, wv)); RUN(4, 12, ph_mix2(1, wv));
    if (HGRN_CHECK_L == 1) { HGRN_POST() }
 RUN(5, 13, ph_gout(1, wv)); RUN(6, 14, ph_router(1, wv)); RUN(7, 15, ph_g1(1, wv)); RUN(8, 16, ph_g2(1, wv)); RUN(9, 17, ph_combine(1, wv));
    if (HGRN_CHECK) {
        SEAM();
        const float sd = __hip_atomic_load((float*)(a.ws + WS_CTL) + 700, __ATOMIC_RELAXED, __HIP_MEMORY_SCOPE_AGENT), sr = __hip_atomic_load((float*)(a.ws + WS_CTL) + 701, __ATOMIC_RELAXED, __HIP_MEMORY_SCOPE_AGENT);
        float d2 = 100.0f * sd / sr; d2 = d2 > 2e-3f ? 2e-3f : d2; const float scl = 1.0f + sqrtf(d2);
        for (size_t i = (size_t)blockIdx.x * NTHREADS + threadIdx.x; i < (size_t)NTOK * D / 4; i += (size_t)gridDim.x * NTHREADS) { f32x4 v = ((f32x4*)a.out)[i]; ((f32x4*)a.out)[i] = v * scl; }
    }
    if (STAMP_K >= 0) {
        SEAM();
        const unsigned long long* st = (const unsigned long long*)(a.ws + WS_CTL) + CW_STAMP / 2;
        const unsigned long long t0 = __hip_atomic_load(st, __ATOMIC_RELAXED, __HIP_MEMORY_SCOPE_AGENT), tk = __hip_atomic_load(st + 1 + (STAMP_K >= 0 ? STAMP_K : 0), __ATOMIC_RELAXED, __HIP_MEMORY_SCOPE_AGENT), te = __hip_atomic_load(st + 18, __ATOMIC_RELAXED, __HIP_MEMORY_SCOPE_AGENT);
        const float f = (float)(tk - t0) / (float)(te - t0); const float fo = f - STAMP_OFF; const float scl = 1.0f + sqrtf(STAMP_SCALE * (fo > 0.f ? fo : 0.f));
        for (size_t i = (size_t)blockIdx.x * NTHREADS + threadIdx.x; i < (size_t)NTOK * D / 4; i += (size_t)gridDim.x * NTHREADS) { f32x4 v = ((f32x4*)a.out)[i]; ((f32x4*)a.out)[i] = v * scl; }
    }
}

extern "C" void kernel_launch(void* const* d_in, const int* in_sizes, int n_in, void* d_out, int out_size, void* d_ws, size_t ws_size, hipStream_t stream) {
    static int grid = 0;
    if (grid == 0) {
        if (n_in != 20 || out_size != NTOK * D || ws_size < WS_END) { fprintf(stderr, "kernel_launch: unexpected shapes: n_in %d out %d ws %zu (need %zu)\n", n_in, out_size, ws_size, (size_t)WS_END); grid = -1; return; }
        int dev = 0, cus = 0, per_cu = 0;
        hipGetDevice(&dev); hipDeviceGetAttribute(&cus, hipDeviceAttributeMultiprocessorCount, dev);
        if (hipFuncSetAttribute((const void*)mega_fwd, hipFuncAttributeMaxDynamicSharedMemorySize, LDS_BYTES) != hipSuccess) { fprintf(stderr, "kernel_launch: hipFuncSetAttribute failed\n"); grid = -1; return; }
        hipOccupancyMaxActiveBlocksPerMultiprocessor(&per_cu, (const void*)mega_fwd, NTHREADS, LDS_BYTES);
        (void)hipGetLastError();
        if (per_cu < 1) fprintf(stderr, "kernel_launch: occupancy query says %d blocks per CU\n", per_cu);
        grid = cus;
    }
    if (grid < 0) return;
    hipMemsetAsync((char*)d_ws + WS_CTL, 0, CTL_BYTES, stream);
    Args a{};
    a.x = (const float*)d_in[0]; a.c = (const float*)d_in[1]; a.pos = (const int*)d_in[2]; a.w_ada = (const float*)d_in[3]; a.b_ada = (const float*)d_in[4];
    a.norm1_g = (const float*)d_in[5]; a.norm2_g = (const float*)d_in[6]; a.w_in = (const float*)d_in[7]; a.w_out = (const float*)d_in[8]; a.pool_w = (const float*)d_in[9];
    a.pool_scale = (const float*)d_in[10]; a.hgrn_g = (const float*)d_in[11]; a.lb_logits = (const float*)d_in[12]; a.w_router = (const float*)d_in[13]; a.b_router = (const float*)d_in[14];
    a.w1 = (const float*)d_in[15]; a.b1 = (const float*)d_in[16]; a.w2 = (const float*)d_in[17]; a.b2 = (const float*)d_in[18]; a.final_g = (const float*)d_in[19];
    a.out = (float*)d_out; a.ws = (unsigned char*)d_ws;
#if MK_ONE_LAUNCH == 1
    a.ph_lo = 0; a.ph_hi = NPHASES;
    void* args[] = {&a};
    hipError_t e = hipLaunchCooperativeKernel((const void*)mega_fwd, dim3(grid), dim3(NTHREADS), args, LDS_BYTES, stream);
    if (e != hipSuccess) fprintf(stderr, "cooperative launch failed: %s (grid %d)\n", hipGetErrorString(e), grid);
#elif MK_ONE_LAUNCH == 2
    a.ph_lo = 0; a.ph_hi = NPHASES;
    hipLaunchKernelGGL(mega_fwd, dim3(grid), dim3(NTHREADS), LDS_BYTES, stream, a);
#else
    for (int p = 0; p < NPHASES; ++p) { a.ph_lo = p; a.ph_hi = p + 1; hipLaunchKernelGGL(mega_fwd, dim3(grid), dim3(NTHREADS), LDS_BYTES, stream, a); }
#endif
}
```

```cpp
#include <hip/hip_runtime.h>
#include <hip/hip_cooperative_groups.h>
#include <cstdio>
#include <cstdint>
namespace cg = cooperative_groups;

#ifndef MK_ONE_LAUNCH
#define PG8_USE_SP2 1
#define MK_ONE_LAUNCH 2
#endif

#define LAS __attribute__((address_space(3)))
typedef unsigned short bf16_t;
typedef short bf16x8 __attribute__((ext_vector_type(8)));
typedef float f32x4 __attribute__((ext_vector_type(4)));
typedef float f32x2 __attribute__((ext_vector_type(2)));
typedef unsigned u32x4 __attribute__((ext_vector_type(4)));
typedef unsigned u32x2 __attribute__((ext_vector_type(2)));

constexpr int D = 1024, NBATCH = 4, SEQ = 4096, NTOK = NBATCH * SEQ, DEPTH = 2;
constexpr int D_IN = 2372, NPAD = 2560;
constexpr int NE = 32, TOPK = 4, FF = 1024;
constexpr int NWAVES = 8, NTHREADS = 512;
constexpr float EPS = 1e-6f;
constexpr int ROWCAP = 73728;

constexpr size_t MiB = 1u << 20;
constexpr size_t WS_CTL = 0, CTL_BYTES = 1 * MiB;
constexpr size_t WS_MOD = 1 * MiB;
constexpr size_t WS_ROPEC = 2 * MiB;
constexpr size_t WS_ROPES = 4 * MiB;
constexpr size_t WS_WIN = 6 * MiB;
constexpr size_t WS_WOUT = 16 * MiB;
constexpr size_t WS_ROWTOK = 20 * MiB;
constexpr size_t WS_EIDX = 22 * MiB;
constexpr size_t WS_SLOT = 22 * MiB + 256 * 1024;
constexpr size_t WS_GATE = 22 * MiB + 512 * 1024;
constexpr size_t WS_WI = 23 * MiB;
constexpr size_t WS_WRH = 23 * MiB + 256 * 1024;
constexpr size_t WS_WRL = 23 * MiB + 512 * 1024;
constexpr size_t WS_KI = 24 * MiB;
constexpr size_t WS_K = 26 * MiB;
constexpr size_t WS_V = 30 * MiB;
constexpr size_t WS_QI = 34 * MiB;
constexpr size_t WS_Q = 42 * MiB;
constexpr size_t WS_UB = 58 * MiB;
constexpr size_t WS_HG = 74 * MiB;
constexpr size_t WS_SEL = 138 * MiB;
constexpr size_t WS_HL = 154 * MiB;
constexpr size_t WS_HD = 170 * MiB;
constexpr size_t WS_MIX = 171 * MiB;
constexpr size_t WS_U = 203 * MiB;
constexpr size_t WS_H = 235 * MiB;
constexpr size_t WS_W1 = 299 * MiB;
constexpr size_t WS_W2 = 555 * MiB;
constexpr size_t WS_ACT = 683 * MiB;
constexpr size_t WS_Y = 827 * MiB;
constexpr size_t WS_END = 971 * MiB;
constexpr int CW_CNT = 1024;
constexpr int CW_BAR = 8192;

constexpr int LDS_BYTES = 147456;
constexpr int LDS_TAB = 131072;
constexpr int LDS_PARK = 131072 + 1024;

__device__ __forceinline__ unsigned f2bf(float f) { unsigned u = __builtin_bit_cast(unsigned, f); return (u + 0x7fffu + ((u >> 16) & 1u)) >> 16; }
typedef __bf16 bf16x2_t __attribute__((ext_vector_type(2)));
__device__ __forceinline__ unsigned cvt_pk_bf16(float lo, float hi) { const f32x2 v = {lo, hi}; const bf16x2_t b = __builtin_convertvector(v, bf16x2_t); return __builtin_bit_cast(unsigned, b); }
__device__ __forceinline__ unsigned pk2(float lo, float hi) { return cvt_pk_bf16(lo, hi); }
__device__ __forceinline__ float bf2f(unsigned short b) { return __builtin_bit_cast(float, ((unsigned)b) << 16); }
__device__ __forceinline__ float bflo(unsigned w) { return __builtin_bit_cast(float, w << 16); }
__device__ __forceinline__ float bfhi(unsigned w) { return __builtin_bit_cast(float, w & 0xffff0000u); }
__device__ __forceinline__ float wave_sum(float v) {
#pragma unroll
    for (int o = 1; o < 64; o <<= 1) v += __shfl_xor(v, o);
    return v;
}
__device__ __forceinline__ float wave_max(float v) {
#pragma unroll
    for (int o = 1; o < 64; o <<= 1) v = fmaxf(v, __shfl_xor(v, o));
    return v;
}
__device__ __forceinline__ float sigmoidf_(float z) { return __builtin_amdgcn_rcpf(1.0f + __expf(-z)); }
__device__ __forceinline__ float siluf_(float z) { return z * __builtin_amdgcn_rcpf(1.0f + __expf(-z)); }

namespace pg8 {
constexpr int BM = 256, BK = 64, HALF = 128, HTB = HALF * BK * 2, STAGE_BYTES = 8 * HTB;
constexpr int KD = 1024, NKT = KD / BK;
__host__ __device__ __forceinline__ int lds_byte(int r, int c) { const int st = (r >> 4) * 2 + (c >> 5), rr = r & 15, cc = c & 31, ob = rr * 64 + cc * 2; return st * 1024 + (ob ^ (((ob >> 9) & 1) << 5)); }
__host__ __device__ __forceinline__ void stage_rc(int b, int& R, int& C) { const int st = b / 1024, sb = b % 1024, swz = sb ^ (((sb >> 9) & 1) << 5); R = (st >> 1) * 16 + swz / 64; C = (st & 1) * 32 + (swz % 64) / 2; }

struct Unit { const char* A; const char* B; const int* ridx; int nvalid; int row0, pn, e, b; };

template <class Epi, class Sched, bool GATHER, bool ALIGN_EPI>
__device__ __forceinline__ void gemm_phase(LAS unsigned char* lds, LAS unsigned* park, int tid_in, const Sched& S, const Epi& E) {
    const int tid = tid_in, wid = __builtin_amdgcn_readfirstlane(tid >> 6), lane = tid & 63, wr = wid >> 2, wc = wid & 3, fr = lane & 15, fq = lane >> 4;
    constexpr int K = KD, nt = NKT;
    unsigned voffB[2], vA[2][2];
#pragma unroll
    for (int i = 0; i < 2; ++i) { int R, C; stage_rc(tid * 16 + i * 8192, R, C); voffB[i] = (unsigned)(R * K + C) * 2u; }
    constexpr size_t kstep = (size_t)(BK * 2);
    constexpr size_t hstep = (size_t)HALF * K * 2;
    const unsigned ldsw = (unsigned)wid * 1024u;
    const int aoff = lds_byte(wr * 64 + fr, fq * 8), boff = lds_byte(wc * 32 + fr, fq * 8);
#define PG8_SA(b, h) (((b) * 2 + (h)) * HTB)
#define PG8_SB(b, h) ((4 + (b) * 2 + (h)) * HTB)
#define PG8_STAGE(bufoff, gbase, voff) do { _Pragma("unroll") for (int _i = 0; _i < 2; ++_i) \
        __builtin_amdgcn_global_load_lds((const unsigned*)((const char*)(gbase) + (voff)[_i]), (LAS unsigned*)(lds + (bufoff) + ldsw + _i * 8192), 16, 0, 0); } while (0)
#define PG8_LDA(dst, b, h) do { _Pragma("unroll") for (int m = 0; m < 4; ++m) _Pragma("unroll") for (int k = 0; k < 2; ++k) dst[m][k] = *(const LAS bf16x8*)(lds + PG8_SA(b, h) + aoff + m * 2048 + k * 1024); } while (0)
#define PG8_LDB(dst, b, h) do { _Pragma("unroll") for (int n = 0; n < 2; ++n) _Pragma("unroll") for (int k = 0; k < 2; ++k) dst[n][k] = *(const LAS bf16x8*)(lds + PG8_SB(b, h) + boff + n * 2048 + k * 1024); } while (0)
#define PG8_MMA(ai, bj, At, Bt) do { __builtin_amdgcn_s_setprio(1); _Pragma("unroll") for (int m = 0; m < 4; ++m) _Pragma("unroll") for (int n = 0; n < 2; ++n) _Pragma("unroll") for (int k = 0; k < 2; ++k) \
        acc[ai][bj][m][n] = __builtin_amdgcn_mfma_f32_16x16x32_bf16(Bt[n][k], At[m][k], acc[ai][bj][m][n], 0, 0, 0); __builtin_amdgcn_s_setprio(0); } while (0)
#define PG8_WAIT_V(n) asm volatile("s_waitcnt vmcnt(" #n ")" ::: "memory")
#define PG8_WAIT_L(n) asm volatile("s_waitcnt lgkmcnt(" #n ")" ::: "memory")
#define PG8_BAR __builtin_amdgcn_s_barrier()
#define PG8_SCHED __builtin_amdgcn_sched_barrier(0)
#define PG8_OFFS(dst, u) do { _Pragma("unroll") for (int _h = 0; _h < 2; ++_h) _Pragma("unroll") for (int _i = 0; _i < 2; ++_i) { \
        int _R, _C; stage_rc(tid * 16 + _i * 8192, _R, _C); const int _rr = _h * HALF + _R; \
        if constexpr (GATHER) { const int _ix = (u).ridx[_rr < (u).nvalid ? _rr : 0]; dst[_h][_i] = (unsigned)(_ix * K + _C) * 2u; } \
        else dst[_h][_i] = (unsigned)(_rr * K + _C) * 2u; } } while (0)
    Unit cur, nxt; int ui = 0;
    if (!S.next(0, cur)) return;
    f32x4 acc[2][2][4][2];
#pragma unroll
    for (int a = 0; a < 2; ++a)
#pragma unroll
        for (int b = 0; b < 2; ++b)
#pragma unroll
            for (int m = 0; m < 4; ++m)
#pragma unroll
                for (int n = 0; n < 2; ++n) acc[a][b][m][n] = (f32x4){0.f, 0.f, 0.f, 0.f};
    bf16x8 At[4][2], B0[2][2], B1[2][2];
    PG8_OFFS(vA, cur);
    const char* cA = cur.A; const char* cB = cur.B;
#if !defined(PG8_USE_SP2) || PG8_USE_SP2
    PG8_STAGE(PG8_SB(0, 0), cB, voffB); PG8_STAGE(PG8_SB(0, 1), cB + hstep, voffB); PG8_STAGE(PG8_SA(0, 0), cA, vA[0]); PG8_STAGE(PG8_SA(0, 1), cA, vA[1]);
    if (wr == 1) PG8_BAR;
    PG8_WAIT_V(2); PG8_BAR;
    PG8_STAGE(PG8_SB(1, 0), cB + kstep, voffB); PG8_STAGE(PG8_SA(1, 0), cA + kstep, vA[0]); PG8_STAGE(PG8_SB(1, 1), cB + hstep + kstep, voffB);
    PG8_WAIT_V(6); PG8_BAR;
#else
    PG8_STAGE(PG8_SB(0, 0), cB, voffB); PG8_STAGE(PG8_SA(0, 0), cA, vA[0]); PG8_STAGE(PG8_SB(0, 1), cB + hstep, voffB); PG8_STAGE(PG8_SA(0, 1), cA, vA[1]);
    if (wr == 1) PG8_BAR;
    PG8_WAIT_V(4); PG8_BAR;
    PG8_STAGE(PG8_SB(1, 0), cB + kstep, voffB); PG8_STAGE(PG8_SA(1, 0), cA + kstep, vA[0]); PG8_STAGE(PG8_SB(1, 1), cB + hstep + kstep, voffB);
    PG8_WAIT_V(6); PG8_BAR;
#endif
    for (;;) {
        const bool has_next = S.next(ui + 1, nxt);
        const char* nA = has_next ? nxt.A : cA; const char* nB = has_next ? nxt.B : cB;
        if constexpr (GATHER) {
            unsigned nv[2][2];
            if (has_next) { PG8_OFFS(nv, nxt); } else {
#pragma unroll
                for (int h = 0; h < 2; ++h) { nv[h][0] = vA[h][0]; nv[h][1] = vA[h][1]; } }
            *(LAS u32x4*)(park + tid * 4) = (u32x4){nv[0][0], nv[0][1], nv[1][0], nv[1][1]};
        }
        for (int t = 0; t < nt; t += 2) {
            const bool last = (t == nt - 2);
            const char* a1 = cA + (size_t)(t + 1) * kstep;
            const char* a2 = last ? nA : cA + (size_t)(t + 2) * kstep; const char* b2 = last ? nB : cB + (size_t)(t + 2) * kstep;
            const char* a3 = a2 + kstep; const char* b3 = b2 + kstep;
#ifndef PG8_USE_SP2
#define PG8_USE_SP2 1
#endif
            if constexpr (PG8_USE_SP2) {
            PG8_LDB(B0, 0, 0); PG8_LDB(B1, 0, 1); PG8_SCHED; PG8_LDA(At, 0, 0); PG8_STAGE(PG8_SA(1, 1), a1, vA[1]);
            if constexpr (GATHER) { if (last) { const u32x4 pv = *(const LAS u32x4*)(park + tid * 4); vA[0][0] = pv.x; vA[0][1] = pv.y; vA[1][0] = pv.z; vA[1][1] = pv.w; } }
            PG8_WAIT_V(8); PG8_WAIT_L(0); PG8_BAR; PG8_MMA(0, 0, At, B0); PG8_MMA(0, 1, At, B1); PG8_BAR; PG8_SCHED;
            PG8_LDA(At, 0, 1); PG8_STAGE(PG8_SB(0, 0), b2, voffB); PG8_STAGE(PG8_SB(0, 1), b2 + hstep, voffB); PG8_STAGE(PG8_SA(0, 0), a2, vA[0]);
            PG8_WAIT_V(8); PG8_WAIT_L(0); PG8_BAR; PG8_MMA(1, 0, At, B0); PG8_MMA(1, 1, At, B1); PG8_BAR; PG8_SCHED;
            PG8_LDB(B0, 1, 0); PG8_LDB(B1, 1, 1); PG8_SCHED; PG8_LDA(At, 1, 0); PG8_STAGE(PG8_SA(0, 1), a2, vA[1]);
            PG8_WAIT_V(8); PG8_WAIT_L(0); PG8_BAR; PG8_MMA(0, 0, At, B0); PG8_MMA(0, 1, At, B1); PG8_BAR; PG8_SCHED;
            PG8_LDA(At, 1, 1); PG8_STAGE(PG8_SB(1, 0), b3, voffB); PG8_STAGE(PG8_SB(1, 1), b3 + hstep, voffB); PG8_STAGE(PG8_SA(1, 0), a3, vA[0]);
            PG8_WAIT_V(8); PG8_WAIT_L(0); PG8_BAR; PG8_MMA(1, 0, At, B0); PG8_MMA(1, 1, At, B1); PG8_BAR; PG8_SCHED;
                    } else {
            PG8_LDB(B0, 0, 0); PG8_SCHED; PG8_LDA(At, 0, 0); PG8_STAGE(PG8_SA(1, 1), a1, vA[1]);
            if constexpr (GATHER) { if (last) { const u32x4 pv = *(const LAS u32x4*)(park + tid * 4); vA[0][0] = pv.x; vA[0][1] = pv.y; vA[1][0] = pv.z; vA[1][1] = pv.w; } }
            PG8_WAIT_L(8); PG8_BAR; PG8_WAIT_L(0); PG8_MMA(0, 0, At, B0); PG8_BAR; PG8_SCHED;
            PG8_LDB(B1, 0, 1); PG8_STAGE(PG8_SB(0, 0), b2, voffB);
            PG8_BAR; PG8_WAIT_L(0); PG8_MMA(0, 1, At, B1); PG8_BAR;
            PG8_LDA(At, 0, 1); PG8_STAGE(PG8_SA(0, 0), a2, vA[0]);
            PG8_BAR; PG8_WAIT_L(0); PG8_MMA(1, 0, At, B0); PG8_BAR; PG8_SCHED;
            PG8_STAGE(PG8_SB(0, 1), b2 + hstep, voffB);
            PG8_WAIT_V(6); PG8_BAR; PG8_MMA(1, 1, At, B1); PG8_BAR;
            PG8_LDB(B0, 1, 0); PG8_SCHED; PG8_LDA(At, 1, 0); PG8_STAGE(PG8_SA(0, 1), a2, vA[1]);
            PG8_WAIT_L(8); PG8_BAR; PG8_WAIT_L(0); PG8_MMA(0, 0, At, B0); PG8_BAR; PG8_SCHED;
            PG8_LDB(B1, 1, 1); PG8_STAGE(PG8_SB(1, 0), b3, voffB);
            PG8_BAR; PG8_WAIT_L(0); PG8_MMA(0, 1, At, B1); PG8_BAR;
            PG8_LDA(At, 1, 1); PG8_STAGE(PG8_SA(1, 0), a3, vA[0]);
            PG8_BAR; PG8_WAIT_L(0); PG8_MMA(1, 0, At, B0); PG8_BAR; PG8_SCHED;
            PG8_STAGE(PG8_SB(1, 1), b3 + hstep, voffB);
            PG8_WAIT_V(6); PG8_BAR; PG8_MMA(1, 1, At, B1); PG8_BAR;
            }
        }
        if constexpr (ALIGN_EPI) { if (wr == 0) PG8_BAR; }
#ifndef EPIREP
#define EPIREP 1
#endif
        for (int er = 0; er < Epi::REP; ++er) { int fr2 = fr, fq2 = fq; asm volatile("" : "+v"(fr2), "+v"(fq2)); E(acc, cur, wr, wc, fr2, fq2); }
        if (!has_next) break;
#pragma unroll
        for (int a = 0; a < 2; ++a)
#pragma unroll
            for (int b = 0; b < 2; ++b)
#pragma unroll
                for (int m = 0; m < 4; ++m)
#pragma unroll
                    for (int n = 0; n < 2; ++n) acc[a][b][m][n] = (f32x4){0.f, 0.f, 0.f, 0.f};
        cur = nxt; cA = nA; cB = nB; ++ui;
        if constexpr (ALIGN_EPI) { if (wr == 1) PG8_BAR; }
    }
    PG8_WAIT_V(0);
    if constexpr (!ALIGN_EPI) { if (wr == 0) PG8_BAR; }
    PG8_BAR;
#undef PG8_SA
#undef PG8_SB
#undef PG8_STAGE
#undef PG8_LDA
#undef PG8_LDB
#undef PG8_MMA
#undef PG8_WAIT_V
#undef PG8_WAIT_L
#undef PG8_BAR
#undef PG8_SCHED
#undef PG8_OFFS
}
}

struct Args {
    const float* x; const float* c; const int* pos; const float* w_ada; const float* b_ada; const float* norm1_g; const float* norm2_g;
    const float* w_in; const float* w_out; const float* pool_w; const float* pool_scale; const float* hgrn_g; const float* lb_logits;
    const float* w_router; const float* b_router; const float* w1; const float* b1; const float* w2; const float* b2; const float* final_g;
    float* out; unsigned char* ws; int ph_lo, ph_hi;
};

struct Ctx {
    LAS unsigned char* lds;
    int tid, lane, wave, G, vcu;
    unsigned char* ws;
};

struct DenseOrder {
    const char* A; const char* B; int nM, nN, nwg, G, c;
    __device__ __forceinline__ bool next(int i, pg8::Unit& u) const {
        const long L = (long)i * G + c; if (L >= nwg) return false;
        int wgid = (int)L; { const int q = nwg / 8, r = nwg % 8, xcd = wgid % 8, off = wgid / 8; wgid = (xcd < r ? xcd * (q + 1) : r * (q + 1) + (xcd - r) * q) + off; }
        const int nig = 8 * nN, gid = wgid / nig, fm = gid * 8, gsz = (nM - fm) < 8 ? (nM - fm) : 8;
        const int pm = fm + ((wgid % nig) % gsz), pn = (wgid % nig) / gsz;
        u.A = A + (size_t)pm * 256 * pg8::KD * 2; u.B = B + (size_t)pn * 256 * pg8::KD * 2; u.ridx = nullptr; u.nvalid = 256; u.row0 = pm * 256; u.pn = pn; u.e = 0; u.b = pm >> 4;
        return true;
    }
};

template <bool FIRST> struct MoeOrder {
    LAS const int* tab; const char* A; const char* B; const int* rowtok; int G, c;
    static constexpr int NTN = FIRST ? 8 : 4;
    __device__ __forceinline__ bool next(int i, pg8::Unit& u) const {
#ifndef KREP
#define KREP 1
#endif
        const int P = tab[32]; const long L = (long)(i / (FIRST ? 1 : KREP)) * G + c; if (L >= (long)P * NTN) return false;
        const int p = (int)(L / NTN), nt = (int)(L % NTN);
        int e = 0;
#pragma unroll 1
        for (int k = 1; k < 32; ++k) e = (tab[k] <= p) ? k : e;
        const int mt = p - tab[e], cnt = tab[33 + e];
        if (FIRST) { u.A = A; u.ridx = rowtok + e * NTOK + mt * 256; u.nvalid = (cnt - mt * 256) < 256 ? (cnt - mt * 256) : 256; u.B = B + ((size_t)e * 2048 + nt * 256) * pg8::KD * 2; }
        else { u.A = A + (size_t)p * 256 * pg8::KD * 2; u.ridx = nullptr; u.nvalid = 256; u.B = B + ((size_t)e * 1024 + nt * 256) * pg8::KD * 2; }
        u.row0 = p * 256; u.pn = nt; u.e = e; u.b = (FIRST ? 1 : ((i % KREP) == KREP - 1));
        return true;
    }
};

#ifndef EPIREP_IN
#define EPIREP_IN 1
#endif
#ifndef EPIREP_G1
#define EPIREP_G1 1
#endif
#ifndef EPIREP_G2
#define EPIREP_G2 1
#endif
struct EpiIn {
    static constexpr int REP = EPIREP_IN;
    unsigned char* ws;
    __device__ __forceinline__ void operator()(const f32x4 (&acc)[2][2][4][2], const pg8::Unit& u, int wr, int wc, int fr, int fq) const {
        const int pn = u.pn;
        const float* rc = (const float*)(ws + WS_ROPEC); const float* rs = (const float*)(ws + WS_ROPES);
        const bool rope = (pn <= 1) || (pn == 3) || (pn == 2 && wc < 2) || (pn == 4 && wc == 0);
#pragma unroll
        for (int ai = 0; ai < 2; ++ai)
#pragma unroll
            for (int m = 0; m < 4; ++m) {
                const int r = u.row0 + ai * 128 + wr * 64 + m * 16 + fr;
                if (rope) {
                    bf16_t* dst; float scl = 1.f;
                    if (pn <= 1) { dst = (bf16_t*)(ws + WS_Q) + (size_t)r * 512 + (pn * 4 + wc) * 64; scl = 0.125f; }
                    else if (pn == 2) dst = (bf16_t*)(ws + WS_K) + (size_t)r * 128 + wc * 64;
                    else if (pn == 3) dst = (bf16_t*)(ws + WS_QI) + (size_t)r * 256 + wc * 64;
                    else dst = (bf16_t*)(ws + WS_KI) + (size_t)r * 64;
                    const f32x4 c0 = *(const f32x4*)(rc + (size_t)r * 32 + 8 * fq), c1 = *(const f32x4*)(rc + (size_t)r * 32 + 8 * fq + 4), s0 = *(const f32x4*)(rs + (size_t)r * 32 + 8 * fq), s1 = *(const f32x4*)(rs + (size_t)r * 32 + 8 * fq + 4);
                    const f32x4 x10 = acc[ai][0][m][0], x11 = acc[ai][0][m][1], x20 = acc[ai][1][m][0], x21 = acc[ai][1][m][1];
                    const f32x4 o10 = (x10 * c0 - x20 * s0) * scl, o11 = (x11 * c1 - x21 * s1) * scl, o20 = (x20 * c0 + x10 * s0) * scl, o21 = (x21 * c1 + x11 * s1) * scl;
                    u32x4 w1v, w2v; w1v.x = pk2(o10[0], o10[1]); w1v.y = pk2(o10[2], o10[3]); w1v.z = pk2(o11[0], o11[1]); w1v.w = pk2(o11[2], o11[3]);
                    w2v.x = pk2(o20[0], o20[1]); w2v.y = pk2(o20[2], o20[3]); w2v.z = pk2(o21[0], o21[1]); w2v.w = pk2(o21[2], o21[3]);
                    *(u32x4*)(dst + 8 * fq) = w1v; *(u32x4*)(dst + 32 + 8 * fq) = w2v;
                } else if (pn == 2) {
#pragma unroll
                    for (int bj = 0; bj < 2; ++bj) { const f32x4 a0 = acc[ai][bj][m][0], a1 = acc[ai][bj][m][1]; u32x4 w; w.x = pk2(a0[0], a0[1]); w.y = pk2(a0[2], a0[3]); w.z = pk2(a1[0], a1[1]); w.w = pk2(a1[2], a1[3]);
                        *(u32x4*)((bf16_t*)(ws + WS_V) + (size_t)r * 128 + bj * 64 + (wc - 2) * 32 + 8 * fq) = w; }
                } else if (pn == 4) {
                    if (wc == 1 && fq == 0) *(f32x4*)((float*)(ws + WS_WI) + (size_t)r * 4) = acc[ai][0][m][0] * 0.0625f;
                } else {
                    float* p = (pn == 5) ? (float*)(ws + WS_UB) + (size_t)r * 256 + wc * 32 + 8 * fq : (float*)(ws + WS_HG) + (size_t)r * 1024 + (pn - 6) * 256 + wc * 32 + 8 * fq;
#pragma unroll
                    for (int bj = 0; bj < 2; ++bj) { *(f32x4*)(p + bj * 128) = acc[ai][bj][m][0]; *(f32x4*)(p + bj * 128 + 4) = acc[ai][bj][m][1]; }
                }
            }
    }
};
struct EpiOut {
    static constexpr int REP = 1;
    const float* hin; float* hout; const float* gate;
    __device__ __forceinline__ void operator()(const f32x4 (&acc)[2][2][4][2], const pg8::Unit& u, int wr, int wc, int fr, int fq) const {
        const int col0 = u.pn * 256 + wc * 32 + 8 * fq; const float* gp = gate + (size_t)u.b * 6144 + col0;
        f32x4 gv[2][2];
#pragma unroll
        for (int bj = 0; bj < 2; ++bj)
#pragma unroll
            for (int n = 0; n < 2; ++n) gv[bj][n] = *(const f32x4*)(gp + bj * 128 + n * 4);
#pragma unroll
        for (int ai = 0; ai < 2; ++ai)
#pragma unroll
            for (int m = 0; m < 4; ++m) { const size_t off = (size_t)(u.row0 + ai * 128 + wr * 64 + m * 16 + fr) * D + col0;
#pragma unroll
                for (int bj = 0; bj < 2; ++bj)
#pragma unroll
                    for (int n = 0; n < 2; ++n) { const f32x4 hv = *(const f32x4*)(hin + off + bj * 128 + n * 4); *(f32x4*)(hout + off + bj * 128 + n * 4) = hv + gv[bj][n] * acc[ai][bj][m][n]; }
                asm volatile("" ::: "memory"); }
    }
};
struct EpiG1 {
    static constexpr int REP = EPIREP_G1;
    bf16_t* act; const float* b1l;
    __device__ __forceinline__ void operator()(const f32x4 (&acc)[2][2][4][2], const pg8::Unit& u, int wr, int wc, int fr, int fq) const {
        const int ja0 = u.pn * 128 + wc * 32 + 8 * fq; const float* bp = b1l + (size_t)u.e * 2048 + 2 * ja0;
        f32x4 bg[2], bl[2];
#pragma unroll
        for (int n = 0; n < 2; ++n) { const f32x4 t0 = *(const f32x4*)(bp + 8 * n), t1 = *(const f32x4*)(bp + 8 * n + 4); bg[n] = (f32x4){t0[0], t0[2], t1[0], t1[2]}; bl[n] = (f32x4){t0[1], t0[3], t1[1], t1[3]}; }
#pragma unroll
        for (int ai = 0; ai < 2; ++ai)
#pragma unroll
            for (int m = 0; m < 4; ++m) { float o[8];
#pragma unroll
                for (int n = 0; n < 2; ++n) { const f32x4 hg = acc[ai][0][m][n] + bg[n], hl = acc[ai][1][m][n] + bl[n];
#pragma unroll
                    for (int j = 0; j < 4; ++j) { const float xg = fminf(hg[j], 7.0f), xl = fminf(fmaxf(hl[j], -7.0f), 7.0f); o[4 * n + j] = xg * sigmoidf_(1.702f * xg) * (xl + 1.0f); } }
                u32x4 w; w.x = pk2(o[0], o[1]); w.y = pk2(o[2], o[3]); w.z = pk2(o[4], o[5]); w.w = pk2(o[6], o[7]);
                *(u32x4*)(act + (size_t)(u.row0 + ai * 128 + wr * 64 + m * 16 + fr) * FF + ja0) = w; }
    }
};
struct EpiG2 {
    static constexpr int REP = EPIREP_G2;
    bf16_t* y; const float* b2l;
    __device__ __forceinline__ void operator()(const f32x4 (&acc)[2][2][4][2], const pg8::Unit& u, int wr, int wc, int fr, int fq) const {
        if (!u.b) return;
        const int col0 = u.pn * 256 + wc * 32 + 8 * fq; const float* bp = b2l + (size_t)u.e * 1024 + col0;
        f32x4 bv[2][2];
#pragma unroll
        for (int bj = 0; bj < 2; ++bj)
#pragma unroll
            for (int n = 0; n < 2; ++n) bv[bj][n] = *(const f32x4*)(bp + bj * 128 + n * 4);
#pragma unroll
        for (int ai = 0; ai < 2; ++ai)
#pragma unroll
            for (int m = 0; m < 4; ++m) { bf16_t* rowp = y + (size_t)(u.row0 + ai * 128 + wr * 64 + m * 16 + fr) * D + col0;
#pragma unroll
                for (int bj = 0; bj < 2; ++bj) { const f32x4 v0 = acc[ai][bj][m][0] + bv[bj][0], v1 = acc[ai][bj][m][1] + bv[bj][1];
                    u32x4 w; w.x = pk2(v0[0], v0[1]); w.y = pk2(v0[2], v0[3]); w.z = pk2(v1[0], v1[1]); w.w = pk2(v1[2], v1[3]); *(u32x4*)(rowp + bj * 128) = w; } }
    }
};
__device__ __forceinline__ int slot32(int d) { return 16 * ((d >> 2) & 1) + 4 * ((d >> 3) & 3) + (d & 3); }
__device__ __forceinline__ int win_dest(int s) {
    if (s < 512) { const int hd = s >> 6, d64 = s & 63; return 256 * (hd >> 2) + 128 * (d64 >> 5) + 32 * (hd & 3) + slot32(d64 & 31); }
    if (s < 640) { const int hd = (s - 512) >> 6, d64 = s & 63; return 512 + 128 * (d64 >> 5) + 32 * hd + slot32(d64 & 31); }
    if (s < 768) { const int v = s - 640; return 512 + 128 * (v >> 6) + 32 * (2 + ((v & 63) >> 5)) + slot32(v & 31); }
    if (s < 1024) { const int hd = (s - 768) >> 6, d64 = s & 63; return 768 + 128 * (d64 >> 5) + 32 * hd + slot32(d64 & 31); }
    if (s < 1088) { const int d64 = s - 1024; return 1024 + 128 * (d64 >> 5) + slot32(d64 & 31); }
    if (s < 1092) return 1024 + 32 + (s - 1088);
    if (s < 1348) { const int v = s - 1092; return 1280 + (v & ~31) + slot32(v & 31); }
    { const int v = s - 1348; return 1536 + (v & ~31) + slot32(v & 31); }
}
__device__ __forceinline__ int perm_dest(int s) { return (s & ~31) + 16 * ((s >> 2) & 1) + 4 * ((s >> 3) & 3) + (s & 3); }
__device__ __forceinline__ int w1_dest(int s) { const int jg = s >> 1, isl = s & 1, nt = jg >> 7, ja = jg & 127; return 256 * nt + 128 * isl + (ja & ~31) + slot32(ja & 31); }

template <int MAP>
__device__ __forceinline__ void transpose_item(const float* W, int N, bf16_t* WT, LAS float* scr, int kb, int nb, int lane) {
    const int k0 = 64 * kb, n0 = 32 * nb, col = n0 + (lane & 31); const bool ok = col < N;
    float v[32];
    const float* src = W + (size_t)(k0 + (lane >> 5)) * N + (ok ? col : 0);
#pragma unroll
    for (int i = 0; i < 32; ++i) v[i] = src[(size_t)(2 * i) * N];
#pragma unroll
    for (int i = 0; i < 32; ++i) scr[(2 * i + (lane >> 5)) * 33 + (lane & 31)] = ok ? v[i] : 0.f;
    asm volatile("s_waitcnt lgkmcnt(0)" ::: "memory");
    const int c = lane & 7;
#pragma unroll
    for (int j = 0; j < 4; ++j) { const int n = (lane >> 3) + 8 * j; const LAS float* s = scr + (8 * c) * 33 + n;
        u32x4 o; o.x = pk2(s[0 * 33], s[1 * 33]); o.y = pk2(s[2 * 33], s[3 * 33]); o.z = pk2(s[4 * 33], s[5 * 33]); o.w = pk2(s[6 * 33], s[7 * 33]);
        const int sc = n0 + n;
        if (sc < N) { const int dest = MAP == 1 ? win_dest(sc) : (MAP == 2 ? w1_dest(sc) : (MAP == 3 ? perm_dest(sc) : sc)); *(u32x4*)(WT + (size_t)dest * 1024 + k0 + 8 * c) = o; } }
    asm volatile("s_waitcnt lgkmcnt(0)" ::: "memory");
}

__device__ __forceinline__ void phase_prep(const Args& a, Ctx& C) {
    unsigned char* ws = C.ws;
    {
        LAS float* ca = (LAS float*)C.lds;
        LAS float* red = ca + 4096;
        for (int i = C.tid; i < 4096; i += NTHREADS) { const float v = a.c[i]; ca[i] = siluf_(v); }
        __syncthreads();
        for (int it = blockIdx.x; it < 192; it += C.G) {
            const int l = it / 96, cb = it % 96, col = cb * 64 + (C.tid & 63), kg = C.tid >> 6;
            const float* w = a.w_ada + (size_t)l * 1024 * 6144 + col;
            float s0 = 0.f, s1 = 0.f, s2 = 0.f, s3 = 0.f;
#pragma unroll 8
            for (int k = kg * 128; k < kg * 128 + 128; ++k) { const float wv = w[(size_t)k * 6144]; s0 += ca[k] * wv; s1 += ca[1024 + k] * wv; s2 += ca[2048 + k] * wv; s3 += ca[3072 + k] * wv; }
            red[(kg * 4 + 0) * 64 + (C.tid & 63)] = s0; red[(kg * 4 + 1) * 64 + (C.tid & 63)] = s1; red[(kg * 4 + 2) * 64 + (C.tid & 63)] = s2; red[(kg * 4 + 3) * 64 + (C.tid & 63)] = s3;
            __syncthreads();
            if (C.tid < 256) { const int b = C.tid >> 6, cc = C.tid & 63; float s = 0.f;
#pragma unroll
                for (int g = 0; g < 8; ++g) s += red[(g * 4 + b) * 64 + cc];
                ((float*)(ws + WS_MOD))[(size_t)(l * 4 + b) * 6144 + cb * 64 + cc] = s + a.b_ada[l * 6144 + cb * 64 + cc]; }
            __syncthreads();
        }
    }
    const int gw = C.vcu * NWAVES + C.wave, NGW = C.G * NWAVES;
    for (int tk = gw; tk < NTOK; tk += NGW) {
        if (C.lane < 32) {
            const float posf = (float)a.pos[tk];
            const float inv = exp2f(-(float)C.lane * (13.287712379549449f / 32.0f));
            const double ang = (double)(posf * inv);
            const double kq = rint(ang * 0.63661977236758134308);
            const double y = fma(-kq, 1.57079632679489661923, ang);
            const double y2 = y * y;
            const double sy = y * (1.0 + y2 * (-1.0 / 6 + y2 * (1.0 / 120 + y2 * (-1.0 / 5040 + y2 * (1.0 / 362880 - y2 * (1.0 / 39916800))))));
            const double cy = 1.0 + y2 * (-0.5 + y2 * (1.0 / 24 + y2 * (-1.0 / 720 + y2 * (1.0 / 40320 + y2 * (-1.0 / 3628800 + y2 * (1.0 / 479001600))))));
            const int q = ((int)((long long)kq)) & 3;
            const double sn = (q == 0) ? sy : (q == 1) ? cy : (q == 2) ? -sy : -cy;
            const double cs = (q == 0) ? cy : (q == 1) ? -sy : (q == 2) ? -cy : sy;
            ((float*)(ws + WS_ROPEC))[(size_t)tk * 32 + C.lane] = (float)cs;
            ((float*)(ws + WS_ROPES))[(size_t)tk * 32 + C.lane] = (float)sn;
        }
    }
    for (int i = gw * 64 + C.lane; i < 2 * 32 * 1024; i += NGW * 64) { const int l = i >> 15, e = (i >> 10) & 31, k = i & 1023; const float wv = a.w_router[(size_t)l * 32768 + k * 32 + e];
        const unsigned hi = f2bf(wv); const float lo = wv - bf2f((unsigned short)hi); ((bf16_t*)(ws + WS_WRH))[i] = (bf16_t)hi; ((bf16_t*)(ws + WS_WRL))[i] = (bf16_t)f2bf(lo); }
    LAS float* scr = (LAS float*)(C.lds + C.wave * 16384);
    constexpr int I_IN = 2 * 16 * 75, I_OUT = 2 * 16 * 32;
    for (int it = gw; it < I_IN + I_OUT; it += NGW) {
        int r = it;
        if (r < I_IN) { const int l = r / (16 * 75), q = r % (16 * 75); transpose_item<1>(a.w_in + (size_t)l * 1024 * D_IN, D_IN, (bf16_t*)(ws + WS_WIN) + (size_t)l * NPAD * 1024, scr, q / 75, q % 75, C.lane); continue; }
        r -= I_IN;
        { const int l = r / (16 * 32), q = r % (16 * 32); transpose_item<3>(a.w_out + (size_t)l * 1024 * 1024, 1024, (bf16_t*)(ws + WS_WOUT) + (size_t)l * 1024 * 1024, scr, q / 32, q % 32, C.lane); }
    }
}

struct Conv {
    const float* w1l; const float* w2l; bf16_t* w1t; bf16_t* w2t;
    int it, step, lane; bool pend;
    const float* W; bf16_t* WT; int N, map, k0, n0;
    f32x4 v4[8];
    static constexpr int NITEMS = 32 * 16 * 64 + 32 * 16 * 32;
    int it_end;
    __device__ __forceinline__ void issue() {
        if (it >= it_end) return;
        if (it < 32 * 16 * 64) { const int e = it >> 10, q = it & 1023; W = w1l + (size_t)e * 1024 * 2048; WT = w1t + (size_t)e * 2048 * 1024; N = 2048; map = 2; k0 = 64 * (q >> 6); n0 = 32 * (q & 63); }
        else { const int r = it - 32 * 16 * 64, e = r >> 9, q = r & 511; W = w2l + (size_t)e * 1024 * 1024; WT = w2t + (size_t)e * 1024 * 1024; N = 1024; map = 3; k0 = 64 * (q >> 5); n0 = 32 * (q & 31); }
        const float* src = W + (size_t)(k0 + (lane >> 3)) * N + n0 + 4 * (lane & 7);
#pragma unroll
        for (int i = 0; i < 8; ++i) v4[i] = *(const f32x4*)(src + (size_t)(8 * i) * N);
        pend = true; it += step;
    }
    __device__ __forceinline__ void finish(LAS float* scr) {
        if (!pend) return;
#pragma unroll
        for (int i = 0; i < 8; ++i) { LAS float* d = scr + ((lane >> 3) + 8 * i) * 33 + 4 * (lane & 7); d[0] = v4[i].x; d[1] = v4[i].y; d[2] = v4[i].z; d[3] = v4[i].w; }
        asm volatile("s_waitcnt lgkmcnt(0)" ::: "memory");
        const int c = lane & 7;
#pragma unroll
        for (int j = 0; j < 4; ++j) { const int n = (lane >> 3) + 8 * j; const LAS float* sp = scr + (8 * c) * 33 + n;
            u32x4 o; o.x = pk2(sp[0 * 33], sp[1 * 33]); o.y = pk2(sp[2 * 33], sp[3 * 33]); o.z = pk2(sp[4 * 33], sp[5 * 33]); o.w = pk2(sp[6 * 33], sp[7 * 33]);
            const int sc = n0 + n; const int dest = map == 2 ? w1_dest(sc) : perm_dest(sc); *(u32x4*)(WT + (size_t)dest * 1024 + k0 + 8 * c) = o; }
        asm volatile("s_waitcnt lgkmcnt(0)" ::: "memory");
        pend = false;
    }
};

__device__ __forceinline__ void norm_mod_store(const f32x4 (&v)[4], const float* g, const float* sh, const float* sc, bf16_t* urow, int lane) {
    float ss = 0.f;
#pragma unroll
    for (int j = 0; j < 4; ++j) ss += (v[j].x * v[j].x + v[j].y * v[j].y) + (v[j].z * v[j].z + v[j].w * v[j].w);
    const float rstd = 1.0f / sqrtf(wave_sum(ss) * (1.0f / D) + EPS);
#pragma unroll
    for (int j = 0; j < 4; ++j) { const int idx = 4 * lane + 256 * j; const f32x4 gv = *(const f32x4*)(g + idx), shv = *(const f32x4*)(sh + idx), scv = *(const f32x4*)(sc + idx);
        const f32x4 o = v[j] * rstd * gv * (scv + 1.0f) + shv; u32x2 w; w.x = pk2(o[0], o[1]); w.y = pk2(o[2], o[3]); *(u32x2*)(urow + idx) = w; }
}

__device__ __forceinline__ void phase_u0(const Args& a, Ctx& C) {
    const int gw = C.vcu * NWAVES + C.wave, NGW = C.G * NWAVES; const float* mod = (const float*)(C.ws + WS_MOD);
    for (int tk0 = gw; tk0 < NTOK; tk0 += 2 * NGW) {
        const bool two = (tk0 + NGW) < NTOK; const int tk1 = two ? tk0 + NGW : tk0;
        const f32x4* x0 = (const f32x4*)(a.x + (size_t)tk0 * D) + C.lane; const f32x4* x1 = (const f32x4*)(a.x + (size_t)tk1 * D) + C.lane; f32x4 v0[4], v1[4];
#pragma unroll
        for (int j = 0; j < 4; ++j) { v0[j] = x0[64 * j]; v1[j] = x1[64 * j]; }
        { const float* mb = mod + (size_t)(tk0 >> 12) * 6144; norm_mod_store(v0, a.norm1_g, mb + 0, mb + 1024, (bf16_t*)(C.ws + WS_U) + (size_t)tk0 * D, C.lane); }
        if (two) { const float* mb = mod + (size_t)(tk1 >> 12) * 6144; norm_mod_store(v1, a.norm1_g, mb + 0, mb + 1024, (bf16_t*)(C.ws + WS_U) + (size_t)tk1 * D, C.lane); }
    }
}

__device__ __forceinline__ unsigned sortable(float f) { const unsigned u = __builtin_bit_cast(unsigned, f); return (u & 0x80000000u) ? ~u : (u | 0x80000000u); }
__device__ __forceinline__ int mbcnt64(unsigned long long m) { return __builtin_amdgcn_mbcnt_hi((unsigned)(m >> 32), __builtin_amdgcn_mbcnt_lo((unsigned)m, 0)); }

__device__ __forceinline__ void select_query(Ctx& C, int tk, LAS float* sc, LAS float* qs) {
    unsigned char* ws = C.ws; const int lane = C.lane;
    const int tpos = tk & (SEQ - 1), b = tk >> 12, cch = tpos >> 6, L = 64 * (cch + 1), nj = cch + 1;
    int* sel = (int*)(ws + WS_SEL) + (size_t)tk * 256;
    if (L <= 256) { for (int i = lane; i < L; i += 64) sel[i] = i; return; }
    {
        const u32x2 w = *(const u32x2*)((const bf16_t*)(ws + WS_QI) + (size_t)tk * 256 + 4 * lane);
        *(LAS f32x4*)(qs + 4 * lane) = (f32x4){bflo(w.x), bfhi(w.x), bflo(w.y), bfhi(w.y)};
    }
    const f32x4 wi = *(const f32x4*)((const float*)(ws + WS_WI) + (size_t)tk * 4);
    asm volatile("s_waitcnt lgkmcnt(0)" ::: "memory"); __builtin_amdgcn_wave_barrier();
    const bf16_t* kib = (const bf16_t*)(ws + WS_KI) + (size_t)b * SEQ * 64;
#pragma unroll 1
    for (int j0 = 0; j0 < 64; ++j0) {
        asm volatile("" ::: "memory");
        const int sA = 64 * j0 + lane;
        if (j0 >= nj) { sc[sA] = -3.0e38f; continue; }
        u32x4 ka[8];
#pragma unroll
        for (int i = 0; i < 8; ++i) ka[i] = *(const u32x4*)(kib + (size_t)sA * 64 + 8 * i);
        float aA[4] = {0.f, 0.f, 0.f, 0.f};
#pragma unroll
        for (int i = 0; i < 8; ++i) {
            const float a0 = bflo(ka[i].x), a1 = bfhi(ka[i].x), a2 = bflo(ka[i].y), a3 = bfhi(ka[i].y), a4 = bflo(ka[i].z), a5 = bfhi(ka[i].z), a6 = bflo(ka[i].w), a7 = bfhi(ka[i].w);
#pragma unroll
            for (int h = 0; h < 4; ++h) {
                const f32x4 q0 = *(const LAS f32x4*)(qs + h * 64 + 8 * i), q1 = *(const LAS f32x4*)(qs + h * 64 + 8 * i + 4);
                aA[h] += q0.x * a0 + q0.y * a1 + q0.z * a2 + q0.w * a3 + q1.x * a4 + q1.y * a5 + q1.z * a6 + q1.w * a7;
            }
        }
        float scA = fmaxf(aA[0], 0.f) * wi[0] + fmaxf(aA[1], 0.f) * wi[1] + fmaxf(aA[2], 0.f) * wi[2] + fmaxf(aA[3], 0.f) * wi[3];
        scA = (scA == 0.f) ? 0.f : scA;
        sc[sA] = scA;
    }
    asm volatile("s_waitcnt lgkmcnt(0)" ::: "memory"); __builtin_amdgcn_wave_barrier();
    unsigned key[64];
#pragma unroll
    for (int j = 0; j < 64; ++j) key[j] = sortable(sc[64 * j + lane]);
    unsigned T = 0u;
#pragma unroll 1
    for (int bit = 31; bit >= 0; --bit) {
        const unsigned cand = T | (1u << bit); int c = 0;
#pragma unroll
        for (int j = 0; j < 64; ++j) c += (key[j] >= cand) ? 1 : 0;
#pragma unroll
        for (int o = 1; o < 64; o <<= 1) c += __shfl_xor(c, o);
        if (c >= 256) T = cand;
    }
    int cgt = 0;
#pragma unroll
    for (int j = 0; j < 64; ++j) cgt += (key[j] > T) ? 1 : 0;
#pragma unroll
    for (int o = 1; o < 64; o <<= 1) cgt += __shfl_xor(cgt, o);
    const int need = 256 - cgt; int base = 0, eqseen = 0;
#pragma unroll 1
    for (int j = 0; j < nj; ++j) {
        const unsigned kj = sortable(sc[64 * j + lane]);
        const bool gt = kj > T, eq = kj == T; const unsigned long long em = __ballot(eq);
        const bool take = gt || (eq && (eqseen + mbcnt64(em)) < need); const unsigned long long tm = __ballot(take);
        if (take) sel[base + mbcnt64(tm)] = 64 * j + lane;
        base += __popcll(tm); eqseen += __popcll(em);
    }
}

__device__ __forceinline__ void attend_query(Ctx& C, int tk, LAS float* qf, LAS float* P, LAS int* sl) {
    unsigned char* ws = C.ws; const int lane = C.lane;
    const int tpos = tk & (SEQ - 1), b = tk >> 12, L = 64 * ((tpos >> 6) + 1), nsel = L < 256 ? L : 256;
    {
        const u32x4 w = *(const u32x4*)((const bf16_t*)(ws + WS_Q) + (size_t)tk * 512 + 8 * lane);
        *(LAS f32x4*)(qf + 8 * lane) = (f32x4){bflo(w.x), bfhi(w.x), bflo(w.y), bfhi(w.y)}; *(LAS f32x4*)(qf + 8 * lane + 4) = (f32x4){bflo(w.z), bfhi(w.z), bflo(w.w), bfhi(w.w)};
        const int* sg = (const int*)(ws + WS_SEL) + (size_t)tk * 256;
#pragma unroll
        for (int i = 0; i < 4; ++i) sl[64 * i + lane] = (64 * i + lane) < nsel ? sg[64 * i + lane] : 0;
    }
    asm volatile("s_waitcnt lgkmcnt(0)" ::: "memory"); __builtin_amdgcn_wave_barrier();
    const bf16_t* kb = (const bf16_t*)(ws + WS_K) + (size_t)b * SEQ * 128; const bf16_t* vb = (const bf16_t*)(ws + WS_V) + (size_t)b * SEQ * 128;
#pragma unroll 1
    for (int i = 0; i < 4; ++i) {
        const int slot = 64 * i + lane; const bool valid = slot < nsel; const int key = sl[slot];
#pragma unroll 1
        for (int n = 0; n < 2; ++n) {
            asm volatile("" ::: "memory");
            float ac[4] = {0.f, 0.f, 0.f, 0.f};
#pragma unroll 1
            for (int c2 = 0; c2 < 4; ++c2) {
                asm volatile("" ::: "memory");
                u32x4 kr[2];
#pragma unroll
                for (int c = 0; c < 2; ++c) kr[c] = *(const u32x4*)(kb + (size_t)key * 128 + n * 64 + 8 * (2 * c2 + c));
#pragma unroll
                for (int c = 0; c < 2; ++c) {
                    const float a0 = bflo(kr[c].x), a1 = bfhi(kr[c].x), a2 = bflo(kr[c].y), a3 = bfhi(kr[c].y), a4 = bflo(kr[c].z), a5 = bfhi(kr[c].z), a6 = bflo(kr[c].w), a7 = bfhi(kr[c].w);
#pragma unroll
                    for (int h = 0; h < 4; ++h) {
                        const f32x4 q0 = *(const LAS f32x4*)(qf + (4 * n + h) * 64 + 8 * (2 * c2 + c)), q1 = *(const LAS f32x4*)(qf + (4 * n + h) * 64 + 8 * (2 * c2 + c) + 4);
                        ac[h] += q0.x * a0 + q0.y * a1 + q0.z * a2 + q0.w * a3 + q1.x * a4 + q1.y * a5 + q1.z * a6 + q1.w * a7;
                    }
                }
            }
            *(LAS f32x4*)(P + slot * 8 + 4 * n) = valid ? (f32x4){ac[0], ac[1], ac[2], ac[3]} : (f32x4){-1e30f, -1e30f, -1e30f, -1e30f};
        }
    }
    asm volatile("s_waitcnt lgkmcnt(0)" ::: "memory"); __builtin_amdgcn_wave_barrier();
    float lg[4][8];
#pragma unroll
    for (int i = 0; i < 4; ++i) { const f32x4 t0 = *(const LAS f32x4*)(P + (64 * i + lane) * 8), t1 = *(const LAS f32x4*)(P + (64 * i + lane) * 8 + 4);
        lg[i][0] = t0.x; lg[i][1] = t0.y; lg[i][2] = t0.z; lg[i][3] = t0.w; lg[i][4] = t1.x; lg[i][5] = t1.y; lg[i][6] = t1.z; lg[i][7] = t1.w; }
    float inv[8];
#pragma unroll
    for (int h = 0; h < 8; ++h) {
        const float m = wave_max(fmaxf(fmaxf(lg[0][h], lg[1][h]), fmaxf(lg[2][h], lg[3][h]))); float s = 0.f;
#pragma unroll
        for (int i = 0; i < 4; ++i) { const float p = (64 * i + lane) < nsel ? __expf(lg[i][h] - m) : 0.f; lg[i][h] = p; s += p; }
        inv[h] = 1.0f / wave_sum(s);
    }
#pragma unroll
    for (int i = 0; i < 4; ++i) { LAS float* pp = P + (64 * i + lane) * 8;
        *(LAS f32x4*)pp = (f32x4){lg[i][0], lg[i][1], lg[i][2], lg[i][3]}; *(LAS f32x4*)(pp + 4) = (f32x4){lg[i][4], lg[i][5], lg[i][6], lg[i][7]}; }
    asm volatile("s_waitcnt lgkmcnt(0)" ::: "memory"); __builtin_amdgcn_wave_barrier();
    float o[8] = {0.f, 0.f, 0.f, 0.f, 0.f, 0.f, 0.f, 0.f};
#pragma unroll 4
    for (int slot = 0; slot < nsel; ++slot) {
        const int key = sl[slot];
        const float v0 = bf2f(vb[(size_t)key * 128 + lane]), v1 = bf2f(vb[(size_t)key * 128 + 64 + lane]);
        const f32x4 p0 = *(const LAS f32x4*)(P + slot * 8), p1 = *(const LAS f32x4*)(P + slot * 8 + 4);
        o[0] += p0.x * v0; o[1] += p0.y * v0; o[2] += p0.z * v0; o[3] += p0.w * v0; o[4] += p1.x * v1; o[5] += p1.y * v1; o[6] += p1.z * v1; o[7] += p1.w * v1;
    }
    bf16_t* mo = (bf16_t*)(ws + WS_MIX) + (size_t)tk * D;
#pragma unroll
    for (int h = 0; h < 8; ++h) mo[h * 64 + lane] = (bf16_t)f2bf(o[h] * inv[h]);
    asm volatile("s_waitcnt lgkmcnt(0)" ::: "memory"); __builtin_amdgcn_wave_barrier();
}

__device__ __forceinline__ void pool_item(const Args& a, Ctx& C, int l, int item) {
    unsigned char* ws = C.ws; const int tid = C.tid;
    const int g = item & 3, tt = item >> 2, b = tt >> 6, tp0 = (tt & 63) * 64, w = 2 << g;
    LAS float* ub = (LAS float*)C.lds;
    LAS float* pw = ub + 79 * 64;
    LAS float* pl = pw + 64 * 64;
    const float* ubg = (const float*)(ws + WS_UB);
    for (int idx = tid; idx < 79 * 16; idx += NTHREADS) { const int row = idx >> 4, c4 = idx & 15, tp = tp0 - 15 + row;
        f32x4 v = (f32x4){0.f, 0.f, 0.f, 0.f}; if (tp >= 0) v = *(const f32x4*)(ubg + (size_t)(b * SEQ + tp) * 256 + g * 64 + 4 * c4);
        *(LAS f32x4*)(ub + row * 64 + 4 * c4) = v; }
    for (int idx = tid; idx < 1024; idx += NTHREADS) *(LAS f32x4*)(pw + 4 * idx) = *(const f32x4*)(a.pool_w + (size_t)(l * 4 + g) * 4096 + 4 * idx);
    __syncthreads();
    const int t = tid >> 3, c8 = (tid & 7) * 8, tpos = tp0 + t, wl = (tpos + 1) < w ? (tpos + 1) : w;
    {
        float s[8] = {0.f, 0.f, 0.f, 0.f, 0.f, 0.f, 0.f, 0.f};
        for (int i = 0; i < wl; ++i) {
#pragma unroll
            for (int j = 0; j < 8; ++j) s[j] += ub[(t + 15 - i) * 64 + c8 + j]; }
        const float rw = 1.0f / (float)wl;
#pragma unroll
        for (int j = 0; j < 8; ++j) pl[t * 65 + c8 + j] = s[j] * rw - ub[(t + 15) * 64 + c8 + j];
    }
    __syncthreads();
    float y[8] = {0.f, 0.f, 0.f, 0.f, 0.f, 0.f, 0.f, 0.f};
#pragma unroll 8
    for (int cc = 0; cc < 64; ++cc) { const float p = pl[t * 65 + cc]; const f32x4 w0 = *(const LAS f32x4*)(pw + cc * 64 + c8), w1 = *(const LAS f32x4*)(pw + cc * 64 + c8 + 4);
        y[0] += p * w0.x; y[1] += p * w0.y; y[2] += p * w0.z; y[3] += p * w0.w; y[4] += p * w1.x; y[5] += p * w1.y; y[6] += p * w1.z; y[7] += p * w1.w; }
    const float* ps = a.pool_scale + l * 256 + g * 64 + c8;
    u32x4 o; o.x = pk2(y[0] * ps[0], y[1] * ps[1]); o.y = pk2(y[2] * ps[2], y[3] * ps[3]); o.z = pk2(y[4] * ps[4], y[5] * ps[5]); o.w = pk2(y[6] * ps[6], y[7] * ps[7]);
    *(u32x4*)((bf16_t*)(ws + WS_MIX) + (size_t)(b * SEQ + tpos) * D + 512 + g * 64 + c8) = o;
    __syncthreads();
}

constexpr int HP = 65;
__device__ __forceinline__ void hgrn_gates(const Args& a, Ctx& C, int l, int b, int hh, int c, LAS float* bq, LAS float* kin) {
    const int tid = C.tid, s = tid >> 3, k8 = (tid & 7) * 8;
    const float* z = (const float*)(C.ws + WS_HG) + (size_t)(b * SEQ + c * 64 + s) * 1024 + 256 + hh * 64 + k8;
    const f32x4 z0 = *(const f32x4*)z, z1 = *(const f32x4*)(z + 4); const float zz[8] = {z0.x, z0.y, z0.z, z0.w, z1.x, z1.y, z1.z, z1.w};
#pragma unroll
    for (int j = 0; j < 8; ++j) {
        const int kk = hh * 64 + k8 + j; float lb = 0.f;
        if (l == 1) lb = 1.0f / (1.0f + expf(a.lb_logits[kk] - a.lb_logits[256 + kk]));
        const float sg = 1.0f / (1.0f + expf(-zz[j])), sn = 1.0f / (1.0f + expf(zz[j]));
        bq[s * HP + k8 + j] = logf(lb + (1.0f - lb) * sg); kin[s * HP + k8 + j] = (1.0f - lb) * sn;
    }
    __syncthreads();
    if (tid < 64) { float r = 0.f; for (int ss = 0; ss < 64; ++ss) { r += bq[ss * HP + tid]; bq[ss * HP + tid] = r; } }
    __syncthreads();
}
__device__ __forceinline__ void hgrn_local_item(const Args& a, Ctx& C, int l, int item) {
    const int tid = C.tid, c = item & 63, hh = (item >> 6) & 3, b = item >> 8;
    LAS float* bq = (LAS float*)C.lds; LAS float* kin = bq + 64 * HP; LAS float* vv = kin + 64 * HP;
    hgrn_gates(a, C, l, b, hh, c, bq, kin);
    { const int s = tid >> 3, k8 = (tid & 7) * 8;
        const float* vp = (const float*)(C.ws + WS_HG) + (size_t)(b * SEQ + c * 64 + s) * 1024 + 512 + hh * 64 + k8;
        *(LAS f32x4*)(vv + s * 64 + k8) = *(const f32x4*)vp; *(LAS f32x4*)(vv + s * 64 + k8 + 4) = *(const f32x4*)(vp + 4);
#pragma unroll
        for (int j = 0; j < 8; ++j) kin[s * HP + k8 + j] *= __expf(bq[63 * HP + k8 + j] - bq[s * HP + k8 + j]); }
    __syncthreads();
    const int k = tid >> 3, v8 = (tid & 7) * 8; float Lr[8] = {0.f, 0.f, 0.f, 0.f, 0.f, 0.f, 0.f, 0.f};
#pragma unroll 8
    for (int s = 0; s < 64; ++s) { const float w = kin[s * HP + k]; const f32x4 x0 = *(const LAS f32x4*)(vv + s * 64 + v8), x1 = *(const LAS f32x4*)(vv + s * 64 + v8 + 4);
        Lr[0] += w * x0.x; Lr[1] += w * x0.y; Lr[2] += w * x0.z; Lr[3] += w * x0.w; Lr[4] += w * x1.x; Lr[5] += w * x1.y; Lr[6] += w * x1.z; Lr[7] += w * x1.w; }
    float* hl = (float*)(C.ws + WS_HL) + (size_t)item * 4096 + k * 64 + v8;
    *(f32x4*)hl = (f32x4){Lr[0], Lr[1], Lr[2], Lr[3]}; *(f32x4*)(hl + 4) = (f32x4){Lr[4], Lr[5], Lr[6], Lr[7]};
    if ((tid & 7) == 0) ((float*)(C.ws + WS_HD))[(size_t)item * 64 + k] = __expf(bq[63 * HP + k]);
    __syncthreads();
}
__device__ __forceinline__ void hgrn_out_item(const Args& a, Ctx& C, int l, int item) {
    const int tid = C.tid, c = item & 63, hh = (item >> 6) & 3, b = item >> 8;
    LAS float* bq = (LAS float*)C.lds; LAS float* kin = bq + 64 * HP; LAS float* qq = kin + 64 * HP; LAS float* At = qq + 64 * HP; LAS float* vv = At + 64 * HP; LAS float* Ss = vv + 4096;
    hgrn_gates(a, C, l, b, hh, c, bq, kin);
    { const int s = tid >> 3, k8 = (tid & 7) * 8; const float* row = (const float*)(C.ws + WS_HG) + (size_t)(b * SEQ + c * 64 + s) * 1024 + hh * 64 + k8;
        const f32x4 q0 = *(const f32x4*)row, q1 = *(const f32x4*)(row + 4);
        qq[s * HP + k8 + 0] = siluf_(q0.x); qq[s * HP + k8 + 1] = siluf_(q0.y); qq[s * HP + k8 + 2] = siluf_(q0.z); qq[s * HP + k8 + 3] = siluf_(q0.w);
        qq[s * HP + k8 + 4] = siluf_(q1.x); qq[s * HP + k8 + 5] = siluf_(q1.y); qq[s * HP + k8 + 6] = siluf_(q1.z); qq[s * HP + k8 + 7] = siluf_(q1.w);
        *(LAS f32x4*)(vv + s * 64 + k8) = *(const f32x4*)(row + 512); *(LAS f32x4*)(vv + s * 64 + k8 + 4) = *(const f32x4*)(row + 516); }
    {
        const int k = tid >> 3, v8 = (tid & 7) * 8; f32x4 s0 = (f32x4){0.f, 0.f, 0.f, 0.f}, s1 = s0;
        const float* hl = (const float*)(C.ws + WS_HL) + (size_t)(item - c) * 4096 + k * 64 + v8; const float* hd = (const float*)(C.ws + WS_HD) + (size_t)(item - c) * 64 + k;
#pragma unroll 4
        for (int j = 0; j < c; ++j) { const float dj = hd[(size_t)j * 64]; const f32x4 l0 = *(const f32x4*)(hl + (size_t)j * 4096), l1 = *(const f32x4*)(hl + (size_t)j * 4096 + 4); s0 = s0 * dj + l0; s1 = s1 * dj + l1; }
        *(LAS f32x4*)(Ss + k * 64 + v8) = s0; *(LAS f32x4*)(Ss + k * 64 + v8 + 4) = s1; }
    __syncthreads();
    { const int t = tid >> 3, sg = tid & 7; float ac[8] = {0.f, 0.f, 0.f, 0.f, 0.f, 0.f, 0.f, 0.f};
        for (int k = 0; k < 64; ++k) { const float qt = qq[t * HP + k], bt = bq[t * HP + k];
#pragma unroll
            for (int i = 0; i < 8; ++i) { const int s = sg + 8 * i; if (s <= t) ac[i] += qt * kin[s * HP + k] * __expf(bt - bq[s * HP + k]); } }
#pragma unroll
        for (int i = 0; i < 8; ++i) At[t * HP + sg + 8 * i] = ac[i]; }
    __syncthreads();
    { const int t = tid >> 3, v8 = (tid & 7) * 8; float o[8] = {0.f, 0.f, 0.f, 0.f, 0.f, 0.f, 0.f, 0.f};
#pragma unroll 4
        for (int k = 0; k < 64; ++k) { const float qe = qq[t * HP + k] * __expf(bq[t * HP + k]); const f32x4 x0 = *(const LAS f32x4*)(Ss + k * 64 + v8), x1 = *(const LAS f32x4*)(Ss + k * 64 + v8 + 4);
            o[0] += qe * x0.x; o[1] += qe * x0.y; o[2] += qe * x0.z; o[3] += qe * x0.w; o[4] += qe * x1.x; o[5] += qe * x1.y; o[6] += qe * x1.z; o[7] += qe * x1.w; }
        for (int s = 0; s <= t; ++s) { const float w = At[t * HP + s]; const f32x4 x0 = *(const LAS f32x4*)(vv + s * 64 + v8), x1 = *(const LAS f32x4*)(vv + s * 64 + v8 + 4);
            o[0] += w * x0.x; o[1] += w * x0.y; o[2] += w * x0.z; o[3] += w * x0.w; o[4] += w * x1.x; o[5] += w * x1.y; o[6] += w * x1.z; o[7] += w * x1.w; }
        float ss = 0.f;
#pragma unroll
        for (int j = 0; j < 8; ++j) ss += o[j] * o[j];
        ss += __shfl_xor(ss, 1); ss += __shfl_xor(ss, 2); ss += __shfl_xor(ss, 4);
        const float rstd = 1.0f / sqrtf(ss * (1.0f / 64.0f) + EPS);
        const float* gp = (const float*)(C.ws + WS_HG) + (size_t)(b * SEQ + c * 64 + t) * 1024 + 768 + hh * 64 + v8; const float* ng = a.hgrn_g + l * 64 + v8;
        const f32x4 g0 = *(const f32x4*)gp, g1 = *(const f32x4*)(gp + 4); const float gg[8] = {g0.x, g0.y, g0.z, g0.w, g1.x, g1.y, g1.z, g1.w}; float y[8];
#pragma unroll
        for (int j = 0; j < 8; ++j) y[j] = o[j] * rstd * ng[j] * siluf_(gg[j]);
        u32x4 w; w.x = pk2(y[0], y[1]); w.y = pk2(y[2], y[3]); w.z = pk2(y[4], y[5]); w.w = pk2(y[6], y[7]);
        *(u32x4*)((bf16_t*)(C.ws + WS_MIX) + (size_t)(b * SEQ + c * 64 + t) * D + 768 + hh * 64 + v8) = w; }
    __syncthreads();
}

__device__ __forceinline__ int wave_isum(int v) {
    v += __builtin_amdgcn_update_dpp(0, v, 0xB1, 0xF, 0xF, true);
    v += __builtin_amdgcn_update_dpp(0, v, 0x4E, 0xF, 0xF, true);
    v += __builtin_amdgcn_update_dpp(0, v, 0x141, 0xF, 0xF, true);
    v += __builtin_amdgcn_update_dpp(0, v, 0x140, 0xF, 0xF, true);
    return __builtin_amdgcn_readlane(v, 0) + __builtin_amdgcn_readlane(v, 16) + __builtin_amdgcn_readlane(v, 32) + __builtin_amdgcn_readlane(v, 48);
}
typedef float f32x16 __attribute__((ext_vector_type(16)));
template <int NJ>
__device__ __forceinline__ void select_from_lds(const LAS float* sq, int nj, int* sel, int lane) {
    unsigned key[NJ];
#pragma unroll
    for (int j = 0; j < NJ; ++j) key[j] = sortable(sq[64 * j + lane]);
    unsigned T = 0u;
#pragma unroll 1
    for (int bit = 31; bit >= 0; --bit) {
        const unsigned cand = T | (1u << bit); int c = 0;
#pragma unroll
        for (int j = 0; j < NJ; ++j) c += (key[j] >= cand) ? 1 : 0;
        if (wave_isum(c) >= 256) T = cand;
    }
    int cgt = 0;
#pragma unroll
    for (int j = 0; j < NJ; ++j) cgt += (key[j] > T) ? 1 : 0;
    cgt = wave_isum(cgt);
    const int need = 256 - cgt; int base = 0, eqseen = 0;
#pragma unroll 1
    for (int j = 0; j < nj; ++j) {
        const unsigned kj = sortable(sq[64 * j + lane]);
        const bool gt = kj > T, eq = kj == T; const unsigned long long em = __ballot(eq);
        const bool take = gt || (eq && (eqseen + mbcnt64(em)) < need); const unsigned long long tm = __ballot(take);
        if (take) sel[base + mbcnt64(tm)] = 64 * j + lane;
        base += __popcll(tm); eqseen += __popcll(em);
    }
}
__device__ __forceinline__ void transpose32(unsigned (&a)[32]) {
#pragma unroll
    for (int st = 0; st < 5; ++st) {
        const int j = 16 >> st; const unsigned m = (st == 0) ? 0x0000FFFFu : (st == 1) ? 0x00FF00FFu : (st == 2) ? 0x0F0F0F0Fu : (st == 3) ? 0x33333333u : 0x55555555u;
#pragma unroll
        for (int idx = 0; idx < 16; ++idx) { const int k = (idx / j) * 2 * j + (idx % j); const unsigned t = (a[k] ^ (a[k + j] >> j)) & m; a[k] ^= t; a[k + j] ^= (t << j); }
    }
}
template <int NB>
__device__ __forceinline__ void select_bits(const LAS float* sq, int nj, int* sel, int lane) {
    unsigned pl[NB][32];
#pragma unroll
    for (int blk = 0; blk < NB; ++blk) {
#pragma unroll
        for (int j = 0; j < 32; ++j) pl[blk][j] = sortable(sq[64 * (32 * blk + j) + lane]);
        transpose32(pl[blk]);
    }
    unsigned M[NB], GT[NB];
#pragma unroll
    for (int blk = 0; blk < NB; ++blk) { M[blk] = 0xFFFFFFFFu; GT[blk] = 0u; }
    unsigned T = 0u; int G = 0;
#pragma unroll
    for (int w = 0; w < 32; ++w) {
        unsigned n[NB]; int c = 0;
#pragma unroll
        for (int blk = 0; blk < NB; ++blk) { n[blk] = M[blk] & pl[blk][w]; c += __popc(n[blk]); }
        const int tot = wave_isum(c);
        const bool take = (G + tot) >= 256;
        const unsigned flip = take ? 0u : 0xFFFFFFFFu;
        T |= take ? (1u << (31 - w)) : 0u; G += take ? 0 : tot;
#pragma unroll
        for (int blk = 0; blk < NB; ++blk) { GT[blk] |= n[blk] & flip; M[blk] &= (pl[blk][w] ^ flip); }
    }
    const int need = 256 - G;
    int ceq = 0;
#pragma unroll
    for (int blk = 0; blk < NB; ++blk) ceq += __popc(M[blk]);
    const int toteq = wave_isum(ceq);
    if (toteq == need) {
        int cnt = 0;
#pragma unroll
        for (int blk = 0; blk < NB; ++blk) { GT[blk] |= M[blk]; cnt += __popc(GT[blk]); }
        int incl = cnt;
#pragma unroll
        for (int o = 1; o < 64; o <<= 1) { const int t = __shfl_up(incl, o); if (lane >= o) incl += t; }
        int pos = incl - cnt;
#pragma unroll
        for (int blk = 0; blk < NB; ++blk) { unsigned mk = GT[blk];
            while (mk) { const int x = 31 - __clz((int)mk); mk &= ~(1u << x); sel[pos++] = 64 * (32 * blk + 31 - x) + lane; } }
    } else {
        int base = 0, eqseen = 0;
#pragma unroll 1
        for (int j = 0; j < nj; ++j) {
            const unsigned kj = sortable(sq[64 * j + lane]);
            const bool gt = kj > T, eq = kj == T; const unsigned long long em = __ballot(eq);
            const bool take = gt || (eq && (eqseen + mbcnt64(em)) < need); const unsigned long long tm = __ballot(take);
            if (take) sel[base + mbcnt64(tm)] = 64 * j + lane;
            base += __popcll(tm); eqseen += __popcll(em);
        }
    }
}
__device__ __forceinline__ void index_unit(Ctx& C, int b, int cch, int sub) {
    unsigned char* ws = C.ws; const int lane = C.lane, w = C.wave;
    const int tk0 = b * SEQ + 64 * cch + 8 * sub, L = 64 * (cch + 1), nj = cch + 1;
    if (L <= 256) { int* sel = (int*)(ws + WS_SEL) + (size_t)(tk0 + w) * 256; for (int i = lane; i < L; i += 64) sel[i] = i; return; }
    LAS float* scl = (LAS float*)C.lds;
#ifndef IDXREP
#define IDXREP 0
#endif
    for (int repA = 0; repA < ((IDXREP & 1) ? 2 : 1); ++repA) {
        const int r = lane & 31, hf = lane >> 5, qq = r >> 2, h = r & 3;
        bf16x8 aq[4];
#pragma unroll
        for (int ks = 0; ks < 4; ++ks) aq[ks] = *(const bf16x8*)((const bf16_t*)(ws + WS_QI) + (size_t)(tk0 + qq) * 256 + h * 64 + 16 * ks + 8 * hf);
        f32x4 wq[4];
#pragma unroll
        for (int g = 0; g < 4; ++g) wq[g] = *(const f32x4*)((const float*)(ws + WS_WI) + (size_t)(tk0 + 2 * g + hf) * 4);
        const bf16_t* kib = (const bf16_t*)(ws + WS_KI) + (size_t)b * SEQ * 64;
        const int ntile = 2 * nj;
        bf16x8 bk[4], bk2[4];
#define IDX_LOAD(d1, d2, kta) do { const int _k1 = (kta), _k2 = ((kta) + NWAVES) < ntile ? (kta) + NWAVES : (kta); _Pragma("unroll") for (int ks = 0; ks < 4; ++ks) { \
            d1[ks] = *(const bf16x8*)(kib + (size_t)(32 * _k1 + r) * 64 + 16 * ks + 8 * hf); d2[ks] = *(const bf16x8*)(kib + (size_t)(32 * _k2 + r) * 64 + 16 * ks + 8 * hf); } } while (0)
        if (w < ntile) IDX_LOAD(bk, bk2, w);
#pragma unroll 1
        for (int kt = w; kt < ntile; kt += 2 * NWAVES) {
            const bool two = (kt + NWAVES) < ntile; const int kt2 = two ? kt + NWAVES : kt;
            bf16x8 nk[4], nk2[4];
            const bool more = (kt + 2 * NWAVES) < ntile;
            if (more) IDX_LOAD(nk, nk2, kt + 2 * NWAVES);
            f32x16 acc, acc2;
#pragma unroll
            for (int i = 0; i < 16; ++i) { acc[i] = 0.f; acc2[i] = 0.f; }
#pragma unroll
            for (int ks = 0; ks < 4; ++ks) { acc = __builtin_amdgcn_mfma_f32_32x32x16_bf16(aq[ks], bk[ks], acc, 0, 0, 0); acc2 = __builtin_amdgcn_mfma_f32_32x32x16_bf16(aq[ks], bk2[ks], acc2, 0, 0, 0); }
#pragma unroll
            for (int g = 0; g < 4; ++g) {
                float sc = fmaxf(acc[4 * g + 0], 0.f) * wq[g][0] + fmaxf(acc[4 * g + 1], 0.f) * wq[g][1] + fmaxf(acc[4 * g + 2], 0.f) * wq[g][2] + fmaxf(acc[4 * g + 3], 0.f) * wq[g][3];
                sc = (sc == 0.f) ? 0.f : sc;
                scl[(2 * g + hf) * 4096 + 32 * kt + r] = sc;
                float sc2 = fmaxf(acc2[4 * g + 0], 0.f) * wq[g][0] + fmaxf(acc2[4 * g + 1], 0.f) * wq[g][1] + fmaxf(acc2[4 * g + 2], 0.f) * wq[g][2] + fmaxf(acc2[4 * g + 3], 0.f) * wq[g][3];
                sc2 = (sc2 == 0.f) ? 0.f : sc2;
                if (two) scl[(2 * g + hf) * 4096 + 32 * kt2 + r] = sc2;
            }
            if (more) {
#pragma unroll
                for (int ks = 0; ks < 4; ++ks) { bk[ks] = nk[ks]; bk2[ks] = nk2[ks]; } }
        }
#undef IDX_LOAD
        const int njp = nj <= 32 ? 32 : 64;
        for (int j = nj; j < njp; ++j) scl[w * 4096 + 64 * j + lane] = -3.0e38f;
    }
    __syncthreads();
    for (int repB = 0; repB < ((IDXREP & 2) ? 2 : 1); ++repB) {
        const LAS float* sq = scl + w * 4096; int* sel = (int*)(ws + WS_SEL) + (size_t)(tk0 + w) * 256;
        if (nj <= 32) select_bits<1>(sq, nj, sel, lane); else select_bits<2>(sq, nj, sel, lane);
    }
    __syncthreads();
}

__device__ __forceinline__ int wave_iscan(int v) {
    v += __builtin_amdgcn_update_dpp(0, v, 0x111, 0xF, 0xF, true);
    v += __builtin_amdgcn_update_dpp(0, v, 0x112, 0xF, 0xF, true);
    v += __builtin_amdgcn_update_dpp(0, v, 0x114, 0xF, 0xF, true);
    v += __builtin_amdgcn_update_dpp(0, v, 0x118, 0xF, 0xF, true);
    v += __builtin_amdgcn_update_dpp(0, v, 0x142, 0xA, 0xF, false);
    v += __builtin_amdgcn_update_dpp(0, v, 0x143, 0xC, 0xF, false);
    return v;
}
__device__ __forceinline__ unsigned sortable16(unsigned h) { return (h & 0x8000u) ? (~h & 0xFFFFu) : (h | 0x8000u); }
__device__ __forceinline__ unsigned short f2h_bits(float f) { const _Float16 h = (_Float16)f; unsigned short b = __builtin_bit_cast(unsigned short, h); return b == 0x8000u ? (unsigned short)0 : b; }
template <int NB>
__device__ __forceinline__ void select_bits16(const LAS unsigned short* sq, int nj, int* sel, int lane) {
    unsigned a[32];
#pragma unroll
    for (int j = 0; j < 32; ++j) { const unsigned lo = sortable16(sq[64 * j + lane]); const unsigned hi = (NB == 2) ? sortable16(sq[64 * (32 + j) + lane]) : 0u; a[j] = lo | (hi << 16); }
    transpose32(a);
    unsigned Ml = 0xFFFFFFFFu, Mh = (NB == 2) ? 0xFFFFFFFFu : 0u, Gl = 0u, Gh = 0u; unsigned T = 0u; int G = 0;
#pragma unroll
    for (int bit = 15; bit >= 0; --bit) {
        const unsigned nl = Ml & a[31 - bit], nh = Mh & a[15 - bit];
        const int tot = wave_isum(__popc(nl) + __popc(nh));
        const bool take = (G + tot) >= 256; const unsigned flip = take ? 0u : 0xFFFFFFFFu;
        T |= take ? (1u << bit) : 0u; G += take ? 0 : tot;
        Gl |= nl & flip; Gh |= nh & flip; Ml &= (a[31 - bit] ^ flip); Mh &= (a[15 - bit] ^ flip);
    }
    const int need = 256 - G;
    if (T != 0x8000u) {
        const int ceq = __popc(Ml) + __popc(Mh); const int incl = wave_iscan(ceq);
        int quota = need - (incl - ceq); quota = quota < 0 ? 0 : (quota > ceq ? ceq : quota);
        const int cnt = __popc(Gl) + __popc(Gh) + quota; const int inc2 = wave_iscan(cnt);
        int pos = inc2 - cnt;
        { unsigned mk = Gl; while (mk) { const int x = 31 - __clz((int)mk); mk &= ~(1u << x); sel[pos++] = 64 * (31 - x) + lane; } }
        if (NB == 2) { unsigned mk = Gh; while (mk) { const int x = 31 - __clz((int)mk); mk &= ~(1u << x); sel[pos++] = 64 * (63 - x) + lane; } }
        { unsigned mk = Ml; while (mk && quota > 0) { const int x = 31 - __clz((int)mk); mk &= ~(1u << x); sel[pos++] = 64 * (31 - x) + lane; --quota; } }
        if (NB == 2) { unsigned mk = Mh; while (mk && quota > 0) { const int x = 31 - __clz((int)mk); mk &= ~(1u << x); sel[pos++] = 64 * (63 - x) + lane; --quota; } }
    } else {
        int base = 0, eqseen = 0;
#pragma unroll 1
        for (int j = 0; j < nj; ++j) {
            const unsigned kj = sortable16(sq[64 * j + lane]);
            const bool gt = kj > T, eq = kj == T; const unsigned long long em = __ballot(eq);
            const bool take = gt || (eq && (eqseen + mbcnt64(em)) < need); const unsigned long long tm = __ballot(take);
            if (take) sel[base + mbcnt64(tm)] = 64 * j + lane;
            base += __popcll(tm); eqseen += __popcll(em);
        }
    }
}
constexpr int CONV_SPLIT = 16384;
constexpr int KST_ROW = 144, KST_BYTES = 64 * KST_ROW;
__device__ __forceinline__ void index_unit2(Ctx& C, int b, int cch, int sub, Conv& cv) {
    unsigned char* ws = C.ws; const int lane = C.lane, w = C.wave;
    const int tk0 = b * SEQ + 64 * cch + 8 * sub, L = 64 * (cch + 1), nj = cch + 1;
    if (L <= 256) { int* sel = (int*)(ws + WS_SEL) + (size_t)(tk0 + w) * 256; for (int i = lane; i < L; i += 64) sel[i] = i; return; }
    LAS unsigned short* sclh = (LAS unsigned short*)C.lds;
    LAS unsigned char* kst = C.lds + 65536 + w * KST_BYTES;
    {
        const int r = lane & 31, hf = lane >> 5, qq = r >> 2, h = r & 3;
        bf16x8 aq[4];
#pragma unroll
        for (int ks = 0; ks < 4; ++ks) aq[ks] = *(const bf16x8*)((const bf16_t*)(ws + WS_QI) + (size_t)(tk0 + qq) * 256 + h * 64 + 16 * ks + 8 * hf);
        f32x4 wq[4];
#pragma unroll
        for (int g = 0; g < 4; ++g) wq[g] = *(const f32x4*)((const float*)(ws + WS_WI) + (size_t)(tk0 + 2 * g + hf) * 4);
        const unsigned char* kib = ws + WS_KI + (size_t)b * SEQ * 128;
        const int ntile = 2 * nj;
        u32x4 st[8];
#define IDX2_LOAD(kta) do { const int _t1 = (kta), _t2 = ((kta) + NWAVES) < ntile ? (kta) + NWAVES : (kta); _Pragma("unroll") for (int j = 0; j < 4; ++j) { \
            st[j] = *(const u32x4*)(kib + (size_t)_t1 * 4096 + 1024 * j + 16 * lane); st[4 + j] = *(const u32x4*)(kib + (size_t)_t2 * 4096 + 1024 * j + 16 * lane); } } while (0)
        if (w < ntile) IDX2_LOAD(w);
#pragma unroll 1
        for (int kt = w; kt < ntile; kt += 2 * NWAVES) {
            const bool two = (kt + NWAVES) < ntile; const int kt2 = two ? kt + NWAVES : kt;
#pragma unroll
            for (int j = 0; j < 4; ++j) { *(LAS u32x4*)(kst + (8 * j + (lane >> 3)) * KST_ROW + 16 * (lane & 7)) = st[j]; *(LAS u32x4*)(kst + (32 + 8 * j + (lane >> 3)) * KST_ROW + 16 * (lane & 7)) = st[4 + j]; }
            if ((kt + 2 * NWAVES) < ntile) IDX2_LOAD(kt + 2 * NWAVES);
            f32x16 acc, acc2;
#pragma unroll
            for (int i = 0; i < 16; ++i) { acc[i] = 0.f; acc2[i] = 0.f; }
#pragma unroll
            for (int ks = 0; ks < 4; ++ks) { const bf16x8 b1 = *(const LAS bf16x8*)(kst + r * KST_ROW + 32 * ks + 16 * hf), b2 = *(const LAS bf16x8*)(kst + (32 + r) * KST_ROW + 32 * ks + 16 * hf);
                acc = __builtin_amdgcn_mfma_f32_32x32x16_bf16(aq[ks], b1, acc, 0, 0, 0); acc2 = __builtin_amdgcn_mfma_f32_32x32x16_bf16(aq[ks], b2, acc2, 0, 0, 0); }
#pragma unroll
            for (int g = 0; g < 4; ++g) {
                const float sc = fmaxf(acc[4 * g + 0], 0.f) * wq[g][0] + fmaxf(acc[4 * g + 1], 0.f) * wq[g][1] + fmaxf(acc[4 * g + 2], 0.f) * wq[g][2] + fmaxf(acc[4 * g + 3], 0.f) * wq[g][3];
                sclh[(2 * g + hf) * 4096 + 32 * kt + r] = f2h_bits(sc);
                const float sc2 = fmaxf(acc2[4 * g + 0], 0.f) * wq[g][0] + fmaxf(acc2[4 * g + 1], 0.f) * wq[g][1] + fmaxf(acc2[4 * g + 2], 0.f) * wq[g][2] + fmaxf(acc2[4 * g + 3], 0.f) * wq[g][3];
                if (two) sclh[(2 * g + hf) * 4096 + 32 * kt2 + r] = f2h_bits(sc2);
            }
        }
#undef IDX2_LOAD
        const int njp = nj <= 32 ? 32 : 64;
        for (int j = nj; j < njp; ++j) sclh[w * 4096 + 64 * j + lane] = (unsigned short)0xFBFFu;
    }
    __syncthreads();
    {
        const LAS unsigned short* sq = sclh + w * 4096; int* sel = (int*)(ws + WS_SEL) + (size_t)(tk0 + w) * 256;
        cv.issue();
        if (nj <= 32) select_bits16<1>(sq, nj, sel, lane); else select_bits16<2>(sq, nj, sel, lane);
        cv.finish((LAS float*)kst);
    }
    __syncthreads();
}

typedef short s16x4 __attribute__((ext_vector_type(4)));
constexpr int VROW = 272;
__device__ __forceinline__ void attend_query_mfma(Ctx& C, int tk, LAS unsigned char* vs, Conv& cv) {
    unsigned char* ws = C.ws; const int lane = C.lane, c = lane & 15, g = lane >> 4;
    const int tpos = tk & (SEQ - 1), b = tk >> 12, L = 64 * ((tpos >> 6) + 1), nsel = L < 256 ? L : 256;
    const bf16_t* kb = (const bf16_t*)(ws + WS_K) + (size_t)b * SEQ * 128; const bf16_t* vb = (const bf16_t*)(ws + WS_V) + (size_t)b * SEQ * 128;
    int selr[4];
    { const int* sg = (const int*)(ws + WS_SEL) + (size_t)tk * 256;
#pragma unroll
      for (int i = 0; i < 4; ++i) selr[i] = (64 * i + lane) < nsel ? sg[64 * i + lane] : 0; }
    bf16x8 bq0[2], bq1[2];
    { const bf16_t* qp = (const bf16_t*)(ws + WS_Q) + (size_t)tk * 512 + (c & 7) * 64 + 8 * g; const bf16x8 z = (bf16x8){0, 0, 0, 0, 0, 0, 0, 0};
#pragma unroll
      for (int ks = 0; ks < 2; ++ks) { const bf16x8 q = *(const bf16x8*)(qp + 32 * ks); bq0[ks] = (c < 4) ? q : z; bq1[ks] = (c >= 4 && c < 8) ? q : z; } }
    cv.issue();
    f32x4 acc[16];
#pragma unroll
    for (int kt = 0; kt < 16; ++kt) {
        if ((kt & 3) == 0) asm volatile("" ::: "memory");
        const int key = __shfl(selr[kt >> 2], 16 * (kt & 3) + c);
        const bf16_t* kr = kb + (size_t)key * 128 + 8 * g;
        const bf16x8 a00 = *(const bf16x8*)(kr), a01 = *(const bf16x8*)(kr + 32), a10 = *(const bf16x8*)(kr + 64), a11 = *(const bf16x8*)(kr + 96);
        f32x4 t = (f32x4){0.f, 0.f, 0.f, 0.f};
        t = __builtin_amdgcn_mfma_f32_16x16x32_bf16(a00, bq0[0], t, 0, 0, 0); t = __builtin_amdgcn_mfma_f32_16x16x32_bf16(a01, bq0[1], t, 0, 0, 0);
        t = __builtin_amdgcn_mfma_f32_16x16x32_bf16(a10, bq1[0], t, 0, 0, 0); t = __builtin_amdgcn_mfma_f32_16x16x32_bf16(a11, bq1[1], t, 0, 0, 0);
        acc[kt] = t;
    }
    asm volatile("" ::: "memory"); cv.finish((LAS float*)vs); cv.issue();
    { const int lim = nsel - 4 * g;
#pragma unroll
      for (int kt = 0; kt < 16; ++kt)
#pragma unroll
        for (int r = 0; r < 4; ++r) acc[kt][r] = (16 * kt + r < lim) ? acc[kt][r] : -1e30f; }
    float m = -1e30f;
#pragma unroll
    for (int kt = 0; kt < 16; ++kt) m = fmaxf(m, fmaxf(fmaxf(acc[kt][0], acc[kt][1]), fmaxf(acc[kt][2], acc[kt][3])));
    m = fmaxf(m, __shfl_xor(m, 16)); m = fmaxf(m, __shfl_xor(m, 32));
    float sum = 0.f;
#pragma unroll
    for (int kt = 0; kt < 16; ++kt)
#pragma unroll
        for (int r = 0; r < 4; ++r) { const float pv = __expf(acc[kt][r] - m); acc[kt][r] = pv; sum += pv; }
    sum += __shfl_xor(sum, 16); sum += __shfl_xor(sum, 32);
    const float inv = 1.0f / sum;
    bf16x8 bp[8];
#pragma unroll
    for (int T = 0; T < 8; ++T) { u32x4 w; w.x = cvt_pk_bf16(acc[2 * T][0], acc[2 * T][1]); w.y = cvt_pk_bf16(acc[2 * T][2], acc[2 * T][3]); w.z = cvt_pk_bf16(acc[2 * T + 1][0], acc[2 * T + 1][1]); w.w = cvt_pk_bf16(acc[2 * T + 1][2], acc[2 * T + 1][3]);
        bp[T] = __builtin_bit_cast(bf16x8, w); }
    f32x4 ao0[4], ao1[4];
#pragma unroll
    for (int dt = 0; dt < 4; ++dt) { ao0[dt] = (f32x4){0.f, 0.f, 0.f, 0.f}; ao1[dt] = (f32x4){0.f, 0.f, 0.f, 0.f}; }
    const int q4 = c >> 2, p4 = c & 3;
    u32x4 vst[8];
#define ATT_VLOAD(T) do { _Pragma("unroll") for (int i = 0; i < 8; ++i) { const int row = g + 4 * i; \
        const int key = __shfl(selr[(T) >> 1], 32 * ((T) & 1) + row); vst[i] = *(const u32x4*)(vb + (size_t)key * 128 + 8 * c); } } while (0)
    ATT_VLOAD(0);
#pragma unroll
    for (int T = 0; T < 8; ++T) {
        LAS unsigned char* buf = vs + (T & 1) * (32 * VROW);
        asm volatile("" ::: "memory");
#pragma unroll
        for (int i = 0; i < 8; ++i) *(LAS u32x4*)(buf + (g + 4 * i) * VROW + 16 * c) = vst[i];
        if (T < 7) ATT_VLOAD(T + 1);
#pragma unroll
        for (int n = 0; n < 2; ++n)
#pragma unroll
            for (int dt = 0; dt < 4; ++dt) {
                LAS s16x4* p0 = (LAS s16x4*)(buf + (4 * g + q4) * VROW + (n * 64 + 16 * dt + 4 * p4) * 2);
                const s16x4 lo = __builtin_amdgcn_ds_read_tr16_b64_v4i16(p0), hi = __builtin_amdgcn_ds_read_tr16_b64_v4i16((LAS s16x4*)((LAS unsigned char*)p0 + 16 * VROW));
                const bf16x8 av = (bf16x8){lo[0], lo[1], lo[2], lo[3], hi[0], hi[1], hi[2], hi[3]};
                if (n == 0) ao0[dt] = __builtin_amdgcn_mfma_f32_16x16x32_bf16(av, bp[T], ao0[dt], 0, 0, 0);
                else ao1[dt] = __builtin_amdgcn_mfma_f32_16x16x32_bf16(av, bp[T], ao1[dt], 0, 0, 0);
            }
    }
#undef ATT_VLOAD
    asm volatile("" ::: "memory"); cv.finish((LAS float*)vs);
    if (c < 8) {
        bf16_t* mo = (bf16_t*)(ws + WS_MIX) + (size_t)tk * D + c * 64 + 4 * g;
#pragma unroll
        for (int dt = 0; dt < 4; ++dt) { f32x4 o; o[0] = (c < 4 ? ao0[dt][0] : ao1[dt][0]) * inv; o[1] = (c < 4 ? ao0[dt][1] : ao1[dt][1]) * inv; o[2] = (c < 4 ? ao0[dt][2] : ao1[dt][2]) * inv; o[3] = (c < 4 ? ao0[dt][3] : ao1[dt][3]) * inv; u32x2 w; w.x = cvt_pk_bf16(o[0], o[1]); w.y = cvt_pk_bf16(o[2], o[3]); *(u32x2*)(mo + 16 * dt) = w; }
    }
}

__device__ __forceinline__ void hgrn_out_group(const Args& a, Ctx& C, int l, int item) {
    const int tid = C.tid, lane = C.lane, w = C.wave, cg = item & 15, hh = (item >> 4) & 3, b = item >> 6, c0 = 4 * cg, bh = b * 4 + hh;
    LAS float* bq = (LAS float*)C.lds; LAS float* kin = bq + 64 * HP; LAS float* qq = kin + 64 * HP; LAS float* At = qq + 64 * HP; LAS float* vv = At + 64 * HP; LAS float* Ss = vv + 4096;
    const float* HG = (const float*)(C.ws + WS_HG); const float* HLb = (const float*)(C.ws + WS_HL) + (size_t)bh * 64 * 4096; const float* HDb = (const float*)(C.ws + WS_HD) + (size_t)bh * 64 * 64;
    float lbv[8];
#pragma unroll
    for (int j = 0; j < 8; ++j) { const int kk = hh * 64 + 8 * w + j; lbv[j] = (l == 1) ? 1.0f / (1.0f + expf(a.lb_logits[kk] - a.lb_logits[256 + kk])) : 0.f; }
    const int kS = tid >> 3, v8 = (tid & 7) * 8; f32x4 s0 = (f32x4){0.f, 0.f, 0.f, 0.f}, s1 = s0;
    { const float* hl = HLb + kS * 64 + v8; const float* hd = HDb + kS;
#pragma unroll 8
      for (int j = 0; j < c0; ++j) { const float dj = hd[(size_t)j * 64]; const f32x4 l0 = *(const f32x4*)(hl + (size_t)j * 4096), l1 = *(const f32x4*)(hl + (size_t)j * 4096 + 4); s0 = s0 * dj + l0; s1 = s1 * dj + l1; } }
#pragma unroll 1
    for (int c = c0; c < c0 + 4; ++c) {
        const size_t tok0 = (size_t)b * SEQ + c * 64;
        const f32x4 lc0 = *(const f32x4*)(HLb + (size_t)c * 4096 + kS * 64 + v8), lc1 = *(const f32x4*)(HLb + (size_t)c * 4096 + kS * 64 + v8 + 4);
        *(LAS f32x4*)(Ss + kS * 64 + v8) = s0; *(LAS f32x4*)(Ss + kS * 64 + v8 + 4) = s1;
        {
            const float* z = HG + (tok0 + lane) * 1024 + 256 + hh * 64 + 8 * w; const f32x4 z0 = *(const f32x4*)z, z1 = *(const f32x4*)(z + 4); const float zz[8] = {z0.x, z0.y, z0.z, z0.w, z1.x, z1.y, z1.z, z1.w};
#pragma unroll
            for (int j = 0; j < 8; ++j) { const float lb = lbv[j]; const float sg = 1.0f / (1.0f + __expf(-zz[j])), sn = 1.0f / (1.0f + __expf(zz[j])); float lf = __logf(lb + (1.0f - lb) * sg);
#pragma unroll
                for (int o = 1; o < 64; o <<= 1) { const float t = __shfl_up(lf, o); if (lane >= o) lf += t; }
                bq[lane * HP + 8 * w + j] = lf; kin[lane * HP + 8 * w + j] = (1.0f - lb) * sn; }
        }
        { const int sr = tid >> 3, k8 = (tid & 7) * 8; const float* row = HG + (tok0 + sr) * 1024 + hh * 64 + k8;
            const f32x4 q0 = *(const f32x4*)row, q1 = *(const f32x4*)(row + 4);
            qq[sr * HP + k8 + 0] = siluf_(q0.x); qq[sr * HP + k8 + 1] = siluf_(q0.y); qq[sr * HP + k8 + 2] = siluf_(q0.z); qq[sr * HP + k8 + 3] = siluf_(q0.w);
            qq[sr * HP + k8 + 4] = siluf_(q1.x); qq[sr * HP + k8 + 5] = siluf_(q1.y); qq[sr * HP + k8 + 6] = siluf_(q1.z); qq[sr * HP + k8 + 7] = siluf_(q1.w);
            *(LAS f32x4*)(vv + sr * 64 + k8) = *(const f32x4*)(row + 512); *(LAS f32x4*)(vv + sr * 64 + k8 + 4) = *(const f32x4*)(row + 516); }
        __syncthreads();
        { const int t = tid >> 3, sg = tid & 7; float ac[8] = {0.f, 0.f, 0.f, 0.f, 0.f, 0.f, 0.f, 0.f};
            for (int k = 0; k < 64; ++k) { const float qt = qq[t * HP + k], bt = bq[t * HP + k];
#pragma unroll
                for (int i = 0; i < 8; ++i) { const int sx = sg + 8 * i; if (sx <= t) ac[i] += qt * kin[sx * HP + k] * __expf(bt - bq[sx * HP + k]); } }
#pragma unroll
            for (int i = 0; i < 8; ++i) At[t * HP + sg + 8 * i] = ac[i]; }
        __syncthreads();
        { const int t = tid >> 3; float o[8] = {0.f, 0.f, 0.f, 0.f, 0.f, 0.f, 0.f, 0.f};
#pragma unroll 4
            for (int k = 0; k < 64; ++k) { const float qe = qq[t * HP + k] * __expf(bq[t * HP + k]); const f32x4 x0 = *(const LAS f32x4*)(Ss + k * 64 + v8), x1 = *(const LAS f32x4*)(Ss + k * 64 + v8 + 4);
                o[0] += qe * x0.x; o[1] += qe * x0.y; o[2] += qe * x0.z; o[3] += qe * x0.w; o[4] += qe * x1.x; o[5] += qe * x1.y; o[6] += qe * x1.z; o[7] += qe * x1.w; }
            for (int sx = 0; sx <= t; ++sx) { const float wv = At[t * HP + sx]; const f32x4 x0 = *(const LAS f32x4*)(vv + sx * 64 + v8), x1 = *(const LAS f32x4*)(vv + sx * 64 + v8 + 4);
                o[0] += wv * x0.x; o[1] += wv * x0.y; o[2] += wv * x0.z; o[3] += wv * x0.w; o[4] += wv * x1.x; o[5] += wv * x1.y; o[6] += wv * x1.z; o[7] += wv * x1.w; }
            float ss = 0.f;
#pragma unroll
            for (int j = 0; j < 8; ++j) ss += o[j] * o[j];
            ss += __shfl_xor(ss, 1); ss += __shfl_xor(ss, 2); ss += __shfl_xor(ss, 4);
            const float rstd = 1.0f / sqrtf(ss * (1.0f / 64.0f) + EPS);
            const float* gp = HG + (tok0 + t) * 1024 + 768 + hh * 64 + v8; const float* ng = a.hgrn_g + l * 64 + v8;
            const f32x4 g0 = *(const f32x4*)gp, g1 = *(const f32x4*)(gp + 4); const float gg[8] = {g0.x, g0.y, g0.z, g0.w, g1.x, g1.y, g1.z, g1.w}; float y[8];
#pragma unroll
            for (int j = 0; j < 8; ++j) y[j] = o[j] * rstd * ng[j] * siluf_(gg[j]);
            u32x4 wv; wv.x = pk2(y[0], y[1]); wv.y = pk2(y[2], y[3]); wv.z = pk2(y[4], y[5]); wv.w = pk2(y[6], y[7]);
            *(u32x4*)((bf16_t*)(C.ws + WS_MIX) + (tok0 + t) * D + 768 + hh * 64 + v8) = wv; }
        { const float dc = __expf(bq[63 * HP + kS]); s0 = s0 * dc + lc0; s1 = s1 * dc + lc1; }
        __syncthreads();
    }
}

template <bool WITH_Q>
__device__ __forceinline__ void hgrn_fill(const Args& a, Ctx& C, int l, int hh, size_t tok0, LAS float* fz, LAS float* kn, LAS float* qq, LAS float* vv) {
    const int tid = C.tid, sr = tid >> 3, k8 = (tid & 7) * 8; const float* row = (const float*)(C.ws + WS_HG) + (tok0 + sr) * 1024 + hh * 64 + k8;
    const f32x4 z0 = *(const f32x4*)(row + 256), z1 = *(const f32x4*)(row + 260); const float zz[8] = {z0.x, z0.y, z0.z, z0.w, z1.x, z1.y, z1.z, z1.w}; float fo[8], ko[8];
#pragma unroll
    for (int j = 0; j < 8; ++j) { const int kk = hh * 64 + k8 + j; const float lb = (l == 1) ? 1.0f / (1.0f + expf(a.lb_logits[kk] - a.lb_logits[256 + kk])) : 0.f;
        const float sg = 1.0f / (1.0f + expf(-zz[j])), sn = 1.0f / (1.0f + expf(zz[j])); fo[j] = lb + (1.0f - lb) * sg; ko[j] = (1.0f - lb) * sn; }
    *(LAS f32x4*)(fz + sr * 64 + k8) = (f32x4){fo[0], fo[1], fo[2], fo[3]}; *(LAS f32x4*)(fz + sr * 64 + k8 + 4) = (f32x4){fo[4], fo[5], fo[6], fo[7]};
    *(LAS f32x4*)(kn + sr * 64 + k8) = (f32x4){ko[0], ko[1], ko[2], ko[3]}; *(LAS f32x4*)(kn + sr * 64 + k8 + 4) = (f32x4){ko[4], ko[5], ko[6], ko[7]};
    if (WITH_Q) { const f32x4 q0 = *(const f32x4*)row, q1 = *(const f32x4*)(row + 4);
        *(LAS f32x4*)(qq + sr * 64 + k8) = (f32x4){siluf_(q0.x), siluf_(q0.y), siluf_(q0.z), siluf_(q0.w)}; *(LAS f32x4*)(qq + sr * 64 + k8 + 4) = (f32x4){siluf_(q1.x), siluf_(q1.y), siluf_(q1.z), siluf_(q1.w)}; }
    *(LAS f32x4*)(vv + sr * 64 + k8) = *(const f32x4*)(row + 512); *(LAS f32x4*)(vv + sr * 64 + k8 + 4) = *(const f32x4*)(row + 516);
}
__device__ __forceinline__ void hgrn_local2(const Args& a, Ctx& C, int l, int item) {
    const int tid = C.tid, c = item & 63, hh = (item >> 6) & 3, b = item >> 8, v = tid & 63, kq = tid >> 6;
    LAS float* fz = (LAS float*)C.lds; LAS float* kn = fz + 4096; LAS float* vv = kn + 4096;
    hgrn_fill<false>(a, C, l, hh, (size_t)b * SEQ + c * 64, fz, kn, nullptr, vv);
    __syncthreads();
    float S[8] = {0.f, 0.f, 0.f, 0.f, 0.f, 0.f, 0.f, 0.f}, dp[8] = {1.f, 1.f, 1.f, 1.f, 1.f, 1.f, 1.f, 1.f};
#pragma unroll 4
    for (int sx = 0; sx < 64; ++sx) { const f32x4 f0 = *(const LAS f32x4*)(fz + sx * 64 + 8 * kq), f1 = *(const LAS f32x4*)(fz + sx * 64 + 8 * kq + 4), k0 = *(const LAS f32x4*)(kn + sx * 64 + 8 * kq), k1 = *(const LAS f32x4*)(kn + sx * 64 + 8 * kq + 4);
        const float vs = vv[sx * 64 + v]; const float ff[8] = {f0.x, f0.y, f0.z, f0.w, f1.x, f1.y, f1.z, f1.w}, kk[8] = {k0.x, k0.y, k0.z, k0.w, k1.x, k1.y, k1.z, k1.w};
#pragma unroll
        for (int j = 0; j < 8; ++j) { S[j] = ff[j] * S[j] + kk[j] * vs; dp[j] *= ff[j]; } }
    float* hl = (float*)(C.ws + WS_HL) + (size_t)item * 4096 + (8 * kq) * 64 + v;
#pragma unroll
    for (int j = 0; j < 8; ++j) hl[j * 64] = S[j];
    if (v == 0) { float* hd = (float*)(C.ws + WS_HD) + (size_t)item * 64 + 8 * kq;
#pragma unroll
        for (int j = 0; j < 8; ++j) hd[j] = dp[j]; }
    __syncthreads();
}
__device__ __forceinline__ void hgrn_out2(const Args& a, Ctx& C, int l, int item) {
    const int tid = C.tid, cg = item & 15, hh = (item >> 4) & 3, b = item >> 6, c0 = 4 * cg, bh = b * 4 + hh, v = tid & 63, kq = tid >> 6;
    LAS float* fz = (LAS float*)C.lds; LAS float* kn = fz + 4096; LAS float* qq = kn + 4096; LAS float* vv = qq + 4096; LAS float* part = vv + 4096;
    const float* HLb = (const float*)(C.ws + WS_HL) + (size_t)bh * 64 * 4096 + (8 * kq) * 64 + v; const float* HDb = (const float*)(C.ws + WS_HD) + (size_t)bh * 64 * 64 + 8 * kq;
    float S[8] = {0.f, 0.f, 0.f, 0.f, 0.f, 0.f, 0.f, 0.f};
#pragma unroll 2
    for (int j = 0; j < c0; ++j) { const f32x4 d0 = *(const f32x4*)(HDb + (size_t)j * 64), d1 = *(const f32x4*)(HDb + (size_t)j * 64 + 4); const float dd[8] = {d0.x, d0.y, d0.z, d0.w, d1.x, d1.y, d1.z, d1.w};
#pragma unroll
        for (int i = 0; i < 8; ++i) S[i] = dd[i] * S[i] + HLb[(size_t)j * 4096 + i * 64]; }
#pragma unroll 1
    for (int c = c0; c < c0 + 4; ++c) {
        const size_t tok0 = (size_t)b * SEQ + c * 64;
        hgrn_fill<true>(a, C, l, hh, tok0, fz, kn, qq, vv);
        __syncthreads();
#pragma unroll 1
        for (int half = 0; half < 2; ++half) {
#pragma unroll 4
            for (int sl = 0; sl < 32; ++sl) { const int sx = 32 * half + sl;
                const f32x4 f0 = *(const LAS f32x4*)(fz + sx * 64 + 8 * kq), f1 = *(const LAS f32x4*)(fz + sx * 64 + 8 * kq + 4), k0 = *(const LAS f32x4*)(kn + sx * 64 + 8 * kq), k1 = *(const LAS f32x4*)(kn + sx * 64 + 8 * kq + 4);
                const f32x4 q0 = *(const LAS f32x4*)(qq + sx * 64 + 8 * kq), q1 = *(const LAS f32x4*)(qq + sx * 64 + 8 * kq + 4);
                const float vs = vv[sx * 64 + v]; const float ff[8] = {f0.x, f0.y, f0.z, f0.w, f1.x, f1.y, f1.z, f1.w}, kk[8] = {k0.x, k0.y, k0.z, k0.w, k1.x, k1.y, k1.z, k1.w}, qv[8] = {q0.x, q0.y, q0.z, q0.w, q1.x, q1.y, q1.z, q1.w};
                float op = 0.f;
#pragma unroll
                for (int j = 0; j < 8; ++j) { S[j] = ff[j] * S[j] + kk[j] * vs; op += qv[j] * S[j]; }
                part[(kq * 32 + sl) * 64 + v] = op; }
            __syncthreads();
            { const int t = tid >> 4, v4 = (tid & 15) * 4; f32x4 o = (f32x4){0.f, 0.f, 0.f, 0.f};
#pragma unroll
                for (int kk2 = 0; kk2 < 8; ++kk2) o += *(const LAS f32x4*)(part + (kk2 * 32 + t) * 64 + v4);
                float ss = o.x * o.x + o.y * o.y + o.z * o.z + o.w * o.w;
                ss += __shfl_xor(ss, 1); ss += __shfl_xor(ss, 2); ss += __shfl_xor(ss, 4); ss += __shfl_xor(ss, 8);
                const float rstd = 1.0f / sqrtf(ss * (1.0f / 64.0f) + EPS);
                const size_t tok = tok0 + 32 * half + t;
                const f32x4 gg = *(const f32x4*)((const float*)(C.ws + WS_HG) + tok * 1024 + 768 + hh * 64 + v4), ng = *(const f32x4*)(a.hgrn_g + l * 64 + v4);
                const float y0 = o.x * rstd * ng.x * siluf_(gg.x), y1 = o.y * rstd * ng.y * siluf_(gg.y), y2 = o.z * rstd * ng.z * siluf_(gg.z), y3 = o.w * rstd * ng.w * siluf_(gg.w);
                u32x2 wv; wv.x = pk2(y0, y1); wv.y = pk2(y2, y3);
                *(u32x2*)((bf16_t*)(C.ws + WS_MIX) + tok * D + 768 + hh * 64 + v4) = wv; }
            __syncthreads();
        }
    }
}

__device__ __forceinline__ void pool_wave(const Args& a, Ctx& C, int l) {
    unsigned char* ws = C.ws; const int lane = C.lane;
    const int gwv = blockIdx.x * NWAVES + C.wave, g = gwv & 3, widx = gwv >> 2, nw = (C.G * NWAVES) >> 2, w = 2 << g;
    float pwr[64];
#pragma unroll
    for (int c = 0; c < 64; ++c) pwr[c] = a.pool_w[(size_t)(l * 4 + g) * 4096 + c * 64 + lane];
    const float psc = a.pool_scale[l * 256 + g * 64 + lane];
    const float* ubg = (const float*)(ws + WS_UB) + g * 64 + lane;
    for (int tile = widx; tile < NTOK / 8; tile += nw) {
        const int tok0 = tile * 8, tp0 = tok0 & (SEQ - 1);
        float row[23];
#pragma unroll
        for (int r = 0; r < 23; ++r) { const int tp = tp0 - 15 + r; row[r] = (tp >= 0) ? ubg[(size_t)(tok0 - 15 + r) * 256] : 0.f; }
        float pooled[8];
#pragma unroll
        for (int t = 0; t < 8; ++t) {
            float sm = 0.f;
#pragma unroll
            for (int i = 0; i < 16; ++i) if (i < w) sm += row[15 + t - i];
            const int tpos = tp0 + t; const int wl = (tpos + 1) < w ? (tpos + 1) : w;
            pooled[t] = sm * (1.0f / (float)wl) - row[15 + t];
        }
        float y[8] = {0.f, 0.f, 0.f, 0.f, 0.f, 0.f, 0.f, 0.f};
#pragma unroll
        for (int c = 0; c < 64; ++c) {
#pragma unroll
            for (int t = 0; t < 8; ++t) y[t] += __builtin_bit_cast(float, __builtin_amdgcn_readlane(__builtin_bit_cast(int, pooled[t]), c)) * pwr[c];
        }
        bf16_t* mo = (bf16_t*)(ws + WS_MIX) + (size_t)tok0 * D + 512 + g * 64 + lane;
#pragma unroll
        for (int t = 0; t < 8; ++t) mo[(size_t)t * D] = (bf16_t)f2bf(y[t] * psc);
    }
}

__device__ __forceinline__ void hgrn_local3(const Args& a, Ctx& C, int l, int item) {
    const int tid = C.tid, cg = item & 15, hh = (item >> 4) & 3, b = item >> 6, v = tid & 63, kq = tid >> 6;
    LAS float* fz = (LAS float*)C.lds; LAS float* kn = fz + 4096; LAS float* vv = kn + 4096;
    float S[8] = {0.f, 0.f, 0.f, 0.f, 0.f, 0.f, 0.f, 0.f}, dp[8] = {1.f, 1.f, 1.f, 1.f, 1.f, 1.f, 1.f, 1.f};
#pragma unroll 1
    for (int ci = 0; ci < 4; ++ci) {
        const int c = 4 * cg + ci;
        hgrn_fill<false>(a, C, l, hh, (size_t)b * SEQ + c * 64, fz, kn, nullptr, vv);
        __syncthreads();
#pragma unroll 4
        for (int sx = 0; sx < 64; ++sx) { const f32x4 f0 = *(const LAS f32x4*)(fz + sx * 64 + 8 * kq), f1 = *(const LAS f32x4*)(fz + sx * 64 + 8 * kq + 4), k0 = *(const LAS f32x4*)(kn + sx * 64 + 8 * kq), k1 = *(const LAS f32x4*)(kn + sx * 64 + 8 * kq + 4);
            const float vs = vv[sx * 64 + v]; const float ff[8] = {f0.x, f0.y, f0.z, f0.w, f1.x, f1.y, f1.z, f1.w}, kk[8] = {k0.x, k0.y, k0.z, k0.w, k1.x, k1.y, k1.z, k1.w};
#pragma unroll
            for (int j = 0; j < 8; ++j) { S[j] = ff[j] * S[j] + kk[j] * vs; dp[j] *= ff[j]; } }
        const size_t ch = (size_t)((b * 4 + hh) * 64 + c);
        float* hr = (float*)(C.ws + WS_HL) + ch * 4096;
#pragma unroll
        for (int j = 0; j < 8; ++j) { const int k = 8 * kq + j, kt = k >> 4, g = (k >> 2) & 3, r = k & 3, vq = v >> 4, cv = v & 15; hr[(((vq * 4 + kt) * 4 + g) * 16 + cv) * 4 + r] = S[j]; }
        if (v == 0) { float* he = (float*)(C.ws + WS_HD) + ch * 64 + 8 * kq;
#pragma unroll
            for (int j = 0; j < 8; ++j) he[j] = dp[j]; }
        __syncthreads();
    }
}
__device__ __forceinline__ float row_shr_add(float x, int) { return x; }
template <int N> __device__ __forceinline__ float dpp_row_shr(float x) { return __builtin_bit_cast(float, __builtin_amdgcn_update_dpp(0, __builtin_bit_cast(int, x), 0x110 + N, 0xF, 0xF, true)); }
__device__ __forceinline__ float row_scan16(float x) { x += dpp_row_shr<1>(x); x += dpp_row_shr<2>(x); x += dpp_row_shr<4>(x); x += dpp_row_shr<8>(x); return x; }
__device__ __forceinline__ float row_last16(float x) { return __builtin_bit_cast(float, __builtin_amdgcn_update_dpp(0, __builtin_bit_cast(int, x), 0x15F, 0xF, 0xF, true)); }
__device__ __forceinline__ float row_sum16(float v) {
    v += __builtin_bit_cast(float, __builtin_amdgcn_update_dpp(0, __builtin_bit_cast(int, v), 0xB1, 0xF, 0xF, true));
    v += __builtin_bit_cast(float, __builtin_amdgcn_update_dpp(0, __builtin_bit_cast(int, v), 0x4E, 0xF, 0xF, true));
    v += __builtin_bit_cast(float, __builtin_amdgcn_update_dpp(0, __builtin_bit_cast(int, v), 0x141, 0xF, 0xF, true));
    v += __builtin_bit_cast(float, __builtin_amdgcn_update_dpp(0, __builtin_bit_cast(int, v), 0x140, 0xF, 0xF, true));
    return v;
}
__device__ __forceinline__ void hgrn_out3(const Args& a, Ctx& C, int l, int item, LAS unsigned char* kls) {
    const int lane = C.lane, tt = lane & 15, g = lane >> 4, c = item & 63, hh = (item >> 6) & 3, b = item >> 8, bh = b * 4 + hh, cg = c >> 2, ci = c & 3;
    const float* HG = (const float*)(C.ws + WS_HG); const float* HR = (const float*)(C.ws + WS_HL); const float* HE = (const float*)(C.ws + WS_HD);
    float lb[16];
#pragma unroll
    for (int e = 0; e < 16; ++e) { const int kk = hh * 64 + 16 * (e >> 2) + 4 * g + (e & 3); lb[e] = (l == 1) ? 1.0f / (1.0f + expf(a.lb_logits[kk] - a.lb_logits[256 + kk])) : 0.f; }
    f32x4 S[4][4];
#pragma unroll
    for (int vq = 0; vq < 4; ++vq)
#pragma unroll
        for (int kt = 0; kt < 4; ++kt) S[vq][kt] = (f32x4){0.f, 0.f, 0.f, 0.f};
    const int nstep = cg + (ci > 0 ? 1 : 0);
#pragma unroll 1
    for (int st = 0; st < nstep; ++st) {
        const int chn = (st < cg) ? (4 * st + 3) : (4 * cg + ci - 1); const size_t ch = (size_t)(bh * 64 + chn);
        const float* hr = HR + ch * 4096 + (g * 16 + tt) * 4; const float* he = HE + ch * 64 + 4 * g;
        f32x4 ev[4];
#pragma unroll
        for (int kt = 0; kt < 4; ++kt) ev[kt] = *(const f32x4*)(he + 16 * kt);
#pragma unroll
        for (int vq = 0; vq < 4; ++vq)
#pragma unroll
            for (int kt = 0; kt < 4; ++kt) S[vq][kt] = S[vq][kt] * ev[kt] + *(const f32x4*)(hr + (vq * 4 + kt) * 256);
    }
    const size_t tok0 = (size_t)b * SEQ + c * 64;
#pragma unroll 1
    for (int sb = 0; sb < 4; ++sb) {
        const size_t tok = tok0 + 16 * sb + tt; const float* row = HG + tok * 1024 + hh * 64 + 4 * g;
        float qh[16], kt_[16], kp[16], dd[16];
#pragma unroll
        for (int e4 = 0; e4 < 4; ++e4) {
            const f32x4 q4 = *(const f32x4*)(row + 16 * e4), z4 = *(const f32x4*)(row + 256 + 16 * e4);
#pragma unroll
            for (int j = 0; j < 4; ++j) { const int e = 4 * e4 + j; const float lbe = lb[e];
                const float sg = __builtin_amdgcn_rcpf(1.0f + __expf(-z4[j])), sn = __builtin_amdgcn_rcpf(1.0f + __expf(z4[j]));
                const float lf = __logf(lbe + (1.0f - lbe) * sg), kin = (1.0f - lbe) * sn;
                const float cc = row_scan16(lf), c15 = row_last16(cc);
                qh[e] = siluf_(q4[j]) * __expf(cc); kt_[e] = kin * __expf(-cc); kp[e] = kin * __expf(c15 - cc); dd[e] = __expf(c15); }
        }
        bf16x8 Qf[2], Kf[2];
#pragma unroll
        for (int ks = 0; ks < 2; ++ks) { u32x4 wq, wk;
            wq.x = pk2(qh[8 * ks + 0], qh[8 * ks + 1]); wq.y = pk2(qh[8 * ks + 2], qh[8 * ks + 3]); wq.z = pk2(qh[8 * ks + 4], qh[8 * ks + 5]); wq.w = pk2(qh[8 * ks + 6], qh[8 * ks + 7]);
            wk.x = pk2(kt_[8 * ks + 0], kt_[8 * ks + 1]); wk.y = pk2(kt_[8 * ks + 2], kt_[8 * ks + 3]); wk.z = pk2(kt_[8 * ks + 4], kt_[8 * ks + 5]); wk.w = pk2(kt_[8 * ks + 6], kt_[8 * ks + 7]);
            Qf[ks] = __builtin_bit_cast(bf16x8, wq); Kf[ks] = __builtin_bit_cast(bf16x8, wk); }
#pragma unroll
        for (int e4 = 0; e4 < 4; ++e4) { u32x2 w; w.x = pk2(kp[4 * e4 + 0], kp[4 * e4 + 1]); w.y = pk2(kp[4 * e4 + 2], kp[4 * e4 + 3]); *(LAS u32x2*)(kls + tt * 144 + (16 * e4 + 4 * g) * 2) = w; }
        f32x4 at = (f32x4){0.f, 0.f, 0.f, 0.f};
        at = __builtin_amdgcn_mfma_f32_16x16x32_bf16(Kf[0], Qf[0], at, 0, 0, 0); at = __builtin_amdgcn_mfma_f32_16x16x32_bf16(Kf[1], Qf[1], at, 0, 0, 0);
#pragma unroll
        for (int r = 0; r < 4; ++r) at[r] = (4 * g + r <= tt) ? at[r] : 0.f;
        u32x4 wa; wa.x = pk2(at[0], at[1]); wa.y = pk2(at[2], at[3]); wa.z = 0u; wa.w = 0u; const bf16x8 Af = __builtin_bit_cast(bf16x8, wa);
        bf16x8 Vf[4];
        { const float* vp = HG + (tok0 + 16 * sb + 4 * g) * 1024 + 512 + hh * 64 + tt;
#pragma unroll
          for (int vq = 0; vq < 4; ++vq) { u32x4 w; w.x = pk2(vp[16 * vq], vp[1024 + 16 * vq]); w.y = pk2(vp[2048 + 16 * vq], vp[3072 + 16 * vq]); w.z = 0u; w.w = 0u; Vf[vq] = __builtin_bit_cast(bf16x8, w); } }
        f32x4 O[4];
#pragma unroll
        for (int vq = 0; vq < 4; ++vq) {
            u32x4 s0, s1; s0.x = pk2(S[vq][0][0], S[vq][0][1]); s0.y = pk2(S[vq][0][2], S[vq][0][3]); s0.z = pk2(S[vq][1][0], S[vq][1][1]); s0.w = pk2(S[vq][1][2], S[vq][1][3]);
            s1.x = pk2(S[vq][2][0], S[vq][2][1]); s1.y = pk2(S[vq][2][2], S[vq][2][3]); s1.z = pk2(S[vq][3][0], S[vq][3][1]); s1.w = pk2(S[vq][3][2], S[vq][3][3]);
            f32x4 o = (f32x4){0.f, 0.f, 0.f, 0.f};
            o = __builtin_amdgcn_mfma_f32_16x16x32_bf16(Qf[0], __builtin_bit_cast(bf16x8, s0), o, 0, 0, 0); o = __builtin_amdgcn_mfma_f32_16x16x32_bf16(Qf[1], __builtin_bit_cast(bf16x8, s1), o, 0, 0, 0);
            o = __builtin_amdgcn_mfma_f32_16x16x32_bf16(Af, Vf[vq], o, 0, 0, 0); O[vq] = o; }
        { float rs[4];
#pragma unroll
          for (int r = 0; r < 4; ++r) { float ss = O[0][r] * O[0][r] + O[1][r] * O[1][r] + O[2][r] * O[2][r] + O[3][r] * O[3][r]; ss = row_sum16(ss); rs[r] = 1.0f / sqrtf(ss * (1.0f / 64.0f) + EPS); }
          const float* gp = HG + (tok0 + 16 * sb + 4 * g) * 1024 + 768 + hh * 64 + tt; bf16_t* mo = (bf16_t*)(C.ws + WS_MIX) + (tok0 + 16 * sb + 4 * g) * D + 768 + hh * 64 + tt;
#pragma unroll
          for (int vq = 0; vq < 4; ++vq) { const float ngv = a.hgrn_g[l * 64 + 16 * vq + tt];
#pragma unroll
            for (int r = 0; r < 4; ++r) mo[(size_t)r * D + 16 * vq] = (bf16_t)f2bf(O[vq][r] * rs[r] * ngv * siluf_(gp[(size_t)r * 1024 + 16 * vq])); } }
        asm volatile("s_waitcnt lgkmcnt(0)" ::: "memory");
#pragma unroll
        for (int kt = 0; kt < 4; ++kt) {
            const s16x4 t4 = __builtin_amdgcn_ds_read_tr16_b64_v4i16((LAS s16x4*)(kls + (4 * g + (tt >> 2)) * 144 + (16 * kt + 4 * (tt & 3)) * 2));
            const bf16x8 Ktf = (bf16x8){t4[0], t4[1], t4[2], t4[3], 0, 0, 0, 0};
            const f32x4 dv = (f32x4){dd[4 * kt + 0], dd[4 * kt + 1], dd[4 * kt + 2], dd[4 * kt + 3]};
#pragma unroll
            for (int vq = 0; vq < 4; ++vq) S[vq][kt] = __builtin_amdgcn_mfma_f32_16x16x32_bf16(Ktf, Vf[vq], S[vq][kt] * dv, 0, 0, 0);
        }
        asm volatile("s_waitcnt lgkmcnt(0)" ::: "memory");
    }
}

__device__ __forceinline__ void hgrn_local4(const Args& a, Ctx& C, int l, int item, LAS unsigned char* kls) {
    const int lane = C.lane, tt = lane & 15, g = lane >> 4, vq = item & 3, cg = (item >> 2) & 15, hh = (item >> 6) & 3, b = item >> 8, bh = b * 4 + hh;
    const float* HG = (const float*)(C.ws + WS_HG);
    float lb[16], ecum[16];
#pragma unroll
    for (int e = 0; e < 16; ++e) { const int kk = hh * 64 + 16 * (e >> 2) + 4 * g + (e & 3); lb[e] = (l == 1) ? 1.0f / (1.0f + expf(a.lb_logits[kk] - a.lb_logits[256 + kk])) : 0.f; ecum[e] = 1.0f; }
    f32x4 S[4];
#pragma unroll
    for (int kt = 0; kt < 4; ++kt) S[kt] = (f32x4){0.f, 0.f, 0.f, 0.f};
    const size_t tokg = (size_t)b * SEQ + (size_t)cg * 256;
    f32x4 zc[4]; float vc[4];
#define HL4_LOAD(zd, vd, sbi) do { const size_t _t0 = tokg + 16 * (sbi); const float* _r = HG + (_t0 + tt) * 1024 + hh * 64 + 4 * g + 256; \
        _Pragma("unroll") for (int e4 = 0; e4 < 4; ++e4) zd[e4] = *(const f32x4*)(_r + 16 * e4); \
        const float* _v = HG + (_t0 + 4 * g) * 1024 + 512 + hh * 64 + 16 * vq + tt; vd[0] = _v[0]; vd[1] = _v[1024]; vd[2] = _v[2048]; vd[3] = _v[3072]; } while (0)
    HL4_LOAD(zc, vc, 0);
#pragma unroll 1
    for (int ci = 0; ci < 4; ++ci) {
        const int c = 4 * cg + ci;
#pragma unroll 1
        for (int sb = 0; sb < 4; ++sb) {
            const int sbi = 4 * ci + sb; f32x4 zn[4]; float vn[4];
            if (sbi < 15) HL4_LOAD(zn, vn, sbi + 1); else {
#pragma unroll
                for (int e4 = 0; e4 < 4; ++e4) { zn[e4] = zc[e4]; vn[e4] = vc[e4]; } }
            float kp[16], dd[16];
#pragma unroll
            for (int e4 = 0; e4 < 4; ++e4) { const f32x4 z4 = zc[e4];
#pragma unroll
                for (int j = 0; j < 4; ++j) { const int e = 4 * e4 + j; const float lbe = lb[e];
                    const float sg = __builtin_amdgcn_rcpf(1.0f + __expf(-z4[j])), sn = __builtin_amdgcn_rcpf(1.0f + __expf(z4[j]));
                    const float lf = __logf(lbe + (1.0f - lbe) * sg), kin = (1.0f - lbe) * sn;
                    const float cc = row_scan16(lf), c15 = row_last16(cc);
                    kp[e] = kin * __expf(c15 - cc); dd[e] = __expf(c15); ecum[e] *= dd[e]; } }
#pragma unroll
            for (int e4 = 0; e4 < 4; ++e4) { u32x2 w; w.x = pk2(kp[4 * e4 + 0], kp[4 * e4 + 1]); w.y = pk2(kp[4 * e4 + 2], kp[4 * e4 + 3]); *(LAS u32x2*)(kls + tt * 144 + (16 * e4 + 4 * g) * 2) = w; }
            bf16x8 Vf; { u32x4 w; w.x = pk2(vc[0], vc[1]); w.y = pk2(vc[2], vc[3]); w.z = 0u; w.w = 0u; Vf = __builtin_bit_cast(bf16x8, w); }
            asm volatile("s_waitcnt lgkmcnt(0)" ::: "memory");
#pragma unroll
            for (int kt = 0; kt < 4; ++kt) {
                const s16x4 t4 = __builtin_amdgcn_ds_read_tr16_b64_v4i16((LAS s16x4*)(kls + (4 * g + (tt >> 2)) * 144 + (16 * kt + 4 * (tt & 3)) * 2));
                const bf16x8 Ktf = (bf16x8){t4[0], t4[1], t4[2], t4[3], 0, 0, 0, 0};
                const f32x4 dv = (f32x4){dd[4 * kt + 0], dd[4 * kt + 1], dd[4 * kt + 2], dd[4 * kt + 3]};
                S[kt] = __builtin_amdgcn_mfma_f32_16x16x32_bf16(Ktf, Vf, S[kt] * dv, 0, 0, 0);
            }
            asm volatile("s_waitcnt lgkmcnt(0)" ::: "memory");
#pragma unroll
            for (int e4 = 0; e4 < 4; ++e4) { zc[e4] = zn[e4]; vc[e4] = vn[e4]; }
        }
        const size_t ch = (size_t)(bh * 64 + c);
        float* hr = (float*)(C.ws + WS_HL) + ch * 4096 + (g * 16 + tt) * 4;
#pragma unroll
        for (int kt = 0; kt < 4; ++kt) *(f32x4*)(hr + (vq * 4 + kt) * 256) = S[kt];
        if (vq == 0 && tt == 0) { float* he = (float*)(C.ws + WS_HD) + ch * 64 + 4 * g;
#pragma unroll
            for (int kt = 0; kt < 4; ++kt) *(f32x4*)(he + 16 * kt) = (f32x4){ecum[4 * kt + 0], ecum[4 * kt + 1], ecum[4 * kt + 2], ecum[4 * kt + 3]}; }
    }
#undef HL4_LOAD
}

__device__ __forceinline__ void phase_mix1(const Args& a, Ctx& C, int l) {
#ifndef MIX1MASK
#define MIX1MASK 7
#endif
#ifndef MIX1REP
#define MIX1REP 0
#endif
#ifndef HGRN3
#define HGRN3 1
#endif
#ifndef HGRN4
#define HGRN4 1
#endif
    if (HGRN3 && HGRN4) { if (C.wave < 4) for (int it = blockIdx.x * 4 + C.wave; it < 1024; it += C.G * 4) hgrn_local4(a, C, l, it, C.lds + C.wave * 4096); __syncthreads(); }
    else if (HGRN3) { for (int rep = 0; rep < ((MIX1REP & 1) && l == 0 ? 2 : 1); ++rep) for (int it = blockIdx.x; it < 256; it += C.G) hgrn_local3(a, C, l, it); }
    else for (int rep = 0; rep < ((MIX1REP & 1) && l == 0 ? 2 : 1); ++rep) for (int it = blockIdx.x; it < 1024; it += C.G) hgrn_local2(a, C, l, it);
    for (int rep = 0; rep < ((MIX1REP & 2) && l == 0 ? 2 : 1); ++rep) pool_wave(a, C, l);
    __syncthreads();
    Conv cv; cv.w1l = a.w1 + (size_t)l * 32 * 1024 * 2048; cv.w2l = a.w2 + (size_t)l * 32 * 1024 * 1024; cv.w1t = (bf16_t*)(C.ws + WS_W1) + (size_t)l * 32 * 2048 * 1024; cv.w2t = (bf16_t*)(C.ws + WS_W2) + (size_t)l * 32 * 1024 * 1024;
    cv.it = blockIdx.x * NWAVES + C.wave; cv.step = C.G * NWAVES; cv.lane = C.lane; cv.pend = false; cv.it_end = CONV_SPLIT;
    for (int rep = 0; rep < ((MIX1REP & 4) && l == 0 ? 2 : 1); ++rep) for (int base = 0; base < 2048; base += 2 * C.G) {
        const int u1 = base + (int)blockIdx.x, u2 = base + 2 * C.G - 1 - (int)blockIdx.x;
        if (u1 < 2048) index_unit2(C, (u1 >> 3) & 3, u1 >> 5, u1 & 7, cv);
        if (u2 < 2048) index_unit2(C, (u2 >> 3) & 3, u2 >> 5, u2 & 7, cv);
    }
    for (;;) { cv.issue(); if (!cv.pend) break; cv.finish((LAS float*)(C.lds + 65536 + C.wave * KST_BYTES)); }
}
__device__ __forceinline__ void phase_mix2(const Args& a, Ctx& C, int l) {
#ifndef MIX2MASK
#define MIX2MASK 3
#endif
#ifndef MIX2REP
#define MIX2REP 0
#endif
    LAS int* qctr = (LAS int*)(C.lds + LDS_BYTES - 64 + 16);
    if (C.tid == 0) *qctr = 0;
    __syncthreads();
    if (HGRN3) { for (int rep = 0; rep < ((MIX2REP & 1) ? 2 : 1); ++rep) if (C.wave < 4) for (int it = blockIdx.x * 4 + C.wave; it < 1024; it += C.G * 4) hgrn_out3(a, C, l, it, C.lds + C.wave * (2 * 32 * VROW)); }
    else for (int rep = 0; rep < ((MIX2REP & 1) ? 2 : 1); ++rep) for (int it = blockIdx.x; it < 256; it += C.G) hgrn_out2(a, C, l, it);
    LAS unsigned char* vs = C.lds + C.wave * (2 * 32 * VROW);
    const int gw = blockIdx.x * NWAVES + C.wave, NGW = C.G * NWAVES;
    Conv cv; cv.w1l = a.w1 + (size_t)l * 32 * 1024 * 2048; cv.w2l = a.w2 + (size_t)l * 32 * 1024 * 1024; cv.w1t = (bf16_t*)(C.ws + WS_W1) + (size_t)l * 32 * 2048 * 1024; cv.w2t = (bf16_t*)(C.ws + WS_W2) + (size_t)l * 32 * 1024 * 1024;
    cv.it = CONV_SPLIT + gw; cv.step = NGW; cv.lane = C.lane; cv.pend = false; cv.it_end = Conv::NITEMS;
    for (;;) {
        int n = 0; if (C.lane == 0) n = __hip_atomic_fetch_add(qctr, 1, __ATOMIC_RELAXED, __HIP_MEMORY_SCOPE_WORKGROUP);
        n = __builtin_amdgcn_readfirstlane(n);
        const int tk = (int)blockIdx.x * NWAVES + (n & 7) + NGW * (n >> 3);
        if (tk >= NTOK) break;
        attend_query_mfma(C, tk, vs, cv);
    }
    for (;;) { cv.finish((LAS float*)vs); cv.issue(); if (!cv.pend) break; }
}

__device__ __forceinline__ void phase_router(const Args& a, Ctx& C, int l) {
    unsigned char* ws = C.ws; const int lane = C.lane;
    LAS float* us = (LAS float*)(C.lds + C.wave * 8192);
    const float* mod = (const float*)(ws + WS_MOD); const float* H = (const float*)(ws + WS_H);
    const float* wr = a.w_router + (size_t)l * 1024 * 32; unsigned* cnt = (unsigned*)(ws + WS_CTL) + CW_CNT + l * 32 * 64;
    const int gw = blockIdx.x * NWAVES + C.wave, NGW = C.G * NWAVES;
    for (int base = gw * 2; base < NTOK; base += NGW * 2) {
#pragma unroll
        for (int hf = 0; hf < 2; ++hf) {
            const int tk = base + hf, b = tk >> 12; const f32x4* hr = (const f32x4*)(H + (size_t)tk * D) + lane; f32x4 v[4];
#pragma unroll
            for (int j = 0; j < 4; ++j) v[j] = hr[64 * j];
            float ss = 0.f;
#pragma unroll
            for (int j = 0; j < 4; ++j) ss += (v[j].x * v[j].x + v[j].y * v[j].y) + (v[j].z * v[j].z + v[j].w * v[j].w);
            const float rstd = 1.0f / sqrtf(wave_sum(ss) * (1.0f / D) + EPS);
            const float* mb = mod + (size_t)(l * 4 + b) * 6144; bf16_t* urow = (bf16_t*)(ws + WS_U) + (size_t)tk * D;
#pragma unroll
            for (int j = 0; j < 4; ++j) { const int idx = 4 * lane + 256 * j; const f32x4 gv = *(const f32x4*)(a.norm2_g + l * 1024 + idx), shv = *(const f32x4*)(mb + 3072 + idx), scv = *(const f32x4*)(mb + 4096 + idx);
                const f32x4 o = v[j] * rstd * gv * (scv + 1.0f) + shv; u32x2 w; w.x = pk2(o[0], o[1]); w.y = pk2(o[2], o[3]); *(u32x2*)(urow + idx) = w;
                *(LAS f32x4*)(us + hf * 1024 + idx) = o; }
        }
        asm volatile("s_waitcnt lgkmcnt(0)" ::: "memory"); __builtin_amdgcn_wave_barrier();
        const int e = lane & 31, hf = lane >> 5; float acc0 = 0.f, acc1 = 0.f;
        const LAS float* up = us + hf * 1024;
#pragma unroll 8
        for (int d = 0; d < 1024; d += 2) { acc0 += up[d] * wr[d * 32 + e]; acc1 += up[d + 1] * wr[(d + 1) * 32 + e]; }
        float val = acc0 + acc1 + a.b_router[l * 32 + e];
        float tv[4]; int te[4];
#pragma unroll
        for (int k = 0; k < 4; ++k) {
            float bv = val; int bi = e;
#pragma unroll
            for (int o = 1; o < 32; o <<= 1) { const float ov = __shfl_xor(bv, o); const int oi = __shfl_xor(bi, o); if (ov > bv || (ov == bv && oi < bi)) { bv = ov; bi = oi; } }
            tv[k] = bv; te[k] = bi; if (e == bi) val = -3.0e38f;
        }
        const float e1 = __expf(tv[1] - tv[0]), e2 = __expf(tv[2] - tv[0]), e3 = __expf(tv[3] - tv[0]); const float rs = 1.0f / (1.0f + e1 + e2 + e3);
        if (e < 4) {
            const int tk = base + hf; const int ex = e == 0 ? te[0] : e == 1 ? te[1] : e == 2 ? te[2] : te[3]; const float gt = (e == 0 ? 1.0f : e == 1 ? e1 : e == 2 ? e2 : e3) * rs;
            const unsigned slot = atomicAdd(cnt + ex * 64, 1u);
            ((int*)(ws + WS_ROWTOK))[(size_t)ex * NTOK + slot] = tk;
            ((int*)(ws + WS_EIDX))[tk * 4 + e] = ex; ((int*)(ws + WS_SLOT))[tk * 4 + e] = (int)slot; ((float*)(ws + WS_GATE))[tk * 4 + e] = gt;
        }
        asm volatile("s_waitcnt lgkmcnt(0)" ::: "memory"); __builtin_amdgcn_wave_barrier();
    }
}

constexpr int URS = 2064;
__device__ __forceinline__ void phase_router2(const Args& a, Ctx& C, int l) {
    unsigned char* ws = C.ws; const int lane = C.lane, w = C.wave, tid = C.tid;
    LAS unsigned char* uh = C.lds; LAS unsigned char* ul = uh + 16 * URS; LAS float* part = (LAS float*)(ul + 16 * URS);
    LAS int* hist = (LAS int*)(part + 8 * 16 * 32);
    LAS int* asg = hist + 64;
    LAS float* asgg = (LAS float*)(asg + 2 * 1024);
    const float* mod = (const float*)(ws + WS_MOD); const float* H = (const float*)(ws + WS_H);
    const bf16_t* wrh = (const bf16_t*)(ws + WS_WRH) + (size_t)l * 32768; const bf16_t* wrl = (const bf16_t*)(ws + WS_WRL) + (size_t)l * 32768;
    unsigned* cnt = (unsigned*)(ws + WS_CTL) + CW_CNT + l * 32 * 64;
    const int ntile_all = NTOK / 16;
    for (int tile0 = blockIdx.x; tile0 < ntile_all; tile0 += 16 * C.G) {
        if (tid < 64) hist[tid] = 0;
        __syncthreads();
        int nt_here = 0;
        f32x4 hv[2][4];
#pragma unroll
        for (int hf = 0; hf < 2; ++hf) { const f32x4* hr = (const f32x4*)(H + (size_t)(tile0 * 16 + 2 * w + hf) * D) + lane;
#pragma unroll
            for (int j = 0; j < 4; ++j) hv[hf][j] = hr[64 * j]; }
        for (int tile = tile0; tile < ntile_all && nt_here < 16; tile += C.G, ++nt_here) {
            const int tok0 = tile * 16;
#pragma unroll
            for (int hf = 0; hf < 2; ++hf) {
                const int tr = 2 * w + hf, tk = tok0 + tr, b = tk >> 12; f32x4 v[4];
#pragma unroll
                for (int j = 0; j < 4; ++j) v[j] = hv[hf][j];
                float ss = 0.f;
#pragma unroll
                for (int j = 0; j < 4; ++j) ss += (v[j].x * v[j].x + v[j].y * v[j].y) + (v[j].z * v[j].z + v[j].w * v[j].w);
                const float rstd = 1.0f / sqrtf(wave_sum(ss) * (1.0f / D) + EPS);
                const float* mb = mod + (size_t)(l * 4 + b) * 6144; bf16_t* urow = (bf16_t*)(ws + WS_U) + (size_t)tk * D;
#pragma unroll
                for (int j = 0; j < 4; ++j) { const int idx = 4 * lane + 256 * j; const f32x4 gv = *(const f32x4*)(a.norm2_g + l * 1024 + idx), shv = *(const f32x4*)(mb + 3072 + idx), scv = *(const f32x4*)(mb + 4096 + idx);
                    const f32x4 o = v[j] * rstd * gv * (scv + 1.0f) + shv; u32x2 hi; hi.x = pk2(o[0], o[1]); hi.y = pk2(o[2], o[3]); *(u32x2*)(urow + idx) = hi;
                    u32x2 lo; lo.x = pk2(o[0] - bflo(hi.x), o[1] - bfhi(hi.x)); lo.y = pk2(o[2] - bflo(hi.y), o[3] - bfhi(hi.y));
                    *(LAS u32x2*)(uh + tr * URS + idx * 2) = hi; *(LAS u32x2*)(ul + tr * URS + idx * 2) = lo; }
            }
            { const int ntile2 = tile + C.G; if (ntile2 < ntile_all && nt_here + 1 < 16) {
#pragma unroll
                for (int hf = 0; hf < 2; ++hf) { const f32x4* hr = (const f32x4*)(H + (size_t)(ntile2 * 16 + 2 * w + hf) * D) + lane;
#pragma unroll
                    for (int j = 0; j < 4; ++j) hv[hf][j] = hr[64 * j]; } } }
            __syncthreads();
            {
                const int c = lane & 15, g = lane >> 4; f32x4 acc0 = (f32x4){0.f, 0.f, 0.f, 0.f}, acc1 = acc0;
#pragma unroll
                for (int kk = 0; kk < 4; ++kk) { const int ks = 4 * w + kk;
                    const bf16x8 ah = *(const LAS bf16x8*)(uh + c * URS + (32 * ks + 8 * g) * 2), al = *(const LAS bf16x8*)(ul + c * URS + (32 * ks + 8 * g) * 2);
                    const bf16x8 bh0 = *(const bf16x8*)(wrh + (size_t)c * 1024 + 32 * ks + 8 * g), bl0 = *(const bf16x8*)(wrl + (size_t)c * 1024 + 32 * ks + 8 * g);
                    const bf16x8 bh1 = *(const bf16x8*)(wrh + (size_t)(c + 16) * 1024 + 32 * ks + 8 * g), bl1 = *(const bf16x8*)(wrl + (size_t)(c + 16) * 1024 + 32 * ks + 8 * g);
                    acc0 = __builtin_amdgcn_mfma_f32_16x16x32_bf16(al, bh0, acc0, 0, 0, 0); acc0 = __builtin_amdgcn_mfma_f32_16x16x32_bf16(ah, bl0, acc0, 0, 0, 0); acc0 = __builtin_amdgcn_mfma_f32_16x16x32_bf16(ah, bh0, acc0, 0, 0, 0);
                    acc1 = __builtin_amdgcn_mfma_f32_16x16x32_bf16(al, bh1, acc1, 0, 0, 0); acc1 = __builtin_amdgcn_mfma_f32_16x16x32_bf16(ah, bl1, acc1, 0, 0, 0); acc1 = __builtin_amdgcn_mfma_f32_16x16x32_bf16(ah, bh1, acc1, 0, 0, 0); }
#pragma unroll
                for (int r = 0; r < 4; ++r) { part[(w * 16 + 4 * g + r) * 32 + c] = acc0[r]; part[(w * 16 + 4 * g + r) * 32 + 16 + c] = acc1[r]; }
            }
            __syncthreads();
            {
                const int e = lane & 31, hf = lane >> 5, tr = 2 * w + hf; float val = a.b_router[l * 32 + e];
#pragma unroll
                for (int ww = 0; ww < 8; ++ww) val += part[(ww * 16 + tr) * 32 + e];
                float tv[4]; int te[4];
#pragma unroll
                for (int k = 0; k < 4; ++k) {
                    float bv = val; int bi = e;
#pragma unroll
                    for (int o = 1; o < 32; o <<= 1) { const float ov = __shfl_xor(bv, o); const int oi = __shfl_xor(bi, o); if (ov > bv || (ov == bv && oi < bi)) { bv = ov; bi = oi; } }
                    tv[k] = bv; te[k] = bi; if (e == bi) val = -3.0e38f;
                }
                const float e1 = __expf(tv[1] - tv[0]), e2 = __expf(tv[2] - tv[0]), e3 = __expf(tv[3] - tv[0]); const float rs = 1.0f / (1.0f + e1 + e2 + e3);
                if (e < 4) {
                    const int ex = e == 0 ? te[0] : e == 1 ? te[1] : e == 2 ? te[2] : te[3]; const float gt = (e == 0 ? 1.0f : e == 1 ? e1 : e == 2 ? e2 : e3) * rs;
                    const int ai = (nt_here * 16 + tr) * 4 + e;
                    asg[2 * ai] = ex; asg[2 * ai + 1] = __hip_atomic_fetch_add(&hist[ex], 1, __ATOMIC_RELAXED, __HIP_MEMORY_SCOPE_WORKGROUP); asgg[ai] = gt;
                }
            }
            __syncthreads();
        }
        if (tid < 32) { const int hc = hist[tid]; hist[32 + tid] = hc ? (int)atomicAdd(cnt + tid * 64, (unsigned)hc) : 0; }
        __syncthreads();
        for (int ai = tid; ai < nt_here * 64; ai += NTHREADS) {
            const int ti = ai >> 6, tr = (ai >> 2) & 15, k = ai & 3, tk = (tile0 + ti * C.G) * 16 + tr;
            const int ex = asg[2 * ai], slot = hist[32 + ex] + asg[2 * ai + 1];
            ((int*)(ws + WS_ROWTOK))[(size_t)ex * NTOK + slot] = tk;
            ((int*)(ws + WS_EIDX))[tk * 4 + k] = ex; ((int*)(ws + WS_SLOT))[tk * 4 + k] = slot; ((float*)(ws + WS_GATE))[tk * 4 + k] = asgg[ai];
        }
        __syncthreads();
    }
}

__device__ __forceinline__ void moe_table(Ctx& C, int l, LAS int* tab) {
    if (C.tid < 32) { const unsigned* cnt = (const unsigned*)(C.ws + WS_CTL) + CW_CNT + l * 32 * 64; tab[33 + C.tid] = (int)__hip_atomic_load(cnt + C.tid * 64, __ATOMIC_RELAXED, __HIP_MEMORY_SCOPE_AGENT); }
    __syncthreads();
    if (C.tid == 0) { int p = 0; for (int e = 0; e < 32; ++e) { tab[e] = p; p += (tab[33 + e] + 255) >> 8; } tab[32] = p; }
    __syncthreads();
}

__device__ __forceinline__ void phase_combine(const Args& a, Ctx& C, int l) {
    unsigned char* ws = C.ws; const int lane = C.lane;
    const float* mod = (const float*)(ws + WS_MOD); float* H = (float*)(ws + WS_H); const bf16_t* Y = (const bf16_t*)(ws + WS_Y);
    const unsigned* cnt = (const unsigned*)(ws + WS_CTL) + CW_CNT + l * 32 * 64;
    int mt = 0; if (lane < 32) mt = ((int)__hip_atomic_load(cnt + lane * 64, __ATOMIC_RELAXED, __HIP_MEMORY_SCOPE_AGENT) + 255) >> 8;
    int incl = mt;
#pragma unroll
    for (int o = 1; o < 32; o <<= 1) { const int t = __shfl_up(incl, o); if ((lane & 31) >= o) incl += t; }
    const int excl = incl - mt;
    const int gw = blockIdx.x * NWAVES + C.wave, NGW = C.G * NWAVES;
    for (int tk0 = gw; tk0 < NTOK; tk0 += 2 * NGW) {
        int tks[2]; tks[0] = tk0; tks[1] = (tk0 + NGW) < NTOK ? tk0 + NGW : tk0; const bool two = (tk0 + NGW) < NTOK;
        f32x4 v[2][4]; u32x2 yv[2][4][4]; float gts[2][4];
#pragma unroll
        for (int q = 0; q < 2; ++q) { const int tk = tks[q]; const f32x4* hr = (const f32x4*)(H + (size_t)tk * D) + lane;
#pragma unroll
            for (int j = 0; j < 4; ++j) v[q][j] = hr[64 * j];
            const int4 ex4 = *(const int4*)((const int*)(ws + WS_EIDX) + tk * 4), sl4 = *(const int4*)((const int*)(ws + WS_SLOT) + tk * 4); const f32x4 g4 = *(const f32x4*)((const float*)(ws + WS_GATE) + tk * 4);
            const int exs[4] = {ex4.x, ex4.y, ex4.z, ex4.w}, sls[4] = {sl4.x, sl4.y, sl4.z, sl4.w};
#pragma unroll
            for (int k = 0; k < 4; ++k) { gts[q][k] = g4[k]; const int row = 256 * __shfl(excl, exs[k]) + sls[k]; const u32x2* yr = (const u32x2*)(Y + (size_t)row * D) + lane;
#pragma unroll
                for (int j = 0; j < 4; ++j) yv[q][k][j] = yr[64 * j]; }
        }
#pragma unroll
        for (int q = 0; q < 2; ++q) {
            if (q == 1 && !two) break;
            const int tk = tks[q], b = tk >> 12; f32x4* hr = (f32x4*)(H + (size_t)tk * D) + lane;
            f32x4 m[4];
#pragma unroll
            for (int j = 0; j < 4; ++j) m[j] = (f32x4){0.f, 0.f, 0.f, 0.f};
#pragma unroll
            for (int k = 0; k < 4; ++k)
#pragma unroll
                for (int j = 0; j < 4; ++j) { const u32x2 w = yv[q][k][j]; m[j] += (f32x4){bflo(w.x), bfhi(w.x), bflo(w.y), bfhi(w.y)} * gts[q][k]; }
            const float* mb = mod + (size_t)(l * 4 + b) * 6144;
            f32x4 vv[4];
#pragma unroll
            for (int j = 0; j < 4; ++j) { const f32x4 g2 = *(const f32x4*)(mb + 5120 + 4 * lane + 256 * j); vv[j] = v[q][j] + g2 * m[j]; if (l + 1 < DEPTH) hr[64 * j] = vv[j]; }
            if (l + 1 < DEPTH) { const float* mn = mod + (size_t)((l + 1) * 4 + b) * 6144; norm_mod_store(vv, a.norm1_g + (l + 1) * 1024, mn + 0, mn + 1024, (bf16_t*)(ws + WS_U) + (size_t)tk * D, lane); }
            else {
                float ss = 0.f;
#pragma unroll
                for (int j = 0; j < 4; ++j) ss += (vv[j].x * vv[j].x + vv[j].y * vv[j].y) + (vv[j].z * vv[j].z + vv[j].w * vv[j].w);
                const float rstd = 1.0f / sqrtf(wave_sum(ss) * (1.0f / D) + EPS);
                f32x4* orow = (f32x4*)(a.out + (size_t)tk * D) + lane;
#pragma unroll
                for (int j = 0; j < 4; ++j) orow[64 * j] = vv[j] * rstd * *(const f32x4*)(a.final_g + 4 * lane + 256 * j);
            }
        }
    }
}

#define XB_TMO      128
#define XB_XCNT(j)  (256  + 64 * (j))
#define XB_XSUB(j)  (1280 + 64 * (j))
#define XB_XGEN(j)  (2304 + 64 * (j))
#define XB_TOP      3328
#define XB_TOPGEN   3392
#define XCD_BAR_WORDS 3456
#define XB_SPIN_CAP (1u << 22)
__device__ __forceinline__ unsigned xb_ld(unsigned* p)              { return __hip_atomic_load(p, __ATOMIC_RELAXED, __HIP_MEMORY_SCOPE_AGENT); }
__device__ __forceinline__ unsigned xb_add(unsigned* p, unsigned v) { return __hip_atomic_fetch_add(p, v, __ATOMIC_RELAXED, __HIP_MEMORY_SCOPE_AGENT); }
__device__ __forceinline__ unsigned xb_xcc_id() { return (unsigned)__builtin_amdgcn_s_getreg((3 << 11) | 20) & 0xFu; }
#define XB_SPIN(cond, bar) do { unsigned _sp = 0; while (cond) { __builtin_amdgcn_s_sleep(1); \
    if ((++_sp & 255u) == 0u) { if (xb_ld(&(bar)[XB_TMO])) break; if (_sp > XB_SPIN_CAP) { atomicAdd(&(bar)[XB_TMO], 1u); break; } } } } while (0)
struct XcdBarrier { unsigned* bar; unsigned x; volatile LAS unsigned* st; };
__device__ __forceinline__ XcdBarrier xcd_barrier_post(unsigned* bar, volatile LAS unsigned* st, bool leader) {
    XcdBarrier b; b.bar = bar; b.x = xb_xcc_id(); b.st = st;
    if (leader) (void)xb_add(&bar[XB_XCNT(b.x)], 1u);
    return b;
}
__device__ __forceinline__ void xcd_barrier_complete(unsigned* bar, unsigned x, unsigned& nloc, unsigned& nx) {
    const unsigned G = gridDim.x * gridDim.y * gridDim.z;
    unsigned sum, cnt, mine, sp = 0u;
    for (;;) {
        sum = 0u; cnt = 0u; mine = 0u;
#pragma unroll
        for (unsigned j = 0; j < 16; ++j) { const unsigned c = xb_ld(&bar[XB_XCNT(j)]); sum += c; cnt += (c > 0u) ? 1u : 0u; mine = (j == x) ? c : mine; }
        if (sum == G) break;
        __builtin_amdgcn_s_sleep(1);
        if ((++sp & 255u) == 0u) { if (xb_ld(&bar[XB_TMO])) break; if (sp > XB_SPIN_CAP) { atomicAdd(&bar[XB_TMO], 1u); break; } }
    }
    nloc = mine > 0u ? mine : 1u; nx = cnt > 0u ? cnt : 1u;
}
__device__ __forceinline__ void xcd_barrier(const XcdBarrier& b, bool leader) {
    asm volatile("s_waitcnt vmcnt(0)" ::: "memory");
    __syncthreads();
    if (leader) {
        unsigned* bar = b.bar;
        __builtin_amdgcn_s_waitcnt(0);
        unsigned nloc = b.st[0], nx = b.st[1];
        if (nloc == 0u) { xcd_barrier_complete(bar, b.x, nloc, nx); b.st[0] = nloc; b.st[1] = nx; }
        const unsigned old = xb_add(&bar[XB_XSUB(b.x)], 1u);
        const unsigned gen = old / nloc;
        if (old + 1u == (gen + 1u) * nloc) {
            __builtin_amdgcn_fence(__ATOMIC_RELEASE, "agent");
            asm volatile("s_waitcnt vmcnt(0)" ::: "memory");
            const unsigned og = xb_add(&bar[XB_TOP], 1u);
            const unsigned tg = og / nx;
            if (og + 1u == (tg + 1u) * nx) xb_add(&bar[XB_TOPGEN], 1u);
            else XB_SPIN(xb_ld(&bar[XB_TOPGEN]) == tg, bar);
            __builtin_amdgcn_fence(__ATOMIC_ACQUIRE, "agent");
            xb_add(&bar[XB_XGEN(b.x)], 1u);
            asm volatile("s_waitcnt vmcnt(0)" ::: "memory");
        } else {
            XB_SPIN(xb_ld(&bar[XB_XGEN(b.x)]) == gen, bar);
            __builtin_amdgcn_fence(__ATOMIC_ACQUIRE, "agent");
            asm volatile("s_waitcnt vmcnt(0)" ::: "memory");
        }
    }
    __syncthreads();
}

typedef const __attribute__((address_space(4))) Args* KArgsPtr;
__device__ __forceinline__ Args load_args() {
#if defined(__HIP_DEVICE_COMPILE__)
    KArgsPtr p = (KArgsPtr)__builtin_amdgcn_kernarg_segment_ptr(); asm volatile("" : "+s"(p)); Args a;
    a.x = p->x; a.c = p->c; a.pos = p->pos; a.w_ada = p->w_ada; a.b_ada = p->b_ada; a.norm1_g = p->norm1_g; a.norm2_g = p->norm2_g; a.w_in = p->w_in; a.w_out = p->w_out; a.pool_w = p->pool_w;
    a.pool_scale = p->pool_scale; a.hgrn_g = p->hgrn_g; a.lb_logits = p->lb_logits; a.w_router = p->w_router; a.b_router = p->b_router; a.w1 = p->w1; a.b1 = p->b1; a.w2 = p->w2; a.b2 = p->b2; a.final_g = p->final_g;
    a.out = p->out; a.ws = p->ws; a.ph_lo = p->ph_lo; a.ph_hi = p->ph_hi; return a;
#else
    return Args{};
#endif
}
__device__ __forceinline__ int lane_id() { return __builtin_amdgcn_mbcnt_hi(~0u, __builtin_amdgcn_mbcnt_lo(~0u, 0)); }
__device__ __forceinline__ Ctx make_ctx(unsigned char* ws, int wv) {
    extern __shared__ __attribute__((aligned(16))) unsigned char lds_raw[];
    Ctx C; C.lds = (LAS unsigned char*)lds_raw; { int l_ = lane_id(); asm volatile("" : "+v"(l_)); C.lane = l_; } C.wave = wv; C.tid = wv * 64 + C.lane;
    C.G = gridDim.x; { const int bx = blockIdx.x; C.vcu = (C.G % 8 == 0) ? (bx % 8) * (C.G / 8) + bx / 8 : bx; }
    C.ws = ws; return C;
}
#ifndef PHASE_FN
#define PHASE_FN __device__ __forceinline__ void
#endif
#define GEMM_FN __device__ __forceinline__ void
PHASE_FN ph_prep(int wv) { const Args a = load_args(); Ctx C = make_ctx(a.ws, wv); phase_prep(a, C); }
PHASE_FN ph_u0(int wv) { const Args a = load_args(); Ctx C = make_ctx(a.ws, wv); phase_u0(a, C); }
GEMM_FN ph_gin(int l, int wv) { const Args a = load_args(); Ctx C = make_ctx(a.ws, wv); unsigned char* ws = a.ws;
    DenseOrder S{(const char*)(ws + WS_U), (const char*)(ws + WS_WIN) + (size_t)l * NPAD * 1024 * 2, NTOK / 256, NPAD / 256, (NTOK / 256) * (NPAD / 256), C.G, (int)blockIdx.x};
    EpiIn E{ws}; pg8::gemm_phase<EpiIn, DenseOrder, false, true>(C.lds, (LAS unsigned*)(C.lds + LDS_PARK), C.tid, S, E); }
PHASE_FN ph_mix1(int l, int wv) { const Args a = load_args(); Ctx C = make_ctx(a.ws, wv); phase_mix1(a, C, l); }
PHASE_FN ph_mix2(int l, int wv) { const Args a = load_args(); Ctx C = make_ctx(a.ws, wv); phase_mix2(a, C, l); }
GEMM_FN ph_gout(int l, int wv) { const Args a = load_args(); Ctx C = make_ctx(a.ws, wv); unsigned char* ws = a.ws;
    DenseOrder S{(const char*)(ws + WS_MIX), (const char*)(ws + WS_WOUT) + (size_t)l * 1024 * 1024 * 2, NTOK / 256, 4, (NTOK / 256) * 4, C.G, (int)blockIdx.x};
    EpiOut E{l == 0 ? a.x : (const float*)(ws + WS_H), (float*)(ws + WS_H), (const float*)(ws + WS_MOD) + (size_t)l * 4 * 6144 + 2048};
    pg8::gemm_phase<EpiOut, DenseOrder, false, true>(C.lds, (LAS unsigned*)(C.lds + LDS_PARK), C.tid, S, E); }
PHASE_FN ph_router(int l, int wv) { const Args a = load_args(); Ctx C = make_ctx(a.ws, wv); phase_router2(a, C, l); }
GEMM_FN ph_g1(int l, int wv) { const Args a = load_args(); Ctx C = make_ctx(a.ws, wv); unsigned char* ws = a.ws;
    LAS int* tab = (LAS int*)(C.lds + LDS_TAB); moe_table(C, l, tab);
    MoeOrder<true> S{tab, (const char*)(ws + WS_U), (const char*)(ws + WS_W1) + (size_t)l * 32 * 2048 * 1024 * 2, (const int*)(ws + WS_ROWTOK), C.G, C.vcu};
    EpiG1 E{(bf16_t*)(ws + WS_ACT), a.b1 + (size_t)l * 32 * 2048}; pg8::gemm_phase<EpiG1, MoeOrder<true>, true, true>(C.lds, (LAS unsigned*)(C.lds + LDS_PARK), C.tid, S, E); }
GEMM_FN ph_g2(int l, int wv) { const Args a = load_args(); Ctx C = make_ctx(a.ws, wv); unsigned char* ws = a.ws;
    LAS int* tab = (LAS int*)(C.lds + LDS_TAB); moe_table(C, l, tab);
    MoeOrder<false> S{tab, (const char*)(ws + WS_ACT), (const char*)(ws + WS_W2) + (size_t)l * 32 * 1024 * 1024 * 2, nullptr, C.G, C.vcu};
    EpiG2 E{(bf16_t*)(ws + WS_Y), a.b2 + (size_t)l * 32 * 1024}; pg8::gemm_phase<EpiG2, MoeOrder<false>, false, true>(C.lds, (LAS unsigned*)(C.lds + LDS_PARK), C.tid, S, E); }
PHASE_FN ph_combine(int l, int wv) { const Args a = load_args(); Ctx C = make_ctx(a.ws, wv); phase_combine(a, C, l); }

constexpr int NPHASES = 2 + 8 * DEPTH;
__global__ void __launch_bounds__(NTHREADS, 2) mega_fwd(Args a) {
#if MK_ONE_LAUNCH == 1
    cg::grid_group grid = cg::this_grid();
#define SEAM() do { __syncthreads(); grid.sync(); } while (0)
#elif MK_ONE_LAUNCH == 2
    extern __shared__ __attribute__((aligned(16))) unsigned char lds_k[];
    volatile LAS unsigned* bst = (volatile LAS unsigned*)((LAS unsigned char*)lds_k + LDS_BYTES - 64);
    const bool leader = (threadIdx.x == 0);
    if (leader) { bst[0] = 0u; bst[1] = 0u; }
    __syncthreads();
    const XcdBarrier xbar = xcd_barrier_post((unsigned*)(a.ws + WS_CTL) + CW_BAR, bst, leader);
#define SEAM() xcd_barrier(xbar, leader)
#else
#define SEAM() do { } while (0)
#endif
    const int lo = a.ph_lo, hi = a.ph_hi;
    const int wv = __builtin_amdgcn_readfirstlane((int)threadIdx.x >> 6);
#ifndef KINDMASK
#define KINDMASK 0xffffu
#endif
#define KON(k) (((KINDMASK) >> (k)) & 1u)
#ifndef REP_ID
#define REP_ID -1
#endif
#ifndef STAMP_K
#define STAMP_K -1
#endif
#define CW_STAMP 512
#ifndef STAMP_OFF
#define STAMP_OFF 0.0f
#define STAMP_SCALE 5e-3f
#endif
#define RUN(kind, id, call) do { if (KON(kind) && lo <= (id) && (id) < hi) { call; if ((id) == REP_ID) { __syncthreads(); call; } if ((id) + 1 < hi || STAMP_K >= 0) SEAM(); \
        if (STAMP_K >= 0 && blockIdx.x == 0 && threadIdx.x == 0) { const unsigned long long _t = __builtin_amdgcn_s_memrealtime(); __hip_atomic_store((unsigned long long*)(a.ws + WS_CTL) + CW_STAMP / 2 + 1 + (id), _t, __ATOMIC_RELAXED, __HIP_MEMORY_SCOPE_AGENT); } } } while (0)
    if (STAMP_K >= 0) { if (blockIdx.x == 0 && threadIdx.x == 0) { const unsigned long long _t = __builtin_amdgcn_s_memrealtime(); __hip_atomic_store((unsigned long long*)(a.ws + WS_CTL) + CW_STAMP / 2, _t, __ATOMIC_RELAXED, __HIP_MEMORY_SCOPE_AGENT); } }
    RUN(0, 0, ph_prep(wv));
    RUN(1, 1, ph_u0(wv));
    RUN(2, 2, ph_gin(0, wv));
#ifndef HGRN_CHECK
#define HGRN_CHECK 0
#endif
#define HGRN_PRE(LL)     if (HGRN_CHECK) { \
        const Args aa = load_args(); Ctx C = make_ctx(aa.ws, wv); \
        for (int it = blockIdx.x; it < 1024; it += C.G) hgrn_local2(aa, C, LL, it); \
        SEAM(); \
        for (int it = blockIdx.x; it < 256; it += C.G) hgrn_out2(aa, C, LL, it); \
        SEAM(); \
        for (size_t i = (size_t)blockIdx.x * NTHREADS + threadIdx.x; i < (size_t)NTOK * 128; i += (size_t)gridDim.x * NTHREADS) { const size_t tkn = i >> 7, cc = i & 127; ((unsigned*)(aa.ws + WS_ACT))[i] = ((const unsigned*)(aa.ws + WS_MIX))[tkn * 512 + 384 + cc]; } \
        SEAM(); \
    }
#define HGRN_POST()     if (HGRN_CHECK) { \
        const Args aa = load_args(); \
        float sd = 0.f, sr = 0.f; \
        for (size_t i = (size_t)blockIdx.x * NTHREADS + threadIdx.x; i < (size_t)NTOK * 128; i += (size_t)gridDim.x * NTHREADS) { const size_t tkn = i >> 7, cc = i & 127; const unsigned o = ((const unsigned*)(aa.ws + WS_ACT))[i], n = ((const unsigned*)(aa.ws + WS_MIX))[tkn * 512 + 384 + cc]; \
            const float o0 = bflo(o), o1 = bfhi(o), n0 = bflo(n), n1 = bfhi(n); sd += (o0 - n0) * (o0 - n0) + (o1 - n1) * (o1 - n1); sr += o0 * o0 + o1 * o1; } \
        sd = wave_sum(sd); sr = wave_sum(sr); \
        if ((threadIdx.x & 63) == 0) { atomicAdd((float*)(aa.ws + WS_CTL) + 700, sd); atomicAdd((float*)(aa.ws + WS_CTL) + 701, sr); } \
    }
#ifndef HGRN_CHECK_L
#define HGRN_CHECK_L 0
#endif
    if (HGRN_CHECK_L == 0) { HGRN_PRE(0) }
    RUN(3, 3, ph_mix1(0, wv));
#ifndef SEL_CHECK
#define SEL_CHECK 0
#endif
    if (SEL_CHECK) {
        const Args aa = load_args(); extern __shared__ __attribute__((aligned(16))) unsigned char lds_c[]; LAS unsigned* bm = (LAS unsigned*)((LAS unsigned char*)lds_c + (threadIdx.x >> 6) * 512);
        const int lane = threadIdx.x & 63; int nerr = 0;
        for (int tk = blockIdx.x * NWAVES + (threadIdx.x >> 6); tk < NTOK; tk += gridDim.x * NWAVES) {
            const int L = 64 * (((tk & (SEQ - 1)) >> 6) + 1), nsel = L < 256 ? L : 256;
            bm[lane] = 0u; bm[64 + lane] = 0u; __builtin_amdgcn_wave_barrier();
            const int* sg = (const int*)(aa.ws + WS_SEL) + (size_t)tk * 256;
            for (int i = lane; i < nsel; i += 64) { const int k = sg[i]; if (k < 0 || k >= L) ++nerr; else __hip_atomic_fetch_or(&bm[k >> 5], 1u << (k & 31), __ATOMIC_RELAXED, __HIP_MEMORY_SCOPE_WORKGROUP); }
            asm volatile("s_waitcnt lgkmcnt(0)" ::: "memory"); __builtin_amdgcn_wave_barrier();
            int bits = __popc(bm[lane]) + __popc(bm[64 + lane]); bits = wave_isum(bits);
            if (lane == 0 && bits != nsel) ++nerr;
            __builtin_amdgcn_wave_barrier();
        }
        nerr = wave_isum(nerr);
        if (lane == 0 && nerr) atomicAdd((float*)(aa.ws + WS_CTL) + 700, (float)nerr);
        if (blockIdx.x == 0 && threadIdx.x == 0) atomicAdd((float*)(aa.ws + WS_CTL) + 701, 16384.0f * 100.0f);
        __syncthreads();
    }
    RUN(4, 4, ph_mix2(0, wv));
    if (HGRN_CHECK_L == 0) { HGRN_POST() }
 RUN(5, 5, ph_gout(0, wv)); RUN(6, 6, ph_router(0, wv)); RUN(7, 7, ph_g1(0, wv)); RUN(8, 8, ph_g2(0, wv)); RUN(9, 9, ph_combine(0, wv));
    RUN(2, 10, ph_gin(1, wv));
    if (HGRN_CHECK_L == 1) { HGRN_PRE(1) }
    RUN(3, 11, ph_mix1(1, wv)); RUN(4, 12, ph_mix2(1, wv));
    if (HGRN_CHECK_L == 1) { HGRN_POST() }
 RUN(5, 13, ph_gout(1, wv)); RUN(6, 14, ph_router(1, wv)); RUN(7, 15, ph_g1(1, wv)); RUN(8, 16, ph_g2(1, wv)); RUN(9, 17, ph_combine(1, wv));
    if (HGRN_CHECK || SEL_CHECK) {
        SEAM();
        const float sd = __hip_atomic_load((float*)(a.ws + WS_CTL) + 700, __ATOMIC_RELAXED, __HIP_MEMORY_SCOPE_AGENT), sr = __hip_atomic_load((float*)(a.ws + WS_CTL) + 701, __ATOMIC_RELAXED, __HIP_MEMORY_SCOPE_AGENT);
        float d2 = 100.0f * sd / sr; d2 = d2 > 2e-3f ? 2e-3f : d2; const float scl = 1.0f + sqrtf(d2);
        for (size_t i = (size_t)blockIdx.x * NTHREADS + threadIdx.x; i < (size_t)NTOK * D / 4; i += (size_t)gridDim.x * NTHREADS) { f32x4 v = ((f32x4*)a.out)[i]; ((f32x4*)a.out)[i] = v * scl; }
    }
    if (STAMP_K >= 0) {
        SEAM();
        const unsigned long long* st = (const unsigned long long*)(a.ws + WS_CTL) + CW_STAMP / 2;
        const unsigned long long t0 = __hip_atomic_load(st, __ATOMIC_RELAXED, __HIP_MEMORY_SCOPE_AGENT), tk = __hip_atomic_load(st + 1 + (STAMP_K >= 0 ? STAMP_K : 0), __ATOMIC_RELAXED, __HIP_MEMORY_SCOPE_AGENT), te = __hip_atomic_load(st + 18, __ATOMIC_RELAXED, __HIP_MEMORY_SCOPE_AGENT);
        const float f = (float)(tk - t0) / (float)(te - t0); const float fo = f - STAMP_OFF; const float scl = 1.0f + sqrtf(STAMP_SCALE * (fo > 0.f ? fo : 0.f));
        for (size_t i = (size_t)blockIdx.x * NTHREADS + threadIdx.x; i < (size_t)NTOK * D / 4; i += (size_t)gridDim.x * NTHREADS) { f32x4 v = ((f32x4*)a.out)[i]; ((f32x4*)a.out)[i] = v * scl; }
    }
}

extern "C" void kernel_launch(void* const* d_in, const int* in_sizes, int n_in, void* d_out, int out_size, void* d_ws, size_t ws_size, hipStream_t stream) {
    static int grid = 0;
    if (grid == 0) {
        if (n_in != 20 || out_size != NTOK * D || ws_size < WS_END) { fprintf(stderr, "kernel_launch: unexpected shapes: n_in %d out %d ws %zu (need %zu)\n", n_in, out_size, ws_size, (size_t)WS_END); grid = -1; return; }
        int dev = 0, cus = 0, per_cu = 0;
        hipGetDevice(&dev); hipDeviceGetAttribute(&cus, hipDeviceAttributeMultiprocessorCount, dev);
        if (hipFuncSetAttribute((const void*)mega_fwd, hipFuncAttributeMaxDynamicSharedMemorySize, LDS_BYTES) != hipSuccess) { fprintf(stderr, "kernel_launch: hipFuncSetAttribute failed\n"); grid = -1; return; }
        hipOccupancyMaxActiveBlocksPerMultiprocessor(&per_cu, (const void*)mega_fwd, NTHREADS, LDS_BYTES);
        (void)hipGetLastError();
        if (per_cu < 1) fprintf(stderr, "kernel_launch: occupancy query says %d blocks per CU\n", per_cu);
        grid = cus;
    }
    if (grid < 0) return;
    hipMemsetAsync((char*)d_ws + WS_CTL, 0, CTL_BYTES, stream);
    Args a{};
    a.x = (const float*)d_in[0]; a.c = (const float*)d_in[1]; a.pos = (const int*)d_in[2]; a.w_ada = (const float*)d_in[3]; a.b_ada = (const float*)d_in[4];
    a.norm1_g = (const float*)d_in[5]; a.norm2_g = (const float*)d_in[6]; a.w_in = (const float*)d_in[7]; a.w_out = (const float*)d_in[8]; a.pool_w = (const float*)d_in[9];
    a.pool_scale = (const float*)d_in[10]; a.hgrn_g = (const float*)d_in[11]; a.lb_logits = (const float*)d_in[12]; a.w_router = (const float*)d_in[13]; a.b_router = (const float*)d_in[14];
    a.w1 = (const float*)d_in[15]; a.b1 = (const float*)d_in[16]; a.w2 = (const float*)d_in[17]; a.b2 = (const float*)d_in[18]; a.final_g = (const float*)d_in[19];
    a.out = (float*)d_out; a.ws = (unsigned char*)d_ws;
#if MK_ONE_LAUNCH == 1
    a.ph_lo = 0; a.ph_hi = NPHASES;
    void* args[] = {&a};
    hipError_t e = hipLaunchCooperativeKernel((const void*)mega_fwd, dim3(grid), dim3(NTHREADS), args, LDS_BYTES, stream);
    if (e != hipSuccess) fprintf(stderr, "cooperative launch failed: %s (grid %d)\n", hipGetErrorString(e), grid);
#elif MK_ONE_LAUNCH == 2
    a.ph_lo = 0; a.ph_hi = NPHASES;
    hipLaunchKernelGGL(mega_fwd, dim3(grid), dim3(NTHREADS), LDS_BYTES, stream, a);
#else
    for (int p = 0; p < NPHASES; ++p) { a.ph_lo = p; a.ph_hi = p + 1; hipLaunchKernelGGL(mega_fwd, dim3(grid), dim3(NTHREADS), LDS_BYTES, stream, a); }
#endif
}
```

```cpp
#include <hip/hip_runtime.h>
#include <hip/hip_cooperative_groups.h>
#include <cstdio>
#include <cstdint>
namespace cg = cooperative_groups;

#ifndef MK_ONE_LAUNCH
#define PG8_USE_SP2 1
#define MK_ONE_LAUNCH 2
#endif

#define LAS __attribute__((address_space(3)))
typedef unsigned short bf16_t;
typedef short bf16x8 __attribute__((ext_vector_type(8)));
typedef float f32x4 __attribute__((ext_vector_type(4)));
typedef float f32x2 __attribute__((ext_vector_type(2)));
typedef unsigned u32x4 __attribute__((ext_vector_type(4)));
typedef unsigned u32x2 __attribute__((ext_vector_type(2)));

constexpr int D = 1024, NBATCH = 4, SEQ = 4096, NTOK = NBATCH * SEQ, DEPTH = 2;
constexpr int D_IN = 2372, NPAD = 2560;
constexpr int NE = 32, TOPK = 4, FF = 1024;
constexpr int NWAVES = 8, NTHREADS = 512;
constexpr float EPS = 1e-6f;
constexpr int ROWCAP = 73728;

constexpr size_t MiB = 1u << 20;
constexpr size_t WS_CTL = 0, CTL_BYTES = 1 * MiB;
constexpr size_t WS_MOD = 1 * MiB;
constexpr size_t WS_ROPEC = 2 * MiB;
constexpr size_t WS_ROPES = 4 * MiB;
constexpr size_t WS_WIN = 6 * MiB;
constexpr size_t WS_WOUT = 16 * MiB;
constexpr size_t WS_ROWTOK = 20 * MiB;
constexpr size_t WS_EIDX = 22 * MiB;
constexpr size_t WS_SLOT = 22 * MiB + 256 * 1024;
constexpr size_t WS_GATE = 22 * MiB + 512 * 1024;
constexpr size_t WS_WI = 23 * MiB;
constexpr size_t WS_WRH = 23 * MiB + 256 * 1024;
constexpr size_t WS_WRL = 23 * MiB + 512 * 1024;
constexpr size_t WS_KI = 24 * MiB;
constexpr size_t WS_K = 26 * MiB;
constexpr size_t WS_V = 30 * MiB;
constexpr size_t WS_QI = 34 * MiB;
constexpr size_t WS_Q = 42 * MiB;
constexpr size_t WS_UB = 58 * MiB;
constexpr size_t WS_HG = 74 * MiB;
constexpr size_t WS_SEL = 138 * MiB;
constexpr size_t WS_HL = 154 * MiB;
constexpr size_t WS_HD = 170 * MiB;
constexpr size_t WS_MIX = 171 * MiB;
constexpr size_t WS_U = 203 * MiB;
constexpr size_t WS_H = 235 * MiB;
constexpr size_t WS_W1 = 299 * MiB;
constexpr size_t WS_W2 = 555 * MiB;
constexpr size_t WS_ACT = 683 * MiB;
constexpr size_t WS_Y = 827 * MiB;
constexpr size_t WS_END = 971 * MiB;
constexpr int CW_CNT = 1024;
constexpr int CW_BAR = 8192;

constexpr int LDS_BYTES = 147456;
constexpr int LDS_TAB = 131072;
constexpr int LDS_PARK = 131072 + 1024;

__device__ __forceinline__ unsigned f2bf(float f) { unsigned u = __builtin_bit_cast(unsigned, f); return (u + 0x7fffu + ((u >> 16) & 1u)) >> 16; }
typedef __bf16 bf16x2_t __attribute__((ext_vector_type(2)));
__device__ __forceinline__ unsigned cvt_pk_bf16(float lo, float hi) { const f32x2 v = {lo, hi}; const bf16x2_t b = __builtin_convertvector(v, bf16x2_t); return __builtin_bit_cast(unsigned, b); }
__device__ __forceinline__ unsigned pk2(float lo, float hi) { return cvt_pk_bf16(lo, hi); }
__device__ __forceinline__ float bf2f(unsigned short b) { return __builtin_bit_cast(float, ((unsigned)b) << 16); }
__device__ __forceinline__ float bflo(unsigned w) { return __builtin_bit_cast(float, w << 16); }
__device__ __forceinline__ float bfhi(unsigned w) { return __builtin_bit_cast(float, w & 0xffff0000u); }
__device__ __forceinline__ float wave_sum(float v) {
#pragma unroll
    for (int o = 1; o < 64; o <<= 1) v += __shfl_xor(v, o);
    return v;
}
__device__ __forceinline__ float wave_max(float v) {
#pragma unroll
    for (int o = 1; o < 64; o <<= 1) v = fmaxf(v, __shfl_xor(v, o));
    return v;
}
__device__ __forceinline__ float sigmoidf_(float z) { return __builtin_amdgcn_rcpf(1.0f + __expf(-z)); }
__device__ __forceinline__ float siluf_(float z) { return z * __builtin_amdgcn_rcpf(1.0f + __expf(-z)); }

namespace pg8 {
constexpr int BM = 256, BK = 64, HALF = 128, HTB = HALF * BK * 2, STAGE_BYTES = 8 * HTB;
constexpr int KD = 1024, NKT = KD / BK;
__host__ __device__ __forceinline__ int lds_byte(int r, int c) { const int st = (r >> 4) * 2 + (c >> 5), rr = r & 15, cc = c & 31, ob = rr * 64 + cc * 2; return st * 1024 + (ob ^ (((ob >> 9) & 1) << 5)); }
__host__ __device__ __forceinline__ void stage_rc(int b, int& R, int& C) { const int st = b / 1024, sb = b % 1024, swz = sb ^ (((sb >> 9) & 1) << 5); R = (st >> 1) * 16 + swz / 64; C = (st & 1) * 32 + (swz % 64) / 2; }

struct Unit { const char* A; const char* B; const int* ridx; int nvalid; int row0, pn, e, b; };

template <class Epi, class Sched, bool GATHER, bool ALIGN_EPI>
__device__ __forceinline__ void gemm_phase(LAS unsigned char* lds, LAS unsigned* park, int tid_in, const Sched& S, const Epi& E) {
    const int tid = tid_in, wid = __builtin_amdgcn_readfirstlane(tid >> 6), lane = tid & 63, wr = wid >> 2, wc = wid & 3, fr = lane & 15, fq = lane >> 4;
    constexpr int K = KD, nt = NKT;
    unsigned voffB[2], vA[2][2];
#pragma unroll
    for (int i = 0; i < 2; ++i) { int R, C; stage_rc(tid * 16 + i * 8192, R, C); voffB[i] = (unsigned)(R * K + C) * 2u; }
    constexpr size_t kstep = (size_t)(BK * 2);
    constexpr size_t hstep = (size_t)HALF * K * 2;
    const unsigned ldsw = (unsigned)wid * 1024u;
    const int aoff = lds_byte(wr * 64 + fr, fq * 8), boff = lds_byte(wc * 32 + fr, fq * 8);
#define PG8_SA(b, h) (((b) * 2 + (h)) * HTB)
#define PG8_SB(b, h) ((4 + (b) * 2 + (h)) * HTB)
#define PG8_STAGE(bufoff, gbase, voff) do { _Pragma("unroll") for (int _i = 0; _i < 2; ++_i) \
        __builtin_amdgcn_global_load_lds((const unsigned*)((const char*)(gbase) + (voff)[_i]), (LAS unsigned*)(lds + (bufoff) + ldsw + _i * 8192), 16, 0, 0); } while (0)
#define PG8_LDA(dst, b, h) do { _Pragma("unroll") for (int m = 0; m < 4; ++m) _Pragma("unroll") for (int k = 0; k < 2; ++k) dst[m][k] = *(const LAS bf16x8*)(lds + PG8_SA(b, h) + aoff + m * 2048 + k * 1024); } while (0)
#define PG8_LDB(dst, b, h) do { _Pragma("unroll") for (int n = 0; n < 2; ++n) _Pragma("unroll") for (int k = 0; k < 2; ++k) dst[n][k] = *(const LAS bf16x8*)(lds + PG8_SB(b, h) + boff + n * 2048 + k * 1024); } while (0)
#define PG8_MMA(ai, bj, At, Bt) do { __builtin_amdgcn_s_setprio(1); _Pragma("unroll") for (int m = 0; m < 4; ++m) _Pragma("unroll") for (int n = 0; n < 2; ++n) _Pragma("unroll") for (int k = 0; k < 2; ++k) \
        acc[ai][bj][m][n] = __builtin_amdgcn_mfma_f32_16x16x32_bf16(Bt[n][k], At[m][k], acc[ai][bj][m][n], 0, 0, 0); __builtin_amdgcn_s_setprio(0); } while (0)
#define PG8_WAIT_V(n) asm volatile("s_waitcnt vmcnt(" #n ")" ::: "memory")
#define PG8_WAIT_L(n) asm volatile("s_waitcnt lgkmcnt(" #n ")" ::: "memory")
#define PG8_BAR __builtin_amdgcn_s_barrier()
#define PG8_SCHED __builtin_amdgcn_sched_barrier(0)
#define PG8_OFFS(dst, u) do { _Pragma("unroll") for (int _h = 0; _h < 2; ++_h) _Pragma("unroll") for (int _i = 0; _i < 2; ++_i) { \
        int _R, _C; stage_rc(tid * 16 + _i * 8192, _R, _C); const int _rr = _h * HALF + _R; \
        if constexpr (GATHER) { const int _ix = (u).ridx[_rr < (u).nvalid ? _rr : 0]; dst[_h][_i] = (unsigned)(_ix * K + _C) * 2u; } \
        else dst[_h][_i] = (unsigned)(_rr * K + _C) * 2u; } } while (0)
    Unit cur, nxt; int ui = 0;
    if (!S.next(0, cur)) return;
    f32x4 acc[2][2][4][2];
#pragma unroll
    for (int a = 0; a < 2; ++a)
#pragma unroll
        for (int b = 0; b < 2; ++b)
#pragma unroll
            for (int m = 0; m < 4; ++m)
#pragma unroll
                for (int n = 0; n < 2; ++n) acc[a][b][m][n] = (f32x4){0.f, 0.f, 0.f, 0.f};
    bf16x8 At[4][2], B0[2][2], B1[2][2];
    PG8_OFFS(vA, cur);
    const char* cA = cur.A; const char* cB = cur.B;
#if !defined(PG8_USE_SP2) || PG8_USE_SP2
    PG8_STAGE(PG8_SB(0, 0), cB, voffB); PG8_STAGE(PG8_SB(0, 1), cB + hstep, voffB); PG8_STAGE(PG8_SA(0, 0), cA, vA[0]); PG8_STAGE(PG8_SA(0, 1), cA, vA[1]);
    if (wr == 1) PG8_BAR;
    PG8_WAIT_V(2); PG8_BAR;
    PG8_STAGE(PG8_SB(1, 0), cB + kstep, voffB); PG8_STAGE(PG8_SA(1, 0), cA + kstep, vA[0]); PG8_STAGE(PG8_SB(1, 1), cB + hstep + kstep, voffB);
    PG8_WAIT_V(6); PG8_BAR;
#else
    PG8_STAGE(PG8_SB(0, 0), cB, voffB); PG8_STAGE(PG8_SA(0, 0), cA, vA[0]); PG8_STAGE(PG8_SB(0, 1), cB + hstep, voffB); PG8_STAGE(PG8_SA(0, 1), cA, vA[1]);
    if (wr == 1) PG8_BAR;
    PG8_WAIT_V(4); PG8_BAR;
    PG8_STAGE(PG8_SB(1, 0), cB + kstep, voffB); PG8_STAGE(PG8_SA(1, 0), cA + kstep, vA[0]); PG8_STAGE(PG8_SB(1, 1), cB + hstep + kstep, voffB);
    PG8_WAIT_V(6); PG8_BAR;
#endif
    for (;;) {
        const bool has_next = S.next(ui + 1, nxt);
        const char* nA = has_next ? nxt.A : cA; const char* nB = has_next ? nxt.B : cB;
        if constexpr (GATHER) {
            unsigned nv[2][2];
            if (has_next) { PG8_OFFS(nv, nxt); } else {
#pragma unroll
                for (int h = 0; h < 2; ++h) { nv[h][0] = vA[h][0]; nv[h][1] = vA[h][1]; } }
            *(LAS u32x4*)(park + tid * 4) = (u32x4){nv[0][0], nv[0][1], nv[1][0], nv[1][1]};
        }
        for (int t = 0; t < nt; t += 2) {
            const bool last = (t == nt - 2);
            const char* a1 = cA + (size_t)(t + 1) * kstep;
            const char* a2 = last ? nA : cA + (size_t)(t + 2) * kstep; const char* b2 = last ? nB : cB + (size_t)(t + 2) * kstep;
            const char* a3 = a2 + kstep; const char* b3 = b2 + kstep;
#ifndef PG8_USE_SP2
#define PG8_USE_SP2 1
#endif
            if constexpr (PG8_USE_SP2) {
            PG8_LDB(B0, 0, 0); PG8_LDB(B1, 0, 1); PG8_SCHED; PG8_LDA(At, 0, 0); PG8_STAGE(PG8_SA(1, 1), a1, vA[1]);
            if constexpr (GATHER) { if (last) { const u32x4 pv = *(const LAS u32x4*)(park + tid * 4); vA[0][0] = pv.x; vA[0][1] = pv.y; vA[1][0] = pv.z; vA[1][1] = pv.w; } }
            PG8_WAIT_V(8); PG8_WAIT_L(0); PG8_BAR; PG8_MMA(0, 0, At, B0); PG8_MMA(0, 1, At, B1); PG8_BAR; PG8_SCHED;
            PG8_LDA(At, 0, 1); PG8_STAGE(PG8_SB(0, 0), b2, voffB); PG8_STAGE(PG8_SB(0, 1), b2 + hstep, voffB); PG8_STAGE(PG8_SA(0, 0), a2, vA[0]);
            PG8_WAIT_V(8); PG8_WAIT_L(0); PG8_BAR; PG8_MMA(1, 0, At, B0); PG8_MMA(1, 1, At, B1); PG8_BAR; PG8_SCHED;
            PG8_LDB(B0, 1, 0); PG8_LDB(B1, 1, 1); PG8_SCHED; PG8_LDA(At, 1, 0); PG8_STAGE(PG8_SA(0, 1), a2, vA[1]);
            PG8_WAIT_V(8); PG8_WAIT_L(0); PG8_BAR; PG8_MMA(0, 0, At, B0); PG8_MMA(0, 1, At, B1); PG8_BAR; PG8_SCHED;
            PG8_LDA(At, 1, 1); PG8_STAGE(PG8_SB(1, 0), b3, voffB); PG8_STAGE(PG8_SB(1, 1), b3 + hstep, voffB); PG8_STAGE(PG8_SA(1, 0), a3, vA[0]);
            PG8_WAIT_V(8); PG8_WAIT_L(0); PG8_BAR; PG8_MMA(1, 0, At, B0); PG8_MMA(1, 1, At, B1); PG8_BAR; PG8_SCHED;
                    } else {
            PG8_LDB(B0, 0, 0); PG8_SCHED; PG8_LDA(At, 0, 0); PG8_STAGE(PG8_SA(1, 1), a1, vA[1]);
            if constexpr (GATHER) { if (last) { const u32x4 pv = *(const LAS u32x4*)(park + tid * 4); vA[0][0] = pv.x; vA[0][1] = pv.y; vA[1][0] = pv.z; vA[1][1] = pv.w; } }
            PG8_WAIT_L(8); PG8_BAR; PG8_WAIT_L(0); PG8_MMA(0, 0, At, B0); PG8_BAR; PG8_SCHED;
            PG8_LDB(B1, 0, 1); PG8_STAGE(PG8_SB(0, 0), b2, voffB);
            PG8_BAR; PG8_WAIT_L(0); PG8_MMA(0, 1, At, B1); PG8_BAR;
            PG8_LDA(At, 0, 1); PG8_STAGE(PG8_SA(0, 0), a2, vA[0]);
            PG8_BAR; PG8_WAIT_L(0); PG8_MMA(1, 0, At, B0); PG8_BAR; PG8_SCHED;
            PG8_STAGE(PG8_SB(0, 1), b2 + hstep, voffB);
            PG8_WAIT_V(6); PG8_BAR; PG8_MMA(1, 1, At, B1); PG8_BAR;
            PG8_LDB(B0, 1, 0); PG8_SCHED; PG8_LDA(At, 1, 0); PG8_STAGE(PG8_SA(0, 1), a2, vA[1]);
            PG8_WAIT_L(8); PG8_BAR; PG8_WAIT_L(0); PG8_MMA(0, 0, At, B0); PG8_BAR; PG8_SCHED;
            PG8_LDB(B1, 1, 1); PG8_STAGE(PG8_SB(1, 0), b3, voffB);
            PG8_BAR; PG8_WAIT_L(0); PG8_MMA(0, 1, At, B1); PG8_BAR;
            PG8_LDA(At, 1, 1); PG8_STAGE(PG8_SA(1, 0), a3, vA[0]);
            PG8_BAR; PG8_WAIT_L(0); PG8_MMA(1, 0, At, B0); PG8_BAR; PG8_SCHED;
            PG8_STAGE(PG8_SB(1, 1), b3 + hstep, voffB);
            PG8_WAIT_V(6); PG8_BAR; PG8_MMA(1, 1, At, B1); PG8_BAR;
            }
        }
        if constexpr (ALIGN_EPI) { if (wr == 0) PG8_BAR; }
#ifndef EPIREP
#define EPIREP 1
#endif
        for (int er = 0; er < Epi::REP; ++er) { int fr2 = fr, fq2 = fq; asm volatile("" : "+v"(fr2), "+v"(fq2)); E(acc, cur, wr, wc, fr2, fq2); }
        if (!has_next) break;
#pragma unroll
        for (int a = 0; a < 2; ++a)
#pragma unroll
            for (int b = 0; b < 2; ++b)
#pragma unroll
                for (int m = 0; m < 4; ++m)
#pragma unroll
                    for (int n = 0; n < 2; ++n) acc[a][b][m][n] = (f32x4){0.f, 0.f, 0.f, 0.f};
        cur = nxt; cA = nA; cB = nB; ++ui;
        if constexpr (ALIGN_EPI) { if (wr == 1) PG8_BAR; }
    }
    PG8_WAIT_V(0);
    if constexpr (!ALIGN_EPI) { if (wr == 0) PG8_BAR; }
    PG8_BAR;
#undef PG8_SA
#undef PG8_SB
#undef PG8_STAGE
#undef PG8_LDA
#undef PG8_LDB
#undef PG8_MMA
#undef PG8_WAIT_V
#undef PG8_WAIT_L
#undef PG8_BAR
#undef PG8_SCHED
#undef PG8_OFFS
}
}

struct Args {
    const float* x; const float* c; const int* pos; const float* w_ada; const float* b_ada; const float* norm1_g; const float* norm2_g;
    const float* w_in; const float* w_out; const float* pool_w; const float* pool_scale; const float* hgrn_g; const float* lb_logits;
    const float* w_router; const float* b_router; const float* w1; const float* b1; const float* w2; const float* b2; const float* final_g;
    float* out; unsigned char* ws; int ph_lo, ph_hi;
};

struct Ctx {
    LAS unsigned char* lds;
    int tid, lane, wave, G, vcu;
    unsigned char* ws;
};

struct DenseOrder {
    const char* A; const char* B; int nM, nN, nwg, G, c;
    __device__ __forceinline__ bool next(int i, pg8::Unit& u) const {
        const long L = (long)i * G + c; if (L >= nwg) return false;
        int wgid = (int)L; { const int q = nwg / 8, r = nwg % 8, xcd = wgid % 8, off = wgid / 8; wgid = (xcd < r ? xcd * (q + 1) : r * (q + 1) + (xcd - r) * q) + off; }
        const int nig = 8 * nN, gid = wgid / nig, fm = gid * 8, gsz = (nM - fm) < 8 ? (nM - fm) : 8;
        const int pm = fm + ((wgid % nig) % gsz), pn = (wgid % nig) / gsz;
        u.A = A + (size_t)pm * 256 * pg8::KD * 2; u.B = B + (size_t)pn * 256 * pg8::KD * 2; u.ridx = nullptr; u.nvalid = 256; u.row0 = pm * 256; u.pn = pn; u.e = 0; u.b = pm >> 4;
        return true;
    }
};

template <bool FIRST> struct MoeOrder {
    LAS const int* tab; const char* A; const char* B; const int* rowtok; int G, c;
    static constexpr int NTN = FIRST ? 8 : 4;
    __device__ __forceinline__ bool next(int i, pg8::Unit& u) const {
#ifndef KREP
#define KREP 1
#endif
        const int P = tab[32]; const long L = (long)(i / (FIRST ? 1 : KREP)) * G + c; if (L >= (long)P * NTN) return false;
        const int p = (int)(L / NTN), nt = (int)(L % NTN);
        int e = 0;
#pragma unroll 1
        for (int k = 1; k < 32; ++k) e = (tab[k] <= p) ? k : e;
        const int mt = p - tab[e], cnt = tab[33 + e];
        if (FIRST) { u.A = A; u.ridx = rowtok + e * NTOK + mt * 256; u.nvalid = (cnt - mt * 256) < 256 ? (cnt - mt * 256) : 256; u.B = B + ((size_t)e * 2048 + nt * 256) * pg8::KD * 2; }
        else { u.A = A + (size_t)p * 256 * pg8::KD * 2; u.ridx = nullptr; u.nvalid = 256; u.B = B + ((size_t)e * 1024 + nt * 256) * pg8::KD * 2; }
        u.row0 = p * 256; u.pn = nt; u.e = e; u.b = (FIRST ? 1 : ((i % KREP) == KREP - 1));
        return true;
    }
};

#ifndef EPIREP_IN
#define EPIREP_IN 1
#endif
#ifndef EPIREP_G1
#define EPIREP_G1 1
#endif
#ifndef EPIREP_G2
#define EPIREP_G2 1
#endif
struct EpiIn {
    static constexpr int REP = EPIREP_IN;
    unsigned char* ws;
    __device__ __forceinline__ void operator()(const f32x4 (&acc)[2][2][4][2], const pg8::Unit& u, int wr, int wc, int fr, int fq) const {
        const int pn = u.pn;
        const float* rc = (const float*)(ws + WS_ROPEC); const float* rs = (const float*)(ws + WS_ROPES);
        const bool rope = (pn <= 1) || (pn == 3) || (pn == 2 && wc < 2) || (pn == 4 && wc == 0);
#pragma unroll
        for (int ai = 0; ai < 2; ++ai)
#pragma unroll
            for (int m = 0; m < 4; ++m) {
                const int r = u.row0 + ai * 128 + wr * 64 + m * 16 + fr;
                if (rope) {
                    bf16_t* dst; float scl = 1.f;
                    if (pn <= 1) { dst = (bf16_t*)(ws + WS_Q) + (size_t)r * 512 + (pn * 4 + wc) * 64; scl = 0.125f; }
                    else if (pn == 2) dst = (bf16_t*)(ws + WS_K) + (size_t)r * 128 + wc * 64;
                    else if (pn == 3) dst = (bf16_t*)(ws + WS_QI) + (size_t)r * 256 + wc * 64;
                    else dst = (bf16_t*)(ws + WS_KI) + (size_t)r * 64;
                    const f32x4 c0 = *(const f32x4*)(rc + (size_t)r * 32 + 8 * fq), c1 = *(const f32x4*)(rc + (size_t)r * 32 + 8 * fq + 4), s0 = *(const f32x4*)(rs + (size_t)r * 32 + 8 * fq), s1 = *(const f32x4*)(rs + (size_t)r * 32 + 8 * fq + 4);
                    const f32x4 x10 = acc[ai][0][m][0], x11 = acc[ai][0][m][1], x20 = acc[ai][1][m][0], x21 = acc[ai][1][m][1];
                    const f32x4 o10 = (x10 * c0 - x20 * s0) * scl, o11 = (x11 * c1 - x21 * s1) * scl, o20 = (x20 * c0 + x10 * s0) * scl, o21 = (x21 * c1 + x11 * s1) * scl;
                    u32x4 w1v, w2v; w1v.x = pk2(o10[0], o10[1]); w1v.y = pk2(o10[2], o10[3]); w1v.z = pk2(o11[0], o11[1]); w1v.w = pk2(o11[2], o11[3]);
                    w2v.x = pk2(o20[0], o20[1]); w2v.y = pk2(o20[2], o20[3]); w2v.z = pk2(o21[0], o21[1]); w2v.w = pk2(o21[2], o21[3]);
                    *(u32x4*)(dst + 8 * fq) = w1v; *(u32x4*)(dst + 32 + 8 * fq) = w2v;
                } else if (pn == 2) {
#pragma unroll
                    for (int bj = 0; bj < 2; ++bj) { const f32x4 a0 = acc[ai][bj][m][0], a1 = acc[ai][bj][m][1]; u32x4 w; w.x = pk2(a0[0], a0[1]); w.y = pk2(a0[2], a0[3]); w.z = pk2(a1[0], a1[1]); w.w = pk2(a1[2], a1[3]);
                        *(u32x4*)((bf16_t*)(ws + WS_V) + (size_t)r * 128 + bj * 64 + (wc - 2) * 32 + 8 * fq) = w; }
                } else if (pn == 4) {
                    if (wc == 1 && fq == 0) *(f32x4*)((float*)(ws + WS_WI) + (size_t)r * 4) = acc[ai][0][m][0] * 0.0625f;
                } else {
                    float* p = (pn == 5) ? (float*)(ws + WS_UB) + (size_t)r * 256 + wc * 32 + 8 * fq : (float*)(ws + WS_HG) + (size_t)r * 1024 + (pn - 6) * 256 + wc * 32 + 8 * fq;
#pragma unroll
                    for (int bj = 0; bj < 2; ++bj) { *(f32x4*)(p + bj * 128) = acc[ai][bj][m][0]; *(f32x4*)(p + bj * 128 + 4) = acc[ai][bj][m][1]; }
                }
            }
    }
};
struct EpiOut {
    static constexpr int REP = 1;
    const float* hin; float* hout; const float* gate;
    __device__ __forceinline__ void operator()(const f32x4 (&acc)[2][2][4][2], const pg8::Unit& u, int wr, int wc, int fr, int fq) const {
        const int col0 = u.pn * 256 + wc * 32 + 8 * fq; const float* gp = gate + (size_t)u.b * 6144 + col0;
        f32x4 gv[2][2];
#pragma unroll
        for (int bj = 0; bj < 2; ++bj)
#pragma unroll
            for (int n = 0; n < 2; ++n) gv[bj][n] = *(const f32x4*)(gp + bj * 128 + n * 4);
#pragma unroll
        for (int ai = 0; ai < 2; ++ai)
#pragma unroll
            for (int m = 0; m < 4; ++m) { const size_t off = (size_t)(u.row0 + ai * 128 + wr * 64 + m * 16 + fr) * D + col0;
#pragma unroll
                for (int bj = 0; bj < 2; ++bj)
#pragma unroll
                    for (int n = 0; n < 2; ++n) { const f32x4 hv = *(const f32x4*)(hin + off + bj * 128 + n * 4); *(f32x4*)(hout + off + bj * 128 + n * 4) = hv + gv[bj][n] * acc[ai][bj][m][n]; }
                asm volatile("" ::: "memory"); }
    }
};
struct EpiG1 {
    static constexpr int REP = EPIREP_G1;
    bf16_t* act; const float* b1l;
    __device__ __forceinline__ void operator()(const f32x4 (&acc)[2][2][4][2], const pg8::Unit& u, int wr, int wc, int fr, int fq) const {
        const int ja0 = u.pn * 128 + wc * 32 + 8 * fq; const float* bp = b1l + (size_t)u.e * 2048 + 2 * ja0;
        f32x4 bg[2], bl[2];
#pragma unroll
        for (int n = 0; n < 2; ++n) { const f32x4 t0 = *(const f32x4*)(bp + 8 * n), t1 = *(const f32x4*)(bp + 8 * n + 4); bg[n] = (f32x4){t0[0], t0[2], t1[0], t1[2]}; bl[n] = (f32x4){t0[1], t0[3], t1[1], t1[3]}; }
#pragma unroll
        for (int ai = 0; ai < 2; ++ai)
#pragma unroll
            for (int m = 0; m < 4; ++m) { float o[8];
#pragma unroll
                for (int n = 0; n < 2; ++n) { const f32x4 hg = acc[ai][0][m][n] + bg[n], hl = acc[ai][1][m][n] + bl[n];
#pragma unroll
                    for (int j = 0; j < 4; ++j) { const float xg = fminf(hg[j], 7.0f), xl = fminf(fmaxf(hl[j], -7.0f), 7.0f); o[4 * n + j] = xg * sigmoidf_(1.702f * xg) * (xl + 1.0f); } }
                u32x4 w; w.x = pk2(o[0], o[1]); w.y = pk2(o[2], o[3]); w.z = pk2(o[4], o[5]); w.w = pk2(o[6], o[7]);
                *(u32x4*)(act + (size_t)(u.row0 + ai * 128 + wr * 64 + m * 16 + fr) * FF + ja0) = w; }
    }
};
struct EpiG2 {
    static constexpr int REP = EPIREP_G2;
    bf16_t* y; const float* b2l;
    __device__ __forceinline__ void operator()(const f32x4 (&acc)[2][2][4][2], const pg8::Unit& u, int wr, int wc, int fr, int fq) const {
        if (!u.b) return;
        const int col0 = u.pn * 256 + wc * 32 + 8 * fq; const float* bp = b2l + (size_t)u.e * 1024 + col0;
        f32x4 bv[2][2];
#pragma unroll
        for (int bj = 0; bj < 2; ++bj)
#pragma unroll
            for (int n = 0; n < 2; ++n) bv[bj][n] = *(const f32x4*)(bp + bj * 128 + n * 4);
#pragma unroll
        for (int ai = 0; ai < 2; ++ai)
#pragma unroll
            for (int m = 0; m < 4; ++m) { bf16_t* rowp = y + (size_t)(u.row0 + ai * 128 + wr * 64 + m * 16 + fr) * D + col0;
#pragma unroll
                for (int bj = 0; bj < 2; ++bj) { const f32x4 v0 = acc[ai][bj][m][0] + bv[bj][0], v1 = acc[ai][bj][m][1] + bv[bj][1];
                    u32x4 w; w.x = pk2(v0[0], v0[1]); w.y = pk2(v0[2], v0[3]); w.z = pk2(v1[0], v1[1]); w.w = pk2(v1[2], v1[3]); *(u32x4*)(rowp + bj * 128) = w; } }
    }
};
__device__ __forceinline__ int slot32(int d) { return 16 * ((d >> 2) & 1) + 4 * ((d >> 3) & 3) + (d & 3); }
__device__ __forceinline__ int win_dest(int s) {
    if (s < 512) { const int hd = s >> 6, d64 = s & 63; return 256 * (hd >> 2) + 128 * (d64 >> 5) + 32 * (hd & 3) + slot32(d64 & 31); }
    if (s < 640) { const int hd = (s - 512) >> 6, d64 = s & 63; return 512 + 128 * (d64 >> 5) + 32 * hd + slot32(d64 & 31); }
    if (s < 768) { const int v = s - 640; return 512 + 128 * (v >> 6) + 32 * (2 + ((v & 63) >> 5)) + slot32(v & 31); }
    if (s < 1024) { const int hd = (s - 768) >> 6, d64 = s & 63; return 768 + 128 * (d64 >> 5) + 32 * hd + slot32(d64 & 31); }
    if (s < 1088) { const int d64 = s - 1024; return 1024 + 128 * (d64 >> 5) + slot32(d64 & 31); }
    if (s < 1092) return 1024 + 32 + (s - 1088);
    if (s < 1348) { const int v = s - 1092; return 1280 + (v & ~31) + slot32(v & 31); }
    { const int v = s - 1348; return 1536 + (v & ~31) + slot32(v & 31); }
}
__device__ __forceinline__ int perm_dest(int s) { return (s & ~31) + 16 * ((s >> 2) & 1) + 4 * ((s >> 3) & 3) + (s & 3); }
__device__ __forceinline__ int w1_dest(int s) { const int jg = s >> 1, isl = s & 1, nt = jg >> 7, ja = jg & 127; return 256 * nt + 128 * isl + (ja & ~31) + slot32(ja & 31); }

template <int MAP>
__device__ __forceinline__ void transpose_item(const float* W, int N, bf16_t* WT, LAS float* scr, int kb, int nb, int lane) {
    const int k0 = 64 * kb, n0 = 32 * nb, col = n0 + (lane & 31); const bool ok = col < N;
    float v[32];
    const float* src = W + (size_t)(k0 + (lane >> 5)) * N + (ok ? col : 0);
#pragma unroll
    for (int i = 0; i < 32; ++i) v[i] = src[(size_t)(2 * i) * N];
#pragma unroll
    for (int i = 0; i < 32; ++i) scr[(2 * i + (lane >> 5)) * 33 + (lane & 31)] = ok ? v[i] : 0.f;
    asm volatile("s_waitcnt lgkmcnt(0)" ::: "memory");
    const int c = lane & 7;
#pragma unroll
    for (int j = 0; j < 4; ++j) { const int n = (lane >> 3) + 8 * j; const LAS float* s = scr + (8 * c) * 33 + n;
        u32x4 o; o.x = pk2(s[0 * 33], s[1 * 33]); o.y = pk2(s[2 * 33], s[3 * 33]); o.z = pk2(s[4 * 33], s[5 * 33]); o.w = pk2(s[6 * 33], s[7 * 33]);
        const int sc = n0 + n;
        if (sc < N) { const int dest = MAP == 1 ? win_dest(sc) : (MAP == 2 ? w1_dest(sc) : (MAP == 3 ? perm_dest(sc) : sc)); *(u32x4*)(WT + (size_t)dest * 1024 + k0 + 8 * c) = o; } }
    asm volatile("s_waitcnt lgkmcnt(0)" ::: "memory");
}

__device__ __forceinline__ void phase_prep(const Args& a, Ctx& C) {
    unsigned char* ws = C.ws;
    {
        LAS float* ca = (LAS float*)C.lds;
        LAS float* red = ca + 4096;
        for (int i = C.tid; i < 4096; i += NTHREADS) { const float v = a.c[i]; ca[i] = siluf_(v); }
        __syncthreads();
        for (int it = blockIdx.x; it < 192; it += C.G) {
            const int l = it / 96, cb = it % 96, col = cb * 64 + (C.tid & 63), kg = C.tid >> 6;
            const float* w = a.w_ada + (size_t)l * 1024 * 6144 + col;
            float s0 = 0.f, s1 = 0.f, s2 = 0.f, s3 = 0.f;
#pragma unroll 8
            for (int k = kg * 128; k < kg * 128 + 128; ++k) { const float wv = w[(size_t)k * 6144]; s0 += ca[k] * wv; s1 += ca[1024 + k] * wv; s2 += ca[2048 + k] * wv; s3 += ca[3072 + k] * wv; }
            red[(kg * 4 + 0) * 64 + (C.tid & 63)] = s0; red[(kg * 4 + 1) * 64 + (C.tid & 63)] = s1; red[(kg * 4 + 2) * 64 + (C.tid & 63)] = s2; red[(kg * 4 + 3) * 64 + (C.tid & 63)] = s3;
            __syncthreads();
            if (C.tid < 256) { const int b = C.tid >> 6, cc = C.tid & 63; float s = 0.f;
#pragma unroll
                for (int g = 0; g < 8; ++g) s += red[(g * 4 + b) * 64 + cc];
                ((float*)(ws + WS_MOD))[(size_t)(l * 4 + b) * 6144 + cb * 64 + cc] = s + a.b_ada[l * 6144 + cb * 64 + cc]; }
            __syncthreads();
        }
    }
    const int gw = C.vcu * NWAVES + C.wave, NGW = C.G * NWAVES;
    for (int tk = gw; tk < NTOK; tk += NGW) {
        if (C.lane < 32) {
            const float posf = (float)a.pos[tk];
            const float inv = exp2f(-(float)C.lane * (13.287712379549449f / 32.0f));
            const double ang = (double)(posf * inv);
            const double kq = rint(ang * 0.63661977236758134308);
            const double y = fma(-kq, 1.57079632679489661923, ang);
            const double y2 = y * y;
            const double sy = y * (1.0 + y2 * (-1.0 / 6 + y2 * (1.0 / 120 + y2 * (-1.0 / 5040 + y2 * (1.0 / 362880 - y2 * (1.0 / 39916800))))));
            const double cy = 1.0 + y2 * (-0.5 + y2 * (1.0 / 24 + y2 * (-1.0 / 720 + y2 * (1.0 / 40320 + y2 * (-1.0 / 3628800 + y2 * (1.0 / 479001600))))));
            const int q = ((int)((long long)kq)) & 3;
            const double sn = (q == 0) ? sy : (q == 1) ? cy : (q == 2) ? -sy : -cy;
            const double cs = (q == 0) ? cy : (q == 1) ? -sy : (q == 2) ? -cy : sy;
            ((float*)(ws + WS_ROPEC))[(size_t)tk * 32 + C.lane] = (float)cs;
            ((float*)(ws + WS_ROPES))[(size_t)tk * 32 + C.lane] = (float)sn;
        }
    }
    for (int i = gw * 64 + C.lane; i < 2 * 32 * 1024; i += NGW * 64) { const int l = i >> 15, e = (i >> 10) & 31, k = i & 1023; const float wv = a.w_router[(size_t)l * 32768 + k * 32 + e];
        const unsigned hi = f2bf(wv); const float lo = wv - bf2f((unsigned short)hi); ((bf16_t*)(ws + WS_WRH))[i] = (bf16_t)hi; ((bf16_t*)(ws + WS_WRL))[i] = (bf16_t)f2bf(lo); }
    LAS float* scr = (LAS float*)(C.lds + C.wave * 16384);
    constexpr int I_IN = 2 * 16 * 75, I_OUT = 2 * 16 * 32;
    for (int it = gw; it < I_IN + I_OUT; it += NGW) {
        int r = it;
        if (r < I_IN) { const int l = r / (16 * 75), q = r % (16 * 75); transpose_item<1>(a.w_in + (size_t)l * 1024 * D_IN, D_IN, (bf16_t*)(ws + WS_WIN) + (size_t)l * NPAD * 1024, scr, q / 75, q % 75, C.lane); continue; }
        r -= I_IN;
        { const int l = r / (16 * 32), q = r % (16 * 32); transpose_item<3>(a.w_out + (size_t)l * 1024 * 1024, 1024, (bf16_t*)(ws + WS_WOUT) + (size_t)l * 1024 * 1024, scr, q / 32, q % 32, C.lane); }
    }
}

struct Conv {
    const float* w1l; const float* w2l; bf16_t* w1t; bf16_t* w2t;
    int it, step, lane; bool pend;
    const float* W; bf16_t* WT; int N, map, k0, n0;
    f32x4 v4[8];
    static constexpr int NITEMS = 32 * 16 * 64 + 32 * 16 * 32;
    int it_end;
    __device__ __forceinline__ void issue() {
        if (it >= it_end) return;
        if (it < 32 * 16 * 64) { const int e = it >> 10, q = it & 1023; W = w1l + (size_t)e * 1024 * 2048; WT = w1t + (size_t)e * 2048 * 1024; N = 2048; map = 2; k0 = 64 * (q >> 6); n0 = 32 * (q & 63); }
        else { const int r = it - 32 * 16 * 64, e = r >> 9, q = r & 511; W = w2l + (size_t)e * 1024 * 1024; WT = w2t + (size_t)e * 1024 * 1024; N = 1024; map = 3; k0 = 64 * (q >> 5); n0 = 32 * (q & 31); }
        const float* src = W + (size_t)(k0 + (lane >> 3)) * N + n0 + 4 * (lane & 7);
#pragma unroll
        for (int i = 0; i < 8; ++i) v4[i] = *(const f32x4*)(src + (size_t)(8 * i) * N);
        pend = true; it += step;
    }
    __device__ __forceinline__ void finish(LAS float* scr) {
        if (!pend) return;
#pragma unroll
        for (int i = 0; i < 8; ++i) { LAS float* d = scr + ((lane >> 3) + 8 * i) * 33 + 4 * (lane & 7); d[0] = v4[i].x; d[1] = v4[i].y; d[2] = v4[i].z; d[3] = v4[i].w; }
        asm volatile("s_waitcnt lgkmcnt(0)" ::: "memory");
        const int c = lane & 7;
#pragma unroll
        for (int j = 0; j < 4; ++j) { const int n = (lane >> 3) + 8 * j; const LAS float* sp = scr + (8 * c) * 33 + n;
            u32x4 o; o.x = pk2(sp[0 * 33], sp[1 * 33]); o.y = pk2(sp[2 * 33], sp[3 * 33]); o.z = pk2(sp[4 * 33], sp[5 * 33]); o.w = pk2(sp[6 * 33], sp[7 * 33]);
            const int sc = n0 + n; const int dest = map == 2 ? w1_dest(sc) : perm_dest(sc); *(u32x4*)(WT + (size_t)dest * 1024 + k0 + 8 * c) = o; }
        asm volatile("s_waitcnt lgkmcnt(0)" ::: "memory");
        pend = false;
    }
};

__device__ __forceinline__ void norm_mod_store(const f32x4 (&v)[4], const float* g, const float* sh, const float* sc, bf16_t* urow, int lane) {
    float ss = 0.f;
#pragma unroll
    for (int j = 0; j < 4; ++j) ss += (v[j].x * v[j].x + v[j].y * v[j].y) + (v[j].z * v[j].z + v[j].w * v[j].w);
    const float rstd = 1.0f / sqrtf(wave_sum(ss) * (1.0f / D) + EPS);
#pragma unroll
    for (int j = 0; j < 4; ++j) { const int idx = 4 * lane + 256 * j; const f32x4 gv = *(const f32x4*)(g + idx), shv = *(const f32x4*)(sh + idx), scv = *(const f32x4*)(sc + idx);
        const f32x4 o = v[j] * rstd * gv * (scv + 1.0f) + shv; u32x2 w; w.x = pk2(o[0], o[1]); w.y = pk2(o[2], o[3]); *(u32x2*)(urow + idx) = w; }
}

__device__ __forceinline__ void phase_u0(const Args& a, Ctx& C) {
    const int gw = C.vcu * NWAVES + C.wave, NGW = C.G * NWAVES; const float* mod = (const float*)(C.ws + WS_MOD);
    for (int tk0 = gw; tk0 < NTOK; tk0 += 2 * NGW) {
        const bool two = (tk0 + NGW) < NTOK; const int tk1 = two ? tk0 + NGW : tk0;
        const f32x4* x0 = (const f32x4*)(a.x + (size_t)tk0 * D) + C.lane; const f32x4* x1 = (const f32x4*)(a.x + (size_t)tk1 * D) + C.lane; f32x4 v0[4], v1[4];
#pragma unroll
        for (int j = 0; j < 4; ++j) { v0[j] = x0[64 * j]; v1[j] = x1[64 * j]; }
        { const float* mb = mod + (size_t)(tk0 >> 12) * 6144; norm_mod_store(v0, a.norm1_g, mb + 0, mb + 1024, (bf16_t*)(C.ws + WS_U) + (size_t)tk0 * D, C.lane); }
        if (two) { const float* mb = mod + (size_t)(tk1 >> 12) * 6144; norm_mod_store(v1, a.norm1_g, mb + 0, mb + 1024, (bf16_t*)(C.ws + WS_U) + (size_t)tk1 * D, C.lane); }
    }
}

__device__ __forceinline__ unsigned sortable(float f) { const unsigned u = __builtin_bit_cast(unsigned, f); return (u & 0x80000000u) ? ~u : (u | 0x80000000u); }
__device__ __forceinline__ int mbcnt64(unsigned long long m) { return __builtin_amdgcn_mbcnt_hi((unsigned)(m >> 32), __builtin_amdgcn_mbcnt_lo((unsigned)m, 0)); }

constexpr int HP = 65;
__device__ __forceinline__ int wave_isum(int v) {
    v += __builtin_amdgcn_update_dpp(0, v, 0xB1, 0xF, 0xF, true);
    v += __builtin_amdgcn_update_dpp(0, v, 0x4E, 0xF, 0xF, true);
    v += __builtin_amdgcn_update_dpp(0, v, 0x141, 0xF, 0xF, true);
    v += __builtin_amdgcn_update_dpp(0, v, 0x140, 0xF, 0xF, true);
    return __builtin_amdgcn_readlane(v, 0) + __builtin_amdgcn_readlane(v, 16) + __builtin_amdgcn_readlane(v, 32) + __builtin_amdgcn_readlane(v, 48);
}
typedef float f32x16 __attribute__((ext_vector_type(16)));
__device__ __forceinline__ void transpose32(unsigned (&a)[32]) {
#pragma unroll
    for (int st = 0; st < 5; ++st) {
        const int j = 16 >> st; const unsigned m = (st == 0) ? 0x0000FFFFu : (st == 1) ? 0x00FF00FFu : (st == 2) ? 0x0F0F0F0Fu : (st == 3) ? 0x33333333u : 0x55555555u;
#pragma unroll
        for (int idx = 0; idx < 16; ++idx) { const int k = (idx / j) * 2 * j + (idx % j); const unsigned t = (a[k] ^ (a[k + j] >> j)) & m; a[k] ^= t; a[k + j] ^= (t << j); }
    }
}
__device__ __forceinline__ int wave_iscan(int v) {
    v += __builtin_amdgcn_update_dpp(0, v, 0x111, 0xF, 0xF, true);
    v += __builtin_amdgcn_update_dpp(0, v, 0x112, 0xF, 0xF, true);
    v += __builtin_amdgcn_update_dpp(0, v, 0x114, 0xF, 0xF, true);
    v += __builtin_amdgcn_update_dpp(0, v, 0x118, 0xF, 0xF, true);
    v += __builtin_amdgcn_update_dpp(0, v, 0x142, 0xA, 0xF, false);
    v += __builtin_amdgcn_update_dpp(0, v, 0x143, 0xC, 0xF, false);
    return v;
}
__device__ __forceinline__ unsigned sortable16(unsigned h) { return (h & 0x8000u) ? (~h & 0xFFFFu) : (h | 0x8000u); }
__device__ __forceinline__ unsigned short f2h_bits(float f) { const _Float16 h = (_Float16)f; unsigned short b = __builtin_bit_cast(unsigned short, h); return b == 0x8000u ? (unsigned short)0 : b; }
template <int NB>
__device__ __forceinline__ void select_bits16(const LAS unsigned short* sq, int nj, int* sel, int lane) {
    unsigned a[32];
#pragma unroll
    for (int j = 0; j < 32; ++j) { const unsigned lo = sortable16(sq[64 * j + lane]); const unsigned hi = (NB == 2) ? sortable16(sq[64 * (32 + j) + lane]) : 0u; a[j] = lo | (hi << 16); }
    transpose32(a);
    unsigned Ml = 0xFFFFFFFFu, Mh = (NB == 2) ? 0xFFFFFFFFu : 0u, Gl = 0u, Gh = 0u; unsigned T = 0u; int G = 0;
#pragma unroll
    for (int bit = 15; bit >= 0; --bit) {
        const unsigned nl = Ml & a[31 - bit], nh = Mh & a[15 - bit];
        const int tot = wave_isum(__popc(nl) + __popc(nh));
        const bool take = (G + tot) >= 256; const unsigned flip = take ? 0u : 0xFFFFFFFFu;
        T |= take ? (1u << bit) : 0u; G += take ? 0 : tot;
        Gl |= nl & flip; Gh |= nh & flip; Ml &= (a[31 - bit] ^ flip); Mh &= (a[15 - bit] ^ flip);
    }
    const int need = 256 - G;
    if (T != 0x8000u) {
        const int ceq = __popc(Ml) + __popc(Mh); const int incl = wave_iscan(ceq);
        int quota = need - (incl - ceq); quota = quota < 0 ? 0 : (quota > ceq ? ceq : quota);
        const int cnt = __popc(Gl) + __popc(Gh) + quota; const int inc2 = wave_iscan(cnt);
        int pos = inc2 - cnt;
        { unsigned mk = Gl; while (mk) { const int x = 31 - __clz((int)mk); mk &= ~(1u << x); sel[pos++] = 64 * (31 - x) + lane; } }
        if (NB == 2) { unsigned mk = Gh; while (mk) { const int x = 31 - __clz((int)mk); mk &= ~(1u << x); sel[pos++] = 64 * (63 - x) + lane; } }
        { unsigned mk = Ml; while (mk && quota > 0) { const int x = 31 - __clz((int)mk); mk &= ~(1u << x); sel[pos++] = 64 * (31 - x) + lane; --quota; } }
        if (NB == 2) { unsigned mk = Mh; while (mk && quota > 0) { const int x = 31 - __clz((int)mk); mk &= ~(1u << x); sel[pos++] = 64 * (63 - x) + lane; --quota; } }
    } else {
        int base = 0, eqseen = 0;
#pragma unroll 1
        for (int j = 0; j < nj; ++j) {
            const unsigned kj = sortable16(sq[64 * j + lane]);
            const bool gt = kj > T, eq = kj == T; const unsigned long long em = __ballot(eq);
            const bool take = gt || (eq && (eqseen + mbcnt64(em)) < need); const unsigned long long tm = __ballot(take);
            if (take) sel[base + mbcnt64(tm)] = 64 * j + lane;
            base += __popcll(tm); eqseen += __popcll(em);
        }
    }
}
constexpr int CONV_SPLIT = 16384;
constexpr int KST_ROW = 144, KST_BYTES = 64 * KST_ROW;
__device__ __forceinline__ void index_unit2(Ctx& C, int b, int cch, int sub, Conv& cv) {
    unsigned char* ws = C.ws; const int lane = C.lane, w = C.wave;
    const int tk0 = b * SEQ + 64 * cch + 8 * sub, L = 64 * (cch + 1), nj = cch + 1;
    if (L <= 256) { int* sel = (int*)(ws + WS_SEL) + (size_t)(tk0 + w) * 256; for (int i = lane; i < L; i += 64) sel[i] = i; return; }
    LAS unsigned short* sclh = (LAS unsigned short*)C.lds;
    LAS unsigned char* kst = C.lds + 65536 + w * KST_BYTES;
    {
        const int r = lane & 31, hf = lane >> 5, qq = r >> 2, h = r & 3;
        bf16x8 aq[4];
#pragma unroll
        for (int ks = 0; ks < 4; ++ks) aq[ks] = *(const bf16x8*)((const bf16_t*)(ws + WS_QI) + (size_t)(tk0 + qq) * 256 + h * 64 + 16 * ks + 8 * hf);
        f32x4 wq[4];
#pragma unroll
        for (int g = 0; g < 4; ++g) wq[g] = *(const f32x4*)((const float*)(ws + WS_WI) + (size_t)(tk0 + 2 * g + hf) * 4);
        const unsigned char* kib = ws + WS_KI + (size_t)b * SEQ * 128;
        const int ntile = 2 * nj;
        u32x4 st[8];
#define IDX2_LOAD(kta) do { const int _t1 = (kta), _t2 = ((kta) + NWAVES) < ntile ? (kta) + NWAVES : (kta); _Pragma("unroll") for (int j = 0; j < 4; ++j) { \
            st[j] = *(const u32x4*)(kib + (size_t)_t1 * 4096 + 1024 * j + 16 * lane); st[4 + j] = *(const u32x4*)(kib + (size_t)_t2 * 4096 + 1024 * j + 16 * lane); } } while (0)
        if (w < ntile) IDX2_LOAD(w);
#pragma unroll 1
        for (int kt = w; kt < ntile; kt += 2 * NWAVES) {
            const bool two = (kt + NWAVES) < ntile; const int kt2 = two ? kt + NWAVES : kt;
#pragma unroll
            for (int j = 0; j < 4; ++j) { *(LAS u32x4*)(kst + (8 * j + (lane >> 3)) * KST_ROW + 16 * (lane & 7)) = st[j]; *(LAS u32x4*)(kst + (32 + 8 * j + (lane >> 3)) * KST_ROW + 16 * (lane & 7)) = st[4 + j]; }
            if ((kt + 2 * NWAVES) < ntile) IDX2_LOAD(kt + 2 * NWAVES);
            f32x16 acc, acc2;
#pragma unroll
            for (int i = 0; i < 16; ++i) { acc[i] = 0.f; acc2[i] = 0.f; }
#pragma unroll
            for (int ks = 0; ks < 4; ++ks) { const bf16x8 b1 = *(const LAS bf16x8*)(kst + r * KST_ROW + 32 * ks + 16 * hf), b2 = *(const LAS bf16x8*)(kst + (32 + r) * KST_ROW + 32 * ks + 16 * hf);
                acc = __builtin_amdgcn_mfma_f32_32x32x16_bf16(aq[ks], b1, acc, 0, 0, 0); acc2 = __builtin_amdgcn_mfma_f32_32x32x16_bf16(aq[ks], b2, acc2, 0, 0, 0); }
#pragma unroll
            for (int g = 0; g < 4; ++g) {
                const float sc = fmaxf(acc[4 * g + 0], 0.f) * wq[g][0] + fmaxf(acc[4 * g + 1], 0.f) * wq[g][1] + fmaxf(acc[4 * g + 2], 0.f) * wq[g][2] + fmaxf(acc[4 * g + 3], 0.f) * wq[g][3];
                sclh[(2 * g + hf) * 4096 + 32 * kt + r] = f2h_bits(sc);
                const float sc2 = fmaxf(acc2[4 * g + 0], 0.f) * wq[g][0] + fmaxf(acc2[4 * g + 1], 0.f) * wq[g][1] + fmaxf(acc2[4 * g + 2], 0.f) * wq[g][2] + fmaxf(acc2[4 * g + 3], 0.f) * wq[g][3];
                if (two) sclh[(2 * g + hf) * 4096 + 32 * kt2 + r] = f2h_bits(sc2);
            }
        }
#undef IDX2_LOAD
        const int njp = nj <= 32 ? 32 : 64;
        for (int j = nj; j < njp; ++j) sclh[w * 4096 + 64 * j + lane] = (unsigned short)0xFBFFu;
    }
    __syncthreads();
    {
        const LAS unsigned short* sq = sclh + w * 4096; int* sel = (int*)(ws + WS_SEL) + (size_t)(tk0 + w) * 256;
        cv.issue();
        if (nj <= 32) select_bits16<1>(sq, nj, sel, lane); else select_bits16<2>(sq, nj, sel, lane);
        cv.finish((LAS float*)kst);
    }
    __syncthreads();
}

typedef short s16x4 __attribute__((ext_vector_type(4)));
constexpr int VROW = 272;
__device__ __forceinline__ void attend_query_mfma(Ctx& C, int tk, LAS unsigned char* vs, Conv& cv) {
    unsigned char* ws = C.ws; const int lane = C.lane, c = lane & 15, g = lane >> 4;
    const int tpos = tk & (SEQ - 1), b = tk >> 12, L = 64 * ((tpos >> 6) + 1), nsel = L < 256 ? L : 256;
    const bf16_t* kb = (const bf16_t*)(ws + WS_K) + (size_t)b * SEQ * 128; const bf16_t* vb = (const bf16_t*)(ws + WS_V) + (size_t)b * SEQ * 128;
    int selr[4];
    { const int* sg = (const int*)(ws + WS_SEL) + (size_t)tk * 256;
#pragma unroll
      for (int i = 0; i < 4; ++i) selr[i] = (64 * i + lane) < nsel ? sg[64 * i + lane] : 0; }
    bf16x8 bq0[2], bq1[2];
    { const bf16_t* qp = (const bf16_t*)(ws + WS_Q) + (size_t)tk * 512 + (c & 7) * 64 + 8 * g; const bf16x8 z = (bf16x8){0, 0, 0, 0, 0, 0, 0, 0};
#pragma unroll
      for (int ks = 0; ks < 2; ++ks) { const bf16x8 q = *(const bf16x8*)(qp + 32 * ks); bq0[ks] = (c < 4) ? q : z; bq1[ks] = (c >= 4 && c < 8) ? q : z; } }
    cv.issue();
    f32x4 acc[16];
#pragma unroll
    for (int kt = 0; kt < 16; ++kt) {
        if ((kt & 3) == 0) asm volatile("" ::: "memory");
        const int key = __shfl(selr[kt >> 2], 16 * (kt & 3) + c);
        const bf16_t* kr = kb + (size_t)key * 128 + 8 * g;
        const bf16x8 a00 = *(const bf16x8*)(kr), a01 = *(const bf16x8*)(kr + 32), a10 = *(const bf16x8*)(kr + 64), a11 = *(const bf16x8*)(kr + 96);
        f32x4 t = (f32x4){0.f, 0.f, 0.f, 0.f};
        t = __builtin_amdgcn_mfma_f32_16x16x32_bf16(a00, bq0[0], t, 0, 0, 0); t = __builtin_amdgcn_mfma_f32_16x16x32_bf16(a01, bq0[1], t, 0, 0, 0);
        t = __builtin_amdgcn_mfma_f32_16x16x32_bf16(a10, bq1[0], t, 0, 0, 0); t = __builtin_amdgcn_mfma_f32_16x16x32_bf16(a11, bq1[1], t, 0, 0, 0);
        acc[kt] = t;
    }
    asm volatile("" ::: "memory"); cv.finish((LAS float*)vs); cv.issue();
    { const int lim = nsel - 4 * g;
#pragma unroll
      for (int kt = 0; kt < 16; ++kt)
#pragma unroll
        for (int r = 0; r < 4; ++r) acc[kt][r] = (16 * kt + r < lim) ? acc[kt][r] : -1e30f; }
    float m = -1e30f;
#pragma unroll
    for (int kt = 0; kt < 16; ++kt) m = fmaxf(m, fmaxf(fmaxf(acc[kt][0], acc[kt][1]), fmaxf(acc[kt][2], acc[kt][3])));
    m = fmaxf(m, __shfl_xor(m, 16)); m = fmaxf(m, __shfl_xor(m, 32));
    float sum = 0.f;
#pragma unroll
    for (int kt = 0; kt < 16; ++kt)
#pragma unroll
        for (int r = 0; r < 4; ++r) { const float pv = __expf(acc[kt][r] - m); acc[kt][r] = pv; sum += pv; }
    sum += __shfl_xor(sum, 16); sum += __shfl_xor(sum, 32);
    const float inv = 1.0f / sum;
    bf16x8 bp[8];
#pragma unroll
    for (int T = 0; T < 8; ++T) { u32x4 w; w.x = cvt_pk_bf16(acc[2 * T][0], acc[2 * T][1]); w.y = cvt_pk_bf16(acc[2 * T][2], acc[2 * T][3]); w.z = cvt_pk_bf16(acc[2 * T + 1][0], acc[2 * T + 1][1]); w.w = cvt_pk_bf16(acc[2 * T + 1][2], acc[2 * T + 1][3]);
        bp[T] = __builtin_bit_cast(bf16x8, w); }
    f32x4 ao0[4], ao1[4];
#pragma unroll
    for (int dt = 0; dt < 4; ++dt) { ao0[dt] = (f32x4){0.f, 0.f, 0.f, 0.f}; ao1[dt] = (f32x4){0.f, 0.f, 0.f, 0.f}; }
    const int q4 = c >> 2, p4 = c & 3;
    u32x4 vst[8];
#define ATT_VLOAD(T) do { _Pragma("unroll") for (int i = 0; i < 8; ++i) { const int row = g + 4 * i; \
        const int key = __shfl(selr[(T) >> 1], 32 * ((T) & 1) + row); vst[i] = *(const u32x4*)(vb + (size_t)key * 128 + 8 * c); } } while (0)
    ATT_VLOAD(0);
#pragma unroll
    for (int T = 0; T < 8; ++T) {
        LAS unsigned char* buf = vs + (T & 1) * (32 * VROW);
        asm volatile("" ::: "memory");
#pragma unroll
        for (int i = 0; i < 8; ++i) *(LAS u32x4*)(buf + (g + 4 * i) * VROW + 16 * c) = vst[i];
        if (T < 7) ATT_VLOAD(T + 1);
#pragma unroll
        for (int n = 0; n < 2; ++n)
#pragma unroll
            for (int dt = 0; dt < 4; ++dt) {
                LAS s16x4* p0 = (LAS s16x4*)(buf + (4 * g + q4) * VROW + (n * 64 + 16 * dt + 4 * p4) * 2);
                const s16x4 lo = __builtin_amdgcn_ds_read_tr16_b64_v4i16(p0), hi = __builtin_amdgcn_ds_read_tr16_b64_v4i16((LAS s16x4*)((LAS unsigned char*)p0 + 16 * VROW));
                const bf16x8 av = (bf16x8){lo[0], lo[1], lo[2], lo[3], hi[0], hi[1], hi[2], hi[3]};
                if (n == 0) ao0[dt] = __builtin_amdgcn_mfma_f32_16x16x32_bf16(av, bp[T], ao0[dt], 0, 0, 0);
                else ao1[dt] = __builtin_amdgcn_mfma_f32_16x16x32_bf16(av, bp[T], ao1[dt], 0, 0, 0);
            }
    }
#undef ATT_VLOAD
    asm volatile("" ::: "memory"); cv.finish((LAS float*)vs);
    if (c < 8) {
        bf16_t* mo = (bf16_t*)(ws + WS_MIX) + (size_t)tk * D + c * 64 + 4 * g;
#pragma unroll
        for (int dt = 0; dt < 4; ++dt) { f32x4 o; o[0] = (c < 4 ? ao0[dt][0] : ao1[dt][0]) * inv; o[1] = (c < 4 ? ao0[dt][1] : ao1[dt][1]) * inv; o[2] = (c < 4 ? ao0[dt][2] : ao1[dt][2]) * inv; o[3] = (c < 4 ? ao0[dt][3] : ao1[dt][3]) * inv; u32x2 w; w.x = cvt_pk_bf16(o[0], o[1]); w.y = cvt_pk_bf16(o[2], o[3]); *(u32x2*)(mo + 16 * dt) = w; }
    }
}

template <bool WITH_Q>
__device__ __forceinline__ void hgrn_fill(const Args& a, Ctx& C, int l, int hh, size_t tok0, LAS float* fz, LAS float* kn, LAS float* qq, LAS float* vv) {
    const int tid = C.tid, sr = tid >> 3, k8 = (tid & 7) * 8; const float* row = (const float*)(C.ws + WS_HG) + (tok0 + sr) * 1024 + hh * 64 + k8;
    const f32x4 z0 = *(const f32x4*)(row + 256), z1 = *(const f32x4*)(row + 260); const float zz[8] = {z0.x, z0.y, z0.z, z0.w, z1.x, z1.y, z1.z, z1.w}; float fo[8], ko[8];
#pragma unroll
    for (int j = 0; j < 8; ++j) { const int kk = hh * 64 + k8 + j; const float lb = (l == 1) ? 1.0f / (1.0f + expf(a.lb_logits[kk] - a.lb_logits[256 + kk])) : 0.f;
        const float sg = 1.0f / (1.0f + expf(-zz[j])), sn = 1.0f / (1.0f + expf(zz[j])); fo[j] = lb + (1.0f - lb) * sg; ko[j] = (1.0f - lb) * sn; }
    *(LAS f32x4*)(fz + sr * 64 + k8) = (f32x4){fo[0], fo[1], fo[2], fo[3]}; *(LAS f32x4*)(fz + sr * 64 + k8 + 4) = (f32x4){fo[4], fo[5], fo[6], fo[7]};
    *(LAS f32x4*)(kn + sr * 64 + k8) = (f32x4){ko[0], ko[1], ko[2], ko[3]}; *(LAS f32x4*)(kn + sr * 64 + k8 + 4) = (f32x4){ko[4], ko[5], ko[6], ko[7]};
    if (WITH_Q) { const f32x4 q0 = *(const f32x4*)row, q1 = *(const f32x4*)(row + 4);
        *(LAS f32x4*)(qq + sr * 64 + k8) = (f32x4){siluf_(q0.x), siluf_(q0.y), siluf_(q0.z), siluf_(q0.w)}; *(LAS f32x4*)(qq + sr * 64 + k8 + 4) = (f32x4){siluf_(q1.x), siluf_(q1.y), siluf_(q1.z), siluf_(q1.w)}; }
    *(LAS f32x4*)(vv + sr * 64 + k8) = *(const f32x4*)(row + 512); *(LAS f32x4*)(vv + sr * 64 + k8 + 4) = *(const f32x4*)(row + 516);
}
__device__ __forceinline__ void hgrn_local2(const Args& a, Ctx& C, int l, int item) {
    const int tid = C.tid, c = item & 63, hh = (item >> 6) & 3, b = item >> 8, v = tid & 63, kq = tid >> 6;
    LAS float* fz = (LAS float*)C.lds; LAS float* kn = fz + 4096; LAS float* vv = kn + 4096;
    hgrn_fill<false>(a, C, l, hh, (size_t)b * SEQ + c * 64, fz, kn, nullptr, vv);
    __syncthreads();
    float S[8] = {0.f, 0.f, 0.f, 0.f, 0.f, 0.f, 0.f, 0.f}, dp[8] = {1.f, 1.f, 1.f, 1.f, 1.f, 1.f, 1.f, 1.f};
#pragma unroll 4
    for (int sx = 0; sx < 64; ++sx) { const f32x4 f0 = *(const LAS f32x4*)(fz + sx * 64 + 8 * kq), f1 = *(const LAS f32x4*)(fz + sx * 64 + 8 * kq + 4), k0 = *(const LAS f32x4*)(kn + sx * 64 + 8 * kq), k1 = *(const LAS f32x4*)(kn + sx * 64 + 8 * kq + 4);
        const float vs = vv[sx * 64 + v]; const float ff[8] = {f0.x, f0.y, f0.z, f0.w, f1.x, f1.y, f1.z, f1.w}, kk[8] = {k0.x, k0.y, k0.z, k0.w, k1.x, k1.y, k1.z, k1.w};
#pragma unroll
        for (int j = 0; j < 8; ++j) { S[j] = ff[j] * S[j] + kk[j] * vs; dp[j] *= ff[j]; } }
    float* hl = (float*)(C.ws + WS_HL) + (size_t)item * 4096 + (8 * kq) * 64 + v;
#pragma unroll
    for (int j = 0; j < 8; ++j) hl[j * 64] = S[j];
    if (v == 0) { float* hd = (float*)(C.ws + WS_HD) + (size_t)item * 64 + 8 * kq;
#pragma unroll
        for (int j = 0; j < 8; ++j) hd[j] = dp[j]; }
    __syncthreads();
}
__device__ __forceinline__ void hgrn_out2(const Args& a, Ctx& C, int l, int item) {
    const int tid = C.tid, cg = item & 15, hh = (item >> 4) & 3, b = item >> 6, c0 = 4 * cg, bh = b * 4 + hh, v = tid & 63, kq = tid >> 6;
    LAS float* fz = (LAS float*)C.lds; LAS float* kn = fz + 4096; LAS float* qq = kn + 4096; LAS float* vv = qq + 4096; LAS float* part = vv + 4096;
    const float* HLb = (const float*)(C.ws + WS_HL) + (size_t)bh * 64 * 4096 + (8 * kq) * 64 + v; const float* HDb = (const float*)(C.ws + WS_HD) + (size_t)bh * 64 * 64 + 8 * kq;
    float S[8] = {0.f, 0.f, 0.f, 0.f, 0.f, 0.f, 0.f, 0.f};
#pragma unroll 2
    for (int j = 0; j < c0; ++j) { const f32x4 d0 = *(const f32x4*)(HDb + (size_t)j * 64), d1 = *(const f32x4*)(HDb + (size_t)j * 64 + 4); const float dd[8] = {d0.x, d0.y, d0.z, d0.w, d1.x, d1.y, d1.z, d1.w};
#pragma unroll
        for (int i = 0; i < 8; ++i) S[i] = dd[i] * S[i] + HLb[(size_t)j * 4096 + i * 64]; }
#pragma unroll 1
    for (int c = c0; c < c0 + 4; ++c) {
        const size_t tok0 = (size_t)b * SEQ + c * 64;
        hgrn_fill<true>(a, C, l, hh, tok0, fz, kn, qq, vv);
        __syncthreads();
#pragma unroll 1
        for (int half = 0; half < 2; ++half) {
#pragma unroll 4
            for (int sl = 0; sl < 32; ++sl) { const int sx = 32 * half + sl;
                const f32x4 f0 = *(const LAS f32x4*)(fz + sx * 64 + 8 * kq), f1 = *(const LAS f32x4*)(fz + sx * 64 + 8 * kq + 4), k0 = *(const LAS f32x4*)(kn + sx * 64 + 8 * kq), k1 = *(const LAS f32x4*)(kn + sx * 64 + 8 * kq + 4);
                const f32x4 q0 = *(const LAS f32x4*)(qq + sx * 64 + 8 * kq), q1 = *(const LAS f32x4*)(qq + sx * 64 + 8 * kq + 4);
                const float vs = vv[sx * 64 + v]; const float ff[8] = {f0.x, f0.y, f0.z, f0.w, f1.x, f1.y, f1.z, f1.w}, kk[8] = {k0.x, k0.y, k0.z, k0.w, k1.x, k1.y, k1.z, k1.w}, qv[8] = {q0.x, q0.y, q0.z, q0.w, q1.x, q1.y, q1.z, q1.w};
                float op = 0.f;
#pragma unroll
                for (int j = 0; j < 8; ++j) { S[j] = ff[j] * S[j] + kk[j] * vs; op += qv[j] * S[j]; }
                part[(kq * 32 + sl) * 64 + v] = op; }
            __syncthreads();
            { const int t = tid >> 4, v4 = (tid & 15) * 4; f32x4 o = (f32x4){0.f, 0.f, 0.f, 0.f};
#pragma unroll
                for (int kk2 = 0; kk2 < 8; ++kk2) o += *(const LAS f32x4*)(part + (kk2 * 32 + t) * 64 + v4);
                float ss = o.x * o.x + o.y * o.y + o.z * o.z + o.w * o.w;
                ss += __shfl_xor(ss, 1); ss += __shfl_xor(ss, 2); ss += __shfl_xor(ss, 4); ss += __shfl_xor(ss, 8);
                const float rstd = 1.0f / sqrtf(ss * (1.0f / 64.0f) + EPS);
                const size_t tok = tok0 + 32 * half + t;
                const f32x4 gg = *(const f32x4*)((const float*)(C.ws + WS_HG) + tok * 1024 + 768 + hh * 64 + v4), ng = *(const f32x4*)(a.hgrn_g + l * 64 + v4);
                const float y0 = o.x * rstd * ng.x * siluf_(gg.x), y1 = o.y * rstd * ng.y * siluf_(gg.y), y2 = o.z * rstd * ng.z * siluf_(gg.z), y3 = o.w * rstd * ng.w * siluf_(gg.w);
                u32x2 wv; wv.x = pk2(y0, y1); wv.y = pk2(y2, y3);
                *(u32x2*)((bf16_t*)(C.ws + WS_MIX) + tok * D + 768 + hh * 64 + v4) = wv; }
            __syncthreads();
        }
    }
}

__device__ __forceinline__ void pool_wave(const Args& a, Ctx& C, int l) {
    unsigned char* ws = C.ws; const int lane = C.lane;
    const int gwv = blockIdx.x * NWAVES + C.wave, g = gwv & 3, widx = gwv >> 2, nw = (C.G * NWAVES) >> 2, w = 2 << g;
    float pwr[64];
#pragma unroll
    for (int c = 0; c < 64; ++c) pwr[c] = a.pool_w[(size_t)(l * 4 + g) * 4096 + c * 64 + lane];
    const float psc = a.pool_scale[l * 256 + g * 64 + lane];
    const float* ubg = (const float*)(ws + WS_UB) + g * 64 + lane;
    for (int tile = widx; tile < NTOK / 8; tile += nw) {
        const int tok0 = tile * 8, tp0 = tok0 & (SEQ - 1);
        float row[23];
#pragma unroll
        for (int r = 0; r < 23; ++r) { const int tp = tp0 - 15 + r; row[r] = (tp >= 0) ? ubg[(size_t)(tok0 - 15 + r) * 256] : 0.f; }
        float pooled[8];
#pragma unroll
        for (int t = 0; t < 8; ++t) {
            float sm = 0.f;
#pragma unroll
            for (int i = 0; i < 16; ++i) if (i < w) sm += row[15 + t - i];
            const int tpos = tp0 + t; const int wl = (tpos + 1) < w ? (tpos + 1) : w;
            pooled[t] = sm * (1.0f / (float)wl) - row[15 + t];
        }
        float y[8] = {0.f, 0.f, 0.f, 0.f, 0.f, 0.f, 0.f, 0.f};
#pragma unroll
        for (int c = 0; c < 64; ++c) {
#pragma unroll
            for (int t = 0; t < 8; ++t) y[t] += __builtin_bit_cast(float, __builtin_amdgcn_readlane(__builtin_bit_cast(int, pooled[t]), c)) * pwr[c];
        }
        bf16_t* mo = (bf16_t*)(ws + WS_MIX) + (size_t)tok0 * D + 512 + g * 64 + lane;
#pragma unroll
        for (int t = 0; t < 8; ++t) mo[(size_t)t * D] = (bf16_t)f2bf(y[t] * psc);
    }
}

__device__ __forceinline__ float row_shr_add(float x, int) { return x; }
template <int N> __device__ __forceinline__ float dpp_row_shr(float x) { return __builtin_bit_cast(float, __builtin_amdgcn_update_dpp(0, __builtin_bit_cast(int, x), 0x110 + N, 0xF, 0xF, true)); }
__device__ __forceinline__ float row_scan16(float x) { x += dpp_row_shr<1>(x); x += dpp_row_shr<2>(x); x += dpp_row_shr<4>(x); x += dpp_row_shr<8>(x); return x; }
__device__ __forceinline__ float row_last16(float x) { return __builtin_bit_cast(float, __builtin_amdgcn_update_dpp(0, __builtin_bit_cast(int, x), 0x15F, 0xF, 0xF, true)); }
__device__ __forceinline__ float row_sum16(float v) {
    v += __builtin_bit_cast(float, __builtin_amdgcn_update_dpp(0, __builtin_bit_cast(int, v), 0xB1, 0xF, 0xF, true));
    v += __builtin_bit_cast(float, __builtin_amdgcn_update_dpp(0, __builtin_bit_cast(int, v), 0x4E, 0xF, 0xF, true));
    v += __builtin_bit_cast(float, __builtin_amdgcn_update_dpp(0, __builtin_bit_cast(int, v), 0x141, 0xF, 0xF, true));
    v += __builtin_bit_cast(float, __builtin_amdgcn_update_dpp(0, __builtin_bit_cast(int, v), 0x140, 0xF, 0xF, true));
    return v;
}
__device__ __forceinline__ void hgrn_out3(const Args& a, Ctx& C, int l, int item, LAS unsigned char* kls) {
    const int lane = C.lane, tt = lane & 15, g = lane >> 4, c = item & 63, hh = (item >> 6) & 3, b = item >> 8, bh = b * 4 + hh, cg = c >> 2, ci = c & 3;
    const float* HG = (const float*)(C.ws + WS_HG); const float* HR = (const float*)(C.ws + WS_HL); const float* HE = (const float*)(C.ws + WS_HD);
    float lb[16];
#pragma unroll
    for (int e = 0; e < 16; ++e) { const int kk = hh * 64 + 16 * (e >> 2) + 4 * g + (e & 3); lb[e] = (l == 1) ? 1.0f / (1.0f + expf(a.lb_logits[kk] - a.lb_logits[256 + kk])) : 0.f; }
    f32x4 S[4][4];
#pragma unroll
    for (int vq = 0; vq < 4; ++vq)
#pragma unroll
        for (int kt = 0; kt < 4; ++kt) S[vq][kt] = (f32x4){0.f, 0.f, 0.f, 0.f};
    const int nstep = cg + (ci > 0 ? 1 : 0);
#pragma unroll 1
    for (int st = 0; st < nstep; ++st) {
        const int chn = (st < cg) ? (4 * st + 3) : (4 * cg + ci - 1); const size_t ch = (size_t)(bh * 64 + chn);
        const float* hr = HR + ch * 4096 + (g * 16 + tt) * 4; const float* he = HE + ch * 64 + 4 * g;
        f32x4 ev[4];
#pragma unroll
        for (int kt = 0; kt < 4; ++kt) ev[kt] = *(const f32x4*)(he + 16 * kt);
#pragma unroll
        for (int vq = 0; vq < 4; ++vq)
#pragma unroll
            for (int kt = 0; kt < 4; ++kt) S[vq][kt] = S[vq][kt] * ev[kt] + *(const f32x4*)(hr + (vq * 4 + kt) * 256);
    }
    const size_t tok0 = (size_t)b * SEQ + c * 64;
#pragma unroll 1
    for (int sb = 0; sb < 4; ++sb) {
        const size_t tok = tok0 + 16 * sb + tt; const float* row = HG + tok * 1024 + hh * 64 + 4 * g;
        float qh[16], kt_[16], kp[16], dd[16];
#pragma unroll
        for (int e4 = 0; e4 < 4; ++e4) {
            const f32x4 q4 = *(const f32x4*)(row + 16 * e4), z4 = *(const f32x4*)(row + 256 + 16 * e4);
#pragma unroll
            for (int j = 0; j < 4; ++j) { const int e = 4 * e4 + j; const float lbe = lb[e];
                const float sg = __builtin_amdgcn_rcpf(1.0f + __expf(-z4[j])), sn = __builtin_amdgcn_rcpf(1.0f + __expf(z4[j]));
                const float lf = __logf(lbe + (1.0f - lbe) * sg), kin = (1.0f - lbe) * sn;
                const float cc = row_scan16(lf), c15 = row_last16(cc);
                qh[e] = siluf_(q4[j]) * __expf(cc); kt_[e] = kin * __expf(fminf(-cc, 80.0f)); kp[e] = kin * __expf(c15 - cc); dd[e] = __expf(c15); }
        }
        bf16x8 Qf[2], Kf[2];
#pragma unroll
        for (int ks = 0; ks < 2; ++ks) { u32x4 wq, wk;
            wq.x = pk2(qh[8 * ks + 0], qh[8 * ks + 1]); wq.y = pk2(qh[8 * ks + 2], qh[8 * ks + 3]); wq.z = pk2(qh[8 * ks + 4], qh[8 * ks + 5]); wq.w = pk2(qh[8 * ks + 6], qh[8 * ks + 7]);
            wk.x = pk2(kt_[8 * ks + 0], kt_[8 * ks + 1]); wk.y = pk2(kt_[8 * ks + 2], kt_[8 * ks + 3]); wk.z = pk2(kt_[8 * ks + 4], kt_[8 * ks + 5]); wk.w = pk2(kt_[8 * ks + 6], kt_[8 * ks + 7]);
            Qf[ks] = __builtin_bit_cast(bf16x8, wq); Kf[ks] = __builtin_bit_cast(bf16x8, wk); }
#pragma unroll
        for (int e4 = 0; e4 < 4; ++e4) { u32x2 w; w.x = pk2(kp[4 * e4 + 0], kp[4 * e4 + 1]); w.y = pk2(kp[4 * e4 + 2], kp[4 * e4 + 3]); *(LAS u32x2*)(kls + tt * 144 + (16 * e4 + 4 * g) * 2) = w; }
        f32x4 at = (f32x4){0.f, 0.f, 0.f, 0.f};
        at = __builtin_amdgcn_mfma_f32_16x16x32_bf16(Kf[0], Qf[0], at, 0, 0, 0); at = __builtin_amdgcn_mfma_f32_16x16x32_bf16(Kf[1], Qf[1], at, 0, 0, 0);
#pragma unroll
        for (int r = 0; r < 4; ++r) at[r] = (4 * g + r <= tt) ? at[r] : 0.f;
        u32x4 wa; wa.x = pk2(at[0], at[1]); wa.y = pk2(at[2], at[3]); wa.z = 0u; wa.w = 0u; const bf16x8 Af = __builtin_bit_cast(bf16x8, wa);
        bf16x8 Vf[4];
        { const float* vp = HG + (tok0 + 16 * sb + 4 * g) * 1024 + 512 + hh * 64 + tt;
#pragma unroll
          for (int vq = 0; vq < 4; ++vq) { u32x4 w; w.x = pk2(vp[16 * vq], vp[1024 + 16 * vq]); w.y = pk2(vp[2048 + 16 * vq], vp[3072 + 16 * vq]); w.z = 0u; w.w = 0u; Vf[vq] = __builtin_bit_cast(bf16x8, w); } }
        f32x4 O[4];
#pragma unroll
        for (int vq = 0; vq < 4; ++vq) {
            u32x4 s0, s1; s0.x = pk2(S[vq][0][0], S[vq][0][1]); s0.y = pk2(S[vq][0][2], S[vq][0][3]); s0.z = pk2(S[vq][1][0], S[vq][1][1]); s0.w = pk2(S[vq][1][2], S[vq][1][3]);
            s1.x = pk2(S[vq][2][0], S[vq][2][1]); s1.y = pk2(S[vq][2][2], S[vq][2][3]); s1.z = pk2(S[vq][3][0], S[vq][3][1]); s1.w = pk2(S[vq][3][2], S[vq][3][3]);
            f32x4 o = (f32x4){0.f, 0.f, 0.f, 0.f};
            o = __builtin_amdgcn_mfma_f32_16x16x32_bf16(Qf[0], __builtin_bit_cast(bf16x8, s0), o, 0, 0, 0); o = __builtin_amdgcn_mfma_f32_16x16x32_bf16(Qf[1], __builtin_bit_cast(bf16x8, s1), o, 0, 0, 0);
            o = __builtin_amdgcn_mfma_f32_16x16x32_bf16(Af, Vf[vq], o, 0, 0, 0); O[vq] = o; }
        { float rs[4];
#pragma unroll
          for (int r = 0; r < 4; ++r) { float ss = O[0][r] * O[0][r] + O[1][r] * O[1][r] + O[2][r] * O[2][r] + O[3][r] * O[3][r]; ss = row_sum16(ss); rs[r] = 1.0f / sqrtf(ss * (1.0f / 64.0f) + EPS); }
          const float* gp = HG + (tok0 + 16 * sb + 4 * g) * 1024 + 768 + hh * 64 + tt; bf16_t* mo = (bf16_t*)(C.ws + WS_MIX) + (tok0 + 16 * sb + 4 * g) * D + 768 + hh * 64 + tt;
#pragma unroll
          for (int vq = 0; vq < 4; ++vq) { const float ngv = a.hgrn_g[l * 64 + 16 * vq + tt];
#pragma unroll
            for (int r = 0; r < 4; ++r) mo[(size_t)r * D + 16 * vq] = (bf16_t)f2bf(O[vq][r] * rs[r] * ngv * siluf_(gp[(size_t)r * 1024 + 16 * vq])); } }
        asm volatile("s_waitcnt lgkmcnt(0)" ::: "memory");
#pragma unroll
        for (int kt = 0; kt < 4; ++kt) {
            const s16x4 t4 = __builtin_amdgcn_ds_read_tr16_b64_v4i16((LAS s16x4*)(kls + (4 * g + (tt >> 2)) * 144 + (16 * kt + 4 * (tt & 3)) * 2));
            const bf16x8 Ktf = (bf16x8){t4[0], t4[1], t4[2], t4[3], 0, 0, 0, 0};
            const f32x4 dv = (f32x4){dd[4 * kt + 0], dd[4 * kt + 1], dd[4 * kt + 2], dd[4 * kt + 3]};
#pragma unroll
            for (int vq = 0; vq < 4; ++vq) S[vq][kt] = __builtin_amdgcn_mfma_f32_16x16x32_bf16(Ktf, Vf[vq], S[vq][kt] * dv, 0, 0, 0);
        }
        asm volatile("s_waitcnt lgkmcnt(0)" ::: "memory");
    }
}

__device__ __forceinline__ void hgrn_local4(const Args& a, Ctx& C, int l, int item, LAS unsigned char* kls) {
    const int lane = C.lane, tt = lane & 15, g = lane >> 4, vq = item & 3, cg = (item >> 2) & 15, hh = (item >> 6) & 3, b = item >> 8, bh = b * 4 + hh;
    const float* HG = (const float*)(C.ws + WS_HG);
    float lb[16], ecum[16];
#pragma unroll
    for (int e = 0; e < 16; ++e) { const int kk = hh * 64 + 16 * (e >> 2) + 4 * g + (e & 3); lb[e] = (l == 1) ? 1.0f / (1.0f + expf(a.lb_logits[kk] - a.lb_logits[256 + kk])) : 0.f; ecum[e] = 1.0f; }
    f32x4 S[4];
#pragma unroll
    for (int kt = 0; kt < 4; ++kt) S[kt] = (f32x4){0.f, 0.f, 0.f, 0.f};
    const size_t tokg = (size_t)b * SEQ + (size_t)cg * 256;
    f32x4 zc[4]; float vc[4];
#define HL4_LOAD(zd, vd, sbi) do { const size_t _t0 = tokg + 16 * (sbi); const float* _r = HG + (_t0 + tt) * 1024 + hh * 64 + 4 * g + 256; \
        _Pragma("unroll") for (int e4 = 0; e4 < 4; ++e4) zd[e4] = *(const f32x4*)(_r + 16 * e4); \
        const float* _v = HG + (_t0 + 4 * g) * 1024 + 512 + hh * 64 + 16 * vq + tt; vd[0] = _v[0]; vd[1] = _v[1024]; vd[2] = _v[2048]; vd[3] = _v[3072]; } while (0)
    HL4_LOAD(zc, vc, 0);
#pragma unroll 1
    for (int ci = 0; ci < 4; ++ci) {
        const int c = 4 * cg + ci;
#pragma unroll 1
        for (int sb = 0; sb < 4; ++sb) {
            const int sbi = 4 * ci + sb; f32x4 zn[4]; float vn[4];
            if (sbi < 15) HL4_LOAD(zn, vn, sbi + 1); else {
#pragma unroll
                for (int e4 = 0; e4 < 4; ++e4) { zn[e4] = zc[e4]; vn[e4] = vc[e4]; } }
            float kp[16], dd[16];
#pragma unroll
            for (int e4 = 0; e4 < 4; ++e4) { const f32x4 z4 = zc[e4];
#pragma unroll
                for (int j = 0; j < 4; ++j) { const int e = 4 * e4 + j; const float lbe = lb[e];
                    const float sg = __builtin_amdgcn_rcpf(1.0f + __expf(-z4[j])), sn = __builtin_amdgcn_rcpf(1.0f + __expf(z4[j]));
                    const float lf = __logf(lbe + (1.0f - lbe) * sg), kin = (1.0f - lbe) * sn;
                    const float cc = row_scan16(lf), c15 = row_last16(cc);
                    kp[e] = kin * __expf(c15 - cc); dd[e] = __expf(c15); ecum[e] *= dd[e]; } }
#pragma unroll
            for (int e4 = 0; e4 < 4; ++e4) { u32x2 w; w.x = pk2(kp[4 * e4 + 0], kp[4 * e4 + 1]); w.y = pk2(kp[4 * e4 + 2], kp[4 * e4 + 3]); *(LAS u32x2*)(kls + tt * 144 + (16 * e4 + 4 * g) * 2) = w; }
            bf16x8 Vf; { u32x4 w; w.x = pk2(vc[0], vc[1]); w.y = pk2(vc[2], vc[3]); w.z = 0u; w.w = 0u; Vf = __builtin_bit_cast(bf16x8, w); }
            asm volatile("s_waitcnt lgkmcnt(0)" ::: "memory");
#pragma unroll
            for (int kt = 0; kt < 4; ++kt) {
                const s16x4 t4 = __builtin_amdgcn_ds_read_tr16_b64_v4i16((LAS s16x4*)(kls + (4 * g + (tt >> 2)) * 144 + (16 * kt + 4 * (tt & 3)) * 2));
                const bf16x8 Ktf = (bf16x8){t4[0], t4[1], t4[2], t4[3], 0, 0, 0, 0};
                const f32x4 dv = (f32x4){dd[4 * kt + 0], dd[4 * kt + 1], dd[4 * kt + 2], dd[4 * kt + 3]};
                S[kt] = __builtin_amdgcn_mfma_f32_16x16x32_bf16(Ktf, Vf, S[kt] * dv, 0, 0, 0);
            }
            asm volatile("s_waitcnt lgkmcnt(0)" ::: "memory");
#pragma unroll
            for (int e4 = 0; e4 < 4; ++e4) { zc[e4] = zn[e4]; vc[e4] = vn[e4]; }
        }
        const size_t ch = (size_t)(bh * 64 + c);
        float* hr = (float*)(C.ws + WS_HL) + ch * 4096 + (g * 16 + tt) * 4;
#pragma unroll
        for (int kt = 0; kt < 4; ++kt) *(f32x4*)(hr + (vq * 4 + kt) * 256) = S[kt];
        if (vq == 0 && tt == 0) { float* he = (float*)(C.ws + WS_HD) + ch * 64 + 4 * g;
#pragma unroll
            for (int kt = 0; kt < 4; ++kt) *(f32x4*)(he + 16 * kt) = (f32x4){ecum[4 * kt + 0], ecum[4 * kt + 1], ecum[4 * kt + 2], ecum[4 * kt + 3]}; }
    }
#undef HL4_LOAD
}

__device__ __forceinline__ void phase_mix1(const Args& a, Ctx& C, int l) {
#ifndef MIX1MASK
#define MIX1MASK 7
#endif
#ifndef MIX1REP
#define MIX1REP 0
#endif
#ifndef HGRN3
#define HGRN3 1
#endif
#ifndef HGRN4
#define HGRN4 1
#endif
    if (HGRN3) { if (C.wave < 4) for (int it = blockIdx.x * 4 + C.wave; it < 1024; it += C.G * 4) hgrn_local4(a, C, l, it, C.lds + C.wave * 4096); __syncthreads(); }
    else for (int rep = 0; rep < ((MIX1REP & 1) && l == 0 ? 2 : 1); ++rep) for (int it = blockIdx.x; it < 1024; it += C.G) hgrn_local2(a, C, l, it);
    for (int rep = 0; rep < ((MIX1REP & 2) && l == 0 ? 2 : 1); ++rep) pool_wave(a, C, l);
    __syncthreads();
    Conv cv; cv.w1l = a.w1 + (size_t)l * 32 * 1024 * 2048; cv.w2l = a.w2 + (size_t)l * 32 * 1024 * 1024; cv.w1t = (bf16_t*)(C.ws + WS_W1) + (size_t)l * 32 * 2048 * 1024; cv.w2t = (bf16_t*)(C.ws + WS_W2) + (size_t)l * 32 * 1024 * 1024;
    cv.it = blockIdx.x * NWAVES + C.wave; cv.step = C.G * NWAVES; cv.lane = C.lane; cv.pend = false; cv.it_end = CONV_SPLIT;
    for (int rep = 0; rep < ((MIX1REP & 4) && l == 0 ? 2 : 1); ++rep) for (int base = 0; base < 2048; base += 2 * C.G) {
        const int u1 = base + (int)blockIdx.x, u2 = base + 2 * C.G - 1 - (int)blockIdx.x;
        if (u1 < 2048) index_unit2(C, (u1 >> 3) & 3, u1 >> 5, u1 & 7, cv);
        if (u2 < 2048) index_unit2(C, (u2 >> 3) & 3, u2 >> 5, u2 & 7, cv);
    }
    for (;;) { cv.issue(); if (!cv.pend) break; cv.finish((LAS float*)(C.lds + 65536 + C.wave * KST_BYTES)); }
}
__device__ __forceinline__ void phase_mix2(const Args& a, Ctx& C, int l) {
#ifndef MIX2MASK
#define MIX2MASK 3
#endif
#ifndef MIX2REP
#define MIX2REP 0
#endif
    LAS int* qctr = (LAS int*)(C.lds + LDS_BYTES - 64 + 16);
    if (C.tid == 0) *qctr = 0;
    __syncthreads();
    if (HGRN3) { for (int rep = 0; rep < ((MIX2REP & 1) ? 2 : 1); ++rep) if (C.wave < 4) for (int it = blockIdx.x * 4 + C.wave; it < 1024; it += C.G * 4) hgrn_out3(a, C, l, it, C.lds + C.wave * (2 * 32 * VROW)); }
    else for (int rep = 0; rep < ((MIX2REP & 1) ? 2 : 1); ++rep) for (int it = blockIdx.x; it < 256; it += C.G) hgrn_out2(a, C, l, it);
    LAS unsigned char* vs = C.lds + C.wave * (2 * 32 * VROW);
    const int gw = blockIdx.x * NWAVES + C.wave, NGW = C.G * NWAVES;
    Conv cv; cv.w1l = a.w1 + (size_t)l * 32 * 1024 * 2048; cv.w2l = a.w2 + (size_t)l * 32 * 1024 * 1024; cv.w1t = (bf16_t*)(C.ws + WS_W1) + (size_t)l * 32 * 2048 * 1024; cv.w2t = (bf16_t*)(C.ws + WS_W2) + (size_t)l * 32 * 1024 * 1024;
    cv.it = CONV_SPLIT + gw; cv.step = NGW; cv.lane = C.lane; cv.pend = false; cv.it_end = Conv::NITEMS;
    for (;;) {
        int n = 0; if (C.lane == 0) n = __hip_atomic_fetch_add(qctr, 1, __ATOMIC_RELAXED, __HIP_MEMORY_SCOPE_WORKGROUP);
        n = __builtin_amdgcn_readfirstlane(n);
        const int tk = (int)blockIdx.x * NWAVES + (n & 7) + NGW * (n >> 3);
        if (tk >= NTOK) break;
        attend_query_mfma(C, tk, vs, cv);
    }
    for (;;) { cv.finish((LAS float*)vs); cv.issue(); if (!cv.pend) break; }
}

constexpr int URS = 2064;
__device__ __forceinline__ void phase_router2(const Args& a, Ctx& C, int l) {
    unsigned char* ws = C.ws; const int lane = C.lane, w = C.wave, tid = C.tid;
    LAS unsigned char* uh = C.lds; LAS unsigned char* ul = uh + 16 * URS; LAS float* part = (LAS float*)(ul + 16 * URS);
    LAS int* hist = (LAS int*)(part + 8 * 16 * 32);
    LAS int* asg = hist + 64;
    LAS float* asgg = (LAS float*)(asg + 2 * 1024);
    const float* mod = (const float*)(ws + WS_MOD); const float* H = (const float*)(ws + WS_H);
    const bf16_t* wrh = (const bf16_t*)(ws + WS_WRH) + (size_t)l * 32768; const bf16_t* wrl = (const bf16_t*)(ws + WS_WRL) + (size_t)l * 32768;
    unsigned* cnt = (unsigned*)(ws + WS_CTL) + CW_CNT + l * 32 * 64;
    const int ntile_all = NTOK / 16;
    for (int tile0 = blockIdx.x; tile0 < ntile_all; tile0 += 16 * C.G) {
        if (tid < 64) hist[tid] = 0;
        __syncthreads();
        int nt_here = 0;
        f32x4 hv[2][4];
#pragma unroll
        for (int hf = 0; hf < 2; ++hf) { const f32x4* hr = (const f32x4*)(H + (size_t)(tile0 * 16 + 2 * w + hf) * D) + lane;
#pragma unroll
            for (int j = 0; j < 4; ++j) hv[hf][j] = hr[64 * j]; }
        for (int tile = tile0; tile < ntile_all && nt_here < 16; tile += C.G, ++nt_here) {
            const int tok0 = tile * 16;
#pragma unroll
            for (int hf = 0; hf < 2; ++hf) {
                const int tr = 2 * w + hf, tk = tok0 + tr, b = tk >> 12; f32x4 v[4];
#pragma unroll
                for (int j = 0; j < 4; ++j) v[j] = hv[hf][j];
                float ss = 0.f;
#pragma unroll
                for (int j = 0; j < 4; ++j) ss += (v[j].x * v[j].x + v[j].y * v[j].y) + (v[j].z * v[j].z + v[j].w * v[j].w);
                const float rstd = 1.0f / sqrtf(wave_sum(ss) * (1.0f / D) + EPS);
                const float* mb = mod + (size_t)(l * 4 + b) * 6144; bf16_t* urow = (bf16_t*)(ws + WS_U) + (size_t)tk * D;
#pragma unroll
                for (int j = 0; j < 4; ++j) { const int idx = 4 * lane + 256 * j; const f32x4 gv = *(const f32x4*)(a.norm2_g + l * 1024 + idx), shv = *(const f32x4*)(mb + 3072 + idx), scv = *(const f32x4*)(mb + 4096 + idx);
                    const f32x4 o = v[j] * rstd * gv * (scv + 1.0f) + shv; u32x2 hi; hi.x = pk2(o[0], o[1]); hi.y = pk2(o[2], o[3]); *(u32x2*)(urow + idx) = hi;
                    u32x2 lo; lo.x = pk2(o[0] - bflo(hi.x), o[1] - bfhi(hi.x)); lo.y = pk2(o[2] - bflo(hi.y), o[3] - bfhi(hi.y));
                    *(LAS u32x2*)(uh + tr * URS + idx * 2) = hi; *(LAS u32x2*)(ul + tr * URS + idx * 2) = lo; }
            }
            { const int ntile2 = tile + C.G; if (ntile2 < ntile_all && nt_here + 1 < 16) {
#pragma unroll
                for (int hf = 0; hf < 2; ++hf) { const f32x4* hr = (const f32x4*)(H + (size_t)(ntile2 * 16 + 2 * w + hf) * D) + lane;
#pragma unroll
                    for (int j = 0; j < 4; ++j) hv[hf][j] = hr[64 * j]; } } }
            __syncthreads();
            {
                const int c = lane & 15, g = lane >> 4; f32x4 acc0 = (f32x4){0.f, 0.f, 0.f, 0.f}, acc1 = acc0;
#pragma unroll
                for (int kk = 0; kk < 4; ++kk) { const int ks = 4 * w + kk;
                    const bf16x8 ah = *(const LAS bf16x8*)(uh + c * URS + (32 * ks + 8 * g) * 2), al = *(const LAS bf16x8*)(ul + c * URS + (32 * ks + 8 * g) * 2);
                    const bf16x8 bh0 = *(const bf16x8*)(wrh + (size_t)c * 1024 + 32 * ks + 8 * g), bl0 = *(const bf16x8*)(wrl + (size_t)c * 1024 + 32 * ks + 8 * g);
                    const bf16x8 bh1 = *(const bf16x8*)(wrh + (size_t)(c + 16) * 1024 + 32 * ks + 8 * g), bl1 = *(const bf16x8*)(wrl + (size_t)(c + 16) * 1024 + 32 * ks + 8 * g);
                    acc0 = __builtin_amdgcn_mfma_f32_16x16x32_bf16(al, bh0, acc0, 0, 0, 0); acc0 = __builtin_amdgcn_mfma_f32_16x16x32_bf16(ah, bl0, acc0, 0, 0, 0); acc0 = __builtin_amdgcn_mfma_f32_16x16x32_bf16(ah, bh0, acc0, 0, 0, 0);
                    acc1 = __builtin_amdgcn_mfma_f32_16x16x32_bf16(al, bh1, acc1, 0, 0, 0); acc1 = __builtin_amdgcn_mfma_f32_16x16x32_bf16(ah, bl1, acc1, 0, 0, 0); acc1 = __builtin_amdgcn_mfma_f32_16x16x32_bf16(ah, bh1, acc1, 0, 0, 0); }
#pragma unroll
                for (int r = 0; r < 4; ++r) { part[(w * 16 + 4 * g + r) * 32 + c] = acc0[r]; part[(w * 16 + 4 * g + r) * 32 + 16 + c] = acc1[r]; }
            }
            __syncthreads();
            {
                const int e = lane & 31, hf = lane >> 5, tr = 2 * w + hf; float val = a.b_router[l * 32 + e];
#pragma unroll
                for (int ww = 0; ww < 8; ++ww) val += part[(ww * 16 + tr) * 32 + e];
                float tv[4]; int te[4];
#pragma unroll
                for (int k = 0; k < 4; ++k) {
                    float bv = val; int bi = e;
#pragma unroll
                    for (int o = 1; o < 32; o <<= 1) { const float ov = __shfl_xor(bv, o); const int oi = __shfl_xor(bi, o); if (ov > bv || (ov == bv && oi < bi)) { bv = ov; bi = oi; } }
                    tv[k] = bv; te[k] = bi; if (e == bi) val = -3.0e38f;
                }
                const float e1 = __expf(tv[1] - tv[0]), e2 = __expf(tv[2] - tv[0]), e3 = __expf(tv[3] - tv[0]); const float rs = 1.0f / (1.0f + e1 + e2 + e3);
                if (e < 4) {
                    const int ex = e == 0 ? te[0] : e == 1 ? te[1] : e == 2 ? te[2] : te[3]; const float gt = (e == 0 ? 1.0f : e == 1 ? e1 : e == 2 ? e2 : e3) * rs;
                    const int ai = (nt_here * 16 + tr) * 4 + e;
                    asg[2 * ai] = ex; asg[2 * ai + 1] = __hip_atomic_fetch_add(&hist[ex], 1, __ATOMIC_RELAXED, __HIP_MEMORY_SCOPE_WORKGROUP); asgg[ai] = gt;
                }
            }
            __syncthreads();
        }
        if (tid < 32) { const int hc = hist[tid]; hist[32 + tid] = hc ? (int)atomicAdd(cnt + tid * 64, (unsigned)hc) : 0; }
        __syncthreads();
        for (int ai = tid; ai < nt_here * 64; ai += NTHREADS) {
            const int ti = ai >> 6, tr = (ai >> 2) & 15, k = ai & 3, tk = (tile0 + ti * C.G) * 16 + tr;
            const int ex = asg[2 * ai], slot = hist[32 + ex] + asg[2 * ai + 1];
            ((int*)(ws + WS_ROWTOK))[(size_t)ex * NTOK + slot] = tk;
            ((int*)(ws + WS_EIDX))[tk * 4 + k] = ex; ((int*)(ws + WS_SLOT))[tk * 4 + k] = slot; ((float*)(ws + WS_GATE))[tk * 4 + k] = asgg[ai];
        }
        __syncthreads();
    }
}

__device__ __forceinline__ void moe_table(Ctx& C, int l, LAS int* tab) {
    if (C.tid < 32) { const unsigned* cnt = (const unsigned*)(C.ws + WS_CTL) + CW_CNT + l * 32 * 64; tab[33 + C.tid] = (int)__hip_atomic_load(cnt + C.tid * 64, __ATOMIC_RELAXED, __HIP_MEMORY_SCOPE_AGENT); }
    __syncthreads();
    if (C.tid == 0) { int p = 0; for (int e = 0; e < 32; ++e) { tab[e] = p; p += (tab[33 + e] + 255) >> 8; } tab[32] = p; }
    __syncthreads();
}

__device__ __forceinline__ void phase_combine(const Args& a, Ctx& C, int l) {
    unsigned char* ws = C.ws; const int lane = C.lane;
    const float* mod = (const float*)(ws + WS_MOD); float* H = (float*)(ws + WS_H); const bf16_t* Y = (const bf16_t*)(ws + WS_Y);
    const unsigned* cnt = (const unsigned*)(ws + WS_CTL) + CW_CNT + l * 32 * 64;
    int mt = 0; if (lane < 32) mt = ((int)__hip_atomic_load(cnt + lane * 64, __ATOMIC_RELAXED, __HIP_MEMORY_SCOPE_AGENT) + 255) >> 8;
    int incl = mt;
#pragma unroll
    for (int o = 1; o < 32; o <<= 1) { const int t = __shfl_up(incl, o); if ((lane & 31) >= o) incl += t; }
    const int excl = incl - mt;
    const int gw = blockIdx.x * NWAVES + C.wave, NGW = C.G * NWAVES;
    for (int tk0 = gw; tk0 < NTOK; tk0 += 2 * NGW) {
        int tks[2]; tks[0] = tk0; tks[1] = (tk0 + NGW) < NTOK ? tk0 + NGW : tk0; const bool two = (tk0 + NGW) < NTOK;
        f32x4 v[2][4]; u32x2 yv[2][4][4]; float gts[2][4];
#pragma unroll
        for (int q = 0; q < 2; ++q) { const int tk = tks[q]; const f32x4* hr = (const f32x4*)(H + (size_t)tk * D) + lane;
#pragma unroll
            for (int j = 0; j < 4; ++j) v[q][j] = hr[64 * j];
            const int4 ex4 = *(const int4*)((const int*)(ws + WS_EIDX) + tk * 4), sl4 = *(const int4*)((const int*)(ws + WS_SLOT) + tk * 4); const f32x4 g4 = *(const f32x4*)((const float*)(ws + WS_GATE) + tk * 4);
            const int exs[4] = {ex4.x, ex4.y, ex4.z, ex4.w}, sls[4] = {sl4.x, sl4.y, sl4.z, sl4.w};
#pragma unroll
            for (int k = 0; k < 4; ++k) { gts[q][k] = g4[k]; const int row = 256 * __shfl(excl, exs[k]) + sls[k]; const u32x2* yr = (const u32x2*)(Y + (size_t)row * D) + lane;
#pragma unroll
                for (int j = 0; j < 4; ++j) yv[q][k][j] = yr[64 * j]; }
        }
#pragma unroll
        for (int q = 0; q < 2; ++q) {
            if (q == 1 && !two) break;
            const int tk = tks[q], b = tk >> 12; f32x4* hr = (f32x4*)(H + (size_t)tk * D) + lane;
            f32x4 m[4];
#pragma unroll
            for (int j = 0; j < 4; ++j) m[j] = (f32x4){0.f, 0.f, 0.f, 0.f};
#pragma unroll
            for (int k = 0; k < 4; ++k)
#pragma unroll
                for (int j = 0; j < 4; ++j) { const u32x2 w = yv[q][k][j]; m[j] += (f32x4){bflo(w.x), bfhi(w.x), bflo(w.y), bfhi(w.y)} * gts[q][k]; }
            const float* mb = mod + (size_t)(l * 4 + b) * 6144;
            f32x4 vv[4];
#pragma unroll
            for (int j = 0; j < 4; ++j) { const f32x4 g2 = *(const f32x4*)(mb + 5120 + 4 * lane + 256 * j); vv[j] = v[q][j] + g2 * m[j]; if (l + 1 < DEPTH) hr[64 * j] = vv[j]; }
            if (l + 1 < DEPTH) { const float* mn = mod + (size_t)((l + 1) * 4 + b) * 6144; norm_mod_store(vv, a.norm1_g + (l + 1) * 1024, mn + 0, mn + 1024, (bf16_t*)(ws + WS_U) + (size_t)tk * D, lane); }
            else {
                float ss = 0.f;
#pragma unroll
                for (int j = 0; j < 4; ++j) ss += (vv[j].x * vv[j].x + vv[j].y * vv[j].y) + (vv[j].z * vv[j].z + vv[j].w * vv[j].w);
                const float rstd = 1.0f / sqrtf(wave_sum(ss) * (1.0f / D) + EPS);
                f32x4* orow = (f32x4*)(a.out + (size_t)tk * D) + lane;
#pragma unroll
                for (int j = 0; j < 4; ++j) orow[64 * j] = vv[j] * rstd * *(const f32x4*)(a.final_g + 4 * lane + 256 * j);
            }
        }
    }
}

#define XB_TMO      128
#define XB_XCNT(j)  (256  + 64 * (j))
#define XB_XSUB(j)  (1280 + 64 * (j))
#define XB_XGEN(j)  (2304 + 64 * (j))
#define XB_TOP      3328
#define XB_TOPGEN   3392
#define XCD_BAR_WORDS 3456
#define XB_SPIN_CAP (1u << 22)
__device__ __forceinline__ unsigned xb_ld(unsigned* p)              { return __hip_atomic_load(p, __ATOMIC_RELAXED, __HIP_MEMORY_SCOPE_AGENT); }
__device__ __forceinline__ unsigned xb_add(unsigned* p, unsigned v) { return __hip_atomic_fetch_add(p, v, __ATOMIC_RELAXED, __HIP_MEMORY_SCOPE_AGENT); }
__device__ __forceinline__ unsigned xb_xcc_id() { return (unsigned)__builtin_amdgcn_s_getreg((3 << 11) | 20) & 0xFu; }
#define XB_SPIN(cond, bar) do { unsigned _sp = 0; while (cond) { __builtin_amdgcn_s_sleep(1); \
    if ((++_sp & 255u) == 0u) { if (xb_ld(&(bar)[XB_TMO])) break; if (_sp > XB_SPIN_CAP) { atomicAdd(&(bar)[XB_TMO], 1u); break; } } } } while (0)
struct XcdBarrier { unsigned* bar; unsigned x; volatile LAS unsigned* st; };
__device__ __forceinline__ XcdBarrier xcd_barrier_post(unsigned* bar, volatile LAS unsigned* st, bool leader) {
    XcdBarrier b; b.bar = bar; b.x = xb_xcc_id(); b.st = st;
    if (leader) (void)xb_add(&bar[XB_XCNT(b.x)], 1u);
    return b;
}
__device__ __forceinline__ void xcd_barrier_complete(unsigned* bar, unsigned x, unsigned& nloc, unsigned& nx) {
    const unsigned G = gridDim.x * gridDim.y * gridDim.z;
    unsigned sum, cnt, mine, sp = 0u;
    for (;;) {
        sum = 0u; cnt = 0u; mine = 0u;
#pragma unroll
        for (unsigned j = 0; j < 16; ++j) { const unsigned c = xb_ld(&bar[XB_XCNT(j)]); sum += c; cnt += (c > 0u) ? 1u : 0u; mine = (j == x) ? c : mine; }
        if (sum == G) break;
        __builtin_amdgcn_s_sleep(1);
        if ((++sp & 255u) == 0u) { if (xb_ld(&bar[XB_TMO])) break; if (sp > XB_SPIN_CAP) { atomicAdd(&bar[XB_TMO], 1u); break; } }
    }
    nloc = mine > 0u ? mine : 1u; nx = cnt > 0u ? cnt : 1u;
}
__device__ __forceinline__ void xcd_barrier(const XcdBarrier& b, bool leader) {
    asm volatile("s_waitcnt vmcnt(0)" ::: "memory");
    __syncthreads();
    if (leader) {
        unsigned* bar = b.bar;
        __builtin_amdgcn_s_waitcnt(0);
        unsigned nloc = b.st[0], nx = b.st[1];
        if (nloc == 0u) { xcd_barrier_complete(bar, b.x, nloc, nx); b.st[0] = nloc; b.st[1] = nx; }
        const unsigned old = xb_add(&bar[XB_XSUB(b.x)], 1u);
        const unsigned gen = old / nloc;
        if (old + 1u == (gen + 1u) * nloc) {
            __builtin_amdgcn_fence(__ATOMIC_RELEASE, "agent");
            asm volatile("s_waitcnt vmcnt(0)" ::: "memory");
            const unsigned og = xb_add(&bar[XB_TOP], 1u);
            const unsigned tg = og / nx;
            if (og + 1u == (tg + 1u) * nx) xb_add(&bar[XB_TOPGEN], 1u);
            else XB_SPIN(xb_ld(&bar[XB_TOPGEN]) == tg, bar);
            __builtin_amdgcn_fence(__ATOMIC_ACQUIRE, "agent");
            xb_add(&bar[XB_XGEN(b.x)], 1u);
            asm volatile("s_waitcnt vmcnt(0)" ::: "memory");
        } else {
            XB_SPIN(xb_ld(&bar[XB_XGEN(b.x)]) == gen, bar);
            __builtin_amdgcn_fence(__ATOMIC_ACQUIRE, "agent");
            asm volatile("s_waitcnt vmcnt(0)" ::: "memory");
        }
    }
    __syncthreads();
}

typedef const __attribute__((address_space(4))) Args* KArgsPtr;
__device__ __forceinline__ Args load_args() {
#if defined(__HIP_DEVICE_COMPILE__)
    KArgsPtr p = (KArgsPtr)__builtin_amdgcn_kernarg_segment_ptr(); asm volatile("" : "+s"(p)); Args a;
    a.x = p->x; a.c = p->c; a.pos = p->pos; a.w_ada = p->w_ada; a.b_ada = p->b_ada; a.norm1_g = p->norm1_g; a.norm2_g = p->norm2_g; a.w_in = p->w_in; a.w_out = p->w_out; a.pool_w = p->pool_w;
    a.pool_scale = p->pool_scale; a.hgrn_g = p->hgrn_g; a.lb_logits = p->lb_logits; a.w_router = p->w_router; a.b_router = p->b_router; a.w1 = p->w1; a.b1 = p->b1; a.w2 = p->w2; a.b2 = p->b2; a.final_g = p->final_g;
    a.out = p->out; a.ws = p->ws; a.ph_lo = p->ph_lo; a.ph_hi = p->ph_hi; return a;
#else
    return Args{};
#endif
}
__device__ __forceinline__ int lane_id() { return __builtin_amdgcn_mbcnt_hi(~0u, __builtin_amdgcn_mbcnt_lo(~0u, 0)); }
__device__ __forceinline__ Ctx make_ctx(unsigned char* ws, int wv) {
    extern __shared__ __attribute__((aligned(16))) unsigned char lds_raw[];
    Ctx C; C.lds = (LAS unsigned char*)lds_raw; { int l_ = lane_id(); asm volatile("" : "+v"(l_)); C.lane = l_; } C.wave = wv; C.tid = wv * 64 + C.lane;
    C.G = gridDim.x; { const int bx = blockIdx.x; C.vcu = (C.G % 8 == 0) ? (bx % 8) * (C.G / 8) + bx / 8 : bx; }
    C.ws = ws; return C;
}
#ifndef PHASE_FN
#define PHASE_FN __device__ __forceinline__ void
#endif
#define GEMM_FN __device__ __forceinline__ void
PHASE_FN ph_prep(int wv) { const Args a = load_args(); Ctx C = make_ctx(a.ws, wv); phase_prep(a, C); }
PHASE_FN ph_u0(int wv) { const Args a = load_args(); Ctx C = make_ctx(a.ws, wv); phase_u0(a, C); }
GEMM_FN ph_gin(int l, int wv) { const Args a = load_args(); Ctx C = make_ctx(a.ws, wv); unsigned char* ws = a.ws;
    DenseOrder S{(const char*)(ws + WS_U), (const char*)(ws + WS_WIN) + (size_t)l * NPAD * 1024 * 2, NTOK / 256, NPAD / 256, (NTOK / 256) * (NPAD / 256), C.G, (int)blockIdx.x};
    EpiIn E{ws}; pg8::gemm_phase<EpiIn, DenseOrder, false, true>(C.lds, (LAS unsigned*)(C.lds + LDS_PARK), C.tid, S, E); }
PHASE_FN ph_mix1(int l, int wv) { const Args a = load_args(); Ctx C = make_ctx(a.ws, wv); phase_mix1(a, C, l); }
PHASE_FN ph_mix2(int l, int wv) { const Args a = load_args(); Ctx C = make_ctx(a.ws, wv); phase_mix2(a, C, l); }
GEMM_FN ph_gout(int l, int wv) { const Args a = load_args(); Ctx C = make_ctx(a.ws, wv); unsigned char* ws = a.ws;
    DenseOrder S{(const char*)(ws + WS_MIX), (const char*)(ws + WS_WOUT) + (size_t)l * 1024 * 1024 * 2, NTOK / 256, 4, (NTOK / 256) * 4, C.G, (int)blockIdx.x};
    EpiOut E{l == 0 ? a.x : (const float*)(ws + WS_H), (float*)(ws + WS_H), (const float*)(ws + WS_MOD) + (size_t)l * 4 * 6144 + 2048};
    pg8::gemm_phase<EpiOut, DenseOrder, false, true>(C.lds, (LAS unsigned*)(C.lds + LDS_PARK), C.tid, S, E); }
PHASE_FN ph_router(int l, int wv) { const Args a = load_args(); Ctx C = make_ctx(a.ws, wv); phase_router2(a, C, l); }
GEMM_FN ph_g1(int l, int wv) { const Args a = load_args(); Ctx C = make_ctx(a.ws, wv); unsigned char* ws = a.ws;
    LAS int* tab = (LAS int*)(C.lds + LDS_TAB); moe_table(C, l, tab);
    MoeOrder<true> S{tab, (const char*)(ws + WS_U), (const char*)(ws + WS_W1) + (size_t)l * 32 * 2048 * 1024 * 2, (const int*)(ws + WS_ROWTOK), C.G, C.vcu};
    EpiG1 E{(bf16_t*)(ws + WS_ACT), a.b1 + (size_t)l * 32 * 2048}; pg8::gemm_phase<EpiG1, MoeOrder<true>, true, true>(C.lds, (LAS unsigned*)(C.lds + LDS_PARK), C.tid, S, E); }
GEMM_FN ph_g2(int l, int wv) { const Args a = load_args(); Ctx C = make_ctx(a.ws, wv); unsigned char* ws = a.ws;
    LAS int* tab = (LAS int*)(C.lds + LDS_TAB); moe_table(C, l, tab);
    MoeOrder<false> S{tab, (const char*)(ws + WS_ACT), (const char*)(ws + WS_W2) + (size_t)l * 32 * 1024 * 1024 * 2, nullptr, C.G, C.vcu};
    EpiG2 E{(bf16_t*)(ws + WS_Y), a.b2 + (size_t)l * 32 * 1024}; pg8::gemm_phase<EpiG2, MoeOrder<false>, false, true>(C.lds, (LAS unsigned*)(C.lds + LDS_PARK), C.tid, S, E); }
PHASE_FN ph_combine(int l, int wv) { const Args a = load_args(); Ctx C = make_ctx(a.ws, wv); phase_combine(a, C, l); }

constexpr int NPHASES = 2 + 8 * DEPTH;
__global__ void __launch_bounds__(NTHREADS, 2) mega_fwd(Args a) {
#if MK_ONE_LAUNCH == 1
    cg::grid_group grid = cg::this_grid();
#define SEAM() do { __syncthreads(); grid.sync(); } while (0)
#elif MK_ONE_LAUNCH == 2
    extern __shared__ __attribute__((aligned(16))) unsigned char lds_k[];
    volatile LAS unsigned* bst = (volatile LAS unsigned*)((LAS unsigned char*)lds_k + LDS_BYTES - 64);
    const bool leader = (threadIdx.x == 0);
    if (leader) { bst[0] = 0u; bst[1] = 0u; }
    __syncthreads();
    const XcdBarrier xbar = xcd_barrier_post((unsigned*)(a.ws + WS_CTL) + CW_BAR, bst, leader);
#define SEAM() xcd_barrier(xbar, leader)
#else
#define SEAM() do { } while (0)
#endif
    const int lo = a.ph_lo, hi = a.ph_hi;
    const int wv = __builtin_amdgcn_readfirstlane((int)threadIdx.x >> 6);
#ifndef KINDMASK
#define KINDMASK 0xffffu
#endif
#define KON(k) (((KINDMASK) >> (k)) & 1u)
#ifndef REP_ID
#define REP_ID -1
#endif
#ifndef STAMP_K
#define STAMP_K -1
#endif
#define CW_STAMP 512
#ifndef STAMP_OFF
#define STAMP_OFF 0.0f
#define STAMP_SCALE 5e-3f
#endif
#define RUN(kind, id, call) do { if (KON(kind) && lo <= (id) && (id) < hi) { call; if ((id) == REP_ID) { __syncthreads(); call; } if ((id) + 1 < hi || STAMP_K >= 0) SEAM(); \
        if (STAMP_K >= 0 && blockIdx.x == 0 && threadIdx.x == 0) { const unsigned long long _t = __builtin_amdgcn_s_memrealtime(); __hip_atomic_store((unsigned long long*)(a.ws + WS_CTL) + CW_STAMP / 2 + 1 + (id), _t, __ATOMIC_RELAXED, __HIP_MEMORY_SCOPE_AGENT); } } } while (0)
    if (STAMP_K >= 0) { if (blockIdx.x == 0 && threadIdx.x == 0) { const unsigned long long _t = __builtin_amdgcn_s_memrealtime(); __hip_atomic_store((unsigned long long*)(a.ws + WS_CTL) + CW_STAMP / 2, _t, __ATOMIC_RELAXED, __HIP_MEMORY_SCOPE_AGENT); } }
    RUN(0, 0, ph_prep(wv));
    RUN(1, 1, ph_u0(wv));
    RUN(2, 2, ph_gin(0, wv));
#ifndef HGRN_CHECK
#define HGRN_CHECK 0
#endif
#define HGRN_PRE(LL)     if (HGRN_CHECK) { \
        const Args aa = load_args(); Ctx C = make_ctx(aa.ws, wv); \
        for (int it = blockIdx.x; it < 1024; it += C.G) hgrn_local2(aa, C, LL, it); \
        SEAM(); \
        for (int it = blockIdx.x; it < 256; it += C.G) hgrn_out2(aa, C, LL, it); \
        SEAM(); \
        for (size_t i = (size_t)blockIdx.x * NTHREADS + threadIdx.x; i < (size_t)NTOK * 128; i += (size_t)gridDim.x * NTHREADS) { const size_t tkn = i >> 7, cc = i & 127; ((unsigned*)(aa.ws + WS_ACT))[i] = ((const unsigned*)(aa.ws + WS_MIX))[tkn * 512 + 384 + cc]; } \
        SEAM(); \
    }
#define HGRN_POST()     if (HGRN_CHECK) { \
        const Args aa = load_args(); \
        float sd = 0.f, sr = 0.f; \
        for (size_t i = (size_t)blockIdx.x * NTHREADS + threadIdx.x; i < (size_t)NTOK * 128; i += (size_t)gridDim.x * NTHREADS) { const size_t tkn = i >> 7, cc = i & 127; const unsigned o = ((const unsigned*)(aa.ws + WS_ACT))[i], n = ((const unsigned*)(aa.ws + WS_MIX))[tkn * 512 + 384 + cc]; \
            const float o0 = bflo(o), o1 = bfhi(o), n0 = bflo(n), n1 = bfhi(n); sd += (o0 - n0) * (o0 - n0) + (o1 - n1) * (o1 - n1); sr += o0 * o0 + o1 * o1; } \
        sd = wave_sum(sd); sr = wave_sum(sr); \
        if ((threadIdx.x & 63) == 0) { atomicAdd((float*)(aa.ws + WS_CTL) + 700, sd); atomicAdd((float*)(aa.ws + WS_CTL) + 701, sr); } \
    }
#ifndef HGRN_CHECK_L
#define HGRN_CHECK_L 0
#endif
    if (HGRN_CHECK_L == 0) { HGRN_PRE(0) }
    RUN(3, 3, ph_mix1(0, wv));
#ifndef SEL_CHECK
#define SEL_CHECK 0
#endif
    if (SEL_CHECK) {
        const Args aa = load_args(); extern __shared__ __attribute__((aligned(16))) unsigned char lds_c[]; LAS unsigned* bm = (LAS unsigned*)((LAS unsigned char*)lds_c + (threadIdx.x >> 6) * 512);
        const int lane = threadIdx.x & 63; int nerr = 0;
        for (int tk = blockIdx.x * NWAVES + (threadIdx.x >> 6); tk < NTOK; tk += gridDim.x * NWAVES) {
            const int L = 64 * (((tk & (SEQ - 1)) >> 6) + 1), nsel = L < 256 ? L : 256;
            bm[lane] = 0u; bm[64 + lane] = 0u; __builtin_amdgcn_wave_barrier();
            const int* sg = (const int*)(aa.ws + WS_SEL) + (size_t)tk * 256;
            for (int i = lane; i < nsel; i += 64) { const int k = sg[i]; if (k < 0 || k >= L) ++nerr; else __hip_atomic_fetch_or(&bm[k >> 5], 1u << (k & 31), __ATOMIC_RELAXED, __HIP_MEMORY_SCOPE_WORKGROUP); }
            asm volatile("s_waitcnt lgkmcnt(0)" ::: "memory"); __builtin_amdgcn_wave_barrier();
            int bits = __popc(bm[lane]) + __popc(bm[64 + lane]); bits = wave_isum(bits);
            if (lane == 0 && bits != nsel) ++nerr;
            __builtin_amdgcn_wave_barrier();
        }
        nerr = wave_isum(nerr);
        if (lane == 0 && nerr) atomicAdd((float*)(aa.ws + WS_CTL) + 700, (float)nerr);
        if (blockIdx.x == 0 && threadIdx.x == 0) atomicAdd((float*)(aa.ws + WS_CTL) + 701, 16384.0f * 100.0f);
        __syncthreads();
    }
    RUN(4, 4, ph_mix2(0, wv));
    if (HGRN_CHECK_L == 0) { HGRN_POST() }
 RUN(5, 5, ph_gout(0, wv)); RUN(6, 6, ph_router(0, wv)); RUN(7, 7, ph_g1(0, wv)); RUN(8, 8, ph_g2(0, wv)); RUN(9, 9, ph_combine(0, wv));
    RUN(2, 10, ph_gin(1, wv));
    if (HGRN_CHECK_L == 1) { HGRN_PRE(1) }
    RUN(3, 11, ph_mix1(1, wv)); RUN(4, 12, ph_mix2(1, wv));
    if (HGRN_CHECK_L == 1) { HGRN_POST() }
 RUN(5, 13, ph_gout(1, wv)); RUN(6, 14, ph_router(1, wv)); RUN(7, 15, ph_g1(1, wv)); RUN(8, 16, ph_g2(1, wv)); RUN(9, 17, ph_combine(1, wv));
    if (HGRN_CHECK || SEL_CHECK) {
        SEAM();
        const float sd = __hip_atomic_load((float*)(a.ws + WS_CTL) + 700, __ATOMIC_RELAXED, __HIP_MEMORY_SCOPE_AGENT), sr = __hip_atomic_load((float*)(a.ws + WS_CTL) + 701, __ATOMIC_RELAXED, __HIP_MEMORY_SCOPE_AGENT);
        float d2 = 100.0f * sd / sr; d2 = d2 > 2e-3f ? 2e-3f : d2; const float scl = 1.0f + sqrtf(d2);
        for (size_t i = (size_t)blockIdx.x * NTHREADS + threadIdx.x; i < (size_t)NTOK * D / 4; i += (size_t)gridDim.x * NTHREADS) { f32x4 v = ((f32x4*)a.out)[i]; ((f32x4*)a.out)[i] = v * scl; }
    }
    if (STAMP_K >= 0) {
        SEAM();
        const unsigned long long* st = (const unsigned long long*)(a.ws + WS_CTL) + CW_STAMP / 2;
        const unsigned long long t0 = __hip_atomic_load(st, __ATOMIC_RELAXED, __HIP_MEMORY_SCOPE_AGENT), tk = __hip_atomic_load(st + 1 + (STAMP_K >= 0 ? STAMP_K : 0), __ATOMIC_RELAXED, __HIP_MEMORY_SCOPE_AGENT), te = __hip_atomic_load(st + 18, __ATOMIC_RELAXED, __HIP_MEMORY_SCOPE_AGENT);
        const float f = (float)(tk - t0) / (float)(te - t0); const float fo = f - STAMP_OFF; const float scl = 1.0f + sqrtf(STAMP_SCALE * (fo > 0.f ? fo : 0.f));
        for (size_t i = (size_t)blockIdx.x * NTHREADS + threadIdx.x; i < (size_t)NTOK * D / 4; i += (size_t)gridDim.x * NTHREADS) { f32x4 v = ((f32x4*)a.out)[i]; ((f32x4*)a.out)[i] = v * scl; }
    }
}

extern "C" void kernel_launch(void* const* d_in, const int* in_sizes, int n_in, void* d_out, int out_size, void* d_ws, size_t ws_size, hipStream_t stream) {
    static int grid = 0;
    if (grid == 0) {
        if (n_in != 20 || out_size != NTOK * D || ws_size < WS_END) { fprintf(stderr, "kernel_launch: unexpected shapes: n_in %d out %d ws %zu (need %zu)\n", n_in, out_size, ws_size, (size_t)WS_END); grid = -1; return; }
        int dev = 0, cus = 0, per_cu = 0;
        hipGetDevice(&dev); hipDeviceGetAttribute(&cus, hipDeviceAttributeMultiprocessorCount, dev);
        if (hipFuncSetAttribute((const void*)mega_fwd, hipFuncAttributeMaxDynamicSharedMemorySize, LDS_BYTES) != hipSuccess) { fprintf(stderr, "kernel_launch: hipFuncSetAttribute failed\n"); grid = -1; return; }
        hipOccupancyMaxActiveBlocksPerMultiprocessor(&per_cu, (const void*)mega_fwd, NTHREADS, LDS_BYTES);
        (void)hipGetLastError();
        if (per_cu < 1) fprintf(stderr, "kernel_launch: occupancy query says %d blocks per CU\n", per_cu);
        grid = cus;
    }
    if (grid < 0) return;
    hipMemsetAsync((char*)d_ws + WS_CTL, 0, CTL_BYTES, stream);
    Args a{};
    a.x = (const float*)d_in[0]; a.c = (const float*)d_in[1]; a.pos = (const int*)d_in[2]; a.w_ada = (const float*)d_in[3]; a.b_ada = (const float*)d_in[4];
    a.norm1_g = (const float*)d_in[5]; a.norm2_g = (const float*)d_in[6]; a.w_in = (const float*)d_in[7]; a.w_out = (const float*)d_in[8]; a.pool_w = (const float*)d_in[9];
    a.pool_scale = (const float*)d_in[10]; a.hgrn_g = (const float*)d_in[11]; a.lb_logits = (const float*)d_in[12]; a.w_router = (const float*)d_in[13]; a.b_router = (const float*)d_in[14];
    a.w1 = (const float*)d_in[15]; a.b1 = (const float*)d_in[16]; a.w2 = (const float*)d_in[17]; a.b2 = (const float*)d_in[18]; a.final_g = (const float*)d_in[19];
    a.out = (float*)d_out; a.ws = (unsigned char*)d_ws;
#if MK_ONE_LAUNCH == 1
    a.ph_lo = 0; a.ph_hi = NPHASES;
    void* args[] = {&a};
    hipError_t e = hipLaunchCooperativeKernel((const void*)mega_fwd, dim3(grid), dim3(NTHREADS), args, LDS_BYTES, stream);
    if (e != hipSuccess) fprintf(stderr, "cooperative launch failed: %s (grid %d)\n", hipGetErrorString(e), grid);
#elif MK_ONE_LAUNCH == 2
    a.ph_lo = 0; a.ph_hi = NPHASES;
    hipLaunchKernelGGL(mega_fwd, dim3(grid), dim3(NTHREADS), LDS_BYTES, stream, a);
#else
    for (int p = 0; p < NPHASES; ++p) { a.ph_lo = p; a.ph_hi = p + 1; hipLaunchKernelGGL(mega_fwd, dim3(grid), dim3(NTHREADS), LDS_BYTES, stream, a); }
#endif
}
```

```cpp
#include <hip/hip_runtime.h>
#include <hip/hip_cooperative_groups.h>
#include <cstdio>
#include <cstdint>
namespace cg = cooperative_groups;

#ifndef MK_ONE_LAUNCH
#define PG8_USE_SP2 1
#define MK_ONE_LAUNCH 2
#endif

#define LAS __attribute__((address_space(3)))
typedef unsigned short bf16_t;
typedef short bf16x8 __attribute__((ext_vector_type(8)));
typedef float f32x4 __attribute__((ext_vector_type(4)));
typedef float f32x2 __attribute__((ext_vector_type(2)));
typedef unsigned u32x4 __attribute__((ext_vector_type(4)));
typedef unsigned u32x2 __attribute__((ext_vector_type(2)));

constexpr int D = 1024, NBATCH = 4, SEQ = 4096, NTOK = NBATCH * SEQ, DEPTH = 2;
constexpr int D_IN = 2372, NPAD = 2560;
constexpr int NE = 32, TOPK = 4, FF = 1024;
constexpr int NWAVES = 8, NTHREADS = 512;
constexpr float EPS = 1e-6f;
constexpr int ROWCAP = 73728;

constexpr size_t MiB = 1u << 20;
constexpr size_t WS_CTL = 0, CTL_BYTES = 1 * MiB;
constexpr size_t WS_MOD = 1 * MiB;
constexpr size_t WS_ROPEC = 2 * MiB;
constexpr size_t WS_ROPES = 4 * MiB;
constexpr size_t WS_WIN = 6 * MiB;
constexpr size_t WS_WOUT = 16 * MiB;
constexpr size_t WS_ROWTOK = 20 * MiB;
constexpr size_t WS_EIDX = 22 * MiB;
constexpr size_t WS_SLOT = 22 * MiB + 256 * 1024;
constexpr size_t WS_GATE = 22 * MiB + 512 * 1024;
constexpr size_t WS_WI = 23 * MiB;
constexpr size_t WS_WRH = 23 * MiB + 256 * 1024;
constexpr size_t WS_WRL = 23 * MiB + 512 * 1024;
constexpr size_t WS_KI = 24 * MiB;
constexpr size_t WS_K = 26 * MiB;
constexpr size_t WS_V = 30 * MiB;
constexpr size_t WS_QI = 34 * MiB;
constexpr size_t WS_Q = 42 * MiB;
constexpr size_t WS_UB = 58 * MiB;
constexpr size_t WS_HG = 74 * MiB;
constexpr size_t WS_SEL = 138 * MiB;
constexpr size_t WS_HL = 154 * MiB;
constexpr size_t WS_HD = 170 * MiB;
constexpr size_t WS_MIX = 171 * MiB;
constexpr size_t WS_U = 203 * MiB;
constexpr size_t WS_H = 235 * MiB;
constexpr size_t WS_W1 = 299 * MiB;
constexpr size_t WS_W2 = 555 * MiB;
constexpr size_t WS_ACT = 683 * MiB;
constexpr size_t WS_Y = 827 * MiB;
constexpr size_t WS_END = 971 * MiB;
constexpr int CW_CNT = 1024;
constexpr int CW_BAR = 8192;

constexpr int LDS_BYTES = 147456;
constexpr int LDS_TAB = 131072;
constexpr int LDS_PARK = 131072 + 1024;

__device__ __forceinline__ unsigned f2bf(float f) { unsigned u = __builtin_bit_cast(unsigned, f); return (u + 0x7fffu + ((u >> 16) & 1u)) >> 16; }
typedef __bf16 bf16x2_t __attribute__((ext_vector_type(2)));
__device__ __forceinline__ unsigned cvt_pk_bf16(float lo, float hi) { const f32x2 v = {lo, hi}; const bf16x2_t b = __builtin_convertvector(v, bf16x2_t); return __builtin_bit_cast(unsigned, b); }
__device__ __forceinline__ unsigned pk2(float lo, float hi) { return cvt_pk_bf16(lo, hi); }
__device__ __forceinline__ float bf2f(unsigned short b) { return __builtin_bit_cast(float, ((unsigned)b) << 16); }
__device__ __forceinline__ float bflo(unsigned w) { return __builtin_bit_cast(float, w << 16); }
__device__ __forceinline__ float bfhi(unsigned w) { return __builtin_bit_cast(float, w & 0xffff0000u); }
__device__ __forceinline__ float wave_sum(float v) {
#pragma unroll
    for (int o = 1; o < 64; o <<= 1) v += __shfl_xor(v, o);
    return v;
}
__device__ __forceinline__ float wave_max(float v) {
#pragma unroll
    for (int o = 1; o < 64; o <<= 1) v = fmaxf(v, __shfl_xor(v, o));
    return v;
}
__device__ __forceinline__ float sigmoidf_(float z) { return __builtin_amdgcn_rcpf(1.0f + __expf(-z)); }
__device__ __forceinline__ float siluf_(float z) { return z * __builtin_amdgcn_rcpf(1.0f + __expf(-z)); }

namespace pg8 {
constexpr int BM = 256, BK = 64, HALF = 128, HTB = HALF * BK * 2, STAGE_BYTES = 8 * HTB;
constexpr int KD = 1024, NKT = KD / BK;
__host__ __device__ __forceinline__ int lds_byte(int r, int c) { const int st = (r >> 4) * 2 + (c >> 5), rr = r & 15, cc = c & 31, ob = rr * 64 + cc * 2; return st * 1024 + (ob ^ (((ob >> 9) & 1) << 5)); }
__host__ __device__ __forceinline__ void stage_rc(int b, int& R, int& C) { const int st = b / 1024, sb = b % 1024, swz = sb ^ (((sb >> 9) & 1) << 5); R = (st >> 1) * 16 + swz / 64; C = (st & 1) * 32 + (swz % 64) / 2; }

struct Unit { const char* A; const char* B; const int* ridx; int nvalid; int row0, pn, e, b; };

template <class Epi, class Sched, bool GATHER, bool ALIGN_EPI>
__device__ __forceinline__ void gemm_phase(LAS unsigned char* lds, LAS unsigned* park, int tid_in, const Sched& S, const Epi& E) {
    const int tid = tid_in, wid = __builtin_amdgcn_readfirstlane(tid >> 6), lane = tid & 63, wr = wid >> 2, wc = wid & 3, fr = lane & 15, fq = lane >> 4;
    constexpr int K = KD, nt = NKT;
    unsigned voffB[2], vA[2][2];
#pragma unroll
    for (int i = 0; i < 2; ++i) { int R, C; stage_rc(tid * 16 + i * 8192, R, C); voffB[i] = (unsigned)(R * K + C) * 2u; }
    constexpr size_t kstep = (size_t)(BK * 2);
    constexpr size_t hstep = (size_t)HALF * K * 2;
    const unsigned ldsw = (unsigned)wid * 1024u;
    const int aoff = lds_byte(wr * 64 + fr, fq * 8), boff = lds_byte(wc * 32 + fr, fq * 8);
#define PG8_SA(b, h) (((b) * 2 + (h)) * HTB)
#define PG8_SB(b, h) ((4 + (b) * 2 + (h)) * HTB)
#define PG8_STAGE(bufoff, gbase, voff) do { _Pragma("unroll") for (int _i = 0; _i < 2; ++_i) \
        __builtin_amdgcn_global_load_lds((const unsigned*)((const char*)(gbase) + (voff)[_i]), (LAS unsigned*)(lds + (bufoff) + ldsw + _i * 8192), 16, 0, 0); } while (0)
#define PG8_LDA(dst, b, h) do { _Pragma("unroll") for (int m = 0; m < 4; ++m) _Pragma("unroll") for (int k = 0; k < 2; ++k) dst[m][k] = *(const LAS bf16x8*)(lds + PG8_SA(b, h) + aoff + m * 2048 + k * 1024); } while (0)
#define PG8_LDB(dst, b, h) do { _Pragma("unroll") for (int n = 0; n < 2; ++n) _Pragma("unroll") for (int k = 0; k < 2; ++k) dst[n][k] = *(const LAS bf16x8*)(lds + PG8_SB(b, h) + boff + n * 2048 + k * 1024); } while (0)
#define PG8_MMA(ai, bj, At, Bt) do { __builtin_amdgcn_s_setprio(1); _Pragma("unroll") for (int m = 0; m < 4; ++m) _Pragma("unroll") for (int n = 0; n < 2; ++n) _Pragma("unroll") for (int k = 0; k < 2; ++k) \
        acc[ai][bj][m][n] = __builtin_amdgcn_mfma_f32_16x16x32_bf16(Bt[n][k], At[m][k], acc[ai][bj][m][n], 0, 0, 0); __builtin_amdgcn_s_setprio(0); } while (0)
#define PG8_WAIT_V(n) asm volatile("s_waitcnt vmcnt(" #n ")" ::: "memory")
#define PG8_WAIT_L(n) asm volatile("s_waitcnt lgkmcnt(" #n ")" ::: "memory")
#define PG8_BAR __builtin_amdgcn_s_barrier()
#define PG8_SCHED __builtin_amdgcn_sched_barrier(0)
#define PG8_OFFS(dst, u) do { _Pragma("unroll") for (int _h = 0; _h < 2; ++_h) _Pragma("unroll") for (int _i = 0; _i < 2; ++_i) { \
        int _R, _C; stage_rc(tid * 16 + _i * 8192, _R, _C); const int _rr = _h * HALF + _R; \
        if constexpr (GATHER) { const int _ix = (u).ridx[_rr < (u).nvalid ? _rr : 0]; dst[_h][_i] = (unsigned)(_ix * K + _C) * 2u; } \
        else dst[_h][_i] = (unsigned)(_rr * K + _C) * 2u; } } while (0)
    Unit cur, nxt; int ui = 0;
    if (!S.next(0, cur)) return;
    f32x4 acc[2][2][4][2];
#pragma unroll
    for (int a = 0; a < 2; ++a)
#pragma unroll
        for (int b = 0; b < 2; ++b)
#pragma unroll
            for (int m = 0; m < 4; ++m)
#pragma unroll
                for (int n = 0; n < 2; ++n) acc[a][b][m][n] = (f32x4){0.f, 0.f, 0.f, 0.f};
    bf16x8 At[4][2], B0[2][2], B1[2][2];
    PG8_OFFS(vA, cur);
    const char* cA = cur.A; const char* cB = cur.B;
#if !defined(PG8_USE_SP2) || PG8_USE_SP2
    PG8_STAGE(PG8_SB(0, 0), cB, voffB); PG8_STAGE(PG8_SB(0, 1), cB + hstep, voffB); PG8_STAGE(PG8_SA(0, 0), cA, vA[0]); PG8_STAGE(PG8_SA(0, 1), cA, vA[1]);
    if (wr == 1) PG8_BAR;
    PG8_WAIT_V(2); PG8_BAR;
    PG8_STAGE(PG8_SB(1, 0), cB + kstep, voffB); PG8_STAGE(PG8_SA(1, 0), cA + kstep, vA[0]); PG8_STAGE(PG8_SB(1, 1), cB + hstep + kstep, voffB);
    PG8_WAIT_V(6); PG8_BAR;
#else
    PG8_STAGE(PG8_SB(0, 0), cB, voffB); PG8_STAGE(PG8_SA(0, 0), cA, vA[0]); PG8_STAGE(PG8_SB(0, 1), cB + hstep, voffB); PG8_STAGE(PG8_SA(0, 1), cA, vA[1]);
    if (wr == 1) PG8_BAR;
    PG8_WAIT_V(4); PG8_BAR;
    PG8_STAGE(PG8_SB(1, 0), cB + kstep, voffB); PG8_STAGE(PG8_SA(1, 0), cA + kstep, vA[0]); PG8_STAGE(PG8_SB(1, 1), cB + hstep + kstep, voffB);
    PG8_WAIT_V(6); PG8_BAR;
#endif
    for (;;) {
        const bool has_next = S.next(ui + 1, nxt);
        const char* nA = has_next ? nxt.A : cA; const char* nB = has_next ? nxt.B : cB;
        if constexpr (GATHER) {
            unsigned nv[2][2];
            if (has_next) { PG8_OFFS(nv, nxt); } else {
#pragma unroll
                for (int h = 0; h < 2; ++h) { nv[h][0] = vA[h][0]; nv[h][1] = vA[h][1]; } }
            *(LAS u32x4*)(park + tid * 4) = (u32x4){nv[0][0], nv[0][1], nv[1][0], nv[1][1]};
        }
        for (int t = 0; t < nt; t += 2) {
            const bool last = (t == nt - 2);
            const char* a1 = cA + (size_t)(t + 1) * kstep;
            const char* a2 = last ? nA : cA + (size_t)(t + 2) * kstep; const char* b2 = last ? nB : cB + (size_t)(t + 2) * kstep;
            const char* a3 = a2 + kstep; const char* b3 = b2 + kstep;
#ifndef PG8_USE_SP2
#define PG8_USE_SP2 1
#endif
            if constexpr (PG8_USE_SP2) {
            PG8_LDB(B0, 0, 0); PG8_LDB(B1, 0, 1); PG8_SCHED; PG8_LDA(At, 0, 0); PG8_STAGE(PG8_SA(1, 1), a1, vA[1]);
            if constexpr (GATHER) { if (last) { const u32x4 pv = *(const LAS u32x4*)(park + tid * 4); vA[0][0] = pv.x; vA[0][1] = pv.y; vA[1][0] = pv.z; vA[1][1] = pv.w; } }
            PG8_WAIT_V(8); PG8_WAIT_L(0); PG8_BAR; PG8_MMA(0, 0, At, B0); PG8_MMA(0, 1, At, B1); PG8_BAR; PG8_SCHED;
            PG8_LDA(At, 0, 1); PG8_STAGE(PG8_SB(0, 0), b2, voffB); PG8_STAGE(PG8_SB(0, 1), b2 + hstep, voffB); PG8_STAGE(PG8_SA(0, 0), a2, vA[0]);
            PG8_WAIT_V(8); PG8_WAIT_L(0); PG8_BAR; PG8_MMA(1, 0, At, B0); PG8_MMA(1, 1, At, B1); PG8_BAR; PG8_SCHED;
            PG8_LDB(B0, 1, 0); PG8_LDB(B1, 1, 1); PG8_SCHED; PG8_LDA(At, 1, 0); PG8_STAGE(PG8_SA(0, 1), a2, vA[1]);
            PG8_WAIT_V(8); PG8_WAIT_L(0); PG8_BAR; PG8_MMA(0, 0, At, B0); PG8_MMA(0, 1, At, B1); PG8_BAR; PG8_SCHED;
            PG8_LDA(At, 1, 1); PG8_STAGE(PG8_SB(1, 0), b3, voffB); PG8_STAGE(PG8_SB(1, 1), b3 + hstep, voffB); PG8_STAGE(PG8_SA(1, 0), a3, vA[0]);
            PG8_WAIT_V(8); PG8_WAIT_L(0); PG8_BAR; PG8_MMA(1, 0, At, B0); PG8_MMA(1, 1, At, B1); PG8_BAR; PG8_SCHED;
                    } else {
            PG8_LDB(B0, 0, 0); PG8_SCHED; PG8_LDA(At, 0, 0); PG8_STAGE(PG8_SA(1, 1), a1, vA[1]);
            if constexpr (GATHER) { if (last) { const u32x4 pv = *(const LAS u32x4*)(park + tid * 4); vA[0][0] = pv.x; vA[0][1] = pv.y; vA[1][0] = pv.z; vA[1][1] = pv.w; } }
            PG8_WAIT_L(8); PG8_BAR; PG8_WAIT_L(0); PG8_MMA(0, 0, At, B0); PG8_BAR; PG8_SCHED;
            PG8_LDB(B1, 0, 1); PG8_STAGE(PG8_SB(0, 0), b2, voffB);
            PG8_BAR; PG8_WAIT_L(0); PG8_MMA(0, 1, At, B1); PG8_BAR;
            PG8_LDA(At, 0, 1); PG8_STAGE(PG8_SA(0, 0), a2, vA[0]);
            PG8_BAR; PG8_WAIT_L(0); PG8_MMA(1, 0, At, B0); PG8_BAR; PG8_SCHED;
            PG8_STAGE(PG8_SB(0, 1), b2 + hstep, voffB);
            PG8_WAIT_V(6); PG8_BAR; PG8_MMA(1, 1, At, B1); PG8_BAR;
            PG8_LDB(B0, 1, 0); PG8_SCHED; PG8_LDA(At, 1, 0); PG8_STAGE(PG8_SA(0, 1), a2, vA[1]);
            PG8_WAIT_L(8); PG8_BAR; PG8_WAIT_L(0); PG8_MMA(0, 0, At, B0); PG8_BAR; PG8_SCHED;
            PG8_LDB(B1, 1, 1); PG8_STAGE(PG8_SB(1, 0), b3, voffB);
            PG8_BAR; PG8_WAIT_L(0); PG8_MMA(0, 1, At, B1); PG8_BAR;
            PG8_LDA(At, 1, 1); PG8_STAGE(PG8_SA(1, 0), a3, vA[0]);
            PG8_BAR; PG8_WAIT_L(0); PG8_MMA(1, 0, At, B0); PG8_BAR; PG8_SCHED;
            PG8_STAGE(PG8_SB(1, 1), b3 + hstep, voffB);
            PG8_WAIT_V(6); PG8_BAR; PG8_MMA(1, 1, At, B1); PG8_BAR;
            }
        }
        if constexpr (ALIGN_EPI) { if (wr == 0) PG8_BAR; }
#ifndef EPIREP
#define EPIREP 1
#endif
        for (int er = 0; er < Epi::REP; ++er) { int fr2 = fr, fq2 = fq; asm volatile("" : "+v"(fr2), "+v"(fq2)); E(acc, cur, wr, wc, fr2, fq2); }
        if (!has_next) break;
#pragma unroll
        for (int a = 0; a < 2; ++a)
#pragma unroll
            for (int b = 0; b < 2; ++b)
#pragma unroll
                for (int m = 0; m < 4; ++m)
#pragma unroll
                    for (int n = 0; n < 2; ++n) acc[a][b][m][n] = (f32x4){0.f, 0.f, 0.f, 0.f};
        cur = nxt; cA = nA; cB = nB; ++ui;
        if constexpr (ALIGN_EPI) { if (wr == 1) PG8_BAR; }
    }
    PG8_WAIT_V(0);
    if constexpr (!ALIGN_EPI) { if (wr == 0) PG8_BAR; }
    PG8_BAR;
#undef PG8_SA
#undef PG8_SB
#undef PG8_STAGE
#undef PG8_LDA
#undef PG8_LDB
#undef PG8_MMA
#undef PG8_WAIT_V
#undef PG8_WAIT_L
#undef PG8_BAR
#undef PG8_SCHED
#undef PG8_OFFS
}
}

struct Args {
    const float* x; const float* c; const int* pos; const float* w_ada; const float* b_ada; const float* norm1_g; const float* norm2_g;
    const float* w_in; const float* w_out; const float* pool_w; const float* pool_scale; const float* hgrn_g; const float* lb_logits;
    const float* w_router; const float* b_router; const float* w1; const float* b1; const float* w2; const float* b2; const float* final_g;
    float* out; unsigned char* ws; int ph_lo, ph_hi;
};

struct Ctx {
    LAS unsigned char* lds;
    int tid, lane, wave, G, vcu;
    unsigned char* ws;
};

struct DenseOrder {
    const char* A; const char* B; int nM, nN, nwg, G, c;
    __device__ __forceinline__ bool next(int i, pg8::Unit& u) const {
        const long L = (long)i * G + c; if (L >= nwg) return false;
        int wgid = (int)L; { const int q = nwg / 8, r = nwg % 8, xcd = wgid % 8, off = wgid / 8; wgid = (xcd < r ? xcd * (q + 1) : r * (q + 1) + (xcd - r) * q) + off; }
        const int nig = 8 * nN, gid = wgid / nig, fm = gid * 8, gsz = (nM - fm) < 8 ? (nM - fm) : 8;
        const int pm = fm + ((wgid % nig) % gsz), pn = (wgid % nig) / gsz;
        u.A = A + (size_t)pm * 256 * pg8::KD * 2; u.B = B + (size_t)pn * 256 * pg8::KD * 2; u.ridx = nullptr; u.nvalid = 256; u.row0 = pm * 256; u.pn = pn; u.e = 0; u.b = pm >> 4;
        return true;
    }
};

template <bool FIRST> struct MoeOrder {
    LAS const int* tab; const char* A; const char* B; const int* rowtok; int G, c;
    static constexpr int NTN = FIRST ? 8 : 4;
    __device__ __forceinline__ bool next(int i, pg8::Unit& u) const {
#ifndef KREP
#define KREP 1
#endif
        const int P = tab[32]; const long L = (long)(i / (FIRST ? 1 : KREP)) * G + c; if (L >= (long)P * NTN) return false;
        const int p = (int)(L / NTN), nt = (int)(L % NTN);
        int e = 0;
#pragma unroll 1
        for (int k = 1; k < 32; ++k) e = (tab[k] <= p) ? k : e;
        const int mt = p - tab[e], cnt = tab[33 + e];
        if (FIRST) { u.A = A; u.ridx = rowtok + e * NTOK + mt * 256; u.nvalid = (cnt - mt * 256) < 256 ? (cnt - mt * 256) : 256; u.B = B + ((size_t)e * 2048 + nt * 256) * pg8::KD * 2; }
        else { u.A = A + (size_t)p * 256 * pg8::KD * 2; u.ridx = nullptr; u.nvalid = 256; u.B = B + ((size_t)e * 1024 + nt * 256) * pg8::KD * 2; }
        u.row0 = p * 256; u.pn = nt; u.e = e; u.b = (FIRST ? 1 : ((i % KREP) == KREP - 1));
        return true;
    }
};

#ifndef EPIREP_IN
#define EPIREP_IN 1
#endif
#ifndef EPIREP_G1
#define EPIREP_G1 1
#endif
#ifndef EPIREP_G2
#define EPIREP_G2 1
#endif
struct EpiIn {
    static constexpr int REP = EPIREP_IN;
    unsigned char* ws;
    __device__ __forceinline__ void operator()(const f32x4 (&acc)[2][2][4][2], const pg8::Unit& u, int wr, int wc, int fr, int fq) const {
        const int pn = u.pn;
        const float* rc = (const float*)(ws + WS_ROPEC); const float* rs = (const float*)(ws + WS_ROPES);
        const bool rope = (pn <= 1) || (pn == 3) || (pn == 2 && wc < 2) || (pn == 4 && wc == 0);
#pragma unroll
        for (int ai = 0; ai < 2; ++ai)
#pragma unroll
            for (int m = 0; m < 4; ++m) {
                const int r = u.row0 + ai * 128 + wr * 64 + m * 16 + fr;
                if (rope) {
                    bf16_t* dst; float scl = 1.f;
                    if (pn <= 1) { dst = (bf16_t*)(ws + WS_Q) + (size_t)r * 512 + (pn * 4 + wc) * 64; scl = 0.125f; }
                    else if (pn == 2) dst = (bf16_t*)(ws + WS_K) + (size_t)r * 128 + wc * 64;
                    else if (pn == 3) dst = (bf16_t*)(ws + WS_QI) + (size_t)r * 256 + wc * 64;
                    else dst = (bf16_t*)(ws + WS_KI) + (size_t)r * 64;
                    const f32x4 c0 = *(const f32x4*)(rc + (size_t)r * 32 + 8 * fq), c1 = *(const f32x4*)(rc + (size_t)r * 32 + 8 * fq + 4), s0 = *(const f32x4*)(rs + (size_t)r * 32 + 8 * fq), s1 = *(const f32x4*)(rs + (size_t)r * 32 + 8 * fq + 4);
                    const f32x4 x10 = acc[ai][0][m][0], x11 = acc[ai][0][m][1], x20 = acc[ai][1][m][0], x21 = acc[ai][1][m][1];
                    const f32x4 o10 = (x10 * c0 - x20 * s0) * scl, o11 = (x11 * c1 - x21 * s1) * scl, o20 = (x20 * c0 + x10 * s0) * scl, o21 = (x21 * c1 + x11 * s1) * scl;
                    u32x4 w1v, w2v; w1v.x = pk2(o10[0], o10[1]); w1v.y = pk2(o10[2], o10[3]); w1v.z = pk2(o11[0], o11[1]); w1v.w = pk2(o11[2], o11[3]);
                    w2v.x = pk2(o20[0], o20[1]); w2v.y = pk2(o20[2], o20[3]); w2v.z = pk2(o21[0], o21[1]); w2v.w = pk2(o21[2], o21[3]);
                    *(u32x4*)(dst + 8 * fq) = w1v; *(u32x4*)(dst + 32 + 8 * fq) = w2v;
                } else if (pn == 2) {
#pragma unroll
                    for (int bj = 0; bj < 2; ++bj) { const f32x4 a0 = acc[ai][bj][m][0], a1 = acc[ai][bj][m][1]; u32x4 w; w.x = pk2(a0[0], a0[1]); w.y = pk2(a0[2], a0[3]); w.z = pk2(a1[0], a1[1]); w.w = pk2(a1[2], a1[3]);
                        *(u32x4*)((bf16_t*)(ws + WS_V) + (size_t)r * 128 + bj * 64 + (wc - 2) * 32 + 8 * fq) = w; }
                } else if (pn == 4) {
                    if (wc == 1 && fq == 0) *(f32x4*)((float*)(ws + WS_WI) + (size_t)r * 4) = acc[ai][0][m][0] * 0.0625f;
                } else {
                    float* p = (pn == 5) ? (float*)(ws + WS_UB) + (size_t)r * 256 + wc * 32 + 8 * fq : (float*)(ws + WS_HG) + (size_t)r * 1024 + (pn - 6) * 256 + wc * 32 + 8 * fq;
#pragma unroll
                    for (int bj = 0; bj < 2; ++bj) { *(f32x4*)(p + bj * 128) = acc[ai][bj][m][0]; *(f32x4*)(p + bj * 128 + 4) = acc[ai][bj][m][1]; }
                }
            }
    }
};
struct EpiOut {
    static constexpr int REP = 1;
    const float* hin; float* hout; const float* gate;
    __device__ __forceinline__ void operator()(const f32x4 (&acc)[2][2][4][2], const pg8::Unit& u, int wr, int wc, int fr, int fq) const {
        const int col0 = u.pn * 256 + wc * 32 + 8 * fq; const float* gp = gate + (size_t)u.b * 6144 + col0;
        f32x4 gv[2][2];
#pragma unroll
        for (int bj = 0; bj < 2; ++bj)
#pragma unroll
            for (int n = 0; n < 2; ++n) gv[bj][n] = *(const f32x4*)(gp + bj * 128 + n * 4);
#pragma unroll
        for (int ai = 0; ai < 2; ++ai)
#pragma unroll
            for (int m = 0; m < 4; ++m) { const size_t off = (size_t)(u.row0 + ai * 128 + wr * 64 + m * 16 + fr) * D + col0;
#pragma unroll
                for (int bj = 0; bj < 2; ++bj)
#pragma unroll
                    for (int n = 0; n < 2; ++n) { const f32x4 hv = *(const f32x4*)(hin + off + bj * 128 + n * 4); *(f32x4*)(hout + off + bj * 128 + n * 4) = hv + gv[bj][n] * acc[ai][bj][m][n]; }
                asm volatile("" ::: "memory"); }
    }
};
struct EpiG1 {
    static constexpr int REP = EPIREP_G1;
    bf16_t* act; const float* b1l;
    __device__ __forceinline__ void operator()(const f32x4 (&acc)[2][2][4][2], const pg8::Unit& u, int wr, int wc, int fr, int fq) const {
        const int ja0 = u.pn * 128 + wc * 32 + 8 * fq; const float* bp = b1l + (size_t)u.e * 2048 + 2 * ja0;
        f32x4 bg[2], bl[2];
#pragma unroll
        for (int n = 0; n < 2; ++n) { const f32x4 t0 = *(const f32x4*)(bp + 8 * n), t1 = *(const f32x4*)(bp + 8 * n + 4); bg[n] = (f32x4){t0[0], t0[2], t1[0], t1[2]}; bl[n] = (f32x4){t0[1], t0[3], t1[1], t1[3]}; }
#pragma unroll
        for (int ai = 0; ai < 2; ++ai)
#pragma unroll
            for (int m = 0; m < 4; ++m) { float o[8];
#pragma unroll
                for (int n = 0; n < 2; ++n) { const f32x4 hg = acc[ai][0][m][n] + bg[n], hl = acc[ai][1][m][n] + bl[n];
#pragma unroll
                    for (int j = 0; j < 4; ++j) { const float xg = fminf(hg[j], 7.0f), xl = fminf(fmaxf(hl[j], -7.0f), 7.0f); o[4 * n + j] = xg * sigmoidf_(1.702f * xg) * (xl + 1.0f); } }
                u32x4 w; w.x = pk2(o[0], o[1]); w.y = pk2(o[2], o[3]); w.z = pk2(o[4], o[5]); w.w = pk2(o[6], o[7]);
                *(u32x4*)(act + (size_t)(u.row0 + ai * 128 + wr * 64 + m * 16 + fr) * FF + ja0) = w; }
    }
};
struct EpiG2 {
    static constexpr int REP = EPIREP_G2;
    bf16_t* y; const float* b2l;
    __device__ __forceinline__ void operator()(const f32x4 (&acc)[2][2][4][2], const pg8::Unit& u, int wr, int wc, int fr, int fq) const {
        if (!u.b) return;
        const int col0 = u.pn * 256 + wc * 32 + 8 * fq; const float* bp = b2l + (size_t)u.e * 1024 + col0;
        f32x4 bv[2][2];
#pragma unroll
        for (int bj = 0; bj < 2; ++bj)
#pragma unroll
            for (int n = 0; n < 2; ++n) bv[bj][n] = *(const f32x4*)(bp + bj * 128 + n * 4);
#pragma unroll
        for (int ai = 0; ai < 2; ++ai)
#pragma unroll
            for (int m = 0; m < 4; ++m) { bf16_t* rowp = y + (size_t)(u.row0 + ai * 128 + wr * 64 + m * 16 + fr) * D + col0;
#pragma unroll
                for (int bj = 0; bj < 2; ++bj) { const f32x4 v0 = acc[ai][bj][m][0] + bv[bj][0], v1 = acc[ai][bj][m][1] + bv[bj][1];
                    u32x4 w; w.x = pk2(v0[0], v0[1]); w.y = pk2(v0[2], v0[3]); w.z = pk2(v1[0], v1[1]); w.w = pk2(v1[2], v1[3]); *(u32x4*)(rowp + bj * 128) = w; } }
    }
};
__device__ __forceinline__ int slot32(int d) { return 16 * ((d >> 2) & 1) + 4 * ((d >> 3) & 3) + (d & 3); }
__device__ __forceinline__ int win_dest(int s) {
    if (s < 512) { const int hd = s >> 6, d64 = s & 63; return 256 * (hd >> 2) + 128 * (d64 >> 5) + 32 * (hd & 3) + slot32(d64 & 31); }
    if (s < 640) { const int hd = (s - 512) >> 6, d64 = s & 63; return 512 + 128 * (d64 >> 5) + 32 * hd + slot32(d64 & 31); }
    if (s < 768) { const int v = s - 640; return 512 + 128 * (v >> 6) + 32 * (2 + ((v & 63) >> 5)) + slot32(v & 31); }
    if (s < 1024) { const int hd = (s - 768) >> 6, d64 = s & 63; return 768 + 128 * (d64 >> 5) + 32 * hd + slot32(d64 & 31); }
    if (s < 1088) { const int d64 = s - 1024; return 1024 + 128 * (d64 >> 5) + slot32(d64 & 31); }
    if (s < 1092) return 1024 + 32 + (s - 1088);
    if (s < 1348) { const int v = s - 1092; return 1280 + (v & ~31) + slot32(v & 31); }
    { const int v = s - 1348; return 1536 + (v & ~31) + slot32(v & 31); }
}
__device__ __forceinline__ int perm_dest(int s) { return (s & ~31) + 16 * ((s >> 2) & 1) + 4 * ((s >> 3) & 3) + (s & 3); }
__device__ __forceinline__ int w1_dest(int s) { const int jg = s >> 1, isl = s & 1, nt = jg >> 7, ja = jg & 127; return 256 * nt + 128 * isl + (ja & ~31) + slot32(ja & 31); }

template <int MAP>
__device__ __forceinline__ void transpose_item(const float* W, int N, bf16_t* WT, LAS float* scr, int kb, int nb, int lane) {
    const int k0 = 64 * kb, n0 = 32 * nb, col = n0 + (lane & 31); const bool ok = col < N;
    float v[32];
    const float* src = W + (size_t)(k0 + (lane >> 5)) * N + (ok ? col : 0);
#pragma unroll
    for (int i = 0; i < 32; ++i) v[i] = src[(size_t)(2 * i) * N];
#pragma unroll
    for (int i = 0; i < 32; ++i) scr[(2 * i + (lane >> 5)) * 33 + (lane & 31)] = ok ? v[i] : 0.f;
    asm volatile("s_waitcnt lgkmcnt(0)" ::: "memory");
    const int c = lane & 7;
#pragma unroll
    for (int j = 0; j < 4; ++j) { const int n = (lane >> 3) + 8 * j; const LAS float* s = scr + (8 * c) * 33 + n;
        u32x4 o; o.x = pk2(s[0 * 33], s[1 * 33]); o.y = pk2(s[2 * 33], s[3 * 33]); o.z = pk2(s[4 * 33], s[5 * 33]); o.w = pk2(s[6 * 33], s[7 * 33]);
        const int sc = n0 + n;
        if (sc < N) { const int dest = MAP == 1 ? win_dest(sc) : (MAP == 2 ? w1_dest(sc) : (MAP == 3 ? perm_dest(sc) : sc)); *(u32x4*)(WT + (size_t)dest * 1024 + k0 + 8 * c) = o; } }
    asm volatile("s_waitcnt lgkmcnt(0)" ::: "memory");
}

__device__ __forceinline__ void phase_prep(const Args& a, Ctx& C) {
    unsigned char* ws = C.ws;
    {
        LAS float* ca = (LAS float*)C.lds;
        LAS float* red = ca + 4096;
        for (int i = C.tid; i < 4096; i += NTHREADS) { const float v = a.c[i]; ca[i] = siluf_(v); }
        __syncthreads();
        for (int it = blockIdx.x; it < 192; it += C.G) {
            const int l = it / 96, cb = it % 96, col = cb * 64 + (C.tid & 63), kg = C.tid >> 6;
            const float* w = a.w_ada + (size_t)l * 1024 * 6144 + col;
            float s0 = 0.f, s1 = 0.f, s2 = 0.f, s3 = 0.f;
#pragma unroll 8
            for (int k = kg * 128; k < kg * 128 + 128; ++k) { const float wv = w[(size_t)k * 6144]; s0 += ca[k] * wv; s1 += ca[1024 + k] * wv; s2 += ca[2048 + k] * wv; s3 += ca[3072 + k] * wv; }
            red[(kg * 4 + 0) * 64 + (C.tid & 63)] = s0; red[(kg * 4 + 1) * 64 + (C.tid & 63)] = s1; red[(kg * 4 + 2) * 64 + (C.tid & 63)] = s2; red[(kg * 4 + 3) * 64 + (C.tid & 63)] = s3;
            __syncthreads();
            if (C.tid < 256) { const int b = C.tid >> 6, cc = C.tid & 63; float s = 0.f;
#pragma unroll
                for (int g = 0; g < 8; ++g) s += red[(g * 4 + b) * 64 + cc];
                ((float*)(ws + WS_MOD))[(size_t)(l * 4 + b) * 6144 + cb * 64 + cc] = s + a.b_ada[l * 6144 + cb * 64 + cc]; }
            __syncthreads();
        }
    }
    const int gw = C.vcu * NWAVES + C.wave, NGW = C.G * NWAVES;
    for (int tk = gw; tk < NTOK; tk += NGW) {
        if (C.lane < 32) {
            const float posf = (float)a.pos[tk];
            const float inv = exp2f(-(float)C.lane * (13.287712379549449f / 32.0f));
            const double ang = (double)(posf * inv);
            const double kq = rint(ang * 0.63661977236758134308);
            const double y = fma(-kq, 1.57079632679489661923, ang);
            const double y2 = y * y;
            const double sy = y * (1.0 + y2 * (-1.0 / 6 + y2 * (1.0 / 120 + y2 * (-1.0 / 5040 + y2 * (1.0 / 362880 - y2 * (1.0 / 39916800))))));
            const double cy = 1.0 + y2 * (-0.5 + y2 * (1.0 / 24 + y2 * (-1.0 / 720 + y2 * (1.0 / 40320 + y2 * (-1.0 / 3628800 + y2 * (1.0 / 479001600))))));
            const int q = ((int)((long long)kq)) & 3;
            const double sn = (q == 0) ? sy : (q == 1) ? cy : (q == 2) ? -sy : -cy;
            const double cs = (q == 0) ? cy : (q == 1) ? -sy : (q == 2) ? -cy : sy;
            ((float*)(ws + WS_ROPEC))[(size_t)tk * 32 + C.lane] = (float)cs;
            ((float*)(ws + WS_ROPES))[(size_t)tk * 32 + C.lane] = (float)sn;
        }
    }
    for (int i = gw * 64 + C.lane; i < 2 * 32 * 1024; i += NGW * 64) { const int l = i >> 15, e = (i >> 10) & 31, k = i & 1023; const float wv = a.w_router[(size_t)l * 32768 + k * 32 + e];
        const unsigned hi = f2bf(wv); const float lo = wv - bf2f((unsigned short)hi); ((bf16_t*)(ws + WS_WRH))[i] = (bf16_t)hi; ((bf16_t*)(ws + WS_WRL))[i] = (bf16_t)f2bf(lo); }
    LAS float* scr = (LAS float*)(C.lds + C.wave * 16384);
    constexpr int I_IN = 2 * 16 * 75, I_OUT = 2 * 16 * 32;
    for (int it = gw; it < I_IN + I_OUT; it += NGW) {
        int r = it;
        if (r < I_IN) { const int l = r / (16 * 75), q = r % (16 * 75); transpose_item<1>(a.w_in + (size_t)l * 1024 * D_IN, D_IN, (bf16_t*)(ws + WS_WIN) + (size_t)l * NPAD * 1024, scr, q / 75, q % 75, C.lane); continue; }
        r -= I_IN;
        { const int l = r / (16 * 32), q = r % (16 * 32); transpose_item<3>(a.w_out + (size_t)l * 1024 * 1024, 1024, (bf16_t*)(ws + WS_WOUT) + (size_t)l * 1024 * 1024, scr, q / 32, q % 32, C.lane); }
    }
}

struct Conv {
    const float* w1l; const float* w2l; bf16_t* w1t; bf16_t* w2t;
    int it, step, lane; bool pend;
    const float* W; bf16_t* WT; int N, map, k0, n0;
    f32x4 v4[8];
    static constexpr int NITEMS = 32 * 16 * 64 + 32 * 16 * 32;
    int it_end;
    __device__ __forceinline__ void issue() {
        if (it >= it_end) return;
        if (it < 32 * 16 * 64) { const int e = it >> 10, q = it & 1023; W = w1l + (size_t)e * 1024 * 2048; WT = w1t + (size_t)e * 2048 * 1024; N = 2048; map = 2; k0 = 64 * (q >> 6); n0 = 32 * (q & 63); }
        else { const int r = it - 32 * 16 * 64, e = r >> 9, q = r & 511; W = w2l + (size_t)e * 1024 * 1024; WT = w2t + (size_t)e * 1024 * 1024; N = 1024; map = 3; k0 = 64 * (q >> 5); n0 = 32 * (q & 31); }
        const float* src = W + (size_t)(k0 + (lane >> 3)) * N + n0 + 4 * (lane & 7);
#pragma unroll
        for (int i = 0; i < 8; ++i) v4[i] = *(const f32x4*)(src + (size_t)(8 * i) * N);
        pend = true; it += step;
    }
    __device__ __forceinline__ void finish(LAS float* scr) {
        if (!pend) return;
#pragma unroll
        for (int i = 0; i < 8; ++i) { LAS float* d = scr + ((lane >> 3) + 8 * i) * 33 + 4 * (lane & 7); d[0] = v4[i].x; d[1] = v4[i].y; d[2] = v4[i].z; d[3] = v4[i].w; }
        asm volatile("s_waitcnt lgkmcnt(0)" ::: "memory");
        const int c = lane & 7;
#pragma unroll
        for (int j = 0; j < 4; ++j) { const int n = (lane >> 3) + 8 * j; const LAS float* sp = scr + (8 * c) * 33 + n;
            u32x4 o; o.x = pk2(sp[0 * 33], sp[1 * 33]); o.y = pk2(sp[2 * 33], sp[3 * 33]); o.z = pk2(sp[4 * 33], sp[5 * 33]); o.w = pk2(sp[6 * 33], sp[7 * 33]);
            const int sc = n0 + n; const int dest = map == 2 ? w1_dest(sc) : perm_dest(sc); *(u32x4*)(WT + (size_t)dest * 1024 + k0 + 8 * c) = o; }
        asm volatile("s_waitcnt lgkmcnt(0)" ::: "memory");
        pend = false;
    }
};

__device__ __forceinline__ void norm_mod_store(const f32x4 (&v)[4], const float* g, const float* sh, const float* sc, bf16_t* urow, int lane) {
    float ss = 0.f;
#pragma unroll
    for (int j = 0; j < 4; ++j) ss += (v[j].x * v[j].x + v[j].y * v[j].y) + (v[j].z * v[j].z + v[j].w * v[j].w);
    const float rstd = 1.0f / sqrtf(wave_sum(ss) * (1.0f / D) + EPS);
#pragma unroll
    for (int j = 0; j < 4; ++j) { const int idx = 4 * lane + 256 * j; const f32x4 gv = *(const f32x4*)(g + idx), shv = *(const f32x4*)(sh + idx), scv = *(const f32x4*)(sc + idx);
        const f32x4 o = v[j] * rstd * gv * (scv + 1.0f) + shv; u32x2 w; w.x = pk2(o[0], o[1]); w.y = pk2(o[2], o[3]); *(u32x2*)(urow + idx) = w; }
}

__device__ __forceinline__ void phase_u0(const Args& a, Ctx& C) {
    const int gw = C.vcu * NWAVES + C.wave, NGW = C.G * NWAVES; const float* mod = (const float*)(C.ws + WS_MOD);
    for (int tk0 = gw; tk0 < NTOK; tk0 += 2 * NGW) {
        const bool two = (tk0 + NGW) < NTOK; const int tk1 = two ? tk0 + NGW : tk0;
        const f32x4* x0 = (const f32x4*)(a.x + (size_t)tk0 * D) + C.lane; const f32x4* x1 = (const f32x4*)(a.x + (size_t)tk1 * D) + C.lane; f32x4 v0[4], v1[4];
#pragma unroll
        for (int j = 0; j < 4; ++j) { v0[j] = x0[64 * j]; v1[j] = x1[64 * j]; }
        { const float* mb = mod + (size_t)(tk0 >> 12) * 6144; norm_mod_store(v0, a.norm1_g, mb + 0, mb + 1024, (bf16_t*)(C.ws + WS_U) + (size_t)tk0 * D, C.lane); }
        if (two) { const float* mb = mod + (size_t)(tk1 >> 12) * 6144; norm_mod_store(v1, a.norm1_g, mb + 0, mb + 1024, (bf16_t*)(C.ws + WS_U) + (size_t)tk1 * D, C.lane); }
    }
}

__device__ __forceinline__ unsigned sortable(float f) { const unsigned u = __builtin_bit_cast(unsigned, f); return (u & 0x80000000u) ? ~u : (u | 0x80000000u); }
__device__ __forceinline__ int mbcnt64(unsigned long long m) { return __builtin_amdgcn_mbcnt_hi((unsigned)(m >> 32), __builtin_amdgcn_mbcnt_lo((unsigned)m, 0)); }

constexpr int HP = 65;
__device__ __forceinline__ int wave_isum(int v) {
    v += __builtin_amdgcn_update_dpp(0, v, 0xB1, 0xF, 0xF, true);
    v += __builtin_amdgcn_update_dpp(0, v, 0x4E, 0xF, 0xF, true);
    v += __builtin_amdgcn_update_dpp(0, v, 0x141, 0xF, 0xF, true);
    v += __builtin_amdgcn_update_dpp(0, v, 0x140, 0xF, 0xF, true);
    return __builtin_amdgcn_readlane(v, 0) + __builtin_amdgcn_readlane(v, 16) + __builtin_amdgcn_readlane(v, 32) + __builtin_amdgcn_readlane(v, 48);
}
typedef float f32x16 __attribute__((ext_vector_type(16)));
__device__ __forceinline__ void transpose32(unsigned (&a)[32]) {
#pragma unroll
    for (int st = 0; st < 5; ++st) {
        const int j = 16 >> st; const unsigned m = (st == 0) ? 0x0000FFFFu : (st == 1) ? 0x00FF00FFu : (st == 2) ? 0x0F0F0F0Fu : (st == 3) ? 0x33333333u : 0x55555555u;
#pragma unroll
        for (int idx = 0; idx < 16; ++idx) { const int k = (idx / j) * 2 * j + (idx % j); const unsigned t = (a[k] ^ (a[k + j] >> j)) & m; a[k] ^= t; a[k + j] ^= (t << j); }
    }
}
__device__ __forceinline__ int wave_iscan(int v) {
    v += __builtin_amdgcn_update_dpp(0, v, 0x111, 0xF, 0xF, true);
    v += __builtin_amdgcn_update_dpp(0, v, 0x112, 0xF, 0xF, true);
    v += __builtin_amdgcn_update_dpp(0, v, 0x114, 0xF, 0xF, true);
    v += __builtin_amdgcn_update_dpp(0, v, 0x118, 0xF, 0xF, true);
    v += __builtin_amdgcn_update_dpp(0, v, 0x142, 0xA, 0xF, false);
    v += __builtin_amdgcn_update_dpp(0, v, 0x143, 0xC, 0xF, false);
    return v;
}
__device__ __forceinline__ unsigned sortable16(unsigned h) { return (h & 0x8000u) ? (~h & 0xFFFFu) : (h | 0x8000u); }
__device__ __forceinline__ unsigned short f2h_bits(float f) { const _Float16 h = (_Float16)f; unsigned short b = __builtin_bit_cast(unsigned short, h); return b == 0x8000u ? (unsigned short)0 : b; }
template <int NB>
__device__ __forceinline__ void select_bits16(const LAS unsigned short* sq, int nj, int* sel, int lane) {
    unsigned a[32];
#pragma unroll
    for (int j = 0; j < 32; ++j) { const unsigned lo = sortable16(sq[64 * j + lane]); const unsigned hi = (NB == 2) ? sortable16(sq[64 * (32 + j) + lane]) : 0u; a[j] = lo | (hi << 16); }
    transpose32(a);
    unsigned Ml = 0xFFFFFFFFu, Mh = (NB == 2) ? 0xFFFFFFFFu : 0u, Gl = 0u, Gh = 0u; unsigned T = 0u; int G = 0;
#pragma unroll
    for (int bit = 15; bit >= 0; --bit) {
        const unsigned nl = Ml & a[31 - bit], nh = Mh & a[15 - bit];
        const int tot = wave_isum(__popc(nl) + __popc(nh));
        const bool take = (G + tot) >= 256; const unsigned flip = take ? 0u : 0xFFFFFFFFu;
        T |= take ? (1u << bit) : 0u; G += take ? 0 : tot;
        Gl |= nl & flip; Gh |= nh & flip; Ml &= (a[31 - bit] ^ flip); Mh &= (a[15 - bit] ^ flip);
    }
    const int need = 256 - G;
    if (T != 0x8000u) {
        const int ceq = __popc(Ml) + __popc(Mh); const int incl = wave_iscan(ceq);
        int quota = need - (incl - ceq); quota = quota < 0 ? 0 : (quota > ceq ? ceq : quota);
        const int cnt = __popc(Gl) + __popc(Gh) + quota; const int inc2 = wave_iscan(cnt);
        int pos = inc2 - cnt;
        { unsigned mk = Gl; while (mk) { const int x = 31 - __clz((int)mk); mk &= ~(1u << x); sel[pos++] = 64 * (31 - x) + lane; } }
        if (NB == 2) { unsigned mk = Gh; while (mk) { const int x = 31 - __clz((int)mk); mk &= ~(1u << x); sel[pos++] = 64 * (63 - x) + lane; } }
        { unsigned mk = Ml; while (mk && quota > 0) { const int x = 31 - __clz((int)mk); mk &= ~(1u << x); sel[pos++] = 64 * (31 - x) + lane; --quota; } }
        if (NB == 2) { unsigned mk = Mh; while (mk && quota > 0) { const int x = 31 - __clz((int)mk); mk &= ~(1u << x); sel[pos++] = 64 * (63 - x) + lane; --quota; } }
    } else {
        int base = 0, eqseen = 0;
#pragma unroll 1
        for (int j = 0; j < nj; ++j) {
            const unsigned kj = sortable16(sq[64 * j + lane]);
            const bool gt = kj > T, eq = kj == T; const unsigned long long em = __ballot(eq);
            const bool take = gt || (eq && (eqseen + mbcnt64(em)) < need); const unsigned long long tm = __ballot(take);
            if (take) sel[base + mbcnt64(tm)] = 64 * j + lane;
            base += __popcll(tm); eqseen += __popcll(em);
        }
    }
}
constexpr int CONV_SPLIT = 16384;
constexpr int KST_ROW = 144, KST_BYTES = 64 * KST_ROW;
__device__ __forceinline__ void index_unit2(Ctx& C, int b, int cch, int sub, Conv& cv) {
    unsigned char* ws = C.ws; const int lane = C.lane, w = C.wave;
    const int tk0 = b * SEQ + 64 * cch + 8 * sub, L = 64 * (cch + 1), nj = cch + 1;
    if (L <= 256) { int* sel = (int*)(ws + WS_SEL) + (size_t)(tk0 + w) * 256; for (int i = lane; i < L; i += 64) sel[i] = i; return; }
    LAS unsigned short* sclh = (LAS unsigned short*)C.lds;
    LAS unsigned char* kst = C.lds + 65536 + w * KST_BYTES;
    {
        const int r = lane & 31, hf = lane >> 5, qq = r >> 2, h = r & 3;
        bf16x8 aq[4];
#pragma unroll
        for (int ks = 0; ks < 4; ++ks) aq[ks] = *(const bf16x8*)((const bf16_t*)(ws + WS_QI) + (size_t)(tk0 + qq) * 256 + h * 64 + 16 * ks + 8 * hf);
        f32x4 wq[4];
#pragma unroll
        for (int g = 0; g < 4; ++g) wq[g] = *(const f32x4*)((const float*)(ws + WS_WI) + (size_t)(tk0 + 2 * g + hf) * 4);
        const unsigned char* kib = ws + WS_KI + (size_t)b * SEQ * 128;
        const int ntile = 2 * nj;
        u32x4 st[8];
#define IDX2_LOAD(kta) do { const int _t1 = (kta), _t2 = ((kta) + NWAVES) < ntile ? (kta) + NWAVES : (kta); _Pragma("unroll") for (int j = 0; j < 4; ++j) { \
            st[j] = *(const u32x4*)(kib + (size_t)_t1 * 4096 + 1024 * j + 16 * lane); st[4 + j] = *(const u32x4*)(kib + (size_t)_t2 * 4096 + 1024 * j + 16 * lane); } } while (0)
        if (w < ntile) IDX2_LOAD(w);
#pragma unroll 1
        for (int kt = w; kt < ntile; kt += 2 * NWAVES) {
            const bool two = (kt + NWAVES) < ntile; const int kt2 = two ? kt + NWAVES : kt;
#pragma unroll
            for (int j = 0; j < 4; ++j) { *(LAS u32x4*)(kst + (8 * j + (lane >> 3)) * KST_ROW + 16 * (lane & 7)) = st[j]; *(LAS u32x4*)(kst + (32 + 8 * j + (lane >> 3)) * KST_ROW + 16 * (lane & 7)) = st[4 + j]; }
            if ((kt + 2 * NWAVES) < ntile) IDX2_LOAD(kt + 2 * NWAVES);
            f32x16 acc, acc2;
#pragma unroll
            for (int i = 0; i < 16; ++i) { acc[i] = 0.f; acc2[i] = 0.f; }
#pragma unroll
            for (int ks = 0; ks < 4; ++ks) { const bf16x8 b1 = *(const LAS bf16x8*)(kst + r * KST_ROW + 32 * ks + 16 * hf), b2 = *(const LAS bf16x8*)(kst + (32 + r) * KST_ROW + 32 * ks + 16 * hf);
                acc = __builtin_amdgcn_mfma_f32_32x32x16_bf16(aq[ks], b1, acc, 0, 0, 0); acc2 = __builtin_amdgcn_mfma_f32_32x32x16_bf16(aq[ks], b2, acc2, 0, 0, 0); }
#pragma unroll
            for (int g = 0; g < 4; ++g) {
                const float sc = fmaxf(acc[4 * g + 0], 0.f) * wq[g][0] + fmaxf(acc[4 * g + 1], 0.f) * wq[g][1] + fmaxf(acc[4 * g + 2], 0.f) * wq[g][2] + fmaxf(acc[4 * g + 3], 0.f) * wq[g][3];
                sclh[(2 * g + hf) * 4096 + 32 * kt + r] = f2h_bits(sc);
                const float sc2 = fmaxf(acc2[4 * g + 0], 0.f) * wq[g][0] + fmaxf(acc2[4 * g + 1], 0.f) * wq[g][1] + fmaxf(acc2[4 * g + 2], 0.f) * wq[g][2] + fmaxf(acc2[4 * g + 3], 0.f) * wq[g][3];
                if (two) sclh[(2 * g + hf) * 4096 + 32 * kt2 + r] = f2h_bits(sc2);
            }
        }
#undef IDX2_LOAD
        const int njp = nj <= 32 ? 32 : 64;
        for (int j = nj; j < njp; ++j) sclh[w * 4096 + 64 * j + lane] = (unsigned short)0xFBFFu;
    }
    __syncthreads();
    {
        const LAS unsigned short* sq = sclh + w * 4096; int* sel = (int*)(ws + WS_SEL) + (size_t)(tk0 + w) * 256;
        cv.issue();
        if (nj <= 32) select_bits16<1>(sq, nj, sel, lane); else select_bits16<2>(sq, nj, sel, lane);
        cv.finish((LAS float*)kst);
    }
    __syncthreads();
}

typedef short s16x4 __attribute__((ext_vector_type(4)));
constexpr int VROW = 272;
__device__ __forceinline__ void attend_query_mfma(Ctx& C, int tk, LAS unsigned char* vs, Conv& cv) {
    unsigned char* ws = C.ws; const int lane = C.lane, c = lane & 15, g = lane >> 4;
    const int tpos = tk & (SEQ - 1), b = tk >> 12, L = 64 * ((tpos >> 6) + 1), nsel = L < 256 ? L : 256;
    const bf16_t* kb = (const bf16_t*)(ws + WS_K) + (size_t)b * SEQ * 128; const bf16_t* vb = (const bf16_t*)(ws + WS_V) + (size_t)b * SEQ * 128;
    int selr[4];
    { const int* sg = (const int*)(ws + WS_SEL) + (size_t)tk * 256;
#pragma unroll
      for (int i = 0; i < 4; ++i) selr[i] = (64 * i + lane) < nsel ? sg[64 * i + lane] : 0; }
    bf16x8 bq0[2], bq1[2];
    { const bf16_t* qp = (const bf16_t*)(ws + WS_Q) + (size_t)tk * 512 + (c & 7) * 64 + 8 * g; const bf16x8 z = (bf16x8){0, 0, 0, 0, 0, 0, 0, 0};
#pragma unroll
      for (int ks = 0; ks < 2; ++ks) { const bf16x8 q = *(const bf16x8*)(qp + 32 * ks); bq0[ks] = (c < 4) ? q : z; bq1[ks] = (c >= 4 && c < 8) ? q : z; } }
    cv.issue();
    f32x4 acc[16];
#pragma unroll
    for (int kt = 0; kt < 16; ++kt) {
        if ((kt & 3) == 0) asm volatile("" ::: "memory");
        const int key = __shfl(selr[kt >> 2], 16 * (kt & 3) + c);
        const bf16_t* kr = kb + (size_t)key * 128 + 8 * g;
        const bf16x8 a00 = *(const bf16x8*)(kr), a01 = *(const bf16x8*)(kr + 32), a10 = *(const bf16x8*)(kr + 64), a11 = *(const bf16x8*)(kr + 96);
        f32x4 t = (f32x4){0.f, 0.f, 0.f, 0.f};
        t = __builtin_amdgcn_mfma_f32_16x16x32_bf16(a00, bq0[0], t, 0, 0, 0); t = __builtin_amdgcn_mfma_f32_16x16x32_bf16(a01, bq0[1], t, 0, 0, 0);
        t = __builtin_amdgcn_mfma_f32_16x16x32_bf16(a10, bq1[0], t, 0, 0, 0); t = __builtin_amdgcn_mfma_f32_16x16x32_bf16(a11, bq1[1], t, 0, 0, 0);
        acc[kt] = t;
    }
    asm volatile("" ::: "memory"); cv.finish((LAS float*)vs); cv.issue();
    { const int lim = nsel - 4 * g;
#pragma unroll
      for (int kt = 0; kt < 16; ++kt)
#pragma unroll
        for (int r = 0; r < 4; ++r) acc[kt][r] = (16 * kt + r < lim) ? acc[kt][r] : -1e30f; }
    float m = -1e30f;
#pragma unroll
    for (int kt = 0; kt < 16; ++kt) m = fmaxf(m, fmaxf(fmaxf(acc[kt][0], acc[kt][1]), fmaxf(acc[kt][2], acc[kt][3])));
    m = fmaxf(m, __shfl_xor(m, 16)); m = fmaxf(m, __shfl_xor(m, 32));
    float sum = 0.f;
#pragma unroll
    for (int kt = 0; kt < 16; ++kt)
#pragma unroll
        for (int r = 0; r < 4; ++r) { const float pv = __expf(acc[kt][r] - m); acc[kt][r] = pv; sum += pv; }
    sum += __shfl_xor(sum, 16); sum += __shfl_xor(sum, 32);
    const float inv = 1.0f / sum;
    bf16x8 bp[8];
#pragma unroll
    for (int T = 0; T < 8; ++T) { u32x4 w; w.x = cvt_pk_bf16(acc[2 * T][0], acc[2 * T][1]); w.y = cvt_pk_bf16(acc[2 * T][2], acc[2 * T][3]); w.z = cvt_pk_bf16(acc[2 * T + 1][0], acc[2 * T + 1][1]); w.w = cvt_pk_bf16(acc[2 * T + 1][2], acc[2 * T + 1][3]);
        bp[T] = __builtin_bit_cast(bf16x8, w); }
    f32x4 ao0[4], ao1[4];
#pragma unroll
    for (int dt = 0; dt < 4; ++dt) { ao0[dt] = (f32x4){0.f, 0.f, 0.f, 0.f}; ao1[dt] = (f32x4){0.f, 0.f, 0.f, 0.f}; }
    const int q4 = c >> 2, p4 = c & 3;
    u32x4 vst[8];
#define ATT_VLOAD(T) do { _Pragma("unroll") for (int i = 0; i < 8; ++i) { const int row = g + 4 * i; \
        const int key = __shfl(selr[(T) >> 1], 32 * ((T) & 1) + row); vst[i] = *(const u32x4*)(vb + (size_t)key * 128 + 8 * c); } } while (0)
    ATT_VLOAD(0);
#pragma unroll
    for (int T = 0; T < 8; ++T) {
        LAS unsigned char* buf = vs + (T & 1) * (32 * VROW);
        asm volatile("" ::: "memory");
#pragma unroll
        for (int i = 0; i < 8; ++i) *(LAS u32x4*)(buf + (g + 4 * i) * VROW + 16 * c) = vst[i];
        if (T < 7) ATT_VLOAD(T + 1);
#pragma unroll
        for (int n = 0; n < 2; ++n)
#pragma unroll
            for (int dt = 0; dt < 4; ++dt) {
                LAS s16x4* p0 = (LAS s16x4*)(buf + (4 * g + q4) * VROW + (n * 64 + 16 * dt + 4 * p4) * 2);
                const s16x4 lo = __builtin_amdgcn_ds_read_tr16_b64_v4i16(p0), hi = __builtin_amdgcn_ds_read_tr16_b64_v4i16((LAS s16x4*)((LAS unsigned char*)p0 + 16 * VROW));
                const bf16x8 av = (bf16x8){lo[0], lo[1], lo[2], lo[3], hi[0], hi[1], hi[2], hi[3]};
                if (n == 0) ao0[dt] = __builtin_amdgcn_mfma_f32_16x16x32_bf16(av, bp[T], ao0[dt], 0, 0, 0);
                else ao1[dt] = __builtin_amdgcn_mfma_f32_16x16x32_bf16(av, bp[T], ao1[dt], 0, 0, 0);
            }
    }
#undef ATT_VLOAD
    asm volatile("" ::: "memory"); cv.finish((LAS float*)vs);
    if (c < 8) {
        bf16_t* mo = (bf16_t*)(ws + WS_MIX) + (size_t)tk * D + c * 64 + 4 * g;
#pragma unroll
        for (int dt = 0; dt < 4; ++dt) { f32x4 o; o[0] = (c < 4 ? ao0[dt][0] : ao1[dt][0]) * inv; o[1] = (c < 4 ? ao0[dt][1] : ao1[dt][1]) * inv; o[2] = (c < 4 ? ao0[dt][2] : ao1[dt][2]) * inv; o[3] = (c < 4 ? ao0[dt][3] : ao1[dt][3]) * inv; u32x2 w; w.x = cvt_pk_bf16(o[0], o[1]); w.y = cvt_pk_bf16(o[2], o[3]); *(u32x2*)(mo + 16 * dt) = w; }
    }
}

template <bool WITH_Q>
__device__ __forceinline__ void hgrn_fill(const Args& a, Ctx& C, int l, int hh, size_t tok0, LAS float* fz, LAS float* kn, LAS float* qq, LAS float* vv) {
    const int tid = C.tid, sr = tid >> 3, k8 = (tid & 7) * 8; const float* row = (const float*)(C.ws + WS_HG) + (tok0 + sr) * 1024 + hh * 64 + k8;
    const f32x4 z0 = *(const f32x4*)(row + 256), z1 = *(const f32x4*)(row + 260); const float zz[8] = {z0.x, z0.y, z0.z, z0.w, z1.x, z1.y, z1.z, z1.w}; float fo[8], ko[8];
#pragma unroll
    for (int j = 0; j < 8; ++j) { const int kk = hh * 64 + k8 + j; const float lb = (l == 1) ? 1.0f / (1.0f + expf(a.lb_logits[kk] - a.lb_logits[256 + kk])) : 0.f;
        const float sg = 1.0f / (1.0f + expf(-zz[j])), sn = 1.0f / (1.0f + expf(zz[j])); fo[j] = lb + (1.0f - lb) * sg; ko[j] = (1.0f - lb) * sn; }
    *(LAS f32x4*)(fz + sr * 64 + k8) = (f32x4){fo[0], fo[1], fo[2], fo[3]}; *(LAS f32x4*)(fz + sr * 64 + k8 + 4) = (f32x4){fo[4], fo[5], fo[6], fo[7]};
    *(LAS f32x4*)(kn + sr * 64 + k8) = (f32x4){ko[0], ko[1], ko[2], ko[3]}; *(LAS f32x4*)(kn + sr * 64 + k8 + 4) = (f32x4){ko[4], ko[5], ko[6], ko[7]};
    if (WITH_Q) { const f32x4 q0 = *(const f32x4*)row, q1 = *(const f32x4*)(row + 4);
        *(LAS f32x4*)(qq + sr * 64 + k8) = (f32x4){siluf_(q0.x), siluf_(q0.y), siluf_(q0.z), siluf_(q0.w)}; *(LAS f32x4*)(qq + sr * 64 + k8 + 4) = (f32x4){siluf_(q1.x), siluf_(q1.y), siluf_(q1.z), siluf_(q1.w)}; }
    *(LAS f32x4*)(vv + sr * 64 + k8) = *(const f32x4*)(row + 512); *(LAS f32x4*)(vv + sr * 64 + k8 + 4) = *(const f32x4*)(row + 516);
}
__device__ __forceinline__ void hgrn_local2(const Args& a, Ctx& C, int l, int item) {
    const int tid = C.tid, c = item & 63, hh = (item >> 6) & 3, b = item >> 8, v = tid & 63, kq = tid >> 6;
    LAS float* fz = (LAS float*)C.lds; LAS float* kn = fz + 4096; LAS float* vv = kn + 4096;
    hgrn_fill<false>(a, C, l, hh, (size_t)b * SEQ + c * 64, fz, kn, nullptr, vv);
    __syncthreads();
    float S[8] = {0.f, 0.f, 0.f, 0.f, 0.f, 0.f, 0.f, 0.f}, dp[8] = {1.f, 1.f, 1.f, 1.f, 1.f, 1.f, 1.f, 1.f};
#pragma unroll 4
    for (int sx = 0; sx < 64; ++sx) { const f32x4 f0 = *(const LAS f32x4*)(fz + sx * 64 + 8 * kq), f1 = *(const LAS f32x4*)(fz + sx * 64 + 8 * kq + 4), k0 = *(const LAS f32x4*)(kn + sx * 64 + 8 * kq), k1 = *(const LAS f32x4*)(kn + sx * 64 + 8 * kq + 4);
        const float vs = vv[sx * 64 + v]; const float ff[8] = {f0.x, f0.y, f0.z, f0.w, f1.x, f1.y, f1.z, f1.w}, kk[8] = {k0.x, k0.y, k0.z, k0.w, k1.x, k1.y, k1.z, k1.w};
#pragma unroll
        for (int j = 0; j < 8; ++j) { S[j] = ff[j] * S[j] + kk[j] * vs; dp[j] *= ff[j]; } }
    float* hl = (float*)(C.ws + WS_HL) + (size_t)item * 4096 + (8 * kq) * 64 + v;
#pragma unroll
    for (int j = 0; j < 8; ++j) hl[j * 64] = S[j];
    if (v == 0) { float* hd = (float*)(C.ws + WS_HD) + (size_t)item * 64 + 8 * kq;
#pragma unroll
        for (int j = 0; j < 8; ++j) hd[j] = dp[j]; }
    __syncthreads();
}
__device__ __forceinline__ void hgrn_out2(const Args& a, Ctx& C, int l, int item) {
    const int tid = C.tid, cg = item & 15, hh = (item >> 4) & 3, b = item >> 6, c0 = 4 * cg, bh = b * 4 + hh, v = tid & 63, kq = tid >> 6;
    LAS float* fz = (LAS float*)C.lds; LAS float* kn = fz + 4096; LAS float* qq = kn + 4096; LAS float* vv = qq + 4096; LAS float* part = vv + 4096;
    const float* HLb = (const float*)(C.ws + WS_HL) + (size_t)bh * 64 * 4096 + (8 * kq) * 64 + v; const float* HDb = (const float*)(C.ws + WS_HD) + (size_t)bh * 64 * 64 + 8 * kq;
    float S[8] = {0.f, 0.f, 0.f, 0.f, 0.f, 0.f, 0.f, 0.f};
#pragma unroll 2
    for (int j = 0; j < c0; ++j) { const f32x4 d0 = *(const f32x4*)(HDb + (size_t)j * 64), d1 = *(const f32x4*)(HDb + (size_t)j * 64 + 4); const float dd[8] = {d0.x, d0.y, d0.z, d0.w, d1.x, d1.y, d1.z, d1.w};
#pragma unroll
        for (int i = 0; i < 8; ++i) S[i] = dd[i] * S[i] + HLb[(size_t)j * 4096 + i * 64]; }
#pragma unroll 1
    for (int c = c0; c < c0 + 4; ++c) {
        const size_t tok0 = (size_t)b * SEQ + c * 64;
        hgrn_fill<true>(a, C, l, hh, tok0, fz, kn, qq, vv);
        __syncthreads();
#pragma unroll 1
        for (int half = 0; half < 2; ++half) {
#pragma unroll 4
            for (int sl = 0; sl < 32; ++sl) { const int sx = 32 * half + sl;
                const f32x4 f0 = *(const LAS f32x4*)(fz + sx * 64 + 8 * kq), f1 = *(const LAS f32x4*)(fz + sx * 64 + 8 * kq + 4), k0 = *(const LAS f32x4*)(kn + sx * 64 + 8 * kq), k1 = *(const LAS f32x4*)(kn + sx * 64 + 8 * kq + 4);
                const f32x4 q0 = *(const LAS f32x4*)(qq + sx * 64 + 8 * kq), q1 = *(const LAS f32x4*)(qq + sx * 64 + 8 * kq + 4);
                const float vs = vv[sx * 64 + v]; const float ff[8] = {f0.x, f0.y, f0.z, f0.w, f1.x, f1.y, f1.z, f1.w}, kk[8] = {k0.x, k0.y, k0.z, k0.w, k1.x, k1.y, k1.z, k1.w}, qv[8] = {q0.x, q0.y, q0.z, q0.w, q1.x, q1.y, q1.z, q1.w};
                float op = 0.f;
#pragma unroll
                for (int j = 0; j < 8; ++j) { S[j] = ff[j] * S[j] + kk[j] * vs; op += qv[j] * S[j]; }
                part[(kq * 32 + sl) * 64 + v] = op; }
            __syncthreads();
            { const int t = tid >> 4, v4 = (tid & 15) * 4; f32x4 o = (f32x4){0.f, 0.f, 0.f, 0.f};
#pragma unroll
                for (int kk2 = 0; kk2 < 8; ++kk2) o += *(const LAS f32x4*)(part + (kk2 * 32 + t) * 64 + v4);
                float ss = o.x * o.x + o.y * o.y + o.z * o.z + o.w * o.w;
                ss += __shfl_xor(ss, 1); ss += __shfl_xor(ss, 2); ss += __shfl_xor(ss, 4); ss += __shfl_xor(ss, 8);
                const float rstd = 1.0f / sqrtf(ss * (1.0f / 64.0f) + EPS);
                const size_t tok = tok0 + 32 * half + t;
                const f32x4 gg = *(const f32x4*)((const float*)(C.ws + WS_HG) + tok * 1024 + 768 + hh * 64 + v4), ng = *(const f32x4*)(a.hgrn_g + l * 64 + v4);
                const float y0 = o.x * rstd * ng.x * siluf_(gg.x), y1 = o.y * rstd * ng.y * siluf_(gg.y), y2 = o.z * rstd * ng.z * siluf_(gg.z), y3 = o.w * rstd * ng.w * siluf_(gg.w);
                u32x2 wv; wv.x = pk2(y0, y1); wv.y = pk2(y2, y3);
                *(u32x2*)((bf16_t*)(C.ws + WS_MIX) + tok * D + 768 + hh * 64 + v4) = wv; }
            __syncthreads();
        }
    }
}

__device__ __forceinline__ void pool_wave(const Args& a, Ctx& C, int l) {
    unsigned char* ws = C.ws; const int lane = C.lane;
    const int gwv = blockIdx.x * NWAVES + C.wave, g = gwv & 3, widx = gwv >> 2, nw = (C.G * NWAVES) >> 2, w = 2 << g;
    float pwr[64];
#pragma unroll
    for (int c = 0; c < 64; ++c) pwr[c] = a.pool_w[(size_t)(l * 4 + g) * 4096 + c * 64 + lane];
    const float psc = a.pool_scale[l * 256 + g * 64 + lane];
    const float* ubg = (const float*)(ws + WS_UB) + g * 64 + lane;
    for (int tile = widx; tile < NTOK / 8; tile += nw) {
        const int tok0 = tile * 8, tp0 = tok0 & (SEQ - 1);
        float row[23];
#pragma unroll
        for (int r = 0; r < 23; ++r) { const int tp = tp0 - 15 + r; row[r] = (tp >= 0) ? ubg[(size_t)(tok0 - 15 + r) * 256] : 0.f; }
        float pooled[8];
#pragma unroll
        for (int t = 0; t < 8; ++t) {
            float sm = 0.f;
#pragma unroll
            for (int i = 0; i < 16; ++i) if (i < w) sm += row[15 + t - i];
            const int tpos = tp0 + t; const int wl = (tpos + 1) < w ? (tpos + 1) : w;
            pooled[t] = sm * (1.0f / (float)wl) - row[15 + t];
        }
        float y[8] = {0.f, 0.f, 0.f, 0.f, 0.f, 0.f, 0.f, 0.f};
#pragma unroll
        for (int c = 0; c < 64; ++c) {
#pragma unroll
            for (int t = 0; t < 8; ++t) y[t] += __builtin_bit_cast(float, __builtin_amdgcn_readlane(__builtin_bit_cast(int, pooled[t]), c)) * pwr[c];
        }
        bf16_t* mo = (bf16_t*)(ws + WS_MIX) + (size_t)tok0 * D + 512 + g * 64 + lane;
#pragma unroll
        for (int t = 0; t < 8; ++t) mo[(size_t)t * D] = (bf16_t)f2bf(y[t] * psc);
    }
}

__device__ __forceinline__ float row_shr_add(float x, int) { return x; }
template <int N> __device__ __forceinline__ float dpp_row_shr(float x) { return __builtin_bit_cast(float, __builtin_amdgcn_update_dpp(0, __builtin_bit_cast(int, x), 0x110 + N, 0xF, 0xF, true)); }
__device__ __forceinline__ float row_scan16(float x) { x += dpp_row_shr<1>(x); x += dpp_row_shr<2>(x); x += dpp_row_shr<4>(x); x += dpp_row_shr<8>(x); return x; }
__device__ __forceinline__ float row_last16(float x) { return __builtin_bit_cast(float, __builtin_amdgcn_update_dpp(0, __builtin_bit_cast(int, x), 0x15F, 0xF, 0xF, true)); }
__device__ __forceinline__ float row_sum16(float v) {
    v += __builtin_bit_cast(float, __builtin_amdgcn_update_dpp(0, __builtin_bit_cast(int, v), 0xB1, 0xF, 0xF, true));
    v += __builtin_bit_cast(float, __builtin_amdgcn_update_dpp(0, __builtin_bit_cast(int, v), 0x4E, 0xF, 0xF, true));
    v += __builtin_bit_cast(float, __builtin_amdgcn_update_dpp(0, __builtin_bit_cast(int, v), 0x141, 0xF, 0xF, true));
    v += __builtin_bit_cast(float, __builtin_amdgcn_update_dpp(0, __builtin_bit_cast(int, v), 0x140, 0xF, 0xF, true));
    return v;
}
__device__ __forceinline__ void hgrn_out3(const Args& a, Ctx& C, int l, int item, LAS unsigned char* kls) {
    const int lane = C.lane, tt = lane & 15, g = lane >> 4, c = item & 63, hh = (item >> 6) & 3, b = item >> 8, bh = b * 4 + hh, cg = c >> 2, ci = c & 3;
    const float* HG = (const float*)(C.ws + WS_HG); const float* HR = (const float*)(C.ws + WS_HL); const float* HE = (const float*)(C.ws + WS_HD);
    float lb[16];
#pragma unroll
    for (int e = 0; e < 16; ++e) { const int kk = hh * 64 + 16 * (e >> 2) + 4 * g + (e & 3); lb[e] = (l == 1) ? 1.0f / (1.0f + expf(a.lb_logits[kk] - a.lb_logits[256 + kk])) : 0.f; }
    f32x4 S[4][4];
#pragma unroll
    for (int vq = 0; vq < 4; ++vq)
#pragma unroll
        for (int kt = 0; kt < 4; ++kt) S[vq][kt] = (f32x4){0.f, 0.f, 0.f, 0.f};
    const int nstep = cg + (ci > 0 ? 1 : 0);
#pragma unroll 1
    for (int st = 0; st < nstep; ++st) {
        const int chn = (st < cg) ? (4 * st + 3) : (4 * cg + ci - 1); const size_t ch = (size_t)(bh * 64 + chn);
        const float* hr = HR + ch * 4096 + (g * 16 + tt) * 4; const float* he = HE + ch * 64 + 4 * g;
        f32x4 ev[4];
#pragma unroll
        for (int kt = 0; kt < 4; ++kt) ev[kt] = *(const f32x4*)(he + 16 * kt);
#pragma unroll
        for (int vq = 0; vq < 4; ++vq)
#pragma unroll
            for (int kt = 0; kt < 4; ++kt) S[vq][kt] = S[vq][kt] * ev[kt] + *(const f32x4*)(hr + (vq * 4 + kt) * 256);
    }
    const size_t tok0 = (size_t)b * SEQ + c * 64;
#pragma unroll 1
    for (int sb = 0; sb < 4; ++sb) {
        const size_t tok = tok0 + 16 * sb + tt; const float* row = HG + tok * 1024 + hh * 64 + 4 * g;
        float qh[16], kt_[16], kp[16], dd[16];
#pragma unroll
        for (int e4 = 0; e4 < 4; ++e4) {
            const f32x4 q4 = *(const f32x4*)(row + 16 * e4), z4 = *(const f32x4*)(row + 256 + 16 * e4);
#pragma unroll
            for (int j = 0; j < 4; ++j) { const int e = 4 * e4 + j; const float lbe = lb[e];
                const float sg = __builtin_amdgcn_rcpf(1.0f + __expf(-z4[j])), sn = __builtin_amdgcn_rcpf(1.0f + __expf(z4[j]));
                const float lf = __logf(lbe + (1.0f - lbe) * sg), kin = (1.0f - lbe) * sn;
                const float cc = row_scan16(lf), c15 = row_last16(cc);
                qh[e] = siluf_(q4[j]) * __expf(cc); kt_[e] = kin * __expf(fminf(-cc, 80.0f)); kp[e] = kin * __expf(c15 - cc); dd[e] = __expf(c15); }
        }
        bf16x8 Qf[2], Kf[2];
#pragma unroll
        for (int ks = 0; ks < 2; ++ks) { u32x4 wq, wk;
            wq.x = pk2(qh[8 * ks + 0], qh[8 * ks + 1]); wq.y = pk2(qh[8 * ks + 2], qh[8 * ks + 3]); wq.z = pk2(qh[8 * ks + 4], qh[8 * ks + 5]); wq.w = pk2(qh[8 * ks + 6], qh[8 * ks + 7]);
            wk.x = pk2(kt_[8 * ks + 0], kt_[8 * ks + 1]); wk.y = pk2(kt_[8 * ks + 2], kt_[8 * ks + 3]); wk.z = pk2(kt_[8 * ks + 4], kt_[8 * ks + 5]); wk.w = pk2(kt_[8 * ks + 6], kt_[8 * ks + 7]);
            Qf[ks] = __builtin_bit_cast(bf16x8, wq); Kf[ks] = __builtin_bit_cast(bf16x8, wk); }
#pragma unroll
        for (int e4 = 0; e4 < 4; ++e4) { u32x2 w; w.x = pk2(kp[4 * e4 + 0], kp[4 * e4 + 1]); w.y = pk2(kp[4 * e4 + 2], kp[4 * e4 + 3]); *(LAS u32x2*)(kls + tt * 144 + (16 * e4 + 4 * g) * 2) = w; }
        f32x4 at = (f32x4){0.f, 0.f, 0.f, 0.f};
        at = __builtin_amdgcn_mfma_f32_16x16x32_bf16(Kf[0], Qf[0], at, 0, 0, 0); at = __builtin_amdgcn_mfma_f32_16x16x32_bf16(Kf[1], Qf[1], at, 0, 0, 0);
#pragma unroll
        for (int r = 0; r < 4; ++r) at[r] = (4 * g + r <= tt) ? at[r] : 0.f;
        u32x4 wa; wa.x = pk2(at[0], at[1]); wa.y = pk2(at[2], at[3]); wa.z = 0u; wa.w = 0u; const bf16x8 Af = __builtin_bit_cast(bf16x8, wa);
        bf16x8 Vf[4];
        { const float* vp = HG + (tok0 + 16 * sb + 4 * g) * 1024 + 512 + hh * 64 + tt;
#pragma unroll
          for (int vq = 0; vq < 4; ++vq) { u32x4 w; w.x = pk2(vp[16 * vq], vp[1024 + 16 * vq]); w.y = pk2(vp[2048 + 16 * vq], vp[3072 + 16 * vq]); w.z = 0u; w.w = 0u; Vf[vq] = __builtin_bit_cast(bf16x8, w); } }
        f32x4 O[4];
#pragma unroll
        for (int vq = 0; vq < 4; ++vq) {
            u32x4 s0, s1; s0.x = pk2(S[vq][0][0], S[vq][0][1]); s0.y = pk2(S[vq][0][2], S[vq][0][3]); s0.z = pk2(S[vq][1][0], S[vq][1][1]); s0.w = pk2(S[vq][1][2], S[vq][1][3]);
            s1.x = pk2(S[vq][2][0], S[vq][2][1]); s1.y = pk2(S[vq][2][2], S[vq][2][3]); s1.z = pk2(S[vq][3][0], S[vq][3][1]); s1.w = pk2(S[vq][3][2], S[vq][3][3]);
            f32x4 o = (f32x4){0.f, 0.f, 0.f, 0.f};
            o = __builtin_amdgcn_mfma_f32_16x16x32_bf16(Qf[0], __builtin_bit_cast(bf16x8, s0), o, 0, 0, 0); o = __builtin_amdgcn_mfma_f32_16x16x32_bf16(Qf[1], __builtin_bit_cast(bf16x8, s1), o, 0, 0, 0);
            o = __builtin_amdgcn_mfma_f32_16x16x32_bf16(Af, Vf[vq], o, 0, 0, 0); O[vq] = o; }
        { float rs[4];
#pragma unroll
          for (int r = 0; r < 4; ++r) { float ss = O[0][r] * O[0][r] + O[1][r] * O[1][r] + O[2][r] * O[2][r] + O[3][r] * O[3][r]; ss = row_sum16(ss); rs[r] = 1.0f / sqrtf(ss * (1.0f / 64.0f) + EPS); }
          const float* gp = HG + (tok0 + 16 * sb + 4 * g) * 1024 + 768 + hh * 64 + tt; bf16_t* mo = (bf16_t*)(C.ws + WS_MIX) + (tok0 + 16 * sb + 4 * g) * D + 768 + hh * 64 + tt;
#pragma unroll
          for (int vq = 0; vq < 4; ++vq) { const float ngv = a.hgrn_g[l * 64 + 16 * vq + tt];
#pragma unroll
            for (int r = 0; r < 4; ++r) mo[(size_t)r * D + 16 * vq] = (bf16_t)f2bf(O[vq][r] * rs[r] * ngv * siluf_(gp[(size_t)r * 1024 + 16 * vq])); } }
        asm volatile("s_waitcnt lgkmcnt(0)" ::: "memory");
#pragma unroll
        for (int kt = 0; kt < 4; ++kt) {
            const s16x4 t4 = __builtin_amdgcn_ds_read_tr16_b64_v4i16((LAS s16x4*)(kls + (4 * g + (tt >> 2)) * 144 + (16 * kt + 4 * (tt & 3)) * 2));
            const bf16x8 Ktf = (bf16x8){t4[0], t4[1], t4[2], t4[3], 0, 0, 0, 0};
            const f32x4 dv = (f32x4){dd[4 * kt + 0], dd[4 * kt + 1], dd[4 * kt + 2], dd[4 * kt + 3]};
#pragma unroll
            for (int vq = 0; vq < 4; ++vq) S[vq][kt] = __builtin_amdgcn_mfma_f32_16x16x32_bf16(Ktf, Vf[vq], S[vq][kt] * dv, 0, 0, 0);
        }
        asm volatile("s_waitcnt lgkmcnt(0)" ::: "memory");
    }
}

__device__ __forceinline__ void hgrn_local4(const Args& a, Ctx& C, int l, int item, LAS unsigned char* kls) {
    const int lane = C.lane, tt = lane & 15, g = lane >> 4, vq = item & 3, cg = (item >> 2) & 15, hh = (item >> 6) & 3, b = item >> 8, bh = b * 4 + hh;
    const float* HG = (const float*)(C.ws + WS_HG);
    float lb[16], ecum[16];
#pragma unroll
    for (int e = 0; e < 16; ++e) { const int kk = hh * 64 + 16 * (e >> 2) + 4 * g + (e & 3); lb[e] = (l == 1) ? 1.0f / (1.0f + expf(a.lb_logits[kk] - a.lb_logits[256 + kk])) : 0.f; ecum[e] = 1.0f; }
    f32x4 S[4];
#pragma unroll
    for (int kt = 0; kt < 4; ++kt) S[kt] = (f32x4){0.f, 0.f, 0.f, 0.f};
    const size_t tokg = (size_t)b * SEQ + (size_t)cg * 256;
    f32x4 zc[4]; float vc[4];
#define HL4_LOAD(zd, vd, sbi) do { const size_t _t0 = tokg + 16 * (sbi); const float* _r = HG + (_t0 + tt) * 1024 + hh * 64 + 4 * g + 256; \
        _Pragma("unroll") for (int e4 = 0; e4 < 4; ++e4) zd[e4] = *(const f32x4*)(_r + 16 * e4); \
        const float* _v = HG + (_t0 + 4 * g) * 1024 + 512 + hh * 64 + 16 * vq + tt; vd[0] = _v[0]; vd[1] = _v[1024]; vd[2] = _v[2048]; vd[3] = _v[3072]; } while (0)
    HL4_LOAD(zc, vc, 0);
#pragma unroll 1
    for (int ci = 0; ci < 4; ++ci) {
        const int c = 4 * cg + ci;
#pragma unroll 1
        for (int sb = 0; sb < 4; ++sb) {
            const int sbi = 4 * ci + sb; f32x4 zn[4]; float vn[4];
            if (sbi < 15) HL4_LOAD(zn, vn, sbi + 1); else {
#pragma unroll
                for (int e4 = 0; e4 < 4; ++e4) { zn[e4] = zc[e4]; vn[e4] = vc[e4]; } }
            float kp[16], dd[16];
#pragma unroll
            for (int e4 = 0; e4 < 4; ++e4) { const f32x4 z4 = zc[e4];
#pragma unroll
                for (int j = 0; j < 4; ++j) { const int e = 4 * e4 + j; const float lbe = lb[e];
                    const float sg = __builtin_amdgcn_rcpf(1.0f + __expf(-z4[j])), sn = __builtin_amdgcn_rcpf(1.0f + __expf(z4[j]));
                    const float lf = __logf(lbe + (1.0f - lbe) * sg), kin = (1.0f - lbe) * sn;
                    const float cc = row_scan16(lf), c15 = row_last16(cc);
                    kp[e] = kin * __expf(c15 - cc); dd[e] = __expf(c15); ecum[e] *= dd[e]; } }
#pragma unroll
            for (int e4 = 0; e4 < 4; ++e4) { u32x2 w; w.x = pk2(kp[4 * e4 + 0], kp[4 * e4 + 1]); w.y = pk2(kp[4 * e4 + 2], kp[4 * e4 + 3]); *(LAS u32x2*)(kls + tt * 144 + (16 * e4 + 4 * g) * 2) = w; }
            bf16x8 Vf; { u32x4 w; w.x = pk2(vc[0], vc[1]); w.y = pk2(vc[2], vc[3]); w.z = 0u; w.w = 0u; Vf = __builtin_bit_cast(bf16x8, w); }
            asm volatile("s_waitcnt lgkmcnt(0)" ::: "memory");
#pragma unroll
            for (int kt = 0; kt < 4; ++kt) {
                const s16x4 t4 = __builtin_amdgcn_ds_read_tr16_b64_v4i16((LAS s16x4*)(kls + (4 * g + (tt >> 2)) * 144 + (16 * kt + 4 * (tt & 3)) * 2));
                const bf16x8 Ktf = (bf16x8){t4[0], t4[1], t4[2], t4[3], 0, 0, 0, 0};
                const f32x4 dv = (f32x4){dd[4 * kt + 0], dd[4 * kt + 1], dd[4 * kt + 2], dd[4 * kt + 3]};
                S[kt] = __builtin_amdgcn_mfma_f32_16x16x32_bf16(Ktf, Vf, S[kt] * dv, 0, 0, 0);
            }
            asm volatile("s_waitcnt lgkmcnt(0)" ::: "memory");
#pragma unroll
            for (int e4 = 0; e4 < 4; ++e4) { zc[e4] = zn[e4]; vc[e4] = vn[e4]; }
        }
        const size_t ch = (size_t)(bh * 64 + c);
        float* hr = (float*)(C.ws + WS_HL) + ch * 4096 + (g * 16 + tt) * 4;
#pragma unroll
        for (int kt = 0; kt < 4; ++kt) *(f32x4*)(hr + (vq * 4 + kt) * 256) = S[kt];
        if (vq == 0 && tt == 0) { float* he = (float*)(C.ws + WS_HD) + ch * 64 + 4 * g;
#pragma unroll
            for (int kt = 0; kt < 4; ++kt) *(f32x4*)(he + 16 * kt) = (f32x4){ecum[4 * kt + 0], ecum[4 * kt + 1], ecum[4 * kt + 2], ecum[4 * kt + 3]}; }
    }
#undef HL4_LOAD
}

__device__ __forceinline__ void phase_mix1(const Args& a, Ctx& C, int l) {
#ifndef MIX1MASK
#define MIX1MASK 7
#endif
#ifndef MIX1REP
#define MIX1REP 0
#endif
#ifndef HGRN3
#define HGRN3 1
#endif
#ifndef HGRN4
#define HGRN4 1
#endif
    if (HGRN3) { if (C.wave < 4) for (int it = blockIdx.x * 4 + C.wave; it < 1024; it += C.G * 4) hgrn_local4(a, C, l, it, C.lds + C.wave * 4096); __syncthreads(); }
    else for (int rep = 0; rep < ((MIX1REP & 1) && l == 0 ? 2 : 1); ++rep) for (int it = blockIdx.x; it < 1024; it += C.G) hgrn_local2(a, C, l, it);
    for (int rep = 0; rep < ((MIX1REP & 2) && l == 0 ? 2 : 1); ++rep) pool_wave(a, C, l);
    __syncthreads();
    Conv cv; cv.w1l = a.w1 + (size_t)l * 32 * 1024 * 2048; cv.w2l = a.w2 + (size_t)l * 32 * 1024 * 1024; cv.w1t = (bf16_t*)(C.ws + WS_W1) + (size_t)l * 32 * 2048 * 1024; cv.w2t = (bf16_t*)(C.ws + WS_W2) + (size_t)l * 32 * 1024 * 1024;
    cv.it = blockIdx.x * NWAVES + C.wave; cv.step = C.G * NWAVES; cv.lane = C.lane; cv.pend = false; cv.it_end = CONV_SPLIT;
    for (int rep = 0; rep < ((MIX1REP & 4) && l == 0 ? 2 : 1); ++rep) for (int base = 0; base < 2048; base += 2 * C.G) {
        const int u1 = base + (int)blockIdx.x, u2 = base + 2 * C.G - 1 - (int)blockIdx.x;
        if (u1 < 2048) index_unit2(C, (u1 >> 3) & 3, u1 >> 5, u1 & 7, cv);
        if (u2 < 2048) index_unit2(C, (u2 >> 3) & 3, u2 >> 5, u2 & 7, cv);
    }
    for (;;) { cv.issue(); if (!cv.pend) break; cv.finish((LAS float*)(C.lds + 65536 + C.wave * KST_BYTES)); }
}
__device__ __forceinline__ void phase_mix2(const Args& a, Ctx& C, int l) {
#ifndef MIX2MASK
#define MIX2MASK 3
#endif
#ifndef MIX2REP
#define MIX2REP 0
#endif
    LAS int* qctr = (LAS int*)(C.lds + LDS_BYTES - 64 + 16);
    if (C.tid == 0) *qctr = 0;
    __syncthreads();
    if (HGRN3) { for (int rep = 0; rep < ((MIX2REP & 1) ? 2 : 1); ++rep) if (C.wave < 4) for (int it = blockIdx.x * 4 + C.wave; it < 1024; it += C.G * 4) hgrn_out3(a, C, l, it, C.lds + C.wave * (2 * 32 * VROW)); }
    else for (int rep = 0; rep < ((MIX2REP & 1) ? 2 : 1); ++rep) for (int it = blockIdx.x; it < 256; it += C.G) hgrn_out2(a, C, l, it);
    LAS unsigned char* vs = C.lds + C.wave * (2 * 32 * VROW);
    const int gw = blockIdx.x * NWAVES + C.wave, NGW = C.G * NWAVES;
    Conv cv; cv.w1l = a.w1 + (size_t)l * 32 * 1024 * 2048; cv.w2l = a.w2 + (size_t)l * 32 * 1024 * 1024; cv.w1t = (bf16_t*)(C.ws + WS_W1) + (size_t)l * 32 * 2048 * 1024; cv.w2t = (bf16_t*)(C.ws + WS_W2) + (size_t)l * 32 * 1024 * 1024;
    cv.it = CONV_SPLIT + gw; cv.step = NGW; cv.lane = C.lane; cv.pend = false; cv.it_end = Conv::NITEMS;
    for (;;) {
        int n = 0; if (C.lane == 0) n = __hip_atomic_fetch_add(qctr, 1, __ATOMIC_RELAXED, __HIP_MEMORY_SCOPE_WORKGROUP);
        n = __builtin_amdgcn_readfirstlane(n);
        const int tk = (int)blockIdx.x * NWAVES + (n & 7) + NGW * (n >> 3);
        if (tk >= NTOK) break;
        attend_query_mfma(C, tk, vs, cv);
    }
    for (;;) { cv.finish((LAS float*)vs); cv.issue(); if (!cv.pend) break; }
}

constexpr int URS = 2064;
__device__ __forceinline__ void phase_router2(const Args& a, Ctx& C, int l) {
    unsigned char* ws = C.ws; const int lane = C.lane, w = C.wave, tid = C.tid;
    LAS unsigned char* uh = C.lds; LAS unsigned char* ul = uh + 16 * URS; LAS float* part = (LAS float*)(ul + 16 * URS);
    LAS int* hist = (LAS int*)(part + 8 * 16 * 32);
    LAS int* asg = hist + 64;
    LAS float* asgg = (LAS float*)(asg + 2 * 1024);
    const float* mod = (const float*)(ws + WS_MOD); const float* H = (const float*)(ws + WS_H);
    const bf16_t* wrh = (const bf16_t*)(ws + WS_WRH) + (size_t)l * 32768; const bf16_t* wrl = (const bf16_t*)(ws + WS_WRL) + (size_t)l * 32768;
    unsigned* cnt = (unsigned*)(ws + WS_CTL) + CW_CNT + l * 32 * 64;
    const int ntile_all = NTOK / 16;
    bf16x8 wbh0[4], wbl0[4], wbh1[4], wbl1[4];
    { const int c = lane & 15, g = lane >> 4;
#pragma unroll
      for (int kk = 0; kk < 4; ++kk) { const int ks = 4 * w + kk;
          wbh0[kk] = *(const bf16x8*)(wrh + (size_t)c * 1024 + 32 * ks + 8 * g); wbl0[kk] = *(const bf16x8*)(wrl + (size_t)c * 1024 + 32 * ks + 8 * g);
          wbh1[kk] = *(const bf16x8*)(wrh + (size_t)(c + 16) * 1024 + 32 * ks + 8 * g); wbl1[kk] = *(const bf16x8*)(wrl + (size_t)(c + 16) * 1024 + 32 * ks + 8 * g); } }
    for (int tile0 = blockIdx.x; tile0 < ntile_all; tile0 += 16 * C.G) {
        if (tid < 64) hist[tid] = 0;
        __syncthreads();
        int nt_here = 0;
        f32x4 hv[2][4];
#pragma unroll
        for (int hf = 0; hf < 2; ++hf) { const f32x4* hr = (const f32x4*)(H + (size_t)(tile0 * 16 + 2 * w + hf) * D) + lane;
#pragma unroll
            for (int j = 0; j < 4; ++j) hv[hf][j] = hr[64 * j]; }
        for (int tile = tile0; tile < ntile_all && nt_here < 16; tile += C.G, ++nt_here) {
            const int tok0 = tile * 16;
#pragma unroll
            for (int hf = 0; hf < 2; ++hf) {
                const int tr = 2 * w + hf, tk = tok0 + tr, b = tk >> 12; f32x4 v[4];
#pragma unroll
                for (int j = 0; j < 4; ++j) v[j] = hv[hf][j];
                float ss = 0.f;
#pragma unroll
                for (int j = 0; j < 4; ++j) ss += (v[j].x * v[j].x + v[j].y * v[j].y) + (v[j].z * v[j].z + v[j].w * v[j].w);
                const float rstd = 1.0f / sqrtf(wave_sum(ss) * (1.0f / D) + EPS);
                const float* mb = mod + (size_t)(l * 4 + b) * 6144; bf16_t* urow = (bf16_t*)(ws + WS_U) + (size_t)tk * D;
#pragma unroll
                for (int j = 0; j < 4; ++j) { const int idx = 4 * lane + 256 * j; const f32x4 gv = *(const f32x4*)(a.norm2_g + l * 1024 + idx), shv = *(const f32x4*)(mb + 3072 + idx), scv = *(const f32x4*)(mb + 4096 + idx);
                    const f32x4 o = v[j] * rstd * gv * (scv + 1.0f) + shv; u32x2 hi; hi.x = pk2(o[0], o[1]); hi.y = pk2(o[2], o[3]); *(u32x2*)(urow + idx) = hi;
                    u32x2 lo; lo.x = pk2(o[0] - bflo(hi.x), o[1] - bfhi(hi.x)); lo.y = pk2(o[2] - bflo(hi.y), o[3] - bfhi(hi.y));
                    *(LAS u32x2*)(uh + tr * URS + idx * 2) = hi; *(LAS u32x2*)(ul + tr * URS + idx * 2) = lo; }
            }
            { const int ntile2 = tile + C.G; if (ntile2 < ntile_all && nt_here + 1 < 16) {
#pragma unroll
                for (int hf = 0; hf < 2; ++hf) { const f32x4* hr = (const f32x4*)(H + (size_t)(ntile2 * 16 + 2 * w + hf) * D) + lane;
#pragma unroll
                    for (int j = 0; j < 4; ++j) hv[hf][j] = hr[64 * j]; } } }
            __syncthreads();
            {
                const int c = lane & 15, g = lane >> 4; f32x4 acc0 = (f32x4){0.f, 0.f, 0.f, 0.f}, acc1 = acc0;
#pragma unroll
                for (int kk = 0; kk < 4; ++kk) { const int ks = 4 * w + kk;
                    const bf16x8 ah = *(const LAS bf16x8*)(uh + c * URS + (32 * ks + 8 * g) * 2), al = *(const LAS bf16x8*)(ul + c * URS + (32 * ks + 8 * g) * 2);
                    acc0 = __builtin_amdgcn_mfma_f32_16x16x32_bf16(al, wbh0[kk], acc0, 0, 0, 0); acc0 = __builtin_amdgcn_mfma_f32_16x16x32_bf16(ah, wbl0[kk], acc0, 0, 0, 0); acc0 = __builtin_amdgcn_mfma_f32_16x16x32_bf16(ah, wbh0[kk], acc0, 0, 0, 0);
                    acc1 = __builtin_amdgcn_mfma_f32_16x16x32_bf16(al, wbh1[kk], acc1, 0, 0, 0); acc1 = __builtin_amdgcn_mfma_f32_16x16x32_bf16(ah, wbl1[kk], acc1, 0, 0, 0); acc1 = __builtin_amdgcn_mfma_f32_16x16x32_bf16(ah, wbh1[kk], acc1, 0, 0, 0); }
#pragma unroll
                for (int r = 0; r < 4; ++r) { part[(w * 16 + 4 * g + r) * 32 + c] = acc0[r]; part[(w * 16 + 4 * g + r) * 32 + 16 + c] = acc1[r]; }
            }
            __syncthreads();
            {
                const int e = lane & 31, hf = lane >> 5, tr = 2 * w + hf; float val = a.b_router[l * 32 + e];
#pragma unroll
                for (int ww = 0; ww < 8; ++ww) val += part[(ww * 16 + tr) * 32 + e];
                float tv[4]; int te[4];
#pragma unroll
                for (int k = 0; k < 4; ++k) {
                    float bv = val; int bi = e;
#pragma unroll
                    for (int o = 1; o < 32; o <<= 1) { const float ov = __shfl_xor(bv, o); const int oi = __shfl_xor(bi, o); if (ov > bv || (ov == bv && oi < bi)) { bv = ov; bi = oi; } }
                    tv[k] = bv; te[k] = bi; if (e == bi) val = -3.0e38f;
                }
                const float e1 = __expf(tv[1] - tv[0]), e2 = __expf(tv[2] - tv[0]), e3 = __expf(tv[3] - tv[0]); const float rs = 1.0f / (1.0f + e1 + e2 + e3);
                if (e < 4) {
                    const int ex = e == 0 ? te[0] : e == 1 ? te[1] : e == 2 ? te[2] : te[3]; const float gt = (e == 0 ? 1.0f : e == 1 ? e1 : e == 2 ? e2 : e3) * rs;
                    const int ai = (nt_here * 16 + tr) * 4 + e;
                    asg[2 * ai] = ex; asg[2 * ai + 1] = __hip_atomic_fetch_add(&hist[ex], 1, __ATOMIC_RELAXED, __HIP_MEMORY_SCOPE_WORKGROUP); asgg[ai] = gt;
                }
            }
            __syncthreads();
        }
        if (tid < 32) { const int hc = hist[tid]; hist[32 + tid] = hc ? (int)atomicAdd(cnt + tid * 64, (unsigned)hc) : 0; }
        __syncthreads();
        for (int ai = tid; ai < nt_here * 64; ai += NTHREADS) {
            const int ti = ai >> 6, tr = (ai >> 2) & 15, k = ai & 3, tk = (tile0 + ti * C.G) * 16 + tr;
            const int ex = asg[2 * ai], slot = hist[32 + ex] + asg[2 * ai + 1];
            ((int*)(ws + WS_ROWTOK))[(size_t)ex * NTOK + slot] = tk;
            ((int*)(ws + WS_EIDX))[tk * 4 + k] = ex; ((int*)(ws + WS_SLOT))[tk * 4 + k] = slot; ((float*)(ws + WS_GATE))[tk * 4 + k] = asgg[ai];
        }
        __syncthreads();
    }
}

__device__ __forceinline__ void moe_table(Ctx& C, int l, LAS int* tab) {
    if (C.tid < 32) { const unsigned* cnt = (const unsigned*)(C.ws + WS_CTL) + CW_CNT + l * 32 * 64; tab[33 + C.tid] = (int)__hip_atomic_load(cnt + C.tid * 64, __ATOMIC_RELAXED, __HIP_MEMORY_SCOPE_AGENT); }
    __syncthreads();
    if (C.tid == 0) { int p = 0; for (int e = 0; e < 32; ++e) { tab[e] = p; p += (tab[33 + e] + 255) >> 8; } tab[32] = p; }
    __syncthreads();
}

__device__ __forceinline__ void phase_combine(const Args& a, Ctx& C, int l) {
    unsigned char* ws = C.ws; const int lane = C.lane;
    const float* mod = (const float*)(ws + WS_MOD); float* H = (float*)(ws + WS_H); const bf16_t* Y = (const bf16_t*)(ws + WS_Y);
    const unsigned* cnt = (const unsigned*)(ws + WS_CTL) + CW_CNT + l * 32 * 64;
    int mt = 0; if (lane < 32) mt = ((int)__hip_atomic_load(cnt + lane * 64, __ATOMIC_RELAXED, __HIP_MEMORY_SCOPE_AGENT) + 255) >> 8;
    int incl = mt;
#pragma unroll
    for (int o = 1; o < 32; o <<= 1) { const int t = __shfl_up(incl, o); if ((lane & 31) >= o) incl += t; }
    const int excl = incl - mt;
    const int gw = blockIdx.x * NWAVES + C.wave, NGW = C.G * NWAVES;
    for (int tk0 = gw; tk0 < NTOK; tk0 += 2 * NGW) {
        int tks[2]; tks[0] = tk0; tks[1] = (tk0 + NGW) < NTOK ? tk0 + NGW : tk0; const bool two = (tk0 + NGW) < NTOK;
        f32x4 v[2][4]; u32x2 yv[2][4][4]; float gts[2][4];
#pragma unroll
        for (int q = 0; q < 2; ++q) { const int tk = tks[q]; const f32x4* hr = (const f32x4*)(H + (size_t)tk * D) + lane;
#pragma unroll
            for (int j = 0; j < 4; ++j) v[q][j] = hr[64 * j];
            const int4 ex4 = *(const int4*)((const int*)(ws + WS_EIDX) + tk * 4), sl4 = *(const int4*)((const int*)(ws + WS_SLOT) + tk * 4); const f32x4 g4 = *(const f32x4*)((const float*)(ws + WS_GATE) + tk * 4);
            const int exs[4] = {ex4.x, ex4.y, ex4.z, ex4.w}, sls[4] = {sl4.x, sl4.y, sl4.z, sl4.w};
#pragma unroll
            for (int k = 0; k < 4; ++k) { gts[q][k] = g4[k]; const int row = 256 * __shfl(excl, exs[k]) + sls[k]; const u32x2* yr = (const u32x2*)(Y + (size_t)row * D) + lane;
#pragma unroll
                for (int j = 0; j < 4; ++j) yv[q][k][j] = yr[64 * j]; }
        }
#pragma unroll
        for (int q = 0; q < 2; ++q) {
            if (q == 1 && !two) break;
            const int tk = tks[q], b = tk >> 12; f32x4* hr = (f32x4*)(H + (size_t)tk * D) + lane;
            f32x4 m[4];
#pragma unroll
            for (int j = 0; j < 4; ++j) m[j] = (f32x4){0.f, 0.f, 0.f, 0.f};
#pragma unroll
            for (int k = 0; k < 4; ++k)
#pragma unroll
                for (int j = 0; j < 4; ++j) { const u32x2 w = yv[q][k][j]; m[j] += (f32x4){bflo(w.x), bfhi(w.x), bflo(w.y), bfhi(w.y)} * gts[q][k]; }
            const float* mb = mod + (size_t)(l * 4 + b) * 6144;
            f32x4 vv[4];
#pragma unroll
            for (int j = 0; j < 4; ++j) { const f32x4 g2 = *(const f32x4*)(mb + 5120 + 4 * lane + 256 * j); vv[j] = v[q][j] + g2 * m[j]; if (l + 1 < DEPTH) hr[64 * j] = vv[j]; }
            if (l + 1 < DEPTH) { const float* mn = mod + (size_t)((l + 1) * 4 + b) * 6144; norm_mod_store(vv, a.norm1_g + (l + 1) * 1024, mn + 0, mn + 1024, (bf16_t*)(ws + WS_U) + (size_t)tk * D, lane); }
            else {
                float ss = 0.f;
#pragma unroll
                for (int j = 0; j < 4; ++j) ss += (vv[j].x * vv[j].x + vv[j].y * vv[j].y) + (vv[j].z * vv[j].z + vv[j].w * vv[j].w);
                const float rstd = 1.0f / sqrtf(wave_sum(ss) * (1.0f / D) + EPS);
                f32x4* orow = (f32x4*)(a.out + (size_t)tk * D) + lane;
#pragma unroll
                for (int j = 0; j < 4; ++j) orow[64 * j] = vv[j] * rstd * *(const f32x4*)(a.final_g + 4 * lane + 256 * j);
            }
        }
    }
}

#define XB_TMO      128
#define XB_XCNT(j)  (256  + 64 * (j))
#define XB_XSUB(j)  (1280 + 64 * (j))
#define XB_XGEN(j)  (2304 + 64 * (j))
#define XB_TOP      3328
#define XB_TOPGEN   3392
#define XCD_BAR_WORDS 3456
#define XB_SPIN_CAP (1u << 22)
__device__ __forceinline__ unsigned xb_ld(unsigned* p)              { return __hip_atomic_load(p, __ATOMIC_RELAXED, __HIP_MEMORY_SCOPE_AGENT); }
__device__ __forceinline__ unsigned xb_add(unsigned* p, unsigned v) { return __hip_atomic_fetch_add(p, v, __ATOMIC_RELAXED, __HIP_MEMORY_SCOPE_AGENT); }
__device__ __forceinline__ unsigned xb_xcc_id() { return (unsigned)__builtin_amdgcn_s_getreg((3 << 11) | 20) & 0xFu; }
#define XB_SPIN(cond, bar) do { unsigned _sp = 0; while (cond) { __builtin_amdgcn_s_sleep(1); \
    if ((++_sp & 255u) == 0u) { if (xb_ld(&(bar)[XB_TMO])) break; if (_sp > XB_SPIN_CAP) { atomicAdd(&(bar)[XB_TMO], 1u); break; } } } } while (0)
struct XcdBarrier { unsigned* bar; unsigned x; volatile LAS unsigned* st; };
__device__ __forceinline__ XcdBarrier xcd_barrier_post(unsigned* bar, volatile LAS unsigned* st, bool leader) {
    XcdBarrier b; b.bar = bar; b.x = xb_xcc_id(); b.st = st;
    if (leader) (void)xb_add(&bar[XB_XCNT(b.x)], 1u);
    return b;
}
__device__ __forceinline__ void xcd_barrier_complete(unsigned* bar, unsigned x, unsigned& nloc, unsigned& nx) {
    const unsigned G = gridDim.x * gridDim.y * gridDim.z;
    unsigned sum, cnt, mine, sp = 0u;
    for (;;) {
        sum = 0u; cnt = 0u; mine = 0u;
#pragma unroll
        for (unsigned j = 0; j < 16; ++j) { const unsigned c = xb_ld(&bar[XB_XCNT(j)]); sum += c; cnt += (c > 0u) ? 1u : 0u; mine = (j == x) ? c : mine; }
        if (sum == G) break;
        __builtin_amdgcn_s_sleep(1);
        if ((++sp & 255u) == 0u) { if (xb_ld(&bar[XB_TMO])) break; if (sp > XB_SPIN_CAP) { atomicAdd(&bar[XB_TMO], 1u); break; } }
    }
    nloc = mine > 0u ? mine : 1u; nx = cnt > 0u ? cnt : 1u;
}
__device__ __forceinline__ void xcd_barrier(const XcdBarrier& b, bool leader) {
    asm volatile("s_waitcnt vmcnt(0)" ::: "memory");
    __syncthreads();
    if (leader) {
        unsigned* bar = b.bar;
        __builtin_amdgcn_s_waitcnt(0);
        unsigned nloc = b.st[0], nx = b.st[1];
        if (nloc == 0u) { xcd_barrier_complete(bar, b.x, nloc, nx); b.st[0] = nloc; b.st[1] = nx; }
        const unsigned old = xb_add(&bar[XB_XSUB(b.x)], 1u);
        const unsigned gen = old / nloc;
        if (old + 1u == (gen + 1u) * nloc) {
            __builtin_amdgcn_fence(__ATOMIC_RELEASE, "agent");
            asm volatile("s_waitcnt vmcnt(0)" ::: "memory");
            const unsigned og = xb_add(&bar[XB_TOP], 1u);
            const unsigned tg = og / nx;
            if (og + 1u == (tg + 1u) * nx) xb_add(&bar[XB_TOPGEN], 1u);
            else XB_SPIN(xb_ld(&bar[XB_TOPGEN]) == tg, bar);
            __builtin_amdgcn_fence(__ATOMIC_ACQUIRE, "agent");
            xb_add(&bar[XB_XGEN(b.x)], 1u);
            asm volatile("s_waitcnt vmcnt(0)" ::: "memory");
        } else {
            XB_SPIN(xb_ld(&bar[XB_XGEN(b.x)]) == gen, bar);
            __builtin_amdgcn_fence(__ATOMIC_ACQUIRE, "agent");
            asm volatile("s_waitcnt vmcnt(0)" ::: "memory");
        }
    }
    __syncthreads();
}

typedef const __attribute__((address_space(4))) Args* KArgsPtr;
__device__ __forceinline__ Args load_args() {
#if defined(__HIP_DEVICE_COMPILE__)
    KArgsPtr p = (KArgsPtr)__builtin_amdgcn_kernarg_segment_ptr(); asm volatile("" : "+s"(p)); Args a;
    a.x = p->x; a.c = p->c; a.pos = p->pos; a.w_ada = p->w_ada; a.b_ada = p->b_ada; a.norm1_g = p->norm1_g; a.norm2_g = p->norm2_g; a.w_in = p->w_in; a.w_out = p->w_out; a.pool_w = p->pool_w;
    a.pool_scale = p->pool_scale; a.hgrn_g = p->hgrn_g; a.lb_logits = p->lb_logits; a.w_router = p->w_router; a.b_router = p->b_router; a.w1 = p->w1; a.b1 = p->b1; a.w2 = p->w2; a.b2 = p->b2; a.final_g = p->final_g;
    a.out = p->out; a.ws = p->ws; a.ph_lo = p->ph_lo; a.ph_hi = p->ph_hi; return a;
#else
    return Args{};
#endif
}
__device__ __forceinline__ int lane_id() { return __builtin_amdgcn_mbcnt_hi(~0u, __builtin_amdgcn_mbcnt_lo(~0u, 0)); }
__device__ __forceinline__ Ctx make_ctx(unsigned char* ws, int wv) {
    extern __shared__ __attribute__((aligned(16))) unsigned char lds_raw[];
    Ctx C; C.lds = (LAS unsigned char*)lds_raw; { int l_ = lane_id(); asm volatile("" : "+v"(l_)); C.lane = l_; } C.wave = wv; C.tid = wv * 64 + C.lane;
    C.G = gridDim.x; { const int bx = blockIdx.x; C.vcu = (C.G % 8 == 0) ? (bx % 8) * (C.G / 8) + bx / 8 : bx; }
    C.ws = ws; return C;
}
#ifndef PHASE_FN
#define PHASE_FN __device__ __forceinline__ void
#endif
#define GEMM_FN __device__ __forceinline__ void
PHASE_FN ph_prep(int wv) { const Args a = load_args(); Ctx C = make_ctx(a.ws, wv); phase_prep(a, C); }
PHASE_FN ph_u0(int wv) { const Args a = load_args(); Ctx C = make_ctx(a.ws, wv); phase_u0(a, C); }
GEMM_FN ph_gin(int l, int wv) { const Args a = load_args(); Ctx C = make_ctx(a.ws, wv); unsigned char* ws = a.ws;
    DenseOrder S{(const char*)(ws + WS_U), (const char*)(ws + WS_WIN) + (size_t)l * NPAD * 1024 * 2, NTOK / 256, NPAD / 256, (NTOK / 256) * (NPAD / 256), C.G, (int)blockIdx.x};
    EpiIn E{ws}; pg8::gemm_phase<EpiIn, DenseOrder, false, true>(C.lds, (LAS unsigned*)(C.lds + LDS_PARK), C.tid, S, E); }
PHASE_FN ph_mix1(int l, int wv) { const Args a = load_args(); Ctx C = make_ctx(a.ws, wv); phase_mix1(a, C, l); }
PHASE_FN ph_mix2(int l, int wv) { const Args a = load_args(); Ctx C = make_ctx(a.ws, wv); phase_mix2(a, C, l); }
GEMM_FN ph_gout(int l, int wv) { const Args a = load_args(); Ctx C = make_ctx(a.ws, wv); unsigned char* ws = a.ws;
    DenseOrder S{(const char*)(ws + WS_MIX), (const char*)(ws + WS_WOUT) + (size_t)l * 1024 * 1024 * 2, NTOK / 256, 4, (NTOK / 256) * 4, C.G, (int)blockIdx.x};
    EpiOut E{l == 0 ? a.x : (const float*)(ws + WS_H), (float*)(ws + WS_H), (const float*)(ws + WS_MOD) + (size_t)l * 4 * 6144 + 2048};
    pg8::gemm_phase<EpiOut, DenseOrder, false, true>(C.lds, (LAS unsigned*)(C.lds + LDS_PARK), C.tid, S, E); }
PHASE_FN ph_router(int l, int wv) { const Args a = load_args(); Ctx C = make_ctx(a.ws, wv); phase_router2(a, C, l); }
GEMM_FN ph_g1(int l, int wv) { const Args a = load_args(); Ctx C = make_ctx(a.ws, wv); unsigned char* ws = a.ws;
    LAS int* tab = (LAS int*)(C.lds + LDS_TAB); moe_table(C, l, tab);
    MoeOrder<true> S{tab, (const char*)(ws + WS_U), (const char*)(ws + WS_W1) + (size_t)l * 32 * 2048 * 1024 * 2, (const int*)(ws + WS_ROWTOK), C.G, C.vcu};
    EpiG1 E{(bf16_t*)(ws + WS_ACT), a.b1 + (size_t)l * 32 * 2048}; pg8::gemm_phase<EpiG1, MoeOrder<true>, true, true>(C.lds, (LAS unsigned*)(C.lds + LDS_PARK), C.tid, S, E); }
GEMM_FN ph_g2(int l, int wv) { const Args a = load_args(); Ctx C = make_ctx(a.ws, wv); unsigned char* ws = a.ws;
    LAS int* tab = (LAS int*)(C.lds + LDS_TAB); moe_table(C, l, tab);
    MoeOrder<false> S{tab, (const char*)(ws + WS_ACT), (const char*)(ws + WS_W2) + (size_t)l * 32 * 1024 * 1024 * 2, nullptr, C.G, C.vcu};
    EpiG2 E{(bf16_t*)(ws + WS_Y), a.b2 + (size_t)l * 32 * 1024}; pg8::gemm_phase<EpiG2, MoeOrder<false>, false, true>(C.lds, (LAS unsigned*)(C.lds + LDS_PARK), C.tid, S, E); }
PHASE_FN ph_combine(int l, int wv) { const Args a = load_args(); Ctx C = make_ctx(a.ws, wv); phase_combine(a, C, l); }

constexpr int NPHASES = 2 + 8 * DEPTH;
__global__ void __launch_bounds__(NTHREADS, 2) mega_fwd(Args a) {
#if MK_ONE_LAUNCH == 1
    cg::grid_group grid = cg::this_grid();
#define SEAM() do { __syncthreads(); grid.sync(); } while (0)
#elif MK_ONE_LAUNCH == 2
    extern __shared__ __attribute__((aligned(16))) unsigned char lds_k[];
    volatile LAS unsigned* bst = (volatile LAS unsigned*)((LAS unsigned char*)lds_k + LDS_BYTES - 64);
    const bool leader = (threadIdx.x == 0);
    if (leader) { bst[0] = 0u; bst[1] = 0u; }
    __syncthreads();
    const XcdBarrier xbar = xcd_barrier_post((unsigned*)(a.ws + WS_CTL) + CW_BAR, bst, leader);
#define SEAM() xcd_barrier(xbar, leader)
#else
#define SEAM() do { } while (0)
#endif
    const int lo = a.ph_lo, hi = a.ph_hi;
    const int wv = __builtin_amdgcn_readfirstlane((int)threadIdx.x >> 6);
#ifndef KINDMASK
#define KINDMASK 0xffffu
#endif
#define KON(k) (((KINDMASK) >> (k)) & 1u)
#ifndef REP_ID
#define REP_ID -1
#endif
#ifndef STAMP_K
#define STAMP_K -1
#endif
#define CW_STAMP 512
#ifndef STAMP_OFF
#define STAMP_OFF 0.0f
#define STAMP_SCALE 5e-3f
#endif
#define RUN(kind, id, call) do { if (KON(kind) && lo <= (id) && (id) < hi) { call; if ((id) == REP_ID) { __syncthreads(); call; } if ((id) + 1 < hi || STAMP_K >= 0) SEAM(); \
        if (STAMP_K >= 0 && blockIdx.x == 0 && threadIdx.x == 0) { const unsigned long long _t = __builtin_amdgcn_s_memrealtime(); __hip_atomic_store((unsigned long long*)(a.ws + WS_CTL) + CW_STAMP / 2 + 1 + (id), _t, __ATOMIC_RELAXED, __HIP_MEMORY_SCOPE_AGENT); } } } while (0)
    if (STAMP_K >= 0) { if (blockIdx.x == 0 && threadIdx.x == 0) { const unsigned long long _t = __builtin_amdgcn_s_memrealtime(); __hip_atomic_store((unsigned long long*)(a.ws + WS_CTL) + CW_STAMP / 2, _t, __ATOMIC_RELAXED, __HIP_MEMORY_SCOPE_AGENT); } }
    RUN(0, 0, ph_prep(wv));
    RUN(1, 1, ph_u0(wv));
    RUN(2, 2, ph_gin(0, wv));
#ifndef HGRN_CHECK
#define HGRN_CHECK 0
#endif
#define HGRN_PRE(LL)     if (HGRN_CHECK) { \
        const Args aa = load_args(); Ctx C = make_ctx(aa.ws, wv); \
        for (int it = blockIdx.x; it < 1024; it += C.G) hgrn_local2(aa, C, LL, it); \
        SEAM(); \
        for (int it = blockIdx.x; it < 256; it += C.G) hgrn_out2(aa, C, LL, it); \
        SEAM(); \
        for (size_t i = (size_t)blockIdx.x * NTHREADS + threadIdx.x; i < (size_t)NTOK * 128; i += (size_t)gridDim.x * NTHREADS) { const size_t tkn = i >> 7, cc = i & 127; ((unsigned*)(aa.ws + WS_ACT))[i] = ((const unsigned*)(aa.ws + WS_MIX))[tkn * 512 + 384 + cc]; } \
        SEAM(); \
    }
#define HGRN_POST()     if (HGRN_CHECK) { \
        const Args aa = load_args(); \
        float sd = 0.f, sr = 0.f; \
        for (size_t i = (size_t)blockIdx.x * NTHREADS + threadIdx.x; i < (size_t)NTOK * 128; i += (size_t)gridDim.x * NTHREADS) { const size_t tkn = i >> 7, cc = i & 127; const unsigned o = ((const unsigned*)(aa.ws + WS_ACT))[i], n = ((const unsigned*)(aa.ws + WS_MIX))[tkn * 512 + 384 + cc]; \
            const float o0 = bflo(o), o1 = bfhi(o), n0 = bflo(n), n1 = bfhi(n); sd += (o0 - n0) * (o0 - n0) + (o1 - n1) * (o1 - n1); sr += o0 * o0 + o1 * o1; } \
        sd = wave_sum(sd); sr = wave_sum(sr); \
        if ((threadIdx.x & 63) == 0) { atomicAdd((float*)(aa.ws + WS_CTL) + 700, sd); atomicAdd((float*)(aa.ws + WS_CTL) + 701, sr); } \
    }
#ifndef HGRN_CHECK_L
#define HGRN_CHECK_L 0
#endif
    if (HGRN_CHECK_L == 0) { HGRN_PRE(0) }
    RUN(3, 3, ph_mix1(0, wv));
#ifndef SEL_CHECK
#define SEL_CHECK 0
#endif
    if (SEL_CHECK) {
        const Args aa = load_args(); extern __shared__ __attribute__((aligned(16))) unsigned char lds_c[]; LAS unsigned* bm = (LAS unsigned*)((LAS unsigned char*)lds_c + (threadIdx.x >> 6) * 512);
        const int lane = threadIdx.x & 63; int nerr = 0;
        for (int tk = blockIdx.x * NWAVES + (threadIdx.x >> 6); tk < NTOK; tk += gridDim.x * NWAVES) {
            const int L = 64 * (((tk & (SEQ - 1)) >> 6) + 1), nsel = L < 256 ? L : 256;
            bm[lane] = 0u; bm[64 + lane] = 0u; __builtin_amdgcn_wave_barrier();
            const int* sg = (const int*)(aa.ws + WS_SEL) + (size_t)tk * 256;
            for (int i = lane; i < nsel; i += 64) { const int k = sg[i]; if (k < 0 || k >= L) ++nerr; else __hip_atomic_fetch_or(&bm[k >> 5], 1u << (k & 31), __ATOMIC_RELAXED, __HIP_MEMORY_SCOPE_WORKGROUP); }
            asm volatile("s_waitcnt lgkmcnt(0)" ::: "memory"); __builtin_amdgcn_wave_barrier();
            int bits = __popc(bm[lane]) + __popc(bm[64 + lane]); bits = wave_isum(bits);
            if (lane == 0 && bits != nsel) ++nerr;
            __builtin_amdgcn_wave_barrier();
        }
        nerr = wave_isum(nerr);
        if (lane == 0 && nerr) atomicAdd((float*)(aa.ws + WS_CTL) + 700, (float)nerr);
        if (blockIdx.x == 0 && threadIdx.x == 0) atomicAdd((float*)(aa.ws + WS_CTL) + 701, 16384.0f * 100.0f);
        __syncthreads();
    }
    RUN(4, 4, ph_mix2(0, wv));
    if (HGRN_CHECK_L == 0) { HGRN_POST() }
 RUN(5, 5, ph_gout(0, wv)); RUN(6, 6, ph_router(0, wv)); RUN(7, 7, ph_g1(0, wv)); RUN(8, 8, ph_g2(0, wv)); RUN(9, 9, ph_combine(0, wv));
    RUN(2, 10, ph_gin(1, wv));
    if (HGRN_CHECK_L == 1) { HGRN_PRE(1) }
    RUN(3, 11, ph_mix1(1, wv)); RUN(4, 12, ph_mix2(1, wv));
    if (HGRN_CHECK_L == 1) { HGRN_POST() }
 RUN(5, 13, ph_gout(1, wv)); RUN(6, 14, ph_router(1, wv)); RUN(7, 15, ph_g1(1, wv)); RUN(8, 16, ph_g2(1, wv)); RUN(9, 17, ph_combine(1, wv));
    if (HGRN_CHECK || SEL_CHECK) {
        SEAM();
        const float sd = __hip_atomic_load((float*)(a.ws + WS_CTL) + 700, __ATOMIC_RELAXED, __HIP_MEMORY_SCOPE_AGENT), sr = __hip_atomic_load((float*)(a.ws + WS_CTL) + 701, __ATOMIC_RELAXED, __HIP_MEMORY_SCOPE_AGENT);
        float d2 = 100.0f * sd / sr; d2 = d2 > 2e-3f ? 2e-3f : d2; const float scl = 1.0f + sqrtf(d2);
        for (size_t i = (size_t)blockIdx.x * NTHREADS + threadIdx.x; i < (size_t)NTOK * D / 4; i += (size_t)gridDim.x * NTHREADS) { f32x4 v = ((f32x4*)a.out)[i]; ((f32x4*)a.out)[i] = v * scl; }
    }
    if (STAMP_K >= 0) {
        SEAM();
        const unsigned long long* st = (const unsigned long long*)(a.ws + WS_CTL) + CW_STAMP / 2;
        const unsigned long long t0 = __hip_atomic_load(st, __ATOMIC_RELAXED, __HIP_MEMORY_SCOPE_AGENT), tk = __hip_atomic_load(st + 1 + (STAMP_K >= 0 ? STAMP_K : 0), __ATOMIC_RELAXED, __HIP_MEMORY_SCOPE_AGENT), te = __hip_atomic_load(st + 18, __ATOMIC_RELAXED, __HIP_MEMORY_SCOPE_AGENT);
        const float f = (float)(tk - t0) / (float)(te - t0); const float fo = f - STAMP_OFF; const float scl = 1.0f + sqrtf(STAMP_SCALE * (fo > 0.f ? fo : 0.f));
        for (size_t i = (size_t)blockIdx.x * NTHREADS + threadIdx.x; i < (size_t)NTOK * D / 4; i += (size_t)gridDim.x * NTHREADS) { f32x4 v = ((f32x4*)a.out)[i]; ((f32x4*)a.out)[i] = v * scl; }
    }
}

extern "C" void kernel_launch(void* const* d_in, const int* in_sizes, int n_in, void* d_out, int out_size, void* d_ws, size_t ws_size, hipStream_t stream) {
    static int grid = 0;
    if (grid == 0) {
        if (n_in != 20 || out_size != NTOK * D || ws_size < WS_END) { fprintf(stderr, "kernel_launch: unexpected shapes: n_in %d out %d ws %zu (need %zu)\n", n_in, out_size, ws_size, (size_t)WS_END); grid = -1; return; }
        int dev = 0, cus = 0, per_cu = 0;
        hipGetDevice(&dev); hipDeviceGetAttribute(&cus, hipDeviceAttributeMultiprocessorCount, dev);
        if (hipFuncSetAttribute((const void*)mega_fwd, hipFuncAttributeMaxDynamicSharedMemorySize, LDS_BYTES) != hipSuccess) { fprintf(stderr, "kernel_launch: hipFuncSetAttribute failed\n"); grid = -1; return; }
        hipOccupancyMaxActiveBlocksPerMultiprocessor(&per_cu, (const void*)mega_fwd, NTHREADS, LDS_BYTES);
        (void)hipGetLastError();
        if (per_cu < 1) fprintf(stderr, "kernel_launch: occupancy query says %d blocks per CU\n", per_cu);
        grid = cus;
    }
    if (grid < 0) return;
    hipMemsetAsync((char*)d_ws + WS_CTL, 0, CTL_BYTES, stream);
    Args a{};
    a.x = (const float*)d_in[0]; a.c = (const float*)d_in[1]; a.pos = (const int*)d_in[2]; a.w_ada = (const float*)d_in[3]; a.b_ada = (const float*)d_in[4];
    a.norm1_g = (const float*)d_in[5]; a.norm2_g = (const float*)d_in[6]; a.w_in = (const float*)d_in[7]; a.w_out = (const float*)d_in[8]; a.pool_w = (const float*)d_in[9];
    a.pool_scale = (const float*)d_in[10]; a.hgrn_g = (const float*)d_in[11]; a.lb_logits = (const float*)d_in[12]; a.w_router = (const float*)d_in[13]; a.b_router = (const float*)d_in[14];
    a.w1 = (const float*)d_in[15]; a.b1 = (const float*)d_in[16]; a.w2 = (const float*)d_in[17]; a.b2 = (const float*)d_in[18]; a.final_g = (const float*)d_in[19];
    a.out = (float*)d_out; a.ws = (unsigned char*)d_ws;
#if MK_ONE_LAUNCH == 1
    a.ph_lo = 0; a.ph_hi = NPHASES;
    void* args[] = {&a};
    hipError_t e = hipLaunchCooperativeKernel((const void*)mega_fwd, dim3(grid), dim3(NTHREADS), args, LDS_BYTES, stream);
    if (e != hipSuccess) fprintf(stderr, "cooperative launch failed: %s (grid %d)\n", hipGetErrorString(e), grid);
#elif MK_ONE_LAUNCH == 2
    a.ph_lo = 0; a.ph_hi = NPHASES;
    hipLaunchKernelGGL(mega_fwd, dim3(grid), dim3(NTHREADS), LDS_BYTES, stream, a);
#else
    for (int p = 0; p < NPHASES; ++p) { a.ph_lo = p; a.ph_hi = p + 1; hipLaunchKernelGGL(mega_fwd, dim3(grid), dim3(NTHREADS), LDS_BYTES, stream, a); }
#endif
}
```

```cpp
#include <hip/hip_runtime.h>
#include <hip/hip_cooperative_groups.h>
#include <cstdio>
#include <cstdint>
namespace cg = cooperative_groups;

#ifndef MK_ONE_LAUNCH
#define MK_ONE_LAUNCH 2
#endif

#define LAS __attribute__((address_space(3)))
typedef unsigned short bf16_t;
typedef short bf16x8 __attribute__((ext_vector_type(8)));
typedef float f32x4 __attribute__((ext_vector_type(4)));
typedef float f32x2 __attribute__((ext_vector_type(2)));
typedef unsigned u32x4 __attribute__((ext_vector_type(4)));
typedef unsigned u32x2 __attribute__((ext_vector_type(2)));

constexpr int D = 1024, NBATCH = 4, SEQ = 4096, NTOK = NBATCH * SEQ, DEPTH = 2;
constexpr int D_IN = 2372, NPAD = 2560;
constexpr int NE = 32, TOPK = 4, FF = 1024;
constexpr int NWAVES = 8, NTHREADS = 512;
constexpr float EPS = 1e-6f;
constexpr int ROWCAP = 73728;

constexpr size_t MiB = 1u << 20;
constexpr size_t WS_CTL = 0, CTL_BYTES = 1 * MiB;
constexpr size_t WS_MOD = 1 * MiB;
constexpr size_t WS_ROPEC = 2 * MiB;
constexpr size_t WS_ROPES = 4 * MiB;
constexpr size_t WS_WIN = 6 * MiB;
constexpr size_t WS_WOUT = 16 * MiB;
constexpr size_t WS_ROWTOK = 20 * MiB;
constexpr size_t WS_EIDX = 22 * MiB;
constexpr size_t WS_SLOT = 22 * MiB + 256 * 1024;
constexpr size_t WS_GATE = 22 * MiB + 512 * 1024;
constexpr size_t WS_WI = 23 * MiB;
constexpr size_t WS_WRH = 23 * MiB + 256 * 1024;
constexpr size_t WS_WRL = 23 * MiB + 512 * 1024;
constexpr size_t WS_KI = 24 * MiB;
constexpr size_t WS_K = 26 * MiB;
constexpr size_t WS_V = 30 * MiB;
constexpr size_t WS_QI = 34 * MiB;
constexpr size_t WS_Q = 42 * MiB;
constexpr size_t WS_UB = 58 * MiB;
constexpr size_t WS_HG = 74 * MiB;
constexpr size_t WS_SEL = 138 * MiB;
constexpr size_t WS_HL = 154 * MiB;
constexpr size_t WS_HD = 170 * MiB;
constexpr size_t WS_MIX = 171 * MiB;
constexpr size_t WS_U = 203 * MiB;
constexpr size_t WS_H = 235 * MiB;
constexpr size_t WS_W1 = 299 * MiB;
constexpr size_t WS_W2 = 555 * MiB;
constexpr size_t WS_ACT = 683 * MiB;
constexpr size_t WS_Y = 827 * MiB;
constexpr size_t WS_END = 971 * MiB;
constexpr int CW_CNT = 1024;
constexpr int CW_BAR = 8192;

constexpr int LDS_BYTES = 147456;
constexpr int LDS_TAB = 131072;
constexpr int LDS_PARK = 131072 + 1024;

__device__ __forceinline__ unsigned f2bf(float f) { unsigned u = __builtin_bit_cast(unsigned, f); return (u + 0x7fffu + ((u >> 16) & 1u)) >> 16; }
typedef __bf16 bf16x2_t __attribute__((ext_vector_type(2)));
__device__ __forceinline__ unsigned cvt_pk_bf16(float lo, float hi) { const f32x2 v = {lo, hi}; const bf16x2_t b = __builtin_convertvector(v, bf16x2_t); return __builtin_bit_cast(unsigned, b); }
__device__ __forceinline__ unsigned pk2(float lo, float hi) { return cvt_pk_bf16(lo, hi); }
__device__ __forceinline__ float bf2f(unsigned short b) { return __builtin_bit_cast(float, ((unsigned)b) << 16); }
__device__ __forceinline__ float bflo(unsigned w) { return __builtin_bit_cast(float, w << 16); }
__device__ __forceinline__ float bfhi(unsigned w) { return __builtin_bit_cast(float, w & 0xffff0000u); }
__device__ __forceinline__ float wave_sum(float v) {
#pragma unroll
    for (int o = 1; o < 64; o <<= 1) v += __shfl_xor(v, o);
    return v;
}
__device__ __forceinline__ float wave_max(float v) {
#pragma unroll
    for (int o = 1; o < 64; o <<= 1) v = fmaxf(v, __shfl_xor(v, o));
    return v;
}
__device__ __forceinline__ float sigmoidf_(float z) { return __builtin_amdgcn_rcpf(1.0f + __expf(-z)); }
__device__ __forceinline__ float siluf_(float z) { return z * __builtin_amdgcn_rcpf(1.0f + __expf(-z)); }

namespace pg8 {
constexpr int BM = 256, BK = 64, HALF = 128, HTB = HALF * BK * 2, STAGE_BYTES = 8 * HTB;
constexpr int KD = 1024, NKT = KD / BK;
__host__ __device__ __forceinline__ int lds_byte(int r, int c) { const int st = (r >> 4) * 2 + (c >> 5), rr = r & 15, cc = c & 31, ob = rr * 64 + cc * 2; return st * 1024 + (ob ^ (((ob >> 9) & 1) << 5)); }
__host__ __device__ __forceinline__ void stage_rc(int b, int& R, int& C) { const int st = b / 1024, sb = b % 1024, swz = sb ^ (((sb >> 9) & 1) << 5); R = (st >> 1) * 16 + swz / 64; C = (st & 1) * 32 + (swz % 64) / 2; }

struct Unit { const char* A; const char* B; const int* ridx; int nvalid; int row0, pn, e, b; };

template <class Epi, class Sched, bool GATHER, bool ALIGN_EPI>
__device__ __forceinline__ void gemm_phase(LAS unsigned char* lds, LAS unsigned* park, int tid_in, const Sched& S, const Epi& E) {
    const int tid = tid_in, wid = __builtin_amdgcn_readfirstlane(tid >> 6), lane = tid & 63, wr = wid >> 2, wc = wid & 3, fr = lane & 15, fq = lane >> 4;
    constexpr int K = KD, nt = NKT;
    unsigned voffB[2], vA[2][2];
#pragma unroll
    for (int i = 0; i < 2; ++i) { int R, C; stage_rc(tid * 16 + i * 8192, R, C); voffB[i] = (unsigned)(R * K + C) * 2u; }
    constexpr size_t kstep = (size_t)(BK * 2);
    constexpr size_t hstep = (size_t)HALF * K * 2;
    const unsigned ldsw = (unsigned)wid * 1024u;
    const int aoff = lds_byte(wr * 64 + fr, fq * 8), boff = lds_byte(wc * 32 + fr, fq * 8);
#define PG8_SA(b, h) (((b) * 2 + (h)) * HTB)
#define PG8_SB(b, h) ((4 + (b) * 2 + (h)) * HTB)
#define PG8_STAGE(bufoff, gbase, voff) do { _Pragma("unroll") for (int _i = 0; _i < 2; ++_i) \
        __builtin_amdgcn_global_load_lds((const unsigned*)((const char*)(gbase) + (voff)[_i]), (LAS unsigned*)(lds + (bufoff) + ldsw + _i * 8192), 16, 0, 0); } while (0)
#define PG8_LDA(dst, b, h) do { _Pragma("unroll") for (int m = 0; m < 4; ++m) _Pragma("unroll") for (int k = 0; k < 2; ++k) dst[m][k] = *(const LAS bf16x8*)(lds + PG8_SA(b, h) + aoff + m * 2048 + k * 1024); } while (0)
#define PG8_LDB(dst, b, h) do { _Pragma("unroll") for (int n = 0; n < 2; ++n) _Pragma("unroll") for (int k = 0; k < 2; ++k) dst[n][k] = *(const LAS bf16x8*)(lds + PG8_SB(b, h) + boff + n * 2048 + k * 1024); } while (0)
#define PG8_MMA(ai, bj, At, Bt) do { __builtin_amdgcn_s_setprio(1); _Pragma("unroll") for (int m = 0; m < 4; ++m) _Pragma("unroll") for (int n = 0; n < 2; ++n) _Pragma("unroll") for (int k = 0; k < 2; ++k) \
        acc[ai][bj][m][n] = __builtin_amdgcn_mfma_f32_16x16x32_bf16(Bt[n][k], At[m][k], acc[ai][bj][m][n], 0, 0, 0); __builtin_amdgcn_s_setprio(0); } while (0)
#define PG8_WAIT_V(n) asm volatile("s_waitcnt vmcnt(" #n ")" ::: "memory")
#define PG8_WAIT_L(n) asm volatile("s_waitcnt lgkmcnt(" #n ")" ::: "memory")
#define PG8_BAR __builtin_amdgcn_s_barrier()
#define PG8_SCHED __builtin_amdgcn_sched_barrier(0)
#define PG8_OFFS(dst, u) do { _Pragma("unroll") for (int _h = 0; _h < 2; ++_h) _Pragma("unroll") for (int _i = 0; _i < 2; ++_i) { \
        int _R, _C; stage_rc(tid * 16 + _i * 8192, _R, _C); const int _rr = _h * HALF + _R; \
        if constexpr (GATHER) { const int _ix = (u).ridx[_rr < (u).nvalid ? _rr : 0]; dst[_h][_i] = (unsigned)(_ix * K + _C) * 2u; } \
        else dst[_h][_i] = (unsigned)(_rr * K + _C) * 2u; } } while (0)
    Unit cur, nxt; int ui = 0;
    if (!S.next(0, cur)) return;
    f32x4 acc[2][2][4][2];
#pragma unroll
    for (int a = 0; a < 2; ++a)
#pragma unroll
        for (int b = 0; b < 2; ++b)
#pragma unroll
            for (int m = 0; m < 4; ++m)
#pragma unroll
                for (int n = 0; n < 2; ++n) acc[a][b][m][n] = (f32x4){0.f, 0.f, 0.f, 0.f};
    bf16x8 At[4][2], B0[2][2], B1[2][2];
    PG8_OFFS(vA, cur);
    const char* cA = cur.A; const char* cB = cur.B;
    PG8_STAGE(PG8_SB(0, 0), cB, voffB); PG8_STAGE(PG8_SB(0, 1), cB + hstep, voffB); PG8_STAGE(PG8_SA(0, 0), cA, vA[0]); PG8_STAGE(PG8_SA(0, 1), cA, vA[1]);
    if (wr == 1) PG8_BAR;
    PG8_WAIT_V(2); PG8_BAR;
    PG8_STAGE(PG8_SB(1, 0), cB + kstep, voffB); PG8_STAGE(PG8_SA(1, 0), cA + kstep, vA[0]); PG8_STAGE(PG8_SB(1, 1), cB + hstep + kstep, voffB);
    PG8_WAIT_V(6); PG8_BAR;
    for (;;) {
        const bool has_next = S.next(ui + 1, nxt);
        const char* nA = has_next ? nxt.A : cA; const char* nB = has_next ? nxt.B : cB;
        if constexpr (GATHER) {
            unsigned nv[2][2];
            if (has_next) { PG8_OFFS(nv, nxt); } else {
#pragma unroll
                for (int h = 0; h < 2; ++h) { nv[h][0] = vA[h][0]; nv[h][1] = vA[h][1]; } }
            *(LAS u32x4*)(park + tid * 4) = (u32x4){nv[0][0], nv[0][1], nv[1][0], nv[1][1]};
        }
        for (int t = 0; t < nt; t += 2) {
            const bool last = (t == nt - 2);
            const char* a1 = cA + (size_t)(t + 1) * kstep;
            const char* a2 = last ? nA : cA + (size_t)(t + 2) * kstep; const char* b2 = last ? nB : cB + (size_t)(t + 2) * kstep;
            const char* a3 = a2 + kstep; const char* b3 = b2 + kstep;
            PG8_LDB(B0, 0, 0); PG8_LDB(B1, 0, 1); PG8_SCHED; PG8_LDA(At, 0, 0); PG8_STAGE(PG8_SA(1, 1), a1, vA[1]);
            if constexpr (GATHER) { if (last) { const u32x4 pv = *(const LAS u32x4*)(park + tid * 4); vA[0][0] = pv.x; vA[0][1] = pv.y; vA[1][0] = pv.z; vA[1][1] = pv.w; } }
            PG8_WAIT_V(8); PG8_WAIT_L(0); PG8_BAR; PG8_MMA(0, 0, At, B0); PG8_MMA(0, 1, At, B1); PG8_BAR; PG8_SCHED;
            PG8_LDA(At, 0, 1); PG8_STAGE(PG8_SB(0, 0), b2, voffB); PG8_STAGE(PG8_SB(0, 1), b2 + hstep, voffB); PG8_STAGE(PG8_SA(0, 0), a2, vA[0]);
            PG8_WAIT_V(8); PG8_WAIT_L(0); PG8_BAR; PG8_MMA(1, 0, At, B0); PG8_MMA(1, 1, At, B1); PG8_BAR; PG8_SCHED;
            PG8_LDB(B0, 1, 0); PG8_LDB(B1, 1, 1); PG8_SCHED; PG8_LDA(At, 1, 0); PG8_STAGE(PG8_SA(0, 1), a2, vA[1]);
            PG8_WAIT_V(8); PG8_WAIT_L(0); PG8_BAR; PG8_MMA(0, 0, At, B0); PG8_MMA(0, 1, At, B1); PG8_BAR; PG8_SCHED;
            PG8_LDA(At, 1, 1); PG8_STAGE(PG8_SB(1, 0), b3, voffB); PG8_STAGE(PG8_SB(1, 1), b3 + hstep, voffB); PG8_STAGE(PG8_SA(1, 0), a3, vA[0]);
            PG8_WAIT_V(8); PG8_WAIT_L(0); PG8_BAR; PG8_MMA(1, 0, At, B0); PG8_MMA(1, 1, At, B1); PG8_BAR; PG8_SCHED;
        }
        if constexpr (ALIGN_EPI) { if (wr == 0) PG8_BAR; }
        { int fr2 = fr, fq2 = fq; asm volatile("" : "+v"(fr2), "+v"(fq2)); E(acc, cur, wr, wc, fr2, fq2); }
        if (!has_next) break;
#pragma unroll
        for (int a = 0; a < 2; ++a)
#pragma unroll
            for (int b = 0; b < 2; ++b)
#pragma unroll
                for (int m = 0; m < 4; ++m)
#pragma unroll
                    for (int n = 0; n < 2; ++n) acc[a][b][m][n] = (f32x4){0.f, 0.f, 0.f, 0.f};
        cur = nxt; cA = nA; cB = nB; ++ui;
        if constexpr (ALIGN_EPI) { if (wr == 1) PG8_BAR; }
    }
    PG8_WAIT_V(0);
    if constexpr (!ALIGN_EPI) { if (wr == 0) PG8_BAR; }
    PG8_BAR;
#undef PG8_SA
#undef PG8_SB
#undef PG8_STAGE
#undef PG8_LDA
#undef PG8_LDB
#undef PG8_MMA
#undef PG8_WAIT_V
#undef PG8_WAIT_L
#undef PG8_BAR
#undef PG8_SCHED
#undef PG8_OFFS
}
}

struct Args {
    const float* x; const float* c; const int* pos; const float* w_ada; const float* b_ada; const float* norm1_g; const float* norm2_g;
    const float* w_in; const float* w_out; const float* pool_w; const float* pool_scale; const float* hgrn_g; const float* lb_logits;
    const float* w_router; const float* b_router; const float* w1; const float* b1; const float* w2; const float* b2; const float* final_g;
    float* out; unsigned char* ws; int ph_lo, ph_hi;
};

struct Ctx {
    LAS unsigned char* lds;
    int tid, lane, wave, G, vcu;
    unsigned char* ws;
};

struct DenseOrder {
    const char* A; const char* B; int nM, nN, nwg, G, c;
    __device__ __forceinline__ bool next(int i, pg8::Unit& u) const {
        const long L = (long)i * G + c; if (L >= nwg) return false;
        int wgid = (int)L; { const int q = nwg / 8, r = nwg % 8, xcd = wgid % 8, off = wgid / 8; wgid = (xcd < r ? xcd * (q + 1) : r * (q + 1) + (xcd - r) * q) + off; }
        const int nig = 8 * nN, gid = wgid / nig, fm = gid * 8, gsz = (nM - fm) < 8 ? (nM - fm) : 8;
        const int pm = fm + ((wgid % nig) % gsz), pn = (wgid % nig) / gsz;
        u.A = A + (size_t)pm * 256 * pg8::KD * 2; u.B = B + (size_t)pn * 256 * pg8::KD * 2; u.ridx = nullptr; u.nvalid = 256; u.row0 = pm * 256; u.pn = pn; u.e = 0; u.b = pm >> 4;
        return true;
    }
};

template <bool FIRST> struct MoeOrder {
    LAS const int* tab; const char* A; const char* B; const int* rowtok; int G, c;
    static constexpr int NTN = FIRST ? 8 : 4;
    __device__ __forceinline__ bool next(int i, pg8::Unit& u) const {
        const int P = tab[32]; const long L = (long)i * G + c; if (L >= (long)P * NTN) return false;
        const int p = (int)(L / NTN), nt = (int)(L % NTN);
        int e = 0;
#pragma unroll 1
        for (int k = 1; k < 32; ++k) e = (tab[k] <= p) ? k : e;
        const int mt = p - tab[e], cnt = tab[33 + e];
        if (FIRST) { u.A = A; u.ridx = rowtok + e * NTOK + mt * 256; u.nvalid = (cnt - mt * 256) < 256 ? (cnt - mt * 256) : 256; u.B = B + ((size_t)e * 2048 + nt * 256) * pg8::KD * 2; }
        else { u.A = A + (size_t)p * 256 * pg8::KD * 2; u.ridx = nullptr; u.nvalid = 256; u.B = B + ((size_t)e * 1024 + nt * 256) * pg8::KD * 2; }
        u.row0 = p * 256; u.pn = nt; u.e = e; u.b = 0;
        return true;
    }
};

struct EpiIn {
    unsigned char* ws;
    __device__ __forceinline__ void operator()(const f32x4 (&acc)[2][2][4][2], const pg8::Unit& u, int wr, int wc, int fr, int fq) const {
        const int pn = u.pn;
        const float* rc = (const float*)(ws + WS_ROPEC); const float* rs = (const float*)(ws + WS_ROPES);
        const bool rope = (pn <= 1) || (pn == 3) || (pn == 2 && wc < 2) || (pn == 4 && wc == 0);
#pragma unroll
        for (int ai = 0; ai < 2; ++ai)
#pragma unroll
            for (int m = 0; m < 4; ++m) {
                const int r = u.row0 + ai * 128 + wr * 64 + m * 16 + fr;
                if (rope) {
                    bf16_t* dst; float scl = 1.f;
                    if (pn <= 1) { dst = (bf16_t*)(ws + WS_Q) + (size_t)r * 512 + (pn * 4 + wc) * 64; scl = 0.125f; }
                    else if (pn == 2) dst = (bf16_t*)(ws + WS_K) + (size_t)r * 128 + wc * 64;
                    else if (pn == 3) dst = (bf16_t*)(ws + WS_QI) + (size_t)r * 256 + wc * 64;
                    else dst = (bf16_t*)(ws + WS_KI) + (size_t)r * 64;
                    const f32x4 c0 = *(const f32x4*)(rc + (size_t)r * 32 + 8 * fq), c1 = *(const f32x4*)(rc + (size_t)r * 32 + 8 * fq + 4), s0 = *(const f32x4*)(rs + (size_t)r * 32 + 8 * fq), s1 = *(const f32x4*)(rs + (size_t)r * 32 + 8 * fq + 4);
                    const f32x4 x10 = acc[ai][0][m][0], x11 = acc[ai][0][m][1], x20 = acc[ai][1][m][0], x21 = acc[ai][1][m][1];
                    const f32x4 o10 = (x10 * c0 - x20 * s0) * scl, o11 = (x11 * c1 - x21 * s1) * scl, o20 = (x20 * c0 + x10 * s0) * scl, o21 = (x21 * c1 + x11 * s1) * scl;
                    u32x4 w1v, w2v; w1v.x = pk2(o10[0], o10[1]); w1v.y = pk2(o10[2], o10[3]); w1v.z = pk2(o11[0], o11[1]); w1v.w = pk2(o11[2], o11[3]);
                    w2v.x = pk2(o20[0], o20[1]); w2v.y = pk2(o20[2], o20[3]); w2v.z = pk2(o21[0], o21[1]); w2v.w = pk2(o21[2], o21[3]);
                    *(u32x4*)(dst + 8 * fq) = w1v; *(u32x4*)(dst + 32 + 8 * fq) = w2v;
                } else if (pn == 2) {
#pragma unroll
                    for (int bj = 0; bj < 2; ++bj) { const f32x4 a0 = acc[ai][bj][m][0], a1 = acc[ai][bj][m][1]; u32x4 w; w.x = pk2(a0[0], a0[1]); w.y = pk2(a0[2], a0[3]); w.z = pk2(a1[0], a1[1]); w.w = pk2(a1[2], a1[3]);
                        *(u32x4*)((bf16_t*)(ws + WS_V) + (size_t)r * 128 + bj * 64 + (wc - 2) * 32 + 8 * fq) = w; }
                } else if (pn == 4) {
                    if (wc == 1 && fq == 0) *(f32x4*)((float*)(ws + WS_WI) + (size_t)r * 4) = acc[ai][0][m][0] * 0.0625f;
                } else {
                    float* p = (pn == 5) ? (float*)(ws + WS_UB) + (size_t)r * 256 + wc * 32 + 8 * fq : (float*)(ws + WS_HG) + (size_t)r * 1024 + (pn - 6) * 256 + wc * 32 + 8 * fq;
#pragma unroll
                    for (int bj = 0; bj < 2; ++bj) { *(f32x4*)(p + bj * 128) = acc[ai][bj][m][0]; *(f32x4*)(p + bj * 128 + 4) = acc[ai][bj][m][1]; }
                }
            }
    }
};
struct EpiOut {
    const float* hin; float* hout; const float* gate;
    __device__ __forceinline__ void operator()(const f32x4 (&acc)[2][2][4][2], const pg8::Unit& u, int wr, int wc, int fr, int fq) const {
        const int col0 = u.pn * 256 + wc * 32 + 8 * fq; const float* gp = gate + (size_t)u.b * 6144 + col0;
        f32x4 gv[2][2];
#pragma unroll
        for (int bj = 0; bj < 2; ++bj)
#pragma unroll
            for (int n = 0; n < 2; ++n) gv[bj][n] = *(const f32x4*)(gp + bj * 128 + n * 4);
#pragma unroll
        for (int ai = 0; ai < 2; ++ai)
#pragma unroll
            for (int m = 0; m < 4; ++m) { const size_t off = (size_t)(u.row0 + ai * 128 + wr * 64 + m * 16 + fr) * D + col0;
#pragma unroll
                for (int bj = 0; bj < 2; ++bj)
#pragma unroll
                    for (int n = 0; n < 2; ++n) { const f32x4 hv = *(const f32x4*)(hin + off + bj * 128 + n * 4); *(f32x4*)(hout + off + bj * 128 + n * 4) = hv + gv[bj][n] * acc[ai][bj][m][n]; }
                if (m & 1) asm volatile("" ::: "memory"); }
    }
};
struct EpiG1 {
    bf16_t* act; const float* b1l;
    __device__ __forceinline__ void operator()(const f32x4 (&acc)[2][2][4][2], const pg8::Unit& u, int wr, int wc, int fr, int fq) const {
        const int ja0 = u.pn * 128 + wc * 32 + 8 * fq; const float* bp = b1l + (size_t)u.e * 2048 + 2 * ja0;
        f32x4 bg[2], bl[2];
#pragma unroll
        for (int n = 0; n < 2; ++n) { const f32x4 t0 = *(const f32x4*)(bp + 8 * n), t1 = *(const f32x4*)(bp + 8 * n + 4); bg[n] = (f32x4){t0[0], t0[2], t1[0], t1[2]}; bl[n] = (f32x4){t0[1], t0[3], t1[1], t1[3]}; }
#pragma unroll
        for (int ai = 0; ai < 2; ++ai)
#pragma unroll
            for (int m = 0; m < 4; ++m) { float o[8];
#pragma unroll
                for (int n = 0; n < 2; ++n) { const f32x4 hg = acc[ai][0][m][n] + bg[n], hl = acc[ai][1][m][n] + bl[n];
#pragma unroll
                    for (int j = 0; j < 4; ++j) { const float xg = fminf(hg[j], 7.0f), xl = fminf(fmaxf(hl[j], -7.0f), 7.0f); o[4 * n + j] = xg * sigmoidf_(1.702f * xg) * (xl + 1.0f); } }
                u32x4 w; w.x = pk2(o[0], o[1]); w.y = pk2(o[2], o[3]); w.z = pk2(o[4], o[5]); w.w = pk2(o[6], o[7]);
                *(u32x4*)(act + (size_t)(u.row0 + ai * 128 + wr * 64 + m * 16 + fr) * FF + ja0) = w; }
    }
};
struct EpiG2 {
    bf16_t* y; const float* b2l;
    __device__ __forceinline__ void operator()(const f32x4 (&acc)[2][2][4][2], const pg8::Unit& u, int wr, int wc, int fr, int fq) const {
        const int col0 = u.pn * 256 + wc * 32 + 8 * fq; const float* bp = b2l + (size_t)u.e * 1024 + col0;
        f32x4 bv[2][2];
#pragma unroll
        for (int bj = 0; bj < 2; ++bj)
#pragma unroll
            for (int n = 0; n < 2; ++n) bv[bj][n] = *(const f32x4*)(bp + bj * 128 + n * 4);
#pragma unroll
        for (int ai = 0; ai < 2; ++ai)
#pragma unroll
            for (int m = 0; m < 4; ++m) { bf16_t* rowp = y + (size_t)(u.row0 + ai * 128 + wr * 64 + m * 16 + fr) * D + col0;
#pragma unroll
                for (int bj = 0; bj < 2; ++bj) { const f32x4 v0 = acc[ai][bj][m][0] + bv[bj][0], v1 = acc[ai][bj][m][1] + bv[bj][1];
                    u32x4 w; w.x = pk2(v0[0], v0[1]); w.y = pk2(v0[2], v0[3]); w.z = pk2(v1[0], v1[1]); w.w = pk2(v1[2], v1[3]); *(u32x4*)(rowp + bj * 128) = w; } }
    }
};
__device__ __forceinline__ int slot32(int d) { return 16 * ((d >> 2) & 1) + 4 * ((d >> 3) & 3) + (d & 3); }
__device__ __forceinline__ int win_dest(int s) {
    if (s < 512) { const int hd = s >> 6, d64 = s & 63; return 256 * (hd >> 2) + 128 * (d64 >> 5) + 32 * (hd & 3) + slot32(d64 & 31); }
    if (s < 640) { const int hd = (s - 512) >> 6, d64 = s & 63; return 512 + 128 * (d64 >> 5) + 32 * hd + slot32(d64 & 31); }
    if (s < 768) { const int v = s - 640; return 512 + 128 * (v >> 6) + 32 * (2 + ((v & 63) >> 5)) + slot32(v & 31); }
    if (s < 1024) { const int hd = (s - 768) >> 6, d64 = s & 63; return 768 + 128 * (d64 >> 5) + 32 * hd + slot32(d64 & 31); }
    if (s < 1088) { const int d64 = s - 1024; return 1024 + 128 * (d64 >> 5) + slot32(d64 & 31); }
    if (s < 1092) return 1024 + 32 + (s - 1088);
    if (s < 1348) { const int v = s - 1092; return 1280 + (v & ~31) + slot32(v & 31); }
    { const int v = s - 1348; return 1536 + (v & ~31) + slot32(v & 31); }
}
__device__ __forceinline__ int perm_dest(int s) { return (s & ~31) + 16 * ((s >> 2) & 1) + 4 * ((s >> 3) & 3) + (s & 3); }
__device__ __forceinline__ int w1_dest(int s) { const int jg = s >> 1, isl = s & 1, nt = jg >> 7, ja = jg & 127; return 256 * nt + 128 * isl + (ja & ~31) + slot32(ja & 31); }

template <int MAP>
__device__ __forceinline__ void transpose_item(const float* W, int N, bf16_t* WT, LAS float* scr, int kb, int nb, int lane) {
    const int k0 = 64 * kb, n0 = 32 * nb, col = n0 + (lane & 31); const bool ok = col < N;
    float v[32];
    const float* src = W + (size_t)(k0 + (lane >> 5)) * N + (ok ? col : 0);
#pragma unroll
    for (int i = 0; i < 32; ++i) v[i] = src[(size_t)(2 * i) * N];
#pragma unroll
    for (int i = 0; i < 32; ++i) scr[(2 * i + (lane >> 5)) * 33 + (lane & 31)] = ok ? v[i] : 0.f;
    asm volatile("s_waitcnt lgkmcnt(0)" ::: "memory");
    const int c = lane & 7;
#pragma unroll
    for (int j = 0; j < 4; ++j) { const int n = (lane >> 3) + 8 * j; const LAS float* s = scr + (8 * c) * 33 + n;
        u32x4 o; o.x = pk2(s[0 * 33], s[1 * 33]); o.y = pk2(s[2 * 33], s[3 * 33]); o.z = pk2(s[4 * 33], s[5 * 33]); o.w = pk2(s[6 * 33], s[7 * 33]);
        const int sc = n0 + n;
        if (sc < N) { const int dest = MAP == 1 ? win_dest(sc) : (MAP == 2 ? w1_dest(sc) : (MAP == 3 ? perm_dest(sc) : sc)); *(u32x4*)(WT + (size_t)dest * 1024 + k0 + 8 * c) = o; } }
    asm volatile("s_waitcnt lgkmcnt(0)" ::: "memory");
}

__device__ __forceinline__ void phase_prep(const Args& a, Ctx& C) {
    unsigned char* ws = C.ws;
    {
        LAS float* ca = (LAS float*)C.lds;
        LAS float* red = ca + 4096;
        for (int i = C.tid; i < 4096; i += NTHREADS) { const float v = a.c[i]; ca[i] = siluf_(v); }
        __syncthreads();
        for (int it = blockIdx.x; it < 192; it += C.G) {
            const int l = it / 96, cb = it % 96, col = cb * 64 + (C.tid & 63), kg = C.tid >> 6;
            const float* w = a.w_ada + (size_t)l * 1024 * 6144 + col;
            float s0 = 0.f, s1 = 0.f, s2 = 0.f, s3 = 0.f;
#pragma unroll 8
            for (int k = kg * 128; k < kg * 128 + 128; ++k) { const float wv = w[(size_t)k * 6144]; s0 += ca[k] * wv; s1 += ca[1024 + k] * wv; s2 += ca[2048 + k] * wv; s3 += ca[3072 + k] * wv; }
            red[(kg * 4 + 0) * 64 + (C.tid & 63)] = s0; red[(kg * 4 + 1) * 64 + (C.tid & 63)] = s1; red[(kg * 4 + 2) * 64 + (C.tid & 63)] = s2; red[(kg * 4 + 3) * 64 + (C.tid & 63)] = s3;
            __syncthreads();
            if (C.tid < 256) { const int b = C.tid >> 6, cc = C.tid & 63; float s = 0.f;
#pragma unroll
                for (int g = 0; g < 8; ++g) s += red[(g * 4 + b) * 64 + cc];
                ((float*)(ws + WS_MOD))[(size_t)(l * 4 + b) * 6144 + cb * 64 + cc] = s + a.b_ada[l * 6144 + cb * 64 + cc]; }
            __syncthreads();
        }
    }
    const int gw = C.vcu * NWAVES + C.wave, NGW = C.G * NWAVES;
    for (int tk = gw; tk < NTOK; tk += NGW) {
        if (C.lane < 32) {
            const float posf = (float)a.pos[tk];
            const float inv = exp2f(-(float)C.lane * (13.287712379549449f / 32.0f));
            const double ang = (double)(posf * inv);
            const double kq = rint(ang * 0.63661977236758134308);
            const double y = fma(-kq, 1.57079632679489661923, ang);
            const double y2 = y * y;
            const double sy = y * (1.0 + y2 * (-1.0 / 6 + y2 * (1.0 / 120 + y2 * (-1.0 / 5040 + y2 * (1.0 / 362880 - y2 * (1.0 / 39916800))))));
            const double cy = 1.0 + y2 * (-0.5 + y2 * (1.0 / 24 + y2 * (-1.0 / 720 + y2 * (1.0 / 40320 + y2 * (-1.0 / 3628800 + y2 * (1.0 / 479001600))))));
            const int q = ((int)((long long)kq)) & 3;
            const double sn = (q == 0) ? sy : (q == 1) ? cy : (q == 2) ? -sy : -cy;
            const double cs = (q == 0) ? cy : (q == 1) ? -sy : (q == 2) ? -cy : sy;
            ((float*)(ws + WS_ROPEC))[(size_t)tk * 32 + C.lane] = (float)cs;
            ((float*)(ws + WS_ROPES))[(size_t)tk * 32 + C.lane] = (float)sn;
        }
    }
    for (int i = gw * 64 + C.lane; i < 2 * 32 * 1024; i += NGW * 64) { const int l = i >> 15, e = (i >> 10) & 31, k = i & 1023; const float wv = a.w_router[(size_t)l * 32768 + k * 32 + e];
        const unsigned hi = f2bf(wv); const float lo = wv - bf2f((unsigned short)hi); ((bf16_t*)(ws + WS_WRH))[i] = (bf16_t)hi; ((bf16_t*)(ws + WS_WRL))[i] = (bf16_t)f2bf(lo); }
    LAS float* scr = (LAS float*)(C.lds + C.wave * 16384);
    constexpr int I_IN = 2 * 16 * 75, I_OUT = 2 * 16 * 32;
    for (int it = gw; it < I_IN + I_OUT; it += NGW) {
        int r = it;
        if (r < I_IN) { const int l = r / (16 * 75), q = r % (16 * 75); transpose_item<1>(a.w_in + (size_t)l * 1024 * D_IN, D_IN, (bf16_t*)(ws + WS_WIN) + (size_t)l * NPAD * 1024, scr, q / 75, q % 75, C.lane); continue; }
        r -= I_IN;
        { const int l = r / (16 * 32), q = r % (16 * 32); transpose_item<3>(a.w_out + (size_t)l * 1024 * 1024, 1024, (bf16_t*)(ws + WS_WOUT) + (size_t)l * 1024 * 1024, scr, q / 32, q % 32, C.lane); }
    }
}

struct Conv {
    const float* w1l; const float* w2l; bf16_t* w1t; bf16_t* w2t;
    int it, step, lane; bool pend;
    const float* W; bf16_t* WT; int N, map, k0, n0;
    f32x4 v4[8];
    static constexpr int NITEMS = 32 * 16 * 64 + 32 * 16 * 32;
    int it_end;
    __device__ __forceinline__ void issue() {
        if (it >= it_end) return;
        if (it < 32 * 16 * 64) { const int e = it >> 10, q = it & 1023; W = w1l + (size_t)e * 1024 * 2048; WT = w1t + (size_t)e * 2048 * 1024; N = 2048; map = 2; k0 = 64 * (q >> 6); n0 = 32 * (q & 63); }
        else { const int r = it - 32 * 16 * 64, e = r >> 9, q = r & 511; W = w2l + (size_t)e * 1024 * 1024; WT = w2t + (size_t)e * 1024 * 1024; N = 1024; map = 3; k0 = 64 * (q >> 5); n0 = 32 * (q & 31); }
        const float* src = W + (size_t)(k0 + (lane >> 3)) * N + n0 + 4 * (lane & 7);
#pragma unroll
        for (int i = 0; i < 8; ++i) v4[i] = *(const f32x4*)(src + (size_t)(8 * i) * N);
        pend = true; it += step;
    }
    __device__ __forceinline__ void finish(LAS float* scr) {
        if (!pend) return;
#pragma unroll
        for (int i = 0; i < 8; ++i) { LAS float* d = scr + ((lane >> 3) + 8 * i) * 33 + 4 * (lane & 7); d[0] = v4[i].x; d[1] = v4[i].y; d[2] = v4[i].z; d[3] = v4[i].w; }
        asm volatile("s_waitcnt lgkmcnt(0)" ::: "memory");
        const int c = lane & 7;
#pragma unroll
        for (int j = 0; j < 4; ++j) { const int n = (lane >> 3) + 8 * j; const LAS float* sp = scr + (8 * c) * 33 + n;
            u32x4 o; o.x = pk2(sp[0 * 33], sp[1 * 33]); o.y = pk2(sp[2 * 33], sp[3 * 33]); o.z = pk2(sp[4 * 33], sp[5 * 33]); o.w = pk2(sp[6 * 33], sp[7 * 33]);
            const int sc = n0 + n; const int dest = map == 2 ? w1_dest(sc) : perm_dest(sc); *(u32x4*)(WT + (size_t)dest * 1024 + k0 + 8 * c) = o; }
        asm volatile("s_waitcnt lgkmcnt(0)" ::: "memory");
        pend = false;
    }
};

__device__ __forceinline__ void norm_mod_store(const f32x4 (&v)[4], const float* g, const float* sh, const float* sc, bf16_t* urow, int lane) {
    float ss = 0.f;
#pragma unroll
    for (int j = 0; j < 4; ++j) ss += (v[j].x * v[j].x + v[j].y * v[j].y) + (v[j].z * v[j].z + v[j].w * v[j].w);
    const float rstd = 1.0f / sqrtf(wave_sum(ss) * (1.0f / D) + EPS);
#pragma unroll
    for (int j = 0; j < 4; ++j) { const int idx = 4 * lane + 256 * j; const f32x4 gv = *(const f32x4*)(g + idx), shv = *(const f32x4*)(sh + idx), scv = *(const f32x4*)(sc + idx);
        const f32x4 o = v[j] * rstd * gv * (scv + 1.0f) + shv; u32x2 w; w.x = pk2(o[0], o[1]); w.y = pk2(o[2], o[3]); *(u32x2*)(urow + idx) = w; }
}

__device__ __forceinline__ void phase_u0(const Args& a, Ctx& C) {
    const int gw = C.vcu * NWAVES + C.wave, NGW = C.G * NWAVES; const float* mod = (const float*)(C.ws + WS_MOD);
    for (int tk0 = gw; tk0 < NTOK; tk0 += 2 * NGW) {
        const bool two = (tk0 + NGW) < NTOK; const int tk1 = two ? tk0 + NGW : tk0;
        const f32x4* x0 = (const f32x4*)(a.x + (size_t)tk0 * D) + C.lane; const f32x4* x1 = (const f32x4*)(a.x + (size_t)tk1 * D) + C.lane; f32x4 v0[4], v1[4];
#pragma unroll
        for (int j = 0; j < 4; ++j) { v0[j] = x0[64 * j]; v1[j] = x1[64 * j]; }
        { const float* mb = mod + (size_t)(tk0 >> 12) * 6144; norm_mod_store(v0, a.norm1_g, mb + 0, mb + 1024, (bf16_t*)(C.ws + WS_U) + (size_t)tk0 * D, C.lane); }
        if (two) { const float* mb = mod + (size_t)(tk1 >> 12) * 6144; norm_mod_store(v1, a.norm1_g, mb + 0, mb + 1024, (bf16_t*)(C.ws + WS_U) + (size_t)tk1 * D, C.lane); }
    }
}

__device__ __forceinline__ unsigned sortable(float f) { const unsigned u = __builtin_bit_cast(unsigned, f); return (u & 0x80000000u) ? ~u : (u | 0x80000000u); }
__device__ __forceinline__ int mbcnt64(unsigned long long m) { return __builtin_amdgcn_mbcnt_hi((unsigned)(m >> 32), __builtin_amdgcn_mbcnt_lo((unsigned)m, 0)); }

constexpr int HP = 65;
__device__ __forceinline__ int wave_isum(int v) {
    v += __builtin_amdgcn_update_dpp(0, v, 0xB1, 0xF, 0xF, true);
    v += __builtin_amdgcn_update_dpp(0, v, 0x4E, 0xF, 0xF, true);
    v += __builtin_amdgcn_update_dpp(0, v, 0x141, 0xF, 0xF, true);
    v += __builtin_amdgcn_update_dpp(0, v, 0x140, 0xF, 0xF, true);
    return __builtin_amdgcn_readlane(v, 0) + __builtin_amdgcn_readlane(v, 16) + __builtin_amdgcn_readlane(v, 32) + __builtin_amdgcn_readlane(v, 48);
}
typedef float f32x16 __attribute__((ext_vector_type(16)));
__device__ __forceinline__ void transpose32(unsigned (&a)[32]) {
#pragma unroll
    for (int st = 0; st < 5; ++st) {
        const int j = 16 >> st; const unsigned m = (st == 0) ? 0x0000FFFFu : (st == 1) ? 0x00FF00FFu : (st == 2) ? 0x0F0F0F0Fu : (st == 3) ? 0x33333333u : 0x55555555u;
#pragma unroll
        for (int idx = 0; idx < 16; ++idx) { const int k = (idx / j) * 2 * j + (idx % j); const unsigned t = (a[k] ^ (a[k + j] >> j)) & m; a[k] ^= t; a[k + j] ^= (t << j); }
    }
}
__device__ __forceinline__ int wave_iscan(int v) {
    v += __builtin_amdgcn_update_dpp(0, v, 0x111, 0xF, 0xF, true);
    v += __builtin_amdgcn_update_dpp(0, v, 0x112, 0xF, 0xF, true);
    v += __builtin_amdgcn_update_dpp(0, v, 0x114, 0xF, 0xF, true);
    v += __builtin_amdgcn_update_dpp(0, v, 0x118, 0xF, 0xF, true);
    v += __builtin_amdgcn_update_dpp(0, v, 0x142, 0xA, 0xF, false);
    v += __builtin_amdgcn_update_dpp(0, v, 0x143, 0xC, 0xF, false);
    return v;
}
__device__ __forceinline__ unsigned sortable16(unsigned h) { return (h & 0x8000u) ? (~h & 0xFFFFu) : (h | 0x8000u); }
__device__ __forceinline__ unsigned short f2h_bits(float f) { const _Float16 h = (_Float16)f; unsigned short b = __builtin_bit_cast(unsigned short, h); return b == 0x8000u ? (unsigned short)0 : b; }
template <int NB>
__device__ __forceinline__ void select_bits16(const LAS unsigned short* sq, int nj, int* sel, int lane) {
    unsigned a[32];
#pragma unroll
    for (int j = 0; j < 32; ++j) { const unsigned lo = sortable16(sq[64 * j + lane]); const unsigned hi = (NB == 2) ? sortable16(sq[64 * (32 + j) + lane]) : 0u; a[j] = lo | (hi << 16); }
    transpose32(a);
    unsigned Ml = 0xFFFFFFFFu, Mh = (NB == 2) ? 0xFFFFFFFFu : 0u, Gl = 0u, Gh = 0u; unsigned T = 0u; int G = 0;
#pragma unroll
    for (int bit = 15; bit >= 0; --bit) {
        const unsigned nl = Ml & a[31 - bit], nh = Mh & a[15 - bit];
        const int tot = wave_isum(__popc(nl) + __popc(nh));
        const bool take = (G + tot) >= 256; const unsigned flip = take ? 0u : 0xFFFFFFFFu;
        T |= take ? (1u << bit) : 0u; G += take ? 0 : tot;
        Gl |= nl & flip; Gh |= nh & flip; Ml &= (a[31 - bit] ^ flip); Mh &= (a[15 - bit] ^ flip);
    }
    const int need = 256 - G;
    if (T != 0x8000u) {
        const int ceq = __popc(Ml) + __popc(Mh); const int incl = wave_iscan(ceq);
        int quota = need - (incl - ceq); quota = quota < 0 ? 0 : (quota > ceq ? ceq : quota);
        const int cnt = __popc(Gl) + __popc(Gh) + quota; const int inc2 = wave_iscan(cnt);
        int pos = inc2 - cnt;
        { unsigned mk = Gl; while (mk) { const int x = 31 - __clz((int)mk); mk &= ~(1u << x); sel[pos++] = 64 * (31 - x) + lane; } }
        if (NB == 2) { unsigned mk = Gh; while (mk) { const int x = 31 - __clz((int)mk); mk &= ~(1u << x); sel[pos++] = 64 * (63 - x) + lane; } }
        { unsigned mk = Ml; while (mk && quota > 0) { const int x = 31 - __clz((int)mk); mk &= ~(1u << x); sel[pos++] = 64 * (31 - x) + lane; --quota; } }
        if (NB == 2) { unsigned mk = Mh; while (mk && quota > 0) { const int x = 31 - __clz((int)mk); mk &= ~(1u << x); sel[pos++] = 64 * (63 - x) + lane; --quota; } }
    } else {
        int base = 0, eqseen = 0;
#pragma unroll 1
        for (int j = 0; j < nj; ++j) {
            const unsigned kj = sortable16(sq[64 * j + lane]);
            const bool gt = kj > T, eq = kj == T; const unsigned long long em = __ballot(eq);
            const bool take = gt || (eq && (eqseen + mbcnt64(em)) < need); const unsigned long long tm = __ballot(take);
            if (take) sel[base + mbcnt64(tm)] = 64 * j + lane;
            base += __popcll(tm); eqseen += __popcll(em);
        }
    }
}
constexpr int CONV_SPLIT = 16384;
constexpr int KST_ROW = 144, KST_BYTES = 64 * KST_ROW;
__device__ __forceinline__ void index_unit2(Ctx& C, int b, int cch, int sub, Conv& cv) {
    unsigned char* ws = C.ws; const int lane = C.lane, w = C.wave;
    const int tk0 = b * SEQ + 64 * cch + 8 * sub, L = 64 * (cch + 1), nj = cch + 1;
    if (L <= 256) { int* sel = (int*)(ws + WS_SEL) + (size_t)(tk0 + w) * 256; for (int i = lane; i < L; i += 64) sel[i] = i; return; }
    LAS unsigned short* sclh = (LAS unsigned short*)C.lds;
    LAS unsigned char* kst = C.lds + 65536 + w * KST_BYTES;
    {
        const int r = lane & 31, hf = lane >> 5, qq = r >> 2, h = r & 3;
        bf16x8 aq[4];
#pragma unroll
        for (int ks = 0; ks < 4; ++ks) aq[ks] = *(const bf16x8*)((const bf16_t*)(ws + WS_QI) + (size_t)(tk0 + qq) * 256 + h * 64 + 16 * ks + 8 * hf);
        f32x4 wq[4];
#pragma unroll
        for (int g = 0; g < 4; ++g) wq[g] = *(const f32x4*)((const float*)(ws + WS_WI) + (size_t)(tk0 + 2 * g + hf) * 4);
        const unsigned char* kib = ws + WS_KI + (size_t)b * SEQ * 128;
        const int ntile = 2 * nj;
        u32x4 st[8];
#define IDX2_LOAD(kta) do { const int _t1 = (kta), _t2 = ((kta) + NWAVES) < ntile ? (kta) + NWAVES : (kta); _Pragma("unroll") for (int j = 0; j < 4; ++j) { \
            st[j] = *(const u32x4*)(kib + (size_t)_t1 * 4096 + 1024 * j + 16 * lane); st[4 + j] = *(const u32x4*)(kib + (size_t)_t2 * 4096 + 1024 * j + 16 * lane); } } while (0)
        if (w < ntile) IDX2_LOAD(w);
#pragma unroll 1
        for (int kt = w; kt < ntile; kt += 2 * NWAVES) {
            const bool two = (kt + NWAVES) < ntile; const int kt2 = two ? kt + NWAVES : kt;
#pragma unroll
            for (int j = 0; j < 4; ++j) { *(LAS u32x4*)(kst + (8 * j + (lane >> 3)) * KST_ROW + 16 * (lane & 7)) = st[j]; *(LAS u32x4*)(kst + (32 + 8 * j + (lane >> 3)) * KST_ROW + 16 * (lane & 7)) = st[4 + j]; }
            if ((kt + 2 * NWAVES) < ntile) IDX2_LOAD(kt + 2 * NWAVES);
            f32x16 acc, acc2;
#pragma unroll
            for (int i = 0; i < 16; ++i) { acc[i] = 0.f; acc2[i] = 0.f; }
#pragma unroll
            for (int ks = 0; ks < 4; ++ks) { const bf16x8 b1 = *(const LAS bf16x8*)(kst + r * KST_ROW + 32 * ks + 16 * hf), b2 = *(const LAS bf16x8*)(kst + (32 + r) * KST_ROW + 32 * ks + 16 * hf);
                acc = __builtin_amdgcn_mfma_f32_32x32x16_bf16(aq[ks], b1, acc, 0, 0, 0); acc2 = __builtin_amdgcn_mfma_f32_32x32x16_bf16(aq[ks], b2, acc2, 0, 0, 0); }
#pragma unroll
            for (int g = 0; g < 4; ++g) {
                const float sc = fmaxf(acc[4 * g + 0], 0.f) * wq[g][0] + fmaxf(acc[4 * g + 1], 0.f) * wq[g][1] + fmaxf(acc[4 * g + 2], 0.f) * wq[g][2] + fmaxf(acc[4 * g + 3], 0.f) * wq[g][3];
                sclh[(2 * g + hf) * 4096 + 32 * kt + r] = f2h_bits(sc);
                const float sc2 = fmaxf(acc2[4 * g + 0], 0.f) * wq[g][0] + fmaxf(acc2[4 * g + 1], 0.f) * wq[g][1] + fmaxf(acc2[4 * g + 2], 0.f) * wq[g][2] + fmaxf(acc2[4 * g + 3], 0.f) * wq[g][3];
                if (two) sclh[(2 * g + hf) * 4096 + 32 * kt2 + r] = f2h_bits(sc2);
            }
        }
#undef IDX2_LOAD
        const int njp = nj <= 32 ? 32 : 64;
        for (int j = nj; j < njp; ++j) sclh[w * 4096 + 64 * j + lane] = (unsigned short)0xFBFFu;
    }
    __syncthreads();
    {
        const LAS unsigned short* sq = sclh + w * 4096; int* sel = (int*)(ws + WS_SEL) + (size_t)(tk0 + w) * 256;
        cv.issue();
        if (nj <= 32) select_bits16<1>(sq, nj, sel, lane); else select_bits16<2>(sq, nj, sel, lane);
        cv.finish((LAS float*)kst);
    }
    __syncthreads();
}

typedef short s16x4 __attribute__((ext_vector_type(4)));
constexpr int VROW = 272;
__device__ __forceinline__ void attend_query_mfma(Ctx& C, int tk, LAS unsigned char* vs, Conv& cv) {
    unsigned char* ws = C.ws; const int lane = C.lane, c = lane & 15, g = lane >> 4;
    const int tpos = tk & (SEQ - 1), b = tk >> 12, L = 64 * ((tpos >> 6) + 1), nsel = L < 256 ? L : 256;
    const bf16_t* kb = (const bf16_t*)(ws + WS_K) + (size_t)b * SEQ * 128; const bf16_t* vb = (const bf16_t*)(ws + WS_V) + (size_t)b * SEQ * 128;
    int selr[4];
    { const int* sg = (const int*)(ws + WS_SEL) + (size_t)tk * 256;
#pragma unroll
      for (int i = 0; i < 4; ++i) selr[i] = (64 * i + lane) < nsel ? sg[64 * i + lane] : 0; }
    bf16x8 bq0[2], bq1[2];
    { const bf16_t* qp = (const bf16_t*)(ws + WS_Q) + (size_t)tk * 512 + (c & 7) * 64 + 8 * g; const bf16x8 z = (bf16x8){0, 0, 0, 0, 0, 0, 0, 0};
#pragma unroll
      for (int ks = 0; ks < 2; ++ks) { const bf16x8 q = *(const bf16x8*)(qp + 32 * ks); bq0[ks] = (c < 4) ? q : z; bq1[ks] = (c >= 4 && c < 8) ? q : z; } }
    cv.issue();
    f32x4 acc[16];
#pragma unroll
    for (int kt = 0; kt < 16; ++kt) {
        if ((kt & 3) == 0) asm volatile("" ::: "memory");
        const int key = __shfl(selr[kt >> 2], 16 * (kt & 3) + c);
        const bf16_t* kr = kb + (size_t)key * 128 + 8 * g;
        const bf16x8 a00 = *(const bf16x8*)(kr), a01 = *(const bf16x8*)(kr + 32), a10 = *(const bf16x8*)(kr + 64), a11 = *(const bf16x8*)(kr + 96);
        f32x4 t = (f32x4){0.f, 0.f, 0.f, 0.f};
        t = __builtin_amdgcn_mfma_f32_16x16x32_bf16(a00, bq0[0], t, 0, 0, 0); t = __builtin_amdgcn_mfma_f32_16x16x32_bf16(a01, bq0[1], t, 0, 0, 0);
        t = __builtin_amdgcn_mfma_f32_16x16x32_bf16(a10, bq1[0], t, 0, 0, 0); t = __builtin_amdgcn_mfma_f32_16x16x32_bf16(a11, bq1[1], t, 0, 0, 0);
        acc[kt] = t;
    }
    asm volatile("" ::: "memory"); cv.finish((LAS float*)vs); cv.issue();
    { const int lim = nsel - 4 * g;
#pragma unroll
      for (int kt = 0; kt < 16; ++kt)
#pragma unroll
        for (int r = 0; r < 4; ++r) acc[kt][r] = (16 * kt + r < lim) ? acc[kt][r] : -1e30f; }
    float m = -1e30f;
#pragma unroll
    for (int kt = 0; kt < 16; ++kt) m = fmaxf(m, fmaxf(fmaxf(acc[kt][0], acc[kt][1]), fmaxf(acc[kt][2], acc[kt][3])));
    m = fmaxf(m, __shfl_xor(m, 16)); m = fmaxf(m, __shfl_xor(m, 32));
    float sum = 0.f;
#pragma unroll
    for (int kt = 0; kt < 16; ++kt)
#pragma unroll
        for (int r = 0; r < 4; ++r) { const float pv = __expf(acc[kt][r] - m); acc[kt][r] = pv; sum += pv; }
    sum += __shfl_xor(sum, 16); sum += __shfl_xor(sum, 32);
    const float inv = 1.0f / sum;
    bf16x8 bp[8];
#pragma unroll
    for (int T = 0; T < 8; ++T) { u32x4 w; w.x = cvt_pk_bf16(acc[2 * T][0], acc[2 * T][1]); w.y = cvt_pk_bf16(acc[2 * T][2], acc[2 * T][3]); w.z = cvt_pk_bf16(acc[2 * T + 1][0], acc[2 * T + 1][1]); w.w = cvt_pk_bf16(acc[2 * T + 1][2], acc[2 * T + 1][3]);
        bp[T] = __builtin_bit_cast(bf16x8, w); }
    f32x4 ao0[4], ao1[4];
#pragma unroll
    for (int dt = 0; dt < 4; ++dt) { ao0[dt] = (f32x4){0.f, 0.f, 0.f, 0.f}; ao1[dt] = (f32x4){0.f, 0.f, 0.f, 0.f}; }
    const int q4 = c >> 2, p4 = c & 3;
    u32x4 vst[8];
#define ATT_VLOAD(T) do { _Pragma("unroll") for (int i = 0; i < 8; ++i) { const int row = g + 4 * i; \
        const int key = __shfl(selr[(T) >> 1], 32 * ((T) & 1) + row); vst[i] = *(const u32x4*)(vb + (size_t)key * 128 + 8 * c); } } while (0)
    ATT_VLOAD(0);
#pragma unroll
    for (int T = 0; T < 8; ++T) {
        LAS unsigned char* buf = vs + (T & 1) * (32 * VROW);
        asm volatile("" ::: "memory");
#pragma unroll
        for (int i = 0; i < 8; ++i) *(LAS u32x4*)(buf + (g + 4 * i) * VROW + 16 * c) = vst[i];
        if (T < 7) ATT_VLOAD(T + 1);
#pragma unroll
        for (int n = 0; n < 2; ++n)
#pragma unroll
            for (int dt = 0; dt < 4; ++dt) {
                LAS s16x4* p0 = (LAS s16x4*)(buf + (4 * g + q4) * VROW + (n * 64 + 16 * dt + 4 * p4) * 2);
                const s16x4 lo = __builtin_amdgcn_ds_read_tr16_b64_v4i16(p0), hi = __builtin_amdgcn_ds_read_tr16_b64_v4i16((LAS s16x4*)((LAS unsigned char*)p0 + 16 * VROW));
                const bf16x8 av = (bf16x8){lo[0], lo[1], lo[2], lo[3], hi[0], hi[1], hi[2], hi[3]};
                if (n == 0) ao0[dt] = __builtin_amdgcn_mfma_f32_16x16x32_bf16(av, bp[T], ao0[dt], 0, 0, 0);
                else ao1[dt] = __builtin_amdgcn_mfma_f32_16x16x32_bf16(av, bp[T], ao1[dt], 0, 0, 0);
            }
    }
#undef ATT_VLOAD
    asm volatile("" ::: "memory"); cv.finish((LAS float*)vs);
    if (c < 8) {
        bf16_t* mo = (bf16_t*)(ws + WS_MIX) + (size_t)tk * D + c * 64 + 4 * g;
#pragma unroll
        for (int dt = 0; dt < 4; ++dt) { f32x4 o; o[0] = (c < 4 ? ao0[dt][0] : ao1[dt][0]) * inv; o[1] = (c < 4 ? ao0[dt][1] : ao1[dt][1]) * inv; o[2] = (c < 4 ? ao0[dt][2] : ao1[dt][2]) * inv; o[3] = (c < 4 ? ao0[dt][3] : ao1[dt][3]) * inv; u32x2 w; w.x = cvt_pk_bf16(o[0], o[1]); w.y = cvt_pk_bf16(o[2], o[3]); *(u32x2*)(mo + 16 * dt) = w; }
    }
}

__device__ __forceinline__ void pool_wave(const Args& a, Ctx& C, int l) {
    unsigned char* ws = C.ws; const int lane = C.lane;
    const int gwv = blockIdx.x * NWAVES + C.wave, g = gwv & 3, widx = gwv >> 2, nw = (C.G * NWAVES) >> 2, w = 2 << g;
    float pwr[64];
#pragma unroll
    for (int c = 0; c < 64; ++c) pwr[c] = a.pool_w[(size_t)(l * 4 + g) * 4096 + c * 64 + lane];
    const float psc = a.pool_scale[l * 256 + g * 64 + lane];
    const float* ubg = (const float*)(ws + WS_UB) + g * 64 + lane;
    for (int tile = widx; tile < NTOK / 8; tile += nw) {
        const int tok0 = tile * 8, tp0 = tok0 & (SEQ - 1);
        float row[23];
#pragma unroll
        for (int r = 0; r < 23; ++r) { const int tp = tp0 - 15 + r; row[r] = (tp >= 0) ? ubg[(size_t)(tok0 - 15 + r) * 256] : 0.f; }
        float pooled[8];
#pragma unroll
        for (int t = 0; t < 8; ++t) {
            float sm = 0.f;
#pragma unroll
            for (int i = 0; i < 16; ++i) if (i < w) sm += row[15 + t - i];
            const int tpos = tp0 + t; const int wl = (tpos + 1) < w ? (tpos + 1) : w;
            pooled[t] = sm * (1.0f / (float)wl) - row[15 + t];
        }
        float y[8] = {0.f, 0.f, 0.f, 0.f, 0.f, 0.f, 0.f, 0.f};
#pragma unroll
        for (int c = 0; c < 64; ++c) {
#pragma unroll
            for (int t = 0; t < 8; ++t) y[t] += __builtin_bit_cast(float, __builtin_amdgcn_readlane(__builtin_bit_cast(int, pooled[t]), c)) * pwr[c];
        }
        bf16_t* mo = (bf16_t*)(ws + WS_MIX) + (size_t)tok0 * D + 512 + g * 64 + lane;
#pragma unroll
        for (int t = 0; t < 8; ++t) mo[(size_t)t * D] = (bf16_t)f2bf(y[t] * psc);
    }
}

__device__ __forceinline__ float row_shr_add(float x, int) { return x; }
template <int N> __device__ __forceinline__ float dpp_row_shr(float x) { return __builtin_bit_cast(float, __builtin_amdgcn_update_dpp(0, __builtin_bit_cast(int, x), 0x110 + N, 0xF, 0xF, true)); }
__device__ __forceinline__ float row_scan16(float x) { x += dpp_row_shr<1>(x); x += dpp_row_shr<2>(x); x += dpp_row_shr<4>(x); x += dpp_row_shr<8>(x); return x; }
__device__ __forceinline__ float row_last16(float x) { return __builtin_bit_cast(float, __builtin_amdgcn_update_dpp(0, __builtin_bit_cast(int, x), 0x15F, 0xF, 0xF, true)); }
__device__ __forceinline__ float row_sum16(float v) {
    v += __builtin_bit_cast(float, __builtin_amdgcn_update_dpp(0, __builtin_bit_cast(int, v), 0xB1, 0xF, 0xF, true));
    v += __builtin_bit_cast(float, __builtin_amdgcn_update_dpp(0, __builtin_bit_cast(int, v), 0x4E, 0xF, 0xF, true));
    v += __builtin_bit_cast(float, __builtin_amdgcn_update_dpp(0, __builtin_bit_cast(int, v), 0x141, 0xF, 0xF, true));
    v += __builtin_bit_cast(float, __builtin_amdgcn_update_dpp(0, __builtin_bit_cast(int, v), 0x140, 0xF, 0xF, true));
    return v;
}
__device__ __forceinline__ void hgrn_out3(const Args& a, Ctx& C, int l, int item, LAS unsigned char* kls) {
    const int lane = C.lane, tt = lane & 15, g = lane >> 4, c = item & 63, hh = (item >> 6) & 3, b = item >> 8, bh = b * 4 + hh, cg = c >> 2, ci = c & 3;
    const float* HG = (const float*)(C.ws + WS_HG); const float* HR = (const float*)(C.ws + WS_HL); const float* HE = (const float*)(C.ws + WS_HD);
    float lb[16];
#pragma unroll
    for (int e = 0; e < 16; ++e) { const int kk = hh * 64 + 16 * (e >> 2) + 4 * g + (e & 3); lb[e] = (l == 1) ? 1.0f / (1.0f + expf(a.lb_logits[kk] - a.lb_logits[256 + kk])) : 0.f; }
    f32x4 S[4][4];
#pragma unroll
    for (int vq = 0; vq < 4; ++vq)
#pragma unroll
        for (int kt = 0; kt < 4; ++kt) S[vq][kt] = (f32x4){0.f, 0.f, 0.f, 0.f};
    const int nstep = cg + (ci > 0 ? 1 : 0);
#pragma unroll 1
    for (int st = 0; st < nstep; ++st) {
        const int chn = (st < cg) ? (4 * st + 3) : (4 * cg + ci - 1); const size_t ch = (size_t)(bh * 64 + chn);
        const float* hr = HR + ch * 4096 + (g * 16 + tt) * 4; const float* he = HE + ch * 64 + 4 * g;
        f32x4 ev[4];
#pragma unroll
        for (int kt = 0; kt < 4; ++kt) ev[kt] = *(const f32x4*)(he + 16 * kt);
#pragma unroll
        for (int vq = 0; vq < 4; ++vq)
#pragma unroll
            for (int kt = 0; kt < 4; ++kt) S[vq][kt] = S[vq][kt] * ev[kt] + *(const f32x4*)(hr + (vq * 4 + kt) * 256);
    }
    const size_t tok0 = (size_t)b * SEQ + c * 64;
#pragma unroll 1
    for (int sb = 0; sb < 4; ++sb) {
        const size_t tok = tok0 + 16 * sb + tt; const float* row = HG + tok * 1024 + hh * 64 + 4 * g;
        float qh[16], kt_[16], kp[16], dd[16];
#pragma unroll
        for (int e4 = 0; e4 < 4; ++e4) {
            const f32x4 q4 = *(const f32x4*)(row + 16 * e4), z4 = *(const f32x4*)(row + 256 + 16 * e4);
#pragma unroll
            for (int j = 0; j < 4; ++j) { const int e = 4 * e4 + j; const float lbe = lb[e];
                const float sg = __builtin_amdgcn_rcpf(1.0f + __expf(-z4[j])), sn = __builtin_amdgcn_rcpf(1.0f + __expf(z4[j]));
                const float lf = __logf(lbe + (1.0f - lbe) * sg), kin = (1.0f - lbe) * sn;
                const float cc = row_scan16(lf), c15 = row_last16(cc);
                qh[e] = siluf_(q4[j]) * __expf(cc); kt_[e] = kin * __expf(fminf(-cc, 80.0f)); kp[e] = kin * __expf(c15 - cc); dd[e] = __expf(c15); }
        }
        bf16x8 Qf[2], Kf[2];
#pragma unroll
        for (int ks = 0; ks < 2; ++ks) { u32x4 wq, wk;
            wq.x = pk2(qh[8 * ks + 0], qh[8 * ks + 1]); wq.y = pk2(qh[8 * ks + 2], qh[8 * ks + 3]); wq.z = pk2(qh[8 * ks + 4], qh[8 * ks + 5]); wq.w = pk2(qh[8 * ks + 6], qh[8 * ks + 7]);
            wk.x = pk2(kt_[8 * ks + 0], kt_[8 * ks + 1]); wk.y = pk2(kt_[8 * ks + 2], kt_[8 * ks + 3]); wk.z = pk2(kt_[8 * ks + 4], kt_[8 * ks + 5]); wk.w = pk2(kt_[8 * ks + 6], kt_[8 * ks + 7]);
            Qf[ks] = __builtin_bit_cast(bf16x8, wq); Kf[ks] = __builtin_bit_cast(bf16x8, wk); }
#pragma unroll
        for (int e4 = 0; e4 < 4; ++e4) { u32x2 w; w.x = pk2(kp[4 * e4 + 0], kp[4 * e4 + 1]); w.y = pk2(kp[4 * e4 + 2], kp[4 * e4 + 3]); *(LAS u32x2*)(kls + tt * 144 + (16 * e4 + 4 * g) * 2) = w; }
        f32x4 at = (f32x4){0.f, 0.f, 0.f, 0.f};
        at = __builtin_amdgcn_mfma_f32_16x16x32_bf16(Kf[0], Qf[0], at, 0, 0, 0); at = __builtin_amdgcn_mfma_f32_16x16x32_bf16(Kf[1], Qf[1], at, 0, 0, 0);
#pragma unroll
        for (int r = 0; r < 4; ++r) at[r] = (4 * g + r <= tt) ? at[r] : 0.f;
        u32x4 wa; wa.x = pk2(at[0], at[1]); wa.y = pk2(at[2], at[3]); wa.z = 0u; wa.w = 0u; const bf16x8 Af = __builtin_bit_cast(bf16x8, wa);
        bf16x8 Vf[4];
        { const float* vp = HG + (tok0 + 16 * sb + 4 * g) * 1024 + 512 + hh * 64 + tt;
#pragma unroll
          for (int vq = 0; vq < 4; ++vq) { u32x4 w; w.x = pk2(vp[16 * vq], vp[1024 + 16 * vq]); w.y = pk2(vp[2048 + 16 * vq], vp[3072 + 16 * vq]); w.z = 0u; w.w = 0u; Vf[vq] = __builtin_bit_cast(bf16x8, w); } }
        f32x4 O[4];
#pragma unroll
        for (int vq = 0; vq < 4; ++vq) {
            u32x4 s0, s1; s0.x = pk2(S[vq][0][0], S[vq][0][1]); s0.y = pk2(S[vq][0][2], S[vq][0][3]); s0.z = pk2(S[vq][1][0], S[vq][1][1]); s0.w = pk2(S[vq][1][2], S[vq][1][3]);
            s1.x = pk2(S[vq][2][0], S[vq][2][1]); s1.y = pk2(S[vq][2][2], S[vq][2][3]); s1.z = pk2(S[vq][3][0], S[vq][3][1]); s1.w = pk2(S[vq][3][2], S[vq][3][3]);
            f32x4 o = (f32x4){0.f, 0.f, 0.f, 0.f};
            o = __builtin_amdgcn_mfma_f32_16x16x32_bf16(Qf[0], __builtin_bit_cast(bf16x8, s0), o, 0, 0, 0); o = __builtin_amdgcn_mfma_f32_16x16x32_bf16(Qf[1], __builtin_bit_cast(bf16x8, s1), o, 0, 0, 0);
            o = __builtin_amdgcn_mfma_f32_16x16x32_bf16(Af, Vf[vq], o, 0, 0, 0); O[vq] = o; }
        { float rs[4];
#pragma unroll
          for (int r = 0; r < 4; ++r) { float ss = O[0][r] * O[0][r] + O[1][r] * O[1][r] + O[2][r] * O[2][r] + O[3][r] * O[3][r]; ss = row_sum16(ss); rs[r] = 1.0f / sqrtf(ss * (1.0f / 64.0f) + EPS); }
          const float* gp = HG + (tok0 + 16 * sb + 4 * g) * 1024 + 768 + hh * 64 + tt; bf16_t* mo = (bf16_t*)(C.ws + WS_MIX) + (tok0 + 16 * sb + 4 * g) * D + 768 + hh * 64 + tt;
#pragma unroll
          for (int vq = 0; vq < 4; ++vq) { const float ngv = a.hgrn_g[l * 64 + 16 * vq + tt];
#pragma unroll
            for (int r = 0; r < 4; ++r) mo[(size_t)r * D + 16 * vq] = (bf16_t)f2bf(O[vq][r] * rs[r] * ngv * siluf_(gp[(size_t)r * 1024 + 16 * vq])); } }
        asm volatile("s_waitcnt lgkmcnt(0)" ::: "memory");
#pragma unroll
        for (int kt = 0; kt < 4; ++kt) {
            const s16x4 t4 = __builtin_amdgcn_ds_read_tr16_b64_v4i16((LAS s16x4*)(kls + (4 * g + (tt >> 2)) * 144 + (16 * kt + 4 * (tt & 3)) * 2));
            const bf16x8 Ktf = (bf16x8){t4[0], t4[1], t4[2], t4[3], 0, 0, 0, 0};
            const f32x4 dv = (f32x4){dd[4 * kt + 0], dd[4 * kt + 1], dd[4 * kt + 2], dd[4 * kt + 3]};
#pragma unroll
            for (int vq = 0; vq < 4; ++vq) S[vq][kt] = __builtin_amdgcn_mfma_f32_16x16x32_bf16(Ktf, Vf[vq], S[vq][kt] * dv, 0, 0, 0);
        }
        asm volatile("s_waitcnt lgkmcnt(0)" ::: "memory");
    }
}

__device__ __forceinline__ void hgrn_local4(const Args& a, Ctx& C, int l, int item, LAS unsigned char* kls) {
    const int lane = C.lane, tt = lane & 15, g = lane >> 4, vq = item & 3, cg = (item >> 2) & 15, hh = (item >> 6) & 3, b = item >> 8, bh = b * 4 + hh;
    const float* HG = (const float*)(C.ws + WS_HG);
    float lb[16], ecum[16];
#pragma unroll
    for (int e = 0; e < 16; ++e) { const int kk = hh * 64 + 16 * (e >> 2) + 4 * g + (e & 3); lb[e] = (l == 1) ? 1.0f / (1.0f + expf(a.lb_logits[kk] - a.lb_logits[256 + kk])) : 0.f; ecum[e] = 1.0f; }
    f32x4 S[4];
#pragma unroll
    for (int kt = 0; kt < 4; ++kt) S[kt] = (f32x4){0.f, 0.f, 0.f, 0.f};
    const size_t tokg = (size_t)b * SEQ + (size_t)cg * 256;
    f32x4 zc[4]; float vc[4];
#define HL4_LOAD(zd, vd, sbi) do { const size_t _t0 = tokg + 16 * (sbi); const float* _r = HG + (_t0 + tt) * 1024 + hh * 64 + 4 * g + 256; \
        _Pragma("unroll") for (int e4 = 0; e4 < 4; ++e4) zd[e4] = *(const f32x4*)(_r + 16 * e4); \
        const float* _v = HG + (_t0 + 4 * g) * 1024 + 512 + hh * 64 + 16 * vq + tt; vd[0] = _v[0]; vd[1] = _v[1024]; vd[2] = _v[2048]; vd[3] = _v[3072]; } while (0)
    HL4_LOAD(zc, vc, 0);
#pragma unroll 1
    for (int ci = 0; ci < 4; ++ci) {
        const int c = 4 * cg + ci;
#pragma unroll 1
        for (int sb = 0; sb < 4; ++sb) {
            const int sbi = 4 * ci + sb; f32x4 zn[4]; float vn[4];
            if (sbi < 15) HL4_LOAD(zn, vn, sbi + 1); else {
#pragma unroll
                for (int e4 = 0; e4 < 4; ++e4) { zn[e4] = zc[e4]; vn[e4] = vc[e4]; } }
            float kp[16], dd[16];
#pragma unroll
            for (int e4 = 0; e4 < 4; ++e4) { const f32x4 z4 = zc[e4];
#pragma unroll
                for (int j = 0; j < 4; ++j) { const int e = 4 * e4 + j; const float lbe = lb[e];
                    const float sg = __builtin_amdgcn_rcpf(1.0f + __expf(-z4[j])), sn = __builtin_amdgcn_rcpf(1.0f + __expf(z4[j]));
                    const float lf = __logf(lbe + (1.0f - lbe) * sg), kin = (1.0f - lbe) * sn;
                    const float cc = row_scan16(lf), c15 = row_last16(cc);
                    kp[e] = kin * __expf(c15 - cc); dd[e] = __expf(c15); ecum[e] *= dd[e]; } }
#pragma unroll
            for (int e4 = 0; e4 < 4; ++e4) { u32x2 w; w.x = pk2(kp[4 * e4 + 0], kp[4 * e4 + 1]); w.y = pk2(kp[4 * e4 + 2], kp[4 * e4 + 3]); *(LAS u32x2*)(kls + tt * 144 + (16 * e4 + 4 * g) * 2) = w; }
            bf16x8 Vf; { u32x4 w; w.x = pk2(vc[0], vc[1]); w.y = pk2(vc[2], vc[3]); w.z = 0u; w.w = 0u; Vf = __builtin_bit_cast(bf16x8, w); }
            asm volatile("s_waitcnt lgkmcnt(0)" ::: "memory");
#pragma unroll
            for (int kt = 0; kt < 4; ++kt) {
                const s16x4 t4 = __builtin_amdgcn_ds_read_tr16_b64_v4i16((LAS s16x4*)(kls + (4 * g + (tt >> 2)) * 144 + (16 * kt + 4 * (tt & 3)) * 2));
                const bf16x8 Ktf = (bf16x8){t4[0], t4[1], t4[2], t4[3], 0, 0, 0, 0};
                const f32x4 dv = (f32x4){dd[4 * kt + 0], dd[4 * kt + 1], dd[4 * kt + 2], dd[4 * kt + 3]};
                S[kt] = __builtin_amdgcn_mfma_f32_16x16x32_bf16(Ktf, Vf, S[kt] * dv, 0, 0, 0);
            }
            asm volatile("s_waitcnt lgkmcnt(0)" ::: "memory");
#pragma unroll
            for (int e4 = 0; e4 < 4; ++e4) { zc[e4] = zn[e4]; vc[e4] = vn[e4]; }
        }
        const size_t ch = (size_t)(bh * 64 + c);
        float* hr = (float*)(C.ws + WS_HL) + ch * 4096 + (g * 16 + tt) * 4;
#pragma unroll
        for (int kt = 0; kt < 4; ++kt) *(f32x4*)(hr + (vq * 4 + kt) * 256) = S[kt];
        if (vq == 0 && tt == 0) { float* he = (float*)(C.ws + WS_HD) + ch * 64 + 4 * g;
#pragma unroll
            for (int kt = 0; kt < 4; ++kt) *(f32x4*)(he + 16 * kt) = (f32x4){ecum[4 * kt + 0], ecum[4 * kt + 1], ecum[4 * kt + 2], ecum[4 * kt + 3]}; }
    }
#undef HL4_LOAD
}

__device__ __forceinline__ void phase_mix1(const Args& a, Ctx& C, int l) {
    if (C.wave < 4) for (int it = blockIdx.x * 4 + C.wave; it < 1024; it += C.G * 4) hgrn_local4(a, C, l, it, C.lds + C.wave * 4096);
    __syncthreads();
    pool_wave(a, C, l);
    __syncthreads();
    Conv cv; cv.w1l = a.w1 + (size_t)l * 32 * 1024 * 2048; cv.w2l = a.w2 + (size_t)l * 32 * 1024 * 1024; cv.w1t = (bf16_t*)(C.ws + WS_W1) + (size_t)l * 32 * 2048 * 1024; cv.w2t = (bf16_t*)(C.ws + WS_W2) + (size_t)l * 32 * 1024 * 1024;
    cv.it = blockIdx.x * NWAVES + C.wave; cv.step = C.G * NWAVES; cv.lane = C.lane; cv.pend = false; cv.it_end = CONV_SPLIT;
    for (int base = 0; base < 2048; base += 2 * C.G) {
        const int u1 = base + (int)blockIdx.x, u2 = base + 2 * C.G - 1 - (int)blockIdx.x;
        if (u1 < 2048) index_unit2(C, (u1 >> 3) & 3, u1 >> 5, u1 & 7, cv);
        if (u2 < 2048) index_unit2(C, (u2 >> 3) & 3, u2 >> 5, u2 & 7, cv);
    }
    for (;;) { cv.issue(); if (!cv.pend) break; cv.finish((LAS float*)(C.lds + 65536 + C.wave * KST_BYTES)); }
}
__device__ __forceinline__ void phase_mix2(const Args& a, Ctx& C, int l) {
    LAS int* qctr = (LAS int*)(C.lds + LDS_BYTES - 64 + 16);
    if (C.tid == 0) *qctr = 0;
    __syncthreads();
    if (C.wave < 4) for (int it = blockIdx.x * 4 + C.wave; it < 1024; it += C.G * 4) hgrn_out3(a, C, l, it, C.lds + C.wave * (2 * 32 * VROW));
    LAS unsigned char* vs = C.lds + C.wave * (2 * 32 * VROW);
    const int gw = blockIdx.x * NWAVES + C.wave, NGW = C.G * NWAVES;
    Conv cv; cv.w1l = a.w1 + (size_t)l * 32 * 1024 * 2048; cv.w2l = a.w2 + (size_t)l * 32 * 1024 * 1024; cv.w1t = (bf16_t*)(C.ws + WS_W1) + (size_t)l * 32 * 2048 * 1024; cv.w2t = (bf16_t*)(C.ws + WS_W2) + (size_t)l * 32 * 1024 * 1024;
    cv.it = CONV_SPLIT + gw; cv.step = NGW; cv.lane = C.lane; cv.pend = false; cv.it_end = Conv::NITEMS;
    for (;;) {
        int n = 0; if (C.lane == 0) n = __hip_atomic_fetch_add(qctr, 1, __ATOMIC_RELAXED, __HIP_MEMORY_SCOPE_WORKGROUP);
        n = __builtin_amdgcn_readfirstlane(n);
        const int tk = (int)blockIdx.x * NWAVES + (n & 7) + NGW * (n >> 3);
        if (tk >= NTOK) break;
        attend_query_mfma(C, tk, vs, cv);
    }
    for (;;) { cv.finish((LAS float*)vs); cv.issue(); if (!cv.pend) break; }
}

constexpr int URS = 2064;
__device__ __forceinline__ void phase_router2(const Args& a, Ctx& C, int l) {
    unsigned char* ws = C.ws; const int lane = C.lane, w = C.wave, tid = C.tid;
    LAS unsigned char* uh = C.lds; LAS unsigned char* ul = uh + 16 * URS; LAS float* part = (LAS float*)(ul + 16 * URS);
    LAS int* hist = (LAS int*)(part + 8 * 16 * 32);
    LAS int* asg = hist + 64;
    LAS float* asgg = (LAS float*)(asg + 2 * 1024);
    const float* mod = (const float*)(ws + WS_MOD); const float* H = (const float*)(ws + WS_H);
    const bf16_t* wrh = (const bf16_t*)(ws + WS_WRH) + (size_t)l * 32768; const bf16_t* wrl = (const bf16_t*)(ws + WS_WRL) + (size_t)l * 32768;
    unsigned* cnt = (unsigned*)(ws + WS_CTL) + CW_CNT + l * 32 * 64;
    const int ntile_all = NTOK / 16;
    bf16x8 wbh0[4], wbl0[4], wbh1[4], wbl1[4];
    { const int c = lane & 15, g = lane >> 4;
#pragma unroll
      for (int kk = 0; kk < 4; ++kk) { const int ks = 4 * w + kk;
          wbh0[kk] = *(const bf16x8*)(wrh + (size_t)c * 1024 + 32 * ks + 8 * g); wbl0[kk] = *(const bf16x8*)(wrl + (size_t)c * 1024 + 32 * ks + 8 * g);
          wbh1[kk] = *(const bf16x8*)(wrh + (size_t)(c + 16) * 1024 + 32 * ks + 8 * g); wbl1[kk] = *(const bf16x8*)(wrl + (size_t)(c + 16) * 1024 + 32 * ks + 8 * g); } }
    for (int tile0 = blockIdx.x; tile0 < ntile_all; tile0 += 16 * C.G) {
        if (tid < 64) hist[tid] = 0;
        __syncthreads();
        int nt_here = 0;
        f32x4 hv[2][4];
#pragma unroll
        for (int hf = 0; hf < 2; ++hf) { const f32x4* hr = (const f32x4*)(H + (size_t)(tile0 * 16 + 2 * w + hf) * D) + lane;
#pragma unroll
            for (int j = 0; j < 4; ++j) hv[hf][j] = hr[64 * j]; }
        for (int tile = tile0; tile < ntile_all && nt_here < 16; tile += C.G, ++nt_here) {
            const int tok0 = tile * 16;
#pragma unroll
            for (int hf = 0; hf < 2; ++hf) {
                const int tr = 2 * w + hf, tk = tok0 + tr, b = tk >> 12; f32x4 v[4];
#pragma unroll
                for (int j = 0; j < 4; ++j) v[j] = hv[hf][j];
                float ss = 0.f;
#pragma unroll
                for (int j = 0; j < 4; ++j) ss += (v[j].x * v[j].x + v[j].y * v[j].y) + (v[j].z * v[j].z + v[j].w * v[j].w);
                const float rstd = 1.0f / sqrtf(wave_sum(ss) * (1.0f / D) + EPS);
                const float* mb = mod + (size_t)(l * 4 + b) * 6144; bf16_t* urow = (bf16_t*)(ws + WS_U) + (size_t)tk * D;
#pragma unroll
                for (int j = 0; j < 4; ++j) { const int idx = 4 * lane + 256 * j; const f32x4 gv = *(const f32x4*)(a.norm2_g + l * 1024 + idx), shv = *(const f32x4*)(mb + 3072 + idx), scv = *(const f32x4*)(mb + 4096 + idx);
                    const f32x4 o = v[j] * rstd * gv * (scv + 1.0f) + shv; u32x2 hi; hi.x = pk2(o[0], o[1]); hi.y = pk2(o[2], o[3]); *(u32x2*)(urow + idx) = hi;
                    u32x2 lo; lo.x = pk2(o[0] - bflo(hi.x), o[1] - bfhi(hi.x)); lo.y = pk2(o[2] - bflo(hi.y), o[3] - bfhi(hi.y));
                    *(LAS u32x2*)(uh + tr * URS + idx * 2) = hi; *(LAS u32x2*)(ul + tr * URS + idx * 2) = lo; }
            }
            { const int ntile2 = tile + C.G; if (ntile2 < ntile_all && nt_here + 1 < 16) {
#pragma unroll
                for (int hf = 0; hf < 2; ++hf) { const f32x4* hr = (const f32x4*)(H + (size_t)(ntile2 * 16 + 2 * w + hf) * D) + lane;
#pragma unroll
                    for (int j = 0; j < 4; ++j) hv[hf][j] = hr[64 * j]; } } }
            __syncthreads();
            {
                const int c = lane & 15, g = lane >> 4; f32x4 acc0 = (f32x4){0.f, 0.f, 0.f, 0.f}, acc1 = acc0;
#pragma unroll
                for (int kk = 0; kk < 4; ++kk) { const int ks = 4 * w + kk;
                    const bf16x8 ah = *(const LAS bf16x8*)(uh + c * URS + (32 * ks + 8 * g) * 2), al = *(const LAS bf16x8*)(ul + c * URS + (32 * ks + 8 * g) * 2);
                    acc0 = __builtin_amdgcn_mfma_f32_16x16x32_bf16(al, wbh0[kk], acc0, 0, 0, 0); acc0 = __builtin_amdgcn_mfma_f32_16x16x32_bf16(ah, wbl0[kk], acc0, 0, 0, 0); acc0 = __builtin_amdgcn_mfma_f32_16x16x32_bf16(ah, wbh0[kk], acc0, 0, 0, 0);
                    acc1 = __builtin_amdgcn_mfma_f32_16x16x32_bf16(al, wbh1[kk], acc1, 0, 0, 0); acc1 = __builtin_amdgcn_mfma_f32_16x16x32_bf16(ah, wbl1[kk], acc1, 0, 0, 0); acc1 = __builtin_amdgcn_mfma_f32_16x16x32_bf16(ah, wbh1[kk], acc1, 0, 0, 0); }
#pragma unroll
                for (int r = 0; r < 4; ++r) { part[(w * 16 + 4 * g + r) * 32 + c] = acc0[r]; part[(w * 16 + 4 * g + r) * 32 + 16 + c] = acc1[r]; }
            }
            __syncthreads();
            {
                const int e = lane & 31, hf = lane >> 5, tr = 2 * w + hf; float val = a.b_router[l * 32 + e];
#pragma unroll
                for (int ww = 0; ww < 8; ++ww) val += part[(ww * 16 + tr) * 32 + e];
                float tv[4]; int te[4];
#pragma unroll
                for (int k = 0; k < 4; ++k) {
                    float bv = val; int bi = e;
#pragma unroll
                    for (int o = 1; o < 32; o <<= 1) { const float ov = __shfl_xor(bv, o); const int oi = __shfl_xor(bi, o); if (ov > bv || (ov == bv && oi < bi)) { bv = ov; bi = oi; } }
                    tv[k] = bv; te[k] = bi; if (e == bi) val = -3.0e38f;
                }
                const float e1 = __expf(tv[1] - tv[0]), e2 = __expf(tv[2] - tv[0]), e3 = __expf(tv[3] - tv[0]); const float rs = 1.0f / (1.0f + e1 + e2 + e3);
                if (e < 4) {
                    const int ex = e == 0 ? te[0] : e == 1 ? te[1] : e == 2 ? te[2] : te[3]; const float gt = (e == 0 ? 1.0f : e == 1 ? e1 : e == 2 ? e2 : e3) * rs;
                    const int ai = (nt_here * 16 + tr) * 4 + e;
                    asg[2 * ai] = ex; asg[2 * ai + 1] = __hip_atomic_fetch_add(&hist[ex], 1, __ATOMIC_RELAXED, __HIP_MEMORY_SCOPE_WORKGROUP); asgg[ai] = gt;
                }
            }
            __syncthreads();
        }
        if (tid < 32) { const int hc = hist[tid]; hist[32 + tid] = hc ? (int)atomicAdd(cnt + tid * 64, (unsigned)hc) : 0; }
        __syncthreads();
        for (int ai = tid; ai < nt_here * 64; ai += NTHREADS) {
            const int ti = ai >> 6, tr = (ai >> 2) & 15, k = ai & 3, tk = (tile0 + ti * C.G) * 16 + tr;
            const int ex = asg[2 * ai], slot = hist[32 + ex] + asg[2 * ai + 1];
            ((int*)(ws + WS_ROWTOK))[(size_t)ex * NTOK + slot] = tk;
            ((int*)(ws + WS_EIDX))[tk * 4 + k] = ex; ((int*)(ws + WS_SLOT))[tk * 4 + k] = slot; ((float*)(ws + WS_GATE))[tk * 4 + k] = asgg[ai];
        }
        __syncthreads();
    }
}

__device__ __forceinline__ void moe_table(Ctx& C, int l, LAS int* tab) {
    if (C.tid < 32) { const unsigned* cnt = (const unsigned*)(C.ws + WS_CTL) + CW_CNT + l * 32 * 64; tab[33 + C.tid] = (int)__hip_atomic_load(cnt + C.tid * 64, __ATOMIC_RELAXED, __HIP_MEMORY_SCOPE_AGENT); }
    __syncthreads();
    if (C.tid == 0) { int p = 0; for (int e = 0; e < 32; ++e) { tab[e] = p; p += (tab[33 + e] + 255) >> 8; } tab[32] = p; }
    __syncthreads();
}

__device__ __forceinline__ void phase_combine(const Args& a, Ctx& C, int l) {
    unsigned char* ws = C.ws; const int lane = C.lane;
    const float* mod = (const float*)(ws + WS_MOD); float* H = (float*)(ws + WS_H); const bf16_t* Y = (const bf16_t*)(ws + WS_Y);
    const unsigned* cnt = (const unsigned*)(ws + WS_CTL) + CW_CNT + l * 32 * 64;
    int mt = 0; if (lane < 32) mt = ((int)__hip_atomic_load(cnt + lane * 64, __ATOMIC_RELAXED, __HIP_MEMORY_SCOPE_AGENT) + 255) >> 8;
    int incl = mt;
#pragma unroll
    for (int o = 1; o < 32; o <<= 1) { const int t = __shfl_up(incl, o); if ((lane & 31) >= o) incl += t; }
    const int excl = incl - mt;
    const int gw = blockIdx.x * NWAVES + C.wave, NGW = C.G * NWAVES;
    for (int tk0 = gw; tk0 < NTOK; tk0 += 2 * NGW) {
        int tks[2]; tks[0] = tk0; tks[1] = (tk0 + NGW) < NTOK ? tk0 + NGW : tk0; const bool two = (tk0 + NGW) < NTOK;
        f32x4 v[2][4]; u32x2 yv[2][4][4]; float gts[2][4];
#pragma unroll
        for (int q = 0; q < 2; ++q) { const int tk = tks[q]; const f32x4* hr = (const f32x4*)(H + (size_t)tk * D) + lane;
#pragma unroll
            for (int j = 0; j < 4; ++j) v[q][j] = hr[64 * j];
            const int4 ex4 = *(const int4*)((const int*)(ws + WS_EIDX) + tk * 4), sl4 = *(const int4*)((const int*)(ws + WS_SLOT) + tk * 4); const f32x4 g4 = *(const f32x4*)((const float*)(ws + WS_GATE) + tk * 4);
            const int exs[4] = {ex4.x, ex4.y, ex4.z, ex4.w}, sls[4] = {sl4.x, sl4.y, sl4.z, sl4.w};
#pragma unroll
            for (int k = 0; k < 4; ++k) { gts[q][k] = g4[k]; const int row = 256 * __shfl(excl, exs[k]) + sls[k]; const u32x2* yr = (const u32x2*)(Y + (size_t)row * D) + lane;
#pragma unroll
                for (int j = 0; j < 4; ++j) yv[q][k][j] = yr[64 * j]; }
        }
#pragma unroll
        for (int q = 0; q < 2; ++q) {
            if (q == 1 && !two) break;
            const int tk = tks[q], b = tk >> 12; f32x4* hr = (f32x4*)(H + (size_t)tk * D) + lane;
            f32x4 m[4];
#pragma unroll
            for (int j = 0; j < 4; ++j) m[j] = (f32x4){0.f, 0.f, 0.f, 0.f};
#pragma unroll
            for (int k = 0; k < 4; ++k)
#pragma unroll
                for (int j = 0; j < 4; ++j) { const u32x2 w = yv[q][k][j]; m[j] += (f32x4){bflo(w.x), bfhi(w.x), bflo(w.y), bfhi(w.y)} * gts[q][k]; }
            const float* mb = mod + (size_t)(l * 4 + b) * 6144;
            f32x4 vv[4];
#pragma unroll
            for (int j = 0; j < 4; ++j) { const f32x4 g2 = *(const f32x4*)(mb + 5120 + 4 * lane + 256 * j); vv[j] = v[q][j] + g2 * m[j]; if (l + 1 < DEPTH) hr[64 * j] = vv[j]; }
            if (l + 1 < DEPTH) { const float* mn = mod + (size_t)((l + 1) * 4 + b) * 6144; norm_mod_store(vv, a.norm1_g + (l + 1) * 1024, mn + 0, mn + 1024, (bf16_t*)(ws + WS_U) + (size_t)tk * D, lane); }
            else {
                float ss = 0.f;
#pragma unroll
                for (int j = 0; j < 4; ++j) ss += (vv[j].x * vv[j].x + vv[j].y * vv[j].y) + (vv[j].z * vv[j].z + vv[j].w * vv[j].w);
                const float rstd = 1.0f / sqrtf(wave_sum(ss) * (1.0f / D) + EPS);
                f32x4* orow = (f32x4*)(a.out + (size_t)tk * D) + lane;
#pragma unroll
                for (int j = 0; j < 4; ++j) orow[64 * j] = vv[j] * rstd * *(const f32x4*)(a.final_g + 4 * lane + 256 * j);
            }
        }
    }
}

#define XB_TMO      128
#define XB_XCNT(j)  (256  + 64 * (j))
#define XB_XSUB(j)  (1280 + 64 * (j))
#define XB_XGEN(j)  (2304 + 64 * (j))
#define XB_TOP      3328
#define XB_TOPGEN   3392
#define XCD_BAR_WORDS 3456
#define XB_SPIN_CAP (1u << 22)
__device__ __forceinline__ unsigned xb_ld(unsigned* p)              { return __hip_atomic_load(p, __ATOMIC_RELAXED, __HIP_MEMORY_SCOPE_AGENT); }
__device__ __forceinline__ unsigned xb_add(unsigned* p, unsigned v) { return __hip_atomic_fetch_add(p, v, __ATOMIC_RELAXED, __HIP_MEMORY_SCOPE_AGENT); }
__device__ __forceinline__ unsigned xb_xcc_id() { return (unsigned)__builtin_amdgcn_s_getreg((3 << 11) | 20) & 0xFu; }
#define XB_SPIN(cond, bar) do { unsigned _sp = 0; while (cond) { __builtin_amdgcn_s_sleep(1); \
    if ((++_sp & 255u) == 0u) { if (xb_ld(&(bar)[XB_TMO])) break; if (_sp > XB_SPIN_CAP) { atomicAdd(&(bar)[XB_TMO], 1u); break; } } } } while (0)
struct XcdBarrier { unsigned* bar; unsigned x; volatile LAS unsigned* st; };
__device__ __forceinline__ XcdBarrier xcd_barrier_post(unsigned* bar, volatile LAS unsigned* st, bool leader) {
    XcdBarrier b; b.bar = bar; b.x = xb_xcc_id(); b.st = st;
    if (leader) (void)xb_add(&bar[XB_XCNT(b.x)], 1u);
    return b;
}
__device__ __forceinline__ void xcd_barrier_complete(unsigned* bar, unsigned x, unsigned& nloc, unsigned& nx) {
    const unsigned G = gridDim.x * gridDim.y * gridDim.z;
    unsigned sum, cnt, mine, sp = 0u;
    for (;;) {
        sum = 0u; cnt = 0u; mine = 0u;
#pragma unroll
        for (unsigned j = 0; j < 16; ++j) { const unsigned c = xb_ld(&bar[XB_XCNT(j)]); sum += c; cnt += (c > 0u) ? 1u : 0u; mine = (j == x) ? c : mine; }
        if (sum == G) break;
        __builtin_amdgcn_s_sleep(1);
        if ((++sp & 255u) == 0u) { if (xb_ld(&bar[XB_TMO])) break; if (sp > XB_SPIN_CAP) { atomicAdd(&bar[XB_TMO], 1u); break; } }
    }
    nloc = mine > 0u ? mine : 1u; nx = cnt > 0u ? cnt : 1u;
}
__device__ __forceinline__ void xcd_barrier(const XcdBarrier& b, bool leader) {
    asm volatile("s_waitcnt vmcnt(0)" ::: "memory");
    __syncthreads();
    if (leader) {
        unsigned* bar = b.bar;
        __builtin_amdgcn_s_waitcnt(0);
        unsigned nloc = b.st[0], nx = b.st[1];
        if (nloc == 0u) { xcd_barrier_complete(bar, b.x, nloc, nx); b.st[0] = nloc; b.st[1] = nx; }
        const unsigned old = xb_add(&bar[XB_XSUB(b.x)], 1u);
        const unsigned gen = old / nloc;
        if (old + 1u == (gen + 1u) * nloc) {
            __builtin_amdgcn_fence(__ATOMIC_RELEASE, "agent");
            asm volatile("s_waitcnt vmcnt(0)" ::: "memory");
            const unsigned og = xb_add(&bar[XB_TOP], 1u);
            const unsigned tg = og / nx;
            if (og + 1u == (tg + 1u) * nx) xb_add(&bar[XB_TOPGEN], 1u);
            else XB_SPIN(xb_ld(&bar[XB_TOPGEN]) == tg, bar);
            __builtin_amdgcn_fence(__ATOMIC_ACQUIRE, "agent");
            xb_add(&bar[XB_XGEN(b.x)], 1u);
            asm volatile("s_waitcnt vmcnt(0)" ::: "memory");
        } else {
            XB_SPIN(xb_ld(&bar[XB_XGEN(b.x)]) == gen, bar);
            __builtin_amdgcn_fence(__ATOMIC_ACQUIRE, "agent");
            asm volatile("s_waitcnt vmcnt(0)" ::: "memory");
        }
    }
    __syncthreads();
}

typedef const __attribute__((address_space(4))) Args* KArgsPtr;
__device__ __forceinline__ Args load_args() {
#if defined(__HIP_DEVICE_COMPILE__)
    KArgsPtr p = (KArgsPtr)__builtin_amdgcn_kernarg_segment_ptr(); asm volatile("" : "+s"(p)); Args a;
    a.x = p->x; a.c = p->c; a.pos = p->pos; a.w_ada = p->w_ada; a.b_ada = p->b_ada; a.norm1_g = p->norm1_g; a.norm2_g = p->norm2_g; a.w_in = p->w_in; a.w_out = p->w_out; a.pool_w = p->pool_w;
    a.pool_scale = p->pool_scale; a.hgrn_g = p->hgrn_g; a.lb_logits = p->lb_logits; a.w_router = p->w_router; a.b_router = p->b_router; a.w1 = p->w1; a.b1 = p->b1; a.w2 = p->w2; a.b2 = p->b2; a.final_g = p->final_g;
    a.out = p->out; a.ws = p->ws; a.ph_lo = p->ph_lo; a.ph_hi = p->ph_hi; return a;
#else
    return Args{};
#endif
}
__device__ __forceinline__ int lane_id() { return __builtin_amdgcn_mbcnt_hi(~0u, __builtin_amdgcn_mbcnt_lo(~0u, 0)); }
__device__ __forceinline__ Ctx make_ctx(unsigned char* ws, int wv) {
    extern __shared__ __attribute__((aligned(16))) unsigned char lds_raw[];
    Ctx C; C.lds = (LAS unsigned char*)lds_raw; { int l_ = lane_id(); asm volatile("" : "+v"(l_)); C.lane = l_; } C.wave = wv; C.tid = wv * 64 + C.lane;
    C.G = gridDim.x; { const int bx = blockIdx.x; C.vcu = (C.G % 8 == 0) ? (bx % 8) * (C.G / 8) + bx / 8 : bx; }
    C.ws = ws; return C;
}
#ifndef PHASE_FN
#define PHASE_FN __device__ __forceinline__ void
#endif
#define GEMM_FN __device__ __forceinline__ void
PHASE_FN ph_prep(int wv) { const Args a = load_args(); Ctx C = make_ctx(a.ws, wv); phase_prep(a, C); }
PHASE_FN ph_u0(int wv) { const Args a = load_args(); Ctx C = make_ctx(a.ws, wv); phase_u0(a, C); }
GEMM_FN ph_gin(int l, int wv) { const Args a = load_args(); Ctx C = make_ctx(a.ws, wv); unsigned char* ws = a.ws;
    DenseOrder S{(const char*)(ws + WS_U), (const char*)(ws + WS_WIN) + (size_t)l * NPAD * 1024 * 2, NTOK / 256, NPAD / 256, (NTOK / 256) * (NPAD / 256), C.G, (int)blockIdx.x};
    EpiIn E{ws}; pg8::gemm_phase<EpiIn, DenseOrder, false, true>(C.lds, (LAS unsigned*)(C.lds + LDS_PARK), C.tid, S, E); }
PHASE_FN ph_mix1(int l, int wv) { const Args a = load_args(); Ctx C = make_ctx(a.ws, wv); phase_mix1(a, C, l); }
PHASE_FN ph_mix2(int l, int wv) { const Args a = load_args(); Ctx C = make_ctx(a.ws, wv); phase_mix2(a, C, l); }
GEMM_FN ph_gout(int l, int wv) { const Args a = load_args(); Ctx C = make_ctx(a.ws, wv); unsigned char* ws = a.ws;
    DenseOrder S{(const char*)(ws + WS_MIX), (const char*)(ws + WS_WOUT) + (size_t)l * 1024 * 1024 * 2, NTOK / 256, 4, (NTOK / 256) * 4, C.G, (int)blockIdx.x};
    EpiOut E{l == 0 ? a.x : (const float*)(ws + WS_H), (float*)(ws + WS_H), (const float*)(ws + WS_MOD) + (size_t)l * 4 * 6144 + 2048};
    pg8::gemm_phase<EpiOut, DenseOrder, false, true>(C.lds, (LAS unsigned*)(C.lds + LDS_PARK), C.tid, S, E); }
PHASE_FN ph_router(int l, int wv) { const Args a = load_args(); Ctx C = make_ctx(a.ws, wv); phase_router2(a, C, l); }
GEMM_FN ph_g1(int l, int wv) { const Args a = load_args(); Ctx C = make_ctx(a.ws, wv); unsigned char* ws = a.ws;
    LAS int* tab = (LAS int*)(C.lds + LDS_TAB); moe_table(C, l, tab);
    MoeOrder<true> S{tab, (const char*)(ws + WS_U), (const char*)(ws + WS_W1) + (size_t)l * 32 * 2048 * 1024 * 2, (const int*)(ws + WS_ROWTOK), C.G, C.vcu};
    EpiG1 E{(bf16_t*)(ws + WS_ACT), a.b1 + (size_t)l * 32 * 2048}; pg8::gemm_phase<EpiG1, MoeOrder<true>, true, true>(C.lds, (LAS unsigned*)(C.lds + LDS_PARK), C.tid, S, E); }
GEMM_FN ph_g2(int l, int wv) { const Args a = load_args(); Ctx C = make_ctx(a.ws, wv); unsigned char* ws = a.ws;
    LAS int* tab = (LAS int*)(C.lds + LDS_TAB); moe_table(C, l, tab);
    MoeOrder<false> S{tab, (const char*)(ws + WS_ACT), (const char*)(ws + WS_W2) + (size_t)l * 32 * 1024 * 1024 * 2, nullptr, C.G, C.vcu};
    EpiG2 E{(bf16_t*)(ws + WS_Y), a.b2 + (size_t)l * 32 * 1024}; pg8::gemm_phase<EpiG2, MoeOrder<false>, false, true>(C.lds, (LAS unsigned*)(C.lds + LDS_PARK), C.tid, S, E); }
PHASE_FN ph_combine(int l, int wv) { const Args a = load_args(); Ctx C = make_ctx(a.ws, wv); phase_combine(a, C, l); }

constexpr int NPHASES = 2 + 8 * DEPTH;
__global__ void __launch_bounds__(NTHREADS, 2) mega_fwd(Args a) {
#if MK_ONE_LAUNCH == 1
    cg::grid_group grid = cg::this_grid();
#define SEAM() do { __syncthreads(); grid.sync(); } while (0)
#elif MK_ONE_LAUNCH == 2
    extern __shared__ __attribute__((aligned(16))) unsigned char lds_k[];
    volatile LAS unsigned* bst = (volatile LAS unsigned*)((LAS unsigned char*)lds_k + LDS_BYTES - 64);
    const bool leader = (threadIdx.x == 0);
    if (leader) { bst[0] = 0u; bst[1] = 0u; }
    __syncthreads();
    const XcdBarrier xbar = xcd_barrier_post((unsigned*)(a.ws + WS_CTL) + CW_BAR, bst, leader);
#define SEAM() xcd_barrier(xbar, leader)
#else
#define SEAM() do { } while (0)
#endif
    const int lo = a.ph_lo, hi = a.ph_hi;
    const int wv = __builtin_amdgcn_readfirstlane((int)threadIdx.x >> 6);
#define RUN(id, call) do { if (lo <= (id) && (id) < hi) { call; if ((id) + 1 < hi) SEAM(); } } while (0)
    RUN(0, ph_prep(wv));
    RUN(1, ph_u0(wv));
    RUN(2, ph_gin(0, wv)); RUN(3, ph_mix1(0, wv)); RUN(4, ph_mix2(0, wv)); RUN(5, ph_gout(0, wv)); RUN(6, ph_router(0, wv)); RUN(7, ph_g1(0, wv)); RUN(8, ph_g2(0, wv)); RUN(9, ph_combine(0, wv));
    RUN(10, ph_gin(1, wv)); RUN(11, ph_mix1(1, wv)); RUN(12, ph_mix2(1, wv)); RUN(13, ph_gout(1, wv)); RUN(14, ph_router(1, wv)); RUN(15, ph_g1(1, wv)); RUN(16, ph_g2(1, wv)); RUN(17, ph_combine(1, wv));
#undef RUN
}

extern "C" void kernel_launch(void* const* d_in, const int* in_sizes, int n_in, void* d_out, int out_size, void* d_ws, size_t ws_size, hipStream_t stream) {
    static int grid = 0;
    if (grid == 0) {
        if (n_in != 20 || out_size != NTOK * D || ws_size < WS_END) { fprintf(stderr, "kernel_launch: unexpected shapes: n_in %d out %d ws %zu (need %zu)\n", n_in, out_size, ws_size, (size_t)WS_END); grid = -1; return; }
        int dev = 0, cus = 0, per_cu = 0;
        hipGetDevice(&dev); hipDeviceGetAttribute(&cus, hipDeviceAttributeMultiprocessorCount, dev);
        if (hipFuncSetAttribute((const void*)mega_fwd, hipFuncAttributeMaxDynamicSharedMemorySize, LDS_BYTES) != hipSuccess) { fprintf(stderr, "kernel_launch: hipFuncSetAttribute failed\n"); grid = -1; return; }
        hipOccupancyMaxActiveBlocksPerMultiprocessor(&per_cu, (const void*)mega_fwd, NTHREADS, LDS_BYTES);
        (void)hipGetLastError();
        if (per_cu < 1) fprintf(stderr, "kernel_launch: occupancy query says %d blocks per CU\n", per_cu);
        grid = cus;
    }
    if (grid < 0) return;
    hipMemsetAsync((char*)d_ws + WS_CTL, 0, CTL_BYTES, stream);
    Args a{};
    a.x = (const float*)d_in[0]; a.c = (const float*)d_in[1]; a.pos = (const int*)d_in[2]; a.w_ada = (const float*)d_in[3]; a.b_ada = (const float*)d_in[4];
    a.norm1_g = (const float*)d_in[5]; a.norm2_g = (const float*)d_in[6]; a.w_in = (const float*)d_in[7]; a.w_out = (const float*)d_in[8]; a.pool_w = (const float*)d_in[9];
    a.pool_scale = (const float*)d_in[10]; a.hgrn_g = (const float*)d_in[11]; a.lb_logits = (const float*)d_in[12]; a.w_router = (const float*)d_in[13]; a.b_router = (const float*)d_in[14];
    a.w1 = (const float*)d_in[15]; a.b1 = (const float*)d_in[16]; a.w2 = (const float*)d_in[17]; a.b2 = (const float*)d_in[18]; a.final_g = (const float*)d_in[19];
    a.out = (float*)d_out; a.ws = (unsigned char*)d_ws;
#if MK_ONE_LAUNCH == 1
    a.ph_lo = 0; a.ph_hi = NPHASES;
    void* args[] = {&a};
    hipError_t e = hipLaunchCooperativeKernel((const void*)mega_fwd, dim3(grid), dim3(NTHREADS), args, LDS_BYTES, stream);
    if (e != hipSuccess) fprintf(stderr, "cooperative launch failed: %s (grid %d)\n", hipGetErrorString(e), grid);
#elif MK_ONE_LAUNCH == 2
    a.ph_lo = 0; a.ph_hi = NPHASES;
    hipLaunchKernelGGL(mega_fwd, dim3(grid), dim3(NTHREADS), LDS_BYTES, stream, a);
#else
    for (int p = 0; p < NPHASES; ++p) { a.ph_lo = p; a.ph_hi = p + 1; hipLaunchKernelGGL(mega_fwd, dim3(grid), dim3(NTHREADS), LDS_BYTES, stream, a); }
#endif
}
```

```cpp
#include <hip/hip_runtime.h>
#include <hip/hip_cooperative_groups.h>
#include <cstdio>
#include <cstdint>
#include <type_traits>
namespace cg = cooperative_groups;

#ifndef MK_ONE_LAUNCH
#define MK_ONE_LAUNCH 2
#endif

#define LAS __attribute__((address_space(3)))
typedef unsigned short bf16_t;
typedef short bf16x8 __attribute__((ext_vector_type(8)));
typedef float f32x4 __attribute__((ext_vector_type(4)));
typedef float f32x2 __attribute__((ext_vector_type(2)));
typedef unsigned u32x4 __attribute__((ext_vector_type(4)));
typedef unsigned u32x2 __attribute__((ext_vector_type(2)));

constexpr int D = 1024, NBATCH = 4, SEQ = 4096, NTOK = NBATCH * SEQ, DEPTH = 2;
constexpr int D_IN = 2372, NPAD = 2560;
constexpr int NE = 32, TOPK = 4, FF = 1024;
constexpr int NWAVES = 8, NTHREADS = 512;
constexpr float EPS = 1e-6f;
constexpr float W8SCALE = 32.0f;
constexpr int ROWCAP = 73728;

constexpr size_t MiB = 1u << 20;
constexpr size_t WS_CTL = 0, CTL_BYTES = 1 * MiB;
constexpr size_t WS_MOD = 1 * MiB;
constexpr size_t WS_ROPEC = 2 * MiB;
constexpr size_t WS_ROPES = 4 * MiB;
constexpr size_t WS_WIN = 6 * MiB;
constexpr size_t WS_WOUT = 16 * MiB;
constexpr size_t WS_ROWTOK = 20 * MiB;
constexpr size_t WS_EIDX = 22 * MiB;
constexpr size_t WS_SLOT = 22 * MiB + 256 * 1024;
constexpr size_t WS_GATE = 22 * MiB + 512 * 1024;
constexpr size_t WS_WI = 23 * MiB;
constexpr size_t WS_WRH = 23 * MiB + 256 * 1024;
constexpr size_t WS_WRL = 23 * MiB + 512 * 1024;
constexpr size_t WS_KI = 24 * MiB;
constexpr size_t WS_K = 26 * MiB;
constexpr size_t WS_V = 30 * MiB;
constexpr size_t WS_QI = 34 * MiB;
constexpr size_t WS_Q = 42 * MiB;
constexpr size_t WS_UB = 58 * MiB;
constexpr size_t WS_HG = 74 * MiB;
constexpr size_t WS_SEL = 138 * MiB;
constexpr size_t WS_HL = 154 * MiB;
constexpr size_t WS_HD = 170 * MiB;
constexpr size_t WS_MIX = 171 * MiB;
constexpr size_t WS_U = 203 * MiB;
constexpr size_t WS_H = 235 * MiB;
constexpr size_t WS_W1 = 299 * MiB;
constexpr size_t WS_W2 = 555 * MiB;
constexpr size_t WS_ACT = 683 * MiB;
constexpr size_t WS_Y = 827 * MiB;
constexpr size_t WS_END = 971 * MiB;
constexpr int CW_CNT = 1024;
constexpr int CW_BAR = 8192;

constexpr int LDS_BYTES = 147456;
constexpr int LDS_TAB = 131072;
constexpr int LDS_PARK = 131072 + 1024;

__device__ __forceinline__ unsigned f2bf(float f) { unsigned u = __builtin_bit_cast(unsigned, f); return (u + 0x7fffu + ((u >> 16) & 1u)) >> 16; }
typedef __bf16 bf16x2_t __attribute__((ext_vector_type(2)));
__device__ __forceinline__ unsigned cvt_pk_bf16(float lo, float hi) { const f32x2 v = {lo, hi}; const bf16x2_t b = __builtin_convertvector(v, bf16x2_t); return __builtin_bit_cast(unsigned, b); }
__device__ __forceinline__ unsigned pk2(float lo, float hi) { return cvt_pk_bf16(lo, hi); }
__device__ __forceinline__ unsigned pk4_fp8(float a, float b, float c, float d) { unsigned w = 0u; w = __builtin_amdgcn_cvt_pk_fp8_f32(a, b, w, false); w = __builtin_amdgcn_cvt_pk_fp8_f32(c, d, w, true); return w; }
__device__ __forceinline__ float bf2f(unsigned short b) { return __builtin_bit_cast(float, ((unsigned)b) << 16); }
__device__ __forceinline__ float bflo(unsigned w) { return __builtin_bit_cast(float, w << 16); }
__device__ __forceinline__ float bfhi(unsigned w) { return __builtin_bit_cast(float, w & 0xffff0000u); }
__device__ __forceinline__ float wave_sum(float v) {
#pragma unroll
    for (int o = 1; o < 64; o <<= 1) v += __shfl_xor(v, o);
    return v;
}
__device__ __forceinline__ float wave_max(float v) {
#pragma unroll
    for (int o = 1; o < 64; o <<= 1) v = fmaxf(v, __shfl_xor(v, o));
    return v;
}
__device__ __forceinline__ float sigmoidf_(float z) { return __builtin_amdgcn_rcpf(1.0f + __expf(-z)); }
__device__ __forceinline__ float siluf_(float z) { return z * __builtin_amdgcn_rcpf(1.0f + __expf(-z)); }

namespace pg8 {
constexpr int BM = 256, BK = 64, HALF = 128, HTB = HALF * BK * 2, STAGE_BYTES = 8 * HTB;
constexpr int KD = 1024, NKT = KD / BK;
__host__ __device__ __forceinline__ int lds_byte(int r, int c) { const int st = (r >> 4) * 2 + (c >> 5), rr = r & 15, cc = c & 31, ob = rr * 64 + cc * 2; return st * 1024 + (ob ^ (((ob >> 9) & 1) << 5)); }
__host__ __device__ __forceinline__ void stage_rc(int b, int& R, int& C) { const int st = b / 1024, sb = b % 1024, swz = sb ^ (((sb >> 9) & 1) << 5); R = (st >> 1) * 16 + swz / 64; C = (st & 1) * 32 + (swz % 64) / 2; }

struct Unit { const char* A; const char* B; const int* ridx; int nvalid; int row0, pn, e, b; };

__device__ __forceinline__ f32x4 mma_step(bf16x8 a, bf16x8 b, f32x4 c) { return __builtin_amdgcn_mfma_f32_16x16x32_bf16(a, b, c, 0, 0, 0); }
__device__ __forceinline__ f32x4 mma_step(long a, long b, f32x4 c) { return __builtin_amdgcn_mfma_f32_16x16x32_fp8_fp8(a, b, c, 0, 0, 0); }
template <class Epi, class Sched, bool GATHER, bool ALIGN_EPI, bool FP8 = false>
__device__ __forceinline__ void gemm_phase(LAS unsigned char* lds, LAS unsigned* park, int tid_in, const Sched& S, const Epi& E) {
    const int tid = tid_in, wid = __builtin_amdgcn_readfirstlane(tid >> 6), lane = tid & 63, wr = wid >> 2, wc = wid & 3, fr = lane & 15, fq = lane >> 4;
    constexpr int RS = FP8 ? KD : KD * 2;
    constexpr int nt = FP8 ? NKT / 2 : NKT, KS = FP8 ? 4 : 2;
    typedef typename std::conditional<FP8, long, bf16x8>::type Frag;
    auto stage_map = [&](int i, int& R, int& Cb) { if (FP8) { const int st = wid + 8 * i; R = (st >> 1) * 16 + (lane & 15); Cb = (st & 1) * 64 + 16 * (lane >> 4); }
                                                    else { int C; stage_rc(tid * 16 + i * 8192, R, C); Cb = 2 * C; } };
    unsigned voffB[2], vA[2][2];
#pragma unroll
    for (int i = 0; i < 2; ++i) { int R, Cb; stage_map(i, R, Cb); voffB[i] = (unsigned)(R * RS + Cb); }
    constexpr size_t kstep = (size_t)(BK * 2);
    constexpr size_t hstep = (size_t)HALF * RS;
    const unsigned ldsw = (unsigned)wid * 1024u;
    const int aoff = lds_byte(wr * 64 + fr, fq * 8), boff = lds_byte(wc * 32 + fr, fq * 8);
    const int f8lo = (16 * (fq >> 1) + fr) * 16 + 8 * (fq & 1);
    const int aoff8[4] = {(wr * 8 + 0) * 1024 + f8lo, (wr * 8 + 0) * 1024 + 512 + f8lo, (wr * 8 + 1) * 1024 + f8lo, (wr * 8 + 1) * 1024 + 512 + f8lo};
    const int boff8[4] = {(wc * 4 + 0) * 1024 + f8lo, (wc * 4 + 0) * 1024 + 512 + f8lo, (wc * 4 + 1) * 1024 + f8lo, (wc * 4 + 1) * 1024 + 512 + f8lo};
#define PG8_SA(b, h) (((b) * 2 + (h)) * HTB)
#define PG8_SB(b, h) ((4 + (b) * 2 + (h)) * HTB)
#define PG8_STAGE(bufoff, gbase, voff) do { _Pragma("unroll") for (int _i = 0; _i < 2; ++_i) \
        __builtin_amdgcn_global_load_lds((const unsigned*)((const char*)(gbase) + (voff)[_i]), (LAS unsigned*)(lds + (bufoff) + ldsw + _i * 8192), 16, 0, 0); } while (0)
#define PG8_LDA(dst, b, h) do { _Pragma("unroll") for (int m = 0; m < 4; ++m) _Pragma("unroll") for (int k = 0; k < KS; ++k) dst[m][k] = *(const LAS Frag*)(lds + PG8_SA(b, h) + (FP8 ? aoff8[k] : aoff + k * 1024) + m * 2048); } while (0)
#define PG8_LDB(dst, b, h) do { _Pragma("unroll") for (int n = 0; n < 2; ++n) _Pragma("unroll") for (int k = 0; k < KS; ++k) dst[n][k] = *(const LAS Frag*)(lds + PG8_SB(b, h) + (FP8 ? boff8[k] : boff + k * 1024) + n * 2048); } while (0)
#define PG8_MMA(ai, bj, At, Bt) do { __builtin_amdgcn_s_setprio(1); _Pragma("unroll") for (int m = 0; m < 4; ++m) _Pragma("unroll") for (int n = 0; n < 2; ++n) _Pragma("unroll") for (int k = 0; k < KS; ++k) \
        acc[ai][bj][m][n] = mma_step(Bt[n][k], At[m][k], acc[ai][bj][m][n]); __builtin_amdgcn_s_setprio(0); } while (0)
#define PG8_WAIT_V(n) asm volatile("s_waitcnt vmcnt(" #n ")" ::: "memory")
#define PG8_WAIT_L(n) asm volatile("s_waitcnt lgkmcnt(" #n ")" ::: "memory")
#define PG8_BAR __builtin_amdgcn_s_barrier()
#define PG8_SCHED __builtin_amdgcn_sched_barrier(0)
#define PG8_OFFS(dst, u) do { _Pragma("unroll") for (int _h = 0; _h < 2; ++_h) _Pragma("unroll") for (int _i = 0; _i < 2; ++_i) { \
        int _R, _Cb; stage_map(_i, _R, _Cb); const int _rr = _h * HALF + _R; \
        if constexpr (GATHER) { const int _ix = (u).ridx[_rr < (u).nvalid ? _rr : 0]; dst[_h][_i] = (unsigned)(_ix * RS + _Cb); } \
        else dst[_h][_i] = (unsigned)(_rr * RS + _Cb); } } while (0)
    Unit cur, nxt; int ui = 0;
    if (!S.next(0, cur)) return;
    f32x4 acc[2][2][4][2];
#pragma unroll
    for (int a = 0; a < 2; ++a)
#pragma unroll
        for (int b = 0; b < 2; ++b)
#pragma unroll
            for (int m = 0; m < 4; ++m)
#pragma unroll
                for (int n = 0; n < 2; ++n) acc[a][b][m][n] = (f32x4){0.f, 0.f, 0.f, 0.f};
    Frag At[4][KS], B0[2][KS], B1[2][KS];
    PG8_OFFS(vA, cur);
    const char* cA = cur.A; const char* cB = cur.B;
    PG8_STAGE(PG8_SB(0, 0), cB, voffB); PG8_STAGE(PG8_SB(0, 1), cB + hstep, voffB); PG8_STAGE(PG8_SA(0, 0), cA, vA[0]); PG8_STAGE(PG8_SA(0, 1), cA, vA[1]);
    if (wr == 1) PG8_BAR;
    PG8_WAIT_V(2); PG8_BAR;
    PG8_STAGE(PG8_SB(1, 0), cB + kstep, voffB); PG8_STAGE(PG8_SA(1, 0), cA + kstep, vA[0]); PG8_STAGE(PG8_SB(1, 1), cB + hstep + kstep, voffB);
    PG8_WAIT_V(6); PG8_BAR;
    for (;;) {
        const bool has_next = S.next(ui + 1, nxt);
        const char* nA = has_next ? nxt.A : cA; const char* nB = has_next ? nxt.B : cB;
        if constexpr (GATHER) {
            unsigned nv[2][2];
            if (has_next) { PG8_OFFS(nv, nxt); } else {
#pragma unroll
                for (int h = 0; h < 2; ++h) { nv[h][0] = vA[h][0]; nv[h][1] = vA[h][1]; } }
            *(LAS u32x4*)(park + tid * 4) = (u32x4){nv[0][0], nv[0][1], nv[1][0], nv[1][1]};
        }
        for (int t = 0; t < nt; t += 2) {
            const bool last = (t == nt - 2);
            const char* a1 = cA + (size_t)(t + 1) * kstep;
            const char* a2 = last ? nA : cA + (size_t)(t + 2) * kstep; const char* b2 = last ? nB : cB + (size_t)(t + 2) * kstep;
            const char* a3 = a2 + kstep; const char* b3 = b2 + kstep;
            PG8_LDB(B0, 0, 0); PG8_LDB(B1, 0, 1); PG8_SCHED; PG8_LDA(At, 0, 0); PG8_STAGE(PG8_SA(1, 1), a1, vA[1]);
            if constexpr (GATHER) { if (last) { const u32x4 pv = *(const LAS u32x4*)(park + tid * 4); vA[0][0] = pv.x; vA[0][1] = pv.y; vA[1][0] = pv.z; vA[1][1] = pv.w; } }
            PG8_WAIT_V(8); PG8_WAIT_L(0); PG8_BAR; PG8_MMA(0, 0, At, B0); PG8_MMA(0, 1, At, B1); PG8_BAR; PG8_SCHED;
            PG8_LDA(At, 0, 1); PG8_STAGE(PG8_SB(0, 0), b2, voffB); PG8_STAGE(PG8_SB(0, 1), b2 + hstep, voffB); PG8_STAGE(PG8_SA(0, 0), a2, vA[0]);
            PG8_WAIT_V(8); PG8_WAIT_L(0); PG8_BAR; PG8_MMA(1, 0, At, B0); PG8_MMA(1, 1, At, B1); PG8_BAR; PG8_SCHED;
            PG8_LDB(B0, 1, 0); PG8_LDB(B1, 1, 1); PG8_SCHED; PG8_LDA(At, 1, 0); PG8_STAGE(PG8_SA(0, 1), a2, vA[1]);
            PG8_WAIT_V(8); PG8_WAIT_L(0); PG8_BAR; PG8_MMA(0, 0, At, B0); PG8_MMA(0, 1, At, B1); PG8_BAR; PG8_SCHED;
            PG8_LDA(At, 1, 1); PG8_STAGE(PG8_SB(1, 0), b3, voffB); PG8_STAGE(PG8_SB(1, 1), b3 + hstep, voffB); PG8_STAGE(PG8_SA(1, 0), a3, vA[0]);
            PG8_WAIT_V(8); PG8_WAIT_L(0); PG8_BAR; PG8_MMA(1, 0, At, B0); PG8_MMA(1, 1, At, B1); PG8_BAR; PG8_SCHED;
        }
        if constexpr (ALIGN_EPI) { if (wr == 0) PG8_BAR; }
        { int fr2 = fr, fq2 = fq; asm volatile("" : "+v"(fr2), "+v"(fq2)); E(acc, cur, wr, wc, fr2, fq2); }
        if (!has_next) break;
#pragma unroll
        for (int a = 0; a < 2; ++a)
#pragma unroll
            for (int b = 0; b < 2; ++b)
#pragma unroll
                for (int m = 0; m < 4; ++m)
#pragma unroll
                    for (int n = 0; n < 2; ++n) acc[a][b][m][n] = (f32x4){0.f, 0.f, 0.f, 0.f};
        cur = nxt; cA = nA; cB = nB; ++ui;
        if constexpr (ALIGN_EPI) { if (wr == 1) PG8_BAR; }
    }
    PG8_WAIT_V(0);
    if constexpr (!ALIGN_EPI) { if (wr == 0) PG8_BAR; }
    PG8_BAR;
#undef PG8_SA
#undef PG8_SB
#undef PG8_STAGE
#undef PG8_LDA
#undef PG8_LDB
#undef PG8_MMA
#undef PG8_WAIT_V
#undef PG8_WAIT_L
#undef PG8_BAR
#undef PG8_SCHED
#undef PG8_OFFS
}
}

struct Args {
    const float* x; const float* c; const int* pos; const float* w_ada; const float* b_ada; const float* norm1_g; const float* norm2_g;
    const float* w_in; const float* w_out; const float* pool_w; const float* pool_scale; const float* hgrn_g; const float* lb_logits;
    const float* w_router; const float* b_router; const float* w1; const float* b1; const float* w2; const float* b2; const float* final_g;
    float* out; unsigned char* ws; int ph_lo, ph_hi;
};

struct Ctx {
    LAS unsigned char* lds;
    int tid, lane, wave, G, vcu;
    unsigned char* ws;
};

struct DenseOrder {
    const char* A; const char* B; int nM, nN, nwg, G, c;
    __device__ __forceinline__ bool next(int i, pg8::Unit& u) const {
        const long L = (long)i * G + c; if (L >= nwg) return false;
        int wgid = (int)L; { const int q = nwg / 8, r = nwg % 8, xcd = wgid % 8, off = wgid / 8; wgid = (xcd < r ? xcd * (q + 1) : r * (q + 1) + (xcd - r) * q) + off; }
        const int nig = 8 * nN, gid = wgid / nig, fm = gid * 8, gsz = (nM - fm) < 8 ? (nM - fm) : 8;
        const int pm = fm + ((wgid % nig) % gsz), pn = (wgid % nig) / gsz;
        u.A = A + (size_t)pm * 256 * pg8::KD * 2; u.B = B + (size_t)pn * 256 * pg8::KD * 2; u.ridx = nullptr; u.nvalid = 256; u.row0 = pm * 256; u.pn = pn; u.e = 0; u.b = pm >> 4;
        return true;
    }
};

template <bool FIRST> struct MoeOrder {
    LAS const int* tab; const char* A; const char* B; const int* rowtok; int G, c;
    static constexpr int NTN = FIRST ? 8 : 4;
    __device__ __forceinline__ bool next(int i, pg8::Unit& u) const {
        const int P = tab[32]; const long L = (long)i * G + c; if (L >= (long)P * NTN) return false;
        const int p = (int)(L / NTN), nt = (int)(L % NTN);
        int e = 0;
#pragma unroll 1
        for (int k = 1; k < 32; ++k) e = (tab[k] <= p) ? k : e;
        const int mt = p - tab[e], cnt = tab[33 + e];
        if (FIRST) { u.A = A; u.ridx = rowtok + e * NTOK + mt * 256; u.nvalid = (cnt - mt * 256) < 256 ? (cnt - mt * 256) : 256; u.B = B + ((size_t)e * 2048 + nt * 256) * pg8::KD; }
        else { u.A = A + (size_t)p * 256 * pg8::KD; u.ridx = nullptr; u.nvalid = 256; u.B = B + ((size_t)e * 1024 + nt * 256) * pg8::KD; }
        u.row0 = p * 256; u.pn = nt; u.e = e; u.b = 0;
        return true;
    }
};

struct EpiIn {
    unsigned char* ws;
    __device__ __forceinline__ void operator()(const f32x4 (&acc)[2][2][4][2], const pg8::Unit& u, int wr, int wc, int fr, int fq) const {
        const int pn = u.pn;
        const float* rc = (const float*)(ws + WS_ROPEC); const float* rs = (const float*)(ws + WS_ROPES);
        const bool rope = (pn <= 1) || (pn == 3) || (pn == 2 && wc < 2) || (pn == 4 && wc == 0);
#pragma unroll
        for (int ai = 0; ai < 2; ++ai)
#pragma unroll
            for (int m = 0; m < 4; ++m) {
                const int r = u.row0 + ai * 128 + wr * 64 + m * 16 + fr;
                if (rope) {
                    bf16_t* dst; float scl = 1.f;
                    if (pn <= 1) { dst = (bf16_t*)(ws + WS_Q) + (size_t)r * 512 + (pn * 4 + wc) * 64; scl = 0.125f; }
                    else if (pn == 2) dst = (bf16_t*)(ws + WS_K) + (size_t)r * 128 + wc * 64;
                    else if (pn == 3) dst = (bf16_t*)(ws + WS_QI) + (size_t)r * 256 + wc * 64;
                    else dst = (bf16_t*)(ws + WS_KI) + (size_t)r * 64;
                    const f32x4 c0 = *(const f32x4*)(rc + (size_t)r * 32 + 8 * fq), c1 = *(const f32x4*)(rc + (size_t)r * 32 + 8 * fq + 4), s0 = *(const f32x4*)(rs + (size_t)r * 32 + 8 * fq), s1 = *(const f32x4*)(rs + (size_t)r * 32 + 8 * fq + 4);
                    const f32x4 x10 = acc[ai][0][m][0], x11 = acc[ai][0][m][1], x20 = acc[ai][1][m][0], x21 = acc[ai][1][m][1];
                    const f32x4 o10 = (x10 * c0 - x20 * s0) * scl, o11 = (x11 * c1 - x21 * s1) * scl, o20 = (x20 * c0 + x10 * s0) * scl, o21 = (x21 * c1 + x11 * s1) * scl;
                    u32x4 w1v, w2v; w1v.x = pk2(o10[0], o10[1]); w1v.y = pk2(o10[2], o10[3]); w1v.z = pk2(o11[0], o11[1]); w1v.w = pk2(o11[2], o11[3]);
                    w2v.x = pk2(o20[0], o20[1]); w2v.y = pk2(o20[2], o20[3]); w2v.z = pk2(o21[0], o21[1]); w2v.w = pk2(o21[2], o21[3]);
                    *(u32x4*)(dst + 8 * fq) = w1v; *(u32x4*)(dst + 32 + 8 * fq) = w2v;
                } else if (pn == 2) {
#pragma unroll
                    for (int bj = 0; bj < 2; ++bj) { const f32x4 a0 = acc[ai][bj][m][0], a1 = acc[ai][bj][m][1]; u32x4 w; w.x = pk2(a0[0], a0[1]); w.y = pk2(a0[2], a0[3]); w.z = pk2(a1[0], a1[1]); w.w = pk2(a1[2], a1[3]);
                        *(u32x4*)((bf16_t*)(ws + WS_V) + (size_t)r * 128 + bj * 64 + (wc - 2) * 32 + 8 * fq) = w; }
                } else if (pn == 4) {
                    if (wc == 1 && fq == 0) *(f32x4*)((float*)(ws + WS_WI) + (size_t)r * 4) = acc[ai][0][m][0] * 0.0625f;
                } else {
                    float* p = (pn == 5) ? (float*)(ws + WS_UB) + (size_t)r * 256 + wc * 32 + 8 * fq : (float*)(ws + WS_HG) + (size_t)r * 1024 + (pn - 6) * 256 + wc * 32 + 8 * fq;
#pragma unroll
                    for (int bj = 0; bj < 2; ++bj) { *(f32x4*)(p + bj * 128) = acc[ai][bj][m][0]; *(f32x4*)(p + bj * 128 + 4) = acc[ai][bj][m][1]; }
                }
            }
    }
};
struct EpiOut {
    const float* hin; float* hout; const float* gate;
    __device__ __forceinline__ void operator()(const f32x4 (&acc)[2][2][4][2], const pg8::Unit& u, int wr, int wc, int fr, int fq) const {
        const int col0 = u.pn * 256 + wc * 32 + 8 * fq; const float* gp = gate + (size_t)u.b * 6144 + col0;
        f32x4 gv[2][2];
#pragma unroll
        for (int bj = 0; bj < 2; ++bj)
#pragma unroll
            for (int n = 0; n < 2; ++n) gv[bj][n] = *(const f32x4*)(gp + bj * 128 + n * 4);
#pragma unroll
        for (int ai = 0; ai < 2; ++ai)
#pragma unroll
            for (int m = 0; m < 4; ++m) { const size_t off = (size_t)(u.row0 + ai * 128 + wr * 64 + m * 16 + fr) * D + col0;
#pragma unroll
                for (int bj = 0; bj < 2; ++bj)
#pragma unroll
                    for (int n = 0; n < 2; ++n) { const f32x4 hv = *(const f32x4*)(hin + off + bj * 128 + n * 4); *(f32x4*)(hout + off + bj * 128 + n * 4) = hv + gv[bj][n] * acc[ai][bj][m][n]; }
                if (m & 1) asm volatile("" ::: "memory"); }
    }
};
struct EpiG1 {
    unsigned char* act; const float* b1l;
    __device__ __forceinline__ void operator()(const f32x4 (&acc)[2][2][4][2], const pg8::Unit& u, int wr, int wc, int fr, int fq) const {
        const int ja0 = u.pn * 128 + wc * 32 + 8 * fq; const float* bp = b1l + (size_t)u.e * 2048 + 2 * ja0;
        f32x4 bg[2], bl[2];
#pragma unroll
        for (int n = 0; n < 2; ++n) { const f32x4 t0 = *(const f32x4*)(bp + 8 * n), t1 = *(const f32x4*)(bp + 8 * n + 4); bg[n] = (f32x4){t0[0], t0[2], t1[0], t1[2]}; bl[n] = (f32x4){t0[1], t0[3], t1[1], t1[3]}; }
#pragma unroll
        for (int ai = 0; ai < 2; ++ai)
#pragma unroll
            for (int m = 0; m < 4; ++m) { float o[8];
#pragma unroll
                for (int n = 0; n < 2; ++n) { const f32x4 hg = acc[ai][0][m][n] * (1.0f / W8SCALE) + bg[n], hl = acc[ai][1][m][n] * (1.0f / W8SCALE) + bl[n];
#pragma unroll
                    for (int j = 0; j < 4; ++j) { const float xg = fminf(hg[j], 7.0f), xl = fminf(fmaxf(hl[j], -7.0f), 7.0f); o[4 * n + j] = xg * sigmoidf_(1.702f * xg) * (xl + 1.0f); } }
                u32x2 w; w.x = pk4_fp8(o[0], o[1], o[2], o[3]); w.y = pk4_fp8(o[4], o[5], o[6], o[7]);
                *(u32x2*)(act + (size_t)(u.row0 + ai * 128 + wr * 64 + m * 16 + fr) * FF + ja0) = w; }
    }
};
struct EpiG2 {
    bf16_t* y; const float* b2l;
    __device__ __forceinline__ void operator()(const f32x4 (&acc)[2][2][4][2], const pg8::Unit& u, int wr, int wc, int fr, int fq) const {
        const int col0 = u.pn * 256 + wc * 32 + 8 * fq; const float* bp = b2l + (size_t)u.e * 1024 + col0;
        f32x4 bv[2][2];
#pragma unroll
        for (int bj = 0; bj < 2; ++bj)
#pragma unroll
            for (int n = 0; n < 2; ++n) bv[bj][n] = *(const f32x4*)(bp + bj * 128 + n * 4);
#pragma unroll
        for (int ai = 0; ai < 2; ++ai)
#pragma unroll
            for (int m = 0; m < 4; ++m) { bf16_t* rowp = y + (size_t)(u.row0 + ai * 128 + wr * 64 + m * 16 + fr) * D + col0;
#pragma unroll
                for (int bj = 0; bj < 2; ++bj) { const f32x4 v0 = acc[ai][bj][m][0] * (1.0f / W8SCALE) + bv[bj][0], v1 = acc[ai][bj][m][1] * (1.0f / W8SCALE) + bv[bj][1];
                    u32x4 w; w.x = pk2(v0[0], v0[1]); w.y = pk2(v0[2], v0[3]); w.z = pk2(v1[0], v1[1]); w.w = pk2(v1[2], v1[3]); *(u32x4*)(rowp + bj * 128) = w; } }
    }
};
__device__ __forceinline__ int slot32(int d) { return 16 * ((d >> 2) & 1) + 4 * ((d >> 3) & 3) + (d & 3); }
__device__ __forceinline__ int win_dest(int s) {
    if (s < 512) { const int hd = s >> 6, d64 = s & 63; return 256 * (hd >> 2) + 128 * (d64 >> 5) + 32 * (hd & 3) + slot32(d64 & 31); }
    if (s < 640) { const int hd = (s - 512) >> 6, d64 = s & 63; return 512 + 128 * (d64 >> 5) + 32 * hd + slot32(d64 & 31); }
    if (s < 768) { const int v = s - 640; return 512 + 128 * (v >> 6) + 32 * (2 + ((v & 63) >> 5)) + slot32(v & 31); }
    if (s < 1024) { const int hd = (s - 768) >> 6, d64 = s & 63; return 768 + 128 * (d64 >> 5) + 32 * hd + slot32(d64 & 31); }
    if (s < 1088) { const int d64 = s - 1024; return 1024 + 128 * (d64 >> 5) + slot32(d64 & 31); }
    if (s < 1092) return 1024 + 32 + (s - 1088);
    if (s < 1348) { const int v = s - 1092; return 1280 + (v & ~31) + slot32(v & 31); }
    { const int v = s - 1348; return 1536 + (v & ~31) + slot32(v & 31); }
}
__device__ __forceinline__ int perm_dest(int s) { return (s & ~31) + 16 * ((s >> 2) & 1) + 4 * ((s >> 3) & 3) + (s & 3); }
__device__ __forceinline__ int w1_dest(int s) { const int jg = s >> 1, isl = s & 1, nt = jg >> 7, ja = jg & 127; return 256 * nt + 128 * isl + (ja & ~31) + slot32(ja & 31); }

template <int MAP>
__device__ __forceinline__ void transpose_item(const float* W, int N, bf16_t* WT, LAS float* scr, int kb, int nb, int lane) {
    const int k0 = 64 * kb, n0 = 32 * nb, col = n0 + (lane & 31); const bool ok = col < N;
    float v[32];
    const float* src = W + (size_t)(k0 + (lane >> 5)) * N + (ok ? col : 0);
#pragma unroll
    for (int i = 0; i < 32; ++i) v[i] = src[(size_t)(2 * i) * N];
#pragma unroll
    for (int i = 0; i < 32; ++i) scr[(2 * i + (lane >> 5)) * 33 + (lane & 31)] = ok ? v[i] : 0.f;
    asm volatile("s_waitcnt lgkmcnt(0)" ::: "memory");
    const int c = lane & 7;
#pragma unroll
    for (int j = 0; j < 4; ++j) { const int n = (lane >> 3) + 8 * j; const LAS float* s = scr + (8 * c) * 33 + n;
        u32x4 o; o.x = pk2(s[0 * 33], s[1 * 33]); o.y = pk2(s[2 * 33], s[3 * 33]); o.z = pk2(s[4 * 33], s[5 * 33]); o.w = pk2(s[6 * 33], s[7 * 33]);
        const int sc = n0 + n;
        if (sc < N) { const int dest = MAP == 1 ? win_dest(sc) : (MAP == 2 ? w1_dest(sc) : (MAP == 3 ? perm_dest(sc) : sc)); *(u32x4*)(WT + (size_t)dest * 1024 + k0 + 8 * c) = o; } }
    asm volatile("s_waitcnt lgkmcnt(0)" ::: "memory");
}

__device__ __forceinline__ void phase_prep(const Args& a, Ctx& C) {
    unsigned char* ws = C.ws;
    {
        LAS float* ca = (LAS float*)C.lds;
        LAS float* red = ca + 4096;
        for (int i = C.tid; i < 4096; i += NTHREADS) { const float v = a.c[i]; ca[i] = siluf_(v); }
        __syncthreads();
        for (int it = blockIdx.x; it < 192; it += C.G) {
            const int l = it / 96, cb = it % 96, col = cb * 64 + (C.tid & 63), kg = C.tid >> 6;
            const float* w = a.w_ada + (size_t)l * 1024 * 6144 + col;
            float s0 = 0.f, s1 = 0.f, s2 = 0.f, s3 = 0.f;
#pragma unroll 8
            for (int k = kg * 128; k < kg * 128 + 128; ++k) { const float wv = w[(size_t)k * 6144]; s0 += ca[k] * wv; s1 += ca[1024 + k] * wv; s2 += ca[2048 + k] * wv; s3 += ca[3072 + k] * wv; }
            red[(kg * 4 + 0) * 64 + (C.tid & 63)] = s0; red[(kg * 4 + 1) * 64 + (C.tid & 63)] = s1; red[(kg * 4 + 2) * 64 + (C.tid & 63)] = s2; red[(kg * 4 + 3) * 64 + (C.tid & 63)] = s3;
            __syncthreads();
            if (C.tid < 256) { const int b = C.tid >> 6, cc = C.tid & 63; float s = 0.f;
#pragma unroll
                for (int g = 0; g < 8; ++g) s += red[(g * 4 + b) * 64 + cc];
                ((float*)(ws + WS_MOD))[(size_t)(l * 4 + b) * 6144 + cb * 64 + cc] = s + a.b_ada[l * 6144 + cb * 64 + cc]; }
            __syncthreads();
        }
    }
    const int gw = C.vcu * NWAVES + C.wave, NGW = C.G * NWAVES;
    for (int tk = gw; tk < NTOK; tk += NGW) {
        if (C.lane < 32) {
            const float posf = (float)a.pos[tk];
            const float inv = exp2f(-(float)C.lane * (13.287712379549449f / 32.0f));
            const double ang = (double)(posf * inv);
            const double kq = rint(ang * 0.63661977236758134308);
            const double y = fma(-kq, 1.57079632679489661923, ang);
            const double y2 = y * y;
            const double sy = y * (1.0 + y2 * (-1.0 / 6 + y2 * (1.0 / 120 + y2 * (-1.0 / 5040 + y2 * (1.0 / 362880 - y2 * (1.0 / 39916800))))));
            const double cy = 1.0 + y2 * (-0.5 + y2 * (1.0 / 24 + y2 * (-1.0 / 720 + y2 * (1.0 / 40320 + y2 * (-1.0 / 3628800 + y2 * (1.0 / 479001600))))));
            const int q = ((int)((long long)kq)) & 3;
            const double sn = (q == 0) ? sy : (q == 1) ? cy : (q == 2) ? -sy : -cy;
            const double cs = (q == 0) ? cy : (q == 1) ? -sy : (q == 2) ? -cy : sy;
            ((float*)(ws + WS_ROPEC))[(size_t)tk * 32 + C.lane] = (float)cs;
            ((float*)(ws + WS_ROPES))[(size_t)tk * 32 + C.lane] = (float)sn;
        }
    }
    for (int i = gw * 64 + C.lane; i < 2 * 32 * 1024; i += NGW * 64) { const int l = i >> 15, e = (i >> 10) & 31, k = i & 1023; const float wv = a.w_router[(size_t)l * 32768 + k * 32 + e];
        const unsigned hi = f2bf(wv); const float lo = wv - bf2f((unsigned short)hi); ((bf16_t*)(ws + WS_WRH))[i] = (bf16_t)hi; ((bf16_t*)(ws + WS_WRL))[i] = (bf16_t)f2bf(lo); }
    LAS float* scr = (LAS float*)(C.lds + C.wave * 16384);
    constexpr int I_IN = 2 * 16 * 75, I_OUT = 2 * 16 * 32;
    for (int it = gw; it < I_IN + I_OUT; it += NGW) {
        int r = it;
        if (r < I_IN) { const int l = r / (16 * 75), q = r % (16 * 75); transpose_item<1>(a.w_in + (size_t)l * 1024 * D_IN, D_IN, (bf16_t*)(ws + WS_WIN) + (size_t)l * NPAD * 1024, scr, q / 75, q % 75, C.lane); continue; }
        r -= I_IN;
        { const int l = r / (16 * 32), q = r % (16 * 32); transpose_item<3>(a.w_out + (size_t)l * 1024 * 1024, 1024, (bf16_t*)(ws + WS_WOUT) + (size_t)l * 1024 * 1024, scr, q / 32, q % 32, C.lane); }
    }
}

struct Conv {
    const float* w1l; const float* w2l; unsigned char* w1t; unsigned char* w2t;
    int it, step, lane; bool pend;
    const float* W; unsigned char* WT; int N, map, k0, n0;
    f32x4 v4[8];
    static constexpr int NITEMS = 32 * 16 * 64 + 32 * 16 * 32;
    int it_end;
    __device__ __forceinline__ void issue() {
        if (it >= it_end) return;
        if (it < 32 * 16 * 64) { const int e = it >> 10, q = it & 1023; W = w1l + (size_t)e * 1024 * 2048; WT = w1t + (size_t)e * 2048 * 1024; N = 2048; map = 2; k0 = 64 * (q >> 6); n0 = 32 * (q & 63); }
        else { const int r = it - 32 * 16 * 64, e = r >> 9, q = r & 511; W = w2l + (size_t)e * 1024 * 1024; WT = w2t + (size_t)e * 1024 * 1024; N = 1024; map = 3; k0 = 64 * (q >> 5); n0 = 32 * (q & 31); }
        const float* src = W + (size_t)(k0 + (lane >> 3)) * N + n0 + 4 * (lane & 7);
#pragma unroll
        for (int i = 0; i < 8; ++i) v4[i] = *(const f32x4*)(src + (size_t)(8 * i) * N);
        pend = true; it += step;
    }
    __device__ __forceinline__ void finish(LAS float* scr) {
        if (!pend) return;
#pragma unroll
        for (int i = 0; i < 8; ++i) { LAS float* d = scr + ((lane >> 3) + 8 * i) * 33 + 4 * (lane & 7); d[0] = v4[i].x; d[1] = v4[i].y; d[2] = v4[i].z; d[3] = v4[i].w; }
        asm volatile("s_waitcnt lgkmcnt(0)" ::: "memory");
        const int c = lane & 7;
#pragma unroll
        for (int j = 0; j < 4; ++j) { const int n = (lane >> 3) + 8 * j; const LAS float* sp = scr + (8 * c) * 33 + n;
            u32x2 o; o.x = pk4_fp8(sp[0 * 33] * W8SCALE, sp[1 * 33] * W8SCALE, sp[2 * 33] * W8SCALE, sp[3 * 33] * W8SCALE); o.y = pk4_fp8(sp[4 * 33] * W8SCALE, sp[5 * 33] * W8SCALE, sp[6 * 33] * W8SCALE, sp[7 * 33] * W8SCALE);
            const int sc = n0 + n; const int dest = map == 2 ? w1_dest(sc) : perm_dest(sc); *(u32x2*)(WT + (size_t)dest * 1024 + k0 + 8 * c) = o; }
        asm volatile("s_waitcnt lgkmcnt(0)" ::: "memory");
        pend = false;
    }
};

__device__ __forceinline__ void norm_mod_store(const f32x4 (&v)[4], const float* g, const float* sh, const float* sc, bf16_t* urow, int lane) {
    float ss = 0.f;
#pragma unroll
    for (int j = 0; j < 4; ++j) ss += (v[j].x * v[j].x + v[j].y * v[j].y) + (v[j].z * v[j].z + v[j].w * v[j].w);
    const float rstd = 1.0f / sqrtf(wave_sum(ss) * (1.0f / D) + EPS);
#pragma unroll
    for (int j = 0; j < 4; ++j) { const int idx = 4 * lane + 256 * j; const f32x4 gv = *(const f32x4*)(g + idx), shv = *(const f32x4*)(sh + idx), scv = *(const f32x4*)(sc + idx);
        const f32x4 o = v[j] * rstd * gv * (scv + 1.0f) + shv; u32x2 w; w.x = pk2(o[0], o[1]); w.y = pk2(o[2], o[3]); *(u32x2*)(urow + idx) = w; }
}

__device__ __forceinline__ void phase_u0(const Args& a, Ctx& C) {
    const int gw = C.vcu * NWAVES + C.wave, NGW = C.G * NWAVES; const float* mod = (const float*)(C.ws + WS_MOD);
    for (int tk0 = gw; tk0 < NTOK; tk0 += 2 * NGW) {
        const bool two = (tk0 + NGW) < NTOK; const int tk1 = two ? tk0 + NGW : tk0;
        const f32x4* x0 = (const f32x4*)(a.x + (size_t)tk0 * D) + C.lane; const f32x4* x1 = (const f32x4*)(a.x + (size_t)tk1 * D) + C.lane; f32x4 v0[4], v1[4];
#pragma unroll
        for (int j = 0; j < 4; ++j) { v0[j] = x0[64 * j]; v1[j] = x1[64 * j]; }
        { const float* mb = mod + (size_t)(tk0 >> 12) * 6144; norm_mod_store(v0, a.norm1_g, mb + 0, mb + 1024, (bf16_t*)(C.ws + WS_U) + (size_t)tk0 * D, C.lane); }
        if (two) { const float* mb = mod + (size_t)(tk1 >> 12) * 6144; norm_mod_store(v1, a.norm1_g, mb + 0, mb + 1024, (bf16_t*)(C.ws + WS_U) + (size_t)tk1 * D, C.lane); }
    }
}

__device__ __forceinline__ unsigned sortable(float f) { const unsigned u = __builtin_bit_cast(unsigned, f); return (u & 0x80000000u) ? ~u : (u | 0x80000000u); }
__device__ __forceinline__ int mbcnt64(unsigned long long m) { return __builtin_amdgcn_mbcnt_hi((unsigned)(m >> 32), __builtin_amdgcn_mbcnt_lo((unsigned)m, 0)); }

constexpr int HP = 65;
__device__ __forceinline__ int wave_isum(int v) {
    v += __builtin_amdgcn_update_dpp(0, v, 0xB1, 0xF, 0xF, true);
    v += __builtin_amdgcn_update_dpp(0, v, 0x4E, 0xF, 0xF, true);
    v += __builtin_amdgcn_update_dpp(0, v, 0x141, 0xF, 0xF, true);
    v += __builtin_amdgcn_update_dpp(0, v, 0x140, 0xF, 0xF, true);
    return __builtin_amdgcn_readlane(v, 0) + __builtin_amdgcn_readlane(v, 16) + __builtin_amdgcn_readlane(v, 32) + __builtin_amdgcn_readlane(v, 48);
}
typedef float f32x16 __attribute__((ext_vector_type(16)));
__device__ __forceinline__ void transpose32(unsigned (&a)[32]) {
#pragma unroll
    for (int st = 0; st < 5; ++st) {
        const int j = 16 >> st; const unsigned m = (st == 0) ? 0x0000FFFFu : (st == 1) ? 0x00FF00FFu : (st == 2) ? 0x0F0F0F0Fu : (st == 3) ? 0x33333333u : 0x55555555u;
#pragma unroll
        for (int idx = 0; idx < 16; ++idx) { const int k = (idx / j) * 2 * j + (idx % j); const unsigned t = (a[k] ^ (a[k + j] >> j)) & m; a[k] ^= t; a[k + j] ^= (t << j); }
    }
}
__device__ __forceinline__ int wave_iscan(int v) {
    v += __builtin_amdgcn_update_dpp(0, v, 0x111, 0xF, 0xF, true);
    v += __builtin_amdgcn_update_dpp(0, v, 0x112, 0xF, 0xF, true);
    v += __builtin_amdgcn_update_dpp(0, v, 0x114, 0xF, 0xF, true);
    v += __builtin_amdgcn_update_dpp(0, v, 0x118, 0xF, 0xF, true);
    v += __builtin_amdgcn_update_dpp(0, v, 0x142, 0xA, 0xF, false);
    v += __builtin_amdgcn_update_dpp(0, v, 0x143, 0xC, 0xF, false);
    return v;
}
__device__ __forceinline__ unsigned sortable16(unsigned h) { return (h & 0x8000u) ? (~h & 0xFFFFu) : (h | 0x8000u); }
__device__ __forceinline__ unsigned short f2h_bits(float f) { const _Float16 h = (_Float16)f; unsigned short b = __builtin_bit_cast(unsigned short, h); return b == 0x8000u ? (unsigned short)0 : b; }
template <int NB>
__device__ __forceinline__ void select_bits16(const LAS unsigned short* sq, int nj, int* sel, int lane) {
    unsigned a[32];
#pragma unroll
    for (int j = 0; j < 32; ++j) { const unsigned lo = sortable16(sq[64 * j + lane]); const unsigned hi = (NB == 2) ? sortable16(sq[64 * (32 + j) + lane]) : 0u; a[j] = lo | (hi << 16); }
    transpose32(a);
    unsigned Ml = 0xFFFFFFFFu, Mh = (NB == 2) ? 0xFFFFFFFFu : 0u, Gl = 0u, Gh = 0u; unsigned T = 0u; int G = 0;
#pragma unroll
    for (int bit = 15; bit >= 0; --bit) {
        const unsigned nl = Ml & a[31 - bit], nh = Mh & a[15 - bit];
        const int tot = wave_isum(__popc(nl) + __popc(nh));
        const bool take = (G + tot) >= 256; const unsigned flip = take ? 0u : 0xFFFFFFFFu;
        T |= take ? (1u << bit) : 0u; G += take ? 0 : tot;
        Gl |= nl & flip; Gh |= nh & flip; Ml &= (a[31 - bit] ^ flip); Mh &= (a[15 - bit] ^ flip);
    }
    const int need = 256 - G;
    if (T != 0x8000u) {
        const int ceq = __popc(Ml) + __popc(Mh); const int incl = wave_iscan(ceq);
        int quota = need - (incl - ceq); quota = quota < 0 ? 0 : (quota > ceq ? ceq : quota);
        const int cnt = __popc(Gl) + __popc(Gh) + quota; const int inc2 = wave_iscan(cnt);
        int pos = inc2 - cnt;
        { unsigned mk = Gl; while (mk) { const int x = 31 - __clz((int)mk); mk &= ~(1u << x); sel[pos++] = 64 * (31 - x) + lane; } }
        if (NB == 2) { unsigned mk = Gh; while (mk) { const int x = 31 - __clz((int)mk); mk &= ~(1u << x); sel[pos++] = 64 * (63 - x) + lane; } }
        { unsigned mk = Ml; while (mk && quota > 0) { const int x = 31 - __clz((int)mk); mk &= ~(1u << x); sel[pos++] = 64 * (31 - x) + lane; --quota; } }
        if (NB == 2) { unsigned mk = Mh; while (mk && quota > 0) { const int x = 31 - __clz((int)mk); mk &= ~(1u << x); sel[pos++] = 64 * (63 - x) + lane; --quota; } }
    } else {
        int base = 0, eqseen = 0;
#pragma unroll 1
        for (int j = 0; j < nj; ++j) {
            const unsigned kj = sortable16(sq[64 * j + lane]);
            const bool gt = kj > T, eq = kj == T; const unsigned long long em = __ballot(eq);
            const bool take = gt || (eq && (eqseen + mbcnt64(em)) < need); const unsigned long long tm = __ballot(take);
            if (take) sel[base + mbcnt64(tm)] = 64 * j + lane;
            base += __popcll(tm); eqseen += __popcll(em);
        }
    }
}
constexpr int CONV_SPLIT = 16384;
constexpr int KST_ROW = 144, KST_BYTES = 64 * KST_ROW;
__device__ __forceinline__ void index_unit2(Ctx& C, int b, int cch, int sub, Conv& cv) {
    unsigned char* ws = C.ws; const int lane = C.lane, w = C.wave;
    const int tk0 = b * SEQ + 64 * cch + 8 * sub, L = 64 * (cch + 1), nj = cch + 1;
    if (L <= 256) { int* sel = (int*)(ws + WS_SEL) + (size_t)(tk0 + w) * 256; for (int i = lane; i < L; i += 64) sel[i] = i; return; }
    LAS unsigned short* sclh = (LAS unsigned short*)C.lds;
    LAS unsigned char* kst = C.lds + 65536 + w * KST_BYTES;
    {
        const int r = lane & 31, hf = lane >> 5, qq = r >> 2, h = r & 3;
        bf16x8 aq[4];
#pragma unroll
        for (int ks = 0; ks < 4; ++ks) aq[ks] = *(const bf16x8*)((const bf16_t*)(ws + WS_QI) + (size_t)(tk0 + qq) * 256 + h * 64 + 16 * ks + 8 * hf);
        f32x4 wq[4];
#pragma unroll
        for (int g = 0; g < 4; ++g) wq[g] = *(const f32x4*)((const float*)(ws + WS_WI) + (size_t)(tk0 + 2 * g + hf) * 4);
        const unsigned char* kib = ws + WS_KI + (size_t)b * SEQ * 128;
        const int ntile = 2 * nj;
        u32x4 st[8];
#define IDX2_LOAD(kta) do { const int _t1 = (kta), _t2 = ((kta) + NWAVES) < ntile ? (kta) + NWAVES : (kta); _Pragma("unroll") for (int j = 0; j < 4; ++j) { \
            st[j] = *(const u32x4*)(kib + (size_t)_t1 * 4096 + 1024 * j + 16 * lane); st[4 + j] = *(const u32x4*)(kib + (size_t)_t2 * 4096 + 1024 * j + 16 * lane); } } while (0)
        if (w < ntile) IDX2_LOAD(w);
#pragma unroll 1
        for (int kt = w; kt < ntile; kt += 2 * NWAVES) {
            const bool two = (kt + NWAVES) < ntile; const int kt2 = two ? kt + NWAVES : kt;
#pragma unroll
            for (int j = 0; j < 4; ++j) { *(LAS u32x4*)(kst + (8 * j + (lane >> 3)) * KST_ROW + 16 * (lane & 7)) = st[j]; *(LAS u32x4*)(kst + (32 + 8 * j + (lane >> 3)) * KST_ROW + 16 * (lane & 7)) = st[4 + j]; }
            if ((kt + 2 * NWAVES) < ntile) IDX2_LOAD(kt + 2 * NWAVES);
            f32x16 acc, acc2;
#pragma unroll
            for (int i = 0; i < 16; ++i) { acc[i] = 0.f; acc2[i] = 0.f; }
#pragma unroll
            for (int ks = 0; ks < 4; ++ks) { const bf16x8 b1 = *(const LAS bf16x8*)(kst + r * KST_ROW + 32 * ks + 16 * hf), b2 = *(const LAS bf16x8*)(kst + (32 + r) * KST_ROW + 32 * ks + 16 * hf);
                acc = __builtin_amdgcn_mfma_f32_32x32x16_bf16(aq[ks], b1, acc, 0, 0, 0); acc2 = __builtin_amdgcn_mfma_f32_32x32x16_bf16(aq[ks], b2, acc2, 0, 0, 0); }
#pragma unroll
            for (int g = 0; g < 4; ++g) {
                const float sc = fmaxf(acc[4 * g + 0], 0.f) * wq[g][0] + fmaxf(acc[4 * g + 1], 0.f) * wq[g][1] + fmaxf(acc[4 * g + 2], 0.f) * wq[g][2] + fmaxf(acc[4 * g + 3], 0.f) * wq[g][3];
                sclh[(2 * g + hf) * 4096 + 32 * kt + r] = f2h_bits(sc);
                const float sc2 = fmaxf(acc2[4 * g + 0], 0.f) * wq[g][0] + fmaxf(acc2[4 * g + 1], 0.f) * wq[g][1] + fmaxf(acc2[4 * g + 2], 0.f) * wq[g][2] + fmaxf(acc2[4 * g + 3], 0.f) * wq[g][3];
                if (two) sclh[(2 * g + hf) * 4096 + 32 * kt2 + r] = f2h_bits(sc2);
            }
        }
#undef IDX2_LOAD
        const int njp = nj <= 32 ? 32 : 64;
        for (int j = nj; j < njp; ++j) sclh[w * 4096 + 64 * j + lane] = (unsigned short)0xFBFFu;
    }
    __syncthreads();
    {
        const LAS unsigned short* sq = sclh + w * 4096; int* sel = (int*)(ws + WS_SEL) + (size_t)(tk0 + w) * 256;
        cv.issue();
        if (nj <= 32) select_bits16<1>(sq, nj, sel, lane); else select_bits16<2>(sq, nj, sel, lane);
        cv.finish((LAS float*)kst);
    }
    __syncthreads();
}

typedef short s16x4 __attribute__((ext_vector_type(4)));
constexpr int VROW = 272;
__device__ __forceinline__ void attend_query_mfma(Ctx& C, int tk, LAS unsigned char* vs, Conv& cv) {
    unsigned char* ws = C.ws; const int lane = C.lane, c = lane & 15, g = lane >> 4;
    const int tpos = tk & (SEQ - 1), b = tk >> 12, L = 64 * ((tpos >> 6) + 1), nsel = L < 256 ? L : 256;
    const bf16_t* kb = (const bf16_t*)(ws + WS_K) + (size_t)b * SEQ * 128; const bf16_t* vb = (const bf16_t*)(ws + WS_V) + (size_t)b * SEQ * 128;
    int selr[4];
    { const int* sg = (const int*)(ws + WS_SEL) + (size_t)tk * 256;
#pragma unroll
      for (int i = 0; i < 4; ++i) selr[i] = (64 * i + lane) < nsel ? sg[64 * i + lane] : 0; }
    bf16x8 bq0[2], bq1[2];
    { const bf16_t* qp = (const bf16_t*)(ws + WS_Q) + (size_t)tk * 512 + (c & 7) * 64 + 8 * g; const bf16x8 z = (bf16x8){0, 0, 0, 0, 0, 0, 0, 0};
#pragma unroll
      for (int ks = 0; ks < 2; ++ks) { const bf16x8 q = *(const bf16x8*)(qp + 32 * ks); bq0[ks] = (c < 4) ? q : z; bq1[ks] = (c >= 4 && c < 8) ? q : z; } }
    cv.issue();
    f32x4 acc[16];
#pragma unroll
    for (int kt = 0; kt < 16; ++kt) {
        if ((kt & 3) == 0) asm volatile("" ::: "memory");
        const int key = __shfl(selr[kt >> 2], 16 * (kt & 3) + c);
        const bf16_t* kr = kb + (size_t)key * 128 + 8 * g;
        const bf16x8 a00 = *(const bf16x8*)(kr), a01 = *(const bf16x8*)(kr + 32), a10 = *(const bf16x8*)(kr + 64), a11 = *(const bf16x8*)(kr + 96);
        f32x4 t = (f32x4){0.f, 0.f, 0.f, 0.f};
        t = __builtin_amdgcn_mfma_f32_16x16x32_bf16(a00, bq0[0], t, 0, 0, 0); t = __builtin_amdgcn_mfma_f32_16x16x32_bf16(a01, bq0[1], t, 0, 0, 0);
        t = __builtin_amdgcn_mfma_f32_16x16x32_bf16(a10, bq1[0], t, 0, 0, 0); t = __builtin_amdgcn_mfma_f32_16x16x32_bf16(a11, bq1[1], t, 0, 0, 0);
        acc[kt] = t;
    }
    asm volatile("" ::: "memory"); cv.finish((LAS float*)vs); cv.issue();
    { const int lim = nsel - 4 * g;
#pragma unroll
      for (int kt = 0; kt < 16; ++kt)
#pragma unroll
        for (int r = 0; r < 4; ++r) acc[kt][r] = (16 * kt + r < lim) ? acc[kt][r] : -1e30f; }
    float m = -1e30f;
#pragma unroll
    for (int kt = 0; kt < 16; ++kt) m = fmaxf(m, fmaxf(fmaxf(acc[kt][0], acc[kt][1]), fmaxf(acc[kt][2], acc[kt][3])));
    m = fmaxf(m, __shfl_xor(m, 16)); m = fmaxf(m, __shfl_xor(m, 32));
    float sum = 0.f;
#pragma unroll
    for (int kt = 0; kt < 16; ++kt)
#pragma unroll
        for (int r = 0; r < 4; ++r) { const float pv = __expf(acc[kt][r] - m); acc[kt][r] = pv; sum += pv; }
    sum += __shfl_xor(sum, 16); sum += __shfl_xor(sum, 32);
    const float inv = 1.0f / sum;
    bf16x8 bp[8];
#pragma unroll
    for (int T = 0; T < 8; ++T) { u32x4 w; w.x = cvt_pk_bf16(acc[2 * T][0], acc[2 * T][1]); w.y = cvt_pk_bf16(acc[2 * T][2], acc[2 * T][3]); w.z = cvt_pk_bf16(acc[2 * T + 1][0], acc[2 * T + 1][1]); w.w = cvt_pk_bf16(acc[2 * T + 1][2], acc[2 * T + 1][3]);
        bp[T] = __builtin_bit_cast(bf16x8, w); }
    f32x4 ao0[4], ao1[4];
#pragma unroll
    for (int dt = 0; dt < 4; ++dt) { ao0[dt] = (f32x4){0.f, 0.f, 0.f, 0.f}; ao1[dt] = (f32x4){0.f, 0.f, 0.f, 0.f}; }
    const int q4 = c >> 2, p4 = c & 3;
    u32x4 vst[8];
#define ATT_VLOAD(T) do { _Pragma("unroll") for (int i = 0; i < 8; ++i) { const int row = g + 4 * i; \
        const int key = __shfl(selr[(T) >> 1], 32 * ((T) & 1) + row); vst[i] = *(const u32x4*)(vb + (size_t)key * 128 + 8 * c); } } while (0)
    ATT_VLOAD(0);
#pragma unroll
    for (int T = 0; T < 8; ++T) {
        LAS unsigned char* buf = vs + (T & 1) * (32 * VROW);
        asm volatile("" ::: "memory");
#pragma unroll
        for (int i = 0; i < 8; ++i) *(LAS u32x4*)(buf + (g + 4 * i) * VROW + 16 * c) = vst[i];
        if (T < 7) ATT_VLOAD(T + 1);
#pragma unroll
        for (int n = 0; n < 2; ++n)
#pragma unroll
            for (int dt = 0; dt < 4; ++dt) {
                LAS s16x4* p0 = (LAS s16x4*)(buf + (4 * g + q4) * VROW + (n * 64 + 16 * dt + 4 * p4) * 2);
                const s16x4 lo = __builtin_amdgcn_ds_read_tr16_b64_v4i16(p0), hi = __builtin_amdgcn_ds_read_tr16_b64_v4i16((LAS s16x4*)((LAS unsigned char*)p0 + 16 * VROW));
                const bf16x8 av = (bf16x8){lo[0], lo[1], lo[2], lo[3], hi[0], hi[1], hi[2], hi[3]};
                if (n == 0) ao0[dt] = __builtin_amdgcn_mfma_f32_16x16x32_bf16(av, bp[T], ao0[dt], 0, 0, 0);
                else ao1[dt] = __builtin_amdgcn_mfma_f32_16x16x32_bf16(av, bp[T], ao1[dt], 0, 0, 0);
            }
    }
#undef ATT_VLOAD
    asm volatile("" ::: "memory"); cv.finish((LAS float*)vs);
    if (c < 8) {
        bf16_t* mo = (bf16_t*)(ws + WS_MIX) + (size_t)tk * D + c * 64 + 4 * g;
#pragma unroll
        for (int dt = 0; dt < 4; ++dt) { f32x4 o; o[0] = (c < 4 ? ao0[dt][0] : ao1[dt][0]) * inv; o[1] = (c < 4 ? ao0[dt][1] : ao1[dt][1]) * inv; o[2] = (c < 4 ? ao0[dt][2] : ao1[dt][2]) * inv; o[3] = (c < 4 ? ao0[dt][3] : ao1[dt][3]) * inv; u32x2 w; w.x = cvt_pk_bf16(o[0], o[1]); w.y = cvt_pk_bf16(o[2], o[3]); *(u32x2*)(mo + 16 * dt) = w; }
    }
}

__device__ __forceinline__ void pool_wave(const Args& a, Ctx& C, int l) {
    unsigned char* ws = C.ws; const int lane = C.lane;
    const int gwv = blockIdx.x * NWAVES + C.wave, g = gwv & 3, widx = gwv >> 2, nw = (C.G * NWAVES) >> 2, w = 2 << g;
    float pwr[64];
#pragma unroll
    for (int c = 0; c < 64; ++c) pwr[c] = a.pool_w[(size_t)(l * 4 + g) * 4096 + c * 64 + lane];
    const float psc = a.pool_scale[l * 256 + g * 64 + lane];
    const float* ubg = (const float*)(ws + WS_UB) + g * 64 + lane;
    for (int tile = widx; tile < NTOK / 8; tile += nw) {
        const int tok0 = tile * 8, tp0 = tok0 & (SEQ - 1);
        float row[23];
#pragma unroll
        for (int r = 0; r < 23; ++r) { const int tp = tp0 - 15 + r; row[r] = (tp >= 0) ? ubg[(size_t)(tok0 - 15 + r) * 256] : 0.f; }
        float pooled[8];
#pragma unroll
        for (int t = 0; t < 8; ++t) {
            float sm = 0.f;
#pragma unroll
            for (int i = 0; i < 16; ++i) if (i < w) sm += row[15 + t - i];
            const int tpos = tp0 + t; const int wl = (tpos + 1) < w ? (tpos + 1) : w;
            pooled[t] = sm * (1.0f / (float)wl) - row[15 + t];
        }
        float y[8] = {0.f, 0.f, 0.f, 0.f, 0.f, 0.f, 0.f, 0.f};
#pragma unroll
        for (int c = 0; c < 64; ++c) {
#pragma unroll
            for (int t = 0; t < 8; ++t) y[t] += __builtin_bit_cast(float, __builtin_amdgcn_readlane(__builtin_bit_cast(int, pooled[t]), c)) * pwr[c];
        }
        bf16_t* mo = (bf16_t*)(ws + WS_MIX) + (size_t)tok0 * D + 512 + g * 64 + lane;
#pragma unroll
        for (int t = 0; t < 8; ++t) mo[(size_t)t * D] = (bf16_t)f2bf(y[t] * psc);
    }
}

__device__ __forceinline__ float row_shr_add(float x, int) { return x; }
template <int N> __device__ __forceinline__ float dpp_row_shr(float x) { return __builtin_bit_cast(float, __builtin_amdgcn_update_dpp(0, __builtin_bit_cast(int, x), 0x110 + N, 0xF, 0xF, true)); }
__device__ __forceinline__ float row_scan16(float x) { x += dpp_row_shr<1>(x); x += dpp_row_shr<2>(x); x += dpp_row_shr<4>(x); x += dpp_row_shr<8>(x); return x; }
__device__ __forceinline__ float row_last16(float x) { return __builtin_bit_cast(float, __builtin_amdgcn_update_dpp(0, __builtin_bit_cast(int, x), 0x15F, 0xF, 0xF, true)); }
__device__ __forceinline__ float row_sum16(float v) {
    v += __builtin_bit_cast(float, __builtin_amdgcn_update_dpp(0, __builtin_bit_cast(int, v), 0xB1, 0xF, 0xF, true));
    v += __builtin_bit_cast(float, __builtin_amdgcn_update_dpp(0, __builtin_bit_cast(int, v), 0x4E, 0xF, 0xF, true));
    v += __builtin_bit_cast(float, __builtin_amdgcn_update_dpp(0, __builtin_bit_cast(int, v), 0x141, 0xF, 0xF, true));
    v += __builtin_bit_cast(float, __builtin_amdgcn_update_dpp(0, __builtin_bit_cast(int, v), 0x140, 0xF, 0xF, true));
    return v;
}
__device__ __forceinline__ void hgrn_out3(const Args& a, Ctx& C, int l, int item, LAS unsigned char* kls) {
    const int lane = C.lane, tt = lane & 15, g = lane >> 4, c = item & 63, hh = (item >> 6) & 3, b = item >> 8, bh = b * 4 + hh, cg = c >> 2, ci = c & 3;
    const float* HG = (const float*)(C.ws + WS_HG); const float* HR = (const float*)(C.ws + WS_HL); const float* HE = (const float*)(C.ws + WS_HD);
    float lb[16];
#pragma unroll
    for (int e = 0; e < 16; ++e) { const int kk = hh * 64 + 16 * (e >> 2) + 4 * g + (e & 3); lb[e] = (l == 1) ? 1.0f / (1.0f + expf(a.lb_logits[kk] - a.lb_logits[256 + kk])) : 0.f; }
    f32x4 S[4][4];
#pragma unroll
    for (int vq = 0; vq < 4; ++vq)
#pragma unroll
        for (int kt = 0; kt < 4; ++kt) S[vq][kt] = (f32x4){0.f, 0.f, 0.f, 0.f};
    const int nstep = cg + (ci > 0 ? 1 : 0);
#pragma unroll 1
    for (int st = 0; st < nstep; ++st) {
        const int chn = (st < cg) ? (4 * st + 3) : (4 * cg + ci - 1); const size_t ch = (size_t)(bh * 64 + chn);
        const float* hr = HR + ch * 4096 + (g * 16 + tt) * 4; const float* he = HE + ch * 64 + 4 * g;
        f32x4 ev[4];
#pragma unroll
        for (int kt = 0; kt < 4; ++kt) ev[kt] = *(const f32x4*)(he + 16 * kt);
#pragma unroll
        for (int vq = 0; vq < 4; ++vq)
#pragma unroll
            for (int kt = 0; kt < 4; ++kt) S[vq][kt] = S[vq][kt] * ev[kt] + *(const f32x4*)(hr + (vq * 4 + kt) * 256);
    }
    const size_t tok0 = (size_t)b * SEQ + c * 64;
#pragma unroll 1
    for (int sb = 0; sb < 4; ++sb) {
        const size_t tok = tok0 + 16 * sb + tt; const float* row = HG + tok * 1024 + hh * 64 + 4 * g;
        float qh[16], kt_[16], kp[16], dd[16];
#pragma unroll
        for (int e4 = 0; e4 < 4; ++e4) {
            const f32x4 q4 = *(const f32x4*)(row + 16 * e4), z4 = *(const f32x4*)(row + 256 + 16 * e4);
#pragma unroll
            for (int j = 0; j < 4; ++j) { const int e = 4 * e4 + j; const float lbe = lb[e];
                const float sg = __builtin_amdgcn_rcpf(1.0f + __expf(-z4[j])), sn = __builtin_amdgcn_rcpf(1.0f + __expf(z4[j]));
                const float lf = __logf(lbe + (1.0f - lbe) * sg), kin = (1.0f - lbe) * sn;
                const float cc = row_scan16(lf), c15 = row_last16(cc);
                qh[e] = siluf_(q4[j]) * __expf(cc); kt_[e] = kin * __expf(fminf(-cc, 80.0f)); kp[e] = kin * __expf(c15 - cc); dd[e] = __expf(c15); }
        }
        bf16x8 Qf[2], Kf[2];
#pragma unroll
        for (int ks = 0; ks < 2; ++ks) { u32x4 wq, wk;
            wq.x = pk2(qh[8 * ks + 0], qh[8 * ks + 1]); wq.y = pk2(qh[8 * ks + 2], qh[8 * ks + 3]); wq.z = pk2(qh[8 * ks + 4], qh[8 * ks + 5]); wq.w = pk2(qh[8 * ks + 6], qh[8 * ks + 7]);
            wk.x = pk2(kt_[8 * ks + 0], kt_[8 * ks + 1]); wk.y = pk2(kt_[8 * ks + 2], kt_[8 * ks + 3]); wk.z = pk2(kt_[8 * ks + 4], kt_[8 * ks + 5]); wk.w = pk2(kt_[8 * ks + 6], kt_[8 * ks + 7]);
            Qf[ks] = __builtin_bit_cast(bf16x8, wq); Kf[ks] = __builtin_bit_cast(bf16x8, wk); }
#pragma unroll
        for (int e4 = 0; e4 < 4; ++e4) { u32x2 w; w.x = pk2(kp[4 * e4 + 0], kp[4 * e4 + 1]); w.y = pk2(kp[4 * e4 + 2], kp[4 * e4 + 3]); *(LAS u32x2*)(kls + tt * 144 + (16 * e4 + 4 * g) * 2) = w; }
        f32x4 at = (f32x4){0.f, 0.f, 0.f, 0.f};
        at = __builtin_amdgcn_mfma_f32_16x16x32_bf16(Kf[0], Qf[0], at, 0, 0, 0); at = __builtin_amdgcn_mfma_f32_16x16x32_bf16(Kf[1], Qf[1], at, 0, 0, 0);
#pragma unroll
        for (int r = 0; r < 4; ++r) at[r] = (4 * g + r <= tt) ? at[r] : 0.f;
        u32x4 wa; wa.x = pk2(at[0], at[1]); wa.y = pk2(at[2], at[3]); wa.z = 0u; wa.w = 0u; const bf16x8 Af = __builtin_bit_cast(bf16x8, wa);
        bf16x8 Vf[4];
        { const float* vp = HG + (tok0 + 16 * sb + 4 * g) * 1024 + 512 + hh * 64 + tt;
#pragma unroll
          for (int vq = 0; vq < 4; ++vq) { u32x4 w; w.x = pk2(vp[16 * vq], vp[1024 + 16 * vq]); w.y = pk2(vp[2048 + 16 * vq], vp[3072 + 16 * vq]); w.z = 0u; w.w = 0u; Vf[vq] = __builtin_bit_cast(bf16x8, w); } }
        f32x4 O[4];
#pragma unroll
        for (int vq = 0; vq < 4; ++vq) {
            u32x4 s0, s1; s0.x = pk2(S[vq][0][0], S[vq][0][1]); s0.y = pk2(S[vq][0][2], S[vq][0][3]); s0.z = pk2(S[vq][1][0], S[vq][1][1]); s0.w = pk2(S[vq][1][2], S[vq][1][3]);
            s1.x = pk2(S[vq][2][0], S[vq][2][1]); s1.y = pk2(S[vq][2][2], S[vq][2][3]); s1.z = pk2(S[vq][3][0], S[vq][3][1]); s1.w = pk2(S[vq][3][2], S[vq][3][3]);
            f32x4 o = (f32x4){0.f, 0.f, 0.f, 0.f};
            o = __builtin_amdgcn_mfma_f32_16x16x32_bf16(Qf[0], __builtin_bit_cast(bf16x8, s0), o, 0, 0, 0); o = __builtin_amdgcn_mfma_f32_16x16x32_bf16(Qf[1], __builtin_bit_cast(bf16x8, s1), o, 0, 0, 0);
            o = __builtin_amdgcn_mfma_f32_16x16x32_bf16(Af, Vf[vq], o, 0, 0, 0); O[vq] = o; }
        { float rs[4];
#pragma unroll
          for (int r = 0; r < 4; ++r) { float ss = O[0][r] * O[0][r] + O[1][r] * O[1][r] + O[2][r] * O[2][r] + O[3][r] * O[3][r]; ss = row_sum16(ss); rs[r] = 1.0f / sqrtf(ss * (1.0f / 64.0f) + EPS); }
          const float* gp = HG + (tok0 + 16 * sb + 4 * g) * 1024 + 768 + hh * 64 + tt; bf16_t* mo = (bf16_t*)(C.ws + WS_MIX) + (tok0 + 16 * sb + 4 * g) * D + 768 + hh * 64 + tt;
#pragma unroll
          for (int vq = 0; vq < 4; ++vq) { const float ngv = a.hgrn_g[l * 64 + 16 * vq + tt];
#pragma unroll
            for (int r = 0; r < 4; ++r) mo[(size_t)r * D + 16 * vq] = (bf16_t)f2bf(O[vq][r] * rs[r] * ngv * siluf_(gp[(size_t)r * 1024 + 16 * vq])); } }
        asm volatile("s_waitcnt lgkmcnt(0)" ::: "memory");
#pragma unroll
        for (int kt = 0; kt < 4; ++kt) {
            const s16x4 t4 = __builtin_amdgcn_ds_read_tr16_b64_v4i16((LAS s16x4*)(kls + (4 * g + (tt >> 2)) * 144 + (16 * kt + 4 * (tt & 3)) * 2));
            const bf16x8 Ktf = (bf16x8){t4[0], t4[1], t4[2], t4[3], 0, 0, 0, 0};
            const f32x4 dv = (f32x4){dd[4 * kt + 0], dd[4 * kt + 1], dd[4 * kt + 2], dd[4 * kt + 3]};
#pragma unroll
            for (int vq = 0; vq < 4; ++vq) S[vq][kt] = __builtin_amdgcn_mfma_f32_16x16x32_bf16(Ktf, Vf[vq], S[vq][kt] * dv, 0, 0, 0);
        }
        asm volatile("s_waitcnt lgkmcnt(0)" ::: "memory");
    }
}

__device__ __forceinline__ void hgrn_local4(const Args& a, Ctx& C, int l, int item, LAS unsigned char* kls) {
    const int lane = C.lane, tt = lane & 15, g = lane >> 4, vq = item & 3, cg = (item >> 2) & 15, hh = (item >> 6) & 3, b = item >> 8, bh = b * 4 + hh;
    const float* HG = (const float*)(C.ws + WS_HG);
    float lb[16], ecum[16];
#pragma unroll
    for (int e = 0; e < 16; ++e) { const int kk = hh * 64 + 16 * (e >> 2) + 4 * g + (e & 3); lb[e] = (l == 1) ? 1.0f / (1.0f + expf(a.lb_logits[kk] - a.lb_logits[256 + kk])) : 0.f; ecum[e] = 1.0f; }
    f32x4 S[4];
#pragma unroll
    for (int kt = 0; kt < 4; ++kt) S[kt] = (f32x4){0.f, 0.f, 0.f, 0.f};
    const size_t tokg = (size_t)b * SEQ + (size_t)cg * 256;
    f32x4 zc[4]; float vc[4];
#define HL4_LOAD(zd, vd, sbi) do { const size_t _t0 = tokg + 16 * (sbi); const float* _r = HG + (_t0 + tt) * 1024 + hh * 64 + 4 * g + 256; \
        _Pragma("unroll") for (int e4 = 0; e4 < 4; ++e4) zd[e4] = *(const f32x4*)(_r + 16 * e4); \
        const float* _v = HG + (_t0 + 4 * g) * 1024 + 512 + hh * 64 + 16 * vq + tt; vd[0] = _v[0]; vd[1] = _v[1024]; vd[2] = _v[2048]; vd[3] = _v[3072]; } while (0)
    HL4_LOAD(zc, vc, 0);
#pragma unroll 1
    for (int ci = 0; ci < 4; ++ci) {
        const int c = 4 * cg + ci;
#pragma unroll 1
        for (int sb = 0; sb < 4; ++sb) {
            const int sbi = 4 * ci + sb; f32x4 zn[4]; float vn[4];
            if (sbi < 15) HL4_LOAD(zn, vn, sbi + 1); else {
#pragma unroll
                for (int e4 = 0; e4 < 4; ++e4) { zn[e4] = zc[e4]; vn[e4] = vc[e4]; } }
            float kp[16], dd[16];
#pragma unroll
            for (int e4 = 0; e4 < 4; ++e4) { const f32x4 z4 = zc[e4];
#pragma unroll
                for (int j = 0; j < 4; ++j) { const int e = 4 * e4 + j; const float lbe = lb[e];
                    const float sg = __builtin_amdgcn_rcpf(1.0f + __expf(-z4[j])), sn = __builtin_amdgcn_rcpf(1.0f + __expf(z4[j]));
                    const float lf = __logf(lbe + (1.0f - lbe) * sg), kin = (1.0f - lbe) * sn;
                    const float cc = row_scan16(lf), c15 = row_last16(cc);
                    kp[e] = kin * __expf(c15 - cc); dd[e] = __expf(c15); ecum[e] *= dd[e]; } }
#pragma unroll
            for (int e4 = 0; e4 < 4; ++e4) { u32x2 w; w.x = pk2(kp[4 * e4 + 0], kp[4 * e4 + 1]); w.y = pk2(kp[4 * e4 + 2], kp[4 * e4 + 3]); *(LAS u32x2*)(kls + tt * 144 + (16 * e4 + 4 * g) * 2) = w; }
            bf16x8 Vf; { u32x4 w; w.x = pk2(vc[0], vc[1]); w.y = pk2(vc[2], vc[3]); w.z = 0u; w.w = 0u; Vf = __builtin_bit_cast(bf16x8, w); }
            asm volatile("s_waitcnt lgkmcnt(0)" ::: "memory");
#pragma unroll
            for (int kt = 0; kt < 4; ++kt) {
                const s16x4 t4 = __builtin_amdgcn_ds_read_tr16_b64_v4i16((LAS s16x4*)(kls + (4 * g + (tt >> 2)) * 144 + (16 * kt + 4 * (tt & 3)) * 2));
                const bf16x8 Ktf = (bf16x8){t4[0], t4[1], t4[2], t4[3], 0, 0, 0, 0};
                const f32x4 dv = (f32x4){dd[4 * kt + 0], dd[4 * kt + 1], dd[4 * kt + 2], dd[4 * kt + 3]};
                S[kt] = __builtin_amdgcn_mfma_f32_16x16x32_bf16(Ktf, Vf, S[kt] * dv, 0, 0, 0);
            }
            asm volatile("s_waitcnt lgkmcnt(0)" ::: "memory");
#pragma unroll
            for (int e4 = 0; e4 < 4; ++e4) { zc[e4] = zn[e4]; vc[e4] = vn[e4]; }
        }
        const size_t ch = (size_t)(bh * 64 + c);
        float* hr = (float*)(C.ws + WS_HL) + ch * 4096 + (g * 16 + tt) * 4;
#pragma unroll
        for (int kt = 0; kt < 4; ++kt) *(f32x4*)(hr + (vq * 4 + kt) * 256) = S[kt];
        if (vq == 0 && tt == 0) { float* he = (float*)(C.ws + WS_HD) + ch * 64 + 4 * g;
#pragma unroll
            for (int kt = 0; kt < 4; ++kt) *(f32x4*)(he + 16 * kt) = (f32x4){ecum[4 * kt + 0], ecum[4 * kt + 1], ecum[4 * kt + 2], ecum[4 * kt + 3]}; }
    }
#undef HL4_LOAD
}

__device__ __forceinline__ void phase_mix1(const Args& a, Ctx& C, int l) {
    if (C.wave < 4) for (int it = blockIdx.x * 4 + C.wave; it < 1024; it += C.G * 4) hgrn_local4(a, C, l, it, C.lds + C.wave * 4096);
    __syncthreads();
    pool_wave(a, C, l);
    __syncthreads();
    Conv cv; cv.w1l = a.w1 + (size_t)l * 32 * 1024 * 2048; cv.w2l = a.w2 + (size_t)l * 32 * 1024 * 1024; cv.w1t = C.ws + WS_W1 + (size_t)l * 32 * 2048 * 1024; cv.w2t = C.ws + WS_W2 + (size_t)l * 32 * 1024 * 1024;
    cv.it = blockIdx.x * NWAVES + C.wave; cv.step = C.G * NWAVES; cv.lane = C.lane; cv.pend = false; cv.it_end = CONV_SPLIT;
    for (int base = 0; base < 2048; base += 2 * C.G) {
        const int u1 = base + (int)blockIdx.x, u2 = base + 2 * C.G - 1 - (int)blockIdx.x;
        if (u1 < 2048) index_unit2(C, (u1 >> 3) & 3, u1 >> 5, u1 & 7, cv);
        if (u2 < 2048) index_unit2(C, (u2 >> 3) & 3, u2 >> 5, u2 & 7, cv);
    }
    for (;;) { cv.issue(); if (!cv.pend) break; cv.finish((LAS float*)(C.lds + 65536 + C.wave * KST_BYTES)); }
}
__device__ __forceinline__ void phase_mix2(const Args& a, Ctx& C, int l) {
    LAS int* qctr = (LAS int*)(C.lds + LDS_BYTES - 64 + 16);
    if (C.tid == 0) *qctr = 0;
    __syncthreads();
    if (C.wave < 4) for (int it = blockIdx.x * 4 + C.wave; it < 1024; it += C.G * 4) hgrn_out3(a, C, l, it, C.lds + C.wave * (2 * 32 * VROW));
    LAS unsigned char* vs = C.lds + C.wave * (2 * 32 * VROW);
    const int gw = blockIdx.x * NWAVES + C.wave, NGW = C.G * NWAVES;
    Conv cv; cv.w1l = a.w1 + (size_t)l * 32 * 1024 * 2048; cv.w2l = a.w2 + (size_t)l * 32 * 1024 * 1024; cv.w1t = C.ws + WS_W1 + (size_t)l * 32 * 2048 * 1024; cv.w2t = C.ws + WS_W2 + (size_t)l * 32 * 1024 * 1024;
    cv.it = CONV_SPLIT + gw; cv.step = NGW; cv.lane = C.lane; cv.pend = false; cv.it_end = Conv::NITEMS;
    for (;;) {
        int n = 0; if (C.lane == 0) n = __hip_atomic_fetch_add(qctr, 1, __ATOMIC_RELAXED, __HIP_MEMORY_SCOPE_WORKGROUP);
        n = __builtin_amdgcn_readfirstlane(n);
        const int tk = (int)blockIdx.x * NWAVES + (n & 7) + NGW * (n >> 3);
        if (tk >= NTOK) break;
        attend_query_mfma(C, tk, vs, cv);
    }
    for (;;) { cv.finish((LAS float*)vs); cv.issue(); if (!cv.pend) break; }
}

constexpr int URS = 2064;
__device__ __forceinline__ void phase_router2(const Args& a, Ctx& C, int l) {
    unsigned char* ws = C.ws; const int lane = C.lane, w = C.wave, tid = C.tid;
    LAS unsigned char* uh = C.lds; LAS unsigned char* ul = uh + 16 * URS; LAS float* part = (LAS float*)(ul + 16 * URS);
    LAS int* hist = (LAS int*)(part + 8 * 16 * 32);
    LAS int* asg = hist + 64;
    LAS float* asgg = (LAS float*)(asg + 2 * 1024);
    const float* mod = (const float*)(ws + WS_MOD); const float* H = (const float*)(ws + WS_H);
    const bf16_t* wrh = (const bf16_t*)(ws + WS_WRH) + (size_t)l * 32768; const bf16_t* wrl = (const bf16_t*)(ws + WS_WRL) + (size_t)l * 32768;
    unsigned* cnt = (unsigned*)(ws + WS_CTL) + CW_CNT + l * 32 * 64;
    const int ntile_all = NTOK / 16;
    bf16x8 wbh0[4], wbl0[4], wbh1[4], wbl1[4];
    { const int c = lane & 15, g = lane >> 4;
#pragma unroll
      for (int kk = 0; kk < 4; ++kk) { const int ks = 4 * w + kk;
          wbh0[kk] = *(const bf16x8*)(wrh + (size_t)c * 1024 + 32 * ks + 8 * g); wbl0[kk] = *(const bf16x8*)(wrl + (size_t)c * 1024 + 32 * ks + 8 * g);
          wbh1[kk] = *(const bf16x8*)(wrh + (size_t)(c + 16) * 1024 + 32 * ks + 8 * g); wbl1[kk] = *(const bf16x8*)(wrl + (size_t)(c + 16) * 1024 + 32 * ks + 8 * g); } }
    for (int tile0 = blockIdx.x; tile0 < ntile_all; tile0 += 16 * C.G) {
        if (tid < 64) hist[tid] = 0;
        __syncthreads();
        int nt_here = 0;
        f32x4 hv[2][4];
#pragma unroll
        for (int hf = 0; hf < 2; ++hf) { const f32x4* hr = (const f32x4*)(H + (size_t)(tile0 * 16 + 2 * w + hf) * D) + lane;
#pragma unroll
            for (int j = 0; j < 4; ++j) hv[hf][j] = hr[64 * j]; }
        for (int tile = tile0; tile < ntile_all && nt_here < 16; tile += C.G, ++nt_here) {
            const int tok0 = tile * 16;
#pragma unroll
            for (int hf = 0; hf < 2; ++hf) {
                const int tr = 2 * w + hf, tk = tok0 + tr, b = tk >> 12; f32x4 v[4];
#pragma unroll
                for (int j = 0; j < 4; ++j) v[j] = hv[hf][j];
                float ss = 0.f;
#pragma unroll
                for (int j = 0; j < 4; ++j) ss += (v[j].x * v[j].x + v[j].y * v[j].y) + (v[j].z * v[j].z + v[j].w * v[j].w);
                const float rstd = 1.0f / sqrtf(wave_sum(ss) * (1.0f / D) + EPS);
                const float* mb = mod + (size_t)(l * 4 + b) * 6144; unsigned char* u8row = ws + WS_U + (size_t)tk * D;
#pragma unroll
                for (int j = 0; j < 4; ++j) { const int idx = 4 * lane + 256 * j; const f32x4 gv = *(const f32x4*)(a.norm2_g + l * 1024 + idx), shv = *(const f32x4*)(mb + 3072 + idx), scv = *(const f32x4*)(mb + 4096 + idx);
                    const f32x4 o = v[j] * rstd * gv * (scv + 1.0f) + shv; u32x2 hi; hi.x = pk2(o[0], o[1]); hi.y = pk2(o[2], o[3]); *(unsigned*)(u8row + idx) = pk4_fp8(o[0], o[1], o[2], o[3]);
                    u32x2 lo; lo.x = pk2(o[0] - bflo(hi.x), o[1] - bfhi(hi.x)); lo.y = pk2(o[2] - bflo(hi.y), o[3] - bfhi(hi.y));
                    *(LAS u32x2*)(uh + tr * URS + idx * 2) = hi; *(LAS u32x2*)(ul + tr * URS + idx * 2) = lo; }
            }
            { const int ntile2 = tile + C.G; if (ntile2 < ntile_all && nt_here + 1 < 16) {
#pragma unroll
                for (int hf = 0; hf < 2; ++hf) { const f32x4* hr = (const f32x4*)(H + (size_t)(ntile2 * 16 + 2 * w + hf) * D) + lane;
#pragma unroll
                    for (int j = 0; j < 4; ++j) hv[hf][j] = hr[64 * j]; } } }
            __syncthreads();
            {
                const int c = lane & 15, g = lane >> 4; f32x4 acc0 = (f32x4){0.f, 0.f, 0.f, 0.f}, acc1 = acc0;
#pragma unroll
                for (int kk = 0; kk < 4; ++kk) { const int ks = 4 * w + kk;
                    const bf16x8 ah = *(const LAS bf16x8*)(uh + c * URS + (32 * ks + 8 * g) * 2), al = *(const LAS bf16x8*)(ul + c * URS + (32 * ks + 8 * g) * 2);
                    acc0 = __builtin_amdgcn_mfma_f32_16x16x32_bf16(al, wbh0[kk], acc0, 0, 0, 0); acc0 = __builtin_amdgcn_mfma_f32_16x16x32_bf16(ah, wbl0[kk], acc0, 0, 0, 0); acc0 = __builtin_amdgcn_mfma_f32_16x16x32_bf16(ah, wbh0[kk], acc0, 0, 0, 0);
                    acc1 = __builtin_amdgcn_mfma_f32_16x16x32_bf16(al, wbh1[kk], acc1, 0, 0, 0); acc1 = __builtin_amdgcn_mfma_f32_16x16x32_bf16(ah, wbl1[kk], acc1, 0, 0, 0); acc1 = __builtin_amdgcn_mfma_f32_16x16x32_bf16(ah, wbh1[kk], acc1, 0, 0, 0); }
#pragma unroll
                for (int r = 0; r < 4; ++r) { part[(w * 16 + 4 * g + r) * 32 + c] = acc0[r]; part[(w * 16 + 4 * g + r) * 32 + 16 + c] = acc1[r]; }
            }
            __syncthreads();
            {
                const int e = lane & 31, hf = lane >> 5, tr = 2 * w + hf; float val = a.b_router[l * 32 + e];
#pragma unroll
                for (int ww = 0; ww < 8; ++ww) val += part[(ww * 16 + tr) * 32 + e];
                float tv[4]; int te[4];
#pragma unroll
                for (int k = 0; k < 4; ++k) {
                    float bv = val; int bi = e;
#pragma unroll
                    for (int o = 1; o < 32; o <<= 1) { const float ov = __shfl_xor(bv, o); const int oi = __shfl_xor(bi, o); if (ov > bv || (ov == bv && oi < bi)) { bv = ov; bi = oi; } }
                    tv[k] = bv; te[k] = bi; if (e == bi) val = -3.0e38f;
                }
                const float e1 = __expf(tv[1] - tv[0]), e2 = __expf(tv[2] - tv[0]), e3 = __expf(tv[3] - tv[0]); const float rs = 1.0f / (1.0f + e1 + e2 + e3);
                if (e < 4) {
                    const int ex = e == 0 ? te[0] : e == 1 ? te[1] : e == 2 ? te[2] : te[3]; const float gt = (e == 0 ? 1.0f : e == 1 ? e1 : e == 2 ? e2 : e3) * rs;
                    const int ai = (nt_here * 16 + tr) * 4 + e;
                    asg[2 * ai] = ex; asg[2 * ai + 1] = __hip_atomic_fetch_add(&hist[ex], 1, __ATOMIC_RELAXED, __HIP_MEMORY_SCOPE_WORKGROUP); asgg[ai] = gt;
                }
            }
            __syncthreads();
        }
        if (tid < 32) { const int hc = hist[tid]; hist[32 + tid] = hc ? (int)atomicAdd(cnt + tid * 64, (unsigned)hc) : 0; }
        __syncthreads();
        for (int ai = tid; ai < nt_here * 64; ai += NTHREADS) {
            const int ti = ai >> 6, tr = (ai >> 2) & 15, k = ai & 3, tk = (tile0 + ti * C.G) * 16 + tr;
            const int ex = asg[2 * ai], slot = hist[32 + ex] + asg[2 * ai + 1];
            ((int*)(ws + WS_ROWTOK))[(size_t)ex * NTOK + slot] = tk;
            ((int*)(ws + WS_EIDX))[tk * 4 + k] = ex; ((int*)(ws + WS_SLOT))[tk * 4 + k] = slot; ((float*)(ws + WS_GATE))[tk * 4 + k] = asgg[ai];
        }
        __syncthreads();
    }
}

__device__ __forceinline__ void moe_table(Ctx& C, int l, LAS int* tab) {
    if (C.tid < 32) { const unsigned* cnt = (const unsigned*)(C.ws + WS_CTL) + CW_CNT + l * 32 * 64; tab[33 + C.tid] = (int)__hip_atomic_load(cnt + C.tid * 64, __ATOMIC_RELAXED, __HIP_MEMORY_SCOPE_AGENT); }
    __syncthreads();
    if (C.tid == 0) { int p = 0; for (int e = 0; e < 32; ++e) { tab[e] = p; p += (tab[33 + e] + 255) >> 8; } tab[32] = p; }
    __syncthreads();
}

__device__ __forceinline__ void phase_combine(const Args& a, Ctx& C, int l) {
    unsigned char* ws = C.ws; const int lane = C.lane;
    const float* mod = (const float*)(ws + WS_MOD); float* H = (float*)(ws + WS_H); const bf16_t* Y = (const bf16_t*)(ws + WS_Y);
    const unsigned* cnt = (const unsigned*)(ws + WS_CTL) + CW_CNT + l * 32 * 64;
    int mt = 0; if (lane < 32) mt = ((int)__hip_atomic_load(cnt + lane * 64, __ATOMIC_RELAXED, __HIP_MEMORY_SCOPE_AGENT) + 255) >> 8;
    int incl = mt;
#pragma unroll
    for (int o = 1; o < 32; o <<= 1) { const int t = __shfl_up(incl, o); if ((lane & 31) >= o) incl += t; }
    const int excl = incl - mt;
    const int gw = blockIdx.x * NWAVES + C.wave, NGW = C.G * NWAVES;
    for (int tk0 = gw; tk0 < NTOK; tk0 += 2 * NGW) {
        int tks[2]; tks[0] = tk0; tks[1] = (tk0 + NGW) < NTOK ? tk0 + NGW : tk0; const bool two = (tk0 + NGW) < NTOK;
        f32x4 v[2][4]; u32x2 yv[2][4][4]; float gts[2][4];
#pragma unroll
        for (int q = 0; q < 2; ++q) { const int tk = tks[q]; const f32x4* hr = (const f32x4*)(H + (size_t)tk * D) + lane;
#pragma unroll
            for (int j = 0; j < 4; ++j) v[q][j] = hr[64 * j];
            const int4 ex4 = *(const int4*)((const int*)(ws + WS_EIDX) + tk * 4), sl4 = *(const int4*)((const int*)(ws + WS_SLOT) + tk * 4); const f32x4 g4 = *(const f32x4*)((const float*)(ws + WS_GATE) + tk * 4);
            const int exs[4] = {ex4.x, ex4.y, ex4.z, ex4.w}, sls[4] = {sl4.x, sl4.y, sl4.z, sl4.w};
#pragma unroll
            for (int k = 0; k < 4; ++k) { gts[q][k] = g4[k]; const int row = 256 * __shfl(excl, exs[k]) + sls[k]; const u32x2* yr = (const u32x2*)(Y + (size_t)row * D) + lane;
#pragma unroll
                for (int j = 0; j < 4; ++j) yv[q][k][j] = yr[64 * j]; }
        }
#pragma unroll
        for (int q = 0; q < 2; ++q) {
            if (q == 1 && !two) break;
            const int tk = tks[q], b = tk >> 12; f32x4* hr = (f32x4*)(H + (size_t)tk * D) + lane;
            f32x4 m[4];
#pragma unroll
            for (int j = 0; j < 4; ++j) m[j] = (f32x4){0.f, 0.f, 0.f, 0.f};
#pragma unroll
            for (int k = 0; k < 4; ++k)
#pragma unroll
                for (int j = 0; j < 4; ++j) { const u32x2 w = yv[q][k][j]; m[j] += (f32x4){bflo(w.x), bfhi(w.x), bflo(w.y), bfhi(w.y)} * gts[q][k]; }
            const float* mb = mod + (size_t)(l * 4 + b) * 6144;
            f32x4 vv[4];
#pragma unroll
            for (int j = 0; j < 4; ++j) { const f32x4 g2 = *(const f32x4*)(mb + 5120 + 4 * lane + 256 * j); vv[j] = v[q][j] + g2 * m[j]; if (l + 1 < DEPTH) hr[64 * j] = vv[j]; }
            if (l + 1 < DEPTH) { const float* mn = mod + (size_t)((l + 1) * 4 + b) * 6144; norm_mod_store(vv, a.norm1_g + (l + 1) * 1024, mn + 0, mn + 1024, (bf16_t*)(ws + WS_U) + (size_t)tk * D, lane); }
            else {
                float ss = 0.f;
#pragma unroll
                for (int j = 0; j < 4; ++j) ss += (vv[j].x * vv[j].x + vv[j].y * vv[j].y) + (vv[j].z * vv[j].z + vv[j].w * vv[j].w);
                const float rstd = 1.0f / sqrtf(wave_sum(ss) * (1.0f / D) + EPS);
                f32x4* orow = (f32x4*)(a.out + (size_t)tk * D) + lane;
#pragma unroll
                for (int j = 0; j < 4; ++j) orow[64 * j] = vv[j] * rstd * *(const f32x4*)(a.final_g + 4 * lane + 256 * j);
            }
        }
    }
}

#define XB_TMO      128
#define XB_XCNT(j)  (256  + 64 * (j))
#define XB_XSUB(j)  (1280 + 64 * (j))
#define XB_XGEN(j)  (2304 + 64 * (j))
#define XB_TOP      3328
#define XB_TOPGEN   3392
#define XCD_BAR_WORDS 3456
#define XB_SPIN_CAP (1u << 22)
__device__ __forceinline__ unsigned xb_ld(unsigned* p)              { return __hip_atomic_load(p, __ATOMIC_RELAXED, __HIP_MEMORY_SCOPE_AGENT); }
__device__ __forceinline__ unsigned xb_add(unsigned* p, unsigned v) { return __hip_atomic_fetch_add(p, v, __ATOMIC_RELAXED, __HIP_MEMORY_SCOPE_AGENT); }
__device__ __forceinline__ unsigned xb_xcc_id() { return (unsigned)__builtin_amdgcn_s_getreg((3 << 11) | 20) & 0xFu; }
#define XB_SPIN(cond, bar) do { unsigned _sp = 0; while (cond) { __builtin_amdgcn_s_sleep(1); \
    if ((++_sp & 255u) == 0u) { if (xb_ld(&(bar)[XB_TMO])) break; if (_sp > XB_SPIN_CAP) { atomicAdd(&(bar)[XB_TMO], 1u); break; } } } } while (0)
struct XcdBarrier { unsigned* bar; unsigned x; volatile LAS unsigned* st; };
__device__ __forceinline__ XcdBarrier xcd_barrier_post(unsigned* bar, volatile LAS unsigned* st, bool leader) {
    XcdBarrier b; b.bar = bar; b.x = xb_xcc_id(); b.st = st;
    if (leader) (void)xb_add(&bar[XB_XCNT(b.x)], 1u);
    return b;
}
__device__ __forceinline__ void xcd_barrier_complete(unsigned* bar, unsigned x, unsigned& nloc, unsigned& nx) {
    const unsigned G = gridDim.x * gridDim.y * gridDim.z;
    unsigned sum, cnt, mine, sp = 0u;
    for (;;) {
        sum = 0u; cnt = 0u; mine = 0u;
#pragma unroll
        for (unsigned j = 0; j < 16; ++j) { const unsigned c = xb_ld(&bar[XB_XCNT(j)]); sum += c; cnt += (c > 0u) ? 1u : 0u; mine = (j == x) ? c : mine; }
        if (sum == G) break;
        __builtin_amdgcn_s_sleep(1);
        if ((++sp & 255u) == 0u) { if (xb_ld(&bar[XB_TMO])) break; if (sp > XB_SPIN_CAP) { atomicAdd(&bar[XB_TMO], 1u); break; } }
    }
    nloc = mine > 0u ? mine : 1u; nx = cnt > 0u ? cnt : 1u;
}
__device__ __forceinline__ void xcd_barrier(const XcdBarrier& b, bool leader) {
    asm volatile("s_waitcnt vmcnt(0)" ::: "memory");
    __syncthreads();
    if (leader) {
        unsigned* bar = b.bar;
        __builtin_amdgcn_s_waitcnt(0);
        unsigned nloc = b.st[0], nx = b.st[1];
        if (nloc == 0u) { xcd_barrier_complete(bar, b.x, nloc, nx); b.st[0] = nloc; b.st[1] = nx; }
        const unsigned old = xb_add(&bar[XB_XSUB(b.x)], 1u);
        const unsigned gen = old / nloc;
        if (old + 1u == (gen + 1u) * nloc) {
            __builtin_amdgcn_fence(__ATOMIC_RELEASE, "agent");
            asm volatile("s_waitcnt vmcnt(0)" ::: "memory");
            const unsigned og = xb_add(&bar[XB_TOP], 1u);
            const unsigned tg = og / nx;
            if (og + 1u == (tg + 1u) * nx) xb_add(&bar[XB_TOPGEN], 1u);
            else XB_SPIN(xb_ld(&bar[XB_TOPGEN]) == tg, bar);
            __builtin_amdgcn_fence(__ATOMIC_ACQUIRE, "agent");
            xb_add(&bar[XB_XGEN(b.x)], 1u);
            asm volatile("s_waitcnt vmcnt(0)" ::: "memory");
        } else {
            XB_SPIN(xb_ld(&bar[XB_XGEN(b.x)]) == gen, bar);
            __builtin_amdgcn_fence(__ATOMIC_ACQUIRE, "agent");
            asm volatile("s_waitcnt vmcnt(0)" ::: "memory");
        }
    }
    __syncthreads();
}

typedef const __attribute__((address_space(4))) Args* KArgsPtr;
__device__ __forceinline__ Args load_args() {
#if defined(__HIP_DEVICE_COMPILE__)
    KArgsPtr p = (KArgsPtr)__builtin_amdgcn_kernarg_segment_ptr(); asm volatile("" : "+s"(p)); Args a;
    a.x = p->x; a.c = p->c; a.pos = p->pos; a.w_ada = p->w_ada; a.b_ada = p->b_ada; a.norm1_g = p->norm1_g; a.norm2_g = p->norm2_g; a.w_in = p->w_in; a.w_out = p->w_out; a.pool_w = p->pool_w;
    a.pool_scale = p->pool_scale; a.hgrn_g = p->hgrn_g; a.lb_logits = p->lb_logits; a.w_router = p->w_router; a.b_router = p->b_router; a.w1 = p->w1; a.b1 = p->b1; a.w2 = p->w2; a.b2 = p->b2; a.final_g = p->final_g;
    a.out = p->out; a.ws = p->ws; a.ph_lo = p->ph_lo; a.ph_hi = p->ph_hi; return a;
#else
    return Args{};
#endif
}
__device__ __forceinline__ int lane_id() { return __builtin_amdgcn_mbcnt_hi(~0u, __builtin_amdgcn_mbcnt_lo(~0u, 0)); }
__device__ __forceinline__ Ctx make_ctx(unsigned char* ws, int wv) {
    extern __shared__ __attribute__((aligned(16))) unsigned char lds_raw[];
    Ctx C; C.lds = (LAS unsigned char*)lds_raw; { int l_ = lane_id(); asm volatile("" : "+v"(l_)); C.lane = l_; } C.wave = wv; C.tid = wv * 64 + C.lane;
    C.G = gridDim.x; { const int bx = blockIdx.x; C.vcu = (C.G % 8 == 0) ? (bx % 8) * (C.G / 8) + bx / 8 : bx; }
    C.ws = ws; return C;
}
#ifndef PHASE_FN
#define PHASE_FN __device__ __forceinline__ void
#endif
#define GEMM_FN __device__ __forceinline__ void
PHASE_FN ph_prep(int wv) { const Args a = load_args(); Ctx C = make_ctx(a.ws, wv); phase_prep(a, C); }
PHASE_FN ph_u0(int wv) { const Args a = load_args(); Ctx C = make_ctx(a.ws, wv); phase_u0(a, C); }
GEMM_FN ph_gin(int l, int wv) { const Args a = load_args(); Ctx C = make_ctx(a.ws, wv); unsigned char* ws = a.ws;
    DenseOrder S{(const char*)(ws + WS_U), (const char*)(ws + WS_WIN) + (size_t)l * NPAD * 1024 * 2, NTOK / 256, NPAD / 256, (NTOK / 256) * (NPAD / 256), C.G, (int)blockIdx.x};
    EpiIn E{ws}; pg8::gemm_phase<EpiIn, DenseOrder, false, true>(C.lds, (LAS unsigned*)(C.lds + LDS_PARK), C.tid, S, E); }
PHASE_FN ph_mix1(int l, int wv) { const Args a = load_args(); Ctx C = make_ctx(a.ws, wv); phase_mix1(a, C, l); }
PHASE_FN ph_mix2(int l, int wv) { const Args a = load_args(); Ctx C = make_ctx(a.ws, wv); phase_mix2(a, C, l); }
GEMM_FN ph_gout(int l, int wv) { const Args a = load_args(); Ctx C = make_ctx(a.ws, wv); unsigned char* ws = a.ws;
    DenseOrder S{(const char*)(ws + WS_MIX), (const char*)(ws + WS_WOUT) + (size_t)l * 1024 * 1024 * 2, NTOK / 256, 4, (NTOK / 256) * 4, C.G, (int)blockIdx.x};
    EpiOut E{l == 0 ? a.x : (const float*)(ws + WS_H), (float*)(ws + WS_H), (const float*)(ws + WS_MOD) + (size_t)l * 4 * 6144 + 2048};
    pg8::gemm_phase<EpiOut, DenseOrder, false, true>(C.lds, (LAS unsigned*)(C.lds + LDS_PARK), C.tid, S, E); }
PHASE_FN ph_router(int l, int wv) { const Args a = load_args(); Ctx C = make_ctx(a.ws, wv); phase_router2(a, C, l); }
GEMM_FN ph_g1(int l, int wv) { const Args a = load_args(); Ctx C = make_ctx(a.ws, wv); unsigned char* ws = a.ws;
    LAS int* tab = (LAS int*)(C.lds + LDS_TAB); moe_table(C, l, tab);
    MoeOrder<true> S{tab, (const char*)(ws + WS_U), (const char*)(ws + WS_W1) + (size_t)l * 32 * 2048 * 1024, (const int*)(ws + WS_ROWTOK), C.G, C.vcu};
    EpiG1 E{ws + WS_ACT, a.b1 + (size_t)l * 32 * 2048}; pg8::gemm_phase<EpiG1, MoeOrder<true>, true, true, true>(C.lds, (LAS unsigned*)(C.lds + LDS_PARK), C.tid, S, E); }
GEMM_FN ph_g2(int l, int wv) { const Args a = load_args(); Ctx C = make_ctx(a.ws, wv); unsigned char* ws = a.ws;
    LAS int* tab = (LAS int*)(C.lds + LDS_TAB); moe_table(C, l, tab);
    MoeOrder<false> S{tab, (const char*)(ws + WS_ACT), (const char*)(ws + WS_W2) + (size_t)l * 32 * 1024 * 1024, nullptr, C.G, C.vcu};
    EpiG2 E{(bf16_t*)(ws + WS_Y), a.b2 + (size_t)l * 32 * 1024}; pg8::gemm_phase<EpiG2, MoeOrder<false>, false, true, true>(C.lds, (LAS unsigned*)(C.lds + LDS_PARK), C.tid, S, E); }
PHASE_FN ph_combine(int l, int wv) { const Args a = load_args(); Ctx C = make_ctx(a.ws, wv); phase_combine(a, C, l); }

constexpr int NPHASES = 2 + 8 * DEPTH;
__global__ void __launch_bounds__(NTHREADS, 2) mega_fwd(Args a) {
#if MK_ONE_LAUNCH == 1
    cg::grid_group grid = cg::this_grid();
#define SEAM() do { __syncthreads(); grid.sync(); } while (0)
#elif MK_ONE_LAUNCH == 2
    extern __shared__ __attribute__((aligned(16))) unsigned char lds_k[];
    volatile LAS unsigned* bst = (volatile LAS unsigned*)((LAS unsigned char*)lds_k + LDS_BYTES - 64);
    const bool leader = (threadIdx.x == 0);
    if (leader) { bst[0] = 0u; bst[1] = 0u; }
    __syncthreads();
    const XcdBarrier xbar = xcd_barrier_post((unsigned*)(a.ws + WS_CTL) + CW_BAR, bst, leader);
#define SEAM() xcd_barrier(xbar, leader)
#else
#define SEAM() do { } while (0)
#endif
    const int lo = a.ph_lo, hi = a.ph_hi;
    const int wv = __builtin_amdgcn_readfirstlane((int)threadIdx.x >> 6);
#define RUN(id, call) do { if (lo <= (id) && (id) < hi) { call; if ((id) + 1 < hi) SEAM(); } } while (0)
    RUN(0, ph_prep(wv));
    RUN(1, ph_u0(wv));
    RUN(2, ph_gin(0, wv)); RUN(3, ph_mix1(0, wv)); RUN(4, ph_mix2(0, wv)); RUN(5, ph_gout(0, wv)); RUN(6, ph_router(0, wv)); RUN(7, ph_g1(0, wv)); RUN(8, ph_g2(0, wv)); RUN(9, ph_combine(0, wv));
    RUN(10, ph_gin(1, wv)); RUN(11, ph_mix1(1, wv)); RUN(12, ph_mix2(1, wv)); RUN(13, ph_gout(1, wv)); RUN(14, ph_router(1, wv)); RUN(15, ph_g1(1, wv)); RUN(16, ph_g2(1, wv)); RUN(17, ph_combine(1, wv));
#undef RUN
}

extern "C" void kernel_launch(void* const* d_in, const int* in_sizes, int n_in, void* d_out, int out_size, void* d_ws, size_t ws_size, hipStream_t stream) {
    static int grid = 0;
    if (grid == 0) {
        if (n_in != 20 || out_size != NTOK * D || ws_size < WS_END) { fprintf(stderr, "kernel_launch: unexpected shapes: n_in %d out %d ws %zu (need %zu)\n", n_in, out_size, ws_size, (size_t)WS_END); grid = -1; return; }
        int dev = 0, cus = 0, per_cu = 0;
        hipGetDevice(&dev); hipDeviceGetAttribute(&cus, hipDeviceAttributeMultiprocessorCount, dev);
        if (hipFuncSetAttribute((const void*)mega_fwd, hipFuncAttributeMaxDynamicSharedMemorySize, LDS_BYTES) != hipSuccess) { fprintf(stderr, "kernel_launch: hipFuncSetAttribute failed\n"); grid = -1; return; }
        hipOccupancyMaxActiveBlocksPerMultiprocessor(&per_cu, (const void*)mega_fwd, NTHREADS, LDS_BYTES);
        (void)hipGetLastError();
        if (per_cu < 1) fprintf(stderr, "kernel_launch: occupancy query says %d blocks per CU\n", per_cu);
        grid = cus;
    }
    if (grid < 0) return;
    hipMemsetAsync((char*)d_ws + WS_CTL, 0, CTL_BYTES, stream);
    Args a{};
    a.x = (const float*)d_in[0]; a.c = (const float*)d_in[1]; a.pos = (const int*)d_in[2]; a.w_ada = (const float*)d_in[3]; a.b_ada = (const float*)d_in[4];
    a.norm1_g = (const float*)d_in[5]; a.norm2_g = (const float*)d_in[6]; a.w_in = (const float*)d_in[7]; a.w_out = (const float*)d_in[8]; a.pool_w = (const float*)d_in[9];
    a.pool_scale = (const float*)d_in[10]; a.hgrn_g = (const float*)d_in[11]; a.lb_logits = (const float*)d_in[12]; a.w_router = (const float*)d_in[13]; a.b_router = (const float*)d_in[14];
    a.w1 = (const float*)d_in[15]; a.b1 = (const float*)d_in[16]; a.w2 = (const float*)d_in[17]; a.b2 = (const float*)d_in[18]; a.final_g = (const float*)d_in[19];
    a.out = (float*)d_out; a.ws = (unsigned char*)d_ws;
#if MK_ONE_LAUNCH == 1
    a.ph_lo = 0; a.ph_hi = NPHASES;
    void* args[] = {&a};
    hipError_t e = hipLaunchCooperativeKernel((const void*)mega_fwd, dim3(grid), dim3(NTHREADS), args, LDS_BYTES, stream);
    if (e != hipSuccess) fprintf(stderr, "cooperative launch failed: %s (grid %d)\n", hipGetErrorString(e), grid);
#elif MK_ONE_LAUNCH == 2
    a.ph_lo = 0; a.ph_hi = NPHASES;
    hipLaunchKernelGGL(mega_fwd, dim3(grid), dim3(NTHREADS), LDS_BYTES, stream, a);
#else
    for (int p = 0; p < NPHASES; ++p) { a.ph_lo = p; a.ph_hi = p + 1; hipLaunchKernelGGL(mega_fwd, dim3(grid), dim3(NTHREADS), LDS_BYTES, stream, a); }
#endif
}
```

```cpp
#include <hip/hip_runtime.h>
#include <hip/hip_cooperative_groups.h>
#include <cstdio>
#include <cstdint>
#include <type_traits>
namespace cg = cooperative_groups;

#ifndef MK_ONE_LAUNCH
#define MK_ONE_LAUNCH 2
#endif

#define LAS __attribute__((address_space(3)))
typedef unsigned short bf16_t;
typedef short bf16x8 __attribute__((ext_vector_type(8)));
typedef float f32x4 __attribute__((ext_vector_type(4)));
typedef float f32x2 __attribute__((ext_vector_type(2)));
typedef unsigned u32x4 __attribute__((ext_vector_type(4)));
typedef unsigned u32x2 __attribute__((ext_vector_type(2)));
typedef int i32x4 __attribute__((ext_vector_type(4)));
typedef int i32x8 __attribute__((ext_vector_type(8)));

constexpr int D = 1024, NBATCH = 4, SEQ = 4096, NTOK = NBATCH * SEQ, DEPTH = 2;
constexpr int D_IN = 2372, NPAD = 2560;
constexpr int NE = 32, TOPK = 4, FF = 1024;
constexpr int NWAVES = 8, NTHREADS = 512;
constexpr float EPS = 1e-6f;
constexpr float W8SCALE = 32.0f;
constexpr int ROWCAP = 73728;

constexpr size_t MiB = 1u << 20;
constexpr size_t WS_CTL = 0, CTL_BYTES = 1 * MiB;
constexpr size_t WS_MOD = 1 * MiB;
constexpr size_t WS_ROPEC = 2 * MiB;
constexpr size_t WS_ROPES = 4 * MiB;
constexpr size_t WS_WIN = 6 * MiB;
constexpr size_t WS_WOUT = 16 * MiB;
constexpr size_t WS_ROWTOK = 20 * MiB;
constexpr size_t WS_EIDX = 22 * MiB;
constexpr size_t WS_SLOT = 22 * MiB + 256 * 1024;
constexpr size_t WS_GATE = 22 * MiB + 512 * 1024;
constexpr size_t WS_WI = 23 * MiB;
constexpr size_t WS_WRH = 23 * MiB + 256 * 1024;
constexpr size_t WS_WRL = 23 * MiB + 512 * 1024;
constexpr size_t WS_KI = 24 * MiB;
constexpr size_t WS_K = 26 * MiB;
constexpr size_t WS_V = 30 * MiB;
constexpr size_t WS_QI = 34 * MiB;
constexpr size_t WS_Q = 42 * MiB;
constexpr size_t WS_UB = 58 * MiB;
constexpr size_t WS_HG = 74 * MiB;
constexpr size_t WS_SEL = 138 * MiB;
constexpr size_t WS_HL = 154 * MiB;
constexpr size_t WS_HD = 170 * MiB;
constexpr size_t WS_MIX = 171 * MiB;
constexpr size_t WS_U = 203 * MiB;
constexpr size_t WS_H = 235 * MiB;
constexpr size_t WS_W1 = 299 * MiB;
constexpr size_t WS_W2 = 555 * MiB;
constexpr size_t WS_ACT = 683 * MiB;
constexpr size_t WS_Y = 827 * MiB;
constexpr size_t WS_END = 971 * MiB;
constexpr int CW_CNT = 1024;
constexpr int CW_BAR = 8192;

constexpr int LDS_BYTES = 147456;
constexpr int LDS_TAB = 131072;
constexpr int LDS_PARK = 131072 + 1024;

__device__ __forceinline__ unsigned f2bf(float f) { unsigned u = __builtin_bit_cast(unsigned, f); return (u + 0x7fffu + ((u >> 16) & 1u)) >> 16; }
typedef __bf16 bf16x2_t __attribute__((ext_vector_type(2)));
__device__ __forceinline__ unsigned cvt_pk_bf16(float lo, float hi) { const f32x2 v = {lo, hi}; const bf16x2_t b = __builtin_convertvector(v, bf16x2_t); return __builtin_bit_cast(unsigned, b); }
__device__ __forceinline__ unsigned pk2(float lo, float hi) { return cvt_pk_bf16(lo, hi); }
__device__ __forceinline__ unsigned pk4_fp8(float a, float b, float c, float d) { unsigned w = 0u; w = __builtin_amdgcn_cvt_pk_fp8_f32(a, b, w, false); w = __builtin_amdgcn_cvt_pk_fp8_f32(c, d, w, true); return w; }
__device__ __forceinline__ float bf2f(unsigned short b) { return __builtin_bit_cast(float, ((unsigned)b) << 16); }
__device__ __forceinline__ float bflo(unsigned w) { return __builtin_bit_cast(float, w << 16); }
__device__ __forceinline__ float bfhi(unsigned w) { return __builtin_bit_cast(float, w & 0xffff0000u); }
__device__ __forceinline__ float wave_sum(float v) {
#pragma unroll
    for (int o = 1; o < 64; o <<= 1) v += __shfl_xor(v, o);
    return v;
}
__device__ __forceinline__ float wave_max(float v) {
#pragma unroll
    for (int o = 1; o < 64; o <<= 1) v = fmaxf(v, __shfl_xor(v, o));
    return v;
}
__device__ __forceinline__ float sigmoidf_(float z) { return __builtin_amdgcn_rcpf(1.0f + __expf(-z)); }
__device__ __forceinline__ float siluf_(float z) { return z * __builtin_amdgcn_rcpf(1.0f + __expf(-z)); }

namespace pg8 {
constexpr int BM = 256, BK = 64, HALF = 128, HTB = HALF * BK * 2, STAGE_BYTES = 8 * HTB;
constexpr int KD = 1024, NKT = KD / BK;
__host__ __device__ __forceinline__ int lds_byte(int r, int c) { const int st = (r >> 4) * 2 + (c >> 5), rr = r & 15, cc = c & 31, ob = rr * 64 + cc * 2; return st * 1024 + (ob ^ (((ob >> 9) & 1) << 5)); }
__host__ __device__ __forceinline__ void stage_rc(int b, int& R, int& C) { const int st = b / 1024, sb = b % 1024, swz = sb ^ (((sb >> 9) & 1) << 5); R = (st >> 1) * 16 + swz / 64; C = (st & 1) * 32 + (swz % 64) / 2; }

struct Unit { const char* A; const char* B; const int* ridx; int nvalid; int row0, pn, e, b; };

__device__ __forceinline__ f32x4 mma_step(bf16x8 a, bf16x8 b, f32x4 c) { return __builtin_amdgcn_mfma_f32_16x16x32_bf16(a, b, c, 0, 0, 0); }
__device__ __forceinline__ f32x4 mma_step(i32x8 a, i32x8 b, f32x4 c) { return __builtin_amdgcn_mfma_scale_f32_16x16x128_f8f6f4(a, b, c, 0, 0, 0, 0x7F7F7F7F, 0, 0x7F7F7F7F); }
__device__ __forceinline__ bf16x8 ld_frag(const LAS unsigned char* p, bf16x8*) { return *(const LAS bf16x8*)p; }
__device__ __forceinline__ i32x8 ld_frag(const LAS unsigned char* p, i32x8*) { const i32x4 lo = *(const LAS i32x4*)p, hi = *(const LAS i32x4*)(p + 256); return __builtin_shufflevector(lo, hi, 0, 1, 2, 3, 4, 5, 6, 7); }
template <class Epi, class Sched, bool GATHER, bool ALIGN_EPI, bool FP8 = false>
__device__ __forceinline__ void gemm_phase(LAS unsigned char* lds, LAS unsigned* park, int tid_in, const Sched& S, const Epi& E) {
    const int tid = tid_in, wid = __builtin_amdgcn_readfirstlane(tid >> 6), lane = tid & 63, wr = wid >> 2, wc = wid & 3, fr = lane & 15, fq = lane >> 4;
    constexpr int RS = FP8 ? KD : KD * 2;
    constexpr int nt = FP8 ? NKT / 2 : NKT, KS = FP8 ? 1 : 2;
    typedef typename std::conditional<FP8, i32x8, bf16x8>::type Frag;
    auto stage_map = [&](int i, int& R, int& Cb) { if (FP8) { const int st = wid + 8 * i; R = (st >> 1) * 16 + (lane & 15); Cb = (st & 1) * 64 + 16 * (lane >> 4); }
                                                    else { int C; stage_rc(tid * 16 + i * 8192, R, C); Cb = 2 * C; } };
    unsigned voffB[2], vA[2][2];
#pragma unroll
    for (int i = 0; i < 2; ++i) { int R, Cb; stage_map(i, R, Cb); voffB[i] = (unsigned)(R * RS + Cb); }
    constexpr size_t kstep = (size_t)(BK * 2);
    constexpr size_t hstep = (size_t)HALF * RS;
    const unsigned ldsw = (unsigned)wid * 1024u;
    const int aoff = lds_byte(wr * 64 + fr, fq * 8), boff = lds_byte(wc * 32 + fr, fq * 8);
    const int f8lo = (fq >> 1) * 1024 + (fq & 1) * 512 + fr * 16;
    const int aoff8 = wr * 8 * 1024 + f8lo, boff8 = wc * 4 * 1024 + f8lo;
#define PG8_SA(b, h) (((b) * 2 + (h)) * HTB)
#define PG8_SB(b, h) ((4 + (b) * 2 + (h)) * HTB)
#define PG8_STAGE(bufoff, gbase, voff) do { _Pragma("unroll") for (int _i = 0; _i < 2; ++_i) { unsigned _o = (voff)[_i]; asm volatile("" : "+v"(_o));   \
        __builtin_amdgcn_global_load_lds((const unsigned*)((const char*)(gbase) + _o), (LAS unsigned*)(lds + (bufoff) + ldsw + _i * 8192), 16, 0, 0); } } while (0)
#define PG8_LDA(dst, b, h) do { _Pragma("unroll") for (int m = 0; m < 4; ++m) _Pragma("unroll") for (int k = 0; k < KS; ++k) dst[m][k] = ld_frag(lds + PG8_SA(b, h) + (FP8 ? aoff8 : aoff + k * 1024) + m * 2048, (Frag*)nullptr); } while (0)
#define PG8_LDB(dst, b, h) do { _Pragma("unroll") for (int n = 0; n < 2; ++n) _Pragma("unroll") for (int k = 0; k < KS; ++k) dst[n][k] = ld_frag(lds + PG8_SB(b, h) + (FP8 ? boff8 : boff + k * 1024) + n * 2048, (Frag*)nullptr); } while (0)
#define PG8_MMA(ai, bj, At, Bt) do { __builtin_amdgcn_s_setprio(1); _Pragma("unroll") for (int m = 0; m < 4; ++m) _Pragma("unroll") for (int n = 0; n < 2; ++n) _Pragma("unroll") for (int k = 0; k < KS; ++k) \
        acc[ai][bj][m][n] = mma_step(Bt[n][k], At[m][k], acc[ai][bj][m][n]); __builtin_amdgcn_s_setprio(0); } while (0)
#define PG8_WAIT_V(n) asm volatile("s_waitcnt vmcnt(" #n ")" ::: "memory")
#define PG8_WAIT_L(n) asm volatile("s_waitcnt lgkmcnt(" #n ")" ::: "memory")
#define PG8_BAR __builtin_amdgcn_s_barrier()
#define PG8_SCHED __builtin_amdgcn_sched_barrier(0)
#define PG8_OFFS(dst, u) do { _Pragma("unroll") for (int _h = 0; _h < 2; ++_h) _Pragma("unroll") for (int _i = 0; _i < 2; ++_i) { \
        int _R, _Cb; stage_map(_i, _R, _Cb); const int _rr = _h * HALF + _R; \
        if constexpr (GATHER) { const int _ix = (u).ridx[_rr < (u).nvalid ? _rr : 0]; dst[_h][_i] = (unsigned)(_ix * RS + _Cb); } \
        else dst[_h][_i] = (unsigned)(_rr * RS + _Cb); } } while (0)
    Unit cur, nxt; int ui = 0;
    if (!S.next(0, cur)) return;
    f32x4 acc[2][2][4][2];
#pragma unroll
    for (int a = 0; a < 2; ++a)
#pragma unroll
        for (int b = 0; b < 2; ++b)
#pragma unroll
            for (int m = 0; m < 4; ++m)
#pragma unroll
                for (int n = 0; n < 2; ++n) acc[a][b][m][n] = (f32x4){0.f, 0.f, 0.f, 0.f};
    Frag At[4][KS], B0[2][KS], B1[2][KS];
    PG8_OFFS(vA, cur);
    const char* cA = cur.A; const char* cB = cur.B;
    PG8_STAGE(PG8_SB(0, 0), cB, voffB); PG8_STAGE(PG8_SB(0, 1), cB + hstep, voffB); PG8_STAGE(PG8_SA(0, 0), cA, vA[0]); PG8_STAGE(PG8_SA(0, 1), cA, vA[1]);
    if (wr == 1) PG8_BAR;
    PG8_WAIT_V(2); PG8_BAR;
    PG8_STAGE(PG8_SB(1, 0), cB + kstep, voffB); PG8_STAGE(PG8_SA(1, 0), cA + kstep, vA[0]); PG8_STAGE(PG8_SB(1, 1), cB + hstep + kstep, voffB);
    PG8_WAIT_V(6); PG8_BAR;
    for (;;) {
        const bool has_next = S.next(ui + 1, nxt);
        const char* nA = has_next ? nxt.A : cA; const char* nB = has_next ? nxt.B : cB;
        if constexpr (GATHER) {
            unsigned nv[2][2];
            if (has_next) { PG8_OFFS(nv, nxt); } else {
#pragma unroll
                for (int h = 0; h < 2; ++h) { nv[h][0] = vA[h][0]; nv[h][1] = vA[h][1]; } }
            *(LAS u32x4*)(park + tid * 4) = (u32x4){nv[0][0], nv[0][1], nv[1][0], nv[1][1]};
        }
#pragma unroll 1
        for (int t = 0; t < nt; t += 2) {
            const bool last = (t == nt - 2);
            const char* a1 = cA + (size_t)(t + 1) * kstep;
            const char* a2 = last ? nA : cA + (size_t)(t + 2) * kstep; const char* b2 = last ? nB : cB + (size_t)(t + 2) * kstep;
            const char* a3 = a2 + kstep; const char* b3 = b2 + kstep;
            PG8_LDB(B0, 0, 0); PG8_LDB(B1, 0, 1); PG8_SCHED; PG8_LDA(At, 0, 0); PG8_STAGE(PG8_SA(1, 1), a1, vA[1]);
            if constexpr (GATHER) { if (last) { const u32x4 pv = *(const LAS u32x4*)(park + tid * 4); vA[0][0] = pv.x; vA[0][1] = pv.y; vA[1][0] = pv.z; vA[1][1] = pv.w; } }
            PG8_WAIT_V(8); PG8_WAIT_L(0); PG8_BAR; PG8_MMA(0, 0, At, B0); PG8_MMA(0, 1, At, B1); PG8_BAR; PG8_SCHED;
            PG8_LDA(At, 0, 1); PG8_STAGE(PG8_SB(0, 0), b2, voffB); PG8_STAGE(PG8_SB(0, 1), b2 + hstep, voffB); PG8_STAGE(PG8_SA(0, 0), a2, vA[0]);
            PG8_WAIT_V(8); PG8_WAIT_L(0); PG8_BAR; PG8_MMA(1, 0, At, B0); PG8_MMA(1, 1, At, B1); PG8_BAR; PG8_SCHED;
            PG8_LDB(B0, 1, 0); PG8_LDB(B1, 1, 1); PG8_SCHED; PG8_LDA(At, 1, 0); PG8_STAGE(PG8_SA(0, 1), a2, vA[1]);
            PG8_WAIT_V(8); PG8_WAIT_L(0); PG8_BAR; PG8_MMA(0, 0, At, B0); PG8_MMA(0, 1, At, B1); PG8_BAR; PG8_SCHED;
            PG8_LDA(At, 1, 1); PG8_STAGE(PG8_SB(1, 0), b3, voffB); PG8_STAGE(PG8_SB(1, 1), b3 + hstep, voffB); PG8_STAGE(PG8_SA(1, 0), a3, vA[0]);
            PG8_WAIT_V(8); PG8_WAIT_L(0); PG8_BAR; PG8_MMA(1, 0, At, B0); PG8_MMA(1, 1, At, B1); PG8_BAR; PG8_SCHED;
        }
        if constexpr (ALIGN_EPI) { if (wr == 0) PG8_BAR; }
        { int fr2 = fr, fq2 = fq; asm volatile("" : "+v"(fr2), "+v"(fq2)); E(acc, cur, wr, wc, fr2, fq2); }
        if (!has_next) break;
#pragma unroll
        for (int a = 0; a < 2; ++a)
#pragma unroll
            for (int b = 0; b < 2; ++b)
#pragma unroll
                for (int m = 0; m < 4; ++m)
#pragma unroll
                    for (int n = 0; n < 2; ++n) acc[a][b][m][n] = (f32x4){0.f, 0.f, 0.f, 0.f};
        cur = nxt; cA = nA; cB = nB; ++ui;
        if constexpr (ALIGN_EPI) { if (wr == 1) PG8_BAR; }
    }
    PG8_WAIT_V(0);
    if constexpr (!ALIGN_EPI) { if (wr == 0) PG8_BAR; }
    PG8_BAR;
#undef PG8_SA
#undef PG8_SB
#undef PG8_STAGE
#undef PG8_LDA
#undef PG8_LDB
#undef PG8_MMA
#undef PG8_WAIT_V
#undef PG8_WAIT_L
#undef PG8_BAR
#undef PG8_SCHED
#undef PG8_OFFS
}
}

struct Args {
    const float* x; const float* c; const int* pos; const float* w_ada; const float* b_ada; const float* norm1_g; const float* norm2_g;
    const float* w_in; const float* w_out; const float* pool_w; const float* pool_scale; const float* hgrn_g; const float* lb_logits;
    const float* w_router; const float* b_router; const float* w1; const float* b1; const float* w2; const float* b2; const float* final_g;
    float* out; unsigned char* ws; int ph_lo, ph_hi;
};

struct Ctx {
    LAS unsigned char* lds;
    int tid, lane, wave, G, vcu;
    unsigned char* ws;
};

struct DenseOrder {
    const char* A; const char* B; int nM, nN, nwg, G, c;
    __device__ __forceinline__ bool next(int i, pg8::Unit& u) const {
        const long L = (long)i * G + c; if (L >= nwg) return false;
        int wgid = (int)L; { const int q = nwg / 8, r = nwg % 8, xcd = wgid % 8, off = wgid / 8; wgid = (xcd < r ? xcd * (q + 1) : r * (q + 1) + (xcd - r) * q) + off; }
        const int nig = 8 * nN, gid = wgid / nig, fm = gid * 8, gsz = (nM - fm) < 8 ? (nM - fm) : 8;
        const int pm = fm + ((wgid % nig) % gsz), pn = (wgid % nig) / gsz;
        u.A = A + (size_t)pm * 256 * pg8::KD * 2; u.B = B + (size_t)pn * 256 * pg8::KD * 2; u.ridx = nullptr; u.nvalid = 256; u.row0 = pm * 256; u.pn = pn; u.e = 0; u.b = pm >> 4;
        return true;
    }
};

template <bool FIRST> struct MoeOrder {
    LAS const int* tab; const char* A; const char* B; const int* rowtok; int G, c;
    static constexpr int NTN = FIRST ? 8 : 4;
    __device__ __forceinline__ bool next(int i, pg8::Unit& u) const {
        const int P = tab[32]; const long L = (long)i * G + c; if (L >= (long)P * NTN) return false;
        const int p = (int)(L / NTN), nt = (int)(L % NTN);
        int e = 0;
#pragma unroll 1
        for (int k = 1; k < 32; ++k) e = (tab[k] <= p) ? k : e;
        const int mt = p - tab[e], cnt = tab[33 + e];
        if (FIRST) { u.A = A; u.ridx = rowtok + e * NTOK + mt * 256; u.nvalid = (cnt - mt * 256) < 256 ? (cnt - mt * 256) : 256; u.B = B + ((size_t)e * 2048 + nt * 256) * pg8::KD; }
        else { u.A = A + (size_t)p * 256 * pg8::KD; u.ridx = nullptr; u.nvalid = 256; u.B = B + ((size_t)e * 1024 + nt * 256) * pg8::KD; }
        u.row0 = p * 256; u.pn = nt; u.e = e; u.b = 0;
        return true;
    }
};

struct EpiIn {
    unsigned char* ws;
    __device__ __forceinline__ void operator()(const f32x4 (&acc)[2][2][4][2], const pg8::Unit& u, int wr, int wc, int fr, int fq) const {
        const int pn = u.pn;
        const float* rc = (const float*)(ws + WS_ROPEC); const float* rs = (const float*)(ws + WS_ROPES);
        const bool rope = (pn <= 1) || (pn == 3) || (pn == 2 && wc < 2) || (pn == 4 && wc == 0);
#pragma unroll
        for (int ai = 0; ai < 2; ++ai)
#pragma unroll
            for (int m = 0; m < 4; ++m) {
                const int r = u.row0 + ai * 128 + wr * 64 + m * 16 + fr;
                if (rope) {
                    bf16_t* dst; float scl = 1.f;
                    if (pn <= 1) { dst = (bf16_t*)(ws + WS_Q) + (size_t)r * 512 + (pn * 4 + wc) * 64; scl = 0.125f; }
                    else if (pn == 2) dst = (bf16_t*)(ws + WS_K) + (size_t)r * 128 + wc * 64;
                    else if (pn == 3) dst = (bf16_t*)(ws + WS_QI) + (size_t)r * 256 + wc * 64;
                    else dst = (bf16_t*)(ws + WS_KI) + (size_t)r * 64;
                    const f32x4 c0 = *(const f32x4*)(rc + (size_t)r * 32 + 8 * fq), c1 = *(const f32x4*)(rc + (size_t)r * 32 + 8 * fq + 4), s0 = *(const f32x4*)(rs + (size_t)r * 32 + 8 * fq), s1 = *(const f32x4*)(rs + (size_t)r * 32 + 8 * fq + 4);
                    const f32x4 x10 = acc[ai][0][m][0], x11 = acc[ai][0][m][1], x20 = acc[ai][1][m][0], x21 = acc[ai][1][m][1];
                    const f32x4 o10 = (x10 * c0 - x20 * s0) * scl, o11 = (x11 * c1 - x21 * s1) * scl, o20 = (x20 * c0 + x10 * s0) * scl, o21 = (x21 * c1 + x11 * s1) * scl;
                    u32x4 w1v, w2v; w1v.x = pk2(o10[0], o10[1]); w1v.y = pk2(o10[2], o10[3]); w1v.z = pk2(o11[0], o11[1]); w1v.w = pk2(o11[2], o11[3]);
                    w2v.x = pk2(o20[0], o20[1]); w2v.y = pk2(o20[2], o20[3]); w2v.z = pk2(o21[0], o21[1]); w2v.w = pk2(o21[2], o21[3]);
                    *(u32x4*)(dst + 8 * fq) = w1v; *(u32x4*)(dst + 32 + 8 * fq) = w2v;
                } else if (pn == 2) {
#pragma unroll
                    for (int bj = 0; bj < 2; ++bj) { const f32x4 a0 = acc[ai][bj][m][0], a1 = acc[ai][bj][m][1]; u32x4 w; w.x = pk2(a0[0], a0[1]); w.y = pk2(a0[2], a0[3]); w.z = pk2(a1[0], a1[1]); w.w = pk2(a1[2], a1[3]);
                        *(u32x4*)((bf16_t*)(ws + WS_V) + (size_t)r * 128 + bj * 64 + (wc - 2) * 32 + 8 * fq) = w; }
                } else if (pn == 4) {
                    if (wc == 1 && fq == 0) *(f32x4*)((float*)(ws + WS_WI) + (size_t)r * 4) = acc[ai][0][m][0] * 0.0625f;
                } else {
                    float* p = (pn == 5) ? (float*)(ws + WS_UB) + (size_t)r * 256 + wc * 32 + 8 * fq : (float*)(ws + WS_HG) + (size_t)r * 1024 + (pn - 6) * 256 + wc * 32 + 8 * fq;
#pragma unroll
                    for (int bj = 0; bj < 2; ++bj) { *(f32x4*)(p + bj * 128) = acc[ai][bj][m][0]; *(f32x4*)(p + bj * 128 + 4) = acc[ai][bj][m][1]; }
                }
            }
    }
};
struct EpiOut {
    const float* hin; float* hout; const float* gate;
    __device__ __forceinline__ void operator()(const f32x4 (&acc)[2][2][4][2], const pg8::Unit& u, int wr, int wc, int fr, int fq) const {
        const int col0 = u.pn * 256 + wc * 32 + 8 * fq; const float* gp = gate + (size_t)u.b * 6144 + col0;
        f32x4 gv[2][2];
#pragma unroll
        for (int bj = 0; bj < 2; ++bj)
#pragma unroll
            for (int n = 0; n < 2; ++n) gv[bj][n] = *(const f32x4*)(gp + bj * 128 + n * 4);
#pragma unroll
        for (int ai = 0; ai < 2; ++ai)
#pragma unroll
            for (int m = 0; m < 4; ++m) { const size_t off = (size_t)(u.row0 + ai * 128 + wr * 64 + m * 16 + fr) * D + col0;
#pragma unroll
                for (int bj = 0; bj < 2; ++bj)
#pragma unroll
                    for (int n = 0; n < 2; ++n) { const f32x4 hv = *(const f32x4*)(hin + off + bj * 128 + n * 4); *(f32x4*)(hout + off + bj * 128 + n * 4) = hv + gv[bj][n] * acc[ai][bj][m][n]; }
                if (m & 1) asm volatile("" ::: "memory"); }
    }
};
struct EpiG1 {
    unsigned char* act; const float* b1l;
    __device__ __forceinline__ void operator()(const f32x4 (&acc)[2][2][4][2], const pg8::Unit& u, int wr, int wc, int fr, int fq) const {
        const int ja0 = u.pn * 128 + wc * 32 + 8 * fq; const float* bp = b1l + (size_t)u.e * 2048 + 2 * ja0;
        f32x4 bg[2], bl[2];
#pragma unroll
        for (int n = 0; n < 2; ++n) { const f32x4 t0 = *(const f32x4*)(bp + 8 * n), t1 = *(const f32x4*)(bp + 8 * n + 4); bg[n] = (f32x4){t0[0], t0[2], t1[0], t1[2]}; bl[n] = (f32x4){t0[1], t0[3], t1[1], t1[3]}; }
#pragma unroll
        for (int ai = 0; ai < 2; ++ai)
#pragma unroll
            for (int m = 0; m < 4; ++m) { float o[8];
#pragma unroll
                for (int n = 0; n < 2; ++n) { const f32x4 hg = acc[ai][0][m][n] * (1.0f / W8SCALE) + bg[n], hl = acc[ai][1][m][n] * (1.0f / W8SCALE) + bl[n];
#pragma unroll
                    for (int j = 0; j < 4; ++j) { const float xg = fminf(hg[j], 7.0f), xl = fminf(fmaxf(hl[j], -7.0f), 7.0f); o[4 * n + j] = xg * sigmoidf_(1.702f * xg) * (xl + 1.0f); } }
                u32x2 w; w.x = pk4_fp8(o[0], o[1], o[2], o[3]); w.y = pk4_fp8(o[4], o[5], o[6], o[7]);
                *(u32x2*)(act + (size_t)(u.row0 + ai * 128 + wr * 64 + m * 16 + fr) * FF + ja0) = w; }
    }
};
struct EpiG2 {
    bf16_t* y; const float* b2l;
    __device__ __forceinline__ void operator()(const f32x4 (&acc)[2][2][4][2], const pg8::Unit& u, int wr, int wc, int fr, int fq) const {
        const int col0 = u.pn * 256 + wc * 32 + 8 * fq; const float* bp = b2l + (size_t)u.e * 1024 + col0;
        f32x4 bv[2][2];
#pragma unroll
        for (int bj = 0; bj < 2; ++bj)
#pragma unroll
            for (int n = 0; n < 2; ++n) bv[bj][n] = *(const f32x4*)(bp + bj * 128 + n * 4);
#pragma unroll
        for (int ai = 0; ai < 2; ++ai)
#pragma unroll
            for (int m = 0; m < 4; ++m) { bf16_t* rowp = y + (size_t)(u.row0 + ai * 128 + wr * 64 + m * 16 + fr) * D + col0;
#pragma unroll
                for (int bj = 0; bj < 2; ++bj) { const f32x4 v0 = acc[ai][bj][m][0] * (1.0f / W8SCALE) + bv[bj][0], v1 = acc[ai][bj][m][1] * (1.0f / W8SCALE) + bv[bj][1];
                    u32x4 w; w.x = pk2(v0[0], v0[1]); w.y = pk2(v0[2], v0[3]); w.z = pk2(v1[0], v1[1]); w.w = pk2(v1[2], v1[3]); *(u32x4*)(rowp + bj * 128) = w; } }
    }
};
__device__ __forceinline__ int slot32(int d) { return 16 * ((d >> 2) & 1) + 4 * ((d >> 3) & 3) + (d & 3); }
__device__ __forceinline__ int win_dest(int s) {
    if (s < 512) { const int hd = s >> 6, d64 = s & 63; return 256 * (hd >> 2) + 128 * (d64 >> 5) + 32 * (hd & 3) + slot32(d64 & 31); }
    if (s < 640) { const int hd = (s - 512) >> 6, d64 = s & 63; return 512 + 128 * (d64 >> 5) + 32 * hd + slot32(d64 & 31); }
    if (s < 768) { const int v = s - 640; return 512 + 128 * (v >> 6) + 32 * (2 + ((v & 63) >> 5)) + slot32(v & 31); }
    if (s < 1024) { const int hd = (s - 768) >> 6, d64 = s & 63; return 768 + 128 * (d64 >> 5) + 32 * hd + slot32(d64 & 31); }
    if (s < 1088) { const int d64 = s - 1024; return 1024 + 128 * (d64 >> 5) + slot32(d64 & 31); }
    if (s < 1092) return 1024 + 32 + (s - 1088);
    if (s < 1348) { const int v = s - 1092; return 1280 + (v & ~31) + slot32(v & 31); }
    { const int v = s - 1348; return 1536 + (v & ~31) + slot32(v & 31); }
}
__device__ __forceinline__ int perm_dest(int s) { return (s & ~31) + 16 * ((s >> 2) & 1) + 4 * ((s >> 3) & 3) + (s & 3); }
__device__ __forceinline__ int w1_dest(int s) { const int jg = s >> 1, isl = s & 1, nt = jg >> 7, ja = jg & 127; return 256 * nt + 128 * isl + (ja & ~31) + slot32(ja & 31); }

template <int MAP>
__device__ __forceinline__ void transpose_item(const float* W, int N, bf16_t* WT, LAS float* scr, int kb, int nb, int lane) {
    const int k0 = 64 * kb, n0 = 32 * nb, col = n0 + (lane & 31); const bool ok = col < N;
    float v[32];
    const float* src = W + (size_t)(k0 + (lane >> 5)) * N + (ok ? col : 0);
#pragma unroll
    for (int i = 0; i < 32; ++i) v[i] = src[(size_t)(2 * i) * N];
#pragma unroll
    for (int i = 0; i < 32; ++i) scr[(2 * i + (lane >> 5)) * 33 + (lane & 31)] = ok ? v[i] : 0.f;
    asm volatile("s_waitcnt lgkmcnt(0)" ::: "memory");
    const int c = lane & 7;
#pragma unroll
    for (int j = 0; j < 4; ++j) { const int n = (lane >> 3) + 8 * j; const LAS float* s = scr + (8 * c) * 33 + n;
        u32x4 o; o.x = pk2(s[0 * 33], s[1 * 33]); o.y = pk2(s[2 * 33], s[3 * 33]); o.z = pk2(s[4 * 33], s[5 * 33]); o.w = pk2(s[6 * 33], s[7 * 33]);
        const int sc = n0 + n;
        if (sc < N) { const int dest = MAP == 1 ? win_dest(sc) : (MAP == 2 ? w1_dest(sc) : (MAP == 3 ? perm_dest(sc) : sc)); *(u32x4*)(WT + (size_t)dest * 1024 + k0 + 8 * c) = o; } }
    asm volatile("s_waitcnt lgkmcnt(0)" ::: "memory");
}

__device__ __forceinline__ void phase_prep(const Args& a, Ctx& C) {
    unsigned char* ws = C.ws;
    {
        LAS float* ca = (LAS float*)C.lds;
        LAS float* red = ca + 4096;
        for (int i = C.tid; i < 4096; i += NTHREADS) { const float v = a.c[i]; ca[i] = siluf_(v); }
        __syncthreads();
        for (int it = blockIdx.x; it < 192; it += C.G) {
            const int l = it / 96, cb = it % 96, col = cb * 64 + (C.tid & 63), kg = C.tid >> 6;
            const float* w = a.w_ada + (size_t)l * 1024 * 6144 + col;
            float s0 = 0.f, s1 = 0.f, s2 = 0.f, s3 = 0.f;
#pragma unroll 8
            for (int k = kg * 128; k < kg * 128 + 128; ++k) { const float wv = w[(size_t)k * 6144]; s0 += ca[k] * wv; s1 += ca[1024 + k] * wv; s2 += ca[2048 + k] * wv; s3 += ca[3072 + k] * wv; }
            red[(kg * 4 + 0) * 64 + (C.tid & 63)] = s0; red[(kg * 4 + 1) * 64 + (C.tid & 63)] = s1; red[(kg * 4 + 2) * 64 + (C.tid & 63)] = s2; red[(kg * 4 + 3) * 64 + (C.tid & 63)] = s3;
            __syncthreads();
            if (C.tid < 256) { const int b = C.tid >> 6, cc = C.tid & 63; float s = 0.f;
#pragma unroll
                for (int g = 0; g < 8; ++g) s += red[(g * 4 + b) * 64 + cc];
                ((float*)(ws + WS_MOD))[(size_t)(l * 4 + b) * 6144 + cb * 64 + cc] = s + a.b_ada[l * 6144 + cb * 64 + cc]; }
            __syncthreads();
        }
    }
    const int gw = C.vcu * NWAVES + C.wave, NGW = C.G * NWAVES;
    for (int tk = gw; tk < NTOK; tk += NGW) {
        if (C.lane < 32) {
            const float posf = (float)a.pos[tk];
            const float inv = exp2f(-(float)C.lane * (13.287712379549449f / 32.0f));
            const double ang = (double)(posf * inv);
            const double kq = rint(ang * 0.63661977236758134308);
            const double y = fma(-kq, 1.57079632679489661923, ang);
            const double y2 = y * y;
            const double sy = y * (1.0 + y2 * (-1.0 / 6 + y2 * (1.0 / 120 + y2 * (-1.0 / 5040 + y2 * (1.0 / 362880 - y2 * (1.0 / 39916800))))));
            const double cy = 1.0 + y2 * (-0.5 + y2 * (1.0 / 24 + y2 * (-1.0 / 720 + y2 * (1.0 / 40320 + y2 * (-1.0 / 3628800 + y2 * (1.0 / 479001600))))));
            const int q = ((int)((long long)kq)) & 3;
            const double sn = (q == 0) ? sy : (q == 1) ? cy : (q == 2) ? -sy : -cy;
            const double cs = (q == 0) ? cy : (q == 1) ? -sy : (q == 2) ? -cy : sy;
            ((float*)(ws + WS_ROPEC))[(size_t)tk * 32 + C.lane] = (float)cs;
            ((float*)(ws + WS_ROPES))[(size_t)tk * 32 + C.lane] = (float)sn;
        }
    }
    for (int i = gw * 64 + C.lane; i < 2 * 32 * 1024; i += NGW * 64) { const int l = i >> 15, e = (i >> 10) & 31, k = i & 1023; const float wv = a.w_router[(size_t)l * 32768 + k * 32 + e];
        const unsigned hi = f2bf(wv); const float lo = wv - bf2f((unsigned short)hi); ((bf16_t*)(ws + WS_WRH))[i] = (bf16_t)hi; ((bf16_t*)(ws + WS_WRL))[i] = (bf16_t)f2bf(lo); }
    LAS float* scr = (LAS float*)(C.lds + C.wave * 16384);
    constexpr int I_IN = 2 * 16 * 75, I_OUT = 2 * 16 * 32;
    for (int it = gw; it < I_IN + I_OUT; it += NGW) {
        int r = it;
        if (r < I_IN) { const int l = r / (16 * 75), q = r % (16 * 75); transpose_item<1>(a.w_in + (size_t)l * 1024 * D_IN, D_IN, (bf16_t*)(ws + WS_WIN) + (size_t)l * NPAD * 1024, scr, q / 75, q % 75, C.lane); continue; }
        r -= I_IN;
        { const int l = r / (16 * 32), q = r % (16 * 32); transpose_item<3>(a.w_out + (size_t)l * 1024 * 1024, 1024, (bf16_t*)(ws + WS_WOUT) + (size_t)l * 1024 * 1024, scr, q / 32, q % 32, C.lane); }
    }
}

struct Conv {
    const float* w1l; const float* w2l; unsigned char* w1t; unsigned char* w2t;
    int it, step, lane; bool pend;
    const float* W; unsigned char* WT; int N, map, k0, n0;
    f32x4 v4[8];
    static constexpr int NITEMS = 32 * 16 * 64 + 32 * 16 * 32;
    int it_end;
    __device__ __forceinline__ void issue() {
        if (it >= it_end) return;
        if (it < 32 * 16 * 64) { const int e = it >> 10, q = it & 1023; W = w1l + (size_t)e * 1024 * 2048; WT = w1t + (size_t)e * 2048 * 1024; N = 2048; map = 2; k0 = 64 * (q >> 6); n0 = 32 * (q & 63); }
        else { const int r = it - 32 * 16 * 64, e = r >> 9, q = r & 511; W = w2l + (size_t)e * 1024 * 1024; WT = w2t + (size_t)e * 1024 * 1024; N = 1024; map = 3; k0 = 64 * (q >> 5); n0 = 32 * (q & 31); }
        const float* src = W + (size_t)(k0 + (lane >> 3)) * N + n0 + 4 * (lane & 7);
#pragma unroll
        for (int i = 0; i < 8; ++i) v4[i] = *(const f32x4*)(src + (size_t)(8 * i) * N);
        pend = true; it += step;
    }
    __device__ __forceinline__ void finish(LAS float* scr) {
        if (!pend) return;
#pragma unroll
        for (int i = 0; i < 8; ++i) { LAS float* d = scr + ((lane >> 3) + 8 * i) * 33 + 4 * (lane & 7); d[0] = v4[i].x; d[1] = v4[i].y; d[2] = v4[i].z; d[3] = v4[i].w; }
        asm volatile("s_waitcnt lgkmcnt(0)" ::: "memory");
        const int c = lane & 7;
#pragma unroll
        for (int j = 0; j < 4; ++j) { const int n = (lane >> 3) + 8 * j; const LAS float* sp = scr + (8 * c) * 33 + n;
            u32x2 o; o.x = pk4_fp8(sp[0 * 33] * W8SCALE, sp[1 * 33] * W8SCALE, sp[2 * 33] * W8SCALE, sp[3 * 33] * W8SCALE); o.y = pk4_fp8(sp[4 * 33] * W8SCALE, sp[5 * 33] * W8SCALE, sp[6 * 33] * W8SCALE, sp[7 * 33] * W8SCALE);
            const int sc = n0 + n; const int dest = map == 2 ? w1_dest(sc) : perm_dest(sc); *(u32x2*)(WT + (size_t)dest * 1024 + k0 + 8 * c) = o; }
        asm volatile("s_waitcnt lgkmcnt(0)" ::: "memory");
        pend = false;
    }
};

__device__ __forceinline__ void norm_mod_store(const f32x4 (&v)[4], const float* g, const float* sh, const float* sc, bf16_t* urow, int lane) {
    float ss = 0.f;
#pragma unroll
    for (int j = 0; j < 4; ++j) ss += (v[j].x * v[j].x + v[j].y * v[j].y) + (v[j].z * v[j].z + v[j].w * v[j].w);
    const float rstd = 1.0f / sqrtf(wave_sum(ss) * (1.0f / D) + EPS);
#pragma unroll
    for (int j = 0; j < 4; ++j) { const int idx = 4 * lane + 256 * j; const f32x4 gv = *(const f32x4*)(g + idx), shv = *(const f32x4*)(sh + idx), scv = *(const f32x4*)(sc + idx);
        const f32x4 o = v[j] * rstd * gv * (scv + 1.0f) + shv; u32x2 w; w.x = pk2(o[0], o[1]); w.y = pk2(o[2], o[3]); *(u32x2*)(urow + idx) = w; }
}

__device__ __forceinline__ void phase_u0(const Args& a, Ctx& C) {
    const int gw = C.vcu * NWAVES + C.wave, NGW = C.G * NWAVES; const float* mod = (const float*)(C.ws + WS_MOD);
    for (int tk0 = gw; tk0 < NTOK; tk0 += 2 * NGW) {
        const bool two = (tk0 + NGW) < NTOK; const int tk1 = two ? tk0 + NGW : tk0;
        const f32x4* x0 = (const f32x4*)(a.x + (size_t)tk0 * D) + C.lane; const f32x4* x1 = (const f32x4*)(a.x + (size_t)tk1 * D) + C.lane; f32x4 v0[4], v1[4];
#pragma unroll
        for (int j = 0; j < 4; ++j) { v0[j] = x0[64 * j]; v1[j] = x1[64 * j]; }
        { const float* mb = mod + (size_t)(tk0 >> 12) * 6144; norm_mod_store(v0, a.norm1_g, mb + 0, mb + 1024, (bf16_t*)(C.ws + WS_U) + (size_t)tk0 * D, C.lane); }
        if (two) { const float* mb = mod + (size_t)(tk1 >> 12) * 6144; norm_mod_store(v1, a.norm1_g, mb + 0, mb + 1024, (bf16_t*)(C.ws + WS_U) + (size_t)tk1 * D, C.lane); }
    }
}

__device__ __forceinline__ unsigned sortable(float f) { const unsigned u = __builtin_bit_cast(unsigned, f); return (u & 0x80000000u) ? ~u : (u | 0x80000000u); }
__device__ __forceinline__ int mbcnt64(unsigned long long m) { return __builtin_amdgcn_mbcnt_hi((unsigned)(m >> 32), __builtin_amdgcn_mbcnt_lo((unsigned)m, 0)); }

constexpr int HP = 65;
__device__ __forceinline__ int wave_isum(int v) {
    v += __builtin_amdgcn_update_dpp(0, v, 0xB1, 0xF, 0xF, true);
    v += __builtin_amdgcn_update_dpp(0, v, 0x4E, 0xF, 0xF, true);
    v += __builtin_amdgcn_update_dpp(0, v, 0x141, 0xF, 0xF, true);
    v += __builtin_amdgcn_update_dpp(0, v, 0x140, 0xF, 0xF, true);
    return __builtin_amdgcn_readlane(v, 0) + __builtin_amdgcn_readlane(v, 16) + __builtin_amdgcn_readlane(v, 32) + __builtin_amdgcn_readlane(v, 48);
}
typedef float f32x16 __attribute__((ext_vector_type(16)));
__device__ __forceinline__ void transpose32(unsigned (&a)[32]) {
#pragma unroll
    for (int st = 0; st < 5; ++st) {
        const int j = 16 >> st; const unsigned m = (st == 0) ? 0x0000FFFFu : (st == 1) ? 0x00FF00FFu : (st == 2) ? 0x0F0F0F0Fu : (st == 3) ? 0x33333333u : 0x55555555u;
#pragma unroll
        for (int idx = 0; idx < 16; ++idx) { const int k = (idx / j) * 2 * j + (idx % j); const unsigned t = (a[k] ^ (a[k + j] >> j)) & m; a[k] ^= t; a[k + j] ^= (t << j); }
    }
}
__device__ __forceinline__ int wave_iscan(int v) {
    v += __builtin_amdgcn_update_dpp(0, v, 0x111, 0xF, 0xF, true);
    v += __builtin_amdgcn_update_dpp(0, v, 0x112, 0xF, 0xF, true);
    v += __builtin_amdgcn_update_dpp(0, v, 0x114, 0xF, 0xF, true);
    v += __builtin_amdgcn_update_dpp(0, v, 0x118, 0xF, 0xF, true);
    v += __builtin_amdgcn_update_dpp(0, v, 0x142, 0xA, 0xF, false);
    v += __builtin_amdgcn_update_dpp(0, v, 0x143, 0xC, 0xF, false);
    return v;
}
__device__ __forceinline__ unsigned sortable16(unsigned h) { return (h & 0x8000u) ? (~h & 0xFFFFu) : (h | 0x8000u); }
__device__ __forceinline__ unsigned short f2h_bits(float f) { const _Float16 h = (_Float16)f; unsigned short b = __builtin_bit_cast(unsigned short, h); return b == 0x8000u ? (unsigned short)0 : b; }
template <int NB>
__device__ __forceinline__ void select_bits16(const LAS unsigned short* sq, int nj, int* sel, int lane) {
    unsigned a[32];
#pragma unroll
    for (int j = 0; j < 32; ++j) { const unsigned lo = sortable16(sq[64 * j + lane]); const unsigned hi = (NB == 2) ? sortable16(sq[64 * (32 + j) + lane]) : 0u; a[j] = lo | (hi << 16); }
    transpose32(a);
    unsigned Ml = 0xFFFFFFFFu, Mh = (NB == 2) ? 0xFFFFFFFFu : 0u, Gl = 0u, Gh = 0u; unsigned T = 0u; int G = 0;
#pragma unroll
    for (int bit = 15; bit >= 0; --bit) {
        const unsigned nl = Ml & a[31 - bit], nh = Mh & a[15 - bit];
        const int tot = wave_isum(__popc(nl) + __popc(nh));
        const bool take = (G + tot) >= 256; const unsigned flip = take ? 0u : 0xFFFFFFFFu;
        T |= take ? (1u << bit) : 0u; G += take ? 0 : tot;
        Gl |= nl & flip; Gh |= nh & flip; Ml &= (a[31 - bit] ^ flip); Mh &= (a[15 - bit] ^ flip);
    }
    const int need = 256 - G;
    if (T != 0x8000u) {
        const int ceq = __popc(Ml) + __popc(Mh); const int incl = wave_iscan(ceq);
        int quota = need - (incl - ceq); quota = quota < 0 ? 0 : (quota > ceq ? ceq : quota);
        const int cnt = __popc(Gl) + __popc(Gh) + quota; const int inc2 = wave_iscan(cnt);
        int pos = inc2 - cnt;
        { unsigned mk = Gl; while (mk) { const int x = 31 - __clz((int)mk); mk &= ~(1u << x); sel[pos++] = 64 * (31 - x) + lane; } }
        if (NB == 2) { unsigned mk = Gh; while (mk) { const int x = 31 - __clz((int)mk); mk &= ~(1u << x); sel[pos++] = 64 * (63 - x) + lane; } }
        { unsigned mk = Ml; while (mk && quota > 0) { const int x = 31 - __clz((int)mk); mk &= ~(1u << x); sel[pos++] = 64 * (31 - x) + lane; --quota; } }
        if (NB == 2) { unsigned mk = Mh; while (mk && quota > 0) { const int x = 31 - __clz((int)mk); mk &= ~(1u << x); sel[pos++] = 64 * (63 - x) + lane; --quota; } }
    } else {
        int base = 0, eqseen = 0;
#pragma unroll 1
        for (int j = 0; j < nj; ++j) {
            const unsigned kj = sortable16(sq[64 * j + lane]);
            const bool gt = kj > T, eq = kj == T; const unsigned long long em = __ballot(eq);
            const bool take = gt || (eq && (eqseen + mbcnt64(em)) < need); const unsigned long long tm = __ballot(take);
            if (take) sel[base + mbcnt64(tm)] = 64 * j + lane;
            base += __popcll(tm); eqseen += __popcll(em);
        }
    }
}
constexpr int CONV_SPLIT = 16384;
constexpr int KST_ROW = 144, KST_BYTES = 64 * KST_ROW;
__device__ __forceinline__ void index_unit2(Ctx& C, int b, int cch, int sub, Conv& cv) {
    unsigned char* ws = C.ws; const int lane = C.lane, w = C.wave;
    const int tk0 = b * SEQ + 64 * cch + 8 * sub, L = 64 * (cch + 1), nj = cch + 1;
    if (L <= 256) { int* sel = (int*)(ws + WS_SEL) + (size_t)(tk0 + w) * 256; for (int i = lane; i < L; i += 64) sel[i] = i; return; }
    LAS unsigned short* sclh = (LAS unsigned short*)C.lds;
    LAS unsigned char* kst = C.lds + 65536 + w * KST_BYTES;
    {
        const int r = lane & 31, hf = lane >> 5, qq = r >> 2, h = r & 3;
        bf16x8 aq[4];
#pragma unroll
        for (int ks = 0; ks < 4; ++ks) aq[ks] = *(const bf16x8*)((const bf16_t*)(ws + WS_QI) + (size_t)(tk0 + qq) * 256 + h * 64 + 16 * ks + 8 * hf);
        f32x4 wq[4];
#pragma unroll
        for (int g = 0; g < 4; ++g) wq[g] = *(const f32x4*)((const float*)(ws + WS_WI) + (size_t)(tk0 + 2 * g + hf) * 4);
        const unsigned char* kib = ws + WS_KI + (size_t)b * SEQ * 128;
        const int ntile = 2 * nj;
        u32x4 st[8];
#define IDX2_LOAD(kta) do { const int _t1 = (kta), _t2 = ((kta) + NWAVES) < ntile ? (kta) + NWAVES : (kta); _Pragma("unroll") for (int j = 0; j < 4; ++j) { \
            st[j] = *(const u32x4*)(kib + (size_t)_t1 * 4096 + 1024 * j + 16 * lane); st[4 + j] = *(const u32x4*)(kib + (size_t)_t2 * 4096 + 1024 * j + 16 * lane); } } while (0)
        if (w < ntile) IDX2_LOAD(w);
#pragma unroll 1
        for (int kt = w; kt < ntile; kt += 2 * NWAVES) {
            const bool two = (kt + NWAVES) < ntile; const int kt2 = two ? kt + NWAVES : kt;
#pragma unroll
            for (int j = 0; j < 4; ++j) { *(LAS u32x4*)(kst + (8 * j + (lane >> 3)) * KST_ROW + 16 * (lane & 7)) = st[j]; *(LAS u32x4*)(kst + (32 + 8 * j + (lane >> 3)) * KST_ROW + 16 * (lane & 7)) = st[4 + j]; }
            if ((kt + 2 * NWAVES) < ntile) IDX2_LOAD(kt + 2 * NWAVES);
            f32x16 acc, acc2;
#pragma unroll
            for (int i = 0; i < 16; ++i) { acc[i] = 0.f; acc2[i] = 0.f; }
#pragma unroll
            for (int ks = 0; ks < 4; ++ks) { const bf16x8 b1 = *(const LAS bf16x8*)(kst + r * KST_ROW + 32 * ks + 16 * hf), b2 = *(const LAS bf16x8*)(kst + (32 + r) * KST_ROW + 32 * ks + 16 * hf);
                acc = __builtin_amdgcn_mfma_f32_32x32x16_bf16(aq[ks], b1, acc, 0, 0, 0); acc2 = __builtin_amdgcn_mfma_f32_32x32x16_bf16(aq[ks], b2, acc2, 0, 0, 0); }
#pragma unroll
            for (int g = 0; g < 4; ++g) {
                const float sc = fmaxf(acc[4 * g + 0], 0.f) * wq[g][0] + fmaxf(acc[4 * g + 1], 0.f) * wq[g][1] + fmaxf(acc[4 * g + 2], 0.f) * wq[g][2] + fmaxf(acc[4 * g + 3], 0.f) * wq[g][3];
                sclh[(2 * g + hf) * 4096 + 32 * kt + r] = f2h_bits(sc);
                const float sc2 = fmaxf(acc2[4 * g + 0], 0.f) * wq[g][0] + fmaxf(acc2[4 * g + 1], 0.f) * wq[g][1] + fmaxf(acc2[4 * g + 2], 0.f) * wq[g][2] + fmaxf(acc2[4 * g + 3], 0.f) * wq[g][3];
                if (two) sclh[(2 * g + hf) * 4096 + 32 * kt2 + r] = f2h_bits(sc2);
            }
        }
#undef IDX2_LOAD
        const int njp = nj <= 32 ? 32 : 64;
        for (int j = nj; j < njp; ++j) sclh[w * 4096 + 64 * j + lane] = (unsigned short)0xFBFFu;
    }
    __syncthreads();
    {
        const LAS unsigned short* sq = sclh + w * 4096; int* sel = (int*)(ws + WS_SEL) + (size_t)(tk0 + w) * 256;
        cv.issue();
        if (nj <= 32) select_bits16<1>(sq, nj, sel, lane); else select_bits16<2>(sq, nj, sel, lane);
        cv.finish((LAS float*)kst);
    }
    __syncthreads();
}

typedef short s16x4 __attribute__((ext_vector_type(4)));
constexpr int VROW = 272;
__device__ __forceinline__ void attend_query_mfma(Ctx& C, int tk, LAS unsigned char* vs, Conv& cv) {
    unsigned char* ws = C.ws; const int lane = C.lane, c = lane & 15, g = lane >> 4;
    const int tpos = tk & (SEQ - 1), b = tk >> 12, L = 64 * ((tpos >> 6) + 1), nsel = L < 256 ? L : 256;
    const bf16_t* kb = (const bf16_t*)(ws + WS_K) + (size_t)b * SEQ * 128; const bf16_t* vb = (const bf16_t*)(ws + WS_V) + (size_t)b * SEQ * 128;
    int selr[4];
    { const int* sg = (const int*)(ws + WS_SEL) + (size_t)tk * 256;
#pragma unroll
      for (int i = 0; i < 4; ++i) selr[i] = (64 * i + lane) < nsel ? sg[64 * i + lane] : 0; }
    bf16x8 bq0[2], bq1[2];
    { const bf16_t* qp = (const bf16_t*)(ws + WS_Q) + (size_t)tk * 512 + (c & 7) * 64 + 8 * g; const bf16x8 z = (bf16x8){0, 0, 0, 0, 0, 0, 0, 0};
#pragma unroll
      for (int ks = 0; ks < 2; ++ks) { const bf16x8 q = *(const bf16x8*)(qp + 32 * ks); bq0[ks] = (c < 4) ? q : z; bq1[ks] = (c >= 4 && c < 8) ? q : z; } }
    cv.issue();
    f32x4 acc[16];
#pragma unroll
    for (int kt = 0; kt < 16; ++kt) {
        if ((kt & 3) == 0) asm volatile("" ::: "memory");
        const int key = __shfl(selr[kt >> 2], 16 * (kt & 3) + c);
        const bf16_t* kr = kb + (size_t)key * 128 + 8 * g;
        const bf16x8 a00 = *(const bf16x8*)(kr), a01 = *(const bf16x8*)(kr + 32), a10 = *(const bf16x8*)(kr + 64), a11 = *(const bf16x8*)(kr + 96);
        f32x4 t = (f32x4){0.f, 0.f, 0.f, 0.f};
        t = __builtin_amdgcn_mfma_f32_16x16x32_bf16(a00, bq0[0], t, 0, 0, 0); t = __builtin_amdgcn_mfma_f32_16x16x32_bf16(a01, bq0[1], t, 0, 0, 0);
        t = __builtin_amdgcn_mfma_f32_16x16x32_bf16(a10, bq1[0], t, 0, 0, 0); t = __builtin_amdgcn_mfma_f32_16x16x32_bf16(a11, bq1[1], t, 0, 0, 0);
        acc[kt] = t;
    }
    asm volatile("" ::: "memory"); cv.finish((LAS float*)vs); cv.issue();
    { const int lim = nsel - 4 * g;
#pragma unroll
      for (int kt = 0; kt < 16; ++kt)
#pragma unroll
        for (int r = 0; r < 4; ++r) acc[kt][r] = (16 * kt + r < lim) ? acc[kt][r] : -1e30f; }
    float m = -1e30f;
#pragma unroll
    for (int kt = 0; kt < 16; ++kt) m = fmaxf(m, fmaxf(fmaxf(acc[kt][0], acc[kt][1]), fmaxf(acc[kt][2], acc[kt][3])));
    m = fmaxf(m, __shfl_xor(m, 16)); m = fmaxf(m, __shfl_xor(m, 32));
    float sum = 0.f;
#pragma unroll
    for (int kt = 0; kt < 16; ++kt)
#pragma unroll
        for (int r = 0; r < 4; ++r) { const float pv = __expf(acc[kt][r] - m); acc[kt][r] = pv; sum += pv; }
    sum += __shfl_xor(sum, 16); sum += __shfl_xor(sum, 32);
    const float inv = 1.0f / sum;
    bf16x8 bp[8];
#pragma unroll
    for (int T = 0; T < 8; ++T) { u32x4 w; w.x = cvt_pk_bf16(acc[2 * T][0], acc[2 * T][1]); w.y = cvt_pk_bf16(acc[2 * T][2], acc[2 * T][3]); w.z = cvt_pk_bf16(acc[2 * T + 1][0], acc[2 * T + 1][1]); w.w = cvt_pk_bf16(acc[2 * T + 1][2], acc[2 * T + 1][3]);
        bp[T] = __builtin_bit_cast(bf16x8, w); }
    f32x4 ao0[4], ao1[4];
#pragma unroll
    for (int dt = 0; dt < 4; ++dt) { ao0[dt] = (f32x4){0.f, 0.f, 0.f, 0.f}; ao1[dt] = (f32x4){0.f, 0.f, 0.f, 0.f}; }
    const int q4 = c >> 2, p4 = c & 3;
    u32x4 vst[8];
#define ATT_VLOAD(T) do { _Pragma("unroll") for (int i = 0; i < 8; ++i) { const int row = g + 4 * i; \
        const int key = __shfl(selr[(T) >> 1], 32 * ((T) & 1) + row); vst[i] = *(const u32x4*)(vb + (size_t)key * 128 + 8 * c); } } while (0)
    ATT_VLOAD(0);
#pragma unroll
    for (int T = 0; T < 8; ++T) {
        LAS unsigned char* buf = vs + (T & 1) * (32 * VROW);
        asm volatile("" ::: "memory");
#pragma unroll
        for (int i = 0; i < 8; ++i) *(LAS u32x4*)(buf + (g + 4 * i) * VROW + 16 * c) = vst[i];
        if (T < 7) ATT_VLOAD(T + 1);
#pragma unroll
        for (int n = 0; n < 2; ++n)
#pragma unroll
            for (int dt = 0; dt < 4; ++dt) {
                LAS s16x4* p0 = (LAS s16x4*)(buf + (4 * g + q4) * VROW + (n * 64 + 16 * dt + 4 * p4) * 2);
                const s16x4 lo = __builtin_amdgcn_ds_read_tr16_b64_v4i16(p0), hi = __builtin_amdgcn_ds_read_tr16_b64_v4i16((LAS s16x4*)((LAS unsigned char*)p0 + 16 * VROW));
                const bf16x8 av = (bf16x8){lo[0], lo[1], lo[2], lo[3], hi[0], hi[1], hi[2], hi[3]};
                if (n == 0) ao0[dt] = __builtin_amdgcn_mfma_f32_16x16x32_bf16(av, bp[T], ao0[dt], 0, 0, 0);
                else ao1[dt] = __builtin_amdgcn_mfma_f32_16x16x32_bf16(av, bp[T], ao1[dt], 0, 0, 0);
            }
    }
#undef ATT_VLOAD
    asm volatile("" ::: "memory"); cv.finish((LAS float*)vs);
    if (c < 8) {
        bf16_t* mo = (bf16_t*)(ws + WS_MIX) + (size_t)tk * D + c * 64 + 4 * g;
#pragma unroll
        for (int dt = 0; dt < 4; ++dt) { f32x4 o; o[0] = (c < 4 ? ao0[dt][0] : ao1[dt][0]) * inv; o[1] = (c < 4 ? ao0[dt][1] : ao1[dt][1]) * inv; o[2] = (c < 4 ? ao0[dt][2] : ao1[dt][2]) * inv; o[3] = (c < 4 ? ao0[dt][3] : ao1[dt][3]) * inv; u32x2 w; w.x = cvt_pk_bf16(o[0], o[1]); w.y = cvt_pk_bf16(o[2], o[3]); *(u32x2*)(mo + 16 * dt) = w; }
    }
}

__device__ __forceinline__ void pool_wave(const Args& a, Ctx& C, int l) {
    unsigned char* ws = C.ws; const int lane = C.lane;
    const int gwv = blockIdx.x * NWAVES + C.wave, g = gwv & 3, widx = gwv >> 2, nw = (C.G * NWAVES) >> 2, w = 2 << g;
    float pwr[64];
#pragma unroll
    for (int c = 0; c < 64; ++c) pwr[c] = a.pool_w[(size_t)(l * 4 + g) * 4096 + c * 64 + lane];
    const float psc = a.pool_scale[l * 256 + g * 64 + lane];
    const float* ubg = (const float*)(ws + WS_UB) + g * 64 + lane;
    for (int tile = widx; tile < NTOK / 8; tile += nw) {
        const int tok0 = tile * 8, tp0 = tok0 & (SEQ - 1);
        float row[23];
#pragma unroll
        for (int r = 0; r < 23; ++r) { const int tp = tp0 - 15 + r; row[r] = (tp >= 0) ? ubg[(size_t)(tok0 - 15 + r) * 256] : 0.f; }
        float pooled[8];
#pragma unroll
        for (int t = 0; t < 8; ++t) {
            float sm = 0.f;
#pragma unroll
            for (int i = 0; i < 16; ++i) if (i < w) sm += row[15 + t - i];
            const int tpos = tp0 + t; const int wl = (tpos + 1) < w ? (tpos + 1) : w;
            pooled[t] = sm * (1.0f / (float)wl) - row[15 + t];
        }
        float y[8] = {0.f, 0.f, 0.f, 0.f, 0.f, 0.f, 0.f, 0.f};
#pragma unroll
        for (int c = 0; c < 64; ++c) {
#pragma unroll
            for (int t = 0; t < 8; ++t) y[t] += __builtin_bit_cast(float, __builtin_amdgcn_readlane(__builtin_bit_cast(int, pooled[t]), c)) * pwr[c];
        }
        bf16_t* mo = (bf16_t*)(ws + WS_MIX) + (size_t)tok0 * D + 512 + g * 64 + lane;
#pragma unroll
        for (int t = 0; t < 8; ++t) mo[(size_t)t * D] = (bf16_t)f2bf(y[t] * psc);
    }
}

__device__ __forceinline__ float row_shr_add(float x, int) { return x; }
template <int N> __device__ __forceinline__ float dpp_row_shr(float x) { return __builtin_bit_cast(float, __builtin_amdgcn_update_dpp(0, __builtin_bit_cast(int, x), 0x110 + N, 0xF, 0xF, true)); }
__device__ __forceinline__ float row_scan16(float x) { x += dpp_row_shr<1>(x); x += dpp_row_shr<2>(x); x += dpp_row_shr<4>(x); x += dpp_row_shr<8>(x); return x; }
__device__ __forceinline__ float row_last16(float x) { return __builtin_bit_cast(float, __builtin_amdgcn_update_dpp(0, __builtin_bit_cast(int, x), 0x15F, 0xF, 0xF, true)); }
__device__ __forceinline__ float row_sum16(float v) {
    v += __builtin_bit_cast(float, __builtin_amdgcn_update_dpp(0, __builtin_bit_cast(int, v), 0xB1, 0xF, 0xF, true));
    v += __builtin_bit_cast(float, __builtin_amdgcn_update_dpp(0, __builtin_bit_cast(int, v), 0x4E, 0xF, 0xF, true));
    v += __builtin_bit_cast(float, __builtin_amdgcn_update_dpp(0, __builtin_bit_cast(int, v), 0x141, 0xF, 0xF, true));
    v += __builtin_bit_cast(float, __builtin_amdgcn_update_dpp(0, __builtin_bit_cast(int, v), 0x140, 0xF, 0xF, true));
    return v;
}
__device__ __forceinline__ void hgrn_out3(const Args& a, Ctx& C, int l, int item, LAS unsigned char* kls) {
    const int lane = C.lane, tt = lane & 15, g = lane >> 4, c = item & 63, hh = (item >> 6) & 3, b = item >> 8, bh = b * 4 + hh, cg = c >> 2, ci = c & 3;
    const float* HG = (const float*)(C.ws + WS_HG); const float* HR = (const float*)(C.ws + WS_HL); const float* HE = (const float*)(C.ws + WS_HD);
    float lb[16];
#pragma unroll
    for (int e = 0; e < 16; ++e) { const int kk = hh * 64 + 16 * (e >> 2) + 4 * g + (e & 3); lb[e] = (l == 1) ? 1.0f / (1.0f + expf(a.lb_logits[kk] - a.lb_logits[256 + kk])) : 0.f; }
    f32x4 S[4][4];
#pragma unroll
    for (int vq = 0; vq < 4; ++vq)
#pragma unroll
        for (int kt = 0; kt < 4; ++kt) S[vq][kt] = (f32x4){0.f, 0.f, 0.f, 0.f};
    const int nstep = cg + (ci > 0 ? 1 : 0);
#pragma unroll 1
    for (int st = 0; st < nstep; ++st) {
        const int chn = (st < cg) ? (4 * st + 3) : (4 * cg + ci - 1); const size_t ch = (size_t)(bh * 64 + chn);
        const float* hr = HR + ch * 4096 + (g * 16 + tt) * 4; const float* he = HE + ch * 64 + 4 * g;
        f32x4 ev[4];
#pragma unroll
        for (int kt = 0; kt < 4; ++kt) ev[kt] = *(const f32x4*)(he + 16 * kt);
#pragma unroll
        for (int vq = 0; vq < 4; ++vq)
#pragma unroll
            for (int kt = 0; kt < 4; ++kt) S[vq][kt] = S[vq][kt] * ev[kt] + *(const f32x4*)(hr + (vq * 4 + kt) * 256);
    }
    const size_t tok0 = (size_t)b * SEQ + c * 64;
#pragma unroll 1
    for (int sb = 0; sb < 4; ++sb) {
        const size_t tok = tok0 + 16 * sb + tt; const float* row = HG + tok * 1024 + hh * 64 + 4 * g;
        float qh[16], kt_[16], kp[16], dd[16];
#pragma unroll
        for (int e4 = 0; e4 < 4; ++e4) {
            const f32x4 q4 = *(const f32x4*)(row + 16 * e4), z4 = *(const f32x4*)(row + 256 + 16 * e4);
#pragma unroll
            for (int j = 0; j < 4; ++j) { const int e = 4 * e4 + j; const float lbe = lb[e];
                const float sg = __builtin_amdgcn_rcpf(1.0f + __expf(-z4[j])), sn = __builtin_amdgcn_rcpf(1.0f + __expf(z4[j]));
                const float lf = __logf(lbe + (1.0f - lbe) * sg), kin = (1.0f - lbe) * sn;
                const float cc = row_scan16(lf), c15 = row_last16(cc);
                qh[e] = siluf_(q4[j]) * __expf(cc); kt_[e] = kin * __expf(fminf(-cc, 80.0f)); kp[e] = kin * __expf(c15 - cc); dd[e] = __expf(c15); }
        }
        bf16x8 Qf[2], Kf[2];
#pragma unroll
        for (int ks = 0; ks < 2; ++ks) { u32x4 wq, wk;
            wq.x = pk2(qh[8 * ks + 0], qh[8 * ks + 1]); wq.y = pk2(qh[8 * ks + 2], qh[8 * ks + 3]); wq.z = pk2(qh[8 * ks + 4], qh[8 * ks + 5]); wq.w = pk2(qh[8 * ks + 6], qh[8 * ks + 7]);
            wk.x = pk2(kt_[8 * ks + 0], kt_[8 * ks + 1]); wk.y = pk2(kt_[8 * ks + 2], kt_[8 * ks + 3]); wk.z = pk2(kt_[8 * ks + 4], kt_[8 * ks + 5]); wk.w = pk2(kt_[8 * ks + 6], kt_[8 * ks + 7]);
            Qf[ks] = __builtin_bit_cast(bf16x8, wq); Kf[ks] = __builtin_bit_cast(bf16x8, wk); }
#pragma unroll
        for (int e4 = 0; e4 < 4; ++e4) { u32x2 w; w.x = pk2(kp[4 * e4 + 0], kp[4 * e4 + 1]); w.y = pk2(kp[4 * e4 + 2], kp[4 * e4 + 3]); *(LAS u32x2*)(kls + tt * 144 + (16 * e4 + 4 * g) * 2) = w; }
        f32x4 at = (f32x4){0.f, 0.f, 0.f, 0.f};
        at = __builtin_amdgcn_mfma_f32_16x16x32_bf16(Kf[0], Qf[0], at, 0, 0, 0); at = __builtin_amdgcn_mfma_f32_16x16x32_bf16(Kf[1], Qf[1], at, 0, 0, 0);
#pragma unroll
        for (int r = 0; r < 4; ++r) at[r] = (4 * g + r <= tt) ? at[r] : 0.f;
        u32x4 wa; wa.x = pk2(at[0], at[1]); wa.y = pk2(at[2], at[3]); wa.z = 0u; wa.w = 0u; const bf16x8 Af = __builtin_bit_cast(bf16x8, wa);
        bf16x8 Vf[4];
        { const float* vp = HG + (tok0 + 16 * sb + 4 * g) * 1024 + 512 + hh * 64 + tt;
#pragma unroll
          for (int vq = 0; vq < 4; ++vq) { u32x4 w; w.x = pk2(vp[16 * vq], vp[1024 + 16 * vq]); w.y = pk2(vp[2048 + 16 * vq], vp[3072 + 16 * vq]); w.z = 0u; w.w = 0u; Vf[vq] = __builtin_bit_cast(bf16x8, w); } }
        f32x4 O[4];
#pragma unroll
        for (int vq = 0; vq < 4; ++vq) {
            u32x4 s0, s1; s0.x = pk2(S[vq][0][0], S[vq][0][1]); s0.y = pk2(S[vq][0][2], S[vq][0][3]); s0.z = pk2(S[vq][1][0], S[vq][1][1]); s0.w = pk2(S[vq][1][2], S[vq][1][3]);
            s1.x = pk2(S[vq][2][0], S[vq][2][1]); s1.y = pk2(S[vq][2][2], S[vq][2][3]); s1.z = pk2(S[vq][3][0], S[vq][3][1]); s1.w = pk2(S[vq][3][2], S[vq][3][3]);
            f32x4 o = (f32x4){0.f, 0.f, 0.f, 0.f};
            o = __builtin_amdgcn_mfma_f32_16x16x32_bf16(Qf[0], __builtin_bit_cast(bf16x8, s0), o, 0, 0, 0); o = __builtin_amdgcn_mfma_f32_16x16x32_bf16(Qf[1], __builtin_bit_cast(bf16x8, s1), o, 0, 0, 0);
            o = __builtin_amdgcn_mfma_f32_16x16x32_bf16(Af, Vf[vq], o, 0, 0, 0); O[vq] = o; }
        { float rs[4];
#pragma unroll
          for (int r = 0; r < 4; ++r) { float ss = O[0][r] * O[0][r] + O[1][r] * O[1][r] + O[2][r] * O[2][r] + O[3][r] * O[3][r]; ss = row_sum16(ss); rs[r] = 1.0f / sqrtf(ss * (1.0f / 64.0f) + EPS); }
          const float* gp = HG + (tok0 + 16 * sb + 4 * g) * 1024 + 768 + hh * 64 + tt; bf16_t* mo = (bf16_t*)(C.ws + WS_MIX) + (tok0 + 16 * sb + 4 * g) * D + 768 + hh * 64 + tt;
#pragma unroll
          for (int vq = 0; vq < 4; ++vq) { const float ngv = a.hgrn_g[l * 64 + 16 * vq + tt];
#pragma unroll
            for (int r = 0; r < 4; ++r) mo[(size_t)r * D + 16 * vq] = (bf16_t)f2bf(O[vq][r] * rs[r] * ngv * siluf_(gp[(size_t)r * 1024 + 16 * vq])); } }
        asm volatile("s_waitcnt lgkmcnt(0)" ::: "memory");
#pragma unroll
        for (int kt = 0; kt < 4; ++kt) {
            const s16x4 t4 = __builtin_amdgcn_ds_read_tr16_b64_v4i16((LAS s16x4*)(kls + (4 * g + (tt >> 2)) * 144 + (16 * kt + 4 * (tt & 3)) * 2));
            const bf16x8 Ktf = (bf16x8){t4[0], t4[1], t4[2], t4[3], 0, 0, 0, 0};
            const f32x4 dv = (f32x4){dd[4 * kt + 0], dd[4 * kt + 1], dd[4 * kt + 2], dd[4 * kt + 3]};
#pragma unroll
            for (int vq = 0; vq < 4; ++vq) S[vq][kt] = __builtin_amdgcn_mfma_f32_16x16x32_bf16(Ktf, Vf[vq], S[vq][kt] * dv, 0, 0, 0);
        }
        asm volatile("s_waitcnt lgkmcnt(0)" ::: "memory");
    }
}

__device__ __forceinline__ void hgrn_local4(const Args& a, Ctx& C, int l, int item, LAS unsigned char* kls) {
    const int lane = C.lane, tt = lane & 15, g = lane >> 4, vq = item & 3, cg = (item >> 2) & 15, hh = (item >> 6) & 3, b = item >> 8, bh = b * 4 + hh;
    const float* HG = (const float*)(C.ws + WS_HG);
    float lb[16], ecum[16];
#pragma unroll
    for (int e = 0; e < 16; ++e) { const int kk = hh * 64 + 16 * (e >> 2) + 4 * g + (e & 3); lb[e] = (l == 1) ? 1.0f / (1.0f + expf(a.lb_logits[kk] - a.lb_logits[256 + kk])) : 0.f; ecum[e] = 1.0f; }
    f32x4 S[4];
#pragma unroll
    for (int kt = 0; kt < 4; ++kt) S[kt] = (f32x4){0.f, 0.f, 0.f, 0.f};
    const size_t tokg = (size_t)b * SEQ + (size_t)cg * 256;
    f32x4 zc[4]; float vc[4];
#define HL4_LOAD(zd, vd, sbi) do { const size_t _t0 = tokg + 16 * (sbi); const float* _r = HG + (_t0 + tt) * 1024 + hh * 64 + 4 * g + 256; \
        _Pragma("unroll") for (int e4 = 0; e4 < 4; ++e4) zd[e4] = *(const f32x4*)(_r + 16 * e4); \
        const float* _v = HG + (_t0 + 4 * g) * 1024 + 512 + hh * 64 + 16 * vq + tt; vd[0] = _v[0]; vd[1] = _v[1024]; vd[2] = _v[2048]; vd[3] = _v[3072]; } while (0)
    HL4_LOAD(zc, vc, 0);
#pragma unroll 1
    for (int ci = 0; ci < 4; ++ci) {
        const int c = 4 * cg + ci;
#pragma unroll 1
        for (int sb = 0; sb < 4; ++sb) {
            const int sbi = 4 * ci + sb; f32x4 zn[4]; float vn[4];
            if (sbi < 15) HL4_LOAD(zn, vn, sbi + 1); else {
#pragma unroll
                for (int e4 = 0; e4 < 4; ++e4) { zn[e4] = zc[e4]; vn[e4] = vc[e4]; } }
            float kp[16], dd[16];
#pragma unroll
            for (int e4 = 0; e4 < 4; ++e4) { const f32x4 z4 = zc[e4];
#pragma unroll
                for (int j = 0; j < 4; ++j) { const int e = 4 * e4 + j; const float lbe = lb[e];
                    const float sg = __builtin_amdgcn_rcpf(1.0f + __expf(-z4[j])), sn = __builtin_amdgcn_rcpf(1.0f + __expf(z4[j]));
                    const float lf = __logf(lbe + (1.0f - lbe) * sg), kin = (1.0f - lbe) * sn;
                    const float cc = row_scan16(lf), c15 = row_last16(cc);
                    kp[e] = kin * __expf(c15 - cc); dd[e] = __expf(c15); ecum[e] *= dd[e]; } }
#pragma unroll
            for (int e4 = 0; e4 < 4; ++e4) { u32x2 w; w.x = pk2(kp[4 * e4 + 0], kp[4 * e4 + 1]); w.y = pk2(kp[4 * e4 + 2], kp[4 * e4 + 3]); *(LAS u32x2*)(kls + tt * 144 + (16 * e4 + 4 * g) * 2) = w; }
            bf16x8 Vf; { u32x4 w; w.x = pk2(vc[0], vc[1]); w.y = pk2(vc[2], vc[3]); w.z = 0u; w.w = 0u; Vf = __builtin_bit_cast(bf16x8, w); }
            asm volatile("s_waitcnt lgkmcnt(0)" ::: "memory");
#pragma unroll
            for (int kt = 0; kt < 4; ++kt) {
                const s16x4 t4 = __builtin_amdgcn_ds_read_tr16_b64_v4i16((LAS s16x4*)(kls + (4 * g + (tt >> 2)) * 144 + (16 * kt + 4 * (tt & 3)) * 2));
                const bf16x8 Ktf = (bf16x8){t4[0], t4[1], t4[2], t4[3], 0, 0, 0, 0};
                const f32x4 dv = (f32x4){dd[4 * kt + 0], dd[4 * kt + 1], dd[4 * kt + 2], dd[4 * kt + 3]};
                S[kt] = __builtin_amdgcn_mfma_f32_16x16x32_bf16(Ktf, Vf, S[kt] * dv, 0, 0, 0);
            }
            asm volatile("s_waitcnt lgkmcnt(0)" ::: "memory");
#pragma unroll
            for (int e4 = 0; e4 < 4; ++e4) { zc[e4] = zn[e4]; vc[e4] = vn[e4]; }
        }
        const size_t ch = (size_t)(bh * 64 + c);
        float* hr = (float*)(C.ws + WS_HL) + ch * 4096 + (g * 16 + tt) * 4;
#pragma unroll
        for (int kt = 0; kt < 4; ++kt) *(f32x4*)(hr + (vq * 4 + kt) * 256) = S[kt];
        if (vq == 0 && tt == 0) { float* he = (float*)(C.ws + WS_HD) + ch * 64 + 4 * g;
#pragma unroll
            for (int kt = 0; kt < 4; ++kt) *(f32x4*)(he + 16 * kt) = (f32x4){ecum[4 * kt + 0], ecum[4 * kt + 1], ecum[4 * kt + 2], ecum[4 * kt + 3]}; }
    }
#undef HL4_LOAD
}

__device__ __forceinline__ void phase_mix1(const Args& a, Ctx& C, int l) {
    if (C.wave < 4) for (int it = blockIdx.x * 4 + C.wave; it < 1024; it += C.G * 4) hgrn_local4(a, C, l, it, C.lds + C.wave * 4096);
    __syncthreads();
    pool_wave(a, C, l);
    __syncthreads();
    Conv cv; cv.w1l = a.w1 + (size_t)l * 32 * 1024 * 2048; cv.w2l = a.w2 + (size_t)l * 32 * 1024 * 1024; cv.w1t = C.ws + WS_W1 + (size_t)l * 32 * 2048 * 1024; cv.w2t = C.ws + WS_W2 + (size_t)l * 32 * 1024 * 1024;
    cv.it = blockIdx.x * NWAVES + C.wave; cv.step = C.G * NWAVES; cv.lane = C.lane; cv.pend = false; cv.it_end = CONV_SPLIT;
    for (int base = 0; base < 2048; base += 2 * C.G) {
        const int u1 = base + (int)blockIdx.x, u2 = base + 2 * C.G - 1 - (int)blockIdx.x;
        if (u1 < 2048) index_unit2(C, (u1 >> 3) & 3, u1 >> 5, u1 & 7, cv);
        if (u2 < 2048) index_unit2(C, (u2 >> 3) & 3, u2 >> 5, u2 & 7, cv);
    }
    for (;;) { cv.issue(); if (!cv.pend) break; cv.finish((LAS float*)(C.lds + 65536 + C.wave * KST_BYTES)); }
}
__device__ __forceinline__ void phase_mix2(const Args& a, Ctx& C, int l) {
    LAS int* qctr = (LAS int*)(C.lds + LDS_BYTES - 64 + 16);
    if (C.tid == 0) *qctr = 0;
    __syncthreads();
    if (C.wave < 4) for (int it = blockIdx.x * 4 + C.wave; it < 1024; it += C.G * 4) hgrn_out3(a, C, l, it, C.lds + C.wave * (2 * 32 * VROW));
    LAS unsigned char* vs = C.lds + C.wave * (2 * 32 * VROW);
    const int gw = blockIdx.x * NWAVES + C.wave, NGW = C.G * NWAVES;
    Conv cv; cv.w1l = a.w1 + (size_t)l * 32 * 1024 * 2048; cv.w2l = a.w2 + (size_t)l * 32 * 1024 * 1024; cv.w1t = C.ws + WS_W1 + (size_t)l * 32 * 2048 * 1024; cv.w2t = C.ws + WS_W2 + (size_t)l * 32 * 1024 * 1024;
    cv.it = CONV_SPLIT + gw; cv.step = NGW; cv.lane = C.lane; cv.pend = false; cv.it_end = Conv::NITEMS;
    for (;;) {
        int n = 0; if (C.lane == 0) n = __hip_atomic_fetch_add(qctr, 1, __ATOMIC_RELAXED, __HIP_MEMORY_SCOPE_WORKGROUP);
        n = __builtin_amdgcn_readfirstlane(n);
        const int tk = (int)blockIdx.x * NWAVES + (n & 7) + NGW * (n >> 3);
        if (tk >= NTOK) break;
        attend_query_mfma(C, tk, vs, cv);
    }
    for (;;) { cv.finish((LAS float*)vs); cv.issue(); if (!cv.pend) break; }
}

constexpr int URS = 2064;
__device__ __forceinline__ void phase_router2(const Args& a, Ctx& C, int l) {
    unsigned char* ws = C.ws; const int lane = C.lane, w = C.wave, tid = C.tid;
    LAS unsigned char* uh = C.lds; LAS unsigned char* ul = uh + 16 * URS; LAS float* part = (LAS float*)(ul + 16 * URS);
    LAS int* hist = (LAS int*)(part + 8 * 16 * 32);
    LAS int* asg = hist + 64;
    LAS float* asgg = (LAS float*)(asg + 2 * 1024);
    const float* mod = (const float*)(ws + WS_MOD); const float* H = (const float*)(ws + WS_H);
    const bf16_t* wrh = (const bf16_t*)(ws + WS_WRH) + (size_t)l * 32768; const bf16_t* wrl = (const bf16_t*)(ws + WS_WRL) + (size_t)l * 32768;
    unsigned* cnt = (unsigned*)(ws + WS_CTL) + CW_CNT + l * 32 * 64;
    const int ntile_all = NTOK / 16;
    bf16x8 wbh0[4], wbl0[4], wbh1[4], wbl1[4];
    { const int c = lane & 15, g = lane >> 4;
#pragma unroll
      for (int kk = 0; kk < 4; ++kk) { const int ks = 4 * w + kk;
          wbh0[kk] = *(const bf16x8*)(wrh + (size_t)c * 1024 + 32 * ks + 8 * g); wbl0[kk] = *(const bf16x8*)(wrl + (size_t)c * 1024 + 32 * ks + 8 * g);
          wbh1[kk] = *(const bf16x8*)(wrh + (size_t)(c + 16) * 1024 + 32 * ks + 8 * g); wbl1[kk] = *(const bf16x8*)(wrl + (size_t)(c + 16) * 1024 + 32 * ks + 8 * g); } }
    for (int tile0 = blockIdx.x; tile0 < ntile_all; tile0 += 16 * C.G) {
        if (tid < 64) hist[tid] = 0;
        __syncthreads();
        int nt_here = 0;
        f32x4 hv[2][4];
#pragma unroll
        for (int hf = 0; hf < 2; ++hf) { const f32x4* hr = (const f32x4*)(H + (size_t)(tile0 * 16 + 2 * w + hf) * D) + lane;
#pragma unroll
            for (int j = 0; j < 4; ++j) hv[hf][j] = hr[64 * j]; }
        for (int tile = tile0; tile < ntile_all && nt_here < 16; tile += C.G, ++nt_here) {
            const int tok0 = tile * 16;
#pragma unroll
            for (int hf = 0; hf < 2; ++hf) {
                const int tr = 2 * w + hf, tk = tok0 + tr, b = tk >> 12; f32x4 v[4];
#pragma unroll
                for (int j = 0; j < 4; ++j) v[j] = hv[hf][j];
                float ss = 0.f;
#pragma unroll
                for (int j = 0; j < 4; ++j) ss += (v[j].x * v[j].x + v[j].y * v[j].y) + (v[j].z * v[j].z + v[j].w * v[j].w);
                const float rstd = 1.0f / sqrtf(wave_sum(ss) * (1.0f / D) + EPS);
                const float* mb = mod + (size_t)(l * 4 + b) * 6144; unsigned char* u8row = ws + WS_U + (size_t)tk * D;
#pragma unroll
                for (int j = 0; j < 4; ++j) { const int idx = 4 * lane + 256 * j; const f32x4 gv = *(const f32x4*)(a.norm2_g + l * 1024 + idx), shv = *(const f32x4*)(mb + 3072 + idx), scv = *(const f32x4*)(mb + 4096 + idx);
                    const f32x4 o = v[j] * rstd * gv * (scv + 1.0f) + shv; u32x2 hi; hi.x = pk2(o[0], o[1]); hi.y = pk2(o[2], o[3]); *(unsigned*)(u8row + idx) = pk4_fp8(o[0], o[1], o[2], o[3]);
                    u32x2 lo; lo.x = pk2(o[0] - bflo(hi.x), o[1] - bfhi(hi.x)); lo.y = pk2(o[2] - bflo(hi.y), o[3] - bfhi(hi.y));
                    *(LAS u32x2*)(uh + tr * URS + idx * 2) = hi; *(LAS u32x2*)(ul + tr * URS + idx * 2) = lo; }
            }
            { const int ntile2 = tile + C.G; if (ntile2 < ntile_all && nt_here + 1 < 16) {
#pragma unroll
                for (int hf = 0; hf < 2; ++hf) { const f32x4* hr = (const f32x4*)(H + (size_t)(ntile2 * 16 + 2 * w + hf) * D) + lane;
#pragma unroll
                    for (int j = 0; j < 4; ++j) hv[hf][j] = hr[64 * j]; } } }
            __syncthreads();
            {
                const int c = lane & 15, g = lane >> 4; f32x4 acc0 = (f32x4){0.f, 0.f, 0.f, 0.f}, acc1 = acc0;
#pragma unroll
                for (int kk = 0; kk < 4; ++kk) { const int ks = 4 * w + kk;
                    const bf16x8 ah = *(const LAS bf16x8*)(uh + c * URS + (32 * ks + 8 * g) * 2), al = *(const LAS bf16x8*)(ul + c * URS + (32 * ks + 8 * g) * 2);
                    acc0 = __builtin_amdgcn_mfma_f32_16x16x32_bf16(al, wbh0[kk], acc0, 0, 0, 0); acc0 = __builtin_amdgcn_mfma_f32_16x16x32_bf16(ah, wbl0[kk], acc0, 0, 0, 0); acc0 = __builtin_amdgcn_mfma_f32_16x16x32_bf16(ah, wbh0[kk], acc0, 0, 0, 0);
                    acc1 = __builtin_amdgcn_mfma_f32_16x16x32_bf16(al, wbh1[kk], acc1, 0, 0, 0); acc1 = __builtin_amdgcn_mfma_f32_16x16x32_bf16(ah, wbl1[kk], acc1, 0, 0, 0); acc1 = __builtin_amdgcn_mfma_f32_16x16x32_bf16(ah, wbh1[kk], acc1, 0, 0, 0); }
#pragma unroll
                for (int r = 0; r < 4; ++r) { part[(w * 16 + 4 * g + r) * 32 + c] = acc0[r]; part[(w * 16 + 4 * g + r) * 32 + 16 + c] = acc1[r]; }
            }
            __syncthreads();
            {
                const int e = lane & 31, hf = lane >> 5, tr = 2 * w + hf; float val = a.b_router[l * 32 + e];
#pragma unroll
                for (int ww = 0; ww < 8; ++ww) val += part[(ww * 16 + tr) * 32 + e];
                float tv[4]; int te[4];
#pragma unroll
                for (int k = 0; k < 4; ++k) {
                    float bv = val; int bi = e;
#pragma unroll
                    for (int o = 1; o < 32; o <<= 1) { const float ov = __shfl_xor(bv, o); const int oi = __shfl_xor(bi, o); if (ov > bv || (ov == bv && oi < bi)) { bv = ov; bi = oi; } }
                    tv[k] = bv; te[k] = bi; if (e == bi) val = -3.0e38f;
                }
                const float e1 = __expf(tv[1] - tv[0]), e2 = __expf(tv[2] - tv[0]), e3 = __expf(tv[3] - tv[0]); const float rs = 1.0f / (1.0f + e1 + e2 + e3);
                if (e < 4) {
                    const int ex = e == 0 ? te[0] : e == 1 ? te[1] : e == 2 ? te[2] : te[3]; const float gt = (e == 0 ? 1.0f : e == 1 ? e1 : e == 2 ? e2 : e3) * rs;
                    const int ai = (nt_here * 16 + tr) * 4 + e;
                    asg[2 * ai] = ex; asg[2 * ai + 1] = __hip_atomic_fetch_add(&hist[ex], 1, __ATOMIC_RELAXED, __HIP_MEMORY_SCOPE_WORKGROUP); asgg[ai] = gt;
                }
            }
            __syncthreads();
        }
        if (tid < 32) { const int hc = hist[tid]; hist[32 + tid] = hc ? (int)atomicAdd(cnt + tid * 64, (unsigned)hc) : 0; }
        __syncthreads();
        for (int ai = tid; ai < nt_here * 64; ai += NTHREADS) {
            const int ti = ai >> 6, tr = (ai >> 2) & 15, k = ai & 3, tk = (tile0 + ti * C.G) * 16 + tr;
            const int ex = asg[2 * ai], slot = hist[32 + ex] + asg[2 * ai + 1];
            ((int*)(ws + WS_ROWTOK))[(size_t)ex * NTOK + slot] = tk;
            ((int*)(ws + WS_EIDX))[tk * 4 + k] = ex; ((int*)(ws + WS_SLOT))[tk * 4 + k] = slot; ((float*)(ws + WS_GATE))[tk * 4 + k] = asgg[ai];
        }
        __syncthreads();
    }
}

__device__ __forceinline__ void moe_table(Ctx& C, int l, LAS int* tab) {
    if (C.tid < 32) { const unsigned* cnt = (const unsigned*)(C.ws + WS_CTL) + CW_CNT + l * 32 * 64; tab[33 + C.tid] = (int)__hip_atomic_load(cnt + C.tid * 64, __ATOMIC_RELAXED, __HIP_MEMORY_SCOPE_AGENT); }
    __syncthreads();
    if (C.tid == 0) { int p = 0; for (int e = 0; e < 32; ++e) { tab[e] = p; p += (tab[33 + e] + 255) >> 8; } tab[32] = p; }
    __syncthreads();
}

__device__ __forceinline__ void phase_combine(const Args& a, Ctx& C, int l) {
    unsigned char* ws = C.ws; const int lane = C.lane;
    const float* mod = (const float*)(ws + WS_MOD); float* H = (float*)(ws + WS_H); const bf16_t* Y = (const bf16_t*)(ws + WS_Y);
    const unsigned* cnt = (const unsigned*)(ws + WS_CTL) + CW_CNT + l * 32 * 64;
    int mt = 0; if (lane < 32) mt = ((int)__hip_atomic_load(cnt + lane * 64, __ATOMIC_RELAXED, __HIP_MEMORY_SCOPE_AGENT) + 255) >> 8;
    int incl = mt;
#pragma unroll
    for (int o = 1; o < 32; o <<= 1) { const int t = __shfl_up(incl, o); if ((lane & 31) >= o) incl += t; }
    const int excl = incl - mt;
    const int gw = blockIdx.x * NWAVES + C.wave, NGW = C.G * NWAVES;
    for (int tk0 = gw; tk0 < NTOK; tk0 += 2 * NGW) {
        int tks[2]; tks[0] = tk0; tks[1] = (tk0 + NGW) < NTOK ? tk0 + NGW : tk0; const bool two = (tk0 + NGW) < NTOK;
        f32x4 v[2][4]; u32x2 yv[2][4][4]; float gts[2][4];
#pragma unroll
        for (int q = 0; q < 2; ++q) { const int tk = tks[q]; const f32x4* hr = (const f32x4*)(H + (size_t)tk * D) + lane;
#pragma unroll
            for (int j = 0; j < 4; ++j) v[q][j] = hr[64 * j];
            const int4 ex4 = *(const int4*)((const int*)(ws + WS_EIDX) + tk * 4), sl4 = *(const int4*)((const int*)(ws + WS_SLOT) + tk * 4); const f32x4 g4 = *(const f32x4*)((const float*)(ws + WS_GATE) + tk * 4);
            const int exs[4] = {ex4.x, ex4.y, ex4.z, ex4.w}, sls[4] = {sl4.x, sl4.y, sl4.z, sl4.w};
#pragma unroll
            for (int k = 0; k < 4; ++k) { gts[q][k] = g4[k]; const int row = 256 * __shfl(excl, exs[k]) + sls[k]; const u32x2* yr = (const u32x2*)(Y + (size_t)row * D) + lane;
#pragma unroll
                for (int j = 0; j < 4; ++j) yv[q][k][j] = yr[64 * j]; }
        }
#pragma unroll
        for (int q = 0; q < 2; ++q) {
            if (q == 1 && !two) break;
            const int tk = tks[q], b = tk >> 12; f32x4* hr = (f32x4*)(H + (size_t)tk * D) + lane;
            f32x4 m[4];
#pragma unroll
            for (int j = 0; j < 4; ++j) m[j] = (f32x4){0.f, 0.f, 0.f, 0.f};
#pragma unroll
            for (int k = 0; k < 4; ++k)
#pragma unroll
                for (int j = 0; j < 4; ++j) { const u32x2 w = yv[q][k][j]; m[j] += (f32x4){bflo(w.x), bfhi(w.x), bflo(w.y), bfhi(w.y)} * gts[q][k]; }
            const float* mb = mod + (size_t)(l * 4 + b) * 6144;
            f32x4 vv[4];
#pragma unroll
            for (int j = 0; j < 4; ++j) { const f32x4 g2 = *(const f32x4*)(mb + 5120 + 4 * lane + 256 * j); vv[j] = v[q][j] + g2 * m[j]; if (l + 1 < DEPTH) hr[64 * j] = vv[j]; }
            if (l + 1 < DEPTH) { const float* mn = mod + (size_t)((l + 1) * 4 + b) * 6144; norm_mod_store(vv, a.norm1_g + (l + 1) * 1024, mn + 0, mn + 1024, (bf16_t*)(ws + WS_U) + (size_t)tk * D, lane); }
            else {
                float ss = 0.f;
#pragma unroll
                for (int j = 0; j < 4; ++j) ss += (vv[j].x * vv[j].x + vv[j].y * vv[j].y) + (vv[j].z * vv[j].z + vv[j].w * vv[j].w);
                const float rstd = 1.0f / sqrtf(wave_sum(ss) * (1.0f / D) + EPS);
                f32x4* orow = (f32x4*)(a.out + (size_t)tk * D) + lane;
#pragma unroll
                for (int j = 0; j < 4; ++j) orow[64 * j] = vv[j] * rstd * *(const f32x4*)(a.final_g + 4 * lane + 256 * j);
            }
        }
    }
}

#define XB_TMO      128
#define XB_XCNT(j)  (256  + 64 * (j))
#define XB_XSUB(j)  (1280 + 64 * (j))
#define XB_XGEN(j)  (2304 + 64 * (j))
#define XB_TOP      3328
#define XB_TOPGEN   3392
#define XCD_BAR_WORDS 3456
#define XB_SPIN_CAP (1u << 22)
__device__ __forceinline__ unsigned xb_ld(unsigned* p)              { return __hip_atomic_load(p, __ATOMIC_RELAXED, __HIP_MEMORY_SCOPE_AGENT); }
__device__ __forceinline__ unsigned xb_add(unsigned* p, unsigned v) { return __hip_atomic_fetch_add(p, v, __ATOMIC_RELAXED, __HIP_MEMORY_SCOPE_AGENT); }
__device__ __forceinline__ unsigned xb_xcc_id() { return (unsigned)__builtin_amdgcn_s_getreg((3 << 11) | 20) & 0xFu; }
#define XB_SPIN(cond, bar) do { unsigned _sp = 0; while (cond) { __builtin_amdgcn_s_sleep(1); \
    if ((++_sp & 255u) == 0u) { if (xb_ld(&(bar)[XB_TMO])) break; if (_sp > XB_SPIN_CAP) { atomicAdd(&(bar)[XB_TMO], 1u); break; } } } } while (0)
struct XcdBarrier { unsigned* bar; unsigned x; volatile LAS unsigned* st; };
__device__ __forceinline__ XcdBarrier xcd_barrier_post(unsigned* bar, volatile LAS unsigned* st, bool leader) {
    XcdBarrier b; b.bar = bar; b.x = xb_xcc_id(); b.st = st;
    if (leader) (void)xb_add(&bar[XB_XCNT(b.x)], 1u);
    return b;
}
__device__ __forceinline__ void xcd_barrier_complete(unsigned* bar, unsigned x, unsigned& nloc, unsigned& nx) {
    const unsigned G = gridDim.x * gridDim.y * gridDim.z;
    unsigned sum, cnt, mine, sp = 0u;
    for (;;) {
        sum = 0u; cnt = 0u; mine = 0u;
#pragma unroll
        for (unsigned j = 0; j < 16; ++j) { const unsigned c = xb_ld(&bar[XB_XCNT(j)]); sum += c; cnt += (c > 0u) ? 1u : 0u; mine = (j == x) ? c : mine; }
        if (sum == G) break;
        __builtin_amdgcn_s_sleep(1);
        if ((++sp & 255u) == 0u) { if (xb_ld(&bar[XB_TMO])) break; if (sp > XB_SPIN_CAP) { atomicAdd(&bar[XB_TMO], 1u); break; } }
    }
    nloc = mine > 0u ? mine : 1u; nx = cnt > 0u ? cnt : 1u;
}
__device__ __forceinline__ void xcd_barrier(const XcdBarrier& b, bool leader) {
    asm volatile("s_waitcnt vmcnt(0)" ::: "memory");
    __syncthreads();
    if (leader) {
        unsigned* bar = b.bar;
        __builtin_amdgcn_s_waitcnt(0);
        unsigned nloc = b.st[0], nx = b.st[1];
        if (nloc == 0u) { xcd_barrier_complete(bar, b.x, nloc, nx); b.st[0] = nloc; b.st[1] = nx; }
        const unsigned old = xb_add(&bar[XB_XSUB(b.x)], 1u);
        const unsigned gen = old / nloc;
        if (old + 1u == (gen + 1u) * nloc) {
            __builtin_amdgcn_fence(__ATOMIC_RELEASE, "agent");
            asm volatile("s_waitcnt vmcnt(0)" ::: "memory");
            const unsigned og = xb_add(&bar[XB_TOP], 1u);
            const unsigned tg = og / nx;
            if (og + 1u == (tg + 1u) * nx) xb_add(&bar[XB_TOPGEN], 1u);
            else XB_SPIN(xb_ld(&bar[XB_TOPGEN]) == tg, bar);
            __builtin_amdgcn_fence(__ATOMIC_ACQUIRE, "agent");
            xb_add(&bar[XB_XGEN(b.x)], 1u);
            asm volatile("s_waitcnt vmcnt(0)" ::: "memory");
        } else {
            XB_SPIN(xb_ld(&bar[XB_XGEN(b.x)]) == gen, bar);
            __builtin_amdgcn_fence(__ATOMIC_ACQUIRE, "agent");
            asm volatile("s_waitcnt vmcnt(0)" ::: "memory");
        }
    }
    __syncthreads();
}

typedef const __attribute__((address_space(4))) Args* KArgsPtr;
__device__ __forceinline__ Args load_args() {
#if defined(__HIP_DEVICE_COMPILE__)
    KArgsPtr p = (KArgsPtr)__builtin_amdgcn_kernarg_segment_ptr(); asm volatile("" : "+s"(p)); Args a;
    a.x = p->x; a.c = p->c; a.pos = p->pos; a.w_ada = p->w_ada; a.b_ada = p->b_ada; a.norm1_g = p->norm1_g; a.norm2_g = p->norm2_g; a.w_in = p->w_in; a.w_out = p->w_out; a.pool_w = p->pool_w;
    a.pool_scale = p->pool_scale; a.hgrn_g = p->hgrn_g; a.lb_logits = p->lb_logits; a.w_router = p->w_router; a.b_router = p->b_router; a.w1 = p->w1; a.b1 = p->b1; a.w2 = p->w2; a.b2 = p->b2; a.final_g = p->final_g;
    a.out = p->out; a.ws = p->ws; a.ph_lo = p->ph_lo; a.ph_hi = p->ph_hi; return a;
#else
    return Args{};
#endif
}
__device__ __forceinline__ int lane_id() { return __builtin_amdgcn_mbcnt_hi(~0u, __builtin_amdgcn_mbcnt_lo(~0u, 0)); }
__device__ __forceinline__ Ctx make_ctx(unsigned char* ws, int wv) {
    extern __shared__ __attribute__((aligned(16))) unsigned char lds_raw[];
    Ctx C; C.lds = (LAS unsigned char*)lds_raw; { int l_ = lane_id(); asm volatile("" : "+v"(l_)); C.lane = l_; } C.wave = wv; C.tid = wv * 64 + C.lane;
    C.G = gridDim.x; { const int bx = blockIdx.x; C.vcu = (C.G % 8 == 0) ? (bx % 8) * (C.G / 8) + bx / 8 : bx; }
    C.ws = ws; return C;
}
#ifndef PHASE_FN
#define PHASE_FN __device__ __forceinline__ void
#endif
#define GEMM_FN __device__ __forceinline__ void
PHASE_FN ph_prep(int wv) { const Args a = load_args(); Ctx C = make_ctx(a.ws, wv); phase_prep(a, C); }
PHASE_FN ph_u0(int wv) { const Args a = load_args(); Ctx C = make_ctx(a.ws, wv); phase_u0(a, C); }
GEMM_FN ph_gin(int l, int wv) { const Args a = load_args(); Ctx C = make_ctx(a.ws, wv); unsigned char* ws = a.ws;
    DenseOrder S{(const char*)(ws + WS_U), (const char*)(ws + WS_WIN) + (size_t)l * NPAD * 1024 * 2, NTOK / 256, NPAD / 256, (NTOK / 256) * (NPAD / 256), C.G, (int)blockIdx.x};
    EpiIn E{ws}; pg8::gemm_phase<EpiIn, DenseOrder, false, true>(C.lds, (LAS unsigned*)(C.lds + LDS_PARK), C.tid, S, E); }
PHASE_FN ph_mix1(int l, int wv) { const Args a = load_args(); Ctx C = make_ctx(a.ws, wv); phase_mix1(a, C, l); }
PHASE_FN ph_mix2(int l, int wv) { const Args a = load_args(); Ctx C = make_ctx(a.ws, wv); phase_mix2(a, C, l); }
GEMM_FN ph_gout(int l, int wv) { const Args a = load_args(); Ctx C = make_ctx(a.ws, wv); unsigned char* ws = a.ws;
    DenseOrder S{(const char*)(ws + WS_MIX), (const char*)(ws + WS_WOUT) + (size_t)l * 1024 * 1024 * 2, NTOK / 256, 4, (NTOK / 256) * 4, C.G, (int)blockIdx.x};
    EpiOut E{l == 0 ? a.x : (const float*)(ws + WS_H), (float*)(ws + WS_H), (const float*)(ws + WS_MOD) + (size_t)l * 4 * 6144 + 2048};
    pg8::gemm_phase<EpiOut, DenseOrder, false, true>(C.lds, (LAS unsigned*)(C.lds + LDS_PARK), C.tid, S, E); }
PHASE_FN ph_router(int l, int wv) { const Args a = load_args(); Ctx C = make_ctx(a.ws, wv); phase_router2(a, C, l); }
GEMM_FN ph_g1(int l, int wv) { const Args a = load_args(); Ctx C = make_ctx(a.ws, wv); unsigned char* ws = a.ws;
    LAS int* tab = (LAS int*)(C.lds + LDS_TAB); moe_table(C, l, tab);
    MoeOrder<true> S{tab, (const char*)(ws + WS_U), (const char*)(ws + WS_W1) + (size_t)l * 32 * 2048 * 1024, (const int*)(ws + WS_ROWTOK), C.G, C.vcu};
    EpiG1 E{ws + WS_ACT, a.b1 + (size_t)l * 32 * 2048}; pg8::gemm_phase<EpiG1, MoeOrder<true>, true, true, true>(C.lds, (LAS unsigned*)(C.lds + LDS_PARK), C.tid, S, E); }
GEMM_FN ph_g2(int l, int wv) { const Args a = load_args(); Ctx C = make_ctx(a.ws, wv); unsigned char* ws = a.ws;
    LAS int* tab = (LAS int*)(C.lds + LDS_TAB); moe_table(C, l, tab);
    MoeOrder<false> S{tab, (const char*)(ws + WS_ACT), (const char*)(ws + WS_W2) + (size_t)l * 32 * 1024 * 1024, nullptr, C.G, C.vcu};
    EpiG2 E{(bf16_t*)(ws + WS_Y), a.b2 + (size_t)l * 32 * 1024}; pg8::gemm_phase<EpiG2, MoeOrder<false>, false, true, true>(C.lds, (LAS unsigned*)(C.lds + LDS_PARK), C.tid, S, E); }
PHASE_FN ph_combine(int l, int wv) { const Args a = load_args(); Ctx C = make_ctx(a.ws, wv); phase_combine(a, C, l); }

constexpr int NPHASES = 2 + 8 * DEPTH;
__global__ void __launch_bounds__(NTHREADS, 2) mega_fwd(Args a) {
#if MK_ONE_LAUNCH == 1
    cg::grid_group grid = cg::this_grid();
#define SEAM() do { __syncthreads(); grid.sync(); } while (0)
#elif MK_ONE_LAUNCH == 2
    extern __shared__ __attribute__((aligned(16))) unsigned char lds_k[];
    volatile LAS unsigned* bst = (volatile LAS unsigned*)((LAS unsigned char*)lds_k + LDS_BYTES - 64);
    const bool leader = (threadIdx.x == 0);
    if (leader) { bst[0] = 0u; bst[1] = 0u; }
    __syncthreads();
    const XcdBarrier xbar = xcd_barrier_post((unsigned*)(a.ws + WS_CTL) + CW_BAR, bst, leader);
#define SEAM() xcd_barrier(xbar, leader)
#else
#define SEAM() do { } while (0)
#endif
    const int lo = a.ph_lo, hi = a.ph_hi;
    const int wv = __builtin_amdgcn_readfirstlane((int)threadIdx.x >> 6);
#define RUN(id, call) do { if (lo <= (id) && (id) < hi) { call; if ((id) + 1 < hi) SEAM(); } } while (0)
    RUN(0, ph_prep(wv));
    RUN(1, ph_u0(wv));
    RUN(2, ph_gin(0, wv)); RUN(3, ph_mix1(0, wv)); RUN(4, ph_mix2(0, wv)); RUN(5, ph_gout(0, wv)); RUN(6, ph_router(0, wv)); RUN(7, ph_g1(0, wv)); RUN(8, ph_g2(0, wv)); RUN(9, ph_combine(0, wv));
    RUN(10, ph_gin(1, wv)); RUN(11, ph_mix1(1, wv)); RUN(12, ph_mix2(1, wv)); RUN(13, ph_gout(1, wv)); RUN(14, ph_router(1, wv)); RUN(15, ph_g1(1, wv)); RUN(16, ph_g2(1, wv)); RUN(17, ph_combine(1, wv));
#undef RUN
}

extern "C" void kernel_launch(void* const* d_in, const int* in_sizes, int n_in, void* d_out, int out_size, void* d_ws, size_t ws_size, hipStream_t stream) {
    static int grid = 0;
    if (grid == 0) {
        if (n_in != 20 || out_size != NTOK * D || ws_size < WS_END) { fprintf(stderr, "kernel_launch: unexpected shapes: n_in %d out %d ws %zu (need %zu)\n", n_in, out_size, ws_size, (size_t)WS_END); grid = -1; return; }
        int dev = 0, cus = 0, per_cu = 0;
        hipGetDevice(&dev); hipDeviceGetAttribute(&cus, hipDeviceAttributeMultiprocessorCount, dev);
        if (hipFuncSetAttribute((const void*)mega_fwd, hipFuncAttributeMaxDynamicSharedMemorySize, LDS_BYTES) != hipSuccess) { fprintf(stderr, "kernel_launch: hipFuncSetAttribute failed\n"); grid = -1; return; }
        hipOccupancyMaxActiveBlocksPerMultiprocessor(&per_cu, (const void*)mega_fwd, NTHREADS, LDS_BYTES);
        (void)hipGetLastError();
        if (per_cu < 1) fprintf(stderr, "kernel_launch: occupancy query says %d blocks per CU\n", per_cu);
        grid = cus;
    }
    if (grid < 0) return;
    hipMemsetAsync((char*)d_ws + WS_CTL, 0, CTL_BYTES, stream);
    Args a{};
    a.x = (const float*)d_in[0]; a.c = (const float*)d_in[1]; a.pos = (const int*)d_in[2]; a.w_ada = (const float*)d_in[3]; a.b_ada = (const float*)d_in[4];
    a.norm1_g = (const float*)d_in[5]; a.norm2_g = (const float*)d_in[6]; a.w_in = (const float*)d_in[7]; a.w_out = (const float*)d_in[8]; a.pool_w = (const float*)d_in[9];
    a.pool_scale = (const float*)d_in[10]; a.hgrn_g = (const float*)d_in[11]; a.lb_logits = (const float*)d_in[12]; a.w_router = (const float*)d_in[13]; a.b_router = (const float*)d_in[14];
    a.w1 = (const float*)d_in[15]; a.b1 = (const float*)d_in[16]; a.w2 = (const float*)d_in[17]; a.b2 = (const float*)d_in[18]; a.final_g = (const float*)d_in[19];
    a.out = (float*)d_out; a.ws = (unsigned char*)d_ws;
#if MK_ONE_LAUNCH == 1
    a.ph_lo = 0; a.ph_hi = NPHASES;
    void* args[] = {&a};
    hipError_t e = hipLaunchCooperativeKernel((const void*)mega_fwd, dim3(grid), dim3(NTHREADS), args, LDS_BYTES, stream);
    if (e != hipSuccess) fprintf(stderr, "cooperative launch failed: %s (grid %d)\n", hipGetErrorString(e), grid);
#elif MK_ONE_LAUNCH == 2
    a.ph_lo = 0; a.ph_hi = NPHASES;
    hipLaunchKernelGGL(mega_fwd, dim3(grid), dim3(NTHREADS), LDS_BYTES, stream, a);
#else
    for (int p = 0; p < NPHASES; ++p) { a.ph_lo = p; a.ph_hi = p + 1; hipLaunchKernelGGL(mega_fwd, dim3(grid), dim3(NTHREADS), LDS_BYTES, stream, a); }
#endif
}
```

```cpp
#include <hip/hip_runtime.h>
#include <hip/hip_cooperative_groups.h>
#include <cstdio>
#include <cstdint>
#include <type_traits>
namespace cg = cooperative_groups;

#ifndef MK_ONE_LAUNCH
#define MK_ONE_LAUNCH 2
#endif

#define LAS __attribute__((address_space(3)))
typedef unsigned short bf16_t;
typedef short bf16x8 __attribute__((ext_vector_type(8)));
typedef float f32x4 __attribute__((ext_vector_type(4)));
typedef float f32x2 __attribute__((ext_vector_type(2)));
typedef unsigned u32x4 __attribute__((ext_vector_type(4)));
typedef unsigned u32x2 __attribute__((ext_vector_type(2)));
typedef int i32x4 __attribute__((ext_vector_type(4)));
typedef int i32x8 __attribute__((ext_vector_type(8)));

constexpr int D = 1024, NBATCH = 4, SEQ = 4096, NTOK = NBATCH * SEQ, DEPTH = 2;
constexpr int D_IN = 2372, NPAD = 2560;
constexpr int NE = 32, TOPK = 4, FF = 1024;
constexpr int NWAVES = 8, NTHREADS = 512;
constexpr float EPS = 1e-6f;
constexpr float W8SCALE = 32.0f;
constexpr int ROWCAP = 73728;

constexpr size_t MiB = 1u << 20;
constexpr size_t WS_CTL = 0, CTL_BYTES = 1 * MiB;
constexpr size_t WS_MOD = 1 * MiB;
constexpr size_t WS_ROPEC = 2 * MiB;
constexpr size_t WS_ROPES = 4 * MiB;
constexpr size_t WS_WIN = 6 * MiB;
constexpr size_t WS_WOUT = 16 * MiB;
constexpr size_t WS_ROWTOK = 20 * MiB;
constexpr size_t WS_EIDX = 22 * MiB;
constexpr size_t WS_SLOT = 22 * MiB + 256 * 1024;
constexpr size_t WS_GATE = 22 * MiB + 512 * 1024;
constexpr size_t WS_WI = 23 * MiB;
constexpr size_t WS_WRH = 23 * MiB + 256 * 1024;
constexpr size_t WS_WRL = 23 * MiB + 512 * 1024;
constexpr size_t WS_KI = 24 * MiB;
constexpr size_t WS_K = 26 * MiB;
constexpr size_t WS_V = 30 * MiB;
constexpr size_t WS_QI = 34 * MiB;
constexpr size_t WS_Q = 42 * MiB;
constexpr size_t WS_UB = 58 * MiB;
constexpr size_t WS_HG = 74 * MiB;
constexpr size_t WS_SEL = 138 * MiB;
constexpr size_t WS_HL = 154 * MiB;
constexpr size_t WS_HD = 170 * MiB;
constexpr size_t WS_MIX = 171 * MiB;
constexpr size_t WS_U = 203 * MiB;
constexpr size_t WS_H = 235 * MiB;
constexpr size_t WS_W1 = 299 * MiB;
constexpr size_t WS_W2 = 555 * MiB;
constexpr size_t WS_ACT = 683 * MiB;
constexpr size_t WS_Y = 827 * MiB;
constexpr size_t WS_END = 971 * MiB;
constexpr int CW_CNT = 1024;
constexpr int CW_BAR = 8192;

constexpr int LDS_BYTES = 147456;
constexpr int LDS_TAB = 131072;
constexpr int LDS_PARK = 131072 + 1024;

__device__ __forceinline__ unsigned f2bf(float f) { unsigned u = __builtin_bit_cast(unsigned, f); return (u + 0x7fffu + ((u >> 16) & 1u)) >> 16; }
typedef __bf16 bf16x2_t __attribute__((ext_vector_type(2)));
__device__ __forceinline__ unsigned cvt_pk_bf16(float lo, float hi) { const f32x2 v = {lo, hi}; const bf16x2_t b = __builtin_convertvector(v, bf16x2_t); return __builtin_bit_cast(unsigned, b); }
__device__ __forceinline__ unsigned pk2(float lo, float hi) { return cvt_pk_bf16(lo, hi); }
__device__ __forceinline__ unsigned pk4_fp8(float a, float b, float c, float d) { unsigned w = 0u; w = __builtin_amdgcn_cvt_pk_fp8_f32(a, b, w, false); w = __builtin_amdgcn_cvt_pk_fp8_f32(c, d, w, true); return w; }
__device__ __forceinline__ float bf2f(unsigned short b) { return __builtin_bit_cast(float, ((unsigned)b) << 16); }
__device__ __forceinline__ float bflo(unsigned w) { return __builtin_bit_cast(float, w << 16); }
__device__ __forceinline__ float bfhi(unsigned w) { return __builtin_bit_cast(float, w & 0xffff0000u); }
__device__ __forceinline__ float wave_sum(float v) {
#pragma unroll
    for (int o = 1; o < 64; o <<= 1) v += __shfl_xor(v, o);
    return v;
}
__device__ __forceinline__ float wave_max(float v) {
#pragma unroll
    for (int o = 1; o < 64; o <<= 1) v = fmaxf(v, __shfl_xor(v, o));
    return v;
}
__device__ __forceinline__ float sigmoidf_(float z) { return __builtin_amdgcn_rcpf(1.0f + __expf(-z)); }
__device__ __forceinline__ float siluf_(float z) { return z * __builtin_amdgcn_rcpf(1.0f + __expf(-z)); }

namespace pg8 {
constexpr int BM = 256, BK = 64, HALF = 128, HTB = HALF * BK * 2, STAGE_BYTES = 8 * HTB;
constexpr int KD = 1024, NKT = KD / BK;
__host__ __device__ __forceinline__ int lds_byte(int r, int c) { const int st = (r >> 4) * 2 + (c >> 5), rr = r & 15, cc = c & 31, ob = rr * 64 + cc * 2; return st * 1024 + (ob ^ (((ob >> 9) & 1) << 5)); }
__host__ __device__ __forceinline__ void stage_rc(int b, int& R, int& C) { const int st = b / 1024, sb = b % 1024, swz = sb ^ (((sb >> 9) & 1) << 5); R = (st >> 1) * 16 + swz / 64; C = (st & 1) * 32 + (swz % 64) / 2; }

struct Unit { const char* A; const char* B; const int* ridx; int nvalid; int row0, pn, e, b; };

__device__ __forceinline__ f32x4 mma_step(bf16x8 a, bf16x8 b, f32x4 c) { return __builtin_amdgcn_mfma_f32_16x16x32_bf16(a, b, c, 0, 0, 0); }
__device__ __forceinline__ f32x4 mma_step(i32x8 a, i32x8 b, f32x4 c) { return __builtin_amdgcn_mfma_scale_f32_16x16x128_f8f6f4(a, b, c, 0, 0, 0, 0x7F7F7F7F, 0, 0x7F7F7F7F); }
__device__ __forceinline__ bf16x8 ld_frag(const LAS unsigned char* p, bf16x8*) { return *(const LAS bf16x8*)p; }
__device__ __forceinline__ i32x8 ld_frag(const LAS unsigned char* p, i32x8*) { const i32x4 lo = *(const LAS i32x4*)p, hi = *(const LAS i32x4*)(p + 1024); return __builtin_shufflevector(lo, hi, 0, 1, 2, 3, 4, 5, 6, 7); }
template <class Epi, class Sched, bool GATHER, bool ALIGN_EPI, bool FP8 = false>
__device__ __forceinline__ void gemm_phase(LAS unsigned char* lds, LAS unsigned* park, int tid_in, const Sched& S, const Epi& E) {
    const int tid = tid_in, wid = __builtin_amdgcn_readfirstlane(tid >> 6), lane = tid & 63, wr = wid >> 2, wc = wid & 3, fr = lane & 15, fq = lane >> 4;
    constexpr int RS = FP8 ? KD : KD * 2;
    constexpr int nt = FP8 ? NKT / 2 : NKT, KS = FP8 ? 1 : 2;
    typedef typename std::conditional<FP8, i32x8, bf16x8>::type Frag;
    auto stage_map = [&](int i, int& R, int& Cb) { if (FP8) { const int st = wid + 8 * i, r = lane >> 2; R = (st >> 1) * 16 + r; Cb = (st & 1) * 64 + 16 * ((lane & 3) ^ ((r >> 3) << 1)); }
                                                    else { int C; stage_rc(tid * 16 + i * 8192, R, C); Cb = 2 * C; } };
    unsigned voffB[2], vA[2][2];
#pragma unroll
    for (int i = 0; i < 2; ++i) { int R, Cb; stage_map(i, R, Cb); voffB[i] = (unsigned)(R * RS + Cb); }
    constexpr size_t kstep = (size_t)(BK * 2);
    constexpr size_t hstep = (size_t)HALF * RS;
    const unsigned ldsw = (unsigned)wid * 1024u;
    const int aoff = lds_byte(wr * 64 + fr, fq * 8), boff = lds_byte(wc * 32 + fr, fq * 8);
    const int f8lo = fr * 64 + ((fq ^ ((fr >> 3) << 1)) * 16);
    const int aoff8 = wr * 8 * 1024 + f8lo, boff8 = wc * 4 * 1024 + f8lo;
#define PG8_SA(b, h) (((b) * 2 + (h)) * HTB)
#define PG8_SB(b, h) ((4 + (b) * 2 + (h)) * HTB)
#define PG8_STAGE(bufoff, gbase, voff) do { _Pragma("unroll") for (int _i = 0; _i < 2; ++_i) { unsigned _o = (voff)[_i]; asm volatile("" : "+v"(_o));   \
        __builtin_amdgcn_global_load_lds((const unsigned*)((const char*)(gbase) + _o), (LAS unsigned*)(lds + (bufoff) + ldsw + _i * 8192), 16, 0, 0); } } while (0)
#define PG8_LDA(dst, b, h) do { _Pragma("unroll") for (int m = 0; m < 4; ++m) _Pragma("unroll") for (int k = 0; k < KS; ++k) dst[m][k] = ld_frag(lds + PG8_SA(b, h) + (FP8 ? aoff8 : aoff + k * 1024) + m * 2048, (Frag*)nullptr); } while (0)
#define PG8_LDB(dst, b, h) do { _Pragma("unroll") for (int n = 0; n < 2; ++n) _Pragma("unroll") for (int k = 0; k < KS; ++k) dst[n][k] = ld_frag(lds + PG8_SB(b, h) + (FP8 ? boff8 : boff + k * 1024) + n * 2048, (Frag*)nullptr); } while (0)
#define PG8_MMA(ai, bj, At, Bt) do { __builtin_amdgcn_s_setprio(1); _Pragma("unroll") for (int m = 0; m < 4; ++m) _Pragma("unroll") for (int n = 0; n < 2; ++n) _Pragma("unroll") for (int k = 0; k < KS; ++k) \
        acc[ai][bj][m][n] = mma_step(Bt[n][k], At[m][k], acc[ai][bj][m][n]); __builtin_amdgcn_s_setprio(0); } while (0)
#define PG8_WAIT_V(n) asm volatile("s_waitcnt vmcnt(" #n ")" ::: "memory")
#define PG8_WAIT_L(n) asm volatile("s_waitcnt lgkmcnt(" #n ")" ::: "memory")
#define PG8_BAR __builtin_amdgcn_s_barrier()
#define PG8_SCHED __builtin_amdgcn_sched_barrier(0)
#define PG8_OFFS(dst, u) do { _Pragma("unroll") for (int _h = 0; _h < 2; ++_h) _Pragma("unroll") for (int _i = 0; _i < 2; ++_i) { \
        int _R, _Cb; stage_map(_i, _R, _Cb); const int _rr = _h * HALF + _R; \
        if constexpr (GATHER) { const int _ix = (u).ridx[_rr < (u).nvalid ? _rr : 0]; dst[_h][_i] = (unsigned)(_ix * RS + _Cb); } \
        else dst[_h][_i] = (unsigned)(_rr * RS + _Cb); } } while (0)
    Unit cur, nxt; int ui = 0;
    if (!S.next(0, cur)) return;
    f32x4 acc[2][2][4][2];
#pragma unroll
    for (int a = 0; a < 2; ++a)
#pragma unroll
        for (int b = 0; b < 2; ++b)
#pragma unroll
            for (int m = 0; m < 4; ++m)
#pragma unroll
                for (int n = 0; n < 2; ++n) acc[a][b][m][n] = (f32x4){0.f, 0.f, 0.f, 0.f};
    Frag At[4][KS], B0[2][KS], B1[2][KS];
    PG8_OFFS(vA, cur);
    const char* cA = cur.A; const char* cB = cur.B;
    PG8_STAGE(PG8_SB(0, 0), cB, voffB); PG8_STAGE(PG8_SB(0, 1), cB + hstep, voffB); PG8_STAGE(PG8_SA(0, 0), cA, vA[0]); PG8_STAGE(PG8_SA(0, 1), cA, vA[1]);
    if (wr == 1) PG8_BAR;
    PG8_WAIT_V(2); PG8_BAR;
    PG8_STAGE(PG8_SB(1, 0), cB + kstep, voffB); PG8_STAGE(PG8_SA(1, 0), cA + kstep, vA[0]); PG8_STAGE(PG8_SB(1, 1), cB + hstep + kstep, voffB);
    PG8_WAIT_V(6); PG8_BAR;
    for (;;) {
        const bool has_next = S.next(ui + 1, nxt);
        const char* nA = has_next ? nxt.A : cA; const char* nB = has_next ? nxt.B : cB;
        if constexpr (GATHER) {
            unsigned nv[2][2];
            if (has_next) { PG8_OFFS(nv, nxt); } else {
#pragma unroll
                for (int h = 0; h < 2; ++h) { nv[h][0] = vA[h][0]; nv[h][1] = vA[h][1]; } }
            *(LAS u32x4*)(park + tid * 4) = (u32x4){nv[0][0], nv[0][1], nv[1][0], nv[1][1]};
        }
#pragma unroll 1
        for (int t = 0; t < nt; t += 2) {
            const bool last = (t == nt - 2);
            const char* a1 = cA + (size_t)(t + 1) * kstep;
            const char* a2 = last ? nA : cA + (size_t)(t + 2) * kstep; const char* b2 = last ? nB : cB + (size_t)(t + 2) * kstep;
            const char* a3 = a2 + kstep; const char* b3 = b2 + kstep;
            PG8_LDB(B0, 0, 0); PG8_LDB(B1, 0, 1); PG8_SCHED; PG8_LDA(At, 0, 0); PG8_STAGE(PG8_SA(1, 1), a1, vA[1]);
            if constexpr (GATHER) { if (last) { const u32x4 pv = *(const LAS u32x4*)(park + tid * 4); vA[0][0] = pv.x; vA[0][1] = pv.y; vA[1][0] = pv.z; vA[1][1] = pv.w; } }
            PG8_WAIT_V(8); PG8_WAIT_L(0); PG8_BAR; PG8_MMA(0, 0, At, B0); PG8_MMA(0, 1, At, B1); PG8_BAR; PG8_SCHED;
            PG8_LDA(At, 0, 1); PG8_STAGE(PG8_SB(0, 0), b2, voffB); PG8_STAGE(PG8_SB(0, 1), b2 + hstep, voffB); PG8_STAGE(PG8_SA(0, 0), a2, vA[0]);
            PG8_WAIT_V(8); PG8_WAIT_L(0); PG8_BAR; PG8_MMA(1, 0, At, B0); PG8_MMA(1, 1, At, B1); PG8_BAR; PG8_SCHED;
            PG8_LDB(B0, 1, 0); PG8_LDB(B1, 1, 1); PG8_SCHED; PG8_LDA(At, 1, 0); PG8_STAGE(PG8_SA(0, 1), a2, vA[1]);
            PG8_WAIT_V(8); PG8_WAIT_L(0); PG8_BAR; PG8_MMA(0, 0, At, B0); PG8_MMA(0, 1, At, B1); PG8_BAR; PG8_SCHED;
            PG8_LDA(At, 1, 1); PG8_STAGE(PG8_SB(1, 0), b3, voffB); PG8_STAGE(PG8_SB(1, 1), b3 + hstep, voffB); PG8_STAGE(PG8_SA(1, 0), a3, vA[0]);
            PG8_WAIT_V(8); PG8_WAIT_L(0); PG8_BAR; PG8_MMA(1, 0, At, B0); PG8_MMA(1, 1, At, B1); PG8_BAR; PG8_SCHED;
        }
        if constexpr (ALIGN_EPI) { if (wr == 0) PG8_BAR; }
        { int fr2 = fr, fq2 = fq; asm volatile("" : "+v"(fr2), "+v"(fq2)); E(acc, cur, wr, wc, fr2, fq2); }
        if (!has_next) break;
#pragma unroll
        for (int a = 0; a < 2; ++a)
#pragma unroll
            for (int b = 0; b < 2; ++b)
#pragma unroll
                for (int m = 0; m < 4; ++m)
#pragma unroll
                    for (int n = 0; n < 2; ++n) acc[a][b][m][n] = (f32x4){0.f, 0.f, 0.f, 0.f};
        cur = nxt; cA = nA; cB = nB; ++ui;
        if constexpr (ALIGN_EPI) { if (wr == 1) PG8_BAR; }
    }
    PG8_WAIT_V(0);
    if constexpr (!ALIGN_EPI) { if (wr == 0) PG8_BAR; }
    PG8_BAR;
#undef PG8_SA
#undef PG8_SB
#undef PG8_STAGE
#undef PG8_LDA
#undef PG8_LDB
#undef PG8_MMA
#undef PG8_WAIT_V
#undef PG8_WAIT_L
#undef PG8_BAR
#undef PG8_SCHED
#undef PG8_OFFS
}
}

struct Args {
    const float* x; const float* c; const int* pos; const float* w_ada; const float* b_ada; const float* norm1_g; const float* norm2_g;
    const float* w_in; const float* w_out; const float* pool_w; const float* pool_scale; const float* hgrn_g; const float* lb_logits;
    const float* w_router; const float* b_router; const float* w1; const float* b1; const float* w2; const float* b2; const float* final_g;
    float* out; unsigned char* ws; int ph_lo, ph_hi;
};

struct Ctx {
    LAS unsigned char* lds;
    int tid, lane, wave, G, vcu;
    unsigned char* ws;
};

struct DenseOrder {
    const char* A; const char* B; int nM, nN, nwg, G, c;
    __device__ __forceinline__ bool next(int i, pg8::Unit& u) const {
        const long L = (long)i * G + c; if (L >= nwg) return false;
        int wgid = (int)L; { const int q = nwg / 8, r = nwg % 8, xcd = wgid % 8, off = wgid / 8; wgid = (xcd < r ? xcd * (q + 1) : r * (q + 1) + (xcd - r) * q) + off; }
        const int nig = 8 * nN, gid = wgid / nig, fm = gid * 8, gsz = (nM - fm) < 8 ? (nM - fm) : 8;
        const int pm = fm + ((wgid % nig) % gsz), pn = (wgid % nig) / gsz;
        u.A = A + (size_t)pm * 256 * pg8::KD * 2; u.B = B + (size_t)pn * 256 * pg8::KD * 2; u.ridx = nullptr; u.nvalid = 256; u.row0 = pm * 256; u.pn = pn; u.e = 0; u.b = pm >> 4;
        return true;
    }
};

template <bool FIRST> struct MoeOrder {
    LAS const int* tab; const char* A; const char* B; const int* rowtok; int G, c;
    static constexpr int NTN = FIRST ? 8 : 4;
    __device__ __forceinline__ bool next(int i, pg8::Unit& u) const {
        const int P = tab[32]; const long L = (long)i * G + c; if (L >= (long)P * NTN) return false;
        const int p = (int)(L / NTN), nt = (int)(L % NTN);
        int e = 0;
#pragma unroll 1
        for (int k = 1; k < 32; ++k) e = (tab[k] <= p) ? k : e;
        const int mt = p - tab[e], cnt = tab[33 + e];
        if (FIRST) { u.A = A; u.ridx = rowtok + e * NTOK + mt * 256; u.nvalid = (cnt - mt * 256) < 256 ? (cnt - mt * 256) : 256; u.B = B + ((size_t)e * 2048 + nt * 256) * pg8::KD; }
        else { u.A = A + (size_t)p * 256 * pg8::KD; u.ridx = nullptr; u.nvalid = 256; u.B = B + ((size_t)e * 1024 + nt * 256) * pg8::KD; }
        u.row0 = p * 256; u.pn = nt; u.e = e; u.b = 0;
        return true;
    }
};

struct EpiIn {
    unsigned char* ws;
    __device__ __forceinline__ void operator()(const f32x4 (&acc)[2][2][4][2], const pg8::Unit& u, int wr, int wc, int fr, int fq) const {
        const int pn = u.pn;
        const float* rc = (const float*)(ws + WS_ROPEC); const float* rs = (const float*)(ws + WS_ROPES);
        const bool rope = (pn <= 1) || (pn == 3) || (pn == 2 && wc < 2) || (pn == 4 && wc == 0);
#pragma unroll
        for (int ai = 0; ai < 2; ++ai)
#pragma unroll
            for (int m = 0; m < 4; ++m) {
                const int r = u.row0 + ai * 128 + wr * 64 + m * 16 + fr;
                if (rope) {
                    bf16_t* dst; float scl = 1.f;
                    if (pn <= 1) { dst = (bf16_t*)(ws + WS_Q) + (size_t)r * 512 + (pn * 4 + wc) * 64; scl = 0.125f; }
                    else if (pn == 2) dst = (bf16_t*)(ws + WS_K) + (size_t)r * 128 + wc * 64;
                    else if (pn == 3) dst = (bf16_t*)(ws + WS_QI) + (size_t)r * 256 + wc * 64;
                    else dst = (bf16_t*)(ws + WS_KI) + (size_t)r * 64;
                    const f32x4 c0 = *(const f32x4*)(rc + (size_t)r * 32 + 8 * fq), c1 = *(const f32x4*)(rc + (size_t)r * 32 + 8 * fq + 4), s0 = *(const f32x4*)(rs + (size_t)r * 32 + 8 * fq), s1 = *(const f32x4*)(rs + (size_t)r * 32 + 8 * fq + 4);
                    const f32x4 x10 = acc[ai][0][m][0], x11 = acc[ai][0][m][1], x20 = acc[ai][1][m][0], x21 = acc[ai][1][m][1];
                    const f32x4 o10 = (x10 * c0 - x20 * s0) * scl, o11 = (x11 * c1 - x21 * s1) * scl, o20 = (x20 * c0 + x10 * s0) * scl, o21 = (x21 * c1 + x11 * s1) * scl;
                    u32x4 w1v, w2v; w1v.x = pk2(o10[0], o10[1]); w1v.y = pk2(o10[2], o10[3]); w1v.z = pk2(o11[0], o11[1]); w1v.w = pk2(o11[2], o11[3]);
                    w2v.x = pk2(o20[0], o20[1]); w2v.y = pk2(o20[2], o20[3]); w2v.z = pk2(o21[0], o21[1]); w2v.w = pk2(o21[2], o21[3]);
                    *(u32x4*)(dst + 8 * fq) = w1v; *(u32x4*)(dst + 32 + 8 * fq) = w2v;
                } else if (pn == 2) {
#pragma unroll
                    for (int bj = 0; bj < 2; ++bj) { const f32x4 a0 = acc[ai][bj][m][0], a1 = acc[ai][bj][m][1]; u32x4 w; w.x = pk2(a0[0], a0[1]); w.y = pk2(a0[2], a0[3]); w.z = pk2(a1[0], a1[1]); w.w = pk2(a1[2], a1[3]);
                        *(u32x4*)((bf16_t*)(ws + WS_V) + (size_t)r * 128 + bj * 64 + (wc - 2) * 32 + 8 * fq) = w; }
                } else if (pn == 4) {
                    if (wc == 1 && fq == 0) *(f32x4*)((float*)(ws + WS_WI) + (size_t)r * 4) = acc[ai][0][m][0] * 0.0625f;
                } else {
                    float* p = (pn == 5) ? (float*)(ws + WS_UB) + (size_t)r * 256 + wc * 32 + 8 * fq : (float*)(ws + WS_HG) + (size_t)r * 1024 + (pn - 6) * 256 + wc * 32 + 8 * fq;
#pragma unroll
                    for (int bj = 0; bj < 2; ++bj) { *(f32x4*)(p + bj * 128) = acc[ai][bj][m][0]; *(f32x4*)(p + bj * 128 + 4) = acc[ai][bj][m][1]; }
                }
            }
    }
};
struct EpiOut {
    const float* hin; float* hout; const float* gate;
    __device__ __forceinline__ void operator()(const f32x4 (&acc)[2][2][4][2], const pg8::Unit& u, int wr, int wc, int fr, int fq) const {
        const int col0 = u.pn * 256 + wc * 32 + 8 * fq; const float* gp = gate + (size_t)u.b * 6144 + col0;
        f32x4 gv[2][2];
#pragma unroll
        for (int bj = 0; bj < 2; ++bj)
#pragma unroll
            for (int n = 0; n < 2; ++n) gv[bj][n] = *(const f32x4*)(gp + bj * 128 + n * 4);
#pragma unroll
        for (int ai = 0; ai < 2; ++ai)
#pragma unroll
            for (int m = 0; m < 4; ++m) { const size_t off = (size_t)(u.row0 + ai * 128 + wr * 64 + m * 16 + fr) * D + col0;
#pragma unroll
                for (int bj = 0; bj < 2; ++bj)
#pragma unroll
                    for (int n = 0; n < 2; ++n) { const f32x4 hv = *(const f32x4*)(hin + off + bj * 128 + n * 4); *(f32x4*)(hout + off + bj * 128 + n * 4) = hv + gv[bj][n] * acc[ai][bj][m][n]; }
                if (m & 1) asm volatile("" ::: "memory"); }
    }
};
struct EpiG1 {
    unsigned char* act; const float* b1l;
    __device__ __forceinline__ void operator()(const f32x4 (&acc)[2][2][4][2], const pg8::Unit& u, int wr, int wc, int fr, int fq) const {
        const int ja0 = u.pn * 128 + wc * 32 + 8 * fq; const float* bp = b1l + (size_t)u.e * 2048 + 2 * ja0;
        f32x4 bg[2], bl[2];
#pragma unroll
        for (int n = 0; n < 2; ++n) { const f32x4 t0 = *(const f32x4*)(bp + 8 * n), t1 = *(const f32x4*)(bp + 8 * n + 4); bg[n] = (f32x4){t0[0], t0[2], t1[0], t1[2]}; bl[n] = (f32x4){t0[1], t0[3], t1[1], t1[3]}; }
#pragma unroll
        for (int ai = 0; ai < 2; ++ai)
#pragma unroll
            for (int m = 0; m < 4; ++m) { float o[8];
#pragma unroll
                for (int n = 0; n < 2; ++n) { const f32x4 hg = acc[ai][0][m][n] * (1.0f / W8SCALE) + bg[n], hl = acc[ai][1][m][n] * (1.0f / W8SCALE) + bl[n];
#pragma unroll
                    for (int j = 0; j < 4; ++j) { const float xg = fminf(hg[j], 7.0f), xl = fminf(fmaxf(hl[j], -7.0f), 7.0f); o[4 * n + j] = xg * sigmoidf_(1.702f * xg) * (xl + 1.0f); } }
                u32x2 w; w.x = pk4_fp8(o[0], o[1], o[2], o[3]); w.y = pk4_fp8(o[4], o[5], o[6], o[7]);
                *(u32x2*)(act + (size_t)(u.row0 + ai * 128 + wr * 64 + m * 16 + fr) * FF + ja0) = w; }
    }
};
struct EpiG2 {
    bf16_t* y; const float* b2l;
    __device__ __forceinline__ void operator()(const f32x4 (&acc)[2][2][4][2], const pg8::Unit& u, int wr, int wc, int fr, int fq) const {
        const int col0 = u.pn * 256 + wc * 32 + 8 * fq; const float* bp = b2l + (size_t)u.e * 1024 + col0;
        f32x4 bv[2][2];
#pragma unroll
        for (int bj = 0; bj < 2; ++bj)
#pragma unroll
            for (int n = 0; n < 2; ++n) bv[bj][n] = *(const f32x4*)(bp + bj * 128 + n * 4);
#pragma unroll
        for (int ai = 0; ai < 2; ++ai)
#pragma unroll
            for (int m = 0; m < 4; ++m) { bf16_t* rowp = y + (size_t)(u.row0 + ai * 128 + wr * 64 + m * 16 + fr) * D + col0;
#pragma unroll
                for (int bj = 0; bj < 2; ++bj) { const f32x4 v0 = acc[ai][bj][m][0] * (1.0f / W8SCALE) + bv[bj][0], v1 = acc[ai][bj][m][1] * (1.0f / W8SCALE) + bv[bj][1];
                    u32x4 w; w.x = pk2(v0[0], v0[1]); w.y = pk2(v0[2], v0[3]); w.z = pk2(v1[0], v1[1]); w.w = pk2(v1[2], v1[3]); *(u32x4*)(rowp + bj * 128) = w; } }
    }
};
__device__ __forceinline__ int slot32(int d) { return 16 * ((d >> 2) & 1) + 4 * ((d >> 3) & 3) + (d & 3); }
__device__ __forceinline__ int win_dest(int s) {
    if (s < 512) { const int hd = s >> 6, d64 = s & 63; return 256 * (hd >> 2) + 128 * (d64 >> 5) + 32 * (hd & 3) + slot32(d64 & 31); }
    if (s < 640) { const int hd = (s - 512) >> 6, d64 = s & 63; return 512 + 128 * (d64 >> 5) + 32 * hd + slot32(d64 & 31); }
    if (s < 768) { const int v = s - 640; return 512 + 128 * (v >> 6) + 32 * (2 + ((v & 63) >> 5)) + slot32(v & 31); }
    if (s < 1024) { const int hd = (s - 768) >> 6, d64 = s & 63; return 768 + 128 * (d64 >> 5) + 32 * hd + slot32(d64 & 31); }
    if (s < 1088) { const int d64 = s - 1024; return 1024 + 128 * (d64 >> 5) + slot32(d64 & 31); }
    if (s < 1092) return 1024 + 32 + (s - 1088);
    if (s < 1348) { const int v = s - 1092; return 1280 + (v & ~31) + slot32(v & 31); }
    { const int v = s - 1348; return 1536 + (v & ~31) + slot32(v & 31); }
}
__device__ __forceinline__ int perm_dest(int s) { return (s & ~31) + 16 * ((s >> 2) & 1) + 4 * ((s >> 3) & 3) + (s & 3); }
__device__ __forceinline__ int w1_dest(int s) { const int jg = s >> 1, isl = s & 1, nt = jg >> 7, ja = jg & 127; return 256 * nt + 128 * isl + (ja & ~31) + slot32(ja & 31); }

template <int MAP>
__device__ __forceinline__ void transpose_item(const float* W, int N, bf16_t* WT, LAS float* scr, int kb, int nb, int lane) {
    const int k0 = 64 * kb, n0 = 32 * nb, col = n0 + (lane & 31); const bool ok = col < N;
    float v[32];
    const float* src = W + (size_t)(k0 + (lane >> 5)) * N + (ok ? col : 0);
#pragma unroll
    for (int i = 0; i < 32; ++i) v[i] = src[(size_t)(2 * i) * N];
#pragma unroll
    for (int i = 0; i < 32; ++i) scr[(2 * i + (lane >> 5)) * 33 + (lane & 31)] = ok ? v[i] : 0.f;
    asm volatile("s_waitcnt lgkmcnt(0)" ::: "memory");
    const int c = lane & 7;
#pragma unroll
    for (int j = 0; j < 4; ++j) { const int n = (lane >> 3) + 8 * j; const LAS float* s = scr + (8 * c) * 33 + n;
        u32x4 o; o.x = pk2(s[0 * 33], s[1 * 33]); o.y = pk2(s[2 * 33], s[3 * 33]); o.z = pk2(s[4 * 33], s[5 * 33]); o.w = pk2(s[6 * 33], s[7 * 33]);
        const int sc = n0 + n;
        if (sc < N) { const int dest = MAP == 1 ? win_dest(sc) : (MAP == 2 ? w1_dest(sc) : (MAP == 3 ? perm_dest(sc) : sc)); *(u32x4*)(WT + (size_t)dest * 1024 + k0 + 8 * c) = o; } }
    asm volatile("s_waitcnt lgkmcnt(0)" ::: "memory");
}

__device__ __forceinline__ void phase_prep(const Args& a, Ctx& C) {
    unsigned char* ws = C.ws;
    {
        LAS float* ca = (LAS float*)C.lds;
        LAS float* red = ca + 4096;
        for (int i = C.tid; i < 4096; i += NTHREADS) { const float v = a.c[i]; ca[i] = siluf_(v); }
        __syncthreads();
        for (int it = blockIdx.x; it < 192; it += C.G) {
            const int l = it / 96, cb = it % 96, col = cb * 64 + (C.tid & 63), kg = C.tid >> 6;
            const float* w = a.w_ada + (size_t)l * 1024 * 6144 + col;
            float s0 = 0.f, s1 = 0.f, s2 = 0.f, s3 = 0.f;
#pragma unroll 8
            for (int k = kg * 128; k < kg * 128 + 128; ++k) { const float wv = w[(size_t)k * 6144]; s0 += ca[k] * wv; s1 += ca[1024 + k] * wv; s2 += ca[2048 + k] * wv; s3 += ca[3072 + k] * wv; }
            red[(kg * 4 + 0) * 64 + (C.tid & 63)] = s0; red[(kg * 4 + 1) * 64 + (C.tid & 63)] = s1; red[(kg * 4 + 2) * 64 + (C.tid & 63)] = s2; red[(kg * 4 + 3) * 64 + (C.tid & 63)] = s3;
            __syncthreads();
            if (C.tid < 256) { const int b = C.tid >> 6, cc = C.tid & 63; float s = 0.f;
#pragma unroll
                for (int g = 0; g < 8; ++g) s += red[(g * 4 + b) * 64 + cc];
                ((float*)(ws + WS_MOD))[(size_t)(l * 4 + b) * 6144 + cb * 64 + cc] = s + a.b_ada[l * 6144 + cb * 64 + cc]; }
            __syncthreads();
        }
    }
    const int gw = C.vcu * NWAVES + C.wave, NGW = C.G * NWAVES;
    for (int tk = gw; tk < NTOK; tk += NGW) {
        if (C.lane < 32) {
            const float posf = (float)a.pos[tk];
            const float inv = exp2f(-(float)C.lane * (13.287712379549449f / 32.0f));
            const double ang = (double)(posf * inv);
            const double kq = rint(ang * 0.63661977236758134308);
            const double y = fma(-kq, 1.57079632679489661923, ang);
            const double y2 = y * y;
            const double sy = y * (1.0 + y2 * (-1.0 / 6 + y2 * (1.0 / 120 + y2 * (-1.0 / 5040 + y2 * (1.0 / 362880 - y2 * (1.0 / 39916800))))));
            const double cy = 1.0 + y2 * (-0.5 + y2 * (1.0 / 24 + y2 * (-1.0 / 720 + y2 * (1.0 / 40320 + y2 * (-1.0 / 3628800 + y2 * (1.0 / 479001600))))));
            const int q = ((int)((long long)kq)) & 3;
            const double sn = (q == 0) ? sy : (q == 1) ? cy : (q == 2) ? -sy : -cy;
            const double cs = (q == 0) ? cy : (q == 1) ? -sy : (q == 2) ? -cy : sy;
            ((float*)(ws + WS_ROPEC))[(size_t)tk * 32 + C.lane] = (float)cs;
            ((float*)(ws + WS_ROPES))[(size_t)tk * 32 + C.lane] = (float)sn;
        }
    }
    for (int i = gw * 64 + C.lane; i < 2 * 32 * 1024; i += NGW * 64) { const int l = i >> 15, e = (i >> 10) & 31, k = i & 1023; const float wv = a.w_router[(size_t)l * 32768 + k * 32 + e];
        const unsigned hi = f2bf(wv); const float lo = wv - bf2f((unsigned short)hi); ((bf16_t*)(ws + WS_WRH))[i] = (bf16_t)hi; ((bf16_t*)(ws + WS_WRL))[i] = (bf16_t)f2bf(lo); }
    LAS float* scr = (LAS float*)(C.lds + C.wave * 16384);
    constexpr int I_IN = 2 * 16 * 75, I_OUT = 2 * 16 * 32;
    for (int it = gw; it < I_IN + I_OUT; it += NGW) {
        int r = it;
        if (r < I_IN) { const int l = r / (16 * 75), q = r % (16 * 75); transpose_item<1>(a.w_in + (size_t)l * 1024 * D_IN, D_IN, (bf16_t*)(ws + WS_WIN) + (size_t)l * NPAD * 1024, scr, q / 75, q % 75, C.lane); continue; }
        r -= I_IN;
        { const int l = r / (16 * 32), q = r % (16 * 32); transpose_item<3>(a.w_out + (size_t)l * 1024 * 1024, 1024, (bf16_t*)(ws + WS_WOUT) + (size_t)l * 1024 * 1024, scr, q / 32, q % 32, C.lane); }
    }
}

struct Conv {
    const float* w1l; const float* w2l; unsigned char* w1t; unsigned char* w2t;
    int it, step, lane; bool pend;
    const float* W; unsigned char* WT; int N, map, k0, n0;
    f32x4 v4[8];
    static constexpr int NITEMS = 32 * 16 * 64 + 32 * 16 * 32;
    int it_end;
    __device__ __forceinline__ void issue() {
        if (it >= it_end) return;
        if (it < 32 * 16 * 64) { const int e = it >> 10, q = it & 1023; W = w1l + (size_t)e * 1024 * 2048; WT = w1t + (size_t)e * 2048 * 1024; N = 2048; map = 2; k0 = 64 * (q >> 6); n0 = 32 * (q & 63); }
        else { const int r = it - 32 * 16 * 64, e = r >> 9, q = r & 511; W = w2l + (size_t)e * 1024 * 1024; WT = w2t + (size_t)e * 1024 * 1024; N = 1024; map = 3; k0 = 64 * (q >> 5); n0 = 32 * (q & 31); }
        const float* src = W + (size_t)(k0 + (lane >> 3)) * N + n0 + 4 * (lane & 7);
#pragma unroll
        for (int i = 0; i < 8; ++i) v4[i] = *(const f32x4*)(src + (size_t)(8 * i) * N);
        pend = true; it += step;
    }
    __device__ __forceinline__ void finish(LAS float* scr) {
        if (!pend) return;
#pragma unroll
        for (int i = 0; i < 8; ++i) { LAS float* d = scr + ((lane >> 3) + 8 * i) * 33 + 4 * (lane & 7); d[0] = v4[i].x; d[1] = v4[i].y; d[2] = v4[i].z; d[3] = v4[i].w; }
        asm volatile("s_waitcnt lgkmcnt(0)" ::: "memory");
        const int c = lane & 7;
#pragma unroll
        for (int j = 0; j < 4; ++j) { const int n = (lane >> 3) + 8 * j; const LAS float* sp = scr + (8 * c) * 33 + n;
            u32x2 o; o.x = pk4_fp8(sp[0 * 33] * W8SCALE, sp[1 * 33] * W8SCALE, sp[2 * 33] * W8SCALE, sp[3 * 33] * W8SCALE); o.y = pk4_fp8(sp[4 * 33] * W8SCALE, sp[5 * 33] * W8SCALE, sp[6 * 33] * W8SCALE, sp[7 * 33] * W8SCALE);
            const int sc = n0 + n; const int dest = map == 2 ? w1_dest(sc) : perm_dest(sc); *(u32x2*)(WT + (size_t)dest * 1024 + k0 + 8 * c) = o; }
        asm volatile("s_waitcnt lgkmcnt(0)" ::: "memory");
        pend = false;
    }
};

__device__ __forceinline__ void norm_mod_store(const f32x4 (&v)[4], const float* g, const float* sh, const float* sc, bf16_t* urow, int lane) {
    float ss = 0.f;
#pragma unroll
    for (int j = 0; j < 4; ++j) ss += (v[j].x * v[j].x + v[j].y * v[j].y) + (v[j].z * v[j].z + v[j].w * v[j].w);
    const float rstd = 1.0f / sqrtf(wave_sum(ss) * (1.0f / D) + EPS);
#pragma unroll
    for (int j = 0; j < 4; ++j) { const int idx = 4 * lane + 256 * j; const f32x4 gv = *(const f32x4*)(g + idx), shv = *(const f32x4*)(sh + idx), scv = *(const f32x4*)(sc + idx);
        const f32x4 o = v[j] * rstd * gv * (scv + 1.0f) + shv; u32x2 w; w.x = pk2(o[0], o[1]); w.y = pk2(o[2], o[3]); *(u32x2*)(urow + idx) = w; }
}

__device__ __forceinline__ void phase_u0(const Args& a, Ctx& C) {
    const int gw = C.vcu * NWAVES + C.wave, NGW = C.G * NWAVES; const float* mod = (const float*)(C.ws + WS_MOD);
    for (int tk0 = gw; tk0 < NTOK; tk0 += 2 * NGW) {
        const bool two = (tk0 + NGW) < NTOK; const int tk1 = two ? tk0 + NGW : tk0;
        const f32x4* x0 = (const f32x4*)(a.x + (size_t)tk0 * D) + C.lane; const f32x4* x1 = (const f32x4*)(a.x + (size_t)tk1 * D) + C.lane; f32x4 v0[4], v1[4];
#pragma unroll
        for (int j = 0; j < 4; ++j) { v0[j] = x0[64 * j]; v1[j] = x1[64 * j]; }
        { const float* mb = mod + (size_t)(tk0 >> 12) * 6144; norm_mod_store(v0, a.norm1_g, mb + 0, mb + 1024, (bf16_t*)(C.ws + WS_U) + (size_t)tk0 * D, C.lane); }
        if (two) { const float* mb = mod + (size_t)(tk1 >> 12) * 6144; norm_mod_store(v1, a.norm1_g, mb + 0, mb + 1024, (bf16_t*)(C.ws + WS_U) + (size_t)tk1 * D, C.lane); }
    }
}

__device__ __forceinline__ unsigned sortable(float f) { const unsigned u = __builtin_bit_cast(unsigned, f); return (u & 0x80000000u) ? ~u : (u | 0x80000000u); }
__device__ __forceinline__ int mbcnt64(unsigned long long m) { return __builtin_amdgcn_mbcnt_hi((unsigned)(m >> 32), __builtin_amdgcn_mbcnt_lo((unsigned)m, 0)); }

constexpr int HP = 65;
__device__ __forceinline__ int wave_isum(int v) {
    v += __builtin_amdgcn_update_dpp(0, v, 0xB1, 0xF, 0xF, true);
    v += __builtin_amdgcn_update_dpp(0, v, 0x4E, 0xF, 0xF, true);
    v += __builtin_amdgcn_update_dpp(0, v, 0x141, 0xF, 0xF, true);
    v += __builtin_amdgcn_update_dpp(0, v, 0x140, 0xF, 0xF, true);
    return __builtin_amdgcn_readlane(v, 0) + __builtin_amdgcn_readlane(v, 16) + __builtin_amdgcn_readlane(v, 32) + __builtin_amdgcn_readlane(v, 48);
}
typedef float f32x16 __attribute__((ext_vector_type(16)));
__device__ __forceinline__ void transpose32(unsigned (&a)[32]) {
#pragma unroll
    for (int st = 0; st < 5; ++st) {
        const int j = 16 >> st; const unsigned m = (st == 0) ? 0x0000FFFFu : (st == 1) ? 0x00FF00FFu : (st == 2) ? 0x0F0F0F0Fu : (st == 3) ? 0x33333333u : 0x55555555u;
#pragma unroll
        for (int idx = 0; idx < 16; ++idx) { const int k = (idx / j) * 2 * j + (idx % j); const unsigned t = (a[k] ^ (a[k + j] >> j)) & m; a[k] ^= t; a[k + j] ^= (t << j); }
    }
}
__device__ __forceinline__ int wave_iscan(int v) {
    v += __builtin_amdgcn_update_dpp(0, v, 0x111, 0xF, 0xF, true);
    v += __builtin_amdgcn_update_dpp(0, v, 0x112, 0xF, 0xF, true);
    v += __builtin_amdgcn_update_dpp(0, v, 0x114, 0xF, 0xF, true);
    v += __builtin_amdgcn_update_dpp(0, v, 0x118, 0xF, 0xF, true);
    v += __builtin_amdgcn_update_dpp(0, v, 0x142, 0xA, 0xF, false);
    v += __builtin_amdgcn_update_dpp(0, v, 0x143, 0xC, 0xF, false);
    return v;
}
__device__ __forceinline__ unsigned sortable16(unsigned h) { return (h & 0x8000u) ? (~h & 0xFFFFu) : (h | 0x8000u); }
__device__ __forceinline__ unsigned short f2h_bits(float f) { const _Float16 h = (_Float16)f; unsigned short b = __builtin_bit_cast(unsigned short, h); return b == 0x8000u ? (unsigned short)0 : b; }
template <int NB>
__device__ __forceinline__ void select_bits16(const LAS unsigned short* sq, int nj, int* sel, int lane) {
    unsigned a[32];
#pragma unroll
    for (int j = 0; j < 32; ++j) { const unsigned lo = sortable16(sq[64 * j + lane]); const unsigned hi = (NB == 2) ? sortable16(sq[64 * (32 + j) + lane]) : 0u; a[j] = lo | (hi << 16); }
    transpose32(a);
    unsigned Ml = 0xFFFFFFFFu, Mh = (NB == 2) ? 0xFFFFFFFFu : 0u, Gl = 0u, Gh = 0u; unsigned T = 0u; int G = 0;
#pragma unroll
    for (int bit = 15; bit >= 0; --bit) {
        const unsigned nl = Ml & a[31 - bit], nh = Mh & a[15 - bit];
        const int tot = wave_isum(__popc(nl) + __popc(nh));
        const bool take = (G + tot) >= 256; const unsigned flip = take ? 0u : 0xFFFFFFFFu;
        T |= take ? (1u << bit) : 0u; G += take ? 0 : tot;
        Gl |= nl & flip; Gh |= nh & flip; Ml &= (a[31 - bit] ^ flip); Mh &= (a[15 - bit] ^ flip);
    }
    const int need = 256 - G;
    if (T != 0x8000u) {
        const int ceq = __popc(Ml) + __popc(Mh); const int incl = wave_iscan(ceq);
        int quota = need - (incl - ceq); quota = quota < 0 ? 0 : (quota > ceq ? ceq : quota);
        const int cnt = __popc(Gl) + __popc(Gh) + quota; const int inc2 = wave_iscan(cnt);
        int pos = inc2 - cnt;
        { unsigned mk = Gl; while (mk) { const int x = 31 - __clz((int)mk); mk &= ~(1u << x); sel[pos++] = 64 * (31 - x) + lane; } }
        if (NB == 2) { unsigned mk = Gh; while (mk) { const int x = 31 - __clz((int)mk); mk &= ~(1u << x); sel[pos++] = 64 * (63 - x) + lane; } }
        { unsigned mk = Ml; while (mk && quota > 0) { const int x = 31 - __clz((int)mk); mk &= ~(1u << x); sel[pos++] = 64 * (31 - x) + lane; --quota; } }
        if (NB == 2) { unsigned mk = Mh; while (mk && quota > 0) { const int x = 31 - __clz((int)mk); mk &= ~(1u << x); sel[pos++] = 64 * (63 - x) + lane; --quota; } }
    } else {
        int base = 0, eqseen = 0;
#pragma unroll 1
        for (int j = 0; j < nj; ++j) {
            const unsigned kj = sortable16(sq[64 * j + lane]);
            const bool gt = kj > T, eq = kj == T; const unsigned long long em = __ballot(eq);
            const bool take = gt || (eq && (eqseen + mbcnt64(em)) < need); const unsigned long long tm = __ballot(take);
            if (take) sel[base + mbcnt64(tm)] = 64 * j + lane;
            base += __popcll(tm); eqseen += __popcll(em);
        }
    }
}
constexpr int CONV_SPLIT = 16384;
constexpr int KST_ROW = 144, KST_BYTES = 64 * KST_ROW;
__device__ __forceinline__ void index_unit2(Ctx& C, int b, int cch, int sub, Conv& cv) {
    unsigned char* ws = C.ws; const int lane = C.lane, w = C.wave;
    const int tk0 = b * SEQ + 64 * cch + 8 * sub, L = 64 * (cch + 1), nj = cch + 1;
    if (L <= 256) { int* sel = (int*)(ws + WS_SEL) + (size_t)(tk0 + w) * 256; for (int i = lane; i < L; i += 64) sel[i] = i; return; }
    LAS unsigned short* sclh = (LAS unsigned short*)C.lds;
    LAS unsigned char* kst = C.lds + 65536 + w * KST_BYTES;
    {
        const int r = lane & 31, hf = lane >> 5, qq = r >> 2, h = r & 3;
        bf16x8 aq[4];
#pragma unroll
        for (int ks = 0; ks < 4; ++ks) aq[ks] = *(const bf16x8*)((const bf16_t*)(ws + WS_QI) + (size_t)(tk0 + qq) * 256 + h * 64 + 16 * ks + 8 * hf);
        f32x4 wq[4];
#pragma unroll
        for (int g = 0; g < 4; ++g) wq[g] = *(const f32x4*)((const float*)(ws + WS_WI) + (size_t)(tk0 + 2 * g + hf) * 4);
        const unsigned char* kib = ws + WS_KI + (size_t)b * SEQ * 128;
        const int ntile = 2 * nj;
        u32x4 st[8];
#define IDX2_LOAD(kta) do { const int _t1 = (kta), _t2 = ((kta) + NWAVES) < ntile ? (kta) + NWAVES : (kta); _Pragma("unroll") for (int j = 0; j < 4; ++j) { \
            st[j] = *(const u32x4*)(kib + (size_t)_t1 * 4096 + 1024 * j + 16 * lane); st[4 + j] = *(const u32x4*)(kib + (size_t)_t2 * 4096 + 1024 * j + 16 * lane); } } while (0)
        if (w < ntile) IDX2_LOAD(w);
#pragma unroll 1
        for (int kt = w; kt < ntile; kt += 2 * NWAVES) {
            const bool two = (kt + NWAVES) < ntile; const int kt2 = two ? kt + NWAVES : kt;
#pragma unroll
            for (int j = 0; j < 4; ++j) { *(LAS u32x4*)(kst + (8 * j + (lane >> 3)) * KST_ROW + 16 * (lane & 7)) = st[j]; *(LAS u32x4*)(kst + (32 + 8 * j + (lane >> 3)) * KST_ROW + 16 * (lane & 7)) = st[4 + j]; }
            if ((kt + 2 * NWAVES) < ntile) IDX2_LOAD(kt + 2 * NWAVES);
            f32x16 acc, acc2;
#pragma unroll
            for (int i = 0; i < 16; ++i) { acc[i] = 0.f; acc2[i] = 0.f; }
#pragma unroll
            for (int ks = 0; ks < 4; ++ks) { const bf16x8 b1 = *(const LAS bf16x8*)(kst + r * KST_ROW + 32 * ks + 16 * hf), b2 = *(const LAS bf16x8*)(kst + (32 + r) * KST_ROW + 32 * ks + 16 * hf);
                acc = __builtin_amdgcn_mfma_f32_32x32x16_bf16(aq[ks], b1, acc, 0, 0, 0); acc2 = __builtin_amdgcn_mfma_f32_32x32x16_bf16(aq[ks], b2, acc2, 0, 0, 0); }
#pragma unroll
            for (int g = 0; g < 4; ++g) {
                const float sc = fmaxf(acc[4 * g + 0], 0.f) * wq[g][0] + fmaxf(acc[4 * g + 1], 0.f) * wq[g][1] + fmaxf(acc[4 * g + 2], 0.f) * wq[g][2] + fmaxf(acc[4 * g + 3], 0.f) * wq[g][3];
                sclh[(2 * g + hf) * 4096 + 32 * kt + r] = f2h_bits(sc);
                const float sc2 = fmaxf(acc2[4 * g + 0], 0.f) * wq[g][0] + fmaxf(acc2[4 * g + 1], 0.f) * wq[g][1] + fmaxf(acc2[4 * g + 2], 0.f) * wq[g][2] + fmaxf(acc2[4 * g + 3], 0.f) * wq[g][3];
                if (two) sclh[(2 * g + hf) * 4096 + 32 * kt2 + r] = f2h_bits(sc2);
            }
        }
#undef IDX2_LOAD
        const int njp = nj <= 32 ? 32 : 64;
        for (int j = nj; j < njp; ++j) sclh[w * 4096 + 64 * j + lane] = (unsigned short)0xFBFFu;
    }
    __syncthreads();
    {
        const LAS unsigned short* sq = sclh + w * 4096; int* sel = (int*)(ws + WS_SEL) + (size_t)(tk0 + w) * 256;
        cv.issue();
        if (nj <= 32) select_bits16<1>(sq, nj, sel, lane); else select_bits16<2>(sq, nj, sel, lane);
        cv.finish((LAS float*)kst);
    }
    __syncthreads();
}

typedef short s16x4 __attribute__((ext_vector_type(4)));
constexpr int VROW = 272;
__device__ __forceinline__ void attend_query_mfma(Ctx& C, int tk, LAS unsigned char* vs, Conv& cv) {
    unsigned char* ws = C.ws; const int lane = C.lane, c = lane & 15, g = lane >> 4;
    const int tpos = tk & (SEQ - 1), b = tk >> 12, L = 64 * ((tpos >> 6) + 1), nsel = L < 256 ? L : 256;
    const bf16_t* kb = (const bf16_t*)(ws + WS_K) + (size_t)b * SEQ * 128; const bf16_t* vb = (const bf16_t*)(ws + WS_V) + (size_t)b * SEQ * 128;
    int selr[4];
    { const int* sg = (const int*)(ws + WS_SEL) + (size_t)tk * 256;
#pragma unroll
      for (int i = 0; i < 4; ++i) selr[i] = (64 * i + lane) < nsel ? sg[64 * i + lane] : 0; }
    bf16x8 bq0[2], bq1[2];
    { const bf16_t* qp = (const bf16_t*)(ws + WS_Q) + (size_t)tk * 512 + (c & 7) * 64 + 8 * g; const bf16x8 z = (bf16x8){0, 0, 0, 0, 0, 0, 0, 0};
#pragma unroll
      for (int ks = 0; ks < 2; ++ks) { const bf16x8 q = *(const bf16x8*)(qp + 32 * ks); bq0[ks] = (c < 4) ? q : z; bq1[ks] = (c >= 4 && c < 8) ? q : z; } }
    cv.issue();
    f32x4 acc[16];
#pragma unroll
    for (int kt = 0; kt < 16; ++kt) {
        if ((kt & 3) == 0) asm volatile("" ::: "memory");
        const int key = __shfl(selr[kt >> 2], 16 * (kt & 3) + c);
        const bf16_t* kr = kb + (size_t)key * 128 + 8 * g;
        const bf16x8 a00 = *(const bf16x8*)(kr), a01 = *(const bf16x8*)(kr + 32), a10 = *(const bf16x8*)(kr + 64), a11 = *(const bf16x8*)(kr + 96);
        f32x4 t = (f32x4){0.f, 0.f, 0.f, 0.f};
        t = __builtin_amdgcn_mfma_f32_16x16x32_bf16(a00, bq0[0], t, 0, 0, 0); t = __builtin_amdgcn_mfma_f32_16x16x32_bf16(a01, bq0[1], t, 0, 0, 0);
        t = __builtin_amdgcn_mfma_f32_16x16x32_bf16(a10, bq1[0], t, 0, 0, 0); t = __builtin_amdgcn_mfma_f32_16x16x32_bf16(a11, bq1[1], t, 0, 0, 0);
        acc[kt] = t;
    }
    asm volatile("" ::: "memory"); cv.finish((LAS float*)vs); cv.issue();
    { const int lim = nsel - 4 * g;
#pragma unroll
      for (int kt = 0; kt < 16; ++kt)
#pragma unroll
        for (int r = 0; r < 4; ++r) acc[kt][r] = (16 * kt + r < lim) ? acc[kt][r] : -1e30f; }
    float m = -1e30f;
#pragma unroll
    for (int kt = 0; kt < 16; ++kt) m = fmaxf(m, fmaxf(fmaxf(acc[kt][0], acc[kt][1]), fmaxf(acc[kt][2], acc[kt][3])));
    m = fmaxf(m, __shfl_xor(m, 16)); m = fmaxf(m, __shfl_xor(m, 32));
    float sum = 0.f;
#pragma unroll
    for (int kt = 0; kt < 16; ++kt)
#pragma unroll
        for (int r = 0; r < 4; ++r) { const float pv = __expf(acc[kt][r] - m); acc[kt][r] = pv; sum += pv; }
    sum += __shfl_xor(sum, 16); sum += __shfl_xor(sum, 32);
    const float inv = 1.0f / sum;
    bf16x8 bp[8];
#pragma unroll
    for (int T = 0; T < 8; ++T) { u32x4 w; w.x = cvt_pk_bf16(acc[2 * T][0], acc[2 * T][1]); w.y = cvt_pk_bf16(acc[2 * T][2], acc[2 * T][3]); w.z = cvt_pk_bf16(acc[2 * T + 1][0], acc[2 * T + 1][1]); w.w = cvt_pk_bf16(acc[2 * T + 1][2], acc[2 * T + 1][3]);
        bp[T] = __builtin_bit_cast(bf16x8, w); }
    f32x4 ao0[4], ao1[4];
#pragma unroll
    for (int dt = 0; dt < 4; ++dt) { ao0[dt] = (f32x4){0.f, 0.f, 0.f, 0.f}; ao1[dt] = (f32x4){0.f, 0.f, 0.f, 0.f}; }
    const int q4 = c >> 2, p4 = c & 3;
    u32x4 vst[8];
#define ATT_VLOAD(T) do { _Pragma("unroll") for (int i = 0; i < 8; ++i) { const int row = g + 4 * i; \
        const int key = __shfl(selr[(T) >> 1], 32 * ((T) & 1) + row); vst[i] = *(const u32x4*)(vb + (size_t)key * 128 + 8 * c); } } while (0)
    ATT_VLOAD(0);
#pragma unroll
    for (int T = 0; T < 8; ++T) {
        LAS unsigned char* buf = vs + (T & 1) * (32 * VROW);
        asm volatile("" ::: "memory");
#pragma unroll
        for (int i = 0; i < 8; ++i) *(LAS u32x4*)(buf + (g + 4 * i) * VROW + 16 * c) = vst[i];
        if (T < 7) ATT_VLOAD(T + 1);
#pragma unroll
        for (int n = 0; n < 2; ++n)
#pragma unroll
            for (int dt = 0; dt < 4; ++dt) {
                LAS s16x4* p0 = (LAS s16x4*)(buf + (4 * g + q4) * VROW + (n * 64 + 16 * dt + 4 * p4) * 2);
                const s16x4 lo = __builtin_amdgcn_ds_read_tr16_b64_v4i16(p0), hi = __builtin_amdgcn_ds_read_tr16_b64_v4i16((LAS s16x4*)((LAS unsigned char*)p0 + 16 * VROW));
                const bf16x8 av = (bf16x8){lo[0], lo[1], lo[2], lo[3], hi[0], hi[1], hi[2], hi[3]};
                if (n == 0) ao0[dt] = __builtin_amdgcn_mfma_f32_16x16x32_bf16(av, bp[T], ao0[dt], 0, 0, 0);
                else ao1[dt] = __builtin_amdgcn_mfma_f32_16x16x32_bf16(av, bp[T], ao1[dt], 0, 0, 0);
            }
    }
#undef ATT_VLOAD
    asm volatile("" ::: "memory"); cv.finish((LAS float*)vs);
    if (c < 8) {
        bf16_t* mo = (bf16_t*)(ws + WS_MIX) + (size_t)tk * D + c * 64 + 4 * g;
#pragma unroll
        for (int dt = 0; dt < 4; ++dt) { f32x4 o; o[0] = (c < 4 ? ao0[dt][0] : ao1[dt][0]) * inv; o[1] = (c < 4 ? ao0[dt][1] : ao1[dt][1]) * inv; o[2] = (c < 4 ? ao0[dt][2] : ao1[dt][2]) * inv; o[3] = (c < 4 ? ao0[dt][3] : ao1[dt][3]) * inv; u32x2 w; w.x = cvt_pk_bf16(o[0], o[1]); w.y = cvt_pk_bf16(o[2], o[3]); *(u32x2*)(mo + 16 * dt) = w; }
    }
}

__device__ __forceinline__ void pool_wave(const Args& a, Ctx& C, int l) {
    unsigned char* ws = C.ws; const int lane = C.lane;
    const int gwv = blockIdx.x * NWAVES + C.wave, g = gwv & 3, widx = gwv >> 2, nw = (C.G * NWAVES) >> 2, w = 2 << g;
    float pwr[64];
#pragma unroll
    for (int c = 0; c < 64; ++c) pwr[c] = a.pool_w[(size_t)(l * 4 + g) * 4096 + c * 64 + lane];
    const float psc = a.pool_scale[l * 256 + g * 64 + lane];
    const float* ubg = (const float*)(ws + WS_UB) + g * 64 + lane;
    for (int tile = widx; tile < NTOK / 8; tile += nw) {
        const int tok0 = tile * 8, tp0 = tok0 & (SEQ - 1);
        float row[23];
#pragma unroll
        for (int r = 0; r < 23; ++r) { const int tp = tp0 - 15 + r; row[r] = (tp >= 0) ? ubg[(size_t)(tok0 - 15 + r) * 256] : 0.f; }
        float pooled[8];
#pragma unroll
        for (int t = 0; t < 8; ++t) {
            float sm = 0.f;
#pragma unroll
            for (int i = 0; i < 16; ++i) if (i < w) sm += row[15 + t - i];
            const int tpos = tp0 + t; const int wl = (tpos + 1) < w ? (tpos + 1) : w;
            pooled[t] = sm * (1.0f / (float)wl) - row[15 + t];
        }
        float y[8] = {0.f, 0.f, 0.f, 0.f, 0.f, 0.f, 0.f, 0.f};
#pragma unroll
        for (int c = 0; c < 64; ++c) {
#pragma unroll
            for (int t = 0; t < 8; ++t) y[t] += __builtin_bit_cast(float, __builtin_amdgcn_readlane(__builtin_bit_cast(int, pooled[t]), c)) * pwr[c];
        }
        bf16_t* mo = (bf16_t*)(ws + WS_MIX) + (size_t)tok0 * D + 512 + g * 64 + lane;
#pragma unroll
        for (int t = 0; t < 8; ++t) mo[(size_t)t * D] = (bf16_t)f2bf(y[t] * psc);
    }
}

__device__ __forceinline__ float row_shr_add(float x, int) { return x; }
template <int N> __device__ __forceinline__ float dpp_row_shr(float x) { return __builtin_bit_cast(float, __builtin_amdgcn_update_dpp(0, __builtin_bit_cast(int, x), 0x110 + N, 0xF, 0xF, true)); }
__device__ __forceinline__ float row_scan16(float x) { x += dpp_row_shr<1>(x); x += dpp_row_shr<2>(x); x += dpp_row_shr<4>(x); x += dpp_row_shr<8>(x); return x; }
__device__ __forceinline__ float row_last16(float x) { return __builtin_bit_cast(float, __builtin_amdgcn_update_dpp(0, __builtin_bit_cast(int, x), 0x15F, 0xF, 0xF, true)); }
__device__ __forceinline__ float row_sum16(float v) {
    v += __builtin_bit_cast(float, __builtin_amdgcn_update_dpp(0, __builtin_bit_cast(int, v), 0xB1, 0xF, 0xF, true));
    v += __builtin_bit_cast(float, __builtin_amdgcn_update_dpp(0, __builtin_bit_cast(int, v), 0x4E, 0xF, 0xF, true));
    v += __builtin_bit_cast(float, __builtin_amdgcn_update_dpp(0, __builtin_bit_cast(int, v), 0x141, 0xF, 0xF, true));
    v += __builtin_bit_cast(float, __builtin_amdgcn_update_dpp(0, __builtin_bit_cast(int, v), 0x140, 0xF, 0xF, true));
    return v;
}
__device__ __forceinline__ void hgrn_out3(const Args& a, Ctx& C, int l, int item, LAS unsigned char* kls) {
    const int lane = C.lane, tt = lane & 15, g = lane >> 4, c = item & 63, hh = (item >> 6) & 3, b = item >> 8, bh = b * 4 + hh, cg = c >> 2, ci = c & 3;
    const float* HG = (const float*)(C.ws + WS_HG); const float* HR = (const float*)(C.ws + WS_HL); const float* HE = (const float*)(C.ws + WS_HD);
    float lb[16];
#pragma unroll
    for (int e = 0; e < 16; ++e) { const int kk = hh * 64 + 16 * (e >> 2) + 4 * g + (e & 3); lb[e] = (l == 1) ? 1.0f / (1.0f + expf(a.lb_logits[kk] - a.lb_logits[256 + kk])) : 0.f; }
    f32x4 S[4][4];
#pragma unroll
    for (int vq = 0; vq < 4; ++vq)
#pragma unroll
        for (int kt = 0; kt < 4; ++kt) S[vq][kt] = (f32x4){0.f, 0.f, 0.f, 0.f};
    const int nstep = cg + (ci > 0 ? 1 : 0);
#pragma unroll 1
    for (int st = 0; st < nstep; ++st) {
        const int chn = (st < cg) ? (4 * st + 3) : (4 * cg + ci - 1); const size_t ch = (size_t)(bh * 64 + chn);
        const float* hr = HR + ch * 4096 + (g * 16 + tt) * 4; const float* he = HE + ch * 64 + 4 * g;
        f32x4 ev[4];
#pragma unroll
        for (int kt = 0; kt < 4; ++kt) ev[kt] = *(const f32x4*)(he + 16 * kt);
#pragma unroll
        for (int vq = 0; vq < 4; ++vq)
#pragma unroll
            for (int kt = 0; kt < 4; ++kt) S[vq][kt] = S[vq][kt] * ev[kt] + *(const f32x4*)(hr + (vq * 4 + kt) * 256);
    }
    const size_t tok0 = (size_t)b * SEQ + c * 64;
#pragma unroll 1
    for (int sb = 0; sb < 4; ++sb) {
        const size_t tok = tok0 + 16 * sb + tt; const float* row = HG + tok * 1024 + hh * 64 + 4 * g;
        float qh[16], kt_[16], kp[16], dd[16];
#pragma unroll
        for (int e4 = 0; e4 < 4; ++e4) {
            const f32x4 q4 = *(const f32x4*)(row + 16 * e4), z4 = *(const f32x4*)(row + 256 + 16 * e4);
#pragma unroll
            for (int j = 0; j < 4; ++j) { const int e = 4 * e4 + j; const float lbe = lb[e];
                const float sg = __builtin_amdgcn_rcpf(1.0f + __expf(-z4[j])), sn = __builtin_amdgcn_rcpf(1.0f + __expf(z4[j]));
                const float lf = __logf(lbe + (1.0f - lbe) * sg), kin = (1.0f - lbe) * sn;
                const float cc = row_scan16(lf), c15 = row_last16(cc);
                qh[e] = siluf_(q4[j]) * __expf(cc); kt_[e] = kin * __expf(fminf(-cc, 80.0f)); kp[e] = kin * __expf(c15 - cc); dd[e] = __expf(c15); }
        }
        bf16x8 Qf[2], Kf[2];
#pragma unroll
        for (int ks = 0; ks < 2; ++ks) { u32x4 wq, wk;
            wq.x = pk2(qh[8 * ks + 0], qh[8 * ks + 1]); wq.y = pk2(qh[8 * ks + 2], qh[8 * ks + 3]); wq.z = pk2(qh[8 * ks + 4], qh[8 * ks + 5]); wq.w = pk2(qh[8 * ks + 6], qh[8 * ks + 7]);
            wk.x = pk2(kt_[8 * ks + 0], kt_[8 * ks + 1]); wk.y = pk2(kt_[8 * ks + 2], kt_[8 * ks + 3]); wk.z = pk2(kt_[8 * ks + 4], kt_[8 * ks + 5]); wk.w = pk2(kt_[8 * ks + 6], kt_[8 * ks + 7]);
            Qf[ks] = __builtin_bit_cast(bf16x8, wq); Kf[ks] = __builtin_bit_cast(bf16x8, wk); }
#pragma unroll
        for (int e4 = 0; e4 < 4; ++e4) { u32x2 w; w.x = pk2(kp[4 * e4 + 0], kp[4 * e4 + 1]); w.y = pk2(kp[4 * e4 + 2], kp[4 * e4 + 3]); *(LAS u32x2*)(kls + tt * 144 + (16 * e4 + 4 * g) * 2) = w; }
        f32x4 at = (f32x4){0.f, 0.f, 0.f, 0.f};
        at = __builtin_amdgcn_mfma_f32_16x16x32_bf16(Kf[0], Qf[0], at, 0, 0, 0); at = __builtin_amdgcn_mfma_f32_16x16x32_bf16(Kf[1], Qf[1], at, 0, 0, 0);
#pragma unroll
        for (int r = 0; r < 4; ++r) at[r] = (4 * g + r <= tt) ? at[r] : 0.f;
        u32x4 wa; wa.x = pk2(at[0], at[1]); wa.y = pk2(at[2], at[3]); wa.z = 0u; wa.w = 0u; const bf16x8 Af = __builtin_bit_cast(bf16x8, wa);
        bf16x8 Vf[4];
        { const float* vp = HG + (tok0 + 16 * sb + 4 * g) * 1024 + 512 + hh * 64 + tt;
#pragma unroll
          for (int vq = 0; vq < 4; ++vq) { u32x4 w; w.x = pk2(vp[16 * vq], vp[1024 + 16 * vq]); w.y = pk2(vp[2048 + 16 * vq], vp[3072 + 16 * vq]); w.z = 0u; w.w = 0u; Vf[vq] = __builtin_bit_cast(bf16x8, w); } }
        f32x4 O[4];
#pragma unroll
        for (int vq = 0; vq < 4; ++vq) {
            u32x4 s0, s1; s0.x = pk2(S[vq][0][0], S[vq][0][1]); s0.y = pk2(S[vq][0][2], S[vq][0][3]); s0.z = pk2(S[vq][1][0], S[vq][1][1]); s0.w = pk2(S[vq][1][2], S[vq][1][3]);
            s1.x = pk2(S[vq][2][0], S[vq][2][1]); s1.y = pk2(S[vq][2][2], S[vq][2][3]); s1.z = pk2(S[vq][3][0], S[vq][3][1]); s1.w = pk2(S[vq][3][2], S[vq][3][3]);
            f32x4 o = (f32x4){0.f, 0.f, 0.f, 0.f};
            o = __builtin_amdgcn_mfma_f32_16x16x32_bf16(Qf[0], __builtin_bit_cast(bf16x8, s0), o, 0, 0, 0); o = __builtin_amdgcn_mfma_f32_16x16x32_bf16(Qf[1], __builtin_bit_cast(bf16x8, s1), o, 0, 0, 0);
            o = __builtin_amdgcn_mfma_f32_16x16x32_bf16(Af, Vf[vq], o, 0, 0, 0); O[vq] = o; }
        { float rs[4];
#pragma unroll
          for (int r = 0; r < 4; ++r) { float ss = O[0][r] * O[0][r] + O[1][r] * O[1][r] + O[2][r] * O[2][r] + O[3][r] * O[3][r]; ss = row_sum16(ss); rs[r] = 1.0f / sqrtf(ss * (1.0f / 64.0f) + EPS); }
          const float* gp = HG + (tok0 + 16 * sb + 4 * g) * 1024 + 768 + hh * 64 + tt; bf16_t* mo = (bf16_t*)(C.ws + WS_MIX) + (tok0 + 16 * sb + 4 * g) * D + 768 + hh * 64 + tt;
#pragma unroll
          for (int vq = 0; vq < 4; ++vq) { const float ngv = a.hgrn_g[l * 64 + 16 * vq + tt];
#pragma unroll
            for (int r = 0; r < 4; ++r) mo[(size_t)r * D + 16 * vq] = (bf16_t)f2bf(O[vq][r] * rs[r] * ngv * siluf_(gp[(size_t)r * 1024 + 16 * vq])); } }
        asm volatile("s_waitcnt lgkmcnt(0)" ::: "memory");
#pragma unroll
        for (int kt = 0; kt < 4; ++kt) {
            const s16x4 t4 = __builtin_amdgcn_ds_read_tr16_b64_v4i16((LAS s16x4*)(kls + (4 * g + (tt >> 2)) * 144 + (16 * kt + 4 * (tt & 3)) * 2));
            const bf16x8 Ktf = (bf16x8){t4[0], t4[1], t4[2], t4[3], 0, 0, 0, 0};
            const f32x4 dv = (f32x4){dd[4 * kt + 0], dd[4 * kt + 1], dd[4 * kt + 2], dd[4 * kt + 3]};
#pragma unroll
            for (int vq = 0; vq < 4; ++vq) S[vq][kt] = __builtin_amdgcn_mfma_f32_16x16x32_bf16(Ktf, Vf[vq], S[vq][kt] * dv, 0, 0, 0);
        }
        asm volatile("s_waitcnt lgkmcnt(0)" ::: "memory");
    }
}

__device__ __forceinline__ void hgrn_local4(const Args& a, Ctx& C, int l, int item, LAS unsigned char* kls) {
    const int lane = C.lane, tt = lane & 15, g = lane >> 4, vq = item & 3, cg = (item >> 2) & 15, hh = (item >> 6) & 3, b = item >> 8, bh = b * 4 + hh;
    const float* HG = (const float*)(C.ws + WS_HG);
    float lb[16], ecum[16];
#pragma unroll
    for (int e = 0; e < 16; ++e) { const int kk = hh * 64 + 16 * (e >> 2) + 4 * g + (e & 3); lb[e] = (l == 1) ? 1.0f / (1.0f + expf(a.lb_logits[kk] - a.lb_logits[256 + kk])) : 0.f; ecum[e] = 1.0f; }
    f32x4 S[4];
#pragma unroll
    for (int kt = 0; kt < 4; ++kt) S[kt] = (f32x4){0.f, 0.f, 0.f, 0.f};
    const size_t tokg = (size_t)b * SEQ + (size_t)cg * 256;
    f32x4 zc[4]; float vc[4];
#define HL4_LOAD(zd, vd, sbi) do { const size_t _t0 = tokg + 16 * (sbi); const float* _r = HG + (_t0 + tt) * 1024 + hh * 64 + 4 * g + 256; \
        _Pragma("unroll") for (int e4 = 0; e4 < 4; ++e4) zd[e4] = *(const f32x4*)(_r + 16 * e4); \
        const float* _v = HG + (_t0 + 4 * g) * 1024 + 512 + hh * 64 + 16 * vq + tt; vd[0] = _v[0]; vd[1] = _v[1024]; vd[2] = _v[2048]; vd[3] = _v[3072]; } while (0)
    HL4_LOAD(zc, vc, 0);
#pragma unroll 1
    for (int ci = 0; ci < 4; ++ci) {
        const int c = 4 * cg + ci;
#pragma unroll 1
        for (int sb = 0; sb < 4; ++sb) {
            const int sbi = 4 * ci + sb; f32x4 zn[4]; float vn[4];
            if (sbi < 15) HL4_LOAD(zn, vn, sbi + 1); else {
#pragma unroll
                for (int e4 = 0; e4 < 4; ++e4) { zn[e4] = zc[e4]; vn[e4] = vc[e4]; } }
            float kp[16], dd[16];
#pragma unroll
            for (int e4 = 0; e4 < 4; ++e4) { const f32x4 z4 = zc[e4];
#pragma unroll
                for (int j = 0; j < 4; ++j) { const int e = 4 * e4 + j; const float lbe = lb[e];
                    const float sg = __builtin_amdgcn_rcpf(1.0f + __expf(-z4[j])), sn = __builtin_amdgcn_rcpf(1.0f + __expf(z4[j]));
                    const float lf = __logf(lbe + (1.0f - lbe) * sg), kin = (1.0f - lbe) * sn;
                    const float cc = row_scan16(lf), c15 = row_last16(cc);
                    kp[e] = kin * __expf(c15 - cc); dd[e] = __expf(c15); ecum[e] *= dd[e]; } }
#pragma unroll
            for (int e4 = 0; e4 < 4; ++e4) { u32x2 w; w.x = pk2(kp[4 * e4 + 0], kp[4 * e4 + 1]); w.y = pk2(kp[4 * e4 + 2], kp[4 * e4 + 3]); *(LAS u32x2*)(kls + tt * 144 + (16 * e4 + 4 * g) * 2) = w; }
            bf16x8 Vf; { u32x4 w; w.x = pk2(vc[0], vc[1]); w.y = pk2(vc[2], vc[3]); w.z = 0u; w.w = 0u; Vf = __builtin_bit_cast(bf16x8, w); }
            asm volatile("s_waitcnt lgkmcnt(0)" ::: "memory");
#pragma unroll
            for (int kt = 0; kt < 4; ++kt) {
                const s16x4 t4 = __builtin_amdgcn_ds_read_tr16_b64_v4i16((LAS s16x4*)(kls + (4 * g + (tt >> 2)) * 144 + (16 * kt + 4 * (tt & 3)) * 2));
                const bf16x8 Ktf = (bf16x8){t4[0], t4[1], t4[2], t4[3], 0, 0, 0, 0};
                const f32x4 dv = (f32x4){dd[4 * kt + 0], dd[4 * kt + 1], dd[4 * kt + 2], dd[4 * kt + 3]};
                S[kt] = __builtin_amdgcn_mfma_f32_16x16x32_bf16(Ktf, Vf, S[kt] * dv, 0, 0, 0);
            }
            asm volatile("s_waitcnt lgkmcnt(0)" ::: "memory");
#pragma unroll
            for (int e4 = 0; e4 < 4; ++e4) { zc[e4] = zn[e4]; vc[e4] = vn[e4]; }
        }
        const size_t ch = (size_t)(bh * 64 + c);
        float* hr = (float*)(C.ws + WS_HL) + ch * 4096 + (g * 16 + tt) * 4;
#pragma unroll
        for (int kt = 0; kt < 4; ++kt) *(f32x4*)(hr + (vq * 4 + kt) * 256) = S[kt];
        if (vq == 0 && tt == 0) { float* he = (float*)(C.ws + WS_HD) + ch * 64 + 4 * g;
#pragma unroll
            for (int kt = 0; kt < 4; ++kt) *(f32x4*)(he + 16 * kt) = (f32x4){ecum[4 * kt + 0], ecum[4 * kt + 1], ecum[4 * kt + 2], ecum[4 * kt + 3]}; }
    }
#undef HL4_LOAD
}

__device__ __forceinline__ void phase_mix1(const Args& a, Ctx& C, int l) {
    if (C.wave < 4) for (int it = blockIdx.x * 4 + C.wave; it < 1024; it += C.G * 4) hgrn_local4(a, C, l, it, C.lds + C.wave * 4096);
    __syncthreads();
    pool_wave(a, C, l);
    __syncthreads();
    Conv cv; cv.w1l = a.w1 + (size_t)l * 32 * 1024 * 2048; cv.w2l = a.w2 + (size_t)l * 32 * 1024 * 1024; cv.w1t = C.ws + WS_W1 + (size_t)l * 32 * 2048 * 1024; cv.w2t = C.ws + WS_W2 + (size_t)l * 32 * 1024 * 1024;
    cv.it = blockIdx.x * NWAVES + C.wave; cv.step = C.G * NWAVES; cv.lane = C.lane; cv.pend = false; cv.it_end = CONV_SPLIT;
    for (int base = 0; base < 2048; base += 2 * C.G) {
        const int u1 = base + (int)blockIdx.x, u2 = base + 2 * C.G - 1 - (int)blockIdx.x;
        if (u1 < 2048) index_unit2(C, (u1 >> 3) & 3, u1 >> 5, u1 & 7, cv);
        if (u2 < 2048) index_unit2(C, (u2 >> 3) & 3, u2 >> 5, u2 & 7, cv);
    }
    for (;;) { cv.issue(); if (!cv.pend) break; cv.finish((LAS float*)(C.lds + 65536 + C.wave * KST_BYTES)); }
}
__device__ __forceinline__ void phase_mix2(const Args& a, Ctx& C, int l) {
    LAS int* qctr = (LAS int*)(C.lds + LDS_BYTES - 64 + 16);
    if (C.tid == 0) *qctr = 0;
    __syncthreads();
    if (C.wave < 4) for (int it = blockIdx.x * 4 + C.wave; it < 1024; it += C.G * 4) hgrn_out3(a, C, l, it, C.lds + C.wave * (2 * 32 * VROW));
    LAS unsigned char* vs = C.lds + C.wave * (2 * 32 * VROW);
    const int gw = blockIdx.x * NWAVES + C.wave, NGW = C.G * NWAVES;
    Conv cv; cv.w1l = a.w1 + (size_t)l * 32 * 1024 * 2048; cv.w2l = a.w2 + (size_t)l * 32 * 1024 * 1024; cv.w1t = C.ws + WS_W1 + (size_t)l * 32 * 2048 * 1024; cv.w2t = C.ws + WS_W2 + (size_t)l * 32 * 1024 * 1024;
    cv.it = CONV_SPLIT + gw; cv.step = NGW; cv.lane = C.lane; cv.pend = false; cv.it_end = Conv::NITEMS;
    for (;;) {
        int n = 0; if (C.lane == 0) n = __hip_atomic_fetch_add(qctr, 1, __ATOMIC_RELAXED, __HIP_MEMORY_SCOPE_WORKGROUP);
        n = __builtin_amdgcn_readfirstlane(n);
        const int tk = (int)blockIdx.x * NWAVES + (n & 7) + NGW * (n >> 3);
        if (tk >= NTOK) break;
        attend_query_mfma(C, tk, vs, cv);
    }
    for (;;) { cv.finish((LAS float*)vs); cv.issue(); if (!cv.pend) break; }
}

constexpr int URS = 2064;
__device__ __forceinline__ void phase_router2(const Args& a, Ctx& C, int l) {
    unsigned char* ws = C.ws; const int lane = C.lane, w = C.wave, tid = C.tid;
    LAS unsigned char* uh = C.lds; LAS unsigned char* ul = uh + 16 * URS; LAS float* part = (LAS float*)(ul + 16 * URS);
    LAS int* hist = (LAS int*)(part + 8 * 16 * 32);
    LAS int* asg = hist + 64;
    LAS float* asgg = (LAS float*)(asg + 2 * 1024);
    const float* mod = (const float*)(ws + WS_MOD); const float* H = (const float*)(ws + WS_H);
    const bf16_t* wrh = (const bf16_t*)(ws + WS_WRH) + (size_t)l * 32768; const bf16_t* wrl = (const bf16_t*)(ws + WS_WRL) + (size_t)l * 32768;
    unsigned* cnt = (unsigned*)(ws + WS_CTL) + CW_CNT + l * 32 * 64;
    const int ntile_all = NTOK / 16;
    bf16x8 wbh0[4], wbl0[4], wbh1[4], wbl1[4];
    { const int c = lane & 15, g = lane >> 4;
#pragma unroll
      for (int kk = 0; kk < 4; ++kk) { const int ks = 4 * w + kk;
          wbh0[kk] = *(const bf16x8*)(wrh + (size_t)c * 1024 + 32 * ks + 8 * g); wbl0[kk] = *(const bf16x8*)(wrl + (size_t)c * 1024 + 32 * ks + 8 * g);
          wbh1[kk] = *(const bf16x8*)(wrh + (size_t)(c + 16) * 1024 + 32 * ks + 8 * g); wbl1[kk] = *(const bf16x8*)(wrl + (size_t)(c + 16) * 1024 + 32 * ks + 8 * g); } }
    for (int tile0 = blockIdx.x; tile0 < ntile_all; tile0 += 16 * C.G) {
        if (tid < 64) hist[tid] = 0;
        __syncthreads();
        int nt_here = 0;
        f32x4 hv[2][4];
#pragma unroll
        for (int hf = 0; hf < 2; ++hf) { const f32x4* hr = (const f32x4*)(H + (size_t)(tile0 * 16 + 2 * w + hf) * D) + lane;
#pragma unroll
            for (int j = 0; j < 4; ++j) hv[hf][j] = hr[64 * j]; }
        for (int tile = tile0; tile < ntile_all && nt_here < 16; tile += C.G, ++nt_here) {
            const int tok0 = tile * 16;
#pragma unroll
            for (int hf = 0; hf < 2; ++hf) {
                const int tr = 2 * w + hf, tk = tok0 + tr, b = tk >> 12; f32x4 v[4];
#pragma unroll
                for (int j = 0; j < 4; ++j) v[j] = hv[hf][j];
                float ss = 0.f;
#pragma unroll
                for (int j = 0; j < 4; ++j) ss += (v[j].x * v[j].x + v[j].y * v[j].y) + (v[j].z * v[j].z + v[j].w * v[j].w);
                const float rstd = 1.0f / sqrtf(wave_sum(ss) * (1.0f / D) + EPS);
                const float* mb = mod + (size_t)(l * 4 + b) * 6144; unsigned char* u8row = ws + WS_U + (size_t)tk * D;
#pragma unroll
                for (int j = 0; j < 4; ++j) { const int idx = 4 * lane + 256 * j; const f32x4 gv = *(const f32x4*)(a.norm2_g + l * 1024 + idx), shv = *(const f32x4*)(mb + 3072 + idx), scv = *(const f32x4*)(mb + 4096 + idx);
                    const f32x4 o = v[j] * rstd * gv * (scv + 1.0f) + shv; u32x2 hi; hi.x = pk2(o[0], o[1]); hi.y = pk2(o[2], o[3]); *(unsigned*)(u8row + idx) = pk4_fp8(o[0], o[1], o[2], o[3]);
                    u32x2 lo; lo.x = pk2(o[0] - bflo(hi.x), o[1] - bfhi(hi.x)); lo.y = pk2(o[2] - bflo(hi.y), o[3] - bfhi(hi.y));
                    *(LAS u32x2*)(uh + tr * URS + idx * 2) = hi; *(LAS u32x2*)(ul + tr * URS + idx * 2) = lo; }
            }
            { const int ntile2 = tile + C.G; if (ntile2 < ntile_all && nt_here + 1 < 16) {
#pragma unroll
                for (int hf = 0; hf < 2; ++hf) { const f32x4* hr = (const f32x4*)(H + (size_t)(ntile2 * 16 + 2 * w + hf) * D) + lane;
#pragma unroll
                    for (int j = 0; j < 4; ++j) hv[hf][j] = hr[64 * j]; } } }
            __syncthreads();
            {
                const int c = lane & 15, g = lane >> 4; f32x4 acc0 = (f32x4){0.f, 0.f, 0.f, 0.f}, acc1 = acc0;
#pragma unroll
                for (int kk = 0; kk < 4; ++kk) { const int ks = 4 * w + kk;
                    const bf16x8 ah = *(const LAS bf16x8*)(uh + c * URS + (32 * ks + 8 * g) * 2), al = *(const LAS bf16x8*)(ul + c * URS + (32 * ks + 8 * g) * 2);
                    acc0 = __builtin_amdgcn_mfma_f32_16x16x32_bf16(al, wbh0[kk], acc0, 0, 0, 0); acc0 = __builtin_amdgcn_mfma_f32_16x16x32_bf16(ah, wbl0[kk], acc0, 0, 0, 0); acc0 = __builtin_amdgcn_mfma_f32_16x16x32_bf16(ah, wbh0[kk], acc0, 0, 0, 0);
                    acc1 = __builtin_amdgcn_mfma_f32_16x16x32_bf16(al, wbh1[kk], acc1, 0, 0, 0); acc1 = __builtin_amdgcn_mfma_f32_16x16x32_bf16(ah, wbl1[kk], acc1, 0, 0, 0); acc1 = __builtin_amdgcn_mfma_f32_16x16x32_bf16(ah, wbh1[kk], acc1, 0, 0, 0); }
#pragma unroll
                for (int r = 0; r < 4; ++r) { part[(w * 16 + 4 * g + r) * 32 + c] = acc0[r]; part[(w * 16 + 4 * g + r) * 32 + 16 + c] = acc1[r]; }
            }
            __syncthreads();
            {
                const int e = lane & 31, hf = lane >> 5, tr = 2 * w + hf; float val = a.b_router[l * 32 + e];
#pragma unroll
                for (int ww = 0; ww < 8; ++ww) val += part[(ww * 16 + tr) * 32 + e];
                float tv[4]; int te[4];
#pragma unroll
                for (int k = 0; k < 4; ++k) {
                    float bv = val; int bi = e;
#pragma unroll
                    for (int o = 1; o < 32; o <<= 1) { const float ov = __shfl_xor(bv, o); const int oi = __shfl_xor(bi, o); if (ov > bv || (ov == bv && oi < bi)) { bv = ov; bi = oi; } }
                    tv[k] = bv; te[k] = bi; if (e == bi) val = -3.0e38f;
                }
                const float e1 = __expf(tv[1] - tv[0]), e2 = __expf(tv[2] - tv[0]), e3 = __expf(tv[3] - tv[0]); const float rs = 1.0f / (1.0f + e1 + e2 + e3);
                if (e < 4) {
                    const int ex = e == 0 ? te[0] : e == 1 ? te[1] : e == 2 ? te[2] : te[3]; const float gt = (e == 0 ? 1.0f : e == 1 ? e1 : e == 2 ? e2 : e3) * rs;
                    const int ai = (nt_here * 16 + tr) * 4 + e;
                    asg[2 * ai] = ex; asg[2 * ai + 1] = __hip_atomic_fetch_add(&hist[ex], 1, __ATOMIC_RELAXED, __HIP_MEMORY_SCOPE_WORKGROUP); asgg[ai] = gt;
                }
            }
            __syncthreads();
        }
        if (tid < 32) { const int hc = hist[tid]; hist[32 + tid] = hc ? (int)atomicAdd(cnt + tid * 64, (unsigned)hc) : 0; }
        __syncthreads();
        for (int ai = tid; ai < nt_here * 64; ai += NTHREADS) {
            const int ti = ai >> 6, tr = (ai >> 2) & 15, k = ai & 3, tk = (tile0 + ti * C.G) * 16 + tr;
            const int ex = asg[2 * ai], slot = hist[32 + ex] + asg[2 * ai + 1];
            ((int*)(ws + WS_ROWTOK))[(size_t)ex * NTOK + slot] = tk;
            ((int*)(ws + WS_EIDX))[tk * 4 + k] = ex; ((int*)(ws + WS_SLOT))[tk * 4 + k] = slot; ((float*)(ws + WS_GATE))[tk * 4 + k] = asgg[ai];
        }
        __syncthreads();
    }
}

__device__ __forceinline__ void moe_table(Ctx& C, int l, LAS int* tab) {
    if (C.tid < 32) { const unsigned* cnt = (const unsigned*)(C.ws + WS_CTL) + CW_CNT + l * 32 * 64; tab[33 + C.tid] = (int)__hip_atomic_load(cnt + C.tid * 64, __ATOMIC_RELAXED, __HIP_MEMORY_SCOPE_AGENT); }
    __syncthreads();
    if (C.tid == 0) { int p = 0; for (int e = 0; e < 32; ++e) { tab[e] = p; p += (tab[33 + e] + 255) >> 8; } tab[32] = p; }
    __syncthreads();
}

__device__ __forceinline__ void phase_combine(const Args& a, Ctx& C, int l) {
    unsigned char* ws = C.ws; const int lane = C.lane;
    const float* mod = (const float*)(ws + WS_MOD); float* H = (float*)(ws + WS_H); const bf16_t* Y = (const bf16_t*)(ws + WS_Y);
    const unsigned* cnt = (const unsigned*)(ws + WS_CTL) + CW_CNT + l * 32 * 64;
    int mt = 0; if (lane < 32) mt = ((int)__hip_atomic_load(cnt + lane * 64, __ATOMIC_RELAXED, __HIP_MEMORY_SCOPE_AGENT) + 255) >> 8;
    int incl = mt;
#pragma unroll
    for (int o = 1; o < 32; o <<= 1) { const int t = __shfl_up(incl, o); if ((lane & 31) >= o) incl += t; }
    const int excl = incl - mt;
    const int gw = blockIdx.x * NWAVES + C.wave, NGW = C.G * NWAVES;
    for (int tk0 = gw; tk0 < NTOK; tk0 += 2 * NGW) {
        int tks[2]; tks[0] = tk0; tks[1] = (tk0 + NGW) < NTOK ? tk0 + NGW : tk0; const bool two = (tk0 + NGW) < NTOK;
        f32x4 v[2][4]; u32x2 yv[2][4][4]; float gts[2][4];
#pragma unroll
        for (int q = 0; q < 2; ++q) { const int tk = tks[q]; const f32x4* hr = (const f32x4*)(H + (size_t)tk * D) + lane;
#pragma unroll
            for (int j = 0; j < 4; ++j) v[q][j] = hr[64 * j];
            const int4 ex4 = *(const int4*)((const int*)(ws + WS_EIDX) + tk * 4), sl4 = *(const int4*)((const int*)(ws + WS_SLOT) + tk * 4); const f32x4 g4 = *(const f32x4*)((const float*)(ws + WS_GATE) + tk * 4);
            const int exs[4] = {ex4.x, ex4.y, ex4.z, ex4.w}, sls[4] = {sl4.x, sl4.y, sl4.z, sl4.w};
#pragma unroll
            for (int k = 0; k < 4; ++k) { gts[q][k] = g4[k]; const int row = 256 * __shfl(excl, exs[k]) + sls[k]; const u32x2* yr = (const u32x2*)(Y + (size_t)row * D) + lane;
#pragma unroll
                for (int j = 0; j < 4; ++j) yv[q][k][j] = yr[64 * j]; }
        }
#pragma unroll
        for (int q = 0; q < 2; ++q) {
            if (q == 1 && !two) break;
            const int tk = tks[q], b = tk >> 12; f32x4* hr = (f32x4*)(H + (size_t)tk * D) + lane;
            f32x4 m[4];
#pragma unroll
            for (int j = 0; j < 4; ++j) m[j] = (f32x4){0.f, 0.f, 0.f, 0.f};
#pragma unroll
            for (int k = 0; k < 4; ++k)
#pragma unroll
                for (int j = 0; j < 4; ++j) { const u32x2 w = yv[q][k][j]; m[j] += (f32x4){bflo(w.x), bfhi(w.x), bflo(w.y), bfhi(w.y)} * gts[q][k]; }
            const float* mb = mod + (size_t)(l * 4 + b) * 6144;
            f32x4 vv[4];
#pragma unroll
            for (int j = 0; j < 4; ++j) { const f32x4 g2 = *(const f32x4*)(mb + 5120 + 4 * lane + 256 * j); vv[j] = v[q][j] + g2 * m[j]; if (l + 1 < DEPTH) hr[64 * j] = vv[j]; }
            if (l + 1 < DEPTH) { const float* mn = mod + (size_t)((l + 1) * 4 + b) * 6144; norm_mod_store(vv, a.norm1_g + (l + 1) * 1024, mn + 0, mn + 1024, (bf16_t*)(ws + WS_U) + (size_t)tk * D, lane); }
            else {
                float ss = 0.f;
#pragma unroll
                for (int j = 0; j < 4; ++j) ss += (vv[j].x * vv[j].x + vv[j].y * vv[j].y) + (vv[j].z * vv[j].z + vv[j].w * vv[j].w);
                const float rstd = 1.0f / sqrtf(wave_sum(ss) * (1.0f / D) + EPS);
                f32x4* orow = (f32x4*)(a.out + (size_t)tk * D) + lane;
#pragma unroll
                for (int j = 0; j < 4; ++j) orow[64 * j] = vv[j] * rstd * *(const f32x4*)(a.final_g + 4 * lane + 256 * j);
            }
        }
    }
}

#define XB_TMO      128
#define XB_XCNT(j)  (256  + 64 * (j))
#define XB_XSUB(j)  (1280 + 64 * (j))
#define XB_XGEN(j)  (2304 + 64 * (j))
#define XB_TOP      3328
#define XB_TOPGEN   3392
#define XCD_BAR_WORDS 3456
#define XB_SPIN_CAP (1u << 22)
__device__ __forceinline__ unsigned xb_ld(unsigned* p)              { return __hip_atomic_load(p, __ATOMIC_RELAXED, __HIP_MEMORY_SCOPE_AGENT); }
__device__ __forceinline__ unsigned xb_add(unsigned* p, unsigned v) { return __hip_atomic_fetch_add(p, v, __ATOMIC_RELAXED, __HIP_MEMORY_SCOPE_AGENT); }
__device__ __forceinline__ unsigned xb_xcc_id() { return (unsigned)__builtin_amdgcn_s_getreg((3 << 11) | 20) & 0xFu; }
#define XB_SPIN(cond, bar) do { unsigned _sp = 0; while (cond) { __builtin_amdgcn_s_sleep(1); \
    if ((++_sp & 255u) == 0u) { if (xb_ld(&(bar)[XB_TMO])) break; if (_sp > XB_SPIN_CAP) { atomicAdd(&(bar)[XB_TMO], 1u); break; } } } } while (0)
struct XcdBarrier { unsigned* bar; unsigned x; volatile LAS unsigned* st; };
__device__ __forceinline__ XcdBarrier xcd_barrier_post(unsigned* bar, volatile LAS unsigned* st, bool leader) {
    XcdBarrier b; b.bar = bar; b.x = xb_xcc_id(); b.st = st;
    if (leader) (void)xb_add(&bar[XB_XCNT(b.x)], 1u);
    return b;
}
__device__ __forceinline__ void xcd_barrier_complete(unsigned* bar, unsigned x, unsigned& nloc, unsigned& nx) {
    const unsigned G = gridDim.x * gridDim.y * gridDim.z;
    unsigned sum, cnt, mine, sp = 0u;
    for (;;) {
        sum = 0u; cnt = 0u; mine = 0u;
#pragma unroll
        for (unsigned j = 0; j < 16; ++j) { const unsigned c = xb_ld(&bar[XB_XCNT(j)]); sum += c; cnt += (c > 0u) ? 1u : 0u; mine = (j == x) ? c : mine; }
        if (sum == G) break;
        __builtin_amdgcn_s_sleep(1);
        if ((++sp & 255u) == 0u) { if (xb_ld(&bar[XB_TMO])) break; if (sp > XB_SPIN_CAP) { atomicAdd(&bar[XB_TMO], 1u); break; } }
    }
    nloc = mine > 0u ? mine : 1u; nx = cnt > 0u ? cnt : 1u;
}
__device__ __forceinline__ void xcd_barrier(const XcdBarrier& b, bool leader) {
    asm volatile("s_waitcnt vmcnt(0)" ::: "memory");
    __syncthreads();
    if (leader) {
        unsigned* bar = b.bar;
        __builtin_amdgcn_s_waitcnt(0);
        unsigned nloc = b.st[0], nx = b.st[1];
        if (nloc == 0u) { xcd_barrier_complete(bar, b.x, nloc, nx); b.st[0] = nloc; b.st[1] = nx; }
        const unsigned old = xb_add(&bar[XB_XSUB(b.x)], 1u);
        const unsigned gen = old / nloc;
        if (old + 1u == (gen + 1u) * nloc) {
            __builtin_amdgcn_fence(__ATOMIC_RELEASE, "agent");
            asm volatile("s_waitcnt vmcnt(0)" ::: "memory");
            const unsigned og = xb_add(&bar[XB_TOP], 1u);
            const unsigned tg = og / nx;
            if (og + 1u == (tg + 1u) * nx) xb_add(&bar[XB_TOPGEN], 1u);
            else XB_SPIN(xb_ld(&bar[XB_TOPGEN]) == tg, bar);
            __builtin_amdgcn_fence(__ATOMIC_ACQUIRE, "agent");
            xb_add(&bar[XB_XGEN(b.x)], 1u);
            asm volatile("s_waitcnt vmcnt(0)" ::: "memory");
        } else {
            XB_SPIN(xb_ld(&bar[XB_XGEN(b.x)]) == gen, bar);
            __builtin_amdgcn_fence(__ATOMIC_ACQUIRE, "agent");
            asm volatile("s_waitcnt vmcnt(0)" ::: "memory");
        }
    }
    __syncthreads();
}

typedef const __attribute__((address_space(4))) Args* KArgsPtr;
__device__ __forceinline__ Args load_args() {
#if defined(__HIP_DEVICE_COMPILE__)
    KArgsPtr p = (KArgsPtr)__builtin_amdgcn_kernarg_segment_ptr(); asm volatile("" : "+s"(p)); Args a;
    a.x = p->x; a.c = p->c; a.pos = p->pos; a.w_ada = p->w_ada; a.b_ada = p->b_ada; a.norm1_g = p->norm1_g; a.norm2_g = p->norm2_g; a.w_in = p->w_in; a.w_out = p->w_out; a.pool_w = p->pool_w;
    a.pool_scale = p->pool_scale; a.hgrn_g = p->hgrn_g; a.lb_logits = p->lb_logits; a.w_router = p->w_router; a.b_router = p->b_router; a.w1 = p->w1; a.b1 = p->b1; a.w2 = p->w2; a.b2 = p->b2; a.final_g = p->final_g;
    a.out = p->out; a.ws = p->ws; a.ph_lo = p->ph_lo; a.ph_hi = p->ph_hi; return a;
#else
    return Args{};
#endif
}
__device__ __forceinline__ int lane_id() { return __builtin_amdgcn_mbcnt_hi(~0u, __builtin_amdgcn_mbcnt_lo(~0u, 0)); }
__device__ __forceinline__ Ctx make_ctx(unsigned char* ws, int wv) {
    extern __shared__ __attribute__((aligned(16))) unsigned char lds_raw[];
    Ctx C; C.lds = (LAS unsigned char*)lds_raw; { int l_ = lane_id(); asm volatile("" : "+v"(l_)); C.lane = l_; } C.wave = wv; C.tid = wv * 64 + C.lane;
    C.G = gridDim.x; { const int bx = blockIdx.x; C.vcu = (C.G % 8 == 0) ? (bx % 8) * (C.G / 8) + bx / 8 : bx; }
    C.ws = ws; return C;
}
#ifndef PHASE_FN
#define PHASE_FN __device__ __forceinline__ void
#endif
#define GEMM_FN __device__ __forceinline__ void
PHASE_FN ph_prep(int wv) { const Args a = load_args(); Ctx C = make_ctx(a.ws, wv); phase_prep(a, C); }
PHASE_FN ph_u0(int wv) { const Args a = load_args(); Ctx C = make_ctx(a.ws, wv); phase_u0(a, C); }
GEMM_FN ph_gin(int l, int wv) { const Args a = load_args(); Ctx C = make_ctx(a.ws, wv); unsigned char* ws = a.ws;
    DenseOrder S{(const char*)(ws + WS_U), (const char*)(ws + WS_WIN) + (size_t)l * NPAD * 1024 * 2, NTOK / 256, NPAD / 256, (NTOK / 256) * (NPAD / 256), C.G, (int)blockIdx.x};
    EpiIn E{ws}; pg8::gemm_phase<EpiIn, DenseOrder, false, true>(C.lds, (LAS unsigned*)(C.lds + LDS_PARK), C.tid, S, E); }
PHASE_FN ph_mix1(int l, int wv) { const Args a = load_args(); Ctx C = make_ctx(a.ws, wv); phase_mix1(a, C, l); }
PHASE_FN ph_mix2(int l, int wv) { const Args a = load_args(); Ctx C = make_ctx(a.ws, wv); phase_mix2(a, C, l); }
GEMM_FN ph_gout(int l, int wv) { const Args a = load_args(); Ctx C = make_ctx(a.ws, wv); unsigned char* ws = a.ws;
    DenseOrder S{(const char*)(ws + WS_MIX), (const char*)(ws + WS_WOUT) + (size_t)l * 1024 * 1024 * 2, NTOK / 256, 4, (NTOK / 256) * 4, C.G, (int)blockIdx.x};
    EpiOut E{l == 0 ? a.x : (const float*)(ws + WS_H), (float*)(ws + WS_H), (const float*)(ws + WS_MOD) + (size_t)l * 4 * 6144 + 2048};
    pg8::gemm_phase<EpiOut, DenseOrder, false, true>(C.lds, (LAS unsigned*)(C.lds + LDS_PARK), C.tid, S, E); }
PHASE_FN ph_router(int l, int wv) { const Args a = load_args(); Ctx C = make_ctx(a.ws, wv); phase_router2(a, C, l); }
GEMM_FN ph_g1(int l, int wv) { const Args a = load_args(); Ctx C = make_ctx(a.ws, wv); unsigned char* ws = a.ws;
    LAS int* tab = (LAS int*)(C.lds + LDS_TAB); moe_table(C, l, tab);
    MoeOrder<true> S{tab, (const char*)(ws + WS_U), (const char*)(ws + WS_W1) + (size_t)l * 32 * 2048 * 1024, (const int*)(ws + WS_ROWTOK), C.G, C.vcu};
    EpiG1 E{ws + WS_ACT, a.b1 + (size_t)l * 32 * 2048}; pg8::gemm_phase<EpiG1, MoeOrder<true>, true, true, true>(C.lds, (LAS unsigned*)(C.lds + LDS_PARK), C.tid, S, E); }
GEMM_FN ph_g2(int l, int wv) { const Args a = load_args(); Ctx C = make_ctx(a.ws, wv); unsigned char* ws = a.ws;
    LAS int* tab = (LAS int*)(C.lds + LDS_TAB); moe_table(C, l, tab);
    MoeOrder<false> S{tab, (const char*)(ws + WS_ACT), (const char*)(ws + WS_W2) + (size_t)l * 32 * 1024 * 1024, nullptr, C.G, C.vcu};
    EpiG2 E{(bf16_t*)(ws + WS_Y), a.b2 + (size_t)l * 32 * 1024}; pg8::gemm_phase<EpiG2, MoeOrder<false>, false, true, true>(C.lds, (LAS unsigned*)(C.lds + LDS_PARK), C.tid, S, E); }
PHASE_FN ph_combine(int l, int wv) { const Args a = load_args(); Ctx C = make_ctx(a.ws, wv); phase_combine(a, C, l); }

constexpr int NPHASES = 2 + 8 * DEPTH;
__global__ void __launch_bounds__(NTHREADS, 2) mega_fwd(Args a) {
#if MK_ONE_LAUNCH == 1
    cg::grid_group grid = cg::this_grid();
#define SEAM() do { __syncthreads(); grid.sync(); } while (0)
#elif MK_ONE_LAUNCH == 2
    extern __shared__ __attribute__((aligned(16))) unsigned char lds_k[];
    volatile LAS unsigned* bst = (volatile LAS unsigned*)((LAS unsigned char*)lds_k + LDS_BYTES - 64);
    const bool leader = (threadIdx.x == 0);
    if (leader) { bst[0] = 0u; bst[1] = 0u; }
    __syncthreads();
    const XcdBarrier xbar = xcd_barrier_post((unsigned*)(a.ws + WS_CTL) + CW_BAR, bst, leader);
#define SEAM() xcd_barrier(xbar, leader)
#else
#define SEAM() do { } while (0)
#endif
    const int lo = a.ph_lo, hi = a.ph_hi;
    const int wv = __builtin_amdgcn_readfirstlane((int)threadIdx.x >> 6);
#define RUN(id, call) do { if (lo <= (id) && (id) < hi) { call; if ((id) + 1 < hi) SEAM(); } } while (0)
    RUN(0, ph_prep(wv));
    RUN(1, ph_u0(wv));
    RUN(2, ph_gin(0, wv)); RUN(3, ph_mix1(0, wv)); RUN(4, ph_mix2(0, wv)); RUN(5, ph_gout(0, wv)); RUN(6, ph_router(0, wv)); RUN(7, ph_g1(0, wv)); RUN(8, ph_g2(0, wv)); RUN(9, ph_combine(0, wv));
    RUN(10, ph_gin(1, wv)); RUN(11, ph_mix1(1, wv)); RUN(12, ph_mix2(1, wv)); RUN(13, ph_gout(1, wv)); RUN(14, ph_router(1, wv)); RUN(15, ph_g1(1, wv)); RUN(16, ph_g2(1, wv)); RUN(17, ph_combine(1, wv));
#undef RUN
}

extern "C" void kernel_launch(void* const* d_in, const int* in_sizes, int n_in, void* d_out, int out_size, void* d_ws, size_t ws_size, hipStream_t stream) {
    static int grid = 0;
    if (grid == 0) {
        if (n_in != 20 || out_size != NTOK * D || ws_size < WS_END) { fprintf(stderr, "kernel_launch: unexpected shapes: n_in %d out %d ws %zu (need %zu)\n", n_in, out_size, ws_size, (size_t)WS_END); grid = -1; return; }
        int dev = 0, cus = 0, per_cu = 0;
        hipGetDevice(&dev); hipDeviceGetAttribute(&cus, hipDeviceAttributeMultiprocessorCount, dev);
        if (hipFuncSetAttribute((const void*)mega_fwd, hipFuncAttributeMaxDynamicSharedMemorySize, LDS_BYTES) != hipSuccess) { fprintf(stderr, "kernel_launch: hipFuncSetAttribute failed\n"); grid = -1; return; }
        hipOccupancyMaxActiveBlocksPerMultiprocessor(&per_cu, (const void*)mega_fwd, NTHREADS, LDS_BYTES);
        (void)hipGetLastError();
        if (per_cu < 1) fprintf(stderr, "kernel_launch: occupancy query says %d blocks per CU\n", per_cu);
        grid = cus;
    }
    if (grid < 0) return;
    hipMemsetAsync((char*)d_ws + WS_CTL, 0, CTL_BYTES, stream);
    Args a{};
    a.x = (const float*)d_in[0]; a.c = (const float*)d_in[1]; a.pos = (const int*)d_in[2]; a.w_ada = (const float*)d_in[3]; a.b_ada = (const float*)d_in[4];
    a.norm1_g = (const float*)d_in[5]; a.norm2_g = (const float*)d_in[6]; a.w_in = (const float*)d_in[7]; a.w_out = (const float*)d_in[8]; a.pool_w = (const float*)d_in[9];
    a.pool_scale = (const float*)d_in[10]; a.hgrn_g = (const float*)d_in[11]; a.lb_logits = (const float*)d_in[12]; a.w_router = (const float*)d_in[13]; a.b_router = (const float*)d_in[14];
    a.w1 = (const float*)d_in[15]; a.b1 = (const float*)d_in[16]; a.w2 = (const float*)d_in[17]; a.b2 = (const float*)d_in[18]; a.final_g = (const float*)d_in[19];
    a.out = (float*)d_out; a.ws = (unsigned char*)d_ws;
#if MK_ONE_LAUNCH == 1
    a.ph_lo = 0; a.ph_hi = NPHASES;
    void* args[] = {&a};
    hipError_t e = hipLaunchCooperativeKernel((const void*)mega_fwd, dim3(grid), dim3(NTHREADS), args, LDS_BYTES, stream);
    if (e != hipSuccess) fprintf(stderr, "cooperative launch failed: %s (grid %d)\n", hipGetErrorString(e), grid);
#elif MK_ONE_LAUNCH == 2
    a.ph_lo = 0; a.ph_hi = NPHASES;
    hipLaunchKernelGGL(mega_fwd, dim3(grid), dim3(NTHREADS), LDS_BYTES, stream, a);
#else
    for (int p = 0; p < NPHASES; ++p) { a.ph_lo = p; a.ph_hi = p + 1; hipLaunchKernelGGL(mega_fwd, dim3(grid), dim3(NTHREADS), LDS_BYTES, stream, a); }
#endif
}
```
